# Optimizing an MI355X kernel written in HIP

```python
import jax
import jax.numpy as jnp
from jax import lax
import numpy as np

D_MODEL = 1024
BATCH = 1
SEQ = 16384
DEPTH = 2

GRID_W = 64
CTX_LEN = 256
N_MIXERS = 2
N_ATTN_LAYERS = (DEPTH + 1) // 2
N_HGRN_LAYERS = DEPTH // 2
RMS_EPS = 1e-6

ATTN_HEADS = 16
ATTN_KV_HEADS = 2
ATTN_GROUP = ATTN_HEADS // ATTN_KV_HEADS
HEAD_DIM = 64
Q_DIM = ATTN_HEADS * HEAD_DIM
KV_DIM = ATTN_KV_HEADS * HEAD_DIM
QKV_DIM = Q_DIM + 2 * KV_DIM
WINDOW = 128
ATTN_BLOCK = 128
ROPE_BASE = 10000.0

HGRN_HEADS = 8
HGRN_DK = D_MODEL // HGRN_HEADS
HGRN_DV = D_MODEL // HGRN_HEADS
HGRN_FDIM = HGRN_HEADS * HGRN_DK
HGRN_IDIM = HGRN_HEADS * HGRN_DV
HGRN_IN_DIM = 3 * HGRN_FDIM + 2 * HGRN_IDIM
HGRN_CHUNK = 64

N_EXPERTS = 32
TOP_K = 4
D_FF = D_MODEL
SWIGLU_LIMIT = 7.0
SWIGLU_ALPHA = 1.702
MOE_BLOCK = 128

kernel_name = 'hybrid_swa_hgrn2_moe_flow_block'


def rmsnorm(x, g):
    xf = x.astype(jnp.float32)
    y = xf * lax.rsqrt(jnp.mean(xf * xf, axis=-1, keepdims=True) + RMS_EPS)
    return (y * g.astype(jnp.float32)).astype(x.dtype)


def modulate(h, shift, scale):
    return h * (1 + scale) + shift


def axial_angles(rows):
    n = HEAD_DIM // 4
    row_pos = jnp.repeat(jnp.arange(rows, dtype=jnp.float32), GRID_W)
    col_pos = jnp.broadcast_to(jnp.arange(GRID_W, dtype=jnp.float32)[None, :], (rows, GRID_W)).reshape(-1)
    inv_freq = ROPE_BASE ** (-jnp.arange(n, dtype=jnp.float32) / n)
    return row_pos[:, None] * inv_freq[None, :], col_pos[:, None] * inv_freq[None, :]


def _rotate(x, ang):
    x1, x2 = jnp.split(x, 2, axis=-1)
    cos = jnp.cos(ang)[None, :, None, :]
    sin = jnp.sin(ang)[None, :, None, :]
    return jnp.concatenate([x1 * cos - x2 * sin, x2 * cos + x1 * sin], axis=-1)


def axial_rope(x, ang_row, ang_col):
    xf = x.astype(jnp.float32)
    half = x.shape[-1] // 2
    out = jnp.concatenate([_rotate(xf[..., :half], ang_row), _rotate(xf[..., half:], ang_col)], axis=-1)
    return out.astype(x.dtype)


def attn_mixer(h_lat, h_ctx, ang_row, ang_col, w_qkv, b_qkv, sink, w_o, need_ctx_out):
    B, L, _ = h_lat.shape
    C = h_ctx.shape[1]
    dt = h_lat.dtype
    scale = HEAD_DIM ** -0.5
    qkv = h_lat @ w_qkv + b_qkv
    q = qkv[..., :Q_DIM].reshape(B, L, ATTN_HEADS, HEAD_DIM)
    k = qkv[..., Q_DIM:Q_DIM + KV_DIM].reshape(B, L, ATTN_KV_HEADS, HEAD_DIM)
    v = qkv[..., Q_DIM + KV_DIM:].reshape(B, L, ATTN_KV_HEADS, HEAD_DIM)
    q = axial_rope(q, ang_row, ang_col).reshape(B, L, ATTN_KV_HEADS, ATTN_GROUP, HEAD_DIM)
    k = axial_rope(k, ang_row, ang_col)
    if need_ctx_out:
        qkv_c = h_ctx @ w_qkv + b_qkv
        q_c = qkv_c[..., :Q_DIM].reshape(B, C, ATTN_KV_HEADS, ATTN_GROUP, HEAD_DIM)
        kv_c = qkv_c[..., Q_DIM:]
    else:
        kv_c = h_ctx @ w_qkv[:, Q_DIM:] + b_qkv[Q_DIM:]
    k_c = kv_c[..., :KV_DIM].reshape(B, C, ATTN_KV_HEADS, HEAD_DIM)
    v_c = kv_c[..., KV_DIM:].reshape(B, C, ATTN_KV_HEADS, HEAD_DIM)
    sink_kg = sink.astype(jnp.float32).reshape(ATTN_KV_HEADS, ATTN_GROUP)

    def softmax_with_sink(logits):
        s = jnp.broadcast_to(sink_kg[None, :, :, None, None], logits.shape[:-1] + (1,))
        return jax.nn.softmax(jnp.concatenate([logits, s], axis=-1), axis=-1)[..., :-1].astype(dt)

    NB = L // ATTN_BLOCK
    NW = 3 * ATTN_BLOCK

    def window_blocks(t):
        tp = jnp.pad(t, ((0, 0), (ATTN_BLOCK, ATTN_BLOCK), (0, 0), (0, 0)))
        tp = tp.reshape(B, NB + 2, ATTN_BLOCK, ATTN_KV_HEADS, HEAD_DIM)
        w = jnp.concatenate([tp[:, :-2], tp[:, 1:-1], tp[:, 2:]], axis=2)
        return jnp.moveaxis(w, 1, 0)

    q_blk = jnp.moveaxis(q.reshape(B, NB, ATTN_BLOCK, ATTN_KV_HEADS, ATTN_GROUP, HEAD_DIM), 1, 0)
    k_win = window_blocks(k)
    v_win = window_blocks(v)
    offs_q = jnp.arange(ATTN_BLOCK)
    offs_k = jnp.arange(NW) - ATTN_BLOCK

    def block(args):
        n, qb, kb, vb = args
        q_pos = n * ATTN_BLOCK + offs_q
        k_pos = n * ATTN_BLOCK + offs_k
        valid = (jnp.abs(q_pos[:, None] - k_pos[None, :]) <= WINDOW) & ((k_pos >= 0) & (k_pos < L))[None, :]
        s_win = jnp.einsum('bqkgd,bskd->bkgqs', qb, kb).astype(jnp.float32) * scale
        s_win = jnp.where(valid, s_win, -jnp.inf)
        s_ctx = jnp.einsum('bqkgd,bskd->bkgqs', qb, k_c).astype(jnp.float32) * scale
        p = softmax_with_sink(jnp.concatenate([s_win, s_ctx], axis=-1))
        o = (jnp.einsum('bkgqs,bskd->bqkgd', p[..., :NW], vb)
             + jnp.einsum('bkgqs,bskd->bqkgd', p[..., NW:], v_c))
        return o.reshape(B, ATTN_BLOCK, Q_DIM)

    o = lax.map(block, (jnp.arange(NB), q_blk, k_win, v_win))
    y_lat = jnp.moveaxis(o, 0, 1).reshape(B, L, Q_DIM) @ w_o
    y_ctx = None
    if need_ctx_out:
        s = jnp.einsum('bqkgd,bskd->bkgqs', q_c, k_c).astype(jnp.float32) * scale
        p = softmax_with_sink(s)
        o_c = jnp.einsum('bkgqs,bskd->bqkgd', p, v_c).reshape(B, C, Q_DIM)
        y_ctx = o_c @ w_o
    return y_lat, y_ctx


def hgrn_chunk_scan(k, v, log_f, s0, q=None):
    B, T, H, DK = k.shape
    DV = v.shape[-1]
    NC = T // HGRN_CHUNK
    with_outputs = q is not None

    def to_chunks(t):
        return t.astype(jnp.float32).reshape(B, NC, HGRN_CHUNK, H, t.shape[-1]).transpose(1, 0, 3, 2, 4)

    lower = jnp.tril(jnp.ones((HGRN_CHUNK, HGRN_CHUNK), dtype=bool))
    xs = (to_chunks(k), to_chunks(v), to_chunks(log_f)) + ((to_chunks(q),) if with_outputs else ())

    def step(S, inp):
        kc, vc, gc = inp[0], inp[1], inp[2]
        G = jnp.cumsum(gc, axis=2)
        G_last = G[:, :, -1]
        k_end = kc * jnp.exp(G_last[:, :, None, :] - G)
        S_new = jnp.exp(G_last)[..., None] * S + jnp.einsum('bhsd,bhsv->bhdv', k_end, vc)
        if not with_outputs:
            return S_new, None
        qc = inp[3]
        o_inter = jnp.einsum('bhtd,bhdv->bhtv', qc * jnp.exp(G), S)
        decay = jnp.exp(jnp.where(lower[:, :, None], G[:, :, :, None, :] - G[:, :, None, :, :], -jnp.inf))
        A = jnp.einsum('bhtd,bhsd,bhtsd->bhts', qc, kc, decay)
        return S_new, o_inter + jnp.einsum('bhts,bhsv->bhtv', A, vc)

    S_fin, o = lax.scan(step, s0, xs)
    if with_outputs:
        o = o.transpose(1, 0, 3, 2, 4).reshape(B, T, H, DV)
    return o, S_fin


def hgrn_mixer(h_lat, h_ctx, layer_idx, w_in, lb_param, norm_g, w_o, need_ctx_out):
    B, L, _ = h_lat.shape
    C = h_ctx.shape[1]
    dt = h_lat.dtype
    F, I, H = HGRN_FDIM, HGRN_IDIM, HGRN_HEADS
    lb_soft = jax.nn.softmax(lb_param.astype(jnp.float32), axis=0)
    lb = jnp.cumsum(lb_soft, axis=0)[layer_idx] - lb_soft[0]

    def forget(z, lb_d, T):
        zf = z.astype(jnp.float32)
        f = lb_d + (1 - lb_d) * jax.nn.sigmoid(zf)
        k = (1 - lb_d) * jax.nn.sigmoid(-zf)
        return k.reshape(B, T, H, HGRN_DK), jnp.log(f).reshape(B, T, H, HGRN_DK)

    q, zf, zb, i, g = jnp.split(h_lat @ w_in, [F, 2 * F, 3 * F, 3 * F + I], axis=-1)
    q = jax.nn.silu(q).reshape(B, L, H, HGRN_DK)
    i = i.reshape(B, L, H, HGRN_DV)
    kf, lf = forget(zf, lb[0], L)
    kb, lbw = forget(zb, lb[1], L)
    if need_ctx_out:
        q_c, zf_c, zb_c, i_c, g_c = jnp.split(h_ctx @ w_in, [F, 2 * F, 3 * F, 3 * F + I], axis=-1)
        q_c = jax.nn.silu(q_c).reshape(B, C, H, HGRN_DK)
    else:
        zf_c, zb_c, i_c = jnp.split(h_ctx @ w_in[:, F:3 * F + I], [F, 2 * F], axis=-1)
        q_c = None
    i_c = i_c.reshape(B, C, H, HGRN_DV)
    kf_c, lf_c = forget(zf_c, lb[0], C)
    kb_c, lb_c = forget(zb_c, lb[1], C)

    flip = lambda t: jnp.flip(t, axis=1)
    s0 = jnp.zeros((B, H, HGRN_DK, HGRN_DV), jnp.float32)
    o_cf, s_cf = hgrn_chunk_scan(kf_c, i_c, lf_c, s0, q_c)
    o_cb, s_cb = hgrn_chunk_scan(flip(kb_c), flip(i_c), flip(lb_c), s0, None if q_c is None else flip(q_c))
    o_lf, _ = hgrn_chunk_scan(kf, i, lf, s_cf, q)
    o_lb, _ = hgrn_chunk_scan(flip(kb), flip(i), flip(lbw), s_cb, flip(q))

    def readout(o, gate, T):
        o = rmsnorm(o, norm_g.reshape(H, HGRN_DV)).astype(dt).reshape(B, T, I)
        return (o * jax.nn.silu(gate)) @ w_o

    y_lat = readout(o_lf + flip(o_lb), g, L)
    y_ctx = readout(o_cf + flip(o_cb), g_c, C) if need_ctx_out else None
    return y_lat, y_ctx


def moe(t, router_w, router_b, w_gu, b_gu, w_dn, b_dn):
    T, D = t.shape
    A = T * TOP_K
    logits = (t @ router_w + router_b).astype(jnp.float32)
    top_logit, top_e = lax.top_k(logits, TOP_K)
    gate = jax.nn.softmax(top_logit, axis=-1).astype(t.dtype)
    e_flat = top_e.reshape(-1)
    order = jnp.argsort(e_flat, stable=True)
    e_s = e_flat[order]
    tok_s = order // TOP_K
    gate_s = gate.reshape(-1)[order]
    counts = jnp.bincount(e_flat, length=N_EXPERTS)
    starts = jnp.cumsum(counts) - counts
    padded = (counts + MOE_BLOCK - 1) // MOE_BLOCK * MOE_BLOCK
    p_end = jnp.cumsum(padded)
    p_start = p_end - padded
    dest = p_start[e_s] + jnp.arange(A) - starts[e_s]
    n_blk = (A + N_EXPERTS * (MOE_BLOCK - 1) + MOE_BLOCK - 1) // MOE_BLOCK
    buf = jnp.zeros((n_blk * MOE_BLOCK, D), t.dtype).at[dest].set(t[tok_s])
    blk_e = jnp.minimum(jnp.searchsorted(p_end, jnp.arange(n_blk) * MOE_BLOCK, side='right'), N_EXPERTS - 1)

    def expert_block(args):
        xb, e = args
        gu = xb @ w_gu[e] + b_gu[e]
        g_, u_ = jnp.split(gu, 2, axis=-1)
        g_ = jnp.minimum(g_, SWIGLU_LIMIT)
        u_ = jnp.clip(u_, -SWIGLU_LIMIT, SWIGLU_LIMIT)
        hdn = g_ * jax.nn.sigmoid(SWIGLU_ALPHA * g_) * (u_ + 1)
        return hdn @ w_dn[e] + b_dn[e]

    out_buf = lax.map(expert_block, (buf.reshape(n_blk, MOE_BLOCK, D), blk_e)).reshape(-1, D)
    return jnp.zeros((T, D), t.dtype).at[tok_s].add(out_buf[dest] * gate_s[:, None])


def setup_inputs(seed: int = 0):
    key = jax.random.key(seed)
    ks = jax.random.split(key, 21)
    D = D_MODEL

    def nrm(k, shape, s):
        return jax.random.normal(k, shape, jnp.float32) * s

    return {
        'x': nrm(ks[0], (BATCH, SEQ, D), 1.0),
        'c': nrm(ks[1], (BATCH, D), 1.0),
        'ctx': nrm(ks[2], (BATCH, CTX_LEN, D), 1.0),
        'c_ctx': nrm(ks[3], (D,), 1.0),
        'ada_w': nrm(ks[4], (DEPTH, D, 6 * D), 0.5 * D ** -0.5),
        'ada_b': nrm(ks[5], (DEPTH, 6 * D), 0.02),
        'norm_g': 1.0 + nrm(ks[6], (DEPTH, 4, D), 0.05),
        'attn_w_qkv': nrm(ks[7], (N_ATTN_LAYERS, D, QKV_DIM), D ** -0.5),
        'attn_b_qkv': nrm(ks[8], (N_ATTN_LAYERS, QKV_DIM), 0.02),
        'attn_sink': nrm(ks[9], (N_ATTN_LAYERS, ATTN_HEADS), 0.5),
        'attn_w_o': nrm(ks[10], (N_ATTN_LAYERS, Q_DIM, D), Q_DIM ** -0.5),
        'hgrn_w_in': nrm(ks[11], (N_HGRN_LAYERS, D, HGRN_IN_DIM), D ** -0.5),
        'hgrn_lb': nrm(ks[12], (DEPTH, 2, HGRN_FDIM), 0.5),
        'hgrn_norm_g': 1.0 + nrm(ks[13], (N_HGRN_LAYERS, HGRN_IDIM), 0.05),
        'hgrn_w_o': nrm(ks[14], (N_HGRN_LAYERS, HGRN_IDIM, D), HGRN_IDIM ** -0.5),
        'router_w': nrm(ks[15], (DEPTH, D, N_EXPERTS), D ** -0.5),
        'router_b': nrm(ks[16], (DEPTH, N_EXPERTS), 0.01),
        'moe_w_gu': nrm(ks[17], (DEPTH, N_EXPERTS, D, 2 * D_FF), D ** -0.5),
        'moe_b_gu': nrm(ks[18], (DEPTH, N_EXPERTS, 2 * D_FF), 0.02),
        'moe_w_dn': nrm(ks[19], (DEPTH, N_EXPERTS, D_FF, D), D_FF ** -0.5),
        'moe_b_dn': nrm(ks[20], (DEPTH, N_EXPERTS, D), 0.02),
    }


def reference(x, c, ctx, c_ctx, ada_w, ada_b, norm_g, attn_w_qkv, attn_b_qkv, attn_sink, attn_w_o,
              hgrn_w_in, hgrn_lb, hgrn_norm_g, hgrn_w_o, router_w, router_b, moe_w_gu, moe_b_gu,
              moe_w_dn, moe_b_dn):
    B, L, D = x.shape
    C = ctx.shape[1]
    ROWS = L // GRID_W
    ang_row, ang_col = axial_angles(ROWS)
    x_ctx = ctx
    silu_c = jax.nn.silu(c)
    silu_cc = jax.nn.silu(c_ctx)
    for i in range(DEPTH):
        need_ctx = i < DEPTH - 1
        sh1, sc1, g1, sh2, sc2, g2 = [m[:, None, :] for m in jnp.split(silu_c @ ada_w[i] + ada_b[i], 6, axis=-1)]
        sh1c, sc1c, g1c, sh2c, sc2c, g2c = jnp.split(silu_cc @ ada_w[i] + ada_b[i], 6, axis=-1)
        h = modulate(rmsnorm(x, norm_g[i, 0]), sh1, sc1)
        hc = modulate(rmsnorm(x_ctx, norm_g[i, 0]), sh1c, sc1c)
        j = i // N_MIXERS
        if i % N_MIXERS == 0:
            y, yc = attn_mixer(h, hc, ang_row, ang_col, attn_w_qkv[j], attn_b_qkv[j], attn_sink[j],
                               attn_w_o[j], need_ctx)
        else:
            y, yc = hgrn_mixer(h, hc, i, hgrn_w_in[j], hgrn_lb, hgrn_norm_g[j], hgrn_w_o[j], need_ctx)
        x = x + g1 * rmsnorm(y, norm_g[i, 1])
        h2 = modulate(rmsnorm(x, norm_g[i, 2]), sh2, sc2)
        if need_ctx:
            x_ctx = x_ctx + g1c * rmsnorm(yc, norm_g[i, 1])
            h2c = modulate(rmsnorm(x_ctx, norm_g[i, 2]), sh2c, sc2c)
            tokens = jnp.concatenate([h2c, h2], axis=1).reshape(-1, D)
            y2 = moe(tokens, router_w[i], router_b[i], moe_w_gu[i], moe_b_gu[i], moe_w_dn[i], moe_b_dn[i])
            y2 = y2.reshape(B, C + L, D)
            x_ctx = x_ctx + g2c * rmsnorm(y2[:, :C], norm_g[i, 3])
            y2 = y2[:, C:]
        else:
            y2 = moe(h2.reshape(-1, D), router_w[i], router_b[i], moe_w_gu[i], moe_b_gu[i], moe_w_dn[i],
                     moe_b_dn[i]).reshape(B, L, D)
        x = x + g2 * rmsnorm(y2, norm_g[i, 3])
    return x
```

```cpp
#include <hip/hip_runtime.h>
#include <cstdint>
#include <cstdio>

#define LAS __attribute__((address_space(3)))
typedef unsigned short bf16_t;
typedef short bf16x8 __attribute__((ext_vector_type(8)));
typedef float f32x4 __attribute__((ext_vector_type(4)));
typedef unsigned u32x4 __attribute__((ext_vector_type(4)));
typedef unsigned u32x2 __attribute__((ext_vector_type(2)));

constexpr int D = 1024, L = 16384, C = 256, R = L + C;
constexpr int QKVD = 1280, HIN = 5120, NE = 32, TOPK = 4;
constexpr int PADM = 256, MAXROWS = 74752;
constexpr float EPS = 1e-6f;
constexpr float LOG2E = 1.4426950408889634f;
constexpr int NPHASE = 21;
constexpr int LDS_BYTES = 147456;

constexpr size_t MiB = 1u << 20;
constexpr size_t al(size_t x) { return (x + MiB - 1) / MiB * MiB; }
constexpr size_t WS_CTL = 0;
constexpr size_t WS_MOD = WS_CTL + MiB;
constexpr size_t WS_X = WS_MOD + MiB;
constexpr size_t WS_H = WS_X + al((size_t)R * D * 4);
constexpr size_t WS_Q = WS_H + al((size_t)R * D * 2);
constexpr size_t WS_K = WS_Q + al((size_t)R * D * 2);
constexpr size_t WS_V = WS_K + al((size_t)R * 128 * 2);
constexpr size_t WS_O = WS_V + al((size_t)R * 128 * 2);
constexpr size_t WS_TK = WS_O + al((size_t)R * D * 2);
constexpr size_t WS_LIST = WS_TK + MiB;
constexpr size_t WS_HDN = WS_LIST + 3 * MiB;
constexpr size_t WS_RAW1 = WS_HDN + al((size_t)MAXROWS * 1024 * 2);
constexpr size_t WS_RAW2 = WS_RAW1 + al((size_t)MAXROWS * 2048 * 4);
constexpr size_t WS_QH = WS_RAW2 + al((size_t)MAXROWS * 1024 * 4);
constexpr size_t WS_KF = WS_QH + al((size_t)L * D * 2);
constexpr size_t WS_KB = WS_KF + al((size_t)R * D * 2);
constexpr size_t WS_IV = WS_KB + al((size_t)R * D * 2);
constexpr size_t WS_SG = WS_IV + al((size_t)R * D * 2);
constexpr size_t WS_OF = WS_SG + al((size_t)L * D * 2);
constexpr size_t WS_OB = WS_OF + al((size_t)L * D * 4);
constexpr size_t WS_RR = WS_OB + al((size_t)L * D * 4);
constexpr size_t WS_END = WS_RR + al((size_t)L * D * 2);
constexpr int CW_CNT = 1024;
constexpr int MOD_ROPE = 32768;
constexpr int MOD_LB = 49152;

struct Args { const float* in[21]; float* out; unsigned char* ws; int ph_lo, ph_hi; };

__device__ __forceinline__ unsigned f2bf(float f) { unsigned u = __float_as_uint(f); return (u + 0x7fffu + ((u >> 16) & 1u)) >> 16; }
__device__ __forceinline__ unsigned pk2(float lo, float hi) { return f2bf(lo) | (f2bf(hi) << 16); }
__device__ __forceinline__ float bflo(unsigned u) { return __uint_as_float(u << 16); }
__device__ __forceinline__ float bfhi(unsigned u) { return __uint_as_float(u & 0xffff0000u); }
__device__ __forceinline__ float bf2f(bf16_t b) { return __uint_as_float(((unsigned)b) << 16); }
__device__ __forceinline__ float wave_sum(float v) {
#pragma unroll
    for (int o = 32; o > 0; o >>= 1) v += __shfl_xor(v, o);
    return v;
}
__device__ __forceinline__ float silu_f(float x) { return x / (1.f + __expf(-x)); }
__device__ __forceinline__ float sigmoid_f(float x) { return 1.f / (1.f + __expf(-x)); }

typedef const __attribute__((address_space(4))) Args* CArgs;
struct Ctx {
    CArgs a;
    LAS unsigned char* lds;
    int tid, lane, wave, nwg, wg;
    unsigned char* ws;
    __device__ __forceinline__ float* modp(int layer, int which) const { return (float*)(ws + WS_MOD) + (layer * 2 + which) * 6144; }
    __device__ __forceinline__ const float* xin0(int r) const { return r < C ? a->in[2] + (size_t)r * D : a->in[0] + (size_t)(r - C) * D; }
};

__device__ __forceinline__ void phase_prep(const Ctx& c) {
    LAS float* red = (LAS float*)c.lds;
    const float* cv = c.a->in[1]; const float* ccv = c.a->in[3]; const float* ada_w = c.a->in[4]; const float* ada_b = c.a->in[5];
    for (int item = c.wg; item < 193; item += c.nwg) {
        if (item < 192) {
            const int layer = item / 96, cb = item % 96, col = cb * 64 + c.lane;
            const float* W = ada_w + (size_t)layer * D * 6144 + col;
            float a0 = 0.f, a1 = 0.f;
            const int k0 = c.wave * 128;
#pragma unroll 8
            for (int k = 0; k < 128; ++k) { const float w = W[(size_t)(k0 + k) * 6144]; a0 += silu_f(cv[k0 + k]) * w; a1 += silu_f(ccv[k0 + k]) * w; }
            red[(0 * 8 + c.wave) * 64 + c.lane] = a0; red[(1 * 8 + c.wave) * 64 + c.lane] = a1;
            __syncthreads();
            if (c.tid < 128) {
                const int which = c.tid >> 6, l = c.tid & 63; float s = 0.f;
#pragma unroll
                for (int w = 0; w < 8; ++w) s += red[(which * 8 + w) * 64 + l];
                c.modp(layer, which)[cb * 64 + l] = s + ada_b[layer * 6144 + cb * 64 + l];
            }
            __syncthreads();
        } else {
            float* modbase = (float*)(c.ws + WS_MOD);
            for (int i = c.tid; i < 4096; i += 512) {
                const int pos = i >> 4, j = i & 15;
                const double ang = (double)pos * pow(10000.0, -(double)j / 16.0);
                modbase[MOD_ROPE + 2 * i] = (float)cos(ang); modbase[MOD_ROPE + 2 * i + 1] = (float)sin(ang);
            }
            const float* lbp = c.a->in[12];
            for (int i = c.tid; i < 2048; i += 512) { const float p0 = lbp[i], p1 = lbp[2048 + i]; modbase[MOD_LB + i] = 1.f / (1.f + __expf(p0 - p1)); }
        }
    }
}

__device__ __forceinline__ void row_load(const float* p, int lane, f32x4 (&v)[4]) {
#pragma unroll
    for (int j = 0; j < 4; ++j) v[j] = *(const f32x4*)(p + lane * 4 + 256 * j);
}
__device__ __forceinline__ float row_ss(const f32x4 (&v)[4]) {
    float s = 0.f;
#pragma unroll
    for (int j = 0; j < 4; ++j) s += v[j].x * v[j].x + v[j].y * v[j].y + v[j].z * v[j].z + v[j].w * v[j].w;
    return wave_sum(s);
}
__device__ __forceinline__ void row_modnorm_store(const f32x4 (&x)[4], float rstd, const float* g, const float* sh, const float* sc, bf16_t* out, int lane, f32x4 (*hout)[4] = nullptr) {
#pragma unroll
    for (int j = 0; j < 4; ++j) {
        const int c0 = lane * 4 + 256 * j;
        const f32x4 gv = *(const f32x4*)(g + c0), shv = *(const f32x4*)(sh + c0), scv = *(const f32x4*)(sc + c0);
        f32x4 h;
        h.x = x[j].x * rstd * gv.x * (1.f + scv.x) + shv.x; h.y = x[j].y * rstd * gv.y * (1.f + scv.y) + shv.y;
        h.z = x[j].z * rstd * gv.z * (1.f + scv.z) + shv.z; h.w = x[j].w * rstd * gv.w * (1.f + scv.w) + shv.w;
        if (hout) (*hout)[j] = h;
        u32x2 o; o.x = pk2(h.x, h.y); o.y = pk2(h.z, h.w);
        *(u32x2*)(out + c0) = o;
    }
}

__device__ __forceinline__ void phase_norm0(const Ctx& c) {
    bf16_t* H = (bf16_t*)(c.ws + WS_H); const float* ng = c.a->in[6];
    for (int r = c.wg * 8 + c.wave; r < R; r += c.nwg * 8) {
        f32x4 x[4]; row_load(c.xin0(r), c.lane, x);
        const float rstd = rsqrtf(row_ss(x) * (1.f / D) + EPS);
        const float* m = c.modp(0, r < C ? 1 : 0);
        row_modnorm_store(x, rstd, ng, m + 0, m + 1024, H + (size_t)r * D, c.lane);
    }
}

__device__ __forceinline__ void sgemm_tile(LAS unsigned char* lds, const bf16_t* A, int lda, const int* rowlist, int nvalid, int row0,
                           const float* B, int ldb, int col0, const float* bias, float* Cout, int ldc, int crow0, int K) {
    const int tid = threadIdx.x, lane = tid & 63, w = tid >> 6, wm = w >> 1, wn = w & 1;
    LAS bf16_t* sA = (LAS bf16_t*)lds;
    LAS bf16_t* sB = (LAS bf16_t*)(lds + 128 * 40 * 2);
    const int ar = tid >> 2, ak = (tid & 3) * 8;
    size_t arow;
    if (rowlist) arow = (row0 + ar) < nvalid ? (size_t)rowlist[row0 + ar] : 0; else arow = (size_t)(row0 + ar);
    const bf16_t* ap = A + arow * lda + ak;
    const int bk = tid >> 4, bn = (tid & 15) * 4;
    const float* bp = B + (size_t)bk * ldb + col0 + bn;
    f32x4 acc[2][2];
#pragma unroll
    for (int i = 0; i < 2; ++i)
#pragma unroll
        for (int j = 0; j < 2; ++j) acc[i][j] = (f32x4){0.f, 0.f, 0.f, 0.f};
    for (int k0 = 0; k0 < K; k0 += 32) {
        const u32x4 av = *(const u32x4*)(ap + k0);
        const f32x4 bv = *(const f32x4*)(bp + (size_t)k0 * ldb);
        __syncthreads();
        *(LAS u32x4*)(sA + ar * 40 + ak) = av;
        sB[(bn + 0) * 40 + bk] = (bf16_t)f2bf(bv.x); sB[(bn + 1) * 40 + bk] = (bf16_t)f2bf(bv.y);
        sB[(bn + 2) * 40 + bk] = (bf16_t)f2bf(bv.z); sB[(bn + 3) * 40 + bk] = (bf16_t)f2bf(bv.w);
        __syncthreads();
        bf16x8 a[2], b[2];
#pragma unroll
        for (int i = 0; i < 2; ++i) a[i] = *(const LAS bf16x8*)(sA + (wm * 32 + i * 16 + (lane & 15)) * 40 + (lane >> 4) * 8);
#pragma unroll
        for (int j = 0; j < 2; ++j) b[j] = *(const LAS bf16x8*)(sB + (wn * 32 + j * 16 + (lane & 15)) * 40 + (lane >> 4) * 8);
#pragma unroll
        for (int i = 0; i < 2; ++i)
#pragma unroll
            for (int j = 0; j < 2; ++j) acc[i][j] = __builtin_amdgcn_mfma_f32_16x16x32_bf16(a[i], b[j], acc[i][j], 0, 0, 0);
    }
#pragma unroll
    for (int i = 0; i < 2; ++i)
#pragma unroll
        for (int j = 0; j < 2; ++j) {
            const int col = col0 + wn * 32 + j * 16 + (lane & 15);
            const float bb = bias ? bias[col] : 0.f;
#pragma unroll
            for (int e = 0; e < 4; ++e) {
                const int row = crow0 + wm * 32 + i * 16 + (lane >> 4) * 4 + e;
                Cout[(size_t)row * ldc + col] = acc[i][j][e] + bb;
            }
        }
    __syncthreads();
}

__device__ __forceinline__ void phase_gemm_dense(const Ctx& c, const bf16_t* A, int M, const float* B, int N, const float* bias, float* Cout) {
    const int nmt = M / 128, nnt = N / 64;
    for (int item = c.wg; item < nmt * nnt; item += c.nwg) {
        const int mt = item % nmt, nt = item / nmt;
        sgemm_tile(c.lds, A, D, nullptr, 0, mt * 128, B, N, nt * 64, bias, Cout, N, mt * 128, D);
    }
}

__device__ __forceinline__ void phase_rope(const Ctx& c) {
    const float* raw = (const float*)(c.ws + WS_RAW1); const float* tab = (const float*)(c.ws + WS_MOD) + MOD_ROPE;
    bf16_t* Q = (bf16_t*)(c.ws + WS_Q); bf16_t* K = (bf16_t*)(c.ws + WS_K); bf16_t* V = (bf16_t*)(c.ws + WS_V);
    const float qs = 0.125f * LOG2E;
    for (int r = c.wg * 8 + c.wave; r < R; r += c.nwg * 8) {
        const float* row = raw + (size_t)r * QKVD;
        const bool lat = r >= C; const int t = r - C;
        for (int col = c.lane; col < QKVD; col += 64) {
            float val = row[col];
            if (col < 1152 && lat) {
                const int within = col & 63, half = within >> 5, part = (within >> 4) & 1, j = within & 15;
                const int pos = half == 0 ? (t >> 6) : (t & 63);
                const float cs = tab[2 * (pos * 16 + j)], sn = tab[2 * (pos * 16 + j) + 1];
                const float x1 = part == 0 ? val : row[col - 16], x2 = part == 0 ? row[col + 16] : val;
                val = part == 0 ? (x1 * cs - x2 * sn) : (x2 * cs + x1 * sn);
            }
            if (col < 1024) Q[(size_t)r * D + col] = (bf16_t)f2bf(val * qs);
            else if (col < 1152) K[(size_t)r * 128 + (col - 1024)] = (bf16_t)f2bf(val);
            else V[(size_t)r * 128 + (col - 1152)] = (bf16_t)f2bf(val);
        }
    }
}

__device__ __forceinline__ void phase_attn_simple(const Ctx& c) {
    const bf16_t* Q = (const bf16_t*)(c.ws + WS_Q); const bf16_t* K = (const bf16_t*)(c.ws + WS_K); const bf16_t* V = (const bf16_t*)(c.ws + WS_V);
    bf16_t* O = (bf16_t*)(c.ws + WS_O); const float* sink = c.a->in[9];
    LAS unsigned* sK = (LAS unsigned*)c.lds;
    LAS unsigned* sV = (LAS unsigned*)(c.lds + 16384);
    for (int item = c.wg; item < 260; item += c.nwg) {
        const bool isctx = item >= 256;
        const int n = isctx ? 0 : (item >> 1), kh = item & 1, cb = isctx ? ((item - 256) >> 1) : 0;
        const int qrow0 = isctx ? cb * 128 : C + n * 128;
        const int nchunk = isctx ? 2 : 5;
        for (int pp = 0; pp < 2; ++pp) {
            const int pi = c.tid + 512 * pp, qi = pi & 127, g = pi >> 7, hq = kh * 8 + g;
            const int tq = n * 128 + qi;
            unsigned q[32];
            {
                const u32x4* qp = (const u32x4*)(Q + (size_t)(qrow0 + qi) * D + hq * 64);
#pragma unroll
                for (int i = 0; i < 8; ++i) { const u32x4 u = qp[i]; q[4 * i] = u.x; q[4 * i + 1] = u.y; q[4 * i + 2] = u.z; q[4 * i + 3] = u.w; }
            }
            const float sink2 = sink[hq] * LOG2E;
            float m = sink2, l = 0.f;
            float acc[64];
#pragma unroll
            for (int i = 0; i < 64; ++i) acc[i] = 0.f;
            for (int pass = 0; pass < 2; ++pass) {
                if (pass == 1) l = exp2f(sink2 - m);
                for (int ch = 0; ch < nchunk; ++ch) {
                    int krow0, tk0 = 0; bool win = false;
                    if (ch < 2) krow0 = ch * 128;
                    else { const int b = n + ch - 3; if (b < 0 || b >= 128) continue; krow0 = C + b * 128; tk0 = b * 128; win = true; }
                    __syncthreads();
                    {
                        const int rr = c.tid >> 2, cc = (c.tid & 3) * 8;
                        const u32x4* kp = (const u32x4*)(K + (size_t)(krow0 + rr) * 128 + kh * 64) + (c.tid & 3) * 2;
                        *(LAS u32x4*)(sK + rr * 32 + cc) = kp[0]; *(LAS u32x4*)(sK + rr * 32 + cc + 4) = kp[1];
                        if (pass == 1) { const u32x4* vp = (const u32x4*)(V + (size_t)(krow0 + rr) * 128 + kh * 64) + (c.tid & 3) * 2;
                            *(LAS u32x4*)(sV + rr * 32 + cc) = vp[0]; *(LAS u32x4*)(sV + rr * 32 + cc + 4) = vp[1]; }
                    }
                    __syncthreads();
                    for (int key = 0; key < 128; ++key) {
                        const LAS u32x4* kp = (const LAS u32x4*)(sK + key * 32);
                        float s = 0.f;
#pragma unroll
                        for (int i = 0; i < 8; ++i) { const u32x4 u = kp[i];
                            s += bflo(q[4 * i]) * bflo(u.x) + bfhi(q[4 * i]) * bfhi(u.x) + bflo(q[4 * i + 1]) * bflo(u.y) + bfhi(q[4 * i + 1]) * bfhi(u.y)
                               + bflo(q[4 * i + 2]) * bflo(u.z) + bfhi(q[4 * i + 2]) * bfhi(u.z) + bflo(q[4 * i + 3]) * bflo(u.w) + bfhi(q[4 * i + 3]) * bfhi(u.w); }
                        bool valid = true;
                        if (win) { const int dt = tq - (tk0 + key); valid = (dt <= 128) && (dt >= -128); }
                        if (pass == 0) { if (valid) m = fmaxf(m, s); }
                        else {
                            const float p = valid ? exp2f(s - m) : 0.f;
                            l += p;
                            const LAS u32x4* vp = (const LAS u32x4*)(sV + key * 32);
#pragma unroll
                            for (int i = 0; i < 8; ++i) { const u32x4 u = vp[i];
                                acc[8 * i] += p * bflo(u.x); acc[8 * i + 1] += p * bfhi(u.x); acc[8 * i + 2] += p * bflo(u.y); acc[8 * i + 3] += p * bfhi(u.y);
                                acc[8 * i + 4] += p * bflo(u.z); acc[8 * i + 5] += p * bfhi(u.z); acc[8 * i + 6] += p * bflo(u.w); acc[8 * i + 7] += p * bfhi(u.w); }
                        }
                    }
                }
            }
            const float il = 1.f / l;
            u32x4* op = (u32x4*)(O + (size_t)(qrow0 + qi) * D + hq * 64);
#pragma unroll
            for (int i = 0; i < 8; ++i) { u32x4 u; u.x = pk2(acc[8 * i] * il, acc[8 * i + 1] * il); u.y = pk2(acc[8 * i + 2] * il, acc[8 * i + 3] * il);
                u.z = pk2(acc[8 * i + 4] * il, acc[8 * i + 5] * il); u.w = pk2(acc[8 * i + 6] * il, acc[8 * i + 7] * il); op[i] = u; }
        }
        __syncthreads();
    }
}

__device__ __forceinline__ void phase_postmix(const Ctx& c, int layer, int r_lo, int yoff) {
    const float* Y = (const float*)(c.ws + WS_RAW1); float* X = (float*)(c.ws + WS_X); bf16_t* H = (bf16_t*)(c.ws + WS_H);
    const float* ng = c.a->in[6] + layer * 4 * D; const float* Wr = c.a->in[15] + (size_t)layer * D * NE; const float* br = c.a->in[16] + layer * NE;
    unsigned* cnt = (unsigned*)(c.ws + WS_CTL) + CW_CNT + layer * NE;
    int* tk_e = (int*)(c.ws + WS_TK); float* tk_g = (float*)(c.ws + WS_TK) + R * 4; int* tk_slot = (int*)(c.ws + WS_TK) + 2 * R * 4;
    int* list = (int*)(c.ws + WS_LIST);
    LAS float* pr = (LAS float*)c.lds + c.wave * (64 * 33);
    LAS float* hrow = (LAS float*)c.lds + 8 * 64 * 33 + c.wave * 1024;
    for (int r = r_lo + c.wg * 8 + c.wave; r < R; r += c.nwg * 8) {
        const float* m = c.modp(layer, r < C ? 1 : 0);
        const float* xsrc = layer == 0 ? c.xin0(r) : X + (size_t)r * D;
        f32x4 y[4], x[4]; row_load(Y + (size_t)(r - yoff) * D, c.lane, y); row_load(xsrc, c.lane, x);
        const float rstd_y = rsqrtf(row_ss(y) * (1.f / D) + EPS);
#pragma unroll
        for (int j = 0; j < 4; ++j) {
            const int c0 = c.lane * 4 + 256 * j;
            const f32x4 g1 = *(const f32x4*)(m + 2048 + c0), n1 = *(const f32x4*)(ng + D + c0);
            x[j].x += g1.x * (y[j].x * rstd_y * n1.x); x[j].y += g1.y * (y[j].y * rstd_y * n1.y);
            x[j].z += g1.z * (y[j].z * rstd_y * n1.z); x[j].w += g1.w * (y[j].w * rstd_y * n1.w);
            *(f32x4*)(X + (size_t)r * D + c0) = x[j];
        }
        const float rstd_x = rsqrtf(row_ss(x) * (1.f / D) + EPS);
        f32x4 h[4];
        row_modnorm_store(x, rstd_x, ng + 2 * D, m + 3072, m + 4096, H + (size_t)r * D, c.lane, &h);
#pragma unroll
        for (int j = 0; j < 4; ++j) *(LAS f32x4*)(hrow + c.lane * 4 + 256 * j) = h[j];
        float p[32];
#pragma unroll
        for (int e = 0; e < 32; ++e) p[e] = 0.f;
#pragma unroll 2
        for (int k = 0; k < 16; ++k) {
            const int col = c.lane * 4 + 256 * (k >> 2) + (k & 3);
            const float hv = hrow[col]; const f32x4* wrow = (const f32x4*)(Wr + (size_t)col * NE);
#pragma unroll
            for (int e4 = 0; e4 < 8; ++e4) { const f32x4 wv = wrow[e4]; p[4 * e4] += hv * wv.x; p[4 * e4 + 1] += hv * wv.y; p[4 * e4 + 2] += hv * wv.z; p[4 * e4 + 3] += hv * wv.w; }
        }
#pragma unroll
        for (int e = 0; e < 32; ++e) pr[c.lane * 33 + e] = p[e];
        asm volatile("s_waitcnt lgkmcnt(0)" ::: "memory");
        __builtin_amdgcn_wave_barrier();
        float logit = -INFINITY;
        if (c.lane < 32) { float s = br[c.lane]; for (int l2 = 0; l2 < 64; ++l2) s += pr[l2 * 33 + c.lane]; logit = s; }
        asm volatile("s_waitcnt lgkmcnt(0)" ::: "memory");
        __builtin_amdgcn_wave_barrier();
        float tv[4]; int te[4];
#pragma unroll
        for (int k = 0; k < 4; ++k) {
            float bv = logit; int bi = c.lane;
#pragma unroll
            for (int o = 32; o > 0; o >>= 1) {
                const float ov = __shfl_xor(bv, o); const int oi = __shfl_xor(bi, o);
                if (ov > bv || (ov == bv && oi < bi)) { bv = ov; bi = oi; }
            }
            tv[k] = bv; te[k] = bi;
            if (c.lane == bi) logit = -INFINITY;
        }
        if (c.lane == 0) {
            const float e1 = __expf(tv[1] - tv[0]), e2 = __expf(tv[2] - tv[0]), e3 = __expf(tv[3] - tv[0]);
            const float inv = 1.f / (1.f + e1 + e2 + e3);
            const float gk[4] = {inv, e1 * inv, e2 * inv, e3 * inv};
#pragma unroll
            for (int k = 0; k < 4; ++k) {
                const unsigned slot = atomicAdd(&cnt[te[k]], 1u);
                list[(size_t)te[k] * R + slot] = r;
                tk_e[r * 4 + k] = te[k]; tk_g[r * 4 + k] = gk[k]; tk_slot[r * 4 + k] = (int)slot;
            }
        }
    }
}

__device__ __forceinline__ void moe_offsets(const Ctx& c, int layer, LAS int* so) {
    const unsigned* cnt = (const unsigned*)(c.ws + WS_CTL) + CW_CNT + layer * NE;
    __syncthreads();
    if (c.tid == 0) { int acc = 0; for (int e = 0; e < NE; ++e) { const int n = (int)cnt[e]; so[e] = acc; so[64 + e] = n; acc += (n + PADM - 1) / PADM * PADM; } so[32] = acc; }
    __syncthreads();
}

__device__ __forceinline__ void phase_moe_gemm(const Ctx& c, int layer, bool down) {
    LAS int* so = (LAS int*)(c.lds + 32768);
    moe_offsets(c, layer, so);
    const int N = down ? 1024 : 2048, nnt = N / 64;
    const float* W = down ? c.a->in[19] + (size_t)layer * NE * 1024 * 1024 : c.a->in[17] + (size_t)layer * NE * 1024 * 2048;
    const float* bias = down ? c.a->in[20] + (size_t)layer * NE * 1024 : c.a->in[18] + (size_t)layer * NE * 2048;
    const bf16_t* A = down ? (const bf16_t*)(c.ws + WS_HDN) : (const bf16_t*)(c.ws + WS_H);
    float* Cout = down ? (float*)(c.ws + WS_RAW2) : (float*)(c.ws + WS_RAW1);
    const int* list = (const int*)(c.ws + WS_LIST);
    int base = 0;
    for (int e = 0; e < NE; ++e) {
        const int n = so[64 + e], nmt = (n + 127) / 128, nitems = nmt * nnt;
        int first = c.wg - (base % c.nwg); if (first < 0) first += c.nwg;
        for (int li = first; li < nitems; li += c.nwg) {
            const int mt = li % nmt, nt = li / nmt;
            if (down) sgemm_tile(c.lds, A, 1024, nullptr, 0, so[e] + mt * 128, W + (size_t)e * 1024 * 1024, 1024, nt * 64, bias + e * 1024, Cout, 1024, so[e] + mt * 128, 1024);
            else sgemm_tile(c.lds, A, D, list + (size_t)e * R, n, mt * 128, W + (size_t)e * 1024 * 2048, 2048, nt * 64, bias + e * 2048, Cout, 2048, so[e] + mt * 128, 1024);
        }
        base += nitems;
    }
}

__device__ __forceinline__ void phase_swiglu(const Ctx& c, int layer) {
    LAS int* so = (LAS int*)(c.lds + 32768);
    moe_offsets(c, layer, so);
    const float* gu = (const float*)(c.ws + WS_RAW1); bf16_t* hdn = (bf16_t*)(c.ws + WS_HDN);
    for (int e = 0; e < NE; ++e) {
        const int n = so[64 + e], nrow = (n + 127) / 128 * 128;
        for (int rr = c.wg * 8 + c.wave; rr < nrow; rr += c.nwg * 8) {
            const size_t row = (size_t)(so[e] + rr);
            for (int col = c.lane * 4; col < 1024; col += 256) {
                const f32x4 g4 = *(const f32x4*)(gu + row * 2048 + col), u4 = *(const f32x4*)(gu + row * 2048 + 1024 + col);
                float hv[4];
#pragma unroll
                for (int i = 0; i < 4; ++i) { const float g = fminf(g4[i], 7.f), u = fminf(fmaxf(u4[i], -7.f), 7.f); hv[i] = g * sigmoid_f(1.702f * g) * (u + 1.f); }
                u32x2 o; o.x = pk2(hv[0], hv[1]); o.y = pk2(hv[2], hv[3]);
                *(u32x2*)(hdn + row * 1024 + col) = o;
            }
        }
    }
}

__device__ __forceinline__ void phase_combine(const Ctx& c, int layer) {
    LAS int* so = (LAS int*)(c.lds + 32768);
    moe_offsets(c, layer, so);
    const float* outb = (const float*)(c.ws + WS_RAW2); float* X = (float*)(c.ws + WS_X); bf16_t* H = (bf16_t*)(c.ws + WS_H);
    const float* ngl = c.a->in[6] + layer * 4 * D;
    const int* tk_e = (const int*)(c.ws + WS_TK); const float* tk_g = (const float*)(c.ws + WS_TK) + R * 4; const int* tk_slot = (const int*)(c.ws + WS_TK) + 2 * R * 4;
    const int r_lo = layer == 0 ? 0 : C;
    for (int r = r_lo + c.wg * 8 + c.wave; r < R; r += c.nwg * 8) {
        const float* m = c.modp(layer, r < C ? 1 : 0);
        f32x4 y[4];
#pragma unroll
        for (int j = 0; j < 4; ++j) y[j] = (f32x4){0.f, 0.f, 0.f, 0.f};
#pragma unroll
        for (int k = 0; k < 4; ++k) {
            const int e = tk_e[r * 4 + k], slot = tk_slot[r * 4 + k]; const float g = tk_g[r * 4 + k];
            const float* src = outb + (size_t)(so[e] + slot) * 1024;
#pragma unroll
            for (int j = 0; j < 4; ++j) { const f32x4 v = *(const f32x4*)(src + c.lane * 4 + 256 * j); y[j] += v * g; }
        }
        const float rstd_y = rsqrtf(row_ss(y) * (1.f / D) + EPS);
        f32x4 x[4]; row_load(X + (size_t)r * D, c.lane, x);
#pragma unroll
        for (int j = 0; j < 4; ++j) {
            const int c0 = c.lane * 4 + 256 * j;
            const f32x4 g2 = *(const f32x4*)(m + 5120 + c0), n3 = *(const f32x4*)(ngl + 3 * D + c0);
            x[j].x += g2.x * (y[j].x * rstd_y * n3.x); x[j].y += g2.y * (y[j].y * rstd_y * n3.y);
            x[j].z += g2.z * (y[j].z * rstd_y * n3.z); x[j].w += g2.w * (y[j].w * rstd_y * n3.w);
            if (layer == 0) *(f32x4*)(X + (size_t)r * D + c0) = x[j];
            else *(f32x4*)(c.a->out + (size_t)(r - C) * D + c0) = x[j];
        }
        if (layer == 0) {
            const float rstd_x = rsqrtf(row_ss(x) * (1.f / D) + EPS);
            const float* m1 = c.modp(1, r < C ? 1 : 0);
            row_modnorm_store(x, rstd_x, c.a->in[6] + 4 * D, m1 + 0, m1 + 1024, H + (size_t)r * D, c.lane);
        }
    }
}

__device__ __forceinline__ void phase_hgrn_elem(const Ctx& c) {
    const float* raw = (const float*)(c.ws + WS_RAW1); const float* lb = (const float*)(c.ws + WS_MOD) + MOD_LB;
    bf16_t* QH = (bf16_t*)(c.ws + WS_QH); _Float16* KF = (_Float16*)(c.ws + WS_KF); _Float16* KB = (_Float16*)(c.ws + WS_KB);
    bf16_t* IV = (bf16_t*)(c.ws + WS_IV); bf16_t* SGp = (bf16_t*)(c.ws + WS_SG);
    for (int r = c.wg * 8 + c.wave; r < R; r += c.nwg * 8) {
        const float* row = raw + (size_t)r * HIN; const bool lat = r >= C; const int t = r - C;
        for (int col = c.lane; col < D; col += 64) {
            const float zf = row[1024 + col], zb = row[2048 + col];
            KF[(size_t)r * D + col] = (_Float16)((1.f - lb[col]) * sigmoid_f(-zf));
            KB[(size_t)r * D + col] = (_Float16)((1.f - lb[1024 + col]) * sigmoid_f(-zb));
            IV[(size_t)r * D + col] = (bf16_t)f2bf(row[3072 + col]);
            if (lat) { QH[(size_t)t * D + col] = (bf16_t)f2bf(silu_f(row[col])); SGp[(size_t)t * D + col] = (bf16_t)f2bf(silu_f(row[4096 + col])); }
        }
    }
}

__device__ __forceinline__ void phase_hgrn_rec(const Ctx& c) {
    const bf16_t* QH = (const bf16_t*)(c.ws + WS_QH); const bf16_t* IV = (const bf16_t*)(c.ws + WS_IV);
    LAS float* sf = (LAS float*)c.lds; LAS float* sk = sf + 32 * 128; LAS float* sq = sk + 32 * 128; LAS float* si = sq + 32 * 128;
    for (int item = c.wg; item < 16; item += c.nwg) {
        const int head = item >> 1, dir = item & 1;
        const _Float16* KX = (const _Float16*)(c.ws + (dir == 0 ? WS_KF : WS_KB));
        float* OUT = (float*)(c.ws + (dir == 0 ? WS_OF : WS_OB));
        const int v = c.tid >> 2, dq = c.tid & 3;
        float s[32];
#pragma unroll
        for (int j = 0; j < 32; ++j) s[j] = 0.f;
        for (int b = 0; b < R / 32; ++b) {
            __syncthreads();
            {
                const int tt = c.tid >> 4, c8 = (c.tid & 15) * 8;
                const int idx = b * 32 + tt;
                int r; bool lat;
                if (idx < C) { r = dir == 0 ? idx : C - 1 - idx; lat = false; } else { const int t = dir == 0 ? idx - C : L - 1 - (idx - C); r = C + t; lat = true; }
                const u32x4 ku = *(const u32x4*)(KX + (size_t)r * D + head * 128 + c8);
                const u32x4 iu = *(const u32x4*)(IV + (size_t)r * D + head * 128 + c8);
                u32x4 qu = (u32x4){0u, 0u, 0u, 0u};
                if (lat) qu = *(const u32x4*)(QH + (size_t)(r - C) * D + head * 128 + c8);
                const _Float16* kh = (const _Float16*)&ku;
                const unsigned iw[4] = {iu.x, iu.y, iu.z, iu.w}, qw[4] = {qu.x, qu.y, qu.z, qu.w};
#pragma unroll
                for (int i = 0; i < 8; ++i) {
                    const float kv = (float)kh[i];
                    sk[tt * 128 + c8 + i] = kv; sf[tt * 128 + c8 + i] = 1.f - kv;
                    si[tt * 128 + c8 + i] = (i & 1) ? bfhi(iw[i >> 1]) : bflo(iw[i >> 1]);
                    sq[tt * 128 + c8 + i] = (i & 1) ? bfhi(qw[i >> 1]) : bflo(qw[i >> 1]);
                }
            }
            __syncthreads();
            const bool latb = (b * 32) >= C;
            for (int tt = 0; tt < 32; ++tt) {
                const float iv = si[tt * 128 + v];
                float o = 0.f;
#pragma unroll
                for (int j4 = 0; j4 < 8; ++j4) {
                    const f32x4 f4 = *(const LAS f32x4*)(sf + tt * 128 + dq * 32 + j4 * 4), k4 = *(const LAS f32x4*)(sk + tt * 128 + dq * 32 + j4 * 4), q4 = *(const LAS f32x4*)(sq + tt * 128 + dq * 32 + j4 * 4);
#pragma unroll
                    for (int i = 0; i < 4; ++i) { float& sr = s[j4 * 4 + i]; sr = f4[i] * sr + k4[i] * iv; o += q4[i] * sr; }
                }
                if (latb) {
                    o += __shfl_xor(o, 1); o += __shfl_xor(o, 2);
                    const int idx = b * 32 + tt; const int t = dir == 0 ? idx - C : L - 1 - (idx - C);
                    if (dq == 0) OUT[(size_t)t * D + head * 128 + v] = o;
                }
            }
        }
        __syncthreads();
    }
}

__device__ __forceinline__ void phase_readout(const Ctx& c) {
    const float* OF = (const float*)(c.ws + WS_OF); const float* OB = (const float*)(c.ws + WS_OB); const bf16_t* SGp = (const bf16_t*)(c.ws + WS_SG);
    bf16_t* RR = (bf16_t*)(c.ws + WS_RR); const float* hng = c.a->in[13];
    for (int t = c.wg * 8 + c.wave; t < L; t += c.nwg * 8) {
        f32x4 a[4], b[4]; row_load(OF + (size_t)t * D, c.lane, a); row_load(OB + (size_t)t * D, c.lane, b);
#pragma unroll
        for (int j = 0; j < 4; ++j) {
            const f32x4 o = a[j] + b[j];
            float ss = o.x * o.x + o.y * o.y + o.z * o.z + o.w * o.w;
#pragma unroll
            for (int sh = 16; sh > 0; sh >>= 1) ss += __shfl_xor(ss, sh);
            const float rstd = rsqrtf(ss * (1.f / 128.f) + EPS);
            const int c0 = c.lane * 4 + 256 * j;
            const f32x4 g = *(const f32x4*)(hng + c0);
            const u32x2 sg = *(const u32x2*)(SGp + (size_t)t * D + c0);
            u32x2 ov; ov.x = pk2(o.x * rstd * g.x * bflo(sg.x), o.y * rstd * g.y * bfhi(sg.x)); ov.y = pk2(o.z * rstd * g.z * bflo(sg.y), o.w * rstd * g.w * bfhi(sg.y));
            *(u32x2*)(RR + (size_t)t * D + c0) = ov;
        }
    }
}

__device__ __forceinline__ void launder(Ctx& c) { asm volatile("" : "+s"(c.a)); asm volatile("" : "+s"(c.ws)); }
__global__ void __launch_bounds__(512, 2) mk_fwd(Args args) {
    extern __shared__ __attribute__((aligned(16))) unsigned char lds_raw[];
    Ctx c; c.a = (CArgs)__builtin_amdgcn_kernarg_segment_ptr(); c.lds = (LAS unsigned char*)lds_raw; c.tid = threadIdx.x; c.lane = c.tid & 63; c.wave = c.tid >> 6; c.nwg = gridDim.x; c.wg = blockIdx.x; c.ws = c.a->ws;
    const int lo = c.a->ph_lo, hi = c.a->ph_hi;
#define IN(k) (lo <= (k) && (k) < hi && (launder(c), true))
    if (IN(0)) phase_prep(c);
    if (IN(1)) phase_norm0(c);
    if (IN(2)) phase_gemm_dense(c, (const bf16_t*)(c.ws + WS_H), R, c.a->in[7], QKVD, c.a->in[8], (float*)(c.ws + WS_RAW1));
    if (IN(3)) phase_rope(c);
    if (IN(4)) phase_attn_simple(c);
    if (IN(5)) phase_gemm_dense(c, (const bf16_t*)(c.ws + WS_O), R, c.a->in[10], D, nullptr, (float*)(c.ws + WS_RAW1));
    if (IN(6)) phase_postmix(c, 0, 0, 0);
    if (IN(7)) phase_moe_gemm(c, 0, false);
    if (IN(8)) phase_swiglu(c, 0);
    if (IN(9)) phase_moe_gemm(c, 0, true);
    if (IN(10)) phase_combine(c, 0);
    if (IN(11)) phase_gemm_dense(c, (const bf16_t*)(c.ws + WS_H), R, c.a->in[11], HIN, nullptr, (float*)(c.ws + WS_RAW1));
    if (IN(12)) phase_hgrn_elem(c);
    if (IN(13)) phase_hgrn_rec(c);
    if (IN(14)) phase_readout(c);
    if (IN(15)) phase_gemm_dense(c, (const bf16_t*)(c.ws + WS_RR), L, c.a->in[14], D, nullptr, (float*)(c.ws + WS_RAW1));
    if (IN(16)) phase_postmix(c, 1, C, C);
    if (IN(17)) phase_moe_gemm(c, 1, false);
    if (IN(18)) phase_swiglu(c, 1);
    if (IN(19)) phase_moe_gemm(c, 1, true);
    if (IN(20)) phase_combine(c, 1);
#undef IN
}

extern "C" void kernel_launch(void* const* d_in, const int* in_sizes, int n_in, void* d_out, int out_size, void* d_ws, size_t ws_size, hipStream_t stream) {
    static int grid = 0;
    if (grid == 0) {
        if (n_in != 21 || out_size != L * D || ws_size < WS_END) { fprintf(stderr, "kernel_launch: unexpected problem (n_in %d out %d ws %zu need %zu)\n", n_in, out_size, ws_size, (size_t)WS_END); grid = -1; return; }
        int dev = 0, cus = 0, per_cu = 0;
        hipGetDevice(&dev); hipDeviceGetAttribute(&cus, hipDeviceAttributeMultiprocessorCount, dev);
        if (hipFuncSetAttribute((const void*)mk_fwd, hipFuncAttributeMaxDynamicSharedMemorySize, LDS_BYTES) != hipSuccess) { fprintf(stderr, "kernel_launch: hipFuncSetAttribute failed\n"); grid = -1; return; }
        hipOccupancyMaxActiveBlocksPerMultiprocessor(&per_cu, (const void*)mk_fwd, 512, LDS_BYTES);
        if (per_cu < 1) fprintf(stderr, "kernel_launch: occupancy query says %d\n", per_cu);
        (void)hipGetLastError();
        grid = cus > 0 ? cus : 256;
    }
    if (grid < 0) return;
    hipMemsetAsync((char*)d_ws + WS_CTL, 0, MiB, stream);
    Args a{};
    for (int i = 0; i < 21; ++i) a.in[i] = (const float*)d_in[i];
    a.out = (float*)d_out; a.ws = (unsigned char*)d_ws;
    for (int ph = 0; ph < NPHASE; ++ph) {
        a.ph_lo = ph; a.ph_hi = ph + 1;
        hipLaunchKernelGGL(mk_fwd, dim3(grid), dim3(512), LDS_BYTES, stream, a);
    }
}
```

```cpp
#include <hip/hip_runtime.h>
#include <cstdint>
#include <cstdio>

#define LAS __attribute__((address_space(3)))
typedef unsigned short bf16_t;
typedef short bf16x8 __attribute__((ext_vector_type(8)));
typedef float f32x4 __attribute__((ext_vector_type(4)));
typedef unsigned u32x4 __attribute__((ext_vector_type(4)));
typedef unsigned u32x2 __attribute__((ext_vector_type(2)));

constexpr int D = 1024, L = 16384, C = 256, R = L + C;
constexpr int QKVD = 1280, HIN = 5120, NE = 32, TOPK = 4;
constexpr int PADM = 256, MAXROWS = 74752;
constexpr float EPS = 1e-6f;
constexpr float LOG2E = 1.4426950408889634f;
constexpr int NPHASE = 21;
constexpr int LDS_BYTES = 147456;

constexpr size_t MiB = 1u << 20;
constexpr size_t al(size_t x) { return (x + MiB - 1) / MiB * MiB; }
constexpr size_t WS_CTL = 0;
constexpr size_t WS_MOD = WS_CTL + MiB;
constexpr size_t WS_X = WS_MOD + MiB;
constexpr size_t WS_H = WS_X + al((size_t)R * D * 4);
constexpr size_t WS_Q = WS_H + al((size_t)R * D * 2);
constexpr size_t WS_K = WS_Q + al((size_t)R * D * 2);
constexpr size_t WS_V = WS_K + al((size_t)R * 128 * 2);
constexpr size_t WS_O = WS_V + al((size_t)R * 128 * 2);
constexpr size_t WS_TK = WS_O + al((size_t)R * D * 2);
constexpr size_t WS_LIST = WS_TK + MiB;
constexpr size_t WS_HDN = WS_LIST + 3 * MiB;
constexpr size_t WS_RAW1 = WS_HDN + al((size_t)MAXROWS * 1024 * 2);
constexpr size_t WS_RAW2 = WS_RAW1 + al((size_t)MAXROWS * 2048 * 4);
constexpr size_t WS_QH = WS_RAW2 + al((size_t)MAXROWS * 1024 * 4);
constexpr size_t WS_KF = WS_QH + al((size_t)L * D * 2);
constexpr size_t WS_KB = WS_KF + al((size_t)R * D * 2);
constexpr size_t WS_IV = WS_KB + al((size_t)R * D * 2);
constexpr size_t WS_SG = WS_IV + al((size_t)R * D * 2);
constexpr size_t WS_OF = WS_SG + al((size_t)L * D * 2);
constexpr size_t WS_OB = WS_OF + al((size_t)L * D * 4);
constexpr size_t WS_RR = WS_OB + al((size_t)L * D * 4);
constexpr size_t WS_END = WS_RR + al((size_t)L * D * 2);
constexpr int CW_CNT = 1024;
constexpr int CW_BAR = 4096;
constexpr int MOD_ROPE = 32768;
constexpr int MOD_LB = 49152;

struct Args { const float* in[21]; float* out; unsigned char* ws; int ph_lo, ph_hi; };

__device__ __forceinline__ unsigned f2bf(float f) { unsigned u = __float_as_uint(f); return (u + 0x7fffu + ((u >> 16) & 1u)) >> 16; }
__device__ __forceinline__ unsigned pk2(float lo, float hi) { return f2bf(lo) | (f2bf(hi) << 16); }
__device__ __forceinline__ float bflo(unsigned u) { return __uint_as_float(u << 16); }
__device__ __forceinline__ float bfhi(unsigned u) { return __uint_as_float(u & 0xffff0000u); }
__device__ __forceinline__ float bf2f(bf16_t b) { return __uint_as_float(((unsigned)b) << 16); }
__device__ __forceinline__ float wave_sum(float v) {
#pragma unroll
    for (int o = 32; o > 0; o >>= 1) v += __shfl_xor(v, o);
    return v;
}
__device__ __forceinline__ float silu_f(float x) { return x / (1.f + __expf(-x)); }
__device__ __forceinline__ float sigmoid_f(float x) { return 1.f / (1.f + __expf(-x)); }

typedef const __attribute__((address_space(4))) Args* CArgs;
struct Ctx {
    CArgs a;
    LAS unsigned char* lds;
    int tid, lane, wave, nwg, wg;
    unsigned char* ws;
    __device__ __forceinline__ float* modp(int layer, int which) const { return (float*)(ws + WS_MOD) + (layer * 2 + which) * 6144; }
    __device__ __forceinline__ const float* xin0(int r) const { return r < C ? a->in[2] + (size_t)r * D : a->in[0] + (size_t)(r - C) * D; }
};

__device__ __forceinline__ void phase_prep(const Ctx& c) {
    LAS float* red = (LAS float*)c.lds;
    const float* cv = c.a->in[1]; const float* ccv = c.a->in[3]; const float* ada_w = c.a->in[4]; const float* ada_b = c.a->in[5];
    for (int item = c.wg; item < 193; item += c.nwg) {
        if (item < 192) {
            const int layer = item / 96, cb = item % 96, col = cb * 64 + c.lane;
            const float* W = ada_w + (size_t)layer * D * 6144 + col;
            float a0 = 0.f, a1 = 0.f;
            const int k0 = c.wave * 128;
#pragma unroll 8
            for (int k = 0; k < 128; ++k) { const float w = W[(size_t)(k0 + k) * 6144]; a0 += silu_f(cv[k0 + k]) * w; a1 += silu_f(ccv[k0 + k]) * w; }
            red[(0 * 8 + c.wave) * 64 + c.lane] = a0; red[(1 * 8 + c.wave) * 64 + c.lane] = a1;
            __syncthreads();
            if (c.tid < 128) {
                const int which = c.tid >> 6, l = c.tid & 63; float s = 0.f;
#pragma unroll
                for (int w = 0; w < 8; ++w) s += red[(which * 8 + w) * 64 + l];
                c.modp(layer, which)[cb * 64 + l] = s + ada_b[layer * 6144 + cb * 64 + l];
            }
            __syncthreads();
        } else {
            float* modbase = (float*)(c.ws + WS_MOD);
            for (int i = c.tid; i < 4096; i += 512) {
                const int pos = i >> 4, j = i & 15;
                const double ang = (double)pos * pow(10000.0, -(double)j / 16.0);
                modbase[MOD_ROPE + 2 * i] = (float)cos(ang); modbase[MOD_ROPE + 2 * i + 1] = (float)sin(ang);
            }
            const float* lbp = c.a->in[12];
            for (int i = c.tid; i < 2048; i += 512) { const float p0 = lbp[i], p1 = lbp[2048 + i]; modbase[MOD_LB + i] = 1.f / (1.f + __expf(p0 - p1)); }
        }
    }
}

__device__ __forceinline__ void row_load(const float* p, int lane, f32x4 (&v)[4]) {
#pragma unroll
    for (int j = 0; j < 4; ++j) v[j] = *(const f32x4*)(p + lane * 4 + 256 * j);
}
__device__ __forceinline__ float row_ss(const f32x4 (&v)[4]) {
    float s = 0.f;
#pragma unroll
    for (int j = 0; j < 4; ++j) s += v[j].x * v[j].x + v[j].y * v[j].y + v[j].z * v[j].z + v[j].w * v[j].w;
    return wave_sum(s);
}
__device__ __forceinline__ void row_modnorm_store(const f32x4 (&x)[4], float rstd, const float* g, const float* sh, const float* sc, bf16_t* out, int lane, f32x4 (*hout)[4] = nullptr) {
#pragma unroll
    for (int j = 0; j < 4; ++j) {
        const int c0 = lane * 4 + 256 * j;
        const f32x4 gv = *(const f32x4*)(g + c0), shv = *(const f32x4*)(sh + c0), scv = *(const f32x4*)(sc + c0);
        f32x4 h;
        h.x = x[j].x * rstd * gv.x * (1.f + scv.x) + shv.x; h.y = x[j].y * rstd * gv.y * (1.f + scv.y) + shv.y;
        h.z = x[j].z * rstd * gv.z * (1.f + scv.z) + shv.z; h.w = x[j].w * rstd * gv.w * (1.f + scv.w) + shv.w;
        if (hout) (*hout)[j] = h;
        u32x2 o; o.x = pk2(h.x, h.y); o.y = pk2(h.z, h.w);
        *(u32x2*)(out + c0) = o;
    }
}

__device__ __forceinline__ void phase_norm0(const Ctx& c) {
    bf16_t* H = (bf16_t*)(c.ws + WS_H); const float* ng = c.a->in[6];
    for (int r = c.wg * 8 + c.wave; r < R; r += c.nwg * 8) {
        f32x4 x[4]; row_load(c.xin0(r), c.lane, x);
        const float rstd = rsqrtf(row_ss(x) * (1.f / D) + EPS);
        const float* m = c.modp(0, r < C ? 1 : 0);
        row_modnorm_store(x, rstd, ng, m + 0, m + 1024, H + (size_t)r * D, c.lane);
    }
}

__device__ __forceinline__ void sgemm_tile(LAS unsigned char* lds, const bf16_t* A, int lda, const int* rowlist, int nvalid, int row0,
                           const float* B, int ldb, int col0, const float* bias, float* Cout, int ldc, int crow0, int K) {
    const int tid = threadIdx.x, lane = tid & 63, w = tid >> 6, wm = w >> 1, wn = w & 1;
    LAS bf16_t* sA = (LAS bf16_t*)lds;
    LAS bf16_t* sB = (LAS bf16_t*)(lds + 128 * 40 * 2);
    const int ar = tid >> 2, ak = (tid & 3) * 8;
    size_t arow;
    if (rowlist) arow = (row0 + ar) < nvalid ? (size_t)rowlist[row0 + ar] : 0; else arow = (size_t)(row0 + ar);
    const bf16_t* ap = A + arow * lda + ak;
    const int bk = tid >> 4, bn = (tid & 15) * 4;
    const float* bp = B + (size_t)bk * ldb + col0 + bn;
    f32x4 acc[2][2];
#pragma unroll
    for (int i = 0; i < 2; ++i)
#pragma unroll
        for (int j = 0; j < 2; ++j) acc[i][j] = (f32x4){0.f, 0.f, 0.f, 0.f};
    for (int k0 = 0; k0 < K; k0 += 32) {
        const u32x4 av = *(const u32x4*)(ap + k0);
        const f32x4 bv = *(const f32x4*)(bp + (size_t)k0 * ldb);
        __syncthreads();
        *(LAS u32x4*)(sA + ar * 40 + ak) = av;
        sB[(bn + 0) * 40 + bk] = (bf16_t)f2bf(bv.x); sB[(bn + 1) * 40 + bk] = (bf16_t)f2bf(bv.y);
        sB[(bn + 2) * 40 + bk] = (bf16_t)f2bf(bv.z); sB[(bn + 3) * 40 + bk] = (bf16_t)f2bf(bv.w);
        __syncthreads();
        bf16x8 a[2], b[2];
#pragma unroll
        for (int i = 0; i < 2; ++i) a[i] = *(const LAS bf16x8*)(sA + (wm * 32 + i * 16 + (lane & 15)) * 40 + (lane >> 4) * 8);
#pragma unroll
        for (int j = 0; j < 2; ++j) b[j] = *(const LAS bf16x8*)(sB + (wn * 32 + j * 16 + (lane & 15)) * 40 + (lane >> 4) * 8);
#pragma unroll
        for (int i = 0; i < 2; ++i)
#pragma unroll
            for (int j = 0; j < 2; ++j) acc[i][j] = __builtin_amdgcn_mfma_f32_16x16x32_bf16(a[i], b[j], acc[i][j], 0, 0, 0);
    }
#pragma unroll
    for (int i = 0; i < 2; ++i)
#pragma unroll
        for (int j = 0; j < 2; ++j) {
            const int col = col0 + wn * 32 + j * 16 + (lane & 15);
            const float bb = bias ? bias[col] : 0.f;
#pragma unroll
            for (int e = 0; e < 4; ++e) {
                const int row = crow0 + wm * 32 + i * 16 + (lane >> 4) * 4 + e;
                Cout[(size_t)row * ldc + col] = acc[i][j][e] + bb;
            }
        }
    __syncthreads();
}

__device__ __forceinline__ void phase_gemm_dense(const Ctx& c, const bf16_t* A, int M, const float* B, int N, const float* bias, float* Cout) {
    const int nmt = M / 128, nnt = N / 64;
    for (int item = c.wg; item < nmt * nnt; item += c.nwg) {
        const int mt = item % nmt, nt = item / nmt;
        sgemm_tile(c.lds, A, D, nullptr, 0, mt * 128, B, N, nt * 64, bias, Cout, N, mt * 128, D);
    }
}

__device__ __forceinline__ void phase_rope(const Ctx& c) {
    const float* raw = (const float*)(c.ws + WS_RAW1); const float* tab = (const float*)(c.ws + WS_MOD) + MOD_ROPE;
    bf16_t* Q = (bf16_t*)(c.ws + WS_Q); bf16_t* K = (bf16_t*)(c.ws + WS_K); bf16_t* V = (bf16_t*)(c.ws + WS_V);
    const float qs = 0.125f * LOG2E;
    for (int r = c.wg * 8 + c.wave; r < R; r += c.nwg * 8) {
        const float* row = raw + (size_t)r * QKVD;
        const bool lat = r >= C; const int t = r - C;
        for (int col = c.lane; col < QKVD; col += 64) {
            float val = row[col];
            if (col < 1152 && lat) {
                const int within = col & 63, half = within >> 5, part = (within >> 4) & 1, j = within & 15;
                const int pos = half == 0 ? (t >> 6) : (t & 63);
                const float cs = tab[2 * (pos * 16 + j)], sn = tab[2 * (pos * 16 + j) + 1];
                const float x1 = part == 0 ? val : row[col - 16], x2 = part == 0 ? row[col + 16] : val;
                val = part == 0 ? (x1 * cs - x2 * sn) : (x2 * cs + x1 * sn);
            }
            if (col < 1024) Q[(size_t)r * D + col] = (bf16_t)f2bf(val * qs);
            else if (col < 1152) K[(size_t)r * 128 + (col - 1024)] = (bf16_t)f2bf(val);
            else V[(size_t)r * 128 + (col - 1152)] = (bf16_t)f2bf(val);
        }
    }
}

__device__ __forceinline__ void phase_attn_simple(const Ctx& c) {
    const bf16_t* Q = (const bf16_t*)(c.ws + WS_Q); const bf16_t* K = (const bf16_t*)(c.ws + WS_K); const bf16_t* V = (const bf16_t*)(c.ws + WS_V);
    bf16_t* O = (bf16_t*)(c.ws + WS_O); const float* sink = c.a->in[9];
    LAS unsigned* sK = (LAS unsigned*)c.lds;
    LAS unsigned* sV = (LAS unsigned*)(c.lds + 16384);
    for (int item = c.wg; item < 260; item += c.nwg) {
        const bool isctx = item >= 256;
        const int n = isctx ? 0 : (item >> 1), kh = item & 1, cb = isctx ? ((item - 256) >> 1) : 0;
        const int qrow0 = isctx ? cb * 128 : C + n * 128;
        const int nchunk = isctx ? 2 : 5;
        for (int pp = 0; pp < 2; ++pp) {
            const int pi = c.tid + 512 * pp, qi = pi & 127, g = pi >> 7, hq = kh * 8 + g;
            const int tq = n * 128 + qi;
            unsigned q[32];
            {
                const u32x4* qp = (const u32x4*)(Q + (size_t)(qrow0 + qi) * D + hq * 64);
#pragma unroll
                for (int i = 0; i < 8; ++i) { const u32x4 u = qp[i]; q[4 * i] = u.x; q[4 * i + 1] = u.y; q[4 * i + 2] = u.z; q[4 * i + 3] = u.w; }
            }
            const float sink2 = sink[hq] * LOG2E;
            float m = sink2, l = 0.f;
            float acc[64];
#pragma unroll
            for (int i = 0; i < 64; ++i) acc[i] = 0.f;
            for (int pass = 0; pass < 2; ++pass) {
                if (pass == 1) l = exp2f(sink2 - m);
                for (int ch = 0; ch < nchunk; ++ch) {
                    int krow0, tk0 = 0; bool win = false;
                    if (ch < 2) krow0 = ch * 128;
                    else { const int b = n + ch - 3; if (b < 0 || b >= 128) continue; krow0 = C + b * 128; tk0 = b * 128; win = true; }
                    __syncthreads();
                    {
                        const int rr = c.tid >> 2, cc = (c.tid & 3) * 8;
                        const u32x4* kp = (const u32x4*)(K + (size_t)(krow0 + rr) * 128 + kh * 64) + (c.tid & 3) * 2;
                        *(LAS u32x4*)(sK + rr * 32 + cc) = kp[0]; *(LAS u32x4*)(sK + rr * 32 + cc + 4) = kp[1];
                        if (pass == 1) { const u32x4* vp = (const u32x4*)(V + (size_t)(krow0 + rr) * 128 + kh * 64) + (c.tid & 3) * 2;
                            *(LAS u32x4*)(sV + rr * 32 + cc) = vp[0]; *(LAS u32x4*)(sV + rr * 32 + cc + 4) = vp[1]; }
                    }
                    __syncthreads();
                    for (int key = 0; key < 128; ++key) {
                        const LAS u32x4* kp = (const LAS u32x4*)(sK + key * 32);
                        float s = 0.f;
#pragma unroll
                        for (int i = 0; i < 8; ++i) { const u32x4 u = kp[i];
                            s += bflo(q[4 * i]) * bflo(u.x) + bfhi(q[4 * i]) * bfhi(u.x) + bflo(q[4 * i + 1]) * bflo(u.y) + bfhi(q[4 * i + 1]) * bfhi(u.y)
                               + bflo(q[4 * i + 2]) * bflo(u.z) + bfhi(q[4 * i + 2]) * bfhi(u.z) + bflo(q[4 * i + 3]) * bflo(u.w) + bfhi(q[4 * i + 3]) * bfhi(u.w); }
                        bool valid = true;
                        if (win) { const int dt = tq - (tk0 + key); valid = (dt <= 128) && (dt >= -128); }
                        if (pass == 0) { if (valid) m = fmaxf(m, s); }
                        else {
                            const float p = valid ? exp2f(s - m) : 0.f;
                            l += p;
                            const LAS u32x4* vp = (const LAS u32x4*)(sV + key * 32);
#pragma unroll
                            for (int i = 0; i < 8; ++i) { const u32x4 u = vp[i];
                                acc[8 * i] += p * bflo(u.x); acc[8 * i + 1] += p * bfhi(u.x); acc[8 * i + 2] += p * bflo(u.y); acc[8 * i + 3] += p * bfhi(u.y);
                                acc[8 * i + 4] += p * bflo(u.z); acc[8 * i + 5] += p * bfhi(u.z); acc[8 * i + 6] += p * bflo(u.w); acc[8 * i + 7] += p * bfhi(u.w); }
                        }
                    }
                }
            }
            const float il = 1.f / l;
            u32x4* op = (u32x4*)(O + (size_t)(qrow0 + qi) * D + hq * 64);
#pragma unroll
            for (int i = 0; i < 8; ++i) { u32x4 u; u.x = pk2(acc[8 * i] * il, acc[8 * i + 1] * il); u.y = pk2(acc[8 * i + 2] * il, acc[8 * i + 3] * il);
                u.z = pk2(acc[8 * i + 4] * il, acc[8 * i + 5] * il); u.w = pk2(acc[8 * i + 6] * il, acc[8 * i + 7] * il); op[i] = u; }
        }
        __syncthreads();
    }
}

__device__ __forceinline__ void phase_postmix(const Ctx& c, int layer, int r_lo, int yoff) {
    const float* Y = (const float*)(c.ws + WS_RAW1); float* X = (float*)(c.ws + WS_X); bf16_t* H = (bf16_t*)(c.ws + WS_H);
    const float* ng = c.a->in[6] + layer * 4 * D; const float* Wr = c.a->in[15] + (size_t)layer * D * NE; const float* br = c.a->in[16] + layer * NE;
    unsigned* cnt = (unsigned*)(c.ws + WS_CTL) + CW_CNT + layer * NE;
    int* tk_e = (int*)(c.ws + WS_TK); float* tk_g = (float*)(c.ws + WS_TK) + R * 4; int* tk_slot = (int*)(c.ws + WS_TK) + 2 * R * 4;
    int* list = (int*)(c.ws + WS_LIST);
    LAS float* pr = (LAS float*)c.lds + c.wave * (64 * 33);
    LAS float* hrow = (LAS float*)c.lds + 8 * 64 * 33 + c.wave * 1024;
    for (int r = r_lo + c.wg * 8 + c.wave; r < R; r += c.nwg * 8) {
        const float* m = c.modp(layer, r < C ? 1 : 0);
        const float* xsrc = layer == 0 ? c.xin0(r) : X + (size_t)r * D;
        f32x4 y[4], x[4]; row_load(Y + (size_t)(r - yoff) * D, c.lane, y); row_load(xsrc, c.lane, x);
        const float rstd_y = rsqrtf(row_ss(y) * (1.f / D) + EPS);
#pragma unroll
        for (int j = 0; j < 4; ++j) {
            const int c0 = c.lane * 4 + 256 * j;
            const f32x4 g1 = *(const f32x4*)(m + 2048 + c0), n1 = *(const f32x4*)(ng + D + c0);
            x[j].x += g1.x * (y[j].x * rstd_y * n1.x); x[j].y += g1.y * (y[j].y * rstd_y * n1.y);
            x[j].z += g1.z * (y[j].z * rstd_y * n1.z); x[j].w += g1.w * (y[j].w * rstd_y * n1.w);
            *(f32x4*)(X + (size_t)r * D + c0) = x[j];
        }
        const float rstd_x = rsqrtf(row_ss(x) * (1.f / D) + EPS);
        f32x4 h[4];
        row_modnorm_store(x, rstd_x, ng + 2 * D, m + 3072, m + 4096, H + (size_t)r * D, c.lane, &h);
#pragma unroll
        for (int j = 0; j < 4; ++j) *(LAS f32x4*)(hrow + c.lane * 4 + 256 * j) = h[j];
        float p[32];
#pragma unroll
        for (int e = 0; e < 32; ++e) p[e] = 0.f;
#pragma unroll 2
        for (int k = 0; k < 16; ++k) {
            const int col = c.lane * 4 + 256 * (k >> 2) + (k & 3);
            const float hv = hrow[col]; const f32x4* wrow = (const f32x4*)(Wr + (size_t)col * NE);
#pragma unroll
            for (int e4 = 0; e4 < 8; ++e4) { const f32x4 wv = wrow[e4]; p[4 * e4] += hv * wv.x; p[4 * e4 + 1] += hv * wv.y; p[4 * e4 + 2] += hv * wv.z; p[4 * e4 + 3] += hv * wv.w; }
        }
#pragma unroll
        for (int e = 0; e < 32; ++e) pr[c.lane * 33 + e] = p[e];
        asm volatile("s_waitcnt lgkmcnt(0)" ::: "memory");
        __builtin_amdgcn_wave_barrier();
        float logit = -INFINITY;
        if (c.lane < 32) { float s = br[c.lane]; for (int l2 = 0; l2 < 64; ++l2) s += pr[l2 * 33 + c.lane]; logit = s; }
        asm volatile("s_waitcnt lgkmcnt(0)" ::: "memory");
        __builtin_amdgcn_wave_barrier();
        float tv[4]; int te[4];
#pragma unroll
        for (int k = 0; k < 4; ++k) {
            float bv = logit; int bi = c.lane;
#pragma unroll
            for (int o = 32; o > 0; o >>= 1) {
                const float ov = __shfl_xor(bv, o); const int oi = __shfl_xor(bi, o);
                if (ov > bv || (ov == bv && oi < bi)) { bv = ov; bi = oi; }
            }
            tv[k] = bv; te[k] = bi;
            if (c.lane == bi) logit = -INFINITY;
        }
        if (c.lane == 0) {
            const float e1 = __expf(tv[1] - tv[0]), e2 = __expf(tv[2] - tv[0]), e3 = __expf(tv[3] - tv[0]);
            const float inv = 1.f / (1.f + e1 + e2 + e3);
            const float gk[4] = {inv, e1 * inv, e2 * inv, e3 * inv};
#pragma unroll
            for (int k = 0; k < 4; ++k) {
                const unsigned slot = atomicAdd(&cnt[te[k]], 1u);
                list[(size_t)te[k] * R + slot] = r;
                tk_e[r * 4 + k] = te[k]; tk_g[r * 4 + k] = gk[k]; tk_slot[r * 4 + k] = (int)slot;
            }
        }
    }
}

__device__ __forceinline__ void moe_offsets(const Ctx& c, int layer, LAS int* so) {
    const unsigned* cnt = (const unsigned*)(c.ws + WS_CTL) + CW_CNT + layer * NE;
    __syncthreads();
    if (c.tid == 0) { int acc = 0; for (int e = 0; e < NE; ++e) { const int n = (int)cnt[e]; so[e] = acc; so[64 + e] = n; acc += (n + PADM - 1) / PADM * PADM; } so[32] = acc; }
    __syncthreads();
}

__device__ __forceinline__ void phase_moe_gemm(const Ctx& c, int layer, bool down) {
    LAS int* so = (LAS int*)(c.lds + 32768);
    moe_offsets(c, layer, so);
    const int N = down ? 1024 : 2048, nnt = N / 64;
    const float* W = down ? c.a->in[19] + (size_t)layer * NE * 1024 * 1024 : c.a->in[17] + (size_t)layer * NE * 1024 * 2048;
    const float* bias = down ? c.a->in[20] + (size_t)layer * NE * 1024 : c.a->in[18] + (size_t)layer * NE * 2048;
    const bf16_t* A = down ? (const bf16_t*)(c.ws + WS_HDN) : (const bf16_t*)(c.ws + WS_H);
    float* Cout = down ? (float*)(c.ws + WS_RAW2) : (float*)(c.ws + WS_RAW1);
    const int* list = (const int*)(c.ws + WS_LIST);
    int base = 0;
    for (int e = 0; e < NE; ++e) {
        const int n = so[64 + e], nmt = (n + 127) / 128, nitems = nmt * nnt;
        int first = c.wg - (base % c.nwg); if (first < 0) first += c.nwg;
        for (int li = first; li < nitems; li += c.nwg) {
            const int mt = li % nmt, nt = li / nmt;
            if (down) sgemm_tile(c.lds, A, 1024, nullptr, 0, so[e] + mt * 128, W + (size_t)e * 1024 * 1024, 1024, nt * 64, bias + e * 1024, Cout, 1024, so[e] + mt * 128, 1024);
            else sgemm_tile(c.lds, A, D, list + (size_t)e * R, n, mt * 128, W + (size_t)e * 1024 * 2048, 2048, nt * 64, bias + e * 2048, Cout, 2048, so[e] + mt * 128, 1024);
        }
        base += nitems;
    }
}

__device__ __forceinline__ void phase_swiglu(const Ctx& c, int layer) {
    LAS int* so = (LAS int*)(c.lds + 32768);
    moe_offsets(c, layer, so);
    const float* gu = (const float*)(c.ws + WS_RAW1); bf16_t* hdn = (bf16_t*)(c.ws + WS_HDN);
    for (int e = 0; e < NE; ++e) {
        const int n = so[64 + e], nrow = (n + 127) / 128 * 128;
        for (int rr = c.wg * 8 + c.wave; rr < nrow; rr += c.nwg * 8) {
            const size_t row = (size_t)(so[e] + rr);
            for (int col = c.lane * 4; col < 1024; col += 256) {
                const f32x4 g4 = *(const f32x4*)(gu + row * 2048 + col), u4 = *(const f32x4*)(gu + row * 2048 + 1024 + col);
                float hv[4];
#pragma unroll
                for (int i = 0; i < 4; ++i) { const float g = fminf(g4[i], 7.f), u = fminf(fmaxf(u4[i], -7.f), 7.f); hv[i] = g * sigmoid_f(1.702f * g) * (u + 1.f); }
                u32x2 o; o.x = pk2(hv[0], hv[1]); o.y = pk2(hv[2], hv[3]);
                *(u32x2*)(hdn + row * 1024 + col) = o;
            }
        }
    }
}

__device__ __forceinline__ void phase_combine(const Ctx& c, int layer) {
    LAS int* so = (LAS int*)(c.lds + 32768);
    moe_offsets(c, layer, so);
    const float* outb = (const float*)(c.ws + WS_RAW2); float* X = (float*)(c.ws + WS_X); bf16_t* H = (bf16_t*)(c.ws + WS_H);
    const float* ngl = c.a->in[6] + layer * 4 * D;
    const int* tk_e = (const int*)(c.ws + WS_TK); const float* tk_g = (const float*)(c.ws + WS_TK) + R * 4; const int* tk_slot = (const int*)(c.ws + WS_TK) + 2 * R * 4;
    const int r_lo = layer == 0 ? 0 : C;
    for (int r = r_lo + c.wg * 8 + c.wave; r < R; r += c.nwg * 8) {
        const float* m = c.modp(layer, r < C ? 1 : 0);
        f32x4 y[4];
#pragma unroll
        for (int j = 0; j < 4; ++j) y[j] = (f32x4){0.f, 0.f, 0.f, 0.f};
#pragma unroll
        for (int k = 0; k < 4; ++k) {
            const int e = tk_e[r * 4 + k], slot = tk_slot[r * 4 + k]; const float g = tk_g[r * 4 + k];
            const float* src = outb + (size_t)(so[e] + slot) * 1024;
#pragma unroll
            for (int j = 0; j < 4; ++j) { const f32x4 v = *(const f32x4*)(src + c.lane * 4 + 256 * j); y[j] += v * g; }
        }
        const float rstd_y = rsqrtf(row_ss(y) * (1.f / D) + EPS);
        f32x4 x[4]; row_load(X + (size_t)r * D, c.lane, x);
#pragma unroll
        for (int j = 0; j < 4; ++j) {
            const int c0 = c.lane * 4 + 256 * j;
            const f32x4 g2 = *(const f32x4*)(m + 5120 + c0), n3 = *(const f32x4*)(ngl + 3 * D + c0);
            x[j].x += g2.x * (y[j].x * rstd_y * n3.x); x[j].y += g2.y * (y[j].y * rstd_y * n3.y);
            x[j].z += g2.z * (y[j].z * rstd_y * n3.z); x[j].w += g2.w * (y[j].w * rstd_y * n3.w);
            if (layer == 0) *(f32x4*)(X + (size_t)r * D + c0) = x[j];
            else *(f32x4*)(c.a->out + (size_t)(r - C) * D + c0) = x[j];
        }
        if (layer == 0) {
            const float rstd_x = rsqrtf(row_ss(x) * (1.f / D) + EPS);
            const float* m1 = c.modp(1, r < C ? 1 : 0);
            row_modnorm_store(x, rstd_x, c.a->in[6] + 4 * D, m1 + 0, m1 + 1024, H + (size_t)r * D, c.lane);
        }
    }
}

__device__ __forceinline__ void phase_hgrn_elem(const Ctx& c) {
    const float* raw = (const float*)(c.ws + WS_RAW1); const float* lb = (const float*)(c.ws + WS_MOD) + MOD_LB;
    bf16_t* QH = (bf16_t*)(c.ws + WS_QH); _Float16* KF = (_Float16*)(c.ws + WS_KF); _Float16* KB = (_Float16*)(c.ws + WS_KB);
    bf16_t* IV = (bf16_t*)(c.ws + WS_IV); bf16_t* SGp = (bf16_t*)(c.ws + WS_SG);
    for (int r = c.wg * 8 + c.wave; r < R; r += c.nwg * 8) {
        const float* row = raw + (size_t)r * HIN; const bool lat = r >= C; const int t = r - C;
        for (int col = c.lane; col < D; col += 64) {
            const float zf = row[1024 + col], zb = row[2048 + col];
            KF[(size_t)r * D + col] = (_Float16)((1.f - lb[col]) * sigmoid_f(-zf));
            KB[(size_t)r * D + col] = (_Float16)((1.f - lb[1024 + col]) * sigmoid_f(-zb));
            IV[(size_t)r * D + col] = (bf16_t)f2bf(row[3072 + col]);
            if (lat) { QH[(size_t)t * D + col] = (bf16_t)f2bf(silu_f(row[col])); SGp[(size_t)t * D + col] = (bf16_t)f2bf(silu_f(row[4096 + col])); }
        }
    }
}

__device__ __forceinline__ void phase_hgrn_rec(const Ctx& c) {
    const bf16_t* QH = (const bf16_t*)(c.ws + WS_QH); const bf16_t* IV = (const bf16_t*)(c.ws + WS_IV);
    LAS float* sf = (LAS float*)c.lds; LAS float* sk = sf + 32 * 128; LAS float* sq = sk + 32 * 128; LAS float* si = sq + 32 * 128;
    for (int item = c.wg; item < 16; item += c.nwg) {
        const int head = item >> 1, dir = item & 1;
        const _Float16* KX = (const _Float16*)(c.ws + (dir == 0 ? WS_KF : WS_KB));
        float* OUT = (float*)(c.ws + (dir == 0 ? WS_OF : WS_OB));
        const int v = c.tid >> 2, dq = c.tid & 3;
        float s[32];
#pragma unroll
        for (int j = 0; j < 32; ++j) s[j] = 0.f;
        for (int b = 0; b < R / 32; ++b) {
            __syncthreads();
            {
                const int tt = c.tid >> 4, c8 = (c.tid & 15) * 8;
                const int idx = b * 32 + tt;
                int r; bool lat;
                if (idx < C) { r = dir == 0 ? idx : C - 1 - idx; lat = false; } else { const int t = dir == 0 ? idx - C : L - 1 - (idx - C); r = C + t; lat = true; }
                const u32x4 ku = *(const u32x4*)(KX + (size_t)r * D + head * 128 + c8);
                const u32x4 iu = *(const u32x4*)(IV + (size_t)r * D + head * 128 + c8);
                u32x4 qu = (u32x4){0u, 0u, 0u, 0u};
                if (lat) qu = *(const u32x4*)(QH + (size_t)(r - C) * D + head * 128 + c8);
                const _Float16* kh = (const _Float16*)&ku;
                const unsigned iw[4] = {iu.x, iu.y, iu.z, iu.w}, qw[4] = {qu.x, qu.y, qu.z, qu.w};
#pragma unroll
                for (int i = 0; i < 8; ++i) {
                    const float kv = (float)kh[i];
                    sk[tt * 128 + c8 + i] = kv; sf[tt * 128 + c8 + i] = 1.f - kv;
                    si[tt * 128 + c8 + i] = (i & 1) ? bfhi(iw[i >> 1]) : bflo(iw[i >> 1]);
                    sq[tt * 128 + c8 + i] = (i & 1) ? bfhi(qw[i >> 1]) : bflo(qw[i >> 1]);
                }
            }
            __syncthreads();
            const bool latb = (b * 32) >= C;
            for (int tt = 0; tt < 32; ++tt) {
                const float iv = si[tt * 128 + v];
                float o = 0.f;
#pragma unroll
                for (int j4 = 0; j4 < 8; ++j4) {
                    const f32x4 f4 = *(const LAS f32x4*)(sf + tt * 128 + dq * 32 + j4 * 4), k4 = *(const LAS f32x4*)(sk + tt * 128 + dq * 32 + j4 * 4), q4 = *(const LAS f32x4*)(sq + tt * 128 + dq * 32 + j4 * 4);
#pragma unroll
                    for (int i = 0; i < 4; ++i) { float& sr = s[j4 * 4 + i]; sr = f4[i] * sr + k4[i] * iv; o += q4[i] * sr; }
                }
                if (latb) {
                    o += __shfl_xor(o, 1); o += __shfl_xor(o, 2);
                    const int idx = b * 32 + tt; const int t = dir == 0 ? idx - C : L - 1 - (idx - C);
                    if (dq == 0) OUT[(size_t)t * D + head * 128 + v] = o;
                }
            }
        }
        __syncthreads();
    }
}

__device__ __forceinline__ void phase_readout(const Ctx& c) {
    const float* OF = (const float*)(c.ws + WS_OF); const float* OB = (const float*)(c.ws + WS_OB); const bf16_t* SGp = (const bf16_t*)(c.ws + WS_SG);
    bf16_t* RR = (bf16_t*)(c.ws + WS_RR); const float* hng = c.a->in[13];
    for (int t = c.wg * 8 + c.wave; t < L; t += c.nwg * 8) {
        f32x4 a[4], b[4]; row_load(OF + (size_t)t * D, c.lane, a); row_load(OB + (size_t)t * D, c.lane, b);
#pragma unroll
        for (int j = 0; j < 4; ++j) {
            const f32x4 o = a[j] + b[j];
            float ss = o.x * o.x + o.y * o.y + o.z * o.z + o.w * o.w;
#pragma unroll
            for (int sh = 16; sh > 0; sh >>= 1) ss += __shfl_xor(ss, sh);
            const float rstd = rsqrtf(ss * (1.f / 128.f) + EPS);
            const int c0 = c.lane * 4 + 256 * j;
            const f32x4 g = *(const f32x4*)(hng + c0);
            const u32x2 sg = *(const u32x2*)(SGp + (size_t)t * D + c0);
            u32x2 ov; ov.x = pk2(o.x * rstd * g.x * bflo(sg.x), o.y * rstd * g.y * bfhi(sg.x)); ov.y = pk2(o.z * rstd * g.z * bflo(sg.y), o.w * rstd * g.w * bfhi(sg.y));
            *(u32x2*)(RR + (size_t)t * D + c0) = ov;
        }
    }
}

#define XB_TMO      128
#define XB_XCNT(j)  (256  + 64 * (j))
#define XB_XSUB(j)  (1280 + 64 * (j))
#define XB_XGEN(j)  (2304 + 64 * (j))
#define XB_TOP      3328
#define XB_TOPGEN   3392
#define XCD_BAR_WORDS 3456
#define XB_SPIN_CAP (1u << 18)
__device__ __forceinline__ unsigned xb_ld(unsigned* p)              { return __hip_atomic_load(p, __ATOMIC_RELAXED, __HIP_MEMORY_SCOPE_AGENT); }
__device__ __forceinline__ unsigned xb_add(unsigned* p, unsigned v) { return __hip_atomic_fetch_add(p, v, __ATOMIC_RELAXED, __HIP_MEMORY_SCOPE_AGENT); }
__device__ __forceinline__ unsigned xb_xcc_id() { return (unsigned)__builtin_amdgcn_s_getreg((3 << 11) | 20) & 0xFu; }
#define XB_SPIN(cond, bar) do { unsigned _sp = 0; while (cond) { __builtin_amdgcn_s_sleep(1); \
    if ((++_sp & 255u) == 0u) { if (xb_ld(&(bar)[XB_TMO])) break; if (_sp > XB_SPIN_CAP) { atomicAdd(&(bar)[XB_TMO], 1u); break; } } } } while (0)
struct XcdBarrier { unsigned* bar; unsigned x; volatile LAS unsigned* st; };
__device__ __forceinline__ XcdBarrier xcd_barrier_post(unsigned* bar, volatile LAS unsigned* st) {
    XcdBarrier b; b.bar = bar; b.x = xb_xcc_id(); b.st = st;
    if (threadIdx.x == 0) (void)xb_add(&bar[XB_XCNT(b.x)], 1u);
    return b;
}
__device__ __forceinline__ void xcd_barrier_complete(unsigned* bar, unsigned x, unsigned& nloc, unsigned& nx) {
    const unsigned G = gridDim.x * gridDim.y * gridDim.z;
    unsigned sum, cnt, mine, sp = 0u;
    for (;;) {
        sum = 0u; cnt = 0u; mine = 0u;
#pragma unroll
        for (unsigned j = 0; j < 16; ++j) { const unsigned c = xb_ld(&bar[XB_XCNT(j)]); sum += c; cnt += (c > 0u) ? 1u : 0u; mine = (j == x) ? c : mine; }
        if (sum == G) break;
        __builtin_amdgcn_s_sleep(1);
        if ((++sp & 255u) == 0u) { if (xb_ld(&bar[XB_TMO])) break; if (sp > XB_SPIN_CAP) { atomicAdd(&bar[XB_TMO], 1u); break; } }
    }
    nloc = mine > 0u ? mine : 1u; nx = cnt > 0u ? cnt : 1u;
}
__device__ __forceinline__ void xcd_barrier(const XcdBarrier& b) {
    asm volatile("s_waitcnt vmcnt(0)" ::: "memory");
    __syncthreads();
    if (threadIdx.x == 0) {
        unsigned* bar = b.bar;
        __builtin_amdgcn_s_waitcnt(0);
        unsigned nloc = b.st[0], nx = b.st[1];
        if (nloc == 0u) { xcd_barrier_complete(bar, b.x, nloc, nx); b.st[0] = nloc; b.st[1] = nx; }
        const unsigned old = xb_add(&bar[XB_XSUB(b.x)], 1u);
        const unsigned gen = old / nloc;
        if (old + 1u == (gen + 1u) * nloc) {
            __builtin_amdgcn_fence(__ATOMIC_RELEASE, "agent");
            asm volatile("s_waitcnt vmcnt(0)" ::: "memory");
            const unsigned og = xb_add(&bar[XB_TOP], 1u);
            const unsigned tg = og / nx;
            if (og + 1u == (tg + 1u) * nx) xb_add(&bar[XB_TOPGEN], 1u);
            else XB_SPIN(xb_ld(&bar[XB_TOPGEN]) == tg, bar);
            __builtin_amdgcn_fence(__ATOMIC_ACQUIRE, "agent");
            xb_add(&bar[XB_XGEN(b.x)], 1u);
            asm volatile("s_waitcnt vmcnt(0)" ::: "memory");
        } else {
            XB_SPIN(xb_ld(&bar[XB_XGEN(b.x)]) == gen, bar);
            __builtin_amdgcn_fence(__ATOMIC_ACQUIRE, "agent");
            asm volatile("s_waitcnt vmcnt(0)" ::: "memory");
        }
    }
    __syncthreads();
}

__device__ __forceinline__ void launder(Ctx& c) { asm volatile("" : "+s"(c.a)); asm volatile("" : "+s"(c.ws)); }
__global__ void __launch_bounds__(512, 2) mk_fwd(Args args) {
    extern __shared__ __attribute__((aligned(16))) unsigned char lds_raw[];
    Ctx c; c.a = (CArgs)__builtin_amdgcn_kernarg_segment_ptr(); c.lds = (LAS unsigned char*)lds_raw; c.tid = threadIdx.x; c.lane = c.tid & 63; c.wave = c.tid >> 6; c.nwg = gridDim.x; c.wg = blockIdx.x; c.ws = c.a->ws;
    volatile LAS unsigned* bst = (volatile LAS unsigned*)(c.lds + LDS_BYTES - 64);
    if (c.tid < 4) bst[c.tid] = 0u;
    __syncthreads();
    const XcdBarrier bar = xcd_barrier_post((unsigned*)(c.ws + WS_CTL) + CW_BAR, bst);
    const int lo = c.a->ph_lo, hi = c.a->ph_hi;
#define SEAM(k) do { if (lo <= (k) && (k) + 1 < hi) xcd_barrier(bar); } while (0)
#define IN(k) (lo <= (k) && (k) < hi && (launder(c), true))
    if (IN(0)) phase_prep(c);
    SEAM(0);
    if (IN(1)) phase_norm0(c);
    SEAM(1);
    if (IN(2)) phase_gemm_dense(c, (const bf16_t*)(c.ws + WS_H), R, c.a->in[7], QKVD, c.a->in[8], (float*)(c.ws + WS_RAW1));
    SEAM(2);
    if (IN(3)) phase_rope(c);
    SEAM(3);
    if (IN(4)) phase_attn_simple(c);
    SEAM(4);
    if (IN(5)) phase_gemm_dense(c, (const bf16_t*)(c.ws + WS_O), R, c.a->in[10], D, nullptr, (float*)(c.ws + WS_RAW1));
    SEAM(5);
    if (IN(6)) phase_postmix(c, 0, 0, 0);
    SEAM(6);
    if (IN(7)) phase_moe_gemm(c, 0, false);
    SEAM(7);
    if (IN(8)) phase_swiglu(c, 0);
    SEAM(8);
    if (IN(9)) phase_moe_gemm(c, 0, true);
    SEAM(9);
    if (IN(10)) phase_combine(c, 0);
    SEAM(10);
    if (IN(11)) phase_gemm_dense(c, (const bf16_t*)(c.ws + WS_H), R, c.a->in[11], HIN, nullptr, (float*)(c.ws + WS_RAW1));
    SEAM(11);
    if (IN(12)) phase_hgrn_elem(c);
    SEAM(12);
    if (IN(13)) phase_hgrn_rec(c);
    SEAM(13);
    if (IN(14)) phase_readout(c);
    SEAM(14);
    if (IN(15)) phase_gemm_dense(c, (const bf16_t*)(c.ws + WS_RR), L, c.a->in[14], D, nullptr, (float*)(c.ws + WS_RAW1));
    SEAM(15);
    if (IN(16)) phase_postmix(c, 1, C, C);
    SEAM(16);
    if (IN(17)) phase_moe_gemm(c, 1, false);
    SEAM(17);
    if (IN(18)) phase_swiglu(c, 1);
    SEAM(18);
    if (IN(19)) phase_moe_gemm(c, 1, true);
    SEAM(19);
    if (IN(20)) phase_combine(c, 1);
#undef IN
#undef SEAM
}

extern "C" void kernel_launch(void* const* d_in, const int* in_sizes, int n_in, void* d_out, int out_size, void* d_ws, size_t ws_size, hipStream_t stream) {
    static int grid = 0;
    if (grid == 0) {
        if (n_in != 21 || out_size != L * D || ws_size < WS_END) { fprintf(stderr, "kernel_launch: unexpected problem (n_in %d out %d ws %zu need %zu)\n", n_in, out_size, ws_size, (size_t)WS_END); grid = -1; return; }
        int dev = 0, cus = 0, per_cu = 0;
        hipGetDevice(&dev); hipDeviceGetAttribute(&cus, hipDeviceAttributeMultiprocessorCount, dev);
        if (hipFuncSetAttribute((const void*)mk_fwd, hipFuncAttributeMaxDynamicSharedMemorySize, LDS_BYTES) != hipSuccess) { fprintf(stderr, "kernel_launch: hipFuncSetAttribute failed\n"); grid = -1; return; }
        hipOccupancyMaxActiveBlocksPerMultiprocessor(&per_cu, (const void*)mk_fwd, 512, LDS_BYTES);
        if (per_cu < 1) fprintf(stderr, "kernel_launch: occupancy query says %d\n", per_cu);
        (void)hipGetLastError();
        grid = cus > 0 ? cus : 256;
    }
    if (grid < 0) return;
    hipMemsetAsync((char*)d_ws + WS_CTL, 0, MiB, stream);
    Args a{};
    for (int i = 0; i < 21; ++i) a.in[i] = (const float*)d_in[i];
    a.out = (float*)d_out; a.ws = (unsigned char*)d_ws;
    a.ph_lo = 0; a.ph_hi = NPHASE;
    hipLaunchKernelGGL(mk_fwd, dim3(grid), dim3(512), LDS_BYTES, stream, a);
}
```

```cpp
#include <hip/hip_runtime.h>
#include <cstdint>
#include <cstdio>

#define LAS __attribute__((address_space(3)))
typedef unsigned short bf16_t;
typedef short bf16x8 __attribute__((ext_vector_type(8)));
typedef float f32x4 __attribute__((ext_vector_type(4)));
typedef unsigned u32x4 __attribute__((ext_vector_type(4)));
typedef unsigned u32x2 __attribute__((ext_vector_type(2)));

constexpr int D = 1024, L = 16384, C = 256, R = L + C;
constexpr int QKVD = 1280, HIN = 5120, NE = 32, TOPK = 4;
constexpr int PADM = 256, MAXROWS = 74752;
constexpr float EPS = 1e-6f;
constexpr float LOG2E = 1.4426950408889634f;
constexpr int NPHASE = 19;
constexpr int LDS_BYTES = 147456;

constexpr size_t MiB = 1u << 20;
constexpr size_t al(size_t x) { return (x + MiB - 1) / MiB * MiB; }
constexpr size_t WS_CTL = 0;
constexpr size_t WS_MOD = WS_CTL + MiB;
constexpr size_t WS_X = WS_MOD + MiB;
constexpr size_t WS_H = WS_X + al((size_t)R * D * 4);
constexpr size_t WS_Q = WS_H + al((size_t)R * D * 2);
constexpr size_t WS_K = WS_Q + al((size_t)R * D * 2);
constexpr size_t WS_V = WS_K + al((size_t)R * 128 * 2);
constexpr size_t WS_O = WS_V + al((size_t)R * 128 * 2);
constexpr size_t WS_TK = WS_O + al((size_t)R * D * 2);
constexpr size_t WS_LIST = WS_TK + MiB;
constexpr size_t WS_HDN = WS_LIST + 3 * MiB;
constexpr size_t WS_RAW1 = WS_HDN + al((size_t)MAXROWS * 1024 * 2);
constexpr size_t WS_OUTB = WS_RAW1 + al((size_t)R * HIN * 4);
constexpr size_t WS_QH = WS_OUTB + al((size_t)MAXROWS * 1024 * 2);
constexpr size_t WS_KF = WS_QH + al((size_t)L * D * 2);
constexpr size_t WS_KB = WS_KF + al((size_t)R * D * 2);
constexpr size_t WS_IV = WS_KB + al((size_t)R * D * 2);
constexpr size_t WS_SG = WS_IV + al((size_t)R * D * 2);
constexpr size_t WS_OF = WS_SG + al((size_t)L * D * 2);
constexpr size_t WS_OB = WS_OF + al((size_t)L * D * 4);
constexpr size_t WS_RR = WS_OB + al((size_t)L * D * 4);
constexpr size_t WS_WQKV = WS_RR + al((size_t)L * D * 2);
constexpr size_t WS_WO = WS_WQKV + al((size_t)QKVD * D * 2);
constexpr size_t WS_WIN = WS_WO + al((size_t)D * D * 2);
constexpr size_t WS_WHO = WS_WIN + al((size_t)HIN * D * 2);
constexpr size_t WS_WGU = WS_WHO + al((size_t)D * D * 2);
constexpr size_t WS_WDN = WS_WGU + al((size_t)2 * NE * 2048 * D * 2);
constexpr size_t WS_END = WS_WDN + al((size_t)2 * NE * 1024 * D * 2);
static_assert(WS_END <= (size_t)2048 * MiB, "workspace map exceeds 4x the largest input");
constexpr int CW_CNT = 1024;
constexpr int CW_BAR = 4096;
constexpr int MOD_ROPE = 32768;
constexpr int MOD_LB = 49152;

struct Args { const float* in[21]; float* out; unsigned char* ws; int ph_lo, ph_hi; };

__device__ __forceinline__ unsigned f2bf(float f) { unsigned u = __float_as_uint(f); return (u + 0x7fffu + ((u >> 16) & 1u)) >> 16; }
__device__ __forceinline__ unsigned pk2(float lo, float hi) { return f2bf(lo) | (f2bf(hi) << 16); }
__device__ __forceinline__ float bflo(unsigned u) { return __uint_as_float(u << 16); }
__device__ __forceinline__ float bfhi(unsigned u) { return __uint_as_float(u & 0xffff0000u); }
__device__ __forceinline__ float bf2f(bf16_t b) { return __uint_as_float(((unsigned)b) << 16); }
__device__ __forceinline__ float wave_sum(float v) {
#pragma unroll
    for (int o = 32; o > 0; o >>= 1) v += __shfl_xor(v, o);
    return v;
}
__device__ __forceinline__ float silu_f(float x) { return x / (1.f + __expf(-x)); }
__device__ __forceinline__ float sigmoid_f(float x) { return 1.f / (1.f + __expf(-x)); }

typedef const __attribute__((address_space(4))) Args* CArgs;
struct Ctx {
    CArgs a;
    LAS unsigned char* lds;
    int tid, lane, wave, nwg, wg;
    unsigned char* ws;
    __device__ __forceinline__ float* modp(int layer, int which) const { return (float*)(ws + WS_MOD) + (layer * 2 + which) * 6144; }
    __device__ __forceinline__ const float* xin0(int r) const { return r < C ? a->in[2] + (size_t)r * D : a->in[0] + (size_t)(r - C) * D; }
};


namespace pg8 {
constexpr int BM = 256, BK = 64, HALF = 128, HTB = HALF * BK * 2, STAGE_BYTES = 8 * HTB, KD = 1024, NXCD = 8, WGM = 8;
__device__ __forceinline__ int lds_byte(int r, int c) { const int st = (r >> 4) * 2 + (c >> 5), rr = r & 15, cc = c & 31, ob = rr * 64 + cc * 2; return st * 1024 + (ob ^ (((ob >> 9) & 1) << 5)); }
__device__ __forceinline__ void stage_rc(int b, int& Rr, int& Cc) { const int st = b / 1024, sb = b % 1024, swz = sb ^ (((sb >> 9) & 1) << 5); Rr = (st >> 1) * 16 + swz / 64; Cc = (st & 1) * 32 + (swz % 64) / 2; }
__device__ __forceinline__ int perm32(int rho) { const int n = rho >> 4, i = rho & 15; return 8 * (i >> 2) + 4 * n + (i & 3); }

struct Unit { int pm, pn, e, goff, gcnt; };
struct Gemm { const bf16_t* A; const bf16_t* Bt; size_t bstride; const int* list; };

struct StaticOrder {
    int nM, nN, nwg, G, c;
    __device__ __forceinline__ void init(int M, int N, int G_, int c_) { nM = M / BM; nN = N / BM; nwg = nM * nN; G = G_; c = c_; }
    __device__ __forceinline__ bool next(int i, Unit& u) const {
        const long Lq = (long)i * G + c; if (Lq >= nwg) return false;
        int wgid = (int)Lq; { const int q = nwg / NXCD, r = nwg % NXCD, xcd = wgid % NXCD, off = wgid / NXCD; wgid = (xcd < r ? xcd * (q + 1) : r * (q + 1) + (xcd - r) * q) + off; }
        const int nig = WGM * nN, gid = wgid / nig, fm = gid * WGM, gsz = (nM - fm) < WGM ? (nM - fm) : WGM;
        u.pm = fm + ((wgid % nig) % gsz); u.pn = (wgid % nig) / gsz; u.e = 0; u.goff = 0; u.gcnt = 0; return true;
    }
};
struct MoeOrder {
    const LAS int* tp; const LAS int* cnt; int npn, G, vcu;
    __device__ __forceinline__ bool next(int i, Unit& u) const {
        const int lin = i * G + vcu; if (lin >= tp[32] * npn) return false;
        const int rt = lin / npn; int e = 0;
#pragma unroll 8
        for (int k = 1; k < 32; ++k) e += (rt >= tp[k]) ? 1 : 0;
        const int mt = rt - tp[e];
        u.pm = rt; u.pn = lin - rt * npn; u.e = e; u.goff = e * R + mt * 256; u.gcnt = cnt[e] - mt * 256; return true;
    }
};

__device__ __forceinline__ void a_offsets(const Gemm& g, const Unit& u, const int (&sR)[2], const int (&sC)[2], unsigned (&v)[2][2]) {
#pragma unroll
    for (int h = 0; h < 2; ++h)
#pragma unroll
        for (int i = 0; i < 2; ++i) {
            const int rr = h * HALF + sR[i]; int row;
            if (g.list) row = rr < u.gcnt ? g.list[u.goff + rr] : 0; else row = u.pm * BM + rr;
            v[h][i] = (unsigned)(row * KD + sC[i]) * 2u;
        }
}

struct EpiF32 {
    static constexpr bool PERM = false;
    float* Cp; int ldc; const float* bias;
    __device__ __forceinline__ void operator()(const f32x4 (&acc)[2][2][4][2], const Unit& u, int wr, int wc, int fr, int fq) const {
        const int row0 = u.pm * BM + wr * 64 + fr, col0 = u.pn * BM + wc * 32 + 4 * fq;
#pragma unroll
        for (int bj = 0; bj < 2; ++bj)
#pragma unroll
            for (int n = 0; n < 2; ++n) {
                const int col = col0 + bj * HALF + n * 16;
                const f32x4 bv = bias ? *(const f32x4*)(bias + col) : (f32x4){0.f, 0.f, 0.f, 0.f};
#pragma unroll
                for (int ai = 0; ai < 2; ++ai)
#pragma unroll
                    for (int m = 0; m < 4; ++m) *(f32x4*)(Cp + (size_t)(row0 + ai * HALF + m * 16) * ldc + col) = acc[ai][bj][m][n] + bv;
            }
    }
};
struct EpiSwiglu {
    static constexpr bool PERM = false;
    bf16_t* Hd; const float* bgu;
    __device__ __forceinline__ void operator()(const f32x4 (&acc)[2][2][4][2], const Unit& u, int wr, int wc, int fr, int fq) const {
        const int row0 = u.pm * BM + wr * 64 + fr, cg0 = u.pn * HALF + wc * 32 + 4 * fq;
        const float* bb = bgu + (size_t)u.e * 2048;
#pragma unroll
        for (int n = 0; n < 2; ++n) {
            const int cg = cg0 + n * 16;
            const f32x4 bg = *(const f32x4*)(bb + cg), bu = *(const f32x4*)(bb + 1024 + cg);
#pragma unroll
            for (int ai = 0; ai < 2; ++ai)
#pragma unroll
                for (int m = 0; m < 4; ++m) {
                    const f32x4 gv = acc[ai][0][m][n] + bg, uv = acc[ai][1][m][n] + bu; float hv[4];
#pragma unroll
                    for (int q = 0; q < 4; ++q) { const float gg = fminf(gv[q], 7.f), uu = fminf(fmaxf(uv[q], -7.f), 7.f); hv[q] = gg * (1.f / (1.f + __expf(-1.702f * gg))) * (uu + 1.f); }
                    u32x2 o; o.x = pk2(hv[0], hv[1]); o.y = pk2(hv[2], hv[3]);
                    *(u32x2*)(Hd + (size_t)(row0 + ai * HALF + m * 16) * 1024 + cg) = o;
                }
        }
    }
};
struct EpiBf16Bias {
    static constexpr bool PERM = false;
    bf16_t* Op; const float* bias; int bias_estride;
    __device__ __forceinline__ void operator()(const f32x4 (&acc)[2][2][4][2], const Unit& u, int wr, int wc, int fr, int fq) const {
        const int row0 = u.pm * BM + wr * 64 + fr, col0 = u.pn * BM + wc * 32 + 4 * fq;
        const float* bb = bias + (size_t)u.e * bias_estride;
#pragma unroll
        for (int bj = 0; bj < 2; ++bj)
#pragma unroll
            for (int n = 0; n < 2; ++n) {
                const int col = col0 + bj * HALF + n * 16;
                const f32x4 bv = *(const f32x4*)(bb + col);
#pragma unroll
                for (int ai = 0; ai < 2; ++ai)
#pragma unroll
                    for (int m = 0; m < 4; ++m) { const f32x4 v = acc[ai][bj][m][n] + bv; u32x2 o; o.x = pk2(v[0], v[1]); o.y = pk2(v[2], v[3]);
                        *(u32x2*)(Op + (size_t)(row0 + ai * HALF + m * 16) * 1024 + col) = o; }
            }
    }
};

template <class Epi, class Sched, bool ALIGN_EPI>
__device__ __forceinline__ void gemm_phase(LAS unsigned char* lds, const Gemm g, const Sched& S, const Epi& E) {
    const int tid = threadIdx.x, wid = __builtin_amdgcn_readfirstlane(tid >> 6), lane = tid & 63, wr = wid >> 2, wc = wid & 3, fr = lane & 15, fq = lane >> 4;
    constexpr int K = KD, nt = K / BK;
    int sR[2], sC[2]; unsigned voffB[2];
#pragma unroll
    for (int i = 0; i < 2; ++i) { stage_rc(tid * 16 + i * 8192, sR[i], sC[i]); const int Rb = Epi::PERM ? ((sR[i] & ~31) + perm32(sR[i] & 31)) : sR[i]; voffB[i] = (unsigned)(Rb * K + sC[i]) * 2u; }
    constexpr size_t kstep = (size_t)(BK * 2), hstep = (size_t)HALF * K * 2, tstep = 2 * hstep;
    const unsigned ldsw = (unsigned)wid * 1024u;
    const int aoff = lds_byte(wr * 64 + fr, fq * 8), boff = lds_byte(wc * 32 + fr, fq * 8);
    const char* Ab = (const char*)g.A;
#define PG8_SA(b, h) (((b) * 2 + (h)) * HTB)
#define PG8_SB(b, h) ((4 + (b) * 2 + (h)) * HTB)
#define PG8_STAGE_B(bufoff, gbase) do { _Pragma("unroll") for (int _i = 0; _i < 2; ++_i) \
        __builtin_amdgcn_global_load_lds((const unsigned*)((const char*)(gbase) + voffB[_i]), (LAS unsigned*)(lds + (bufoff) + ldsw + _i * 8192), 16, 0, 0); } while (0)
#define PG8_STAGE_A(bufoff, kb, v) do { _Pragma("unroll") for (int _i = 0; _i < 2; ++_i) \
        __builtin_amdgcn_global_load_lds((const unsigned*)(Ab + (size_t)(kb) + (v)[_i]), (LAS unsigned*)(lds + (bufoff) + ldsw + _i * 8192), 16, 0, 0); } while (0)
#define PG8_LDA(dst, b, h) do { _Pragma("unroll") for (int m = 0; m < 4; ++m) _Pragma("unroll") for (int k = 0; k < 2; ++k) dst[m][k] = *(const LAS bf16x8*)(lds + PG8_SA(b, h) + aoff + m * 2048 + k * 1024); } while (0)
#define PG8_LDB(dst, b, h) do { _Pragma("unroll") for (int n = 0; n < 2; ++n) _Pragma("unroll") for (int k = 0; k < 2; ++k) dst[n][k] = *(const LAS bf16x8*)(lds + PG8_SB(b, h) + boff + n * 2048 + k * 1024); } while (0)
#define PG8_MMA(ai, bj, At, Bt) do { __builtin_amdgcn_s_setprio(1); _Pragma("unroll") for (int m = 0; m < 4; ++m) _Pragma("unroll") for (int n = 0; n < 2; ++n) _Pragma("unroll") for (int k = 0; k < 2; ++k) \
        acc[ai][bj][m][n] = __builtin_amdgcn_mfma_f32_16x16x32_bf16(Bt[n][k], At[m][k], acc[ai][bj][m][n], 0, 0, 0); __builtin_amdgcn_s_setprio(0); } while (0)
#define PG8_WAIT_V(n) asm volatile("s_waitcnt vmcnt(" #n ")" ::: "memory")
#define PG8_WAIT_L(n) asm volatile("s_waitcnt lgkmcnt(" #n ")" ::: "memory")
#define PG8_BAR __builtin_amdgcn_s_barrier()
#define PG8_SCHED __builtin_amdgcn_sched_barrier(0)
    Unit cur, nxt; int ui = 0;
    if (!S.next(0, cur)) return;
    unsigned cv[2][2], nv[2][2];
    a_offsets(g, cur, sR, sC, cv);
    f32x4 acc[2][2][4][2];
#pragma unroll
    for (int a = 0; a < 2; ++a)
#pragma unroll
        for (int b = 0; b < 2; ++b)
#pragma unroll
            for (int m = 0; m < 4; ++m)
#pragma unroll
                for (int n = 0; n < 2; ++n) acc[a][b][m][n] = (f32x4){0.f, 0.f, 0.f, 0.f};
    bf16x8 At[4][2], B0[2][2], B1[2][2];
    const char* cB = (const char*)g.Bt + ((size_t)cur.e * g.bstride) * 2 + (size_t)cur.pn * tstep;
    PG8_STAGE_B(PG8_SB(0, 0), cB); PG8_STAGE_B(PG8_SB(0, 1), cB + hstep); PG8_STAGE_A(PG8_SA(0, 0), 0, cv[0]); PG8_STAGE_A(PG8_SA(0, 1), 0, cv[1]);
    if (wr == 1) PG8_BAR;
    PG8_WAIT_V(2); PG8_BAR;
    PG8_STAGE_B(PG8_SB(1, 0), cB + kstep); PG8_STAGE_A(PG8_SA(1, 0), kstep, cv[0]); PG8_STAGE_B(PG8_SB(1, 1), cB + hstep + kstep);
    PG8_WAIT_V(6); PG8_BAR;
    for (;;) {
        const bool has_next = S.next(ui + 1, nxt);
        const char* nB = cB;
        if (has_next) { a_offsets(g, nxt, sR, sC, nv); nB = (const char*)g.Bt + ((size_t)nxt.e * g.bstride) * 2 + (size_t)nxt.pn * tstep; }
        else {
#pragma unroll
            for (int h = 0; h < 2; ++h)
#pragma unroll
                for (int i = 0; i < 2; ++i) nv[h][i] = cv[h][i];
        }
        for (int t = 0; t < nt; t += 2) {
            const bool last = (t == nt - 2);
            const size_t k1 = (size_t)(t + 1) * kstep, k2 = last ? 0 : (size_t)(t + 2) * kstep, k3 = k2 + kstep;
            const char* b2 = last ? nB : cB + (size_t)(t + 2) * kstep; const char* b3 = b2 + kstep;
            unsigned w0[2], w1[2];
#pragma unroll
            for (int i = 0; i < 2; ++i) { w0[i] = last ? nv[0][i] : cv[0][i]; w1[i] = last ? nv[1][i] : cv[1][i]; }
            PG8_LDB(B0, 0, 0); PG8_LDB(B1, 0, 1); PG8_SCHED; PG8_LDA(At, 0, 0); PG8_STAGE_A(PG8_SA(1, 1), k1, cv[1]);
            PG8_WAIT_V(8); PG8_WAIT_L(0); PG8_BAR; PG8_MMA(0, 0, At, B0); PG8_MMA(0, 1, At, B1); PG8_BAR; PG8_SCHED;
            PG8_LDA(At, 0, 1); PG8_STAGE_B(PG8_SB(0, 0), b2); PG8_STAGE_B(PG8_SB(0, 1), b2 + hstep); PG8_STAGE_A(PG8_SA(0, 0), k2, w0);
            PG8_WAIT_V(8); PG8_WAIT_L(0); PG8_BAR; PG8_MMA(1, 0, At, B0); PG8_MMA(1, 1, At, B1); PG8_BAR; PG8_SCHED;
            PG8_LDB(B0, 1, 0); PG8_LDB(B1, 1, 1); PG8_SCHED; PG8_LDA(At, 1, 0); PG8_STAGE_A(PG8_SA(0, 1), k2, w1);
            PG8_WAIT_V(8); PG8_WAIT_L(0); PG8_BAR; PG8_MMA(0, 0, At, B0); PG8_MMA(0, 1, At, B1); PG8_BAR; PG8_SCHED;
            PG8_LDA(At, 1, 1); PG8_STAGE_B(PG8_SB(1, 0), b3); PG8_STAGE_B(PG8_SB(1, 1), b3 + hstep); PG8_STAGE_A(PG8_SA(1, 0), k3, w0);
            PG8_WAIT_V(8); PG8_WAIT_L(0); PG8_BAR; PG8_MMA(1, 0, At, B0); PG8_MMA(1, 1, At, B1); PG8_BAR; PG8_SCHED;
        }
        if constexpr (ALIGN_EPI) { if (wr == 0) PG8_BAR; }
        E(acc, cur, wr, wc, fr, fq);
        if (!has_next) break;
#pragma unroll
        for (int a = 0; a < 2; ++a)
#pragma unroll
            for (int b = 0; b < 2; ++b)
#pragma unroll
                for (int m = 0; m < 4; ++m)
#pragma unroll
                    for (int n = 0; n < 2; ++n) acc[a][b][m][n] = (f32x4){0.f, 0.f, 0.f, 0.f};
        cur = nxt; cB = nB; ++ui;
#pragma unroll
        for (int h = 0; h < 2; ++h)
#pragma unroll
            for (int i = 0; i < 2; ++i) cv[h][i] = nv[h][i];
        if constexpr (ALIGN_EPI) { if (wr == 1) PG8_BAR; }
    }
    PG8_WAIT_V(0);
    if constexpr (!ALIGN_EPI) { if (wr == 0) PG8_BAR; }
    PG8_BAR;
#undef PG8_SA
#undef PG8_SB
#undef PG8_STAGE_A
#undef PG8_STAGE_B
#undef PG8_LDA
#undef PG8_LDB
#undef PG8_MMA
#undef PG8_WAIT_V
#undef PG8_WAIT_L
#undef PG8_BAR
#undef PG8_SCHED
}
}

__device__ __forceinline__ void transpose_block(const float* W, int ldw, int n0, int k0, bf16_t* WTrow0  , LAS float* scr, int lane) {
    f32x4 v[16];
    const float* src = W + (size_t)(k0 + (lane >> 4)) * ldw + n0 + (lane & 15) * 4;
#pragma unroll
    for (int i = 0; i < 16; ++i) v[i] = *(const f32x4*)(src + (size_t)(4 * i) * ldw);
#pragma unroll
    for (int i = 0; i < 16; ++i) { LAS float* d = scr + ((lane >> 4) + 4 * i) * 65 + (lane & 15) * 4; d[0] = v[i].x; d[1] = v[i].y; d[2] = v[i].z; d[3] = v[i].w; }
    asm volatile("s_waitcnt lgkmcnt(0)" ::: "memory"); __builtin_amdgcn_wave_barrier();
    const int c8 = lane & 7;
#pragma unroll
    for (int jj = 0; jj < 8; ++jj) {
        const int n = (lane >> 3) + 8 * jj; const LAS float* p = scr + (8 * c8) * 65 + n;
        u32x4 o; o.x = pk2(p[0], p[65]); o.y = pk2(p[2 * 65], p[3 * 65]); o.z = pk2(p[4 * 65], p[5 * 65]); o.w = pk2(p[6 * 65], p[7 * 65]);
        *(u32x4*)(WTrow0 + (size_t)n * 1024 + k0 + 8 * c8) = o;
    }
    asm volatile("s_waitcnt lgkmcnt(0)" ::: "memory"); __builtin_amdgcn_wave_barrier();
}

__device__ __forceinline__ void phase_prep(const Ctx& c) {
    LAS float* red = (LAS float*)c.lds;
    const float* cv = c.a->in[1]; const float* ccv = c.a->in[3]; const float* ada_w = c.a->in[4]; const float* ada_b = c.a->in[5];
    for (int item = c.wg; item < 193; item += c.nwg) {
        if (item < 192) {
            const int layer = item / 96, cb = item % 96, col = cb * 64 + c.lane;
            const float* W = ada_w + (size_t)layer * D * 6144 + col;
            float a0 = 0.f, a1 = 0.f;
            const int k0 = c.wave * 128;
#pragma unroll 8
            for (int k = 0; k < 128; ++k) { const float w = W[(size_t)(k0 + k) * 6144]; a0 += silu_f(cv[k0 + k]) * w; a1 += silu_f(ccv[k0 + k]) * w; }
            red[(0 * 8 + c.wave) * 64 + c.lane] = a0; red[(1 * 8 + c.wave) * 64 + c.lane] = a1;
            __syncthreads();
            if (c.tid < 128) {
                const int which = c.tid >> 6, l = c.tid & 63; float s = 0.f;
#pragma unroll
                for (int w = 0; w < 8; ++w) s += red[(which * 8 + w) * 64 + l];
                c.modp(layer, which)[cb * 64 + l] = s + ada_b[layer * 6144 + cb * 64 + l];
            }
            __syncthreads();
        } else {
            float* modbase = (float*)(c.ws + WS_MOD);
            for (int i = c.tid; i < 4096; i += 512) {
                const int pos = i >> 4, j = i & 15;
                const double ang = (double)pos * pow(10000.0, -(double)j / 16.0);
                modbase[MOD_ROPE + 2 * i] = (float)cos(ang); modbase[MOD_ROPE + 2 * i + 1] = (float)sin(ang);
            }
            const float* lbp = c.a->in[12];
            for (int i = c.tid; i < 2048; i += 512) { const float p0 = lbp[i], p1 = lbp[2048 + i]; modbase[MOD_LB + i] = 1.f / (1.f + __expf(p0 - p1)); }
        }
    }
}

__device__ __forceinline__ void row_load(const float* p, int lane, f32x4 (&v)[4]) {
#pragma unroll
    for (int j = 0; j < 4; ++j) v[j] = *(const f32x4*)(p + lane * 4 + 256 * j);
}
__device__ __forceinline__ float row_ss(const f32x4 (&v)[4]) {
    float s = 0.f;
#pragma unroll
    for (int j = 0; j < 4; ++j) s += v[j].x * v[j].x + v[j].y * v[j].y + v[j].z * v[j].z + v[j].w * v[j].w;
    return wave_sum(s);
}
__device__ __forceinline__ void row_modnorm_store(const f32x4 (&x)[4], float rstd, const float* g, const float* sh, const float* sc, bf16_t* out, int lane, f32x4 (*hout)[4] = nullptr) {
#pragma unroll
    for (int j = 0; j < 4; ++j) {
        const int c0 = lane * 4 + 256 * j;
        const f32x4 gv = *(const f32x4*)(g + c0), shv = *(const f32x4*)(sh + c0), scv = *(const f32x4*)(sc + c0);
        f32x4 h;
        h.x = x[j].x * rstd * gv.x * (1.f + scv.x) + shv.x; h.y = x[j].y * rstd * gv.y * (1.f + scv.y) + shv.y;
        h.z = x[j].z * rstd * gv.z * (1.f + scv.z) + shv.z; h.w = x[j].w * rstd * gv.w * (1.f + scv.w) + shv.w;
        if (hout) (*hout)[j] = h;
        u32x2 o; o.x = pk2(h.x, h.y); o.y = pk2(h.z, h.w);
        *(u32x2*)(out + c0) = o;
    }
}

__device__ __forceinline__ void phase_norm0(const Ctx& c) {
    bf16_t* H = (bf16_t*)(c.ws + WS_H); const float* ng = c.a->in[6];
    for (int r = c.wg * 8 + c.wave; r < R; r += c.nwg * 8) {
        f32x4 x[4]; row_load(c.xin0(r), c.lane, x);
        const float rstd = rsqrtf(row_ss(x) * (1.f / D) + EPS);
        const float* m = c.modp(0, r < C ? 1 : 0);
        row_modnorm_store(x, rstd, ng, m + 0, m + 1024, H + (size_t)r * D, c.lane);
    }
}

__device__ __forceinline__ void phase_rope(const Ctx& c) {
    const float* raw = (const float*)(c.ws + WS_RAW1); const float* tab = (const float*)(c.ws + WS_MOD) + MOD_ROPE;
    bf16_t* Q = (bf16_t*)(c.ws + WS_Q); bf16_t* K = (bf16_t*)(c.ws + WS_K); bf16_t* V = (bf16_t*)(c.ws + WS_V);
    const float qs = 0.125f * LOG2E;
    for (int r = c.wg * 8 + c.wave; r < R; r += c.nwg * 8) {
        const float* row = raw + (size_t)r * QKVD;
        const bool lat = r >= C; const int t = r - C;
        for (int col = c.lane; col < QKVD; col += 64) {
            float val = row[col];
            if (col < 1152 && lat) {
                const int within = col & 63, half = within >> 5, part = (within >> 4) & 1, j = within & 15;
                const int pos = half == 0 ? (t >> 6) : (t & 63);
                const float cs = tab[2 * (pos * 16 + j)], sn = tab[2 * (pos * 16 + j) + 1];
                const float x1 = part == 0 ? val : row[col - 16], x2 = part == 0 ? row[col + 16] : val;
                val = part == 0 ? (x1 * cs - x2 * sn) : (x2 * cs + x1 * sn);
            }
            if (col < 1024) Q[(size_t)r * D + col] = (bf16_t)f2bf(val * qs);
            else if (col < 1152) K[(size_t)r * 128 + (col - 1024)] = (bf16_t)f2bf(val);
            else V[(size_t)r * 128 + (col - 1152)] = (bf16_t)f2bf(val);
        }
    }
}

__device__ __forceinline__ void phase_attn_simple(const Ctx& c) {
    const bf16_t* Q = (const bf16_t*)(c.ws + WS_Q); const bf16_t* K = (const bf16_t*)(c.ws + WS_K); const bf16_t* V = (const bf16_t*)(c.ws + WS_V);
    bf16_t* O = (bf16_t*)(c.ws + WS_O); const float* sink = c.a->in[9];
    LAS unsigned* sK = (LAS unsigned*)c.lds;
    LAS unsigned* sV = (LAS unsigned*)(c.lds + 16384);
    for (int item = c.wg; item < 260; item += c.nwg) {
        const bool isctx = item >= 256;
        const int n = isctx ? 0 : (item >> 1), kh = item & 1, cb = isctx ? ((item - 256) >> 1) : 0;
        const int qrow0 = isctx ? cb * 128 : C + n * 128;
        const int nchunk = isctx ? 2 : 5;
        for (int pp = 0; pp < 2; ++pp) {
            const int pi = c.tid + 512 * pp, qi = pi & 127, g = pi >> 7, hq = kh * 8 + g;
            const int tq = n * 128 + qi;
            unsigned q[32];
            {
                const u32x4* qp = (const u32x4*)(Q + (size_t)(qrow0 + qi) * D + hq * 64);
#pragma unroll
                for (int i = 0; i < 8; ++i) { const u32x4 u = qp[i]; q[4 * i] = u.x; q[4 * i + 1] = u.y; q[4 * i + 2] = u.z; q[4 * i + 3] = u.w; }
            }
            const float sink2 = sink[hq] * LOG2E;
            float m = sink2, l = 0.f;
            float acc[64];
#pragma unroll
            for (int i = 0; i < 64; ++i) acc[i] = 0.f;
            for (int pass = 0; pass < 2; ++pass) {
                if (pass == 1) l = exp2f(sink2 - m);
                for (int ch = 0; ch < nchunk; ++ch) {
                    int krow0, tk0 = 0; bool win = false;
                    if (ch < 2) krow0 = ch * 128;
                    else { const int b = n + ch - 3; if (b < 0 || b >= 128) continue; krow0 = C + b * 128; tk0 = b * 128; win = true; }
                    __syncthreads();
                    {
                        const int rr = c.tid >> 2, cc = (c.tid & 3) * 8;
                        const u32x4* kp = (const u32x4*)(K + (size_t)(krow0 + rr) * 128 + kh * 64) + (c.tid & 3) * 2;
                        *(LAS u32x4*)(sK + rr * 32 + cc) = kp[0]; *(LAS u32x4*)(sK + rr * 32 + cc + 4) = kp[1];
                        if (pass == 1) { const u32x4* vp = (const u32x4*)(V + (size_t)(krow0 + rr) * 128 + kh * 64) + (c.tid & 3) * 2;
                            *(LAS u32x4*)(sV + rr * 32 + cc) = vp[0]; *(LAS u32x4*)(sV + rr * 32 + cc + 4) = vp[1]; }
                    }
                    __syncthreads();
                    for (int key = 0; key < 128; ++key) {
                        const LAS u32x4* kp = (const LAS u32x4*)(sK + key * 32);
                        float s = 0.f;
#pragma unroll
                        for (int i = 0; i < 8; ++i) { const u32x4 u = kp[i];
                            s += bflo(q[4 * i]) * bflo(u.x) + bfhi(q[4 * i]) * bfhi(u.x) + bflo(q[4 * i + 1]) * bflo(u.y) + bfhi(q[4 * i + 1]) * bfhi(u.y)
                               + bflo(q[4 * i + 2]) * bflo(u.z) + bfhi(q[4 * i + 2]) * bfhi(u.z) + bflo(q[4 * i + 3]) * bflo(u.w) + bfhi(q[4 * i + 3]) * bfhi(u.w); }
                        bool valid = true;
                        if (win) { const int dt = tq - (tk0 + key); valid = (dt <= 128) && (dt >= -128); }
                        if (pass == 0) { if (valid) m = fmaxf(m, s); }
                        else {
                            const float p = valid ? exp2f(s - m) : 0.f;
                            l += p;
                            const LAS u32x4* vp = (const LAS u32x4*)(sV + key * 32);
#pragma unroll
                            for (int i = 0; i < 8; ++i) { const u32x4 u = vp[i];
                                acc[8 * i] += p * bflo(u.x); acc[8 * i + 1] += p * bfhi(u.x); acc[8 * i + 2] += p * bflo(u.y); acc[8 * i + 3] += p * bfhi(u.y);
                                acc[8 * i + 4] += p * bflo(u.z); acc[8 * i + 5] += p * bfhi(u.z); acc[8 * i + 6] += p * bflo(u.w); acc[8 * i + 7] += p * bfhi(u.w); }
                        }
                    }
                }
            }
            const float il = 1.f / l;
            u32x4* op = (u32x4*)(O + (size_t)(qrow0 + qi) * D + hq * 64);
#pragma unroll
            for (int i = 0; i < 8; ++i) { u32x4 u; u.x = pk2(acc[8 * i] * il, acc[8 * i + 1] * il); u.y = pk2(acc[8 * i + 2] * il, acc[8 * i + 3] * il);
                u.z = pk2(acc[8 * i + 4] * il, acc[8 * i + 5] * il); u.w = pk2(acc[8 * i + 6] * il, acc[8 * i + 7] * il); op[i] = u; }
        }
        __syncthreads();
    }
}

__device__ __forceinline__ void phase_postmix(const Ctx& c, int layer, int r_lo, int yoff) {
    const float* Y = (const float*)(c.ws + WS_RAW1); float* X = (float*)(c.ws + WS_X); bf16_t* H = (bf16_t*)(c.ws + WS_H);
    const float* ng = c.a->in[6] + layer * 4 * D; const float* Wr = c.a->in[15] + (size_t)layer * D * NE; const float* br = c.a->in[16] + layer * NE;
    unsigned* cnt = (unsigned*)(c.ws + WS_CTL) + CW_CNT + layer * NE;
    int* tk_e = (int*)(c.ws + WS_TK); float* tk_g = (float*)(c.ws + WS_TK) + R * 4; int* tk_slot = (int*)(c.ws + WS_TK) + 2 * R * 4;
    int* list = (int*)(c.ws + WS_LIST);
    LAS float* pr = (LAS float*)c.lds + c.wave * (64 * 33);
    LAS float* hrow = (LAS float*)c.lds + 8 * 64 * 33 + c.wave * 1024;
    for (int r = r_lo + c.wg * 8 + c.wave; r < R; r += c.nwg * 8) {
        const float* m = c.modp(layer, r < C ? 1 : 0);
        const float* xsrc = layer == 0 ? c.xin0(r) : X + (size_t)r * D;
        f32x4 y[4], x[4]; row_load(Y + (size_t)(r - yoff) * D, c.lane, y); row_load(xsrc, c.lane, x);
        const float rstd_y = rsqrtf(row_ss(y) * (1.f / D) + EPS);
#pragma unroll
        for (int j = 0; j < 4; ++j) {
            const int c0 = c.lane * 4 + 256 * j;
            const f32x4 g1 = *(const f32x4*)(m + 2048 + c0), n1 = *(const f32x4*)(ng + D + c0);
            x[j].x += g1.x * (y[j].x * rstd_y * n1.x); x[j].y += g1.y * (y[j].y * rstd_y * n1.y);
            x[j].z += g1.z * (y[j].z * rstd_y * n1.z); x[j].w += g1.w * (y[j].w * rstd_y * n1.w);
            *(f32x4*)(X + (size_t)r * D + c0) = x[j];
        }
        const float rstd_x = rsqrtf(row_ss(x) * (1.f / D) + EPS);
        f32x4 h[4];
        row_modnorm_store(x, rstd_x, ng + 2 * D, m + 3072, m + 4096, H + (size_t)r * D, c.lane, &h);
#pragma unroll
        for (int j = 0; j < 4; ++j) *(LAS f32x4*)(hrow + c.lane * 4 + 256 * j) = h[j];
        float p[32];
#pragma unroll
        for (int e = 0; e < 32; ++e) p[e] = 0.f;
#pragma unroll 2
        for (int k = 0; k < 16; ++k) {
            const int col = c.lane * 4 + 256 * (k >> 2) + (k & 3);
            const float hv = hrow[col]; const f32x4* wrow = (const f32x4*)(Wr + (size_t)col * NE);
#pragma unroll
            for (int e4 = 0; e4 < 8; ++e4) { const f32x4 wv = wrow[e4]; p[4 * e4] += hv * wv.x; p[4 * e4 + 1] += hv * wv.y; p[4 * e4 + 2] += hv * wv.z; p[4 * e4 + 3] += hv * wv.w; }
        }
#pragma unroll
        for (int e = 0; e < 32; ++e) pr[c.lane * 33 + e] = p[e];
        asm volatile("s_waitcnt lgkmcnt(0)" ::: "memory");
        __builtin_amdgcn_wave_barrier();
        float logit = -INFINITY;
        if (c.lane < 32) { float s = br[c.lane]; for (int l2 = 0; l2 < 64; ++l2) s += pr[l2 * 33 + c.lane]; logit = s; }
        asm volatile("s_waitcnt lgkmcnt(0)" ::: "memory");
        __builtin_amdgcn_wave_barrier();
        float tv[4]; int te[4];
#pragma unroll
        for (int k = 0; k < 4; ++k) {
            float bv = logit; int bi = c.lane;
#pragma unroll
            for (int o = 32; o > 0; o >>= 1) {
                const float ov = __shfl_xor(bv, o); const int oi = __shfl_xor(bi, o);
                if (ov > bv || (ov == bv && oi < bi)) { bv = ov; bi = oi; }
            }
            tv[k] = bv; te[k] = bi;
            if (c.lane == bi) logit = -INFINITY;
        }
        if (c.lane == 0) {
            const float e1 = __expf(tv[1] - tv[0]), e2 = __expf(tv[2] - tv[0]), e3 = __expf(tv[3] - tv[0]);
            const float inv = 1.f / (1.f + e1 + e2 + e3);
            const float gk[4] = {inv, e1 * inv, e2 * inv, e3 * inv};
#pragma unroll
            for (int k = 0; k < 4; ++k) {
                const unsigned slot = atomicAdd(&cnt[te[k]], 1u);
                list[(size_t)te[k] * R + slot] = r;
                tk_e[r * 4 + k] = te[k]; tk_g[r * 4 + k] = gk[k]; tk_slot[r * 4 + k] = (int)slot;
            }
        }
    }
}

__device__ __forceinline__ void moe_offsets(const Ctx& c, int layer, LAS int* so) {
    const unsigned* cnt = (const unsigned*)(c.ws + WS_CTL) + CW_CNT + layer * NE;
    __syncthreads();
    if (c.tid == 0) { int acc = 0; for (int e = 0; e < NE; ++e) { const int n = (int)cnt[e]; so[e] = acc; so[64 + e] = n; acc += (n + PADM - 1) / PADM * PADM; } so[32] = acc; }
    __syncthreads();
}

__device__ __forceinline__ void moe_tables(const Ctx& c, int layer, LAS int* tb) {
    const unsigned* cnt = (const unsigned*)(c.ws + WS_CTL) + CW_CNT + layer * NE;
    __syncthreads();
    if (c.tid == 0) { int acc = 0; for (int e = 0; e < NE; ++e) { const int n = (int)cnt[e]; tb[e] = acc; tb[64 + e] = n; acc += (n + PADM - 1) / PADM; } tb[32] = acc; }
    __syncthreads();
}
__device__ __forceinline__ int vcu_of(const Ctx& c) { return (c.nwg % 8 == 0) ? (c.wg % 8) * (c.nwg / 8) + c.wg / 8 : c.wg; }
__device__ __forceinline__ void phase_moe_gu(const Ctx& c, int layer) {
    LAS int* tb = (LAS int*)(c.lds + 131072 + 1024);
    moe_tables(c, layer, tb);
    pg8::Gemm g{(const bf16_t*)(c.ws + WS_H), (const bf16_t*)(c.ws + WS_WGU) + (size_t)layer * NE * 2048 * 1024, (size_t)2048 * 1024, (const int*)(c.ws + WS_LIST)};
    pg8::MoeOrder S{tb, tb + 64, 8, c.nwg, vcu_of(c)};
    pg8::EpiSwiglu E{(bf16_t*)(c.ws + WS_HDN), c.a->in[18] + (size_t)layer * NE * 2048};
    pg8::gemm_phase<pg8::EpiSwiglu, pg8::MoeOrder, true>(c.lds, g, S, E);
}
__device__ __forceinline__ void phase_moe_dn(const Ctx& c, int layer) {
    LAS int* tb = (LAS int*)(c.lds + 131072 + 1024);
    moe_tables(c, layer, tb);
    pg8::Gemm g{(const bf16_t*)(c.ws + WS_HDN), (const bf16_t*)(c.ws + WS_WDN) + (size_t)layer * NE * 1024 * 1024, (size_t)1024 * 1024, nullptr};
    pg8::MoeOrder S{tb, tb + 64, 4, c.nwg, vcu_of(c)};
    pg8::EpiBf16Bias E{(bf16_t*)(c.ws + WS_OUTB), c.a->in[20] + (size_t)layer * NE * 1024, 1024};
    pg8::gemm_phase<pg8::EpiBf16Bias, pg8::MoeOrder, true>(c.lds, g, S, E);
}
__device__ __forceinline__ void phase_gemm_f32(const Ctx& c, const bf16_t* A, int M, const bf16_t* Bt, int N, const float* bias, float* Cout) {
    pg8::Gemm g{A, Bt, 0, nullptr}; pg8::StaticOrder S; S.init(M, N, c.nwg, c.wg);
    pg8::EpiF32 E{Cout, N, bias};
    pg8::gemm_phase<pg8::EpiF32, pg8::StaticOrder, true>(c.lds, g, S, E);
}

__device__ __forceinline__ void phase_norm0(const Ctx& c);
__device__ __forceinline__ void phase_convert(const Ctx& c) {
    LAS float* scr = (LAS float*)c.lds + c.wave * (64 * 65);
    const int gw = c.wg * 8 + c.wave, NGW = c.nwg * 8;
    constexpr int I_QKV = 20 * 16, I_O = 16 * 16, I_IN = 80 * 16, I_HO = 16 * 16, I_GU = 64 * 32 * 16, I_DN = 64 * 16 * 16, TOT = I_QKV + I_O + I_IN + I_HO + I_GU + I_DN;
    for (int it = gw; it < TOT; it += NGW) {
        int r = it;
        if (r < I_QKV) { const int nb = r % 20, kb = r / 20; transpose_block(c.a->in[7], QKVD, nb * 64, kb * 64, (bf16_t*)(c.ws + WS_WQKV) + (size_t)nb * 64 * 1024, scr, c.lane); continue; } r -= I_QKV;
        if (r < I_O) { const int nb = r % 16, kb = r / 16; transpose_block(c.a->in[10], D, nb * 64, kb * 64, (bf16_t*)(c.ws + WS_WO) + (size_t)nb * 64 * 1024, scr, c.lane); continue; } r -= I_O;
        if (r < I_IN) { const int nb = r % 80, kb = r / 80; transpose_block(c.a->in[11], HIN, nb * 64, kb * 64, (bf16_t*)(c.ws + WS_WIN) + (size_t)nb * 64 * 1024, scr, c.lane); continue; } r -= I_IN;
        if (r < I_HO) { const int nb = r % 16, kb = r / 16; transpose_block(c.a->in[14], D, nb * 64, kb * 64, (bf16_t*)(c.ws + WS_WHO) + (size_t)nb * 64 * 1024, scr, c.lane); continue; } r -= I_HO;
        if (r < I_GU) { const int mat = r / 512, rr = r % 512, nb = rr % 32, kb = rr / 32; const int n0 = ((nb & 3) >> 1) * 1024 + (nb >> 2) * 128 + (nb & 1) * 64;
            transpose_block(c.a->in[17] + (size_t)mat * 1024 * 2048, 2048, n0, kb * 64, (bf16_t*)(c.ws + WS_WGU) + ((size_t)mat * 2048 + nb * 64) * 1024, scr, c.lane); continue; } r -= I_GU;
        { const int mat = r / 256, rr = r % 256, nb = rr % 16, kb = rr / 16;
            transpose_block(c.a->in[19] + (size_t)mat * 1024 * 1024, 1024, nb * 64, kb * 64, (bf16_t*)(c.ws + WS_WDN) + ((size_t)mat * 1024 + nb * 64) * 1024, scr, c.lane); }
    }
    __syncthreads();
    phase_norm0(c);
}

__device__ __forceinline__ void phase_combine(const Ctx& c, int layer) {
    LAS int* so = (LAS int*)(c.lds + 32768);
    moe_offsets(c, layer, so);
    const bf16_t* outb = (const bf16_t*)(c.ws + WS_OUTB); float* X = (float*)(c.ws + WS_X); bf16_t* H = (bf16_t*)(c.ws + WS_H);
    const float* ngl = c.a->in[6] + layer * 4 * D;
    const int* tk_e = (const int*)(c.ws + WS_TK); const float* tk_g = (const float*)(c.ws + WS_TK) + R * 4; const int* tk_slot = (const int*)(c.ws + WS_TK) + 2 * R * 4;
    const int r_lo = layer == 0 ? 0 : C;
    for (int r = r_lo + c.wg * 8 + c.wave; r < R; r += c.nwg * 8) {
        const float* m = c.modp(layer, r < C ? 1 : 0);
        f32x4 y[4];
#pragma unroll
        for (int j = 0; j < 4; ++j) y[j] = (f32x4){0.f, 0.f, 0.f, 0.f};
#pragma unroll
        for (int k = 0; k < 4; ++k) {
            const int e = tk_e[r * 4 + k], slot = tk_slot[r * 4 + k]; const float g = tk_g[r * 4 + k];
            const bf16_t* src = outb + (size_t)(so[e] + slot) * 1024;
#pragma unroll
            for (int j = 0; j < 4; ++j) { const u32x2 w = *(const u32x2*)(src + c.lane * 4 + 256 * j); y[j] += (f32x4){bflo(w.x), bfhi(w.x), bflo(w.y), bfhi(w.y)} * g; }
        }
        const float rstd_y = rsqrtf(row_ss(y) * (1.f / D) + EPS);
        f32x4 x[4]; row_load(X + (size_t)r * D, c.lane, x);
#pragma unroll
        for (int j = 0; j < 4; ++j) {
            const int c0 = c.lane * 4 + 256 * j;
            const f32x4 g2 = *(const f32x4*)(m + 5120 + c0), n3 = *(const f32x4*)(ngl + 3 * D + c0);
            x[j].x += g2.x * (y[j].x * rstd_y * n3.x); x[j].y += g2.y * (y[j].y * rstd_y * n3.y);
            x[j].z += g2.z * (y[j].z * rstd_y * n3.z); x[j].w += g2.w * (y[j].w * rstd_y * n3.w);
            if (layer == 0) *(f32x4*)(X + (size_t)r * D + c0) = x[j];
            else *(f32x4*)(c.a->out + (size_t)(r - C) * D + c0) = x[j];
        }
        if (layer == 0) {
            const float rstd_x = rsqrtf(row_ss(x) * (1.f / D) + EPS);
            const float* m1 = c.modp(1, r < C ? 1 : 0);
            row_modnorm_store(x, rstd_x, c.a->in[6] + 4 * D, m1 + 0, m1 + 1024, H + (size_t)r * D, c.lane);
        }
    }
}

__device__ __forceinline__ void phase_hgrn_elem(const Ctx& c) {
    const float* raw = (const float*)(c.ws + WS_RAW1); const float* lb = (const float*)(c.ws + WS_MOD) + MOD_LB;
    bf16_t* QH = (bf16_t*)(c.ws + WS_QH); _Float16* KF = (_Float16*)(c.ws + WS_KF); _Float16* KB = (_Float16*)(c.ws + WS_KB);
    bf16_t* IV = (bf16_t*)(c.ws + WS_IV); bf16_t* SGp = (bf16_t*)(c.ws + WS_SG);
    for (int r = c.wg * 8 + c.wave; r < R; r += c.nwg * 8) {
        const float* row = raw + (size_t)r * HIN; const bool lat = r >= C; const int t = r - C;
        for (int col = c.lane; col < D; col += 64) {
            const float zf = row[1024 + col], zb = row[2048 + col];
            KF[(size_t)r * D + col] = (_Float16)((1.f - lb[col]) * sigmoid_f(-zf));
            KB[(size_t)r * D + col] = (_Float16)((1.f - lb[1024 + col]) * sigmoid_f(-zb));
            IV[(size_t)r * D + col] = (bf16_t)f2bf(row[3072 + col]);
            if (lat) { QH[(size_t)t * D + col] = (bf16_t)f2bf(silu_f(row[col])); SGp[(size_t)t * D + col] = (bf16_t)f2bf(silu_f(row[4096 + col])); }
        }
    }
}

__device__ __forceinline__ void phase_hgrn_rec(const Ctx& c) {
    const bf16_t* QH = (const bf16_t*)(c.ws + WS_QH); const bf16_t* IV = (const bf16_t*)(c.ws + WS_IV);
    LAS float* sf = (LAS float*)c.lds; LAS float* sk = sf + 32 * 128; LAS float* sq = sk + 32 * 128; LAS float* si = sq + 32 * 128;
    for (int item = c.wg; item < 16; item += c.nwg) {
        const int head = item >> 1, dir = item & 1;
        const _Float16* KX = (const _Float16*)(c.ws + (dir == 0 ? WS_KF : WS_KB));
        float* OUT = (float*)(c.ws + (dir == 0 ? WS_OF : WS_OB));
        const int v = c.tid >> 2, dq = c.tid & 3;
        float s[32];
#pragma unroll
        for (int j = 0; j < 32; ++j) s[j] = 0.f;
        for (int b = 0; b < R / 32; ++b) {
            __syncthreads();
            {
                const int tt = c.tid >> 4, c8 = (c.tid & 15) * 8;
                const int idx = b * 32 + tt;
                int r; bool lat;
                if (idx < C) { r = dir == 0 ? idx : C - 1 - idx; lat = false; } else { const int t = dir == 0 ? idx - C : L - 1 - (idx - C); r = C + t; lat = true; }
                const u32x4 ku = *(const u32x4*)(KX + (size_t)r * D + head * 128 + c8);
                const u32x4 iu = *(const u32x4*)(IV + (size_t)r * D + head * 128 + c8);
                u32x4 qu = (u32x4){0u, 0u, 0u, 0u};
                if (lat) qu = *(const u32x4*)(QH + (size_t)(r - C) * D + head * 128 + c8);
                const _Float16* kh = (const _Float16*)&ku;
                const unsigned iw[4] = {iu.x, iu.y, iu.z, iu.w}, qw[4] = {qu.x, qu.y, qu.z, qu.w};
#pragma unroll
                for (int i = 0; i < 8; ++i) {
                    const float kv = (float)kh[i];
                    sk[tt * 128 + c8 + i] = kv; sf[tt * 128 + c8 + i] = 1.f - kv;
                    si[tt * 128 + c8 + i] = (i & 1) ? bfhi(iw[i >> 1]) : bflo(iw[i >> 1]);
                    sq[tt * 128 + c8 + i] = (i & 1) ? bfhi(qw[i >> 1]) : bflo(qw[i >> 1]);
                }
            }
            __syncthreads();
            const bool latb = (b * 32) >= C;
            for (int tt = 0; tt < 32; ++tt) {
                const float iv = si[tt * 128 + v];
                float o = 0.f;
#pragma unroll
                for (int j4 = 0; j4 < 8; ++j4) {
                    const f32x4 f4 = *(const LAS f32x4*)(sf + tt * 128 + dq * 32 + j4 * 4), k4 = *(const LAS f32x4*)(sk + tt * 128 + dq * 32 + j4 * 4), q4 = *(const LAS f32x4*)(sq + tt * 128 + dq * 32 + j4 * 4);
#pragma unroll
                    for (int i = 0; i < 4; ++i) { float& sr = s[j4 * 4 + i]; sr = f4[i] * sr + k4[i] * iv; o += q4[i] * sr; }
                }
                if (latb) {
                    o += __shfl_xor(o, 1); o += __shfl_xor(o, 2);
                    const int idx = b * 32 + tt; const int t = dir == 0 ? idx - C : L - 1 - (idx - C);
                    if (dq == 0) OUT[(size_t)t * D + head * 128 + v] = o;
                }
            }
        }
        __syncthreads();
    }
}

__device__ __forceinline__ void phase_readout(const Ctx& c) {
    const float* OF = (const float*)(c.ws + WS_OF); const float* OB = (const float*)(c.ws + WS_OB); const bf16_t* SGp = (const bf16_t*)(c.ws + WS_SG);
    bf16_t* RR = (bf16_t*)(c.ws + WS_RR); const float* hng = c.a->in[13];
    for (int t = c.wg * 8 + c.wave; t < L; t += c.nwg * 8) {
        f32x4 a[4], b[4]; row_load(OF + (size_t)t * D, c.lane, a); row_load(OB + (size_t)t * D, c.lane, b);
#pragma unroll
        for (int j = 0; j < 4; ++j) {
            const f32x4 o = a[j] + b[j];
            float ss = o.x * o.x + o.y * o.y + o.z * o.z + o.w * o.w;
#pragma unroll
            for (int sh = 16; sh > 0; sh >>= 1) ss += __shfl_xor(ss, sh);
            const float rstd = rsqrtf(ss * (1.f / 128.f) + EPS);
            const int c0 = c.lane * 4 + 256 * j;
            const f32x4 g = *(const f32x4*)(hng + c0);
            const u32x2 sg = *(const u32x2*)(SGp + (size_t)t * D + c0);
            u32x2 ov; ov.x = pk2(o.x * rstd * g.x * bflo(sg.x), o.y * rstd * g.y * bfhi(sg.x)); ov.y = pk2(o.z * rstd * g.z * bflo(sg.y), o.w * rstd * g.w * bfhi(sg.y));
            *(u32x2*)(RR + (size_t)t * D + c0) = ov;
        }
    }
}

#define XB_TMO      128
#define XB_XCNT(j)  (256  + 64 * (j))
#define XB_XSUB(j)  (1280 + 64 * (j))
#define XB_XGEN(j)  (2304 + 64 * (j))
#define XB_TOP      3328
#define XB_TOPGEN   3392
#define XCD_BAR_WORDS 3456
#define XB_SPIN_CAP (1u << 18)
__device__ __forceinline__ unsigned xb_ld(unsigned* p)              { return __hip_atomic_load(p, __ATOMIC_RELAXED, __HIP_MEMORY_SCOPE_AGENT); }
__device__ __forceinline__ unsigned xb_add(unsigned* p, unsigned v) { return __hip_atomic_fetch_add(p, v, __ATOMIC_RELAXED, __HIP_MEMORY_SCOPE_AGENT); }
__device__ __forceinline__ unsigned xb_xcc_id() { return (unsigned)__builtin_amdgcn_s_getreg((3 << 11) | 20) & 0xFu; }
#define XB_SPIN(cond, bar) do { unsigned _sp = 0; while (cond) { __builtin_amdgcn_s_sleep(1); \
    if ((++_sp & 255u) == 0u) { if (xb_ld(&(bar)[XB_TMO])) break; if (_sp > XB_SPIN_CAP) { atomicAdd(&(bar)[XB_TMO], 1u); break; } } } } while (0)
struct XcdBarrier { unsigned* bar; unsigned x; volatile LAS unsigned* st; };
__device__ __forceinline__ XcdBarrier xcd_barrier_post(unsigned* bar, volatile LAS unsigned* st) {
    XcdBarrier b; b.bar = bar; b.x = xb_xcc_id(); b.st = st;
    if (threadIdx.x == 0) (void)xb_add(&bar[XB_XCNT(b.x)], 1u);
    return b;
}
__device__ __forceinline__ void xcd_barrier_complete(unsigned* bar, unsigned x, unsigned& nloc, unsigned& nx) {
    const unsigned G = gridDim.x * gridDim.y * gridDim.z;
    unsigned sum, cnt, mine, sp = 0u;
    for (;;) {
        sum = 0u; cnt = 0u; mine = 0u;
#pragma unroll
        for (unsigned j = 0; j < 16; ++j) { const unsigned c = xb_ld(&bar[XB_XCNT(j)]); sum += c; cnt += (c > 0u) ? 1u : 0u; mine = (j == x) ? c : mine; }
        if (sum == G) break;
        __builtin_amdgcn_s_sleep(1);
        if ((++sp & 255u) == 0u) { if (xb_ld(&bar[XB_TMO])) break; if (sp > XB_SPIN_CAP) { atomicAdd(&bar[XB_TMO], 1u); break; } }
    }
    nloc = mine > 0u ? mine : 1u; nx = cnt > 0u ? cnt : 1u;
}
__device__ __forceinline__ void xcd_barrier(const XcdBarrier& b) {
    asm volatile("s_waitcnt vmcnt(0)" ::: "memory");
    __syncthreads();
    if (threadIdx.x == 0) {
        unsigned* bar = b.bar;
        __builtin_amdgcn_s_waitcnt(0);
        unsigned nloc = b.st[0], nx = b.st[1];
        if (nloc == 0u) { xcd_barrier_complete(bar, b.x, nloc, nx); b.st[0] = nloc; b.st[1] = nx; }
        const unsigned old = xb_add(&bar[XB_XSUB(b.x)], 1u);
        const unsigned gen = old / nloc;
        if (old + 1u == (gen + 1u) * nloc) {
            __builtin_amdgcn_fence(__ATOMIC_RELEASE, "agent");
            asm volatile("s_waitcnt vmcnt(0)" ::: "memory");
            const unsigned og = xb_add(&bar[XB_TOP], 1u);
            const unsigned tg = og / nx;
            if (og + 1u == (tg + 1u) * nx) xb_add(&bar[XB_TOPGEN], 1u);
            else XB_SPIN(xb_ld(&bar[XB_TOPGEN]) == tg, bar);
            __builtin_amdgcn_fence(__ATOMIC_ACQUIRE, "agent");
            xb_add(&bar[XB_XGEN(b.x)], 1u);
            asm volatile("s_waitcnt vmcnt(0)" ::: "memory");
        } else {
            XB_SPIN(xb_ld(&bar[XB_XGEN(b.x)]) == gen, bar);
            __builtin_amdgcn_fence(__ATOMIC_ACQUIRE, "agent");
            asm volatile("s_waitcnt vmcnt(0)" ::: "memory");
        }
    }
    __syncthreads();
}

__device__ __forceinline__ void launder(Ctx& c) { asm volatile("" : "+s"(c.a)); asm volatile("" : "+s"(c.ws)); }
__global__ void __launch_bounds__(512, 2) mk_fwd(Args args) {
    extern __shared__ __attribute__((aligned(16))) unsigned char lds_raw[];
    Ctx c; c.a = (CArgs)__builtin_amdgcn_kernarg_segment_ptr(); c.lds = (LAS unsigned char*)lds_raw; c.tid = threadIdx.x; c.lane = c.tid & 63; c.wave = c.tid >> 6; c.nwg = gridDim.x; c.wg = blockIdx.x; c.ws = c.a->ws;
    volatile LAS unsigned* bst = (volatile LAS unsigned*)(c.lds + LDS_BYTES - 64);
    if (c.tid < 4) bst[c.tid] = 0u;
    __syncthreads();
    const XcdBarrier bar = xcd_barrier_post((unsigned*)(c.ws + WS_CTL) + CW_BAR, bst);
    const int lo = c.a->ph_lo, hi = c.a->ph_hi;
#define SEAM(k) do { if (lo <= (k) && (k) + 1 < hi) xcd_barrier(bar); } while (0)
#define IN(k) (lo <= (k) && (k) < hi && (launder(c), true))
    if (IN(0)) phase_prep(c);
    SEAM(0);
    if (IN(1)) phase_convert(c);
    SEAM(1);
    if (IN(2)) phase_gemm_f32(c, (const bf16_t*)(c.ws + WS_H), R, (const bf16_t*)(c.ws + WS_WQKV), QKVD, c.a->in[8], (float*)(c.ws + WS_RAW1));
    SEAM(2);
    if (IN(3)) phase_rope(c);
    SEAM(3);
    if (IN(4)) phase_attn_simple(c);
    SEAM(4);
    if (IN(5)) phase_gemm_f32(c, (const bf16_t*)(c.ws + WS_O), R, (const bf16_t*)(c.ws + WS_WO), D, nullptr, (float*)(c.ws + WS_RAW1));
    SEAM(5);
    if (IN(6)) phase_postmix(c, 0, 0, 0);
    SEAM(6);
    if (IN(7)) phase_moe_gu(c, 0);
    SEAM(7);
    if (IN(8)) phase_moe_dn(c, 0);
    SEAM(8);
    if (IN(9)) phase_combine(c, 0);
    SEAM(9);
    if (IN(10)) phase_gemm_f32(c, (const bf16_t*)(c.ws + WS_H), R, (const bf16_t*)(c.ws + WS_WIN), HIN, nullptr, (float*)(c.ws + WS_RAW1));
    SEAM(10);
    if (IN(11)) phase_hgrn_elem(c);
    SEAM(11);
    if (IN(12)) phase_hgrn_rec(c);
    SEAM(12);
    if (IN(13)) phase_readout(c);
    SEAM(13);
    if (IN(14)) phase_gemm_f32(c, (const bf16_t*)(c.ws + WS_RR), L, (const bf16_t*)(c.ws + WS_WHO), D, nullptr, (float*)(c.ws + WS_RAW1));
    SEAM(14);
    if (IN(15)) phase_postmix(c, 1, C, C);
    SEAM(15);
    if (IN(16)) phase_moe_gu(c, 1);
    SEAM(16);
    if (IN(17)) phase_moe_dn(c, 1);
    SEAM(17);
    if (IN(18)) phase_combine(c, 1);
#undef IN
#undef SEAM
}

extern "C" void kernel_launch(void* const* d_in, const int* in_sizes, int n_in, void* d_out, int out_size, void* d_ws, size_t ws_size, hipStream_t stream) {
    static int grid = 0;
    if (grid == 0) {
        if (n_in != 21 || out_size != L * D || ws_size < WS_END) { fprintf(stderr, "kernel_launch: unexpected problem (n_in %d out %d ws %zu need %zu)\n", n_in, out_size, ws_size, (size_t)WS_END); grid = -1; return; }
        int dev = 0, cus = 0, per_cu = 0;
        hipGetDevice(&dev); hipDeviceGetAttribute(&cus, hipDeviceAttributeMultiprocessorCount, dev);
        if (hipFuncSetAttribute((const void*)mk_fwd, hipFuncAttributeMaxDynamicSharedMemorySize, LDS_BYTES) != hipSuccess) { fprintf(stderr, "kernel_launch: hipFuncSetAttribute failed\n"); grid = -1; return; }
        hipOccupancyMaxActiveBlocksPerMultiprocessor(&per_cu, (const void*)mk_fwd, 512, LDS_BYTES);
        if (per_cu < 1) fprintf(stderr, "kernel_launch: occupancy query says %d\n", per_cu);
        (void)hipGetLastError();
        grid = cus > 0 ? cus : 256;
    }
    if (grid < 0) return;
    hipMemsetAsync((char*)d_ws + WS_CTL, 0, MiB, stream);
    Args a{};
    for (int i = 0; i < 21; ++i) a.in[i] = (const float*)d_in[i];
    a.out = (float*)d_out; a.ws = (unsigned char*)d_ws;
    a.ph_lo = 0; a.ph_hi = NPHASE;
    hipLaunchKernelGGL(mk_fwd, dim3(grid), dim3(512), LDS_BYTES, stream, a);
}
```

```cpp
#include <hip/hip_runtime.h>
#include <cstdint>
#include <cstdio>

#define LAS __attribute__((address_space(3)))
typedef unsigned short bf16_t;
typedef short bf16x8 __attribute__((ext_vector_type(8)));
typedef float f32x4 __attribute__((ext_vector_type(4)));
typedef unsigned u32x4 __attribute__((ext_vector_type(4)));
typedef unsigned u32x2 __attribute__((ext_vector_type(2)));

constexpr int D = 1024, L = 16384, C = 256, R = L + C;
constexpr int QKVD = 1280, HIN = 5120, NE = 32, TOPK = 4;
constexpr int PADM = 256, MAXROWS = 74752;
constexpr float EPS = 1e-6f;
constexpr float LOG2E = 1.4426950408889634f;
constexpr int NPHASE = 20;
constexpr int LDS_BYTES = 147456;

constexpr size_t MiB = 1u << 20;
constexpr size_t al(size_t x) { return (x + MiB - 1) / MiB * MiB; }
constexpr size_t WS_CTL = 0;
constexpr size_t WS_MOD = WS_CTL + MiB;
constexpr size_t WS_X = WS_MOD + MiB;
constexpr size_t WS_H = WS_X + al((size_t)R * D * 4);
constexpr size_t WS_Q = WS_H + al((size_t)R * D * 2);
constexpr size_t WS_K = WS_Q + al((size_t)R * D * 2);
constexpr size_t WS_V = WS_K + al((size_t)R * 128 * 2);
constexpr size_t WS_O = WS_V + al((size_t)R * 128 * 2);
constexpr size_t WS_TK = WS_O + al((size_t)R * D * 2);
constexpr size_t WS_LIST = WS_TK + MiB;
constexpr size_t WS_HDN = WS_LIST + 3 * MiB;
constexpr size_t WS_RAW1 = WS_HDN + al((size_t)MAXROWS * 1024 * 2);
constexpr size_t WS_OUTB = WS_RAW1 + al((size_t)R * HIN * 4);
constexpr size_t WS_QH = WS_OUTB + al((size_t)MAXROWS * 1024 * 2);
constexpr size_t WS_KF = WS_QH + al((size_t)L * D * 2);
constexpr size_t WS_KB = WS_KF + al((size_t)R * D * 2);
constexpr size_t WS_IV = WS_KB + al((size_t)R * D * 2);
constexpr size_t WS_SG = WS_IV + al((size_t)R * D * 2);
constexpr size_t WS_OF = WS_SG + al((size_t)L * D * 2);
constexpr size_t WS_OB = WS_OF + al((size_t)L * D * 4);
constexpr size_t WS_RR = WS_OB + al((size_t)L * D * 4);
constexpr size_t WS_WQKV = WS_RR + al((size_t)L * D * 2);
constexpr size_t WS_WO = WS_WQKV + al((size_t)QKVD * D * 2);
constexpr size_t WS_WIN = WS_WO + al((size_t)D * D * 2);
constexpr size_t WS_WHO = WS_WIN + al((size_t)HIN * D * 2);
constexpr size_t WS_WGU = WS_WHO + al((size_t)D * D * 2);
constexpr size_t WS_WDN = WS_WGU + al((size_t)2 * NE * 2048 * D * 2);
constexpr size_t WS_QSF = WS_WDN + al((size_t)2 * NE * 1024 * D * 2);
constexpr size_t WS_QSB = WS_QSF + al((size_t)L * D * 2);
constexpr size_t WS_DS = WS_QSB + al((size_t)L * D * 2);
constexpr size_t WS_DG = WS_DS + al((size_t)256 * 128 * 128 * 4);
constexpr size_t WS_SST = WS_DG + MiB;
constexpr size_t WS_END = WS_SST + al((size_t)256 * 128 * 128 * 2);
static_assert(WS_END <= (size_t)2048 * MiB, "workspace map exceeds 4x the largest input");
constexpr int CW_CNT = 1024;
constexpr int CW_BAR = 4096;
constexpr int MOD_ROPE = 32768;
constexpr int MOD_LB = 49152;

struct Args { const float* in[21]; float* out; unsigned char* ws; int ph_lo, ph_hi; };

__device__ __forceinline__ unsigned f2bf(float f) { unsigned u = __float_as_uint(f); return (u + 0x7fffu + ((u >> 16) & 1u)) >> 16; }
__device__ __forceinline__ unsigned pk2(float lo, float hi) { return f2bf(lo) | (f2bf(hi) << 16); }
__device__ __forceinline__ float bflo(unsigned u) { return __uint_as_float(u << 16); }
__device__ __forceinline__ float bfhi(unsigned u) { return __uint_as_float(u & 0xffff0000u); }
__device__ __forceinline__ float bf2f(bf16_t b) { return __uint_as_float(((unsigned)b) << 16); }
__device__ __forceinline__ float wave_sum(float v) {
#pragma unroll
    for (int o = 32; o > 0; o >>= 1) v += __shfl_xor(v, o);
    return v;
}
__device__ __forceinline__ float silu_f(float x) { return x / (1.f + __expf(-x)); }
__device__ __forceinline__ float sigmoid_f(float x) { return 1.f / (1.f + __expf(-x)); }

typedef const __attribute__((address_space(4))) Args* CArgs;
struct Ctx {
    CArgs a;
    LAS unsigned char* lds;
    int tid, lane, wave, nwg, wg;
    unsigned char* ws;
    __device__ __forceinline__ float* modp(int layer, int which) const { return (float*)(ws + WS_MOD) + (layer * 2 + which) * 6144; }
    __device__ __forceinline__ const float* xin0(int r) const { return r < C ? a->in[2] + (size_t)r * D : a->in[0] + (size_t)(r - C) * D; }
};


namespace pg8 {
constexpr int BM = 256, BK = 64, HALF = 128, HTB = HALF * BK * 2, STAGE_BYTES = 8 * HTB, KD = 1024, NXCD = 8, WGM = 8;
__device__ __forceinline__ int lds_byte(int r, int c) { const int st = (r >> 4) * 2 + (c >> 5), rr = r & 15, cc = c & 31, ob = rr * 64 + cc * 2; return st * 1024 + (ob ^ (((ob >> 9) & 1) << 5)); }
__device__ __forceinline__ void stage_rc(int b, int& Rr, int& Cc) { const int st = b / 1024, sb = b % 1024, swz = sb ^ (((sb >> 9) & 1) << 5); Rr = (st >> 1) * 16 + swz / 64; Cc = (st & 1) * 32 + (swz % 64) / 2; }
__device__ __forceinline__ int perm32(int rho) { const int n = rho >> 4, i = rho & 15; return 8 * (i >> 2) + 4 * n + (i & 3); }

struct Unit { int pm, pn, e, goff, gcnt; };
struct Gemm { const bf16_t* A; const bf16_t* Bt; size_t bstride; const int* list; };

struct StaticOrder {
    int nM, nN, nwg, G, c;
    __device__ __forceinline__ void init(int M, int N, int G_, int c_) { nM = M / BM; nN = N / BM; nwg = nM * nN; G = G_; c = c_; }
    __device__ __forceinline__ bool next(int i, Unit& u) const {
        const long Lq = (long)i * G + c; if (Lq >= nwg) return false;
        int wgid = (int)Lq; { const int q = nwg / NXCD, r = nwg % NXCD, xcd = wgid % NXCD, off = wgid / NXCD; wgid = (xcd < r ? xcd * (q + 1) : r * (q + 1) + (xcd - r) * q) + off; }
        const int nig = WGM * nN, gid = wgid / nig, fm = gid * WGM, gsz = (nM - fm) < WGM ? (nM - fm) : WGM;
        u.pm = fm + ((wgid % nig) % gsz); u.pn = (wgid % nig) / gsz; u.e = 0; u.goff = 0; u.gcnt = 0; return true;
    }
};
struct MoeOrder {
    const LAS int* tp; const LAS int* cnt; int npn, G, vcu;
    __device__ __forceinline__ bool next(int i, Unit& u) const {
        const int lin = i * G + vcu; if (lin >= tp[32] * npn) return false;
        const int rt = lin / npn; int e = 0;
#pragma unroll 8
        for (int k = 1; k < 32; ++k) e += (rt >= tp[k]) ? 1 : 0;
        const int mt = rt - tp[e];
        u.pm = rt; u.pn = lin - rt * npn; u.e = e; u.goff = e * R + mt * 256; u.gcnt = cnt[e] - mt * 256; return true;
    }
};

__device__ __forceinline__ void a_offsets(const Gemm& g, const Unit& u, const int (&sR)[2], const int (&sC)[2], unsigned (&v)[2][2]) {
#pragma unroll
    for (int h = 0; h < 2; ++h)
#pragma unroll
        for (int i = 0; i < 2; ++i) {
            const int rr = h * HALF + sR[i]; int row;
            if (g.list) row = rr < u.gcnt ? g.list[u.goff + rr] : 0; else row = u.pm * BM + rr;
            v[h][i] = (unsigned)(row * KD + sC[i]) * 2u;
        }
}

struct EpiF32 {
    static constexpr bool PERM = false;
    float* Cp; int ldc; const float* bias;
    __device__ __forceinline__ void operator()(const f32x4 (&acc)[2][2][4][2], const Unit& u, int wr, int wc, int fr, int fq) const {
        const int row0 = u.pm * BM + wr * 64 + fr, col0 = u.pn * BM + wc * 32 + 4 * fq;
#pragma unroll
        for (int bj = 0; bj < 2; ++bj)
#pragma unroll
            for (int n = 0; n < 2; ++n) {
                const int col = col0 + bj * HALF + n * 16;
                const f32x4 bv = bias ? *(const f32x4*)(bias + col) : (f32x4){0.f, 0.f, 0.f, 0.f};
#pragma unroll
                for (int ai = 0; ai < 2; ++ai)
#pragma unroll
                    for (int m = 0; m < 4; ++m) *(f32x4*)(Cp + (size_t)(row0 + ai * HALF + m * 16) * ldc + col) = acc[ai][bj][m][n] + bv;
            }
    }
};
struct EpiSwiglu {
    static constexpr bool PERM = false;
    bf16_t* Hd; const float* bgu;
    __device__ __forceinline__ void operator()(const f32x4 (&acc)[2][2][4][2], const Unit& u, int wr, int wc, int fr, int fq) const {
        const int row0 = u.pm * BM + wr * 64 + fr, cg0 = u.pn * HALF + wc * 32 + 4 * fq;
        const float* bb = bgu + (size_t)u.e * 2048;
#pragma unroll
        for (int n = 0; n < 2; ++n) {
            const int cg = cg0 + n * 16;
            const f32x4 bg = *(const f32x4*)(bb + cg), bu = *(const f32x4*)(bb + 1024 + cg);
#pragma unroll
            for (int ai = 0; ai < 2; ++ai)
#pragma unroll
                for (int m = 0; m < 4; ++m) {
                    const f32x4 gv = acc[ai][0][m][n] + bg, uv = acc[ai][1][m][n] + bu; float hv[4];
#pragma unroll
                    for (int q = 0; q < 4; ++q) { const float gg = fminf(gv[q], 7.f), uu = fminf(fmaxf(uv[q], -7.f), 7.f); hv[q] = gg * (1.f / (1.f + __expf(-1.702f * gg))) * (uu + 1.f); }
                    u32x2 o; o.x = pk2(hv[0], hv[1]); o.y = pk2(hv[2], hv[3]);
                    *(u32x2*)(Hd + (size_t)(row0 + ai * HALF + m * 16) * 1024 + cg) = o;
                }
        }
    }
};
struct EpiBf16Bias {
    static constexpr bool PERM = false;
    bf16_t* Op; const float* bias; int bias_estride;
    __device__ __forceinline__ void operator()(const f32x4 (&acc)[2][2][4][2], const Unit& u, int wr, int wc, int fr, int fq) const {
        const int row0 = u.pm * BM + wr * 64 + fr, col0 = u.pn * BM + wc * 32 + 4 * fq;
        const float* bb = bias + (size_t)u.e * bias_estride;
#pragma unroll
        for (int bj = 0; bj < 2; ++bj)
#pragma unroll
            for (int n = 0; n < 2; ++n) {
                const int col = col0 + bj * HALF + n * 16;
                const f32x4 bv = *(const f32x4*)(bb + col);
#pragma unroll
                for (int ai = 0; ai < 2; ++ai)
#pragma unroll
                    for (int m = 0; m < 4; ++m) { const f32x4 v = acc[ai][bj][m][n] + bv; u32x2 o; o.x = pk2(v[0], v[1]); o.y = pk2(v[2], v[3]);
                        *(u32x2*)(Op + (size_t)(row0 + ai * HALF + m * 16) * 1024 + col) = o; }
            }
    }
};

template <class Epi, class Sched, bool ALIGN_EPI>
__device__ __forceinline__ void gemm_phase(LAS unsigned char* lds, const Gemm g, const Sched& S, const Epi& E) {
    const int tid = threadIdx.x, wid = __builtin_amdgcn_readfirstlane(tid >> 6), lane = tid & 63, wr = wid >> 2, wc = wid & 3, fr = lane & 15, fq = lane >> 4;
    constexpr int K = KD, nt = K / BK;
    int sR[2], sC[2]; unsigned voffB[2];
#pragma unroll
    for (int i = 0; i < 2; ++i) { stage_rc(tid * 16 + i * 8192, sR[i], sC[i]); const int Rb = Epi::PERM ? ((sR[i] & ~31) + perm32(sR[i] & 31)) : sR[i]; voffB[i] = (unsigned)(Rb * K + sC[i]) * 2u; }
    constexpr size_t kstep = (size_t)(BK * 2), hstep = (size_t)HALF * K * 2, tstep = 2 * hstep;
    const unsigned ldsw = (unsigned)wid * 1024u;
    const int aoff = lds_byte(wr * 64 + fr, fq * 8), boff = lds_byte(wc * 32 + fr, fq * 8);
    const char* Ab = (const char*)g.A;
#define PG8_SA(b, h) (((b) * 2 + (h)) * HTB)
#define PG8_SB(b, h) ((4 + (b) * 2 + (h)) * HTB)
#define PG8_STAGE_B(bufoff, gbase) do { _Pragma("unroll") for (int _i = 0; _i < 2; ++_i) \
        __builtin_amdgcn_global_load_lds((const unsigned*)((const char*)(gbase) + voffB[_i]), (LAS unsigned*)(lds + (bufoff) + ldsw + _i * 8192), 16, 0, 0); } while (0)
#define PG8_STAGE_A(bufoff, kb, v) do { _Pragma("unroll") for (int _i = 0; _i < 2; ++_i) \
        __builtin_amdgcn_global_load_lds((const unsigned*)(Ab + (size_t)(kb) + (v)[_i]), (LAS unsigned*)(lds + (bufoff) + ldsw + _i * 8192), 16, 0, 0); } while (0)
#define PG8_LDA(dst, b, h) do { _Pragma("unroll") for (int m = 0; m < 4; ++m) _Pragma("unroll") for (int k = 0; k < 2; ++k) dst[m][k] = *(const LAS bf16x8*)(lds + PG8_SA(b, h) + aoff + m * 2048 + k * 1024); } while (0)
#define PG8_LDB(dst, b, h) do { _Pragma("unroll") for (int n = 0; n < 2; ++n) _Pragma("unroll") for (int k = 0; k < 2; ++k) dst[n][k] = *(const LAS bf16x8*)(lds + PG8_SB(b, h) + boff + n * 2048 + k * 1024); } while (0)
#define PG8_MMA(ai, bj, At, Bt) do { __builtin_amdgcn_s_setprio(1); _Pragma("unroll") for (int m = 0; m < 4; ++m) _Pragma("unroll") for (int n = 0; n < 2; ++n) _Pragma("unroll") for (int k = 0; k < 2; ++k) \
        acc[ai][bj][m][n] = __builtin_amdgcn_mfma_f32_16x16x32_bf16(Bt[n][k], At[m][k], acc[ai][bj][m][n], 0, 0, 0); __builtin_amdgcn_s_setprio(0); } while (0)
#define PG8_WAIT_V(n) asm volatile("s_waitcnt vmcnt(" #n ")" ::: "memory")
#define PG8_WAIT_L(n) asm volatile("s_waitcnt lgkmcnt(" #n ")" ::: "memory")
#define PG8_BAR __builtin_amdgcn_s_barrier()
#define PG8_SCHED __builtin_amdgcn_sched_barrier(0)
    Unit cur, nxt; int ui = 0;
    if (!S.next(0, cur)) return;
    unsigned cv[2][2], nv[2][2];
    a_offsets(g, cur, sR, sC, cv);
    f32x4 acc[2][2][4][2];
#pragma unroll
    for (int a = 0; a < 2; ++a)
#pragma unroll
        for (int b = 0; b < 2; ++b)
#pragma unroll
            for (int m = 0; m < 4; ++m)
#pragma unroll
                for (int n = 0; n < 2; ++n) acc[a][b][m][n] = (f32x4){0.f, 0.f, 0.f, 0.f};
    bf16x8 At[4][2], B0[2][2], B1[2][2];
    const char* cB = (const char*)g.Bt + ((size_t)cur.e * g.bstride) * 2 + (size_t)cur.pn * tstep;
    PG8_STAGE_B(PG8_SB(0, 0), cB); PG8_STAGE_B(PG8_SB(0, 1), cB + hstep); PG8_STAGE_A(PG8_SA(0, 0), 0, cv[0]); PG8_STAGE_A(PG8_SA(0, 1), 0, cv[1]);
    if (wr == 1) PG8_BAR;
    PG8_WAIT_V(2); PG8_BAR;
    PG8_STAGE_B(PG8_SB(1, 0), cB + kstep); PG8_STAGE_A(PG8_SA(1, 0), kstep, cv[0]); PG8_STAGE_B(PG8_SB(1, 1), cB + hstep + kstep);
    PG8_WAIT_V(6); PG8_BAR;
    for (;;) {
        const bool has_next = S.next(ui + 1, nxt);
        const char* nB = cB;
        if (has_next) { a_offsets(g, nxt, sR, sC, nv); nB = (const char*)g.Bt + ((size_t)nxt.e * g.bstride) * 2 + (size_t)nxt.pn * tstep; }
        else {
#pragma unroll
            for (int h = 0; h < 2; ++h)
#pragma unroll
                for (int i = 0; i < 2; ++i) nv[h][i] = cv[h][i];
        }
        for (int t = 0; t < nt; t += 2) {
            const bool last = (t == nt - 2);
            const size_t k1 = (size_t)(t + 1) * kstep, k2 = last ? 0 : (size_t)(t + 2) * kstep, k3 = k2 + kstep;
            const char* b2 = last ? nB : cB + (size_t)(t + 2) * kstep; const char* b3 = b2 + kstep;
            unsigned w0[2], w1[2];
#pragma unroll
            for (int i = 0; i < 2; ++i) { w0[i] = last ? nv[0][i] : cv[0][i]; w1[i] = last ? nv[1][i] : cv[1][i]; }
            PG8_LDB(B0, 0, 0); PG8_LDB(B1, 0, 1); PG8_SCHED; PG8_LDA(At, 0, 0); PG8_STAGE_A(PG8_SA(1, 1), k1, cv[1]);
            PG8_WAIT_V(8); PG8_WAIT_L(0); PG8_BAR; PG8_MMA(0, 0, At, B0); PG8_MMA(0, 1, At, B1); PG8_BAR; PG8_SCHED;
            PG8_LDA(At, 0, 1); PG8_STAGE_B(PG8_SB(0, 0), b2); PG8_STAGE_B(PG8_SB(0, 1), b2 + hstep); PG8_STAGE_A(PG8_SA(0, 0), k2, w0);
            PG8_WAIT_V(8); PG8_WAIT_L(0); PG8_BAR; PG8_MMA(1, 0, At, B0); PG8_MMA(1, 1, At, B1); PG8_BAR; PG8_SCHED;
            PG8_LDB(B0, 1, 0); PG8_LDB(B1, 1, 1); PG8_SCHED; PG8_LDA(At, 1, 0); PG8_STAGE_A(PG8_SA(0, 1), k2, w1);
            PG8_WAIT_V(8); PG8_WAIT_L(0); PG8_BAR; PG8_MMA(0, 0, At, B0); PG8_MMA(0, 1, At, B1); PG8_BAR; PG8_SCHED;
            PG8_LDA(At, 1, 1); PG8_STAGE_B(PG8_SB(1, 0), b3); PG8_STAGE_B(PG8_SB(1, 1), b3 + hstep); PG8_STAGE_A(PG8_SA(1, 0), k3, w0);
            PG8_WAIT_V(8); PG8_WAIT_L(0); PG8_BAR; PG8_MMA(1, 0, At, B0); PG8_MMA(1, 1, At, B1); PG8_BAR; PG8_SCHED;
        }
        if constexpr (ALIGN_EPI) { if (wr == 0) PG8_BAR; }
        E(acc, cur, wr, wc, fr, fq);
        if (!has_next) break;
#pragma unroll
        for (int a = 0; a < 2; ++a)
#pragma unroll
            for (int b = 0; b < 2; ++b)
#pragma unroll
                for (int m = 0; m < 4; ++m)
#pragma unroll
                    for (int n = 0; n < 2; ++n) acc[a][b][m][n] = (f32x4){0.f, 0.f, 0.f, 0.f};
        cur = nxt; cB = nB; ++ui;
#pragma unroll
        for (int h = 0; h < 2; ++h)
#pragma unroll
            for (int i = 0; i < 2; ++i) cv[h][i] = nv[h][i];
        if constexpr (ALIGN_EPI) { if (wr == 1) PG8_BAR; }
    }
    PG8_WAIT_V(0);
    if constexpr (!ALIGN_EPI) { if (wr == 0) PG8_BAR; }
    PG8_BAR;
#undef PG8_SA
#undef PG8_SB
#undef PG8_STAGE_A
#undef PG8_STAGE_B
#undef PG8_LDA
#undef PG8_LDB
#undef PG8_MMA
#undef PG8_WAIT_V
#undef PG8_WAIT_L
#undef PG8_BAR
#undef PG8_SCHED
}
}

__device__ __forceinline__ void transpose_block(const float* W, int ldw, int n0, int k0, bf16_t* WTrow0  , LAS float* scr, int lane) {
    f32x4 v[16];
    const float* src = W + (size_t)(k0 + (lane >> 4)) * ldw + n0 + (lane & 15) * 4;
#pragma unroll
    for (int i = 0; i < 16; ++i) v[i] = *(const f32x4*)(src + (size_t)(4 * i) * ldw);
#pragma unroll
    for (int i = 0; i < 16; ++i) { LAS float* d = scr + ((lane >> 4) + 4 * i) * 65 + (lane & 15) * 4; d[0] = v[i].x; d[1] = v[i].y; d[2] = v[i].z; d[3] = v[i].w; }
    asm volatile("s_waitcnt lgkmcnt(0)" ::: "memory"); __builtin_amdgcn_wave_barrier();
    const int c8 = lane & 7;
#pragma unroll
    for (int jj = 0; jj < 8; ++jj) {
        const int n = (lane >> 3) + 8 * jj; const LAS float* p = scr + (8 * c8) * 65 + n;
        u32x4 o; o.x = pk2(p[0], p[65]); o.y = pk2(p[2 * 65], p[3 * 65]); o.z = pk2(p[4 * 65], p[5 * 65]); o.w = pk2(p[6 * 65], p[7 * 65]);
        *(u32x4*)(WTrow0 + (size_t)n * 1024 + k0 + 8 * c8) = o;
    }
    asm volatile("s_waitcnt lgkmcnt(0)" ::: "memory"); __builtin_amdgcn_wave_barrier();
}

__device__ __forceinline__ void phase_prep(const Ctx& c) {
    LAS float* red = (LAS float*)c.lds;
    const float* cv = c.a->in[1]; const float* ccv = c.a->in[3]; const float* ada_w = c.a->in[4]; const float* ada_b = c.a->in[5];
    for (int item = c.wg; item < 193; item += c.nwg) {
        if (item < 192) {
            const int layer = item / 96, cb = item % 96, col = cb * 64 + c.lane;
            const float* W = ada_w + (size_t)layer * D * 6144 + col;
            float a0 = 0.f, a1 = 0.f;
            const int k0 = c.wave * 128;
#pragma unroll 8
            for (int k = 0; k < 128; ++k) { const float w = W[(size_t)(k0 + k) * 6144]; a0 += silu_f(cv[k0 + k]) * w; a1 += silu_f(ccv[k0 + k]) * w; }
            red[(0 * 8 + c.wave) * 64 + c.lane] = a0; red[(1 * 8 + c.wave) * 64 + c.lane] = a1;
            __syncthreads();
            if (c.tid < 128) {
                const int which = c.tid >> 6, l = c.tid & 63; float s = 0.f;
#pragma unroll
                for (int w = 0; w < 8; ++w) s += red[(which * 8 + w) * 64 + l];
                c.modp(layer, which)[cb * 64 + l] = s + ada_b[layer * 6144 + cb * 64 + l];
            }
            __syncthreads();
        } else {
            float* modbase = (float*)(c.ws + WS_MOD);
            for (int i = c.tid; i < 4096; i += 512) {
                const int pos = i >> 4, j = i & 15;
                const double ang = (double)pos * pow(10000.0, -(double)j / 16.0);
                modbase[MOD_ROPE + 2 * i] = (float)cos(ang); modbase[MOD_ROPE + 2 * i + 1] = (float)sin(ang);
            }
            const float* lbp = c.a->in[12];
            for (int i = c.tid; i < 2048; i += 512) { const float p0 = lbp[i], p1 = lbp[2048 + i]; modbase[MOD_LB + i] = 1.f / (1.f + __expf(p0 - p1)); }
        }
    }
}

__device__ __forceinline__ void row_load(const float* p, int lane, f32x4 (&v)[4]) {
#pragma unroll
    for (int j = 0; j < 4; ++j) v[j] = *(const f32x4*)(p + lane * 4 + 256 * j);
}
__device__ __forceinline__ float row_ss(const f32x4 (&v)[4]) {
    float s = 0.f;
#pragma unroll
    for (int j = 0; j < 4; ++j) s += v[j].x * v[j].x + v[j].y * v[j].y + v[j].z * v[j].z + v[j].w * v[j].w;
    return wave_sum(s);
}
__device__ __forceinline__ void row_modnorm_store(const f32x4 (&x)[4], float rstd, const float* g, const float* sh, const float* sc, bf16_t* out, int lane, f32x4 (*hout)[4] = nullptr) {
#pragma unroll
    for (int j = 0; j < 4; ++j) {
        const int c0 = lane * 4 + 256 * j;
        const f32x4 gv = *(const f32x4*)(g + c0), shv = *(const f32x4*)(sh + c0), scv = *(const f32x4*)(sc + c0);
        f32x4 h;
        h.x = x[j].x * rstd * gv.x * (1.f + scv.x) + shv.x; h.y = x[j].y * rstd * gv.y * (1.f + scv.y) + shv.y;
        h.z = x[j].z * rstd * gv.z * (1.f + scv.z) + shv.z; h.w = x[j].w * rstd * gv.w * (1.f + scv.w) + shv.w;
        if (hout) (*hout)[j] = h;
        u32x2 o; o.x = pk2(h.x, h.y); o.y = pk2(h.z, h.w);
        *(u32x2*)(out + c0) = o;
    }
}

__device__ __forceinline__ void phase_norm0(const Ctx& c) {
    bf16_t* H = (bf16_t*)(c.ws + WS_H); const float* ng = c.a->in[6];
    for (int r = c.wg * 8 + c.wave; r < R; r += c.nwg * 8) {
        f32x4 x[4]; row_load(c.xin0(r), c.lane, x);
        const float rstd = rsqrtf(row_ss(x) * (1.f / D) + EPS);
        const float* m = c.modp(0, r < C ? 1 : 0);
        row_modnorm_store(x, rstd, ng, m + 0, m + 1024, H + (size_t)r * D, c.lane);
    }
}

__device__ __forceinline__ void phase_rope(const Ctx& c) {
    const float* raw = (const float*)(c.ws + WS_RAW1); const float* tab = (const float*)(c.ws + WS_MOD) + MOD_ROPE;
    bf16_t* Q = (bf16_t*)(c.ws + WS_Q); bf16_t* K = (bf16_t*)(c.ws + WS_K); bf16_t* V = (bf16_t*)(c.ws + WS_V);
    const float qs = 0.125f * LOG2E;
    for (int r = c.wg * 8 + c.wave; r < R; r += c.nwg * 8) {
        const float* row = raw + (size_t)r * QKVD;
        const bool lat = r >= C; const int t = r - C;
        for (int col = c.lane; col < QKVD; col += 64) {
            float val = row[col];
            if (col < 1152 && lat) {
                const int within = col & 63, half = within >> 5, part = (within >> 4) & 1, j = within & 15;
                const int pos = half == 0 ? (t >> 6) : (t & 63);
                const float cs = tab[2 * (pos * 16 + j)], sn = tab[2 * (pos * 16 + j) + 1];
                const float x1 = part == 0 ? val : row[col - 16], x2 = part == 0 ? row[col + 16] : val;
                val = part == 0 ? (x1 * cs - x2 * sn) : (x2 * cs + x1 * sn);
            }
            if (col < 1024) Q[(size_t)r * D + col] = (bf16_t)f2bf(val * qs);
            else if (col < 1152) K[(size_t)r * 128 + (col - 1024)] = (bf16_t)f2bf(val);
            else V[(size_t)r * 128 + (col - 1152)] = (bf16_t)f2bf(val);
        }
    }
}

__device__ __forceinline__ void phase_attn_simple(const Ctx& c) {
    const bf16_t* Q = (const bf16_t*)(c.ws + WS_Q); const bf16_t* K = (const bf16_t*)(c.ws + WS_K); const bf16_t* V = (const bf16_t*)(c.ws + WS_V);
    bf16_t* O = (bf16_t*)(c.ws + WS_O); const float* sink = c.a->in[9];
    LAS unsigned* sK = (LAS unsigned*)c.lds;
    LAS unsigned* sV = (LAS unsigned*)(c.lds + 16384);
    for (int item = c.wg; item < 260; item += c.nwg) {
        const bool isctx = item >= 256;
        const int n = isctx ? 0 : (item >> 1), kh = item & 1, cb = isctx ? ((item - 256) >> 1) : 0;
        const int qrow0 = isctx ? cb * 128 : C + n * 128;
        const int nchunk = isctx ? 2 : 5;
        for (int pp = 0; pp < 2; ++pp) {
            const int pi = c.tid + 512 * pp, qi = pi & 127, g = pi >> 7, hq = kh * 8 + g;
            const int tq = n * 128 + qi;
            unsigned q[32];
            {
                const u32x4* qp = (const u32x4*)(Q + (size_t)(qrow0 + qi) * D + hq * 64);
#pragma unroll
                for (int i = 0; i < 8; ++i) { const u32x4 u = qp[i]; q[4 * i] = u.x; q[4 * i + 1] = u.y; q[4 * i + 2] = u.z; q[4 * i + 3] = u.w; }
            }
            const float sink2 = sink[hq] * LOG2E;
            float m = sink2, l = 0.f;
            float acc[64];
#pragma unroll
            for (int i = 0; i < 64; ++i) acc[i] = 0.f;
            for (int pass = 0; pass < 2; ++pass) {
                if (pass == 1) l = exp2f(sink2 - m);
                for (int ch = 0; ch < nchunk; ++ch) {
                    int krow0, tk0 = 0; bool win = false;
                    if (ch < 2) krow0 = ch * 128;
                    else { const int b = n + ch - 3; if (b < 0 || b >= 128) continue; krow0 = C + b * 128; tk0 = b * 128; win = true; }
                    __syncthreads();
                    {
                        const int rr = c.tid >> 2, cc = (c.tid & 3) * 8;
                        const u32x4* kp = (const u32x4*)(K + (size_t)(krow0 + rr) * 128 + kh * 64) + (c.tid & 3) * 2;
                        *(LAS u32x4*)(sK + rr * 32 + cc) = kp[0]; *(LAS u32x4*)(sK + rr * 32 + cc + 4) = kp[1];
                        if (pass == 1) { const u32x4* vp = (const u32x4*)(V + (size_t)(krow0 + rr) * 128 + kh * 64) + (c.tid & 3) * 2;
                            *(LAS u32x4*)(sV + rr * 32 + cc) = vp[0]; *(LAS u32x4*)(sV + rr * 32 + cc + 4) = vp[1]; }
                    }
                    __syncthreads();
                    for (int key = 0; key < 128; ++key) {
                        const LAS u32x4* kp = (const LAS u32x4*)(sK + key * 32);
                        float s = 0.f;
#pragma unroll
                        for (int i = 0; i < 8; ++i) { const u32x4 u = kp[i];
                            s += bflo(q[4 * i]) * bflo(u.x) + bfhi(q[4 * i]) * bfhi(u.x) + bflo(q[4 * i + 1]) * bflo(u.y) + bfhi(q[4 * i + 1]) * bfhi(u.y)
                               + bflo(q[4 * i + 2]) * bflo(u.z) + bfhi(q[4 * i + 2]) * bfhi(u.z) + bflo(q[4 * i + 3]) * bflo(u.w) + bfhi(q[4 * i + 3]) * bfhi(u.w); }
                        bool valid = true;
                        if (win) { const int dt = tq - (tk0 + key); valid = (dt <= 128) && (dt >= -128); }
                        if (pass == 0) { if (valid) m = fmaxf(m, s); }
                        else {
                            const float p = valid ? exp2f(s - m) : 0.f;
                            l += p;
                            const LAS u32x4* vp = (const LAS u32x4*)(sV + key * 32);
#pragma unroll
                            for (int i = 0; i < 8; ++i) { const u32x4 u = vp[i];
                                acc[8 * i] += p * bflo(u.x); acc[8 * i + 1] += p * bfhi(u.x); acc[8 * i + 2] += p * bflo(u.y); acc[8 * i + 3] += p * bfhi(u.y);
                                acc[8 * i + 4] += p * bflo(u.z); acc[8 * i + 5] += p * bfhi(u.z); acc[8 * i + 6] += p * bflo(u.w); acc[8 * i + 7] += p * bfhi(u.w); }
                        }
                    }
                }
            }
            const float il = 1.f / l;
            u32x4* op = (u32x4*)(O + (size_t)(qrow0 + qi) * D + hq * 64);
#pragma unroll
            for (int i = 0; i < 8; ++i) { u32x4 u; u.x = pk2(acc[8 * i] * il, acc[8 * i + 1] * il); u.y = pk2(acc[8 * i + 2] * il, acc[8 * i + 3] * il);
                u.z = pk2(acc[8 * i + 4] * il, acc[8 * i + 5] * il); u.w = pk2(acc[8 * i + 6] * il, acc[8 * i + 7] * il); op[i] = u; }
        }
        __syncthreads();
    }
}

__device__ __forceinline__ void phase_postmix(const Ctx& c, int layer, int r_lo, int yoff) {
    const float* Y = (const float*)(c.ws + WS_RAW1); float* X = (float*)(c.ws + WS_X); bf16_t* H = (bf16_t*)(c.ws + WS_H);
    const float* ng = c.a->in[6] + layer * 4 * D; const float* Wr = c.a->in[15] + (size_t)layer * D * NE; const float* br = c.a->in[16] + layer * NE;
    unsigned* cnt = (unsigned*)(c.ws + WS_CTL) + CW_CNT + layer * NE;
    int* tk_e = (int*)(c.ws + WS_TK); float* tk_g = (float*)(c.ws + WS_TK) + R * 4; int* tk_slot = (int*)(c.ws + WS_TK) + 2 * R * 4;
    int* list = (int*)(c.ws + WS_LIST);
    LAS float* pr = (LAS float*)c.lds + c.wave * (64 * 33);
    LAS float* hrow = (LAS float*)c.lds + 8 * 64 * 33 + c.wave * 1024;
    for (int r = r_lo + c.wg * 8 + c.wave; r < R; r += c.nwg * 8) {
        const float* m = c.modp(layer, r < C ? 1 : 0);
        const float* xsrc = layer == 0 ? c.xin0(r) : X + (size_t)r * D;
        f32x4 y[4], x[4]; row_load(Y + (size_t)(r - yoff) * D, c.lane, y); row_load(xsrc, c.lane, x);
        const float rstd_y = rsqrtf(row_ss(y) * (1.f / D) + EPS);
#pragma unroll
        for (int j = 0; j < 4; ++j) {
            const int c0 = c.lane * 4 + 256 * j;
            const f32x4 g1 = *(const f32x4*)(m + 2048 + c0), n1 = *(const f32x4*)(ng + D + c0);
            x[j].x += g1.x * (y[j].x * rstd_y * n1.x); x[j].y += g1.y * (y[j].y * rstd_y * n1.y);
            x[j].z += g1.z * (y[j].z * rstd_y * n1.z); x[j].w += g1.w * (y[j].w * rstd_y * n1.w);
            *(f32x4*)(X + (size_t)r * D + c0) = x[j];
        }
        const float rstd_x = rsqrtf(row_ss(x) * (1.f / D) + EPS);
        f32x4 h[4];
        row_modnorm_store(x, rstd_x, ng + 2 * D, m + 3072, m + 4096, H + (size_t)r * D, c.lane, &h);
#pragma unroll
        for (int j = 0; j < 4; ++j) *(LAS f32x4*)(hrow + c.lane * 4 + 256 * j) = h[j];
        float p[32];
#pragma unroll
        for (int e = 0; e < 32; ++e) p[e] = 0.f;
#pragma unroll 2
        for (int k = 0; k < 16; ++k) {
            const int col = c.lane * 4 + 256 * (k >> 2) + (k & 3);
            const float hv = hrow[col]; const f32x4* wrow = (const f32x4*)(Wr + (size_t)col * NE);
#pragma unroll
            for (int e4 = 0; e4 < 8; ++e4) { const f32x4 wv = wrow[e4]; p[4 * e4] += hv * wv.x; p[4 * e4 + 1] += hv * wv.y; p[4 * e4 + 2] += hv * wv.z; p[4 * e4 + 3] += hv * wv.w; }
        }
#pragma unroll
        for (int e = 0; e < 32; ++e) pr[c.lane * 33 + e] = p[e];
        asm volatile("s_waitcnt lgkmcnt(0)" ::: "memory");
        __builtin_amdgcn_wave_barrier();
        float logit = -INFINITY;
        if (c.lane < 32) { float s = br[c.lane]; for (int l2 = 0; l2 < 64; ++l2) s += pr[l2 * 33 + c.lane]; logit = s; }
        asm volatile("s_waitcnt lgkmcnt(0)" ::: "memory");
        __builtin_amdgcn_wave_barrier();
        float tv[4]; int te[4];
#pragma unroll
        for (int k = 0; k < 4; ++k) {
            float bv = logit; int bi = c.lane;
#pragma unroll
            for (int o = 32; o > 0; o >>= 1) {
                const float ov = __shfl_xor(bv, o); const int oi = __shfl_xor(bi, o);
                if (ov > bv || (ov == bv && oi < bi)) { bv = ov; bi = oi; }
            }
            tv[k] = bv; te[k] = bi;
            if (c.lane == bi) logit = -INFINITY;
        }
        if (c.lane == 0) {
            const float e1 = __expf(tv[1] - tv[0]), e2 = __expf(tv[2] - tv[0]), e3 = __expf(tv[3] - tv[0]);
            const float inv = 1.f / (1.f + e1 + e2 + e3);
            const float gk[4] = {inv, e1 * inv, e2 * inv, e3 * inv};
#pragma unroll
            for (int k = 0; k < 4; ++k) {
                const unsigned slot = atomicAdd(&cnt[te[k]], 1u);
                list[(size_t)te[k] * R + slot] = r;
                tk_e[r * 4 + k] = te[k]; tk_g[r * 4 + k] = gk[k]; tk_slot[r * 4 + k] = (int)slot;
            }
        }
    }
}

__device__ __forceinline__ void moe_offsets(const Ctx& c, int layer, LAS int* so) {
    const unsigned* cnt = (const unsigned*)(c.ws + WS_CTL) + CW_CNT + layer * NE;
    __syncthreads();
    if (c.tid == 0) { int acc = 0; for (int e = 0; e < NE; ++e) { const int n = (int)cnt[e]; so[e] = acc; so[64 + e] = n; acc += (n + PADM - 1) / PADM * PADM; } so[32] = acc; }
    __syncthreads();
}

__device__ __forceinline__ void moe_tables(const Ctx& c, int layer, LAS int* tb) {
    const unsigned* cnt = (const unsigned*)(c.ws + WS_CTL) + CW_CNT + layer * NE;
    __syncthreads();
    if (c.tid == 0) { int acc = 0; for (int e = 0; e < NE; ++e) { const int n = (int)cnt[e]; tb[e] = acc; tb[64 + e] = n; acc += (n + PADM - 1) / PADM; } tb[32] = acc; }
    __syncthreads();
}
__device__ __forceinline__ int vcu_of(const Ctx& c) { return (c.nwg % 8 == 0) ? (c.wg % 8) * (c.nwg / 8) + c.wg / 8 : c.wg; }
__device__ __forceinline__ void phase_moe_gu(const Ctx& c, int layer) {
    LAS int* tb = (LAS int*)(c.lds + 131072 + 1024);
    moe_tables(c, layer, tb);
    pg8::Gemm g{(const bf16_t*)(c.ws + WS_H), (const bf16_t*)(c.ws + WS_WGU) + (size_t)layer * NE * 2048 * 1024, (size_t)2048 * 1024, (const int*)(c.ws + WS_LIST)};
    pg8::MoeOrder S{tb, tb + 64, 8, c.nwg, vcu_of(c)};
    pg8::EpiSwiglu E{(bf16_t*)(c.ws + WS_HDN), c.a->in[18] + (size_t)layer * NE * 2048};
    pg8::gemm_phase<pg8::EpiSwiglu, pg8::MoeOrder, true>(c.lds, g, S, E);
}
__device__ __forceinline__ void phase_moe_dn(const Ctx& c, int layer) {
    LAS int* tb = (LAS int*)(c.lds + 131072 + 1024);
    moe_tables(c, layer, tb);
    pg8::Gemm g{(const bf16_t*)(c.ws + WS_HDN), (const bf16_t*)(c.ws + WS_WDN) + (size_t)layer * NE * 1024 * 1024, (size_t)1024 * 1024, nullptr};
    pg8::MoeOrder S{tb, tb + 64, 4, c.nwg, vcu_of(c)};
    pg8::EpiBf16Bias E{(bf16_t*)(c.ws + WS_OUTB), c.a->in[20] + (size_t)layer * NE * 1024, 1024};
    pg8::gemm_phase<pg8::EpiBf16Bias, pg8::MoeOrder, true>(c.lds, g, S, E);
}
__device__ __forceinline__ void phase_gemm_f32(const Ctx& c, const bf16_t* A, int M, const bf16_t* Bt, int N, const float* bias, float* Cout) {
    pg8::Gemm g{A, Bt, 0, nullptr}; pg8::StaticOrder S; S.init(M, N, c.nwg, c.wg);
    pg8::EpiF32 E{Cout, N, bias};
    pg8::gemm_phase<pg8::EpiF32, pg8::StaticOrder, true>(c.lds, g, S, E);
}

__device__ __forceinline__ void phase_norm0(const Ctx& c);
__device__ __forceinline__ void phase_convert(const Ctx& c) {
    LAS float* scr = (LAS float*)c.lds + c.wave * (64 * 65);
    const int gw = c.wg * 8 + c.wave, NGW = c.nwg * 8;
    constexpr int I_QKV = 20 * 16, I_O = 16 * 16, I_IN = 80 * 16, I_HO = 16 * 16, I_GU = 64 * 32 * 16, I_DN = 64 * 16 * 16, TOT = I_QKV + I_O + I_IN + I_HO + I_GU + I_DN;
    for (int it = gw; it < TOT; it += NGW) {
        int r = it;
        if (r < I_QKV) { const int nb = r % 20, kb = r / 20; transpose_block(c.a->in[7], QKVD, nb * 64, kb * 64, (bf16_t*)(c.ws + WS_WQKV) + (size_t)nb * 64 * 1024, scr, c.lane); continue; } r -= I_QKV;
        if (r < I_O) { const int nb = r % 16, kb = r / 16; transpose_block(c.a->in[10], D, nb * 64, kb * 64, (bf16_t*)(c.ws + WS_WO) + (size_t)nb * 64 * 1024, scr, c.lane); continue; } r -= I_O;
        if (r < I_IN) { const int nb = r % 80, kb = r / 80; transpose_block(c.a->in[11], HIN, nb * 64, kb * 64, (bf16_t*)(c.ws + WS_WIN) + (size_t)nb * 64 * 1024, scr, c.lane); continue; } r -= I_IN;
        if (r < I_HO) { const int nb = r % 16, kb = r / 16; transpose_block(c.a->in[14], D, nb * 64, kb * 64, (bf16_t*)(c.ws + WS_WHO) + (size_t)nb * 64 * 1024, scr, c.lane); continue; } r -= I_HO;
        if (r < I_GU) { const int mat = r / 512, rr = r % 512, nb = rr % 32, kb = rr / 32; const int n0 = ((nb & 3) >> 1) * 1024 + (nb >> 2) * 128 + (nb & 1) * 64;
            transpose_block(c.a->in[17] + (size_t)mat * 1024 * 2048, 2048, n0, kb * 64, (bf16_t*)(c.ws + WS_WGU) + ((size_t)mat * 2048 + nb * 64) * 1024, scr, c.lane); continue; } r -= I_GU;
        { const int mat = r / 256, rr = r % 256, nb = rr % 16, kb = rr / 16;
            transpose_block(c.a->in[19] + (size_t)mat * 1024 * 1024, 1024, nb * 64, kb * 64, (bf16_t*)(c.ws + WS_WDN) + ((size_t)mat * 1024 + nb * 64) * 1024, scr, c.lane); }
    }
    __syncthreads();
    phase_norm0(c);
}

__device__ __forceinline__ void phase_combine(const Ctx& c, int layer) {
    LAS int* so = (LAS int*)(c.lds + 32768);
    moe_offsets(c, layer, so);
    const bf16_t* outb = (const bf16_t*)(c.ws + WS_OUTB); float* X = (float*)(c.ws + WS_X); bf16_t* H = (bf16_t*)(c.ws + WS_H);
    const float* ngl = c.a->in[6] + layer * 4 * D;
    const int* tk_e = (const int*)(c.ws + WS_TK); const float* tk_g = (const float*)(c.ws + WS_TK) + R * 4; const int* tk_slot = (const int*)(c.ws + WS_TK) + 2 * R * 4;
    const int r_lo = layer == 0 ? 0 : C;
    for (int r = r_lo + c.wg * 8 + c.wave; r < R; r += c.nwg * 8) {
        const float* m = c.modp(layer, r < C ? 1 : 0);
        f32x4 y[4];
#pragma unroll
        for (int j = 0; j < 4; ++j) y[j] = (f32x4){0.f, 0.f, 0.f, 0.f};
#pragma unroll
        for (int k = 0; k < 4; ++k) {
            const int e = tk_e[r * 4 + k], slot = tk_slot[r * 4 + k]; const float g = tk_g[r * 4 + k];
            const bf16_t* src = outb + (size_t)(so[e] + slot) * 1024;
#pragma unroll
            for (int j = 0; j < 4; ++j) { const u32x2 w = *(const u32x2*)(src + c.lane * 4 + 256 * j); y[j] += (f32x4){bflo(w.x), bfhi(w.x), bflo(w.y), bfhi(w.y)} * g; }
        }
        const float rstd_y = rsqrtf(row_ss(y) * (1.f / D) + EPS);
        f32x4 x[4]; row_load(X + (size_t)r * D, c.lane, x);
#pragma unroll
        for (int j = 0; j < 4; ++j) {
            const int c0 = c.lane * 4 + 256 * j;
            const f32x4 g2 = *(const f32x4*)(m + 5120 + c0), n3 = *(const f32x4*)(ngl + 3 * D + c0);
            x[j].x += g2.x * (y[j].x * rstd_y * n3.x); x[j].y += g2.y * (y[j].y * rstd_y * n3.y);
            x[j].z += g2.z * (y[j].z * rstd_y * n3.z); x[j].w += g2.w * (y[j].w * rstd_y * n3.w);
            if (layer == 0) *(f32x4*)(X + (size_t)r * D + c0) = x[j];
            else *(f32x4*)(c.a->out + (size_t)(r - C) * D + c0) = x[j];
        }
        if (layer == 0) {
            const float rstd_x = rsqrtf(row_ss(x) * (1.f / D) + EPS);
            const float* m1 = c.modp(1, r < C ? 1 : 0);
            row_modnorm_store(x, rstd_x, c.a->in[6] + 4 * D, m1 + 0, m1 + 1024, H + (size_t)r * D, c.lane);
        }
    }
}

__device__ __forceinline__ void phase_hgrn_elem(const Ctx& c) {
    const float* raw = (const float*)(c.ws + WS_RAW1); const float* lb = (const float*)(c.ws + WS_MOD) + MOD_LB;
    bf16_t* QH = (bf16_t*)(c.ws + WS_QH); _Float16* KF = (_Float16*)(c.ws + WS_KF); _Float16* KB = (_Float16*)(c.ws + WS_KB);
    bf16_t* IV = (bf16_t*)(c.ws + WS_IV); bf16_t* SGp = (bf16_t*)(c.ws + WS_SG);
    for (int r = c.wg * 8 + c.wave; r < R; r += c.nwg * 8) {
        const float* row = raw + (size_t)r * HIN; const bool lat = r >= C; const int t = r - C;
        for (int col = c.lane; col < D; col += 64) {
            const float zf = row[1024 + col], zb = row[2048 + col];
            KF[(size_t)r * D + col] = (_Float16)((1.f - lb[col]) * sigmoid_f(-zf));
            KB[(size_t)r * D + col] = (_Float16)((1.f - lb[1024 + col]) * sigmoid_f(-zb));
            IV[(size_t)r * D + col] = (bf16_t)f2bf(row[3072 + col]);
            if (lat) { QH[(size_t)t * D + col] = (bf16_t)f2bf(silu_f(row[col])); SGp[(size_t)t * D + col] = (bf16_t)f2bf(silu_f(row[4096 + col])); }
        }
    }
}

__device__ __forceinline__ void phase_hgrn_rec(const Ctx& c) {
    const bf16_t* QH = (const bf16_t*)(c.ws + WS_QH); const bf16_t* IV = (const bf16_t*)(c.ws + WS_IV);
    LAS float* sf = (LAS float*)c.lds; LAS float* sk = sf + 32 * 128; LAS float* sq = sk + 32 * 128; LAS float* si = sq + 32 * 128;
    for (int item = c.wg; item < 16; item += c.nwg) {
        const int head = item >> 1, dir = item & 1;
        const _Float16* KX = (const _Float16*)(c.ws + (dir == 0 ? WS_KF : WS_KB));
        float* OUT = (float*)(c.ws + (dir == 0 ? WS_OF : WS_OB));
        const int v = c.tid >> 2, dq = c.tid & 3;
        float s[32];
#pragma unroll
        for (int j = 0; j < 32; ++j) s[j] = 0.f;
        for (int b = 0; b < R / 32; ++b) {
            __syncthreads();
            {
                const int tt = c.tid >> 4, c8 = (c.tid & 15) * 8;
                const int idx = b * 32 + tt;
                int r; bool lat;
                if (idx < C) { r = dir == 0 ? idx : C - 1 - idx; lat = false; } else { const int t = dir == 0 ? idx - C : L - 1 - (idx - C); r = C + t; lat = true; }
                const u32x4 ku = *(const u32x4*)(KX + (size_t)r * D + head * 128 + c8);
                const u32x4 iu = *(const u32x4*)(IV + (size_t)r * D + head * 128 + c8);
                u32x4 qu = (u32x4){0u, 0u, 0u, 0u};
                if (lat) qu = *(const u32x4*)(QH + (size_t)(r - C) * D + head * 128 + c8);
                const _Float16* kh = (const _Float16*)&ku;
                const unsigned iw[4] = {iu.x, iu.y, iu.z, iu.w}, qw[4] = {qu.x, qu.y, qu.z, qu.w};
#pragma unroll
                for (int i = 0; i < 8; ++i) {
                    const float kv = (float)kh[i];
                    sk[tt * 128 + c8 + i] = kv; sf[tt * 128 + c8 + i] = 1.f - kv;
                    si[tt * 128 + c8 + i] = (i & 1) ? bfhi(iw[i >> 1]) : bflo(iw[i >> 1]);
                    sq[tt * 128 + c8 + i] = (i & 1) ? bfhi(qw[i >> 1]) : bflo(qw[i >> 1]);
                }
            }
            __syncthreads();
            const bool latb = (b * 32) >= C;
            for (int tt = 0; tt < 32; ++tt) {
                const float iv = si[tt * 128 + v];
                float o = 0.f;
#pragma unroll
                for (int j4 = 0; j4 < 8; ++j4) {
                    const f32x4 f4 = *(const LAS f32x4*)(sf + tt * 128 + dq * 32 + j4 * 4), k4 = *(const LAS f32x4*)(sk + tt * 128 + dq * 32 + j4 * 4), q4 = *(const LAS f32x4*)(sq + tt * 128 + dq * 32 + j4 * 4);
#pragma unroll
                    for (int i = 0; i < 4; ++i) { float& sr = s[j4 * 4 + i]; sr = f4[i] * sr + k4[i] * iv; o += q4[i] * sr; }
                }
                if (latb) {
                    o += __shfl_xor(o, 1); o += __shfl_xor(o, 2);
                    const int idx = b * 32 + tt; const int t = dir == 0 ? idx - C : L - 1 - (idx - C);
                    if (dq == 0) OUT[(size_t)t * D + head * 128 + v] = o;
                }
            }
        }
        __syncthreads();
    }
}


namespace hg {
typedef short v4i16_t __attribute__((ext_vector_type(4)));
typedef _Float16 h2_t __attribute__((ext_vector_type(2)));
typedef float f32x2 __attribute__((ext_vector_type(2)));
constexpr int TB = 272, PB = 144;
constexpr int TILE = 64 * TB;
constexpr int T_QD = 0, T_QC = TILE, T_KD = 2 * TILE, T_KE = 3 * TILE, T_KC = 4 * TILE, T_V0 = 5 * TILE, T_V1 = 6 * TILE;
constexpr int T_QL1 = 7 * TILE, T_KL1 = T_QL1 + 16 * TB, T_P = T_KL1 + 16 * TB, T_TOT = T_P + 64 * PB, T_CT = T_TOT + 4096, T_END = T_CT + 512;
static_assert(T_END <= LDS_BYTES - 64, "hgrn scan LDS map");
__device__ __forceinline__ int row_of(int dir, int p) { return p < C ? (dir ? C - 1 - p : p) : (dir ? C + (L - 1 - (p - C)) : p); }
__device__ __forceinline__ int seg_of(int ch) { return ch < 68 ? ch / 17 : 4 + (ch - 68) / 16; }
__device__ __forceinline__ bf16x8 tr_frag(const LAS unsigned char* tile, int row0, int col0, int lane) {
    const int q = (lane & 15) >> 2, p = lane & 3;
    const LAS unsigned char* a = tile + (row0 + q) * TB + (col0 + 4 * p) * 2;
    const v4i16_t lo = __builtin_amdgcn_ds_read_tr16_b64_v4i16((LAS v4i16_t*)a);
    const v4i16_t hi = __builtin_amdgcn_ds_read_tr16_b64_v4i16((LAS v4i16_t*)(a + 4 * TB));
    return (bf16x8){lo[0], lo[1], lo[2], lo[3], hi[0], hi[1], hi[2], hi[3]};
}
}

__device__ __forceinline__ void phase_hgrn_scan(const Ctx& c) {
    using namespace hg;
    const bf16_t* QH = (const bf16_t*)(c.ws + WS_QH); const bf16_t* IV = (const bf16_t*)(c.ws + WS_IV);
    LAS unsigned char* lds = c.lds;
    const int tid = c.tid, lane = c.lane, w = __builtin_amdgcn_readfirstlane(tid >> 6), fr = lane & 15, g = lane >> 4;
    for (int item = c.wg; item < 256; item += c.nwg) {
        const int chain = item >> 4, seg = item & 15, head = chain >> 1, dir = chain & 1, hc = head * 128;
        const int c0 = seg < 4 ? 17 * seg : 68 + 16 * (seg - 4), nch = seg < 4 ? 17 : 16;
        const _Float16* KX = (const _Float16*)(c.ws + (dir ? WS_KB : WS_KF));
        float* OL = (float*)(c.ws + (dir ? WS_OB : WS_OF)); bf16_t* QS = (bf16_t*)(c.ws + (dir ? WS_QSB : WS_QSF));
        __syncthreads();
        for (int i = tid; i < 64 * PB / 4; i += 512) ((LAS unsigned*)(lds + T_P))[i] = 0u;
        f32x4 Sacc[8];
#pragma unroll
        for (int m = 0; m < 8; ++m) Sacc[m] = (f32x4){0.f, 0.f, 0.f, 0.f};
        float dseg0 = 1.f, dseg1 = 1.f;
        unsigned kraw[8], qraw[8]; u32x4 vraw[2];
#define HG_LOAD(cidx) do { const int p0_ = 64 * (cidx); const bool lat_ = (cidx) >= 4; \
        _Pragma("unroll") for (int i = 0; i < 8; ++i) { const int r_ = row_of(dir, p0_ + 8 * w + i); \
            kraw[i] = *(const unsigned*)(KX + (size_t)r_ * D + hc + 2 * lane); \
            qraw[i] = lat_ ? *(const unsigned*)(QH + (size_t)(r_ - C) * D + hc + 2 * lane) : 0u; } \
        _Pragma("unroll") for (int i = 0; i < 2; ++i) { const int idx_ = tid + 512 * i; const int r_ = row_of(dir, p0_ + (idx_ >> 4)); \
            vraw[i] = *(const u32x4*)(IV + (size_t)r_ * D + hc + (idx_ & 15) * 8); } } while (0)
        HG_LOAD(c0);
        for (int ci = 0; ci < nch; ++ci) {
            const int cidx = c0 + ci; const bool lat = cidx >= 4;
            const int vbuf = (ci & 1) ? T_V1 : T_V0;
            float kf[8][2], qf[8][2], cp[8][2];
            {
                float p0 = 1.f, p1 = 1.f;
#pragma unroll
                for (int i = 0; i < 8; ++i) {
                    const h2_t hv = __builtin_bit_cast(h2_t, kraw[i]);
                    kf[i][0] = (float)hv[0]; kf[i][1] = (float)hv[1];
                    qf[i][0] = bflo(qraw[i]); qf[i][1] = bfhi(qraw[i]);
                    p0 *= (1.f - kf[i][0]); p1 *= (1.f - kf[i][1]); cp[i][0] = p0; cp[i][1] = p1;
                }
                *(LAS f32x2*)(lds + T_TOT + (w * 128 + 2 * lane) * 4) = (f32x2){p0, p1};
#pragma unroll
                for (int i = 0; i < 2; ++i) { const int idx = tid + 512 * i; *(LAS u32x4*)(lds + vbuf + (idx >> 4) * TB + (idx & 15) * 16) = vraw[i]; }
            }
            __syncthreads();
            {
                f32x2 T[8];
#pragma unroll
                for (int x = 0; x < 8; ++x) T[x] = *(const LAS f32x2*)(lds + T_TOT + (x * 128 + 2 * lane) * 4);
                const int I = w >> 1, hh = w & 1;
                f32x2 bd[4];
#pragma unroll
                for (int x = 0; x < 4; ++x) bd[x] = T[2 * x] * T[2 * x + 1];
                f32x2 pre = (f32x2){1.f, 1.f}, cum = (f32x2){1.f, 1.f}, suf = (f32x2){1.f, 1.f}, bdI = (f32x2){1.f, 1.f};
#pragma unroll
                for (int x = 0; x < 8; ++x) if (hh && x == w - 1) pre = T[x];
#pragma unroll
                for (int x = 0; x < 4; ++x) { if (x < I) cum = cum * bd[x]; if (x > I) suf = suf * bd[x]; if (x == I) bdI = bd[x]; }
                const f32x2 ctot = (bd[0] * bd[1]) * (bd[2] * bd[3]);
#pragma unroll
                for (int i = 0; i < 8; ++i) {
                    const int tau = 8 * w + i;
                    float QDv[2], KDv[2], KEv[2], QCv[2], KCv[2];
#pragma unroll
                    for (int x = 0; x < 2; ++x) {
                        const float eq = pre[x] * cp[i][x], rc = __builtin_amdgcn_rcpf(eq);
                        QDv[x] = qf[i][x] * eq; KDv[x] = kf[i][x] * rc; KEv[x] = KDv[x] * bdI[x]; QCv[x] = QDv[x] * cum[x]; KCv[x] = KEv[x] * suf[x];
                    }
                    const int to = tau * TB + lane * 4;
                    *(LAS unsigned*)(lds + T_QD + to) = pk2(QDv[0], QDv[1]);
                    *(LAS unsigned*)(lds + T_KD + to) = pk2(KDv[0], KDv[1]);
                    *(LAS unsigned*)(lds + T_KE + to) = pk2(KEv[0], KEv[1]);
                    *(LAS unsigned*)(lds + T_QC + to) = pk2(QCv[0], QCv[1]);
                    *(LAS unsigned*)(lds + T_KC + to) = pk2(KCv[0], KCv[1]);
                    if (I == 3) *(LAS unsigned*)(lds + T_QL1 + (tau - 48) * TB + lane * 4) = pk2(QDv[0] * bd[2][0], QDv[1] * bd[2][1]);
                    if (I == 0) *(LAS unsigned*)(lds + T_KL1 + tau * TB + lane * 4) = pk2(KEv[0] * bd[1][0], KEv[1] * bd[1][1]);
                    if (lat) { const int r = row_of(dir, 64 * cidx + tau); *(unsigned*)(QS + (size_t)(r - C) * D + hc + 2 * lane) = pk2(QCv[0] * dseg0, QCv[1] * dseg1); }
                }
                dseg0 *= ctot[0]; dseg1 *= ctot[1];
                if (w == 0) *(LAS f32x2*)(lds + T_CT + lane * 8) = ctot;
            }
            __syncthreads();
            if (ci + 1 < nch) HG_LOAD(cidx + 1);
            if (lat) {
                const int nblk = w >= 6 ? 2 : 1;
                for (int b = 0; b < nblk; ++b) {
                    int I, J, qoff, qrow, koff, krow; bool diag = false;
                    if (w < 4) { I = 2 + (w >> 1); J = w & 1; qoff = (w >> 1) ? T_QL1 : T_QD; qrow = (w >> 1) ? 0 : 32; koff = (w & 1) ? T_KE : T_KL1; krow = (w & 1) ? 16 : 0; }
                    else if (w == 4) { I = 1; J = 0; qoff = T_QD; qrow = 16; koff = T_KE; krow = 0; }
                    else if (w == 5) { I = 3; J = 2; qoff = T_QD; qrow = 48; koff = T_KE; krow = 32; }
                    else { I = 2 * (w - 6) + b; J = I; qoff = T_QD; qrow = 16 * I; koff = T_KD; krow = 16 * I; diag = true; }
                    f32x4 pa = (f32x4){0.f, 0.f, 0.f, 0.f};
#pragma unroll
                    for (int ks = 0; ks < 4; ++ks) {
                        const bf16x8 av = *(const LAS bf16x8*)(lds + qoff + (qrow + fr) * TB + (32 * ks + 8 * g) * 2);
                        const bf16x8 bv = *(const LAS bf16x8*)(lds + koff + (krow + fr) * TB + (32 * ks + 8 * g) * 2);
                        pa = __builtin_amdgcn_mfma_f32_16x16x32_bf16(av, bv, pa, 0, 0, 0);
                    }
#pragma unroll
                    for (int e = 0; e < 4; ++e) {
                        const int tl = 4 * g + e; const float val = (diag && fr > tl) ? 0.f : pa[e];
                        *(LAS bf16_t*)(lds + T_P + (16 * I + tl) * PB + (16 * J + fr) * 2) = (bf16_t)f2bf(val);
                    }
                }
            }
            f32x4 oacc[4];
#pragma unroll
            for (int m = 0; m < 4; ++m) oacc[m] = (f32x4){0.f, 0.f, 0.f, 0.f};
            if (lat) {
                bf16x8 Sb[4];
#pragma unroll
                for (int ks = 0; ks < 4; ++ks) {
                    const f32x4 a0 = Sacc[2 * ks], a1 = Sacc[2 * ks + 1];
                    const u32x4 pk = (u32x4){pk2(a0[0], a0[1]), pk2(a0[2], a0[3]), pk2(a1[0], a1[1]), pk2(a1[2], a1[3])};
                    Sb[ks] = __builtin_bit_cast(bf16x8, pk);
                }
#pragma unroll
                for (int m = 0; m < 4; ++m)
#pragma unroll
                    for (int ks = 0; ks < 4; ++ks) {
                        const u32x2 lo = *(const LAS u32x2*)(lds + T_QC + (16 * m + fr) * TB + (32 * ks + 4 * g) * 2);
                        const u32x2 hi = *(const LAS u32x2*)(lds + T_QC + (16 * m + fr) * TB + (32 * ks + 16 + 4 * g) * 2);
                        const u32x4 pk = (u32x4){lo.x, lo.y, hi.x, hi.y};
                        oacc[m] = __builtin_amdgcn_mfma_f32_16x16x32_bf16(__builtin_bit_cast(bf16x8, pk), Sb[ks], oacc[m], 0, 0, 0);
                    }
            }
#pragma unroll
            for (int m = 0; m < 8; ++m) { const f32x4 ct = *(const LAS f32x4*)(lds + T_CT + (16 * m + 4 * g) * 4); Sacc[m] = Sacc[m] * ct; }
            bf16x8 Vf[2];
#pragma unroll
            for (int ks = 0; ks < 2; ++ks) Vf[ks] = tr_frag(lds + vbuf, 32 * ks + 8 * g, 16 * w, lane);
#pragma unroll
            for (int m = 0; m < 8; ++m)
#pragma unroll
                for (int ks = 0; ks < 2; ++ks) Sacc[m] = __builtin_amdgcn_mfma_f32_16x16x32_bf16(tr_frag(lds + T_KC, 32 * ks + 8 * g, 16 * m, lane), Vf[ks], Sacc[m], 0, 0, 0);
            __syncthreads();
            if (lat) {
#pragma unroll
                for (int m = 0; m < 4; ++m)
#pragma unroll
                    for (int ks = 0; ks < 2; ++ks) {
                        if (m < 2 && ks == 1) continue;
                        const bf16x8 av = *(const LAS bf16x8*)(lds + T_P + (16 * m + fr) * PB + (32 * ks + 8 * g) * 2);
                        oacc[m] = __builtin_amdgcn_mfma_f32_16x16x32_bf16(av, Vf[ks], oacc[m], 0, 0, 0);
                    }
#pragma unroll
                for (int m = 0; m < 4; ++m)
#pragma unroll
                    for (int e = 0; e < 4; ++e) { const int r = row_of(dir, 64 * cidx + 16 * m + 4 * g + e); OL[(size_t)(r - C) * D + hc + 16 * w + fr] = oacc[m][e]; }
            }
        }
#undef HG_LOAD
        float* DS = (float*)(c.ws + WS_DS) + (size_t)item * 16384; float* DG = (float*)(c.ws + WS_DG) + item * 128;
#pragma unroll
        for (int m = 0; m < 8; ++m)
#pragma unroll
            for (int e = 0; e < 4; ++e) DS[(16 * m + 4 * g + e) * 128 + 16 * w + fr] = Sacc[m][e];
        if (w == 0) { DG[2 * lane] = dseg0; DG[2 * lane + 1] = dseg1; }
    }
}

__device__ __forceinline__ void phase_hgrn_fold(const Ctx& c) {
    const float* DS = (const float*)(c.ws + WS_DS); const float* DG = (const float*)(c.ws + WS_DG); bf16_t* SST = (bf16_t*)(c.ws + WS_SST);
    for (int item = c.wg; item < 256; item += c.nwg) {
        const int chain = item >> 4, slice = item & 15, d = 8 * slice + (c.tid >> 6), v2 = (c.tid & 63) * 2;
        float s0 = 0.f, s1 = 0.f;
        float dv[15]; hg::f32x2 ds[15];
#pragma unroll
        for (int sgi = 0; sgi < 15; ++sgi) { dv[sgi] = DG[(chain * 16 + sgi) * 128 + d]; ds[sgi] = *(const hg::f32x2*)(DS + ((size_t)(chain * 16 + sgi) * 128 + d) * 128 + v2); }
        SST[((size_t)(chain * 16) * 128 + v2) * 128 + d] = 0; SST[((size_t)(chain * 16) * 128 + v2 + 1) * 128 + d] = 0;
#pragma unroll
        for (int sgi = 0; sgi < 15; ++sgi) {
            s0 = dv[sgi] * s0 + ds[sgi][0]; s1 = dv[sgi] * s1 + ds[sgi][1];
            SST[((size_t)(chain * 16 + sgi + 1) * 128 + v2) * 128 + d] = (bf16_t)f2bf(s0); SST[((size_t)(chain * 16 + sgi + 1) * 128 + v2 + 1) * 128 + d] = (bf16_t)f2bf(s1);
        }
    }
}

__device__ __forceinline__ void phase_hgrn_readout(const Ctx& c) {
    const float* OF = (const float*)(c.ws + WS_OF); const float* OB = (const float*)(c.ws + WS_OB); const bf16_t* SGp = (const bf16_t*)(c.ws + WS_SG);
    const bf16_t* SST = (const bf16_t*)(c.ws + WS_SST); bf16_t* RR = (bf16_t*)(c.ws + WS_RR); const float* hng = c.a->in[13];
    const int lane = c.lane, fr = lane & 15, g = lane >> 4;
    for (int it = c.wg * 8 + c.wave; it < 8192; it += c.nwg * 8) {
        const int tt = it >> 3, h = it & 7, t0 = 16 * tt, ch = t0 >> 6;
        f32x4 acc[8];
#pragma unroll
        for (int n = 0; n < 8; ++n) acc[n] = (f32x4){0.f, 0.f, 0.f, 0.f};
#pragma unroll
        for (int dx = 0; dx < 2; ++dx) {
            const int sg = hg::seg_of(dx ? 4 + 255 - ch : 4 + ch);
            const bf16_t* QS = (const bf16_t*)(c.ws + (dx ? WS_QSB : WS_QSF)) + (size_t)(t0 + fr) * D + h * 128 + 8 * g;
            const bf16_t* ST = SST + ((size_t)((h * 2 + dx) * 16 + sg) * 128 + fr) * 128 + 8 * g;
#pragma unroll
            for (int ks = 0; ks < 4; ++ks) {
                const bf16x8 av = *(const bf16x8*)(QS + 32 * ks);
#pragma unroll
                for (int n = 0; n < 8; ++n) acc[n] = __builtin_amdgcn_mfma_f32_16x16x32_bf16(av, *(const bf16x8*)(ST + (size_t)(16 * n) * 128 + 32 * ks), acc[n], 0, 0, 0);
            }
        }
        float ss[4] = {0.f, 0.f, 0.f, 0.f};
#pragma unroll
        for (int n = 0; n < 8; ++n)
#pragma unroll
            for (int e = 0; e < 4; ++e) { const size_t o = (size_t)(t0 + 4 * g + e) * D + h * 128 + 16 * n + fr; const float v = acc[n][e] + OF[o] + OB[o]; acc[n][e] = v; ss[e] += v * v; }
#pragma unroll
        for (int e = 0; e < 4; ++e) {
#pragma unroll
            for (int sh = 8; sh > 0; sh >>= 1) ss[e] += __shfl_xor(ss[e], sh);
            ss[e] = rsqrtf(ss[e] * (1.f / 128.f) + EPS);
        }
#pragma unroll
        for (int n = 0; n < 8; ++n)
#pragma unroll
            for (int e = 0; e < 4; ++e) { const size_t o = (size_t)(t0 + 4 * g + e) * D + h * 128 + 16 * n + fr; RR[o] = (bf16_t)f2bf(acc[n][e] * ss[e] * hng[h * 128 + 16 * n + fr] * bf2f(SGp[o])); }
    }
}

__device__ __forceinline__ void phase_readout(const Ctx& c) {
    const float* OF = (const float*)(c.ws + WS_OF); const float* OB = (const float*)(c.ws + WS_OB); const bf16_t* SGp = (const bf16_t*)(c.ws + WS_SG);
    bf16_t* RR = (bf16_t*)(c.ws + WS_RR); const float* hng = c.a->in[13];
    for (int t = c.wg * 8 + c.wave; t < L; t += c.nwg * 8) {
        f32x4 a[4], b[4]; row_load(OF + (size_t)t * D, c.lane, a); row_load(OB + (size_t)t * D, c.lane, b);
#pragma unroll
        for (int j = 0; j < 4; ++j) {
            const f32x4 o = a[j] + b[j];
            float ss = o.x * o.x + o.y * o.y + o.z * o.z + o.w * o.w;
#pragma unroll
            for (int sh = 16; sh > 0; sh >>= 1) ss += __shfl_xor(ss, sh);
            const float rstd = rsqrtf(ss * (1.f / 128.f) + EPS);
            const int c0 = c.lane * 4 + 256 * j;
            const f32x4 g = *(const f32x4*)(hng + c0);
            const u32x2 sg = *(const u32x2*)(SGp + (size_t)t * D + c0);
            u32x2 ov; ov.x = pk2(o.x * rstd * g.x * bflo(sg.x), o.y * rstd * g.y * bfhi(sg.x)); ov.y = pk2(o.z * rstd * g.z * bflo(sg.y), o.w * rstd * g.w * bfhi(sg.y));
            *(u32x2*)(RR + (size_t)t * D + c0) = ov;
        }
    }
}

#define XB_TMO      128
#define XB_XCNT(j)  (256  + 64 * (j))
#define XB_XSUB(j)  (1280 + 64 * (j))
#define XB_XGEN(j)  (2304 + 64 * (j))
#define XB_TOP      3328
#define XB_TOPGEN   3392
#define XCD_BAR_WORDS 3456
#define XB_SPIN_CAP (1u << 18)
__device__ __forceinline__ unsigned xb_ld(unsigned* p)              { return __hip_atomic_load(p, __ATOMIC_RELAXED, __HIP_MEMORY_SCOPE_AGENT); }
__device__ __forceinline__ unsigned xb_add(unsigned* p, unsigned v) { return __hip_atomic_fetch_add(p, v, __ATOMIC_RELAXED, __HIP_MEMORY_SCOPE_AGENT); }
__device__ __forceinline__ unsigned xb_xcc_id() { return (unsigned)__builtin_amdgcn_s_getreg((3 << 11) | 20) & 0xFu; }
#define XB_SPIN(cond, bar) do { unsigned _sp = 0; while (cond) { __builtin_amdgcn_s_sleep(1); \
    if ((++_sp & 255u) == 0u) { if (xb_ld(&(bar)[XB_TMO])) break; if (_sp > XB_SPIN_CAP) { atomicAdd(&(bar)[XB_TMO], 1u); break; } } } } while (0)
struct XcdBarrier { unsigned* bar; unsigned x; volatile LAS unsigned* st; };
__device__ __forceinline__ XcdBarrier xcd_barrier_post(unsigned* bar, volatile LAS unsigned* st) {
    XcdBarrier b; b.bar = bar; b.x = xb_xcc_id(); b.st = st;
    if (threadIdx.x == 0) (void)xb_add(&bar[XB_XCNT(b.x)], 1u);
    return b;
}
__device__ __forceinline__ void xcd_barrier_complete(unsigned* bar, unsigned x, unsigned& nloc, unsigned& nx) {
    const unsigned G = gridDim.x * gridDim.y * gridDim.z;
    unsigned sum, cnt, mine, sp = 0u;
    for (;;) {
        sum = 0u; cnt = 0u; mine = 0u;
#pragma unroll
        for (unsigned j = 0; j < 16; ++j) { const unsigned c = xb_ld(&bar[XB_XCNT(j)]); sum += c; cnt += (c > 0u) ? 1u : 0u; mine = (j == x) ? c : mine; }
        if (sum == G) break;
        __builtin_amdgcn_s_sleep(1);
        if ((++sp & 255u) == 0u) { if (xb_ld(&bar[XB_TMO])) break; if (sp > XB_SPIN_CAP) { atomicAdd(&bar[XB_TMO], 1u); break; } }
    }
    nloc = mine > 0u ? mine : 1u; nx = cnt > 0u ? cnt : 1u;
}
__device__ __forceinline__ void xcd_barrier(const XcdBarrier& b) {
    asm volatile("s_waitcnt vmcnt(0)" ::: "memory");
    __syncthreads();
    if (threadIdx.x == 0) {
        unsigned* bar = b.bar;
        __builtin_amdgcn_s_waitcnt(0);
        unsigned nloc = b.st[0], nx = b.st[1];
        if (nloc == 0u) { xcd_barrier_complete(bar, b.x, nloc, nx); b.st[0] = nloc; b.st[1] = nx; }
        const unsigned old = xb_add(&bar[XB_XSUB(b.x)], 1u);
        const unsigned gen = old / nloc;
        if (old + 1u == (gen + 1u) * nloc) {
            __builtin_amdgcn_fence(__ATOMIC_RELEASE, "agent");
            asm volatile("s_waitcnt vmcnt(0)" ::: "memory");
            const unsigned og = xb_add(&bar[XB_TOP], 1u);
            const unsigned tg = og / nx;
            if (og + 1u == (tg + 1u) * nx) xb_add(&bar[XB_TOPGEN], 1u);
            else XB_SPIN(xb_ld(&bar[XB_TOPGEN]) == tg, bar);
            __builtin_amdgcn_fence(__ATOMIC_ACQUIRE, "agent");
            xb_add(&bar[XB_XGEN(b.x)], 1u);
            asm volatile("s_waitcnt vmcnt(0)" ::: "memory");
        } else {
            XB_SPIN(xb_ld(&bar[XB_XGEN(b.x)]) == gen, bar);
            __builtin_amdgcn_fence(__ATOMIC_ACQUIRE, "agent");
            asm volatile("s_waitcnt vmcnt(0)" ::: "memory");
        }
    }
    __syncthreads();
}

__device__ __forceinline__ void launder(Ctx& c) { asm volatile("" : "+s"(c.a)); asm volatile("" : "+s"(c.ws)); }
__global__ void __launch_bounds__(512, 2) mk_fwd(Args args) {
    extern __shared__ __attribute__((aligned(16))) unsigned char lds_raw[];
    Ctx c; c.a = (CArgs)__builtin_amdgcn_kernarg_segment_ptr(); c.lds = (LAS unsigned char*)lds_raw; c.tid = threadIdx.x; c.lane = c.tid & 63; c.wave = c.tid >> 6; c.nwg = gridDim.x; c.wg = blockIdx.x; c.ws = c.a->ws;
    volatile LAS unsigned* bst = (volatile LAS unsigned*)(c.lds + LDS_BYTES - 64);
    if (c.tid < 4) bst[c.tid] = 0u;
    __syncthreads();
    const XcdBarrier bar = xcd_barrier_post((unsigned*)(c.ws + WS_CTL) + CW_BAR, bst);
    const int lo = c.a->ph_lo, hi = c.a->ph_hi;
#define SEAM(k) do { if (lo <= (k) && (k) + 1 < hi) xcd_barrier(bar); } while (0)
#define IN(k) (lo <= (k) && (k) < hi && (launder(c), true))
    if (IN(0)) phase_prep(c);
    SEAM(0);
    if (IN(1)) phase_convert(c);
    SEAM(1);
    if (IN(2)) phase_gemm_f32(c, (const bf16_t*)(c.ws + WS_H), R, (const bf16_t*)(c.ws + WS_WQKV), QKVD, c.a->in[8], (float*)(c.ws + WS_RAW1));
    SEAM(2);
    if (IN(3)) phase_rope(c);
    SEAM(3);
    if (IN(4)) phase_attn_simple(c);
    SEAM(4);
    if (IN(5)) phase_gemm_f32(c, (const bf16_t*)(c.ws + WS_O), R, (const bf16_t*)(c.ws + WS_WO), D, nullptr, (float*)(c.ws + WS_RAW1));
    SEAM(5);
    if (IN(6)) phase_postmix(c, 0, 0, 0);
    SEAM(6);
    if (IN(7)) phase_moe_gu(c, 0);
    SEAM(7);
    if (IN(8)) phase_moe_dn(c, 0);
    SEAM(8);
    if (IN(9)) phase_combine(c, 0);
    SEAM(9);
    if (IN(10)) phase_gemm_f32(c, (const bf16_t*)(c.ws + WS_H), R, (const bf16_t*)(c.ws + WS_WIN), HIN, nullptr, (float*)(c.ws + WS_RAW1));
    SEAM(10);
    if (IN(11)) phase_hgrn_elem(c);
    SEAM(11);
    if (IN(12)) phase_hgrn_scan(c);
    SEAM(12);
    if (IN(13)) phase_hgrn_fold(c);
    SEAM(13);
    if (IN(14)) phase_hgrn_readout(c);
    SEAM(14);
    if (IN(15)) phase_gemm_f32(c, (const bf16_t*)(c.ws + WS_RR), L, (const bf16_t*)(c.ws + WS_WHO), D, nullptr, (float*)(c.ws + WS_RAW1));
    SEAM(15);
    if (IN(16)) phase_postmix(c, 1, C, C);
    SEAM(16);
    if (IN(17)) phase_moe_gu(c, 1);
    SEAM(17);
    if (IN(18)) phase_moe_dn(c, 1);
    SEAM(18);
    if (IN(19)) phase_combine(c, 1);
#undef IN
#undef SEAM
}

extern "C" void kernel_launch(void* const* d_in, const int* in_sizes, int n_in, void* d_out, int out_size, void* d_ws, size_t ws_size, hipStream_t stream) {
    static int grid = 0;
    if (grid == 0) {
        if (n_in != 21 || out_size != L * D || ws_size < WS_END) { fprintf(stderr, "kernel_launch: unexpected problem (n_in %d out %d ws %zu need %zu)\n", n_in, out_size, ws_size, (size_t)WS_END); grid = -1; return; }
        int dev = 0, cus = 0, per_cu = 0;
        hipGetDevice(&dev); hipDeviceGetAttribute(&cus, hipDeviceAttributeMultiprocessorCount, dev);
        if (hipFuncSetAttribute((const void*)mk_fwd, hipFuncAttributeMaxDynamicSharedMemorySize, LDS_BYTES) != hipSuccess) { fprintf(stderr, "kernel_launch: hipFuncSetAttribute failed\n"); grid = -1; return; }
        hipOccupancyMaxActiveBlocksPerMultiprocessor(&per_cu, (const void*)mk_fwd, 512, LDS_BYTES);
        if (per_cu < 1) fprintf(stderr, "kernel_launch: occupancy query says %d\n", per_cu);
        (void)hipGetLastError();
        grid = cus > 0 ? cus : 256;
    }
    if (grid < 0) return;
    hipMemsetAsync((char*)d_ws + WS_CTL, 0, MiB, stream);
    Args a{};
    for (int i = 0; i < 21; ++i) a.in[i] = (const float*)d_in[i];
    a.out = (float*)d_out; a.ws = (unsigned char*)d_ws;
    a.ph_lo = 0; a.ph_hi = NPHASE;
    hipLaunchKernelGGL(mk_fwd, dim3(grid), dim3(512), LDS_BYTES, stream, a);
}
```

```cpp
#include <hip/hip_runtime.h>
#include <cstdint>
#include <cstdio>

#define LAS __attribute__((address_space(3)))
typedef unsigned short bf16_t;
typedef short bf16x8 __attribute__((ext_vector_type(8)));
typedef float f32x4 __attribute__((ext_vector_type(4)));
typedef unsigned u32x4 __attribute__((ext_vector_type(4)));
typedef unsigned u32x2 __attribute__((ext_vector_type(2)));
typedef short v4i16_t __attribute__((ext_vector_type(4)));

constexpr int D = 1024, L = 16384, C = 256, R = L + C;
constexpr int QKVD = 1280, HIN = 5120, NE = 32, TOPK = 4;
constexpr int PADM = 256, MAXROWS = 74752;
constexpr float EPS = 1e-6f;
constexpr float LOG2E = 1.4426950408889634f;
constexpr int NPHASE = 20;
constexpr int LDS_BYTES = 147456;

constexpr size_t MiB = 1u << 20;
constexpr size_t al(size_t x) { return (x + MiB - 1) / MiB * MiB; }
constexpr size_t WS_CTL = 0;
constexpr size_t WS_MOD = WS_CTL + MiB;
constexpr size_t WS_X = WS_MOD + MiB;
constexpr size_t WS_H = WS_X + al((size_t)R * D * 4);
constexpr size_t WS_Q = WS_H + al((size_t)R * D * 2);
constexpr size_t WS_K = WS_Q + al((size_t)R * D * 2);
constexpr size_t WS_V = WS_K + al((size_t)R * 128 * 2);
constexpr size_t WS_O = WS_V + al((size_t)R * 128 * 2);
constexpr size_t WS_TK = WS_O + al((size_t)R * D * 2);
constexpr size_t WS_LIST = WS_TK + MiB;
constexpr size_t WS_HDN = WS_LIST + 3 * MiB;
constexpr size_t WS_RAW1 = WS_HDN + al((size_t)MAXROWS * 1024 * 2);
constexpr size_t WS_OUTB = WS_RAW1 + al((size_t)R * HIN * 4);
constexpr size_t WS_QH = WS_OUTB + al((size_t)MAXROWS * 1024 * 2);
constexpr size_t WS_KF = WS_QH + al((size_t)L * D * 2);
constexpr size_t WS_KB = WS_KF + al((size_t)R * D * 2);
constexpr size_t WS_IV = WS_KB + al((size_t)R * D * 2);
constexpr size_t WS_SG = WS_IV + al((size_t)R * D * 2);
constexpr size_t WS_OF = WS_SG + al((size_t)L * D * 2);
constexpr size_t WS_OB = WS_OF + al((size_t)L * D * 4);
constexpr size_t WS_RR = WS_OB + al((size_t)L * D * 4);
constexpr size_t WS_WQKV = WS_RR + al((size_t)L * D * 2);
constexpr size_t WS_WO = WS_WQKV + al((size_t)QKVD * D * 2);
constexpr size_t WS_WIN = WS_WO + al((size_t)D * D * 2);
constexpr size_t WS_WHO = WS_WIN + al((size_t)HIN * D * 2);
constexpr size_t WS_WGU = WS_WHO + al((size_t)D * D * 2);
constexpr size_t WS_WDN = WS_WGU + al((size_t)2 * NE * 2048 * D * 2);
constexpr size_t WS_QSF = WS_WDN + al((size_t)2 * NE * 1024 * D * 2);
constexpr size_t WS_QSB = WS_QSF + al((size_t)L * D * 2);
constexpr size_t WS_DS = WS_QSB + al((size_t)L * D * 2);
constexpr size_t WS_DG = WS_DS + al((size_t)256 * 128 * 128 * 4);
constexpr size_t WS_SST = WS_DG + MiB;
constexpr size_t WS_END = WS_SST + al((size_t)256 * 128 * 128 * 2);
static_assert(WS_END <= (size_t)2048 * MiB, "workspace map exceeds 4x the largest input");
constexpr int CW_CNT = 1024;
constexpr int CW_BAR = 4096;
constexpr int MOD_ROPE = 32768;
constexpr int MOD_LB = 49152;

struct Args { const float* in[21]; float* out; unsigned char* ws; int ph_lo, ph_hi; };

__device__ __forceinline__ unsigned f2bf(float f) { unsigned u = __float_as_uint(f); return (u + 0x7fffu + ((u >> 16) & 1u)) >> 16; }
__device__ __forceinline__ unsigned pk2(float lo, float hi) { return f2bf(lo) | (f2bf(hi) << 16); }
__device__ __forceinline__ float bflo(unsigned u) { return __uint_as_float(u << 16); }
__device__ __forceinline__ float bfhi(unsigned u) { return __uint_as_float(u & 0xffff0000u); }
__device__ __forceinline__ float bf2f(bf16_t b) { return __uint_as_float(((unsigned)b) << 16); }
__device__ __forceinline__ float wave_sum(float v) {
#pragma unroll
    for (int o = 32; o > 0; o >>= 1) v += __shfl_xor(v, o);
    return v;
}
__device__ __forceinline__ float silu_f(float x) { return x / (1.f + __expf(-x)); }
__device__ __forceinline__ float sigmoid_f(float x) { return 1.f / (1.f + __expf(-x)); }

typedef const __attribute__((address_space(4))) Args* CArgs;
struct Ctx {
    CArgs a;
    LAS unsigned char* lds;
    int tid, lane, wave, nwg, wg;
    unsigned char* ws;
    __device__ __forceinline__ float* modp(int layer, int which) const { return (float*)(ws + WS_MOD) + (layer * 2 + which) * 6144; }
    __device__ __forceinline__ const float* xin0(int r) const { return r < C ? a->in[2] + (size_t)r * D : a->in[0] + (size_t)(r - C) * D; }
};


namespace pg8 {
constexpr int BM = 256, BK = 64, HALF = 128, HTB = HALF * BK * 2, STAGE_BYTES = 8 * HTB, KD = 1024, NXCD = 8, WGM = 8;
__device__ __forceinline__ int lds_byte(int r, int c) { const int st = (r >> 4) * 2 + (c >> 5), rr = r & 15, cc = c & 31, ob = rr * 64 + cc * 2; return st * 1024 + (ob ^ (((ob >> 9) & 1) << 5)); }
__device__ __forceinline__ void stage_rc(int b, int& Rr, int& Cc) { const int st = b / 1024, sb = b % 1024, swz = sb ^ (((sb >> 9) & 1) << 5); Rr = (st >> 1) * 16 + swz / 64; Cc = (st & 1) * 32 + (swz % 64) / 2; }
__device__ __forceinline__ int perm32(int rho) { const int n = rho >> 4, i = rho & 15; return 8 * (i >> 2) + 4 * n + (i & 3); }

struct Unit { int pm, pn, e, goff, gcnt; };
struct Gemm { const bf16_t* A; const bf16_t* Bt; size_t bstride; const int* list; };

struct StaticOrder {
    int nM, nN, nwg, G, c;
    __device__ __forceinline__ void init(int M, int N, int G_, int c_) { nM = M / BM; nN = N / BM; nwg = nM * nN; G = G_; c = c_; }
    __device__ __forceinline__ bool next(int i, Unit& u) const {
        const long Lq = (long)i * G + c; if (Lq >= nwg) return false;
        int wgid = (int)Lq; { const int q = nwg / NXCD, r = nwg % NXCD, xcd = wgid % NXCD, off = wgid / NXCD; wgid = (xcd < r ? xcd * (q + 1) : r * (q + 1) + (xcd - r) * q) + off; }
        const int nig = WGM * nN, gid = wgid / nig, fm = gid * WGM, gsz = (nM - fm) < WGM ? (nM - fm) : WGM;
        u.pm = fm + ((wgid % nig) % gsz); u.pn = (wgid % nig) / gsz; u.e = 0; u.goff = 0; u.gcnt = 0; return true;
    }
};
struct MoeOrder {
    const LAS int* tp; const LAS int* cnt; int npn, G, vcu;
    __device__ __forceinline__ bool next(int i, Unit& u) const {
        const int lin = i * G + vcu; if (lin >= tp[32] * npn) return false;
        const int rt = lin / npn; int e = 0;
#pragma unroll 8
        for (int k = 1; k < 32; ++k) e += (rt >= tp[k]) ? 1 : 0;
        const int mt = rt - tp[e];
        u.pm = rt; u.pn = lin - rt * npn; u.e = e; u.goff = e * R + mt * 256; u.gcnt = cnt[e] - mt * 256; return true;
    }
};

__device__ __forceinline__ void a_offsets(const Gemm& g, const Unit& u, const int (&sR)[2], const int (&sC)[2], unsigned (&v)[2][2]) {
#pragma unroll
    for (int h = 0; h < 2; ++h)
#pragma unroll
        for (int i = 0; i < 2; ++i) {
            const int rr = h * HALF + sR[i]; int row;
            if (g.list) row = rr < u.gcnt ? g.list[u.goff + rr] : 0; else row = u.pm * BM + rr;
            v[h][i] = (unsigned)(row * KD + sC[i]) * 2u;
        }
}

struct EpiF32 {
    static constexpr bool PERM = false;
    float* Cp; int ldc; const float* bias;
    __device__ __forceinline__ void operator()(const f32x4 (&acc)[2][2][4][2], const Unit& u, int wr, int wc, int fr, int fq) const {
        const int row0 = u.pm * BM + wr * 64 + fr, col0 = u.pn * BM + wc * 32 + 4 * fq;
#pragma unroll
        for (int bj = 0; bj < 2; ++bj)
#pragma unroll
            for (int n = 0; n < 2; ++n) {
                const int col = col0 + bj * HALF + n * 16;
                const f32x4 bv = bias ? *(const f32x4*)(bias + col) : (f32x4){0.f, 0.f, 0.f, 0.f};
#pragma unroll
                for (int ai = 0; ai < 2; ++ai)
#pragma unroll
                    for (int m = 0; m < 4; ++m) *(f32x4*)(Cp + (size_t)(row0 + ai * HALF + m * 16) * ldc + col) = acc[ai][bj][m][n] + bv;
            }
    }
};
struct EpiSwiglu {
    static constexpr bool PERM = false;
    bf16_t* Hd; const float* bgu;
    __device__ __forceinline__ void operator()(const f32x4 (&acc)[2][2][4][2], const Unit& u, int wr, int wc, int fr, int fq) const {
        const int row0 = u.pm * BM + wr * 64 + fr, cg0 = u.pn * HALF + wc * 32 + 4 * fq;
        const float* bb = bgu + (size_t)u.e * 2048;
#pragma unroll
        for (int n = 0; n < 2; ++n) {
            const int cg = cg0 + n * 16;
            const f32x4 bg = *(const f32x4*)(bb + cg), bu = *(const f32x4*)(bb + 1024 + cg);
#pragma unroll
            for (int ai = 0; ai < 2; ++ai)
#pragma unroll
                for (int m = 0; m < 4; ++m) {
                    const f32x4 gv = acc[ai][0][m][n] + bg, uv = acc[ai][1][m][n] + bu; float hv[4];
#pragma unroll
                    for (int q = 0; q < 4; ++q) { const float gg = fminf(gv[q], 7.f), uu = fminf(fmaxf(uv[q], -7.f), 7.f); hv[q] = gg * (1.f / (1.f + __expf(-1.702f * gg))) * (uu + 1.f); }
                    u32x2 o; o.x = pk2(hv[0], hv[1]); o.y = pk2(hv[2], hv[3]);
                    *(u32x2*)(Hd + (size_t)(row0 + ai * HALF + m * 16) * 1024 + cg) = o;
                }
        }
    }
};
struct EpiBf16Bias {
    static constexpr bool PERM = false;
    bf16_t* Op; const float* bias; int bias_estride;
    __device__ __forceinline__ void operator()(const f32x4 (&acc)[2][2][4][2], const Unit& u, int wr, int wc, int fr, int fq) const {
        const int row0 = u.pm * BM + wr * 64 + fr, col0 = u.pn * BM + wc * 32 + 4 * fq;
        const float* bb = bias + (size_t)u.e * bias_estride;
#pragma unroll
        for (int bj = 0; bj < 2; ++bj)
#pragma unroll
            for (int n = 0; n < 2; ++n) {
                const int col = col0 + bj * HALF + n * 16;
                const f32x4 bv = *(const f32x4*)(bb + col);
#pragma unroll
                for (int ai = 0; ai < 2; ++ai)
#pragma unroll
                    for (int m = 0; m < 4; ++m) { const f32x4 v = acc[ai][bj][m][n] + bv; u32x2 o; o.x = pk2(v[0], v[1]); o.y = pk2(v[2], v[3]);
                        *(u32x2*)(Op + (size_t)(row0 + ai * HALF + m * 16) * 1024 + col) = o; }
            }
    }
};

template <class Epi, class Sched, bool ALIGN_EPI>
__device__ __forceinline__ void gemm_phase(LAS unsigned char* lds, const Gemm g, const Sched& S, const Epi& E) {
    const int tid = threadIdx.x, wid = __builtin_amdgcn_readfirstlane(tid >> 6), lane = tid & 63, wr = wid >> 2, wc = wid & 3, fr = lane & 15, fq = lane >> 4;
    constexpr int K = KD, nt = K / BK;
    int sR[2], sC[2]; unsigned voffB[2];
#pragma unroll
    for (int i = 0; i < 2; ++i) { stage_rc(tid * 16 + i * 8192, sR[i], sC[i]); const int Rb = Epi::PERM ? ((sR[i] & ~31) + perm32(sR[i] & 31)) : sR[i]; voffB[i] = (unsigned)(Rb * K + sC[i]) * 2u; }
    constexpr size_t kstep = (size_t)(BK * 2), hstep = (size_t)HALF * K * 2, tstep = 2 * hstep;
    const unsigned ldsw = (unsigned)wid * 1024u;
    const int aoff = lds_byte(wr * 64 + fr, fq * 8), boff = lds_byte(wc * 32 + fr, fq * 8);
    const char* Ab = (const char*)g.A;
#define PG8_SA(b, h) (((b) * 2 + (h)) * HTB)
#define PG8_SB(b, h) ((4 + (b) * 2 + (h)) * HTB)
#define PG8_STAGE_B(bufoff, gbase) do { _Pragma("unroll") for (int _i = 0; _i < 2; ++_i) \
        __builtin_amdgcn_global_load_lds((const unsigned*)((const char*)(gbase) + voffB[_i]), (LAS unsigned*)(lds + (bufoff) + ldsw + _i * 8192), 16, 0, 0); } while (0)
#define PG8_STAGE_A(bufoff, kb, v) do { _Pragma("unroll") for (int _i = 0; _i < 2; ++_i) \
        __builtin_amdgcn_global_load_lds((const unsigned*)(Ab + (size_t)(kb) + (v)[_i]), (LAS unsigned*)(lds + (bufoff) + ldsw + _i * 8192), 16, 0, 0); } while (0)
#define PG8_LDA(dst, b, h) do { _Pragma("unroll") for (int m = 0; m < 4; ++m) _Pragma("unroll") for (int k = 0; k < 2; ++k) dst[m][k] = *(const LAS bf16x8*)(lds + PG8_SA(b, h) + aoff + m * 2048 + k * 1024); } while (0)
#define PG8_LDB(dst, b, h) do { _Pragma("unroll") for (int n = 0; n < 2; ++n) _Pragma("unroll") for (int k = 0; k < 2; ++k) dst[n][k] = *(const LAS bf16x8*)(lds + PG8_SB(b, h) + boff + n * 2048 + k * 1024); } while (0)
#define PG8_MMA(ai, bj, At, Bt) do { __builtin_amdgcn_s_setprio(1); _Pragma("unroll") for (int m = 0; m < 4; ++m) _Pragma("unroll") for (int n = 0; n < 2; ++n) _Pragma("unroll") for (int k = 0; k < 2; ++k) \
        acc[ai][bj][m][n] = __builtin_amdgcn_mfma_f32_16x16x32_bf16(Bt[n][k], At[m][k], acc[ai][bj][m][n], 0, 0, 0); __builtin_amdgcn_s_setprio(0); } while (0)
#define PG8_WAIT_V(n) asm volatile("s_waitcnt vmcnt(" #n ")" ::: "memory")
#define PG8_WAIT_L(n) asm volatile("s_waitcnt lgkmcnt(" #n ")" ::: "memory")
#define PG8_BAR __builtin_amdgcn_s_barrier()
#define PG8_SCHED __builtin_amdgcn_sched_barrier(0)
    Unit cur, nxt; int ui = 0;
    if (!S.next(0, cur)) return;
    unsigned cv[2][2], nv[2][2];
    a_offsets(g, cur, sR, sC, cv);
    f32x4 acc[2][2][4][2];
#pragma unroll
    for (int a = 0; a < 2; ++a)
#pragma unroll
        for (int b = 0; b < 2; ++b)
#pragma unroll
            for (int m = 0; m < 4; ++m)
#pragma unroll
                for (int n = 0; n < 2; ++n) acc[a][b][m][n] = (f32x4){0.f, 0.f, 0.f, 0.f};
    bf16x8 At[4][2], B0[2][2], B1[2][2];
    const char* cB = (const char*)g.Bt + ((size_t)cur.e * g.bstride) * 2 + (size_t)cur.pn * tstep;
    PG8_STAGE_B(PG8_SB(0, 0), cB); PG8_STAGE_B(PG8_SB(0, 1), cB + hstep); PG8_STAGE_A(PG8_SA(0, 0), 0, cv[0]); PG8_STAGE_A(PG8_SA(0, 1), 0, cv[1]);
    if (wr == 1) PG8_BAR;
    PG8_WAIT_V(2); PG8_BAR;
    PG8_STAGE_B(PG8_SB(1, 0), cB + kstep); PG8_STAGE_A(PG8_SA(1, 0), kstep, cv[0]); PG8_STAGE_B(PG8_SB(1, 1), cB + hstep + kstep);
    PG8_WAIT_V(6); PG8_BAR;
    for (;;) {
        const bool has_next = S.next(ui + 1, nxt);
        const char* nB = cB;
        if (has_next) { a_offsets(g, nxt, sR, sC, nv); nB = (const char*)g.Bt + ((size_t)nxt.e * g.bstride) * 2 + (size_t)nxt.pn * tstep; }
        else {
#pragma unroll
            for (int h = 0; h < 2; ++h)
#pragma unroll
                for (int i = 0; i < 2; ++i) nv[h][i] = cv[h][i];
        }
        for (int t = 0; t < nt; t += 2) {
            const bool last = (t == nt - 2);
            const size_t k1 = (size_t)(t + 1) * kstep, k2 = last ? 0 : (size_t)(t + 2) * kstep, k3 = k2 + kstep;
            const char* b2 = last ? nB : cB + (size_t)(t + 2) * kstep; const char* b3 = b2 + kstep;
            unsigned w0[2], w1[2];
#pragma unroll
            for (int i = 0; i < 2; ++i) { w0[i] = last ? nv[0][i] : cv[0][i]; w1[i] = last ? nv[1][i] : cv[1][i]; }
            PG8_LDB(B0, 0, 0); PG8_LDB(B1, 0, 1); PG8_SCHED; PG8_LDA(At, 0, 0); PG8_STAGE_A(PG8_SA(1, 1), k1, cv[1]);
            PG8_WAIT_V(8); PG8_WAIT_L(0); PG8_BAR; PG8_MMA(0, 0, At, B0); PG8_MMA(0, 1, At, B1); PG8_BAR; PG8_SCHED;
            PG8_LDA(At, 0, 1); PG8_STAGE_B(PG8_SB(0, 0), b2); PG8_STAGE_B(PG8_SB(0, 1), b2 + hstep); PG8_STAGE_A(PG8_SA(0, 0), k2, w0);
            PG8_WAIT_V(8); PG8_WAIT_L(0); PG8_BAR; PG8_MMA(1, 0, At, B0); PG8_MMA(1, 1, At, B1); PG8_BAR; PG8_SCHED;
            PG8_LDB(B0, 1, 0); PG8_LDB(B1, 1, 1); PG8_SCHED; PG8_LDA(At, 1, 0); PG8_STAGE_A(PG8_SA(0, 1), k2, w1);
            PG8_WAIT_V(8); PG8_WAIT_L(0); PG8_BAR; PG8_MMA(0, 0, At, B0); PG8_MMA(0, 1, At, B1); PG8_BAR; PG8_SCHED;
            PG8_LDA(At, 1, 1); PG8_STAGE_B(PG8_SB(1, 0), b3); PG8_STAGE_B(PG8_SB(1, 1), b3 + hstep); PG8_STAGE_A(PG8_SA(1, 0), k3, w0);
            PG8_WAIT_V(8); PG8_WAIT_L(0); PG8_BAR; PG8_MMA(1, 0, At, B0); PG8_MMA(1, 1, At, B1); PG8_BAR; PG8_SCHED;
        }
        if constexpr (ALIGN_EPI) { if (wr == 0) PG8_BAR; }
        E(acc, cur, wr, wc, fr, fq);
        if (!has_next) break;
#pragma unroll
        for (int a = 0; a < 2; ++a)
#pragma unroll
            for (int b = 0; b < 2; ++b)
#pragma unroll
                for (int m = 0; m < 4; ++m)
#pragma unroll
                    for (int n = 0; n < 2; ++n) acc[a][b][m][n] = (f32x4){0.f, 0.f, 0.f, 0.f};
        cur = nxt; cB = nB; ++ui;
#pragma unroll
        for (int h = 0; h < 2; ++h)
#pragma unroll
            for (int i = 0; i < 2; ++i) cv[h][i] = nv[h][i];
        if constexpr (ALIGN_EPI) { if (wr == 1) PG8_BAR; }
    }
    PG8_WAIT_V(0);
    if constexpr (!ALIGN_EPI) { if (wr == 0) PG8_BAR; }
    PG8_BAR;
#undef PG8_SA
#undef PG8_SB
#undef PG8_STAGE_A
#undef PG8_STAGE_B
#undef PG8_LDA
#undef PG8_LDB
#undef PG8_MMA
#undef PG8_WAIT_V
#undef PG8_WAIT_L
#undef PG8_BAR
#undef PG8_SCHED
}
}

__device__ __forceinline__ void transpose_block(const float* W, int ldw, int n0, int k0, bf16_t* WTrow0  , LAS float* scr, int lane) {
    f32x4 v[16];
    const float* src = W + (size_t)(k0 + (lane >> 4)) * ldw + n0 + (lane & 15) * 4;
#pragma unroll
    for (int i = 0; i < 16; ++i) v[i] = *(const f32x4*)(src + (size_t)(4 * i) * ldw);
#pragma unroll
    for (int i = 0; i < 16; ++i) { LAS float* d = scr + ((lane >> 4) + 4 * i) * 65 + (lane & 15) * 4; d[0] = v[i].x; d[1] = v[i].y; d[2] = v[i].z; d[3] = v[i].w; }
    asm volatile("s_waitcnt lgkmcnt(0)" ::: "memory"); __builtin_amdgcn_wave_barrier();
    const int c8 = lane & 7;
#pragma unroll
    for (int jj = 0; jj < 8; ++jj) {
        const int n = (lane >> 3) + 8 * jj; const LAS float* p = scr + (8 * c8) * 65 + n;
        u32x4 o; o.x = pk2(p[0], p[65]); o.y = pk2(p[2 * 65], p[3 * 65]); o.z = pk2(p[4 * 65], p[5 * 65]); o.w = pk2(p[6 * 65], p[7 * 65]);
        *(u32x4*)(WTrow0 + (size_t)n * 1024 + k0 + 8 * c8) = o;
    }
    asm volatile("s_waitcnt lgkmcnt(0)" ::: "memory"); __builtin_amdgcn_wave_barrier();
}

__device__ __forceinline__ void phase_prep(const Ctx& c) {
    LAS float* red = (LAS float*)c.lds;
    const float* cv = c.a->in[1]; const float* ccv = c.a->in[3]; const float* ada_w = c.a->in[4]; const float* ada_b = c.a->in[5];
    for (int item = c.wg; item < 193; item += c.nwg) {
        if (item < 192) {
            const int layer = item / 96, cb = item % 96, col = cb * 64 + c.lane;
            const float* W = ada_w + (size_t)layer * D * 6144 + col;
            float a0 = 0.f, a1 = 0.f;
            const int k0 = c.wave * 128;
#pragma unroll 8
            for (int k = 0; k < 128; ++k) { const float w = W[(size_t)(k0 + k) * 6144]; a0 += silu_f(cv[k0 + k]) * w; a1 += silu_f(ccv[k0 + k]) * w; }
            red[(0 * 8 + c.wave) * 64 + c.lane] = a0; red[(1 * 8 + c.wave) * 64 + c.lane] = a1;
            __syncthreads();
            if (c.tid < 128) {
                const int which = c.tid >> 6, l = c.tid & 63; float s = 0.f;
#pragma unroll
                for (int w = 0; w < 8; ++w) s += red[(which * 8 + w) * 64 + l];
                c.modp(layer, which)[cb * 64 + l] = s + ada_b[layer * 6144 + cb * 64 + l];
            }
            __syncthreads();
        } else {
            float* modbase = (float*)(c.ws + WS_MOD);
            for (int i = c.tid; i < 4096; i += 512) {
                const int pos = i >> 4, j = i & 15;
                const double ang = (double)pos * pow(10000.0, -(double)j / 16.0);
                modbase[MOD_ROPE + 2 * i] = (float)cos(ang); modbase[MOD_ROPE + 2 * i + 1] = (float)sin(ang);
            }
            const float* lbp = c.a->in[12];
            for (int i = c.tid; i < 2048; i += 512) { const float p0 = lbp[i], p1 = lbp[2048 + i]; modbase[MOD_LB + i] = 1.f / (1.f + __expf(p0 - p1)); }
        }
    }
}

__device__ __forceinline__ void row_load(const float* p, int lane, f32x4 (&v)[4]) {
#pragma unroll
    for (int j = 0; j < 4; ++j) v[j] = *(const f32x4*)(p + lane * 4 + 256 * j);
}
__device__ __forceinline__ float row_ss(const f32x4 (&v)[4]) {
    float s = 0.f;
#pragma unroll
    for (int j = 0; j < 4; ++j) s += v[j].x * v[j].x + v[j].y * v[j].y + v[j].z * v[j].z + v[j].w * v[j].w;
    return wave_sum(s);
}
__device__ __forceinline__ void row_modnorm_store(const f32x4 (&x)[4], float rstd, const float* g, const float* sh, const float* sc, bf16_t* out, int lane, f32x4 (*hout)[4] = nullptr) {
#pragma unroll
    for (int j = 0; j < 4; ++j) {
        const int c0 = lane * 4 + 256 * j;
        const f32x4 gv = *(const f32x4*)(g + c0), shv = *(const f32x4*)(sh + c0), scv = *(const f32x4*)(sc + c0);
        f32x4 h;
        h.x = x[j].x * rstd * gv.x * (1.f + scv.x) + shv.x; h.y = x[j].y * rstd * gv.y * (1.f + scv.y) + shv.y;
        h.z = x[j].z * rstd * gv.z * (1.f + scv.z) + shv.z; h.w = x[j].w * rstd * gv.w * (1.f + scv.w) + shv.w;
        if (hout) (*hout)[j] = h;
        u32x2 o; o.x = pk2(h.x, h.y); o.y = pk2(h.z, h.w);
        *(u32x2*)(out + c0) = o;
    }
}

__device__ __forceinline__ void phase_norm0(const Ctx& c) {
    bf16_t* H = (bf16_t*)(c.ws + WS_H); const float* ng = c.a->in[6];
    for (int r = c.wg * 8 + c.wave; r < R; r += c.nwg * 8) {
        f32x4 x[4]; row_load(c.xin0(r), c.lane, x);
        const float rstd = rsqrtf(row_ss(x) * (1.f / D) + EPS);
        const float* m = c.modp(0, r < C ? 1 : 0);
        row_modnorm_store(x, rstd, ng, m + 0, m + 1024, H + (size_t)r * D, c.lane);
    }
}

__device__ __forceinline__ void phase_rope(const Ctx& c) {
    const float* raw = (const float*)(c.ws + WS_RAW1); const float* tab = (const float*)(c.ws + WS_MOD) + MOD_ROPE;
    bf16_t* Q = (bf16_t*)(c.ws + WS_Q); bf16_t* K = (bf16_t*)(c.ws + WS_K); bf16_t* V = (bf16_t*)(c.ws + WS_V);
    const float qs = 0.125f * LOG2E;
    for (int r = c.wg * 8 + c.wave; r < R; r += c.nwg * 8) {
        const float* row = raw + (size_t)r * QKVD;
        const bool lat = r >= C; const int t = r - C;
        for (int col = c.lane; col < QKVD; col += 64) {
            float val = row[col];
            if (col < 1152 && lat) {
                const int within = col & 63, half = within >> 5, part = (within >> 4) & 1, j = within & 15;
                const int pos = half == 0 ? (t >> 6) : (t & 63);
                const float cs = tab[2 * (pos * 16 + j)], sn = tab[2 * (pos * 16 + j) + 1];
                const float x1 = part == 0 ? val : row[col - 16], x2 = part == 0 ? row[col + 16] : val;
                val = part == 0 ? (x1 * cs - x2 * sn) : (x2 * cs + x1 * sn);
            }
            if (col < 1024) Q[(size_t)r * D + col] = (bf16_t)f2bf(val * qs);
            else if (col < 1152) K[(size_t)r * 128 + (col - 1024)] = (bf16_t)f2bf(val);
            else V[(size_t)r * 128 + (col - 1152)] = (bf16_t)f2bf(val);
        }
    }
}

namespace at {
constexpr int KP = 144, TILEB = 64 * KP;
__device__ __forceinline__ bf16x8 tr_frag2(const LAS unsigned char* tile, int row0, int col0, int lane) {
    const int q = (lane & 15) >> 2, p = lane & 3;
    const LAS unsigned char* a = tile + (row0 + q) * KP + (col0 + 4 * p) * 2;
    const v4i16_t lo = __builtin_amdgcn_ds_read_tr16_b64_v4i16((LAS v4i16_t*)a);
    const v4i16_t hi = __builtin_amdgcn_ds_read_tr16_b64_v4i16((LAS v4i16_t*)(a + 16 * KP));
    return (bf16x8){lo[0], lo[1], lo[2], lo[3], hi[0], hi[1], hi[2], hi[3]};
}
}
__device__ __forceinline__ void phase_attn(const Ctx& c) {
    using namespace at;
    const bf16_t* Q = (const bf16_t*)(c.ws + WS_Q); const bf16_t* K = (const bf16_t*)(c.ws + WS_K); const bf16_t* V = (const bf16_t*)(c.ws + WS_V);
    bf16_t* O = (bf16_t*)(c.ws + WS_O); const float* sink = c.a->in[9];
    LAS unsigned char* lds = c.lds;
    const int tid = c.tid, lane = c.lane, w = __builtin_amdgcn_readfirstlane(tid >> 6), fr = lane & 15, g = lane >> 4;
    const int lrow = tid >> 3, lch = tid & 7;
    for (int item = c.wg; item < 264; item += c.nwg) {
        const bool isctx = item >= 256;
        const int ci = item - 256;
        const int n = isctx ? 0 : (item >> 1), kh = isctx ? ((ci >> 1) & 1) : (item & 1), cb = isctx ? (ci >> 2) : 0;
        const int p_lo = isctx ? (ci & 1) : 0, p_hi = isctx ? (ci & 1) + 1 : 2;
        const int hq = kh * 8 + w;
        const float sink2 = sink[hq] * LOG2E;
        for (int pass = p_lo; pass < p_hi; ++pass) {
            const int t0 = 128 * n + 64 * pass, qrow0 = isctx ? cb * 128 + 64 * pass : C + t0;
            const int jlo = isctx ? 0 : (t0 >= 128 ? 0 : (128 - t0) / 64), jhi = isctx ? 0 : ((L - t0 + 128) / 64 < 5 ? (L - t0 + 128) / 64 : 5);
            const int ntile = 4 + (jhi - jlo);
            bf16x8 Qf[4][2];
#pragma unroll
            for (int qb = 0; qb < 4; ++qb)
#pragma unroll
                for (int ks = 0; ks < 2; ++ks) Qf[qb][ks] = *(const bf16x8*)(Q + (size_t)(qrow0 + 16 * qb + fr) * D + hq * 64 + 32 * ks + 8 * g);
            float mrow[4], lsum[4]; f32x4 OT[4][4];
#pragma unroll
            for (int qb = 0; qb < 4; ++qb) { mrow[qb] = sink2; lsum[qb] = 1.f;
#pragma unroll
                for (int nt = 0; nt < 4; ++nt) OT[qb][nt] = (f32x4){0.f, 0.f, 0.f, 0.f}; }
            u32x4 kreg, vreg;
#define AT_KROW(ti) ((ti) < 4 ? 64 * (ti) : C + t0 - 128 + 64 * (jlo + (ti) - 4))
#define AT_LOAD(ti) do { const size_t ro_ = (size_t)(AT_KROW(ti) + lrow) * 128 + kh * 64 + lch * 8; kreg = *(const u32x4*)(K + ro_); vreg = *(const u32x4*)(V + ro_); } while (0)
#define AT_WRITE(buf) do { *(LAS u32x4*)(lds + (buf) * 2 * TILEB + lrow * KP + lch * 16) = kreg; *(LAS u32x4*)(lds + (buf) * 2 * TILEB + TILEB + lrow * KP + lch * 16) = vreg; } while (0)
            AT_LOAD(0); AT_WRITE(0);
            __syncthreads();
            for (int ti = 0; ti < ntile; ++ti) {
                if (ti + 1 < ntile) AT_LOAD(ti + 1);
                const LAS unsigned char* kb = lds + (ti & 1) * 2 * TILEB; const LAS unsigned char* vb = kb + TILEB;
                const int jj = jlo + ti - 4; const bool masked = (ti >= 4) && (jj == 0 || jj == 4);
                const int k0 = t0 - 128 + 64 * jj;
                bf16x8 Kf[4][2], Vf[4][2];
#pragma unroll
                for (int mt = 0; mt < 4; ++mt)
#pragma unroll
                    for (int ks = 0; ks < 2; ++ks) { Kf[mt][ks] = *(const LAS bf16x8*)(kb + (16 * mt + fr) * KP + (32 * ks + 8 * g) * 2); Vf[mt][ks] = tr_frag2(vb, 32 * ks + 4 * g, 16 * mt, lane); }
#pragma unroll
                for (int qb = 0; qb < 4; ++qb) {
                    f32x4 sa[4];
#pragma unroll
                    for (int mt = 0; mt < 4; ++mt) { sa[mt] = (f32x4){0.f, 0.f, 0.f, 0.f};
#pragma unroll
                        for (int ks = 0; ks < 2; ++ks) sa[mt] = __builtin_amdgcn_mfma_f32_16x16x32_bf16(Kf[mt][ks], Qf[qb][ks], sa[mt], 0, 0, 0); }
                    if (masked) {
                        const int tq = t0 + 16 * qb + fr;
#pragma unroll
                        for (int mt = 0; mt < 4; ++mt)
#pragma unroll
                            for (int e = 0; e < 4; ++e) { const int dt = tq - (k0 + 16 * mt + 4 * g + e); if (dt > 128 || dt < -128) sa[mt][e] = -INFINITY; }
                    }
                    float mx = fmaxf(fmaxf(sa[0][0], sa[0][1]), fmaxf(sa[0][2], sa[0][3]));
#pragma unroll
                    for (int mt = 1; mt < 4; ++mt) mx = fmaxf(mx, fmaxf(fmaxf(sa[mt][0], sa[mt][1]), fmaxf(sa[mt][2], sa[mt][3])));
                    mx = fmaxf(mx, __shfl_xor(mx, 16)); mx = fmaxf(mx, __shfl_xor(mx, 32));
                    const float mn = fmaxf(mrow[qb], mx), alpha = __builtin_amdgcn_exp2f(mrow[qb] - mn);
                    mrow[qb] = mn;
                    float rs = 0.f;
#pragma unroll
                    for (int mt = 0; mt < 4; ++mt)
#pragma unroll
                        for (int e = 0; e < 4; ++e) { const float pv = __builtin_amdgcn_exp2f(sa[mt][e] - mn); sa[mt][e] = pv; rs += pv; }
                    rs += __shfl_xor(rs, 16); rs += __shfl_xor(rs, 32);
                    lsum[qb] = lsum[qb] * alpha + rs;
                    bf16x8 Pb[2];
#pragma unroll
                    for (int ks = 0; ks < 2; ++ks) { const f32x4 a0 = sa[2 * ks], a1 = sa[2 * ks + 1];
                        const u32x4 pk = (u32x4){pk2(a0[0], a0[1]), pk2(a0[2], a0[3]), pk2(a1[0], a1[1]), pk2(a1[2], a1[3])}; Pb[ks] = __builtin_bit_cast(bf16x8, pk); }
#pragma unroll
                    for (int nt = 0; nt < 4; ++nt) { OT[qb][nt] = OT[qb][nt] * alpha;
#pragma unroll
                        for (int ks = 0; ks < 2; ++ks) OT[qb][nt] = __builtin_amdgcn_mfma_f32_16x16x32_bf16(Vf[nt][ks], Pb[ks], OT[qb][nt], 0, 0, 0); }
                }
                if (ti + 1 < ntile) AT_WRITE((ti + 1) & 1);
                __syncthreads();
            }
#undef AT_KROW
#undef AT_LOAD
#undef AT_WRITE
#pragma unroll
            for (int qb = 0; qb < 4; ++qb) {
                const float il = 1.f / lsum[qb];
                bf16_t* op = O + (size_t)(qrow0 + 16 * qb + fr) * D + hq * 64 + 4 * g;
#pragma unroll
                for (int nt = 0; nt < 4; ++nt) { const f32x4 v = OT[qb][nt] * il; u32x2 o; o.x = pk2(v[0], v[1]); o.y = pk2(v[2], v[3]); *(u32x2*)(op + 16 * nt) = o; }
            }
        }
    }
}

__device__ __forceinline__ void phase_postmix(const Ctx& c, int layer, int r_lo, int yoff) {
    const float* Y = (const float*)(c.ws + WS_RAW1); float* X = (float*)(c.ws + WS_X); bf16_t* H = (bf16_t*)(c.ws + WS_H);
    const float* ng = c.a->in[6] + layer * 4 * D; const float* Wr = c.a->in[15] + (size_t)layer * D * NE; const float* br = c.a->in[16] + layer * NE;
    unsigned* cnt = (unsigned*)(c.ws + WS_CTL) + CW_CNT + layer * NE;
    int* tk_e = (int*)(c.ws + WS_TK); float* tk_g = (float*)(c.ws + WS_TK) + R * 4; int* tk_slot = (int*)(c.ws + WS_TK) + 2 * R * 4;
    int* list = (int*)(c.ws + WS_LIST);
    LAS float* pr = (LAS float*)c.lds + c.wave * (64 * 33);
    LAS float* hrow = (LAS float*)c.lds + 8 * 64 * 33 + c.wave * 1024;
    for (int r = r_lo + c.wg * 8 + c.wave; r < R; r += c.nwg * 8) {
        const float* m = c.modp(layer, r < C ? 1 : 0);
        const float* xsrc = layer == 0 ? c.xin0(r) : X + (size_t)r * D;
        f32x4 y[4], x[4]; row_load(Y + (size_t)(r - yoff) * D, c.lane, y); row_load(xsrc, c.lane, x);
        const float rstd_y = rsqrtf(row_ss(y) * (1.f / D) + EPS);
#pragma unroll
        for (int j = 0; j < 4; ++j) {
            const int c0 = c.lane * 4 + 256 * j;
            const f32x4 g1 = *(const f32x4*)(m + 2048 + c0), n1 = *(const f32x4*)(ng + D + c0);
            x[j].x += g1.x * (y[j].x * rstd_y * n1.x); x[j].y += g1.y * (y[j].y * rstd_y * n1.y);
            x[j].z += g1.z * (y[j].z * rstd_y * n1.z); x[j].w += g1.w * (y[j].w * rstd_y * n1.w);
            *(f32x4*)(X + (size_t)r * D + c0) = x[j];
        }
        const float rstd_x = rsqrtf(row_ss(x) * (1.f / D) + EPS);
        f32x4 h[4];
        row_modnorm_store(x, rstd_x, ng + 2 * D, m + 3072, m + 4096, H + (size_t)r * D, c.lane, &h);
#pragma unroll
        for (int j = 0; j < 4; ++j) *(LAS f32x4*)(hrow + c.lane * 4 + 256 * j) = h[j];
        float p[32];
#pragma unroll
        for (int e = 0; e < 32; ++e) p[e] = 0.f;
#pragma unroll 2
        for (int k = 0; k < 16; ++k) {
            const int col = c.lane * 4 + 256 * (k >> 2) + (k & 3);
            const float hv = hrow[col]; const f32x4* wrow = (const f32x4*)(Wr + (size_t)col * NE);
#pragma unroll
            for (int e4 = 0; e4 < 8; ++e4) { const f32x4 wv = wrow[e4]; p[4 * e4] += hv * wv.x; p[4 * e4 + 1] += hv * wv.y; p[4 * e4 + 2] += hv * wv.z; p[4 * e4 + 3] += hv * wv.w; }
        }
#pragma unroll
        for (int e = 0; e < 32; ++e) pr[c.lane * 33 + e] = p[e];
        asm volatile("s_waitcnt lgkmcnt(0)" ::: "memory");
        __builtin_amdgcn_wave_barrier();
        float logit = -INFINITY;
        if (c.lane < 32) { float s = br[c.lane]; for (int l2 = 0; l2 < 64; ++l2) s += pr[l2 * 33 + c.lane]; logit = s; }
        asm volatile("s_waitcnt lgkmcnt(0)" ::: "memory");
        __builtin_amdgcn_wave_barrier();
        float tv[4]; int te[4];
#pragma unroll
        for (int k = 0; k < 4; ++k) {
            float bv = logit; int bi = c.lane;
#pragma unroll
            for (int o = 32; o > 0; o >>= 1) {
                const float ov = __shfl_xor(bv, o); const int oi = __shfl_xor(bi, o);
                if (ov > bv || (ov == bv && oi < bi)) { bv = ov; bi = oi; }
            }
            tv[k] = bv; te[k] = bi;
            if (c.lane == bi) logit = -INFINITY;
        }
        if (c.lane == 0) {
            const float e1 = __expf(tv[1] - tv[0]), e2 = __expf(tv[2] - tv[0]), e3 = __expf(tv[3] - tv[0]);
            const float inv = 1.f / (1.f + e1 + e2 + e3);
            const float gk[4] = {inv, e1 * inv, e2 * inv, e3 * inv};
#pragma unroll
            for (int k = 0; k < 4; ++k) {
                const unsigned slot = atomicAdd(&cnt[te[k]], 1u);
                list[(size_t)te[k] * R + slot] = r;
                tk_e[r * 4 + k] = te[k]; tk_g[r * 4 + k] = gk[k]; tk_slot[r * 4 + k] = (int)slot;
            }
        }
    }
}

__device__ __forceinline__ void moe_offsets(const Ctx& c, int layer, LAS int* so) {
    const unsigned* cnt = (const unsigned*)(c.ws + WS_CTL) + CW_CNT + layer * NE;
    __syncthreads();
    if (c.tid == 0) { int acc = 0; for (int e = 0; e < NE; ++e) { const int n = (int)cnt[e]; so[e] = acc; so[64 + e] = n; acc += (n + PADM - 1) / PADM * PADM; } so[32] = acc; }
    __syncthreads();
}

__device__ __forceinline__ void moe_tables(const Ctx& c, int layer, LAS int* tb) {
    const unsigned* cnt = (const unsigned*)(c.ws + WS_CTL) + CW_CNT + layer * NE;
    __syncthreads();
    if (c.tid == 0) { int acc = 0; for (int e = 0; e < NE; ++e) { const int n = (int)cnt[e]; tb[e] = acc; tb[64 + e] = n; acc += (n + PADM - 1) / PADM; } tb[32] = acc; }
    __syncthreads();
}
__device__ __forceinline__ int vcu_of(const Ctx& c) { return (c.nwg % 8 == 0) ? (c.wg % 8) * (c.nwg / 8) + c.wg / 8 : c.wg; }
__device__ __forceinline__ void phase_moe_gu(const Ctx& c, int layer) {
    LAS int* tb = (LAS int*)(c.lds + 131072 + 1024);
    moe_tables(c, layer, tb);
    pg8::Gemm g{(const bf16_t*)(c.ws + WS_H), (const bf16_t*)(c.ws + WS_WGU) + (size_t)layer * NE * 2048 * 1024, (size_t)2048 * 1024, (const int*)(c.ws + WS_LIST)};
    pg8::MoeOrder S{tb, tb + 64, 8, c.nwg, vcu_of(c)};
    pg8::EpiSwiglu E{(bf16_t*)(c.ws + WS_HDN), c.a->in[18] + (size_t)layer * NE * 2048};
    pg8::gemm_phase<pg8::EpiSwiglu, pg8::MoeOrder, true>(c.lds, g, S, E);
}
__device__ __forceinline__ void phase_moe_dn(const Ctx& c, int layer) {
    LAS int* tb = (LAS int*)(c.lds + 131072 + 1024);
    moe_tables(c, layer, tb);
    pg8::Gemm g{(const bf16_t*)(c.ws + WS_HDN), (const bf16_t*)(c.ws + WS_WDN) + (size_t)layer * NE * 1024 * 1024, (size_t)1024 * 1024, nullptr};
    pg8::MoeOrder S{tb, tb + 64, 4, c.nwg, vcu_of(c)};
    pg8::EpiBf16Bias E{(bf16_t*)(c.ws + WS_OUTB), c.a->in[20] + (size_t)layer * NE * 1024, 1024};
    pg8::gemm_phase<pg8::EpiBf16Bias, pg8::MoeOrder, true>(c.lds, g, S, E);
}
__device__ __forceinline__ void phase_gemm_f32(const Ctx& c, const bf16_t* A, int M, const bf16_t* Bt, int N, const float* bias, float* Cout) {
    pg8::Gemm g{A, Bt, 0, nullptr}; pg8::StaticOrder S; S.init(M, N, c.nwg, c.wg);
    pg8::EpiF32 E{Cout, N, bias};
    pg8::gemm_phase<pg8::EpiF32, pg8::StaticOrder, true>(c.lds, g, S, E);
}

__device__ __forceinline__ void phase_norm0(const Ctx& c);
__device__ __forceinline__ void phase_convert(const Ctx& c) {
    LAS float* scr = (LAS float*)c.lds + c.wave * (64 * 65);
    const int gw = c.wg * 8 + c.wave, NGW = c.nwg * 8;
    constexpr int I_QKV = 20 * 16, I_O = 16 * 16, I_IN = 80 * 16, I_HO = 16 * 16, I_GU = 64 * 32 * 16, I_DN = 64 * 16 * 16, TOT = I_QKV + I_O + I_IN + I_HO + I_GU + I_DN;
    for (int it = gw; it < TOT; it += NGW) {
        int r = it;
        if (r < I_QKV) { const int nb = r % 20, kb = r / 20; transpose_block(c.a->in[7], QKVD, nb * 64, kb * 64, (bf16_t*)(c.ws + WS_WQKV) + (size_t)nb * 64 * 1024, scr, c.lane); continue; } r -= I_QKV;
        if (r < I_O) { const int nb = r % 16, kb = r / 16; transpose_block(c.a->in[10], D, nb * 64, kb * 64, (bf16_t*)(c.ws + WS_WO) + (size_t)nb * 64 * 1024, scr, c.lane); continue; } r -= I_O;
        if (r < I_IN) { const int nb = r % 80, kb = r / 80; transpose_block(c.a->in[11], HIN, nb * 64, kb * 64, (bf16_t*)(c.ws + WS_WIN) + (size_t)nb * 64 * 1024, scr, c.lane); continue; } r -= I_IN;
        if (r < I_HO) { const int nb = r % 16, kb = r / 16; transpose_block(c.a->in[14], D, nb * 64, kb * 64, (bf16_t*)(c.ws + WS_WHO) + (size_t)nb * 64 * 1024, scr, c.lane); continue; } r -= I_HO;
        if (r < I_GU) { const int mat = r / 512, rr = r % 512, nb = rr % 32, kb = rr / 32; const int n0 = ((nb & 3) >> 1) * 1024 + (nb >> 2) * 128 + (nb & 1) * 64;
            transpose_block(c.a->in[17] + (size_t)mat * 1024 * 2048, 2048, n0, kb * 64, (bf16_t*)(c.ws + WS_WGU) + ((size_t)mat * 2048 + nb * 64) * 1024, scr, c.lane); continue; } r -= I_GU;
        { const int mat = r / 256, rr = r % 256, nb = rr % 16, kb = rr / 16;
            transpose_block(c.a->in[19] + (size_t)mat * 1024 * 1024, 1024, nb * 64, kb * 64, (bf16_t*)(c.ws + WS_WDN) + ((size_t)mat * 1024 + nb * 64) * 1024, scr, c.lane); }
    }
    __syncthreads();
    phase_norm0(c);
}

__device__ __forceinline__ void phase_combine(const Ctx& c, int layer) {
    LAS int* so = (LAS int*)(c.lds + 32768);
    moe_offsets(c, layer, so);
    const bf16_t* outb = (const bf16_t*)(c.ws + WS_OUTB); float* X = (float*)(c.ws + WS_X); bf16_t* H = (bf16_t*)(c.ws + WS_H);
    const float* ngl = c.a->in[6] + layer * 4 * D;
    const int* tk_e = (const int*)(c.ws + WS_TK); const float* tk_g = (const float*)(c.ws + WS_TK) + R * 4; const int* tk_slot = (const int*)(c.ws + WS_TK) + 2 * R * 4;
    const int r_lo = layer == 0 ? 0 : C;
    for (int r = r_lo + c.wg * 8 + c.wave; r < R; r += c.nwg * 8) {
        const float* m = c.modp(layer, r < C ? 1 : 0);
        f32x4 y[4];
#pragma unroll
        for (int j = 0; j < 4; ++j) y[j] = (f32x4){0.f, 0.f, 0.f, 0.f};
#pragma unroll
        for (int k = 0; k < 4; ++k) {
            const int e = tk_e[r * 4 + k], slot = tk_slot[r * 4 + k]; const float g = tk_g[r * 4 + k];
            const bf16_t* src = outb + (size_t)(so[e] + slot) * 1024;
#pragma unroll
            for (int j = 0; j < 4; ++j) { const u32x2 w = *(const u32x2*)(src + c.lane * 4 + 256 * j); y[j] += (f32x4){bflo(w.x), bfhi(w.x), bflo(w.y), bfhi(w.y)} * g; }
        }
        const float rstd_y = rsqrtf(row_ss(y) * (1.f / D) + EPS);
        f32x4 x[4]; row_load(X + (size_t)r * D, c.lane, x);
#pragma unroll
        for (int j = 0; j < 4; ++j) {
            const int c0 = c.lane * 4 + 256 * j;
            const f32x4 g2 = *(const f32x4*)(m + 5120 + c0), n3 = *(const f32x4*)(ngl + 3 * D + c0);
            x[j].x += g2.x * (y[j].x * rstd_y * n3.x); x[j].y += g2.y * (y[j].y * rstd_y * n3.y);
            x[j].z += g2.z * (y[j].z * rstd_y * n3.z); x[j].w += g2.w * (y[j].w * rstd_y * n3.w);
            if (layer == 0) *(f32x4*)(X + (size_t)r * D + c0) = x[j];
            else *(f32x4*)(c.a->out + (size_t)(r - C) * D + c0) = x[j];
        }
        if (layer == 0) {
            const float rstd_x = rsqrtf(row_ss(x) * (1.f / D) + EPS);
            const float* m1 = c.modp(1, r < C ? 1 : 0);
            row_modnorm_store(x, rstd_x, c.a->in[6] + 4 * D, m1 + 0, m1 + 1024, H + (size_t)r * D, c.lane);
        }
    }
}

__device__ __forceinline__ void phase_hgrn_elem(const Ctx& c) {
    const float* raw = (const float*)(c.ws + WS_RAW1); const float* lb = (const float*)(c.ws + WS_MOD) + MOD_LB;
    bf16_t* QH = (bf16_t*)(c.ws + WS_QH); _Float16* KF = (_Float16*)(c.ws + WS_KF); _Float16* KB = (_Float16*)(c.ws + WS_KB);
    bf16_t* IV = (bf16_t*)(c.ws + WS_IV); bf16_t* SGp = (bf16_t*)(c.ws + WS_SG);
    for (int r = c.wg * 8 + c.wave; r < R; r += c.nwg * 8) {
        const float* row = raw + (size_t)r * HIN; const bool lat = r >= C; const int t = r - C;
        for (int col = c.lane; col < D; col += 64) {
            const float zf = row[1024 + col], zb = row[2048 + col];
            KF[(size_t)r * D + col] = (_Float16)((1.f - lb[col]) * sigmoid_f(-zf));
            KB[(size_t)r * D + col] = (_Float16)((1.f - lb[1024 + col]) * sigmoid_f(-zb));
            IV[(size_t)r * D + col] = (bf16_t)f2bf(row[3072 + col]);
            if (lat) { QH[(size_t)t * D + col] = (bf16_t)f2bf(silu_f(row[col])); SGp[(size_t)t * D + col] = (bf16_t)f2bf(silu_f(row[4096 + col])); }
        }
    }
}

namespace hg {
typedef _Float16 h2_t __attribute__((ext_vector_type(2)));
typedef float f32x2 __attribute__((ext_vector_type(2)));
constexpr int TB = 272, PB = 144;
constexpr int TILE = 64 * TB;
constexpr int T_QD = 0, T_QC = TILE, T_KD = 2 * TILE, T_KE = 3 * TILE, T_KC = 4 * TILE, T_V0 = 5 * TILE, T_V1 = 6 * TILE;
constexpr int T_QL1 = 7 * TILE, T_KL1 = T_QL1 + 16 * TB, T_P = T_KL1 + 16 * TB, T_TOT = T_P + 64 * PB, T_CT = T_TOT + 4096, T_END = T_CT + 512;
static_assert(T_END <= LDS_BYTES - 64, "hgrn scan LDS map");
__device__ __forceinline__ int row_of(int dir, int p) { return p < C ? (dir ? C - 1 - p : p) : (dir ? C + (L - 1 - (p - C)) : p); }
__device__ __forceinline__ int seg_of(int ch) { return ch < 68 ? ch / 17 : 4 + (ch - 68) / 16; }
__device__ __forceinline__ bf16x8 tr_frag(const LAS unsigned char* tile, int row0, int col0, int lane) {
    const int q = (lane & 15) >> 2, p = lane & 3;
    const LAS unsigned char* a = tile + (row0 + q) * TB + (col0 + 4 * p) * 2;
    const v4i16_t lo = __builtin_amdgcn_ds_read_tr16_b64_v4i16((LAS v4i16_t*)a);
    const v4i16_t hi = __builtin_amdgcn_ds_read_tr16_b64_v4i16((LAS v4i16_t*)(a + 4 * TB));
    return (bf16x8){lo[0], lo[1], lo[2], lo[3], hi[0], hi[1], hi[2], hi[3]};
}
}

__device__ __forceinline__ void phase_hgrn_scan(const Ctx& c) {
    using namespace hg;
    const bf16_t* QH = (const bf16_t*)(c.ws + WS_QH); const bf16_t* IV = (const bf16_t*)(c.ws + WS_IV);
    LAS unsigned char* lds = c.lds;
    const int tid = c.tid, lane = c.lane, w = __builtin_amdgcn_readfirstlane(tid >> 6), fr = lane & 15, g = lane >> 4;
    for (int item = c.wg; item < 256; item += c.nwg) {
        const int chain = item >> 4, seg = item & 15, head = chain >> 1, dir = chain & 1, hc = head * 128;
        const int c0 = seg < 4 ? 17 * seg : 68 + 16 * (seg - 4), nch = seg < 4 ? 17 : 16;
        const _Float16* KX = (const _Float16*)(c.ws + (dir ? WS_KB : WS_KF));
        float* OL = (float*)(c.ws + (dir ? WS_OB : WS_OF)); bf16_t* QS = (bf16_t*)(c.ws + (dir ? WS_QSB : WS_QSF));
        __syncthreads();
        for (int i = tid; i < 64 * PB / 4; i += 512) ((LAS unsigned*)(lds + T_P))[i] = 0u;
        f32x4 Sacc[8];
#pragma unroll
        for (int m = 0; m < 8; ++m) Sacc[m] = (f32x4){0.f, 0.f, 0.f, 0.f};
        float dseg0 = 1.f, dseg1 = 1.f;
        unsigned kraw[8], qraw[8]; u32x4 vraw[2];
#define HG_LOAD(cidx) do { const int p0_ = 64 * (cidx); const bool lat_ = (cidx) >= 4; \
        _Pragma("unroll") for (int i = 0; i < 8; ++i) { const int r_ = row_of(dir, p0_ + 8 * w + i); \
            kraw[i] = *(const unsigned*)(KX + (size_t)r_ * D + hc + 2 * lane); \
            qraw[i] = lat_ ? *(const unsigned*)(QH + (size_t)(r_ - C) * D + hc + 2 * lane) : 0u; } \
        _Pragma("unroll") for (int i = 0; i < 2; ++i) { const int idx_ = tid + 512 * i; const int r_ = row_of(dir, p0_ + (idx_ >> 4)); \
            vraw[i] = *(const u32x4*)(IV + (size_t)r_ * D + hc + (idx_ & 15) * 8); } } while (0)
        HG_LOAD(c0);
        for (int ci = 0; ci < nch; ++ci) {
            const int cidx = c0 + ci; const bool lat = cidx >= 4;
            const int vbuf = (ci & 1) ? T_V1 : T_V0;
            float kf[8][2], qf[8][2], cp[8][2];
            {
                float p0 = 1.f, p1 = 1.f;
#pragma unroll
                for (int i = 0; i < 8; ++i) {
                    const h2_t hv = __builtin_bit_cast(h2_t, kraw[i]);
                    kf[i][0] = (float)hv[0]; kf[i][1] = (float)hv[1];
                    qf[i][0] = bflo(qraw[i]); qf[i][1] = bfhi(qraw[i]);
                    p0 *= (1.f - kf[i][0]); p1 *= (1.f - kf[i][1]); cp[i][0] = p0; cp[i][1] = p1;
                }
                *(LAS f32x2*)(lds + T_TOT + (w * 128 + 2 * lane) * 4) = (f32x2){p0, p1};
#pragma unroll
                for (int i = 0; i < 2; ++i) { const int idx = tid + 512 * i; *(LAS u32x4*)(lds + vbuf + (idx >> 4) * TB + (idx & 15) * 16) = vraw[i]; }
            }
            __syncthreads();
            {
                f32x2 T[8];
#pragma unroll
                for (int x = 0; x < 8; ++x) T[x] = *(const LAS f32x2*)(lds + T_TOT + (x * 128 + 2 * lane) * 4);
                const int I = w >> 1, hh = w & 1;
                f32x2 bd[4];
#pragma unroll
                for (int x = 0; x < 4; ++x) bd[x] = T[2 * x] * T[2 * x + 1];
                f32x2 pre = (f32x2){1.f, 1.f}, cum = (f32x2){1.f, 1.f}, suf = (f32x2){1.f, 1.f}, bdI = (f32x2){1.f, 1.f};
#pragma unroll
                for (int x = 0; x < 8; ++x) if (hh && x == w - 1) pre = T[x];
#pragma unroll
                for (int x = 0; x < 4; ++x) { if (x < I) cum = cum * bd[x]; if (x > I) suf = suf * bd[x]; if (x == I) bdI = bd[x]; }
                const f32x2 ctot = (bd[0] * bd[1]) * (bd[2] * bd[3]);
#pragma unroll
                for (int i = 0; i < 8; ++i) {
                    const int tau = 8 * w + i;
                    float QDv[2], KDv[2], KEv[2], QCv[2], KCv[2];
#pragma unroll
                    for (int x = 0; x < 2; ++x) {
                        const float eq = pre[x] * cp[i][x], rc = __builtin_amdgcn_rcpf(eq);
                        QDv[x] = qf[i][x] * eq; KDv[x] = kf[i][x] * rc; KEv[x] = KDv[x] * bdI[x]; QCv[x] = QDv[x] * cum[x]; KCv[x] = KEv[x] * suf[x];
                    }
                    const int to = tau * TB + lane * 4;
                    *(LAS unsigned*)(lds + T_QD + to) = pk2(QDv[0], QDv[1]);
                    *(LAS unsigned*)(lds + T_KD + to) = pk2(KDv[0], KDv[1]);
                    *(LAS unsigned*)(lds + T_KE + to) = pk2(KEv[0], KEv[1]);
                    *(LAS unsigned*)(lds + T_QC + to) = pk2(QCv[0], QCv[1]);
                    *(LAS unsigned*)(lds + T_KC + to) = pk2(KCv[0], KCv[1]);
                    if (I == 3) *(LAS unsigned*)(lds + T_QL1 + (tau - 48) * TB + lane * 4) = pk2(QDv[0] * bd[2][0], QDv[1] * bd[2][1]);
                    if (I == 0) *(LAS unsigned*)(lds + T_KL1 + tau * TB + lane * 4) = pk2(KEv[0] * bd[1][0], KEv[1] * bd[1][1]);
                    if (lat) { const int r = row_of(dir, 64 * cidx + tau); *(unsigned*)(QS + (size_t)(r - C) * D + hc + 2 * lane) = pk2(QCv[0] * dseg0, QCv[1] * dseg1); }
                }
                dseg0 *= ctot[0]; dseg1 *= ctot[1];
                if (w == 0) *(LAS f32x2*)(lds + T_CT + lane * 8) = ctot;
            }
            __syncthreads();
            if (ci + 1 < nch) HG_LOAD(cidx + 1);
            if (lat) {
                const int nblk = w >= 6 ? 2 : 1;
                for (int b = 0; b < nblk; ++b) {
                    int I, J, qoff, qrow, koff, krow; bool diag = false;
                    if (w < 4) { I = 2 + (w >> 1); J = w & 1; qoff = (w >> 1) ? T_QL1 : T_QD; qrow = (w >> 1) ? 0 : 32; koff = (w & 1) ? T_KE : T_KL1; krow = (w & 1) ? 16 : 0; }
                    else if (w == 4) { I = 1; J = 0; qoff = T_QD; qrow = 16; koff = T_KE; krow = 0; }
                    else if (w == 5) { I = 3; J = 2; qoff = T_QD; qrow = 48; koff = T_KE; krow = 32; }
                    else { I = 2 * (w - 6) + b; J = I; qoff = T_QD; qrow = 16 * I; koff = T_KD; krow = 16 * I; diag = true; }
                    f32x4 pa = (f32x4){0.f, 0.f, 0.f, 0.f};
#pragma unroll
                    for (int ks = 0; ks < 4; ++ks) {
                        const bf16x8 av = *(const LAS bf16x8*)(lds + qoff + (qrow + fr) * TB + (32 * ks + 8 * g) * 2);
                        const bf16x8 bv = *(const LAS bf16x8*)(lds + koff + (krow + fr) * TB + (32 * ks + 8 * g) * 2);
                        pa = __builtin_amdgcn_mfma_f32_16x16x32_bf16(av, bv, pa, 0, 0, 0);
                    }
#pragma unroll
                    for (int e = 0; e < 4; ++e) {
                        const int tl = 4 * g + e; const float val = (diag && fr > tl) ? 0.f : pa[e];
                        *(LAS bf16_t*)(lds + T_P + (16 * I + tl) * PB + (16 * J + fr) * 2) = (bf16_t)f2bf(val);
                    }
                }
            }
            f32x4 oacc[4];
#pragma unroll
            for (int m = 0; m < 4; ++m) oacc[m] = (f32x4){0.f, 0.f, 0.f, 0.f};
            if (lat) {
                bf16x8 Sb[4];
#pragma unroll
                for (int ks = 0; ks < 4; ++ks) {
                    const f32x4 a0 = Sacc[2 * ks], a1 = Sacc[2 * ks + 1];
                    const u32x4 pk = (u32x4){pk2(a0[0], a0[1]), pk2(a0[2], a0[3]), pk2(a1[0], a1[1]), pk2(a1[2], a1[3])};
                    Sb[ks] = __builtin_bit_cast(bf16x8, pk);
                }
#pragma unroll
                for (int m = 0; m < 4; ++m)
#pragma unroll
                    for (int ks = 0; ks < 4; ++ks) {
                        const u32x2 lo = *(const LAS u32x2*)(lds + T_QC + (16 * m + fr) * TB + (32 * ks + 4 * g) * 2);
                        const u32x2 hi = *(const LAS u32x2*)(lds + T_QC + (16 * m + fr) * TB + (32 * ks + 16 + 4 * g) * 2);
                        const u32x4 pk = (u32x4){lo.x, lo.y, hi.x, hi.y};
                        oacc[m] = __builtin_amdgcn_mfma_f32_16x16x32_bf16(__builtin_bit_cast(bf16x8, pk), Sb[ks], oacc[m], 0, 0, 0);
                    }
            }
#pragma unroll
            for (int m = 0; m < 8; ++m) { const f32x4 ct = *(const LAS f32x4*)(lds + T_CT + (16 * m + 4 * g) * 4); Sacc[m] = Sacc[m] * ct; }
            bf16x8 Vf[2];
#pragma unroll
            for (int ks = 0; ks < 2; ++ks) Vf[ks] = tr_frag(lds + vbuf, 32 * ks + 8 * g, 16 * w, lane);
#pragma unroll
            for (int m = 0; m < 8; ++m)
#pragma unroll
                for (int ks = 0; ks < 2; ++ks) Sacc[m] = __builtin_amdgcn_mfma_f32_16x16x32_bf16(tr_frag(lds + T_KC, 32 * ks + 8 * g, 16 * m, lane), Vf[ks], Sacc[m], 0, 0, 0);
            __syncthreads();
            if (lat) {
#pragma unroll
                for (int m = 0; m < 4; ++m)
#pragma unroll
                    for (int ks = 0; ks < 2; ++ks) {
                        if (m < 2 && ks == 1) continue;
                        const bf16x8 av = *(const LAS bf16x8*)(lds + T_P + (16 * m + fr) * PB + (32 * ks + 8 * g) * 2);
                        oacc[m] = __builtin_amdgcn_mfma_f32_16x16x32_bf16(av, Vf[ks], oacc[m], 0, 0, 0);
                    }
#pragma unroll
                for (int m = 0; m < 4; ++m)
#pragma unroll
                    for (int e = 0; e < 4; ++e) { const int r = row_of(dir, 64 * cidx + 16 * m + 4 * g + e); OL[(size_t)(r - C) * D + hc + 16 * w + fr] = oacc[m][e]; }
            }
        }
#undef HG_LOAD
        float* DS = (float*)(c.ws + WS_DS) + (size_t)item * 16384; float* DG = (float*)(c.ws + WS_DG) + item * 128;
#pragma unroll
        for (int m = 0; m < 8; ++m)
#pragma unroll
            for (int e = 0; e < 4; ++e) DS[(16 * m + 4 * g + e) * 128 + 16 * w + fr] = Sacc[m][e];
        if (w == 0) { DG[2 * lane] = dseg0; DG[2 * lane + 1] = dseg1; }
    }
}

__device__ __forceinline__ void phase_hgrn_fold(const Ctx& c) {
    const float* DS = (const float*)(c.ws + WS_DS); const float* DG = (const float*)(c.ws + WS_DG); bf16_t* SST = (bf16_t*)(c.ws + WS_SST);
    for (int item = c.wg; item < 256; item += c.nwg) {
        const int chain = item >> 4, slice = item & 15, d = 8 * slice + (c.tid >> 6), v2 = (c.tid & 63) * 2;
        float s0 = 0.f, s1 = 0.f;
        float dv[15]; hg::f32x2 ds[15];
#pragma unroll
        for (int sgi = 0; sgi < 15; ++sgi) { dv[sgi] = DG[(chain * 16 + sgi) * 128 + d]; ds[sgi] = *(const hg::f32x2*)(DS + ((size_t)(chain * 16 + sgi) * 128 + d) * 128 + v2); }
        SST[((size_t)(chain * 16) * 128 + v2) * 128 + d] = 0; SST[((size_t)(chain * 16) * 128 + v2 + 1) * 128 + d] = 0;
#pragma unroll
        for (int sgi = 0; sgi < 15; ++sgi) {
            s0 = dv[sgi] * s0 + ds[sgi][0]; s1 = dv[sgi] * s1 + ds[sgi][1];
            SST[((size_t)(chain * 16 + sgi + 1) * 128 + v2) * 128 + d] = (bf16_t)f2bf(s0); SST[((size_t)(chain * 16 + sgi + 1) * 128 + v2 + 1) * 128 + d] = (bf16_t)f2bf(s1);
        }
    }
}

__device__ __forceinline__ void phase_hgrn_readout(const Ctx& c) {
    const float* OF = (const float*)(c.ws + WS_OF); const float* OB = (const float*)(c.ws + WS_OB); const bf16_t* SGp = (const bf16_t*)(c.ws + WS_SG);
    const bf16_t* SST = (const bf16_t*)(c.ws + WS_SST); bf16_t* RR = (bf16_t*)(c.ws + WS_RR); const float* hng = c.a->in[13];
    const int lane = c.lane, fr = lane & 15, g = lane >> 4;
    for (int it = c.wg * 8 + c.wave; it < 8192; it += c.nwg * 8) {
        const int tt = it >> 3, h = it & 7, t0 = 16 * tt, ch = t0 >> 6;
        f32x4 acc[8];
#pragma unroll
        for (int n = 0; n < 8; ++n) acc[n] = (f32x4){0.f, 0.f, 0.f, 0.f};
#pragma unroll
        for (int dx = 0; dx < 2; ++dx) {
            const int sg = hg::seg_of(dx ? 4 + 255 - ch : 4 + ch);
            const bf16_t* QS = (const bf16_t*)(c.ws + (dx ? WS_QSB : WS_QSF)) + (size_t)(t0 + fr) * D + h * 128 + 8 * g;
            const bf16_t* ST = SST + ((size_t)((h * 2 + dx) * 16 + sg) * 128 + fr) * 128 + 8 * g;
#pragma unroll
            for (int ks = 0; ks < 4; ++ks) {
                const bf16x8 av = *(const bf16x8*)(QS + 32 * ks);
#pragma unroll
                for (int n = 0; n < 8; ++n) acc[n] = __builtin_amdgcn_mfma_f32_16x16x32_bf16(av, *(const bf16x8*)(ST + (size_t)(16 * n) * 128 + 32 * ks), acc[n], 0, 0, 0);
            }
        }
        float ss[4] = {0.f, 0.f, 0.f, 0.f};
#pragma unroll
        for (int n = 0; n < 8; ++n)
#pragma unroll
            for (int e = 0; e < 4; ++e) { const size_t o = (size_t)(t0 + 4 * g + e) * D + h * 128 + 16 * n + fr; const float v = acc[n][e] + OF[o] + OB[o]; acc[n][e] = v; ss[e] += v * v; }
#pragma unroll
        for (int e = 0; e < 4; ++e) {
#pragma unroll
            for (int sh = 8; sh > 0; sh >>= 1) ss[e] += __shfl_xor(ss[e], sh);
            ss[e] = rsqrtf(ss[e] * (1.f / 128.f) + EPS);
        }
#pragma unroll
        for (int n = 0; n < 8; ++n)
#pragma unroll
            for (int e = 0; e < 4; ++e) { const size_t o = (size_t)(t0 + 4 * g + e) * D + h * 128 + 16 * n + fr; RR[o] = (bf16_t)f2bf(acc[n][e] * ss[e] * hng[h * 128 + 16 * n + fr] * bf2f(SGp[o])); }
    }
}

#define XB_TMO      128
#define XB_XCNT(j)  (256  + 64 * (j))
#define XB_XSUB(j)  (1280 + 64 * (j))
#define XB_XGEN(j)  (2304 + 64 * (j))
#define XB_TOP      3328
#define XB_TOPGEN   3392
#define XCD_BAR_WORDS 3456
#define XB_SPIN_CAP (1u << 18)
__device__ __forceinline__ unsigned xb_ld(unsigned* p)              { return __hip_atomic_load(p, __ATOMIC_RELAXED, __HIP_MEMORY_SCOPE_AGENT); }
__device__ __forceinline__ unsigned xb_add(unsigned* p, unsigned v) { return __hip_atomic_fetch_add(p, v, __ATOMIC_RELAXED, __HIP_MEMORY_SCOPE_AGENT); }
__device__ __forceinline__ unsigned xb_xcc_id() { return (unsigned)__builtin_amdgcn_s_getreg((3 << 11) | 20) & 0xFu; }
#define XB_SPIN(cond, bar) do { unsigned _sp = 0; while (cond) { __builtin_amdgcn_s_sleep(1); \
    if ((++_sp & 255u) == 0u) { if (xb_ld(&(bar)[XB_TMO])) break; if (_sp > XB_SPIN_CAP) { atomicAdd(&(bar)[XB_TMO], 1u); break; } } } } while (0)
struct XcdBarrier { unsigned* bar; unsigned x; volatile LAS unsigned* st; };
__device__ __forceinline__ XcdBarrier xcd_barrier_post(unsigned* bar, volatile LAS unsigned* st) {
    XcdBarrier b; b.bar = bar; b.x = xb_xcc_id(); b.st = st;
    if (threadIdx.x == 0) (void)xb_add(&bar[XB_XCNT(b.x)], 1u);
    return b;
}
__device__ __forceinline__ void xcd_barrier_complete(unsigned* bar, unsigned x, unsigned& nloc, unsigned& nx) {
    const unsigned G = gridDim.x * gridDim.y * gridDim.z;
    unsigned sum, cnt, mine, sp = 0u;
    for (;;) {
        sum = 0u; cnt = 0u; mine = 0u;
#pragma unroll
        for (unsigned j = 0; j < 16; ++j) { const unsigned c = xb_ld(&bar[XB_XCNT(j)]); sum += c; cnt += (c > 0u) ? 1u : 0u; mine = (j == x) ? c : mine; }
        if (sum == G) break;
        __builtin_amdgcn_s_sleep(1);
        if ((++sp & 255u) == 0u) { if (xb_ld(&bar[XB_TMO])) break; if (sp > XB_SPIN_CAP) { atomicAdd(&bar[XB_TMO], 1u); break; } }
    }
    nloc = mine > 0u ? mine : 1u; nx = cnt > 0u ? cnt : 1u;
}
__device__ __forceinline__ void xcd_barrier(const XcdBarrier& b) {
    asm volatile("s_waitcnt vmcnt(0)" ::: "memory");
    __syncthreads();
    if (threadIdx.x == 0) {
        unsigned* bar = b.bar;
        __builtin_amdgcn_s_waitcnt(0);
        unsigned nloc = b.st[0], nx = b.st[1];
        if (nloc == 0u) { xcd_barrier_complete(bar, b.x, nloc, nx); b.st[0] = nloc; b.st[1] = nx; }
        const unsigned old = xb_add(&bar[XB_XSUB(b.x)], 1u);
        const unsigned gen = old / nloc;
        if (old + 1u == (gen + 1u) * nloc) {
            __builtin_amdgcn_fence(__ATOMIC_RELEASE, "agent");
            asm volatile("s_waitcnt vmcnt(0)" ::: "memory");
            const unsigned og = xb_add(&bar[XB_TOP], 1u);
            const unsigned tg = og / nx;
            if (og + 1u == (tg + 1u) * nx) xb_add(&bar[XB_TOPGEN], 1u);
            else XB_SPIN(xb_ld(&bar[XB_TOPGEN]) == tg, bar);
            __builtin_amdgcn_fence(__ATOMIC_ACQUIRE, "agent");
            xb_add(&bar[XB_XGEN(b.x)], 1u);
            asm volatile("s_waitcnt vmcnt(0)" ::: "memory");
        } else {
            XB_SPIN(xb_ld(&bar[XB_XGEN(b.x)]) == gen, bar);
            __builtin_amdgcn_fence(__ATOMIC_ACQUIRE, "agent");
            asm volatile("s_waitcnt vmcnt(0)" ::: "memory");
        }
    }
    __syncthreads();
}

__device__ __forceinline__ void launder(Ctx& c) { asm volatile("" : "+s"(c.a)); asm volatile("" : "+s"(c.ws)); }
__global__ void __launch_bounds__(512, 2) mk_fwd(Args args) {
    extern __shared__ __attribute__((aligned(16))) unsigned char lds_raw[];
    Ctx c; c.a = (CArgs)__builtin_amdgcn_kernarg_segment_ptr(); c.lds = (LAS unsigned char*)lds_raw; c.tid = threadIdx.x; c.lane = c.tid & 63; c.wave = c.tid >> 6; c.nwg = gridDim.x; c.wg = blockIdx.x; c.ws = c.a->ws;
    volatile LAS unsigned* bst = (volatile LAS unsigned*)(c.lds + LDS_BYTES - 64);
    if (c.tid < 4) bst[c.tid] = 0u;
    __syncthreads();
    const XcdBarrier bar = xcd_barrier_post((unsigned*)(c.ws + WS_CTL) + CW_BAR, bst);
    const int lo = c.a->ph_lo, hi = c.a->ph_hi;
#define SEAM(k) do { if (lo <= (k) && (k) + 1 < hi) xcd_barrier(bar); } while (0)
#define IN(k) (lo <= (k) && (k) < hi && (launder(c), true))
    if (IN(0)) phase_prep(c);
    SEAM(0);
    if (IN(1)) phase_convert(c);
    SEAM(1);
    if (IN(2)) phase_gemm_f32(c, (const bf16_t*)(c.ws + WS_H), R, (const bf16_t*)(c.ws + WS_WQKV), QKVD, c.a->in[8], (float*)(c.ws + WS_RAW1));
    SEAM(2);
    if (IN(3)) phase_rope(c);
    SEAM(3);
    if (IN(4)) phase_attn(c);
    SEAM(4);
    if (IN(5)) phase_gemm_f32(c, (const bf16_t*)(c.ws + WS_O), R, (const bf16_t*)(c.ws + WS_WO), D, nullptr, (float*)(c.ws + WS_RAW1));
    SEAM(5);
    if (IN(6)) phase_postmix(c, 0, 0, 0);
    SEAM(6);
    if (IN(7)) phase_moe_gu(c, 0);
    SEAM(7);
    if (IN(8)) phase_moe_dn(c, 0);
    SEAM(8);
    if (IN(9)) phase_combine(c, 0);
    SEAM(9);
    if (IN(10)) phase_gemm_f32(c, (const bf16_t*)(c.ws + WS_H), R, (const bf16_t*)(c.ws + WS_WIN), HIN, nullptr, (float*)(c.ws + WS_RAW1));
    SEAM(10);
    if (IN(11)) phase_hgrn_elem(c);
    SEAM(11);
    if (IN(12)) phase_hgrn_scan(c);
    SEAM(12);
    if (IN(13)) phase_hgrn_fold(c);
    SEAM(13);
    if (IN(14)) phase_hgrn_readout(c);
    SEAM(14);
    if (IN(15)) phase_gemm_f32(c, (const bf16_t*)(c.ws + WS_RR), L, (const bf16_t*)(c.ws + WS_WHO), D, nullptr, (float*)(c.ws + WS_RAW1));
    SEAM(15);
    if (IN(16)) phase_postmix(c, 1, C, C);
    SEAM(16);
    if (IN(17)) phase_moe_gu(c, 1);
    SEAM(17);
    if (IN(18)) phase_moe_dn(c, 1);
    SEAM(18);
    if (IN(19)) phase_combine(c, 1);
#undef IN
#undef SEAM
}

extern "C" void kernel_launch(void* const* d_in, const int* in_sizes, int n_in, void* d_out, int out_size, void* d_ws, size_t ws_size, hipStream_t stream) {
    static int grid = 0;
    if (grid == 0) {
        if (n_in != 21 || out_size != L * D || ws_size < WS_END) { fprintf(stderr, "kernel_launch: unexpected problem (n_in %d out %d ws %zu need %zu)\n", n_in, out_size, ws_size, (size_t)WS_END); grid = -1; return; }
        int dev = 0, cus = 0, per_cu = 0;
        hipGetDevice(&dev); hipDeviceGetAttribute(&cus, hipDeviceAttributeMultiprocessorCount, dev);
        if (hipFuncSetAttribute((const void*)mk_fwd, hipFuncAttributeMaxDynamicSharedMemorySize, LDS_BYTES) != hipSuccess) { fprintf(stderr, "kernel_launch: hipFuncSetAttribute failed\n"); grid = -1; return; }
        hipOccupancyMaxActiveBlocksPerMultiprocessor(&per_cu, (const void*)mk_fwd, 512, LDS_BYTES);
        if (per_cu < 1) fprintf(stderr, "kernel_launch: occupancy query says %d\n", per_cu);
        (void)hipGetLastError();
        grid = cus > 0 ? cus : 256;
    }
    if (grid < 0) return;
    hipMemsetAsync((char*)d_ws + WS_CTL, 0, MiB, stream);
    Args a{};
    for (int i = 0; i < 21; ++i) a.in[i] = (const float*)d_in[i];
    a.out = (float*)d_out; a.ws = (unsigned char*)d_ws;
    a.ph_lo = 0; a.ph_hi = NPHASE;
    hipLaunchKernelGGL(mk_fwd, dim3(grid), dim3(512), LDS_BYTES, stream, a);
}
```

```cpp
#include <hip/hip_runtime.h>
#include <cstdint>
#include <cstdio>

#define LAS __attribute__((address_space(3)))
typedef unsigned short bf16_t;
typedef short bf16x8 __attribute__((ext_vector_type(8)));
typedef float f32x4 __attribute__((ext_vector_type(4)));
typedef unsigned u32x4 __attribute__((ext_vector_type(4)));
typedef unsigned u32x2 __attribute__((ext_vector_type(2)));
typedef short v4i16_t __attribute__((ext_vector_type(4)));
typedef float f32x2 __attribute__((ext_vector_type(2)));

constexpr int D = 1024, L = 16384, C = 256, R = L + C;
constexpr int QKVD = 1280, HIN = 5120, NE = 32, TOPK = 4;
constexpr int PADM = 256, MAXROWS = 74752;
constexpr float EPS = 1e-6f;
constexpr float LOG2E = 1.4426950408889634f;
constexpr int NPHASE = 18;
#ifndef PROBE_PH
#define PROBE_PH (-1)
#endif
constexpr int LDS_BYTES = 147456;

constexpr size_t MiB = 1u << 20;
constexpr size_t al(size_t x) { return (x + MiB - 1) / MiB * MiB; }
constexpr size_t WS_CTL = 0;
constexpr size_t WS_MOD = WS_CTL + MiB;
constexpr size_t WS_X = WS_MOD + MiB;
constexpr size_t WS_H = WS_X + al((size_t)R * D * 4);
constexpr size_t WS_Q = WS_H + al((size_t)R * D * 2);
constexpr size_t WS_K = WS_Q + al((size_t)R * D * 2);
constexpr size_t WS_V = WS_K + al((size_t)R * 128 * 2);
constexpr size_t WS_O = WS_V + al((size_t)R * 128 * 2);
constexpr size_t WS_TK = WS_O + al((size_t)R * D * 2);
constexpr size_t WS_LIST = WS_TK + MiB;
constexpr size_t WS_HDN = WS_LIST + 3 * MiB;
constexpr size_t WS_RAW1 = WS_HDN + al((size_t)MAXROWS * 1024 * 2);
constexpr size_t WS_X1 = WS_RAW1 + al((size_t)R * D * 4);
constexpr size_t WS_OUTB = WS_X1 + al((size_t)R * D * 4);
constexpr size_t WS_QH = WS_OUTB + al((size_t)MAXROWS * 1024 * 2);
constexpr size_t WS_KF = WS_QH + al((size_t)L * D * 2);
constexpr size_t WS_KB = WS_KF + al((size_t)R * D * 2);
constexpr size_t WS_IV = WS_KB + al((size_t)R * D * 2);
constexpr size_t WS_SG = WS_IV + al((size_t)R * D * 2);
constexpr size_t WS_OF = WS_SG + al((size_t)L * D * 2);
constexpr size_t WS_OB = WS_OF + al((size_t)L * D * 4);
constexpr size_t WS_RR = WS_OB + al((size_t)L * D * 4);
constexpr size_t WS_WQKV = WS_RR + al((size_t)L * D * 2);
constexpr size_t WS_WO = WS_WQKV + al((size_t)QKVD * D * 2);
constexpr size_t WS_WIN = WS_WO + al((size_t)D * D * 2);
constexpr size_t WS_WHO = WS_WIN + al((size_t)HIN * D * 2);
constexpr size_t WS_WGU = WS_WHO + al((size_t)D * D * 2);
constexpr size_t WS_WDN = WS_WGU + al((size_t)2 * NE * 2048 * D * 2);
constexpr size_t WS_QSF = WS_WDN + al((size_t)2 * NE * 1024 * D * 2);
constexpr size_t WS_QSB = WS_QSF + al((size_t)L * D * 2);
constexpr size_t WS_DS = WS_QSB + al((size_t)L * D * 2);
constexpr size_t WS_DG = WS_DS + al((size_t)256 * 128 * 128 * 4);
constexpr size_t WS_SST = WS_DG + MiB;
constexpr size_t WS_END = WS_SST + al((size_t)256 * 128 * 128 * 2);
static_assert(WS_END <= (size_t)2048 * MiB, "workspace map exceeds 4x the largest input");
constexpr int CW_CNT = 1024;
constexpr int CW_BAR = 4096;
constexpr int MOD_ROPE = 32768;
constexpr int MOD_LB = 49152;

struct Args { const float* in[21]; float* out; unsigned char* ws; int ph_lo, ph_hi; };

__device__ __forceinline__ unsigned f2bf(float f) { unsigned u = __float_as_uint(f); return (u + 0x7fffu + ((u >> 16) & 1u)) >> 16; }
__device__ __forceinline__ unsigned pk2(float lo, float hi) { return f2bf(lo) | (f2bf(hi) << 16); }
__device__ __forceinline__ float bflo(unsigned u) { return __uint_as_float(u << 16); }
__device__ __forceinline__ float bfhi(unsigned u) { return __uint_as_float(u & 0xffff0000u); }
__device__ __forceinline__ float bf2f(bf16_t b) { return __uint_as_float(((unsigned)b) << 16); }
__device__ __forceinline__ float wave_sum(float v) {
#pragma unroll
    for (int o = 32; o > 0; o >>= 1) v += __shfl_xor(v, o);
    return v;
}
__device__ __forceinline__ float silu_f(float x) { return x / (1.f + __expf(-x)); }
__device__ __forceinline__ float sigmoid_f(float x) { return 1.f / (1.f + __expf(-x)); }

typedef const __attribute__((address_space(4))) Args* CArgs;
struct Ctx {
    CArgs a;
    LAS unsigned char* lds;
    int tid, lane, wave, nwg, wg;
    unsigned char* ws;
    __device__ __forceinline__ float* modp(int layer, int which) const { return (float*)(ws + WS_MOD) + (layer * 2 + which) * 6144; }
    __device__ __forceinline__ const float* xin0(int r) const { return r < C ? a->in[2] + (size_t)r * D : a->in[0] + (size_t)(r - C) * D; }
};


namespace pg8 {
constexpr int BM = 256, BK = 64, HALF = 128, HTB = HALF * BK * 2, STAGE_BYTES = 8 * HTB, KD = 1024, NXCD = 8, WGM = 8;
__device__ __forceinline__ int lds_byte(int r, int c) { const int st = (r >> 4) * 2 + (c >> 5), rr = r & 15, cc = c & 31, ob = rr * 64 + cc * 2; return st * 1024 + (ob ^ (((ob >> 9) & 1) << 5)); }
__device__ __forceinline__ void stage_rc(int b, int& Rr, int& Cc) { const int st = b / 1024, sb = b % 1024, swz = sb ^ (((sb >> 9) & 1) << 5); Rr = (st >> 1) * 16 + swz / 64; Cc = (st & 1) * 32 + (swz % 64) / 2; }
__device__ __forceinline__ int perm32(int rho) { const int n = rho >> 4, i = rho & 15; return 8 * (i >> 2) + 4 * n + (i & 3); }

struct Unit { int pm, pn, e, goff, gcnt; };
struct Gemm { const bf16_t* A; const bf16_t* Bt; size_t bstride; const int* list; };

struct StaticOrder {
    int nM, nN, nwg, G, c;
    __device__ __forceinline__ void init(int M, int N, int G_, int c_) { nM = M / BM; nN = N / BM; nwg = nM * nN; G = G_; c = c_; }
    __device__ __forceinline__ bool next(int i, Unit& u) const {
        const long Lq = (long)i * G + c; if (Lq >= nwg) return false;
        int wgid = (int)Lq; { const int q = nwg / NXCD, r = nwg % NXCD, xcd = wgid % NXCD, off = wgid / NXCD; wgid = (xcd < r ? xcd * (q + 1) : r * (q + 1) + (xcd - r) * q) + off; }
        const int nig = WGM * nN, gid = wgid / nig, fm = gid * WGM, gsz = (nM - fm) < WGM ? (nM - fm) : WGM;
        u.pm = fm + ((wgid % nig) % gsz); u.pn = (wgid % nig) / gsz; u.e = 0; u.goff = 0; u.gcnt = 0; return true;
    }
};
struct MoeOrder {
    const LAS int* tp; const LAS int* cnt; int npn, G, vcu;
    __device__ __forceinline__ bool next(int i, Unit& u) const {
        const int lin = i * G + vcu; if (lin >= tp[32] * npn) return false;
        const int rt = lin / npn; int e = 0;
#pragma unroll 8
        for (int k = 1; k < 32; ++k) e += (rt >= tp[k]) ? 1 : 0;
        const int mt = rt - tp[e];
        u.pm = rt; u.pn = lin - rt * npn; u.e = e; u.goff = e * R + mt * 256; u.gcnt = cnt[e] - mt * 256; return true;
    }
};

__device__ __forceinline__ void a_offsets(const Gemm& g, const Unit& u, const int (&sR)[2], const int (&sC)[2], unsigned (&v)[2][2]) {
#pragma unroll
    for (int h = 0; h < 2; ++h)
#pragma unroll
        for (int i = 0; i < 2; ++i) {
            const int rr = h * HALF + sR[i]; int row;
            if (g.list) row = rr < u.gcnt ? g.list[u.goff + rr] : 0; else row = u.pm * BM + rr;
            v[h][i] = (unsigned)(row * KD + sC[i]) * 2u;
        }
}

struct EpiF32 {
    static constexpr bool PERM = false;
    float* Cp; int ldc; const float* bias;
    __device__ __forceinline__ void operator()(const f32x4 (&acc)[2][2][4][2], const Unit& u, int wr, int wc, int fr, int fq) const {
        const int row0 = u.pm * BM + wr * 64 + fr, col0 = u.pn * BM + wc * 32 + 4 * fq;
#pragma unroll
        for (int bj = 0; bj < 2; ++bj)
#pragma unroll
            for (int n = 0; n < 2; ++n) {
                const int col = col0 + bj * HALF + n * 16;
                const f32x4 bv = bias ? *(const f32x4*)(bias + col) : (f32x4){0.f, 0.f, 0.f, 0.f};
#pragma unroll
                for (int ai = 0; ai < 2; ++ai)
#pragma unroll
                    for (int m = 0; m < 4; ++m) *(f32x4*)(Cp + (size_t)(row0 + ai * HALF + m * 16) * ldc + col) = acc[ai][bj][m][n] + bv;
            }
    }
};
struct EpiSwiglu {
    static constexpr bool PERM = false;
    bf16_t* Hd; const float* bgu;
    __device__ __forceinline__ void operator()(const f32x4 (&acc)[2][2][4][2], const Unit& u, int wr, int wc, int fr, int fq) const {
        const int row0 = u.pm * BM + wr * 64 + fr, cg0 = u.pn * HALF + wc * 32 + 4 * fq;
        const float* bb = bgu + (size_t)u.e * 2048;
#pragma unroll
        for (int n = 0; n < 2; ++n) {
            const int cg = cg0 + n * 16;
            const f32x4 bg = *(const f32x4*)(bb + cg), bu = *(const f32x4*)(bb + 1024 + cg);
#pragma unroll
            for (int ai = 0; ai < 2; ++ai)
#pragma unroll
                for (int m = 0; m < 4; ++m) {
                    const f32x4 gv = acc[ai][0][m][n] + bg, uv = acc[ai][1][m][n] + bu; float hv[4];
#pragma unroll
                    for (int q = 0; q < 4; ++q) { const float gg = fminf(gv[q], 7.f), uu = fminf(fmaxf(uv[q], -7.f), 7.f); hv[q] = gg * (1.f / (1.f + __expf(-1.702f * gg))) * (uu + 1.f); }
                    u32x2 o; o.x = pk2(hv[0], hv[1]); o.y = pk2(hv[2], hv[3]);
                    *(u32x2*)(Hd + (size_t)(row0 + ai * HALF + m * 16) * 1024 + cg) = o;
                }
        }
    }
};
struct EpiBf16Bias {
    static constexpr bool PERM = false;
    bf16_t* Op; const float* bias; int bias_estride;
    __device__ __forceinline__ void operator()(const f32x4 (&acc)[2][2][4][2], const Unit& u, int wr, int wc, int fr, int fq) const {
        const int row0 = u.pm * BM + wr * 64 + fr, col0 = u.pn * BM + wc * 32 + 4 * fq;
        const float* bb = bias + (size_t)u.e * bias_estride;
#pragma unroll
        for (int bj = 0; bj < 2; ++bj)
#pragma unroll
            for (int n = 0; n < 2; ++n) {
                const int col = col0 + bj * HALF + n * 16;
                const f32x4 bv = *(const f32x4*)(bb + col);
#pragma unroll
                for (int ai = 0; ai < 2; ++ai)
#pragma unroll
                    for (int m = 0; m < 4; ++m) { const f32x4 v = acc[ai][bj][m][n] + bv; u32x2 o; o.x = pk2(v[0], v[1]); o.y = pk2(v[2], v[3]);
                        *(u32x2*)(Op + (size_t)(row0 + ai * HALF + m * 16) * 1024 + col) = o; }
            }
    }
};

struct EpiQKV {
    static constexpr bool PERM = false;
    bf16_t* Qp; bf16_t* Kp; bf16_t* Vp; const float* bias; const float* tab;
    __device__ __forceinline__ void operator()(const f32x4 (&acc)[2][2][4][2], const Unit& u, int wr, int wc, int fr, int fq) const {
        const bool lat = u.pm > 0; const float qs = 0.125f * LOG2E;
#pragma unroll
        for (int bj = 0; bj < 2; ++bj) {
            const int colt = u.pn * BM + bj * HALF + wc * 32 + 4 * fq;
            const f32x4 b1 = *(const f32x4*)(bias + colt), b2 = *(const f32x4*)(bias + colt + 16);
            const bool isv = (u.pn == 4) && (bj == 1);
#pragma unroll
            for (int ai = 0; ai < 2; ++ai)
#pragma unroll
                for (int m = 0; m < 4; ++m) {
                    const int r = u.pm * BM + ai * HALF + wr * 64 + m * 16 + fr, t = r - C;
                    f32x4 x1 = acc[ai][bj][m][0] + b1, x2 = acc[ai][bj][m][1] + b2;
                    if (lat && !isv) {
                        const int pos = (wc & 1) ? (t & 63) : (t >> 6);
                        const f32x4 t0 = *(const f32x4*)(tab + (pos * 16 + 4 * fq) * 2), t1 = *(const f32x4*)(tab + (pos * 16 + 4 * fq) * 2 + 4);
                        const float cs[4] = {t0[0], t0[2], t1[0], t1[2]}, sn[4] = {t0[1], t0[3], t1[1], t1[3]};
                        f32x4 o1, o2;
#pragma unroll
                        for (int e = 0; e < 4; ++e) { o1[e] = x1[e] * cs[e] - x2[e] * sn[e]; o2[e] = x2[e] * cs[e] + x1[e] * sn[e]; }
                        x1 = o1; x2 = o2;
                    }
                    u32x2 w1, w2;
                    if (u.pn < 4) {
                        w1.x = pk2(x1[0] * qs, x1[1] * qs); w1.y = pk2(x1[2] * qs, x1[3] * qs); w2.x = pk2(x2[0] * qs, x2[1] * qs); w2.y = pk2(x2[2] * qs, x2[3] * qs);
                        *(u32x2*)(Qp + (size_t)r * 1024 + colt) = w1; *(u32x2*)(Qp + (size_t)r * 1024 + colt + 16) = w2;
                    } else {
                        w1.x = pk2(x1[0], x1[1]); w1.y = pk2(x1[2], x1[3]); w2.x = pk2(x2[0], x2[1]); w2.y = pk2(x2[2], x2[3]);
                        bf16_t* dst = (bj == 0 ? Kp : Vp) + (size_t)r * 128 + wc * 32 + 4 * fq;
                        *(u32x2*)dst = w1; *(u32x2*)(dst + 16) = w2;
                    }
                }
        }
    }
};
struct EpiInProj {
    static constexpr bool PERM = false;
    bf16_t* QH; _Float16* KF; _Float16* KB; bf16_t* IV; bf16_t* SG; const float* lb;
    __device__ __forceinline__ void operator()(const f32x4 (&acc)[2][2][4][2], const Unit& u, int wr, int wc, int fr, int fq) const {
        const int seg = u.pn >> 2; const bool lat = u.pm > 0;
        if (!lat && (seg == 0 || seg == 4)) return;
#pragma unroll
        for (int bj = 0; bj < 2; ++bj)
#pragma unroll
            for (int n = 0; n < 2; ++n) {
                const int col = (u.pn & 3) * BM + bj * HALF + wc * 32 + n * 16 + 4 * fq;
                f32x4 lbv = (f32x4){0.f, 0.f, 0.f, 0.f};
                if (seg == 1) lbv = *(const f32x4*)(lb + col); else if (seg == 2) lbv = *(const f32x4*)(lb + 1024 + col);
#pragma unroll
                for (int ai = 0; ai < 2; ++ai)
#pragma unroll
                    for (int m = 0; m < 4; ++m) {
                        const int r = u.pm * BM + ai * HALF + wr * 64 + m * 16 + fr; const f32x4 v = acc[ai][bj][m][n];
                        if (seg == 1 || seg == 2) {
                            typedef _Float16 h4_t __attribute__((ext_vector_type(4)));
                            h4_t hv;
#pragma unroll
                            for (int e = 0; e < 4; ++e) hv[e] = (_Float16)((1.f - lbv[e]) / (1.f + __expf(v[e])));
                            *(h4_t*)((seg == 1 ? KF : KB) + (size_t)r * 1024 + col) = hv;
                        } else if (seg == 3) {
                            u32x2 o; o.x = pk2(v[0], v[1]); o.y = pk2(v[2], v[3]); *(u32x2*)(IV + (size_t)r * 1024 + col) = o;
                        } else {
                            float sv[4];
#pragma unroll
                            for (int e = 0; e < 4; ++e) sv[e] = v[e] / (1.f + __expf(-v[e]));
                            u32x2 o; o.x = pk2(sv[0], sv[1]); o.y = pk2(sv[2], sv[3]); *(u32x2*)((seg == 0 ? QH : SG) + (size_t)(r - C) * 1024 + col) = o;
                        }
                    }
            }
    }
};

template <class Epi, class Sched, bool ALIGN_EPI>
__device__ __forceinline__ void gemm_phase(LAS unsigned char* lds, const Gemm g, const Sched& S, const Epi& E) {
    const int tid = threadIdx.x, wid = __builtin_amdgcn_readfirstlane(tid >> 6), lane = tid & 63, wr = wid >> 2, wc = wid & 3, fr = lane & 15, fq = lane >> 4;
    constexpr int K = KD, nt = K / BK;
    int sR[2], sC[2]; unsigned voffB[2];
#pragma unroll
    for (int i = 0; i < 2; ++i) { stage_rc(tid * 16 + i * 8192, sR[i], sC[i]); const int Rb = Epi::PERM ? ((sR[i] & ~31) + perm32(sR[i] & 31)) : sR[i]; voffB[i] = (unsigned)(Rb * K + sC[i]) * 2u; }
    constexpr size_t kstep = (size_t)(BK * 2), hstep = (size_t)HALF * K * 2, tstep = 2 * hstep;
    const unsigned ldsw = (unsigned)wid * 1024u;
    const int aoff = lds_byte(wr * 64 + fr, fq * 8), boff = lds_byte(wc * 32 + fr, fq * 8);
    const char* Ab = (const char*)g.A;
#define PG8_SA(b, h) (((b) * 2 + (h)) * HTB)
#define PG8_SB(b, h) ((4 + (b) * 2 + (h)) * HTB)
#define PG8_STAGE_B(bufoff, gbase) do { _Pragma("unroll") for (int _i = 0; _i < 2; ++_i) \
        __builtin_amdgcn_global_load_lds((const unsigned*)((const char*)(gbase) + voffB[_i]), (LAS unsigned*)(lds + (bufoff) + ldsw + _i * 8192), 16, 0, 0); } while (0)
#define PG8_STAGE_A(bufoff, kb, v) do { _Pragma("unroll") for (int _i = 0; _i < 2; ++_i) \
        __builtin_amdgcn_global_load_lds((const unsigned*)(Ab + (size_t)(kb) + (v)[_i]), (LAS unsigned*)(lds + (bufoff) + ldsw + _i * 8192), 16, 0, 0); } while (0)
#define PG8_LDA(dst, b, h) do { _Pragma("unroll") for (int m = 0; m < 4; ++m) _Pragma("unroll") for (int k = 0; k < 2; ++k) dst[m][k] = *(const LAS bf16x8*)(lds + PG8_SA(b, h) + aoff + m * 2048 + k * 1024); } while (0)
#define PG8_LDB(dst, b, h) do { _Pragma("unroll") for (int n = 0; n < 2; ++n) _Pragma("unroll") for (int k = 0; k < 2; ++k) dst[n][k] = *(const LAS bf16x8*)(lds + PG8_SB(b, h) + boff + n * 2048 + k * 1024); } while (0)
#define PG8_MMA(ai, bj, At, Bt) do { __builtin_amdgcn_s_setprio(1); _Pragma("unroll") for (int m = 0; m < 4; ++m) _Pragma("unroll") for (int n = 0; n < 2; ++n) _Pragma("unroll") for (int k = 0; k < 2; ++k) \
        acc[ai][bj][m][n] = __builtin_amdgcn_mfma_f32_16x16x32_bf16(Bt[n][k], At[m][k], acc[ai][bj][m][n], 0, 0, 0); __builtin_amdgcn_s_setprio(0); } while (0)
#define PG8_WAIT_V(n) asm volatile("s_waitcnt vmcnt(" #n ")" ::: "memory")
#define PG8_WAIT_L(n) asm volatile("s_waitcnt lgkmcnt(" #n ")" ::: "memory")
#define PG8_BAR __builtin_amdgcn_s_barrier()
#define PG8_SCHED __builtin_amdgcn_sched_barrier(0)
    Unit cur, nxt; int ui = 0;
    if (!S.next(0, cur)) return;
    unsigned cv[2][2], nv[2][2];
    a_offsets(g, cur, sR, sC, cv);
    f32x4 acc[2][2][4][2];
#pragma unroll
    for (int a = 0; a < 2; ++a)
#pragma unroll
        for (int b = 0; b < 2; ++b)
#pragma unroll
            for (int m = 0; m < 4; ++m)
#pragma unroll
                for (int n = 0; n < 2; ++n) acc[a][b][m][n] = (f32x4){0.f, 0.f, 0.f, 0.f};
    bf16x8 At[4][2], B0[2][2], B1[2][2];
    const char* cB = (const char*)g.Bt + ((size_t)cur.e * g.bstride) * 2 + (size_t)cur.pn * tstep;
    PG8_STAGE_B(PG8_SB(0, 0), cB); PG8_STAGE_B(PG8_SB(0, 1), cB + hstep); PG8_STAGE_A(PG8_SA(0, 0), 0, cv[0]); PG8_STAGE_A(PG8_SA(0, 1), 0, cv[1]);
    if (wr == 1) PG8_BAR;
    PG8_WAIT_V(2); PG8_BAR;
    PG8_STAGE_B(PG8_SB(1, 0), cB + kstep); PG8_STAGE_A(PG8_SA(1, 0), kstep, cv[0]); PG8_STAGE_B(PG8_SB(1, 1), cB + hstep + kstep);
    PG8_WAIT_V(6); PG8_BAR;
    for (;;) {
        const bool has_next = S.next(ui + 1, nxt);
        const char* nB = cB;
        if (has_next) { a_offsets(g, nxt, sR, sC, nv); nB = (const char*)g.Bt + ((size_t)nxt.e * g.bstride) * 2 + (size_t)nxt.pn * tstep; }
        else {
#pragma unroll
            for (int h = 0; h < 2; ++h)
#pragma unroll
                for (int i = 0; i < 2; ++i) nv[h][i] = cv[h][i];
        }
        for (int t = 0; t < nt; t += 2) {
            const bool last = (t == nt - 2);
            const size_t k1 = (size_t)(t + 1) * kstep, k2 = last ? 0 : (size_t)(t + 2) * kstep, k3 = k2 + kstep;
            const char* b2 = last ? nB : cB + (size_t)(t + 2) * kstep; const char* b3 = b2 + kstep;
            unsigned w0[2], w1[2];
#pragma unroll
            for (int i = 0; i < 2; ++i) { w0[i] = last ? nv[0][i] : cv[0][i]; w1[i] = last ? nv[1][i] : cv[1][i]; }
            PG8_LDB(B0, 0, 0); PG8_LDB(B1, 0, 1); PG8_SCHED; PG8_LDA(At, 0, 0); PG8_STAGE_A(PG8_SA(1, 1), k1, cv[1]);
            PG8_WAIT_V(8); PG8_WAIT_L(0); PG8_BAR; PG8_MMA(0, 0, At, B0); PG8_MMA(0, 1, At, B1); PG8_BAR; PG8_SCHED;
            PG8_LDA(At, 0, 1); PG8_STAGE_B(PG8_SB(0, 0), b2); PG8_STAGE_B(PG8_SB(0, 1), b2 + hstep); PG8_STAGE_A(PG8_SA(0, 0), k2, w0);
            PG8_WAIT_V(8); PG8_WAIT_L(0); PG8_BAR; PG8_MMA(1, 0, At, B0); PG8_MMA(1, 1, At, B1); PG8_BAR; PG8_SCHED;
            PG8_LDB(B0, 1, 0); PG8_LDB(B1, 1, 1); PG8_SCHED; PG8_LDA(At, 1, 0); PG8_STAGE_A(PG8_SA(0, 1), k2, w1);
            PG8_WAIT_V(8); PG8_WAIT_L(0); PG8_BAR; PG8_MMA(0, 0, At, B0); PG8_MMA(0, 1, At, B1); PG8_BAR; PG8_SCHED;
            PG8_LDA(At, 1, 1); PG8_STAGE_B(PG8_SB(1, 0), b3); PG8_STAGE_B(PG8_SB(1, 1), b3 + hstep); PG8_STAGE_A(PG8_SA(1, 0), k3, w0);
            PG8_WAIT_V(8); PG8_WAIT_L(0); PG8_BAR; PG8_MMA(1, 0, At, B0); PG8_MMA(1, 1, At, B1); PG8_BAR; PG8_SCHED;
        }
        if constexpr (ALIGN_EPI) { if (wr == 0) PG8_BAR; }
        E(acc, cur, wr, wc, fr, fq);
        if (!has_next) break;
#pragma unroll
        for (int a = 0; a < 2; ++a)
#pragma unroll
            for (int b = 0; b < 2; ++b)
#pragma unroll
                for (int m = 0; m < 4; ++m)
#pragma unroll
                    for (int n = 0; n < 2; ++n) acc[a][b][m][n] = (f32x4){0.f, 0.f, 0.f, 0.f};
        cur = nxt; cB = nB; ++ui;
#pragma unroll
        for (int h = 0; h < 2; ++h)
#pragma unroll
            for (int i = 0; i < 2; ++i) cv[h][i] = nv[h][i];
        if constexpr (ALIGN_EPI) { if (wr == 1) PG8_BAR; }
    }
    PG8_WAIT_V(0);
    if constexpr (!ALIGN_EPI) { if (wr == 0) PG8_BAR; }
    PG8_BAR;
#undef PG8_SA
#undef PG8_SB
#undef PG8_STAGE_A
#undef PG8_STAGE_B
#undef PG8_LDA
#undef PG8_LDB
#undef PG8_MMA
#undef PG8_WAIT_V
#undef PG8_WAIT_L
#undef PG8_BAR
#undef PG8_SCHED
}
}

__device__ __forceinline__ void transpose_block(const float* W, int ldw, int n0, int k0, bf16_t* WTrow0  , LAS float* scr, int lane) {
    f32x4 v[16];
    const float* src = W + (size_t)(k0 + (lane >> 4)) * ldw + n0 + (lane & 15) * 4;
#pragma unroll
    for (int i = 0; i < 16; ++i) v[i] = *(const f32x4*)(src + (size_t)(4 * i) * ldw);
#pragma unroll
    for (int i = 0; i < 16; ++i) { LAS float* d = scr + ((lane >> 4) + 4 * i) * 65 + (lane & 15) * 4; d[0] = v[i].x; d[1] = v[i].y; d[2] = v[i].z; d[3] = v[i].w; }
    asm volatile("s_waitcnt lgkmcnt(0)" ::: "memory"); __builtin_amdgcn_wave_barrier();
    const int c8 = lane & 7;
#pragma unroll
    for (int jj = 0; jj < 8; ++jj) {
        const int n = (lane >> 3) + 8 * jj; const LAS float* p = scr + (8 * c8) * 65 + n;
        u32x4 o; o.x = pk2(p[0], p[65]); o.y = pk2(p[2 * 65], p[3 * 65]); o.z = pk2(p[4 * 65], p[5 * 65]); o.w = pk2(p[6 * 65], p[7 * 65]);
        *(u32x4*)(WTrow0 + (size_t)n * 1024 + k0 + 8 * c8) = o;
    }
    asm volatile("s_waitcnt lgkmcnt(0)" ::: "memory"); __builtin_amdgcn_wave_barrier();
}

__device__ __forceinline__ void phase_prep(const Ctx& c) {
    LAS float* red = (LAS float*)c.lds;
    const float* cv = c.a->in[1]; const float* ccv = c.a->in[3]; const float* ada_w = c.a->in[4]; const float* ada_b = c.a->in[5];
    for (int item = c.wg; item < 193; item += c.nwg) {
        if (item < 192) {
            const int layer = item / 96, cb = item % 96, col = cb * 64 + c.lane;
            const float* W = ada_w + (size_t)layer * D * 6144 + col;
            float a0 = 0.f, a1 = 0.f;
            const int k0 = c.wave * 128;
#pragma unroll 32
            for (int k = 0; k < 128; ++k) { const float w = W[(size_t)(k0 + k) * 6144]; a0 += silu_f(cv[k0 + k]) * w; a1 += silu_f(ccv[k0 + k]) * w; }
            red[(0 * 8 + c.wave) * 64 + c.lane] = a0; red[(1 * 8 + c.wave) * 64 + c.lane] = a1;
            __syncthreads();
            if (c.tid < 128) {
                const int which = c.tid >> 6, l = c.tid & 63; float s = 0.f;
#pragma unroll
                for (int w = 0; w < 8; ++w) s += red[(which * 8 + w) * 64 + l];
                c.modp(layer, which)[cb * 64 + l] = s + ada_b[layer * 6144 + cb * 64 + l];
            }
            __syncthreads();
        } else {
            float* modbase = (float*)(c.ws + WS_MOD);
            for (int i = c.tid; i < 4096; i += 512) {
                const int pos = i >> 4, j = i & 15;
                const double ang = (double)pos * pow(10000.0, -(double)j / 16.0);
                modbase[MOD_ROPE + 2 * i] = (float)cos(ang); modbase[MOD_ROPE + 2 * i + 1] = (float)sin(ang);
            }
            const float* lbp = c.a->in[12];
            for (int i = c.tid; i < 2048; i += 512) { const float p0 = lbp[i], p1 = lbp[2048 + i]; modbase[MOD_LB + i] = 1.f / (1.f + __expf(p0 - p1)); }
        }
    }
}

__device__ __forceinline__ void row_load(const float* p, int lane, f32x4 (&v)[4]) {
#pragma unroll
    for (int j = 0; j < 4; ++j) v[j] = *(const f32x4*)(p + lane * 4 + 256 * j);
}
__device__ __forceinline__ float row_ss(const f32x4 (&v)[4]) {
    float s = 0.f;
#pragma unroll
    for (int j = 0; j < 4; ++j) s += v[j].x * v[j].x + v[j].y * v[j].y + v[j].z * v[j].z + v[j].w * v[j].w;
    return wave_sum(s);
}
__device__ __forceinline__ void row_modnorm_store(const f32x4 (&x)[4], float rstd, const float* g, const float* sh, const float* sc, bf16_t* out, int lane, f32x4 (*hout)[4] = nullptr) {
#pragma unroll
    for (int j = 0; j < 4; ++j) {
        const int c0 = lane * 4 + 256 * j;
        const f32x4 gv = *(const f32x4*)(g + c0), shv = *(const f32x4*)(sh + c0), scv = *(const f32x4*)(sc + c0);
        f32x4 h;
        h.x = x[j].x * rstd * gv.x * (1.f + scv.x) + shv.x; h.y = x[j].y * rstd * gv.y * (1.f + scv.y) + shv.y;
        h.z = x[j].z * rstd * gv.z * (1.f + scv.z) + shv.z; h.w = x[j].w * rstd * gv.w * (1.f + scv.w) + shv.w;
        if (hout) (*hout)[j] = h;
        u32x2 o; o.x = pk2(h.x, h.y); o.y = pk2(h.z, h.w);
        *(u32x2*)(out + c0) = o;
    }
}

__device__ __forceinline__ void phase_norm0(const Ctx& c) {
    bf16_t* H = (bf16_t*)(c.ws + WS_H); const float* ng = c.a->in[6];
    for (int r = c.wg * 8 + c.wave; r < R; r += c.nwg * 8) {
        f32x4 x[4]; row_load(c.xin0(r), c.lane, x);
        const float rstd = rsqrtf(row_ss(x) * (1.f / D) + EPS);
        const float* m = c.modp(0, r < C ? 1 : 0);
        row_modnorm_store(x, rstd, ng, m + 0, m + 1024, H + (size_t)r * D, c.lane);
    }
}

namespace at {
constexpr int KP = 144, TILEB = 64 * KP;
__device__ __forceinline__ bf16x8 tr_frag2(const LAS unsigned char* tile, int row0, int col0, int lane) {
    const int q = (lane & 15) >> 2, p = lane & 3;
    const LAS unsigned char* a = tile + (row0 + q) * KP + (col0 + 4 * p) * 2;
    const v4i16_t lo = __builtin_amdgcn_ds_read_tr16_b64_v4i16((LAS v4i16_t*)a);
    const v4i16_t hi = __builtin_amdgcn_ds_read_tr16_b64_v4i16((LAS v4i16_t*)(a + 16 * KP));
    return (bf16x8){lo[0], lo[1], lo[2], lo[3], hi[0], hi[1], hi[2], hi[3]};
}
}
__device__ __forceinline__ void phase_attn(const Ctx& c) {
    using namespace at;
    const bf16_t* Q = (const bf16_t*)(c.ws + WS_Q); const bf16_t* K = (const bf16_t*)(c.ws + WS_K); const bf16_t* V = (const bf16_t*)(c.ws + WS_V);
    bf16_t* O = (bf16_t*)(c.ws + WS_O); const float* sink = c.a->in[9];
    LAS unsigned char* lds = c.lds;
    const int tid = c.tid, lane = c.lane, w = __builtin_amdgcn_readfirstlane(tid >> 6), fr = lane & 15, g = lane >> 4;
    const int lrow = tid >> 3, lch = tid & 7;
    for (int item = c.wg; item < 264; item += c.nwg) {
        const bool isctx = item >= 256;
        const int ci = item - 256;
        const int n = isctx ? 0 : (item >> 1), kh = isctx ? ((ci >> 1) & 1) : (item & 1), cb = isctx ? (ci >> 2) : 0;
        const int p_lo = isctx ? (ci & 1) : 0, p_hi = isctx ? (ci & 1) + 1 : 2;
        const int hq = kh * 8 + w;
        const float sink2 = sink[hq] * LOG2E;
        for (int pass = p_lo; pass < p_hi; ++pass) {
            const int t0 = 128 * n + 64 * pass, qrow0 = isctx ? cb * 128 + 64 * pass : C + t0;
            const int jlo = isctx ? 0 : (t0 >= 128 ? 0 : (128 - t0) / 64), jhi = isctx ? 0 : ((L - t0 + 128) / 64 < 5 ? (L - t0 + 128) / 64 : 5);
            const int ntile = 4 + (jhi - jlo);
            bf16x8 Qf[4][2];
#pragma unroll
            for (int qb = 0; qb < 4; ++qb)
#pragma unroll
                for (int ks = 0; ks < 2; ++ks) Qf[qb][ks] = *(const bf16x8*)(Q + (size_t)(qrow0 + 16 * qb + fr) * D + hq * 64 + 32 * ks + 8 * g);
            float mrow[4], lsum[4]; f32x4 OT[4][4];
#pragma unroll
            for (int qb = 0; qb < 4; ++qb) { mrow[qb] = sink2; lsum[qb] = 1.f;
#pragma unroll
                for (int nt = 0; nt < 4; ++nt) OT[qb][nt] = (f32x4){0.f, 0.f, 0.f, 0.f}; }
            u32x4 kreg, vreg;
#define AT_KROW(ti) ((ti) < 4 ? 64 * (ti) : C + t0 - 128 + 64 * (jlo + (ti) - 4))
#define AT_LOAD(ti) do { const size_t ro_ = (size_t)(AT_KROW(ti) + lrow) * 128 + kh * 64 + lch * 8; kreg = *(const u32x4*)(K + ro_); vreg = *(const u32x4*)(V + ro_); } while (0)
#define AT_WRITE(buf) do { *(LAS u32x4*)(lds + (buf) * 2 * TILEB + lrow * KP + lch * 16) = kreg; *(LAS u32x4*)(lds + (buf) * 2 * TILEB + TILEB + lrow * KP + lch * 16) = vreg; } while (0)
            AT_LOAD(0); AT_WRITE(0);
            __syncthreads();
            for (int ti = 0; ti < ntile; ++ti) {
                if (ti + 1 < ntile) AT_LOAD(ti + 1);
                const LAS unsigned char* kb = lds + (ti & 1) * 2 * TILEB; const LAS unsigned char* vb = kb + TILEB;
                const int jj = jlo + ti - 4; const bool masked = (ti >= 4) && (jj == 0 || jj == 4);
                const int k0 = t0 - 128 + 64 * jj;
                bf16x8 Kf[4][2], Vf[4][2];
#pragma unroll
                for (int mt = 0; mt < 4; ++mt)
#pragma unroll
                    for (int ks = 0; ks < 2; ++ks) { Kf[mt][ks] = *(const LAS bf16x8*)(kb + (16 * mt + fr) * KP + (32 * ks + 8 * g) * 2); Vf[mt][ks] = tr_frag2(vb, 32 * ks + 4 * g, 16 * mt, lane); }
#pragma unroll
                for (int qb = 0; qb < 4; ++qb) {
                    f32x4 sa[4];
#pragma unroll
                    for (int mt = 0; mt < 4; ++mt) { sa[mt] = (f32x4){0.f, 0.f, 0.f, 0.f};
#pragma unroll
                        for (int ks = 0; ks < 2; ++ks) sa[mt] = __builtin_amdgcn_mfma_f32_16x16x32_bf16(Kf[mt][ks], Qf[qb][ks], sa[mt], 0, 0, 0); }
                    if (masked) {
                        const int tq = t0 + 16 * qb + fr;
#pragma unroll
                        for (int mt = 0; mt < 4; ++mt)
#pragma unroll
                            for (int e = 0; e < 4; ++e) { const int dt = tq - (k0 + 16 * mt + 4 * g + e); if (dt > 128 || dt < -128) sa[mt][e] = -INFINITY; }
                    }
                    float mx = fmaxf(fmaxf(sa[0][0], sa[0][1]), fmaxf(sa[0][2], sa[0][3]));
#pragma unroll
                    for (int mt = 1; mt < 4; ++mt) mx = fmaxf(mx, fmaxf(fmaxf(sa[mt][0], sa[mt][1]), fmaxf(sa[mt][2], sa[mt][3])));
                    mx = fmaxf(mx, __shfl_xor(mx, 16)); mx = fmaxf(mx, __shfl_xor(mx, 32));
                    const float mn = fmaxf(mrow[qb], mx), alpha = __builtin_amdgcn_exp2f(mrow[qb] - mn);
                    mrow[qb] = mn;
                    float rs = 0.f;
#pragma unroll
                    for (int mt = 0; mt < 4; ++mt)
#pragma unroll
                        for (int e = 0; e < 4; ++e) { const float pv = __builtin_amdgcn_exp2f(sa[mt][e] - mn); sa[mt][e] = pv; rs += pv; }
                    rs += __shfl_xor(rs, 16); rs += __shfl_xor(rs, 32);
                    lsum[qb] = lsum[qb] * alpha + rs;
                    bf16x8 Pb[2];
#pragma unroll
                    for (int ks = 0; ks < 2; ++ks) { const f32x4 a0 = sa[2 * ks], a1 = sa[2 * ks + 1];
                        const u32x4 pk = (u32x4){pk2(a0[0], a0[1]), pk2(a0[2], a0[3]), pk2(a1[0], a1[1]), pk2(a1[2], a1[3])}; Pb[ks] = __builtin_bit_cast(bf16x8, pk); }
#pragma unroll
                    for (int nt = 0; nt < 4; ++nt) { OT[qb][nt] = OT[qb][nt] * alpha;
#pragma unroll
                        for (int ks = 0; ks < 2; ++ks) OT[qb][nt] = __builtin_amdgcn_mfma_f32_16x16x32_bf16(Vf[nt][ks], Pb[ks], OT[qb][nt], 0, 0, 0); }
                }
                if (ti + 1 < ntile) AT_WRITE((ti + 1) & 1);
                __syncthreads();
            }
#undef AT_KROW
#undef AT_LOAD
#undef AT_WRITE
#pragma unroll
            for (int qb = 0; qb < 4; ++qb) {
                const float il = 1.f / lsum[qb];
                bf16_t* op = O + (size_t)(qrow0 + 16 * qb + fr) * D + hq * 64 + 4 * g;
#pragma unroll
                for (int nt = 0; nt < 4; ++nt) { const f32x4 v = OT[qb][nt] * il; u32x2 o; o.x = pk2(v[0], v[1]); o.y = pk2(v[2], v[3]); *(u32x2*)(op + 16 * nt) = o; }
            }
        }
    }
}

__device__ __forceinline__ void phase_postmix(const Ctx& c, int layer) {
    const float* Y = (const float*)(c.ws + WS_RAW1); bf16_t* H = (bf16_t*)(c.ws + WS_H);
    float* Xout = (float*)(c.ws + (layer == 0 ? WS_X : WS_X1)); const float* Xprev = (const float*)(c.ws + WS_X);
    const float* ng = c.a->in[6] + layer * 4 * D; const float* Wr = c.a->in[15] + (size_t)layer * D * NE; const float* br = c.a->in[16] + layer * NE;
    unsigned* cnt = (unsigned*)(c.ws + WS_CTL) + CW_CNT + layer * NE;
    int* tk_e = (int*)(c.ws + WS_TK); float* tk_g = (float*)(c.ws + WS_TK) + R * 4; int* tk_slot = (int*)(c.ws + WS_TK) + 2 * R * 4;
    int* list = (int*)(c.ws + WS_LIST);
    LAS float* WL = (LAS float*)c.lds;
    LAS float* biasp = (LAS float*)(c.lds + 131072);
    const int lane = c.lane, w = __builtin_amdgcn_readfirstlane(c.tid >> 6), fr = lane & 15, g = lane >> 4;
    const int g_lo = layer == 0 ? 0 : C / 128;
    for (int grp = g_lo + c.wg; grp < R / 128; grp += c.nwg) {
        const int which = grp * 128 < C ? 1 : 0;
        const float* m = c.modp(layer, which);
        __syncthreads();
        for (int idx = c.tid; idx < D * NE; idx += 512) {
            const int k = idx >> 5, e = idx & 31;
            WL[(((k & 255) * 4 + (k >> 8)) * 16 + (e & 15)) * 2 + (e >> 4)] = Wr[idx] * ng[2 * D + k] * (1.f + m[4096 + k]);
        }
        { const int e = c.tid & 31, part = c.tid >> 5; float sacc = 0.f;
          for (int k = part * 64; k < part * 64 + 64; ++k) sacc += m[3072 + k] * Wr[k * NE + e];
          biasp[32 + part * 32 + e] = sacc; }
        __syncthreads();
        if (c.tid < 32) { float sacc = br[c.tid]; for (int p = 0; p < 16; ++p) sacc += biasp[32 + p * 32 + c.tid]; biasp[c.tid] = sacc; }
        __syncthreads();
        const int row0 = grp * 128 + w * 16;
        float rs_keep = 0.f;
        for (int i = 0; i < 16; ++i) {
            const int r = row0 + i;
            const float* xsrc = layer == 0 ? c.xin0(r) : Xprev + (size_t)r * D;
            f32x4 y[4], x[4]; row_load(Y + (size_t)(layer == 0 ? r : r - C) * D, lane, y); row_load(xsrc, lane, x);
            const float rstd_y = rsqrtf(row_ss(y) * (1.f / D) + EPS);
#pragma unroll
            for (int j = 0; j < 4; ++j) {
                const int c0 = lane * 4 + 256 * j;
                const f32x4 g1 = *(const f32x4*)(m + 2048 + c0), n1 = *(const f32x4*)(ng + D + c0);
                x[j].x += g1.x * (y[j].x * rstd_y * n1.x); x[j].y += g1.y * (y[j].y * rstd_y * n1.y);
                x[j].z += g1.z * (y[j].z * rstd_y * n1.z); x[j].w += g1.w * (y[j].w * rstd_y * n1.w);
                *(f32x4*)(Xout + (size_t)r * D + c0) = x[j];
            }
            const float rstd_x = rsqrtf(row_ss(x) * (1.f / D) + EPS);
            row_modnorm_store(x, rstd_x, ng + 2 * D, m + 3072, m + 4096, H + (size_t)r * D, lane);
            if (lane == i) rs_keep = rstd_x;
        }
        asm volatile("s_waitcnt vmcnt(0)" ::: "memory");
        f32x4 la[2]; la[0] = (f32x4){0.f, 0.f, 0.f, 0.f}; la[1] = la[0];
        {
            const float* ap = Xout + (size_t)(row0 + fr) * D + 256 * g;
            const LAS float* bp = WL + (g * 16 + fr) * 2;
#pragma unroll 4
            for (int k4 = 0; k4 < 64; ++k4) {
                const f32x4 a4 = *(const f32x4*)(ap + 4 * k4);
#pragma unroll
                for (int q = 0; q < 4; ++q) {
                    const f32x2 b2 = *(const LAS f32x2*)(bp + (size_t)(4 * k4 + q) * 128);
                    la[0] = __builtin_amdgcn_mfma_f32_16x16x4f32(a4[q], b2[0], la[0], 0, 0, 0);
                    la[1] = __builtin_amdgcn_mfma_f32_16x16x4f32(a4[q], b2[1], la[1], 0, 0, 0);
                }
            }
        }
        float tv[4][4]; int te[4][4];
#pragma unroll
        for (int e = 0; e < 4; ++e) {
            const float rs = __shfl(rs_keep, 4 * g + e);
            float v0 = la[0][e] * rs + biasp[fr], v1 = la[1][e] * rs + biasp[16 + fr];
#pragma unroll
            for (int k = 0; k < 4; ++k) {
                float bv; int bi;
                if (v0 >= v1) { bv = v0; bi = fr; } else { bv = v1; bi = 16 + fr; }
#pragma unroll
                for (int o = 8; o > 0; o >>= 1) {
                    const float ov = __shfl_xor(bv, o); const int oi = __shfl_xor(bi, o);
                    if (ov > bv || (ov == bv && oi < bi)) { bv = ov; bi = oi; }
                }
                tv[e][k] = bv; te[e][k] = bi;
                if (bi == fr) v0 = -INFINITY;
                if (bi == 16 + fr) v1 = -INFINITY;
            }
        }
        if (fr < 4) {
            float v[4]; int ex[4];
#pragma unroll
            for (int k = 0; k < 4; ++k) { v[k] = tv[0][k]; ex[k] = te[0][k];
#pragma unroll
                for (int e = 1; e < 4; ++e) if (fr == e) { v[k] = tv[e][k]; ex[k] = te[e][k]; } }
            const int r = row0 + 4 * g + fr;
            const float e1 = __expf(v[1] - v[0]), e2 = __expf(v[2] - v[0]), e3 = __expf(v[3] - v[0]);
            const float inv = 1.f / (1.f + e1 + e2 + e3);
            const float gk[4] = {inv, e1 * inv, e2 * inv, e3 * inv};
#pragma unroll
            for (int k = 0; k < 4; ++k) {
                const unsigned slot = atomicAdd(&cnt[ex[k]], 1u);
                list[(size_t)ex[k] * R + slot] = r;
                tk_e[r * 4 + k] = ex[k]; tk_g[r * 4 + k] = gk[k]; tk_slot[r * 4 + k] = (int)slot;
            }
        }
    }
}

__device__ __forceinline__ void moe_offsets(const Ctx& c, int layer, LAS int* so) {
    const unsigned* cnt = (const unsigned*)(c.ws + WS_CTL) + CW_CNT + layer * NE;
    __syncthreads();
    if (c.tid == 0) { int acc = 0; for (int e = 0; e < NE; ++e) { const int n = (int)cnt[e]; so[e] = acc; so[64 + e] = n; acc += (n + PADM - 1) / PADM * PADM; } so[32] = acc; }
    __syncthreads();
}

__device__ __forceinline__ void moe_tables(const Ctx& c, int layer, LAS int* tb) {
    const unsigned* cnt = (const unsigned*)(c.ws + WS_CTL) + CW_CNT + layer * NE;
    __syncthreads();
    if (c.tid == 0) { int acc = 0; for (int e = 0; e < NE; ++e) { const int n = (int)cnt[e]; tb[e] = acc; tb[64 + e] = n; acc += (n + PADM - 1) / PADM; } tb[32] = acc; }
    __syncthreads();
}
__device__ __forceinline__ int vcu_of(const Ctx& c) { return (c.nwg % 8 == 0) ? (c.wg % 8) * (c.nwg / 8) + c.wg / 8 : c.wg; }
__device__ __forceinline__ void phase_moe_gu(const Ctx& c, int layer) {
    LAS int* tb = (LAS int*)(c.lds + 131072 + 1024);
    moe_tables(c, layer, tb);
    pg8::Gemm g{(const bf16_t*)(c.ws + WS_H), (const bf16_t*)(c.ws + WS_WGU) + (size_t)layer * NE * 2048 * 1024, (size_t)2048 * 1024, (const int*)(c.ws + WS_LIST)};
    pg8::MoeOrder S{tb, tb + 64, 8, c.nwg, vcu_of(c)};
    pg8::EpiSwiglu E{(bf16_t*)(c.ws + WS_HDN), c.a->in[18] + (size_t)layer * NE * 2048};
    pg8::gemm_phase<pg8::EpiSwiglu, pg8::MoeOrder, true>(c.lds, g, S, E);
}
__device__ __forceinline__ void phase_moe_dn(const Ctx& c, int layer) {
    LAS int* tb = (LAS int*)(c.lds + 131072 + 1024);
    moe_tables(c, layer, tb);
    pg8::Gemm g{(const bf16_t*)(c.ws + WS_HDN), (const bf16_t*)(c.ws + WS_WDN) + (size_t)layer * NE * 1024 * 1024, (size_t)1024 * 1024, nullptr};
    pg8::MoeOrder S{tb, tb + 64, 4, c.nwg, vcu_of(c)};
    pg8::EpiBf16Bias E{(bf16_t*)(c.ws + WS_OUTB), c.a->in[20] + (size_t)layer * NE * 1024, 1024};
    pg8::gemm_phase<pg8::EpiBf16Bias, pg8::MoeOrder, true>(c.lds, g, S, E);
}
__device__ __forceinline__ void phase_gemm_f32(const Ctx& c, const bf16_t* A, int M, const bf16_t* Bt, int N, const float* bias, float* Cout) {
    pg8::Gemm g{A, Bt, 0, nullptr}; pg8::StaticOrder S; S.init(M, N, c.nwg, c.wg);
    pg8::EpiF32 E{Cout, N, bias};
    pg8::gemm_phase<pg8::EpiF32, pg8::StaticOrder, true>(c.lds, g, S, E);
}

__device__ __forceinline__ void phase_gemm_qkv(const Ctx& c) {
    pg8::Gemm g{(const bf16_t*)(c.ws + WS_H), (const bf16_t*)(c.ws + WS_WQKV), 0, nullptr}; pg8::StaticOrder S; S.init(R, QKVD, c.nwg, c.wg);
    pg8::EpiQKV E{(bf16_t*)(c.ws + WS_Q), (bf16_t*)(c.ws + WS_K), (bf16_t*)(c.ws + WS_V), c.a->in[8], (const float*)(c.ws + WS_MOD) + MOD_ROPE};
    pg8::gemm_phase<pg8::EpiQKV, pg8::StaticOrder, true>(c.lds, g, S, E);
}
__device__ __forceinline__ void phase_gemm_inproj(const Ctx& c) {
    pg8::Gemm g{(const bf16_t*)(c.ws + WS_H), (const bf16_t*)(c.ws + WS_WIN), 0, nullptr}; pg8::StaticOrder S; S.init(R, HIN, c.nwg, c.wg);
    pg8::EpiInProj E{(bf16_t*)(c.ws + WS_QH), (_Float16*)(c.ws + WS_KF), (_Float16*)(c.ws + WS_KB), (bf16_t*)(c.ws + WS_IV), (bf16_t*)(c.ws + WS_SG), (const float*)(c.ws + WS_MOD) + MOD_LB};
    pg8::gemm_phase<pg8::EpiInProj, pg8::StaticOrder, true>(c.lds, g, S, E);
}

__device__ __forceinline__ void phase_norm0(const Ctx& c);
__device__ __forceinline__ void phase_convert(const Ctx& c) {
    LAS float* scr = (LAS float*)c.lds + c.wave * (64 * 65);
    const int gw = c.wg * 8 + c.wave, NGW = c.nwg * 8;
    constexpr int I_QKV = 20 * 16, I_O = 16 * 16, I_IN = 80 * 16, I_HO = 16 * 16, I_GU = 64 * 32 * 16, I_DN = 64 * 16 * 16, TOT = I_QKV + I_O + I_IN + I_HO + I_GU + I_DN;
    for (int it = gw; it < TOT; it += NGW) {
        int r = it;
        if (r < I_QKV) { const int nb = r % 20, kb = r / 20; transpose_block(c.a->in[7], QKVD, nb * 64, kb * 64, (bf16_t*)(c.ws + WS_WQKV) + (size_t)nb * 64 * 1024, scr, c.lane); continue; } r -= I_QKV;
        if (r < I_O) { const int nb = r % 16, kb = r / 16; transpose_block(c.a->in[10], D, nb * 64, kb * 64, (bf16_t*)(c.ws + WS_WO) + (size_t)nb * 64 * 1024, scr, c.lane); continue; } r -= I_O;
        if (r < I_IN) { const int nb = r % 80, kb = r / 80; transpose_block(c.a->in[11], HIN, nb * 64, kb * 64, (bf16_t*)(c.ws + WS_WIN) + (size_t)nb * 64 * 1024, scr, c.lane); continue; } r -= I_IN;
        if (r < I_HO) { const int nb = r % 16, kb = r / 16; transpose_block(c.a->in[14], D, nb * 64, kb * 64, (bf16_t*)(c.ws + WS_WHO) + (size_t)nb * 64 * 1024, scr, c.lane); continue; } r -= I_HO;
        if (r < I_GU) { const int mat = r / 512, rr = r % 512, nb = rr % 32, kb = rr / 32; const int n0 = ((nb & 3) >> 1) * 1024 + (nb >> 2) * 128 + (nb & 1) * 64;
            transpose_block(c.a->in[17] + (size_t)mat * 1024 * 2048, 2048, n0, kb * 64, (bf16_t*)(c.ws + WS_WGU) + ((size_t)mat * 2048 + nb * 64) * 1024, scr, c.lane); continue; } r -= I_GU;
        { const int mat = r / 256, rr = r % 256, nb = rr % 16, kb = rr / 16;
            transpose_block(c.a->in[19] + (size_t)mat * 1024 * 1024, 1024, nb * 64, kb * 64, (bf16_t*)(c.ws + WS_WDN) + ((size_t)mat * 1024 + nb * 64) * 1024, scr, c.lane); }
    }
    __syncthreads();
    phase_norm0(c);
}

__device__ __forceinline__ void phase_combine(const Ctx& c, int layer) {
    LAS int* so = (LAS int*)(c.lds + 32768);
    moe_offsets(c, layer, so);
    const bf16_t* outb = (const bf16_t*)(c.ws + WS_OUTB); float* X = (float*)(c.ws + WS_X); bf16_t* H = (bf16_t*)(c.ws + WS_H);
    const float* ngl = c.a->in[6] + layer * 4 * D;
    const int* tk_e = (const int*)(c.ws + WS_TK); const float* tk_g = (const float*)(c.ws + WS_TK) + R * 4; const int* tk_slot = (const int*)(c.ws + WS_TK) + 2 * R * 4;
    const int r_lo = layer == 0 ? 0 : C;
    for (int r = r_lo + c.wg * 8 + c.wave; r < R; r += c.nwg * 8) {
        const float* m = c.modp(layer, r < C ? 1 : 0);
        f32x4 y[4];
#pragma unroll
        for (int j = 0; j < 4; ++j) y[j] = (f32x4){0.f, 0.f, 0.f, 0.f};
#pragma unroll
        for (int k = 0; k < 4; ++k) {
            const int e = tk_e[r * 4 + k], slot = tk_slot[r * 4 + k]; const float g = tk_g[r * 4 + k];
            const bf16_t* src = outb + (size_t)(so[e] + slot) * 1024;
#pragma unroll
            for (int j = 0; j < 4; ++j) { const u32x2 w = *(const u32x2*)(src + c.lane * 4 + 256 * j); y[j] += (f32x4){bflo(w.x), bfhi(w.x), bflo(w.y), bfhi(w.y)} * g; }
        }
        const float rstd_y = rsqrtf(row_ss(y) * (1.f / D) + EPS);
        f32x4 x[4]; row_load((layer == 0 ? X : (const float*)(c.ws + WS_X1)) + (size_t)r * D, c.lane, x);
#pragma unroll
        for (int j = 0; j < 4; ++j) {
            const int c0 = c.lane * 4 + 256 * j;
            const f32x4 g2 = *(const f32x4*)(m + 5120 + c0), n3 = *(const f32x4*)(ngl + 3 * D + c0);
            x[j].x += g2.x * (y[j].x * rstd_y * n3.x); x[j].y += g2.y * (y[j].y * rstd_y * n3.y);
            x[j].z += g2.z * (y[j].z * rstd_y * n3.z); x[j].w += g2.w * (y[j].w * rstd_y * n3.w);
            if (layer == 0) *(f32x4*)(X + (size_t)r * D + c0) = x[j];
            else *(f32x4*)(c.a->out + (size_t)(r - C) * D + c0) = x[j];
        }
        if (layer == 0) {
            const float rstd_x = rsqrtf(row_ss(x) * (1.f / D) + EPS);
            const float* m1 = c.modp(1, r < C ? 1 : 0);
            row_modnorm_store(x, rstd_x, c.a->in[6] + 4 * D, m1 + 0, m1 + 1024, H + (size_t)r * D, c.lane);
        }
    }
}

namespace hg {
typedef _Float16 h2_t __attribute__((ext_vector_type(2)));
constexpr int TB = 272, PB = 144;
constexpr int TILE = 64 * TB;
constexpr int T_QD = 0, T_QC = TILE, T_KD = 2 * TILE, T_KE = 3 * TILE, T_KC = 4 * TILE, T_V0 = 5 * TILE, T_V1 = 6 * TILE;
constexpr int T_QL1 = 7 * TILE, T_KL1 = T_QL1 + 16 * TB, T_P = T_KL1 + 16 * TB, T_TOT = T_P + 64 * PB, T_CT = T_TOT + 4096, T_END = T_CT + 512;
static_assert(T_END <= LDS_BYTES - 64, "hgrn scan LDS map");
__device__ __forceinline__ int row_of(int dir, int p) { return p < C ? (dir ? C - 1 - p : p) : (dir ? C + (L - 1 - (p - C)) : p); }
__device__ __forceinline__ int seg_of(int ch) { return ch < 68 ? ch / 17 : 4 + (ch - 68) / 16; }
__device__ __forceinline__ bf16x8 tr_frag(const LAS unsigned char* tile, int row0, int col0, int lane) {
    const int q = (lane & 15) >> 2, p = lane & 3;
    const LAS unsigned char* a = tile + (row0 + q) * TB + (col0 + 4 * p) * 2;
    const v4i16_t lo = __builtin_amdgcn_ds_read_tr16_b64_v4i16((LAS v4i16_t*)a);
    const v4i16_t hi = __builtin_amdgcn_ds_read_tr16_b64_v4i16((LAS v4i16_t*)(a + 4 * TB));
    return (bf16x8){lo[0], lo[1], lo[2], lo[3], hi[0], hi[1], hi[2], hi[3]};
}
}

__device__ __forceinline__ void phase_hgrn_scan(const Ctx& c) {
    using namespace hg;
    const bf16_t* QH = (const bf16_t*)(c.ws + WS_QH); const bf16_t* IV = (const bf16_t*)(c.ws + WS_IV);
    LAS unsigned char* lds = c.lds;
    const int tid = c.tid, lane = c.lane, w = __builtin_amdgcn_readfirstlane(tid >> 6), fr = lane & 15, g = lane >> 4;
    for (int item = c.wg; item < 256; item += c.nwg) {
        const int chain = item >> 4, seg = item & 15, head = chain >> 1, dir = chain & 1, hc = head * 128;
        const int c0 = seg < 4 ? 17 * seg : 68 + 16 * (seg - 4), nch = seg < 4 ? 17 : 16;
        const _Float16* KX = (const _Float16*)(c.ws + (dir ? WS_KB : WS_KF));
        float* OL = (float*)(c.ws + (dir ? WS_OB : WS_OF)); bf16_t* QS = (bf16_t*)(c.ws + (dir ? WS_QSB : WS_QSF));
        __syncthreads();
        for (int i = tid; i < 64 * PB / 4; i += 512) ((LAS unsigned*)(lds + T_P))[i] = 0u;
        f32x4 Sacc[8];
#pragma unroll
        for (int m = 0; m < 8; ++m) Sacc[m] = (f32x4){0.f, 0.f, 0.f, 0.f};
        float dseg0 = 1.f, dseg1 = 1.f;
        unsigned kraw[8], qraw[8]; u32x4 vraw[2];
#define HG_LOAD(cidx) do { const int p0_ = 64 * (cidx); const bool lat_ = (cidx) >= 4; \
        _Pragma("unroll") for (int i = 0; i < 8; ++i) { const int r_ = row_of(dir, p0_ + 8 * w + i); \
            kraw[i] = *(const unsigned*)(KX + (size_t)r_ * D + hc + 2 * lane); \
            qraw[i] = lat_ ? *(const unsigned*)(QH + (size_t)(r_ - C) * D + hc + 2 * lane) : 0u; } \
        _Pragma("unroll") for (int i = 0; i < 2; ++i) { const int idx_ = tid + 512 * i; const int r_ = row_of(dir, p0_ + (idx_ >> 4)); \
            vraw[i] = *(const u32x4*)(IV + (size_t)r_ * D + hc + (idx_ & 15) * 8); } } while (0)
        HG_LOAD(c0);
        for (int ci = 0; ci < nch; ++ci) {
            const int cidx = c0 + ci; const bool lat = cidx >= 4;
            const int vbuf = (ci & 1) ? T_V1 : T_V0;
            float kf[8][2], qf[8][2], cp[8][2];
            {
                float p0 = 1.f, p1 = 1.f;
#pragma unroll
                for (int i = 0; i < 8; ++i) {
                    const h2_t hv = __builtin_bit_cast(h2_t, kraw[i]);
                    kf[i][0] = (float)hv[0]; kf[i][1] = (float)hv[1];
                    qf[i][0] = bflo(qraw[i]); qf[i][1] = bfhi(qraw[i]);
                    p0 *= (1.f - kf[i][0]); p1 *= (1.f - kf[i][1]); cp[i][0] = p0; cp[i][1] = p1;
                }
                *(LAS f32x2*)(lds + T_TOT + (w * 128 + 2 * lane) * 4) = (f32x2){p0, p1};
#pragma unroll
                for (int i = 0; i < 2; ++i) { const int idx = tid + 512 * i; *(LAS u32x4*)(lds + vbuf + (idx >> 4) * TB + (idx & 15) * 16) = vraw[i]; }
            }
            __syncthreads();
            {
                f32x2 T[8];
#pragma unroll
                for (int x = 0; x < 8; ++x) T[x] = *(const LAS f32x2*)(lds + T_TOT + (x * 128 + 2 * lane) * 4);
                const int I = w >> 1, hh = w & 1;
                f32x2 bd[4];
#pragma unroll
                for (int x = 0; x < 4; ++x) bd[x] = T[2 * x] * T[2 * x + 1];
                f32x2 pre = (f32x2){1.f, 1.f}, cum = (f32x2){1.f, 1.f}, suf = (f32x2){1.f, 1.f}, bdI = (f32x2){1.f, 1.f};
#pragma unroll
                for (int x = 0; x < 8; ++x) if (hh && x == w - 1) pre = T[x];
#pragma unroll
                for (int x = 0; x < 4; ++x) { if (x < I) cum = cum * bd[x]; if (x > I) suf = suf * bd[x]; if (x == I) bdI = bd[x]; }
                const f32x2 ctot = (bd[0] * bd[1]) * (bd[2] * bd[3]);
#pragma unroll
                for (int i = 0; i < 8; ++i) {
                    const int tau = 8 * w + i;
                    float QDv[2], KDv[2], KEv[2], QCv[2], KCv[2];
#pragma unroll
                    for (int x = 0; x < 2; ++x) {
                        const float eq = pre[x] * cp[i][x], rc = __builtin_amdgcn_rcpf(eq);
                        QDv[x] = qf[i][x] * eq; KDv[x] = kf[i][x] * rc; KEv[x] = KDv[x] * bdI[x]; QCv[x] = QDv[x] * cum[x]; KCv[x] = KEv[x] * suf[x];
                    }
                    const int to = tau * TB + lane * 4;
                    *(LAS unsigned*)(lds + T_QD + to) = pk2(QDv[0], QDv[1]);
                    *(LAS unsigned*)(lds + T_KD + to) = pk2(KDv[0], KDv[1]);
                    *(LAS unsigned*)(lds + T_KE + to) = pk2(KEv[0], KEv[1]);
                    *(LAS unsigned*)(lds + T_QC + to) = pk2(QCv[0], QCv[1]);
                    *(LAS unsigned*)(lds + T_KC + to) = pk2(KCv[0], KCv[1]);
                    if (I == 3) *(LAS unsigned*)(lds + T_QL1 + (tau - 48) * TB + lane * 4) = pk2(QDv[0] * bd[2][0], QDv[1] * bd[2][1]);
                    if (I == 0) *(LAS unsigned*)(lds + T_KL1 + tau * TB + lane * 4) = pk2(KEv[0] * bd[1][0], KEv[1] * bd[1][1]);
                    if (lat) { const int r = row_of(dir, 64 * cidx + tau); *(unsigned*)(QS + (size_t)(r - C) * D + hc + 2 * lane) = pk2(QCv[0] * dseg0, QCv[1] * dseg1); }
                }
                dseg0 *= ctot[0]; dseg1 *= ctot[1];
                if (w == 0) *(LAS f32x2*)(lds + T_CT + lane * 8) = ctot;
            }
            __syncthreads();
            if (ci + 1 < nch) HG_LOAD(cidx + 1);
            if (lat) {
                const int nblk = w >= 6 ? 2 : 1;
                for (int b = 0; b < nblk; ++b) {
                    int I, J, qoff, qrow, koff, krow; bool diag = false;
                    if (w < 4) { I = 2 + (w >> 1); J = w & 1; qoff = (w >> 1) ? T_QL1 : T_QD; qrow = (w >> 1) ? 0 : 32; koff = (w & 1) ? T_KE : T_KL1; krow = (w & 1) ? 16 : 0; }
                    else if (w == 4) { I = 1; J = 0; qoff = T_QD; qrow = 16; koff = T_KE; krow = 0; }
                    else if (w == 5) { I = 3; J = 2; qoff = T_QD; qrow = 48; koff = T_KE; krow = 32; }
                    else { I = 2 * (w - 6) + b; J = I; qoff = T_QD; qrow = 16 * I; koff = T_KD; krow = 16 * I; diag = true; }
                    f32x4 pa = (f32x4){0.f, 0.f, 0.f, 0.f};
#pragma unroll
                    for (int ks = 0; ks < 4; ++ks) {
                        const bf16x8 av = *(const LAS bf16x8*)(lds + qoff + (qrow + fr) * TB + (32 * ks + 8 * g) * 2);
                        const bf16x8 bv = *(const LAS bf16x8*)(lds + koff + (krow + fr) * TB + (32 * ks + 8 * g) * 2);
                        pa = __builtin_amdgcn_mfma_f32_16x16x32_bf16(av, bv, pa, 0, 0, 0);
                    }
#pragma unroll
                    for (int e = 0; e < 4; ++e) {
                        const int tl = 4 * g + e; const float val = (diag && fr > tl) ? 0.f : pa[e];
                        *(LAS bf16_t*)(lds + T_P + (16 * I + tl) * PB + (16 * J + fr) * 2) = (bf16_t)f2bf(val);
                    }
                }
            }
            f32x4 oacc[4];
#pragma unroll
            for (int m = 0; m < 4; ++m) oacc[m] = (f32x4){0.f, 0.f, 0.f, 0.f};
            if (lat) {
                bf16x8 Sb[4];
#pragma unroll
                for (int ks = 0; ks < 4; ++ks) {
                    const f32x4 a0 = Sacc[2 * ks], a1 = Sacc[2 * ks + 1];
                    const u32x4 pk = (u32x4){pk2(a0[0], a0[1]), pk2(a0[2], a0[3]), pk2(a1[0], a1[1]), pk2(a1[2], a1[3])};
                    Sb[ks] = __builtin_bit_cast(bf16x8, pk);
                }
#pragma unroll
                for (int m = 0; m < 4; ++m)
#pragma unroll
                    for (int ks = 0; ks < 4; ++ks) {
                        const u32x2 lo = *(const LAS u32x2*)(lds + T_QC + (16 * m + fr) * TB + (32 * ks + 4 * g) * 2);
                        const u32x2 hi = *(const LAS u32x2*)(lds + T_QC + (16 * m + fr) * TB + (32 * ks + 16 + 4 * g) * 2);
                        const u32x4 pk = (u32x4){lo.x, lo.y, hi.x, hi.y};
                        oacc[m] = __builtin_amdgcn_mfma_f32_16x16x32_bf16(__builtin_bit_cast(bf16x8, pk), Sb[ks], oacc[m], 0, 0, 0);
                    }
            }
#pragma unroll
            for (int m = 0; m < 8; ++m) { const f32x4 ct = *(const LAS f32x4*)(lds + T_CT + (16 * m + 4 * g) * 4); Sacc[m] = Sacc[m] * ct; }
            bf16x8 Vf[2];
#pragma unroll
            for (int ks = 0; ks < 2; ++ks) Vf[ks] = tr_frag(lds + vbuf, 32 * ks + 8 * g, 16 * w, lane);
#pragma unroll
            for (int m = 0; m < 8; ++m)
#pragma unroll
                for (int ks = 0; ks < 2; ++ks) Sacc[m] = __builtin_amdgcn_mfma_f32_16x16x32_bf16(tr_frag(lds + T_KC, 32 * ks + 8 * g, 16 * m, lane), Vf[ks], Sacc[m], 0, 0, 0);
            __syncthreads();
            if (lat) {
#pragma unroll
                for (int m = 0; m < 4; ++m)
#pragma unroll
                    for (int ks = 0; ks < 2; ++ks) {
                        if (m < 2 && ks == 1) continue;
                        const bf16x8 av = *(const LAS bf16x8*)(lds + T_P + (16 * m + fr) * PB + (32 * ks + 8 * g) * 2);
                        oacc[m] = __builtin_amdgcn_mfma_f32_16x16x32_bf16(av, Vf[ks], oacc[m], 0, 0, 0);
                    }
#pragma unroll
                for (int m = 0; m < 4; ++m)
#pragma unroll
                    for (int e = 0; e < 4; ++e) { const int r = row_of(dir, 64 * cidx + 16 * m + 4 * g + e); OL[(size_t)(r - C) * D + hc + 16 * w + fr] = oacc[m][e]; }
            }
        }
#undef HG_LOAD
        float* DS = (float*)(c.ws + WS_DS) + (size_t)item * 16384; float* DG = (float*)(c.ws + WS_DG) + item * 128;
#pragma unroll
        for (int m = 0; m < 8; ++m)
#pragma unroll
            for (int e = 0; e < 4; ++e) DS[(16 * m + 4 * g + e) * 128 + 16 * w + fr] = Sacc[m][e];
        if (w == 0) { DG[2 * lane] = dseg0; DG[2 * lane + 1] = dseg1; }
    }
}

__device__ __forceinline__ void phase_hgrn_fold(const Ctx& c) {
    const float* DS = (const float*)(c.ws + WS_DS); const float* DG = (const float*)(c.ws + WS_DG); bf16_t* SST = (bf16_t*)(c.ws + WS_SST);
    for (int item = c.wg; item < 256; item += c.nwg) {
        const int chain = item >> 4, slice = item & 15, d = 8 * slice + (c.tid >> 6), v2 = (c.tid & 63) * 2;
        float s0 = 0.f, s1 = 0.f;
        float dv[15]; f32x2 ds[15];
#pragma unroll
        for (int sgi = 0; sgi < 15; ++sgi) { dv[sgi] = DG[(chain * 16 + sgi) * 128 + d]; ds[sgi] = *(const f32x2*)(DS + ((size_t)(chain * 16 + sgi) * 128 + d) * 128 + v2); }
        SST[((size_t)(chain * 16) * 128 + v2) * 128 + d] = 0; SST[((size_t)(chain * 16) * 128 + v2 + 1) * 128 + d] = 0;
#pragma unroll
        for (int sgi = 0; sgi < 15; ++sgi) {
            s0 = dv[sgi] * s0 + ds[sgi][0]; s1 = dv[sgi] * s1 + ds[sgi][1];
            SST[((size_t)(chain * 16 + sgi + 1) * 128 + v2) * 128 + d] = (bf16_t)f2bf(s0); SST[((size_t)(chain * 16 + sgi + 1) * 128 + v2 + 1) * 128 + d] = (bf16_t)f2bf(s1);
        }
    }
}

__device__ __forceinline__ void phase_hgrn_readout(const Ctx& c) {
    const float* OF = (const float*)(c.ws + WS_OF); const float* OB = (const float*)(c.ws + WS_OB); const bf16_t* SGp = (const bf16_t*)(c.ws + WS_SG);
    const bf16_t* SST = (const bf16_t*)(c.ws + WS_SST); bf16_t* RR = (bf16_t*)(c.ws + WS_RR); const float* hng = c.a->in[13];
    const int lane = c.lane, fr = lane & 15, g = lane >> 4;
    for (int it = c.wg * 8 + c.wave; it < 8192; it += c.nwg * 8) {
        const int tt = it >> 3, h = it & 7, t0 = 16 * tt, ch = t0 >> 6;
        f32x4 acc[8]; float sgv[8][4];
#pragma unroll
        for (int n = 0; n < 8; ++n)
#pragma unroll
            for (int e = 0; e < 4; ++e) { const size_t o = (size_t)(t0 + 4 * g + e) * D + h * 128 + 16 * n + fr; acc[n][e] = OF[o] + OB[o]; sgv[n][e] = bf2f(SGp[o]) * hng[h * 128 + 16 * n + fr]; }
#pragma unroll
        for (int dx = 0; dx < 2; ++dx) {
            const int sg = hg::seg_of(dx ? 4 + 255 - ch : 4 + ch);
            const bf16_t* QS = (const bf16_t*)(c.ws + (dx ? WS_QSB : WS_QSF)) + (size_t)(t0 + fr) * D + h * 128 + 8 * g;
            const bf16_t* ST = SST + ((size_t)((h * 2 + dx) * 16 + sg) * 128 + fr) * 128 + 8 * g;
#pragma unroll
            for (int ks = 0; ks < 4; ++ks) {
                const bf16x8 av = *(const bf16x8*)(QS + 32 * ks);
#pragma unroll
                for (int n = 0; n < 8; ++n) acc[n] = __builtin_amdgcn_mfma_f32_16x16x32_bf16(av, *(const bf16x8*)(ST + (size_t)(16 * n) * 128 + 32 * ks), acc[n], 0, 0, 0);
            }
        }
        float ss[4] = {0.f, 0.f, 0.f, 0.f};
#pragma unroll
        for (int n = 0; n < 8; ++n)
#pragma unroll
            for (int e = 0; e < 4; ++e) { const float v = acc[n][e]; ss[e] += v * v; }
#pragma unroll
        for (int e = 0; e < 4; ++e) {
#pragma unroll
            for (int sh = 8; sh > 0; sh >>= 1) ss[e] += __shfl_xor(ss[e], sh);
            ss[e] = rsqrtf(ss[e] * (1.f / 128.f) + EPS);
        }
#pragma unroll
        for (int n = 0; n < 8; ++n)
#pragma unroll
            for (int e = 0; e < 4; ++e) { const size_t o = (size_t)(t0 + 4 * g + e) * D + h * 128 + 16 * n + fr; RR[o] = (bf16_t)f2bf(acc[n][e] * ss[e] * sgv[n][e]); }
    }
}

#define XB_TMO      128
#define XB_XCNT(j)  (256  + 64 * (j))
#define XB_XSUB(j)  (1280 + 64 * (j))
#define XB_XGEN(j)  (2304 + 64 * (j))
#define XB_TOP      3328
#define XB_TOPGEN   3392
#define XCD_BAR_WORDS 3456
#define XB_SPIN_CAP (1u << 18)
__device__ __forceinline__ unsigned xb_ld(unsigned* p)              { return __hip_atomic_load(p, __ATOMIC_RELAXED, __HIP_MEMORY_SCOPE_AGENT); }
__device__ __forceinline__ unsigned xb_add(unsigned* p, unsigned v) { return __hip_atomic_fetch_add(p, v, __ATOMIC_RELAXED, __HIP_MEMORY_SCOPE_AGENT); }
__device__ __forceinline__ unsigned xb_xcc_id() { return (unsigned)__builtin_amdgcn_s_getreg((3 << 11) | 20) & 0xFu; }
#define XB_SPIN(cond, bar) do { unsigned _sp = 0; while (cond) { __builtin_amdgcn_s_sleep(1); \
    if ((++_sp & 255u) == 0u) { if (xb_ld(&(bar)[XB_TMO])) break; if (_sp > XB_SPIN_CAP) { atomicAdd(&(bar)[XB_TMO], 1u); break; } } } } while (0)
struct XcdBarrier { unsigned* bar; unsigned x; volatile LAS unsigned* st; };
__device__ __forceinline__ XcdBarrier xcd_barrier_post(unsigned* bar, volatile LAS unsigned* st) {
    XcdBarrier b; b.bar = bar; b.x = xb_xcc_id(); b.st = st;
    if (threadIdx.x == 0) (void)xb_add(&bar[XB_XCNT(b.x)], 1u);
    return b;
}
__device__ __forceinline__ void xcd_barrier_complete(unsigned* bar, unsigned x, unsigned& nloc, unsigned& nx) {
    const unsigned G = gridDim.x * gridDim.y * gridDim.z;
    unsigned sum, cnt, mine, sp = 0u;
    for (;;) {
        sum = 0u; cnt = 0u; mine = 0u;
#pragma unroll
        for (unsigned j = 0; j < 16; ++j) { const unsigned c = xb_ld(&bar[XB_XCNT(j)]); sum += c; cnt += (c > 0u) ? 1u : 0u; mine = (j == x) ? c : mine; }
        if (sum == G) break;
        __builtin_amdgcn_s_sleep(1);
        if ((++sp & 255u) == 0u) { if (xb_ld(&bar[XB_TMO])) break; if (sp > XB_SPIN_CAP) { atomicAdd(&bar[XB_TMO], 1u); break; } }
    }
    nloc = mine > 0u ? mine : 1u; nx = cnt > 0u ? cnt : 1u;
}
__device__ __forceinline__ void xcd_barrier(const XcdBarrier& b) {
    asm volatile("s_waitcnt vmcnt(0)" ::: "memory");
    __syncthreads();
    if (threadIdx.x == 0) {
        unsigned* bar = b.bar;
        __builtin_amdgcn_s_waitcnt(0);
        unsigned nloc = b.st[0], nx = b.st[1];
        if (nloc == 0u) { xcd_barrier_complete(bar, b.x, nloc, nx); b.st[0] = nloc; b.st[1] = nx; }
        const unsigned old = xb_add(&bar[XB_XSUB(b.x)], 1u);
        const unsigned gen = old / nloc;
        if (old + 1u == (gen + 1u) * nloc) {
            __builtin_amdgcn_fence(__ATOMIC_RELEASE, "agent");
            asm volatile("s_waitcnt vmcnt(0)" ::: "memory");
            const unsigned og = xb_add(&bar[XB_TOP], 1u);
            const unsigned tg = og / nx;
            if (og + 1u == (tg + 1u) * nx) xb_add(&bar[XB_TOPGEN], 1u);
            else XB_SPIN(xb_ld(&bar[XB_TOPGEN]) == tg, bar);
            __builtin_amdgcn_fence(__ATOMIC_ACQUIRE, "agent");
            xb_add(&bar[XB_XGEN(b.x)], 1u);
            asm volatile("s_waitcnt vmcnt(0)" ::: "memory");
        } else {
            XB_SPIN(xb_ld(&bar[XB_XGEN(b.x)]) == gen, bar);
            __builtin_amdgcn_fence(__ATOMIC_ACQUIRE, "agent");
            asm volatile("s_waitcnt vmcnt(0)" ::: "memory");
        }
    }
    __syncthreads();
}

__device__ __forceinline__ void launder(Ctx& c) { asm volatile("" : "+s"(c.a)); asm volatile("" : "+s"(c.ws)); }
__global__ void __launch_bounds__(512, 2) mk_fwd(Args args) {
    extern __shared__ __attribute__((aligned(16))) unsigned char lds_raw[];
    Ctx c; c.a = (CArgs)__builtin_amdgcn_kernarg_segment_ptr(); c.lds = (LAS unsigned char*)lds_raw; c.tid = threadIdx.x; c.lane = c.tid & 63; c.wave = c.tid >> 6; c.nwg = gridDim.x; c.wg = blockIdx.x; c.ws = c.a->ws;
    volatile LAS unsigned* bst = (volatile LAS unsigned*)(c.lds + LDS_BYTES - 64);
    if (c.tid < 4) bst[c.tid] = 0u;
    __syncthreads();
    const XcdBarrier bar = xcd_barrier_post((unsigned*)(c.ws + WS_CTL) + CW_BAR, bst);
    const int lo = c.a->ph_lo, hi = c.a->ph_hi;
#define SEAM(k) do { if (lo <= (k) && (k) + 1 < hi) xcd_barrier(bar); } while (0)
#define IN(k) (lo <= (k) && (k) < hi && (launder(c), true))
#define PH(k, call) do { if (IN(k)) { call; if (PROBE_PH == (k)) { xcd_barrier(bar); call; xcd_barrier(bar); call; } } SEAM(k); } while (0)
    PH(0, phase_prep(c));
    PH(1, phase_convert(c));
    PH(2, phase_gemm_qkv(c));
    PH(3, phase_attn(c));
    PH(4, phase_gemm_f32(c, (const bf16_t*)(c.ws + WS_O), R, (const bf16_t*)(c.ws + WS_WO), D, nullptr, (float*)(c.ws + WS_RAW1)));
    PH(5, phase_postmix(c, 0));
    PH(6, phase_moe_gu(c, 0));
    PH(7, phase_moe_dn(c, 0));
    PH(8, phase_combine(c, 0));
    PH(9, phase_gemm_inproj(c));
    PH(10, phase_hgrn_scan(c));
    PH(11, phase_hgrn_fold(c));
    PH(12, phase_hgrn_readout(c));
    PH(13, phase_gemm_f32(c, (const bf16_t*)(c.ws + WS_RR), L, (const bf16_t*)(c.ws + WS_WHO), D, nullptr, (float*)(c.ws + WS_RAW1)));
    PH(14, phase_postmix(c, 1));
    PH(15, phase_moe_gu(c, 1));
    PH(16, phase_moe_dn(c, 1));
    PH(17, phase_combine(c, 1));
#undef IN
#undef PH
#undef SEAM
}

extern "C" void kernel_launch(void* const* d_in, const int* in_sizes, int n_in, void* d_out, int out_size, void* d_ws, size_t ws_size, hipStream_t stream) {
    static int grid = 0;
    if (grid == 0) {
        if (n_in != 21 || out_size != L * D || ws_size < WS_END) { fprintf(stderr, "kernel_launch: unexpected problem (n_in %d out %d ws %zu need %zu)\n", n_in, out_size, ws_size, (size_t)WS_END); grid = -1; return; }
        int dev = 0, cus = 0, per_cu = 0;
        hipGetDevice(&dev); hipDeviceGetAttribute(&cus, hipDeviceAttributeMultiprocessorCount, dev);
        if (hipFuncSetAttribute((const void*)mk_fwd, hipFuncAttributeMaxDynamicSharedMemorySize, LDS_BYTES) != hipSuccess) { fprintf(stderr, "kernel_launch: hipFuncSetAttribute failed\n"); grid = -1; return; }
        hipOccupancyMaxActiveBlocksPerMultiprocessor(&per_cu, (const void*)mk_fwd, 512, LDS_BYTES);
        if (per_cu < 1) fprintf(stderr, "kernel_launch: occupancy query says %d\n", per_cu);
        (void)hipGetLastError();
        grid = cus > 0 ? cus : 256;
    }
    if (grid < 0) return;
    hipMemsetAsync((char*)d_ws + WS_CTL, 0, MiB, stream);
    Args a{};
    for (int i = 0; i < 21; ++i) a.in[i] = (const float*)d_in[i];
    a.out = (float*)d_out; a.ws = (unsigned char*)d_ws;
    a.ph_lo = 0; a.ph_hi = NPHASE;
    hipLaunchKernelGGL(mk_fwd, dim3(grid), dim3(512), LDS_BYTES, stream, a);
}
```

```cpp
#include <hip/hip_runtime.h>
#include <cstdint>
#include <cstdio>

#define LAS __attribute__((address_space(3)))
typedef unsigned short bf16_t;
typedef short bf16x8 __attribute__((ext_vector_type(8)));
typedef float f32x4 __attribute__((ext_vector_type(4)));
typedef unsigned u32x4 __attribute__((ext_vector_type(4)));
typedef unsigned u32x2 __attribute__((ext_vector_type(2)));
typedef short v4i16_t __attribute__((ext_vector_type(4)));
typedef float f32x2 __attribute__((ext_vector_type(2)));

constexpr int D = 1024, L = 16384, C = 256, R = L + C;
constexpr int QKVD = 1280, HIN = 5120, NE = 32, TOPK = 4;
constexpr int PADM = 256, MAXROWS = 74752;
constexpr float EPS = 1e-6f;
constexpr float LOG2E = 1.4426950408889634f;
constexpr int NPHASE = 18;
#ifndef SCAN_REP
#define SCAN_REP 1
#endif
#ifndef PROBE_PH
#define PROBE_PH (-1)
#endif
constexpr int LDS_BYTES = 147456;

constexpr size_t MiB = 1u << 20;
constexpr size_t al(size_t x) { return (x + MiB - 1) / MiB * MiB; }
constexpr size_t WS_CTL = 0;
constexpr size_t WS_MOD = WS_CTL + MiB;
constexpr size_t WS_X = WS_MOD + MiB;
constexpr size_t WS_H = WS_X + al((size_t)R * D * 4);
constexpr size_t WS_Q = WS_H + al((size_t)R * D * 2);
constexpr size_t WS_K = WS_Q + al((size_t)R * D * 2);
constexpr size_t WS_V = WS_K + al((size_t)R * 128 * 2);
constexpr size_t WS_O = WS_V + al((size_t)R * 128 * 2);
constexpr size_t WS_TK = WS_O + al((size_t)R * D * 2);
constexpr size_t WS_LIST = WS_TK + MiB;
constexpr size_t WS_HDN = WS_LIST + 3 * MiB;
constexpr size_t WS_RAW1 = WS_HDN + al((size_t)MAXROWS * 1024 * 2);
constexpr size_t WS_X1 = WS_RAW1 + al((size_t)R * D * 4);
constexpr size_t WS_OUTB = WS_X1 + al((size_t)R * D * 4);
constexpr size_t WS_QH = WS_OUTB + al((size_t)MAXROWS * 1024 * 2);
constexpr size_t WS_KF = WS_QH + al((size_t)L * D * 2);
constexpr size_t WS_KB = WS_KF + al((size_t)R * D * 2);
constexpr size_t WS_IV = WS_KB + al((size_t)R * D * 2);
constexpr size_t WS_SG = WS_IV + al((size_t)R * D * 2);
constexpr size_t WS_OF = WS_SG + al((size_t)L * D * 2);
constexpr size_t WS_OB = WS_OF + al((size_t)L * D * 4);
constexpr size_t WS_RR = WS_OB + al((size_t)L * D * 4);
constexpr size_t WS_WQKV = WS_RR + al((size_t)L * D * 2);
constexpr size_t WS_WO = WS_WQKV + al((size_t)QKVD * D * 2);
constexpr size_t WS_WIN = WS_WO + al((size_t)D * D * 2);
constexpr size_t WS_WHO = WS_WIN + al((size_t)HIN * D * 2);
constexpr size_t WS_WGU = WS_WHO + al((size_t)D * D * 2);
constexpr size_t WS_WDN = WS_WGU + al((size_t)2 * NE * 2048 * D * 2);
constexpr size_t WS_QSF = WS_WDN + al((size_t)2 * NE * 1024 * D * 2);
constexpr size_t WS_QSB = WS_QSF + al((size_t)L * D * 2);
constexpr size_t WS_DS = WS_QSB + al((size_t)L * D * 2);
constexpr size_t WS_DG = WS_DS + al((size_t)256 * 128 * 128 * 4);
constexpr size_t WS_SST = WS_DG + MiB;
constexpr size_t WS_END = WS_SST + al((size_t)256 * 128 * 128 * 2);
static_assert(WS_END <= (size_t)2048 * MiB, "workspace map exceeds 4x the largest input");
constexpr int CW_CNT = 1024;
constexpr int CW_BAR = 4096;
constexpr int MOD_ROPE = 32768;
constexpr int MOD_LB = 49152;

struct Args { const float* in[21]; float* out; unsigned char* ws; int ph_lo, ph_hi; };

__device__ __forceinline__ unsigned f2bf(float f) { unsigned u = __float_as_uint(f); return (u + 0x7fffu + ((u >> 16) & 1u)) >> 16; }
__device__ __forceinline__ unsigned pk2(float lo, float hi) { return f2bf(lo) | (f2bf(hi) << 16); }
__device__ __forceinline__ float bflo(unsigned u) { return __uint_as_float(u << 16); }
__device__ __forceinline__ float bfhi(unsigned u) { return __uint_as_float(u & 0xffff0000u); }
__device__ __forceinline__ float bf2f(bf16_t b) { return __uint_as_float(((unsigned)b) << 16); }
__device__ __forceinline__ float wave_sum(float v) {
#pragma unroll
    for (int o = 32; o > 0; o >>= 1) v += __shfl_xor(v, o);
    return v;
}
__device__ __forceinline__ float silu_f(float x) { return x / (1.f + __expf(-x)); }
__device__ __forceinline__ float sigmoid_f(float x) { return 1.f / (1.f + __expf(-x)); }

typedef const __attribute__((address_space(4))) Args* CArgs;
struct Ctx {
    CArgs a;
    LAS unsigned char* lds;
    int tid, lane, wave, nwg, wg;
    unsigned char* ws;
    __device__ __forceinline__ float* modp(int layer, int which) const { return (float*)(ws + WS_MOD) + (layer * 2 + which) * 6144; }
    __device__ __forceinline__ const float* xin0(int r) const { return r < C ? a->in[2] + (size_t)r * D : a->in[0] + (size_t)(r - C) * D; }
};


namespace pg8 {
constexpr int BM = 256, BK = 64, HALF = 128, HTB = HALF * BK * 2, STAGE_BYTES = 8 * HTB, KD = 1024, NXCD = 8, WGM = 8;
__device__ __forceinline__ int lds_byte(int r, int c) { const int st = (r >> 4) * 2 + (c >> 5), rr = r & 15, cc = c & 31, ob = rr * 64 + cc * 2; return st * 1024 + (ob ^ (((ob >> 9) & 1) << 5)); }
__device__ __forceinline__ void stage_rc(int b, int& Rr, int& Cc) { const int st = b / 1024, sb = b % 1024, swz = sb ^ (((sb >> 9) & 1) << 5); Rr = (st >> 1) * 16 + swz / 64; Cc = (st & 1) * 32 + (swz % 64) / 2; }
__device__ __forceinline__ int perm32(int rho) { const int n = rho >> 4, i = rho & 15; return 8 * (i >> 2) + 4 * n + (i & 3); }

struct Unit { int pm, pn, e, goff, gcnt; };
struct Gemm { const bf16_t* A; const bf16_t* Bt; size_t bstride; const int* list; };

struct StaticOrder {
    int nM, nN, nwg, G, c;
    __device__ __forceinline__ void init(int M, int N, int G_, int c_) { nM = M / BM; nN = N / BM; nwg = nM * nN; G = G_; c = c_; }
    __device__ __forceinline__ bool next(int i, Unit& u) const {
        const long Lq = (long)i * G + c; if (Lq >= nwg) return false;
        int wgid = (int)Lq; { const int q = nwg / NXCD, r = nwg % NXCD, xcd = wgid % NXCD, off = wgid / NXCD; wgid = (xcd < r ? xcd * (q + 1) : r * (q + 1) + (xcd - r) * q) + off; }
        const int nig = WGM * nN, gid = wgid / nig, fm = gid * WGM, gsz = (nM - fm) < WGM ? (nM - fm) : WGM;
        u.pm = fm + ((wgid % nig) % gsz); u.pn = (wgid % nig) / gsz; u.e = 0; u.goff = 0; u.gcnt = 0; return true;
    }
};
struct MoeOrder {
    const LAS int* tp; const LAS int* cnt; int npn, G, vcu;
    __device__ __forceinline__ bool next(int i, Unit& u) const {
        const int lin = i * G + vcu; if (lin >= tp[32] * npn) return false;
        const int rt = lin / npn; int e = 0;
#pragma unroll 8
        for (int k = 1; k < 32; ++k) e += (rt >= tp[k]) ? 1 : 0;
        const int mt = rt - tp[e];
        u.pm = rt; u.pn = lin - rt * npn; u.e = e; u.goff = e * R + mt * 256; u.gcnt = cnt[e] - mt * 256; return true;
    }
};

__device__ __forceinline__ void a_offsets(const Gemm& g, const Unit& u, const int (&sR)[2], const int (&sC)[2], unsigned (&v)[2][2]) {
#pragma unroll
    for (int h = 0; h < 2; ++h)
#pragma unroll
        for (int i = 0; i < 2; ++i) {
            const int rr = h * HALF + sR[i]; int row;
            if (g.list) row = rr < u.gcnt ? g.list[u.goff + rr] : 0; else row = u.pm * BM + rr;
            v[h][i] = (unsigned)(row * KD + sC[i]) * 2u;
        }
}

struct EpiF32 {
    static constexpr bool PERM = false;
    float* Cp; int ldc; const float* bias;
    __device__ __forceinline__ void operator()(const f32x4 (&acc)[2][2][4][2], const Unit& u, int wr, int wc, int fr, int fq) const {
        const int row0 = u.pm * BM + wr * 64 + fr, col0 = u.pn * BM + wc * 32 + 4 * fq;
#pragma unroll
        for (int bj = 0; bj < 2; ++bj)
#pragma unroll
            for (int n = 0; n < 2; ++n) {
                const int col = col0 + bj * HALF + n * 16;
                const f32x4 bv = bias ? *(const f32x4*)(bias + col) : (f32x4){0.f, 0.f, 0.f, 0.f};
#pragma unroll
                for (int ai = 0; ai < 2; ++ai)
#pragma unroll
                    for (int m = 0; m < 4; ++m) *(f32x4*)(Cp + (size_t)(row0 + ai * HALF + m * 16) * ldc + col) = acc[ai][bj][m][n] + bv;
            }
    }
};
struct EpiSwiglu {
    static constexpr bool PERM = false;
    bf16_t* Hd; const float* bgu;
    __device__ __forceinline__ void operator()(const f32x4 (&acc)[2][2][4][2], const Unit& u, int wr, int wc, int fr, int fq) const {
        const int row0 = u.pm * BM + wr * 64 + fr, cg0 = u.pn * HALF + wc * 32 + 4 * fq;
        const float* bb = bgu + (size_t)u.e * 2048;
#pragma unroll
        for (int n = 0; n < 2; ++n) {
            const int cg = cg0 + n * 16;
            const f32x4 bg = *(const f32x4*)(bb + cg), bu = *(const f32x4*)(bb + 1024 + cg);
#pragma unroll
            for (int ai = 0; ai < 2; ++ai)
#pragma unroll
                for (int m = 0; m < 4; ++m) {
                    const f32x4 gv = acc[ai][0][m][n] + bg, uv = acc[ai][1][m][n] + bu; float hv[4];
#pragma unroll
                    for (int q = 0; q < 4; ++q) { const float gg = fminf(gv[q], 7.f), uu = fminf(fmaxf(uv[q], -7.f), 7.f); hv[q] = gg * (1.f / (1.f + __expf(-1.702f * gg))) * (uu + 1.f); }
                    u32x2 o; o.x = pk2(hv[0], hv[1]); o.y = pk2(hv[2], hv[3]);
                    *(u32x2*)(Hd + (size_t)(row0 + ai * HALF + m * 16) * 1024 + cg) = o;
                }
        }
    }
};
struct EpiBf16Bias {
    static constexpr bool PERM = false;
    bf16_t* Op; const float* bias; int bias_estride;
    __device__ __forceinline__ void operator()(const f32x4 (&acc)[2][2][4][2], const Unit& u, int wr, int wc, int fr, int fq) const {
        const int row0 = u.pm * BM + wr * 64 + fr, col0 = u.pn * BM + wc * 32 + 4 * fq;
        const float* bb = bias + (size_t)u.e * bias_estride;
#pragma unroll
        for (int bj = 0; bj < 2; ++bj)
#pragma unroll
            for (int n = 0; n < 2; ++n) {
                const int col = col0 + bj * HALF + n * 16;
                const f32x4 bv = *(const f32x4*)(bb + col);
#pragma unroll
                for (int ai = 0; ai < 2; ++ai)
#pragma unroll
                    for (int m = 0; m < 4; ++m) { const f32x4 v = acc[ai][bj][m][n] + bv; u32x2 o; o.x = pk2(v[0], v[1]); o.y = pk2(v[2], v[3]);
                        *(u32x2*)(Op + (size_t)(row0 + ai * HALF + m * 16) * 1024 + col) = o; }
            }
    }
};

struct EpiQKV {
    static constexpr bool PERM = false;
    bf16_t* Qp; bf16_t* Kp; bf16_t* Vp; const float* bias; const float* tab;
    __device__ __forceinline__ void operator()(const f32x4 (&acc)[2][2][4][2], const Unit& u, int wr, int wc, int fr, int fq) const {
        const bool lat = u.pm > 0; const float qs = 0.125f * LOG2E;
#pragma unroll
        for (int bj = 0; bj < 2; ++bj) {
            const int colt = u.pn * BM + bj * HALF + wc * 32 + 4 * fq;
            const f32x4 b1 = *(const f32x4*)(bias + colt), b2 = *(const f32x4*)(bias + colt + 16);
            const bool isv = (u.pn == 4) && (bj == 1);
#pragma unroll
            for (int ai = 0; ai < 2; ++ai)
#pragma unroll
                for (int m = 0; m < 4; ++m) {
                    const int r = u.pm * BM + ai * HALF + wr * 64 + m * 16 + fr, t = r - C;
                    f32x4 x1 = acc[ai][bj][m][0] + b1, x2 = acc[ai][bj][m][1] + b2;
                    if (lat && !isv) {
                        const int pos = (wc & 1) ? (t & 63) : (t >> 6);
                        const f32x4 t0 = *(const f32x4*)(tab + (pos * 16 + 4 * fq) * 2), t1 = *(const f32x4*)(tab + (pos * 16 + 4 * fq) * 2 + 4);
                        const float cs[4] = {t0[0], t0[2], t1[0], t1[2]}, sn[4] = {t0[1], t0[3], t1[1], t1[3]};
                        f32x4 o1, o2;
#pragma unroll
                        for (int e = 0; e < 4; ++e) { o1[e] = x1[e] * cs[e] - x2[e] * sn[e]; o2[e] = x2[e] * cs[e] + x1[e] * sn[e]; }
                        x1 = o1; x2 = o2;
                    }
                    u32x2 w1, w2;
                    if (u.pn < 4) {
                        w1.x = pk2(x1[0] * qs, x1[1] * qs); w1.y = pk2(x1[2] * qs, x1[3] * qs); w2.x = pk2(x2[0] * qs, x2[1] * qs); w2.y = pk2(x2[2] * qs, x2[3] * qs);
                        *(u32x2*)(Qp + (size_t)r * 1024 + colt) = w1; *(u32x2*)(Qp + (size_t)r * 1024 + colt + 16) = w2;
                    } else {
                        w1.x = pk2(x1[0], x1[1]); w1.y = pk2(x1[2], x1[3]); w2.x = pk2(x2[0], x2[1]); w2.y = pk2(x2[2], x2[3]);
                        bf16_t* dst = (bj == 0 ? Kp : Vp) + (size_t)r * 128 + wc * 32 + 4 * fq;
                        *(u32x2*)dst = w1; *(u32x2*)(dst + 16) = w2;
                    }
                }
        }
    }
};
struct EpiInProj {
    static constexpr bool PERM = false;
    bf16_t* QH; _Float16* KF; _Float16* KB; bf16_t* IV; bf16_t* SG; const float* lb;
    __device__ __forceinline__ void operator()(const f32x4 (&acc)[2][2][4][2], const Unit& u, int wr, int wc, int fr, int fq) const {
        const int seg = u.pn >> 2; const bool lat = u.pm > 0;
        if (!lat && (seg == 0 || seg == 4)) return;
#pragma unroll
        for (int bj = 0; bj < 2; ++bj)
#pragma unroll
            for (int n = 0; n < 2; ++n) {
                const int col = (u.pn & 3) * BM + bj * HALF + wc * 32 + n * 16 + 4 * fq;
                f32x4 lbv = (f32x4){0.f, 0.f, 0.f, 0.f};
                if (seg == 1) lbv = *(const f32x4*)(lb + col); else if (seg == 2) lbv = *(const f32x4*)(lb + 1024 + col);
#pragma unroll
                for (int ai = 0; ai < 2; ++ai)
#pragma unroll
                    for (int m = 0; m < 4; ++m) {
                        const int r = u.pm * BM + ai * HALF + wr * 64 + m * 16 + fr; const f32x4 v = acc[ai][bj][m][n];
                        if (seg == 1 || seg == 2) {
                            typedef _Float16 h4_t __attribute__((ext_vector_type(4)));
                            h4_t hv;
#pragma unroll
                            for (int e = 0; e < 4; ++e) hv[e] = (_Float16)((1.f - lbv[e]) / (1.f + __expf(v[e])));
                            *(h4_t*)((seg == 1 ? KF : KB) + (size_t)r * 1024 + col) = hv;
                        } else if (seg == 3) {
                            u32x2 o; o.x = pk2(v[0], v[1]); o.y = pk2(v[2], v[3]); *(u32x2*)(IV + (size_t)r * 1024 + col) = o;
                        } else {
                            float sv[4];
#pragma unroll
                            for (int e = 0; e < 4; ++e) sv[e] = v[e] / (1.f + __expf(-v[e]));
                            u32x2 o; o.x = pk2(sv[0], sv[1]); o.y = pk2(sv[2], sv[3]); *(u32x2*)((seg == 0 ? QH : SG) + (size_t)(r - C) * 1024 + col) = o;
                        }
                    }
            }
    }
};

template <class Epi, class Sched, bool ALIGN_EPI>
__device__ __forceinline__ void gemm_phase(LAS unsigned char* lds, const Gemm g, const Sched& S, const Epi& E) {
    const int tid = threadIdx.x, wid = __builtin_amdgcn_readfirstlane(tid >> 6), lane = tid & 63, wr = wid >> 2, wc = wid & 3, fr = lane & 15, fq = lane >> 4;
    constexpr int K = KD, nt = K / BK;
    int sR[2], sC[2]; unsigned voffB[2];
#pragma unroll
    for (int i = 0; i < 2; ++i) { stage_rc(tid * 16 + i * 8192, sR[i], sC[i]); const int Rb = Epi::PERM ? ((sR[i] & ~31) + perm32(sR[i] & 31)) : sR[i]; voffB[i] = (unsigned)(Rb * K + sC[i]) * 2u; }
    constexpr size_t kstep = (size_t)(BK * 2), hstep = (size_t)HALF * K * 2, tstep = 2 * hstep;
    const unsigned ldsw = (unsigned)wid * 1024u;
    const int aoff = lds_byte(wr * 64 + fr, fq * 8), boff = lds_byte(wc * 32 + fr, fq * 8);
    const char* Ab = (const char*)g.A;
#define PG8_SA(b, h) (((b) * 2 + (h)) * HTB)
#define PG8_SB(b, h) ((4 + (b) * 2 + (h)) * HTB)
#define PG8_STAGE_B(bufoff, gbase) do { _Pragma("unroll") for (int _i = 0; _i < 2; ++_i) \
        __builtin_amdgcn_global_load_lds((const unsigned*)((const char*)(gbase) + voffB[_i]), (LAS unsigned*)(lds + (bufoff) + ldsw + _i * 8192), 16, 0, 0); } while (0)
#define PG8_STAGE_A(bufoff, kb, v) do { _Pragma("unroll") for (int _i = 0; _i < 2; ++_i) \
        __builtin_amdgcn_global_load_lds((const unsigned*)(Ab + (size_t)(kb) + (v)[_i]), (LAS unsigned*)(lds + (bufoff) + ldsw + _i * 8192), 16, 0, 0); } while (0)
#define PG8_LDA(dst, b, h) do { _Pragma("unroll") for (int m = 0; m < 4; ++m) _Pragma("unroll") for (int k = 0; k < 2; ++k) dst[m][k] = *(const LAS bf16x8*)(lds + PG8_SA(b, h) + aoff + m * 2048 + k * 1024); } while (0)
#define PG8_LDB(dst, b, h) do { _Pragma("unroll") for (int n = 0; n < 2; ++n) _Pragma("unroll") for (int k = 0; k < 2; ++k) dst[n][k] = *(const LAS bf16x8*)(lds + PG8_SB(b, h) + boff + n * 2048 + k * 1024); } while (0)
#define PG8_MMA(ai, bj, At, Bt) do { __builtin_amdgcn_s_setprio(1); _Pragma("unroll") for (int m = 0; m < 4; ++m) _Pragma("unroll") for (int n = 0; n < 2; ++n) _Pragma("unroll") for (int k = 0; k < 2; ++k) \
        acc[ai][bj][m][n] = __builtin_amdgcn_mfma_f32_16x16x32_bf16(Bt[n][k], At[m][k], acc[ai][bj][m][n], 0, 0, 0); __builtin_amdgcn_s_setprio(0); } while (0)
#define PG8_WAIT_V(n) asm volatile("s_waitcnt vmcnt(" #n ")" ::: "memory")
#define PG8_WAIT_L(n) asm volatile("s_waitcnt lgkmcnt(" #n ")" ::: "memory")
#define PG8_BAR __builtin_amdgcn_s_barrier()
#define PG8_SCHED __builtin_amdgcn_sched_barrier(0)
    Unit cur, nxt; int ui = 0;
    if (!S.next(0, cur)) return;
    unsigned cv[2][2], nv[2][2];
    a_offsets(g, cur, sR, sC, cv);
    f32x4 acc[2][2][4][2];
#pragma unroll
    for (int a = 0; a < 2; ++a)
#pragma unroll
        for (int b = 0; b < 2; ++b)
#pragma unroll
            for (int m = 0; m < 4; ++m)
#pragma unroll
                for (int n = 0; n < 2; ++n) acc[a][b][m][n] = (f32x4){0.f, 0.f, 0.f, 0.f};
    bf16x8 At[4][2], B0[2][2], B1[2][2];
    const char* cB = (const char*)g.Bt + ((size_t)cur.e * g.bstride) * 2 + (size_t)cur.pn * tstep;
    PG8_STAGE_B(PG8_SB(0, 0), cB); PG8_STAGE_B(PG8_SB(0, 1), cB + hstep); PG8_STAGE_A(PG8_SA(0, 0), 0, cv[0]); PG8_STAGE_A(PG8_SA(0, 1), 0, cv[1]);
    if (wr == 1) PG8_BAR;
    PG8_WAIT_V(2); PG8_BAR;
    PG8_STAGE_B(PG8_SB(1, 0), cB + kstep); PG8_STAGE_A(PG8_SA(1, 0), kstep, cv[0]); PG8_STAGE_B(PG8_SB(1, 1), cB + hstep + kstep);
    PG8_WAIT_V(6); PG8_BAR;
    for (;;) {
        const bool has_next = S.next(ui + 1, nxt);
        const char* nB = cB;
        if (has_next) { a_offsets(g, nxt, sR, sC, nv); nB = (const char*)g.Bt + ((size_t)nxt.e * g.bstride) * 2 + (size_t)nxt.pn * tstep; }
        else {
#pragma unroll
            for (int h = 0; h < 2; ++h)
#pragma unroll
                for (int i = 0; i < 2; ++i) nv[h][i] = cv[h][i];
        }
        for (int t = 0; t < nt; t += 2) {
            const bool last = (t == nt - 2);
            const size_t k1 = (size_t)(t + 1) * kstep, k2 = last ? 0 : (size_t)(t + 2) * kstep, k3 = k2 + kstep;
            const char* b2 = last ? nB : cB + (size_t)(t + 2) * kstep; const char* b3 = b2 + kstep;
            unsigned w0[2], w1[2];
#pragma unroll
            for (int i = 0; i < 2; ++i) { w0[i] = last ? nv[0][i] : cv[0][i]; w1[i] = last ? nv[1][i] : cv[1][i]; }
            PG8_LDB(B0, 0, 0); PG8_LDB(B1, 0, 1); PG8_SCHED; PG8_LDA(At, 0, 0); PG8_STAGE_A(PG8_SA(1, 1), k1, cv[1]);
            PG8_WAIT_V(8); PG8_WAIT_L(0); PG8_BAR; PG8_MMA(0, 0, At, B0); PG8_MMA(0, 1, At, B1); PG8_BAR; PG8_SCHED;
            PG8_LDA(At, 0, 1); PG8_STAGE_B(PG8_SB(0, 0), b2); PG8_STAGE_B(PG8_SB(0, 1), b2 + hstep); PG8_STAGE_A(PG8_SA(0, 0), k2, w0);
            PG8_WAIT_V(8); PG8_WAIT_L(0); PG8_BAR; PG8_MMA(1, 0, At, B0); PG8_MMA(1, 1, At, B1); PG8_BAR; PG8_SCHED;
            PG8_LDB(B0, 1, 0); PG8_LDB(B1, 1, 1); PG8_SCHED; PG8_LDA(At, 1, 0); PG8_STAGE_A(PG8_SA(0, 1), k2, w1);
            PG8_WAIT_V(8); PG8_WAIT_L(0); PG8_BAR; PG8_MMA(0, 0, At, B0); PG8_MMA(0, 1, At, B1); PG8_BAR; PG8_SCHED;
            PG8_LDA(At, 1, 1); PG8_STAGE_B(PG8_SB(1, 0), b3); PG8_STAGE_B(PG8_SB(1, 1), b3 + hstep); PG8_STAGE_A(PG8_SA(1, 0), k3, w0);
            PG8_WAIT_V(8); PG8_WAIT_L(0); PG8_BAR; PG8_MMA(1, 0, At, B0); PG8_MMA(1, 1, At, B1); PG8_BAR; PG8_SCHED;
        }
        if constexpr (ALIGN_EPI) { if (wr == 0) PG8_BAR; }
        E(acc, cur, wr, wc, fr, fq);
        if (!has_next) break;
#pragma unroll
        for (int a = 0; a < 2; ++a)
#pragma unroll
            for (int b = 0; b < 2; ++b)
#pragma unroll
                for (int m = 0; m < 4; ++m)
#pragma unroll
                    for (int n = 0; n < 2; ++n) acc[a][b][m][n] = (f32x4){0.f, 0.f, 0.f, 0.f};
        cur = nxt; cB = nB; ++ui;
#pragma unroll
        for (int h = 0; h < 2; ++h)
#pragma unroll
            for (int i = 0; i < 2; ++i) cv[h][i] = nv[h][i];
        if constexpr (ALIGN_EPI) { if (wr == 1) PG8_BAR; }
    }
    PG8_WAIT_V(0);
    if constexpr (!ALIGN_EPI) { if (wr == 0) PG8_BAR; }
    PG8_BAR;
#undef PG8_SA
#undef PG8_SB
#undef PG8_STAGE_A
#undef PG8_STAGE_B
#undef PG8_LDA
#undef PG8_LDB
#undef PG8_MMA
#undef PG8_WAIT_V
#undef PG8_WAIT_L
#undef PG8_BAR
#undef PG8_SCHED
}
}

__device__ __forceinline__ void transpose_block(const float* W, int ldw, int n0, int k0, bf16_t* WTrow0  , LAS float* scr, int lane) {
    f32x4 v[16];
    const float* src = W + (size_t)(k0 + (lane >> 4)) * ldw + n0 + (lane & 15) * 4;
#pragma unroll
    for (int i = 0; i < 16; ++i) v[i] = *(const f32x4*)(src + (size_t)(4 * i) * ldw);
#pragma unroll
    for (int i = 0; i < 16; ++i) { LAS float* d = scr + ((lane >> 4) + 4 * i) * 65 + (lane & 15) * 4; d[0] = v[i].x; d[1] = v[i].y; d[2] = v[i].z; d[3] = v[i].w; }
    asm volatile("s_waitcnt lgkmcnt(0)" ::: "memory"); __builtin_amdgcn_wave_barrier();
    const int c8 = lane & 7;
#pragma unroll
    for (int jj = 0; jj < 8; ++jj) {
        const int n = (lane >> 3) + 8 * jj; const LAS float* p = scr + (8 * c8) * 65 + n;
        u32x4 o; o.x = pk2(p[0], p[65]); o.y = pk2(p[2 * 65], p[3 * 65]); o.z = pk2(p[4 * 65], p[5 * 65]); o.w = pk2(p[6 * 65], p[7 * 65]);
        *(u32x4*)(WTrow0 + (size_t)n * 1024 + k0 + 8 * c8) = o;
    }
    asm volatile("s_waitcnt lgkmcnt(0)" ::: "memory"); __builtin_amdgcn_wave_barrier();
}

__device__ __forceinline__ void phase_prep(const Ctx& c) {
    LAS float* red = (LAS float*)c.lds;
    const float* cv = c.a->in[1]; const float* ccv = c.a->in[3]; const float* ada_w = c.a->in[4]; const float* ada_b = c.a->in[5];
    for (int item = c.wg; item < 193; item += c.nwg) {
        if (item < 192) {
            const int layer = item / 96, cb = item % 96, col = cb * 64 + c.lane;
            const float* W = ada_w + (size_t)layer * D * 6144 + col;
            float a0 = 0.f, a1 = 0.f;
            const int k0 = c.wave * 128;
#pragma unroll 32
            for (int k = 0; k < 128; ++k) { const float w = W[(size_t)(k0 + k) * 6144]; a0 += silu_f(cv[k0 + k]) * w; a1 += silu_f(ccv[k0 + k]) * w; }
            red[(0 * 8 + c.wave) * 64 + c.lane] = a0; red[(1 * 8 + c.wave) * 64 + c.lane] = a1;
            __syncthreads();
            if (c.tid < 128) {
                const int which = c.tid >> 6, l = c.tid & 63; float s = 0.f;
#pragma unroll
                for (int w = 0; w < 8; ++w) s += red[(which * 8 + w) * 64 + l];
                c.modp(layer, which)[cb * 64 + l] = s + ada_b[layer * 6144 + cb * 64 + l];
            }
            __syncthreads();
        } else {
            float* modbase = (float*)(c.ws + WS_MOD);
            for (int i = c.tid; i < 4096; i += 512) {
                const int pos = i >> 4, j = i & 15;
                const double ang = (double)pos * pow(10000.0, -(double)j / 16.0);
                modbase[MOD_ROPE + 2 * i] = (float)cos(ang); modbase[MOD_ROPE + 2 * i + 1] = (float)sin(ang);
            }
            const float* lbp = c.a->in[12];
            for (int i = c.tid; i < 2048; i += 512) { const float p0 = lbp[i], p1 = lbp[2048 + i]; modbase[MOD_LB + i] = 1.f / (1.f + __expf(p0 - p1)); }
        }
    }
}

__device__ __forceinline__ void row_load(const float* p, int lane, f32x4 (&v)[4]) {
#pragma unroll
    for (int j = 0; j < 4; ++j) v[j] = *(const f32x4*)(p + lane * 4 + 256 * j);
}
__device__ __forceinline__ float row_ss(const f32x4 (&v)[4]) {
    float s = 0.f;
#pragma unroll
    for (int j = 0; j < 4; ++j) s += v[j].x * v[j].x + v[j].y * v[j].y + v[j].z * v[j].z + v[j].w * v[j].w;
    return wave_sum(s);
}
__device__ __forceinline__ void row_modnorm_store(const f32x4 (&x)[4], float rstd, const float* g, const float* sh, const float* sc, bf16_t* out, int lane, f32x4 (*hout)[4] = nullptr) {
#pragma unroll
    for (int j = 0; j < 4; ++j) {
        const int c0 = lane * 4 + 256 * j;
        const f32x4 gv = *(const f32x4*)(g + c0), shv = *(const f32x4*)(sh + c0), scv = *(const f32x4*)(sc + c0);
        f32x4 h;
        h.x = x[j].x * rstd * gv.x * (1.f + scv.x) + shv.x; h.y = x[j].y * rstd * gv.y * (1.f + scv.y) + shv.y;
        h.z = x[j].z * rstd * gv.z * (1.f + scv.z) + shv.z; h.w = x[j].w * rstd * gv.w * (1.f + scv.w) + shv.w;
        if (hout) (*hout)[j] = h;
        u32x2 o; o.x = pk2(h.x, h.y); o.y = pk2(h.z, h.w);
        *(u32x2*)(out + c0) = o;
    }
}

__device__ __forceinline__ void phase_norm0(const Ctx& c) {
    bf16_t* H = (bf16_t*)(c.ws + WS_H); const float* ng = c.a->in[6];
    int r = c.wg * 8 + c.wave;
    f32x4 xn[4];
    if (r < R) row_load(c.xin0(r), c.lane, xn);
    for (; r < R; r += c.nwg * 8) {
        f32x4 x[4];
#pragma unroll
        for (int j = 0; j < 4; ++j) x[j] = xn[j];
        if (r + c.nwg * 8 < R) row_load(c.xin0(r + c.nwg * 8), c.lane, xn);
        const float rstd = rsqrtf(row_ss(x) * (1.f / D) + EPS);
        const float* m = c.modp(0, r < C ? 1 : 0);
        row_modnorm_store(x, rstd, ng, m + 0, m + 1024, H + (size_t)r * D, c.lane);
    }
}

namespace at {
constexpr int KP = 144, TILEB = 64 * KP;
__device__ __forceinline__ bf16x8 tr_frag2(const LAS unsigned char* tile, int row0, int col0, int lane) {
    const int q = (lane & 15) >> 2, p = lane & 3;
    const LAS unsigned char* a = tile + (row0 + q) * KP + (col0 + 4 * p) * 2;
    const v4i16_t lo = __builtin_amdgcn_ds_read_tr16_b64_v4i16((LAS v4i16_t*)a);
    const v4i16_t hi = __builtin_amdgcn_ds_read_tr16_b64_v4i16((LAS v4i16_t*)(a + 16 * KP));
    return (bf16x8){lo[0], lo[1], lo[2], lo[3], hi[0], hi[1], hi[2], hi[3]};
}
}
__device__ __forceinline__ void phase_attn(const Ctx& c) {
    using namespace at;
    const bf16_t* Q = (const bf16_t*)(c.ws + WS_Q); const bf16_t* K = (const bf16_t*)(c.ws + WS_K); const bf16_t* V = (const bf16_t*)(c.ws + WS_V);
    bf16_t* O = (bf16_t*)(c.ws + WS_O); const float* sink = c.a->in[9];
    LAS unsigned char* lds = c.lds;
    const int tid = c.tid, lane = c.lane, w = __builtin_amdgcn_readfirstlane(tid >> 6), fr = lane & 15, g = lane >> 4;
    const int lrow = tid >> 3, lch = tid & 7;
    for (int item = c.wg; item < 264; item += c.nwg) {
        const bool isctx = item >= 256;
        const int ci = item - 256;
        const int n = isctx ? 0 : (item >> 1), kh = isctx ? ((ci >> 1) & 1) : (item & 1), cb = isctx ? (ci >> 2) : 0;
        const int p_lo = isctx ? (ci & 1) : 0, p_hi = isctx ? (ci & 1) + 1 : 2;
        const int hq = kh * 8 + w;
        const float sink2 = sink[hq] * LOG2E;
        for (int pass = p_lo; pass < p_hi; ++pass) {
            const int t0 = 128 * n + 64 * pass, qrow0 = isctx ? cb * 128 + 64 * pass : C + t0;
            const int jlo = isctx ? 0 : (t0 >= 128 ? 0 : (128 - t0) / 64), jhi = isctx ? 0 : ((L - t0 + 128) / 64 < 5 ? (L - t0 + 128) / 64 : 5);
            const int ntile = 4 + (jhi - jlo);
            bf16x8 Qf[4][2];
#pragma unroll
            for (int qb = 0; qb < 4; ++qb)
#pragma unroll
                for (int ks = 0; ks < 2; ++ks) Qf[qb][ks] = *(const bf16x8*)(Q + (size_t)(qrow0 + 16 * qb + fr) * D + hq * 64 + 32 * ks + 8 * g);
            float mrow[4], lsum[4]; f32x4 OT[4][4];
#pragma unroll
            for (int qb = 0; qb < 4; ++qb) { mrow[qb] = sink2; lsum[qb] = 1.f;
#pragma unroll
                for (int nt = 0; nt < 4; ++nt) OT[qb][nt] = (f32x4){0.f, 0.f, 0.f, 0.f}; }
            u32x4 kreg, vreg;
#define AT_KROW(ti) ((ti) < 4 ? 64 * (ti) : C + t0 - 128 + 64 * (jlo + (ti) - 4))
#define AT_LOAD(ti) do { const size_t ro_ = (size_t)(AT_KROW(ti) + lrow) * 128 + kh * 64 + lch * 8; kreg = *(const u32x4*)(K + ro_); vreg = *(const u32x4*)(V + ro_); } while (0)
#define AT_WRITE(buf) do { *(LAS u32x4*)(lds + (buf) * 2 * TILEB + lrow * KP + lch * 16) = kreg; *(LAS u32x4*)(lds + (buf) * 2 * TILEB + TILEB + lrow * KP + lch * 16) = vreg; } while (0)
            AT_LOAD(0); AT_WRITE(0);
            __syncthreads();
            for (int ti = 0; ti < ntile; ++ti) {
                if (ti + 1 < ntile) AT_LOAD(ti + 1);
                const LAS unsigned char* kb = lds + (ti & 1) * 2 * TILEB; const LAS unsigned char* vb = kb + TILEB;
                const int jj = jlo + ti - 4; const bool masked = (ti >= 4) && (jj == 0 || jj == 4);
                const int k0 = t0 - 128 + 64 * jj;
                bf16x8 Kf[4][2], Vf[4][2];
#pragma unroll
                for (int mt = 0; mt < 4; ++mt)
#pragma unroll
                    for (int ks = 0; ks < 2; ++ks) { Kf[mt][ks] = *(const LAS bf16x8*)(kb + (16 * mt + fr) * KP + (32 * ks + 8 * g) * 2); Vf[mt][ks] = tr_frag2(vb, 32 * ks + 4 * g, 16 * mt, lane); }
#pragma unroll
                for (int qb = 0; qb < 4; ++qb) {
                    f32x4 sa[4];
#pragma unroll
                    for (int mt = 0; mt < 4; ++mt) { sa[mt] = (f32x4){0.f, 0.f, 0.f, 0.f};
#pragma unroll
                        for (int ks = 0; ks < 2; ++ks) sa[mt] = __builtin_amdgcn_mfma_f32_16x16x32_bf16(Kf[mt][ks], Qf[qb][ks], sa[mt], 0, 0, 0); }
                    if (masked) {
                        const int tq = t0 + 16 * qb + fr;
#pragma unroll
                        for (int mt = 0; mt < 4; ++mt)
#pragma unroll
                            for (int e = 0; e < 4; ++e) { const int dt = tq - (k0 + 16 * mt + 4 * g + e); if (dt > 128 || dt < -128) sa[mt][e] = -INFINITY; }
                    }
                    float mx = fmaxf(fmaxf(sa[0][0], sa[0][1]), fmaxf(sa[0][2], sa[0][3]));
#pragma unroll
                    for (int mt = 1; mt < 4; ++mt) mx = fmaxf(mx, fmaxf(fmaxf(sa[mt][0], sa[mt][1]), fmaxf(sa[mt][2], sa[mt][3])));
                    mx = fmaxf(mx, __shfl_xor(mx, 16)); mx = fmaxf(mx, __shfl_xor(mx, 32));
                    const float mn = fmaxf(mrow[qb], mx), alpha = __builtin_amdgcn_exp2f(mrow[qb] - mn);
                    mrow[qb] = mn;
                    float rs = 0.f;
#pragma unroll
                    for (int mt = 0; mt < 4; ++mt)
#pragma unroll
                        for (int e = 0; e < 4; ++e) { const float pv = __builtin_amdgcn_exp2f(sa[mt][e] - mn); sa[mt][e] = pv; rs += pv; }
                    rs += __shfl_xor(rs, 16); rs += __shfl_xor(rs, 32);
                    lsum[qb] = lsum[qb] * alpha + rs;
                    bf16x8 Pb[2];
#pragma unroll
                    for (int ks = 0; ks < 2; ++ks) { const f32x4 a0 = sa[2 * ks], a1 = sa[2 * ks + 1];
                        const u32x4 pk = (u32x4){pk2(a0[0], a0[1]), pk2(a0[2], a0[3]), pk2(a1[0], a1[1]), pk2(a1[2], a1[3])}; Pb[ks] = __builtin_bit_cast(bf16x8, pk); }
#pragma unroll
                    for (int nt = 0; nt < 4; ++nt) { OT[qb][nt] = OT[qb][nt] * alpha;
#pragma unroll
                        for (int ks = 0; ks < 2; ++ks) OT[qb][nt] = __builtin_amdgcn_mfma_f32_16x16x32_bf16(Vf[nt][ks], Pb[ks], OT[qb][nt], 0, 0, 0); }
                }
                if (ti + 1 < ntile) AT_WRITE((ti + 1) & 1);
                __syncthreads();
            }
#undef AT_KROW
#undef AT_LOAD
#undef AT_WRITE
#pragma unroll
            for (int qb = 0; qb < 4; ++qb) {
                const float il = 1.f / lsum[qb];
                bf16_t* op = O + (size_t)(qrow0 + 16 * qb + fr) * D + hq * 64 + 4 * g;
#pragma unroll
                for (int nt = 0; nt < 4; ++nt) { const f32x4 v = OT[qb][nt] * il; u32x2 o; o.x = pk2(v[0], v[1]); o.y = pk2(v[2], v[3]); *(u32x2*)(op + 16 * nt) = o; }
            }
        }
    }
}

__device__ __forceinline__ void phase_postmix(const Ctx& c, int layer, bool route) {
    const float* Y = (const float*)(c.ws + WS_RAW1); bf16_t* H = (bf16_t*)(c.ws + WS_H);
    float* Xout = (float*)(c.ws + (layer == 0 ? WS_X : WS_X1)); const float* Xprev = (const float*)(c.ws + WS_X);
    const float* ng = c.a->in[6] + layer * 4 * D; const float* Wr = c.a->in[15] + (size_t)layer * D * NE; const float* br = c.a->in[16] + layer * NE;
    unsigned* cnt = (unsigned*)(c.ws + WS_CTL) + CW_CNT + layer * NE;
    int* tk_e = (int*)(c.ws + WS_TK); float* tk_g = (float*)(c.ws + WS_TK) + R * 4; int* tk_slot = (int*)(c.ws + WS_TK) + 2 * R * 4;
    int* list = (int*)(c.ws + WS_LIST);
    LAS float* WL = (LAS float*)c.lds;
    LAS float* biasp = (LAS float*)(c.lds + 131072);
    LAS float* pvA = (LAS float*)(c.lds + 131072 + 2560); LAS float* pvB = pvA + 1024; LAS float* pvS = pvB + 1024;
    const int lane = c.lane, w = __builtin_amdgcn_readfirstlane(c.tid >> 6), fr = lane & 15, g = lane >> 4;
    const int g_lo = layer == 0 ? 0 : C / 128;
    for (int grp = g_lo + c.wg; grp < R / 128; grp += c.nwg) {
        const int which = grp * 128 < C ? 1 : 0;
        const float* m = c.modp(layer, which);
        __syncthreads();
#pragma unroll 4
        for (int j = 0; j < 16; ++j) {
            const int i4 = c.tid + 512 * j, k = i4 >> 3, e0 = (i4 & 7) * 4;
            const f32x4 wv = *(const f32x4*)(Wr + (size_t)k * NE + e0); const float sc = ng[2 * D + k] * (1.f + m[4096 + k]);
            LAS float* dst = WL + ((((k >> 4) * 4 + (k & 3)) * 4 + ((k >> 2) & 3)) * 16) * 2;
#pragma unroll
            for (int q = 0; q < 4; ++q) { const int e = e0 + q; dst[(e & 15) * 2 + (e >> 4)] = wv[q] * sc; }
        }
        for (int k = c.tid; k < D; k += 512) { pvA[k] = m[2048 + k] * ng[D + k]; pvB[k] = ng[2 * D + k] * (1.f + m[4096 + k]); pvS[k] = m[3072 + k]; }
        { const int e = c.tid & 31, part = c.tid >> 5; float sacc = 0.f;
#pragma unroll 16
          for (int k = part * 64; k < part * 64 + 64; ++k) sacc += m[3072 + k] * Wr[k * NE + e];
          biasp[32 + part * 32 + e] = sacc; }
        __syncthreads();
        if (c.tid < 32) { float sacc = br[c.tid];
#pragma unroll
            for (int p = 0; p < 16; ++p) sacc += biasp[32 + p * 32 + c.tid]; biasp[c.tid] = sacc; }
        __syncthreads();
        const int row0 = grp * 128 + w * 16;
        float rs_keep = 0.f;
        f32x4 yn[4], xn[4];
        row_load(Y + (size_t)(layer == 0 ? row0 : row0 - C) * D, lane, yn); row_load(layer == 0 ? c.xin0(row0) : Xprev + (size_t)row0 * D, lane, xn);
        for (int i = 0; i < 16; ++i) {
            const int r = row0 + i;
            f32x4 y[4], x[4];
#pragma unroll
            for (int j = 0; j < 4; ++j) { y[j] = yn[j]; x[j] = xn[j]; }
            if (i + 1 < 16) { row_load(Y + (size_t)(layer == 0 ? r + 1 : r + 1 - C) * D, lane, yn); row_load(layer == 0 ? c.xin0(r + 1) : Xprev + (size_t)(r + 1) * D, lane, xn); }
            const float rstd_y = rsqrtf(row_ss(y) * (1.f / D) + EPS);
#pragma unroll
            for (int j = 0; j < 4; ++j) {
                const int c0 = lane * 4 + 256 * j;
                x[j] += *(const LAS f32x4*)(pvA + c0) * (y[j] * rstd_y);
                *(f32x4*)(Xout + (size_t)r * D + c0) = x[j];
            }
            const float rstd_x = rsqrtf(row_ss(x) * (1.f / D) + EPS);
#pragma unroll
            for (int j = 0; j < 4; ++j) {
                const int c0 = lane * 4 + 256 * j;
                const f32x4 hv = x[j] * rstd_x * *(const LAS f32x4*)(pvB + c0) + *(const LAS f32x4*)(pvS + c0);
                u32x2 o; o.x = pk2(hv[0], hv[1]); o.y = pk2(hv[2], hv[3]);
                *(u32x2*)(H + (size_t)r * D + c0) = o;
            }
            if (lane == i) rs_keep = rstd_x;
        }
        asm volatile("s_waitcnt vmcnt(0)" ::: "memory");
        f32x4 la[2]; la[0] = (f32x4){0.f, 0.f, 0.f, 0.f}; la[1] = la[0];
        {
            const float* ap = Xout + (size_t)(row0 + fr) * D + 4 * g;
            const LAS float* bp = WL + (g * 16 + fr) * 2;
#pragma unroll 4
            for (int k4 = 0; k4 < 64; ++k4) {
                const f32x4 a4 = *(const f32x4*)(ap + 16 * k4);
#pragma unroll
                for (int q = 0; q < 4; ++q) {
                    const f32x2 b2 = *(const LAS f32x2*)(bp + (size_t)(4 * k4 + q) * 128);
                    la[0] = __builtin_amdgcn_mfma_f32_16x16x4f32(a4[q], b2[0], la[0], 0, 0, 0);
                    la[1] = __builtin_amdgcn_mfma_f32_16x16x4f32(a4[q], b2[1], la[1], 0, 0, 0);
                }
            }
        }
        float tv[4][4]; int te[4][4];
#pragma unroll
        for (int e = 0; e < 4; ++e) {
            const float rs = __shfl(rs_keep, 4 * g + e);
            float v0 = la[0][e] * rs + biasp[fr], v1 = la[1][e] * rs + biasp[16 + fr];
#pragma unroll
            for (int k = 0; k < 4; ++k) {
                float bv; int bi;
                if (v0 >= v1) { bv = v0; bi = fr; } else { bv = v1; bi = 16 + fr; }
#pragma unroll
                for (int o = 8; o > 0; o >>= 1) {
                    const float ov = __shfl_xor(bv, o); const int oi = __shfl_xor(bi, o);
                    if (ov > bv || (ov == bv && oi < bi)) { bv = ov; bi = oi; }
                }
                tv[e][k] = bv; te[e][k] = bi;
                if (bi == fr) v0 = -INFINITY;
                if (bi == 16 + fr) v1 = -INFINITY;
            }
        }
        if (fr < 4 && route) {
            float v[4]; int ex[4];
#pragma unroll
            for (int k = 0; k < 4; ++k) { v[k] = tv[0][k]; ex[k] = te[0][k];
#pragma unroll
                for (int e = 1; e < 4; ++e) if (fr == e) { v[k] = tv[e][k]; ex[k] = te[e][k]; } }
            const int r = row0 + 4 * g + fr;
            const float e1 = __expf(v[1] - v[0]), e2 = __expf(v[2] - v[0]), e3 = __expf(v[3] - v[0]);
            const float inv = 1.f / (1.f + e1 + e2 + e3);
            const float gk[4] = {inv, e1 * inv, e2 * inv, e3 * inv};
#pragma unroll
            for (int k = 0; k < 4; ++k) {
                const unsigned slot = atomicAdd(&cnt[ex[k]], 1u);
                list[(size_t)ex[k] * R + slot] = r;
                tk_e[r * 4 + k] = ex[k]; tk_g[r * 4 + k] = gk[k]; tk_slot[r * 4 + k] = (int)slot;
            }
        }
    }
}

__device__ __forceinline__ void moe_offsets(const Ctx& c, int layer, LAS int* so) {
    const unsigned* cnt = (const unsigned*)(c.ws + WS_CTL) + CW_CNT + layer * NE;
    __syncthreads();
    if (c.tid < 64) {
        const int n = c.tid < NE ? (int)cnt[c.tid] : 0; int pad = (n + PADM - 1) / PADM * PADM, inc = pad;
#pragma unroll
        for (int o = 1; o < 32; o <<= 1) { const int t = __shfl_up(inc, o); if (c.lane >= o) inc += t; }
        if (c.tid < NE) { so[c.tid] = inc - pad; so[64 + c.tid] = n; }
        if (c.tid == NE - 1) so[32] = inc;
    }
    __syncthreads();
}

__device__ __forceinline__ void moe_tables(const Ctx& c, int layer, LAS int* tb) {
    const unsigned* cnt = (const unsigned*)(c.ws + WS_CTL) + CW_CNT + layer * NE;
    __syncthreads();
    if (c.tid < 64) {
        const int n = c.tid < NE ? (int)cnt[c.tid] : 0; int tiles = (n + PADM - 1) / PADM, inc = tiles;
#pragma unroll
        for (int o = 1; o < 32; o <<= 1) { const int t = __shfl_up(inc, o); if (c.lane >= o) inc += t; }
        if (c.tid < NE) { tb[c.tid] = inc - tiles; tb[64 + c.tid] = n; }
        if (c.tid == NE - 1) tb[32] = inc;
    }
    __syncthreads();
}
__device__ __forceinline__ int vcu_of(const Ctx& c) { return (c.nwg % 8 == 0) ? (c.wg % 8) * (c.nwg / 8) + c.wg / 8 : c.wg; }
__device__ __forceinline__ void phase_moe_gu(const Ctx& c, int layer) {
    LAS int* tb = (LAS int*)(c.lds + 131072 + 1024);
    moe_tables(c, layer, tb);
    pg8::Gemm g{(const bf16_t*)(c.ws + WS_H), (const bf16_t*)(c.ws + WS_WGU) + (size_t)layer * NE * 2048 * 1024, (size_t)2048 * 1024, (const int*)(c.ws + WS_LIST)};
    pg8::MoeOrder S{tb, tb + 64, 8, c.nwg, vcu_of(c)};
    pg8::EpiSwiglu E{(bf16_t*)(c.ws + WS_HDN), c.a->in[18] + (size_t)layer * NE * 2048};
    pg8::gemm_phase<pg8::EpiSwiglu, pg8::MoeOrder, true>(c.lds, g, S, E);
}
__device__ __forceinline__ void phase_moe_dn(const Ctx& c, int layer) {
    LAS int* tb = (LAS int*)(c.lds + 131072 + 1024);
    moe_tables(c, layer, tb);
    pg8::Gemm g{(const bf16_t*)(c.ws + WS_HDN), (const bf16_t*)(c.ws + WS_WDN) + (size_t)layer * NE * 1024 * 1024, (size_t)1024 * 1024, nullptr};
    pg8::MoeOrder S{tb, tb + 64, 4, c.nwg, vcu_of(c)};
    pg8::EpiBf16Bias E{(bf16_t*)(c.ws + WS_OUTB), c.a->in[20] + (size_t)layer * NE * 1024, 1024};
    pg8::gemm_phase<pg8::EpiBf16Bias, pg8::MoeOrder, true>(c.lds, g, S, E);
}
__device__ __forceinline__ void phase_gemm_f32(const Ctx& c, const bf16_t* A, int M, const bf16_t* Bt, int N, const float* bias, float* Cout) {
    pg8::Gemm g{A, Bt, 0, nullptr}; pg8::StaticOrder S; S.init(M, N, c.nwg, c.wg);
    pg8::EpiF32 E{Cout, N, bias};
    pg8::gemm_phase<pg8::EpiF32, pg8::StaticOrder, true>(c.lds, g, S, E);
}

__device__ __forceinline__ void phase_gemm_qkv(const Ctx& c) {
    pg8::Gemm g{(const bf16_t*)(c.ws + WS_H), (const bf16_t*)(c.ws + WS_WQKV), 0, nullptr}; pg8::StaticOrder S; S.init(R, QKVD, c.nwg, c.wg);
    pg8::EpiQKV E{(bf16_t*)(c.ws + WS_Q), (bf16_t*)(c.ws + WS_K), (bf16_t*)(c.ws + WS_V), c.a->in[8], (const float*)(c.ws + WS_MOD) + MOD_ROPE};
    pg8::gemm_phase<pg8::EpiQKV, pg8::StaticOrder, true>(c.lds, g, S, E);
}
__device__ __forceinline__ void phase_gemm_inproj(const Ctx& c) {
    pg8::Gemm g{(const bf16_t*)(c.ws + WS_H), (const bf16_t*)(c.ws + WS_WIN), 0, nullptr}; pg8::StaticOrder S; S.init(R, HIN, c.nwg, c.wg);
    pg8::EpiInProj E{(bf16_t*)(c.ws + WS_QH), (_Float16*)(c.ws + WS_KF), (_Float16*)(c.ws + WS_KB), (bf16_t*)(c.ws + WS_IV), (bf16_t*)(c.ws + WS_SG), (const float*)(c.ws + WS_MOD) + MOD_LB};
    pg8::gemm_phase<pg8::EpiInProj, pg8::StaticOrder, true>(c.lds, g, S, E);
}

__device__ __forceinline__ void phase_norm0(const Ctx& c);
__device__ __forceinline__ void phase_convert(const Ctx& c) {
    LAS float* scr = (LAS float*)c.lds + c.wave * (64 * 65);
    const int gw = c.wg * 8 + c.wave, NGW = c.nwg * 8;
    constexpr int I_QKV = 20 * 16, I_O = 16 * 16, I_IN = 80 * 16, I_HO = 16 * 16, I_GU = 64 * 32 * 16, I_DN = 64 * 16 * 16, TOT = I_QKV + I_O + I_IN + I_HO + I_GU + I_DN;
    for (int it = gw; it < TOT; it += NGW) {
        int r = it;
        if (r < I_QKV) { const int nb = r % 20, kb = r / 20; transpose_block(c.a->in[7], QKVD, nb * 64, kb * 64, (bf16_t*)(c.ws + WS_WQKV) + (size_t)nb * 64 * 1024, scr, c.lane); continue; } r -= I_QKV;
        if (r < I_O) { const int nb = r % 16, kb = r / 16; transpose_block(c.a->in[10], D, nb * 64, kb * 64, (bf16_t*)(c.ws + WS_WO) + (size_t)nb * 64 * 1024, scr, c.lane); continue; } r -= I_O;
        if (r < I_IN) { const int nb = r % 80, kb = r / 80; transpose_block(c.a->in[11], HIN, nb * 64, kb * 64, (bf16_t*)(c.ws + WS_WIN) + (size_t)nb * 64 * 1024, scr, c.lane); continue; } r -= I_IN;
        if (r < I_HO) { const int nb = r % 16, kb = r / 16; transpose_block(c.a->in[14], D, nb * 64, kb * 64, (bf16_t*)(c.ws + WS_WHO) + (size_t)nb * 64 * 1024, scr, c.lane); continue; } r -= I_HO;
        if (r < I_GU) { const int mat = r / 512, rr = r % 512, nb = rr % 32, kb = rr / 32; const int n0 = ((nb & 3) >> 1) * 1024 + (nb >> 2) * 128 + (nb & 1) * 64;
            transpose_block(c.a->in[17] + (size_t)mat * 1024 * 2048, 2048, n0, kb * 64, (bf16_t*)(c.ws + WS_WGU) + ((size_t)mat * 2048 + nb * 64) * 1024, scr, c.lane); continue; } r -= I_GU;
        { const int mat = r / 256, rr = r % 256, nb = rr % 16, kb = rr / 16;
            transpose_block(c.a->in[19] + (size_t)mat * 1024 * 1024, 1024, nb * 64, kb * 64, (bf16_t*)(c.ws + WS_WDN) + ((size_t)mat * 1024 + nb * 64) * 1024, scr, c.lane); }
    }
    __syncthreads();
    phase_norm0(c);
}

__device__ __forceinline__ void phase_combine(const Ctx& c, int layer) {
    LAS int* so = (LAS int*)(c.lds + 32768);
    moe_offsets(c, layer, so);
    const bf16_t* outb = (const bf16_t*)(c.ws + WS_OUTB); float* X = (float*)(c.ws + WS_X); bf16_t* H = (bf16_t*)(c.ws + WS_H);
    const float* Xin = layer == 0 ? X : (const float*)(c.ws + WS_X1);
    const float* ngl = c.a->in[6] + layer * 4 * D;
    const int* tk_e = (const int*)(c.ws + WS_TK); const float* tk_g = (const float*)(c.ws + WS_TK) + R * 4; const int* tk_slot = (const int*)(c.ws + WS_TK) + 2 * R * 4;
    const int r_lo = layer == 0 ? 0 : C, stride = c.nwg * 8;
    int r = r_lo + c.wg * 8 + c.wave;
    int pe[4], ps[4]; float pg[4]; u32x2 wn[4][4]; f32x4 xn[4]; float gn[4];
#define CB_TK(row) do { _Pragma("unroll") for (int k = 0; k < 4; ++k) { pe[k] = tk_e[(row) * 4 + k]; ps[k] = tk_slot[(row) * 4 + k]; pg[k] = tk_g[(row) * 4 + k]; } } while (0)
#define CB_DATA(row) do { _Pragma("unroll") for (int k = 0; k < 4; ++k) { const bf16_t* src_ = outb + (size_t)(so[pe[k]] + ps[k]) * 1024; gn[k] = pg[k]; \
        _Pragma("unroll") for (int j = 0; j < 4; ++j) wn[k][j] = *(const u32x2*)(src_ + c.lane * 4 + 256 * j); } row_load(Xin + (size_t)(row) * D, c.lane, xn); } while (0)
    if (r < R) { CB_TK(r); CB_DATA(r); }
    if (r + stride < R) CB_TK(r + stride);
    for (; r < R; r += stride) {
        const float* m = c.modp(layer, r < C ? 1 : 0);
        f32x4 y[4], x[4];
#pragma unroll
        for (int j = 0; j < 4; ++j) { y[j] = (f32x4){0.f, 0.f, 0.f, 0.f}; x[j] = xn[j]; }
#pragma unroll
        for (int k = 0; k < 4; ++k)
#pragma unroll
            for (int j = 0; j < 4; ++j) { const u32x2 w = wn[k][j]; y[j] += (f32x4){bflo(w.x), bfhi(w.x), bflo(w.y), bfhi(w.y)} * gn[k]; }
        if (r + stride < R) CB_DATA(r + stride);
        if (r + 2 * stride < R) CB_TK(r + 2 * stride);
        const float rstd_y = rsqrtf(row_ss(y) * (1.f / D) + EPS);
#pragma unroll
        for (int j = 0; j < 4; ++j) {
            const int c0 = c.lane * 4 + 256 * j;
            const f32x4 g2 = *(const f32x4*)(m + 5120 + c0), n3 = *(const f32x4*)(ngl + 3 * D + c0);
            x[j].x += g2.x * (y[j].x * rstd_y * n3.x); x[j].y += g2.y * (y[j].y * rstd_y * n3.y);
            x[j].z += g2.z * (y[j].z * rstd_y * n3.z); x[j].w += g2.w * (y[j].w * rstd_y * n3.w);
            if (layer == 0) *(f32x4*)(X + (size_t)r * D + c0) = x[j];
            else *(f32x4*)(c.a->out + (size_t)(r - C) * D + c0) = x[j];
        }
        if (layer == 0) {
            const float rstd_x = rsqrtf(row_ss(x) * (1.f / D) + EPS);
            const float* m1 = c.modp(1, r < C ? 1 : 0);
            row_modnorm_store(x, rstd_x, c.a->in[6] + 4 * D, m1 + 0, m1 + 1024, H + (size_t)r * D, c.lane);
        }
    }
#undef CB_TK
#undef CB_DATA
}

namespace hg {
typedef _Float16 h2_t __attribute__((ext_vector_type(2)));
constexpr int TB = 272, PB = 144;
constexpr int TILE = 64 * TB;
constexpr int T_QD = 0, T_QC = TILE, T_KD = 2 * TILE, T_KE = 3 * TILE, T_KC = 4 * TILE, T_V0 = 5 * TILE, T_V1 = 6 * TILE;
constexpr int T_QL1 = 7 * TILE, T_KL1 = T_QL1 + 16 * TB, T_P = T_KL1 + 16 * TB, T_TOT = T_P + 64 * PB, T_CT = T_TOT + 4096, T_END = T_CT + 512;
static_assert(T_END <= LDS_BYTES - 64, "hgrn scan LDS map");
__device__ __forceinline__ int row_of(int dir, int p) { return p < C ? (dir ? C - 1 - p : p) : (dir ? C + (L - 1 - (p - C)) : p); }
__device__ __forceinline__ int seg_of(int ch) { return ch < 68 ? ch / 17 : 4 + (ch - 68) / 16; }
__device__ __forceinline__ bf16x8 tr_frag(const LAS unsigned char* tile, int row0, int col0, int lane) {
    const int q = (lane & 15) >> 2, p = lane & 3;
    const LAS unsigned char* a = tile + (row0 + q) * TB + (col0 + 4 * p) * 2;
    const v4i16_t lo = __builtin_amdgcn_ds_read_tr16_b64_v4i16((LAS v4i16_t*)a);
    const v4i16_t hi = __builtin_amdgcn_ds_read_tr16_b64_v4i16((LAS v4i16_t*)(a + 4 * TB));
    return (bf16x8){lo[0], lo[1], lo[2], lo[3], hi[0], hi[1], hi[2], hi[3]};
}
}

__device__ __forceinline__ void phase_hgrn_scan(const Ctx& c) {
    using namespace hg;
#define HG_BAR() asm volatile("s_waitcnt lgkmcnt(0)\n\ts_barrier" ::: "memory")
    const bf16_t* QH = (const bf16_t*)(c.ws + WS_QH); const bf16_t* IV = (const bf16_t*)(c.ws + WS_IV);
    LAS unsigned char* lds = c.lds;
    const int tid = c.tid, lane = c.lane, w = __builtin_amdgcn_readfirstlane(tid >> 6), fr = lane & 15, g = lane >> 4;
    for (int item_ = c.wg; item_ < 256 * SCAN_REP; item_ += c.nwg) {
        const int item = item_ & 255;
        const int chain = item >> 4, seg = item & 15, head = chain >> 1, dir = chain & 1, hc = head * 128;
        const int c0 = seg < 4 ? 17 * seg : 68 + 16 * (seg - 4), nch = seg < 4 ? 17 : 16;
        const _Float16* KX = (const _Float16*)(c.ws + (dir ? WS_KB : WS_KF));
        float* OL = (float*)(c.ws + (dir ? WS_OB : WS_OF)); bf16_t* QS = (bf16_t*)(c.ws + (dir ? WS_QSB : WS_QSF));
        HG_BAR();
        for (int i = tid; i < 64 * PB / 4; i += 512) ((LAS unsigned*)(lds + T_P))[i] = 0u;
        f32x4 Sacc[8];
#pragma unroll
        for (int m = 0; m < 8; ++m) Sacc[m] = (f32x4){0.f, 0.f, 0.f, 0.f};
        float dseg0 = 1.f, dseg1 = 1.f;
        unsigned kraw[8], qraw[8]; u32x4 vraw[2];
#define HG_LOAD(cidx) do { const int p0_ = 64 * (cidx); const bool lat_ = (cidx) >= 4; \
        _Pragma("unroll") for (int i = 0; i < 8; ++i) { const int r_ = row_of(dir, p0_ + 8 * w + i); \
            kraw[i] = *(const unsigned*)(KX + (size_t)r_ * D + hc + 2 * lane); \
            qraw[i] = lat_ ? *(const unsigned*)(QH + (size_t)(r_ - C) * D + hc + 2 * lane) : 0u; } \
        _Pragma("unroll") for (int i = 0; i < 2; ++i) { const int idx_ = tid + 512 * i; const int r_ = row_of(dir, p0_ + (idx_ >> 4)); \
            vraw[i] = *(const u32x4*)(IV + (size_t)r_ * D + hc + (idx_ & 15) * 8); } } while (0)
        HG_LOAD(c0);
        for (int ci = 0; ci < nch; ++ci) {
            const int cidx = c0 + ci; const bool lat = cidx >= 4;
            const int vbuf = (ci & 1) ? T_V1 : T_V0;
            float kf[8][2], qf[8][2], cp[8][2];
            {
                float p0 = 1.f, p1 = 1.f;
#pragma unroll
                for (int i = 0; i < 8; ++i) {
                    const h2_t hv = __builtin_bit_cast(h2_t, kraw[i]);
                    kf[i][0] = (float)hv[0]; kf[i][1] = (float)hv[1];
                    qf[i][0] = bflo(qraw[i]); qf[i][1] = bfhi(qraw[i]);
                    p0 *= (1.f - kf[i][0]); p1 *= (1.f - kf[i][1]); cp[i][0] = p0; cp[i][1] = p1;
                }
                *(LAS f32x2*)(lds + T_TOT + (w * 128 + 2 * lane) * 4) = (f32x2){p0, p1};
#pragma unroll
                for (int i = 0; i < 2; ++i) { const int idx = tid + 512 * i; *(LAS u32x4*)(lds + vbuf + (idx >> 4) * TB + (idx & 15) * 16) = vraw[i]; }
            }
            HG_BAR();
            {
                f32x2 T[8];
#pragma unroll
                for (int x = 0; x < 8; ++x) T[x] = *(const LAS f32x2*)(lds + T_TOT + (x * 128 + 2 * lane) * 4);
                const int I = w >> 1, hh = w & 1;
                f32x2 bd[4];
#pragma unroll
                for (int x = 0; x < 4; ++x) bd[x] = T[2 * x] * T[2 * x + 1];
                f32x2 pre = (f32x2){1.f, 1.f}, cum = (f32x2){1.f, 1.f}, suf = (f32x2){1.f, 1.f}, bdI = (f32x2){1.f, 1.f};
#pragma unroll
                for (int x = 0; x < 8; ++x) if (hh && x == w - 1) pre = T[x];
#pragma unroll
                for (int x = 0; x < 4; ++x) { if (x < I) cum = cum * bd[x]; if (x > I) suf = suf * bd[x]; if (x == I) bdI = bd[x]; }
                const f32x2 ctot = (bd[0] * bd[1]) * (bd[2] * bd[3]);
#pragma unroll
                for (int i = 0; i < 8; ++i) {
                    const int tau = 8 * w + i;
                    float QDv[2], KDv[2], KEv[2], QCv[2], KCv[2];
#pragma unroll
                    for (int x = 0; x < 2; ++x) {
                        const float eq = pre[x] * cp[i][x], rc = __builtin_amdgcn_rcpf(eq);
                        QDv[x] = qf[i][x] * eq; KDv[x] = kf[i][x] * rc; KEv[x] = KDv[x] * bdI[x]; QCv[x] = QDv[x] * cum[x]; KCv[x] = KEv[x] * suf[x];
                    }
                    const int to = tau * TB + lane * 4;
                    *(LAS unsigned*)(lds + T_QD + to) = pk2(QDv[0], QDv[1]);
                    *(LAS unsigned*)(lds + T_KD + to) = pk2(KDv[0], KDv[1]);
                    *(LAS unsigned*)(lds + T_KE + to) = pk2(KEv[0], KEv[1]);
                    *(LAS unsigned*)(lds + T_QC + to) = pk2(QCv[0], QCv[1]);
                    *(LAS unsigned*)(lds + T_KC + to) = pk2(KCv[0], KCv[1]);
                    if (I == 3) *(LAS unsigned*)(lds + T_QL1 + (tau - 48) * TB + lane * 4) = pk2(QDv[0] * bd[2][0], QDv[1] * bd[2][1]);
                    if (I == 0) *(LAS unsigned*)(lds + T_KL1 + tau * TB + lane * 4) = pk2(KEv[0] * bd[1][0], KEv[1] * bd[1][1]);
                    if (lat) { const int r = row_of(dir, 64 * cidx + tau); *(unsigned*)(QS + (size_t)(r - C) * D + hc + 2 * lane) = pk2(QCv[0] * dseg0, QCv[1] * dseg1); }
                }
                dseg0 *= ctot[0]; dseg1 *= ctot[1];
                if (w == 0) *(LAS f32x2*)(lds + T_CT + lane * 8) = ctot;
            }
            HG_BAR();
            if (ci + 1 < nch) HG_LOAD(cidx + 1);
            if (lat) {
                const int nblk = w >= 6 ? 2 : 1;
                for (int b = 0; b < nblk; ++b) {
                    int I, J, qoff, qrow, koff, krow; bool diag = false;
                    if (w < 4) { I = 2 + (w >> 1); J = w & 1; qoff = (w >> 1) ? T_QL1 : T_QD; qrow = (w >> 1) ? 0 : 32; koff = (w & 1) ? T_KE : T_KL1; krow = (w & 1) ? 16 : 0; }
                    else if (w == 4) { I = 1; J = 0; qoff = T_QD; qrow = 16; koff = T_KE; krow = 0; }
                    else if (w == 5) { I = 3; J = 2; qoff = T_QD; qrow = 48; koff = T_KE; krow = 32; }
                    else { I = 2 * (w - 6) + b; J = I; qoff = T_QD; qrow = 16 * I; koff = T_KD; krow = 16 * I; diag = true; }
                    f32x4 pa = (f32x4){0.f, 0.f, 0.f, 0.f};
#pragma unroll
                    for (int ks = 0; ks < 4; ++ks) {
                        const bf16x8 av = *(const LAS bf16x8*)(lds + qoff + (qrow + fr) * TB + (32 * ks + 8 * g) * 2);
                        const bf16x8 bv = *(const LAS bf16x8*)(lds + koff + (krow + fr) * TB + (32 * ks + 8 * g) * 2);
                        pa = __builtin_amdgcn_mfma_f32_16x16x32_bf16(av, bv, pa, 0, 0, 0);
                    }
#pragma unroll
                    for (int e = 0; e < 4; ++e) {
                        const int tl = 4 * g + e; const float val = (diag && fr > tl) ? 0.f : pa[e];
                        *(LAS bf16_t*)(lds + T_P + (16 * I + tl) * PB + (16 * J + fr) * 2) = (bf16_t)f2bf(val);
                    }
                }
            }
            f32x4 oacc[4];
#pragma unroll
            for (int m = 0; m < 4; ++m) oacc[m] = (f32x4){0.f, 0.f, 0.f, 0.f};
            if (lat) {
                bf16x8 Sb[4];
#pragma unroll
                for (int ks = 0; ks < 4; ++ks) {
                    const f32x4 a0 = Sacc[2 * ks], a1 = Sacc[2 * ks + 1];
                    const u32x4 pk = (u32x4){pk2(a0[0], a0[1]), pk2(a0[2], a0[3]), pk2(a1[0], a1[1]), pk2(a1[2], a1[3])};
                    Sb[ks] = __builtin_bit_cast(bf16x8, pk);
                }
#pragma unroll
                for (int m = 0; m < 4; ++m)
#pragma unroll
                    for (int ks = 0; ks < 4; ++ks) {
                        const u32x2 lo = *(const LAS u32x2*)(lds + T_QC + (16 * m + fr) * TB + (32 * ks + 4 * g) * 2);
                        const u32x2 hi = *(const LAS u32x2*)(lds + T_QC + (16 * m + fr) * TB + (32 * ks + 16 + 4 * g) * 2);
                        const u32x4 pk = (u32x4){lo.x, lo.y, hi.x, hi.y};
                        oacc[m] = __builtin_amdgcn_mfma_f32_16x16x32_bf16(__builtin_bit_cast(bf16x8, pk), Sb[ks], oacc[m], 0, 0, 0);
                    }
            }
#pragma unroll
            for (int m = 0; m < 8; ++m) { const f32x4 ct = *(const LAS f32x4*)(lds + T_CT + (16 * m + 4 * g) * 4); Sacc[m] = Sacc[m] * ct; }
            bf16x8 Vf[2];
#pragma unroll
            for (int ks = 0; ks < 2; ++ks) Vf[ks] = tr_frag(lds + vbuf, 32 * ks + 8 * g, 16 * w, lane);
#pragma unroll
            for (int m = 0; m < 8; ++m)
#pragma unroll
                for (int ks = 0; ks < 2; ++ks) Sacc[m] = __builtin_amdgcn_mfma_f32_16x16x32_bf16(tr_frag(lds + T_KC, 32 * ks + 8 * g, 16 * m, lane), Vf[ks], Sacc[m], 0, 0, 0);
            HG_BAR();
            if (lat) {
#pragma unroll
                for (int m = 0; m < 4; ++m)
#pragma unroll
                    for (int ks = 0; ks < 2; ++ks) {
                        if (m < 2 && ks == 1) continue;
                        const bf16x8 av = *(const LAS bf16x8*)(lds + T_P + (16 * m + fr) * PB + (32 * ks + 8 * g) * 2);
                        oacc[m] = __builtin_amdgcn_mfma_f32_16x16x32_bf16(av, Vf[ks], oacc[m], 0, 0, 0);
                    }
#pragma unroll
                for (int m = 0; m < 4; ++m)
#pragma unroll
                    for (int e = 0; e < 4; ++e) { const int r = row_of(dir, 64 * cidx + 16 * m + 4 * g + e); OL[(size_t)(r - C) * D + hc + 16 * w + fr] = oacc[m][e]; }
            }
        }
#undef HG_LOAD
        float* DS = (float*)(c.ws + WS_DS) + (size_t)item * 16384; float* DG = (float*)(c.ws + WS_DG) + item * 128;
#pragma unroll
        for (int m = 0; m < 8; ++m)
#pragma unroll
            for (int e = 0; e < 4; ++e) DS[(16 * m + 4 * g + e) * 128 + 16 * w + fr] = Sacc[m][e];
        if (w == 0) { DG[2 * lane] = dseg0; DG[2 * lane + 1] = dseg1; }
    }
}

#undef HG_BAR
__device__ __forceinline__ void phase_hgrn_fold(const Ctx& c) {
    const float* DS = (const float*)(c.ws + WS_DS); const float* DG = (const float*)(c.ws + WS_DG); bf16_t* SST = (bf16_t*)(c.ws + WS_SST);
    for (int item = c.wg; item < 256; item += c.nwg) {
        const int chain = item >> 4, slice = item & 15, d = 8 * slice + (c.tid >> 6), v2 = (c.tid & 63) * 2;
        float s0 = 0.f, s1 = 0.f;
        float dv[15]; f32x2 ds[15];
#pragma unroll
        for (int sgi = 0; sgi < 15; ++sgi) { dv[sgi] = DG[(chain * 16 + sgi) * 128 + d]; ds[sgi] = *(const f32x2*)(DS + ((size_t)(chain * 16 + sgi) * 128 + d) * 128 + v2); }
        SST[((size_t)(chain * 16) * 128 + v2) * 128 + d] = 0; SST[((size_t)(chain * 16) * 128 + v2 + 1) * 128 + d] = 0;
#pragma unroll
        for (int sgi = 0; sgi < 15; ++sgi) {
            s0 = dv[sgi] * s0 + ds[sgi][0]; s1 = dv[sgi] * s1 + ds[sgi][1];
            SST[((size_t)(chain * 16 + sgi + 1) * 128 + v2) * 128 + d] = (bf16_t)f2bf(s0); SST[((size_t)(chain * 16 + sgi + 1) * 128 + v2 + 1) * 128 + d] = (bf16_t)f2bf(s1);
        }
    }
}

__device__ __forceinline__ void phase_hgrn_readout(const Ctx& c) {
    constexpr int SP = 272, SBUF = 128 * SP, IBUF = 2 * SBUF;
    static_assert(2 * IBUF + 1024 <= LDS_BYTES - 64, "readout LDS map");
    const float* OF = (const float*)(c.ws + WS_OF); const float* OB = (const float*)(c.ws + WS_OB); const bf16_t* SGp = (const bf16_t*)(c.ws + WS_SG);
    const bf16_t* SST = (const bf16_t*)(c.ws + WS_SST); bf16_t* RR = (bf16_t*)(c.ws + WS_RR); const float* hng = c.a->in[13];
    LAS unsigned char* lds = c.lds; LAS float* ssx = (LAS float*)(c.lds + 2 * IBUF);
    const int tid = c.tid, lane = c.lane, w = __builtin_amdgcn_readfirstlane(tid >> 6), fr = lane & 15, g = lane >> 4, mt = w & 3, nh = w >> 2;
#define RO_BAR() asm volatile("s_waitcnt lgkmcnt(0)\n\ts_barrier" ::: "memory")
    u32x4 sreg[8];
#define RO_SST_LOAD(it) do { const int h_ = (it) >> 8, ch_ = (it) & 255; \
        _Pragma("unroll") for (int j = 0; j < 8; ++j) { const int idx_ = tid + 512 * j, dx_ = idx_ >> 11, rem_ = idx_ & 2047; \
            const int sg_ = hg::seg_of(dx_ ? 4 + 255 - ch_ : 4 + ch_); \
            sreg[j] = *(const u32x4*)(SST + ((size_t)((h_ * 2 + dx_) * 16 + sg_) * 128 + (rem_ >> 4)) * 128 + (rem_ & 15) * 8); } } while (0)
#define RO_SST_WRITE(buf) do { _Pragma("unroll") for (int j = 0; j < 8; ++j) { const int idx_ = tid + 512 * j, dx_ = idx_ >> 11, rem_ = idx_ & 2047; \
            *(LAS u32x4*)(lds + (buf) * IBUF + dx_ * SBUF + (rem_ >> 4) * SP + (rem_ & 15) * 16) = sreg[j]; } } while (0)
    int it = c.wg;
    RO_BAR();
    if (it < 2048) { RO_SST_LOAD(it); RO_SST_WRITE(0); }
    RO_BAR();
    for (int k = 0; it < 2048; it += c.nwg, ++k) {
        const int h = it >> 8, ch = it & 255, t0 = 64 * ch + 16 * mt, buf = k & 1;
        const bool has_next = it + c.nwg < 2048;
        if (has_next) RO_SST_LOAD(it + c.nwg);
        f32x4 acc[4]; float sgv[4][4];
#pragma unroll
        for (int n = 0; n < 4; ++n)
#pragma unroll
            for (int e = 0; e < 4; ++e) { const size_t o = (size_t)(t0 + 4 * g + e) * D + h * 128 + 64 * nh + 16 * n + fr; acc[n][e] = OF[o] + OB[o]; sgv[n][e] = bf2f(SGp[o]) * hng[h * 128 + 64 * nh + 16 * n + fr]; }
#pragma unroll
        for (int dx = 0; dx < 2; ++dx) {
            const bf16_t* QS = (const bf16_t*)(c.ws + (dx ? WS_QSB : WS_QSF)) + (size_t)(t0 + fr) * D + h * 128 + 8 * g;
            const LAS unsigned char* sb = lds + buf * IBUF + dx * SBUF + (64 * nh + fr) * SP + 16 * g;
#pragma unroll
            for (int ks = 0; ks < 4; ++ks) {
                const bf16x8 av = *(const bf16x8*)(QS + 32 * ks);
#pragma unroll
                for (int n = 0; n < 4; ++n) acc[n] = __builtin_amdgcn_mfma_f32_16x16x32_bf16(av, *(const LAS bf16x8*)(sb + (16 * n) * SP + 64 * ks), acc[n], 0, 0, 0);
            }
        }
        float ss[4] = {0.f, 0.f, 0.f, 0.f};
#pragma unroll
        for (int n = 0; n < 4; ++n)
#pragma unroll
            for (int e = 0; e < 4; ++e) ss[e] += acc[n][e] * acc[n][e];
#pragma unroll
        for (int e = 0; e < 4; ++e) {
#pragma unroll
            for (int sh = 8; sh > 0; sh >>= 1) ss[e] += __shfl_xor(ss[e], sh);
        }
        if (fr == 0) *(LAS f32x4*)(ssx + ((k & 1) * 8 + w) * 16 + 4 * g) = (f32x4){ss[0], ss[1], ss[2], ss[3]};
        if (has_next) RO_SST_WRITE(buf ^ 1);
        RO_BAR();
        const f32x4 ps = *(const LAS f32x4*)(ssx + ((k & 1) * 8 + (w ^ 4)) * 16 + 4 * g);
#pragma unroll
        for (int e = 0; e < 4; ++e) ss[e] = rsqrtf((ss[e] + ps[e]) * (1.f / 128.f) + EPS);
#pragma unroll
        for (int n = 0; n < 4; ++n)
#pragma unroll
            for (int e = 0; e < 4; ++e) { const size_t o = (size_t)(t0 + 4 * g + e) * D + h * 128 + 64 * nh + 16 * n + fr; RR[o] = (bf16_t)f2bf(acc[n][e] * ss[e] * sgv[n][e]); }
    }
    RO_BAR();
#undef RO_BAR
#undef RO_SST_LOAD
#undef RO_SST_WRITE
}

#define XB_TMO      128
#define XB_XCNT(j)  (256  + 64 * (j))
#define XB_XSUB(j)  (1280 + 64 * (j))
#define XB_XGEN(j)  (2304 + 64 * (j))
#define XB_TOP      3328
#define XB_TOPGEN   3392
#define XCD_BAR_WORDS 3456
#define XB_SPIN_CAP (1u << 18)
__device__ __forceinline__ unsigned xb_ld(unsigned* p)              { return __hip_atomic_load(p, __ATOMIC_RELAXED, __HIP_MEMORY_SCOPE_AGENT); }
__device__ __forceinline__ unsigned xb_add(unsigned* p, unsigned v) { return __hip_atomic_fetch_add(p, v, __ATOMIC_RELAXED, __HIP_MEMORY_SCOPE_AGENT); }
__device__ __forceinline__ unsigned xb_xcc_id() { return (unsigned)__builtin_amdgcn_s_getreg((3 << 11) | 20) & 0xFu; }
#define XB_SPIN(cond, bar) do { unsigned _sp = 0; while (cond) { __builtin_amdgcn_s_sleep(1); \
    if ((++_sp & 255u) == 0u) { if (xb_ld(&(bar)[XB_TMO])) break; if (_sp > XB_SPIN_CAP) { atomicAdd(&(bar)[XB_TMO], 1u); break; } } } } while (0)
struct XcdBarrier { unsigned* bar; unsigned x; volatile LAS unsigned* st; };
__device__ __forceinline__ XcdBarrier xcd_barrier_post(unsigned* bar, volatile LAS unsigned* st) {
    XcdBarrier b; b.bar = bar; b.x = xb_xcc_id(); b.st = st;
    if (threadIdx.x == 0) (void)xb_add(&bar[XB_XCNT(b.x)], 1u);
    return b;
}
__device__ __forceinline__ void xcd_barrier_complete(unsigned* bar, unsigned x, unsigned& nloc, unsigned& nx) {
    const unsigned G = gridDim.x * gridDim.y * gridDim.z;
    unsigned sum, cnt, mine, sp = 0u;
    for (;;) {
        sum = 0u; cnt = 0u; mine = 0u;
#pragma unroll
        for (unsigned j = 0; j < 16; ++j) { const unsigned c = xb_ld(&bar[XB_XCNT(j)]); sum += c; cnt += (c > 0u) ? 1u : 0u; mine = (j == x) ? c : mine; }
        if (sum == G) break;
        __builtin_amdgcn_s_sleep(1);
        if ((++sp & 255u) == 0u) { if (xb_ld(&bar[XB_TMO])) break; if (sp > XB_SPIN_CAP) { atomicAdd(&bar[XB_TMO], 1u); break; } }
    }
    nloc = mine > 0u ? mine : 1u; nx = cnt > 0u ? cnt : 1u;
}
__device__ __forceinline__ void xcd_barrier(const XcdBarrier& b) {
    asm volatile("s_waitcnt vmcnt(0)" ::: "memory");
    __syncthreads();
    if (threadIdx.x == 0) {
        unsigned* bar = b.bar;
        __builtin_amdgcn_s_waitcnt(0);
        unsigned nloc = b.st[0], nx = b.st[1];
        if (nloc == 0u) { xcd_barrier_complete(bar, b.x, nloc, nx); b.st[0] = nloc; b.st[1] = nx; }
        const unsigned old = xb_add(&bar[XB_XSUB(b.x)], 1u);
        const unsigned gen = old / nloc;
        if (old + 1u == (gen + 1u) * nloc) {
            __builtin_amdgcn_fence(__ATOMIC_RELEASE, "agent");
            asm volatile("s_waitcnt vmcnt(0)" ::: "memory");
            const unsigned og = xb_add(&bar[XB_TOP], 1u);
            const unsigned tg = og / nx;
            if (og + 1u == (tg + 1u) * nx) xb_add(&bar[XB_TOPGEN], 1u);
            else XB_SPIN(xb_ld(&bar[XB_TOPGEN]) == tg, bar);
            __builtin_amdgcn_fence(__ATOMIC_ACQUIRE, "agent");
            xb_add(&bar[XB_XGEN(b.x)], 1u);
            asm volatile("s_waitcnt vmcnt(0)" ::: "memory");
        } else {
            XB_SPIN(xb_ld(&bar[XB_XGEN(b.x)]) == gen, bar);
            __builtin_amdgcn_fence(__ATOMIC_ACQUIRE, "agent");
            asm volatile("s_waitcnt vmcnt(0)" ::: "memory");
        }
    }
    __syncthreads();
}

__device__ __forceinline__ void launder(Ctx& c) { asm volatile("" : "+s"(c.a)); asm volatile("" : "+s"(c.ws)); }
__global__ void __launch_bounds__(512, 2) mk_fwd(Args args) {
    extern __shared__ __attribute__((aligned(16))) unsigned char lds_raw[];
    Ctx c; c.a = (CArgs)__builtin_amdgcn_kernarg_segment_ptr(); c.lds = (LAS unsigned char*)lds_raw; c.tid = threadIdx.x; c.lane = c.tid & 63; c.wave = c.tid >> 6; c.nwg = gridDim.x; c.wg = blockIdx.x; c.ws = c.a->ws;
    volatile LAS unsigned* bst = (volatile LAS unsigned*)(c.lds + LDS_BYTES - 64);
    if (c.tid < 4) bst[c.tid] = 0u;
    __syncthreads();
    const XcdBarrier bar = xcd_barrier_post((unsigned*)(c.ws + WS_CTL) + CW_BAR, bst);
    const int lo = c.a->ph_lo, hi = c.a->ph_hi;
    bool route_ok = true;
#define SEAM(k) do { if (lo <= (k) && (k) + 1 < hi) xcd_barrier(bar); } while (0)
#define IN(k) (lo <= (k) && (k) < hi && (launder(c), true))
#define PH(k, call) do { if (IN(k)) { if (PROBE_PH == (k)) { int nrep_ = 3; asm volatile("" : "+s"(nrep_)); for (int rep_ = 0; rep_ < nrep_; ++rep_) { route_ok = (rep_ + 1 == nrep_); call; if (rep_ + 1 < nrep_) xcd_barrier(bar); } } else { call; } } SEAM(k); } while (0)
    PH(0, phase_prep(c));
    PH(1, phase_convert(c));
    PH(2, phase_gemm_qkv(c));
    PH(3, phase_attn(c));
    PH(4, phase_gemm_f32(c, (const bf16_t*)(c.ws + WS_O), R, (const bf16_t*)(c.ws + WS_WO), D, nullptr, (float*)(c.ws + WS_RAW1)));
    PH(5, phase_postmix(c, 0, route_ok));
    PH(6, phase_moe_gu(c, 0));
    PH(7, phase_moe_dn(c, 0));
    PH(8, phase_combine(c, 0));
    PH(9, phase_gemm_inproj(c));
    PH(10, phase_hgrn_scan(c));
    PH(11, phase_hgrn_fold(c));
    PH(12, phase_hgrn_readout(c));
    PH(13, phase_gemm_f32(c, (const bf16_t*)(c.ws + WS_RR), L, (const bf16_t*)(c.ws + WS_WHO), D, nullptr, (float*)(c.ws + WS_RAW1)));
    PH(14, phase_postmix(c, 1, route_ok));
    PH(15, phase_moe_gu(c, 1));
    PH(16, phase_moe_dn(c, 1));
    PH(17, phase_combine(c, 1));
#undef IN
#undef PH
#undef SEAM
}

extern "C" void kernel_launch(void* const* d_in, const int* in_sizes, int n_in, void* d_out, int out_size, void* d_ws, size_t ws_size, hipStream_t stream) {
    static int grid = 0;
    if (grid == 0) {
        if (n_in != 21 || out_size != L * D || ws_size < WS_END) { fprintf(stderr, "kernel_launch: unexpected problem (n_in %d out %d ws %zu need %zu)\n", n_in, out_size, ws_size, (size_t)WS_END); grid = -1; return; }
        int dev = 0, cus = 0, per_cu = 0;
        hipGetDevice(&dev); hipDeviceGetAttribute(&cus, hipDeviceAttributeMultiprocessorCount, dev);
        if (hipFuncSetAttribute((const void*)mk_fwd, hipFuncAttributeMaxDynamicSharedMemorySize, LDS_BYTES) != hipSuccess) { fprintf(stderr, "kernel_launch: hipFuncSetAttribute failed\n"); grid = -1; return; }
        hipOccupancyMaxActiveBlocksPerMultiprocessor(&per_cu, (const void*)mk_fwd, 512, LDS_BYTES);
        if (per_cu < 1) fprintf(stderr, "kernel_launch: occupancy query says %d\n", per_cu);
        (void)hipGetLastError();
        grid = cus > 0 ? cus : 256;
    }
    if (grid < 0) return;
    hipMemsetAsync((char*)d_ws + WS_CTL, 0, MiB, stream);
    Args a{};
    for (int i = 0; i < 21; ++i) a.in[i] = (const float*)d_in[i];
    a.out = (float*)d_out; a.ws = (unsigned char*)d_ws;
    a.ph_lo = 0; a.ph_hi = NPHASE;
    hipLaunchKernelGGL(mk_fwd, dim3(grid), dim3(512), LDS_BYTES, stream, a);
}
```

```cpp
#include <hip/hip_runtime.h>
#include <cstdint>
#include <cstdio>

#define LAS __attribute__((address_space(3)))
typedef unsigned short bf16_t;
typedef short bf16x8 __attribute__((ext_vector_type(8)));
typedef float f32x4 __attribute__((ext_vector_type(4)));
typedef unsigned u32x4 __attribute__((ext_vector_type(4)));
typedef unsigned u32x2 __attribute__((ext_vector_type(2)));
typedef short v4i16_t __attribute__((ext_vector_type(4)));
typedef float f32x2 __attribute__((ext_vector_type(2)));

constexpr int D = 1024, L = 16384, C = 256, R = L + C;
constexpr int QKVD = 1280, HIN = 5120, NE = 32, TOPK = 4;
constexpr int PADM = 256, MAXROWS = 74752;
constexpr float EPS = 1e-6f;
constexpr float LOG2E = 1.4426950408889634f;
constexpr int NPHASE = 18;
#ifndef SCAN_REP
#define SCAN_REP 1
#endif
#ifndef PROBE_PH
#define PROBE_PH (-1)
#endif
constexpr int LDS_BYTES = 147456;

constexpr size_t MiB = 1u << 20;
constexpr size_t al(size_t x) { return (x + MiB - 1) / MiB * MiB; }
constexpr size_t WS_CTL = 0;
constexpr size_t WS_MOD = WS_CTL + MiB;
constexpr size_t WS_X = WS_MOD + MiB;
constexpr size_t WS_H = WS_X + al((size_t)R * D * 4);
constexpr size_t WS_Q = WS_H + al((size_t)R * D * 2);
constexpr size_t WS_K = WS_Q + al((size_t)R * D * 2);
constexpr size_t WS_V = WS_K + al((size_t)R * 128 * 2);
constexpr size_t WS_O = WS_V + al((size_t)R * 128 * 2);
constexpr size_t WS_TK = WS_O + al((size_t)R * D * 2);
constexpr size_t WS_LIST = WS_TK + MiB;
constexpr size_t WS_HDN = WS_LIST + 3 * MiB;
constexpr size_t WS_RAW1 = WS_HDN + al((size_t)MAXROWS * 1024 * 2);
constexpr size_t WS_X1 = WS_RAW1 + al((size_t)R * D * 4);
constexpr size_t WS_OUTB = WS_X1 + al((size_t)R * D * 4);
constexpr size_t WS_QH = WS_OUTB + al((size_t)MAXROWS * 1024 * 2);
constexpr size_t WS_KF = WS_QH + al((size_t)L * D * 2);
constexpr size_t WS_KB = WS_KF + al((size_t)R * D * 2);
constexpr size_t WS_IV = WS_KB + al((size_t)R * D * 2);
constexpr size_t WS_SG = WS_IV + al((size_t)R * D * 2);
constexpr size_t WS_OF = WS_SG + al((size_t)L * D * 2);
constexpr size_t WS_OB = WS_OF + al((size_t)L * D * 4);
constexpr size_t WS_RR = WS_OB + al((size_t)L * D * 4);
constexpr size_t WS_WQKV = WS_RR + al((size_t)L * D * 2);
constexpr size_t WS_WO = WS_WQKV + al((size_t)QKVD * D * 2);
constexpr size_t WS_WIN = WS_WO + al((size_t)D * D * 2);
constexpr size_t WS_WHO = WS_WIN + al((size_t)HIN * D * 2);
constexpr size_t WS_WGU = WS_WHO + al((size_t)D * D * 2);
constexpr size_t WS_WDN = WS_WGU + al((size_t)2 * NE * 2048 * D * 2);
constexpr size_t WS_QSF = WS_WDN + al((size_t)2 * NE * 1024 * D * 2);
constexpr size_t WS_QSB = WS_QSF + al((size_t)L * D * 2);
constexpr size_t WS_DS = WS_QSB + al((size_t)L * D * 2);
constexpr size_t WS_DG = WS_DS + al((size_t)256 * 128 * 128 * 4);
constexpr size_t WS_SST = WS_DG + MiB;
constexpr size_t WS_END = WS_SST + al((size_t)256 * 128 * 128 * 2);
static_assert(WS_END <= (size_t)2048 * MiB, "workspace map exceeds 4x the largest input");
constexpr int CW_CNT = 1024;
constexpr int CW_BAR = 4096;
constexpr int MOD_ROPE = 32768;
constexpr int MOD_LB = 49152;

struct Args { const float* in[21]; float* out; unsigned char* ws; int ph_lo, ph_hi; };

__device__ __forceinline__ unsigned f2bf(float f) { unsigned u = __float_as_uint(f); return (u + 0x7fffu + ((u >> 16) & 1u)) >> 16; }
typedef float f32x2_t __attribute__((ext_vector_type(2))); typedef __bf16 bf16x2_t __attribute__((ext_vector_type(2)));
__device__ __forceinline__ unsigned pk2(float lo, float hi) { f32x2_t v = {lo, hi}; bf16x2_t b = __builtin_convertvector(v, bf16x2_t); return __builtin_bit_cast(unsigned, b); }
__device__ __forceinline__ float bflo(unsigned u) { return __uint_as_float(u << 16); }
__device__ __forceinline__ float bfhi(unsigned u) { return __uint_as_float(u & 0xffff0000u); }
__device__ __forceinline__ float bf2f(bf16_t b) { return __uint_as_float(((unsigned)b) << 16); }
__device__ __forceinline__ float wave_sum(float v) {
#pragma unroll
    for (int o = 32; o > 0; o >>= 1) v += __shfl_xor(v, o);
    return v;
}
__device__ __forceinline__ float silu_f(float x) { return x / (1.f + __expf(-x)); }
__device__ __forceinline__ float sigmoid_f(float x) { return 1.f / (1.f + __expf(-x)); }

typedef const __attribute__((address_space(4))) Args* CArgs;
struct Ctx {
    CArgs a;
    LAS unsigned char* lds;
    int tid, lane, wave, nwg, wg;
    unsigned char* ws;
    __device__ __forceinline__ float* modp(int layer, int which) const { return (float*)(ws + WS_MOD) + (layer * 2 + which) * 6144; }
    __device__ __forceinline__ const float* xin0(int r) const { return r < C ? a->in[2] + (size_t)r * D : a->in[0] + (size_t)(r - C) * D; }
};


namespace pg8 {
constexpr int BM = 256, BK = 64, HALF = 128, HTB = HALF * BK * 2, STAGE_BYTES = 8 * HTB, KD = 1024, NXCD = 8, WGM = 8;
__device__ __forceinline__ int lds_byte(int r, int c) { const int st = (r >> 4) * 2 + (c >> 5), rr = r & 15, cc = c & 31, ob = rr * 64 + cc * 2; return st * 1024 + (ob ^ (((ob >> 9) & 1) << 5)); }
__device__ __forceinline__ void stage_rc(int b, int& Rr, int& Cc) { const int st = b / 1024, sb = b % 1024, swz = sb ^ (((sb >> 9) & 1) << 5); Rr = (st >> 1) * 16 + swz / 64; Cc = (st & 1) * 32 + (swz % 64) / 2; }
__device__ __forceinline__ int perm32(int rho) { const int n = rho >> 4, i = rho & 15; return 8 * (i >> 2) + 4 * n + (i & 3); }

struct Unit { int pm, pn, e, goff, gcnt; };
struct Gemm { const bf16_t* A; const bf16_t* Bt; size_t bstride; const int* list; };

struct StaticOrder {
    int nM, nN, nwg, G, c;
    __device__ __forceinline__ void init(int M, int N, int G_, int c_) { nM = M / BM; nN = N / BM; nwg = nM * nN; G = G_; c = c_; }
    __device__ __forceinline__ bool next(int i, Unit& u) const {
        const long Lq = (long)i * G + c; if (Lq >= nwg) return false;
        int wgid = (int)Lq; { const int q = nwg / NXCD, r = nwg % NXCD, xcd = wgid % NXCD, off = wgid / NXCD; wgid = (xcd < r ? xcd * (q + 1) : r * (q + 1) + (xcd - r) * q) + off; }
        const int nig = WGM * nN, gid = wgid / nig, fm = gid * WGM, gsz = (nM - fm) < WGM ? (nM - fm) : WGM;
        u.pm = fm + ((wgid % nig) % gsz); u.pn = (wgid % nig) / gsz; u.e = 0; u.goff = 0; u.gcnt = 0; return true;
    }
};
struct MoeOrder {
    const LAS int* tp; const LAS int* cnt; int npn, G, vcu;
    __device__ __forceinline__ bool next(int i, Unit& u) const {
        const int lin = i * G + vcu; if (lin >= tp[32] * npn) return false;
        const int rt = lin / npn; int e = 0;
#pragma unroll 8
        for (int k = 1; k < 32; ++k) e += (rt >= tp[k]) ? 1 : 0;
        const int mt = rt - tp[e];
        u.pm = rt; u.pn = lin - rt * npn; u.e = e; u.goff = e * R + mt * 256; u.gcnt = cnt[e] - mt * 256; return true;
    }
};

__device__ __forceinline__ void a_offsets(const Gemm& g, const Unit& u, const int (&sR)[2], const int (&sC)[2], unsigned (&v)[2][2]) {
#pragma unroll
    for (int h = 0; h < 2; ++h)
#pragma unroll
        for (int i = 0; i < 2; ++i) {
            const int rr = h * HALF + sR[i]; int row;
            if (g.list) row = rr < u.gcnt ? g.list[u.goff + rr] : 0; else row = u.pm * BM + rr;
            v[h][i] = (unsigned)(row * KD + sC[i]) * 2u;
        }
}

struct EpiF32 {
    static constexpr bool PERM = false;
    float* Cp; int ldc; const float* bias;
    __device__ __forceinline__ void operator()(const f32x4 (&acc)[2][2][4][2], const Unit& u, int wr, int wc, int fr, int fq) const {
        const int row0 = u.pm * BM + wr * 64 + fr, col0 = u.pn * BM + wc * 32 + 4 * fq;
#pragma unroll
        for (int bj = 0; bj < 2; ++bj)
#pragma unroll
            for (int n = 0; n < 2; ++n) {
                const int col = col0 + bj * HALF + n * 16;
                const f32x4 bv = bias ? *(const f32x4*)(bias + col) : (f32x4){0.f, 0.f, 0.f, 0.f};
#pragma unroll
                for (int ai = 0; ai < 2; ++ai)
#pragma unroll
                    for (int m = 0; m < 4; ++m) *(f32x4*)(Cp + (size_t)(row0 + ai * HALF + m * 16) * ldc + col) = acc[ai][bj][m][n] + bv;
            }
    }
};
struct EpiSwiglu {
    static constexpr bool PERM = false;
    bf16_t* Hd; const float* bgu;
    __device__ __forceinline__ void operator()(const f32x4 (&acc)[2][2][4][2], const Unit& u, int wr, int wc, int fr, int fq) const {
        const int row0 = u.pm * BM + wr * 64 + fr, cg0 = u.pn * HALF + wc * 32 + 4 * fq;
        const float* bb = bgu + (size_t)u.e * 2048;
#pragma unroll
        for (int n = 0; n < 2; ++n) {
            const int cg = cg0 + n * 16;
            const f32x4 bg = *(const f32x4*)(bb + cg), bu = *(const f32x4*)(bb + 1024 + cg);
#pragma unroll
            for (int ai = 0; ai < 2; ++ai)
#pragma unroll
                for (int m = 0; m < 4; ++m) {
                    const f32x4 gv = acc[ai][0][m][n] + bg, uv = acc[ai][1][m][n] + bu; float hv[4];
#pragma unroll
                    for (int q = 0; q < 4; ++q) { const float gg = fminf(gv[q], 7.f), uu = fminf(fmaxf(uv[q], -7.f), 7.f); hv[q] = gg * (1.f / (1.f + __expf(-1.702f * gg))) * (uu + 1.f); }
                    u32x2 o; o.x = pk2(hv[0], hv[1]); o.y = pk2(hv[2], hv[3]);
                    *(u32x2*)(Hd + (size_t)(row0 + ai * HALF + m * 16) * 1024 + cg) = o;
                }
        }
    }
};
struct EpiBf16Bias {
    static constexpr bool PERM = false;
    bf16_t* Op; const float* bias; int bias_estride;
    __device__ __forceinline__ void operator()(const f32x4 (&acc)[2][2][4][2], const Unit& u, int wr, int wc, int fr, int fq) const {
        const int row0 = u.pm * BM + wr * 64 + fr, col0 = u.pn * BM + wc * 32 + 4 * fq;
        const float* bb = bias + (size_t)u.e * bias_estride;
#pragma unroll
        for (int bj = 0; bj < 2; ++bj)
#pragma unroll
            for (int n = 0; n < 2; ++n) {
                const int col = col0 + bj * HALF + n * 16;
                const f32x4 bv = *(const f32x4*)(bb + col);
#pragma unroll
                for (int ai = 0; ai < 2; ++ai)
#pragma unroll
                    for (int m = 0; m < 4; ++m) { const f32x4 v = acc[ai][bj][m][n] + bv; u32x2 o; o.x = pk2(v[0], v[1]); o.y = pk2(v[2], v[3]);
                        *(u32x2*)(Op + (size_t)(row0 + ai * HALF + m * 16) * 1024 + col) = o; }
            }
    }
};

struct EpiQKV {
    static constexpr bool PERM = false;
    bf16_t* Qp; bf16_t* Kp; bf16_t* Vp; const float* bias; const float* tab;
    __device__ __forceinline__ void operator()(const f32x4 (&acc)[2][2][4][2], const Unit& u, int wr, int wc, int fr, int fq) const {
        const bool lat = u.pm > 0; const float qs = 0.125f * LOG2E;
#pragma unroll
        for (int bj = 0; bj < 2; ++bj) {
            const int colt = u.pn * BM + bj * HALF + wc * 32 + 4 * fq;
            const f32x4 b1 = *(const f32x4*)(bias + colt), b2 = *(const f32x4*)(bias + colt + 16);
            const bool isv = (u.pn == 4) && (bj == 1);
#pragma unroll
            for (int ai = 0; ai < 2; ++ai)
#pragma unroll
                for (int m = 0; m < 4; ++m) {
                    const int r = u.pm * BM + ai * HALF + wr * 64 + m * 16 + fr, t = r - C;
                    f32x4 x1 = acc[ai][bj][m][0] + b1, x2 = acc[ai][bj][m][1] + b2;
                    if (lat && !isv) {
                        const int pos = (wc & 1) ? (t & 63) : (t >> 6);
                        const f32x4 t0 = *(const f32x4*)(tab + (pos * 16 + 4 * fq) * 2), t1 = *(const f32x4*)(tab + (pos * 16 + 4 * fq) * 2 + 4);
                        const float cs[4] = {t0[0], t0[2], t1[0], t1[2]}, sn[4] = {t0[1], t0[3], t1[1], t1[3]};
                        f32x4 o1, o2;
#pragma unroll
                        for (int e = 0; e < 4; ++e) { o1[e] = x1[e] * cs[e] - x2[e] * sn[e]; o2[e] = x2[e] * cs[e] + x1[e] * sn[e]; }
                        x1 = o1; x2 = o2;
                    }
                    u32x2 w1, w2;
                    if (u.pn < 4) {
                        w1.x = pk2(x1[0] * qs, x1[1] * qs); w1.y = pk2(x1[2] * qs, x1[3] * qs); w2.x = pk2(x2[0] * qs, x2[1] * qs); w2.y = pk2(x2[2] * qs, x2[3] * qs);
                        *(u32x2*)(Qp + (size_t)r * 1024 + colt) = w1; *(u32x2*)(Qp + (size_t)r * 1024 + colt + 16) = w2;
                    } else {
                        w1.x = pk2(x1[0], x1[1]); w1.y = pk2(x1[2], x1[3]); w2.x = pk2(x2[0], x2[1]); w2.y = pk2(x2[2], x2[3]);
                        bf16_t* dst = (bj == 0 ? Kp : Vp) + (size_t)r * 128 + wc * 32 + 4 * fq;
                        *(u32x2*)dst = w1; *(u32x2*)(dst + 16) = w2;
                    }
                }
        }
    }
};
struct EpiInProj {
    static constexpr bool PERM = false;
    bf16_t* QH; _Float16* KF; _Float16* KB; bf16_t* IV; bf16_t* SG; const float* lb;
    __device__ __forceinline__ void operator()(const f32x4 (&acc)[2][2][4][2], const Unit& u, int wr, int wc, int fr, int fq) const {
        const int seg = u.pn >> 2; const bool lat = u.pm > 0;
        if (!lat && (seg == 0 || seg == 4)) return;
#pragma unroll
        for (int bj = 0; bj < 2; ++bj)
#pragma unroll
            for (int n = 0; n < 2; ++n) {
                const int col = (u.pn & 3) * BM + bj * HALF + wc * 32 + n * 16 + 4 * fq;
                f32x4 lbv = (f32x4){0.f, 0.f, 0.f, 0.f};
                if (seg == 1) lbv = *(const f32x4*)(lb + col); else if (seg == 2) lbv = *(const f32x4*)(lb + 1024 + col);
#pragma unroll
                for (int ai = 0; ai < 2; ++ai)
#pragma unroll
                    for (int m = 0; m < 4; ++m) {
                        const int r = u.pm * BM + ai * HALF + wr * 64 + m * 16 + fr; const f32x4 v = acc[ai][bj][m][n];
                        if (seg == 1 || seg == 2) {
                            typedef _Float16 h4_t __attribute__((ext_vector_type(4)));
                            h4_t hv;
#pragma unroll
                            for (int e = 0; e < 4; ++e) hv[e] = (_Float16)((1.f - lbv[e]) / (1.f + __expf(v[e])));
                            *(h4_t*)((seg == 1 ? KF : KB) + (size_t)r * 1024 + col) = hv;
                        } else if (seg == 3) {
                            u32x2 o; o.x = pk2(v[0], v[1]); o.y = pk2(v[2], v[3]); *(u32x2*)(IV + (size_t)r * 1024 + col) = o;
                        } else {
                            float sv[4];
#pragma unroll
                            for (int e = 0; e < 4; ++e) sv[e] = v[e] / (1.f + __expf(-v[e]));
                            u32x2 o; o.x = pk2(sv[0], sv[1]); o.y = pk2(sv[2], sv[3]); *(u32x2*)((seg == 0 ? QH : SG) + (size_t)(r - C) * 1024 + col) = o;
                        }
                    }
            }
    }
};

template <class Epi, class Sched, bool ALIGN_EPI, bool GATHER>
__device__ __forceinline__ void gemm_phase(LAS unsigned char* lds, const Gemm g, const Sched& S, const Epi& E, const int tid) {
    const int wid = __builtin_amdgcn_readfirstlane(tid >> 6), lane = tid & 63, wr = wid >> 2, wc = wid & 3, fr = lane & 15, fq = lane >> 4;
    constexpr int K = KD, nt = K / BK;
    int sR[2], sC[2]; unsigned voffB[2], voffA[2];
#pragma unroll
    for (int i = 0; i < 2; ++i) { stage_rc(tid * 16 + i * 8192, sR[i], sC[i]); const int Rb = Epi::PERM ? ((sR[i] & ~31) + perm32(sR[i] & 31)) : sR[i]; voffB[i] = (unsigned)(Rb * K + sC[i]) * 2u; voffA[i] = (unsigned)(sR[i] * K + sC[i]) * 2u; }
    constexpr size_t kstep = (size_t)(BK * 2), hstep = (size_t)HALF * K * 2, tstep = 2 * hstep;
    const unsigned ldsw = (unsigned)wid * 1024u;
    const int aoff = lds_byte(wr * 64 + fr, fq * 8), boff = lds_byte(wc * 32 + fr, fq * 8);
    const char* Ab = (const char*)g.A;
#define PG8_SA(b, h) (((b) * 2 + (h)) * HTB)
#define PG8_SB(b, h) ((4 + (b) * 2 + (h)) * HTB)
#define PG8_STAGE_B(bufoff, gbase) do { _Pragma("unroll") for (int _i = 0; _i < 2; ++_i) \
        __builtin_amdgcn_global_load_lds((const unsigned*)((const char*)(gbase) + voffB[_i]), (LAS unsigned*)(lds + (bufoff) + ldsw + _i * 8192), 16, 0, 0); } while (0)
#define PG8_STAGE_A(bufoff, kb, v, ubase) do { _Pragma("unroll") for (int _i = 0; _i < 2; ++_i) \
        __builtin_amdgcn_global_load_lds((const unsigned*)((GATHER ? Ab : (ubase)) + (size_t)(kb) + (GATHER ? (v)[_i] : voffA[_i])), (LAS unsigned*)(lds + (bufoff) + ldsw + _i * 8192), 16, 0, 0); } while (0)
#define PG8_LDA(dst, b, h) do { _Pragma("unroll") for (int m = 0; m < 4; ++m) _Pragma("unroll") for (int k = 0; k < 2; ++k) dst[m][k] = *(const LAS bf16x8*)(lds + PG8_SA(b, h) + aoff + m * 2048 + k * 1024); } while (0)
#define PG8_LDB(dst, b, h) do { _Pragma("unroll") for (int n = 0; n < 2; ++n) _Pragma("unroll") for (int k = 0; k < 2; ++k) dst[n][k] = *(const LAS bf16x8*)(lds + PG8_SB(b, h) + boff + n * 2048 + k * 1024); } while (0)
#define PG8_MMA(ai, bj, At, Bt) do { __builtin_amdgcn_s_setprio(1); _Pragma("unroll") for (int m = 0; m < 4; ++m) _Pragma("unroll") for (int n = 0; n < 2; ++n) _Pragma("unroll") for (int k = 0; k < 2; ++k) \
        acc[ai][bj][m][n] = __builtin_amdgcn_mfma_f32_16x16x32_bf16(Bt[n][k], At[m][k], acc[ai][bj][m][n], 0, 0, 0); __builtin_amdgcn_s_setprio(0); } while (0)
#define PG8_WAIT_V(n) asm volatile("s_waitcnt vmcnt(" #n ")" ::: "memory")
#define PG8_WAIT_L(n) asm volatile("s_waitcnt lgkmcnt(" #n ")" ::: "memory")
#define PG8_BAR __builtin_amdgcn_s_barrier()
#define PG8_SCHED __builtin_amdgcn_sched_barrier(0)
    Unit cur, nxt; int ui = 0;
    if (!S.next(0, cur)) return;
    unsigned cv[2][2], nv[2][2];
    if constexpr (GATHER) a_offsets(g, cur, sR, sC, cv);
    const char* cA = Ab + (size_t)cur.pm * tstep; const char* nA = cA;
    f32x4 acc[2][2][4][2];
#pragma unroll
    for (int a = 0; a < 2; ++a)
#pragma unroll
        for (int b = 0; b < 2; ++b)
#pragma unroll
            for (int m = 0; m < 4; ++m)
#pragma unroll
                for (int n = 0; n < 2; ++n) acc[a][b][m][n] = (f32x4){0.f, 0.f, 0.f, 0.f};
    bf16x8 At[4][2], B0[2][2], B1[2][2];
    const char* cB = (const char*)g.Bt + ((size_t)cur.e * g.bstride) * 2 + (size_t)cur.pn * tstep;
    PG8_STAGE_B(PG8_SB(0, 0), cB); PG8_STAGE_B(PG8_SB(0, 1), cB + hstep); PG8_STAGE_A(PG8_SA(0, 0), 0, cv[0], cA); PG8_STAGE_A(PG8_SA(0, 1), 0, cv[1], cA + hstep);
    if (wr == 1) PG8_BAR;
    PG8_WAIT_V(2); PG8_BAR;
    PG8_STAGE_B(PG8_SB(1, 0), cB + kstep); PG8_STAGE_A(PG8_SA(1, 0), kstep, cv[0], cA); PG8_STAGE_B(PG8_SB(1, 1), cB + hstep + kstep);
    PG8_WAIT_V(6); PG8_BAR;
    for (;;) {
        const bool has_next = S.next(ui + 1, nxt);
        const char* nB = cB;
        nA = cA;
        if (has_next) { if constexpr (GATHER) a_offsets(g, nxt, sR, sC, nv); nA = Ab + (size_t)nxt.pm * tstep; nB = (const char*)g.Bt + ((size_t)nxt.e * g.bstride) * 2 + (size_t)nxt.pn * tstep; }
        else if constexpr (GATHER) {
#pragma unroll
            for (int h = 0; h < 2; ++h)
#pragma unroll
                for (int i = 0; i < 2; ++i) nv[h][i] = cv[h][i];
        }
        for (int t = 0; t < nt; t += 2) {
            const bool last = (t == nt - 2);
            const size_t k1 = (size_t)(t + 1) * kstep, k2 = last ? 0 : (size_t)(t + 2) * kstep, k3 = k2 + kstep;
            const char* b2 = last ? nB : cB + (size_t)(t + 2) * kstep; const char* b3 = b2 + kstep;
            unsigned w0[2], w1[2];
            if constexpr (GATHER) {
#pragma unroll
                for (int i = 0; i < 2; ++i) { w0[i] = last ? nv[0][i] : cv[0][i]; w1[i] = last ? nv[1][i] : cv[1][i]; }
            }
            const char* a2 = last ? nA : cA;
            PG8_LDB(B0, 0, 0); PG8_LDB(B1, 0, 1); PG8_SCHED; PG8_LDA(At, 0, 0); PG8_STAGE_A(PG8_SA(1, 1), k1, cv[1], cA + hstep);
            PG8_WAIT_V(8); PG8_WAIT_L(0); PG8_BAR; PG8_MMA(0, 0, At, B0); PG8_MMA(0, 1, At, B1); PG8_BAR; PG8_SCHED;
            PG8_LDA(At, 0, 1); PG8_STAGE_B(PG8_SB(0, 0), b2); PG8_STAGE_B(PG8_SB(0, 1), b2 + hstep); PG8_STAGE_A(PG8_SA(0, 0), k2, w0, a2);
            PG8_WAIT_V(8); PG8_WAIT_L(0); PG8_BAR; PG8_MMA(1, 0, At, B0); PG8_MMA(1, 1, At, B1); PG8_BAR; PG8_SCHED;
            PG8_LDB(B0, 1, 0); PG8_LDB(B1, 1, 1); PG8_SCHED; PG8_LDA(At, 1, 0); PG8_STAGE_A(PG8_SA(0, 1), k2, w1, a2 + hstep);
            PG8_WAIT_V(8); PG8_WAIT_L(0); PG8_BAR; PG8_MMA(0, 0, At, B0); PG8_MMA(0, 1, At, B1); PG8_BAR; PG8_SCHED;
            PG8_LDA(At, 1, 1); PG8_STAGE_B(PG8_SB(1, 0), b3); PG8_STAGE_B(PG8_SB(1, 1), b3 + hstep); PG8_STAGE_A(PG8_SA(1, 0), k3, w0, a2);
            PG8_WAIT_V(8); PG8_WAIT_L(0); PG8_BAR; PG8_MMA(1, 0, At, B0); PG8_MMA(1, 1, At, B1); PG8_BAR; PG8_SCHED;
        }
        if constexpr (ALIGN_EPI) { if (wr == 0) PG8_BAR; }
        E(acc, cur, wr, wc, fr, fq);
        if (!has_next) break;
#pragma unroll
        for (int a = 0; a < 2; ++a)
#pragma unroll
            for (int b = 0; b < 2; ++b)
#pragma unroll
                for (int m = 0; m < 4; ++m)
#pragma unroll
                    for (int n = 0; n < 2; ++n) acc[a][b][m][n] = (f32x4){0.f, 0.f, 0.f, 0.f};
        cur = nxt; cB = nB; cA = nA; ++ui;
        if constexpr (GATHER) {
#pragma unroll
            for (int h = 0; h < 2; ++h)
#pragma unroll
                for (int i = 0; i < 2; ++i) cv[h][i] = nv[h][i];
        }
        if constexpr (ALIGN_EPI) { if (wr == 1) PG8_BAR; }
    }
    PG8_WAIT_V(0);
    if constexpr (!ALIGN_EPI) { if (wr == 0) PG8_BAR; }
    PG8_BAR;
#undef PG8_SA
#undef PG8_SB
#undef PG8_STAGE_A
#undef PG8_STAGE_B
#undef PG8_LDA
#undef PG8_LDB
#undef PG8_MMA
#undef PG8_WAIT_V
#undef PG8_WAIT_L
#undef PG8_BAR
#undef PG8_SCHED
}
}

struct TBlk { const float* src; int ldw; bf16_t* dst; };
__device__ __forceinline__ void tb_load(const TBlk& t, int lane, f32x4 (&v)[16]) {
    const float* p = t.src + (size_t)(lane >> 4) * t.ldw + (lane & 15) * 4;
#pragma unroll
    for (int i = 0; i < 16; ++i) v[i] = *(const f32x4*)(p + (size_t)(4 * i) * t.ldw);
}
__device__ __forceinline__ void tb_store(const TBlk& t, int lane, const f32x4 (&v)[16], LAS float* scr) {
#pragma unroll
    for (int i = 0; i < 16; ++i) { LAS float* d = scr + ((lane >> 4) + 4 * i) * 65 + (lane & 15) * 4; d[0] = v[i].x; d[1] = v[i].y; d[2] = v[i].z; d[3] = v[i].w; }
    asm volatile("s_waitcnt lgkmcnt(0)" ::: "memory"); __builtin_amdgcn_wave_barrier();
    const int c8 = lane & 7;
#pragma unroll
    for (int jj = 0; jj < 8; ++jj) {
        const int n = (lane >> 3) + 8 * jj; const LAS float* p = scr + (8 * c8) * 65 + n;
        u32x4 o; o.x = pk2(p[0], p[65]); o.y = pk2(p[2 * 65], p[3 * 65]); o.z = pk2(p[4 * 65], p[5 * 65]); o.w = pk2(p[6 * 65], p[7 * 65]);
        *(u32x4*)(t.dst + (size_t)n * 1024 + 8 * c8) = o;
    }
    asm volatile("s_waitcnt lgkmcnt(0)" ::: "memory"); __builtin_amdgcn_wave_barrier();
}

__device__ __forceinline__ void phase_prep(const Ctx& c) {
    LAS float* red = (LAS float*)c.lds;
    const float* cv = c.a->in[1]; const float* ccv = c.a->in[3]; const float* ada_w = c.a->in[4]; const float* ada_b = c.a->in[5];
    for (int item = c.wg; item < 193; item += c.nwg) {
        if (item < 192) {
            const int layer = item / 96, cb = item % 96, col = cb * 64 + c.lane;
            const float* W = ada_w + (size_t)layer * D * 6144 + col;
            float a0 = 0.f, a1 = 0.f;
            const int k0 = c.wave * 128;
#pragma unroll 32
            for (int k = 0; k < 128; ++k) { const float w = W[(size_t)(k0 + k) * 6144]; a0 += silu_f(cv[k0 + k]) * w; a1 += silu_f(ccv[k0 + k]) * w; }
            red[(0 * 8 + c.wave) * 64 + c.lane] = a0; red[(1 * 8 + c.wave) * 64 + c.lane] = a1;
            __syncthreads();
            if (c.tid < 128) {
                const int which = c.tid >> 6, l = c.tid & 63; float s = 0.f;
#pragma unroll
                for (int w = 0; w < 8; ++w) s += red[(which * 8 + w) * 64 + l];
                c.modp(layer, which)[cb * 64 + l] = s + ada_b[layer * 6144 + cb * 64 + l];
            }
            __syncthreads();
        } else {
            float* modbase = (float*)(c.ws + WS_MOD);
            for (int i = c.tid; i < 4096; i += 512) {
                const int pos = i >> 4, j = i & 15;
                const double ang = (double)pos * pow(10000.0, -(double)j / 16.0);
                modbase[MOD_ROPE + 2 * i] = (float)cos(ang); modbase[MOD_ROPE + 2 * i + 1] = (float)sin(ang);
            }
            const float* lbp = c.a->in[12];
            for (int i = c.tid; i < 2048; i += 512) { const float p0 = lbp[i], p1 = lbp[2048 + i]; modbase[MOD_LB + i] = 1.f / (1.f + __expf(p0 - p1)); }
        }
    }
}

__device__ __forceinline__ void row_load(const float* p, int lane, f32x4 (&v)[4]) {
#pragma unroll
    for (int j = 0; j < 4; ++j) v[j] = *(const f32x4*)(p + lane * 4 + 256 * j);
}
__device__ __forceinline__ float row_ss(const f32x4 (&v)[4]) {
    float s = 0.f;
#pragma unroll
    for (int j = 0; j < 4; ++j) s += v[j].x * v[j].x + v[j].y * v[j].y + v[j].z * v[j].z + v[j].w * v[j].w;
    return wave_sum(s);
}
__device__ __forceinline__ void row_modnorm_store(const f32x4 (&x)[4], float rstd, const float* g, const float* sh, const float* sc, bf16_t* out, int lane, f32x4 (*hout)[4] = nullptr) {
#pragma unroll
    for (int j = 0; j < 4; ++j) {
        const int c0 = lane * 4 + 256 * j;
        const f32x4 gv = *(const f32x4*)(g + c0), shv = *(const f32x4*)(sh + c0), scv = *(const f32x4*)(sc + c0);
        f32x4 h;
        h.x = x[j].x * rstd * gv.x * (1.f + scv.x) + shv.x; h.y = x[j].y * rstd * gv.y * (1.f + scv.y) + shv.y;
        h.z = x[j].z * rstd * gv.z * (1.f + scv.z) + shv.z; h.w = x[j].w * rstd * gv.w * (1.f + scv.w) + shv.w;
        if (hout) (*hout)[j] = h;
        u32x2 o; o.x = pk2(h.x, h.y); o.y = pk2(h.z, h.w);
        *(u32x2*)(out + c0) = o;
    }
}

__device__ __forceinline__ void phase_norm0(const Ctx& c) {
    bf16_t* H = (bf16_t*)(c.ws + WS_H); const float* ng = c.a->in[6];
    int r = c.wg * 8 + c.wave;
    f32x4 xn[4];
    if (r < R) row_load(c.xin0(r), c.lane, xn);
    for (; r < R; r += c.nwg * 8) {
        f32x4 x[4];
#pragma unroll
        for (int j = 0; j < 4; ++j) x[j] = xn[j];
        if (r + c.nwg * 8 < R) row_load(c.xin0(r + c.nwg * 8), c.lane, xn);
        const float rstd = rsqrtf(row_ss(x) * (1.f / D) + EPS);
        const float* m = c.modp(0, r < C ? 1 : 0);
        row_modnorm_store(x, rstd, ng, m + 0, m + 1024, H + (size_t)r * D, c.lane);
    }
}

namespace at {
constexpr int KP = 144, TILEB = 64 * KP;
__device__ __forceinline__ bf16x8 tr_frag2(const LAS unsigned char* tile, int row0, int col0, int lane) {
    const int q = (lane & 15) >> 2, p = lane & 3;
    const LAS unsigned char* a = tile + (row0 + q) * KP + (col0 + 4 * p) * 2;
    const v4i16_t lo = __builtin_amdgcn_ds_read_tr16_b64_v4i16((LAS v4i16_t*)a);
    const v4i16_t hi = __builtin_amdgcn_ds_read_tr16_b64_v4i16((LAS v4i16_t*)(a + 16 * KP));
    return (bf16x8){lo[0], lo[1], lo[2], lo[3], hi[0], hi[1], hi[2], hi[3]};
}
}
__device__ __forceinline__ void phase_attn(const Ctx& c) {
    using namespace at;
    const bf16_t* Q = (const bf16_t*)(c.ws + WS_Q); const bf16_t* K = (const bf16_t*)(c.ws + WS_K); const bf16_t* V = (const bf16_t*)(c.ws + WS_V);
    bf16_t* O = (bf16_t*)(c.ws + WS_O); const float* sink = c.a->in[9];
    LAS unsigned char* lds = c.lds;
    const int tid = c.tid, lane = c.lane, w = __builtin_amdgcn_readfirstlane(tid >> 6), fr = lane & 15, g = lane >> 4;
    const int lrow = tid >> 3, lch = tid & 7;
    for (int item = c.wg; item < 264; item += c.nwg) {
        const bool isctx = item >= 256;
        const int ci = item - 256;
        const int n = isctx ? 0 : (item >> 1), kh = isctx ? ((ci >> 1) & 1) : (item & 1), cb = isctx ? (ci >> 2) : 0;
        const int p_lo = isctx ? (ci & 1) : 0, p_hi = isctx ? (ci & 1) + 1 : 2;
        const int hq = kh * 8 + w;
        const float sink2 = sink[hq] * LOG2E;
        for (int pass = p_lo; pass < p_hi; ++pass) {
            const int t0 = 128 * n + 64 * pass, qrow0 = isctx ? cb * 128 + 64 * pass : C + t0;
            const int jlo = isctx ? 0 : (t0 >= 128 ? 0 : (128 - t0) / 64), jhi = isctx ? 0 : ((L - t0 + 128) / 64 < 5 ? (L - t0 + 128) / 64 : 5);
            const int ntile = 4 + (jhi - jlo);
            LAS unsigned char* qlds = lds + 4 * TILEB + w * TILEB;
#pragma unroll
            for (int qb = 0; qb < 4; ++qb)
#pragma unroll
                for (int ks = 0; ks < 2; ++ks) *(LAS bf16x8*)(qlds + (16 * qb + fr) * KP + (32 * ks + 8 * g) * 2) = *(const bf16x8*)(Q + (size_t)(qrow0 + 16 * qb + fr) * D + hq * 64 + 32 * ks + 8 * g);
            float mrow[4], lsum[4]; f32x4 OT[4][4];
#pragma unroll
            for (int qb = 0; qb < 4; ++qb) { mrow[qb] = sink2; lsum[qb] = 1.f;
#pragma unroll
                for (int nt = 0; nt < 4; ++nt) OT[qb][nt] = (f32x4){0.f, 0.f, 0.f, 0.f}; }
            u32x4 kreg, vreg;
#define AT_KROW(ti) ((ti) < 4 ? 64 * (ti) : C + t0 - 128 + 64 * (jlo + (ti) - 4))
#define AT_LOAD(ti) do { const size_t ro_ = (size_t)(AT_KROW(ti) + lrow) * 128 + kh * 64 + lch * 8; kreg = *(const u32x4*)(K + ro_); vreg = *(const u32x4*)(V + ro_); } while (0)
#define AT_WRITE(buf) do { *(LAS u32x4*)(lds + (buf) * 2 * TILEB + lrow * KP + lch * 16) = kreg; *(LAS u32x4*)(lds + (buf) * 2 * TILEB + TILEB + lrow * KP + lch * 16) = vreg; } while (0)
            AT_LOAD(0); AT_WRITE(0);
            __syncthreads();
            for (int ti = 0; ti < ntile; ++ti) {
                if (ti + 1 < ntile) AT_LOAD(ti + 1);
                const LAS unsigned char* kb = lds + (ti & 1) * 2 * TILEB; const LAS unsigned char* vb = kb + TILEB;
                const int jj = jlo + ti - 4; const bool masked = (ti >= 4) && (jj == 0 || jj == 4);
                const int k0 = t0 - 128 + 64 * jj;
                bf16x8 Kf[4][2];
#pragma unroll
                for (int mt = 0; mt < 4; ++mt)
#pragma unroll
                    for (int ks = 0; ks < 2; ++ks) Kf[mt][ks] = *(const LAS bf16x8*)(kb + (16 * mt + fr) * KP + (32 * ks + 8 * g) * 2);
#pragma unroll
                for (int qb = 0; qb < 4; ++qb) {
                    asm volatile("" ::: "memory");
                    bf16x8 Vf[4][2];
#pragma unroll
                    for (int mt = 0; mt < 4; ++mt)
#pragma unroll
                        for (int ks = 0; ks < 2; ++ks)
                            Vf[mt][ks] = tr_frag2(vb, 32 * ks + 4 * g, 16 * mt, lane);
                    bf16x8 Qq[2];
#pragma unroll
                    for (int ks = 0; ks < 2; ++ks) Qq[ks] = *(const LAS bf16x8*)(qlds + (16 * qb + fr) * KP + (32 * ks + 8 * g) * 2);
                    f32x4 sa[4];
#pragma unroll
                    for (int mt = 0; mt < 4; ++mt) { sa[mt] = (f32x4){0.f, 0.f, 0.f, 0.f};
#pragma unroll
                        for (int ks = 0; ks < 2; ++ks) sa[mt] = __builtin_amdgcn_mfma_f32_16x16x32_bf16(Kf[mt][ks], Qq[ks], sa[mt], 0, 0, 0); }
                    if (masked) {
                        const int tq = t0 + 16 * qb + fr;
#pragma unroll
                        for (int mt = 0; mt < 4; ++mt)
#pragma unroll
                            for (int e = 0; e < 4; ++e) { const int dt = tq - (k0 + 16 * mt + 4 * g + e); if (dt > 128 || dt < -128) sa[mt][e] = -INFINITY; }
                    }
                    float mx = fmaxf(fmaxf(sa[0][0], sa[0][1]), fmaxf(sa[0][2], sa[0][3]));
#pragma unroll
                    for (int mt = 1; mt < 4; ++mt) mx = fmaxf(mx, fmaxf(fmaxf(sa[mt][0], sa[mt][1]), fmaxf(sa[mt][2], sa[mt][3])));
                    mx = fmaxf(mx, __shfl_xor(mx, 16)); mx = fmaxf(mx, __shfl_xor(mx, 32));
                    const float mn = fmaxf(mrow[qb], mx), alpha = __builtin_amdgcn_exp2f(mrow[qb] - mn);
                    mrow[qb] = mn;
                    float rs = 0.f;
#pragma unroll
                    for (int mt = 0; mt < 4; ++mt)
#pragma unroll
                        for (int e = 0; e < 4; ++e) { const float pv = __builtin_amdgcn_exp2f(sa[mt][e] - mn); sa[mt][e] = pv; rs += pv; }
                    rs += __shfl_xor(rs, 16); rs += __shfl_xor(rs, 32);
                    lsum[qb] = lsum[qb] * alpha + rs;
                    bf16x8 Pb[2];
#pragma unroll
                    for (int ks = 0; ks < 2; ++ks) { const f32x4 a0 = sa[2 * ks], a1 = sa[2 * ks + 1];
                        const u32x4 pk = (u32x4){pk2(a0[0], a0[1]), pk2(a0[2], a0[3]), pk2(a1[0], a1[1]), pk2(a1[2], a1[3])}; Pb[ks] = __builtin_bit_cast(bf16x8, pk); }
#pragma unroll
                    for (int nt = 0; nt < 4; ++nt) { OT[qb][nt] = OT[qb][nt] * alpha;
#pragma unroll
                        for (int ks = 0; ks < 2; ++ks) OT[qb][nt] = __builtin_amdgcn_mfma_f32_16x16x32_bf16(Vf[nt][ks], Pb[ks], OT[qb][nt], 0, 0, 0); }
                }
                if (ti + 1 < ntile) AT_WRITE((ti + 1) & 1);
                __syncthreads();
            }
#undef AT_KROW
#undef AT_LOAD
#undef AT_WRITE
#pragma unroll
            for (int qb = 0; qb < 4; ++qb) {
                const float il = 1.f / lsum[qb];
                bf16_t* op = O + (size_t)(qrow0 + 16 * qb + fr) * D + hq * 64 + 4 * g;
#pragma unroll
                for (int nt = 0; nt < 4; ++nt) { const f32x4 v = OT[qb][nt] * il; u32x2 o; o.x = pk2(v[0], v[1]); o.y = pk2(v[2], v[3]); *(u32x2*)(op + 16 * nt) = o; }
            }
        }
    }
}

__device__ __forceinline__ void phase_postmix(const Ctx& c, int layer, bool route) {
    const float* Y = (const float*)(c.ws + WS_RAW1); bf16_t* H = (bf16_t*)(c.ws + WS_H);
    float* Xout = (float*)(c.ws + (layer == 0 ? WS_X : WS_X1)); const float* Xprev = (const float*)(c.ws + WS_X);
    const float* ng = c.a->in[6] + layer * 4 * D; const float* Wr = c.a->in[15] + (size_t)layer * D * NE; const float* br = c.a->in[16] + layer * NE;
    unsigned* cnt = (unsigned*)(c.ws + WS_CTL) + CW_CNT + layer * NE;
    int* tk_e = (int*)(c.ws + WS_TK); float* tk_g = (float*)(c.ws + WS_TK) + R * 4; int* tk_slot = (int*)(c.ws + WS_TK) + 2 * R * 4;
    int* list = (int*)(c.ws + WS_LIST);
    LAS float* WL = (LAS float*)c.lds;
    LAS float* biasp = (LAS float*)(c.lds + 131072);
    LAS unsigned* lcnt = (LAS unsigned*)(c.lds + 145920); LAS unsigned* lbase = lcnt + 32;
    LAS float* pvA = (LAS float*)(c.lds + 131072 + 2560); LAS float* pvB = pvA + 1024; LAS float* pvS = pvB + 1024;
    const int lane = c.lane, w = __builtin_amdgcn_readfirstlane(c.tid >> 6), fr = lane & 15, g = lane >> 4;
    const int g_lo = layer == 0 ? 0 : C / 128;
    for (int grp = g_lo + c.wg; grp < R / 128; grp += c.nwg) {
        const int which = grp * 128 < C ? 1 : 0;
        const float* m = c.modp(layer, which);
        __syncthreads();
        if (c.tid < NE) lcnt[c.tid] = 0u;
#pragma unroll 4
        for (int j = 0; j < 16; ++j) {
            const int i4 = c.tid + 512 * j, k = i4 >> 3, e0 = (i4 & 7) * 4;
            const f32x4 wv = *(const f32x4*)(Wr + (size_t)k * NE + e0); const float sc = ng[2 * D + k] * (1.f + m[4096 + k]);
            LAS float* dst = WL + ((((k >> 4) * 4 + (k & 3)) * 4 + ((k >> 2) & 3)) * 16) * 2;
#pragma unroll
            for (int q = 0; q < 4; ++q) { const int e = e0 + q; dst[(e & 15) * 2 + (e >> 4)] = wv[q] * sc; }
        }
        for (int k = c.tid; k < D; k += 512) { pvA[k] = m[2048 + k] * ng[D + k]; pvB[k] = ng[2 * D + k] * (1.f + m[4096 + k]); pvS[k] = m[3072 + k]; }
        { const int e = c.tid & 31, part = c.tid >> 5; float sacc = 0.f;
#pragma unroll 16
          for (int k = part * 64; k < part * 64 + 64; ++k) sacc += m[3072 + k] * Wr[k * NE + e];
          biasp[32 + part * 32 + e] = sacc; }
        __syncthreads();
        if (c.tid < 32) { float sacc = br[c.tid];
#pragma unroll
            for (int p = 0; p < 16; ++p) sacc += biasp[32 + p * 32 + c.tid]; biasp[c.tid] = sacc; }
        __syncthreads();
        const int row0 = grp * 128 + w * 16;
        float rs_keep = 0.f;
        f32x4 yn[4], xn[4];
        row_load(Y + (size_t)(layer == 0 ? row0 : row0 - C) * D, lane, yn); row_load(layer == 0 ? c.xin0(row0) : Xprev + (size_t)row0 * D, lane, xn);
        for (int i = 0; i < 16; ++i) {
            const int r = row0 + i;
            f32x4 y[4], x[4];
#pragma unroll
            for (int j = 0; j < 4; ++j) { y[j] = yn[j]; x[j] = xn[j]; }
            if (i + 1 < 16) { row_load(Y + (size_t)(layer == 0 ? r + 1 : r + 1 - C) * D, lane, yn); row_load(layer == 0 ? c.xin0(r + 1) : Xprev + (size_t)(r + 1) * D, lane, xn); }
            const float rstd_y = rsqrtf(row_ss(y) * (1.f / D) + EPS);
#pragma unroll
            for (int j = 0; j < 4; ++j) {
                const int c0 = lane * 4 + 256 * j;
                x[j] += *(const LAS f32x4*)(pvA + c0) * (y[j] * rstd_y);
                *(f32x4*)(Xout + (size_t)r * D + c0) = x[j];
            }
            const float rstd_x = rsqrtf(row_ss(x) * (1.f / D) + EPS);
#pragma unroll
            for (int j = 0; j < 4; ++j) {
                const int c0 = lane * 4 + 256 * j;
                const f32x4 hv = x[j] * rstd_x * *(const LAS f32x4*)(pvB + c0) + *(const LAS f32x4*)(pvS + c0);
                u32x2 o; o.x = pk2(hv[0], hv[1]); o.y = pk2(hv[2], hv[3]);
                *(u32x2*)(H + (size_t)r * D + c0) = o;
            }
            if (lane == i) rs_keep = rstd_x;
        }
        asm volatile("s_waitcnt vmcnt(0)" ::: "memory");
        f32x4 la[2]; la[0] = (f32x4){0.f, 0.f, 0.f, 0.f}; la[1] = la[0];
        {
            const float* ap = Xout + (size_t)(row0 + fr) * D + 4 * g;
            const LAS float* bp = WL + (g * 16 + fr) * 2;
#pragma unroll 4
            for (int k4 = 0; k4 < 64; ++k4) {
                const f32x4 a4 = *(const f32x4*)(ap + 16 * k4);
#pragma unroll
                for (int q = 0; q < 4; ++q) {
                    const f32x2 b2 = *(const LAS f32x2*)(bp + (size_t)(4 * k4 + q) * 128);
                    la[0] = __builtin_amdgcn_mfma_f32_16x16x4f32(a4[q], b2[0], la[0], 0, 0, 0);
                    la[1] = __builtin_amdgcn_mfma_f32_16x16x4f32(a4[q], b2[1], la[1], 0, 0, 0);
                }
            }
        }
        float tv[4][4]; int te[4][4];
#pragma unroll
        for (int e = 0; e < 4; ++e) {
            const float rs = __shfl(rs_keep, 4 * g + e);
            float v0 = la[0][e] * rs + biasp[fr], v1 = la[1][e] * rs + biasp[16 + fr];
#pragma unroll
            for (int k = 0; k < 4; ++k) {
                float bv; int bi;
                if (v0 >= v1) { bv = v0; bi = fr; } else { bv = v1; bi = 16 + fr; }
#pragma unroll
                for (int o = 8; o > 0; o >>= 1) {
                    const float ov = __shfl_xor(bv, o); const int oi = __shfl_xor(bi, o);
                    if (ov > bv || (ov == bv && oi < bi)) { bv = ov; bi = oi; }
                }
                tv[e][k] = bv; te[e][k] = bi;
                if (bi == fr) v0 = -INFINITY;
                if (bi == 16 + fr) v1 = -INFINITY;
            }
        }
        float v[4]; int ex[4]; unsigned sl[4];
#pragma unroll
        for (int k = 0; k < 4; ++k) { v[k] = tv[0][k]; ex[k] = te[0][k];
#pragma unroll
            for (int e = 1; e < 4; ++e) if (fr == e) { v[k] = tv[e][k]; ex[k] = te[e][k]; } }
        if (fr < 4 && route) {
#pragma unroll
            for (int k = 0; k < 4; ++k) sl[k] = __hip_atomic_fetch_add(lcnt + ex[k], 1u, __ATOMIC_RELAXED, __HIP_MEMORY_SCOPE_WORKGROUP);
        }
        __syncthreads();
        if (c.tid < NE && route) { const unsigned n = lcnt[c.tid]; lbase[c.tid] = n ? atomicAdd(&cnt[c.tid], n) : 0u; }
        __syncthreads();
        if (fr < 4 && route) {
            const int r = row0 + 4 * g + fr;
            const float e1 = __expf(v[1] - v[0]), e2 = __expf(v[2] - v[0]), e3 = __expf(v[3] - v[0]);
            const float inv = 1.f / (1.f + e1 + e2 + e3);
            const float gk[4] = {inv, e1 * inv, e2 * inv, e3 * inv};
#pragma unroll
            for (int k = 0; k < 4; ++k) {
                const unsigned slot = lbase[ex[k]] + sl[k];
                list[(size_t)ex[k] * R + slot] = r;
                tk_e[r * 4 + k] = ex[k]; tk_g[r * 4 + k] = gk[k]; tk_slot[r * 4 + k] = (int)slot;
            }
        }
    }
}

__device__ __forceinline__ void moe_offsets(const Ctx& c, int layer, LAS int* so) {
    const unsigned* cnt = (const unsigned*)(c.ws + WS_CTL) + CW_CNT + layer * NE;
    __syncthreads();
    if (c.tid < 64) {
        const int n = c.tid < NE ? (int)cnt[c.tid] : 0; int pad = (n + PADM - 1) / PADM * PADM, inc = pad;
#pragma unroll
        for (int o = 1; o < 32; o <<= 1) { const int t = __shfl_up(inc, o); if (c.lane >= o) inc += t; }
        if (c.tid < NE) { so[c.tid] = inc - pad; so[64 + c.tid] = n; }
        if (c.tid == NE - 1) so[32] = inc;
    }
    __syncthreads();
}

__device__ __forceinline__ void moe_tables(const Ctx& c, int layer, LAS int* tb) {
    const unsigned* cnt = (const unsigned*)(c.ws + WS_CTL) + CW_CNT + layer * NE;
    __syncthreads();
    if (c.tid < 64) {
        const int n = c.tid < NE ? (int)cnt[c.tid] : 0; int tiles = (n + PADM - 1) / PADM, inc = tiles;
#pragma unroll
        for (int o = 1; o < 32; o <<= 1) { const int t = __shfl_up(inc, o); if (c.lane >= o) inc += t; }
        if (c.tid < NE) { tb[c.tid] = inc - tiles; tb[64 + c.tid] = n; }
        if (c.tid == NE - 1) tb[32] = inc;
    }
    __syncthreads();
}
__device__ __forceinline__ int vcu_of(const Ctx& c) { return (c.nwg % 8 == 0) ? (c.wg % 8) * (c.nwg / 8) + c.wg / 8 : c.wg; }
__device__ __forceinline__ void phase_moe_gu(const Ctx& c, int layer) {
    LAS int* tb = (LAS int*)(c.lds + 131072 + 1024);
    moe_tables(c, layer, tb);
    pg8::Gemm g{(const bf16_t*)(c.ws + WS_H), (const bf16_t*)(c.ws + WS_WGU) + (size_t)layer * NE * 2048 * 1024, (size_t)2048 * 1024, (const int*)(c.ws + WS_LIST)};
    pg8::MoeOrder S{tb, tb + 64, 8, c.nwg, vcu_of(c)};
    pg8::EpiSwiglu E{(bf16_t*)(c.ws + WS_HDN), c.a->in[18] + (size_t)layer * NE * 2048};
    pg8::gemm_phase<pg8::EpiSwiglu, pg8::MoeOrder, true, true>(c.lds, g, S, E, c.tid);
}
__device__ __forceinline__ void phase_moe_dn(const Ctx& c, int layer) {
    LAS int* tb = (LAS int*)(c.lds + 131072 + 1024);
    moe_tables(c, layer, tb);
    pg8::Gemm g{(const bf16_t*)(c.ws + WS_HDN), (const bf16_t*)(c.ws + WS_WDN) + (size_t)layer * NE * 1024 * 1024, (size_t)1024 * 1024, nullptr};
    pg8::MoeOrder S{tb, tb + 64, 4, c.nwg, vcu_of(c)};
    pg8::EpiBf16Bias E{(bf16_t*)(c.ws + WS_OUTB), c.a->in[20] + (size_t)layer * NE * 1024, 1024};
    pg8::gemm_phase<pg8::EpiBf16Bias, pg8::MoeOrder, true, false>(c.lds, g, S, E, c.tid);
}
__device__ __forceinline__ void phase_gemm_f32(const Ctx& c, const bf16_t* A, int M, const bf16_t* Bt, int N, const float* bias, float* Cout) {
    pg8::Gemm g{A, Bt, 0, nullptr}; pg8::StaticOrder S; S.init(M, N, c.nwg, c.wg);
    pg8::EpiF32 E{Cout, N, bias};
    pg8::gemm_phase<pg8::EpiF32, pg8::StaticOrder, true, false>(c.lds, g, S, E, c.tid);
}

__device__ __forceinline__ void phase_gemm_qkv(const Ctx& c) {
    pg8::Gemm g{(const bf16_t*)(c.ws + WS_H), (const bf16_t*)(c.ws + WS_WQKV), 0, nullptr}; pg8::StaticOrder S; S.init(R, QKVD, c.nwg, c.wg);
    pg8::EpiQKV E{(bf16_t*)(c.ws + WS_Q), (bf16_t*)(c.ws + WS_K), (bf16_t*)(c.ws + WS_V), c.a->in[8], (const float*)(c.ws + WS_MOD) + MOD_ROPE};
    pg8::gemm_phase<pg8::EpiQKV, pg8::StaticOrder, true, false>(c.lds, g, S, E, c.tid);
}
__device__ __forceinline__ void phase_gemm_inproj(const Ctx& c) {
    pg8::Gemm g{(const bf16_t*)(c.ws + WS_H), (const bf16_t*)(c.ws + WS_WIN), 0, nullptr}; pg8::StaticOrder S; S.init(R, HIN, c.nwg, c.wg);
    pg8::EpiInProj E{(bf16_t*)(c.ws + WS_QH), (_Float16*)(c.ws + WS_KF), (_Float16*)(c.ws + WS_KB), (bf16_t*)(c.ws + WS_IV), (bf16_t*)(c.ws + WS_SG), (const float*)(c.ws + WS_MOD) + MOD_LB};
    pg8::gemm_phase<pg8::EpiInProj, pg8::StaticOrder, true, false>(c.lds, g, S, E, c.tid);
}

__device__ __forceinline__ void phase_norm0(const Ctx& c);
__device__ __forceinline__ TBlk convert_item(const Ctx& c, int it) {
    constexpr int I_QKV = 20 * 16, I_O = 16 * 16, I_IN = 80 * 16, I_HO = 16 * 16, I_GU = 64 * 32 * 16;
    int r = it; TBlk t;
    if (r < I_QKV) { const int nb = r % 20, kb = r / 20; t.src = c.a->in[7] + (size_t)kb * 64 * QKVD + nb * 64; t.ldw = QKVD; t.dst = (bf16_t*)(c.ws + WS_WQKV) + (size_t)nb * 64 * 1024 + kb * 64; return t; } r -= I_QKV;
    if (r < I_O) { const int nb = r % 16, kb = r / 16; t.src = c.a->in[10] + (size_t)kb * 64 * D + nb * 64; t.ldw = D; t.dst = (bf16_t*)(c.ws + WS_WO) + (size_t)nb * 64 * 1024 + kb * 64; return t; } r -= I_O;
    if (r < I_IN) { const int nb = r % 80, kb = r / 80; t.src = c.a->in[11] + (size_t)kb * 64 * HIN + nb * 64; t.ldw = HIN; t.dst = (bf16_t*)(c.ws + WS_WIN) + (size_t)nb * 64 * 1024 + kb * 64; return t; } r -= I_IN;
    if (r < I_HO) { const int nb = r % 16, kb = r / 16; t.src = c.a->in[14] + (size_t)kb * 64 * D + nb * 64; t.ldw = D; t.dst = (bf16_t*)(c.ws + WS_WHO) + (size_t)nb * 64 * 1024 + kb * 64; return t; } r -= I_HO;
    if (r < I_GU) { const int mat = r / 512, rr = r % 512, nb = rr % 32, kb = rr / 32; const int n0 = ((nb & 3) >> 1) * 1024 + (nb >> 2) * 128 + (nb & 1) * 64;
        t.src = c.a->in[17] + (size_t)mat * 1024 * 2048 + (size_t)kb * 64 * 2048 + n0; t.ldw = 2048; t.dst = (bf16_t*)(c.ws + WS_WGU) + ((size_t)mat * 2048 + nb * 64) * 1024 + kb * 64; return t; } r -= I_GU;
    { const int mat = r / 256, rr = r % 256, nb = rr % 16, kb = rr / 16;
        t.src = c.a->in[19] + (size_t)mat * 1024 * 1024 + (size_t)kb * 64 * 1024 + nb * 64; t.ldw = 1024; t.dst = (bf16_t*)(c.ws + WS_WDN) + ((size_t)mat * 1024 + nb * 64) * 1024 + kb * 64; }
    return t;
}
__device__ __forceinline__ void phase_convert(const Ctx& c) {
    LAS float* scr = (LAS float*)c.lds + c.wave * (64 * 65);
    const int gw = c.wg * 8 + c.wave, NGW = c.nwg * 8;
    constexpr int TOT = 20 * 16 + 16 * 16 + 80 * 16 + 16 * 16 + 64 * 32 * 16 + 64 * 16 * 16;
    f32x4 va[16], vb[16];
    int it = gw;
    TBlk ta, tbk;
    if (it < TOT) { ta = convert_item(c, it); tb_load(ta, c.lane, va); }
    for (; it < TOT; it += 2 * NGW) {
        const bool hb = it + NGW < TOT;
        if (hb) { tbk = convert_item(c, it + NGW); tb_load(tbk, c.lane, vb); }
        tb_store(ta, c.lane, va, scr);
        const bool ha = it + 2 * NGW < TOT;
        if (ha) { ta = convert_item(c, it + 2 * NGW); tb_load(ta, c.lane, va); }
        if (hb) tb_store(tbk, c.lane, vb, scr);
    }
    __syncthreads();
    phase_norm0(c);
}

__device__ __forceinline__ void phase_combine(const Ctx& c, int layer) {
    LAS int* so = (LAS int*)(c.lds + 32768);
    moe_offsets(c, layer, so);
    const bf16_t* outb = (const bf16_t*)(c.ws + WS_OUTB); float* X = (float*)(c.ws + WS_X); bf16_t* H = (bf16_t*)(c.ws + WS_H);
    const float* Xin = layer == 0 ? X : (const float*)(c.ws + WS_X1);
    const float* ngl = c.a->in[6] + layer * 4 * D;
    const int* tk_e = (const int*)(c.ws + WS_TK); const float* tk_g = (const float*)(c.ws + WS_TK) + R * 4; const int* tk_slot = (const int*)(c.ws + WS_TK) + 2 * R * 4;
    const int r_lo = layer == 0 ? 0 : C, stride = c.nwg * 8;
    int r = r_lo + c.wg * 8 + c.wave;
    int pe[4], ps[4]; float pg[4]; u32x2 wn[4][4]; f32x4 xn[4]; float gn[4];
#define CB_TK(row) do { _Pragma("unroll") for (int k = 0; k < 4; ++k) { pe[k] = tk_e[(row) * 4 + k]; ps[k] = tk_slot[(row) * 4 + k]; pg[k] = tk_g[(row) * 4 + k]; } } while (0)
#define CB_DATA(row) do { _Pragma("unroll") for (int k = 0; k < 4; ++k) { const bf16_t* src_ = outb + (size_t)(so[pe[k]] + ps[k]) * 1024; gn[k] = pg[k]; \
        _Pragma("unroll") for (int j = 0; j < 4; ++j) wn[k][j] = *(const u32x2*)(src_ + c.lane * 4 + 256 * j); } row_load(Xin + (size_t)(row) * D, c.lane, xn); } while (0)
    if (r < R) { CB_TK(r); CB_DATA(r); }
    if (r + stride < R) CB_TK(r + stride);
    for (; r < R; r += stride) {
        const float* m = c.modp(layer, r < C ? 1 : 0);
        f32x4 y[4], x[4];
#pragma unroll
        for (int j = 0; j < 4; ++j) { y[j] = (f32x4){0.f, 0.f, 0.f, 0.f}; x[j] = xn[j]; }
#pragma unroll
        for (int k = 0; k < 4; ++k)
#pragma unroll
            for (int j = 0; j < 4; ++j) { const u32x2 w = wn[k][j]; y[j] += (f32x4){bflo(w.x), bfhi(w.x), bflo(w.y), bfhi(w.y)} * gn[k]; }
        if (r + stride < R) CB_DATA(r + stride);
        if (r + 2 * stride < R) CB_TK(r + 2 * stride);
        const float rstd_y = rsqrtf(row_ss(y) * (1.f / D) + EPS);
#pragma unroll
        for (int j = 0; j < 4; ++j) {
            const int c0 = c.lane * 4 + 256 * j;
            const f32x4 g2 = *(const f32x4*)(m + 5120 + c0), n3 = *(const f32x4*)(ngl + 3 * D + c0);
            x[j].x += g2.x * (y[j].x * rstd_y * n3.x); x[j].y += g2.y * (y[j].y * rstd_y * n3.y);
            x[j].z += g2.z * (y[j].z * rstd_y * n3.z); x[j].w += g2.w * (y[j].w * rstd_y * n3.w);
            if (layer == 0) *(f32x4*)(X + (size_t)r * D + c0) = x[j];
            else *(f32x4*)(c.a->out + (size_t)(r - C) * D + c0) = x[j];
        }
        if (layer == 0) {
            const float rstd_x = rsqrtf(row_ss(x) * (1.f / D) + EPS);
            const float* m1 = c.modp(1, r < C ? 1 : 0);
            row_modnorm_store(x, rstd_x, c.a->in[6] + 4 * D, m1 + 0, m1 + 1024, H + (size_t)r * D, c.lane);
        }
    }
#undef CB_TK
#undef CB_DATA
}

namespace hg {
typedef _Float16 h2_t __attribute__((ext_vector_type(2)));
constexpr int TB = 272, PB = 144;
constexpr int TILE = 64 * TB;
constexpr int T_QD = 0, T_QC = TILE, T_KD = 2 * TILE, T_KE = 3 * TILE, T_KC = 4 * TILE, T_V0 = 5 * TILE, T_V1 = 6 * TILE;
constexpr int T_QL1 = 7 * TILE, T_KL1 = T_QL1 + 16 * TB, T_P = T_KL1 + 16 * TB, T_TOT = T_P + 64 * PB, T_CT = T_TOT + 4096, T_END = T_CT + 512;
static_assert(T_END <= LDS_BYTES - 64, "hgrn scan LDS map");
__device__ __forceinline__ int row_of(int dir, int p) { return p < C ? (dir ? C - 1 - p : p) : (dir ? C + (L - 1 - (p - C)) : p); }
__device__ __forceinline__ int seg_of(int ch) { return ch < 68 ? ch / 17 : 4 + (ch - 68) / 16; }
__device__ __forceinline__ bf16x8 tr_frag(const LAS unsigned char* tile, int row0, int col0, int lane) {
    const int q = (lane & 15) >> 2, p = lane & 3;
    const LAS unsigned char* a = tile + (row0 + q) * TB + (col0 + 4 * p) * 2;
    const v4i16_t lo = __builtin_amdgcn_ds_read_tr16_b64_v4i16((LAS v4i16_t*)a);
    const v4i16_t hi = __builtin_amdgcn_ds_read_tr16_b64_v4i16((LAS v4i16_t*)(a + 4 * TB));
    return (bf16x8){lo[0], lo[1], lo[2], lo[3], hi[0], hi[1], hi[2], hi[3]};
}
}

__device__ __forceinline__ void phase_hgrn_scan(const Ctx& c) {
    using namespace hg;
#define HG_BAR() asm volatile("s_waitcnt lgkmcnt(0)\n\ts_barrier" ::: "memory")
    const bf16_t* QH = (const bf16_t*)(c.ws + WS_QH); const bf16_t* IV = (const bf16_t*)(c.ws + WS_IV);
    LAS unsigned char* lds = c.lds;
    const int tid = c.tid, lane = c.lane, w = __builtin_amdgcn_readfirstlane(tid >> 6), fr = lane & 15, g = lane >> 4;
    for (int item_ = c.wg; item_ < 256 * SCAN_REP; item_ += c.nwg) {
        const int item = item_ & 255;
        const int chain = item >> 4, seg = item & 15, head = chain >> 1, dir = chain & 1, hc = head * 128;
        const int c0 = seg < 4 ? 17 * seg : 68 + 16 * (seg - 4), nch = seg < 4 ? 17 : 16;
        const _Float16* KX = (const _Float16*)(c.ws + (dir ? WS_KB : WS_KF));
        float* OL = (float*)(c.ws + (dir ? WS_OB : WS_OF)); bf16_t* QS = (bf16_t*)(c.ws + (dir ? WS_QSB : WS_QSF));
        HG_BAR();
        for (int i = tid; i < 64 * PB / 4; i += 512) ((LAS unsigned*)(lds + T_P))[i] = 0u;
        f32x4 Sacc[8];
#pragma unroll
        for (int m = 0; m < 8; ++m) Sacc[m] = (f32x4){0.f, 0.f, 0.f, 0.f};
        float dseg0 = 1.f, dseg1 = 1.f;
        unsigned kraw[8], qraw[8]; u32x4 vraw[2];
#define HG_LOAD(cidx) do { const int p0_ = 64 * (cidx); const bool lat_ = (cidx) >= 4; \
        _Pragma("unroll") for (int i = 0; i < 8; ++i) { const int r_ = row_of(dir, p0_ + 8 * w + i); \
            kraw[i] = *(const unsigned*)(KX + (size_t)r_ * D + hc + 2 * lane); \
            qraw[i] = lat_ ? *(const unsigned*)(QH + (size_t)(r_ - C) * D + hc + 2 * lane) : 0u; } \
        _Pragma("unroll") for (int i = 0; i < 2; ++i) { const int idx_ = tid + 512 * i; const int r_ = row_of(dir, p0_ + (idx_ >> 4)); \
            vraw[i] = *(const u32x4*)(IV + (size_t)r_ * D + hc + (idx_ & 15) * 8); } } while (0)
        HG_LOAD(c0);
        for (int ci = 0; ci < nch; ++ci) {
            const int cidx = c0 + ci; const bool lat = cidx >= 4;
            const int vbuf = (ci & 1) ? T_V1 : T_V0;
            float kf[8][2], qf[8][2], cp[8][2];
            {
                float p0 = 1.f, p1 = 1.f;
#pragma unroll
                for (int i = 0; i < 8; ++i) {
                    const h2_t hv = __builtin_bit_cast(h2_t, kraw[i]);
                    kf[i][0] = (float)hv[0]; kf[i][1] = (float)hv[1];
                    qf[i][0] = bflo(qraw[i]); qf[i][1] = bfhi(qraw[i]);
                    p0 *= (1.f - kf[i][0]); p1 *= (1.f - kf[i][1]); cp[i][0] = p0; cp[i][1] = p1;
                }
                *(LAS f32x2*)(lds + T_TOT + (w * 128 + 2 * lane) * 4) = (f32x2){p0, p1};
#pragma unroll
                for (int i = 0; i < 2; ++i) { const int idx = tid + 512 * i; *(LAS u32x4*)(lds + vbuf + (idx >> 4) * TB + (idx & 15) * 16) = vraw[i]; }
            }
            HG_BAR();
            {
                f32x2 T[8];
#pragma unroll
                for (int x = 0; x < 8; ++x) T[x] = *(const LAS f32x2*)(lds + T_TOT + (x * 128 + 2 * lane) * 4);
                const int I = w >> 1, hh = w & 1;
                f32x2 bd[4];
#pragma unroll
                for (int x = 0; x < 4; ++x) bd[x] = T[2 * x] * T[2 * x + 1];
                f32x2 pre = (f32x2){1.f, 1.f}, cum = (f32x2){1.f, 1.f}, suf = (f32x2){1.f, 1.f}, bdI = (f32x2){1.f, 1.f};
#pragma unroll
                for (int x = 0; x < 8; ++x) if (hh && x == w - 1) pre = T[x];
#pragma unroll
                for (int x = 0; x < 4; ++x) { if (x < I) cum = cum * bd[x]; if (x > I) suf = suf * bd[x]; if (x == I) bdI = bd[x]; }
                const f32x2 ctot = (bd[0] * bd[1]) * (bd[2] * bd[3]);
#pragma unroll
                for (int i = 0; i < 8; ++i) {
                    const int tau = 8 * w + i;
                    float QDv[2], KDv[2], KEv[2], QCv[2], KCv[2];
#pragma unroll
                    for (int x = 0; x < 2; ++x) {
                        const float eq = pre[x] * cp[i][x], rc = __builtin_amdgcn_rcpf(eq);
                        QDv[x] = qf[i][x] * eq; KDv[x] = kf[i][x] * rc; KEv[x] = KDv[x] * bdI[x]; QCv[x] = QDv[x] * cum[x]; KCv[x] = KEv[x] * suf[x];
                    }
                    const int to = tau * TB + lane * 4;
                    *(LAS unsigned*)(lds + T_QD + to) = pk2(QDv[0], QDv[1]);
                    *(LAS unsigned*)(lds + T_KD + to) = pk2(KDv[0], KDv[1]);
                    *(LAS unsigned*)(lds + T_KE + to) = pk2(KEv[0], KEv[1]);
                    *(LAS unsigned*)(lds + T_QC + to) = pk2(QCv[0], QCv[1]);
                    *(LAS unsigned*)(lds + T_KC + to) = pk2(KCv[0], KCv[1]);
                    if (I == 3) *(LAS unsigned*)(lds + T_QL1 + (tau - 48) * TB + lane * 4) = pk2(QDv[0] * bd[2][0], QDv[1] * bd[2][1]);
                    if (I == 0) *(LAS unsigned*)(lds + T_KL1 + tau * TB + lane * 4) = pk2(KEv[0] * bd[1][0], KEv[1] * bd[1][1]);
                    if (lat) { const int r = row_of(dir, 64 * cidx + tau); *(unsigned*)(QS + (size_t)(r - C) * D + hc + 2 * lane) = pk2(QCv[0] * dseg0, QCv[1] * dseg1); }
                }
                dseg0 *= ctot[0]; dseg1 *= ctot[1];
                if (w == 0) *(LAS f32x2*)(lds + T_CT + lane * 8) = ctot;
            }
            HG_BAR();
            if (ci + 1 < nch) HG_LOAD(cidx + 1);
            if (lat) {
                const int nblk = w >= 6 ? 2 : 1;
                for (int b = 0; b < nblk; ++b) {
                    int I, J, qoff, qrow, koff, krow; bool diag = false;
                    if (w < 4) { I = 2 + (w >> 1); J = w & 1; qoff = (w >> 1) ? T_QL1 : T_QD; qrow = (w >> 1) ? 0 : 32; koff = (w & 1) ? T_KE : T_KL1; krow = (w & 1) ? 16 : 0; }
                    else if (w == 4) { I = 1; J = 0; qoff = T_QD; qrow = 16; koff = T_KE; krow = 0; }
                    else if (w == 5) { I = 3; J = 2; qoff = T_QD; qrow = 48; koff = T_KE; krow = 32; }
                    else { I = 2 * (w - 6) + b; J = I; qoff = T_QD; qrow = 16 * I; koff = T_KD; krow = 16 * I; diag = true; }
                    f32x4 pa = (f32x4){0.f, 0.f, 0.f, 0.f};
#pragma unroll
                    for (int ks = 0; ks < 4; ++ks) {
                        const bf16x8 av = *(const LAS bf16x8*)(lds + qoff + (qrow + fr) * TB + (32 * ks + 8 * g) * 2);
                        const bf16x8 bv = *(const LAS bf16x8*)(lds + koff + (krow + fr) * TB + (32 * ks + 8 * g) * 2);
                        pa = __builtin_amdgcn_mfma_f32_16x16x32_bf16(av, bv, pa, 0, 0, 0);
                    }
#pragma unroll
                    for (int e = 0; e < 4; ++e) {
                        const int tl = 4 * g + e; const float val = (diag && fr > tl) ? 0.f : pa[e];
                        *(LAS bf16_t*)(lds + T_P + (16 * I + tl) * PB + (16 * J + fr) * 2) = (bf16_t)f2bf(val);
                    }
                }
            }
            f32x4 oacc[4];
#pragma unroll
            for (int m = 0; m < 4; ++m) oacc[m] = (f32x4){0.f, 0.f, 0.f, 0.f};
            if (lat) {
                bf16x8 Sb[4];
#pragma unroll
                for (int ks = 0; ks < 4; ++ks) {
                    const f32x4 a0 = Sacc[2 * ks], a1 = Sacc[2 * ks + 1];
                    const u32x4 pk = (u32x4){pk2(a0[0], a0[1]), pk2(a0[2], a0[3]), pk2(a1[0], a1[1]), pk2(a1[2], a1[3])};
                    Sb[ks] = __builtin_bit_cast(bf16x8, pk);
                }
#pragma unroll
                for (int m = 0; m < 4; ++m)
#pragma unroll
                    for (int ks = 0; ks < 4; ++ks) {
                        const u32x2 lo = *(const LAS u32x2*)(lds + T_QC + (16 * m + fr) * TB + (32 * ks + 4 * g) * 2);
                        const u32x2 hi = *(const LAS u32x2*)(lds + T_QC + (16 * m + fr) * TB + (32 * ks + 16 + 4 * g) * 2);
                        const u32x4 pk = (u32x4){lo.x, lo.y, hi.x, hi.y};
                        oacc[m] = __builtin_amdgcn_mfma_f32_16x16x32_bf16(__builtin_bit_cast(bf16x8, pk), Sb[ks], oacc[m], 0, 0, 0);
                    }
            }
#pragma unroll
            for (int m = 0; m < 8; ++m) { const f32x4 ct = *(const LAS f32x4*)(lds + T_CT + (16 * m + 4 * g) * 4); Sacc[m] = Sacc[m] * ct; }
            bf16x8 Vf[2];
#pragma unroll
            for (int ks = 0; ks < 2; ++ks) Vf[ks] = tr_frag(lds + vbuf, 32 * ks + 8 * g, 16 * w, lane);
#pragma unroll
            for (int m = 0; m < 8; ++m)
#pragma unroll
                for (int ks = 0; ks < 2; ++ks) Sacc[m] = __builtin_amdgcn_mfma_f32_16x16x32_bf16(tr_frag(lds + T_KC, 32 * ks + 8 * g, 16 * m, lane), Vf[ks], Sacc[m], 0, 0, 0);
            HG_BAR();
            if (lat) {
#pragma unroll
                for (int m = 0; m < 4; ++m)
#pragma unroll
                    for (int ks = 0; ks < 2; ++ks) {
                        if (m < 2 && ks == 1) continue;
                        const bf16x8 av = *(const LAS bf16x8*)(lds + T_P + (16 * m + fr) * PB + (32 * ks + 8 * g) * 2);
                        oacc[m] = __builtin_amdgcn_mfma_f32_16x16x32_bf16(av, Vf[ks], oacc[m], 0, 0, 0);
                    }
#pragma unroll
                for (int m = 0; m < 4; ++m)
#pragma unroll
                    for (int e = 0; e < 4; ++e) { const int r = row_of(dir, 64 * cidx + 16 * m + 4 * g + e); OL[(size_t)(r - C) * D + hc + 16 * w + fr] = oacc[m][e]; }
            }
        }
#undef HG_LOAD
        float* DS = (float*)(c.ws + WS_DS) + (size_t)item * 16384; float* DG = (float*)(c.ws + WS_DG) + item * 128;
#pragma unroll
        for (int m = 0; m < 8; ++m)
#pragma unroll
            for (int e = 0; e < 4; ++e) DS[(16 * m + 4 * g + e) * 128 + 16 * w + fr] = Sacc[m][e];
        if (w == 0) { DG[2 * lane] = dseg0; DG[2 * lane + 1] = dseg1; }
    }
}

#undef HG_BAR
__device__ __forceinline__ void phase_hgrn_fold(const Ctx& c) {
    const float* DS = (const float*)(c.ws + WS_DS); const float* DG = (const float*)(c.ws + WS_DG); bf16_t* SST = (bf16_t*)(c.ws + WS_SST);
    for (int item = c.wg; item < 256; item += c.nwg) {
        const int chain = item >> 4, slice = item & 15, d = 8 * slice + (c.tid >> 6), v2 = (c.tid & 63) * 2;
        float s0 = 0.f, s1 = 0.f;
        float dv[15]; f32x2 ds[15];
#pragma unroll
        for (int sgi = 0; sgi < 15; ++sgi) { dv[sgi] = DG[(chain * 16 + sgi) * 128 + d]; ds[sgi] = *(const f32x2*)(DS + ((size_t)(chain * 16 + sgi) * 128 + d) * 128 + v2); }
        SST[((size_t)(chain * 16) * 128 + v2) * 128 + d] = 0; SST[((size_t)(chain * 16) * 128 + v2 + 1) * 128 + d] = 0;
#pragma unroll
        for (int sgi = 0; sgi < 15; ++sgi) {
            s0 = dv[sgi] * s0 + ds[sgi][0]; s1 = dv[sgi] * s1 + ds[sgi][1];
            SST[((size_t)(chain * 16 + sgi + 1) * 128 + v2) * 128 + d] = (bf16_t)f2bf(s0); SST[((size_t)(chain * 16 + sgi + 1) * 128 + v2 + 1) * 128 + d] = (bf16_t)f2bf(s1);
        }
    }
}

__device__ __forceinline__ void phase_hgrn_readout(const Ctx& c) {
    constexpr int SP = 272, SBUF = 128 * SP, IBUF = 2 * SBUF;
    static_assert(2 * IBUF + 1024 <= LDS_BYTES - 64, "readout LDS map");
    const float* OF = (const float*)(c.ws + WS_OF); const float* OB = (const float*)(c.ws + WS_OB); const bf16_t* SGp = (const bf16_t*)(c.ws + WS_SG);
    const bf16_t* SST = (const bf16_t*)(c.ws + WS_SST); bf16_t* RR = (bf16_t*)(c.ws + WS_RR); const float* hng = c.a->in[13];
    LAS unsigned char* lds = c.lds; LAS float* ssx = (LAS float*)(c.lds + 2 * IBUF);
    const int tid = c.tid, lane = c.lane, w = __builtin_amdgcn_readfirstlane(tid >> 6), fr = lane & 15, g = lane >> 4, mt = w & 3, nh = w >> 2;
#define RO_BAR() asm volatile("s_waitcnt lgkmcnt(0)\n\ts_barrier" ::: "memory")
    u32x4 sreg[8];
#define RO_SST_LOAD(it) do { const int h_ = (it) >> 8, ch_ = (it) & 255; \
        _Pragma("unroll") for (int j = 0; j < 8; ++j) { const int idx_ = tid + 512 * j, dx_ = idx_ >> 11, rem_ = idx_ & 2047; \
            const int sg_ = hg::seg_of(dx_ ? 4 + 255 - ch_ : 4 + ch_); \
            sreg[j] = *(const u32x4*)(SST + ((size_t)((h_ * 2 + dx_) * 16 + sg_) * 128 + (rem_ >> 4)) * 128 + (rem_ & 15) * 8); } } while (0)
#define RO_SST_WRITE(buf) do { _Pragma("unroll") for (int j = 0; j < 8; ++j) { const int idx_ = tid + 512 * j, dx_ = idx_ >> 11, rem_ = idx_ & 2047; \
            *(LAS u32x4*)(lds + (buf) * IBUF + dx_ * SBUF + (rem_ >> 4) * SP + (rem_ & 15) * 16) = sreg[j]; } } while (0)
    int it = c.wg;
    RO_BAR();
    if (it < 2048) { RO_SST_LOAD(it); RO_SST_WRITE(0); }
    RO_BAR();
    for (int k = 0; it < 2048; it += c.nwg, ++k) {
        const int h = it >> 8, ch = it & 255, t0 = 64 * ch + 16 * mt, buf = k & 1;
        const bool has_next = it + c.nwg < 2048;
        if (has_next) RO_SST_LOAD(it + c.nwg);
        f32x4 acc[4]; float sgv[4][4];
#pragma unroll
        for (int n = 0; n < 4; ++n)
#pragma unroll
            for (int e = 0; e < 4; ++e) { const size_t o = (size_t)(t0 + 4 * g + e) * D + h * 128 + 64 * nh + 16 * n + fr; acc[n][e] = OF[o] + OB[o]; sgv[n][e] = bf2f(SGp[o]) * hng[h * 128 + 64 * nh + 16 * n + fr]; }
#pragma unroll
        for (int dx = 0; dx < 2; ++dx) {
            const bf16_t* QS = (const bf16_t*)(c.ws + (dx ? WS_QSB : WS_QSF)) + (size_t)(t0 + fr) * D + h * 128 + 8 * g;
            const LAS unsigned char* sb = lds + buf * IBUF + dx * SBUF + (64 * nh + fr) * SP + 16 * g;
#pragma unroll
            for (int ks = 0; ks < 4; ++ks) {
                const bf16x8 av = *(const bf16x8*)(QS + 32 * ks);
#pragma unroll
                for (int n = 0; n < 4; ++n) acc[n] = __builtin_amdgcn_mfma_f32_16x16x32_bf16(av, *(const LAS bf16x8*)(sb + (16 * n) * SP + 64 * ks), acc[n], 0, 0, 0);
            }
        }
        float ss[4] = {0.f, 0.f, 0.f, 0.f};
#pragma unroll
        for (int n = 0; n < 4; ++n)
#pragma unroll
            for (int e = 0; e < 4; ++e) ss[e] += acc[n][e] * acc[n][e];
#pragma unroll
        for (int e = 0; e < 4; ++e) {
#pragma unroll
            for (int sh = 8; sh > 0; sh >>= 1) ss[e] += __shfl_xor(ss[e], sh);
        }
        if (fr == 0) *(LAS f32x4*)(ssx + ((k & 1) * 8 + w) * 16 + 4 * g) = (f32x4){ss[0], ss[1], ss[2], ss[3]};
        if (has_next) RO_SST_WRITE(buf ^ 1);
        RO_BAR();
        const f32x4 ps = *(const LAS f32x4*)(ssx + ((k & 1) * 8 + (w ^ 4)) * 16 + 4 * g);
#pragma unroll
        for (int e = 0; e < 4; ++e) ss[e] = rsqrtf((ss[e] + ps[e]) * (1.f / 128.f) + EPS);
#pragma unroll
        for (int n = 0; n < 4; ++n)
#pragma unroll
            for (int e = 0; e < 4; ++e) { const size_t o = (size_t)(t0 + 4 * g + e) * D + h * 128 + 64 * nh + 16 * n + fr; RR[o] = (bf16_t)f2bf(acc[n][e] * ss[e] * sgv[n][e]); }
    }
    RO_BAR();
#undef RO_BAR
#undef RO_SST_LOAD
#undef RO_SST_WRITE
}

#define XB_TMO      128
#define XB_XCNT(j)  (256  + 64 * (j))
#define XB_XSUB(j)  (1280 + 64 * (j))
#define XB_XGEN(j)  (2304 + 64 * (j))
#define XB_TOP      3328
#define XB_TOPGEN   3392
#define XCD_BAR_WORDS 3456
#define XB_SPIN_CAP (1u << 18)
__device__ __forceinline__ unsigned xb_ld(unsigned* p)              { return __hip_atomic_load(p, __ATOMIC_RELAXED, __HIP_MEMORY_SCOPE_AGENT); }
__device__ __forceinline__ unsigned xb_add(unsigned* p, unsigned v) { return __hip_atomic_fetch_add(p, v, __ATOMIC_RELAXED, __HIP_MEMORY_SCOPE_AGENT); }
__device__ __forceinline__ unsigned xb_xcc_id() { return (unsigned)__builtin_amdgcn_s_getreg((3 << 11) | 20) & 0xFu; }
#define XB_SPIN(cond, bar) do { unsigned _sp = 0; while (cond) { __builtin_amdgcn_s_sleep(1); \
    if ((++_sp & 255u) == 0u) { if (xb_ld(&(bar)[XB_TMO])) break; if (_sp > XB_SPIN_CAP) { atomicAdd(&(bar)[XB_TMO], 1u); break; } } } } while (0)
struct XcdBarrier { unsigned* bar; unsigned x; volatile LAS unsigned* st; };
__device__ __forceinline__ XcdBarrier xcd_barrier_post(unsigned* bar, volatile LAS unsigned* st) {
    XcdBarrier b; b.bar = bar; b.x = xb_xcc_id(); b.st = st;
    if (threadIdx.x == 0) (void)xb_add(&bar[XB_XCNT(b.x)], 1u);
    return b;
}
__device__ __forceinline__ void xcd_barrier_complete(unsigned* bar, unsigned x, unsigned& nloc, unsigned& nx) {
    const unsigned G = gridDim.x * gridDim.y * gridDim.z;
    unsigned sum, cnt, mine, sp = 0u;
    for (;;) {
        sum = 0u; cnt = 0u; mine = 0u;
#pragma unroll
        for (unsigned j = 0; j < 16; ++j) { const unsigned c = xb_ld(&bar[XB_XCNT(j)]); sum += c; cnt += (c > 0u) ? 1u : 0u; mine = (j == x) ? c : mine; }
        if (sum == G) break;
        __builtin_amdgcn_s_sleep(1);
        if ((++sp & 255u) == 0u) { if (xb_ld(&bar[XB_TMO])) break; if (sp > XB_SPIN_CAP) { atomicAdd(&bar[XB_TMO], 1u); break; } }
    }
    nloc = mine > 0u ? mine : 1u; nx = cnt > 0u ? cnt : 1u;
}
__device__ __forceinline__ void xcd_barrier(const XcdBarrier& b) {
    asm volatile("s_waitcnt vmcnt(0)" ::: "memory");
    __syncthreads();
    if (threadIdx.x == 0) {
        unsigned* bar = b.bar;
        __builtin_amdgcn_s_waitcnt(0);
        unsigned nloc = b.st[0], nx = b.st[1];
        if (nloc == 0u) { xcd_barrier_complete(bar, b.x, nloc, nx); b.st[0] = nloc; b.st[1] = nx; }
        const unsigned old = xb_add(&bar[XB_XSUB(b.x)], 1u);
        const unsigned gen = old / nloc;
        if (old + 1u == (gen + 1u) * nloc) {
            __builtin_amdgcn_fence(__ATOMIC_RELEASE, "agent");
            asm volatile("s_waitcnt vmcnt(0)" ::: "memory");
            const unsigned og = xb_add(&bar[XB_TOP], 1u);
            const unsigned tg = og / nx;
            if (og + 1u == (tg + 1u) * nx) xb_add(&bar[XB_TOPGEN], 1u);
            else XB_SPIN(xb_ld(&bar[XB_TOPGEN]) == tg, bar);
            __builtin_amdgcn_fence(__ATOMIC_ACQUIRE, "agent");
            xb_add(&bar[XB_XGEN(b.x)], 1u);
            asm volatile("s_waitcnt vmcnt(0)" ::: "memory");
        } else {
            XB_SPIN(xb_ld(&bar[XB_XGEN(b.x)]) == gen, bar);
            __builtin_amdgcn_fence(__ATOMIC_ACQUIRE, "agent");
            asm volatile("s_waitcnt vmcnt(0)" ::: "memory");
        }
    }
    __syncthreads();
}

__device__ __forceinline__ void launder(Ctx& c) { asm volatile("" : "+s"(c.a)); asm volatile("" : "+s"(c.ws)); asm volatile("" : "+s"(c.wave));
    c.lane = (int)__builtin_amdgcn_mbcnt_hi(~0u, __builtin_amdgcn_mbcnt_lo(~0u, 0u)); c.tid = c.wave * 64 + c.lane; }
__global__ void __launch_bounds__(512, 2) mk_fwd(Args args) {
    extern __shared__ __attribute__((aligned(16))) unsigned char lds_raw[];
    Ctx c; c.a = (CArgs)__builtin_amdgcn_kernarg_segment_ptr(); c.lds = (LAS unsigned char*)lds_raw; c.tid = threadIdx.x; c.lane = c.tid & 63; c.wave = __builtin_amdgcn_readfirstlane(c.tid >> 6); c.nwg = gridDim.x; c.wg = blockIdx.x; c.ws = c.a->ws;
    volatile LAS unsigned* bst = (volatile LAS unsigned*)(c.lds + LDS_BYTES - 64);
    if (c.tid < 4) bst[c.tid] = 0u;
    __syncthreads();
    const XcdBarrier bar = xcd_barrier_post((unsigned*)(c.ws + WS_CTL) + CW_BAR, bst);
    const int lo = c.a->ph_lo, hi = c.a->ph_hi;
    bool route_ok = true;
#define SEAM(k) do { if (lo <= (k) && (k) + 1 < hi) xcd_barrier(bar); } while (0)
#define IN(k) (lo <= (k) && (k) < hi && (launder(c), true))
#define PH(k, call) do { if (IN(k)) { if (PROBE_PH == (k)) { int nrep_ = 3; asm volatile("" : "+s"(nrep_)); for (int rep_ = 0; rep_ < nrep_; ++rep_) { route_ok = (rep_ + 1 == nrep_); call; if (rep_ + 1 < nrep_) xcd_barrier(bar); } } else { call; } } SEAM(k); } while (0)
    PH(0, phase_prep(c));
    PH(1, phase_convert(c));
    PH(2, phase_gemm_qkv(c));
    PH(3, phase_attn(c));
    PH(4, phase_gemm_f32(c, (const bf16_t*)(c.ws + WS_O), R, (const bf16_t*)(c.ws + WS_WO), D, nullptr, (float*)(c.ws + WS_RAW1)));
    PH(5, phase_postmix(c, 0, route_ok));
    PH(6, phase_moe_gu(c, 0));
    PH(7, phase_moe_dn(c, 0));
    PH(8, phase_combine(c, 0));
    PH(9, phase_gemm_inproj(c));
    PH(10, phase_hgrn_scan(c));
    PH(11, phase_hgrn_fold(c));
    PH(12, phase_hgrn_readout(c));
    PH(13, phase_gemm_f32(c, (const bf16_t*)(c.ws + WS_RR), L, (const bf16_t*)(c.ws + WS_WHO), D, nullptr, (float*)(c.ws + WS_RAW1)));
    PH(14, phase_postmix(c, 1, route_ok));
    PH(15, phase_moe_gu(c, 1));
    PH(16, phase_moe_dn(c, 1));
    PH(17, phase_combine(c, 1));
#undef IN
#undef PH
#undef SEAM
}

extern "C" void kernel_launch(void* const* d_in, const int* in_sizes, int n_in, void* d_out, int out_size, void* d_ws, size_t ws_size, hipStream_t stream) {
    static int grid = 0;
    if (grid == 0) {
        if (n_in != 21 || out_size != L * D || ws_size < WS_END) { fprintf(stderr, "kernel_launch: unexpected problem (n_in %d out %d ws %zu need %zu)\n", n_in, out_size, ws_size, (size_t)WS_END); grid = -1; return; }
        int dev = 0, cus = 0, per_cu = 0;
        hipGetDevice(&dev); hipDeviceGetAttribute(&cus, hipDeviceAttributeMultiprocessorCount, dev);
        if (hipFuncSetAttribute((const void*)mk_fwd, hipFuncAttributeMaxDynamicSharedMemorySize, LDS_BYTES) != hipSuccess) { fprintf(stderr, "kernel_launch: hipFuncSetAttribute failed\n"); grid = -1; return; }
        hipOccupancyMaxActiveBlocksPerMultiprocessor(&per_cu, (const void*)mk_fwd, 512, LDS_BYTES);
        if (per_cu < 1) fprintf(stderr, "kernel_launch: occupancy query says %d\n", per_cu);
        (void)hipGetLastError();
        grid = cus > 0 ? cus : 256;
    }
    if (grid < 0) return;
    hipMemsetAsync((char*)d_ws + WS_CTL, 0, MiB, stream);
    Args a{};
    for (int i = 0; i < 21; ++i) a.in[i] = (const float*)d_in[i];
    a.out = (float*)d_out; a.ws = (unsigned char*)d_ws;
    a.ph_lo = 0; a.ph_hi = NPHASE;
    hipLaunchKernelGGL(mk_fwd, dim3(grid), dim3(512), LDS_BYTES, stream, a);
}
```

```cpp
#include <hip/hip_runtime.h>
#include <cstdint>
#include <cstdio>

#define LAS __attribute__((address_space(3)))
typedef unsigned short bf16_t;
typedef short bf16x8 __attribute__((ext_vector_type(8)));
typedef float f32x4 __attribute__((ext_vector_type(4)));
typedef unsigned u32x4 __attribute__((ext_vector_type(4)));
typedef unsigned u32x2 __attribute__((ext_vector_type(2)));
typedef short v4i16_t __attribute__((ext_vector_type(4)));
typedef float f32x2 __attribute__((ext_vector_type(2)));

constexpr int D = 1024, L = 16384, C = 256, R = L + C;
constexpr int QKVD = 1280, HIN = 5120, NE = 32, TOPK = 4;
constexpr int PADM = 256, MAXROWS = 74752;
constexpr float EPS = 1e-6f;
constexpr float LOG2E = 1.4426950408889634f;
constexpr int NPHASE = 18;
#ifndef SCAN_REP
#define SCAN_REP 1
#endif
#ifndef PROBE_PH
#define PROBE_PH (-1)
#endif
constexpr int LDS_BYTES = 147456;

constexpr size_t MiB = 1u << 20;
constexpr size_t al(size_t x) { return (x + MiB - 1) / MiB * MiB; }
constexpr size_t WS_CTL = 0;
constexpr size_t WS_MOD = WS_CTL + MiB;
constexpr size_t WS_X = WS_MOD + MiB;
constexpr size_t WS_H = WS_X + al((size_t)R * D * 4);
constexpr size_t WS_Q = WS_H + al((size_t)R * D * 2);
constexpr size_t WS_K = WS_Q + al((size_t)R * D * 2);
constexpr size_t WS_V = WS_K + al((size_t)R * 128 * 2);
constexpr size_t WS_O = WS_V + al((size_t)R * 128 * 2);
constexpr size_t WS_TK = WS_O + al((size_t)R * D * 2);
constexpr size_t WS_LIST = WS_TK + MiB;
constexpr size_t WS_HDN = WS_LIST + 3 * MiB;
constexpr size_t WS_RAW1 = WS_HDN + al((size_t)MAXROWS * 1024 * 2);
constexpr size_t WS_X1 = WS_RAW1 + al((size_t)R * D * 4);
constexpr size_t WS_OUTB = WS_X1 + al((size_t)R * D * 4);
constexpr size_t WS_QH = WS_OUTB + al((size_t)MAXROWS * 1024 * 2);
constexpr size_t WS_KF = WS_QH + al((size_t)L * D * 2);
constexpr size_t WS_KB = WS_KF + al((size_t)R * D * 2);
constexpr size_t WS_IV = WS_KB + al((size_t)R * D * 2);
constexpr size_t WS_SG = WS_IV + al((size_t)R * D * 2);
constexpr size_t WS_OF = WS_SG + al((size_t)L * D * 2);
constexpr size_t WS_OB = WS_OF + al((size_t)L * D * 4);
constexpr size_t WS_RR = WS_OB + al((size_t)L * D * 4);
constexpr size_t WS_WQKV = WS_RR + al((size_t)L * D * 2);
constexpr size_t WS_WO = WS_WQKV + al((size_t)QKVD * D * 2);
constexpr size_t WS_WIN = WS_WO + al((size_t)D * D * 2);
constexpr size_t WS_WHO = WS_WIN + al((size_t)HIN * D * 2);
constexpr size_t WS_WGU = WS_WHO + al((size_t)D * D * 2);
constexpr size_t WS_WDN = WS_WGU + al((size_t)2 * NE * 2048 * D * 2);
constexpr size_t WS_QSF = WS_WDN + al((size_t)2 * NE * 1024 * D * 2);
constexpr size_t WS_QSB = WS_QSF + al((size_t)L * D * 2);
constexpr size_t WS_DS = WS_QSB + al((size_t)L * D * 2);
constexpr size_t WS_DG = WS_DS + al((size_t)256 * 128 * 128 * 4);
constexpr size_t WS_SST = WS_DG + MiB;
constexpr size_t WS_H8 = WS_SST + al((size_t)256 * 128 * 128 * 2);
constexpr size_t WS_END = WS_H8 + al((size_t)R * D);
static_assert(WS_END <= (size_t)2048 * MiB, "workspace map exceeds 4x the largest input");
constexpr int CW_CNT = 1024;
constexpr int CW_BAR = 4096;
constexpr int MOD_ROPE = 32768;
constexpr int MOD_LB = 49152;

struct Args { const float* in[21]; float* out; unsigned char* ws; int ph_lo, ph_hi; };

__device__ __forceinline__ unsigned f2bf(float f) { unsigned u = __float_as_uint(f); return (u + 0x7fffu + ((u >> 16) & 1u)) >> 16; }
typedef float f32x2_t __attribute__((ext_vector_type(2))); typedef __bf16 bf16x2_t __attribute__((ext_vector_type(2)));
__device__ __forceinline__ unsigned pk2(float lo, float hi) { f32x2_t v = {lo, hi}; bf16x2_t b = __builtin_convertvector(v, bf16x2_t); return __builtin_bit_cast(unsigned, b); }
__device__ __forceinline__ unsigned pk4_fp8(float a, float b, float c, float d) {
    a = fminf(fmaxf(a, -448.f), 448.f); b = fminf(fmaxf(b, -448.f), 448.f); c = fminf(fmaxf(c, -448.f), 448.f); d = fminf(fmaxf(d, -448.f), 448.f);
    int v = __builtin_amdgcn_cvt_pk_fp8_f32(a, b, 0, false); v = __builtin_amdgcn_cvt_pk_fp8_f32(c, d, v, true); return (unsigned)v; }
constexpr float F8_SH = 8.f, F8_SW = 64.f, F8_SHD = 4.f;
__device__ __forceinline__ float bflo(unsigned u) { return __uint_as_float(u << 16); }
__device__ __forceinline__ float bfhi(unsigned u) { return __uint_as_float(u & 0xffff0000u); }
__device__ __forceinline__ float bf2f(bf16_t b) { return __uint_as_float(((unsigned)b) << 16); }
__device__ __forceinline__ float wave_sum(float v) {
#pragma unroll
    for (int o = 32; o > 0; o >>= 1) v += __shfl_xor(v, o);
    return v;
}
__device__ __forceinline__ float silu_f(float x) { return x / (1.f + __expf(-x)); }
__device__ __forceinline__ float sigmoid_f(float x) { return 1.f / (1.f + __expf(-x)); }

typedef const __attribute__((address_space(4))) Args* CArgs;
struct Ctx {
    CArgs a;
    LAS unsigned char* lds;
    int tid, lane, wave, nwg, wg;
    unsigned char* ws;
    __device__ __forceinline__ float* modp(int layer, int which) const { return (float*)(ws + WS_MOD) + (layer * 2 + which) * 6144; }
    __device__ __forceinline__ const float* xin0(int r) const { return r < C ? a->in[2] + (size_t)r * D : a->in[0] + (size_t)(r - C) * D; }
};


namespace pg8 {
constexpr int BM = 256, BK = 64, HALF = 128, HTB = HALF * BK * 2, STAGE_BYTES = 8 * HTB, KD = 1024, NXCD = 8, WGM = 8;
__device__ __forceinline__ int lds_byte(int r, int c) { const int st = (r >> 4) * 2 + (c >> 5), rr = r & 15, cc = c & 31, ob = rr * 64 + cc * 2; return st * 1024 + (ob ^ (((ob >> 9) & 1) << 5)); }
__device__ __forceinline__ void stage_rc(int b, int& Rr, int& Cc) { const int st = b / 1024, sb = b % 1024, swz = sb ^ (((sb >> 9) & 1) << 5); Rr = (st >> 1) * 16 + swz / 64; Cc = (st & 1) * 32 + (swz % 64) / 2; }
__device__ __forceinline__ int perm32(int rho) { const int n = rho >> 4, i = rho & 15; return 8 * (i >> 2) + 4 * n + (i & 3); }

struct Unit { int pm, pn, e, goff, gcnt; };
struct Gemm { const void* A; const void* Bt; size_t bstride; const int* list; };

struct StaticOrder {
    int nM, nN, nwg, G, c;
    __device__ __forceinline__ void init(int M, int N, int G_, int c_) { nM = M / BM; nN = N / BM; nwg = nM * nN; G = G_; c = c_; }
    __device__ __forceinline__ bool next(int i, Unit& u) const {
        const long Lq = (long)i * G + c; if (Lq >= nwg) return false;
        int wgid = (int)Lq; { const int q = nwg / NXCD, r = nwg % NXCD, xcd = wgid % NXCD, off = wgid / NXCD; wgid = (xcd < r ? xcd * (q + 1) : r * (q + 1) + (xcd - r) * q) + off; }
        const int nig = WGM * nN, gid = wgid / nig, fm = gid * WGM, gsz = (nM - fm) < WGM ? (nM - fm) : WGM;
        u.pm = fm + ((wgid % nig) % gsz); u.pn = (wgid % nig) / gsz; u.e = 0; u.goff = 0; u.gcnt = 0; return true;
    }
};
struct MoeOrder {
    const LAS int* tp; const LAS int* cnt; int npn, G, vcu;
    __device__ __forceinline__ bool next(int i, Unit& u) const {
        const int lin = i * G + vcu; if (lin >= tp[32] * npn) return false;
        const int rt = lin / npn; int e = 0;
#pragma unroll 8
        for (int k = 1; k < 32; ++k) e += (rt >= tp[k]) ? 1 : 0;
        const int mt = rt - tp[e];
        u.pm = rt; u.pn = lin - rt * npn; u.e = e; u.goff = e * R + mt * 256; u.gcnt = cnt[e] - mt * 256; return true;
    }
};

template <int KB>
__device__ __forceinline__ void a_offsets(const Gemm& g, const Unit& u, const int (&sR)[2], const int (&sC)[2], unsigned (&v)[2][2]) {
#pragma unroll
    for (int h = 0; h < 2; ++h)
#pragma unroll
        for (int i = 0; i < 2; ++i) {
            const int rr = h * HALF + sR[i]; int row;
            if (g.list) row = rr < u.gcnt ? g.list[u.goff + rr] : 0; else row = u.pm * BM + rr;
            v[h][i] = (unsigned)(row * KB + sC[i] * 2);
        }
}

struct EpiF32 {
    static constexpr bool PERM = false;
    float* Cp; int ldc; const float* bias;
    __device__ __forceinline__ void operator()(const f32x4 (&acc)[2][2][4][2], const Unit& u, int wr, int wc, int fr, int fq) const {
        const int row0 = u.pm * BM + wr * 64 + fr, col0 = u.pn * BM + wc * 32 + 4 * fq;
#pragma unroll
        for (int bj = 0; bj < 2; ++bj)
#pragma unroll
            for (int n = 0; n < 2; ++n) {
                const int col = col0 + bj * HALF + n * 16;
                const f32x4 bv = bias ? *(const f32x4*)(bias + col) : (f32x4){0.f, 0.f, 0.f, 0.f};
#pragma unroll
                for (int ai = 0; ai < 2; ++ai)
#pragma unroll
                    for (int m = 0; m < 4; ++m) *(f32x4*)(Cp + (size_t)(row0 + ai * HALF + m * 16) * ldc + col) = acc[ai][bj][m][n] + bv;
            }
    }
};
struct EpiSwiglu {
    static constexpr bool PERM = false;
    unsigned char* Hd; const float* bgu;
    __device__ __forceinline__ void operator()(const f32x4 (&acc)[2][2][4][2], const Unit& u, int wr, int wc, int fr, int fq) const {
        const int row0 = u.pm * BM + wr * 64 + fr, cg0 = u.pn * HALF + wc * 32 + 4 * fq;
        const float* bb = bgu + (size_t)u.e * 2048;
#pragma unroll
        for (int n = 0; n < 2; ++n) {
            const int cg = cg0 + n * 16;
            const f32x4 bg = *(const f32x4*)(bb + cg), bu = *(const f32x4*)(bb + 1024 + cg);
#pragma unroll
            for (int ai = 0; ai < 2; ++ai)
#pragma unroll
                for (int m = 0; m < 4; ++m) {
                    const f32x4 gv = acc[ai][0][m][n] * (1.f / (F8_SH * F8_SW)) + bg, uv = acc[ai][1][m][n] * (1.f / (F8_SH * F8_SW)) + bu; float hv[4];
#pragma unroll
                    for (int q = 0; q < 4; ++q) { const float gg = fminf(gv[q], 7.f), uu = fminf(fmaxf(uv[q], -7.f), 7.f); hv[q] = gg * (1.f / (1.f + __expf(-1.702f * gg))) * (uu + 1.f); }
                    *(unsigned*)(Hd + (size_t)(row0 + ai * HALF + m * 16) * 1024 + cg) = pk4_fp8(hv[0] * F8_SHD, hv[1] * F8_SHD, hv[2] * F8_SHD, hv[3] * F8_SHD);
                }
        }
    }
};
struct EpiBf16Bias {
    static constexpr bool PERM = false;
    bf16_t* Op; const float* bias; int bias_estride; float scale;
    __device__ __forceinline__ void operator()(const f32x4 (&acc)[2][2][4][2], const Unit& u, int wr, int wc, int fr, int fq) const {
        const int row0 = u.pm * BM + wr * 64 + fr, col0 = u.pn * BM + wc * 32 + 4 * fq;
        const float* bb = bias + (size_t)u.e * bias_estride;
#pragma unroll
        for (int bj = 0; bj < 2; ++bj)
#pragma unroll
            for (int n = 0; n < 2; ++n) {
                const int col = col0 + bj * HALF + n * 16;
                const f32x4 bv = *(const f32x4*)(bb + col);
#pragma unroll
                for (int ai = 0; ai < 2; ++ai)
#pragma unroll
                    for (int m = 0; m < 4; ++m) { const f32x4 v = acc[ai][bj][m][n] * scale + bv; u32x2 o; o.x = pk2(v[0], v[1]); o.y = pk2(v[2], v[3]);
                        *(u32x2*)(Op + (size_t)(row0 + ai * HALF + m * 16) * 1024 + col) = o; }
            }
    }
};

struct EpiQKV {
    static constexpr bool PERM = false;
    bf16_t* Qp; bf16_t* Kp; bf16_t* Vp; const float* bias; const float* tab;
    __device__ __forceinline__ void operator()(const f32x4 (&acc)[2][2][4][2], const Unit& u, int wr, int wc, int fr, int fq) const {
        const bool lat = u.pm > 0; const float qs = 0.125f * LOG2E;
#pragma unroll
        for (int bj = 0; bj < 2; ++bj) {
            const int colt = u.pn * BM + bj * HALF + wc * 32 + 4 * fq;
            const f32x4 b1 = *(const f32x4*)(bias + colt), b2 = *(const f32x4*)(bias + colt + 16);
            const bool isv = (u.pn == 4) && (bj == 1);
#pragma unroll
            for (int ai = 0; ai < 2; ++ai)
#pragma unroll
                for (int m = 0; m < 4; ++m) {
                    const int r = u.pm * BM + ai * HALF + wr * 64 + m * 16 + fr, t = r - C;
                    f32x4 x1 = acc[ai][bj][m][0] + b1, x2 = acc[ai][bj][m][1] + b2;
                    if (lat && !isv) {
                        const int pos = (wc & 1) ? (t & 63) : (t >> 6);
                        const f32x4 t0 = *(const f32x4*)(tab + (pos * 16 + 4 * fq) * 2), t1 = *(const f32x4*)(tab + (pos * 16 + 4 * fq) * 2 + 4);
                        const float cs[4] = {t0[0], t0[2], t1[0], t1[2]}, sn[4] = {t0[1], t0[3], t1[1], t1[3]};
                        f32x4 o1, o2;
#pragma unroll
                        for (int e = 0; e < 4; ++e) { o1[e] = x1[e] * cs[e] - x2[e] * sn[e]; o2[e] = x2[e] * cs[e] + x1[e] * sn[e]; }
                        x1 = o1; x2 = o2;
                    }
                    u32x2 w1, w2;
                    if (u.pn < 4) {
                        w1.x = pk2(x1[0] * qs, x1[1] * qs); w1.y = pk2(x1[2] * qs, x1[3] * qs); w2.x = pk2(x2[0] * qs, x2[1] * qs); w2.y = pk2(x2[2] * qs, x2[3] * qs);
                        *(u32x2*)(Qp + (size_t)r * 1024 + colt) = w1; *(u32x2*)(Qp + (size_t)r * 1024 + colt + 16) = w2;
                    } else {
                        w1.x = pk2(x1[0], x1[1]); w1.y = pk2(x1[2], x1[3]); w2.x = pk2(x2[0], x2[1]); w2.y = pk2(x2[2], x2[3]);
                        bf16_t* dst = (bj == 0 ? Kp : Vp) + (size_t)r * 128 + wc * 32 + 4 * fq;
                        *(u32x2*)dst = w1; *(u32x2*)(dst + 16) = w2;
                    }
                }
        }
    }
};
struct EpiInProj {
    static constexpr bool PERM = false;
    bf16_t* QH; _Float16* KF; _Float16* KB; bf16_t* IV; bf16_t* SG; const float* lb;
    __device__ __forceinline__ void operator()(const f32x4 (&acc)[2][2][4][2], const Unit& u, int wr, int wc, int fr, int fq) const {
        const int seg = u.pn >> 2; const bool lat = u.pm > 0;
        if (!lat && (seg == 0 || seg == 4)) return;
#pragma unroll
        for (int bj = 0; bj < 2; ++bj)
#pragma unroll
            for (int n = 0; n < 2; ++n) {
                const int col = (u.pn & 3) * BM + bj * HALF + wc * 32 + n * 16 + 4 * fq;
                f32x4 lbv = (f32x4){0.f, 0.f, 0.f, 0.f};
                if (seg == 1) lbv = *(const f32x4*)(lb + col); else if (seg == 2) lbv = *(const f32x4*)(lb + 1024 + col);
#pragma unroll
                for (int ai = 0; ai < 2; ++ai)
#pragma unroll
                    for (int m = 0; m < 4; ++m) {
                        const int r = u.pm * BM + ai * HALF + wr * 64 + m * 16 + fr; const f32x4 v = acc[ai][bj][m][n];
                        if (seg == 1 || seg == 2) {
                            typedef _Float16 h4_t __attribute__((ext_vector_type(4)));
                            h4_t hv;
#pragma unroll
                            for (int e = 0; e < 4; ++e) hv[e] = (_Float16)((1.f - lbv[e]) / (1.f + __expf(v[e])));
                            *(h4_t*)((seg == 1 ? KF : KB) + (size_t)r * 1024 + col) = hv;
                        } else if (seg == 3) {
                            u32x2 o; o.x = pk2(v[0], v[1]); o.y = pk2(v[2], v[3]); *(u32x2*)(IV + (size_t)r * 1024 + col) = o;
                        } else {
                            float sv[4];
#pragma unroll
                            for (int e = 0; e < 4; ++e) sv[e] = v[e] / (1.f + __expf(-v[e]));
                            u32x2 o; o.x = pk2(sv[0], sv[1]); o.y = pk2(sv[2], sv[3]); *(u32x2*)((seg == 0 ? QH : SG) + (size_t)(r - C) * 1024 + col) = o;
                        }
                    }
            }
    }
};

typedef int v8i __attribute__((ext_vector_type(8)));
template <class Epi, class Sched, bool ALIGN_EPI, bool GATHER, bool FP8>
__device__ __forceinline__ void gemm_phase(LAS unsigned char* lds, const Gemm g, const Sched& S, const Epi& E, const int tid) {
    const int wid = __builtin_amdgcn_readfirstlane(tid >> 6), lane = tid & 63, wr = wid >> 2, wc = wid & 3, fr = lane & 15, fq = lane >> 4;
    constexpr int KB = FP8 ? 1024 : 2048, nt = 1024 / (FP8 ? 128 : 64);
    int sR[2], sC[2]; unsigned voffB[2], voffA[2];
#pragma unroll
    for (int i = 0; i < 2; ++i) { stage_rc(tid * 16 + i * 8192, sR[i], sC[i]); const int Rb = Epi::PERM ? ((sR[i] & ~31) + perm32(sR[i] & 31)) : sR[i]; voffB[i] = (unsigned)(Rb * KB + sC[i] * 2); voffA[i] = (unsigned)(sR[i] * KB + sC[i] * 2); }
    constexpr size_t kstep = (size_t)(BK * 2), hstep = (size_t)HALF * KB, tstep = 2 * hstep;
    const unsigned ldsw = (unsigned)wid * 1024u;
    const int fc = FP8 ? (32 * (fq >> 1) + 16 * (fq & 1)) : fq * 8;
    const int aoff = lds_byte(wr * 64 + fr, fc), boff = lds_byte(wc * 32 + fr, fc);
    const char* Ab = (const char*)g.A;
#define PG8_SA(b, h) (((b) * 2 + (h)) * HTB)
#define PG8_SB(b, h) ((4 + (b) * 2 + (h)) * HTB)
#define PG8_STAGE_B(bufoff, gbase) do { _Pragma("unroll") for (int _i = 0; _i < 2; ++_i) \
        __builtin_amdgcn_global_load_lds((const unsigned*)((const char*)(gbase) + voffB[_i]), (LAS unsigned*)(lds + (bufoff) + ldsw + _i * 8192), 16, 0, 0); } while (0)
#define PG8_STAGE_A(bufoff, kb, v, ubase) do { _Pragma("unroll") for (int _i = 0; _i < 2; ++_i) \
        __builtin_amdgcn_global_load_lds((const unsigned*)((GATHER ? Ab : (ubase)) + (size_t)(kb) + (GATHER ? (v)[_i] : voffA[_i])), (LAS unsigned*)(lds + (bufoff) + ldsw + _i * 8192), 16, 0, 0); } while (0)
#define PG8_LDA(dst, b, h) do { if constexpr (FP8) { _Pragma("unroll") for (int m = 0; m < 4; ++m) dst##8[m] = *(const LAS v8i*)(lds + PG8_SA(b, h) + aoff + m * 2048); } else { _Pragma("unroll") for (int m = 0; m < 4; ++m) _Pragma("unroll") for (int k = 0; k < 2; ++k) dst[m][k] = *(const LAS bf16x8*)(lds + PG8_SA(b, h) + aoff + m * 2048 + k * 1024); } } while (0)
#define PG8_LDB(dst, b, h) do { if constexpr (FP8) { _Pragma("unroll") for (int n = 0; n < 2; ++n) dst##8[n] = *(const LAS v8i*)(lds + PG8_SB(b, h) + boff + n * 2048); } else { _Pragma("unroll") for (int n = 0; n < 2; ++n) _Pragma("unroll") for (int k = 0; k < 2; ++k) dst[n][k] = *(const LAS bf16x8*)(lds + PG8_SB(b, h) + boff + n * 2048 + k * 1024); } } while (0)
#define PG8_MMA(ai, bj, At, Bt) do { __builtin_amdgcn_s_setprio(1); if constexpr (FP8) { _Pragma("unroll") for (int m = 0; m < 4; ++m) _Pragma("unroll") for (int n = 0; n < 2; ++n) \
        asm volatile("v_mfma_scale_f32_16x16x128_f8f6f4 %0, %1, %2, %0, %3, %3 op_sel_hi:[0,0,0]" : "+v"(acc[ai][bj][m][n]) : "v"(Bt##8[n]), "v"(At##8[m]), "v"(unit_scale)); } else { \
        _Pragma("unroll") for (int m = 0; m < 4; ++m) _Pragma("unroll") for (int n = 0; n < 2; ++n) _Pragma("unroll") for (int k = 0; k < 2; ++k) \
        acc[ai][bj][m][n] = __builtin_amdgcn_mfma_f32_16x16x32_bf16(Bt[n][k], At[m][k], acc[ai][bj][m][n], 0, 0, 0); } __builtin_amdgcn_s_setprio(0); } while (0)
#define PG8_WAIT_V(n) asm volatile("s_waitcnt vmcnt(" #n ")" ::: "memory")
#define PG8_WAIT_L(n) asm volatile("s_waitcnt lgkmcnt(" #n ")" ::: "memory")
#define PG8_BAR __builtin_amdgcn_s_barrier()
#define PG8_SCHED __builtin_amdgcn_sched_barrier(0)
    Unit cur, nxt; int ui = 0;
    if (!S.next(0, cur)) return;
    unsigned cv[2][2], nv[2][2];
    if constexpr (GATHER) a_offsets<KB>(g, cur, sR, sC, cv);
    const char* cA = Ab + (size_t)cur.pm * tstep; const char* nA = cA;
    f32x4 acc[2][2][4][2];
#pragma unroll
    for (int a = 0; a < 2; ++a)
#pragma unroll
        for (int b = 0; b < 2; ++b)
#pragma unroll
            for (int m = 0; m < 4; ++m)
#pragma unroll
                for (int n = 0; n < 2; ++n) acc[a][b][m][n] = (f32x4){0.f, 0.f, 0.f, 0.f};
    bf16x8 At[4][2], B0[2][2], B1[2][2]; v8i At8[4], B08[2], B18[2];
    int unit_scale = 0x7f7f7f7f; asm volatile("" : "+v"(unit_scale));
    const char* cB = (const char*)g.Bt + (size_t)cur.e * g.bstride + (size_t)cur.pn * tstep;
    PG8_STAGE_B(PG8_SB(0, 0), cB); PG8_STAGE_B(PG8_SB(0, 1), cB + hstep); PG8_STAGE_A(PG8_SA(0, 0), 0, cv[0], cA); PG8_STAGE_A(PG8_SA(0, 1), 0, cv[1], cA + hstep);
    if (wr == 1) PG8_BAR;
    PG8_WAIT_V(2); PG8_BAR;
    PG8_STAGE_B(PG8_SB(1, 0), cB + kstep); PG8_STAGE_A(PG8_SA(1, 0), kstep, cv[0], cA); PG8_STAGE_B(PG8_SB(1, 1), cB + hstep + kstep);
    PG8_WAIT_V(6); PG8_BAR;
    for (;;) {
        const bool has_next = S.next(ui + 1, nxt);
        const char* nB = cB;
        nA = cA;
        if (has_next) { if constexpr (GATHER) a_offsets<KB>(g, nxt, sR, sC, nv); nA = Ab + (size_t)nxt.pm * tstep; nB = (const char*)g.Bt + (size_t)nxt.e * g.bstride + (size_t)nxt.pn * tstep; }
        else if constexpr (GATHER) {
#pragma unroll
            for (int h = 0; h < 2; ++h)
#pragma unroll
                for (int i = 0; i < 2; ++i) nv[h][i] = cv[h][i];
        }
#pragma nounroll
        for (int t = 0; t < nt; t += 2) {
            const bool last = (t == nt - 2);
            const size_t k1 = (size_t)(t + 1) * kstep, k2 = last ? 0 : (size_t)(t + 2) * kstep, k3 = k2 + kstep;
            const char* b2 = last ? nB : cB + (size_t)(t + 2) * kstep; const char* b3 = b2 + kstep;
            unsigned w0[2], w1[2];
            if constexpr (GATHER) {
#pragma unroll
                for (int i = 0; i < 2; ++i) { w0[i] = last ? nv[0][i] : cv[0][i]; w1[i] = last ? nv[1][i] : cv[1][i]; }
            }
            const char* a2 = last ? nA : cA;
            PG8_LDB(B0, 0, 0); PG8_LDB(B1, 0, 1); PG8_SCHED; PG8_LDA(At, 0, 0); PG8_STAGE_A(PG8_SA(1, 1), k1, cv[1], cA + hstep);
            PG8_WAIT_V(8); PG8_WAIT_L(0); PG8_BAR; PG8_MMA(0, 0, At, B0); PG8_MMA(0, 1, At, B1); PG8_BAR; PG8_SCHED;
            PG8_LDA(At, 0, 1); PG8_STAGE_B(PG8_SB(0, 0), b2); PG8_STAGE_B(PG8_SB(0, 1), b2 + hstep); PG8_STAGE_A(PG8_SA(0, 0), k2, w0, a2);
            PG8_WAIT_V(8); PG8_WAIT_L(0); PG8_BAR; PG8_MMA(1, 0, At, B0); PG8_MMA(1, 1, At, B1); PG8_BAR; PG8_SCHED;
            PG8_LDB(B0, 1, 0); PG8_LDB(B1, 1, 1); PG8_SCHED; PG8_LDA(At, 1, 0); PG8_STAGE_A(PG8_SA(0, 1), k2, w1, a2 + hstep);
            PG8_WAIT_V(8); PG8_WAIT_L(0); PG8_BAR; PG8_MMA(0, 0, At, B0); PG8_MMA(0, 1, At, B1); PG8_BAR; PG8_SCHED;
            PG8_LDA(At, 1, 1); PG8_STAGE_B(PG8_SB(1, 0), b3); PG8_STAGE_B(PG8_SB(1, 1), b3 + hstep); PG8_STAGE_A(PG8_SA(1, 0), k3, w0, a2);
            PG8_WAIT_V(8); PG8_WAIT_L(0); PG8_BAR; PG8_MMA(1, 0, At, B0); PG8_MMA(1, 1, At, B1); PG8_BAR; PG8_SCHED;
        }
        if constexpr (ALIGN_EPI) { if (wr == 0) PG8_BAR; }
        if constexpr (FP8) asm volatile("s_nop 15\n\ts_nop 15" ::: "memory");
        E(acc, cur, wr, wc, fr, fq);
        if (!has_next) break;
#pragma unroll
        for (int a = 0; a < 2; ++a)
#pragma unroll
            for (int b = 0; b < 2; ++b)
#pragma unroll
                for (int m = 0; m < 4; ++m)
#pragma unroll
                    for (int n = 0; n < 2; ++n) acc[a][b][m][n] = (f32x4){0.f, 0.f, 0.f, 0.f};
        cur = nxt; cB = nB; cA = nA; ++ui;
        if constexpr (GATHER) {
#pragma unroll
            for (int h = 0; h < 2; ++h)
#pragma unroll
                for (int i = 0; i < 2; ++i) cv[h][i] = nv[h][i];
        }
        if constexpr (ALIGN_EPI) { if (wr == 1) PG8_BAR; }
    }
    PG8_WAIT_V(0);
    if constexpr (!ALIGN_EPI) { if (wr == 0) PG8_BAR; }
    PG8_BAR;
#undef PG8_SA
#undef PG8_SB
#undef PG8_STAGE_A
#undef PG8_STAGE_B
#undef PG8_LDA
#undef PG8_LDB
#undef PG8_MMA
#undef PG8_WAIT_V
#undef PG8_WAIT_L
#undef PG8_BAR
#undef PG8_SCHED
}
}

struct TBlk { const float* src; int ldw; bf16_t* dst; unsigned char* dst8; };
__device__ __forceinline__ void tb_load(const TBlk& t, int lane, f32x4 (&v)[16]) {
    const float* p = t.src + (size_t)(lane >> 4) * t.ldw + (lane & 15) * 4;
#pragma unroll
    for (int i = 0; i < 16; ++i) v[i] = *(const f32x4*)(p + (size_t)(4 * i) * t.ldw);
}
__device__ __forceinline__ void tb_store(const TBlk& t, int lane, const f32x4 (&v)[16], LAS float* scr) {
#pragma unroll
    for (int i = 0; i < 16; ++i) { LAS float* d = scr + ((lane >> 4) + 4 * i) * 65 + (lane & 15) * 4; d[0] = v[i].x; d[1] = v[i].y; d[2] = v[i].z; d[3] = v[i].w; }
    asm volatile("s_waitcnt lgkmcnt(0)" ::: "memory"); __builtin_amdgcn_wave_barrier();
    const int c8 = lane & 7;
#pragma unroll
    for (int jj = 0; jj < 8; ++jj) {
        const int n = (lane >> 3) + 8 * jj; const LAS float* p = scr + (8 * c8) * 65 + n;
        if (t.dst8) { u32x2 o; o.x = pk4_fp8(p[0] * F8_SW, p[65] * F8_SW, p[2 * 65] * F8_SW, p[3 * 65] * F8_SW); o.y = pk4_fp8(p[4 * 65] * F8_SW, p[5 * 65] * F8_SW, p[6 * 65] * F8_SW, p[7 * 65] * F8_SW);
            *(u32x2*)(t.dst8 + (size_t)n * 1024 + 8 * c8) = o; }
        else { u32x4 o; o.x = pk2(p[0], p[65]); o.y = pk2(p[2 * 65], p[3 * 65]); o.z = pk2(p[4 * 65], p[5 * 65]); o.w = pk2(p[6 * 65], p[7 * 65]);
            *(u32x4*)(t.dst + (size_t)n * 1024 + 8 * c8) = o; }
    }
    asm volatile("s_waitcnt lgkmcnt(0)" ::: "memory"); __builtin_amdgcn_wave_barrier();
}

__device__ __forceinline__ void phase_prep(const Ctx& c) {
    LAS float* red = (LAS float*)c.lds;
    const float* cv = c.a->in[1]; const float* ccv = c.a->in[3]; const float* ada_w = c.a->in[4]; const float* ada_b = c.a->in[5];
    for (int item = c.wg; item < 193; item += c.nwg) {
        if (item < 192) {
            const int layer = item / 96, cb = item % 96, col = cb * 64 + c.lane;
            const float* W = ada_w + (size_t)layer * D * 6144 + col;
            float a0 = 0.f, a1 = 0.f;
            const int k0 = c.wave * 128;
#pragma unroll 32
            for (int k = 0; k < 128; ++k) { const float w = W[(size_t)(k0 + k) * 6144]; a0 += silu_f(cv[k0 + k]) * w; a1 += silu_f(ccv[k0 + k]) * w; }
            red[(0 * 8 + c.wave) * 64 + c.lane] = a0; red[(1 * 8 + c.wave) * 64 + c.lane] = a1;
            __syncthreads();
            if (c.tid < 128) {
                const int which = c.tid >> 6, l = c.tid & 63; float s = 0.f;
#pragma unroll
                for (int w = 0; w < 8; ++w) s += red[(which * 8 + w) * 64 + l];
                c.modp(layer, which)[cb * 64 + l] = s + ada_b[layer * 6144 + cb * 64 + l];
            }
            __syncthreads();
        } else {
            float* modbase = (float*)(c.ws + WS_MOD);
            for (int i = c.tid; i < 4096; i += 512) {
                const int pos = i >> 4, j = i & 15;
                const double ang = (double)pos * pow(10000.0, -(double)j / 16.0);
                modbase[MOD_ROPE + 2 * i] = (float)cos(ang); modbase[MOD_ROPE + 2 * i + 1] = (float)sin(ang);
            }
            const float* lbp = c.a->in[12];
            for (int i = c.tid; i < 2048; i += 512) { const float p0 = lbp[i], p1 = lbp[2048 + i]; modbase[MOD_LB + i] = 1.f / (1.f + __expf(p0 - p1)); }
        }
    }
}

__device__ __forceinline__ void row_load(const float* p, int lane, f32x4 (&v)[4]) {
#pragma unroll
    for (int j = 0; j < 4; ++j) v[j] = *(const f32x4*)(p + lane * 4 + 256 * j);
}
__device__ __forceinline__ float row_ss(const f32x4 (&v)[4]) {
    float s = 0.f;
#pragma unroll
    for (int j = 0; j < 4; ++j) s += v[j].x * v[j].x + v[j].y * v[j].y + v[j].z * v[j].z + v[j].w * v[j].w;
    return wave_sum(s);
}
__device__ __forceinline__ void row_modnorm_store(const f32x4 (&x)[4], float rstd, const float* g, const float* sh, const float* sc, bf16_t* out, int lane, f32x4 (*hout)[4] = nullptr) {
#pragma unroll
    for (int j = 0; j < 4; ++j) {
        const int c0 = lane * 4 + 256 * j;
        const f32x4 gv = *(const f32x4*)(g + c0), shv = *(const f32x4*)(sh + c0), scv = *(const f32x4*)(sc + c0);
        f32x4 h;
        h.x = x[j].x * rstd * gv.x * (1.f + scv.x) + shv.x; h.y = x[j].y * rstd * gv.y * (1.f + scv.y) + shv.y;
        h.z = x[j].z * rstd * gv.z * (1.f + scv.z) + shv.z; h.w = x[j].w * rstd * gv.w * (1.f + scv.w) + shv.w;
        if (hout) (*hout)[j] = h;
        u32x2 o; o.x = pk2(h.x, h.y); o.y = pk2(h.z, h.w);
        *(u32x2*)(out + c0) = o;
    }
}

__device__ __forceinline__ void phase_norm0(const Ctx& c) {
    bf16_t* H = (bf16_t*)(c.ws + WS_H); const float* ng = c.a->in[6];
    int r = c.wg * 8 + c.wave;
    f32x4 xn[4];
    if (r < R) row_load(c.xin0(r), c.lane, xn);
    for (; r < R; r += c.nwg * 8) {
        f32x4 x[4];
#pragma unroll
        for (int j = 0; j < 4; ++j) x[j] = xn[j];
        if (r + c.nwg * 8 < R) row_load(c.xin0(r + c.nwg * 8), c.lane, xn);
        const float rstd = rsqrtf(row_ss(x) * (1.f / D) + EPS);
        const float* m = c.modp(0, r < C ? 1 : 0);
        row_modnorm_store(x, rstd, ng, m + 0, m + 1024, H + (size_t)r * D, c.lane);
    }
}

namespace at {
constexpr int KP = 144, TILEB = 64 * KP;
__device__ __forceinline__ bf16x8 tr_frag2(const LAS unsigned char* tile, int row0, int col0, int lane) {
    const int q = (lane & 15) >> 2, p = lane & 3;
    const LAS unsigned char* a = tile + (row0 + q) * KP + (col0 + 4 * p) * 2;
    const v4i16_t lo = __builtin_amdgcn_ds_read_tr16_b64_v4i16((LAS v4i16_t*)a);
    const v4i16_t hi = __builtin_amdgcn_ds_read_tr16_b64_v4i16((LAS v4i16_t*)(a + 16 * KP));
    return (bf16x8){lo[0], lo[1], lo[2], lo[3], hi[0], hi[1], hi[2], hi[3]};
}
}
__device__ __forceinline__ void phase_attn(const Ctx& c) {
    using namespace at;
    const bf16_t* Q = (const bf16_t*)(c.ws + WS_Q); const bf16_t* K = (const bf16_t*)(c.ws + WS_K); const bf16_t* V = (const bf16_t*)(c.ws + WS_V);
    bf16_t* O = (bf16_t*)(c.ws + WS_O); const float* sink = c.a->in[9];
    LAS unsigned char* lds = c.lds;
    const int tid = c.tid, lane = c.lane, w = __builtin_amdgcn_readfirstlane(tid >> 6), fr = lane & 15, g = lane >> 4;
    const int lrow = tid >> 3, lch = tid & 7;
    for (int item = c.wg; item < 264; item += c.nwg) {
        const bool isctx = item >= 256;
        const int ci = item - 256;
        const int n = isctx ? 0 : (item >> 1), kh = isctx ? ((ci >> 1) & 1) : (item & 1), cb = isctx ? (ci >> 2) : 0;
        const int p_lo = isctx ? (ci & 1) : 0, p_hi = isctx ? (ci & 1) + 1 : 2;
        const int hq = kh * 8 + w;
        const float sink2 = sink[hq] * LOG2E;
        for (int pass = p_lo; pass < p_hi; ++pass) {
            const int t0 = 128 * n + 64 * pass, qrow0 = isctx ? cb * 128 + 64 * pass : C + t0;
            const int jlo = isctx ? 0 : (t0 >= 128 ? 0 : (128 - t0) / 64), jhi = isctx ? 0 : ((L - t0 + 128) / 64 < 5 ? (L - t0 + 128) / 64 : 5);
            const int ntile = 4 + (jhi - jlo);
            LAS unsigned char* qlds = lds + 4 * TILEB + w * TILEB;
#pragma unroll
            for (int qb = 0; qb < 4; ++qb)
#pragma unroll
                for (int ks = 0; ks < 2; ++ks) *(LAS bf16x8*)(qlds + (16 * qb + fr) * KP + (32 * ks + 8 * g) * 2) = *(const bf16x8*)(Q + (size_t)(qrow0 + 16 * qb + fr) * D + hq * 64 + 32 * ks + 8 * g);
            float mrow[4], lsum[4]; f32x4 OT[4][4];
#pragma unroll
            for (int qb = 0; qb < 4; ++qb) { mrow[qb] = sink2; lsum[qb] = 1.f;
#pragma unroll
                for (int nt = 0; nt < 4; ++nt) OT[qb][nt] = (f32x4){0.f, 0.f, 0.f, 0.f}; }
            u32x4 kreg, vreg;
#define AT_KROW(ti) ((ti) < 4 ? 64 * (ti) : C + t0 - 128 + 64 * (jlo + (ti) - 4))
#define AT_LOAD(ti) do { const size_t ro_ = (size_t)(AT_KROW(ti) + lrow) * 128 + kh * 64 + lch * 8; kreg = *(const u32x4*)(K + ro_); vreg = *(const u32x4*)(V + ro_); } while (0)
#define AT_WRITE(buf) do { *(LAS u32x4*)(lds + (buf) * 2 * TILEB + lrow * KP + lch * 16) = kreg; *(LAS u32x4*)(lds + (buf) * 2 * TILEB + TILEB + lrow * KP + lch * 16) = vreg; } while (0)
            AT_LOAD(0); AT_WRITE(0);
            __syncthreads();
            for (int ti = 0; ti < ntile; ++ti) {
                if (ti + 1 < ntile) AT_LOAD(ti + 1);
                const LAS unsigned char* kb = lds + (ti & 1) * 2 * TILEB; const LAS unsigned char* vb = kb + TILEB;
                const int jj = jlo + ti - 4; const bool masked = (ti >= 4) && (jj == 0 || jj == 4);
                const int k0 = t0 - 128 + 64 * jj;
                bf16x8 Kf[4][2];
#pragma unroll
                for (int mt = 0; mt < 4; ++mt)
#pragma unroll
                    for (int ks = 0; ks < 2; ++ks) Kf[mt][ks] = *(const LAS bf16x8*)(kb + (16 * mt + fr) * KP + (32 * ks + 8 * g) * 2);
#pragma unroll
                for (int qb = 0; qb < 4; ++qb) {
                    asm volatile("" ::: "memory");
                    bf16x8 Vf[4][2];
#pragma unroll
                    for (int mt = 0; mt < 4; ++mt)
#pragma unroll
                        for (int ks = 0; ks < 2; ++ks)
                            Vf[mt][ks] = tr_frag2(vb, 32 * ks + 4 * g, 16 * mt, lane);
                    bf16x8 Qq[2];
#pragma unroll
                    for (int ks = 0; ks < 2; ++ks) Qq[ks] = *(const LAS bf16x8*)(qlds + (16 * qb + fr) * KP + (32 * ks + 8 * g) * 2);
                    f32x4 sa[4];
#pragma unroll
                    for (int mt = 0; mt < 4; ++mt) { sa[mt] = (f32x4){0.f, 0.f, 0.f, 0.f};
#pragma unroll
                        for (int ks = 0; ks < 2; ++ks) sa[mt] = __builtin_amdgcn_mfma_f32_16x16x32_bf16(Kf[mt][ks], Qq[ks], sa[mt], 0, 0, 0); }
                    if (masked) {
                        const int tq = t0 + 16 * qb + fr;
#pragma unroll
                        for (int mt = 0; mt < 4; ++mt)
#pragma unroll
                            for (int e = 0; e < 4; ++e) { const int dt = tq - (k0 + 16 * mt + 4 * g + e); if (dt > 128 || dt < -128) sa[mt][e] = -INFINITY; }
                    }
                    float mx = fmaxf(fmaxf(sa[0][0], sa[0][1]), fmaxf(sa[0][2], sa[0][3]));
#pragma unroll
                    for (int mt = 1; mt < 4; ++mt) mx = fmaxf(mx, fmaxf(fmaxf(sa[mt][0], sa[mt][1]), fmaxf(sa[mt][2], sa[mt][3])));
                    mx = fmaxf(mx, __shfl_xor(mx, 16)); mx = fmaxf(mx, __shfl_xor(mx, 32));
                    const float mn = fmaxf(mrow[qb], mx), alpha = __builtin_amdgcn_exp2f(mrow[qb] - mn);
                    mrow[qb] = mn;
                    float rs = 0.f;
#pragma unroll
                    for (int mt = 0; mt < 4; ++mt)
#pragma unroll
                        for (int e = 0; e < 4; ++e) { const float pv = __builtin_amdgcn_exp2f(sa[mt][e] - mn); sa[mt][e] = pv; rs += pv; }
                    rs += __shfl_xor(rs, 16); rs += __shfl_xor(rs, 32);
                    lsum[qb] = lsum[qb] * alpha + rs;
                    bf16x8 Pb[2];
#pragma unroll
                    for (int ks = 0; ks < 2; ++ks) { const f32x4 a0 = sa[2 * ks], a1 = sa[2 * ks + 1];
                        const u32x4 pk = (u32x4){pk2(a0[0], a0[1]), pk2(a0[2], a0[3]), pk2(a1[0], a1[1]), pk2(a1[2], a1[3])}; Pb[ks] = __builtin_bit_cast(bf16x8, pk); }
#pragma unroll
                    for (int nt = 0; nt < 4; ++nt) { OT[qb][nt] = OT[qb][nt] * alpha;
#pragma unroll
                        for (int ks = 0; ks < 2; ++ks) OT[qb][nt] = __builtin_amdgcn_mfma_f32_16x16x32_bf16(Vf[nt][ks], Pb[ks], OT[qb][nt], 0, 0, 0); }
                }
                if (ti + 1 < ntile) AT_WRITE((ti + 1) & 1);
                __syncthreads();
            }
#undef AT_KROW
#undef AT_LOAD
#undef AT_WRITE
#pragma unroll
            for (int qb = 0; qb < 4; ++qb) {
                const float il = 1.f / lsum[qb];
                bf16_t* op = O + (size_t)(qrow0 + 16 * qb + fr) * D + hq * 64 + 4 * g;
#pragma unroll
                for (int nt = 0; nt < 4; ++nt) { const f32x4 v = OT[qb][nt] * il; u32x2 o; o.x = pk2(v[0], v[1]); o.y = pk2(v[2], v[3]); *(u32x2*)(op + 16 * nt) = o; }
            }
        }
    }
}

__device__ __forceinline__ void phase_postmix(const Ctx& c, int layer, bool route) {
    const float* Y = (const float*)(c.ws + WS_RAW1); unsigned char* H8 = c.ws + WS_H8;
    float* Xout = (float*)(c.ws + (layer == 0 ? WS_X : WS_X1)); const float* Xprev = (const float*)(c.ws + WS_X);
    const float* ng = c.a->in[6] + layer * 4 * D; const float* Wr = c.a->in[15] + (size_t)layer * D * NE; const float* br = c.a->in[16] + layer * NE;
    unsigned* cnt = (unsigned*)(c.ws + WS_CTL) + CW_CNT + layer * NE;
    int* tk_e = (int*)(c.ws + WS_TK); float* tk_g = (float*)(c.ws + WS_TK) + R * 4; int* tk_slot = (int*)(c.ws + WS_TK) + 2 * R * 4;
    int* list = (int*)(c.ws + WS_LIST);
    LAS float* WL = (LAS float*)c.lds;
    LAS float* biasp = (LAS float*)(c.lds + 131072);
    LAS unsigned* lcnt = (LAS unsigned*)(c.lds + 145920); LAS unsigned* lbase = lcnt + 32;
    LAS float* pvA = (LAS float*)(c.lds + 131072 + 2560); LAS float* pvB = pvA + 1024; LAS float* pvS = pvB + 1024;
    const int lane = c.lane, w = __builtin_amdgcn_readfirstlane(c.tid >> 6), fr = lane & 15, g = lane >> 4;
    const int g_lo = layer == 0 ? 0 : C / 128;
    for (int grp = g_lo + c.wg; grp < R / 128; grp += c.nwg) {
        const int which = grp * 128 < C ? 1 : 0;
        const float* m = c.modp(layer, which);
        __syncthreads();
        if (c.tid < NE) lcnt[c.tid] = 0u;
#pragma unroll 4
        for (int j = 0; j < 16; ++j) {
            const int i4 = c.tid + 512 * j, k = i4 >> 3, e0 = (i4 & 7) * 4;
            const f32x4 wv = *(const f32x4*)(Wr + (size_t)k * NE + e0); const float sc = ng[2 * D + k] * (1.f + m[4096 + k]);
            LAS float* dst = WL + ((((k >> 4) * 4 + (k & 3)) * 4 + ((k >> 2) & 3)) * 16) * 2;
#pragma unroll
            for (int q = 0; q < 4; ++q) { const int e = e0 + q; dst[(e & 15) * 2 + (e >> 4)] = wv[q] * sc; }
        }
        for (int k = c.tid; k < D; k += 512) { pvA[k] = m[2048 + k] * ng[D + k]; pvB[k] = ng[2 * D + k] * (1.f + m[4096 + k]); pvS[k] = m[3072 + k]; }
        { const int e = c.tid & 31, part = c.tid >> 5; float sacc = 0.f;
#pragma unroll 16
          for (int k = part * 64; k < part * 64 + 64; ++k) sacc += m[3072 + k] * Wr[k * NE + e];
          biasp[32 + part * 32 + e] = sacc; }
        __syncthreads();
        if (c.tid < 32) { float sacc = br[c.tid];
#pragma unroll
            for (int p = 0; p < 16; ++p) sacc += biasp[32 + p * 32 + c.tid]; biasp[c.tid] = sacc; }
        __syncthreads();
        const int row0 = grp * 128 + w * 16;
        float rs_keep = 0.f;
        f32x4 yn[4], xn[4];
        row_load(Y + (size_t)(layer == 0 ? row0 : row0 - C) * D, lane, yn); row_load(layer == 0 ? c.xin0(row0) : Xprev + (size_t)row0 * D, lane, xn);
        for (int i = 0; i < 16; ++i) {
            const int r = row0 + i;
            f32x4 y[4], x[4];
#pragma unroll
            for (int j = 0; j < 4; ++j) { y[j] = yn[j]; x[j] = xn[j]; }
            if (i + 1 < 16) { row_load(Y + (size_t)(layer == 0 ? r + 1 : r + 1 - C) * D, lane, yn); row_load(layer == 0 ? c.xin0(r + 1) : Xprev + (size_t)(r + 1) * D, lane, xn); }
            const float rstd_y = rsqrtf(row_ss(y) * (1.f / D) + EPS);
#pragma unroll
            for (int j = 0; j < 4; ++j) {
                const int c0 = lane * 4 + 256 * j;
                x[j] += *(const LAS f32x4*)(pvA + c0) * (y[j] * rstd_y);
                *(f32x4*)(Xout + (size_t)r * D + c0) = x[j];
            }
            const float rstd_x = rsqrtf(row_ss(x) * (1.f / D) + EPS);
#pragma unroll
            for (int j = 0; j < 4; ++j) {
                const int c0 = lane * 4 + 256 * j;
                const f32x4 hv = x[j] * rstd_x * *(const LAS f32x4*)(pvB + c0) + *(const LAS f32x4*)(pvS + c0);
                *(unsigned*)(H8 + (size_t)r * D + c0) = pk4_fp8(hv[0] * F8_SH, hv[1] * F8_SH, hv[2] * F8_SH, hv[3] * F8_SH);
            }
            if (lane == i) rs_keep = rstd_x;
        }
        asm volatile("s_waitcnt vmcnt(0)" ::: "memory");
        f32x4 la[2]; la[0] = (f32x4){0.f, 0.f, 0.f, 0.f}; la[1] = la[0];
        {
            const float* ap = Xout + (size_t)(row0 + fr) * D + 4 * g;
            const LAS float* bp = WL + (g * 16 + fr) * 2;
#pragma unroll 4
            for (int k4 = 0; k4 < 64; ++k4) {
                const f32x4 a4 = *(const f32x4*)(ap + 16 * k4);
#pragma unroll
                for (int q = 0; q < 4; ++q) {
                    const f32x2 b2 = *(const LAS f32x2*)(bp + (size_t)(4 * k4 + q) * 128);
                    la[0] = __builtin_amdgcn_mfma_f32_16x16x4f32(a4[q], b2[0], la[0], 0, 0, 0);
                    la[1] = __builtin_amdgcn_mfma_f32_16x16x4f32(a4[q], b2[1], la[1], 0, 0, 0);
                }
            }
        }
        float tv[4][4]; int te[4][4];
#pragma unroll
        for (int e = 0; e < 4; ++e) {
            const float rs = __shfl(rs_keep, 4 * g + e);
            float v0 = la[0][e] * rs + biasp[fr], v1 = la[1][e] * rs + biasp[16 + fr];
#pragma unroll
            for (int k = 0; k < 4; ++k) {
                float bv; int bi;
                if (v0 >= v1) { bv = v0; bi = fr; } else { bv = v1; bi = 16 + fr; }
#pragma unroll
                for (int o = 8; o > 0; o >>= 1) {
                    const float ov = __shfl_xor(bv, o); const int oi = __shfl_xor(bi, o);
                    if (ov > bv || (ov == bv && oi < bi)) { bv = ov; bi = oi; }
                }
                tv[e][k] = bv; te[e][k] = bi;
                if (bi == fr) v0 = -INFINITY;
                if (bi == 16 + fr) v1 = -INFINITY;
            }
        }
        float v[4]; int ex[4]; unsigned sl[4];
#pragma unroll
        for (int k = 0; k < 4; ++k) { v[k] = tv[0][k]; ex[k] = te[0][k];
#pragma unroll
            for (int e = 1; e < 4; ++e) if (fr == e) { v[k] = tv[e][k]; ex[k] = te[e][k]; } }
        if (fr < 4 && route) {
#pragma unroll
            for (int k = 0; k < 4; ++k) sl[k] = __hip_atomic_fetch_add(lcnt + ex[k], 1u, __ATOMIC_RELAXED, __HIP_MEMORY_SCOPE_WORKGROUP);
        }
        __syncthreads();
        if (c.tid < NE && route) { const unsigned n = lcnt[c.tid]; lbase[c.tid] = n ? atomicAdd(&cnt[c.tid], n) : 0u; }
        __syncthreads();
        if (fr < 4 && route) {
            const int r = row0 + 4 * g + fr;
            const float e1 = __expf(v[1] - v[0]), e2 = __expf(v[2] - v[0]), e3 = __expf(v[3] - v[0]);
            const float inv = 1.f / (1.f + e1 + e2 + e3);
            const float gk[4] = {inv, e1 * inv, e2 * inv, e3 * inv};
#pragma unroll
            for (int k = 0; k < 4; ++k) {
                const unsigned slot = lbase[ex[k]] + sl[k];
                list[(size_t)ex[k] * R + slot] = r;
                tk_e[r * 4 + k] = ex[k]; tk_g[r * 4 + k] = gk[k]; tk_slot[r * 4 + k] = (int)slot;
            }
        }
    }
}

__device__ __forceinline__ void moe_offsets(const Ctx& c, int layer, LAS int* so) {
    const unsigned* cnt = (const unsigned*)(c.ws + WS_CTL) + CW_CNT + layer * NE;
    __syncthreads();
    if (c.tid < 64) {
        const int n = c.tid < NE ? (int)cnt[c.tid] : 0; int pad = (n + PADM - 1) / PADM * PADM, inc = pad;
#pragma unroll
        for (int o = 1; o < 32; o <<= 1) { const int t = __shfl_up(inc, o); if (c.lane >= o) inc += t; }
        if (c.tid < NE) { so[c.tid] = inc - pad; so[64 + c.tid] = n; }
        if (c.tid == NE - 1) so[32] = inc;
    }
    __syncthreads();
}

__device__ __forceinline__ void moe_tables(const Ctx& c, int layer, LAS int* tb) {
    const unsigned* cnt = (const unsigned*)(c.ws + WS_CTL) + CW_CNT + layer * NE;
    __syncthreads();
    if (c.tid < 64) {
        const int n = c.tid < NE ? (int)cnt[c.tid] : 0; int tiles = (n + PADM - 1) / PADM, inc = tiles;
#pragma unroll
        for (int o = 1; o < 32; o <<= 1) { const int t = __shfl_up(inc, o); if (c.lane >= o) inc += t; }
        if (c.tid < NE) { tb[c.tid] = inc - tiles; tb[64 + c.tid] = n; }
        if (c.tid == NE - 1) tb[32] = inc;
    }
    __syncthreads();
}
__device__ __forceinline__ int vcu_of(const Ctx& c) { return (c.nwg % 8 == 0) ? (c.wg % 8) * (c.nwg / 8) + c.wg / 8 : c.wg; }
__device__ __forceinline__ void phase_moe_gu(const Ctx& c, int layer) {
    LAS int* tb = (LAS int*)(c.lds + 131072 + 1024);
    moe_tables(c, layer, tb);
    pg8::Gemm g{c.ws + WS_H8, c.ws + WS_WGU + (size_t)layer * NE * 2048 * 1024, (size_t)2048 * 1024, (const int*)(c.ws + WS_LIST)};
    pg8::MoeOrder S{tb, tb + 64, 8, c.nwg, vcu_of(c)};
    pg8::EpiSwiglu E{c.ws + WS_HDN, c.a->in[18] + (size_t)layer * NE * 2048};
    pg8::gemm_phase<pg8::EpiSwiglu, pg8::MoeOrder, true, true, true>(c.lds, g, S, E, c.tid);
}
__device__ __forceinline__ void phase_moe_dn(const Ctx& c, int layer) {
    LAS int* tb = (LAS int*)(c.lds + 131072 + 1024);
    moe_tables(c, layer, tb);
    pg8::Gemm g{c.ws + WS_HDN, c.ws + WS_WDN + (size_t)layer * NE * 1024 * 1024, (size_t)1024 * 1024, nullptr};
    pg8::MoeOrder S{tb, tb + 64, 4, c.nwg, vcu_of(c)};
    pg8::EpiBf16Bias E{(bf16_t*)(c.ws + WS_OUTB), c.a->in[20] + (size_t)layer * NE * 1024, 1024, 1.f / (F8_SHD * F8_SW)};
    pg8::gemm_phase<pg8::EpiBf16Bias, pg8::MoeOrder, true, false, true>(c.lds, g, S, E, c.tid);
}
__device__ __forceinline__ void phase_gemm_f32(const Ctx& c, const bf16_t* A, int M, const bf16_t* Bt, int N, const float* bias, float* Cout) {
    pg8::Gemm g{A, Bt, 0, nullptr}; pg8::StaticOrder S; S.init(M, N, c.nwg, c.wg);
    pg8::EpiF32 E{Cout, N, bias};
    pg8::gemm_phase<pg8::EpiF32, pg8::StaticOrder, true, false, false>(c.lds, g, S, E, c.tid);
}

__device__ __forceinline__ void phase_gemm_qkv(const Ctx& c) {
    pg8::Gemm g{(const bf16_t*)(c.ws + WS_H), (const bf16_t*)(c.ws + WS_WQKV), 0, nullptr}; pg8::StaticOrder S; S.init(R, QKVD, c.nwg, c.wg);
    pg8::EpiQKV E{(bf16_t*)(c.ws + WS_Q), (bf16_t*)(c.ws + WS_K), (bf16_t*)(c.ws + WS_V), c.a->in[8], (const float*)(c.ws + WS_MOD) + MOD_ROPE};
    pg8::gemm_phase<pg8::EpiQKV, pg8::StaticOrder, true, false, false>(c.lds, g, S, E, c.tid);
}
__device__ __forceinline__ void phase_gemm_inproj(const Ctx& c) {
    pg8::Gemm g{(const bf16_t*)(c.ws + WS_H), (const bf16_t*)(c.ws + WS_WIN), 0, nullptr}; pg8::StaticOrder S; S.init(R, HIN, c.nwg, c.wg);
    pg8::EpiInProj E{(bf16_t*)(c.ws + WS_QH), (_Float16*)(c.ws + WS_KF), (_Float16*)(c.ws + WS_KB), (bf16_t*)(c.ws + WS_IV), (bf16_t*)(c.ws + WS_SG), (const float*)(c.ws + WS_MOD) + MOD_LB};
    pg8::gemm_phase<pg8::EpiInProj, pg8::StaticOrder, true, false, false>(c.lds, g, S, E, c.tid);
}

__device__ __forceinline__ void phase_norm0(const Ctx& c);
__device__ __forceinline__ TBlk convert_item(const Ctx& c, int it) {
    constexpr int I_QKV = 20 * 16, I_O = 16 * 16, I_IN = 80 * 16, I_HO = 16 * 16, I_GU = 64 * 32 * 16;
    int r = it; TBlk t; t.dst8 = nullptr; t.dst = nullptr;
    if (r < I_QKV) { const int nb = r % 20, kb = r / 20; t.src = c.a->in[7] + (size_t)kb * 64 * QKVD + nb * 64; t.ldw = QKVD; t.dst = (bf16_t*)(c.ws + WS_WQKV) + (size_t)nb * 64 * 1024 + kb * 64; return t; } r -= I_QKV;
    if (r < I_O) { const int nb = r % 16, kb = r / 16; t.src = c.a->in[10] + (size_t)kb * 64 * D + nb * 64; t.ldw = D; t.dst = (bf16_t*)(c.ws + WS_WO) + (size_t)nb * 64 * 1024 + kb * 64; return t; } r -= I_O;
    if (r < I_IN) { const int nb = r % 80, kb = r / 80; t.src = c.a->in[11] + (size_t)kb * 64 * HIN + nb * 64; t.ldw = HIN; t.dst = (bf16_t*)(c.ws + WS_WIN) + (size_t)nb * 64 * 1024 + kb * 64; return t; } r -= I_IN;
    if (r < I_HO) { const int nb = r % 16, kb = r / 16; t.src = c.a->in[14] + (size_t)kb * 64 * D + nb * 64; t.ldw = D; t.dst = (bf16_t*)(c.ws + WS_WHO) + (size_t)nb * 64 * 1024 + kb * 64; return t; } r -= I_HO;
    if (r < I_GU) { const int mat = r / 512, rr = r % 512, nb = rr % 32, kb = rr / 32; const int n0 = ((nb & 3) >> 1) * 1024 + (nb >> 2) * 128 + (nb & 1) * 64;
        t.src = c.a->in[17] + (size_t)mat * 1024 * 2048 + (size_t)kb * 64 * 2048 + n0; t.ldw = 2048; t.dst8 = c.ws + WS_WGU + ((size_t)mat * 2048 + nb * 64) * 1024 + kb * 64; return t; } r -= I_GU;
    { const int mat = r / 256, rr = r % 256, nb = rr % 16, kb = rr / 16;
        t.src = c.a->in[19] + (size_t)mat * 1024 * 1024 + (size_t)kb * 64 * 1024 + nb * 64; t.ldw = 1024; t.dst8 = c.ws + WS_WDN + ((size_t)mat * 1024 + nb * 64) * 1024 + kb * 64; }
    return t;
}
__device__ __forceinline__ void phase_convert(const Ctx& c) {
    LAS float* scr = (LAS float*)c.lds + c.wave * (64 * 65);
    const int gw = c.wg * 8 + c.wave, NGW = c.nwg * 8;
    constexpr int TOT = 20 * 16 + 16 * 16 + 80 * 16 + 16 * 16 + 64 * 32 * 16 + 64 * 16 * 16;
    f32x4 va[16], vb[16];
    int it = gw;
    TBlk ta, tbk;
    if (it < TOT) { ta = convert_item(c, it); tb_load(ta, c.lane, va); }
    for (; it < TOT; it += 2 * NGW) {
        const bool hb = it + NGW < TOT;
        if (hb) { tbk = convert_item(c, it + NGW); tb_load(tbk, c.lane, vb); }
        tb_store(ta, c.lane, va, scr);
        const bool ha = it + 2 * NGW < TOT;
        if (ha) { ta = convert_item(c, it + 2 * NGW); tb_load(ta, c.lane, va); }
        if (hb) tb_store(tbk, c.lane, vb, scr);
    }
    __syncthreads();
    phase_norm0(c);
}

__device__ __forceinline__ void phase_combine(const Ctx& c, int layer) {
    LAS int* so = (LAS int*)(c.lds + 32768);
    moe_offsets(c, layer, so);
    const bf16_t* outb = (const bf16_t*)(c.ws + WS_OUTB); float* X = (float*)(c.ws + WS_X); bf16_t* H = (bf16_t*)(c.ws + WS_H);
    const float* Xin = layer == 0 ? X : (const float*)(c.ws + WS_X1);
    const float* ngl = c.a->in[6] + layer * 4 * D;
    const int* tk_e = (const int*)(c.ws + WS_TK); const float* tk_g = (const float*)(c.ws + WS_TK) + R * 4; const int* tk_slot = (const int*)(c.ws + WS_TK) + 2 * R * 4;
    const int r_lo = layer == 0 ? 0 : C, stride = c.nwg * 8;
    int r = r_lo + c.wg * 8 + c.wave;
    int pe[4], ps[4]; float pg[4]; u32x2 wn[4][4]; f32x4 xn[4]; float gn[4];
#define CB_TK(row) do { _Pragma("unroll") for (int k = 0; k < 4; ++k) { pe[k] = tk_e[(row) * 4 + k]; ps[k] = tk_slot[(row) * 4 + k]; pg[k] = tk_g[(row) * 4 + k]; } } while (0)
#define CB_DATA(row) do { _Pragma("unroll") for (int k = 0; k < 4; ++k) { const bf16_t* src_ = outb + (size_t)(so[pe[k]] + ps[k]) * 1024; gn[k] = pg[k]; \
        _Pragma("unroll") for (int j = 0; j < 4; ++j) wn[k][j] = *(const u32x2*)(src_ + c.lane * 4 + 256 * j); } row_load(Xin + (size_t)(row) * D, c.lane, xn); } while (0)
    if (r < R) { CB_TK(r); CB_DATA(r); }
    if (r + stride < R) CB_TK(r + stride);
    for (; r < R; r += stride) {
        const float* m = c.modp(layer, r < C ? 1 : 0);
        f32x4 y[4], x[4];
#pragma unroll
        for (int j = 0; j < 4; ++j) { y[j] = (f32x4){0.f, 0.f, 0.f, 0.f}; x[j] = xn[j]; }
#pragma unroll
        for (int k = 0; k < 4; ++k)
#pragma unroll
            for (int j = 0; j < 4; ++j) { const u32x2 w = wn[k][j]; y[j] += (f32x4){bflo(w.x), bfhi(w.x), bflo(w.y), bfhi(w.y)} * gn[k]; }
        if (r + stride < R) CB_DATA(r + stride);
        if (r + 2 * stride < R) CB_TK(r + 2 * stride);
        const float rstd_y = rsqrtf(row_ss(y) * (1.f / D) + EPS);
#pragma unroll
        for (int j = 0; j < 4; ++j) {
            const int c0 = c.lane * 4 + 256 * j;
            const f32x4 g2 = *(const f32x4*)(m + 5120 + c0), n3 = *(const f32x4*)(ngl + 3 * D + c0);
            x[j].x += g2.x * (y[j].x * rstd_y * n3.x); x[j].y += g2.y * (y[j].y * rstd_y * n3.y);
            x[j].z += g2.z * (y[j].z * rstd_y * n3.z); x[j].w += g2.w * (y[j].w * rstd_y * n3.w);
            if (layer == 0) *(f32x4*)(X + (size_t)r * D + c0) = x[j];
            else *(f32x4*)(c.a->out + (size_t)(r - C) * D + c0) = x[j];
        }
        if (layer == 0) {
            const float rstd_x = rsqrtf(row_ss(x) * (1.f / D) + EPS);
            const float* m1 = c.modp(1, r < C ? 1 : 0);
            row_modnorm_store(x, rstd_x, c.a->in[6] + 4 * D, m1 + 0, m1 + 1024, H + (size_t)r * D, c.lane);
        }
    }
#undef CB_TK
#undef CB_DATA
}

namespace hg {
typedef _Float16 h2_t __attribute__((ext_vector_type(2)));
constexpr int TB = 272, PB = 144;
constexpr int TILE = 64 * TB;
constexpr int T_QD = 0, T_QC = TILE, T_KD = 2 * TILE, T_KE = 3 * TILE, T_KC = 4 * TILE, T_V0 = 5 * TILE, T_V1 = 6 * TILE;
constexpr int T_QL1 = 7 * TILE, T_KL1 = T_QL1 + 16 * TB, T_P = T_KL1 + 16 * TB, T_TOT = T_P + 64 * PB, T_CT = T_TOT + 4096, T_END = T_CT + 512;
static_assert(T_END <= LDS_BYTES - 64, "hgrn scan LDS map");
__device__ __forceinline__ int row_of(int dir, int p) { return p < C ? (dir ? C - 1 - p : p) : (dir ? C + (L - 1 - (p - C)) : p); }
__device__ __forceinline__ int seg_of(int ch) { return ch < 68 ? ch / 17 : 4 + (ch - 68) / 16; }
__device__ __forceinline__ bf16x8 tr_frag(const LAS unsigned char* tile, int row0, int col0, int lane) {
    const int q = (lane & 15) >> 2, p = lane & 3;
    const LAS unsigned char* a = tile + (row0 + q) * TB + (col0 + 4 * p) * 2;
    const v4i16_t lo = __builtin_amdgcn_ds_read_tr16_b64_v4i16((LAS v4i16_t*)a);
    const v4i16_t hi = __builtin_amdgcn_ds_read_tr16_b64_v4i16((LAS v4i16_t*)(a + 4 * TB));
    return (bf16x8){lo[0], lo[1], lo[2], lo[3], hi[0], hi[1], hi[2], hi[3]};
}
}

__device__ __forceinline__ void phase_hgrn_scan(const Ctx& c) {
    using namespace hg;
#define HG_BAR() asm volatile("s_waitcnt lgkmcnt(0)\n\ts_barrier" ::: "memory")
    const bf16_t* QH = (const bf16_t*)(c.ws + WS_QH); const bf16_t* IV = (const bf16_t*)(c.ws + WS_IV);
    LAS unsigned char* lds = c.lds;
    const int tid = c.tid, lane = c.lane, w = __builtin_amdgcn_readfirstlane(tid >> 6), fr = lane & 15, g = lane >> 4;
    for (int item_ = c.wg; item_ < 256 * SCAN_REP; item_ += c.nwg) {
        const int item = item_ & 255;
        const int chain = item >> 4, seg = item & 15, head = chain >> 1, dir = chain & 1, hc = head * 128;
        const int c0 = seg < 4 ? 17 * seg : 68 + 16 * (seg - 4), nch = seg < 4 ? 17 : 16;
        const _Float16* KX = (const _Float16*)(c.ws + (dir ? WS_KB : WS_KF));
        float* OL = (float*)(c.ws + (dir ? WS_OB : WS_OF)); bf16_t* QS = (bf16_t*)(c.ws + (dir ? WS_QSB : WS_QSF));
        HG_BAR();
        for (int i = tid; i < 64 * PB / 4; i += 512) ((LAS unsigned*)(lds + T_P))[i] = 0u;
        f32x4 Sacc[8];
#pragma unroll
        for (int m = 0; m < 8; ++m) Sacc[m] = (f32x4){0.f, 0.f, 0.f, 0.f};
        float dseg0 = 1.f, dseg1 = 1.f;
        unsigned kraw[8], qraw[8]; u32x4 vraw[2];
#define HG_LOAD(cidx) do { const int p0_ = 64 * (cidx); const bool lat_ = (cidx) >= 4; \
        _Pragma("unroll") for (int i = 0; i < 8; ++i) { const int r_ = row_of(dir, p0_ + 8 * w + i); \
            kraw[i] = *(const unsigned*)(KX + (size_t)r_ * D + hc + 2 * lane); \
            qraw[i] = lat_ ? *(const unsigned*)(QH + (size_t)(r_ - C) * D + hc + 2 * lane) : 0u; } \
        _Pragma("unroll") for (int i = 0; i < 2; ++i) { const int idx_ = tid + 512 * i; const int r_ = row_of(dir, p0_ + (idx_ >> 4)); \
            vraw[i] = *(const u32x4*)(IV + (size_t)r_ * D + hc + (idx_ & 15) * 8); } } while (0)
        HG_LOAD(c0);
        for (int ci = 0; ci < nch; ++ci) {
            const int cidx = c0 + ci; const bool lat = cidx >= 4;
            const int vbuf = (ci & 1) ? T_V1 : T_V0;
            float kf[8][2], qf[8][2], cp[8][2];
            {
                float p0 = 1.f, p1 = 1.f;
#pragma unroll
                for (int i = 0; i < 8; ++i) {
                    const h2_t hv = __builtin_bit_cast(h2_t, kraw[i]);
                    kf[i][0] = (float)hv[0]; kf[i][1] = (float)hv[1];
                    qf[i][0] = bflo(qraw[i]); qf[i][1] = bfhi(qraw[i]);
                    p0 *= (1.f - kf[i][0]); p1 *= (1.f - kf[i][1]); cp[i][0] = p0; cp[i][1] = p1;
                }
                *(LAS f32x2*)(lds + T_TOT + (w * 128 + 2 * lane) * 4) = (f32x2){p0, p1};
#pragma unroll
                for (int i = 0; i < 2; ++i) { const int idx = tid + 512 * i; *(LAS u32x4*)(lds + vbuf + (idx >> 4) * TB + (idx & 15) * 16) = vraw[i]; }
            }
            HG_BAR();
            {
                f32x2 T[8];
#pragma unroll
                for (int x = 0; x < 8; ++x) T[x] = *(const LAS f32x2*)(lds + T_TOT + (x * 128 + 2 * lane) * 4);
                const int I = w >> 1, hh = w & 1;
                f32x2 bd[4];
#pragma unroll
                for (int x = 0; x < 4; ++x) bd[x] = T[2 * x] * T[2 * x + 1];
                f32x2 pre = (f32x2){1.f, 1.f}, cum = (f32x2){1.f, 1.f}, suf = (f32x2){1.f, 1.f}, bdI = (f32x2){1.f, 1.f};
#pragma unroll
                for (int x = 0; x < 8; ++x) if (hh && x == w - 1) pre = T[x];
#pragma unroll
                for (int x = 0; x < 4; ++x) { if (x < I) cum = cum * bd[x]; if (x > I) suf = suf * bd[x]; if (x == I) bdI = bd[x]; }
                const f32x2 ctot = (bd[0] * bd[1]) * (bd[2] * bd[3]);
#pragma unroll
                for (int i = 0; i < 8; ++i) {
                    const int tau = 8 * w + i;
                    float QDv[2], KDv[2], KEv[2], QCv[2], KCv[2];
#pragma unroll
                    for (int x = 0; x < 2; ++x) {
                        const float eq = pre[x] * cp[i][x], rc = __builtin_amdgcn_rcpf(eq);
                        QDv[x] = qf[i][x] * eq; KDv[x] = kf[i][x] * rc; KEv[x] = KDv[x] * bdI[x]; QCv[x] = QDv[x] * cum[x]; KCv[x] = KEv[x] * suf[x];
                    }
                    const int to = tau * TB + lane * 4;
                    *(LAS unsigned*)(lds + T_QD + to) = pk2(QDv[0], QDv[1]);
                    *(LAS unsigned*)(lds + T_KD + to) = pk2(KDv[0], KDv[1]);
                    *(LAS unsigned*)(lds + T_KE + to) = pk2(KEv[0], KEv[1]);
                    *(LAS unsigned*)(lds + T_QC + to) = pk2(QCv[0], QCv[1]);
                    *(LAS unsigned*)(lds + T_KC + to) = pk2(KCv[0], KCv[1]);
                    if (I == 3) *(LAS unsigned*)(lds + T_QL1 + (tau - 48) * TB + lane * 4) = pk2(QDv[0] * bd[2][0], QDv[1] * bd[2][1]);
                    if (I == 0) *(LAS unsigned*)(lds + T_KL1 + tau * TB + lane * 4) = pk2(KEv[0] * bd[1][0], KEv[1] * bd[1][1]);
                    if (lat) { const int r = row_of(dir, 64 * cidx + tau); *(unsigned*)(QS + (size_t)(r - C) * D + hc + 2 * lane) = pk2(QCv[0] * dseg0, QCv[1] * dseg1); }
                }
                dseg0 *= ctot[0]; dseg1 *= ctot[1];
                if (w == 0) *(LAS f32x2*)(lds + T_CT + lane * 8) = ctot;
            }
            HG_BAR();
            if (ci + 1 < nch) HG_LOAD(cidx + 1);
            if (lat) {
                const int nblk = w >= 6 ? 2 : 1;
                for (int b = 0; b < nblk; ++b) {
                    int I, J, qoff, qrow, koff, krow; bool diag = false;
                    if (w < 4) { I = 2 + (w >> 1); J = w & 1; qoff = (w >> 1) ? T_QL1 : T_QD; qrow = (w >> 1) ? 0 : 32; koff = (w & 1) ? T_KE : T_KL1; krow = (w & 1) ? 16 : 0; }
                    else if (w == 4) { I = 1; J = 0; qoff = T_QD; qrow = 16; koff = T_KE; krow = 0; }
                    else if (w == 5) { I = 3; J = 2; qoff = T_QD; qrow = 48; koff = T_KE; krow = 32; }
                    else { I = 2 * (w - 6) + b; J = I; qoff = T_QD; qrow = 16 * I; koff = T_KD; krow = 16 * I; diag = true; }
                    f32x4 pa = (f32x4){0.f, 0.f, 0.f, 0.f};
#pragma unroll
                    for (int ks = 0; ks < 4; ++ks) {
                        const bf16x8 av = *(const LAS bf16x8*)(lds + qoff + (qrow + fr) * TB + (32 * ks + 8 * g) * 2);
                        const bf16x8 bv = *(const LAS bf16x8*)(lds + koff + (krow + fr) * TB + (32 * ks + 8 * g) * 2);
                        pa = __builtin_amdgcn_mfma_f32_16x16x32_bf16(av, bv, pa, 0, 0, 0);
                    }
#pragma unroll
                    for (int e = 0; e < 4; ++e) {
                        const int tl = 4 * g + e; const float val = (diag && fr > tl) ? 0.f : pa[e];
                        *(LAS bf16_t*)(lds + T_P + (16 * I + tl) * PB + (16 * J + fr) * 2) = (bf16_t)f2bf(val);
                    }
                }
            }
            f32x4 oacc[4];
#pragma unroll
            for (int m = 0; m < 4; ++m) oacc[m] = (f32x4){0.f, 0.f, 0.f, 0.f};
            if (lat) {
                bf16x8 Sb[4];
#pragma unroll
                for (int ks = 0; ks < 4; ++ks) {
                    const f32x4 a0 = Sacc[2 * ks], a1 = Sacc[2 * ks + 1];
                    const u32x4 pk = (u32x4){pk2(a0[0], a0[1]), pk2(a0[2], a0[3]), pk2(a1[0], a1[1]), pk2(a1[2], a1[3])};
                    Sb[ks] = __builtin_bit_cast(bf16x8, pk);
                }
#pragma unroll
                for (int m = 0; m < 4; ++m)
#pragma unroll
                    for (int ks = 0; ks < 4; ++ks) {
                        const u32x2 lo = *(const LAS u32x2*)(lds + T_QC + (16 * m + fr) * TB + (32 * ks + 4 * g) * 2);
                        const u32x2 hi = *(const LAS u32x2*)(lds + T_QC + (16 * m + fr) * TB + (32 * ks + 16 + 4 * g) * 2);
                        const u32x4 pk = (u32x4){lo.x, lo.y, hi.x, hi.y};
                        oacc[m] = __builtin_amdgcn_mfma_f32_16x16x32_bf16(__builtin_bit_cast(bf16x8, pk), Sb[ks], oacc[m], 0, 0, 0);
                    }
            }
#pragma unroll
            for (int m = 0; m < 8; ++m) { const f32x4 ct = *(const LAS f32x4*)(lds + T_CT + (16 * m + 4 * g) * 4); Sacc[m] = Sacc[m] * ct; }
            bf16x8 Vf[2];
#pragma unroll
            for (int ks = 0; ks < 2; ++ks) Vf[ks] = tr_frag(lds + vbuf, 32 * ks + 8 * g, 16 * w, lane);
#pragma unroll
            for (int m = 0; m < 8; ++m)
#pragma unroll
                for (int ks = 0; ks < 2; ++ks) Sacc[m] = __builtin_amdgcn_mfma_f32_16x16x32_bf16(tr_frag(lds + T_KC, 32 * ks + 8 * g, 16 * m, lane), Vf[ks], Sacc[m], 0, 0, 0);
            HG_BAR();
            if (lat) {
#pragma unroll
                for (int m = 0; m < 4; ++m)
#pragma unroll
                    for (int ks = 0; ks < 2; ++ks) {
                        if (m < 2 && ks == 1) continue;
                        const bf16x8 av = *(const LAS bf16x8*)(lds + T_P + (16 * m + fr) * PB + (32 * ks + 8 * g) * 2);
                        oacc[m] = __builtin_amdgcn_mfma_f32_16x16x32_bf16(av, Vf[ks], oacc[m], 0, 0, 0);
                    }
#pragma unroll
                for (int m = 0; m < 4; ++m)
#pragma unroll
                    for (int e = 0; e < 4; ++e) { const int r = row_of(dir, 64 * cidx + 16 * m + 4 * g + e); OL[(size_t)(r - C) * D + hc + 16 * w + fr] = oacc[m][e]; }
            }
        }
#undef HG_LOAD
        float* DS = (float*)(c.ws + WS_DS) + (size_t)item * 16384; float* DG = (float*)(c.ws + WS_DG) + item * 128;
#pragma unroll
        for (int m = 0; m < 8; ++m)
#pragma unroll
            for (int e = 0; e < 4; ++e) DS[(16 * m + 4 * g + e) * 128 + 16 * w + fr] = Sacc[m][e];
        if (w == 0) { DG[2 * lane] = dseg0; DG[2 * lane + 1] = dseg1; }
    }
}

#undef HG_BAR
__device__ __forceinline__ void phase_hgrn_fold(const Ctx& c) {
    const float* DS = (const float*)(c.ws + WS_DS); const float* DG = (const float*)(c.ws + WS_DG); bf16_t* SST = (bf16_t*)(c.ws + WS_SST);
    for (int item = c.wg; item < 256; item += c.nwg) {
        const int chain = item >> 4, slice = item & 15, d = 8 * slice + (c.tid >> 6), v2 = (c.tid & 63) * 2;
        float s0 = 0.f, s1 = 0.f;
        float dv[15]; f32x2 ds[15];
#pragma unroll
        for (int sgi = 0; sgi < 15; ++sgi) { dv[sgi] = DG[(chain * 16 + sgi) * 128 + d]; ds[sgi] = *(const f32x2*)(DS + ((size_t)(chain * 16 + sgi) * 128 + d) * 128 + v2); }
        SST[((size_t)(chain * 16) * 128 + v2) * 128 + d] = 0; SST[((size_t)(chain * 16) * 128 + v2 + 1) * 128 + d] = 0;
#pragma unroll
        for (int sgi = 0; sgi < 15; ++sgi) {
            s0 = dv[sgi] * s0 + ds[sgi][0]; s1 = dv[sgi] * s1 + ds[sgi][1];
            SST[((size_t)(chain * 16 + sgi + 1) * 128 + v2) * 128 + d] = (bf16_t)f2bf(s0); SST[((size_t)(chain * 16 + sgi + 1) * 128 + v2 + 1) * 128 + d] = (bf16_t)f2bf(s1);
        }
    }
}

__device__ __forceinline__ void phase_hgrn_readout(const Ctx& c) {
    constexpr int SP = 272, SBUF = 128 * SP, IBUF = 2 * SBUF;
    static_assert(2 * IBUF + 1024 <= LDS_BYTES - 64, "readout LDS map");
    const float* OF = (const float*)(c.ws + WS_OF); const float* OB = (const float*)(c.ws + WS_OB); const bf16_t* SGp = (const bf16_t*)(c.ws + WS_SG);
    const bf16_t* SST = (const bf16_t*)(c.ws + WS_SST); bf16_t* RR = (bf16_t*)(c.ws + WS_RR); const float* hng = c.a->in[13];
    LAS unsigned char* lds = c.lds; LAS float* ssx = (LAS float*)(c.lds + 2 * IBUF);
    const int tid = c.tid, lane = c.lane, w = __builtin_amdgcn_readfirstlane(tid >> 6), fr = lane & 15, g = lane >> 4, mt = w & 3, nh = w >> 2;
#define RO_BAR() asm volatile("s_waitcnt lgkmcnt(0)\n\ts_barrier" ::: "memory")
    u32x4 sreg[8];
#define RO_SST_LOAD(it) do { const int h_ = (it) >> 8, ch_ = (it) & 255; \
        _Pragma("unroll") for (int j = 0; j < 8; ++j) { const int idx_ = tid + 512 * j, dx_ = idx_ >> 11, rem_ = idx_ & 2047; \
            const int sg_ = hg::seg_of(dx_ ? 4 + 255 - ch_ : 4 + ch_); \
            sreg[j] = *(const u32x4*)(SST + ((size_t)((h_ * 2 + dx_) * 16 + sg_) * 128 + (rem_ >> 4)) * 128 + (rem_ & 15) * 8); } } while (0)
#define RO_SST_WRITE(buf) do { _Pragma("unroll") for (int j = 0; j < 8; ++j) { const int idx_ = tid + 512 * j, dx_ = idx_ >> 11, rem_ = idx_ & 2047; \
            *(LAS u32x4*)(lds + (buf) * IBUF + dx_ * SBUF + (rem_ >> 4) * SP + (rem_ & 15) * 16) = sreg[j]; } } while (0)
    int it = c.wg;
    RO_BAR();
    if (it < 2048) { RO_SST_LOAD(it); RO_SST_WRITE(0); }
    RO_BAR();
    for (int k = 0; it < 2048; it += c.nwg, ++k) {
        const int h = it >> 8, ch = it & 255, t0 = 64 * ch + 16 * mt, buf = k & 1;
        const bool has_next = it + c.nwg < 2048;
        if (has_next) RO_SST_LOAD(it + c.nwg);
        f32x4 acc[4]; float sgv[4][4];
#pragma unroll
        for (int n = 0; n < 4; ++n)
#pragma unroll
            for (int e = 0; e < 4; ++e) { const size_t o = (size_t)(t0 + 4 * g + e) * D + h * 128 + 64 * nh + 16 * n + fr; acc[n][e] = OF[o] + OB[o]; sgv[n][e] = bf2f(SGp[o]) * hng[h * 128 + 64 * nh + 16 * n + fr]; }
#pragma unroll
        for (int dx = 0; dx < 2; ++dx) {
            const bf16_t* QS = (const bf16_t*)(c.ws + (dx ? WS_QSB : WS_QSF)) + (size_t)(t0 + fr) * D + h * 128 + 8 * g;
            const LAS unsigned char* sb = lds + buf * IBUF + dx * SBUF + (64 * nh + fr) * SP + 16 * g;
#pragma unroll
            for (int ks = 0; ks < 4; ++ks) {
                const bf16x8 av = *(const bf16x8*)(QS + 32 * ks);
#pragma unroll
                for (int n = 0; n < 4; ++n) acc[n] = __builtin_amdgcn_mfma_f32_16x16x32_bf16(av, *(const LAS bf16x8*)(sb + (16 * n) * SP + 64 * ks), acc[n], 0, 0, 0);
            }
        }
        float ss[4] = {0.f, 0.f, 0.f, 0.f};
#pragma unroll
        for (int n = 0; n < 4; ++n)
#pragma unroll
            for (int e = 0; e < 4; ++e) ss[e] += acc[n][e] * acc[n][e];
#pragma unroll
        for (int e = 0; e < 4; ++e) {
#pragma unroll
            for (int sh = 8; sh > 0; sh >>= 1) ss[e] += __shfl_xor(ss[e], sh);
        }
        if (fr == 0) *(LAS f32x4*)(ssx + ((k & 1) * 8 + w) * 16 + 4 * g) = (f32x4){ss[0], ss[1], ss[2], ss[3]};
        if (has_next) RO_SST_WRITE(buf ^ 1);
        RO_BAR();
        const f32x4 ps = *(const LAS f32x4*)(ssx + ((k & 1) * 8 + (w ^ 4)) * 16 + 4 * g);
#pragma unroll
        for (int e = 0; e < 4; ++e) ss[e] = rsqrtf((ss[e] + ps[e]) * (1.f / 128.f) + EPS);
#pragma unroll
        for (int n = 0; n < 4; ++n)
#pragma unroll
            for (int e = 0; e < 4; ++e) { const size_t o = (size_t)(t0 + 4 * g + e) * D + h * 128 + 64 * nh + 16 * n + fr; RR[o] = (bf16_t)f2bf(acc[n][e] * ss[e] * sgv[n][e]); }
    }
    RO_BAR();
#undef RO_BAR
#undef RO_SST_LOAD
#undef RO_SST_WRITE
}

#define XB_TMO      128
#define XB_XCNT(j)  (256  + 64 * (j))
#define XB_XSUB(j)  (1280 + 64 * (j))
#define XB_XGEN(j)  (2304 + 64 * (j))
#define XB_TOP      3328
#define XB_TOPGEN   3392
#define XCD_BAR_WORDS 3456
#define XB_SPIN_CAP (1u << 18)
__device__ __forceinline__ unsigned xb_ld(unsigned* p)              { return __hip_atomic_load(p, __ATOMIC_RELAXED, __HIP_MEMORY_SCOPE_AGENT); }
__device__ __forceinline__ unsigned xb_add(unsigned* p, unsigned v) { return __hip_atomic_fetch_add(p, v, __ATOMIC_RELAXED, __HIP_MEMORY_SCOPE_AGENT); }
__device__ __forceinline__ unsigned xb_xcc_id() { return (unsigned)__builtin_amdgcn_s_getreg((3 << 11) | 20) & 0xFu; }
#define XB_SPIN(cond, bar) do { unsigned _sp = 0; while (cond) { __builtin_amdgcn_s_sleep(1); \
    if ((++_sp & 255u) == 0u) { if (xb_ld(&(bar)[XB_TMO])) break; if (_sp > XB_SPIN_CAP) { atomicAdd(&(bar)[XB_TMO], 1u); break; } } } } while (0)
struct XcdBarrier { unsigned* bar; unsigned x; volatile LAS unsigned* st; };
__device__ __forceinline__ XcdBarrier xcd_barrier_post(unsigned* bar, volatile LAS unsigned* st) {
    XcdBarrier b; b.bar = bar; b.x = xb_xcc_id(); b.st = st;
    if (threadIdx.x == 0) (void)xb_add(&bar[XB_XCNT(b.x)], 1u);
    return b;
}
__device__ __forceinline__ void xcd_barrier_complete(unsigned* bar, unsigned x, unsigned& nloc, unsigned& nx) {
    const unsigned G = gridDim.x * gridDim.y * gridDim.z;
    unsigned sum, cnt, mine, sp = 0u;
    for (;;) {
        sum = 0u; cnt = 0u; mine = 0u;
#pragma unroll
        for (unsigned j = 0; j < 16; ++j) { const unsigned c = xb_ld(&bar[XB_XCNT(j)]); sum += c; cnt += (c > 0u) ? 1u : 0u; mine = (j == x) ? c : mine; }
        if (sum == G) break;
        __builtin_amdgcn_s_sleep(1);
        if ((++sp & 255u) == 0u) { if (xb_ld(&bar[XB_TMO])) break; if (sp > XB_SPIN_CAP) { atomicAdd(&bar[XB_TMO], 1u); break; } }
    }
    nloc = mine > 0u ? mine : 1u; nx = cnt > 0u ? cnt : 1u;
}
__device__ __forceinline__ void xcd_barrier(const XcdBarrier& b) {
    asm volatile("s_waitcnt vmcnt(0)" ::: "memory");
    __syncthreads();
    if (threadIdx.x == 0) {
        unsigned* bar = b.bar;
        __builtin_amdgcn_s_waitcnt(0);
        unsigned nloc = b.st[0], nx = b.st[1];
        if (nloc == 0u) { xcd_barrier_complete(bar, b.x, nloc, nx); b.st[0] = nloc; b.st[1] = nx; }
        const unsigned old = xb_add(&bar[XB_XSUB(b.x)], 1u);
        const unsigned gen = old / nloc;
        if (old + 1u == (gen + 1u) * nloc) {
            __builtin_amdgcn_fence(__ATOMIC_RELEASE, "agent");
            asm volatile("s_waitcnt vmcnt(0)" ::: "memory");
            const unsigned og = xb_add(&bar[XB_TOP], 1u);
            const unsigned tg = og / nx;
            if (og + 1u == (tg + 1u) * nx) xb_add(&bar[XB_TOPGEN], 1u);
            else XB_SPIN(xb_ld(&bar[XB_TOPGEN]) == tg, bar);
            __builtin_amdgcn_fence(__ATOMIC_ACQUIRE, "agent");
            xb_add(&bar[XB_XGEN(b.x)], 1u);
            asm volatile("s_waitcnt vmcnt(0)" ::: "memory");
        } else {
            XB_SPIN(xb_ld(&bar[XB_XGEN(b.x)]) == gen, bar);
            __builtin_amdgcn_fence(__ATOMIC_ACQUIRE, "agent");
            asm volatile("s_waitcnt vmcnt(0)" ::: "memory");
        }
    }
    __syncthreads();
}

__device__ __forceinline__ void launder(Ctx& c) { asm volatile("" : "+s"(c.a)); asm volatile("" : "+s"(c.ws)); asm volatile("" : "+s"(c.wave));
    c.lane = (int)__builtin_amdgcn_mbcnt_hi(~0u, __builtin_amdgcn_mbcnt_lo(~0u, 0u)); c.tid = c.wave * 64 + c.lane; }
__global__ void __launch_bounds__(512, 2) mk_fwd(Args args) {
    extern __shared__ __attribute__((aligned(16))) unsigned char lds_raw[];
    Ctx c; c.a = (CArgs)__builtin_amdgcn_kernarg_segment_ptr(); c.lds = (LAS unsigned char*)lds_raw; c.tid = threadIdx.x; c.lane = c.tid & 63; c.wave = __builtin_amdgcn_readfirstlane(c.tid >> 6); c.nwg = gridDim.x; c.wg = blockIdx.x; c.ws = c.a->ws;
    volatile LAS unsigned* bst = (volatile LAS unsigned*)(c.lds + LDS_BYTES - 64);
    if (c.tid < 4) bst[c.tid] = 0u;
    __syncthreads();
    const XcdBarrier bar = xcd_barrier_post((unsigned*)(c.ws + WS_CTL) + CW_BAR, bst);
    const int lo = c.a->ph_lo, hi = c.a->ph_hi;
    bool route_ok = true;
#define SEAM(k) do { if (lo <= (k) && (k) + 1 < hi) xcd_barrier(bar); } while (0)
#define IN(k) (lo <= (k) && (k) < hi && (launder(c), true))
#define PH(k, call) do { if (IN(k)) { if (PROBE_PH == (k)) { int nrep_ = 3; asm volatile("" : "+s"(nrep_)); for (int rep_ = 0; rep_ < nrep_; ++rep_) { route_ok = (rep_ + 1 == nrep_); call; if (rep_ + 1 < nrep_) xcd_barrier(bar); } } else { call; } } SEAM(k); } while (0)
    PH(0, phase_prep(c));
    PH(1, phase_convert(c));
    PH(2, phase_gemm_qkv(c));
    PH(3, phase_attn(c));
    PH(4, phase_gemm_f32(c, (const bf16_t*)(c.ws + WS_O), R, (const bf16_t*)(c.ws + WS_WO), D, nullptr, (float*)(c.ws + WS_RAW1)));
    PH(5, phase_postmix(c, 0, route_ok));
    PH(6, phase_moe_gu(c, 0));
    PH(7, phase_moe_dn(c, 0));
    PH(8, phase_combine(c, 0));
    PH(9, phase_gemm_inproj(c));
    PH(10, phase_hgrn_scan(c));
    PH(11, phase_hgrn_fold(c));
    PH(12, phase_hgrn_readout(c));
    PH(13, phase_gemm_f32(c, (const bf16_t*)(c.ws + WS_RR), L, (const bf16_t*)(c.ws + WS_WHO), D, nullptr, (float*)(c.ws + WS_RAW1)));
    PH(14, phase_postmix(c, 1, route_ok));
    PH(15, phase_moe_gu(c, 1));
    PH(16, phase_moe_dn(c, 1));
    PH(17, phase_combine(c, 1));
#undef IN
#undef PH
#undef SEAM
}

extern "C" void kernel_launch(void* const* d_in, const int* in_sizes, int n_in, void* d_out, int out_size, void* d_ws, size_t ws_size, hipStream_t stream) {
    static int grid = 0;
    if (grid == 0) {
        if (n_in != 21 || out_size != L * D || ws_size < WS_END) { fprintf(stderr, "kernel_launch: unexpected problem (n_in %d out %d ws %zu need %zu)\n", n_in, out_size, ws_size, (size_t)WS_END); grid = -1; return; }
        int dev = 0, cus = 0, per_cu = 0;
        hipGetDevice(&dev); hipDeviceGetAttribute(&cus, hipDeviceAttributeMultiprocessorCount, dev);
        if (hipFuncSetAttribute((const void*)mk_fwd, hipFuncAttributeMaxDynamicSharedMemorySize, LDS_BYTES) != hipSuccess) { fprintf(stderr, "kernel_launch: hipFuncSetAttribute failed\n"); grid = -1; return; }
        hipOccupancyMaxActiveBlocksPerMultiprocessor(&per_cu, (const void*)mk_fwd, 512, LDS_BYTES);
        if (per_cu < 1) fprintf(stderr, "kernel_launch: occupancy query says %d\n", per_cu);
        (void)hipGetLastError();
        grid = cus > 0 ? cus : 256;
    }
    if (grid < 0) return;
    hipMemsetAsync((char*)d_ws + WS_CTL, 0, MiB, stream);
    Args a{};
    for (int i = 0; i < 21; ++i) a.in[i] = (const float*)d_in[i];
    a.out = (float*)d_out; a.ws = (unsigned char*)d_ws;
    a.ph_lo = 0; a.ph_hi = NPHASE;
    hipLaunchKernelGGL(mk_fwd, dim3(grid), dim3(512), LDS_BYTES, stream, a);
}
```

```cpp
#include <hip/hip_runtime.h>
#include <cstdint>
#include <cstdio>

#define LAS __attribute__((address_space(3)))
typedef unsigned short bf16_t;
typedef short bf16x8 __attribute__((ext_vector_type(8)));
typedef float f32x4 __attribute__((ext_vector_type(4)));
typedef unsigned u32x4 __attribute__((ext_vector_type(4)));
typedef unsigned u32x2 __attribute__((ext_vector_type(2)));
typedef short v4i16_t __attribute__((ext_vector_type(4)));
typedef float f32x2 __attribute__((ext_vector_type(2)));

constexpr int D = 1024, L = 16384, C = 256, R = L + C;
constexpr int QKVD = 1280, HIN = 5120, NE = 32, TOPK = 4;
constexpr int PADM = 256, MAXROWS = 74752;
constexpr float EPS = 1e-6f;
constexpr float LOG2E = 1.4426950408889634f;
constexpr int NPHASE = 18;
#ifndef GEMM_REP
#define GEMM_REP 1
#endif
#ifndef PROBE_NOEPI
#define PROBE_NOEPI 0
#endif
#ifndef PROBE_SHORTK
#define PROBE_SHORTK 0
#endif
#ifndef SCAN_REP
#define SCAN_REP 1
#endif
#ifndef PROBE_PH
#define PROBE_PH (-1)
#endif
constexpr int LDS_BYTES = 147456;

constexpr size_t MiB = 1u << 20;
constexpr size_t al(size_t x) { return (x + MiB - 1) / MiB * MiB; }
constexpr size_t WS_CTL = 0;
constexpr size_t WS_MOD = WS_CTL + MiB;
constexpr size_t WS_X = WS_MOD + MiB;
constexpr size_t WS_H = WS_X + al((size_t)R * D * 4);
constexpr size_t WS_Q = WS_H + al((size_t)R * D * 2);
constexpr size_t WS_K = WS_Q + al((size_t)R * D * 2);
constexpr size_t WS_V = WS_K + al((size_t)R * 128 * 2);
constexpr size_t WS_O = WS_V + al((size_t)R * 128 * 2);
constexpr size_t WS_TK = WS_O + al((size_t)R * D * 2);
constexpr size_t WS_LIST = WS_TK + MiB;
constexpr size_t WS_HDN = WS_LIST + 3 * MiB;
constexpr size_t WS_RAW1 = WS_HDN + al((size_t)MAXROWS * 1024 * 2);
constexpr size_t WS_X1 = WS_RAW1 + al((size_t)R * D * 4);
constexpr size_t WS_OUTB = WS_X1 + al((size_t)R * D * 4);
constexpr size_t WS_QH = WS_OUTB + al((size_t)MAXROWS * 1024 * 2);
constexpr size_t WS_KF = WS_QH + al((size_t)L * D * 2);
constexpr size_t WS_KB = WS_KF + al((size_t)R * D * 2);
constexpr size_t WS_IV = WS_KB + al((size_t)R * D * 2);
constexpr size_t WS_SG = WS_IV + al((size_t)R * D * 2);
constexpr size_t WS_OF = WS_SG + al((size_t)L * D * 2);
constexpr size_t WS_OB = WS_OF + al((size_t)L * D * 4);
constexpr size_t WS_RR = WS_OB + al((size_t)L * D * 4);
constexpr size_t WS_WQKV = WS_RR + al((size_t)L * D * 2);
constexpr size_t WS_WO = WS_WQKV + al((size_t)QKVD * D * 2);
constexpr size_t WS_WIN = WS_WO + al((size_t)D * D * 2);
constexpr size_t WS_WHO = WS_WIN + al((size_t)HIN * D * 2);
constexpr size_t WS_WGU = WS_WHO + al((size_t)D * D * 2);
constexpr size_t WS_WDN = WS_WGU + al((size_t)2 * NE * 2048 * D * 2);
constexpr size_t WS_QSF = WS_WDN + al((size_t)2 * NE * 1024 * D * 2);
constexpr size_t WS_QSB = WS_QSF + al((size_t)L * D * 2);
constexpr size_t WS_DS = WS_QSB + al((size_t)L * D * 2);
constexpr size_t WS_DG = WS_DS + al((size_t)256 * 128 * 128 * 4);
constexpr size_t WS_SST = WS_DG + MiB;
constexpr size_t WS_H8 = WS_SST + al((size_t)256 * 128 * 128 * 2);
constexpr size_t WS_END = WS_H8 + al((size_t)R * D);
static_assert(WS_END <= (size_t)2048 * MiB, "workspace map exceeds 4x the largest input");
constexpr int CW_CNT = 1024;
constexpr int CW_BAR = 4096;
constexpr int MOD_ROPE = 32768;
constexpr int MOD_LB = 49152;

struct Args { const float* in[21]; float* out; unsigned char* ws; int ph_lo, ph_hi; };

__device__ __forceinline__ unsigned f2bf(float f) { unsigned u = __float_as_uint(f); return (u + 0x7fffu + ((u >> 16) & 1u)) >> 16; }
typedef float f32x2_t __attribute__((ext_vector_type(2))); typedef __bf16 bf16x2_t __attribute__((ext_vector_type(2)));
__device__ __forceinline__ unsigned pk2(float lo, float hi) { f32x2_t v = {lo, hi}; bf16x2_t b = __builtin_convertvector(v, bf16x2_t); return __builtin_bit_cast(unsigned, b); }
__device__ __forceinline__ unsigned pk4_fp8(float a, float b, float c, float d) {
    a = fminf(fmaxf(a, -448.f), 448.f); b = fminf(fmaxf(b, -448.f), 448.f); c = fminf(fmaxf(c, -448.f), 448.f); d = fminf(fmaxf(d, -448.f), 448.f);
    int v = __builtin_amdgcn_cvt_pk_fp8_f32(a, b, 0, false); v = __builtin_amdgcn_cvt_pk_fp8_f32(c, d, v, true); return (unsigned)v; }
constexpr float F8_SH = 8.f, F8_SW = 64.f, F8_SHD = 4.f;
__device__ __forceinline__ float bflo(unsigned u) { return __uint_as_float(u << 16); }
__device__ __forceinline__ float bfhi(unsigned u) { return __uint_as_float(u & 0xffff0000u); }
__device__ __forceinline__ float bf2f(bf16_t b) { return __uint_as_float(((unsigned)b) << 16); }
__device__ __forceinline__ float wave_sum(float v) {
#pragma unroll
    for (int o = 32; o > 0; o >>= 1) v += __shfl_xor(v, o);
    return v;
}
__device__ __forceinline__ float silu_f(float x) { return x / (1.f + __expf(-x)); }
__device__ __forceinline__ float sigmoid_f(float x) { return 1.f / (1.f + __expf(-x)); }

typedef const __attribute__((address_space(4))) Args* CArgs;
struct Ctx {
    CArgs a;
    LAS unsigned char* lds;
    int tid, lane, wave, nwg, wg;
    unsigned char* ws;
    __device__ __forceinline__ float* modp(int layer, int which) const { return (float*)(ws + WS_MOD) + (layer * 2 + which) * 6144; }
    __device__ __forceinline__ const float* xin0(int r) const { return r < C ? a->in[2] + (size_t)r * D : a->in[0] + (size_t)(r - C) * D; }
};


namespace pg8 {
constexpr int BM = 256, BK = 64, HALF = 128, HTB = HALF * BK * 2, STAGE_BYTES = 8 * HTB, KD = 1024, NXCD = 8, WGM = 8;
__device__ __forceinline__ int lds_byte(int r, int c) { const int st = (r >> 4) * 2 + (c >> 5), rr = r & 15, cc = c & 31, ob = rr * 64 + cc * 2; return st * 1024 + (ob ^ (((ob >> 9) & 1) << 5)); }
__device__ __forceinline__ void stage_rc(int b, int& Rr, int& Cc) { const int st = b / 1024, sb = b % 1024, swz = sb ^ (((sb >> 9) & 1) << 5); Rr = (st >> 1) * 16 + swz / 64; Cc = (st & 1) * 32 + (swz % 64) / 2; }
__device__ __forceinline__ int perm32(int rho) { const int n = rho >> 4, i = rho & 15; return 8 * (i >> 2) + 4 * n + (i & 3); }

struct Unit { int pm, pn, e, goff, gcnt; bool real; };
struct Gemm { const void* A; const void* Bt; size_t bstride; const int* list; };

struct StaticOrder {
    int nM, nN, nwg, G, c;
    __device__ __forceinline__ void init(int M, int N, int G_, int c_) { nM = M / BM; nN = N / BM; nwg = nM * nN; G = G_; c = c_; }
    __device__ __forceinline__ bool next(int i, Unit& u) const {
        const long Lq = (long)i * G + c; if (Lq >= nwg) return false;
        int wgid = (int)Lq; { const int q = nwg / NXCD, r = nwg % NXCD, xcd = wgid % NXCD, off = wgid / NXCD; wgid = (xcd < r ? xcd * (q + 1) : r * (q + 1) + (xcd - r) * q) + off; }
        const int nig = WGM * nN, gid = wgid / nig, fm = gid * WGM, gsz = (nM - fm) < WGM ? (nM - fm) : WGM;
        u.pm = fm + ((wgid % nig) % gsz); u.pn = (wgid % nig) / gsz; u.e = 0; u.goff = 0; u.gcnt = 0; u.real = true; return true;
    }
};
struct MoeOrder {
    const LAS int* tp; const LAS int* cnt; int npn, G, vcu;
    __device__ __forceinline__ bool next(int i, Unit& u) const {
        const int tot = tp[32] * npn; const int lin0 = i * G + vcu; if (lin0 >= tot * GEMM_REP) return false;
        const int lin = lin0 % tot; u.real = lin0 >= tot * (GEMM_REP - 1);
        const int rt = lin / npn; int e = 0;
#pragma unroll 8
        for (int k = 1; k < 32; ++k) e += (rt >= tp[k]) ? 1 : 0;
        const int mt = rt - tp[e];
        u.pm = rt; u.pn = lin - rt * npn; u.e = e; u.goff = e * R + mt * 256; u.gcnt = cnt[e] - mt * 256; return true;
    }
};

template <int KB>
__device__ __forceinline__ void a_offsets(const Gemm& g, const Unit& u, const int (&sR)[2], const int (&sC)[2], unsigned (&v)[2][2]) {
#pragma unroll
    for (int h = 0; h < 2; ++h)
#pragma unroll
        for (int i = 0; i < 2; ++i) {
            const int rr = h * HALF + sR[i]; int row;
            if (g.list) row = rr < u.gcnt ? g.list[u.goff + rr] : 0; else row = u.pm * BM + rr;
            v[h][i] = (unsigned)(row * KB + sC[i] * 2);
        }
}

struct EpiF32 {
    static constexpr bool PERM = false;
    float* Cp; int ldc; const float* bias;
    __device__ __forceinline__ void operator()(const f32x4 (&acc)[2][2][4][2], const Unit& u, int wr, int wc, int fr, int fq) const {
        const int row0 = u.pm * BM + wr * 64 + fr, col0 = u.pn * BM + wc * 32 + 4 * fq;
#pragma unroll
        for (int bj = 0; bj < 2; ++bj)
#pragma unroll
            for (int n = 0; n < 2; ++n) {
                const int col = col0 + bj * HALF + n * 16;
                const f32x4 bv = bias ? *(const f32x4*)(bias + col) : (f32x4){0.f, 0.f, 0.f, 0.f};
#pragma unroll
                for (int ai = 0; ai < 2; ++ai)
#pragma unroll
                    for (int m = 0; m < 4; ++m) *(f32x4*)(Cp + (size_t)(row0 + ai * HALF + m * 16) * ldc + col) = acc[ai][bj][m][n] + bv;
            }
    }
};
struct EpiSwiglu {
    static constexpr bool PERM = true;
    unsigned char* Hd; const float* bgu;
    __device__ __forceinline__ void operator()(const f32x4 (&acc)[2][2][4][2], const Unit& u, int wr, int wc, int fr, int fq) const {
        const int row0 = u.pm * BM + wr * 64 + fr, cg0 = u.pn * HALF + wc * 32 + 8 * fq;
        const float* bb = bgu + (size_t)u.e * 2048;
        f32x4 bg[2], bu[2];
#pragma unroll
        for (int n = 0; n < 2; ++n) { bg[n] = *(const f32x4*)(bb + cg0 + 4 * n); bu[n] = *(const f32x4*)(bb + 1024 + cg0 + 4 * n); }
#pragma unroll
        for (int ai = 0; ai < 2; ++ai)
#pragma unroll
            for (int m = 0; m < 4; ++m) {
                u32x2 o;
#pragma unroll
                for (int n = 0; n < 2; ++n) {
                    const f32x4 gv = acc[ai][0][m][n] * (1.f / (F8_SH * F8_SW)) + bg[n], uv = acc[ai][1][m][n] * (1.f / (F8_SH * F8_SW)) + bu[n]; float hv[4];
#pragma unroll
                    for (int q = 0; q < 4; ++q) { const float gg = fminf(gv[q], 7.f), uu = fminf(fmaxf(uv[q], -7.f), 7.f); hv[q] = gg * (1.f / (1.f + __expf(-1.702f * gg))) * (uu + 1.f); }
                    o[n] = pk4_fp8(hv[0] * F8_SHD, hv[1] * F8_SHD, hv[2] * F8_SHD, hv[3] * F8_SHD);
                }
                *(u32x2*)(Hd + (size_t)(row0 + ai * HALF + m * 16) * 1024 + cg0) = o;
            }
    }
};
struct EpiBf16Bias {
    static constexpr bool PERM = true;
    bf16_t* Op; const float* bias; int bias_estride; float scale;
    __device__ __forceinline__ void operator()(const f32x4 (&acc)[2][2][4][2], const Unit& u, int wr, int wc, int fr, int fq) const {
        const int row0 = u.pm * BM + wr * 64 + fr, col0 = u.pn * BM + wc * 32 + 8 * fq;
        const float* bb = bias + (size_t)u.e * bias_estride;
#pragma unroll
        for (int bj = 0; bj < 2; ++bj) {
            const int col = col0 + bj * HALF;
            const f32x4 b0 = *(const f32x4*)(bb + col), b1 = *(const f32x4*)(bb + col + 4);
#pragma unroll
            for (int ai = 0; ai < 2; ++ai)
#pragma unroll
                for (int m = 0; m < 4; ++m) { const f32x4 v0 = acc[ai][bj][m][0] * scale + b0, v1 = acc[ai][bj][m][1] * scale + b1;
                    u32x4 o; o.x = pk2(v0[0], v0[1]); o.y = pk2(v0[2], v0[3]); o.z = pk2(v1[0], v1[1]); o.w = pk2(v1[2], v1[3]);
                    *(u32x4*)(Op + (size_t)(row0 + ai * HALF + m * 16) * 1024 + col) = o; }
        }
    }
};
struct EpiQKV {
    static constexpr bool PERM = false;
    bf16_t* Qp; bf16_t* Kp; bf16_t* Vp; const float* bias; const float* tab;
    __device__ __forceinline__ void operator()(const f32x4 (&acc)[2][2][4][2], const Unit& u, int wr, int wc, int fr, int fq) const {
        const bool lat = u.pm > 0; const float qs = 0.125f * LOG2E;
#pragma unroll
        for (int bj = 0; bj < 2; ++bj) {
            const int colt = u.pn * BM + bj * HALF + wc * 32 + 4 * fq;
            const f32x4 b1 = *(const f32x4*)(bias + colt), b2 = *(const f32x4*)(bias + colt + 16);
            const bool isv = (u.pn == 4) && (bj == 1);
#pragma unroll
            for (int ai = 0; ai < 2; ++ai)
#pragma unroll
                for (int m = 0; m < 4; ++m) {
                    const int r = u.pm * BM + ai * HALF + wr * 64 + m * 16 + fr, t = r - C;
                    f32x4 x1 = acc[ai][bj][m][0] + b1, x2 = acc[ai][bj][m][1] + b2;
                    if (lat && !isv) {
                        const int pos = (wc & 1) ? (t & 63) : (t >> 6);
                        const f32x4 t0 = *(const f32x4*)(tab + (pos * 16 + 4 * fq) * 2), t1 = *(const f32x4*)(tab + (pos * 16 + 4 * fq) * 2 + 4);
                        const float cs[4] = {t0[0], t0[2], t1[0], t1[2]}, sn[4] = {t0[1], t0[3], t1[1], t1[3]};
                        f32x4 o1, o2;
#pragma unroll
                        for (int e = 0; e < 4; ++e) { o1[e] = x1[e] * cs[e] - x2[e] * sn[e]; o2[e] = x2[e] * cs[e] + x1[e] * sn[e]; }
                        x1 = o1; x2 = o2;
                    }
                    u32x2 w1, w2;
                    if (u.pn < 4) {
                        w1.x = pk2(x1[0] * qs, x1[1] * qs); w1.y = pk2(x1[2] * qs, x1[3] * qs); w2.x = pk2(x2[0] * qs, x2[1] * qs); w2.y = pk2(x2[2] * qs, x2[3] * qs);
                        *(u32x2*)(Qp + (size_t)r * 1024 + colt) = w1; *(u32x2*)(Qp + (size_t)r * 1024 + colt + 16) = w2;
                    } else {
                        w1.x = pk2(x1[0], x1[1]); w1.y = pk2(x1[2], x1[3]); w2.x = pk2(x2[0], x2[1]); w2.y = pk2(x2[2], x2[3]);
                        bf16_t* dst = (bj == 0 ? Kp : Vp) + (size_t)r * 128 + wc * 32 + 4 * fq;
                        *(u32x2*)dst = w1; *(u32x2*)(dst + 16) = w2;
                    }
                }
        }
    }
};
struct EpiInProj {
    static constexpr bool PERM = true;
    bf16_t* QH; _Float16* KF; _Float16* KB; bf16_t* IV; bf16_t* SG; const float* lb;
    __device__ __forceinline__ void operator()(const f32x4 (&acc)[2][2][4][2], const Unit& u, int wr, int wc, int fr, int fq) const {
        const int seg = u.pn >> 2; const bool lat = u.pm > 0;
        if (!lat && (seg == 0 || seg == 4)) return;
        typedef _Float16 h8_t __attribute__((ext_vector_type(8)));
#pragma unroll
        for (int bj = 0; bj < 2; ++bj) {
            const int col = (u.pn & 3) * BM + bj * HALF + wc * 32 + 8 * fq;
            f32x4 lb0 = (f32x4){0.f, 0.f, 0.f, 0.f}, lb1 = lb0;
            if (seg == 1) { lb0 = *(const f32x4*)(lb + col); lb1 = *(const f32x4*)(lb + col + 4); } else if (seg == 2) { lb0 = *(const f32x4*)(lb + 1024 + col); lb1 = *(const f32x4*)(lb + 1024 + col + 4); }
#pragma unroll
            for (int ai = 0; ai < 2; ++ai)
#pragma unroll
                for (int m = 0; m < 4; ++m) {
                    const int r = u.pm * BM + ai * HALF + wr * 64 + m * 16 + fr; const f32x4 v0 = acc[ai][bj][m][0], v1 = acc[ai][bj][m][1];
                    if (seg == 1 || seg == 2) {
                        h8_t hv;
#pragma unroll
                        for (int e = 0; e < 4; ++e) { hv[e] = (_Float16)((1.f - lb0[e]) / (1.f + __expf(v0[e]))); hv[4 + e] = (_Float16)((1.f - lb1[e]) / (1.f + __expf(v1[e]))); }
                        *(h8_t*)((seg == 1 ? KF : KB) + (size_t)r * 1024 + col) = hv;
                    } else if (seg == 3) {
                        u32x4 o; o.x = pk2(v0[0], v0[1]); o.y = pk2(v0[2], v0[3]); o.z = pk2(v1[0], v1[1]); o.w = pk2(v1[2], v1[3]); *(u32x4*)(IV + (size_t)r * 1024 + col) = o;
                    } else {
                        float s0[4], s1[4];
#pragma unroll
                        for (int e = 0; e < 4; ++e) { s0[e] = v0[e] / (1.f + __expf(-v0[e])); s1[e] = v1[e] / (1.f + __expf(-v1[e])); }
                        u32x4 o; o.x = pk2(s0[0], s0[1]); o.y = pk2(s0[2], s0[3]); o.z = pk2(s1[0], s1[1]); o.w = pk2(s1[2], s1[3]); *(u32x4*)((seg == 0 ? QH : SG) + (size_t)(r - C) * 1024 + col) = o;
                    }
                }
        }
    }
};

typedef int v8i __attribute__((ext_vector_type(8)));
template <class Epi, class Sched, bool ALIGN_EPI, bool GATHER, bool FP8>
__device__ __forceinline__ void gemm_phase(LAS unsigned char* lds, const Gemm g, const Sched& S, const Epi& E, const int tid) {
    const int wid = __builtin_amdgcn_readfirstlane(tid >> 6), lane = tid & 63, wr = wid >> 2, wc = wid & 3, fr = lane & 15, fq = lane >> 4;
    constexpr int KB = FP8 ? 1024 : 2048, nt = 1024 / (FP8 ? 128 : 64);
    int sR[2], sC[2]; unsigned voffB[2], voffA[2];
#pragma unroll
    for (int i = 0; i < 2; ++i) { stage_rc(tid * 16 + i * 8192, sR[i], sC[i]); const int Rb = Epi::PERM ? ((sR[i] & ~31) + perm32(sR[i] & 31)) : sR[i]; voffB[i] = (unsigned)(Rb * KB + sC[i] * 2); voffA[i] = (unsigned)(sR[i] * KB + sC[i] * 2); }
    constexpr size_t kstep = (size_t)(BK * 2), hstep = (size_t)HALF * KB, tstep = 2 * hstep;
    const unsigned ldsw = (unsigned)wid * 1024u;
    const int fc = FP8 ? (32 * (fq >> 1) + 16 * (fq & 1)) : fq * 8;
    const int aoff = lds_byte(wr * 64 + fr, fc), boff = lds_byte(wc * 32 + fr, fc);
    const char* Ab = (const char*)g.A;
#define PG8_SA(b, h) (((b) * 2 + (h)) * HTB)
#define PG8_SB(b, h) ((4 + (b) * 2 + (h)) * HTB)
#define PG8_STAGE_B(bufoff, gbase) do { _Pragma("unroll") for (int _i = 0; _i < 2; ++_i) \
        __builtin_amdgcn_global_load_lds((const unsigned*)((const char*)(gbase) + voffB[_i]), (LAS unsigned*)(lds + (bufoff) + ldsw + _i * 8192), 16, 0, 0); } while (0)
#define PG8_STAGE_A(bufoff, kb, v, ubase) do { _Pragma("unroll") for (int _i = 0; _i < 2; ++_i) \
        __builtin_amdgcn_global_load_lds((const unsigned*)((GATHER ? Ab : (ubase)) + (size_t)(kb) + (GATHER ? (v)[_i] : voffA[_i])), (LAS unsigned*)(lds + (bufoff) + ldsw + _i * 8192), 16, 0, 0); } while (0)
#define PG8_LDA(dst, b, h) do { if constexpr (FP8) { _Pragma("unroll") for (int m = 0; m < 4; ++m) dst##8[m] = *(const LAS v8i*)(lds + PG8_SA(b, h) + aoff + m * 2048); } else { _Pragma("unroll") for (int m = 0; m < 4; ++m) _Pragma("unroll") for (int k = 0; k < 2; ++k) dst[m][k] = *(const LAS bf16x8*)(lds + PG8_SA(b, h) + aoff + m * 2048 + k * 1024); } } while (0)
#define PG8_LDB(dst, b, h) do { if constexpr (FP8) { _Pragma("unroll") for (int n = 0; n < 2; ++n) dst##8[n] = *(const LAS v8i*)(lds + PG8_SB(b, h) + boff + n * 2048); } else { _Pragma("unroll") for (int n = 0; n < 2; ++n) _Pragma("unroll") for (int k = 0; k < 2; ++k) dst[n][k] = *(const LAS bf16x8*)(lds + PG8_SB(b, h) + boff + n * 2048 + k * 1024); } } while (0)
#define PG8_MMA(ai, bj, At, Bt) do { __builtin_amdgcn_s_setprio(1); if constexpr (FP8) { _Pragma("unroll") for (int m = 0; m < 4; ++m) _Pragma("unroll") for (int n = 0; n < 2; ++n) \
        asm volatile("v_mfma_scale_f32_16x16x128_f8f6f4 %0, %1, %2, %0, %3, %3 op_sel_hi:[0,0,0]" : "+v"(acc[ai][bj][m][n]) : "v"(Bt##8[n]), "v"(At##8[m]), "v"(unit_scale)); } else { \
        _Pragma("unroll") for (int m = 0; m < 4; ++m) _Pragma("unroll") for (int n = 0; n < 2; ++n) _Pragma("unroll") for (int k = 0; k < 2; ++k) \
        acc[ai][bj][m][n] = __builtin_amdgcn_mfma_f32_16x16x32_bf16(Bt[n][k], At[m][k], acc[ai][bj][m][n], 0, 0, 0); } __builtin_amdgcn_s_setprio(0); } while (0)
#define PG8_WAIT_V(n) asm volatile("s_waitcnt vmcnt(" #n ")" ::: "memory")
#define PG8_WAIT_L(n) asm volatile("s_waitcnt lgkmcnt(" #n ")" ::: "memory")
#define PG8_BAR __builtin_amdgcn_s_barrier()
#define PG8_SCHED __builtin_amdgcn_sched_barrier(0)
    Unit cur, nxt; int ui = 0;
    if (!S.next(0, cur)) return;
    unsigned cv[2][2], nv[2][2];
    if constexpr (GATHER) a_offsets<KB>(g, cur, sR, sC, cv);
    const char* cA = Ab + (size_t)cur.pm * tstep; const char* nA = cA;
    f32x4 acc[2][2][4][2];
#pragma unroll
    for (int a = 0; a < 2; ++a)
#pragma unroll
        for (int b = 0; b < 2; ++b)
#pragma unroll
            for (int m = 0; m < 4; ++m)
#pragma unroll
                for (int n = 0; n < 2; ++n) acc[a][b][m][n] = (f32x4){0.f, 0.f, 0.f, 0.f};
    bf16x8 At[4][2], B0[2][2], B1[2][2]; v8i At8[4], B08[2], B18[2];
    int unit_scale = 0x7f7f7f7f; asm volatile("" : "+v"(unit_scale));
    const char* cB = (const char*)g.Bt + (size_t)cur.e * g.bstride + (size_t)cur.pn * tstep;
    PG8_STAGE_B(PG8_SB(0, 0), cB); PG8_STAGE_B(PG8_SB(0, 1), cB + hstep); PG8_STAGE_A(PG8_SA(0, 0), 0, cv[0], cA); PG8_STAGE_A(PG8_SA(0, 1), 0, cv[1], cA + hstep);
    if (wr == 1) PG8_BAR;
    PG8_WAIT_V(2); PG8_BAR;
    PG8_STAGE_B(PG8_SB(1, 0), cB + kstep); PG8_STAGE_A(PG8_SA(1, 0), kstep, cv[0], cA); PG8_STAGE_B(PG8_SB(1, 1), cB + hstep + kstep);
    PG8_WAIT_V(6); PG8_BAR;
    for (;;) {
        const bool has_next = S.next(ui + 1, nxt);
        const char* nB = cB;
        nA = cA;
        if (has_next) { if constexpr (GATHER) a_offsets<KB>(g, nxt, sR, sC, nv); nA = Ab + (size_t)nxt.pm * tstep; nB = (const char*)g.Bt + (size_t)nxt.e * g.bstride + (size_t)nxt.pn * tstep; }
        else if constexpr (GATHER) {
#pragma unroll
            for (int h = 0; h < 2; ++h)
#pragma unroll
                for (int i = 0; i < 2; ++i) nv[h][i] = cv[h][i];
        }
        const int ntr = (PROBE_SHORTK && !cur.real) ? 2 : nt;
#pragma nounroll
        for (int t = 0; t < ntr; t += 2) {
            const bool last = (t == ntr - 2);
            const size_t k1 = (size_t)(t + 1) * kstep, k2 = last ? 0 : (size_t)(t + 2) * kstep, k3 = k2 + kstep;
            const char* b2 = last ? nB : cB + (size_t)(t + 2) * kstep; const char* b3 = b2 + kstep;
            unsigned w0[2], w1[2];
            if constexpr (GATHER) {
#pragma unroll
                for (int i = 0; i < 2; ++i) { w0[i] = last ? nv[0][i] : cv[0][i]; w1[i] = last ? nv[1][i] : cv[1][i]; }
            }
            const char* a2 = last ? nA : cA;
            PG8_LDB(B0, 0, 0); PG8_LDB(B1, 0, 1); PG8_SCHED; PG8_LDA(At, 0, 0); PG8_STAGE_A(PG8_SA(1, 1), k1, cv[1], cA + hstep);
            PG8_WAIT_V(8); PG8_WAIT_L(0); PG8_BAR; PG8_MMA(0, 0, At, B0); PG8_MMA(0, 1, At, B1); PG8_BAR; PG8_SCHED;
            PG8_LDA(At, 0, 1); PG8_STAGE_B(PG8_SB(0, 0), b2); PG8_STAGE_B(PG8_SB(0, 1), b2 + hstep); PG8_STAGE_A(PG8_SA(0, 0), k2, w0, a2);
            PG8_WAIT_V(8); PG8_WAIT_L(0); PG8_BAR; PG8_MMA(1, 0, At, B0); PG8_MMA(1, 1, At, B1); PG8_BAR; PG8_SCHED;
            PG8_LDB(B0, 1, 0); PG8_LDB(B1, 1, 1); PG8_SCHED; PG8_LDA(At, 1, 0); PG8_STAGE_A(PG8_SA(0, 1), k2, w1, a2 + hstep);
            PG8_WAIT_V(8); PG8_WAIT_L(0); PG8_BAR; PG8_MMA(0, 0, At, B0); PG8_MMA(0, 1, At, B1); PG8_BAR; PG8_SCHED;
            PG8_LDA(At, 1, 1); PG8_STAGE_B(PG8_SB(1, 0), b3); PG8_STAGE_B(PG8_SB(1, 1), b3 + hstep); PG8_STAGE_A(PG8_SA(1, 0), k3, w0, a2);
            PG8_WAIT_V(8); PG8_WAIT_L(0); PG8_BAR; PG8_MMA(1, 0, At, B0); PG8_MMA(1, 1, At, B1); PG8_BAR; PG8_SCHED;
        }
        if constexpr (ALIGN_EPI) { if (wr == 0) PG8_BAR; }
        if constexpr (FP8) asm volatile("s_nop 15\n\ts_nop 15" ::: "memory");
        if (!PROBE_NOEPI || cur.real) E(acc, cur, wr, wc, fr, fq);
        if (!has_next) break;
#pragma unroll
        for (int a = 0; a < 2; ++a)
#pragma unroll
            for (int b = 0; b < 2; ++b)
#pragma unroll
                for (int m = 0; m < 4; ++m)
#pragma unroll
                    for (int n = 0; n < 2; ++n) acc[a][b][m][n] = (f32x4){0.f, 0.f, 0.f, 0.f};
        cur = nxt; cB = nB; cA = nA; ++ui;
        if constexpr (GATHER) {
#pragma unroll
            for (int h = 0; h < 2; ++h)
#pragma unroll
                for (int i = 0; i < 2; ++i) cv[h][i] = nv[h][i];
        }
        if constexpr (ALIGN_EPI) { if (wr == 1) PG8_BAR; }
    }
    PG8_WAIT_V(0);
    if constexpr (!ALIGN_EPI) { if (wr == 0) PG8_BAR; }
    PG8_BAR;
#undef PG8_SA
#undef PG8_SB
#undef PG8_STAGE_A
#undef PG8_STAGE_B
#undef PG8_LDA
#undef PG8_LDB
#undef PG8_MMA
#undef PG8_WAIT_V
#undef PG8_WAIT_L
#undef PG8_BAR
#undef PG8_SCHED
}
}

struct TBlk { const float* src; int ldw; bf16_t* dst; unsigned char* dst8; };
__device__ __forceinline__ void tb_load(const TBlk& t, int lane, f32x4 (&v)[16]) {
    const float* p = t.src + (size_t)(lane >> 4) * t.ldw + (lane & 15) * 4;
#pragma unroll
    for (int i = 0; i < 16; ++i) v[i] = *(const f32x4*)(p + (size_t)(4 * i) * t.ldw);
}
__device__ __forceinline__ void tb_store(const TBlk& t, int lane, const f32x4 (&v)[16], LAS float* scr) {
#pragma unroll
    for (int i = 0; i < 16; ++i) { LAS float* d = scr + ((lane >> 4) + 4 * i) * 65 + (lane & 15) * 4; d[0] = v[i].x; d[1] = v[i].y; d[2] = v[i].z; d[3] = v[i].w; }
    asm volatile("s_waitcnt lgkmcnt(0)" ::: "memory"); __builtin_amdgcn_wave_barrier();
    const int c8 = lane & 7;
#pragma unroll
    for (int jj = 0; jj < 8; ++jj) {
        const int n = (lane >> 3) + 8 * jj; const LAS float* p = scr + (8 * c8) * 65 + n;
        if (t.dst8) { u32x2 o; o.x = pk4_fp8(p[0] * F8_SW, p[65] * F8_SW, p[2 * 65] * F8_SW, p[3 * 65] * F8_SW); o.y = pk4_fp8(p[4 * 65] * F8_SW, p[5 * 65] * F8_SW, p[6 * 65] * F8_SW, p[7 * 65] * F8_SW);
            *(u32x2*)(t.dst8 + (size_t)n * 1024 + 8 * c8) = o; }
        else { u32x4 o; o.x = pk2(p[0], p[65]); o.y = pk2(p[2 * 65], p[3 * 65]); o.z = pk2(p[4 * 65], p[5 * 65]); o.w = pk2(p[6 * 65], p[7 * 65]);
            *(u32x4*)(t.dst + (size_t)n * 1024 + 8 * c8) = o; }
    }
    asm volatile("s_waitcnt lgkmcnt(0)" ::: "memory"); __builtin_amdgcn_wave_barrier();
}

__device__ __forceinline__ void phase_prep(const Ctx& c) {
    LAS float* red = (LAS float*)c.lds;
    const float* cv = c.a->in[1]; const float* ccv = c.a->in[3]; const float* ada_w = c.a->in[4]; const float* ada_b = c.a->in[5];
    for (int item = c.wg; item < 193; item += c.nwg) {
        if (item < 192) {
            const int layer = item / 96, cb = item % 96, col = cb * 64 + c.lane;
            const float* W = ada_w + (size_t)layer * D * 6144 + col;
            float a0 = 0.f, a1 = 0.f;
            const int k0 = c.wave * 128;
#pragma unroll 32
            for (int k = 0; k < 128; ++k) { const float w = W[(size_t)(k0 + k) * 6144]; a0 += silu_f(cv[k0 + k]) * w; a1 += silu_f(ccv[k0 + k]) * w; }
            red[(0 * 8 + c.wave) * 64 + c.lane] = a0; red[(1 * 8 + c.wave) * 64 + c.lane] = a1;
            __syncthreads();
            if (c.tid < 128) {
                const int which = c.tid >> 6, l = c.tid & 63; float s = 0.f;
#pragma unroll
                for (int w = 0; w < 8; ++w) s += red[(which * 8 + w) * 64 + l];
                c.modp(layer, which)[cb * 64 + l] = s + ada_b[layer * 6144 + cb * 64 + l];
            }
            __syncthreads();
        } else {
            float* modbase = (float*)(c.ws + WS_MOD);
            for (int i = c.tid; i < 4096; i += 512) {
                const int pos = i >> 4, j = i & 15;
                const double ang = (double)pos * pow(10000.0, -(double)j / 16.0);
                modbase[MOD_ROPE + 2 * i] = (float)cos(ang); modbase[MOD_ROPE + 2 * i + 1] = (float)sin(ang);
            }
            const float* lbp = c.a->in[12];
            for (int i = c.tid; i < 2048; i += 512) { const float p0 = lbp[i], p1 = lbp[2048 + i]; modbase[MOD_LB + i] = 1.f / (1.f + __expf(p0 - p1)); }
        }
    }
}

__device__ __forceinline__ void row_load(const float* p, int lane, f32x4 (&v)[4]) {
#pragma unroll
    for (int j = 0; j < 4; ++j) v[j] = *(const f32x4*)(p + lane * 4 + 256 * j);
}
__device__ __forceinline__ float row_ss(const f32x4 (&v)[4]) {
    float s = 0.f;
#pragma unroll
    for (int j = 0; j < 4; ++j) s += v[j].x * v[j].x + v[j].y * v[j].y + v[j].z * v[j].z + v[j].w * v[j].w;
    return wave_sum(s);
}
__device__ __forceinline__ void row_modnorm_store(const f32x4 (&x)[4], float rstd, const float* g, const float* sh, const float* sc, bf16_t* out, int lane, f32x4 (*hout)[4] = nullptr) {
#pragma unroll
    for (int j = 0; j < 4; ++j) {
        const int c0 = lane * 4 + 256 * j;
        const f32x4 gv = *(const f32x4*)(g + c0), shv = *(const f32x4*)(sh + c0), scv = *(const f32x4*)(sc + c0);
        f32x4 h;
        h.x = x[j].x * rstd * gv.x * (1.f + scv.x) + shv.x; h.y = x[j].y * rstd * gv.y * (1.f + scv.y) + shv.y;
        h.z = x[j].z * rstd * gv.z * (1.f + scv.z) + shv.z; h.w = x[j].w * rstd * gv.w * (1.f + scv.w) + shv.w;
        if (hout) (*hout)[j] = h;
        u32x2 o; o.x = pk2(h.x, h.y); o.y = pk2(h.z, h.w);
        *(u32x2*)(out + c0) = o;
    }
}

__device__ __forceinline__ void phase_norm0(const Ctx& c) {
    bf16_t* H = (bf16_t*)(c.ws + WS_H); const float* ng = c.a->in[6];
    int r = c.wg * 8 + c.wave;
    f32x4 xn[4];
    if (r < R) row_load(c.xin0(r), c.lane, xn);
    for (; r < R; r += c.nwg * 8) {
        f32x4 x[4];
#pragma unroll
        for (int j = 0; j < 4; ++j) x[j] = xn[j];
        if (r + c.nwg * 8 < R) row_load(c.xin0(r + c.nwg * 8), c.lane, xn);
        const float rstd = rsqrtf(row_ss(x) * (1.f / D) + EPS);
        const float* m = c.modp(0, r < C ? 1 : 0);
        row_modnorm_store(x, rstd, ng, m + 0, m + 1024, H + (size_t)r * D, c.lane);
    }
}

namespace at {
constexpr int KP = 144, TILEB = 64 * KP;
__device__ __forceinline__ bf16x8 tr_frag2(const LAS unsigned char* tile, int row0, int col0, int lane) {
    const int q = (lane & 15) >> 2, p = lane & 3;
    const LAS unsigned char* a = tile + (row0 + q) * KP + (col0 + 4 * p) * 2;
    const v4i16_t lo = __builtin_amdgcn_ds_read_tr16_b64_v4i16((LAS v4i16_t*)a);
    const v4i16_t hi = __builtin_amdgcn_ds_read_tr16_b64_v4i16((LAS v4i16_t*)(a + 16 * KP));
    return (bf16x8){lo[0], lo[1], lo[2], lo[3], hi[0], hi[1], hi[2], hi[3]};
}
}
__device__ __forceinline__ void phase_attn(const Ctx& c) {
    using namespace at;
    const bf16_t* Q = (const bf16_t*)(c.ws + WS_Q); const bf16_t* K = (const bf16_t*)(c.ws + WS_K); const bf16_t* V = (const bf16_t*)(c.ws + WS_V);
    bf16_t* O = (bf16_t*)(c.ws + WS_O); const float* sink = c.a->in[9];
    LAS unsigned char* lds = c.lds;
    const int tid = c.tid, lane = c.lane, w = __builtin_amdgcn_readfirstlane(tid >> 6), fr = lane & 15, g = lane >> 4;
    const int lrow = tid >> 3, lch = tid & 7;
    for (int item = c.wg; item < 264; item += c.nwg) {
        const bool isctx = item >= 256;
        const int ci = item - 256;
        const int n = isctx ? 0 : (item >> 1), kh = isctx ? ((ci >> 1) & 1) : (item & 1), cb = isctx ? (ci >> 2) : 0;
        const int p_lo = isctx ? (ci & 1) : 0, p_hi = isctx ? (ci & 1) + 1 : 2;
        const int hq = kh * 8 + w;
        const float sink2 = sink[hq] * LOG2E;
        for (int pass = p_lo; pass < p_hi; ++pass) {
            const int t0 = 128 * n + 64 * pass, qrow0 = isctx ? cb * 128 + 64 * pass : C + t0;
            const int jlo = isctx ? 0 : (t0 >= 128 ? 0 : (128 - t0) / 64), jhi = isctx ? 0 : ((L - t0 + 128) / 64 < 5 ? (L - t0 + 128) / 64 : 5);
            const int ntile = 4 + (jhi - jlo);
            LAS unsigned char* qlds = lds + 4 * TILEB + w * TILEB;
#pragma unroll
            for (int qb = 0; qb < 4; ++qb)
#pragma unroll
                for (int ks = 0; ks < 2; ++ks) *(LAS bf16x8*)(qlds + (16 * qb + fr) * KP + (32 * ks + 8 * g) * 2) = *(const bf16x8*)(Q + (size_t)(qrow0 + 16 * qb + fr) * D + hq * 64 + 32 * ks + 8 * g);
            float mrow[4], lsum[4]; f32x4 OT[4][4];
#pragma unroll
            for (int qb = 0; qb < 4; ++qb) { mrow[qb] = sink2; lsum[qb] = 1.f;
#pragma unroll
                for (int nt = 0; nt < 4; ++nt) OT[qb][nt] = (f32x4){0.f, 0.f, 0.f, 0.f}; }
            u32x4 kreg, vreg;
#define AT_KROW(ti) ((ti) < 4 ? 64 * (ti) : C + t0 - 128 + 64 * (jlo + (ti) - 4))
#define AT_LOAD(ti) do { const size_t ro_ = (size_t)(AT_KROW(ti) + lrow) * 128 + kh * 64 + lch * 8; kreg = *(const u32x4*)(K + ro_); vreg = *(const u32x4*)(V + ro_); } while (0)
#define AT_WRITE(buf) do { *(LAS u32x4*)(lds + (buf) * 2 * TILEB + lrow * KP + lch * 16) = kreg; *(LAS u32x4*)(lds + (buf) * 2 * TILEB + TILEB + lrow * KP + lch * 16) = vreg; } while (0)
            AT_LOAD(0); AT_WRITE(0);
            __syncthreads();
            for (int ti = 0; ti < ntile; ++ti) {
                if (ti + 1 < ntile) AT_LOAD(ti + 1);
                const LAS unsigned char* kb = lds + (ti & 1) * 2 * TILEB; const LAS unsigned char* vb = kb + TILEB;
                const int jj = jlo + ti - 4; const bool masked = (ti >= 4) && (jj == 0 || jj == 4);
                const int k0 = t0 - 128 + 64 * jj;
                bf16x8 Kf[4][2];
#pragma unroll
                for (int mt = 0; mt < 4; ++mt)
#pragma unroll
                    for (int ks = 0; ks < 2; ++ks) Kf[mt][ks] = *(const LAS bf16x8*)(kb + (16 * mt + fr) * KP + (32 * ks + 8 * g) * 2);
#pragma unroll
                for (int qb = 0; qb < 4; ++qb) {
                    asm volatile("" ::: "memory");
                    bf16x8 Vf[4][2];
#pragma unroll
                    for (int mt = 0; mt < 4; ++mt)
#pragma unroll
                        for (int ks = 0; ks < 2; ++ks)
                            Vf[mt][ks] = tr_frag2(vb, 32 * ks + 4 * g, 16 * mt, lane);
                    bf16x8 Qq[2];
#pragma unroll
                    for (int ks = 0; ks < 2; ++ks) Qq[ks] = *(const LAS bf16x8*)(qlds + (16 * qb + fr) * KP + (32 * ks + 8 * g) * 2);
                    f32x4 sa[4];
#pragma unroll
                    for (int mt = 0; mt < 4; ++mt) { sa[mt] = (f32x4){0.f, 0.f, 0.f, 0.f};
#pragma unroll
                        for (int ks = 0; ks < 2; ++ks) sa[mt] = __builtin_amdgcn_mfma_f32_16x16x32_bf16(Kf[mt][ks], Qq[ks], sa[mt], 0, 0, 0); }
                    if (masked) {
                        const int tq = t0 + 16 * qb + fr;
#pragma unroll
                        for (int mt = 0; mt < 4; ++mt)
#pragma unroll
                            for (int e = 0; e < 4; ++e) { const int dt = tq - (k0 + 16 * mt + 4 * g + e); if (dt > 128 || dt < -128) sa[mt][e] = -INFINITY; }
                    }
                    float mx = fmaxf(fmaxf(sa[0][0], sa[0][1]), fmaxf(sa[0][2], sa[0][3]));
#pragma unroll
                    for (int mt = 1; mt < 4; ++mt) mx = fmaxf(mx, fmaxf(fmaxf(sa[mt][0], sa[mt][1]), fmaxf(sa[mt][2], sa[mt][3])));
                    mx = fmaxf(mx, __shfl_xor(mx, 16)); mx = fmaxf(mx, __shfl_xor(mx, 32));
                    const float mn = fmaxf(mrow[qb], mx), alpha = __builtin_amdgcn_exp2f(mrow[qb] - mn);
                    mrow[qb] = mn;
                    float rs = 0.f;
#pragma unroll
                    for (int mt = 0; mt < 4; ++mt)
#pragma unroll
                        for (int e = 0; e < 4; ++e) { const float pv = __builtin_amdgcn_exp2f(sa[mt][e] - mn); sa[mt][e] = pv; rs += pv; }
                    rs += __shfl_xor(rs, 16); rs += __shfl_xor(rs, 32);
                    lsum[qb] = lsum[qb] * alpha + rs;
                    bf16x8 Pb[2];
#pragma unroll
                    for (int ks = 0; ks < 2; ++ks) { const f32x4 a0 = sa[2 * ks], a1 = sa[2 * ks + 1];
                        const u32x4 pk = (u32x4){pk2(a0[0], a0[1]), pk2(a0[2], a0[3]), pk2(a1[0], a1[1]), pk2(a1[2], a1[3])}; Pb[ks] = __builtin_bit_cast(bf16x8, pk); }
#pragma unroll
                    for (int nt = 0; nt < 4; ++nt) { OT[qb][nt] = OT[qb][nt] * alpha;
#pragma unroll
                        for (int ks = 0; ks < 2; ++ks) OT[qb][nt] = __builtin_amdgcn_mfma_f32_16x16x32_bf16(Vf[nt][ks], Pb[ks], OT[qb][nt], 0, 0, 0); }
                }
                if (ti + 1 < ntile) AT_WRITE((ti + 1) & 1);
                __syncthreads();
            }
#undef AT_KROW
#undef AT_LOAD
#undef AT_WRITE
#pragma unroll
            for (int qb = 0; qb < 4; ++qb) {
                const float il = 1.f / lsum[qb];
                bf16_t* op = O + (size_t)(qrow0 + 16 * qb + fr) * D + hq * 64 + 4 * g;
#pragma unroll
                for (int nt = 0; nt < 4; ++nt) { const f32x4 v = OT[qb][nt] * il; u32x2 o; o.x = pk2(v[0], v[1]); o.y = pk2(v[2], v[3]); *(u32x2*)(op + 16 * nt) = o; }
            }
        }
    }
}

__device__ __forceinline__ void phase_postmix(const Ctx& c, int layer, bool route) {
    const float* Y = (const float*)(c.ws + WS_RAW1); unsigned char* H8 = c.ws + WS_H8;
    float* Xout = (float*)(c.ws + (layer == 0 ? WS_X : WS_X1)); const float* Xprev = (const float*)(c.ws + WS_X);
    const float* ng = c.a->in[6] + layer * 4 * D; const float* Wr = c.a->in[15] + (size_t)layer * D * NE; const float* br = c.a->in[16] + layer * NE;
    unsigned* cnt = (unsigned*)(c.ws + WS_CTL) + CW_CNT + layer * NE;
    int* tk_e = (int*)(c.ws + WS_TK); float* tk_g = (float*)(c.ws + WS_TK) + R * 4; int* tk_slot = (int*)(c.ws + WS_TK) + 2 * R * 4;
    int* list = (int*)(c.ws + WS_LIST);
    LAS float* WL = (LAS float*)c.lds;
    LAS float* biasp = (LAS float*)(c.lds + 131072);
    LAS unsigned* lcnt = (LAS unsigned*)(c.lds + 145920); LAS unsigned* lbase = lcnt + 32;
    LAS float* pvA = (LAS float*)(c.lds + 131072 + 2560); LAS float* pvB = pvA + 1024; LAS float* pvS = pvB + 1024;
    const int lane = c.lane, w = __builtin_amdgcn_readfirstlane(c.tid >> 6), fr = lane & 15, g = lane >> 4;
    const int g_lo = layer == 0 ? 0 : C / 128;
    for (int grp = g_lo + c.wg; grp < R / 128; grp += c.nwg) {
        const int which = grp * 128 < C ? 1 : 0;
        const float* m = c.modp(layer, which);
        __syncthreads();
        if (c.tid < NE) lcnt[c.tid] = 0u;
#pragma unroll 4
        for (int j = 0; j < 16; ++j) {
            const int i4 = c.tid + 512 * j, k = i4 >> 3, e0 = (i4 & 7) * 4;
            const f32x4 wv = *(const f32x4*)(Wr + (size_t)k * NE + e0); const float sc = ng[2 * D + k] * (1.f + m[4096 + k]);
            LAS float* dst = WL + ((((k >> 4) * 4 + (k & 3)) * 4 + ((k >> 2) & 3)) * 16) * 2;
#pragma unroll
            for (int q = 0; q < 4; ++q) { const int e = e0 + q; dst[(e & 15) * 2 + (e >> 4)] = wv[q] * sc; }
        }
        for (int k = c.tid; k < D; k += 512) { pvA[k] = m[2048 + k] * ng[D + k]; pvB[k] = ng[2 * D + k] * (1.f + m[4096 + k]); pvS[k] = m[3072 + k]; }
        { const int e = c.tid & 31, part = c.tid >> 5; float sacc = 0.f;
#pragma unroll 16
          for (int k = part * 64; k < part * 64 + 64; ++k) sacc += m[3072 + k] * Wr[k * NE + e];
          biasp[32 + part * 32 + e] = sacc; }
        __syncthreads();
        if (c.tid < 32) { float sacc = br[c.tid];
#pragma unroll
            for (int p = 0; p < 16; ++p) sacc += biasp[32 + p * 32 + c.tid]; biasp[c.tid] = sacc; }
        __syncthreads();
        const int row0 = grp * 128 + w * 16;
        float rs_keep = 0.f;
        f32x4 yn[4], xn[4];
        row_load(Y + (size_t)(layer == 0 ? row0 : row0 - C) * D, lane, yn); row_load(layer == 0 ? c.xin0(row0) : Xprev + (size_t)row0 * D, lane, xn);
        for (int i = 0; i < 16; ++i) {
            const int r = row0 + i;
            f32x4 y[4], x[4];
#pragma unroll
            for (int j = 0; j < 4; ++j) { y[j] = yn[j]; x[j] = xn[j]; }
            if (i + 1 < 16) { row_load(Y + (size_t)(layer == 0 ? r + 1 : r + 1 - C) * D, lane, yn); row_load(layer == 0 ? c.xin0(r + 1) : Xprev + (size_t)(r + 1) * D, lane, xn); }
            const float rstd_y = rsqrtf(row_ss(y) * (1.f / D) + EPS);
#pragma unroll
            for (int j = 0; j < 4; ++j) {
                const int c0 = lane * 4 + 256 * j;
                x[j] += *(const LAS f32x4*)(pvA + c0) * (y[j] * rstd_y);
                *(f32x4*)(Xout + (size_t)r * D + c0) = x[j];
            }
            const float rstd_x = rsqrtf(row_ss(x) * (1.f / D) + EPS);
#pragma unroll
            for (int j = 0; j < 4; ++j) {
                const int c0 = lane * 4 + 256 * j;
                const f32x4 hv = x[j] * rstd_x * *(const LAS f32x4*)(pvB + c0) + *(const LAS f32x4*)(pvS + c0);
                *(unsigned*)(H8 + (size_t)r * D + c0) = pk4_fp8(hv[0] * F8_SH, hv[1] * F8_SH, hv[2] * F8_SH, hv[3] * F8_SH);
            }
            if (lane == i) rs_keep = rstd_x;
        }
        asm volatile("s_waitcnt vmcnt(0)" ::: "memory");
        f32x4 la[2]; la[0] = (f32x4){0.f, 0.f, 0.f, 0.f}; la[1] = la[0];
        {
            const float* ap = Xout + (size_t)(row0 + fr) * D + 4 * g;
            const LAS float* bp = WL + (g * 16 + fr) * 2;
#pragma unroll 4
            for (int k4 = 0; k4 < 64; ++k4) {
                const f32x4 a4 = *(const f32x4*)(ap + 16 * k4);
#pragma unroll
                for (int q = 0; q < 4; ++q) {
                    const f32x2 b2 = *(const LAS f32x2*)(bp + (size_t)(4 * k4 + q) * 128);
                    la[0] = __builtin_amdgcn_mfma_f32_16x16x4f32(a4[q], b2[0], la[0], 0, 0, 0);
                    la[1] = __builtin_amdgcn_mfma_f32_16x16x4f32(a4[q], b2[1], la[1], 0, 0, 0);
                }
            }
        }
        float tv[4][4]; int te[4][4];
#pragma unroll
        for (int e = 0; e < 4; ++e) {
            const float rs = __shfl(rs_keep, 4 * g + e);
            float v0 = la[0][e] * rs + biasp[fr], v1 = la[1][e] * rs + biasp[16 + fr];
#pragma unroll
            for (int k = 0; k < 4; ++k) {
                float bv; int bi;
                if (v0 >= v1) { bv = v0; bi = fr; } else { bv = v1; bi = 16 + fr; }
#pragma unroll
                for (int o = 8; o > 0; o >>= 1) {
                    const float ov = __shfl_xor(bv, o); const int oi = __shfl_xor(bi, o);
                    if (ov > bv || (ov == bv && oi < bi)) { bv = ov; bi = oi; }
                }
                tv[e][k] = bv; te[e][k] = bi;
                if (bi == fr) v0 = -INFINITY;
                if (bi == 16 + fr) v1 = -INFINITY;
            }
        }
        float v[4]; int ex[4]; unsigned sl[4];
#pragma unroll
        for (int k = 0; k < 4; ++k) { v[k] = tv[0][k]; ex[k] = te[0][k];
#pragma unroll
            for (int e = 1; e < 4; ++e) if (fr == e) { v[k] = tv[e][k]; ex[k] = te[e][k]; } }
        if (fr < 4 && route) {
#pragma unroll
            for (int k = 0; k < 4; ++k) sl[k] = __hip_atomic_fetch_add(lcnt + ex[k], 1u, __ATOMIC_RELAXED, __HIP_MEMORY_SCOPE_WORKGROUP);
        }
        __syncthreads();
        if (c.tid < NE && route) { const unsigned n = lcnt[c.tid]; lbase[c.tid] = n ? atomicAdd(&cnt[c.tid], n) : 0u; }
        __syncthreads();
        if (fr < 4 && route) {
            const int r = row0 + 4 * g + fr;
            const float e1 = __expf(v[1] - v[0]), e2 = __expf(v[2] - v[0]), e3 = __expf(v[3] - v[0]);
            const float inv = 1.f / (1.f + e1 + e2 + e3);
            const float gk[4] = {inv, e1 * inv, e2 * inv, e3 * inv};
#pragma unroll
            for (int k = 0; k < 4; ++k) {
                const unsigned slot = lbase[ex[k]] + sl[k];
                list[(size_t)ex[k] * R + slot] = r;
                tk_e[r * 4 + k] = ex[k]; tk_g[r * 4 + k] = gk[k]; tk_slot[r * 4 + k] = (int)slot;
            }
        }
    }
}

__device__ __forceinline__ void moe_offsets(const Ctx& c, int layer, LAS int* so) {
    const unsigned* cnt = (const unsigned*)(c.ws + WS_CTL) + CW_CNT + layer * NE;
    __syncthreads();
    if (c.tid < 64) {
        const int n = c.tid < NE ? (int)cnt[c.tid] : 0; int pad = (n + PADM - 1) / PADM * PADM, inc = pad;
#pragma unroll
        for (int o = 1; o < 32; o <<= 1) { const int t = __shfl_up(inc, o); if (c.lane >= o) inc += t; }
        if (c.tid < NE) { so[c.tid] = inc - pad; so[64 + c.tid] = n; }
        if (c.tid == NE - 1) so[32] = inc;
    }
    __syncthreads();
}

__device__ __forceinline__ void moe_tables(const Ctx& c, int layer, LAS int* tb) {
    const unsigned* cnt = (const unsigned*)(c.ws + WS_CTL) + CW_CNT + layer * NE;
    __syncthreads();
    if (c.tid < 64) {
        const int n = c.tid < NE ? (int)cnt[c.tid] : 0; int tiles = (n + PADM - 1) / PADM, inc = tiles;
#pragma unroll
        for (int o = 1; o < 32; o <<= 1) { const int t = __shfl_up(inc, o); if (c.lane >= o) inc += t; }
        if (c.tid < NE) { tb[c.tid] = inc - tiles; tb[64 + c.tid] = n; }
        if (c.tid == NE - 1) tb[32] = inc;
    }
    __syncthreads();
}
__device__ __forceinline__ int vcu_of(const Ctx& c) { return (c.nwg % 8 == 0) ? (c.wg % 8) * (c.nwg / 8) + c.wg / 8 : c.wg; }
__device__ __forceinline__ void phase_moe_gu(const Ctx& c, int layer) {
    LAS int* tb = (LAS int*)(c.lds + 131072 + 1024);
    moe_tables(c, layer, tb);
    pg8::Gemm g{c.ws + WS_H8, c.ws + WS_WGU + (size_t)layer * NE * 2048 * 1024, (size_t)2048 * 1024, (const int*)(c.ws + WS_LIST)};
    pg8::MoeOrder S{tb, tb + 64, 8, c.nwg, vcu_of(c)};
    pg8::EpiSwiglu E{c.ws + WS_HDN, c.a->in[18] + (size_t)layer * NE * 2048};
    pg8::gemm_phase<pg8::EpiSwiglu, pg8::MoeOrder, true, true, true>(c.lds, g, S, E, c.tid);
}
__device__ __forceinline__ void phase_moe_dn(const Ctx& c, int layer) {
    LAS int* tb = (LAS int*)(c.lds + 131072 + 1024);
    moe_tables(c, layer, tb);
    pg8::Gemm g{c.ws + WS_HDN, c.ws + WS_WDN + (size_t)layer * NE * 1024 * 1024, (size_t)1024 * 1024, nullptr};
    pg8::MoeOrder S{tb, tb + 64, 4, c.nwg, vcu_of(c)};
    pg8::EpiBf16Bias E{(bf16_t*)(c.ws + WS_OUTB), c.a->in[20] + (size_t)layer * NE * 1024, 1024, 1.f / (F8_SHD * F8_SW)};
    pg8::gemm_phase<pg8::EpiBf16Bias, pg8::MoeOrder, true, false, true>(c.lds, g, S, E, c.tid);
}
__device__ __forceinline__ void phase_gemm_f32(const Ctx& c, const bf16_t* A, int M, const bf16_t* Bt, int N, const float* bias, float* Cout) {
    pg8::Gemm g{A, Bt, 0, nullptr}; pg8::StaticOrder S; S.init(M, N, c.nwg, c.wg);
    pg8::EpiF32 E{Cout, N, bias};
    pg8::gemm_phase<pg8::EpiF32, pg8::StaticOrder, true, false, false>(c.lds, g, S, E, c.tid);
}

__device__ __forceinline__ void phase_gemm_qkv(const Ctx& c) {
    pg8::Gemm g{(const bf16_t*)(c.ws + WS_H), (const bf16_t*)(c.ws + WS_WQKV), 0, nullptr}; pg8::StaticOrder S; S.init(R, QKVD, c.nwg, c.wg);
    pg8::EpiQKV E{(bf16_t*)(c.ws + WS_Q), (bf16_t*)(c.ws + WS_K), (bf16_t*)(c.ws + WS_V), c.a->in[8], (const float*)(c.ws + WS_MOD) + MOD_ROPE};
    pg8::gemm_phase<pg8::EpiQKV, pg8::StaticOrder, true, false, false>(c.lds, g, S, E, c.tid);
}
__device__ __forceinline__ void phase_gemm_inproj(const Ctx& c) {
    pg8::Gemm g{(const bf16_t*)(c.ws + WS_H), (const bf16_t*)(c.ws + WS_WIN), 0, nullptr}; pg8::StaticOrder S; S.init(R, HIN, c.nwg, c.wg);
    pg8::EpiInProj E{(bf16_t*)(c.ws + WS_QH), (_Float16*)(c.ws + WS_KF), (_Float16*)(c.ws + WS_KB), (bf16_t*)(c.ws + WS_IV), (bf16_t*)(c.ws + WS_SG), (const float*)(c.ws + WS_MOD) + MOD_LB};
    pg8::gemm_phase<pg8::EpiInProj, pg8::StaticOrder, true, false, false>(c.lds, g, S, E, c.tid);
}

__device__ __forceinline__ void phase_norm0(const Ctx& c);
__device__ __forceinline__ TBlk convert_item(const Ctx& c, int it) {
    constexpr int I_QKV = 20 * 16, I_O = 16 * 16, I_IN = 80 * 16, I_HO = 16 * 16, I_GU = 64 * 32 * 16;
    int r = it; TBlk t; t.dst8 = nullptr; t.dst = nullptr;
    if (r < I_QKV) { const int nb = r % 20, kb = r / 20; t.src = c.a->in[7] + (size_t)kb * 64 * QKVD + nb * 64; t.ldw = QKVD; t.dst = (bf16_t*)(c.ws + WS_WQKV) + (size_t)nb * 64 * 1024 + kb * 64; return t; } r -= I_QKV;
    if (r < I_O) { const int nb = r % 16, kb = r / 16; t.src = c.a->in[10] + (size_t)kb * 64 * D + nb * 64; t.ldw = D; t.dst = (bf16_t*)(c.ws + WS_WO) + (size_t)nb * 64 * 1024 + kb * 64; return t; } r -= I_O;
    if (r < I_IN) { const int nb = r % 80, kb = r / 80; t.src = c.a->in[11] + (size_t)kb * 64 * HIN + nb * 64; t.ldw = HIN; t.dst = (bf16_t*)(c.ws + WS_WIN) + (size_t)nb * 64 * 1024 + kb * 64; return t; } r -= I_IN;
    if (r < I_HO) { const int nb = r % 16, kb = r / 16; t.src = c.a->in[14] + (size_t)kb * 64 * D + nb * 64; t.ldw = D; t.dst = (bf16_t*)(c.ws + WS_WHO) + (size_t)nb * 64 * 1024 + kb * 64; return t; } r -= I_HO;
    if (r < I_GU) { const int mat = r / 512, rr = r % 512, nb = rr % 32, kb = rr / 32; const int n0 = ((nb & 3) >> 1) * 1024 + (nb >> 2) * 128 + (nb & 1) * 64;
        t.src = c.a->in[17] + (size_t)mat * 1024 * 2048 + (size_t)kb * 64 * 2048 + n0; t.ldw = 2048; t.dst8 = c.ws + WS_WGU + ((size_t)mat * 2048 + nb * 64) * 1024 + kb * 64; return t; } r -= I_GU;
    { const int mat = r / 256, rr = r % 256, nb = rr % 16, kb = rr / 16;
        t.src = c.a->in[19] + (size_t)mat * 1024 * 1024 + (size_t)kb * 64 * 1024 + nb * 64; t.ldw = 1024; t.dst8 = c.ws + WS_WDN + ((size_t)mat * 1024 + nb * 64) * 1024 + kb * 64; }
    return t;
}
__device__ __forceinline__ void phase_convert(const Ctx& c) {
    LAS float* scr = (LAS float*)c.lds + c.wave * (64 * 65);
    const int gw = c.wg * 8 + c.wave, NGW = c.nwg * 8;
    constexpr int TOT = 20 * 16 + 16 * 16 + 80 * 16 + 16 * 16 + 64 * 32 * 16 + 64 * 16 * 16;
    f32x4 va[16], vb[16];
    int it = gw;
    TBlk ta, tbk;
    if (it < TOT) { ta = convert_item(c, it); tb_load(ta, c.lane, va); }
    for (; it < TOT; it += 2 * NGW) {
        const bool hb = it + NGW < TOT;
        if (hb) { tbk = convert_item(c, it + NGW); tb_load(tbk, c.lane, vb); }
        tb_store(ta, c.lane, va, scr);
        const bool ha = it + 2 * NGW < TOT;
        if (ha) { ta = convert_item(c, it + 2 * NGW); tb_load(ta, c.lane, va); }
        if (hb) tb_store(tbk, c.lane, vb, scr);
    }
    __syncthreads();
    phase_norm0(c);
}

__device__ __forceinline__ void phase_combine(const Ctx& c, int layer) {
    LAS int* so = (LAS int*)(c.lds + 32768);
    moe_offsets(c, layer, so);
    const bf16_t* outb = (const bf16_t*)(c.ws + WS_OUTB); float* X = (float*)(c.ws + WS_X); bf16_t* H = (bf16_t*)(c.ws + WS_H);
    const float* Xin = layer == 0 ? X : (const float*)(c.ws + WS_X1);
    const float* ngl = c.a->in[6] + layer * 4 * D;
    const int* tk_e = (const int*)(c.ws + WS_TK); const float* tk_g = (const float*)(c.ws + WS_TK) + R * 4; const int* tk_slot = (const int*)(c.ws + WS_TK) + 2 * R * 4;
    const int r_lo = layer == 0 ? 0 : C, stride = c.nwg * 8;
    int r = r_lo + c.wg * 8 + c.wave;
    int pe[4], ps[4]; float pg[4]; u32x2 wn[4][4]; f32x4 xn[4]; float gn[4];
#define CB_TK(row) do { _Pragma("unroll") for (int k = 0; k < 4; ++k) { pe[k] = tk_e[(row) * 4 + k]; ps[k] = tk_slot[(row) * 4 + k]; pg[k] = tk_g[(row) * 4 + k]; } } while (0)
#define CB_DATA(row) do { _Pragma("unroll") for (int k = 0; k < 4; ++k) { const bf16_t* src_ = outb + (size_t)(so[pe[k]] + ps[k]) * 1024; gn[k] = pg[k]; \
        _Pragma("unroll") for (int j = 0; j < 4; ++j) wn[k][j] = *(const u32x2*)(src_ + c.lane * 4 + 256 * j); } row_load(Xin + (size_t)(row) * D, c.lane, xn); } while (0)
    if (r < R) { CB_TK(r); CB_DATA(r); }
    if (r + stride < R) CB_TK(r + stride);
    for (; r < R; r += stride) {
        const float* m = c.modp(layer, r < C ? 1 : 0);
        f32x4 y[4], x[4];
#pragma unroll
        for (int j = 0; j < 4; ++j) { y[j] = (f32x4){0.f, 0.f, 0.f, 0.f}; x[j] = xn[j]; }
#pragma unroll
        for (int k = 0; k < 4; ++k)
#pragma unroll
            for (int j = 0; j < 4; ++j) { const u32x2 w = wn[k][j]; y[j] += (f32x4){bflo(w.x), bfhi(w.x), bflo(w.y), bfhi(w.y)} * gn[k]; }
        if (r + stride < R) CB_DATA(r + stride);
        if (r + 2 * stride < R) CB_TK(r + 2 * stride);
        const float rstd_y = rsqrtf(row_ss(y) * (1.f / D) + EPS);
#pragma unroll
        for (int j = 0; j < 4; ++j) {
            const int c0 = c.lane * 4 + 256 * j;
            const f32x4 g2 = *(const f32x4*)(m + 5120 + c0), n3 = *(const f32x4*)(ngl + 3 * D + c0);
            x[j].x += g2.x * (y[j].x * rstd_y * n3.x); x[j].y += g2.y * (y[j].y * rstd_y * n3.y);
            x[j].z += g2.z * (y[j].z * rstd_y * n3.z); x[j].w += g2.w * (y[j].w * rstd_y * n3.w);
            if (layer == 0) *(f32x4*)(X + (size_t)r * D + c0) = x[j];
            else *(f32x4*)(c.a->out + (size_t)(r - C) * D + c0) = x[j];
        }
        if (layer == 0) {
            const float rstd_x = rsqrtf(row_ss(x) * (1.f / D) + EPS);
            const float* m1 = c.modp(1, r < C ? 1 : 0);
            row_modnorm_store(x, rstd_x, c.a->in[6] + 4 * D, m1 + 0, m1 + 1024, H + (size_t)r * D, c.lane);
        }
    }
#undef CB_TK
#undef CB_DATA
}

namespace hg {
typedef _Float16 h2_t __attribute__((ext_vector_type(2)));
constexpr int TB = 272, PB = 144;
constexpr int TILE = 64 * TB;
constexpr int T_QD = 0, T_QC = TILE, T_KD = 2 * TILE, T_KE = 3 * TILE, T_KC = 4 * TILE, T_V0 = 5 * TILE, T_V1 = 6 * TILE;
constexpr int T_QL1 = 7 * TILE, T_KL1 = T_QL1 + 16 * TB, T_P = T_KL1 + 16 * TB, T_TOT = T_P + 64 * PB, T_CT = T_TOT + 4096, T_END = T_CT + 512;
static_assert(T_END <= LDS_BYTES - 64, "hgrn scan LDS map");
__device__ __forceinline__ int row_of(int dir, int p) { return p < C ? (dir ? C - 1 - p : p) : (dir ? C + (L - 1 - (p - C)) : p); }
__device__ __forceinline__ int seg_of(int ch) { return ch < 68 ? ch / 17 : 4 + (ch - 68) / 16; }
__device__ __forceinline__ bf16x8 tr_frag(const LAS unsigned char* tile, int row0, int col0, int lane) {
    const int q = (lane & 15) >> 2, p = lane & 3;
    const LAS unsigned char* a = tile + (row0 + q) * TB + (col0 + 4 * p) * 2;
    const v4i16_t lo = __builtin_amdgcn_ds_read_tr16_b64_v4i16((LAS v4i16_t*)a);
    const v4i16_t hi = __builtin_amdgcn_ds_read_tr16_b64_v4i16((LAS v4i16_t*)(a + 4 * TB));
    return (bf16x8){lo[0], lo[1], lo[2], lo[3], hi[0], hi[1], hi[2], hi[3]};
}
}

__device__ __forceinline__ void phase_hgrn_scan(const Ctx& c) {
    using namespace hg;
#define HG_BAR() asm volatile("s_waitcnt lgkmcnt(0)\n\ts_barrier" ::: "memory")
    const bf16_t* QH = (const bf16_t*)(c.ws + WS_QH); const bf16_t* IV = (const bf16_t*)(c.ws + WS_IV);
    LAS unsigned char* lds = c.lds;
    const int tid = c.tid, lane = c.lane, w = __builtin_amdgcn_readfirstlane(tid >> 6), fr = lane & 15, g = lane >> 4;
    for (int item_ = c.wg; item_ < 256 * SCAN_REP; item_ += c.nwg) {
        const int item = item_ & 255;
        const int chain = item >> 4, seg = item & 15, head = chain >> 1, dir = chain & 1, hc = head * 128;
        const int c0 = seg < 4 ? 17 * seg : 68 + 16 * (seg - 4), nch = seg < 4 ? 17 : 16;
        const _Float16* KX = (const _Float16*)(c.ws + (dir ? WS_KB : WS_KF));
        float* OL = (float*)(c.ws + (dir ? WS_OB : WS_OF)); bf16_t* QS = (bf16_t*)(c.ws + (dir ? WS_QSB : WS_QSF));
        HG_BAR();
        for (int i = tid; i < 64 * PB / 4; i += 512) ((LAS unsigned*)(lds + T_P))[i] = 0u;
        f32x4 Sacc[8];
#pragma unroll
        for (int m = 0; m < 8; ++m) Sacc[m] = (f32x4){0.f, 0.f, 0.f, 0.f};
        float dseg0 = 1.f, dseg1 = 1.f;
        unsigned kraw[8], qraw[8]; u32x4 vraw[2];
#define HG_LOAD(cidx) do { const int p0_ = 64 * (cidx); const bool lat_ = (cidx) >= 4; \
        _Pragma("unroll") for (int i = 0; i < 8; ++i) { const int r_ = row_of(dir, p0_ + 8 * w + i); \
            kraw[i] = *(const unsigned*)(KX + (size_t)r_ * D + hc + 2 * lane); \
            qraw[i] = lat_ ? *(const unsigned*)(QH + (size_t)(r_ - C) * D + hc + 2 * lane) : 0u; } \
        _Pragma("unroll") for (int i = 0; i < 2; ++i) { const int idx_ = tid + 512 * i; const int r_ = row_of(dir, p0_ + (idx_ >> 4)); \
            vraw[i] = *(const u32x4*)(IV + (size_t)r_ * D + hc + (idx_ & 15) * 8); } } while (0)
        HG_LOAD(c0);
        for (int ci = 0; ci < nch; ++ci) {
            const int cidx = c0 + ci; const bool lat = cidx >= 4;
            const int vbuf = (ci & 1) ? T_V1 : T_V0;
            float kf[8][2], qf[8][2], cp[8][2];
            {
                float p0 = 1.f, p1 = 1.f;
#pragma unroll
                for (int i = 0; i < 8; ++i) {
                    const h2_t hv = __builtin_bit_cast(h2_t, kraw[i]);
                    kf[i][0] = (float)hv[0]; kf[i][1] = (float)hv[1];
                    qf[i][0] = bflo(qraw[i]); qf[i][1] = bfhi(qraw[i]);
                    p0 *= (1.f - kf[i][0]); p1 *= (1.f - kf[i][1]); cp[i][0] = p0; cp[i][1] = p1;
                }
                *(LAS f32x2*)(lds + T_TOT + (w * 128 + 2 * lane) * 4) = (f32x2){p0, p1};
#pragma unroll
                for (int i = 0; i < 2; ++i) { const int idx = tid + 512 * i; *(LAS u32x4*)(lds + vbuf + (idx >> 4) * TB + (idx & 15) * 16) = vraw[i]; }
            }
            HG_BAR();
            {
                f32x2 T[8];
#pragma unroll
                for (int x = 0; x < 8; ++x) T[x] = *(const LAS f32x2*)(lds + T_TOT + (x * 128 + 2 * lane) * 4);
                const int I = w >> 1, hh = w & 1;
                f32x2 bd[4];
#pragma unroll
                for (int x = 0; x < 4; ++x) bd[x] = T[2 * x] * T[2 * x + 1];
                f32x2 pre = (f32x2){1.f, 1.f}, cum = (f32x2){1.f, 1.f}, suf = (f32x2){1.f, 1.f}, bdI = (f32x2){1.f, 1.f};
#pragma unroll
                for (int x = 0; x < 8; ++x) if (hh && x == w - 1) pre = T[x];
#pragma unroll
                for (int x = 0; x < 4; ++x) { if (x < I) cum = cum * bd[x]; if (x > I) suf = suf * bd[x]; if (x == I) bdI = bd[x]; }
                const f32x2 ctot = (bd[0] * bd[1]) * (bd[2] * bd[3]);
#pragma unroll
                for (int i = 0; i < 8; ++i) {
                    const int tau = 8 * w + i;
                    float QDv[2], KDv[2], KEv[2], QCv[2], KCv[2];
#pragma unroll
                    for (int x = 0; x < 2; ++x) {
                        const float eq = pre[x] * cp[i][x], rc = __builtin_amdgcn_rcpf(eq);
                        QDv[x] = qf[i][x] * eq; KDv[x] = kf[i][x] * rc; KEv[x] = KDv[x] * bdI[x]; QCv[x] = QDv[x] * cum[x]; KCv[x] = KEv[x] * suf[x];
                    }
                    const int to = tau * TB + lane * 4;
                    *(LAS unsigned*)(lds + T_QD + to) = pk2(QDv[0], QDv[1]);
                    *(LAS unsigned*)(lds + T_KD + to) = pk2(KDv[0], KDv[1]);
                    *(LAS unsigned*)(lds + T_KE + to) = pk2(KEv[0], KEv[1]);
                    *(LAS unsigned*)(lds + T_QC + to) = pk2(QCv[0], QCv[1]);
                    *(LAS unsigned*)(lds + T_KC + to) = pk2(KCv[0], KCv[1]);
                    if (I == 3) *(LAS unsigned*)(lds + T_QL1 + (tau - 48) * TB + lane * 4) = pk2(QDv[0] * bd[2][0], QDv[1] * bd[2][1]);
                    if (I == 0) *(LAS unsigned*)(lds + T_KL1 + tau * TB + lane * 4) = pk2(KEv[0] * bd[1][0], KEv[1] * bd[1][1]);
                    if (lat) { const int r = row_of(dir, 64 * cidx + tau); *(unsigned*)(QS + (size_t)(r - C) * D + hc + 2 * lane) = pk2(QCv[0] * dseg0, QCv[1] * dseg1); }
                }
                dseg0 *= ctot[0]; dseg1 *= ctot[1];
                if (w == 0) *(LAS f32x2*)(lds + T_CT + lane * 8) = ctot;
            }
            HG_BAR();
            if (ci + 1 < nch) HG_LOAD(cidx + 1);
            if (lat) {
                const int nblk = w >= 6 ? 2 : 1;
                for (int b = 0; b < nblk; ++b) {
                    int I, J, qoff, qrow, koff, krow; bool diag = false;
                    if (w < 4) { I = 2 + (w >> 1); J = w & 1; qoff = (w >> 1) ? T_QL1 : T_QD; qrow = (w >> 1) ? 0 : 32; koff = (w & 1) ? T_KE : T_KL1; krow = (w & 1) ? 16 : 0; }
                    else if (w == 4) { I = 1; J = 0; qoff = T_QD; qrow = 16; koff = T_KE; krow = 0; }
                    else if (w == 5) { I = 3; J = 2; qoff = T_QD; qrow = 48; koff = T_KE; krow = 32; }
                    else { I = 2 * (w - 6) + b; J = I; qoff = T_QD; qrow = 16 * I; koff = T_KD; krow = 16 * I; diag = true; }
                    f32x4 pa = (f32x4){0.f, 0.f, 0.f, 0.f};
#pragma unroll
                    for (int ks = 0; ks < 4; ++ks) {
                        const bf16x8 av = *(const LAS bf16x8*)(lds + qoff + (qrow + fr) * TB + (32 * ks + 8 * g) * 2);
                        const bf16x8 bv = *(const LAS bf16x8*)(lds + koff + (krow + fr) * TB + (32 * ks + 8 * g) * 2);
                        pa = __builtin_amdgcn_mfma_f32_16x16x32_bf16(av, bv, pa, 0, 0, 0);
                    }
#pragma unroll
                    for (int e = 0; e < 4; ++e) {
                        const int tl = 4 * g + e; const float val = (diag && fr > tl) ? 0.f : pa[e];
                        *(LAS bf16_t*)(lds + T_P + (16 * I + tl) * PB + (16 * J + fr) * 2) = (bf16_t)f2bf(val);
                    }
                }
            }
            f32x4 oacc[4];
#pragma unroll
            for (int m = 0; m < 4; ++m) oacc[m] = (f32x4){0.f, 0.f, 0.f, 0.f};
            if (lat) {
                bf16x8 Sb[4];
#pragma unroll
                for (int ks = 0; ks < 4; ++ks) {
                    const f32x4 a0 = Sacc[2 * ks], a1 = Sacc[2 * ks + 1];
                    const u32x4 pk = (u32x4){pk2(a0[0], a0[1]), pk2(a0[2], a0[3]), pk2(a1[0], a1[1]), pk2(a1[2], a1[3])};
                    Sb[ks] = __builtin_bit_cast(bf16x8, pk);
                }
#pragma unroll
                for (int m = 0; m < 4; ++m)
#pragma unroll
                    for (int ks = 0; ks < 4; ++ks) {
                        const u32x2 lo = *(const LAS u32x2*)(lds + T_QC + (16 * m + fr) * TB + (32 * ks + 4 * g) * 2);
                        const u32x2 hi = *(const LAS u32x2*)(lds + T_QC + (16 * m + fr) * TB + (32 * ks + 16 + 4 * g) * 2);
                        const u32x4 pk = (u32x4){lo.x, lo.y, hi.x, hi.y};
                        oacc[m] = __builtin_amdgcn_mfma_f32_16x16x32_bf16(__builtin_bit_cast(bf16x8, pk), Sb[ks], oacc[m], 0, 0, 0);
                    }
            }
#pragma unroll
            for (int m = 0; m < 8; ++m) { const f32x4 ct = *(const LAS f32x4*)(lds + T_CT + (16 * m + 4 * g) * 4); Sacc[m] = Sacc[m] * ct; }
            bf16x8 Vf[2];
#pragma unroll
            for (int ks = 0; ks < 2; ++ks) Vf[ks] = tr_frag(lds + vbuf, 32 * ks + 8 * g, 16 * w, lane);
#pragma unroll
            for (int m = 0; m < 8; ++m)
#pragma unroll
                for (int ks = 0; ks < 2; ++ks) Sacc[m] = __builtin_amdgcn_mfma_f32_16x16x32_bf16(tr_frag(lds + T_KC, 32 * ks + 8 * g, 16 * m, lane), Vf[ks], Sacc[m], 0, 0, 0);
            HG_BAR();
            if (lat) {
#pragma unroll
                for (int m = 0; m < 4; ++m)
#pragma unroll
                    for (int ks = 0; ks < 2; ++ks) {
                        if (m < 2 && ks == 1) continue;
                        const bf16x8 av = *(const LAS bf16x8*)(lds + T_P + (16 * m + fr) * PB + (32 * ks + 8 * g) * 2);
                        oacc[m] = __builtin_amdgcn_mfma_f32_16x16x32_bf16(av, Vf[ks], oacc[m], 0, 0, 0);
                    }
#pragma unroll
                for (int m = 0; m < 4; ++m)
#pragma unroll
                    for (int e = 0; e < 4; ++e) { const int r = row_of(dir, 64 * cidx + 16 * m + 4 * g + e); OL[(size_t)(r - C) * D + hc + 16 * w + fr] = oacc[m][e]; }
            }
        }
#undef HG_LOAD
        float* DS = (float*)(c.ws + WS_DS) + (size_t)item * 16384; float* DG = (float*)(c.ws + WS_DG) + item * 128;
#pragma unroll
        for (int m = 0; m < 8; ++m)
#pragma unroll
            for (int e = 0; e < 4; ++e) DS[(16 * m + 4 * g + e) * 128 + 16 * w + fr] = Sacc[m][e];
        if (w == 0) { DG[2 * lane] = dseg0; DG[2 * lane + 1] = dseg1; }
    }
}

#undef HG_BAR
__device__ __forceinline__ void phase_hgrn_fold(const Ctx& c) {
    const float* DS = (const float*)(c.ws + WS_DS); const float* DG = (const float*)(c.ws + WS_DG); bf16_t* SST = (bf16_t*)(c.ws + WS_SST);
    for (int item = c.wg; item < 256; item += c.nwg) {
        const int chain = item >> 4, slice = item & 15, d = 8 * slice + (c.tid >> 6), v2 = (c.tid & 63) * 2;
        float s0 = 0.f, s1 = 0.f;
        float dv[15]; f32x2 ds[15];
#pragma unroll
        for (int sgi = 0; sgi < 15; ++sgi) { dv[sgi] = DG[(chain * 16 + sgi) * 128 + d]; ds[sgi] = *(const f32x2*)(DS + ((size_t)(chain * 16 + sgi) * 128 + d) * 128 + v2); }
        SST[((size_t)(chain * 16) * 128 + v2) * 128 + d] = 0; SST[((size_t)(chain * 16) * 128 + v2 + 1) * 128 + d] = 0;
#pragma unroll
        for (int sgi = 0; sgi < 15; ++sgi) {
            s0 = dv[sgi] * s0 + ds[sgi][0]; s1 = dv[sgi] * s1 + ds[sgi][1];
            SST[((size_t)(chain * 16 + sgi + 1) * 128 + v2) * 128 + d] = (bf16_t)f2bf(s0); SST[((size_t)(chain * 16 + sgi + 1) * 128 + v2 + 1) * 128 + d] = (bf16_t)f2bf(s1);
        }
    }
}

__device__ __forceinline__ void phase_hgrn_readout(const Ctx& c) {
    constexpr int SP = 272, SBUF = 128 * SP, IBUF = 2 * SBUF;
    static_assert(2 * IBUF + 1024 <= LDS_BYTES - 64, "readout LDS map");
    const float* OF = (const float*)(c.ws + WS_OF); const float* OB = (const float*)(c.ws + WS_OB); const bf16_t* SGp = (const bf16_t*)(c.ws + WS_SG);
    const bf16_t* SST = (const bf16_t*)(c.ws + WS_SST); bf16_t* RR = (bf16_t*)(c.ws + WS_RR); const float* hng = c.a->in[13];
    LAS unsigned char* lds = c.lds; LAS float* ssx = (LAS float*)(c.lds + 2 * IBUF);
    const int tid = c.tid, lane = c.lane, w = __builtin_amdgcn_readfirstlane(tid >> 6), fr = lane & 15, g = lane >> 4, mt = w & 3, nh = w >> 2;
#define RO_BAR() asm volatile("s_waitcnt lgkmcnt(0)\n\ts_barrier" ::: "memory")
    u32x4 sreg[8];
#define RO_SST_LOAD(it) do { const int h_ = (it) >> 8, ch_ = (it) & 255; \
        _Pragma("unroll") for (int j = 0; j < 8; ++j) { const int idx_ = tid + 512 * j, dx_ = idx_ >> 11, rem_ = idx_ & 2047; \
            const int sg_ = hg::seg_of(dx_ ? 4 + 255 - ch_ : 4 + ch_); \
            sreg[j] = *(const u32x4*)(SST + ((size_t)((h_ * 2 + dx_) * 16 + sg_) * 128 + (rem_ >> 4)) * 128 + (rem_ & 15) * 8); } } while (0)
#define RO_SST_WRITE(buf) do { _Pragma("unroll") for (int j = 0; j < 8; ++j) { const int idx_ = tid + 512 * j, dx_ = idx_ >> 11, rem_ = idx_ & 2047; \
            *(LAS u32x4*)(lds + (buf) * IBUF + dx_ * SBUF + (rem_ >> 4) * SP + (rem_ & 15) * 16) = sreg[j]; } } while (0)
    int it = c.wg;
    RO_BAR();
    if (it < 2048) { RO_SST_LOAD(it); RO_SST_WRITE(0); }
    RO_BAR();
    for (int k = 0; it < 2048; it += c.nwg, ++k) {
        const int h = it >> 8, ch = it & 255, t0 = 64 * ch + 16 * mt, buf = k & 1;
        const bool has_next = it + c.nwg < 2048;
        if (has_next) RO_SST_LOAD(it + c.nwg);
        f32x4 acc[4]; float sgv[4][4];
#pragma unroll
        for (int n = 0; n < 4; ++n)
#pragma unroll
            for (int e = 0; e < 4; ++e) { const size_t o = (size_t)(t0 + 4 * g + e) * D + h * 128 + 64 * nh + 16 * n + fr; acc[n][e] = OF[o] + OB[o]; sgv[n][e] = bf2f(SGp[o]) * hng[h * 128 + 64 * nh + 16 * n + fr]; }
#pragma unroll
        for (int dx = 0; dx < 2; ++dx) {
            const bf16_t* QS = (const bf16_t*)(c.ws + (dx ? WS_QSB : WS_QSF)) + (size_t)(t0 + fr) * D + h * 128 + 8 * g;
            const LAS unsigned char* sb = lds + buf * IBUF + dx * SBUF + (64 * nh + fr) * SP + 16 * g;
#pragma unroll
            for (int ks = 0; ks < 4; ++ks) {
                const bf16x8 av = *(const bf16x8*)(QS + 32 * ks);
#pragma unroll
                for (int n = 0; n < 4; ++n) acc[n] = __builtin_amdgcn_mfma_f32_16x16x32_bf16(av, *(const LAS bf16x8*)(sb + (16 * n) * SP + 64 * ks), acc[n], 0, 0, 0);
            }
        }
        float ss[4] = {0.f, 0.f, 0.f, 0.f};
#pragma unroll
        for (int n = 0; n < 4; ++n)
#pragma unroll
            for (int e = 0; e < 4; ++e) ss[e] += acc[n][e] * acc[n][e];
#pragma unroll
        for (int e = 0; e < 4; ++e) {
#pragma unroll
            for (int sh = 8; sh > 0; sh >>= 1) ss[e] += __shfl_xor(ss[e], sh);
        }
        if (fr == 0) *(LAS f32x4*)(ssx + ((k & 1) * 8 + w) * 16 + 4 * g) = (f32x4){ss[0], ss[1], ss[2], ss[3]};
        if (has_next) RO_SST_WRITE(buf ^ 1);
        RO_BAR();
        const f32x4 ps = *(const LAS f32x4*)(ssx + ((k & 1) * 8 + (w ^ 4)) * 16 + 4 * g);
#pragma unroll
        for (int e = 0; e < 4; ++e) ss[e] = rsqrtf((ss[e] + ps[e]) * (1.f / 128.f) + EPS);
#pragma unroll
        for (int n = 0; n < 4; ++n)
#pragma unroll
            for (int e = 0; e < 4; ++e) { const size_t o = (size_t)(t0 + 4 * g + e) * D + h * 128 + 64 * nh + 16 * n + fr; RR[o] = (bf16_t)f2bf(acc[n][e] * ss[e] * sgv[n][e]); }
    }
    RO_BAR();
#undef RO_BAR
#undef RO_SST_LOAD
#undef RO_SST_WRITE
}

#define XB_TMO      128
#define XB_XCNT(j)  (256  + 64 * (j))
#define XB_XSUB(j)  (1280 + 64 * (j))
#define XB_XGEN(j)  (2304 + 64 * (j))
#define XB_TOP      3328
#define XB_TOPGEN   3392
#define XCD_BAR_WORDS 3456
#define XB_SPIN_CAP (1u << 18)
__device__ __forceinline__ unsigned xb_ld(unsigned* p)              { return __hip_atomic_load(p, __ATOMIC_RELAXED, __HIP_MEMORY_SCOPE_AGENT); }
__device__ __forceinline__ unsigned xb_add(unsigned* p, unsigned v) { return __hip_atomic_fetch_add(p, v, __ATOMIC_RELAXED, __HIP_MEMORY_SCOPE_AGENT); }
__device__ __forceinline__ unsigned xb_xcc_id() { return (unsigned)__builtin_amdgcn_s_getreg((3 << 11) | 20) & 0xFu; }
#define XB_SPIN(cond, bar) do { unsigned _sp = 0; while (cond) { __builtin_amdgcn_s_sleep(1); \
    if ((++_sp & 255u) == 0u) { if (xb_ld(&(bar)[XB_TMO])) break; if (_sp > XB_SPIN_CAP) { atomicAdd(&(bar)[XB_TMO], 1u); break; } } } } while (0)
struct XcdBarrier { unsigned* bar; unsigned x; volatile LAS unsigned* st; };
__device__ __forceinline__ XcdBarrier xcd_barrier_post(unsigned* bar, volatile LAS unsigned* st) {
    XcdBarrier b; b.bar = bar; b.x = xb_xcc_id(); b.st = st;
    if (threadIdx.x == 0) (void)xb_add(&bar[XB_XCNT(b.x)], 1u);
    return b;
}
__device__ __forceinline__ void xcd_barrier_complete(unsigned* bar, unsigned x, unsigned& nloc, unsigned& nx) {
    const unsigned G = gridDim.x * gridDim.y * gridDim.z;
    unsigned sum, cnt, mine, sp = 0u;
    for (;;) {
        sum = 0u; cnt = 0u; mine = 0u;
#pragma unroll
        for (unsigned j = 0; j < 16; ++j) { const unsigned c = xb_ld(&bar[XB_XCNT(j)]); sum += c; cnt += (c > 0u) ? 1u : 0u; mine = (j == x) ? c : mine; }
        if (sum == G) break;
        __builtin_amdgcn_s_sleep(1);
        if ((++sp & 255u) == 0u) { if (xb_ld(&bar[XB_TMO])) break; if (sp > XB_SPIN_CAP) { atomicAdd(&bar[XB_TMO], 1u); break; } }
    }
    nloc = mine > 0u ? mine : 1u; nx = cnt > 0u ? cnt : 1u;
}
__device__ __forceinline__ void xcd_barrier(const XcdBarrier& b) {
    asm volatile("s_waitcnt vmcnt(0)" ::: "memory");
    __syncthreads();
    if (threadIdx.x == 0) {
        unsigned* bar = b.bar;
        __builtin_amdgcn_s_waitcnt(0);
        unsigned nloc = b.st[0], nx = b.st[1];
        if (nloc == 0u) { xcd_barrier_complete(bar, b.x, nloc, nx); b.st[0] = nloc; b.st[1] = nx; }
        const unsigned old = xb_add(&bar[XB_XSUB(b.x)], 1u);
        const unsigned gen = old / nloc;
        if (old + 1u == (gen + 1u) * nloc) {
            __builtin_amdgcn_fence(__ATOMIC_RELEASE, "agent");
            asm volatile("s_waitcnt vmcnt(0)" ::: "memory");
            const unsigned og = xb_add(&bar[XB_TOP], 1u);
            const unsigned tg = og / nx;
            if (og + 1u == (tg + 1u) * nx) xb_add(&bar[XB_TOPGEN], 1u);
            else XB_SPIN(xb_ld(&bar[XB_TOPGEN]) == tg, bar);
            __builtin_amdgcn_fence(__ATOMIC_ACQUIRE, "agent");
            xb_add(&bar[XB_XGEN(b.x)], 1u);
            asm volatile("s_waitcnt vmcnt(0)" ::: "memory");
        } else {
            XB_SPIN(xb_ld(&bar[XB_XGEN(b.x)]) == gen, bar);
            __builtin_amdgcn_fence(__ATOMIC_ACQUIRE, "agent");
            asm volatile("s_waitcnt vmcnt(0)" ::: "memory");
        }
    }
    __syncthreads();
}

__device__ __forceinline__ void launder(Ctx& c) { asm volatile("" : "+s"(c.a)); asm volatile("" : "+s"(c.ws)); asm volatile("" : "+s"(c.wave));
    c.lane = (int)__builtin_amdgcn_mbcnt_hi(~0u, __builtin_amdgcn_mbcnt_lo(~0u, 0u)); c.tid = c.wave * 64 + c.lane; }
__global__ void __launch_bounds__(512, 2) mk_fwd(Args args) {
    extern __shared__ __attribute__((aligned(16))) unsigned char lds_raw[];
    Ctx c; c.a = (CArgs)__builtin_amdgcn_kernarg_segment_ptr(); c.lds = (LAS unsigned char*)lds_raw; c.tid = threadIdx.x; c.lane = c.tid & 63; c.wave = __builtin_amdgcn_readfirstlane(c.tid >> 6); c.nwg = gridDim.x; c.wg = blockIdx.x; c.ws = c.a->ws;
    volatile LAS unsigned* bst = (volatile LAS unsigned*)(c.lds + LDS_BYTES - 64);
    if (c.tid < 4) bst[c.tid] = 0u;
    __syncthreads();
    const XcdBarrier bar = xcd_barrier_post((unsigned*)(c.ws + WS_CTL) + CW_BAR, bst);
    const int lo = c.a->ph_lo, hi = c.a->ph_hi;
    bool route_ok = true;
#define SEAM(k) do { if (lo <= (k) && (k) + 1 < hi) xcd_barrier(bar); } while (0)
#define IN(k) (lo <= (k) && (k) < hi && (launder(c), true))
#define PH(k, call) do { if (IN(k)) { if (PROBE_PH == (k)) { int nrep_ = 3; asm volatile("" : "+s"(nrep_)); for (int rep_ = 0; rep_ < nrep_; ++rep_) { route_ok = (rep_ + 1 == nrep_); call; if (rep_ + 1 < nrep_) xcd_barrier(bar); } } else { call; } } SEAM(k); } while (0)
    PH(0, phase_prep(c));
    PH(1, phase_convert(c));
    PH(2, phase_gemm_qkv(c));
    PH(3, phase_attn(c));
    PH(4, phase_gemm_f32(c, (const bf16_t*)(c.ws + WS_O), R, (const bf16_t*)(c.ws + WS_WO), D, nullptr, (float*)(c.ws + WS_RAW1)));
    PH(5, phase_postmix(c, 0, route_ok));
    PH(6, phase_moe_gu(c, 0));
    PH(7, phase_moe_dn(c, 0));
    PH(8, phase_combine(c, 0));
    PH(9, phase_gemm_inproj(c));
    PH(10, phase_hgrn_scan(c));
    PH(11, phase_hgrn_fold(c));
    PH(12, phase_hgrn_readout(c));
    PH(13, phase_gemm_f32(c, (const bf16_t*)(c.ws + WS_RR), L, (const bf16_t*)(c.ws + WS_WHO), D, nullptr, (float*)(c.ws + WS_RAW1)));
    PH(14, phase_postmix(c, 1, route_ok));
    PH(15, phase_moe_gu(c, 1));
    PH(16, phase_moe_dn(c, 1));
    PH(17, phase_combine(c, 1));
#undef IN
#undef PH
#undef SEAM
}

extern "C" void kernel_launch(void* const* d_in, const int* in_sizes, int n_in, void* d_out, int out_size, void* d_ws, size_t ws_size, hipStream_t stream) {
    static int grid = 0;
    if (grid == 0) {
        if (n_in != 21 || out_size != L * D || ws_size < WS_END) { fprintf(stderr, "kernel_launch: unexpected problem (n_in %d out %d ws %zu need %zu)\n", n_in, out_size, ws_size, (size_t)WS_END); grid = -1; return; }
        int dev = 0, cus = 0, per_cu = 0;
        hipGetDevice(&dev); hipDeviceGetAttribute(&cus, hipDeviceAttributeMultiprocessorCount, dev);
        if (hipFuncSetAttribute((const void*)mk_fwd, hipFuncAttributeMaxDynamicSharedMemorySize, LDS_BYTES) != hipSuccess) { fprintf(stderr, "kernel_launch: hipFuncSetAttribute failed\n"); grid = -1; return; }
        hipOccupancyMaxActiveBlocksPerMultiprocessor(&per_cu, (const void*)mk_fwd, 512, LDS_BYTES);
        if (per_cu < 1) fprintf(stderr, "kernel_launch: occupancy query says %d\n", per_cu);
        (void)hipGetLastError();
        grid = cus > 0 ? cus : 256;
    }
    if (grid < 0) return;
    hipMemsetAsync((char*)d_ws + WS_CTL, 0, MiB, stream);
    Args a{};
    for (int i = 0; i < 21; ++i) a.in[i] = (const float*)d_in[i];
    a.out = (float*)d_out; a.ws = (unsigned char*)d_ws;
    a.ph_lo = 0; a.ph_hi = NPHASE;
    hipLaunchKernelGGL(mk_fwd, dim3(grid), dim3(512), LDS_BYTES, stream, a);
}
```

```cpp
#include <hip/hip_runtime.h>
#include <cstdint>
#include <cstdio>

#define LAS __attribute__((address_space(3)))
typedef unsigned short bf16_t;
typedef short bf16x8 __attribute__((ext_vector_type(8)));
typedef float f32x4 __attribute__((ext_vector_type(4)));
typedef unsigned u32x4 __attribute__((ext_vector_type(4)));
typedef unsigned u32x2 __attribute__((ext_vector_type(2)));
typedef short v4i16_t __attribute__((ext_vector_type(4)));
typedef float f32x2 __attribute__((ext_vector_type(2)));

constexpr int D = 1024, L = 16384, C = 256, R = L + C;
constexpr int QKVD = 1280, HIN = 5120, NE = 32, TOPK = 4;
constexpr int PADM = 256, MAXROWS = 74752;
constexpr float EPS = 1e-6f;
constexpr float LOG2E = 1.4426950408889634f;
constexpr int NPHASE = 18;
#ifndef GEMM_REP
#define GEMM_REP 1
#endif
#ifndef PROBE_NOEPI
#define PROBE_NOEPI 0
#endif
#ifndef PROBE_SHORTK
#define PROBE_SHORTK 0
#endif
#ifndef SCAN_REP
#define SCAN_REP 1
#endif
#ifndef PROBE_PH
#define PROBE_PH (-1)
#endif
constexpr int LDS_BYTES = 147456;

constexpr size_t MiB = 1u << 20;
constexpr size_t al(size_t x) { return (x + MiB - 1) / MiB * MiB; }
constexpr size_t WS_CTL = 0;
constexpr size_t WS_MOD = WS_CTL + MiB;
constexpr size_t WS_X = WS_MOD + MiB;
constexpr size_t WS_H = WS_X + al((size_t)R * D * 4);
constexpr size_t WS_Q = WS_H + al((size_t)R * D * 2);
constexpr size_t WS_K = WS_Q + al((size_t)R * D * 2);
constexpr size_t WS_V = WS_K + al((size_t)R * 128 * 2);
constexpr size_t WS_O = WS_V + al((size_t)R * 128 * 2);
constexpr size_t WS_TK = WS_O + al((size_t)R * D * 2);
constexpr size_t WS_LIST = WS_TK + MiB;
constexpr size_t WS_HDN = WS_LIST + 3 * MiB;
constexpr size_t WS_RAW1 = WS_HDN + al((size_t)MAXROWS * 1024 * 2);
constexpr size_t WS_X1 = WS_RAW1 + al((size_t)R * D * 4);
constexpr size_t WS_OUTB = WS_X1 + al((size_t)R * D * 4);
constexpr size_t WS_QH = WS_OUTB + al((size_t)MAXROWS * 1024 * 2);
constexpr size_t WS_KF = WS_QH + al((size_t)L * D * 2);
constexpr size_t WS_KB = WS_KF + al((size_t)R * D * 2);
constexpr size_t WS_IV = WS_KB + al((size_t)R * D * 2);
constexpr size_t WS_SG = WS_IV + al((size_t)R * D * 2);
constexpr size_t WS_OF = WS_SG + al((size_t)L * D * 2);
constexpr size_t WS_OB = WS_OF + al((size_t)L * D * 4);
constexpr size_t WS_RR = WS_OB + al((size_t)L * D * 4);
constexpr size_t WS_WQKV = WS_RR + al((size_t)L * D * 2);
constexpr size_t WS_WO = WS_WQKV + al((size_t)QKVD * D * 2);
constexpr size_t WS_WIN = WS_WO + al((size_t)D * D * 2);
constexpr size_t WS_WHO = WS_WIN + al((size_t)HIN * D * 2);
constexpr size_t WS_WGU = WS_WHO + al((size_t)D * D * 2);
constexpr size_t WS_WDN = WS_WGU + al((size_t)2 * NE * 2048 * D * 2);
constexpr size_t WS_QSF = WS_WDN + al((size_t)2 * NE * 1024 * D * 2);
constexpr size_t WS_QSB = WS_QSF + al((size_t)L * D * 2);
constexpr size_t WS_DS = WS_QSB + al((size_t)L * D * 2);
constexpr size_t WS_DG = WS_DS + al((size_t)256 * 128 * 128 * 4);
constexpr size_t WS_SST = WS_DG + MiB;
constexpr size_t WS_H8 = WS_SST + al((size_t)256 * 128 * 128 * 2);
constexpr size_t WS_END = WS_H8 + al((size_t)R * D);
static_assert(WS_END <= (size_t)2048 * MiB, "workspace map exceeds 4x the largest input");
constexpr int CW_CNT = 1024;
constexpr int CW_CONV = 2048;
constexpr int CW_BAR = 4096;
constexpr int MOD_ROPE = 32768;
constexpr int MOD_LB = 49152;

struct Args { const float* in[21]; float* out; unsigned char* ws; int ph_lo, ph_hi; };

__device__ __forceinline__ unsigned f2bf(float f) { unsigned u = __float_as_uint(f); return (u + 0x7fffu + ((u >> 16) & 1u)) >> 16; }
typedef float f32x2_t __attribute__((ext_vector_type(2))); typedef __bf16 bf16x2_t __attribute__((ext_vector_type(2)));
__device__ __forceinline__ unsigned pk2(float lo, float hi) { f32x2_t v = {lo, hi}; bf16x2_t b = __builtin_convertvector(v, bf16x2_t); return __builtin_bit_cast(unsigned, b); }
__device__ __forceinline__ unsigned pk4_fp8(float a, float b, float c, float d) {
    a = fminf(fmaxf(a, -448.f), 448.f); b = fminf(fmaxf(b, -448.f), 448.f); c = fminf(fmaxf(c, -448.f), 448.f); d = fminf(fmaxf(d, -448.f), 448.f);
    int v = __builtin_amdgcn_cvt_pk_fp8_f32(a, b, 0, false); v = __builtin_amdgcn_cvt_pk_fp8_f32(c, d, v, true); return (unsigned)v; }
constexpr float F8_SH = 8.f, F8_SW = 64.f, F8_SHD = 4.f;
__device__ __forceinline__ float bflo(unsigned u) { return __uint_as_float(u << 16); }
__device__ __forceinline__ float bfhi(unsigned u) { return __uint_as_float(u & 0xffff0000u); }
__device__ __forceinline__ float bf2f(bf16_t b) { return __uint_as_float(((unsigned)b) << 16); }
__device__ __forceinline__ float wave_sum(float v) {
#pragma unroll
    for (int o = 32; o > 0; o >>= 1) v += __shfl_xor(v, o);
    return v;
}
__device__ __forceinline__ float silu_f(float x) { return x / (1.f + __expf(-x)); }
__device__ __forceinline__ float sigmoid_f(float x) { return 1.f / (1.f + __expf(-x)); }

typedef const __attribute__((address_space(4))) Args* CArgs;
struct Ctx {
    CArgs a;
    LAS unsigned char* lds;
    int tid, lane, wave, nwg, wg;
    unsigned char* ws;
    __device__ __forceinline__ float* modp(int layer, int which) const { return (float*)(ws + WS_MOD) + (layer * 2 + which) * 6144; }
    __device__ __forceinline__ const float* xin0(int r) const { return r < C ? a->in[2] + (size_t)r * D : a->in[0] + (size_t)(r - C) * D; }
};


namespace pg8 {
constexpr int BM = 256, BK = 64, HALF = 128, HTB = HALF * BK * 2, STAGE_BYTES = 8 * HTB, KD = 1024, NXCD = 8, WGM = 8;
__device__ __forceinline__ int lds_byte(int r, int c) { const int st = (r >> 4) * 2 + (c >> 5), rr = r & 15, cc = c & 31, ob = rr * 64 + cc * 2; return st * 1024 + (ob ^ (((ob >> 9) & 1) << 5)); }
__device__ __forceinline__ void stage_rc(int b, int& Rr, int& Cc) { const int st = b / 1024, sb = b % 1024, swz = sb ^ (((sb >> 9) & 1) << 5); Rr = (st >> 1) * 16 + swz / 64; Cc = (st & 1) * 32 + (swz % 64) / 2; }
__device__ __forceinline__ int perm32(int rho) { const int n = rho >> 4, i = rho & 15; return 8 * (i >> 2) + 4 * n + (i & 3); }

struct Unit { int pm, pn, e, goff, gcnt; bool real; int amask, bmask; };
struct Gemm { const void* A; const void* Bt; size_t bstride; const int* list; };

struct StaticOrder {
    int nM, nN, nwg, G, c;
    __device__ __forceinline__ void init(int M, int N, int G_, int c_) { nM = M / BM; nN = N / BM; nwg = nM * nN; G = G_; c = c_; }
    __device__ __forceinline__ bool next(int i, Unit& u) const {
        const int F = nwg / G, Rm = nwg - F * G; int Lq; u.amask = 3; u.bmask = 3;
        if (i < F) Lq = i * G + c;
        else if (i == F && Rm > 0) {
            if (4 * Rm <= G) { if (c >= 4 * Rm) return false; Lq = F * G + (c >> 2); u.amask = 1 << ((c >> 1) & 1); u.bmask = 1 << (c & 1); }
            else if (2 * Rm <= G) { if (c >= 2 * Rm) return false; Lq = F * G + (c >> 1); u.bmask = 1 << (c & 1); }
            else { if (c >= Rm) return false; Lq = F * G + c; }
        } else return false;
        int wgid = Lq; { const int q = nwg / NXCD, r = nwg % NXCD, xcd = wgid % NXCD, off = wgid / NXCD; wgid = (xcd < r ? xcd * (q + 1) : r * (q + 1) + (xcd - r) * q) + off; }
        const int nig = WGM * nN, gid = wgid / nig, fm = gid * WGM, gsz = (nM - fm) < WGM ? (nM - fm) : WGM;
        u.pm = fm + ((wgid % nig) % gsz); u.pn = (wgid % nig) / gsz; u.e = 0; u.goff = 0; u.gcnt = 0; u.real = true; return true;
    }
};
struct MoeOrder {
    const LAS int* tp; const LAS int* cnt; int npn, G, vcu; bool split;
    __device__ __forceinline__ bool next(int i, Unit& u) const {
        const int tot = tp[32] * npn; int lin; u.amask = 3; u.bmask = 3; u.real = true;
        if (GEMM_REP > 1) { const int lin0 = i * G + vcu; if (lin0 >= tot * GEMM_REP) return false; lin = lin0 % tot; u.real = lin0 >= tot * (GEMM_REP - 1); }
        else {
            const int F = tot / G, Rm = tot - F * G;
            if (i < F) lin = i * G + vcu;
            else if (i == F && Rm > 0) {
                if (split && 2 * Rm <= G) { if (vcu >= 2 * Rm) return false; lin = F * G + (vcu >> 1); u.bmask = 1 << (vcu & 1); }
                else { if (vcu >= Rm) return false; lin = F * G + vcu; }
            } else return false;
        }
        const int rt = lin / npn; int e = 0;
#pragma unroll 8
        for (int k = 1; k < 32; ++k) e += (rt >= tp[k]) ? 1 : 0;
        const int mt = rt - tp[e];
        u.pm = rt; u.pn = lin - rt * npn; u.e = e; u.goff = e * R + mt * 256; u.gcnt = cnt[e] - mt * 256; return true;
    }
};

template <int KB>
__device__ __forceinline__ void a_offsets(const Gemm& g, const Unit& u, const int (&sR)[2], const int (&sC)[2], unsigned (&v)[2][2]) {
#pragma unroll
    for (int h = 0; h < 2; ++h)
#pragma unroll
        for (int i = 0; i < 2; ++i) {
            const int rr = h * HALF + sR[i]; int row;
            if (g.list) row = rr < u.gcnt ? g.list[u.goff + rr] : 0; else row = u.pm * BM + rr;
            v[h][i] = (unsigned)(row * KB + sC[i] * 2);
        }
}

struct EpiF32 {
    static constexpr bool PERM = false;
    float* Cp; int ldc; const float* bias;
    __device__ __forceinline__ void operator()(const f32x4 (&acc)[2][2][4][2], const Unit& u, int wr, int wc, int fr, int fq) const {
        const int row0 = u.pm * BM + wr * 64 + fr, col0 = u.pn * BM + wc * 32 + 4 * fq;
#pragma unroll
        for (int bj = 0; bj < 2; ++bj)
#pragma unroll
            for (int n = 0; n < 2; ++n) {
                const int col = col0 + bj * HALF + n * 16;
                if (!((u.bmask >> bj) & 1)) continue;
                const f32x4 bv = bias ? *(const f32x4*)(bias + col) : (f32x4){0.f, 0.f, 0.f, 0.f};
#pragma unroll
                for (int ai = 0; ai < 2; ++ai)
#pragma unroll
                    for (int m = 0; m < 4; ++m) if ((u.amask >> ai) & 1) *(f32x4*)(Cp + (size_t)(row0 + ai * HALF + m * 16) * ldc + col) = acc[ai][bj][m][n] + bv;
            }
    }
};
struct EpiSwiglu {
    static constexpr bool PERM = true;
    unsigned char* Hd; const float* bgu;
    __device__ __forceinline__ void operator()(const f32x4 (&acc)[2][2][4][2], const Unit& u, int wr, int wc, int fr, int fq) const {
        const int row0 = u.pm * BM + wr * 64 + fr, cg0 = u.pn * HALF + wc * 32 + 8 * fq;
        const float* bb = bgu + (size_t)u.e * 2048;
        f32x4 bg[2], bu[2];
#pragma unroll
        for (int n = 0; n < 2; ++n) { bg[n] = *(const f32x4*)(bb + cg0 + 4 * n); bu[n] = *(const f32x4*)(bb + 1024 + cg0 + 4 * n); }
#pragma unroll
        for (int ai = 0; ai < 2; ++ai)
#pragma unroll
            for (int m = 0; m < 4; ++m) {
                u32x2 o;
#pragma unroll
                for (int n = 0; n < 2; ++n) {
                    const f32x4 gv = acc[ai][0][m][n] * (1.f / (F8_SH * F8_SW)) + bg[n], uv = acc[ai][1][m][n] * (1.f / (F8_SH * F8_SW)) + bu[n]; float hv[4];
#pragma unroll
                    for (int q = 0; q < 4; ++q) { const float gg = fminf(gv[q], 7.f), uu = fminf(fmaxf(uv[q], -7.f), 7.f); hv[q] = gg * (1.f / (1.f + __expf(-1.702f * gg))) * (uu + 1.f); }
                    o[n] = pk4_fp8(hv[0] * F8_SHD, hv[1] * F8_SHD, hv[2] * F8_SHD, hv[3] * F8_SHD);
                }
                *(u32x2*)(Hd + (size_t)(row0 + ai * HALF + m * 16) * 1024 + cg0) = o;
            }
    }
};
struct EpiBf16Bias {
    static constexpr bool PERM = true;
    bf16_t* Op; const float* bias; int bias_estride; float scale;
    __device__ __forceinline__ void operator()(const f32x4 (&acc)[2][2][4][2], const Unit& u, int wr, int wc, int fr, int fq) const {
        const int row0 = u.pm * BM + wr * 64 + fr, col0 = u.pn * BM + wc * 32 + 8 * fq;
        const float* bb = bias + (size_t)u.e * bias_estride;
#pragma unroll
        for (int bj = 0; bj < 2; ++bj) {
            const int col = col0 + bj * HALF;
            if (!((u.bmask >> bj) & 1)) continue;
            const f32x4 b0 = *(const f32x4*)(bb + col), b1 = *(const f32x4*)(bb + col + 4);
#pragma unroll
            for (int ai = 0; ai < 2; ++ai)
#pragma unroll
                for (int m = 0; m < 4; ++m) { if (!((u.amask >> ai) & 1)) continue; const f32x4 v0 = acc[ai][bj][m][0] * scale + b0, v1 = acc[ai][bj][m][1] * scale + b1;
                    u32x4 o; o.x = pk2(v0[0], v0[1]); o.y = pk2(v0[2], v0[3]); o.z = pk2(v1[0], v1[1]); o.w = pk2(v1[2], v1[3]);
                    *(u32x4*)(Op + (size_t)(row0 + ai * HALF + m * 16) * 1024 + col) = o; }
        }
    }
};
struct EpiQKV {
    static constexpr bool PERM = false;
    bf16_t* Qp; bf16_t* Kp; bf16_t* Vp; const float* bias; const float* tab;
    __device__ __forceinline__ void operator()(const f32x4 (&acc)[2][2][4][2], const Unit& u, int wr, int wc, int fr, int fq) const {
        const bool lat = u.pm > 0; const float qs = 0.125f * LOG2E;
#pragma unroll
        for (int bj = 0; bj < 2; ++bj) {
            const int colt = u.pn * BM + bj * HALF + wc * 32 + 4 * fq;
            const f32x4 b1 = *(const f32x4*)(bias + colt), b2 = *(const f32x4*)(bias + colt + 16);
            const bool isv = (u.pn == 4) && (bj == 1);
            if (!((u.bmask >> bj) & 1)) continue;
#pragma unroll
            for (int ai = 0; ai < 2; ++ai)
#pragma unroll
                for (int m = 0; m < 4; ++m) {
                    if (!((u.amask >> ai) & 1)) continue;
                    const int r = u.pm * BM + ai * HALF + wr * 64 + m * 16 + fr, t = r - C;
                    f32x4 x1 = acc[ai][bj][m][0] + b1, x2 = acc[ai][bj][m][1] + b2;
                    if (lat && !isv) {
                        const int pos = (wc & 1) ? (t & 63) : (t >> 6);
                        const f32x4 t0 = *(const f32x4*)(tab + (pos * 16 + 4 * fq) * 2), t1 = *(const f32x4*)(tab + (pos * 16 + 4 * fq) * 2 + 4);
                        const float cs[4] = {t0[0], t0[2], t1[0], t1[2]}, sn[4] = {t0[1], t0[3], t1[1], t1[3]};
                        f32x4 o1, o2;
#pragma unroll
                        for (int e = 0; e < 4; ++e) { o1[e] = x1[e] * cs[e] - x2[e] * sn[e]; o2[e] = x2[e] * cs[e] + x1[e] * sn[e]; }
                        x1 = o1; x2 = o2;
                    }
                    u32x2 w1, w2;
                    if (u.pn < 4) {
                        w1.x = pk2(x1[0] * qs, x1[1] * qs); w1.y = pk2(x1[2] * qs, x1[3] * qs); w2.x = pk2(x2[0] * qs, x2[1] * qs); w2.y = pk2(x2[2] * qs, x2[3] * qs);
                        *(u32x2*)(Qp + (size_t)r * 1024 + colt) = w1; *(u32x2*)(Qp + (size_t)r * 1024 + colt + 16) = w2;
                    } else {
                        w1.x = pk2(x1[0], x1[1]); w1.y = pk2(x1[2], x1[3]); w2.x = pk2(x2[0], x2[1]); w2.y = pk2(x2[2], x2[3]);
                        bf16_t* dst = (bj == 0 ? Kp : Vp) + (size_t)r * 128 + wc * 32 + 4 * fq;
                        *(u32x2*)dst = w1; *(u32x2*)(dst + 16) = w2;
                    }
                }
        }
    }
};
struct EpiInProj {
    static constexpr bool PERM = true;
    bf16_t* QH; _Float16* KF; _Float16* KB; bf16_t* IV; bf16_t* SG; const float* lb;
    __device__ __forceinline__ void operator()(const f32x4 (&acc)[2][2][4][2], const Unit& u, int wr, int wc, int fr, int fq) const {
        const int seg = u.pn >> 2; const bool lat = u.pm > 0;
        if (!lat && (seg == 0 || seg == 4)) return;
        typedef _Float16 h8_t __attribute__((ext_vector_type(8)));
#pragma unroll
        for (int bj = 0; bj < 2; ++bj) {
            const int col = (u.pn & 3) * BM + bj * HALF + wc * 32 + 8 * fq;
            if (!((u.bmask >> bj) & 1)) continue;
            f32x4 lb0 = (f32x4){0.f, 0.f, 0.f, 0.f}, lb1 = lb0;
            if (seg == 1) { lb0 = *(const f32x4*)(lb + col); lb1 = *(const f32x4*)(lb + col + 4); } else if (seg == 2) { lb0 = *(const f32x4*)(lb + 1024 + col); lb1 = *(const f32x4*)(lb + 1024 + col + 4); }
#pragma unroll
            for (int ai = 0; ai < 2; ++ai)
#pragma unroll
                for (int m = 0; m < 4; ++m) {
                    if (!((u.amask >> ai) & 1)) continue;
                    const int r = u.pm * BM + ai * HALF + wr * 64 + m * 16 + fr; const f32x4 v0 = acc[ai][bj][m][0], v1 = acc[ai][bj][m][1];
                    if (seg == 1 || seg == 2) {
                        h8_t hv;
#pragma unroll
                        for (int e = 0; e < 4; ++e) { hv[e] = (_Float16)((1.f - lb0[e]) / (1.f + __expf(v0[e]))); hv[4 + e] = (_Float16)((1.f - lb1[e]) / (1.f + __expf(v1[e]))); }
                        *(h8_t*)((seg == 1 ? KF : KB) + (size_t)r * 1024 + col) = hv;
                    } else if (seg == 3) {
                        u32x4 o; o.x = pk2(v0[0], v0[1]); o.y = pk2(v0[2], v0[3]); o.z = pk2(v1[0], v1[1]); o.w = pk2(v1[2], v1[3]); *(u32x4*)(IV + (size_t)r * 1024 + col) = o;
                    } else {
                        float s0[4], s1[4];
#pragma unroll
                        for (int e = 0; e < 4; ++e) { s0[e] = v0[e] / (1.f + __expf(-v0[e])); s1[e] = v1[e] / (1.f + __expf(-v1[e])); }
                        u32x4 o; o.x = pk2(s0[0], s0[1]); o.y = pk2(s0[2], s0[3]); o.z = pk2(s1[0], s1[1]); o.w = pk2(s1[2], s1[3]); *(u32x4*)((seg == 0 ? QH : SG) + (size_t)(r - C) * 1024 + col) = o;
                    }
                }
        }
    }
};

typedef int v8i __attribute__((ext_vector_type(8)));
template <class Epi, class Sched, bool ALIGN_EPI, bool GATHER, bool FP8>
__device__ __forceinline__ void gemm_phase(LAS unsigned char* lds, const Gemm g, const Sched& S, const Epi& E, const int tid) {
    const int wid = __builtin_amdgcn_readfirstlane(tid >> 6), lane = tid & 63, wr = wid >> 2, wc = wid & 3, fr = lane & 15, fq = lane >> 4;
    constexpr int KB = FP8 ? 1024 : 2048, nt = 1024 / (FP8 ? 128 : 64);
    int sR[2], sC[2]; unsigned voffB[2], voffA[2];
#pragma unroll
    for (int i = 0; i < 2; ++i) { stage_rc(tid * 16 + i * 8192, sR[i], sC[i]); const int Rb = Epi::PERM ? ((sR[i] & ~31) + perm32(sR[i] & 31)) : sR[i]; voffB[i] = (unsigned)(Rb * KB + sC[i] * 2); voffA[i] = (unsigned)(sR[i] * KB + sC[i] * 2); }
    constexpr size_t kstep = (size_t)(BK * 2), hstep = (size_t)HALF * KB, tstep = 2 * hstep;
    const unsigned ldsw = (unsigned)wid * 1024u;
    const int fc = FP8 ? (32 * (fq >> 1) + 16 * (fq & 1)) : fq * 8;
    const int aoff = lds_byte(wr * 64 + fr, fc), boff = lds_byte(wc * 32 + fr, fc);
    const char* Ab = (const char*)g.A;
#define PG8_SA(b, h) (((b) * 2 + (h)) * HTB)
#define PG8_SB(b, h) ((4 + (b) * 2 + (h)) * HTB)
#define PG8_STAGE_B(bufoff, gbase) do { _Pragma("unroll") for (int _i = 0; _i < 2; ++_i) \
        __builtin_amdgcn_global_load_lds((const unsigned*)((const char*)(gbase) + voffB[_i]), (LAS unsigned*)(lds + (bufoff) + ldsw + _i * 8192), 16, 0, 0); } while (0)
#define PG8_STAGE_A(bufoff, kb, v, ubase) do { _Pragma("unroll") for (int _i = 0; _i < 2; ++_i) \
        __builtin_amdgcn_global_load_lds((const unsigned*)((GATHER ? Ab : (ubase)) + (size_t)(kb) + (GATHER ? (v)[_i] : voffA[_i])), (LAS unsigned*)(lds + (bufoff) + ldsw + _i * 8192), 16, 0, 0); } while (0)
#define PG8_LDA(dst, b, h) do { if constexpr (FP8) { _Pragma("unroll") for (int m = 0; m < 4; ++m) dst##8[m] = *(const LAS v8i*)(lds + PG8_SA(b, h) + aoff + m * 2048); } else { _Pragma("unroll") for (int m = 0; m < 4; ++m) _Pragma("unroll") for (int k = 0; k < 2; ++k) dst[m][k] = *(const LAS bf16x8*)(lds + PG8_SA(b, h) + aoff + m * 2048 + k * 1024); } } while (0)
#define PG8_LDB(dst, b, h) do { if constexpr (FP8) { _Pragma("unroll") for (int n = 0; n < 2; ++n) dst##8[n] = *(const LAS v8i*)(lds + PG8_SB(b, h) + boff + n * 2048); } else { _Pragma("unroll") for (int n = 0; n < 2; ++n) _Pragma("unroll") for (int k = 0; k < 2; ++k) dst[n][k] = *(const LAS bf16x8*)(lds + PG8_SB(b, h) + boff + n * 2048 + k * 1024); } } while (0)
#define PG8_MMA(ai, bj, At, Bt) do { __builtin_amdgcn_s_setprio(1); if constexpr (FP8) { _Pragma("unroll") for (int m = 0; m < 4; ++m) _Pragma("unroll") for (int n = 0; n < 2; ++n) \
        asm volatile("v_mfma_scale_f32_16x16x128_f8f6f4 %0, %1, %2, %0, %3, %3 op_sel_hi:[0,0,0]" : "+v"(acc[ai][bj][m][n]) : "v"(Bt##8[n]), "v"(At##8[m]), "v"(unit_scale)); } else { \
        _Pragma("unroll") for (int m = 0; m < 4; ++m) _Pragma("unroll") for (int n = 0; n < 2; ++n) _Pragma("unroll") for (int k = 0; k < 2; ++k) \
        acc[ai][bj][m][n] = __builtin_amdgcn_mfma_f32_16x16x32_bf16(Bt[n][k], At[m][k], acc[ai][bj][m][n], 0, 0, 0); } __builtin_amdgcn_s_setprio(0); } while (0)
#define PG8_WAIT_V(n) asm volatile("s_waitcnt vmcnt(" #n ")" ::: "memory")
#define PG8_WAIT_L(n) asm volatile("s_waitcnt lgkmcnt(" #n ")" ::: "memory")
#define PG8_BAR __builtin_amdgcn_s_barrier()
#define PG8_SCHED __builtin_amdgcn_sched_barrier(0)
    Unit cur, nxt; int ui = 0;
    if (!S.next(0, cur)) return;
    unsigned cv[2][2], nv[2][2];
    if constexpr (GATHER) a_offsets<KB>(g, cur, sR, sC, cv);
    const char* cA = Ab + (size_t)cur.pm * tstep; const char* nA = cA;
    f32x4 acc[2][2][4][2];
#pragma unroll
    for (int a = 0; a < 2; ++a)
#pragma unroll
        for (int b = 0; b < 2; ++b)
#pragma unroll
            for (int m = 0; m < 4; ++m)
#pragma unroll
                for (int n = 0; n < 2; ++n) acc[a][b][m][n] = (f32x4){0.f, 0.f, 0.f, 0.f};
    bf16x8 At[4][2], B0[2][2], B1[2][2]; v8i At8[4], B08[2], B18[2];
    int unit_scale = 0x7f7f7f7f; asm volatile("" : "+v"(unit_scale));
    const char* cB = (const char*)g.Bt + (size_t)cur.e * g.bstride + (size_t)cur.pn * tstep;
    PG8_STAGE_B(PG8_SB(0, 0), cB); PG8_STAGE_B(PG8_SB(0, 1), cB + hstep); PG8_STAGE_A(PG8_SA(0, 0), 0, cv[0], cA); PG8_STAGE_A(PG8_SA(0, 1), 0, cv[1], cA + hstep);
    if (wr == 1) PG8_BAR;
    PG8_WAIT_V(2); PG8_BAR;
    PG8_STAGE_B(PG8_SB(1, 0), cB + kstep); PG8_STAGE_A(PG8_SA(1, 0), kstep, cv[0], cA); PG8_STAGE_B(PG8_SB(1, 1), cB + hstep + kstep);
    PG8_WAIT_V(6); PG8_BAR;
    for (;;) {
        const bool has_next = S.next(ui + 1, nxt);
        const char* nB = cB;
        nA = cA;
        if (has_next) { if constexpr (GATHER) a_offsets<KB>(g, nxt, sR, sC, nv); nA = Ab + (size_t)nxt.pm * tstep; nB = (const char*)g.Bt + (size_t)nxt.e * g.bstride + (size_t)nxt.pn * tstep; }
        else if constexpr (GATHER) {
#pragma unroll
            for (int h = 0; h < 2; ++h)
#pragma unroll
                for (int i = 0; i < 2; ++i) nv[h][i] = cv[h][i];
        }
        const int ntr = (PROBE_SHORTK && !cur.real) ? 2 : nt;
        const bool m00 = (cur.amask & 1) && (cur.bmask & 1), m01 = (cur.amask & 1) && (cur.bmask & 2), m10 = (cur.amask & 2) && (cur.bmask & 1), m11 = (cur.amask & 2) && (cur.bmask & 2);
#pragma nounroll
        for (int t = 0; t < ntr; t += 2) {
            const bool last = (t == ntr - 2);
            const size_t k1 = (size_t)(t + 1) * kstep, k2 = last ? 0 : (size_t)(t + 2) * kstep, k3 = k2 + kstep;
            const char* b2 = last ? nB : cB + (size_t)(t + 2) * kstep; const char* b3 = b2 + kstep;
            unsigned w0[2], w1[2];
            if constexpr (GATHER) {
#pragma unroll
                for (int i = 0; i < 2; ++i) { w0[i] = last ? nv[0][i] : cv[0][i]; w1[i] = last ? nv[1][i] : cv[1][i]; }
            }
            const char* a2 = last ? nA : cA;
            PG8_LDB(B0, 0, 0); PG8_LDB(B1, 0, 1); PG8_SCHED; PG8_LDA(At, 0, 0); PG8_STAGE_A(PG8_SA(1, 1), k1, cv[1], cA + hstep);
            PG8_WAIT_V(8); PG8_WAIT_L(0); PG8_BAR; if (m00) PG8_MMA(0, 0, At, B0); if (m01) PG8_MMA(0, 1, At, B1); PG8_BAR; PG8_SCHED;
            PG8_LDA(At, 0, 1); PG8_STAGE_B(PG8_SB(0, 0), b2); PG8_STAGE_B(PG8_SB(0, 1), b2 + hstep); PG8_STAGE_A(PG8_SA(0, 0), k2, w0, a2);
            PG8_WAIT_V(8); PG8_WAIT_L(0); PG8_BAR; if (m10) PG8_MMA(1, 0, At, B0); if (m11) PG8_MMA(1, 1, At, B1); PG8_BAR; PG8_SCHED;
            PG8_LDB(B0, 1, 0); PG8_LDB(B1, 1, 1); PG8_SCHED; PG8_LDA(At, 1, 0); PG8_STAGE_A(PG8_SA(0, 1), k2, w1, a2 + hstep);
            PG8_WAIT_V(8); PG8_WAIT_L(0); PG8_BAR; if (m00) PG8_MMA(0, 0, At, B0); if (m01) PG8_MMA(0, 1, At, B1); PG8_BAR; PG8_SCHED;
            PG8_LDA(At, 1, 1); PG8_STAGE_B(PG8_SB(1, 0), b3); PG8_STAGE_B(PG8_SB(1, 1), b3 + hstep); PG8_STAGE_A(PG8_SA(1, 0), k3, w0, a2);
            PG8_WAIT_V(8); PG8_WAIT_L(0); PG8_BAR; if (m10) PG8_MMA(1, 0, At, B0); if (m11) PG8_MMA(1, 1, At, B1); PG8_BAR; PG8_SCHED;
        }
        if constexpr (ALIGN_EPI) { if (wr == 0) PG8_BAR; }
        if constexpr (FP8) asm volatile("s_nop 15\n\ts_nop 15" ::: "memory");
        if (!PROBE_NOEPI || cur.real) E(acc, cur, wr, wc, fr, fq);
        if (!has_next) break;
#pragma unroll
        for (int a = 0; a < 2; ++a)
#pragma unroll
            for (int b = 0; b < 2; ++b)
#pragma unroll
                for (int m = 0; m < 4; ++m)
#pragma unroll
                    for (int n = 0; n < 2; ++n) acc[a][b][m][n] = (f32x4){0.f, 0.f, 0.f, 0.f};
        cur = nxt; cB = nB; cA = nA; ++ui;
        if constexpr (GATHER) {
#pragma unroll
            for (int h = 0; h < 2; ++h)
#pragma unroll
                for (int i = 0; i < 2; ++i) cv[h][i] = nv[h][i];
        }
        if constexpr (ALIGN_EPI) { if (wr == 1) PG8_BAR; }
    }
    PG8_WAIT_V(0);
    if constexpr (!ALIGN_EPI) { if (wr == 0) PG8_BAR; }
    PG8_BAR;
#undef PG8_SA
#undef PG8_SB
#undef PG8_STAGE_A
#undef PG8_STAGE_B
#undef PG8_LDA
#undef PG8_LDB
#undef PG8_MMA
#undef PG8_WAIT_V
#undef PG8_WAIT_L
#undef PG8_BAR
#undef PG8_SCHED
}
}

struct TBlk { const float* src; int ldw; bf16_t* dst; unsigned char* dst8; };
__device__ __forceinline__ void tb_load(const TBlk& t, int lane, f32x4 (&v)[16]) {
    const float* p = t.src + (size_t)(lane >> 4) * t.ldw + (lane & 15) * 4;
#pragma unroll
    for (int i = 0; i < 16; ++i) v[i] = *(const f32x4*)(p + (size_t)(4 * i) * t.ldw);
}
__device__ __forceinline__ void tb_store(const TBlk& t, int lane, const f32x4 (&v)[16], LAS float* scr) {
#pragma unroll
    for (int i = 0; i < 16; ++i) { LAS float* d = scr + ((lane >> 4) + 4 * i) * 65 + (lane & 15) * 4; d[0] = v[i].x; d[1] = v[i].y; d[2] = v[i].z; d[3] = v[i].w; }
    asm volatile("s_waitcnt lgkmcnt(0)" ::: "memory"); __builtin_amdgcn_wave_barrier();
    const int c8 = lane & 7;
#pragma unroll
    for (int jj = 0; jj < 8; ++jj) {
        const int n = (lane >> 3) + 8 * jj; const LAS float* p = scr + (8 * c8) * 65 + n;
        if (t.dst8) { u32x2 o; o.x = pk4_fp8(p[0] * F8_SW, p[65] * F8_SW, p[2 * 65] * F8_SW, p[3 * 65] * F8_SW); o.y = pk4_fp8(p[4 * 65] * F8_SW, p[5 * 65] * F8_SW, p[6 * 65] * F8_SW, p[7 * 65] * F8_SW);
            *(u32x2*)(t.dst8 + (size_t)n * 1024 + 8 * c8) = o; }
        else { u32x4 o; o.x = pk2(p[0], p[65]); o.y = pk2(p[2 * 65], p[3 * 65]); o.z = pk2(p[4 * 65], p[5 * 65]); o.w = pk2(p[6 * 65], p[7 * 65]);
            *(u32x4*)(t.dst + (size_t)n * 1024 + 8 * c8) = o; }
    }
    asm volatile("s_waitcnt lgkmcnt(0)" ::: "memory"); __builtin_amdgcn_wave_barrier();
}

__device__ __forceinline__ void phase_prep(const Ctx& c) {
    LAS float* red = (LAS float*)c.lds;
    const float* cv = c.a->in[1]; const float* ccv = c.a->in[3]; const float* ada_w = c.a->in[4]; const float* ada_b = c.a->in[5];
    for (int item = c.wg; item < 193; item += c.nwg) {
        if (item < 192) {
            const int layer = item / 96, cb = item % 96, col = cb * 64 + c.lane;
            const float* W = ada_w + (size_t)layer * D * 6144 + col;
            float a0 = 0.f, a1 = 0.f;
            const int k0 = c.wave * 128;
#pragma unroll 32
            for (int k = 0; k < 128; ++k) { const float w = W[(size_t)(k0 + k) * 6144]; a0 += silu_f(cv[k0 + k]) * w; a1 += silu_f(ccv[k0 + k]) * w; }
            red[(0 * 8 + c.wave) * 64 + c.lane] = a0; red[(1 * 8 + c.wave) * 64 + c.lane] = a1;
            __syncthreads();
            if (c.tid < 128) {
                const int which = c.tid >> 6, l = c.tid & 63; float s = 0.f;
#pragma unroll
                for (int w = 0; w < 8; ++w) s += red[(which * 8 + w) * 64 + l];
                c.modp(layer, which)[cb * 64 + l] = s + ada_b[layer * 6144 + cb * 64 + l];
            }
            __syncthreads();
        } else {
            float* modbase = (float*)(c.ws + WS_MOD);
            for (int i = c.tid; i < 4096; i += 512) {
                const int pos = i >> 4, j = i & 15;
                const double ang = (double)pos * pow(10000.0, -(double)j / 16.0);
                modbase[MOD_ROPE + 2 * i] = (float)cos(ang); modbase[MOD_ROPE + 2 * i + 1] = (float)sin(ang);
            }
            const float* lbp = c.a->in[12];
            for (int i = c.tid; i < 2048; i += 512) { const float p0 = lbp[i], p1 = lbp[2048 + i]; modbase[MOD_LB + i] = 1.f / (1.f + __expf(p0 - p1)); }
        }
    }
}

__device__ __forceinline__ void row_load(const float* p, int lane, f32x4 (&v)[4]) {
#pragma unroll
    for (int j = 0; j < 4; ++j) v[j] = *(const f32x4*)(p + lane * 4 + 256 * j);
}
__device__ __forceinline__ float row_ss(const f32x4 (&v)[4]) {
    float s = 0.f;
#pragma unroll
    for (int j = 0; j < 4; ++j) s += v[j].x * v[j].x + v[j].y * v[j].y + v[j].z * v[j].z + v[j].w * v[j].w;
    return wave_sum(s);
}
__device__ __forceinline__ void row_modnorm_store(const f32x4 (&x)[4], float rstd, const float* g, const float* sh, const float* sc, bf16_t* out, int lane, f32x4 (*hout)[4] = nullptr) {
#pragma unroll
    for (int j = 0; j < 4; ++j) {
        const int c0 = lane * 4 + 256 * j;
        const f32x4 gv = *(const f32x4*)(g + c0), shv = *(const f32x4*)(sh + c0), scv = *(const f32x4*)(sc + c0);
        f32x4 h;
        h.x = x[j].x * rstd * gv.x * (1.f + scv.x) + shv.x; h.y = x[j].y * rstd * gv.y * (1.f + scv.y) + shv.y;
        h.z = x[j].z * rstd * gv.z * (1.f + scv.z) + shv.z; h.w = x[j].w * rstd * gv.w * (1.f + scv.w) + shv.w;
        if (hout) (*hout)[j] = h;
        u32x2 o; o.x = pk2(h.x, h.y); o.y = pk2(h.z, h.w);
        *(u32x2*)(out + c0) = o;
    }
}

__device__ __forceinline__ void phase_norm0(const Ctx& c) {
    bf16_t* H = (bf16_t*)(c.ws + WS_H); const float* ng = c.a->in[6];
    int r = c.wg * 8 + c.wave;
    f32x4 xn[4];
    if (r < R) row_load(c.xin0(r), c.lane, xn);
    for (; r < R; r += c.nwg * 8) {
        f32x4 x[4];
#pragma unroll
        for (int j = 0; j < 4; ++j) x[j] = xn[j];
        if (r + c.nwg * 8 < R) row_load(c.xin0(r + c.nwg * 8), c.lane, xn);
        const float rstd = rsqrtf(row_ss(x) * (1.f / D) + EPS);
        const float* m = c.modp(0, r < C ? 1 : 0);
        row_modnorm_store(x, rstd, ng, m + 0, m + 1024, H + (size_t)r * D, c.lane);
    }
}

namespace at {
constexpr int KP = 144, TILEB = 64 * KP;
__device__ __forceinline__ bf16x8 tr_frag2(const LAS unsigned char* tile, int row0, int col0, int lane) {
    const int q = (lane & 15) >> 2, p = lane & 3;
    const LAS unsigned char* a = tile + (row0 + q) * KP + (col0 + 4 * p) * 2;
    const v4i16_t lo = __builtin_amdgcn_ds_read_tr16_b64_v4i16((LAS v4i16_t*)a);
    const v4i16_t hi = __builtin_amdgcn_ds_read_tr16_b64_v4i16((LAS v4i16_t*)(a + 16 * KP));
    return (bf16x8){lo[0], lo[1], lo[2], lo[3], hi[0], hi[1], hi[2], hi[3]};
}
}
__device__ __forceinline__ void phase_attn(const Ctx& c) {
    using namespace at;
    const bf16_t* Q = (const bf16_t*)(c.ws + WS_Q); const bf16_t* K = (const bf16_t*)(c.ws + WS_K); const bf16_t* V = (const bf16_t*)(c.ws + WS_V);
    bf16_t* O = (bf16_t*)(c.ws + WS_O); const float* sink = c.a->in[9];
    LAS unsigned char* lds = c.lds;
    const int tid = c.tid, lane = c.lane, w = __builtin_amdgcn_readfirstlane(tid >> 6), fr = lane & 15, g = lane >> 4;
    const int lrow = tid >> 3, lch = tid & 7;
    for (int item = c.wg; item < 264; item += c.nwg) {
        const bool isctx = item >= 256;
        const int ci = item - 256;
        const int n = isctx ? 0 : (item >> 1), kh = isctx ? ((ci >> 1) & 1) : (item & 1), cb = isctx ? (ci >> 2) : 0;
        const int p_lo = isctx ? (ci & 1) : 0, p_hi = isctx ? (ci & 1) + 1 : 2;
        const int hq = kh * 8 + w;
        const float sink2 = sink[hq] * LOG2E;
        for (int pass = p_lo; pass < p_hi; ++pass) {
            const int t0 = 128 * n + 64 * pass, qrow0 = isctx ? cb * 128 + 64 * pass : C + t0;
            const int jlo = isctx ? 0 : (t0 >= 128 ? 0 : (128 - t0) / 64), jhi = isctx ? 0 : ((L - t0 + 128) / 64 < 5 ? (L - t0 + 128) / 64 : 5);
            const int ntile = 4 + (jhi - jlo);
            LAS unsigned char* qlds = lds + 4 * TILEB + w * TILEB;
#pragma unroll
            for (int qb = 0; qb < 4; ++qb)
#pragma unroll
                for (int ks = 0; ks < 2; ++ks) *(LAS bf16x8*)(qlds + (16 * qb + fr) * KP + (32 * ks + 8 * g) * 2) = *(const bf16x8*)(Q + (size_t)(qrow0 + 16 * qb + fr) * D + hq * 64 + 32 * ks + 8 * g);
            float mrow[4], lsum[4]; f32x4 OT[4][4];
#pragma unroll
            for (int qb = 0; qb < 4; ++qb) { mrow[qb] = sink2; lsum[qb] = 1.f;
#pragma unroll
                for (int nt = 0; nt < 4; ++nt) OT[qb][nt] = (f32x4){0.f, 0.f, 0.f, 0.f}; }
            u32x4 kreg, vreg;
#define AT_KROW(ti) ((ti) < 4 ? 64 * (ti) : C + t0 - 128 + 64 * (jlo + (ti) - 4))
#define AT_LOAD(ti) do { const size_t ro_ = (size_t)(AT_KROW(ti) + lrow) * 128 + kh * 64 + lch * 8; kreg = *(const u32x4*)(K + ro_); vreg = *(const u32x4*)(V + ro_); } while (0)
#define AT_WRITE(buf) do { *(LAS u32x4*)(lds + (buf) * 2 * TILEB + lrow * KP + lch * 16) = kreg; *(LAS u32x4*)(lds + (buf) * 2 * TILEB + TILEB + lrow * KP + lch * 16) = vreg; } while (0)
            AT_LOAD(0); AT_WRITE(0);
            __syncthreads();
            for (int ti = 0; ti < ntile; ++ti) {
                if (ti + 1 < ntile) AT_LOAD(ti + 1);
                const LAS unsigned char* kb = lds + (ti & 1) * 2 * TILEB; const LAS unsigned char* vb = kb + TILEB;
                const int jj = jlo + ti - 4; const bool masked = (ti >= 4) && (jj == 0 || jj == 4);
                const int k0 = t0 - 128 + 64 * jj;
                bf16x8 Kf[4][2];
#pragma unroll
                for (int mt = 0; mt < 4; ++mt)
#pragma unroll
                    for (int ks = 0; ks < 2; ++ks) Kf[mt][ks] = *(const LAS bf16x8*)(kb + (16 * mt + fr) * KP + (32 * ks + 8 * g) * 2);
#pragma unroll
                for (int qb = 0; qb < 4; ++qb) {
                    asm volatile("" ::: "memory");
                    bf16x8 Vf[4][2];
#pragma unroll
                    for (int mt = 0; mt < 4; ++mt)
#pragma unroll
                        for (int ks = 0; ks < 2; ++ks)
                            Vf[mt][ks] = tr_frag2(vb, 32 * ks + 4 * g, 16 * mt, lane);
                    bf16x8 Qq[2];
#pragma unroll
                    for (int ks = 0; ks < 2; ++ks) Qq[ks] = *(const LAS bf16x8*)(qlds + (16 * qb + fr) * KP + (32 * ks + 8 * g) * 2);
                    f32x4 sa[4];
#pragma unroll
                    for (int mt = 0; mt < 4; ++mt) { sa[mt] = (f32x4){0.f, 0.f, 0.f, 0.f};
#pragma unroll
                        for (int ks = 0; ks < 2; ++ks) sa[mt] = __builtin_amdgcn_mfma_f32_16x16x32_bf16(Kf[mt][ks], Qq[ks], sa[mt], 0, 0, 0); }
                    if (masked) {
                        const int tq = t0 + 16 * qb + fr;
#pragma unroll
                        for (int mt = 0; mt < 4; ++mt)
#pragma unroll
                            for (int e = 0; e < 4; ++e) { const int dt = tq - (k0 + 16 * mt + 4 * g + e); if (dt > 128 || dt < -128) sa[mt][e] = -INFINITY; }
                    }
                    float mx = fmaxf(fmaxf(sa[0][0], sa[0][1]), fmaxf(sa[0][2], sa[0][3]));
#pragma unroll
                    for (int mt = 1; mt < 4; ++mt) mx = fmaxf(mx, fmaxf(fmaxf(sa[mt][0], sa[mt][1]), fmaxf(sa[mt][2], sa[mt][3])));
                    mx = fmaxf(mx, __shfl_xor(mx, 16)); mx = fmaxf(mx, __shfl_xor(mx, 32));
                    const float mn = fmaxf(mrow[qb], mx), alpha = __builtin_amdgcn_exp2f(mrow[qb] - mn);
                    mrow[qb] = mn;
                    float rs = 0.f;
#pragma unroll
                    for (int mt = 0; mt < 4; ++mt)
#pragma unroll
                        for (int e = 0; e < 4; ++e) { const float pv = __builtin_amdgcn_exp2f(sa[mt][e] - mn); sa[mt][e] = pv; rs += pv; }
                    rs += __shfl_xor(rs, 16); rs += __shfl_xor(rs, 32);
                    lsum[qb] = lsum[qb] * alpha + rs;
                    bf16x8 Pb[2];
#pragma unroll
                    for (int ks = 0; ks < 2; ++ks) { const f32x4 a0 = sa[2 * ks], a1 = sa[2 * ks + 1];
                        const u32x4 pk = (u32x4){pk2(a0[0], a0[1]), pk2(a0[2], a0[3]), pk2(a1[0], a1[1]), pk2(a1[2], a1[3])}; Pb[ks] = __builtin_bit_cast(bf16x8, pk); }
#pragma unroll
                    for (int nt = 0; nt < 4; ++nt) { OT[qb][nt] = OT[qb][nt] * alpha;
#pragma unroll
                        for (int ks = 0; ks < 2; ++ks) OT[qb][nt] = __builtin_amdgcn_mfma_f32_16x16x32_bf16(Vf[nt][ks], Pb[ks], OT[qb][nt], 0, 0, 0); }
                }
                if (ti + 1 < ntile) AT_WRITE((ti + 1) & 1);
                __syncthreads();
            }
#undef AT_KROW
#undef AT_LOAD
#undef AT_WRITE
#pragma unroll
            for (int qb = 0; qb < 4; ++qb) {
                const float il = 1.f / lsum[qb];
                bf16_t* op = O + (size_t)(qrow0 + 16 * qb + fr) * D + hq * 64 + 4 * g;
#pragma unroll
                for (int nt = 0; nt < 4; ++nt) { const f32x4 v = OT[qb][nt] * il; u32x2 o; o.x = pk2(v[0], v[1]); o.y = pk2(v[2], v[3]); *(u32x2*)(op + 16 * nt) = o; }
            }
        }
    }
}

__device__ __forceinline__ void phase_postmix(const Ctx& c, int layer, bool route) {
    const float* Y = (const float*)(c.ws + WS_RAW1); unsigned char* H8 = c.ws + WS_H8;
    float* Xout = (float*)(c.ws + (layer == 0 ? WS_X : WS_X1)); const float* Xprev = (const float*)(c.ws + WS_X);
    const float* ng = c.a->in[6] + layer * 4 * D; const float* Wr = c.a->in[15] + (size_t)layer * D * NE; const float* br = c.a->in[16] + layer * NE;
    unsigned* cnt = (unsigned*)(c.ws + WS_CTL) + CW_CNT + layer * NE;
    int* tk_e = (int*)(c.ws + WS_TK); float* tk_g = (float*)(c.ws + WS_TK) + R * 4; int* tk_slot = (int*)(c.ws + WS_TK) + 2 * R * 4;
    int* list = (int*)(c.ws + WS_LIST);
    LAS float* WL = (LAS float*)c.lds;
    LAS float* biasp = (LAS float*)(c.lds + 131072);
    LAS unsigned* lcnt = (LAS unsigned*)(c.lds + 145920); LAS unsigned* lbase = lcnt + 32;
    LAS float* pvA = (LAS float*)(c.lds + 131072 + 2560); LAS float* pvB = pvA + 1024; LAS float* pvS = pvB + 1024;
    const int lane = c.lane, w = __builtin_amdgcn_readfirstlane(c.tid >> 6), fr = lane & 15, g = lane >> 4;
    const int g_lo = layer == 0 ? 0 : C / 128;
    for (int grp = g_lo + c.wg; grp < R / 128; grp += c.nwg) {
        const int which = grp * 128 < C ? 1 : 0;
        const float* m = c.modp(layer, which);
        __syncthreads();
        if (c.tid < NE) lcnt[c.tid] = 0u;
#pragma unroll 4
        for (int j = 0; j < 16; ++j) {
            const int i4 = c.tid + 512 * j, k = i4 >> 3, e0 = (i4 & 7) * 4;
            const f32x4 wv = *(const f32x4*)(Wr + (size_t)k * NE + e0); const float sc = ng[2 * D + k] * (1.f + m[4096 + k]);
            LAS float* dst = WL + ((((k >> 4) * 4 + (k & 3)) * 4 + ((k >> 2) & 3)) * 16) * 2;
#pragma unroll
            for (int q = 0; q < 4; ++q) { const int e = e0 + q; dst[(e & 15) * 2 + (e >> 4)] = wv[q] * sc; }
        }
        for (int k = c.tid; k < D; k += 512) { pvA[k] = m[2048 + k] * ng[D + k]; pvB[k] = ng[2 * D + k] * (1.f + m[4096 + k]); pvS[k] = m[3072 + k]; }
        { const int e = c.tid & 31, part = c.tid >> 5; float sacc = 0.f;
#pragma unroll 16
          for (int k = part * 64; k < part * 64 + 64; ++k) sacc += m[3072 + k] * Wr[k * NE + e];
          biasp[32 + part * 32 + e] = sacc; }
        __syncthreads();
        if (c.tid < 32) { float sacc = br[c.tid];
#pragma unroll
            for (int p = 0; p < 16; ++p) sacc += biasp[32 + p * 32 + c.tid]; biasp[c.tid] = sacc; }
        __syncthreads();
        const int row0 = grp * 128 + w * 16;
        float rs_keep = 0.f;
        f32x4 yn[4], xn[4];
        row_load(Y + (size_t)(layer == 0 ? row0 : row0 - C) * D, lane, yn); row_load(layer == 0 ? c.xin0(row0) : Xprev + (size_t)row0 * D, lane, xn);
        for (int i = 0; i < 16; ++i) {
            const int r = row0 + i;
            f32x4 y[4], x[4];
#pragma unroll
            for (int j = 0; j < 4; ++j) { y[j] = yn[j]; x[j] = xn[j]; }
            if (i + 1 < 16) { row_load(Y + (size_t)(layer == 0 ? r + 1 : r + 1 - C) * D, lane, yn); row_load(layer == 0 ? c.xin0(r + 1) : Xprev + (size_t)(r + 1) * D, lane, xn); }
            const float rstd_y = rsqrtf(row_ss(y) * (1.f / D) + EPS);
#pragma unroll
            for (int j = 0; j < 4; ++j) {
                const int c0 = lane * 4 + 256 * j;
                x[j] += *(const LAS f32x4*)(pvA + c0) * (y[j] * rstd_y);
                *(f32x4*)(Xout + (size_t)r * D + c0) = x[j];
            }
            const float rstd_x = rsqrtf(row_ss(x) * (1.f / D) + EPS);
#pragma unroll
            for (int j = 0; j < 4; ++j) {
                const int c0 = lane * 4 + 256 * j;
                const f32x4 hv = x[j] * rstd_x * *(const LAS f32x4*)(pvB + c0) + *(const LAS f32x4*)(pvS + c0);
                *(unsigned*)(H8 + (size_t)r * D + c0) = pk4_fp8(hv[0] * F8_SH, hv[1] * F8_SH, hv[2] * F8_SH, hv[3] * F8_SH);
            }
            if (lane == i) rs_keep = rstd_x;
        }
        asm volatile("s_waitcnt vmcnt(0)" ::: "memory");
        f32x4 la[2]; la[0] = (f32x4){0.f, 0.f, 0.f, 0.f}; la[1] = la[0];
        {
            const float* ap = Xout + (size_t)(row0 + fr) * D + 4 * g;
            const LAS float* bp = WL + (g * 16 + fr) * 2;
#pragma unroll 4
            for (int k4 = 0; k4 < 64; ++k4) {
                const f32x4 a4 = *(const f32x4*)(ap + 16 * k4);
#pragma unroll
                for (int q = 0; q < 4; ++q) {
                    const f32x2 b2 = *(const LAS f32x2*)(bp + (size_t)(4 * k4 + q) * 128);
                    la[0] = __builtin_amdgcn_mfma_f32_16x16x4f32(a4[q], b2[0], la[0], 0, 0, 0);
                    la[1] = __builtin_amdgcn_mfma_f32_16x16x4f32(a4[q], b2[1], la[1], 0, 0, 0);
                }
            }
        }
        float tv[4][4]; int te[4][4];
#pragma unroll
        for (int e = 0; e < 4; ++e) {
            const float rs = __shfl(rs_keep, 4 * g + e);
            float v0 = la[0][e] * rs + biasp[fr], v1 = la[1][e] * rs + biasp[16 + fr];
#pragma unroll
            for (int k = 0; k < 4; ++k) {
                float bv; int bi;
                if (v0 >= v1) { bv = v0; bi = fr; } else { bv = v1; bi = 16 + fr; }
#pragma unroll
                for (int o = 8; o > 0; o >>= 1) {
                    const float ov = __shfl_xor(bv, o); const int oi = __shfl_xor(bi, o);
                    if (ov > bv || (ov == bv && oi < bi)) { bv = ov; bi = oi; }
                }
                tv[e][k] = bv; te[e][k] = bi;
                if (bi == fr) v0 = -INFINITY;
                if (bi == 16 + fr) v1 = -INFINITY;
            }
        }
        float v[4]; int ex[4]; unsigned sl[4];
#pragma unroll
        for (int k = 0; k < 4; ++k) { v[k] = tv[0][k]; ex[k] = te[0][k];
#pragma unroll
            for (int e = 1; e < 4; ++e) if (fr == e) { v[k] = tv[e][k]; ex[k] = te[e][k]; } }
        if (fr < 4 && route) {
#pragma unroll
            for (int k = 0; k < 4; ++k) sl[k] = __hip_atomic_fetch_add(lcnt + ex[k], 1u, __ATOMIC_RELAXED, __HIP_MEMORY_SCOPE_WORKGROUP);
        }
        __syncthreads();
        if (c.tid < NE && route) { const unsigned n = lcnt[c.tid]; lbase[c.tid] = n ? atomicAdd(&cnt[c.tid], n) : 0u; }
        __syncthreads();
        if (fr < 4 && route) {
            const int r = row0 + 4 * g + fr;
            const float e1 = __expf(v[1] - v[0]), e2 = __expf(v[2] - v[0]), e3 = __expf(v[3] - v[0]);
            const float inv = 1.f / (1.f + e1 + e2 + e3);
            const float gk[4] = {inv, e1 * inv, e2 * inv, e3 * inv};
#pragma unroll
            for (int k = 0; k < 4; ++k) {
                const unsigned slot = lbase[ex[k]] + sl[k];
                list[(size_t)ex[k] * R + slot] = r;
                tk_e[r * 4 + k] = ex[k]; tk_g[r * 4 + k] = gk[k]; tk_slot[r * 4 + k] = (int)slot;
            }
        }
    }
}

__device__ __forceinline__ void moe_offsets(const Ctx& c, int layer, LAS int* so) {
    const unsigned* cnt = (const unsigned*)(c.ws + WS_CTL) + CW_CNT + layer * NE;
    __syncthreads();
    if (c.tid < 64) {
        const int n = c.tid < NE ? (int)cnt[c.tid] : 0; int pad = (n + PADM - 1) / PADM * PADM, inc = pad;
#pragma unroll
        for (int o = 1; o < 32; o <<= 1) { const int t = __shfl_up(inc, o); if (c.lane >= o) inc += t; }
        if (c.tid < NE) { so[c.tid] = inc - pad; so[64 + c.tid] = n; }
        if (c.tid == NE - 1) so[32] = inc;
    }
    __syncthreads();
}

__device__ __forceinline__ void moe_tables(const Ctx& c, int layer, LAS int* tb) {
    const unsigned* cnt = (const unsigned*)(c.ws + WS_CTL) + CW_CNT + layer * NE;
    __syncthreads();
    if (c.tid < 64) {
        const int n = c.tid < NE ? (int)cnt[c.tid] : 0; int tiles = (n + PADM - 1) / PADM, inc = tiles;
#pragma unroll
        for (int o = 1; o < 32; o <<= 1) { const int t = __shfl_up(inc, o); if (c.lane >= o) inc += t; }
        if (c.tid < NE) { tb[c.tid] = inc - tiles; tb[64 + c.tid] = n; }
        if (c.tid == NE - 1) tb[32] = inc;
    }
    __syncthreads();
}
__device__ __forceinline__ int vcu_of(const Ctx& c) { return (c.nwg % 8 == 0) ? (c.wg % 8) * (c.nwg / 8) + c.wg / 8 : c.wg; }
__device__ __forceinline__ void phase_moe_gu(const Ctx& c, int layer) {
    LAS int* tb = (LAS int*)(c.lds + 131072 + 1024);
    moe_tables(c, layer, tb);
    pg8::Gemm g{c.ws + WS_H8, c.ws + WS_WGU + (size_t)layer * NE * 2048 * 1024, (size_t)2048 * 1024, (const int*)(c.ws + WS_LIST)};
    pg8::MoeOrder S{tb, tb + 64, 8, c.nwg, vcu_of(c), false};
    pg8::EpiSwiglu E{c.ws + WS_HDN, c.a->in[18] + (size_t)layer * NE * 2048};
    pg8::gemm_phase<pg8::EpiSwiglu, pg8::MoeOrder, true, true, true>(c.lds, g, S, E, c.tid);
}
__device__ __forceinline__ void phase_moe_dn(const Ctx& c, int layer) {
    LAS int* tb = (LAS int*)(c.lds + 131072 + 1024);
    moe_tables(c, layer, tb);
    pg8::Gemm g{c.ws + WS_HDN, c.ws + WS_WDN + (size_t)layer * NE * 1024 * 1024, (size_t)1024 * 1024, nullptr};
    pg8::MoeOrder S{tb, tb + 64, 4, c.nwg, vcu_of(c), true};
    pg8::EpiBf16Bias E{(bf16_t*)(c.ws + WS_OUTB), c.a->in[20] + (size_t)layer * NE * 1024, 1024, 1.f / (F8_SHD * F8_SW)};
    pg8::gemm_phase<pg8::EpiBf16Bias, pg8::MoeOrder, true, false, true>(c.lds, g, S, E, c.tid);
}
__device__ __forceinline__ void phase_gemm_f32(const Ctx& c, const bf16_t* A, int M, const bf16_t* Bt, int N, const float* bias, float* Cout) {
    pg8::Gemm g{A, Bt, 0, nullptr}; pg8::StaticOrder S; S.init(M, N, c.nwg, c.wg);
    pg8::EpiF32 E{Cout, N, bias};
    pg8::gemm_phase<pg8::EpiF32, pg8::StaticOrder, true, false, false>(c.lds, g, S, E, c.tid);
}

__device__ __forceinline__ void phase_gemm_qkv(const Ctx& c) {
    pg8::Gemm g{(const bf16_t*)(c.ws + WS_H), (const bf16_t*)(c.ws + WS_WQKV), 0, nullptr}; pg8::StaticOrder S; S.init(R, QKVD, c.nwg, c.wg);
    pg8::EpiQKV E{(bf16_t*)(c.ws + WS_Q), (bf16_t*)(c.ws + WS_K), (bf16_t*)(c.ws + WS_V), c.a->in[8], (const float*)(c.ws + WS_MOD) + MOD_ROPE};
    pg8::gemm_phase<pg8::EpiQKV, pg8::StaticOrder, true, false, false>(c.lds, g, S, E, c.tid);
}
__device__ __forceinline__ void phase_gemm_inproj(const Ctx& c) {
    pg8::Gemm g{(const bf16_t*)(c.ws + WS_H), (const bf16_t*)(c.ws + WS_WIN), 0, nullptr}; pg8::StaticOrder S; S.init(R, HIN, c.nwg, c.wg);
    pg8::EpiInProj E{(bf16_t*)(c.ws + WS_QH), (_Float16*)(c.ws + WS_KF), (_Float16*)(c.ws + WS_KB), (bf16_t*)(c.ws + WS_IV), (bf16_t*)(c.ws + WS_SG), (const float*)(c.ws + WS_MOD) + MOD_LB};
    pg8::gemm_phase<pg8::EpiInProj, pg8::StaticOrder, true, false, false>(c.lds, g, S, E, c.tid);
}

__device__ __forceinline__ void phase_norm0(const Ctx& c);
constexpr int CONV_A = 20 * 16 + 16 * 16 + 80 * 16 + 16 * 16 + 32 * 32 * 16 + 32 * 16 * 16, CONV_B = 32 * 32 * 16 + 32 * 16 * 16, CONV_CHUNK = 64;
__device__ __forceinline__ TBlk convert_item(const Ctx& c, int it, int part) {
    constexpr int I_QKV = 20 * 16, I_O = 16 * 16, I_IN = 80 * 16, I_HO = 16 * 16, I_GU = 32 * 32 * 16;
    int r = it; TBlk t; t.dst8 = nullptr; t.dst = nullptr;
    if (part == 0) {
        if (r < I_QKV) { const int nb = r % 20, kb = r / 20; t.src = c.a->in[7] + (size_t)kb * 64 * QKVD + nb * 64; t.ldw = QKVD; t.dst = (bf16_t*)(c.ws + WS_WQKV) + (size_t)nb * 64 * 1024 + kb * 64; return t; } r -= I_QKV;
        if (r < I_O) { const int nb = r % 16, kb = r / 16; t.src = c.a->in[10] + (size_t)kb * 64 * D + nb * 64; t.ldw = D; t.dst = (bf16_t*)(c.ws + WS_WO) + (size_t)nb * 64 * 1024 + kb * 64; return t; } r -= I_O;
        if (r < I_IN) { const int nb = r % 80, kb = r / 80; t.src = c.a->in[11] + (size_t)kb * 64 * HIN + nb * 64; t.ldw = HIN; t.dst = (bf16_t*)(c.ws + WS_WIN) + (size_t)nb * 64 * 1024 + kb * 64; return t; } r -= I_IN;
        if (r < I_HO) { const int nb = r % 16, kb = r / 16; t.src = c.a->in[14] + (size_t)kb * 64 * D + nb * 64; t.ldw = D; t.dst = (bf16_t*)(c.ws + WS_WHO) + (size_t)nb * 64 * 1024 + kb * 64; return t; } r -= I_HO;
    }
    const int moff = part * 32;
    if (r < I_GU) { const int mat = moff + r / 512, rr = r % 512, nb = rr % 32, kb = rr / 32; const int n0 = ((nb & 3) >> 1) * 1024 + (nb >> 2) * 128 + (nb & 1) * 64;
        t.src = c.a->in[17] + (size_t)mat * 1024 * 2048 + (size_t)kb * 64 * 2048 + n0; t.ldw = 2048; t.dst8 = c.ws + WS_WGU + ((size_t)mat * 2048 + nb * 64) * 1024 + kb * 64; return t; } r -= I_GU;
    { const int mat = moff + r / 256, rr = r % 256, nb = rr % 16, kb = rr / 16;
        t.src = c.a->in[19] + (size_t)mat * 1024 * 1024 + (size_t)kb * 64 * 1024 + nb * 64; t.ldw = 1024; t.dst8 = c.ws + WS_WDN + ((size_t)mat * 1024 + nb * 64) * 1024 + kb * 64; }
    return t;
}
__device__ __forceinline__ void convert_run(const Ctx& c, int part, int first, int step, int end, LAS float* scr) {
    f32x4 va[16], vb[16];
    int it = first;
    TBlk ta, tbk;
    if (it < end) { ta = convert_item(c, it, part); tb_load(ta, c.lane, va); }
    for (; it < end; it += 2 * step) {
        const bool hb = it + step < end;
        if (hb) { tbk = convert_item(c, it + step, part); tb_load(tbk, c.lane, vb); }
        tb_store(ta, c.lane, va, scr);
        const bool ha = it + 2 * step < end;
        if (ha) { ta = convert_item(c, it + 2 * step, part); tb_load(ta, c.lane, va); }
        if (hb) tb_store(tbk, c.lane, vb, scr);
    }
}
__device__ __forceinline__ void convert_steal(const Ctx& c) {
    LAS float* scr = (LAS float*)c.lds + c.wave * (64 * 65);
    LAS int* chp = (LAS int*)(c.lds + 8 * 64 * 65 * 4);
    unsigned* ctr = (unsigned*)(c.ws + WS_CTL) + CW_CONV;
    for (;;) {
        __syncthreads();
        if (c.tid == 0) *chp = (int)atomicAdd(ctr, 1u);
        __syncthreads();
        const int ch = *chp;
        if (ch >= CONV_B / CONV_CHUNK) break;
        convert_run(c, 1, ch * CONV_CHUNK + c.wave, 8, (ch + 1) * CONV_CHUNK, scr);
    }
}
__device__ __forceinline__ void phase_convert(const Ctx& c) {
    LAS float* scr = (LAS float*)c.lds + c.wave * (64 * 65);
    convert_run(c, 0, c.wg * 8 + c.wave, c.nwg * 8, CONV_A, scr);
    __syncthreads();
    phase_norm0(c);
}

__device__ __forceinline__ void phase_combine(const Ctx& c, int layer) {
    LAS int* so = (LAS int*)(c.lds + 32768);
    moe_offsets(c, layer, so);
    const bf16_t* outb = (const bf16_t*)(c.ws + WS_OUTB); float* X = (float*)(c.ws + WS_X); bf16_t* H = (bf16_t*)(c.ws + WS_H);
    const float* Xin = layer == 0 ? X : (const float*)(c.ws + WS_X1);
    const float* ngl = c.a->in[6] + layer * 4 * D;
    const int* tk_e = (const int*)(c.ws + WS_TK); const float* tk_g = (const float*)(c.ws + WS_TK) + R * 4; const int* tk_slot = (const int*)(c.ws + WS_TK) + 2 * R * 4;
    const int r_lo = layer == 0 ? 0 : C, stride = c.nwg * 8;
    int r = r_lo + c.wg * 8 + c.wave;
    int pe[4], ps[4]; float pg[4]; u32x2 wn[4][4]; f32x4 xn[4]; float gn[4];
#define CB_TK(row) do { _Pragma("unroll") for (int k = 0; k < 4; ++k) { pe[k] = tk_e[(row) * 4 + k]; ps[k] = tk_slot[(row) * 4 + k]; pg[k] = tk_g[(row) * 4 + k]; } } while (0)
#define CB_DATA(row) do { _Pragma("unroll") for (int k = 0; k < 4; ++k) { const bf16_t* src_ = outb + (size_t)(so[pe[k]] + ps[k]) * 1024; gn[k] = pg[k]; \
        _Pragma("unroll") for (int j = 0; j < 4; ++j) wn[k][j] = *(const u32x2*)(src_ + c.lane * 4 + 256 * j); } row_load(Xin + (size_t)(row) * D, c.lane, xn); } while (0)
    if (r < R) { CB_TK(r); CB_DATA(r); }
    if (r + stride < R) CB_TK(r + stride);
    for (; r < R; r += stride) {
        const float* m = c.modp(layer, r < C ? 1 : 0);
        f32x4 y[4], x[4];
#pragma unroll
        for (int j = 0; j < 4; ++j) { y[j] = (f32x4){0.f, 0.f, 0.f, 0.f}; x[j] = xn[j]; }
#pragma unroll
        for (int k = 0; k < 4; ++k)
#pragma unroll
            for (int j = 0; j < 4; ++j) { const u32x2 w = wn[k][j]; y[j] += (f32x4){bflo(w.x), bfhi(w.x), bflo(w.y), bfhi(w.y)} * gn[k]; }
        if (r + stride < R) CB_DATA(r + stride);
        if (r + 2 * stride < R) CB_TK(r + 2 * stride);
        const float rstd_y = rsqrtf(row_ss(y) * (1.f / D) + EPS);
#pragma unroll
        for (int j = 0; j < 4; ++j) {
            const int c0 = c.lane * 4 + 256 * j;
            const f32x4 g2 = *(const f32x4*)(m + 5120 + c0), n3 = *(const f32x4*)(ngl + 3 * D + c0);
            x[j].x += g2.x * (y[j].x * rstd_y * n3.x); x[j].y += g2.y * (y[j].y * rstd_y * n3.y);
            x[j].z += g2.z * (y[j].z * rstd_y * n3.z); x[j].w += g2.w * (y[j].w * rstd_y * n3.w);
            if (layer == 0) *(f32x4*)(X + (size_t)r * D + c0) = x[j];
            else *(f32x4*)(c.a->out + (size_t)(r - C) * D + c0) = x[j];
        }
        if (layer == 0) {
            const float rstd_x = rsqrtf(row_ss(x) * (1.f / D) + EPS);
            const float* m1 = c.modp(1, r < C ? 1 : 0);
            row_modnorm_store(x, rstd_x, c.a->in[6] + 4 * D, m1 + 0, m1 + 1024, H + (size_t)r * D, c.lane);
        }
    }
#undef CB_TK
#undef CB_DATA
}

namespace hg {
typedef _Float16 h2_t __attribute__((ext_vector_type(2)));
constexpr int TB = 272, PB = 144;
constexpr int TILE = 64 * TB;
constexpr int T_QD = 0, T_QC = TILE, T_KD = 2 * TILE, T_KE = 3 * TILE, T_KC = 4 * TILE, T_V0 = 5 * TILE, T_V1 = 6 * TILE;
constexpr int T_QL1 = 7 * TILE, T_KL1 = T_QL1 + 16 * TB, T_P = T_KL1 + 16 * TB, T_TOT = T_P + 64 * PB, T_CT = T_TOT + 4096, T_END = T_CT + 512;
static_assert(T_END <= LDS_BYTES - 64, "hgrn scan LDS map");
__device__ __forceinline__ int row_of(int dir, int p) { return p < C ? (dir ? C - 1 - p : p) : (dir ? C + (L - 1 - (p - C)) : p); }
__device__ __forceinline__ int seg_of(int ch) { return ch < 68 ? ch / 17 : 4 + (ch - 68) / 16; }
__device__ __forceinline__ bf16x8 tr_frag(const LAS unsigned char* tile, int row0, int col0, int lane) {
    const int q = (lane & 15) >> 2, p = lane & 3;
    const LAS unsigned char* a = tile + (row0 + q) * TB + (col0 + 4 * p) * 2;
    const v4i16_t lo = __builtin_amdgcn_ds_read_tr16_b64_v4i16((LAS v4i16_t*)a);
    const v4i16_t hi = __builtin_amdgcn_ds_read_tr16_b64_v4i16((LAS v4i16_t*)(a + 4 * TB));
    return (bf16x8){lo[0], lo[1], lo[2], lo[3], hi[0], hi[1], hi[2], hi[3]};
}
}

__device__ __forceinline__ void phase_hgrn_scan(const Ctx& c) {
    using namespace hg;
#define HG_BAR() asm volatile("s_waitcnt lgkmcnt(0)\n\ts_barrier" ::: "memory")
    const bf16_t* QH = (const bf16_t*)(c.ws + WS_QH); const bf16_t* IV = (const bf16_t*)(c.ws + WS_IV);
    LAS unsigned char* lds = c.lds;
    const int tid = c.tid, lane = c.lane, w = __builtin_amdgcn_readfirstlane(tid >> 6), fr = lane & 15, g = lane >> 4;
    for (int item_ = c.wg; item_ < 256 * SCAN_REP; item_ += c.nwg) {
        const int item = item_ & 255;
        const int chain = item >> 4, seg = item & 15, head = chain >> 1, dir = chain & 1, hc = head * 128;
        const int c0 = seg < 4 ? 17 * seg : 68 + 16 * (seg - 4), nch = seg < 4 ? 17 : 16;
        const _Float16* KX = (const _Float16*)(c.ws + (dir ? WS_KB : WS_KF));
        float* OL = (float*)(c.ws + (dir ? WS_OB : WS_OF)); bf16_t* QS = (bf16_t*)(c.ws + (dir ? WS_QSB : WS_QSF));
        HG_BAR();
        for (int i = tid; i < 64 * PB / 4; i += 512) ((LAS unsigned*)(lds + T_P))[i] = 0u;
        f32x4 Sacc[8];
#pragma unroll
        for (int m = 0; m < 8; ++m) Sacc[m] = (f32x4){0.f, 0.f, 0.f, 0.f};
        float dseg0 = 1.f, dseg1 = 1.f;
        unsigned kraw[8], qraw[8]; u32x4 vraw[2];
#define HG_LOAD(cidx) do { const int p0_ = 64 * (cidx); const bool lat_ = (cidx) >= 4; \
        _Pragma("unroll") for (int i = 0; i < 8; ++i) { const int r_ = row_of(dir, p0_ + 8 * w + i); \
            kraw[i] = *(const unsigned*)(KX + (size_t)r_ * D + hc + 2 * lane); \
            qraw[i] = lat_ ? *(const unsigned*)(QH + (size_t)(r_ - C) * D + hc + 2 * lane) : 0u; } \
        _Pragma("unroll") for (int i = 0; i < 2; ++i) { const int idx_ = tid + 512 * i; const int r_ = row_of(dir, p0_ + (idx_ >> 4)); \
            vraw[i] = *(const u32x4*)(IV + (size_t)r_ * D + hc + (idx_ & 15) * 8); } } while (0)
        HG_LOAD(c0);
        for (int ci = 0; ci < nch; ++ci) {
            const int cidx = c0 + ci; const bool lat = cidx >= 4;
            const int vbuf = (ci & 1) ? T_V1 : T_V0;
            float kf[8][2], qf[8][2], cp[8][2];
            {
                float p0 = 1.f, p1 = 1.f;
#pragma unroll
                for (int i = 0; i < 8; ++i) {
                    const h2_t hv = __builtin_bit_cast(h2_t, kraw[i]);
                    kf[i][0] = (float)hv[0]; kf[i][1] = (float)hv[1];
                    qf[i][0] = bflo(qraw[i]); qf[i][1] = bfhi(qraw[i]);
                    p0 *= (1.f - kf[i][0]); p1 *= (1.f - kf[i][1]); cp[i][0] = p0; cp[i][1] = p1;
                }
                *(LAS f32x2*)(lds + T_TOT + (w * 128 + 2 * lane) * 4) = (f32x2){p0, p1};
#pragma unroll
                for (int i = 0; i < 2; ++i) { const int idx = tid + 512 * i; *(LAS u32x4*)(lds + vbuf + (idx >> 4) * TB + (idx & 15) * 16) = vraw[i]; }
            }
            HG_BAR();
            {
                f32x2 T[8];
#pragma unroll
                for (int x = 0; x < 8; ++x) T[x] = *(const LAS f32x2*)(lds + T_TOT + (x * 128 + 2 * lane) * 4);
                const int I = w >> 1, hh = w & 1;
                f32x2 bd[4];
#pragma unroll
                for (int x = 0; x < 4; ++x) bd[x] = T[2 * x] * T[2 * x + 1];
                f32x2 pre = (f32x2){1.f, 1.f}, cum = (f32x2){1.f, 1.f}, suf = (f32x2){1.f, 1.f}, bdI = (f32x2){1.f, 1.f};
#pragma unroll
                for (int x = 0; x < 8; ++x) if (hh && x == w - 1) pre = T[x];
#pragma unroll
                for (int x = 0; x < 4; ++x) { if (x < I) cum = cum * bd[x]; if (x > I) suf = suf * bd[x]; if (x == I) bdI = bd[x]; }
                const f32x2 ctot = (bd[0] * bd[1]) * (bd[2] * bd[3]);
#pragma unroll
                for (int i = 0; i < 8; ++i) {
                    const int tau = 8 * w + i;
                    float QDv[2], KDv[2], KEv[2], QCv[2], KCv[2];
#pragma unroll
                    for (int x = 0; x < 2; ++x) {
                        const float eq = pre[x] * cp[i][x], rc = __builtin_amdgcn_rcpf(eq);
                        QDv[x] = qf[i][x] * eq; KDv[x] = kf[i][x] * rc; KEv[x] = KDv[x] * bdI[x]; QCv[x] = QDv[x] * cum[x]; KCv[x] = KEv[x] * suf[x];
                    }
                    const int to = tau * TB + lane * 4;
                    *(LAS unsigned*)(lds + T_QD + to) = pk2(QDv[0], QDv[1]);
                    *(LAS unsigned*)(lds + T_KD + to) = pk2(KDv[0], KDv[1]);
                    *(LAS unsigned*)(lds + T_KE + to) = pk2(KEv[0], KEv[1]);
                    *(LAS unsigned*)(lds + T_QC + to) = pk2(QCv[0], QCv[1]);
                    *(LAS unsigned*)(lds + T_KC + to) = pk2(KCv[0], KCv[1]);
                    if (I == 3) *(LAS unsigned*)(lds + T_QL1 + (tau - 48) * TB + lane * 4) = pk2(QDv[0] * bd[2][0], QDv[1] * bd[2][1]);
                    if (I == 0) *(LAS unsigned*)(lds + T_KL1 + tau * TB + lane * 4) = pk2(KEv[0] * bd[1][0], KEv[1] * bd[1][1]);
                    if (lat) { const int r = row_of(dir, 64 * cidx + tau); *(unsigned*)(QS + (size_t)(r - C) * D + hc + 2 * lane) = pk2(QCv[0] * dseg0, QCv[1] * dseg1); }
                }
                dseg0 *= ctot[0]; dseg1 *= ctot[1];
                if (w == 0) *(LAS f32x2*)(lds + T_CT + lane * 8) = ctot;
            }
            HG_BAR();
            if (ci + 1 < nch) HG_LOAD(cidx + 1);
            if (lat) {
                const int nblk = w >= 6 ? 2 : 1;
                for (int b = 0; b < nblk; ++b) {
                    int I, J, qoff, qrow, koff, krow; bool diag = false;
                    if (w < 4) { I = 2 + (w >> 1); J = w & 1; qoff = (w >> 1) ? T_QL1 : T_QD; qrow = (w >> 1) ? 0 : 32; koff = (w & 1) ? T_KE : T_KL1; krow = (w & 1) ? 16 : 0; }
                    else if (w == 4) { I = 1; J = 0; qoff = T_QD; qrow = 16; koff = T_KE; krow = 0; }
                    else if (w == 5) { I = 3; J = 2; qoff = T_QD; qrow = 48; koff = T_KE; krow = 32; }
                    else { I = 2 * (w - 6) + b; J = I; qoff = T_QD; qrow = 16 * I; koff = T_KD; krow = 16 * I; diag = true; }
                    f32x4 pa = (f32x4){0.f, 0.f, 0.f, 0.f};
#pragma unroll
                    for (int ks = 0; ks < 4; ++ks) {
                        const bf16x8 av = *(const LAS bf16x8*)(lds + qoff + (qrow + fr) * TB + (32 * ks + 8 * g) * 2);
                        const bf16x8 bv = *(const LAS bf16x8*)(lds + koff + (krow + fr) * TB + (32 * ks + 8 * g) * 2);
                        pa = __builtin_amdgcn_mfma_f32_16x16x32_bf16(av, bv, pa, 0, 0, 0);
                    }
#pragma unroll
                    for (int e = 0; e < 4; ++e) {
                        const int tl = 4 * g + e; const float val = (diag && fr > tl) ? 0.f : pa[e];
                        *(LAS bf16_t*)(lds + T_P + (16 * I + tl) * PB + (16 * J + fr) * 2) = (bf16_t)f2bf(val);
                    }
                }
            }
            f32x4 oacc[4];
#pragma unroll
            for (int m = 0; m < 4; ++m) oacc[m] = (f32x4){0.f, 0.f, 0.f, 0.f};
            if (lat) {
                bf16x8 Sb[4];
#pragma unroll
                for (int ks = 0; ks < 4; ++ks) {
                    const f32x4 a0 = Sacc[2 * ks], a1 = Sacc[2 * ks + 1];
                    const u32x4 pk = (u32x4){pk2(a0[0], a0[1]), pk2(a0[2], a0[3]), pk2(a1[0], a1[1]), pk2(a1[2], a1[3])};
                    Sb[ks] = __builtin_bit_cast(bf16x8, pk);
                }
#pragma unroll
                for (int m = 0; m < 4; ++m)
#pragma unroll
                    for (int ks = 0; ks < 4; ++ks) {
                        const u32x2 lo = *(const LAS u32x2*)(lds + T_QC + (16 * m + fr) * TB + (32 * ks + 4 * g) * 2);
                        const u32x2 hi = *(const LAS u32x2*)(lds + T_QC + (16 * m + fr) * TB + (32 * ks + 16 + 4 * g) * 2);
                        const u32x4 pk = (u32x4){lo.x, lo.y, hi.x, hi.y};
                        oacc[m] = __builtin_amdgcn_mfma_f32_16x16x32_bf16(__builtin_bit_cast(bf16x8, pk), Sb[ks], oacc[m], 0, 0, 0);
                    }
            }
#pragma unroll
            for (int m = 0; m < 8; ++m) { const f32x4 ct = *(const LAS f32x4*)(lds + T_CT + (16 * m + 4 * g) * 4); Sacc[m] = Sacc[m] * ct; }
            bf16x8 Vf[2];
#pragma unroll
            for (int ks = 0; ks < 2; ++ks) Vf[ks] = tr_frag(lds + vbuf, 32 * ks + 8 * g, 16 * w, lane);
#pragma unroll
            for (int m = 0; m < 8; ++m)
#pragma unroll
                for (int ks = 0; ks < 2; ++ks) Sacc[m] = __builtin_amdgcn_mfma_f32_16x16x32_bf16(tr_frag(lds + T_KC, 32 * ks + 8 * g, 16 * m, lane), Vf[ks], Sacc[m], 0, 0, 0);
            HG_BAR();
            if (lat) {
#pragma unroll
                for (int m = 0; m < 4; ++m)
#pragma unroll
                    for (int ks = 0; ks < 2; ++ks) {
                        if (m < 2 && ks == 1) continue;
                        const bf16x8 av = *(const LAS bf16x8*)(lds + T_P + (16 * m + fr) * PB + (32 * ks + 8 * g) * 2);
                        oacc[m] = __builtin_amdgcn_mfma_f32_16x16x32_bf16(av, Vf[ks], oacc[m], 0, 0, 0);
                    }
#pragma unroll
                for (int m = 0; m < 4; ++m)
#pragma unroll
                    for (int e = 0; e < 4; ++e) { const int r = row_of(dir, 64 * cidx + 16 * m + 4 * g + e); OL[(size_t)(r - C) * D + hc + 16 * w + fr] = oacc[m][e]; }
            }
        }
#undef HG_LOAD
        float* DS = (float*)(c.ws + WS_DS) + (size_t)item * 16384; float* DG = (float*)(c.ws + WS_DG) + item * 128;
#pragma unroll
        for (int m = 0; m < 8; ++m)
#pragma unroll
            for (int e = 0; e < 4; ++e) DS[(16 * m + 4 * g + e) * 128 + 16 * w + fr] = Sacc[m][e];
        if (w == 0) { DG[2 * lane] = dseg0; DG[2 * lane + 1] = dseg1; }
    }
}

#undef HG_BAR
__device__ __forceinline__ void phase_hgrn_fold(const Ctx& c) {
    const float* DS = (const float*)(c.ws + WS_DS); const float* DG = (const float*)(c.ws + WS_DG); bf16_t* SST = (bf16_t*)(c.ws + WS_SST);
    for (int item = c.wg; item < 256; item += c.nwg) {
        const int chain = item >> 4, slice = item & 15, d = 8 * slice + (c.tid >> 6), v2 = (c.tid & 63) * 2;
        float s0 = 0.f, s1 = 0.f;
        float dv[15]; f32x2 ds[15];
#pragma unroll
        for (int sgi = 0; sgi < 15; ++sgi) { dv[sgi] = DG[(chain * 16 + sgi) * 128 + d]; ds[sgi] = *(const f32x2*)(DS + ((size_t)(chain * 16 + sgi) * 128 + d) * 128 + v2); }
        SST[((size_t)(chain * 16) * 128 + v2) * 128 + d] = 0; SST[((size_t)(chain * 16) * 128 + v2 + 1) * 128 + d] = 0;
#pragma unroll
        for (int sgi = 0; sgi < 15; ++sgi) {
            s0 = dv[sgi] * s0 + ds[sgi][0]; s1 = dv[sgi] * s1 + ds[sgi][1];
            SST[((size_t)(chain * 16 + sgi + 1) * 128 + v2) * 128 + d] = (bf16_t)f2bf(s0); SST[((size_t)(chain * 16 + sgi + 1) * 128 + v2 + 1) * 128 + d] = (bf16_t)f2bf(s1);
        }
    }
}

__device__ __forceinline__ void phase_hgrn_readout(const Ctx& c) {
    constexpr int SP = 272, SBUF = 128 * SP, IBUF = 2 * SBUF;
    static_assert(2 * IBUF + 1024 <= LDS_BYTES - 64, "readout LDS map");
    const float* OF = (const float*)(c.ws + WS_OF); const float* OB = (const float*)(c.ws + WS_OB); const bf16_t* SGp = (const bf16_t*)(c.ws + WS_SG);
    const bf16_t* SST = (const bf16_t*)(c.ws + WS_SST); bf16_t* RR = (bf16_t*)(c.ws + WS_RR); const float* hng = c.a->in[13];
    LAS unsigned char* lds = c.lds; LAS float* ssx = (LAS float*)(c.lds + 2 * IBUF);
    const int tid = c.tid, lane = c.lane, w = __builtin_amdgcn_readfirstlane(tid >> 6), fr = lane & 15, g = lane >> 4, mt = w & 3, nh = w >> 2;
#define RO_BAR() asm volatile("s_waitcnt lgkmcnt(0)\n\ts_barrier" ::: "memory")
    u32x4 sreg[8];
#define RO_SST_LOAD(it) do { const int h_ = (it) >> 8, ch_ = (it) & 255; \
        _Pragma("unroll") for (int j = 0; j < 8; ++j) { const int idx_ = tid + 512 * j, dx_ = idx_ >> 11, rem_ = idx_ & 2047; \
            const int sg_ = hg::seg_of(dx_ ? 4 + 255 - ch_ : 4 + ch_); \
            sreg[j] = *(const u32x4*)(SST + ((size_t)((h_ * 2 + dx_) * 16 + sg_) * 128 + (rem_ >> 4)) * 128 + (rem_ & 15) * 8); } } while (0)
#define RO_SST_WRITE(buf) do { _Pragma("unroll") for (int j = 0; j < 8; ++j) { const int idx_ = tid + 512 * j, dx_ = idx_ >> 11, rem_ = idx_ & 2047; \
            *(LAS u32x4*)(lds + (buf) * IBUF + dx_ * SBUF + (rem_ >> 4) * SP + (rem_ & 15) * 16) = sreg[j]; } } while (0)
    int it = c.wg;
    RO_BAR();
    if (it < 2048) { RO_SST_LOAD(it); RO_SST_WRITE(0); }
    RO_BAR();
    for (int k = 0; it < 2048; it += c.nwg, ++k) {
        const int h = it >> 8, ch = it & 255, t0 = 64 * ch + 16 * mt, buf = k & 1;
        const bool has_next = it + c.nwg < 2048;
        if (has_next) RO_SST_LOAD(it + c.nwg);
        f32x4 acc[4]; float sgv[4][4];
#pragma unroll
        for (int n = 0; n < 4; ++n)
#pragma unroll
            for (int e = 0; e < 4; ++e) { const size_t o = (size_t)(t0 + 4 * g + e) * D + h * 128 + 64 * nh + 16 * n + fr; acc[n][e] = OF[o] + OB[o]; sgv[n][e] = bf2f(SGp[o]) * hng[h * 128 + 64 * nh + 16 * n + fr]; }
#pragma unroll
        for (int dx = 0; dx < 2; ++dx) {
            const bf16_t* QS = (const bf16_t*)(c.ws + (dx ? WS_QSB : WS_QSF)) + (size_t)(t0 + fr) * D + h * 128 + 8 * g;
            const LAS unsigned char* sb = lds + buf * IBUF + dx * SBUF + (64 * nh + fr) * SP + 16 * g;
#pragma unroll
            for (int ks = 0; ks < 4; ++ks) {
                const bf16x8 av = *(const bf16x8*)(QS + 32 * ks);
#pragma unroll
                for (int n = 0; n < 4; ++n) acc[n] = __builtin_amdgcn_mfma_f32_16x16x32_bf16(av, *(const LAS bf16x8*)(sb + (16 * n) * SP + 64 * ks), acc[n], 0, 0, 0);
            }
        }
        float ss[4] = {0.f, 0.f, 0.f, 0.f};
#pragma unroll
        for (int n = 0; n < 4; ++n)
#pragma unroll
            for (int e = 0; e < 4; ++e) ss[e] += acc[n][e] * acc[n][e];
#pragma unroll
        for (int e = 0; e < 4; ++e) {
#pragma unroll
            for (int sh = 8; sh > 0; sh >>= 1) ss[e] += __shfl_xor(ss[e], sh);
        }
        if (fr == 0) *(LAS f32x4*)(ssx + ((k & 1) * 8 + w) * 16 + 4 * g) = (f32x4){ss[0], ss[1], ss[2], ss[3]};
        if (has_next) RO_SST_WRITE(buf ^ 1);
        RO_BAR();
        const f32x4 ps = *(const LAS f32x4*)(ssx + ((k & 1) * 8 + (w ^ 4)) * 16 + 4 * g);
#pragma unroll
        for (int e = 0; e < 4; ++e) ss[e] = rsqrtf((ss[e] + ps[e]) * (1.f / 128.f) + EPS);
#pragma unroll
        for (int n = 0; n < 4; ++n)
#pragma unroll
            for (int e = 0; e < 4; ++e) { const size_t o = (size_t)(t0 + 4 * g + e) * D + h * 128 + 64 * nh + 16 * n + fr; RR[o] = (bf16_t)f2bf(acc[n][e] * ss[e] * sgv[n][e]); }
    }
    RO_BAR();
#undef RO_BAR
#undef RO_SST_LOAD
#undef RO_SST_WRITE
}

#define XB_TMO      128
#define XB_XCNT(j)  (256  + 64 * (j))
#define XB_XSUB(j)  (1280 + 64 * (j))
#define XB_XGEN(j)  (2304 + 64 * (j))
#define XB_TOP      3328
#define XB_TOPGEN   3392
#define XCD_BAR_WORDS 3456
#define XB_SPIN_CAP (1u << 18)
__device__ __forceinline__ unsigned xb_ld(unsigned* p)              { return __hip_atomic_load(p, __ATOMIC_RELAXED, __HIP_MEMORY_SCOPE_AGENT); }
__device__ __forceinline__ unsigned xb_add(unsigned* p, unsigned v) { return __hip_atomic_fetch_add(p, v, __ATOMIC_RELAXED, __HIP_MEMORY_SCOPE_AGENT); }
__device__ __forceinline__ unsigned xb_xcc_id() { return (unsigned)__builtin_amdgcn_s_getreg((3 << 11) | 20) & 0xFu; }
#define XB_SPIN(cond, bar) do { unsigned _sp = 0; while (cond) { __builtin_amdgcn_s_sleep(1); \
    if ((++_sp & 255u) == 0u) { if (xb_ld(&(bar)[XB_TMO])) break; if (_sp > XB_SPIN_CAP) { atomicAdd(&(bar)[XB_TMO], 1u); break; } } } } while (0)
struct XcdBarrier { unsigned* bar; unsigned x; volatile LAS unsigned* st; };
__device__ __forceinline__ XcdBarrier xcd_barrier_post(unsigned* bar, volatile LAS unsigned* st) {
    XcdBarrier b; b.bar = bar; b.x = xb_xcc_id(); b.st = st;
    if (threadIdx.x == 0) (void)xb_add(&bar[XB_XCNT(b.x)], 1u);
    return b;
}
__device__ __forceinline__ void xcd_barrier_complete(unsigned* bar, unsigned x, unsigned& nloc, unsigned& nx) {
    const unsigned G = gridDim.x * gridDim.y * gridDim.z;
    unsigned sum, cnt, mine, sp = 0u;
    for (;;) {
        sum = 0u; cnt = 0u; mine = 0u;
#pragma unroll
        for (unsigned j = 0; j < 16; ++j) { const unsigned c = xb_ld(&bar[XB_XCNT(j)]); sum += c; cnt += (c > 0u) ? 1u : 0u; mine = (j == x) ? c : mine; }
        if (sum == G) break;
        __builtin_amdgcn_s_sleep(1);
        if ((++sp & 255u) == 0u) { if (xb_ld(&bar[XB_TMO])) break; if (sp > XB_SPIN_CAP) { atomicAdd(&bar[XB_TMO], 1u); break; } }
    }
    nloc = mine > 0u ? mine : 1u; nx = cnt > 0u ? cnt : 1u;
}
__device__ __forceinline__ void xcd_barrier(const XcdBarrier& b) {
    asm volatile("s_waitcnt vmcnt(0)" ::: "memory");
    __syncthreads();
    if (threadIdx.x == 0) {
        unsigned* bar = b.bar;
        __builtin_amdgcn_s_waitcnt(0);
        unsigned nloc = b.st[0], nx = b.st[1];
        if (nloc == 0u) { xcd_barrier_complete(bar, b.x, nloc, nx); b.st[0] = nloc; b.st[1] = nx; }
        const unsigned old = xb_add(&bar[XB_XSUB(b.x)], 1u);
        const unsigned gen = old / nloc;
        if (old + 1u == (gen + 1u) * nloc) {
            __builtin_amdgcn_fence(__ATOMIC_RELEASE, "agent");
            asm volatile("s_waitcnt vmcnt(0)" ::: "memory");
            const unsigned og = xb_add(&bar[XB_TOP], 1u);
            const unsigned tg = og / nx;
            if (og + 1u == (tg + 1u) * nx) xb_add(&bar[XB_TOPGEN], 1u);
            else XB_SPIN(xb_ld(&bar[XB_TOPGEN]) == tg, bar);
            __builtin_amdgcn_fence(__ATOMIC_ACQUIRE, "agent");
            xb_add(&bar[XB_XGEN(b.x)], 1u);
            asm volatile("s_waitcnt vmcnt(0)" ::: "memory");
        } else {
            XB_SPIN(xb_ld(&bar[XB_XGEN(b.x)]) == gen, bar);
            __builtin_amdgcn_fence(__ATOMIC_ACQUIRE, "agent");
            asm volatile("s_waitcnt vmcnt(0)" ::: "memory");
        }
    }
    __syncthreads();
}

__device__ __forceinline__ void launder(Ctx& c) { asm volatile("" : "+s"(c.a)); asm volatile("" : "+s"(c.ws)); asm volatile("" : "+s"(c.wave));
    c.lane = (int)__builtin_amdgcn_mbcnt_hi(~0u, __builtin_amdgcn_mbcnt_lo(~0u, 0u)); c.tid = c.wave * 64 + c.lane; }
__global__ void __launch_bounds__(512, 2) mk_fwd(Args args) {
    extern __shared__ __attribute__((aligned(16))) unsigned char lds_raw[];
    Ctx c; c.a = (CArgs)__builtin_amdgcn_kernarg_segment_ptr(); c.lds = (LAS unsigned char*)lds_raw; c.tid = threadIdx.x; c.lane = c.tid & 63; c.wave = __builtin_amdgcn_readfirstlane(c.tid >> 6); c.nwg = gridDim.x; c.wg = blockIdx.x; c.ws = c.a->ws;
    volatile LAS unsigned* bst = (volatile LAS unsigned*)(c.lds + LDS_BYTES - 64);
    if (c.tid < 4) bst[c.tid] = 0u;
    __syncthreads();
    const XcdBarrier bar = xcd_barrier_post((unsigned*)(c.ws + WS_CTL) + CW_BAR, bst);
    const int lo = c.a->ph_lo, hi = c.a->ph_hi;
    bool route_ok = true;
#define SEAM(k) do { if (lo <= (k) && (k) + 1 < hi) xcd_barrier(bar); } while (0)
#define IN(k) (lo <= (k) && (k) < hi && (launder(c), true))
#define PH(k, call) do { if (IN(k)) { if (PROBE_PH == (k)) { int nrep_ = 3; asm volatile("" : "+s"(nrep_)); for (int rep_ = 0; rep_ < nrep_; ++rep_) { route_ok = (rep_ + 1 == nrep_); call; if (rep_ + 1 < nrep_) xcd_barrier(bar); } } else { call; } } SEAM(k); } while (0)
    PH(0, phase_prep(c));
    PH(1, phase_convert(c));
    PH(2, phase_gemm_qkv(c));
    PH(3, phase_attn(c));
    PH(4, phase_gemm_f32(c, (const bf16_t*)(c.ws + WS_O), R, (const bf16_t*)(c.ws + WS_WO), D, nullptr, (float*)(c.ws + WS_RAW1)));
    PH(5, { phase_postmix(c, 0, route_ok); convert_steal(c); });
    PH(6, phase_moe_gu(c, 0));
    PH(7, phase_moe_dn(c, 0));
    PH(8, phase_combine(c, 0));
    PH(9, phase_gemm_inproj(c));
    PH(10, phase_hgrn_scan(c));
    PH(11, phase_hgrn_fold(c));
    PH(12, phase_hgrn_readout(c));
    PH(13, phase_gemm_f32(c, (const bf16_t*)(c.ws + WS_RR), L, (const bf16_t*)(c.ws + WS_WHO), D, nullptr, (float*)(c.ws + WS_RAW1)));
    PH(14, phase_postmix(c, 1, route_ok));
    PH(15, phase_moe_gu(c, 1));
    PH(16, phase_moe_dn(c, 1));
    PH(17, phase_combine(c, 1));
#undef IN
#undef PH
#undef SEAM
}

extern "C" void kernel_launch(void* const* d_in, const int* in_sizes, int n_in, void* d_out, int out_size, void* d_ws, size_t ws_size, hipStream_t stream) {
    static int grid = 0;
    if (grid == 0) {
        if (n_in != 21 || out_size != L * D || ws_size < WS_END) { fprintf(stderr, "kernel_launch: unexpected problem (n_in %d out %d ws %zu need %zu)\n", n_in, out_size, ws_size, (size_t)WS_END); grid = -1; return; }
        int dev = 0, cus = 0, per_cu = 0;
        hipGetDevice(&dev); hipDeviceGetAttribute(&cus, hipDeviceAttributeMultiprocessorCount, dev);
        if (hipFuncSetAttribute((const void*)mk_fwd, hipFuncAttributeMaxDynamicSharedMemorySize, LDS_BYTES) != hipSuccess) { fprintf(stderr, "kernel_launch: hipFuncSetAttribute failed\n"); grid = -1; return; }
        hipOccupancyMaxActiveBlocksPerMultiprocessor(&per_cu, (const void*)mk_fwd, 512, LDS_BYTES);
        if (per_cu < 1) fprintf(stderr, "kernel_launch: occupancy query says %d\n", per_cu);
        (void)hipGetLastError();
        grid = cus > 0 ? cus : 256;
    }
    if (grid < 0) return;
    hipMemsetAsync((char*)d_ws + WS_CTL, 0, MiB, stream);
    Args a{};
    for (int i = 0; i < 21; ++i) a.in[i] = (const float*)d_in[i];
    a.out = (float*)d_out; a.ws = (unsigned char*)d_ws;
    a.ph_lo = 0; a.ph_hi = NPHASE;
    hipLaunchKernelGGL(mk_fwd, dim3(grid), dim3(512), LDS_BYTES, stream, a);
}
```

```cpp
#include <hip/hip_runtime.h>
#include <cstdint>
#include <cstdio>

#define LAS __attribute__((address_space(3)))
typedef unsigned short bf16_t;
typedef short bf16x8 __attribute__((ext_vector_type(8)));
typedef float f32x4 __attribute__((ext_vector_type(4)));
typedef unsigned u32x4 __attribute__((ext_vector_type(4)));
typedef unsigned u32x2 __attribute__((ext_vector_type(2)));
typedef short v4i16_t __attribute__((ext_vector_type(4)));
typedef float f32x2 __attribute__((ext_vector_type(2)));

constexpr int D = 1024, L = 16384, C = 256, R = L + C;
constexpr int QKVD = 1280, HIN = 5120, NE = 32, TOPK = 4;
constexpr int PADM = 256, MAXROWS = 74752;
constexpr float EPS = 1e-6f;
constexpr float LOG2E = 1.4426950408889634f;
constexpr int NPHASE = 18;
#ifndef GEMM_REP
#define GEMM_REP 1
#endif
#ifndef PROBE_NOEPI
#define PROBE_NOEPI 0
#endif
#ifndef PROBE_SHORTK
#define PROBE_SHORTK 0
#endif
#ifndef SCAN_REP
#define SCAN_REP 1
#endif
#ifndef PROBE_PH
#define PROBE_PH (-1)
#endif
constexpr int LDS_BYTES = 147456;

constexpr size_t MiB = 1u << 20;
constexpr size_t al(size_t x) { return (x + MiB - 1) / MiB * MiB; }
constexpr size_t WS_CTL = 0;
constexpr size_t WS_MOD = WS_CTL + MiB;
constexpr size_t WS_X = WS_MOD + MiB;
constexpr size_t WS_H = WS_X + al((size_t)R * D * 4);
constexpr size_t WS_Q = WS_H + al((size_t)R * D * 2);
constexpr size_t WS_K = WS_Q + al((size_t)R * D * 2);
constexpr size_t WS_V = WS_K + al((size_t)R * 128 * 2);
constexpr size_t WS_O = WS_V + al((size_t)R * 128 * 2);
constexpr size_t WS_TK = WS_O + al((size_t)R * D * 2);
constexpr size_t WS_LIST = WS_TK + MiB;
constexpr size_t WS_HDN = WS_LIST + 3 * MiB;
constexpr size_t WS_RAW1 = WS_HDN + al((size_t)MAXROWS * 1024 * 2);
constexpr size_t WS_X1 = WS_RAW1 + al((size_t)R * D * 4);
constexpr size_t WS_OUTB = WS_X1 + al((size_t)R * D * 4);
constexpr size_t WS_QH = WS_OUTB + al((size_t)MAXROWS * 1024 * 2);
constexpr size_t WS_KF = WS_QH + al((size_t)L * D * 2);
constexpr size_t WS_KB = WS_KF + al((size_t)R * D * 2);
constexpr size_t WS_IV = WS_KB + al((size_t)R * D * 2);
constexpr size_t WS_SG = WS_IV + al((size_t)R * D * 2);
constexpr size_t WS_OF = WS_SG + al((size_t)L * D * 2);
constexpr size_t WS_OB = WS_OF + al((size_t)L * D * 4);
constexpr size_t WS_RR = WS_OB + al((size_t)L * D * 4);
constexpr size_t WS_WQKV = WS_RR + al((size_t)L * D * 2);
constexpr size_t WS_WO = WS_WQKV + al((size_t)QKVD * D * 2);
constexpr size_t WS_WIN = WS_WO + al((size_t)D * D * 2);
constexpr size_t WS_WHO = WS_WIN + al((size_t)HIN * D * 2);
constexpr size_t WS_WGU = WS_WHO + al((size_t)D * D * 2);
constexpr size_t WS_WDN = WS_WGU + al((size_t)2 * NE * 2048 * D * 2);
constexpr size_t WS_QSF = WS_WDN + al((size_t)2 * NE * 1024 * D * 2);
constexpr size_t WS_QSB = WS_QSF + al((size_t)L * D * 2);
constexpr size_t WS_DS = WS_QSB + al((size_t)L * D * 2);
constexpr size_t WS_DG = WS_DS + al((size_t)256 * 128 * 128 * 4);
constexpr size_t WS_SST = WS_DG + MiB;
constexpr size_t WS_H8 = WS_SST + al((size_t)256 * 128 * 128 * 2);
constexpr size_t WS_END = WS_H8 + al((size_t)R * D);
static_assert(WS_END <= (size_t)2048 * MiB, "workspace map exceeds 4x the largest input");
constexpr int CW_CNT = 1024;
constexpr int CW_CONV = 2048;
constexpr int CW_BAR = 4096;
constexpr int MOD_ROPE = 32768;
constexpr int MOD_LB = 49152;

struct Args { const float* in[21]; float* out; unsigned char* ws; int ph_lo, ph_hi; };

__device__ __forceinline__ unsigned f2bf(float f) { unsigned u = __float_as_uint(f); return (u + 0x7fffu + ((u >> 16) & 1u)) >> 16; }
typedef float f32x2_t __attribute__((ext_vector_type(2))); typedef __bf16 bf16x2_t __attribute__((ext_vector_type(2)));
__device__ __forceinline__ unsigned pk2(float lo, float hi) { f32x2_t v = {lo, hi}; bf16x2_t b = __builtin_convertvector(v, bf16x2_t); return __builtin_bit_cast(unsigned, b); }
__device__ __forceinline__ unsigned pk4_fp8(float a, float b, float c, float d) {
    a = fminf(fmaxf(a, -448.f), 448.f); b = fminf(fmaxf(b, -448.f), 448.f); c = fminf(fmaxf(c, -448.f), 448.f); d = fminf(fmaxf(d, -448.f), 448.f);
    int v = __builtin_amdgcn_cvt_pk_fp8_f32(a, b, 0, false); v = __builtin_amdgcn_cvt_pk_fp8_f32(c, d, v, true); return (unsigned)v; }
constexpr float F8_SH = 8.f, F8_SW = 64.f, F8_SHD = 4.f;
__device__ __forceinline__ float bflo(unsigned u) { return __uint_as_float(u << 16); }
__device__ __forceinline__ float bfhi(unsigned u) { return __uint_as_float(u & 0xffff0000u); }
__device__ __forceinline__ float bf2f(bf16_t b) { return __uint_as_float(((unsigned)b) << 16); }
__device__ __forceinline__ float wave_sum(float v) {
#pragma unroll
    for (int o = 32; o > 0; o >>= 1) v += __shfl_xor(v, o);
    return v;
}
__device__ __forceinline__ float silu_f(float x) { return x / (1.f + __expf(-x)); }
__device__ __forceinline__ float sigmoid_f(float x) { return 1.f / (1.f + __expf(-x)); }

typedef const __attribute__((address_space(4))) Args* CArgs;
struct Ctx {
    CArgs a;
    LAS unsigned char* lds;
    int tid, lane, wave, nwg, wg;
    unsigned char* ws;
    __device__ __forceinline__ float* modp(int layer, int which) const { return (float*)(ws + WS_MOD) + (layer * 2 + which) * 6144; }
    __device__ __forceinline__ const float* xin0(int r) const { return r < C ? a->in[2] + (size_t)r * D : a->in[0] + (size_t)(r - C) * D; }
};


namespace pg8 {
constexpr int BM = 256, BK = 64, HALF = 128, HTB = HALF * BK * 2, STAGE_BYTES = 8 * HTB, KD = 1024, NXCD = 8, WGM = 8;
__device__ __forceinline__ int lds_byte(int r, int c) { const int st = (r >> 4) * 2 + (c >> 5), rr = r & 15, cc = c & 31, ob = rr * 64 + cc * 2; return st * 1024 + (ob ^ (((ob >> 9) & 1) << 5)); }
__device__ __forceinline__ void stage_rc(int b, int& Rr, int& Cc) { const int st = b / 1024, sb = b % 1024, swz = sb ^ (((sb >> 9) & 1) << 5); Rr = (st >> 1) * 16 + swz / 64; Cc = (st & 1) * 32 + (swz % 64) / 2; }
__device__ __forceinline__ int perm32(int rho) { const int n = rho >> 4, i = rho & 15; return 8 * (i >> 2) + 4 * n + (i & 3); }

struct Unit { int pm, pn, e, goff, gcnt; bool real; int amask, bmask; };
struct Gemm { const void* A; const void* Bt; size_t bstride; const int* list; };

struct StaticOrder {
    int nM, nN, nwg, G, c;
    __device__ __forceinline__ void init(int M, int N, int G_, int c_) { nM = M / BM; nN = N / BM; nwg = nM * nN; G = G_; c = c_; }
    __device__ __forceinline__ bool next(int i, Unit& u) const {
        const int F = nwg / G, Rm = nwg - F * G; int Lq; u.amask = 3; u.bmask = 3;
        if (i < F) Lq = i * G + c;
        else if (i == F && Rm > 0) {
            if (4 * Rm <= G) { if (c >= 4 * Rm) return false; Lq = F * G + (c >> 2); u.amask = 1 << ((c >> 1) & 1); u.bmask = 1 << (c & 1); }
            else if (2 * Rm <= G) { if (c >= 2 * Rm) return false; Lq = F * G + (c >> 1); u.bmask = 1 << (c & 1); }
            else { if (c >= Rm) return false; Lq = F * G + c; }
        } else return false;
        int wgid = Lq; { const int q = nwg / NXCD, r = nwg % NXCD, xcd = wgid % NXCD, off = wgid / NXCD; wgid = (xcd < r ? xcd * (q + 1) : r * (q + 1) + (xcd - r) * q) + off; }
        const int nig = WGM * nN, gid = wgid / nig, fm = gid * WGM, gsz = (nM - fm) < WGM ? (nM - fm) : WGM;
        u.pm = fm + ((wgid % nig) % gsz); u.pn = (wgid % nig) / gsz; u.e = 0; u.goff = 0; u.gcnt = 0; u.real = true; return true;
    }
};
struct MoeOrder {
    const LAS int* tp; const LAS int* cnt; int npn, G, vcu; bool split;
    __device__ __forceinline__ bool next(int i, Unit& u) const {
        const int tot = tp[32] * npn; int lin; u.amask = 3; u.bmask = 3; u.real = true;
        if (GEMM_REP > 1) { const int lin0 = i * G + vcu; if (lin0 >= tot * GEMM_REP) return false; lin = lin0 % tot; u.real = lin0 >= tot * (GEMM_REP - 1); }
        else {
            const int F = tot / G, Rm = tot - F * G;
            if (i < F) lin = i * G + vcu;
            else if (i == F && Rm > 0) {
                if (split && 2 * Rm <= G) { if (vcu >= 2 * Rm) return false; lin = F * G + (vcu >> 1); u.bmask = 1 << (vcu & 1); }
                else { if (vcu >= Rm) return false; lin = F * G + vcu; }
            } else return false;
        }
        const int rt = lin / npn; int e = 0;
#pragma unroll 8
        for (int k = 1; k < 32; ++k) e += (rt >= tp[k]) ? 1 : 0;
        const int mt = rt - tp[e];
        u.pm = rt; u.pn = lin - rt * npn; u.e = e; u.goff = e * R + mt * 256; u.gcnt = cnt[e] - mt * 256; return true;
    }
};

template <int KB>
__device__ __forceinline__ void a_offsets(const Gemm& g, const Unit& u, const int (&sR)[2], const int (&sC)[2], unsigned (&v)[2][2]) {
#pragma unroll
    for (int h = 0; h < 2; ++h)
#pragma unroll
        for (int i = 0; i < 2; ++i) {
            const int rr = h * HALF + sR[i]; int row;
            if (g.list) row = rr < u.gcnt ? g.list[u.goff + rr] : 0; else row = u.pm * BM + rr;
            v[h][i] = (unsigned)(row * KB + sC[i] * 2);
        }
}

struct EpiF32 {
    static constexpr bool PERM = false;
    float* Cp; int ldc; const float* bias;
    __device__ __forceinline__ void operator()(const f32x4 (&acc)[2][2][4][2], const Unit& u, int wr, int wc, int fr, int fq) const {
        const int row0 = u.pm * BM + wr * 64 + fr, col0 = u.pn * BM + wc * 32 + 4 * fq;
#pragma unroll
        for (int bj = 0; bj < 2; ++bj)
#pragma unroll
            for (int n = 0; n < 2; ++n) {
                const int col = col0 + bj * HALF + n * 16;
                if (!((u.bmask >> bj) & 1)) continue;
                const f32x4 bv = bias ? *(const f32x4*)(bias + col) : (f32x4){0.f, 0.f, 0.f, 0.f};
#pragma unroll
                for (int ai = 0; ai < 2; ++ai)
#pragma unroll
                    for (int m = 0; m < 4; ++m) if ((u.amask >> ai) & 1) *(f32x4*)(Cp + (size_t)(row0 + ai * HALF + m * 16) * ldc + col) = acc[ai][bj][m][n] + bv;
            }
    }
};
struct EpiSwiglu {
    static constexpr bool PERM = true;
    unsigned char* Hd; const float* bgu;
    __device__ __forceinline__ void operator()(const f32x4 (&acc)[2][2][4][2], const Unit& u, int wr, int wc, int fr, int fq) const {
        const int row0 = u.pm * BM + wr * 64 + fr, cg0 = u.pn * HALF + wc * 32 + 8 * fq;
        const float* bb = bgu + (size_t)u.e * 2048;
        f32x4 bg[2], bu[2];
#pragma unroll
        for (int n = 0; n < 2; ++n) { bg[n] = *(const f32x4*)(bb + cg0 + 4 * n); bu[n] = *(const f32x4*)(bb + 1024 + cg0 + 4 * n); }
#pragma unroll
        for (int ai = 0; ai < 2; ++ai)
#pragma unroll
            for (int m = 0; m < 4; ++m) {
                u32x2 o;
#pragma unroll
                for (int n = 0; n < 2; ++n) {
                    const f32x4 gv = acc[ai][0][m][n] * (1.f / (F8_SH * F8_SW)) + bg[n], uv = acc[ai][1][m][n] * (1.f / (F8_SH * F8_SW)) + bu[n]; float hv[4];
#pragma unroll
                    for (int q = 0; q < 4; ++q) { const float gg = fminf(gv[q], 7.f), uu = fminf(fmaxf(uv[q], -7.f), 7.f); hv[q] = gg * (1.f / (1.f + __expf(-1.702f * gg))) * (uu + 1.f); }
                    o[n] = pk4_fp8(hv[0] * F8_SHD, hv[1] * F8_SHD, hv[2] * F8_SHD, hv[3] * F8_SHD);
                }
                *(u32x2*)(Hd + (size_t)(row0 + ai * HALF + m * 16) * 1024 + cg0) = o;
            }
    }
};
struct EpiBf16Bias {
    static constexpr bool PERM = true;
    bf16_t* Op; const float* bias; int bias_estride; float scale;
    __device__ __forceinline__ void operator()(const f32x4 (&acc)[2][2][4][2], const Unit& u, int wr, int wc, int fr, int fq) const {
        const int row0 = u.pm * BM + wr * 64 + fr, col0 = u.pn * BM + wc * 32 + 8 * fq;
        const float* bb = bias + (size_t)u.e * bias_estride;
#pragma unroll
        for (int bj = 0; bj < 2; ++bj) {
            const int col = col0 + bj * HALF;
            if (!((u.bmask >> bj) & 1)) continue;
            const f32x4 b0 = *(const f32x4*)(bb + col), b1 = *(const f32x4*)(bb + col + 4);
#pragma unroll
            for (int ai = 0; ai < 2; ++ai)
#pragma unroll
                for (int m = 0; m < 4; ++m) { if (!((u.amask >> ai) & 1)) continue; const f32x4 v0 = acc[ai][bj][m][0] * scale + b0, v1 = acc[ai][bj][m][1] * scale + b1;
                    u32x4 o; o.x = pk2(v0[0], v0[1]); o.y = pk2(v0[2], v0[3]); o.z = pk2(v1[0], v1[1]); o.w = pk2(v1[2], v1[3]);
                    *(u32x4*)(Op + (size_t)(row0 + ai * HALF + m * 16) * 1024 + col) = o; }
        }
    }
};
struct EpiQKV {
    static constexpr bool PERM = false;
    bf16_t* Qp; bf16_t* Kp; bf16_t* Vp; const float* bias; const float* tab;
    __device__ __forceinline__ void operator()(const f32x4 (&acc)[2][2][4][2], const Unit& u, int wr, int wc, int fr, int fq) const {
        const bool lat = u.pm > 0; const float qs = 0.125f * LOG2E;
#pragma unroll
        for (int bj = 0; bj < 2; ++bj) {
            const int colt = u.pn * BM + bj * HALF + wc * 32 + 4 * fq;
            const f32x4 b1 = *(const f32x4*)(bias + colt), b2 = *(const f32x4*)(bias + colt + 16);
            const bool isv = (u.pn == 4) && (bj == 1);
            if (!((u.bmask >> bj) & 1)) continue;
#pragma unroll
            for (int ai = 0; ai < 2; ++ai)
#pragma unroll
                for (int m = 0; m < 4; ++m) {
                    if (!((u.amask >> ai) & 1)) continue;
                    const int r = u.pm * BM + ai * HALF + wr * 64 + m * 16 + fr, t = r - C;
                    f32x4 x1 = acc[ai][bj][m][0] + b1, x2 = acc[ai][bj][m][1] + b2;
                    if (lat && !isv) {
                        const int pos = (wc & 1) ? (t & 63) : (t >> 6);
                        const f32x4 t0 = *(const f32x4*)(tab + (pos * 16 + 4 * fq) * 2), t1 = *(const f32x4*)(tab + (pos * 16 + 4 * fq) * 2 + 4);
                        const float cs[4] = {t0[0], t0[2], t1[0], t1[2]}, sn[4] = {t0[1], t0[3], t1[1], t1[3]};
                        f32x4 o1, o2;
#pragma unroll
                        for (int e = 0; e < 4; ++e) { o1[e] = x1[e] * cs[e] - x2[e] * sn[e]; o2[e] = x2[e] * cs[e] + x1[e] * sn[e]; }
                        x1 = o1; x2 = o2;
                    }
                    u32x2 w1, w2;
                    if (u.pn < 4) {
                        w1.x = pk2(x1[0] * qs, x1[1] * qs); w1.y = pk2(x1[2] * qs, x1[3] * qs); w2.x = pk2(x2[0] * qs, x2[1] * qs); w2.y = pk2(x2[2] * qs, x2[3] * qs);
                        *(u32x2*)(Qp + (size_t)r * 1024 + colt) = w1; *(u32x2*)(Qp + (size_t)r * 1024 + colt + 16) = w2;
                    } else {
                        w1.x = pk2(x1[0], x1[1]); w1.y = pk2(x1[2], x1[3]); w2.x = pk2(x2[0], x2[1]); w2.y = pk2(x2[2], x2[3]);
                        bf16_t* dst = (bj == 0 ? Kp : Vp) + (size_t)r * 128 + wc * 32 + 4 * fq;
                        *(u32x2*)dst = w1; *(u32x2*)(dst + 16) = w2;
                    }
                }
        }
    }
};
struct EpiInProj {
    static constexpr bool PERM = true;
    bf16_t* QH; _Float16* KF; _Float16* KB; bf16_t* IV; bf16_t* SG; const float* lb;
    __device__ __forceinline__ void operator()(const f32x4 (&acc)[2][2][4][2], const Unit& u, int wr, int wc, int fr, int fq) const {
        const int seg = u.pn >> 2; const bool lat = u.pm > 0;
        if (!lat && (seg == 0 || seg == 4)) return;
        typedef _Float16 h8_t __attribute__((ext_vector_type(8)));
#pragma unroll
        for (int bj = 0; bj < 2; ++bj) {
            const int col = (u.pn & 3) * BM + bj * HALF + wc * 32 + 8 * fq;
            if (!((u.bmask >> bj) & 1)) continue;
            f32x4 lb0 = (f32x4){0.f, 0.f, 0.f, 0.f}, lb1 = lb0;
            if (seg == 1) { lb0 = *(const f32x4*)(lb + col); lb1 = *(const f32x4*)(lb + col + 4); } else if (seg == 2) { lb0 = *(const f32x4*)(lb + 1024 + col); lb1 = *(const f32x4*)(lb + 1024 + col + 4); }
#pragma unroll
            for (int ai = 0; ai < 2; ++ai)
#pragma unroll
                for (int m = 0; m < 4; ++m) {
                    if (!((u.amask >> ai) & 1)) continue;
                    const int r = u.pm * BM + ai * HALF + wr * 64 + m * 16 + fr; const f32x4 v0 = acc[ai][bj][m][0], v1 = acc[ai][bj][m][1];
                    if (seg == 1 || seg == 2) {
                        h8_t hv;
#pragma unroll
                        for (int e = 0; e < 4; ++e) { hv[e] = (_Float16)((1.f - lb0[e]) / (1.f + __expf(v0[e]))); hv[4 + e] = (_Float16)((1.f - lb1[e]) / (1.f + __expf(v1[e]))); }
                        *(h8_t*)((seg == 1 ? KF : KB) + (size_t)r * 1024 + col) = hv;
                    } else if (seg == 3) {
                        u32x4 o; o.x = pk2(v0[0], v0[1]); o.y = pk2(v0[2], v0[3]); o.z = pk2(v1[0], v1[1]); o.w = pk2(v1[2], v1[3]); *(u32x4*)(IV + (size_t)r * 1024 + col) = o;
                    } else {
                        float s0[4], s1[4];
#pragma unroll
                        for (int e = 0; e < 4; ++e) { s0[e] = v0[e] / (1.f + __expf(-v0[e])); s1[e] = v1[e] / (1.f + __expf(-v1[e])); }
                        u32x4 o; o.x = pk2(s0[0], s0[1]); o.y = pk2(s0[2], s0[3]); o.z = pk2(s1[0], s1[1]); o.w = pk2(s1[2], s1[3]); *(u32x4*)((seg == 0 ? QH : SG) + (size_t)(r - C) * 1024 + col) = o;
                    }
                }
        }
    }
};

typedef int v8i __attribute__((ext_vector_type(8)));
template <class Epi, class Sched, bool ALIGN_EPI, bool GATHER, bool FP8>
__device__ __forceinline__ void gemm_phase(LAS unsigned char* lds, const Gemm g, const Sched& S, const Epi& E, const int tid) {
    const int wid = __builtin_amdgcn_readfirstlane(tid >> 6), lane = tid & 63, wr = wid >> 2, wc = wid & 3, fr = lane & 15, fq = lane >> 4;
    constexpr int KB = FP8 ? 1024 : 2048, nt = 1024 / (FP8 ? 128 : 64);
    int sR[2], sC[2]; unsigned voffB[2], voffA[2];
#pragma unroll
    for (int i = 0; i < 2; ++i) { stage_rc(tid * 16 + i * 8192, sR[i], sC[i]); const int Rb = Epi::PERM ? ((sR[i] & ~31) + perm32(sR[i] & 31)) : sR[i]; voffB[i] = (unsigned)(Rb * KB + sC[i] * 2); voffA[i] = (unsigned)(sR[i] * KB + sC[i] * 2); }
    constexpr size_t kstep = (size_t)(BK * 2), hstep = (size_t)HALF * KB, tstep = 2 * hstep;
    const unsigned ldsw = (unsigned)wid * 1024u;
    const int fc = FP8 ? (32 * (fq >> 1) + 16 * (fq & 1)) : fq * 8;
    const int aoff = lds_byte(wr * 64 + fr, fc), boff = lds_byte(wc * 32 + fr, fc);
    const char* Ab = (const char*)g.A;
#define PG8_SA(b, h) (((b) * 2 + (h)) * HTB)
#define PG8_SB(b, h) ((4 + (b) * 2 + (h)) * HTB)
#define PG8_STAGE_B(bufoff, gbase) do { _Pragma("unroll") for (int _i = 0; _i < 2; ++_i) \
        __builtin_amdgcn_global_load_lds((const unsigned*)((const char*)(gbase) + voffB[_i]), (LAS unsigned*)(lds + (bufoff) + ldsw + _i * 8192), 16, 0, 0); } while (0)
#define PG8_STAGE_A(bufoff, kb, v, ubase) do { _Pragma("unroll") for (int _i = 0; _i < 2; ++_i) \
        __builtin_amdgcn_global_load_lds((const unsigned*)((GATHER ? Ab : (ubase)) + (size_t)(kb) + (GATHER ? (v)[_i] : voffA[_i])), (LAS unsigned*)(lds + (bufoff) + ldsw + _i * 8192), 16, 0, 0); } while (0)
#define PG8_LDA(dst, b, h) do { if constexpr (FP8) { _Pragma("unroll") for (int m = 0; m < 4; ++m) dst##8[m] = *(const LAS v8i*)(lds + PG8_SA(b, h) + aoff + m * 2048); } else { _Pragma("unroll") for (int m = 0; m < 4; ++m) _Pragma("unroll") for (int k = 0; k < 2; ++k) dst[m][k] = *(const LAS bf16x8*)(lds + PG8_SA(b, h) + aoff + m * 2048 + k * 1024); } } while (0)
#define PG8_LDB(dst, b, h) do { if constexpr (FP8) { _Pragma("unroll") for (int n = 0; n < 2; ++n) dst##8[n] = *(const LAS v8i*)(lds + PG8_SB(b, h) + boff + n * 2048); } else { _Pragma("unroll") for (int n = 0; n < 2; ++n) _Pragma("unroll") for (int k = 0; k < 2; ++k) dst[n][k] = *(const LAS bf16x8*)(lds + PG8_SB(b, h) + boff + n * 2048 + k * 1024); } } while (0)
#define PG8_MMA(ai, bj, At, Bt) do { __builtin_amdgcn_s_setprio(1); if constexpr (FP8) { _Pragma("unroll") for (int m = 0; m < 4; ++m) _Pragma("unroll") for (int n = 0; n < 2; ++n) \
        asm volatile("v_mfma_scale_f32_16x16x128_f8f6f4 %0, %1, %2, %0, %3, %3 op_sel_hi:[0,0,0]" : "+v"(acc[ai][bj][m][n]) : "v"(Bt##8[n]), "v"(At##8[m]), "v"(unit_scale)); } else { \
        _Pragma("unroll") for (int m = 0; m < 4; ++m) _Pragma("unroll") for (int n = 0; n < 2; ++n) _Pragma("unroll") for (int k = 0; k < 2; ++k) \
        acc[ai][bj][m][n] = __builtin_amdgcn_mfma_f32_16x16x32_bf16(Bt[n][k], At[m][k], acc[ai][bj][m][n], 0, 0, 0); } __builtin_amdgcn_s_setprio(0); } while (0)
#define PG8_WAIT_V(n) asm volatile("s_waitcnt vmcnt(" #n ")" ::: "memory")
#define PG8_WAIT_L(n) asm volatile("s_waitcnt lgkmcnt(" #n ")" ::: "memory")
#define PG8_BAR __builtin_amdgcn_s_barrier()
#define PG8_SCHED __builtin_amdgcn_sched_barrier(0)
    Unit cur, nxt; int ui = 0;
    if (!S.next(0, cur)) return;
    unsigned cv[2][2], nv[2][2];
    if constexpr (GATHER) a_offsets<KB>(g, cur, sR, sC, cv);
    const char* cA = Ab + (size_t)cur.pm * tstep; const char* nA = cA;
    f32x4 acc[2][2][4][2];
#pragma unroll
    for (int a = 0; a < 2; ++a)
#pragma unroll
        for (int b = 0; b < 2; ++b)
#pragma unroll
            for (int m = 0; m < 4; ++m)
#pragma unroll
                for (int n = 0; n < 2; ++n) acc[a][b][m][n] = (f32x4){0.f, 0.f, 0.f, 0.f};
    bf16x8 At[4][2], B0[2][2], B1[2][2]; v8i At8[4], B08[2], B18[2];
    int unit_scale = 0x7f7f7f7f; asm volatile("" : "+v"(unit_scale));
    const char* cB = (const char*)g.Bt + (size_t)cur.e * g.bstride + (size_t)cur.pn * tstep;
    PG8_STAGE_B(PG8_SB(0, 0), cB); PG8_STAGE_B(PG8_SB(0, 1), cB + hstep); PG8_STAGE_A(PG8_SA(0, 0), 0, cv[0], cA); PG8_STAGE_A(PG8_SA(0, 1), 0, cv[1], cA + hstep);
    if (wr == 1) PG8_BAR;
    PG8_WAIT_V(2); PG8_BAR;
    PG8_STAGE_B(PG8_SB(1, 0), cB + kstep); PG8_STAGE_A(PG8_SA(1, 0), kstep, cv[0], cA); PG8_STAGE_B(PG8_SB(1, 1), cB + hstep + kstep);
    PG8_WAIT_V(6); PG8_BAR;
    for (;;) {
        const bool has_next = S.next(ui + 1, nxt);
        const char* nB = cB;
        nA = cA;
        if (has_next) { if constexpr (GATHER) a_offsets<KB>(g, nxt, sR, sC, nv); nA = Ab + (size_t)nxt.pm * tstep; nB = (const char*)g.Bt + (size_t)nxt.e * g.bstride + (size_t)nxt.pn * tstep; }
        else if constexpr (GATHER) {
#pragma unroll
            for (int h = 0; h < 2; ++h)
#pragma unroll
                for (int i = 0; i < 2; ++i) nv[h][i] = cv[h][i];
        }
        const int ntr = (PROBE_SHORTK && !cur.real) ? 2 : nt;
        const bool m00 = (cur.amask & 1) && (cur.bmask & 1), m01 = (cur.amask & 1) && (cur.bmask & 2), m10 = (cur.amask & 2) && (cur.bmask & 1), m11 = (cur.amask & 2) && (cur.bmask & 2);
#pragma nounroll
        for (int t = 0; t < ntr; t += 2) {
            const bool last = (t == ntr - 2);
            const size_t k1 = (size_t)(t + 1) * kstep, k2 = last ? 0 : (size_t)(t + 2) * kstep, k3 = k2 + kstep;
            const char* b2 = last ? nB : cB + (size_t)(t + 2) * kstep; const char* b3 = b2 + kstep;
            unsigned w0[2], w1[2];
            if constexpr (GATHER) {
#pragma unroll
                for (int i = 0; i < 2; ++i) { w0[i] = last ? nv[0][i] : cv[0][i]; w1[i] = last ? nv[1][i] : cv[1][i]; }
            }
            const char* a2 = last ? nA : cA;
            PG8_LDB(B0, 0, 0); PG8_LDB(B1, 0, 1); PG8_SCHED; PG8_LDA(At, 0, 0); PG8_STAGE_A(PG8_SA(1, 1), k1, cv[1], cA + hstep);
            PG8_WAIT_V(8); PG8_WAIT_L(0); PG8_BAR; if (m00) PG8_MMA(0, 0, At, B0); if (m01) PG8_MMA(0, 1, At, B1); PG8_BAR; PG8_SCHED;
            PG8_LDA(At, 0, 1); PG8_STAGE_B(PG8_SB(0, 0), b2); PG8_STAGE_B(PG8_SB(0, 1), b2 + hstep); PG8_STAGE_A(PG8_SA(0, 0), k2, w0, a2);
            PG8_WAIT_V(8); PG8_WAIT_L(0); PG8_BAR; if (m10) PG8_MMA(1, 0, At, B0); if (m11) PG8_MMA(1, 1, At, B1); PG8_BAR; PG8_SCHED;
            PG8_LDB(B0, 1, 0); PG8_LDB(B1, 1, 1); PG8_SCHED; PG8_LDA(At, 1, 0); PG8_STAGE_A(PG8_SA(0, 1), k2, w1, a2 + hstep);
            PG8_WAIT_V(8); PG8_WAIT_L(0); PG8_BAR; if (m00) PG8_MMA(0, 0, At, B0); if (m01) PG8_MMA(0, 1, At, B1); PG8_BAR; PG8_SCHED;
            PG8_LDA(At, 1, 1); PG8_STAGE_B(PG8_SB(1, 0), b3); PG8_STAGE_B(PG8_SB(1, 1), b3 + hstep); PG8_STAGE_A(PG8_SA(1, 0), k3, w0, a2);
            PG8_WAIT_V(8); PG8_WAIT_L(0); PG8_BAR; if (m10) PG8_MMA(1, 0, At, B0); if (m11) PG8_MMA(1, 1, At, B1); PG8_BAR; PG8_SCHED;
        }
        if constexpr (ALIGN_EPI) { if (wr == 0) PG8_BAR; }
        if constexpr (FP8) asm volatile("s_nop 15\n\ts_nop 15" ::: "memory");
        if (!PROBE_NOEPI || cur.real) E(acc, cur, wr, wc, fr, fq);
        if (!has_next) break;
#pragma unroll
        for (int a = 0; a < 2; ++a)
#pragma unroll
            for (int b = 0; b < 2; ++b)
#pragma unroll
                for (int m = 0; m < 4; ++m)
#pragma unroll
                    for (int n = 0; n < 2; ++n) acc[a][b][m][n] = (f32x4){0.f, 0.f, 0.f, 0.f};
        cur = nxt; cB = nB; cA = nA; ++ui;
        if constexpr (GATHER) {
#pragma unroll
            for (int h = 0; h < 2; ++h)
#pragma unroll
                for (int i = 0; i < 2; ++i) cv[h][i] = nv[h][i];
        }
        if constexpr (ALIGN_EPI) { if (wr == 1) PG8_BAR; }
    }
    PG8_WAIT_V(0);
    if constexpr (!ALIGN_EPI) { if (wr == 0) PG8_BAR; }
    PG8_BAR;
#undef PG8_SA
#undef PG8_SB
#undef PG8_STAGE_A
#undef PG8_STAGE_B
#undef PG8_LDA
#undef PG8_LDB
#undef PG8_MMA
#undef PG8_WAIT_V
#undef PG8_WAIT_L
#undef PG8_BAR
#undef PG8_SCHED
}
}

struct TBlk { const float* src; int ldw; bf16_t* dst; unsigned char* dst8; };
__device__ __forceinline__ void tb_load(const TBlk& t, int lane, f32x4 (&v)[16]) {
    const float* p = t.src + (size_t)(lane >> 4) * t.ldw + (lane & 15) * 4;
#pragma unroll
    for (int i = 0; i < 16; ++i) v[i] = *(const f32x4*)(p + (size_t)(4 * i) * t.ldw);
}
__device__ __forceinline__ void tb_store(const TBlk& t, int lane, const f32x4 (&v)[16], LAS float* scr) {
#pragma unroll
    for (int i = 0; i < 16; ++i) { LAS float* d = scr + ((lane >> 4) + 4 * i) * 65 + (lane & 15) * 4; d[0] = v[i].x; d[1] = v[i].y; d[2] = v[i].z; d[3] = v[i].w; }
    asm volatile("s_waitcnt lgkmcnt(0)" ::: "memory"); __builtin_amdgcn_wave_barrier();
    const int c8 = lane & 7;
#pragma unroll
    for (int jj = 0; jj < 8; ++jj) {
        const int n = (lane >> 3) + 8 * jj; const LAS float* p = scr + (8 * c8) * 65 + n;
        if (t.dst8) { u32x2 o; o.x = pk4_fp8(p[0] * F8_SW, p[65] * F8_SW, p[2 * 65] * F8_SW, p[3 * 65] * F8_SW); o.y = pk4_fp8(p[4 * 65] * F8_SW, p[5 * 65] * F8_SW, p[6 * 65] * F8_SW, p[7 * 65] * F8_SW);
            *(u32x2*)(t.dst8 + (size_t)n * 1024 + 8 * c8) = o; }
        else { u32x4 o; o.x = pk2(p[0], p[65]); o.y = pk2(p[2 * 65], p[3 * 65]); o.z = pk2(p[4 * 65], p[5 * 65]); o.w = pk2(p[6 * 65], p[7 * 65]);
            *(u32x4*)(t.dst + (size_t)n * 1024 + 8 * c8) = o; }
    }
    asm volatile("s_waitcnt lgkmcnt(0)" ::: "memory"); __builtin_amdgcn_wave_barrier();
}

__device__ __forceinline__ void phase_prep(const Ctx& c) {
    LAS float* red = (LAS float*)c.lds;
    const float* cv = c.a->in[1]; const float* ccv = c.a->in[3]; const float* ada_w = c.a->in[4]; const float* ada_b = c.a->in[5];
    for (int item = c.wg; item < 193; item += c.nwg) {
        if (item < 192) {
            const int layer = item / 96, cb = item % 96, col = cb * 64 + c.lane;
            const float* W = ada_w + (size_t)layer * D * 6144 + col;
            float a0 = 0.f, a1 = 0.f;
            const int k0 = c.wave * 128;
#pragma unroll 32
            for (int k = 0; k < 128; ++k) { const float w = W[(size_t)(k0 + k) * 6144]; a0 += silu_f(cv[k0 + k]) * w; a1 += silu_f(ccv[k0 + k]) * w; }
            red[(0 * 8 + c.wave) * 64 + c.lane] = a0; red[(1 * 8 + c.wave) * 64 + c.lane] = a1;
            __syncthreads();
            if (c.tid < 128) {
                const int which = c.tid >> 6, l = c.tid & 63; float s = 0.f;
#pragma unroll
                for (int w = 0; w < 8; ++w) s += red[(which * 8 + w) * 64 + l];
                c.modp(layer, which)[cb * 64 + l] = s + ada_b[layer * 6144 + cb * 64 + l];
            }
            __syncthreads();
        } else {
            float* modbase = (float*)(c.ws + WS_MOD);
            for (int i = c.tid; i < 4096; i += 512) {
                const int pos = i >> 4, j = i & 15;
                const double ang = (double)pos * pow(10000.0, -(double)j / 16.0);
                modbase[MOD_ROPE + 2 * i] = (float)cos(ang); modbase[MOD_ROPE + 2 * i + 1] = (float)sin(ang);
            }
            const float* lbp = c.a->in[12];
            for (int i = c.tid; i < 2048; i += 512) { const float p0 = lbp[i], p1 = lbp[2048 + i]; modbase[MOD_LB + i] = 1.f / (1.f + __expf(p0 - p1)); }
        }
    }
}

__device__ __forceinline__ void row_load(const float* p, int lane, f32x4 (&v)[4]) {
#pragma unroll
    for (int j = 0; j < 4; ++j) v[j] = *(const f32x4*)(p + lane * 4 + 256 * j);
}
__device__ __forceinline__ float row_ss(const f32x4 (&v)[4]) {
    float s = 0.f;
#pragma unroll
    for (int j = 0; j < 4; ++j) s += v[j].x * v[j].x + v[j].y * v[j].y + v[j].z * v[j].z + v[j].w * v[j].w;
    return wave_sum(s);
}
__device__ __forceinline__ void row_modnorm_store(const f32x4 (&x)[4], float rstd, const float* g, const float* sh, const float* sc, bf16_t* out, int lane, f32x4 (*hout)[4] = nullptr) {
#pragma unroll
    for (int j = 0; j < 4; ++j) {
        const int c0 = lane * 4 + 256 * j;
        const f32x4 gv = *(const f32x4*)(g + c0), shv = *(const f32x4*)(sh + c0), scv = *(const f32x4*)(sc + c0);
        f32x4 h;
        h.x = x[j].x * rstd * gv.x * (1.f + scv.x) + shv.x; h.y = x[j].y * rstd * gv.y * (1.f + scv.y) + shv.y;
        h.z = x[j].z * rstd * gv.z * (1.f + scv.z) + shv.z; h.w = x[j].w * rstd * gv.w * (1.f + scv.w) + shv.w;
        if (hout) (*hout)[j] = h;
        u32x2 o; o.x = pk2(h.x, h.y); o.y = pk2(h.z, h.w);
        *(u32x2*)(out + c0) = o;
    }
}

__device__ __forceinline__ void phase_norm0(const Ctx& c) {
    bf16_t* H = (bf16_t*)(c.ws + WS_H); const float* ng = c.a->in[6];
    int r = c.wg * 8 + c.wave;
    f32x4 xn[4];
    if (r < R) row_load(c.xin0(r), c.lane, xn);
    for (; r < R; r += c.nwg * 8) {
        f32x4 x[4];
#pragma unroll
        for (int j = 0; j < 4; ++j) x[j] = xn[j];
        if (r + c.nwg * 8 < R) row_load(c.xin0(r + c.nwg * 8), c.lane, xn);
        const float rstd = rsqrtf(row_ss(x) * (1.f / D) + EPS);
        const float* m = c.modp(0, r < C ? 1 : 0);
        row_modnorm_store(x, rstd, ng, m + 0, m + 1024, H + (size_t)r * D, c.lane);
    }
}

namespace at {
constexpr int KP = 144, TILEB = 64 * KP;
__device__ __forceinline__ bf16x8 tr_frag2(const LAS unsigned char* tile, int row0, int col0, int lane) {
    const int q = (lane & 15) >> 2, p = lane & 3;
    const LAS unsigned char* a = tile + (row0 + q) * KP + (col0 + 4 * p) * 2;
    const v4i16_t lo = __builtin_amdgcn_ds_read_tr16_b64_v4i16((LAS v4i16_t*)a);
    const v4i16_t hi = __builtin_amdgcn_ds_read_tr16_b64_v4i16((LAS v4i16_t*)(a + 16 * KP));
    return (bf16x8){lo[0], lo[1], lo[2], lo[3], hi[0], hi[1], hi[2], hi[3]};
}
}
__device__ __forceinline__ void phase_attn(const Ctx& c) {
    using namespace at;
    const bf16_t* Q = (const bf16_t*)(c.ws + WS_Q); const bf16_t* K = (const bf16_t*)(c.ws + WS_K); const bf16_t* V = (const bf16_t*)(c.ws + WS_V);
    bf16_t* O = (bf16_t*)(c.ws + WS_O); const float* sink = c.a->in[9];
    LAS unsigned char* lds = c.lds;
    const int tid = c.tid, lane = c.lane, w = __builtin_amdgcn_readfirstlane(tid >> 6), fr = lane & 15, g = lane >> 4;
    const int lrow = tid >> 3, lch = tid & 7;
    for (int item = c.wg; item < 264; item += c.nwg) {
        const bool isctx = item >= 256;
        const int ci = item - 256;
        const int n = isctx ? 0 : (item >> 1), kh = isctx ? ((ci >> 1) & 1) : (item & 1), cb = isctx ? (ci >> 2) : 0;
        const int p_lo = isctx ? (ci & 1) : 0, p_hi = isctx ? (ci & 1) + 1 : 2;
        const int hq = kh * 8 + w;
        const float sink2 = sink[hq] * LOG2E;
        for (int pass = p_lo; pass < p_hi; ++pass) {
            const int t0 = 128 * n + 64 * pass, qrow0 = isctx ? cb * 128 + 64 * pass : C + t0;
            const int jlo = isctx ? 0 : (t0 >= 128 ? 0 : (128 - t0) / 64), jhi = isctx ? 0 : ((L - t0 + 128) / 64 < 5 ? (L - t0 + 128) / 64 : 5);
            const int ntile = 4 + (jhi - jlo);
            LAS unsigned char* qlds = lds + 4 * TILEB + w * TILEB;
#pragma unroll
            for (int qb = 0; qb < 4; ++qb)
#pragma unroll
                for (int ks = 0; ks < 2; ++ks) *(LAS bf16x8*)(qlds + (16 * qb + fr) * KP + (32 * ks + 8 * g) * 2) = *(const bf16x8*)(Q + (size_t)(qrow0 + 16 * qb + fr) * D + hq * 64 + 32 * ks + 8 * g);
            float mrow[4], lsum[4]; f32x4 OT[4][4];
#pragma unroll
            for (int qb = 0; qb < 4; ++qb) { mrow[qb] = sink2; lsum[qb] = 1.f;
#pragma unroll
                for (int nt = 0; nt < 4; ++nt) OT[qb][nt] = (f32x4){0.f, 0.f, 0.f, 0.f}; }
            u32x4 kreg, vreg;
#define AT_KROW(ti) ((ti) < 4 ? 64 * (ti) : C + t0 - 128 + 64 * (jlo + (ti) - 4))
#define AT_LOAD(ti) do { const size_t ro_ = (size_t)(AT_KROW(ti) + lrow) * 128 + kh * 64 + lch * 8; kreg = *(const u32x4*)(K + ro_); vreg = *(const u32x4*)(V + ro_); } while (0)
#define AT_WRITE(buf) do { *(LAS u32x4*)(lds + (buf) * 2 * TILEB + lrow * KP + lch * 16) = kreg; *(LAS u32x4*)(lds + (buf) * 2 * TILEB + TILEB + lrow * KP + lch * 16) = vreg; } while (0)
            AT_LOAD(0); AT_WRITE(0);
            __syncthreads();
            for (int ti = 0; ti < ntile; ++ti) {
                if (ti + 1 < ntile) AT_LOAD(ti + 1);
                const LAS unsigned char* kb = lds + (ti & 1) * 2 * TILEB; const LAS unsigned char* vb = kb + TILEB;
                const int jj = jlo + ti - 4; const bool masked = (ti >= 4) && (jj == 0 || jj == 4);
                const int k0 = t0 - 128 + 64 * jj;
                bf16x8 Kf[4][2];
#pragma unroll
                for (int mt = 0; mt < 4; ++mt)
#pragma unroll
                    for (int ks = 0; ks < 2; ++ks) Kf[mt][ks] = *(const LAS bf16x8*)(kb + (16 * mt + fr) * KP + (32 * ks + 8 * g) * 2);
#pragma unroll
                for (int qb = 0; qb < 4; ++qb) {
                    asm volatile("" ::: "memory");
                    bf16x8 Vf[4][2];
#pragma unroll
                    for (int mt = 0; mt < 4; ++mt)
#pragma unroll
                        for (int ks = 0; ks < 2; ++ks)
                            Vf[mt][ks] = tr_frag2(vb, 32 * ks + 4 * g, 16 * mt, lane);
                    bf16x8 Qq[2];
#pragma unroll
                    for (int ks = 0; ks < 2; ++ks) Qq[ks] = *(const LAS bf16x8*)(qlds + (16 * qb + fr) * KP + (32 * ks + 8 * g) * 2);
                    f32x4 sa[4];
#pragma unroll
                    for (int mt = 0; mt < 4; ++mt) { sa[mt] = (f32x4){0.f, 0.f, 0.f, 0.f};
#pragma unroll
                        for (int ks = 0; ks < 2; ++ks) sa[mt] = __builtin_amdgcn_mfma_f32_16x16x32_bf16(Kf[mt][ks], Qq[ks], sa[mt], 0, 0, 0); }
                    if (masked) {
                        const int tq = t0 + 16 * qb + fr;
#pragma unroll
                        for (int mt = 0; mt < 4; ++mt)
#pragma unroll
                            for (int e = 0; e < 4; ++e) { const int dt = tq - (k0 + 16 * mt + 4 * g + e); if (dt > 128 || dt < -128) sa[mt][e] = -INFINITY; }
                    }
                    float mx = fmaxf(fmaxf(sa[0][0], sa[0][1]), fmaxf(sa[0][2], sa[0][3]));
#pragma unroll
                    for (int mt = 1; mt < 4; ++mt) mx = fmaxf(mx, fmaxf(fmaxf(sa[mt][0], sa[mt][1]), fmaxf(sa[mt][2], sa[mt][3])));
                    mx = fmaxf(mx, __shfl_xor(mx, 16)); mx = fmaxf(mx, __shfl_xor(mx, 32));
                    const float mn = fmaxf(mrow[qb], mx), alpha = __builtin_amdgcn_exp2f(mrow[qb] - mn);
                    mrow[qb] = mn;
                    float rs = 0.f;
#pragma unroll
                    for (int mt = 0; mt < 4; ++mt)
#pragma unroll
                        for (int e = 0; e < 4; ++e) { const float pv = __builtin_amdgcn_exp2f(sa[mt][e] - mn); sa[mt][e] = pv; rs += pv; }
                    rs += __shfl_xor(rs, 16); rs += __shfl_xor(rs, 32);
                    lsum[qb] = lsum[qb] * alpha + rs;
                    bf16x8 Pb[2];
#pragma unroll
                    for (int ks = 0; ks < 2; ++ks) { const f32x4 a0 = sa[2 * ks], a1 = sa[2 * ks + 1];
                        const u32x4 pk = (u32x4){pk2(a0[0], a0[1]), pk2(a0[2], a0[3]), pk2(a1[0], a1[1]), pk2(a1[2], a1[3])}; Pb[ks] = __builtin_bit_cast(bf16x8, pk); }
#pragma unroll
                    for (int nt = 0; nt < 4; ++nt) { OT[qb][nt] = OT[qb][nt] * alpha;
#pragma unroll
                        for (int ks = 0; ks < 2; ++ks) OT[qb][nt] = __builtin_amdgcn_mfma_f32_16x16x32_bf16(Vf[nt][ks], Pb[ks], OT[qb][nt], 0, 0, 0); }
                }
                if (ti + 1 < ntile) AT_WRITE((ti + 1) & 1);
                __syncthreads();
            }
#undef AT_KROW
#undef AT_LOAD
#undef AT_WRITE
#pragma unroll
            for (int qb = 0; qb < 4; ++qb) {
                const float il = 1.f / lsum[qb];
                bf16_t* op = O + (size_t)(qrow0 + 16 * qb + fr) * D + hq * 64 + 4 * g;
#pragma unroll
                for (int nt = 0; nt < 4; ++nt) { const f32x4 v = OT[qb][nt] * il; u32x2 o; o.x = pk2(v[0], v[1]); o.y = pk2(v[2], v[3]); *(u32x2*)(op + 16 * nt) = o; }
            }
        }
    }
}

template <int GS>
__device__ __forceinline__ void phase_postmix(const Ctx& c, int layer, bool route) {
    const float* Y = (const float*)(c.ws + WS_RAW1); unsigned char* H8 = c.ws + WS_H8;
    float* Xout = (float*)(c.ws + (layer == 0 ? WS_X : WS_X1)); const float* Xprev = (const float*)(c.ws + WS_X);
    const float* ng = c.a->in[6] + layer * 4 * D; const float* Wr = c.a->in[15] + (size_t)layer * D * NE; const float* br = c.a->in[16] + layer * NE;
    unsigned* cnt = (unsigned*)(c.ws + WS_CTL) + CW_CNT + layer * NE;
    int* tk_e = (int*)(c.ws + WS_TK); float* tk_g = (float*)(c.ws + WS_TK) + R * 4; int* tk_slot = (int*)(c.ws + WS_TK) + 2 * R * 4;
    int* list = (int*)(c.ws + WS_LIST);
    LAS float* WL = (LAS float*)c.lds;
    LAS float* biasp = (LAS float*)(c.lds + 131072);
    LAS unsigned* lcnt = (LAS unsigned*)(c.lds + 145920); LAS unsigned* lbase = lcnt + 32; LAS float* rsx = (LAS float*)(lcnt + 64);
    LAS float* pvA = (LAS float*)(c.lds + 131072 + 2560); LAS float* pvB = pvA + 1024; LAS float* pvS = pvB + 1024;
    const int lane = c.lane, w = __builtin_amdgcn_readfirstlane(c.tid >> 6), fr = lane & 15, g = lane >> 4;
    constexpr int RP = GS / 8, NW2 = GS / 16;
    const int g_lo = layer == 0 ? 0 : C / GS;
    for (int grp = g_lo + c.wg; grp < R / GS; grp += c.nwg) {
        const int which = grp * GS < C ? 1 : 0;
        const float* m = c.modp(layer, which);
        __syncthreads();
        if (c.tid < NE) lcnt[c.tid] = 0u;
#pragma unroll 4
        for (int j = 0; j < 16; ++j) {
            const int i4 = c.tid + 512 * j, k = i4 >> 3, e0 = (i4 & 7) * 4;
            const f32x4 wv = *(const f32x4*)(Wr + (size_t)k * NE + e0); const float sc = ng[2 * D + k] * (1.f + m[4096 + k]);
            LAS float* dst = WL + ((((k >> 4) * 4 + (k & 3)) * 4 + ((k >> 2) & 3)) * 16) * 2;
#pragma unroll
            for (int q = 0; q < 4; ++q) { const int e = e0 + q; dst[(e & 15) * 2 + (e >> 4)] = wv[q] * sc; }
        }
        for (int k = c.tid; k < D; k += 512) { pvA[k] = m[2048 + k] * ng[D + k]; pvB[k] = ng[2 * D + k] * (1.f + m[4096 + k]); pvS[k] = m[3072 + k]; }
        { const int e = c.tid & 31, part = c.tid >> 5; float sacc = 0.f;
#pragma unroll 16
          for (int k = part * 64; k < part * 64 + 64; ++k) sacc += m[3072 + k] * Wr[k * NE + e];
          biasp[32 + part * 32 + e] = sacc; }
        __syncthreads();
        if (c.tid < 32) { float sacc = br[c.tid];
#pragma unroll
            for (int p = 0; p < 16; ++p) sacc += biasp[32 + p * 32 + c.tid]; biasp[c.tid] = sacc; }
        __syncthreads();
        const int row1 = grp * GS + w * RP;
        f32x4 yn[4], xn[4];
        row_load(Y + (size_t)(layer == 0 ? row1 : row1 - C) * D, lane, yn); row_load(layer == 0 ? c.xin0(row1) : Xprev + (size_t)row1 * D, lane, xn);
        for (int i = 0; i < RP; ++i) {
            const int r = row1 + i;
            f32x4 y[4], x[4];
#pragma unroll
            for (int j = 0; j < 4; ++j) { y[j] = yn[j]; x[j] = xn[j]; }
            if (i + 1 < RP) { row_load(Y + (size_t)(layer == 0 ? r + 1 : r + 1 - C) * D, lane, yn); row_load(layer == 0 ? c.xin0(r + 1) : Xprev + (size_t)(r + 1) * D, lane, xn); }
            const float rstd_y = rsqrtf(row_ss(y) * (1.f / D) + EPS);
#pragma unroll
            for (int j = 0; j < 4; ++j) {
                const int c0 = lane * 4 + 256 * j;
                x[j] += *(const LAS f32x4*)(pvA + c0) * (y[j] * rstd_y);
                *(f32x4*)(Xout + (size_t)r * D + c0) = x[j];
            }
            const float rstd_x = rsqrtf(row_ss(x) * (1.f / D) + EPS);
#pragma unroll
            for (int j = 0; j < 4; ++j) {
                const int c0 = lane * 4 + 256 * j;
                const f32x4 hv = x[j] * rstd_x * *(const LAS f32x4*)(pvB + c0) + *(const LAS f32x4*)(pvS + c0);
                *(unsigned*)(H8 + (size_t)r * D + c0) = pk4_fp8(hv[0] * F8_SH, hv[1] * F8_SH, hv[2] * F8_SH, hv[3] * F8_SH);
            }
            if (lane == 0) rsx[w * RP + i] = rstd_x;
        }
        asm volatile("s_waitcnt vmcnt(0)" ::: "memory");
        __syncthreads();
        const int row0 = grp * GS + w * 16; const bool w2 = w < NW2;
        f32x4 la[2]; la[0] = (f32x4){0.f, 0.f, 0.f, 0.f}; la[1] = la[0];
        if (w2) {
            const float* ap = Xout + (size_t)(row0 + fr) * D + 4 * g;
            const LAS float* bp = WL + (g * 16 + fr) * 2;
#pragma unroll 4
            for (int k4 = 0; k4 < 64; ++k4) {
                const f32x4 a4 = *(const f32x4*)(ap + 16 * k4);
#pragma unroll
                for (int q = 0; q < 4; ++q) {
                    const f32x2 b2 = *(const LAS f32x2*)(bp + (size_t)(4 * k4 + q) * 128);
                    la[0] = __builtin_amdgcn_mfma_f32_16x16x4f32(a4[q], b2[0], la[0], 0, 0, 0);
                    la[1] = __builtin_amdgcn_mfma_f32_16x16x4f32(a4[q], b2[1], la[1], 0, 0, 0);
                }
            }
        }
        float tv[4][4]; int te[4][4];
#pragma unroll
        for (int e = 0; e < 4; ++e) {
            const float rs = rsx[(w2 ? w * 16 : 0) + 4 * g + e];
            float v0 = la[0][e] * rs + biasp[fr], v1 = la[1][e] * rs + biasp[16 + fr];
#pragma unroll
            for (int k = 0; k < 4; ++k) {
                float bv; int bi;
                if (v0 >= v1) { bv = v0; bi = fr; } else { bv = v1; bi = 16 + fr; }
#pragma unroll
                for (int o = 8; o > 0; o >>= 1) {
                    const float ov = __shfl_xor(bv, o); const int oi = __shfl_xor(bi, o);
                    if (ov > bv || (ov == bv && oi < bi)) { bv = ov; bi = oi; }
                }
                tv[e][k] = bv; te[e][k] = bi;
                if (bi == fr) v0 = -INFINITY;
                if (bi == 16 + fr) v1 = -INFINITY;
            }
        }
        float v[4]; int ex[4]; unsigned sl[4];
#pragma unroll
        for (int k = 0; k < 4; ++k) { v[k] = tv[0][k]; ex[k] = te[0][k];
#pragma unroll
            for (int e = 1; e < 4; ++e) if (fr == e) { v[k] = tv[e][k]; ex[k] = te[e][k]; } }
        if (fr < 4 && route && w2) {
#pragma unroll
            for (int k = 0; k < 4; ++k) sl[k] = __hip_atomic_fetch_add(lcnt + ex[k], 1u, __ATOMIC_RELAXED, __HIP_MEMORY_SCOPE_WORKGROUP);
        }
        __syncthreads();
        if (c.tid < NE && route) { const unsigned n = lcnt[c.tid]; lbase[c.tid] = n ? atomicAdd(&cnt[c.tid], n) : 0u; }
        __syncthreads();
        if (fr < 4 && route && w2) {
            const int r = row0 + 4 * g + fr;
            const float e1 = __expf(v[1] - v[0]), e2 = __expf(v[2] - v[0]), e3 = __expf(v[3] - v[0]);
            const float inv = 1.f / (1.f + e1 + e2 + e3);
            const float gk[4] = {inv, e1 * inv, e2 * inv, e3 * inv};
#pragma unroll
            for (int k = 0; k < 4; ++k) {
                const unsigned slot = lbase[ex[k]] + sl[k];
                list[(size_t)ex[k] * R + slot] = r;
                tk_e[r * 4 + k] = ex[k]; tk_g[r * 4 + k] = gk[k]; tk_slot[r * 4 + k] = (int)slot;
            }
        }
    }
}

__device__ __forceinline__ void moe_offsets(const Ctx& c, int layer, LAS int* so) {
    const unsigned* cnt = (const unsigned*)(c.ws + WS_CTL) + CW_CNT + layer * NE;
    __syncthreads();
    if (c.tid < 64) {
        const int n = c.tid < NE ? (int)cnt[c.tid] : 0; int pad = (n + PADM - 1) / PADM * PADM, inc = pad;
#pragma unroll
        for (int o = 1; o < 32; o <<= 1) { const int t = __shfl_up(inc, o); if (c.lane >= o) inc += t; }
        if (c.tid < NE) { so[c.tid] = inc - pad; so[64 + c.tid] = n; }
        if (c.tid == NE - 1) so[32] = inc;
    }
    __syncthreads();
}

__device__ __forceinline__ void moe_tables(const Ctx& c, int layer, LAS int* tb) {
    const unsigned* cnt = (const unsigned*)(c.ws + WS_CTL) + CW_CNT + layer * NE;
    __syncthreads();
    if (c.tid < 64) {
        const int n = c.tid < NE ? (int)cnt[c.tid] : 0; int tiles = (n + PADM - 1) / PADM, inc = tiles;
#pragma unroll
        for (int o = 1; o < 32; o <<= 1) { const int t = __shfl_up(inc, o); if (c.lane >= o) inc += t; }
        if (c.tid < NE) { tb[c.tid] = inc - tiles; tb[64 + c.tid] = n; }
        if (c.tid == NE - 1) tb[32] = inc;
    }
    __syncthreads();
}
__device__ __forceinline__ int vcu_of(const Ctx& c) { return (c.nwg % 8 == 0) ? (c.wg % 8) * (c.nwg / 8) + c.wg / 8 : c.wg; }
__device__ __forceinline__ void phase_moe_gu(const Ctx& c, int layer) {
    LAS int* tb = (LAS int*)(c.lds + 131072 + 1024);
    moe_tables(c, layer, tb);
    pg8::Gemm g{c.ws + WS_H8, c.ws + WS_WGU + (size_t)layer * NE * 2048 * 1024, (size_t)2048 * 1024, (const int*)(c.ws + WS_LIST)};
    pg8::MoeOrder S{tb, tb + 64, 8, c.nwg, vcu_of(c), false};
    pg8::EpiSwiglu E{c.ws + WS_HDN, c.a->in[18] + (size_t)layer * NE * 2048};
    pg8::gemm_phase<pg8::EpiSwiglu, pg8::MoeOrder, true, true, true>(c.lds, g, S, E, c.tid);
}
__device__ __forceinline__ void phase_moe_dn(const Ctx& c, int layer) {
    LAS int* tb = (LAS int*)(c.lds + 131072 + 1024);
    moe_tables(c, layer, tb);
    pg8::Gemm g{c.ws + WS_HDN, c.ws + WS_WDN + (size_t)layer * NE * 1024 * 1024, (size_t)1024 * 1024, nullptr};
    pg8::MoeOrder S{tb, tb + 64, 4, c.nwg, vcu_of(c), true};
    pg8::EpiBf16Bias E{(bf16_t*)(c.ws + WS_OUTB), c.a->in[20] + (size_t)layer * NE * 1024, 1024, 1.f / (F8_SHD * F8_SW)};
    pg8::gemm_phase<pg8::EpiBf16Bias, pg8::MoeOrder, true, false, true>(c.lds, g, S, E, c.tid);
}
__device__ __forceinline__ void phase_gemm_f32(const Ctx& c, const bf16_t* A, int M, const bf16_t* Bt, int N, const float* bias, float* Cout) {
    pg8::Gemm g{A, Bt, 0, nullptr}; pg8::StaticOrder S; S.init(M, N, c.nwg, c.wg);
    pg8::EpiF32 E{Cout, N, bias};
    pg8::gemm_phase<pg8::EpiF32, pg8::StaticOrder, true, false, false>(c.lds, g, S, E, c.tid);
}

__device__ __forceinline__ void phase_gemm_qkv(const Ctx& c) {
    pg8::Gemm g{(const bf16_t*)(c.ws + WS_H), (const bf16_t*)(c.ws + WS_WQKV), 0, nullptr}; pg8::StaticOrder S; S.init(R, QKVD, c.nwg, c.wg);
    pg8::EpiQKV E{(bf16_t*)(c.ws + WS_Q), (bf16_t*)(c.ws + WS_K), (bf16_t*)(c.ws + WS_V), c.a->in[8], (const float*)(c.ws + WS_MOD) + MOD_ROPE};
    pg8::gemm_phase<pg8::EpiQKV, pg8::StaticOrder, true, false, false>(c.lds, g, S, E, c.tid);
}
__device__ __forceinline__ void phase_gemm_inproj(const Ctx& c) {
    pg8::Gemm g{(const bf16_t*)(c.ws + WS_H), (const bf16_t*)(c.ws + WS_WIN), 0, nullptr}; pg8::StaticOrder S; S.init(R, HIN, c.nwg, c.wg);
    pg8::EpiInProj E{(bf16_t*)(c.ws + WS_QH), (_Float16*)(c.ws + WS_KF), (_Float16*)(c.ws + WS_KB), (bf16_t*)(c.ws + WS_IV), (bf16_t*)(c.ws + WS_SG), (const float*)(c.ws + WS_MOD) + MOD_LB};
    pg8::gemm_phase<pg8::EpiInProj, pg8::StaticOrder, true, false, false>(c.lds, g, S, E, c.tid);
}

__device__ __forceinline__ void phase_norm0(const Ctx& c);
constexpr int CONV_A = 20 * 16 + 16 * 16 + 80 * 16 + 16 * 16, CONV_B = 32 * 32 * 16 + 32 * 16 * 16, CONV_CHUNK = 64;
__device__ __forceinline__ TBlk convert_item(const Ctx& c, int it, int part) {
    constexpr int I_QKV = 20 * 16, I_O = 16 * 16, I_IN = 80 * 16, I_HO = 16 * 16, I_GU = 32 * 32 * 16;
    int r = it; TBlk t; t.dst8 = nullptr; t.dst = nullptr;
    if (part == 0) {
        if (r < I_QKV) { const int nb = r % 20, kb = r / 20; t.src = c.a->in[7] + (size_t)kb * 64 * QKVD + nb * 64; t.ldw = QKVD; t.dst = (bf16_t*)(c.ws + WS_WQKV) + (size_t)nb * 64 * 1024 + kb * 64; return t; } r -= I_QKV;
        if (r < I_O) { const int nb = r % 16, kb = r / 16; t.src = c.a->in[10] + (size_t)kb * 64 * D + nb * 64; t.ldw = D; t.dst = (bf16_t*)(c.ws + WS_WO) + (size_t)nb * 64 * 1024 + kb * 64; return t; } r -= I_O;
        if (r < I_IN) { const int nb = r % 80, kb = r / 80; t.src = c.a->in[11] + (size_t)kb * 64 * HIN + nb * 64; t.ldw = HIN; t.dst = (bf16_t*)(c.ws + WS_WIN) + (size_t)nb * 64 * 1024 + kb * 64; return t; } r -= I_IN;
        if (r < I_HO) { const int nb = r % 16, kb = r / 16; t.src = c.a->in[14] + (size_t)kb * 64 * D + nb * 64; t.ldw = D; t.dst = (bf16_t*)(c.ws + WS_WHO) + (size_t)nb * 64 * 1024 + kb * 64; return t; } r -= I_HO;
    }
    const int moff = (part - 1) * 32;
    if (r < I_GU) { const int mat = moff + r / 512, rr = r % 512, nb = rr % 32, kb = rr / 32; const int n0 = ((nb & 3) >> 1) * 1024 + (nb >> 2) * 128 + (nb & 1) * 64;
        t.src = c.a->in[17] + (size_t)mat * 1024 * 2048 + (size_t)kb * 64 * 2048 + n0; t.ldw = 2048; t.dst8 = c.ws + WS_WGU + ((size_t)mat * 2048 + nb * 64) * 1024 + kb * 64; return t; } r -= I_GU;
    { const int mat = moff + r / 256, rr = r % 256, nb = rr % 16, kb = rr / 16;
        t.src = c.a->in[19] + (size_t)mat * 1024 * 1024 + (size_t)kb * 64 * 1024 + nb * 64; t.ldw = 1024; t.dst8 = c.ws + WS_WDN + ((size_t)mat * 1024 + nb * 64) * 1024 + kb * 64; }
    return t;
}
__device__ __forceinline__ void convert_run(const Ctx& c, int part, int first, int step, int end, LAS float* scr) {
    f32x4 va[16], vb[16];
    int it = first;
    TBlk ta, tbk;
    if (it < end) { ta = convert_item(c, it, part); tb_load(ta, c.lane, va); }
    for (; it < end; it += 2 * step) {
        const bool hb = it + step < end;
        if (hb) { tbk = convert_item(c, it + step, part); tb_load(tbk, c.lane, vb); }
        tb_store(ta, c.lane, va, scr);
        const bool ha = it + 2 * step < end;
        if (ha) { ta = convert_item(c, it + 2 * step, part); tb_load(ta, c.lane, va); }
        if (hb) tb_store(tbk, c.lane, vb, scr);
    }
}
__device__ __forceinline__ void convert_steal(const Ctx& c, int part) {
    LAS float* scr = (LAS float*)c.lds + c.wave * (64 * 65);
    LAS int* chp = (LAS int*)(c.lds + 8 * 64 * 65 * 4);
    unsigned* ctr = (unsigned*)(c.ws + WS_CTL) + CW_CONV + 64 * part;
    for (;;) {
        __syncthreads();
        if (c.tid == 0) *chp = (int)atomicAdd(ctr, 1u);
        __syncthreads();
        const int ch = *chp;
        if (ch >= CONV_B / CONV_CHUNK) break;
        convert_run(c, part, ch * CONV_CHUNK + c.wave, 8, (ch + 1) * CONV_CHUNK, scr);
    }
}
__device__ __forceinline__ void phase_convert(const Ctx& c) {
    LAS float* scr = (LAS float*)c.lds + c.wave * (64 * 65);
    convert_run(c, 0, c.wg * 8 + c.wave, c.nwg * 8, CONV_A, scr);
    __syncthreads();
    phase_norm0(c);
}

__device__ __forceinline__ void phase_combine(const Ctx& c, int layer) {
    LAS int* so = (LAS int*)(c.lds + 32768);
    moe_offsets(c, layer, so);
    const bf16_t* outb = (const bf16_t*)(c.ws + WS_OUTB); float* X = (float*)(c.ws + WS_X); bf16_t* H = (bf16_t*)(c.ws + WS_H);
    const float* Xin = layer == 0 ? X : (const float*)(c.ws + WS_X1);
    const float* ngl = c.a->in[6] + layer * 4 * D;
    const int* tk_e = (const int*)(c.ws + WS_TK); const float* tk_g = (const float*)(c.ws + WS_TK) + R * 4; const int* tk_slot = (const int*)(c.ws + WS_TK) + 2 * R * 4;
    const int r_lo = layer == 0 ? 0 : C, stride = c.nwg * 8;
    int r = r_lo + c.wg * 8 + c.wave;
    int pe[4], ps[4]; float pg[4]; u32x2 wn[4][4]; f32x4 xn[4]; float gn[4];
#define CB_TK(row) do { _Pragma("unroll") for (int k = 0; k < 4; ++k) { pe[k] = tk_e[(row) * 4 + k]; ps[k] = tk_slot[(row) * 4 + k]; pg[k] = tk_g[(row) * 4 + k]; } } while (0)
#define CB_DATA(row) do { _Pragma("unroll") for (int k = 0; k < 4; ++k) { const bf16_t* src_ = outb + (size_t)(so[pe[k]] + ps[k]) * 1024; gn[k] = pg[k]; \
        _Pragma("unroll") for (int j = 0; j < 4; ++j) wn[k][j] = *(const u32x2*)(src_ + c.lane * 4 + 256 * j); } row_load(Xin + (size_t)(row) * D, c.lane, xn); } while (0)
    if (r < R) { CB_TK(r); CB_DATA(r); }
    if (r + stride < R) CB_TK(r + stride);
    for (; r < R; r += stride) {
        const float* m = c.modp(layer, r < C ? 1 : 0);
        f32x4 y[4], x[4];
#pragma unroll
        for (int j = 0; j < 4; ++j) { y[j] = (f32x4){0.f, 0.f, 0.f, 0.f}; x[j] = xn[j]; }
#pragma unroll
        for (int k = 0; k < 4; ++k)
#pragma unroll
            for (int j = 0; j < 4; ++j) { const u32x2 w = wn[k][j]; y[j] += (f32x4){bflo(w.x), bfhi(w.x), bflo(w.y), bfhi(w.y)} * gn[k]; }
        if (r + stride < R) CB_DATA(r + stride);
        if (r + 2 * stride < R) CB_TK(r + 2 * stride);
        const float rstd_y = rsqrtf(row_ss(y) * (1.f / D) + EPS);
#pragma unroll
        for (int j = 0; j < 4; ++j) {
            const int c0 = c.lane * 4 + 256 * j;
            const f32x4 g2 = *(const f32x4*)(m + 5120 + c0), n3 = *(const f32x4*)(ngl + 3 * D + c0);
            x[j].x += g2.x * (y[j].x * rstd_y * n3.x); x[j].y += g2.y * (y[j].y * rstd_y * n3.y);
            x[j].z += g2.z * (y[j].z * rstd_y * n3.z); x[j].w += g2.w * (y[j].w * rstd_y * n3.w);
            if (layer == 0) *(f32x4*)(X + (size_t)r * D + c0) = x[j];
            else *(f32x4*)(c.a->out + (size_t)(r - C) * D + c0) = x[j];
        }
        if (layer == 0) {
            const float rstd_x = rsqrtf(row_ss(x) * (1.f / D) + EPS);
            const float* m1 = c.modp(1, r < C ? 1 : 0);
            row_modnorm_store(x, rstd_x, c.a->in[6] + 4 * D, m1 + 0, m1 + 1024, H + (size_t)r * D, c.lane);
        }
    }
#undef CB_TK
#undef CB_DATA
}

namespace hg {
typedef _Float16 h2_t __attribute__((ext_vector_type(2)));
constexpr int TB = 272, PB = 144;
constexpr int TILE = 64 * TB;
constexpr int T_QD = 0, T_QC = TILE, T_KD = 2 * TILE, T_KE = 3 * TILE, T_KC = 4 * TILE, T_V0 = 5 * TILE, T_V1 = 6 * TILE;
constexpr int T_QL1 = 7 * TILE, T_KL1 = T_QL1 + 16 * TB, T_P = T_KL1 + 16 * TB, T_TOT = T_P + 64 * PB, T_CT = T_TOT + 4096, T_END = T_CT + 512;
static_assert(T_END <= LDS_BYTES - 64, "hgrn scan LDS map");
__device__ __forceinline__ int row_of(int dir, int p) { return p < C ? (dir ? C - 1 - p : p) : (dir ? C + (L - 1 - (p - C)) : p); }
__device__ __forceinline__ int seg_of(int ch) { return ch < 68 ? ch / 17 : 4 + (ch - 68) / 16; }
__device__ __forceinline__ bf16x8 tr_frag(const LAS unsigned char* tile, int row0, int col0, int lane) {
    const int q = (lane & 15) >> 2, p = lane & 3;
    const LAS unsigned char* a = tile + (row0 + q) * TB + (col0 + 4 * p) * 2;
    const v4i16_t lo = __builtin_amdgcn_ds_read_tr16_b64_v4i16((LAS v4i16_t*)a);
    const v4i16_t hi = __builtin_amdgcn_ds_read_tr16_b64_v4i16((LAS v4i16_t*)(a + 4 * TB));
    return (bf16x8){lo[0], lo[1], lo[2], lo[3], hi[0], hi[1], hi[2], hi[3]};
}
}

__device__ __forceinline__ void phase_hgrn_scan(const Ctx& c) {
    using namespace hg;
#define HG_BAR() asm volatile("s_waitcnt lgkmcnt(0)\n\ts_barrier" ::: "memory")
    const bf16_t* QH = (const bf16_t*)(c.ws + WS_QH); const bf16_t* IV = (const bf16_t*)(c.ws + WS_IV);
    LAS unsigned char* lds = c.lds;
    const int tid = c.tid, lane = c.lane, w = __builtin_amdgcn_readfirstlane(tid >> 6), fr = lane & 15, g = lane >> 4;
    for (int item_ = c.wg; item_ < 256 * SCAN_REP; item_ += c.nwg) {
        const int item = item_ & 255;
        const int chain = item >> 4, seg = item & 15, head = chain >> 1, dir = chain & 1, hc = head * 128;
        const int c0 = seg < 4 ? 17 * seg : 68 + 16 * (seg - 4), nch = seg < 4 ? 17 : 16;
        const _Float16* KX = (const _Float16*)(c.ws + (dir ? WS_KB : WS_KF));
        float* OL = (float*)(c.ws + (dir ? WS_OB : WS_OF)); bf16_t* QS = (bf16_t*)(c.ws + (dir ? WS_QSB : WS_QSF));
        HG_BAR();
        for (int i = tid; i < 64 * PB / 4; i += 512) ((LAS unsigned*)(lds + T_P))[i] = 0u;
        f32x4 Sacc[8];
#pragma unroll
        for (int m = 0; m < 8; ++m) Sacc[m] = (f32x4){0.f, 0.f, 0.f, 0.f};
        float dseg0 = 1.f, dseg1 = 1.f;
        unsigned kraw[8], qraw[8]; u32x4 vraw[2];
#define HG_LOAD(cidx) do { const int p0_ = 64 * (cidx); const bool lat_ = (cidx) >= 4; \
        _Pragma("unroll") for (int i = 0; i < 8; ++i) { const int r_ = row_of(dir, p0_ + 8 * w + i); \
            kraw[i] = *(const unsigned*)(KX + (size_t)r_ * D + hc + 2 * lane); \
            qraw[i] = lat_ ? *(const unsigned*)(QH + (size_t)(r_ - C) * D + hc + 2 * lane) : 0u; } \
        _Pragma("unroll") for (int i = 0; i < 2; ++i) { const int idx_ = tid + 512 * i; const int r_ = row_of(dir, p0_ + (idx_ >> 4)); \
            vraw[i] = *(const u32x4*)(IV + (size_t)r_ * D + hc + (idx_ & 15) * 8); } } while (0)
        HG_LOAD(c0);
        for (int ci = 0; ci < nch; ++ci) {
            const int cidx = c0 + ci; const bool lat = cidx >= 4;
            const int vbuf = (ci & 1) ? T_V1 : T_V0;
            float kf[8][2], qf[8][2], cp[8][2];
            {
                float p0 = 1.f, p1 = 1.f;
#pragma unroll
                for (int i = 0; i < 8; ++i) {
                    const h2_t hv = __builtin_bit_cast(h2_t, kraw[i]);
                    kf[i][0] = (float)hv[0]; kf[i][1] = (float)hv[1];
                    qf[i][0] = bflo(qraw[i]); qf[i][1] = bfhi(qraw[i]);
                    p0 *= (1.f - kf[i][0]); p1 *= (1.f - kf[i][1]); cp[i][0] = p0; cp[i][1] = p1;
                }
                *(LAS f32x2*)(lds + T_TOT + (w * 128 + 2 * lane) * 4) = (f32x2){p0, p1};
#pragma unroll
                for (int i = 0; i < 2; ++i) { const int idx = tid + 512 * i; *(LAS u32x4*)(lds + vbuf + (idx >> 4) * TB + (idx & 15) * 16) = vraw[i]; }
            }
            HG_BAR();
            {
                f32x2 T[8];
#pragma unroll
                for (int x = 0; x < 8; ++x) T[x] = *(const LAS f32x2*)(lds + T_TOT + (x * 128 + 2 * lane) * 4);
                const int I = w >> 1, hh = w & 1;
                f32x2 bd[4];
#pragma unroll
                for (int x = 0; x < 4; ++x) bd[x] = T[2 * x] * T[2 * x + 1];
                f32x2 pre = (f32x2){1.f, 1.f}, cum = (f32x2){1.f, 1.f}, suf = (f32x2){1.f, 1.f}, bdI = (f32x2){1.f, 1.f};
#pragma unroll
                for (int x = 0; x < 8; ++x) if (hh && x == w - 1) pre = T[x];
#pragma unroll
                for (int x = 0; x < 4; ++x) { if (x < I) cum = cum * bd[x]; if (x > I) suf = suf * bd[x]; if (x == I) bdI = bd[x]; }
                const f32x2 ctot = (bd[0] * bd[1]) * (bd[2] * bd[3]);
#pragma unroll
                for (int i = 0; i < 8; ++i) {
                    const int tau = 8 * w + i;
                    float QDv[2], KDv[2], KEv[2], QCv[2], KCv[2];
#pragma unroll
                    for (int x = 0; x < 2; ++x) {
                        const float eq = pre[x] * cp[i][x], rc = __builtin_amdgcn_rcpf(eq);
                        QDv[x] = qf[i][x] * eq; KDv[x] = kf[i][x] * rc; KEv[x] = KDv[x] * bdI[x]; QCv[x] = QDv[x] * cum[x]; KCv[x] = KEv[x] * suf[x];
                    }
                    const int to = tau * TB + lane * 4;
                    *(LAS unsigned*)(lds + T_QD + to) = pk2(QDv[0], QDv[1]);
                    *(LAS unsigned*)(lds + T_KD + to) = pk2(KDv[0], KDv[1]);
                    *(LAS unsigned*)(lds + T_KE + to) = pk2(KEv[0], KEv[1]);
                    *(LAS unsigned*)(lds + T_QC + to) = pk2(QCv[0], QCv[1]);
                    *(LAS unsigned*)(lds + T_KC + to) = pk2(KCv[0], KCv[1]);
                    if (I == 3) *(LAS unsigned*)(lds + T_QL1 + (tau - 48) * TB + lane * 4) = pk2(QDv[0] * bd[2][0], QDv[1] * bd[2][1]);
                    if (I == 0) *(LAS unsigned*)(lds + T_KL1 + tau * TB + lane * 4) = pk2(KEv[0] * bd[1][0], KEv[1] * bd[1][1]);
                    if (lat) { const int r = row_of(dir, 64 * cidx + tau); *(unsigned*)(QS + (size_t)(r - C) * D + hc + 2 * lane) = pk2(QCv[0] * dseg0, QCv[1] * dseg1); }
                }
                dseg0 *= ctot[0]; dseg1 *= ctot[1];
                if (w == 0) *(LAS f32x2*)(lds + T_CT + lane * 8) = ctot;
            }
            HG_BAR();
            if (ci + 1 < nch) HG_LOAD(cidx + 1);
            if (lat) {
                const int nblk = w >= 6 ? 2 : 1;
                for (int b = 0; b < nblk; ++b) {
                    int I, J, qoff, qrow, koff, krow; bool diag = false;
                    if (w < 4) { I = 2 + (w >> 1); J = w & 1; qoff = (w >> 1) ? T_QL1 : T_QD; qrow = (w >> 1) ? 0 : 32; koff = (w & 1) ? T_KE : T_KL1; krow = (w & 1) ? 16 : 0; }
                    else if (w == 4) { I = 1; J = 0; qoff = T_QD; qrow = 16; koff = T_KE; krow = 0; }
                    else if (w == 5) { I = 3; J = 2; qoff = T_QD; qrow = 48; koff = T_KE; krow = 32; }
                    else { I = 2 * (w - 6) + b; J = I; qoff = T_QD; qrow = 16 * I; koff = T_KD; krow = 16 * I; diag = true; }
                    f32x4 pa = (f32x4){0.f, 0.f, 0.f, 0.f};
#pragma unroll
                    for (int ks = 0; ks < 4; ++ks) {
                        const bf16x8 av = *(const LAS bf16x8*)(lds + qoff + (qrow + fr) * TB + (32 * ks + 8 * g) * 2);
                        const bf16x8 bv = *(const LAS bf16x8*)(lds + koff + (krow + fr) * TB + (32 * ks + 8 * g) * 2);
                        pa = __builtin_amdgcn_mfma_f32_16x16x32_bf16(av, bv, pa, 0, 0, 0);
                    }
#pragma unroll
                    for (int e = 0; e < 4; ++e) {
                        const int tl = 4 * g + e; const float val = (diag && fr > tl) ? 0.f : pa[e];
                        *(LAS bf16_t*)(lds + T_P + (16 * I + tl) * PB + (16 * J + fr) * 2) = (bf16_t)f2bf(val);
                    }
                }
            }
            f32x4 oacc[4];
#pragma unroll
            for (int m = 0; m < 4; ++m) oacc[m] = (f32x4){0.f, 0.f, 0.f, 0.f};
            if (lat) {
                bf16x8 Sb[4];
#pragma unroll
                for (int ks = 0; ks < 4; ++ks) {
                    const f32x4 a0 = Sacc[2 * ks], a1 = Sacc[2 * ks + 1];
                    const u32x4 pk = (u32x4){pk2(a0[0], a0[1]), pk2(a0[2], a0[3]), pk2(a1[0], a1[1]), pk2(a1[2], a1[3])};
                    Sb[ks] = __builtin_bit_cast(bf16x8, pk);
                }
#pragma unroll
                for (int m = 0; m < 4; ++m)
#pragma unroll
                    for (int ks = 0; ks < 4; ++ks) {
                        const u32x2 lo = *(const LAS u32x2*)(lds + T_QC + (16 * m + fr) * TB + (32 * ks + 4 * g) * 2);
                        const u32x2 hi = *(const LAS u32x2*)(lds + T_QC + (16 * m + fr) * TB + (32 * ks + 16 + 4 * g) * 2);
                        const u32x4 pk = (u32x4){lo.x, lo.y, hi.x, hi.y};
                        oacc[m] = __builtin_amdgcn_mfma_f32_16x16x32_bf16(__builtin_bit_cast(bf16x8, pk), Sb[ks], oacc[m], 0, 0, 0);
                    }
            }
#pragma unroll
            for (int m = 0; m < 8; ++m) { const f32x4 ct = *(const LAS f32x4*)(lds + T_CT + (16 * m + 4 * g) * 4); Sacc[m] = Sacc[m] * ct; }
            bf16x8 Vf[2];
#pragma unroll
            for (int ks = 0; ks < 2; ++ks) Vf[ks] = tr_frag(lds + vbuf, 32 * ks + 8 * g, 16 * w, lane);
#pragma unroll
            for (int m = 0; m < 8; ++m)
#pragma unroll
                for (int ks = 0; ks < 2; ++ks) Sacc[m] = __builtin_amdgcn_mfma_f32_16x16x32_bf16(tr_frag(lds + T_KC, 32 * ks + 8 * g, 16 * m, lane), Vf[ks], Sacc[m], 0, 0, 0);
            HG_BAR();
            if (lat) {
#pragma unroll
                for (int m = 0; m < 4; ++m)
#pragma unroll
                    for (int ks = 0; ks < 2; ++ks) {
                        if (m < 2 && ks == 1) continue;
                        const bf16x8 av = *(const LAS bf16x8*)(lds + T_P + (16 * m + fr) * PB + (32 * ks + 8 * g) * 2);
                        oacc[m] = __builtin_amdgcn_mfma_f32_16x16x32_bf16(av, Vf[ks], oacc[m], 0, 0, 0);
                    }
#pragma unroll
                for (int m = 0; m < 4; ++m)
#pragma unroll
                    for (int e = 0; e < 4; ++e) { const int r = row_of(dir, 64 * cidx + 16 * m + 4 * g + e); OL[(size_t)(r - C) * D + hc + 16 * w + fr] = oacc[m][e]; }
            }
        }
#undef HG_LOAD
        float* DS = (float*)(c.ws + WS_DS) + (size_t)item * 16384; float* DG = (float*)(c.ws + WS_DG) + item * 128;
#pragma unroll
        for (int m = 0; m < 8; ++m)
#pragma unroll
            for (int e = 0; e < 4; ++e) DS[(16 * m + 4 * g + e) * 128 + 16 * w + fr] = Sacc[m][e];
        if (w == 0) { DG[2 * lane] = dseg0; DG[2 * lane + 1] = dseg1; }
    }
}

#undef HG_BAR
__device__ __forceinline__ void phase_hgrn_fold(const Ctx& c) {
    const float* DS = (const float*)(c.ws + WS_DS); const float* DG = (const float*)(c.ws + WS_DG); bf16_t* SST = (bf16_t*)(c.ws + WS_SST);
    for (int item = c.wg; item < 256; item += c.nwg) {
        const int chain = item >> 4, slice = item & 15, d = 8 * slice + (c.tid >> 6), v2 = (c.tid & 63) * 2;
        float s0 = 0.f, s1 = 0.f;
        float dv[15]; f32x2 ds[15];
#pragma unroll
        for (int sgi = 0; sgi < 15; ++sgi) { dv[sgi] = DG[(chain * 16 + sgi) * 128 + d]; ds[sgi] = *(const f32x2*)(DS + ((size_t)(chain * 16 + sgi) * 128 + d) * 128 + v2); }
        SST[((size_t)(chain * 16) * 128 + v2) * 128 + d] = 0; SST[((size_t)(chain * 16) * 128 + v2 + 1) * 128 + d] = 0;
#pragma unroll
        for (int sgi = 0; sgi < 15; ++sgi) {
            s0 = dv[sgi] * s0 + ds[sgi][0]; s1 = dv[sgi] * s1 + ds[sgi][1];
            SST[((size_t)(chain * 16 + sgi + 1) * 128 + v2) * 128 + d] = (bf16_t)f2bf(s0); SST[((size_t)(chain * 16 + sgi + 1) * 128 + v2 + 1) * 128 + d] = (bf16_t)f2bf(s1);
        }
    }
}

__device__ __forceinline__ void phase_hgrn_readout(const Ctx& c) {
    constexpr int SP = 272, SBUF = 128 * SP, IBUF = 2 * SBUF;
    static_assert(2 * IBUF + 1024 <= LDS_BYTES - 64, "readout LDS map");
    const float* OF = (const float*)(c.ws + WS_OF); const float* OB = (const float*)(c.ws + WS_OB); const bf16_t* SGp = (const bf16_t*)(c.ws + WS_SG);
    const bf16_t* SST = (const bf16_t*)(c.ws + WS_SST); bf16_t* RR = (bf16_t*)(c.ws + WS_RR); const float* hng = c.a->in[13];
    LAS unsigned char* lds = c.lds; LAS float* ssx = (LAS float*)(c.lds + 2 * IBUF);
    const int tid = c.tid, lane = c.lane, w = __builtin_amdgcn_readfirstlane(tid >> 6), fr = lane & 15, g = lane >> 4, mt = w & 3, nh = w >> 2;
#define RO_BAR() asm volatile("s_waitcnt lgkmcnt(0)\n\ts_barrier" ::: "memory")
    u32x4 sreg[8];
#define RO_SST_LOAD(it) do { const int h_ = (it) >> 8, ch_ = (it) & 255; \
        _Pragma("unroll") for (int j = 0; j < 8; ++j) { const int idx_ = tid + 512 * j, dx_ = idx_ >> 11, rem_ = idx_ & 2047; \
            const int sg_ = hg::seg_of(dx_ ? 4 + 255 - ch_ : 4 + ch_); \
            sreg[j] = *(const u32x4*)(SST + ((size_t)((h_ * 2 + dx_) * 16 + sg_) * 128 + (rem_ >> 4)) * 128 + (rem_ & 15) * 8); } } while (0)
#define RO_SST_WRITE(buf) do { _Pragma("unroll") for (int j = 0; j < 8; ++j) { const int idx_ = tid + 512 * j, dx_ = idx_ >> 11, rem_ = idx_ & 2047; \
            *(LAS u32x4*)(lds + (buf) * IBUF + dx_ * SBUF + (rem_ >> 4) * SP + (rem_ & 15) * 16) = sreg[j]; } } while (0)
    int it = c.wg;
    RO_BAR();
    if (it < 2048) { RO_SST_LOAD(it); RO_SST_WRITE(0); }
    RO_BAR();
    for (int k = 0; it < 2048; it += c.nwg, ++k) {
        const int h = it >> 8, ch = it & 255, t0 = 64 * ch + 16 * mt, buf = k & 1;
        const bool has_next = it + c.nwg < 2048;
        if (has_next) RO_SST_LOAD(it + c.nwg);
        f32x4 acc[4]; float sgv[4][4];
#pragma unroll
        for (int n = 0; n < 4; ++n)
#pragma unroll
            for (int e = 0; e < 4; ++e) { const size_t o = (size_t)(t0 + 4 * g + e) * D + h * 128 + 64 * nh + 16 * n + fr; acc[n][e] = OF[o] + OB[o]; sgv[n][e] = bf2f(SGp[o]) * hng[h * 128 + 64 * nh + 16 * n + fr]; }
#pragma unroll
        for (int dx = 0; dx < 2; ++dx) {
            const bf16_t* QS = (const bf16_t*)(c.ws + (dx ? WS_QSB : WS_QSF)) + (size_t)(t0 + fr) * D + h * 128 + 8 * g;
            const LAS unsigned char* sb = lds + buf * IBUF + dx * SBUF + (64 * nh + fr) * SP + 16 * g;
#pragma unroll
            for (int ks = 0; ks < 4; ++ks) {
                const bf16x8 av = *(const bf16x8*)(QS + 32 * ks);
#pragma unroll
                for (int n = 0; n < 4; ++n) acc[n] = __builtin_amdgcn_mfma_f32_16x16x32_bf16(av, *(const LAS bf16x8*)(sb + (16 * n) * SP + 64 * ks), acc[n], 0, 0, 0);
            }
        }
        float ss[4] = {0.f, 0.f, 0.f, 0.f};
#pragma unroll
        for (int n = 0; n < 4; ++n)
#pragma unroll
            for (int e = 0; e < 4; ++e) ss[e] += acc[n][e] * acc[n][e];
#pragma unroll
        for (int e = 0; e < 4; ++e) {
#pragma unroll
            for (int sh = 8; sh > 0; sh >>= 1) ss[e] += __shfl_xor(ss[e], sh);
        }
        if (fr == 0) *(LAS f32x4*)(ssx + ((k & 1) * 8 + w) * 16 + 4 * g) = (f32x4){ss[0], ss[1], ss[2], ss[3]};
        if (has_next) RO_SST_WRITE(buf ^ 1);
        RO_BAR();
        const f32x4 ps = *(const LAS f32x4*)(ssx + ((k & 1) * 8 + (w ^ 4)) * 16 + 4 * g);
#pragma unroll
        for (int e = 0; e < 4; ++e) ss[e] = rsqrtf((ss[e] + ps[e]) * (1.f / 128.f) + EPS);
#pragma unroll
        for (int n = 0; n < 4; ++n)
#pragma unroll
            for (int e = 0; e < 4; ++e) { const size_t o = (size_t)(t0 + 4 * g + e) * D + h * 128 + 64 * nh + 16 * n + fr; RR[o] = (bf16_t)f2bf(acc[n][e] * ss[e] * sgv[n][e]); }
    }
    RO_BAR();
#undef RO_BAR
#undef RO_SST_LOAD
#undef RO_SST_WRITE
}

#define XB_TMO      128
#define XB_XCNT(j)  (256  + 64 * (j))
#define XB_XSUB(j)  (1280 + 64 * (j))
#define XB_XGEN(j)  (2304 + 64 * (j))
#define XB_TOP      3328
#define XB_TOPGEN   3392
#define XCD_BAR_WORDS 3456
#define XB_SPIN_CAP (1u << 18)
__device__ __forceinline__ unsigned xb_ld(unsigned* p)              { return __hip_atomic_load(p, __ATOMIC_RELAXED, __HIP_MEMORY_SCOPE_AGENT); }
__device__ __forceinline__ unsigned xb_add(unsigned* p, unsigned v) { return __hip_atomic_fetch_add(p, v, __ATOMIC_RELAXED, __HIP_MEMORY_SCOPE_AGENT); }
__device__ __forceinline__ unsigned xb_xcc_id() { return (unsigned)__builtin_amdgcn_s_getreg((3 << 11) | 20) & 0xFu; }
#define XB_SPIN(cond, bar) do { unsigned _sp = 0; while (cond) { __builtin_amdgcn_s_sleep(1); \
    if ((++_sp & 255u) == 0u) { if (xb_ld(&(bar)[XB_TMO])) break; if (_sp > XB_SPIN_CAP) { atomicAdd(&(bar)[XB_TMO], 1u); break; } } } } while (0)
struct XcdBarrier { unsigned* bar; unsigned x; volatile LAS unsigned* st; };
__device__ __forceinline__ XcdBarrier xcd_barrier_post(unsigned* bar, volatile LAS unsigned* st) {
    XcdBarrier b; b.bar = bar; b.x = xb_xcc_id(); b.st = st;
    if (threadIdx.x == 0) (void)xb_add(&bar[XB_XCNT(b.x)], 1u);
    return b;
}
__device__ __forceinline__ void xcd_barrier_complete(unsigned* bar, unsigned x, unsigned& nloc, unsigned& nx) {
    const unsigned G = gridDim.x * gridDim.y * gridDim.z;
    unsigned sum, cnt, mine, sp = 0u;
    for (;;) {
        sum = 0u; cnt = 0u; mine = 0u;
#pragma unroll
        for (unsigned j = 0; j < 16; ++j) { const unsigned c = xb_ld(&bar[XB_XCNT(j)]); sum += c; cnt += (c > 0u) ? 1u : 0u; mine = (j == x) ? c : mine; }
        if (sum == G) break;
        __builtin_amdgcn_s_sleep(1);
        if ((++sp & 255u) == 0u) { if (xb_ld(&bar[XB_TMO])) break; if (sp > XB_SPIN_CAP) { atomicAdd(&bar[XB_TMO], 1u); break; } }
    }
    nloc = mine > 0u ? mine : 1u; nx = cnt > 0u ? cnt : 1u;
}
__device__ __forceinline__ void xcd_barrier(const XcdBarrier& b) {
    asm volatile("s_waitcnt vmcnt(0)" ::: "memory");
    __syncthreads();
    if (threadIdx.x == 0) {
        unsigned* bar = b.bar;
        __builtin_amdgcn_s_waitcnt(0);
        unsigned nloc = b.st[0], nx = b.st[1];
        if (nloc == 0u) { xcd_barrier_complete(bar, b.x, nloc, nx); b.st[0] = nloc; b.st[1] = nx; }
        const unsigned old = xb_add(&bar[XB_XSUB(b.x)], 1u);
        const unsigned gen = old / nloc;
        if (old + 1u == (gen + 1u) * nloc) {
            __builtin_amdgcn_fence(__ATOMIC_RELEASE, "agent");
            asm volatile("s_waitcnt vmcnt(0)" ::: "memory");
            const unsigned og = xb_add(&bar[XB_TOP], 1u);
            const unsigned tg = og / nx;
            if (og + 1u == (tg + 1u) * nx) xb_add(&bar[XB_TOPGEN], 1u);
            else XB_SPIN(xb_ld(&bar[XB_TOPGEN]) == tg, bar);
            __builtin_amdgcn_fence(__ATOMIC_ACQUIRE, "agent");
            xb_add(&bar[XB_XGEN(b.x)], 1u);
            asm volatile("s_waitcnt vmcnt(0)" ::: "memory");
        } else {
            XB_SPIN(xb_ld(&bar[XB_XGEN(b.x)]) == gen, bar);
            __builtin_amdgcn_fence(__ATOMIC_ACQUIRE, "agent");
            asm volatile("s_waitcnt vmcnt(0)" ::: "memory");
        }
    }
    __syncthreads();
}

__device__ __forceinline__ void launder(Ctx& c) { asm volatile("" : "+s"(c.a)); asm volatile("" : "+s"(c.ws)); asm volatile("" : "+s"(c.wave));
    c.lane = (int)__builtin_amdgcn_mbcnt_hi(~0u, __builtin_amdgcn_mbcnt_lo(~0u, 0u)); c.tid = c.wave * 64 + c.lane; }
__global__ void __launch_bounds__(512, 2) mk_fwd(Args args) {
    extern __shared__ __attribute__((aligned(16))) unsigned char lds_raw[];
    Ctx c; c.a = (CArgs)__builtin_amdgcn_kernarg_segment_ptr(); c.lds = (LAS unsigned char*)lds_raw; c.tid = threadIdx.x; c.lane = c.tid & 63; c.wave = __builtin_amdgcn_readfirstlane(c.tid >> 6); c.nwg = gridDim.x; c.wg = blockIdx.x; c.ws = c.a->ws;
    volatile LAS unsigned* bst = (volatile LAS unsigned*)(c.lds + LDS_BYTES - 64);
    if (c.tid < 4) bst[c.tid] = 0u;
    __syncthreads();
    const XcdBarrier bar = xcd_barrier_post((unsigned*)(c.ws + WS_CTL) + CW_BAR, bst);
    const int lo = c.a->ph_lo, hi = c.a->ph_hi;
    bool route_ok = true;
#define SEAM(k) do { if (lo <= (k) && (k) + 1 < hi) xcd_barrier(bar); } while (0)
#define IN(k) (lo <= (k) && (k) < hi && (launder(c), true))
#define PH(k, call) do { if (IN(k)) { if (PROBE_PH == (k)) { int nrep_ = 3; asm volatile("" : "+s"(nrep_)); for (int rep_ = 0; rep_ < nrep_; ++rep_) { route_ok = (rep_ + 1 == nrep_); call; if (rep_ + 1 < nrep_) xcd_barrier(bar); } } else { call; } } SEAM(k); } while (0)
    PH(0, phase_prep(c));
    PH(1, phase_convert(c));
    PH(2, phase_gemm_qkv(c));
    PH(3, phase_attn(c));
    PH(4, phase_gemm_f32(c, (const bf16_t*)(c.ws + WS_O), R, (const bf16_t*)(c.ws + WS_WO), D, nullptr, (float*)(c.ws + WS_RAW1)));
    PH(5, { phase_postmix<128>(c, 0, route_ok); convert_steal(c, 1); });
    PH(6, phase_moe_gu(c, 0));
    PH(7, phase_moe_dn(c, 0));
    PH(8, phase_combine(c, 0));
    PH(9, phase_gemm_inproj(c));
    PH(10, phase_hgrn_scan(c));
    PH(11, phase_hgrn_fold(c));
    PH(12, phase_hgrn_readout(c));
    PH(13, phase_gemm_f32(c, (const bf16_t*)(c.ws + WS_RR), L, (const bf16_t*)(c.ws + WS_WHO), D, nullptr, (float*)(c.ws + WS_RAW1)));
    PH(14, { phase_postmix<128>(c, 1, route_ok); convert_steal(c, 2); });
    PH(15, phase_moe_gu(c, 1));
    PH(16, phase_moe_dn(c, 1));
    PH(17, phase_combine(c, 1));
#undef IN
#undef PH
#undef SEAM
}

extern "C" void kernel_launch(void* const* d_in, const int* in_sizes, int n_in, void* d_out, int out_size, void* d_ws, size_t ws_size, hipStream_t stream) {
    static int grid = 0;
    if (grid == 0) {
        if (n_in != 21 || out_size != L * D || ws_size < WS_END) { fprintf(stderr, "kernel_launch: unexpected problem (n_in %d out %d ws %zu need %zu)\n", n_in, out_size, ws_size, (size_t)WS_END); grid = -1; return; }
        int dev = 0, cus = 0, per_cu = 0;
        hipGetDevice(&dev); hipDeviceGetAttribute(&cus, hipDeviceAttributeMultiprocessorCount, dev);
        if (hipFuncSetAttribute((const void*)mk_fwd, hipFuncAttributeMaxDynamicSharedMemorySize, LDS_BYTES) != hipSuccess) { fprintf(stderr, "kernel_launch: hipFuncSetAttribute failed\n"); grid = -1; return; }
        hipOccupancyMaxActiveBlocksPerMultiprocessor(&per_cu, (const void*)mk_fwd, 512, LDS_BYTES);
        if (per_cu < 1) fprintf(stderr, "kernel_launch: occupancy query says %d\n", per_cu);
        (void)hipGetLastError();
        grid = cus > 0 ? cus : 256;
    }
    if (grid < 0) return;
    hipMemsetAsync((char*)d_ws + WS_CTL, 0, MiB, stream);
    Args a{};
    for (int i = 0; i < 21; ++i) a.in[i] = (const float*)d_in[i];
    a.out = (float*)d_out; a.ws = (unsigned char*)d_ws;
    a.ph_lo = 0; a.ph_hi = NPHASE;
    hipLaunchKernelGGL(mk_fwd, dim3(grid), dim3(512), LDS_BYTES, stream, a);
}
```

```cpp
#include <hip/hip_runtime.h>
#include <cstdint>
#include <cstdio>

#define LAS __attribute__((address_space(3)))
typedef unsigned short bf16_t;
typedef short bf16x8 __attribute__((ext_vector_type(8)));
typedef float f32x4 __attribute__((ext_vector_type(4)));
typedef unsigned u32x4 __attribute__((ext_vector_type(4)));
typedef unsigned u32x2 __attribute__((ext_vector_type(2)));
typedef short v4i16_t __attribute__((ext_vector_type(4)));
typedef float f32x2 __attribute__((ext_vector_type(2)));

constexpr int D = 1024, L = 16384, C = 256, R = L + C;
constexpr int QKVD = 1280, HIN = 5120, NE = 32, TOPK = 4;
constexpr int PADM = 256, MAXROWS = 74752;
constexpr float EPS = 1e-6f;
constexpr float LOG2E = 1.4426950408889634f;
constexpr int NPHASE = 18;
#ifndef GEMM_REP
#define GEMM_REP 1
#endif
#ifndef PROBE_NOEPI
#define PROBE_NOEPI 0
#endif
#ifndef PROBE_SHORTK
#define PROBE_SHORTK 0
#endif
#ifndef SCAN_REP
#define SCAN_REP 1
#endif
#ifndef PROBE_PH
#define PROBE_PH (-1)
#endif
constexpr int LDS_BYTES = 147456;

constexpr size_t MiB = 1u << 20;
constexpr size_t al(size_t x) { return (x + MiB - 1) / MiB * MiB; }
constexpr size_t WS_CTL = 0;
constexpr size_t WS_MOD = WS_CTL + MiB;
constexpr size_t WS_X = WS_MOD + MiB;
constexpr size_t WS_H = WS_X + al((size_t)R * D * 4);
constexpr size_t WS_Q = WS_H + al((size_t)R * D * 2);
constexpr size_t WS_K = WS_Q + al((size_t)R * D * 2);
constexpr size_t WS_V = WS_K + al((size_t)R * 128 * 2);
constexpr size_t WS_O = WS_V + al((size_t)R * 128 * 2);
constexpr size_t WS_TK = WS_O + al((size_t)R * D * 2);
constexpr size_t WS_LIST = WS_TK + MiB;
constexpr size_t WS_HDN = WS_LIST + 3 * MiB;
constexpr size_t WS_RAW1 = WS_HDN + al((size_t)MAXROWS * 1024 * 2);
constexpr size_t WS_X1 = WS_RAW1 + al((size_t)R * D * 4);
constexpr size_t WS_OUTB = WS_X1 + al((size_t)R * D * 4);
constexpr size_t WS_QH = WS_OUTB + al((size_t)MAXROWS * 1024 * 2);
constexpr size_t WS_KF = WS_QH + al((size_t)L * D * 2);
constexpr size_t WS_KB = WS_KF + al((size_t)R * D * 2);
constexpr size_t WS_IV = WS_KB + al((size_t)R * D * 2);
constexpr size_t WS_SG = WS_IV + al((size_t)R * D * 2);
constexpr size_t WS_OF = WS_SG + al((size_t)L * D * 2);
constexpr size_t WS_OB = WS_OF + al((size_t)L * D * 4);
constexpr size_t WS_RR = WS_OB + al((size_t)L * D * 4);
constexpr size_t WS_WQKV = WS_RR + al((size_t)L * D * 2);
constexpr size_t WS_WO = WS_WQKV + al((size_t)QKVD * D * 2);
constexpr size_t WS_WIN = WS_WO + al((size_t)D * D * 2);
constexpr size_t WS_WHO = WS_WIN + al((size_t)HIN * D * 2);
constexpr size_t WS_WGU = WS_WHO + al((size_t)D * D * 2);
constexpr size_t WS_WDN = WS_WGU + al((size_t)2 * NE * 2048 * D * 2);
constexpr size_t WS_QSF = WS_WDN + al((size_t)2 * NE * 1024 * D * 2);
constexpr size_t WS_QSB = WS_QSF + al((size_t)L * D * 2);
constexpr size_t WS_DS = WS_QSB + al((size_t)L * D * 2);
constexpr size_t WS_DG = WS_DS + al((size_t)256 * 128 * 128 * 4);
constexpr size_t WS_SST = WS_DG + MiB;
constexpr size_t WS_H8 = WS_SST + al((size_t)256 * 128 * 128 * 2);
constexpr size_t WS_END = WS_H8 + al((size_t)R * D);
static_assert(WS_END <= (size_t)2048 * MiB, "workspace map exceeds 4x the largest input");
constexpr int CW_CNT = 1024;
constexpr int CW_CONV = 2048;
constexpr int CW_BAR = 4096;
constexpr int MOD_ROPE = 32768;
constexpr int MOD_LB = 49152;

struct Args { const float* in[21]; float* out; unsigned char* ws; int ph_lo, ph_hi; };

__device__ __forceinline__ unsigned f2bf(float f) { unsigned u = __float_as_uint(f); return (u + 0x7fffu + ((u >> 16) & 1u)) >> 16; }
typedef float f32x2_t __attribute__((ext_vector_type(2))); typedef __bf16 bf16x2_t __attribute__((ext_vector_type(2)));
__device__ __forceinline__ unsigned pk2(float lo, float hi) { f32x2_t v = {lo, hi}; bf16x2_t b = __builtin_convertvector(v, bf16x2_t); return __builtin_bit_cast(unsigned, b); }
__device__ __forceinline__ unsigned pk4_fp8(float a, float b, float c, float d) {
    a = fminf(fmaxf(a, -448.f), 448.f); b = fminf(fmaxf(b, -448.f), 448.f); c = fminf(fmaxf(c, -448.f), 448.f); d = fminf(fmaxf(d, -448.f), 448.f);
    int v = __builtin_amdgcn_cvt_pk_fp8_f32(a, b, 0, false); v = __builtin_amdgcn_cvt_pk_fp8_f32(c, d, v, true); return (unsigned)v; }
constexpr float F8_SH = 8.f, F8_SW = 64.f, F8_SHD = 4.f;
__device__ __forceinline__ float bflo(unsigned u) { return __uint_as_float(u << 16); }
__device__ __forceinline__ float bfhi(unsigned u) { return __uint_as_float(u & 0xffff0000u); }
__device__ __forceinline__ float bf2f(bf16_t b) { return __uint_as_float(((unsigned)b) << 16); }
__device__ __forceinline__ float wave_sum(float v) {
#pragma unroll
    for (int o = 32; o > 0; o >>= 1) v += __shfl_xor(v, o);
    return v;
}
__device__ __forceinline__ float silu_f(float x) { return x / (1.f + __expf(-x)); }
__device__ __forceinline__ float sigmoid_f(float x) { return 1.f / (1.f + __expf(-x)); }

typedef const __attribute__((address_space(4))) Args* CArgs;
struct Ctx {
    CArgs a;
    LAS unsigned char* lds;
    int tid, lane, wave, nwg, wg;
    unsigned char* ws;
    __device__ __forceinline__ float* modp(int layer, int which) const { return (float*)(ws + WS_MOD) + (layer * 2 + which) * 6144; }
    __device__ __forceinline__ const float* xin0(int r) const { return r < C ? a->in[2] + (size_t)r * D : a->in[0] + (size_t)(r - C) * D; }
};


namespace pg8 {
constexpr int BM = 256, BK = 64, HALF = 128, HTB = HALF * BK * 2, STAGE_BYTES = 8 * HTB, KD = 1024, NXCD = 8, WGM = 8;
__device__ __forceinline__ int lds_byte(int r, int c) { const int st = (r >> 4) * 2 + (c >> 5), rr = r & 15, cc = c & 31, ob = rr * 64 + cc * 2; return st * 1024 + (ob ^ (((ob >> 9) & 1) << 5)); }
__device__ __forceinline__ void stage_rc(int b, int& Rr, int& Cc) { const int st = b / 1024, sb = b % 1024, swz = sb ^ (((sb >> 9) & 1) << 5); Rr = (st >> 1) * 16 + swz / 64; Cc = (st & 1) * 32 + (swz % 64) / 2; }
__device__ __forceinline__ int perm32(int rho) { const int n = rho >> 4, i = rho & 15; return 8 * (i >> 2) + 4 * n + (i & 3); }

struct Unit { int pm, pn, e, goff, gcnt; bool real; int amask, bmask; };
struct Gemm { const void* A; const void* Bt; size_t bstride; const int* list; };

struct StaticOrder {
    int nM, nN, nwg, G, c;
    __device__ __forceinline__ void init(int M, int N, int G_, int c_) { nM = M / BM; nN = N / BM; nwg = nM * nN; G = G_; c = c_; }
    __device__ __forceinline__ bool next(int i, Unit& u) const {
        const int F = nwg / G, Rm = nwg - F * G; int Lq; u.amask = 3; u.bmask = 3;
        if (i < F) Lq = i * G + c;
        else if (i == F && Rm > 0) {
            if (4 * Rm <= G) { if (c >= 4 * Rm) return false; Lq = F * G + (c >> 2); u.amask = 1 << ((c >> 1) & 1); u.bmask = 1 << (c & 1); }
            else if (2 * Rm <= G) { if (c >= 2 * Rm) return false; Lq = F * G + (c >> 1); u.bmask = 1 << (c & 1); }
            else { if (c >= Rm) return false; Lq = F * G + c; }
        } else return false;
        int wgid = Lq; { const int q = nwg / NXCD, r = nwg % NXCD, xcd = wgid % NXCD, off = wgid / NXCD; wgid = (xcd < r ? xcd * (q + 1) : r * (q + 1) + (xcd - r) * q) + off; }
        const int nig = WGM * nN, gid = wgid / nig, fm = gid * WGM, gsz = (nM - fm) < WGM ? (nM - fm) : WGM;
        u.pm = fm + ((wgid % nig) % gsz); u.pn = (wgid % nig) / gsz; u.e = 0; u.goff = 0; u.gcnt = 0; u.real = true; return true;
    }
};
struct MoeOrder {
    const LAS int* tp; const LAS int* cnt; int npn, G, vcu; bool split;
    __device__ __forceinline__ bool next(int i, Unit& u) const {
        const int tot = tp[32] * npn; int lin; u.amask = 3; u.bmask = 3; u.real = true;
        if (GEMM_REP > 1) { const int lin0 = i * G + vcu; if (lin0 >= tot * GEMM_REP) return false; lin = lin0 % tot; u.real = lin0 >= tot * (GEMM_REP - 1); }
        else {
            const int F = tot / G, Rm = tot - F * G;
            if (i < F) lin = i * G + vcu;
            else if (i == F && Rm > 0) {
                if (split && 2 * Rm <= G) { if (vcu >= 2 * Rm) return false; lin = F * G + (vcu >> 1); u.bmask = 1 << (vcu & 1); }
                else { if (vcu >= Rm) return false; lin = F * G + vcu; }
            } else return false;
        }
        const int rt = lin / npn; int e = 0;
#pragma unroll 8
        for (int k = 1; k < 32; ++k) e += (rt >= tp[k]) ? 1 : 0;
        const int mt = rt - tp[e];
        u.pm = rt; u.pn = lin - rt * npn; u.e = e; u.goff = e * R + mt * 256; u.gcnt = cnt[e] - mt * 256; return true;
    }
};

template <int KB>
__device__ __forceinline__ void a_offsets(const Gemm& g, const Unit& u, const int (&sR)[2], const int (&sC)[2], unsigned (&v)[2][2]) {
#pragma unroll
    for (int h = 0; h < 2; ++h)
#pragma unroll
        for (int i = 0; i < 2; ++i) {
            const int rr = h * HALF + sR[i]; int row;
            if (g.list) row = rr < u.gcnt ? g.list[u.goff + rr] : 0; else row = u.pm * BM + rr;
            v[h][i] = (unsigned)(row * KB + sC[i] * 2);
        }
}

struct EpiF32 {
    static constexpr bool PERM = false;
    float* Cp; int ldc; const float* bias;
    __device__ __forceinline__ void operator()(const f32x4 (&acc)[2][2][4][2], const Unit& u, int wr, int wc, int fr, int fq) const {
        const int row0 = u.pm * BM + wr * 64 + fr, col0 = u.pn * BM + wc * 32 + 4 * fq;
#pragma unroll
        for (int bj = 0; bj < 2; ++bj)
#pragma unroll
            for (int n = 0; n < 2; ++n) {
                const int col = col0 + bj * HALF + n * 16;
                if (!((u.bmask >> bj) & 1)) continue;
                const f32x4 bv = bias ? *(const f32x4*)(bias + col) : (f32x4){0.f, 0.f, 0.f, 0.f};
#pragma unroll
                for (int ai = 0; ai < 2; ++ai)
#pragma unroll
                    for (int m = 0; m < 4; ++m) if ((u.amask >> ai) & 1) *(f32x4*)(Cp + (size_t)(row0 + ai * HALF + m * 16) * ldc + col) = acc[ai][bj][m][n] + bv;
            }
    }
};
struct EpiSwiglu {
    static constexpr bool PERM = true;
    unsigned char* Hd; const float* bgu;
    __device__ __forceinline__ void operator()(const f32x4 (&acc)[2][2][4][2], const Unit& u, int wr, int wc, int fr, int fq) const {
        const int row0 = u.pm * BM + wr * 64 + fr, cg0 = u.pn * HALF + wc * 32 + 8 * fq;
        const float* bb = bgu + (size_t)u.e * 2048;
        f32x4 bg[2], bu[2];
#pragma unroll
        for (int n = 0; n < 2; ++n) { bg[n] = *(const f32x4*)(bb + cg0 + 4 * n); bu[n] = *(const f32x4*)(bb + 1024 + cg0 + 4 * n); }
#pragma unroll
        for (int ai = 0; ai < 2; ++ai)
#pragma unroll
            for (int m = 0; m < 4; ++m) {
                u32x2 o;
#pragma unroll
                for (int n = 0; n < 2; ++n) {
                    const f32x4 gv = acc[ai][0][m][n] * (1.f / (F8_SH * F8_SW)) + bg[n], uv = acc[ai][1][m][n] * (1.f / (F8_SH * F8_SW)) + bu[n]; float hv[4];
#pragma unroll
                    for (int q = 0; q < 4; ++q) { const float gg = fminf(gv[q], 7.f), uu = fminf(fmaxf(uv[q], -7.f), 7.f); hv[q] = gg * (1.f / (1.f + __expf(-1.702f * gg))) * (uu + 1.f); }
                    o[n] = pk4_fp8(hv[0] * F8_SHD, hv[1] * F8_SHD, hv[2] * F8_SHD, hv[3] * F8_SHD);
                }
                *(u32x2*)(Hd + (size_t)(row0 + ai * HALF + m * 16) * 1024 + cg0) = o;
            }
    }
};
struct EpiBf16Bias {
    static constexpr bool PERM = true;
    bf16_t* Op; const float* bias; int bias_estride; float scale;
    __device__ __forceinline__ void operator()(const f32x4 (&acc)[2][2][4][2], const Unit& u, int wr, int wc, int fr, int fq) const {
        const int row0 = u.pm * BM + wr * 64 + fr, col0 = u.pn * BM + wc * 32 + 8 * fq;
        const float* bb = bias + (size_t)u.e * bias_estride;
#pragma unroll
        for (int bj = 0; bj < 2; ++bj) {
            const int col = col0 + bj * HALF;
            if (!((u.bmask >> bj) & 1)) continue;
            const f32x4 b0 = *(const f32x4*)(bb + col), b1 = *(const f32x4*)(bb + col + 4);
#pragma unroll
            for (int ai = 0; ai < 2; ++ai)
#pragma unroll
                for (int m = 0; m < 4; ++m) { if (!((u.amask >> ai) & 1)) continue; const f32x4 v0 = acc[ai][bj][m][0] * scale + b0, v1 = acc[ai][bj][m][1] * scale + b1;
                    u32x4 o; o.x = pk2(v0[0], v0[1]); o.y = pk2(v0[2], v0[3]); o.z = pk2(v1[0], v1[1]); o.w = pk2(v1[2], v1[3]);
                    *(u32x4*)(Op + (size_t)(row0 + ai * HALF + m * 16) * 1024 + col) = o; }
        }
    }
};
struct EpiQKV {
    static constexpr bool PERM = false;
    bf16_t* Qp; bf16_t* Kp; bf16_t* Vp; const float* bias; const float* tab;
    __device__ __forceinline__ void operator()(const f32x4 (&acc)[2][2][4][2], const Unit& u, int wr, int wc, int fr, int fq) const {
        const bool lat = u.pm > 0; const float qs = 0.125f * LOG2E;
#pragma unroll
        for (int bj = 0; bj < 2; ++bj) {
            const int colt = u.pn * BM + bj * HALF + wc * 32 + 4 * fq;
            const f32x4 b1 = *(const f32x4*)(bias + colt), b2 = *(const f32x4*)(bias + colt + 16);
            const bool isv = (u.pn == 4) && (bj == 1);
            if (!((u.bmask >> bj) & 1)) continue;
#pragma unroll
            for (int ai = 0; ai < 2; ++ai)
#pragma unroll
                for (int m = 0; m < 4; ++m) {
                    if (!((u.amask >> ai) & 1)) continue;
                    const int r = u.pm * BM + ai * HALF + wr * 64 + m * 16 + fr, t = r - C;
                    f32x4 x1 = acc[ai][bj][m][0] + b1, x2 = acc[ai][bj][m][1] + b2;
                    if (lat && !isv) {
                        const int pos = (wc & 1) ? (t & 63) : (t >> 6);
                        const f32x4 t0 = *(const f32x4*)(tab + (pos * 16 + 4 * fq) * 2), t1 = *(const f32x4*)(tab + (pos * 16 + 4 * fq) * 2 + 4);
                        const float cs[4] = {t0[0], t0[2], t1[0], t1[2]}, sn[4] = {t0[1], t0[3], t1[1], t1[3]};
                        f32x4 o1, o2;
#pragma unroll
                        for (int e = 0; e < 4; ++e) { o1[e] = x1[e] * cs[e] - x2[e] * sn[e]; o2[e] = x2[e] * cs[e] + x1[e] * sn[e]; }
                        x1 = o1; x2 = o2;
                    }
                    u32x2 w1, w2;
                    if (u.pn < 4) {
                        w1.x = pk2(x1[0] * qs, x1[1] * qs); w1.y = pk2(x1[2] * qs, x1[3] * qs); w2.x = pk2(x2[0] * qs, x2[1] * qs); w2.y = pk2(x2[2] * qs, x2[3] * qs);
                        *(u32x2*)(Qp + (size_t)r * 1024 + colt) = w1; *(u32x2*)(Qp + (size_t)r * 1024 + colt + 16) = w2;
                    } else {
                        w1.x = pk2(x1[0], x1[1]); w1.y = pk2(x1[2], x1[3]); w2.x = pk2(x2[0], x2[1]); w2.y = pk2(x2[2], x2[3]);
                        bf16_t* dst = (bj == 0 ? Kp : Vp) + (size_t)r * 128 + wc * 32 + 4 * fq;
                        *(u32x2*)dst = w1; *(u32x2*)(dst + 16) = w2;
                    }
                }
        }
    }
};
struct EpiInProj {
    static constexpr bool PERM = true;
    bf16_t* QH; _Float16* KF; _Float16* KB; bf16_t* IV; bf16_t* SG; const float* lb; float scale;
    __device__ __forceinline__ void operator()(const f32x4 (&acc)[2][2][4][2], const Unit& u, int wr, int wc, int fr, int fq) const {
        const int seg = u.pn >> 2; const bool lat = u.pm > 0;
        if (!lat && (seg == 0 || seg == 4)) return;
        typedef _Float16 h8_t __attribute__((ext_vector_type(8)));
#pragma unroll
        for (int bj = 0; bj < 2; ++bj) {
            const int col = (u.pn & 3) * BM + bj * HALF + wc * 32 + 8 * fq;
            if (!((u.bmask >> bj) & 1)) continue;
            f32x4 lb0 = (f32x4){0.f, 0.f, 0.f, 0.f}, lb1 = lb0;
            if (seg == 1) { lb0 = *(const f32x4*)(lb + col); lb1 = *(const f32x4*)(lb + col + 4); } else if (seg == 2) { lb0 = *(const f32x4*)(lb + 1024 + col); lb1 = *(const f32x4*)(lb + 1024 + col + 4); }
#pragma unroll
            for (int ai = 0; ai < 2; ++ai)
#pragma unroll
                for (int m = 0; m < 4; ++m) {
                    if (!((u.amask >> ai) & 1)) continue;
                    const int r = u.pm * BM + ai * HALF + wr * 64 + m * 16 + fr; const f32x4 v0 = acc[ai][bj][m][0] * scale, v1 = acc[ai][bj][m][1] * scale;
                    if (seg == 1 || seg == 2) {
                        h8_t hv;
#pragma unroll
                        for (int e = 0; e < 4; ++e) { hv[e] = (_Float16)((1.f - lb0[e]) / (1.f + __expf(v0[e]))); hv[4 + e] = (_Float16)((1.f - lb1[e]) / (1.f + __expf(v1[e]))); }
                        *(h8_t*)((seg == 1 ? KF : KB) + (size_t)r * 1024 + col) = hv;
                    } else if (seg == 3) {
                        u32x4 o; o.x = pk2(v0[0], v0[1]); o.y = pk2(v0[2], v0[3]); o.z = pk2(v1[0], v1[1]); o.w = pk2(v1[2], v1[3]); *(u32x4*)(IV + (size_t)r * 1024 + col) = o;
                    } else {
                        float s0[4], s1[4];
#pragma unroll
                        for (int e = 0; e < 4; ++e) { s0[e] = v0[e] / (1.f + __expf(-v0[e])); s1[e] = v1[e] / (1.f + __expf(-v1[e])); }
                        u32x4 o; o.x = pk2(s0[0], s0[1]); o.y = pk2(s0[2], s0[3]); o.z = pk2(s1[0], s1[1]); o.w = pk2(s1[2], s1[3]); *(u32x4*)((seg == 0 ? QH : SG) + (size_t)(r - C) * 1024 + col) = o;
                    }
                }
        }
    }
};

typedef int v8i __attribute__((ext_vector_type(8)));
template <class Epi, class Sched, bool ALIGN_EPI, bool GATHER, bool FP8>
__device__ __forceinline__ void gemm_phase(LAS unsigned char* lds, const Gemm g, const Sched& S, const Epi& E, const int tid) {
    const int wid = __builtin_amdgcn_readfirstlane(tid >> 6), lane = tid & 63, wr = wid >> 2, wc = wid & 3, fr = lane & 15, fq = lane >> 4;
    constexpr int KB = FP8 ? 1024 : 2048, nt = 1024 / (FP8 ? 128 : 64);
    int sR[2], sC[2]; unsigned voffB[2], voffA[2];
#pragma unroll
    for (int i = 0; i < 2; ++i) { stage_rc(tid * 16 + i * 8192, sR[i], sC[i]); const int Rb = Epi::PERM ? ((sR[i] & ~31) + perm32(sR[i] & 31)) : sR[i]; voffB[i] = (unsigned)(Rb * KB + sC[i] * 2); voffA[i] = (unsigned)(sR[i] * KB + sC[i] * 2); }
    constexpr size_t kstep = (size_t)(BK * 2), hstep = (size_t)HALF * KB, tstep = 2 * hstep;
    const unsigned ldsw = (unsigned)wid * 1024u;
    const int fc = FP8 ? (32 * (fq >> 1) + 16 * (fq & 1)) : fq * 8;
    const int aoff = lds_byte(wr * 64 + fr, fc), boff = lds_byte(wc * 32 + fr, fc);
    const char* Ab = (const char*)g.A;
#define PG8_SA(b, h) (((b) * 2 + (h)) * HTB)
#define PG8_SB(b, h) ((4 + (b) * 2 + (h)) * HTB)
#define PG8_STAGE_B(bufoff, gbase) do { _Pragma("unroll") for (int _i = 0; _i < 2; ++_i) \
        __builtin_amdgcn_global_load_lds((const unsigned*)((const char*)(gbase) + voffB[_i]), (LAS unsigned*)(lds + (bufoff) + ldsw + _i * 8192), 16, 0, 0); } while (0)
#define PG8_STAGE_A(bufoff, kb, v, ubase) do { _Pragma("unroll") for (int _i = 0; _i < 2; ++_i) \
        __builtin_amdgcn_global_load_lds((const unsigned*)((GATHER ? Ab : (ubase)) + (size_t)(kb) + (GATHER ? (v)[_i] : voffA[_i])), (LAS unsigned*)(lds + (bufoff) + ldsw + _i * 8192), 16, 0, 0); } while (0)
#define PG8_LDA(dst, b, h) do { if constexpr (FP8) { _Pragma("unroll") for (int m = 0; m < 4; ++m) dst##8[m] = *(const LAS v8i*)(lds + PG8_SA(b, h) + aoff + m * 2048); } else { _Pragma("unroll") for (int m = 0; m < 4; ++m) _Pragma("unroll") for (int k = 0; k < 2; ++k) dst[m][k] = *(const LAS bf16x8*)(lds + PG8_SA(b, h) + aoff + m * 2048 + k * 1024); } } while (0)
#define PG8_LDB(dst, b, h) do { if constexpr (FP8) { _Pragma("unroll") for (int n = 0; n < 2; ++n) dst##8[n] = *(const LAS v8i*)(lds + PG8_SB(b, h) + boff + n * 2048); } else { _Pragma("unroll") for (int n = 0; n < 2; ++n) _Pragma("unroll") for (int k = 0; k < 2; ++k) dst[n][k] = *(const LAS bf16x8*)(lds + PG8_SB(b, h) + boff + n * 2048 + k * 1024); } } while (0)
#define PG8_MMA(ai, bj, At, Bt) do { __builtin_amdgcn_s_setprio(1); if constexpr (FP8) { _Pragma("unroll") for (int m = 0; m < 4; ++m) _Pragma("unroll") for (int n = 0; n < 2; ++n) \
        asm volatile("v_mfma_scale_f32_16x16x128_f8f6f4 %0, %1, %2, %0, %3, %3 op_sel_hi:[0,0,0]" : "+v"(acc[ai][bj][m][n]) : "v"(Bt##8[n]), "v"(At##8[m]), "v"(unit_scale)); } else { \
        _Pragma("unroll") for (int m = 0; m < 4; ++m) _Pragma("unroll") for (int n = 0; n < 2; ++n) _Pragma("unroll") for (int k = 0; k < 2; ++k) \
        acc[ai][bj][m][n] = __builtin_amdgcn_mfma_f32_16x16x32_bf16(Bt[n][k], At[m][k], acc[ai][bj][m][n], 0, 0, 0); } __builtin_amdgcn_s_setprio(0); } while (0)
#define PG8_WAIT_V(n) asm volatile("s_waitcnt vmcnt(" #n ")" ::: "memory")
#define PG8_WAIT_L(n) asm volatile("s_waitcnt lgkmcnt(" #n ")" ::: "memory")
#define PG8_BAR __builtin_amdgcn_s_barrier()
#define PG8_SCHED __builtin_amdgcn_sched_barrier(0)
    Unit cur, nxt; int ui = 0;
    if (!S.next(0, cur)) return;
    unsigned cv[2][2], nv[2][2];
    if constexpr (GATHER) a_offsets<KB>(g, cur, sR, sC, cv);
    const char* cA = Ab + (size_t)cur.pm * tstep; const char* nA = cA;
    f32x4 acc[2][2][4][2];
#pragma unroll
    for (int a = 0; a < 2; ++a)
#pragma unroll
        for (int b = 0; b < 2; ++b)
#pragma unroll
            for (int m = 0; m < 4; ++m)
#pragma unroll
                for (int n = 0; n < 2; ++n) acc[a][b][m][n] = (f32x4){0.f, 0.f, 0.f, 0.f};
    bf16x8 At[4][2], B0[2][2], B1[2][2]; v8i At8[4], B08[2], B18[2];
    int unit_scale = 0x7f7f7f7f; asm volatile("" : "+v"(unit_scale));
    const char* cB = (const char*)g.Bt + (size_t)cur.e * g.bstride + (size_t)cur.pn * tstep;
    PG8_STAGE_B(PG8_SB(0, 0), cB); PG8_STAGE_B(PG8_SB(0, 1), cB + hstep); PG8_STAGE_A(PG8_SA(0, 0), 0, cv[0], cA); PG8_STAGE_A(PG8_SA(0, 1), 0, cv[1], cA + hstep);
    if (wr == 1) PG8_BAR;
    PG8_WAIT_V(2); PG8_BAR;
    PG8_STAGE_B(PG8_SB(1, 0), cB + kstep); PG8_STAGE_A(PG8_SA(1, 0), kstep, cv[0], cA); PG8_STAGE_B(PG8_SB(1, 1), cB + hstep + kstep);
    PG8_WAIT_V(6); PG8_BAR;
    for (;;) {
        const bool has_next = S.next(ui + 1, nxt);
        const char* nB = cB;
        nA = cA;
        if (has_next) { if constexpr (GATHER) a_offsets<KB>(g, nxt, sR, sC, nv); nA = Ab + (size_t)nxt.pm * tstep; nB = (const char*)g.Bt + (size_t)nxt.e * g.bstride + (size_t)nxt.pn * tstep; }
        else if constexpr (GATHER) {
#pragma unroll
            for (int h = 0; h < 2; ++h)
#pragma unroll
                for (int i = 0; i < 2; ++i) nv[h][i] = cv[h][i];
        }
        const int ntr = (PROBE_SHORTK && !cur.real) ? 2 : nt;
        const bool m00 = (cur.amask & 1) && (cur.bmask & 1), m01 = (cur.amask & 1) && (cur.bmask & 2), m10 = (cur.amask & 2) && (cur.bmask & 1), m11 = (cur.amask & 2) && (cur.bmask & 2);
#pragma nounroll
        for (int t = 0; t < ntr; t += 2) {
            const bool last = (t == ntr - 2);
            const size_t k1 = (size_t)(t + 1) * kstep, k2 = last ? 0 : (size_t)(t + 2) * kstep, k3 = k2 + kstep;
            const char* b2 = last ? nB : cB + (size_t)(t + 2) * kstep; const char* b3 = b2 + kstep;
            unsigned w0[2], w1[2];
            if constexpr (GATHER) {
#pragma unroll
                for (int i = 0; i < 2; ++i) { w0[i] = last ? nv[0][i] : cv[0][i]; w1[i] = last ? nv[1][i] : cv[1][i]; }
            }
            const char* a2 = last ? nA : cA;
            PG8_LDB(B0, 0, 0); PG8_LDB(B1, 0, 1); PG8_SCHED; PG8_LDA(At, 0, 0); PG8_STAGE_A(PG8_SA(1, 1), k1, cv[1], cA + hstep);
            PG8_WAIT_V(8); PG8_WAIT_L(0); PG8_BAR; if (m00) PG8_MMA(0, 0, At, B0); if (m01) PG8_MMA(0, 1, At, B1); PG8_BAR; PG8_SCHED;
            PG8_LDA(At, 0, 1); PG8_STAGE_B(PG8_SB(0, 0), b2); PG8_STAGE_B(PG8_SB(0, 1), b2 + hstep); PG8_STAGE_A(PG8_SA(0, 0), k2, w0, a2);
            PG8_WAIT_V(8); PG8_WAIT_L(0); PG8_BAR; if (m10) PG8_MMA(1, 0, At, B0); if (m11) PG8_MMA(1, 1, At, B1); PG8_BAR; PG8_SCHED;
            PG8_LDB(B0, 1, 0); PG8_LDB(B1, 1, 1); PG8_SCHED; PG8_LDA(At, 1, 0); PG8_STAGE_A(PG8_SA(0, 1), k2, w1, a2 + hstep);
            PG8_WAIT_V(8); PG8_WAIT_L(0); PG8_BAR; if (m00) PG8_MMA(0, 0, At, B0); if (m01) PG8_MMA(0, 1, At, B1); PG8_BAR; PG8_SCHED;
            PG8_LDA(At, 1, 1); PG8_STAGE_B(PG8_SB(1, 0), b3); PG8_STAGE_B(PG8_SB(1, 1), b3 + hstep); PG8_STAGE_A(PG8_SA(1, 0), k3, w0, a2);
            PG8_WAIT_V(8); PG8_WAIT_L(0); PG8_BAR; if (m10) PG8_MMA(1, 0, At, B0); if (m11) PG8_MMA(1, 1, At, B1); PG8_BAR; PG8_SCHED;
        }
        if constexpr (ALIGN_EPI) { if (wr == 0) PG8_BAR; }
        if constexpr (FP8) asm volatile("s_nop 15\n\ts_nop 15" ::: "memory");
        if (!PROBE_NOEPI || cur.real) E(acc, cur, wr, wc, fr, fq);
        if (!has_next) break;
#pragma unroll
        for (int a = 0; a < 2; ++a)
#pragma unroll
            for (int b = 0; b < 2; ++b)
#pragma unroll
                for (int m = 0; m < 4; ++m)
#pragma unroll
                    for (int n = 0; n < 2; ++n) acc[a][b][m][n] = (f32x4){0.f, 0.f, 0.f, 0.f};
        cur = nxt; cB = nB; cA = nA; ++ui;
        if constexpr (GATHER) {
#pragma unroll
            for (int h = 0; h < 2; ++h)
#pragma unroll
                for (int i = 0; i < 2; ++i) cv[h][i] = nv[h][i];
        }
        if constexpr (ALIGN_EPI) { if (wr == 1) PG8_BAR; }
    }
    PG8_WAIT_V(0);
    if constexpr (!ALIGN_EPI) { if (wr == 0) PG8_BAR; }
    PG8_BAR;
#undef PG8_SA
#undef PG8_SB
#undef PG8_STAGE_A
#undef PG8_STAGE_B
#undef PG8_LDA
#undef PG8_LDB
#undef PG8_MMA
#undef PG8_WAIT_V
#undef PG8_WAIT_L
#undef PG8_BAR
#undef PG8_SCHED
}
}

struct TBlk { const float* src; int ldw; bf16_t* dst; unsigned char* dst8; };
__device__ __forceinline__ void tb_load(const TBlk& t, int lane, f32x4 (&v)[16]) {
    const float* p = t.src + (size_t)(lane >> 4) * t.ldw + (lane & 15) * 4;
#pragma unroll
    for (int i = 0; i < 16; ++i) v[i] = *(const f32x4*)(p + (size_t)(4 * i) * t.ldw);
}
__device__ __forceinline__ void tb_store(const TBlk& t, int lane, const f32x4 (&v)[16], LAS float* scr) {
#pragma unroll
    for (int i = 0; i < 16; ++i) { LAS float* d = scr + ((lane >> 4) + 4 * i) * 65 + (lane & 15) * 4; d[0] = v[i].x; d[1] = v[i].y; d[2] = v[i].z; d[3] = v[i].w; }
    asm volatile("s_waitcnt lgkmcnt(0)" ::: "memory"); __builtin_amdgcn_wave_barrier();
    const int c8 = lane & 7;
#pragma unroll
    for (int jj = 0; jj < 8; ++jj) {
        const int n = (lane >> 3) + 8 * jj; const LAS float* p = scr + (8 * c8) * 65 + n;
        if (t.dst8) { u32x2 o; o.x = pk4_fp8(p[0] * F8_SW, p[65] * F8_SW, p[2 * 65] * F8_SW, p[3 * 65] * F8_SW); o.y = pk4_fp8(p[4 * 65] * F8_SW, p[5 * 65] * F8_SW, p[6 * 65] * F8_SW, p[7 * 65] * F8_SW);
            *(u32x2*)(t.dst8 + (size_t)n * 1024 + 8 * c8) = o; }
        else { u32x4 o; o.x = pk2(p[0], p[65]); o.y = pk2(p[2 * 65], p[3 * 65]); o.z = pk2(p[4 * 65], p[5 * 65]); o.w = pk2(p[6 * 65], p[7 * 65]);
            *(u32x4*)(t.dst + (size_t)n * 1024 + 8 * c8) = o; }
    }
    asm volatile("s_waitcnt lgkmcnt(0)" ::: "memory"); __builtin_amdgcn_wave_barrier();
}

__device__ __forceinline__ void phase_prep(const Ctx& c) {
    LAS float* red = (LAS float*)c.lds;
    const float* cv = c.a->in[1]; const float* ccv = c.a->in[3]; const float* ada_w = c.a->in[4]; const float* ada_b = c.a->in[5];
    for (int item = c.wg; item < 193; item += c.nwg) {
        if (item < 192) {
            const int layer = item / 96, cb = item % 96, col = cb * 64 + c.lane;
            const float* W = ada_w + (size_t)layer * D * 6144 + col;
            float a0 = 0.f, a1 = 0.f;
            const int k0 = c.wave * 128;
#pragma unroll 32
            for (int k = 0; k < 128; ++k) { const float w = W[(size_t)(k0 + k) * 6144]; a0 += silu_f(cv[k0 + k]) * w; a1 += silu_f(ccv[k0 + k]) * w; }
            red[(0 * 8 + c.wave) * 64 + c.lane] = a0; red[(1 * 8 + c.wave) * 64 + c.lane] = a1;
            __syncthreads();
            if (c.tid < 128) {
                const int which = c.tid >> 6, l = c.tid & 63; float s = 0.f;
#pragma unroll
                for (int w = 0; w < 8; ++w) s += red[(which * 8 + w) * 64 + l];
                c.modp(layer, which)[cb * 64 + l] = s + ada_b[layer * 6144 + cb * 64 + l];
            }
            __syncthreads();
        } else {
            float* modbase = (float*)(c.ws + WS_MOD);
            for (int i = c.tid; i < 4096; i += 512) {
                const int pos = i >> 4, j = i & 15;
                const double ang = (double)pos * pow(10000.0, -(double)j / 16.0);
                modbase[MOD_ROPE + 2 * i] = (float)cos(ang); modbase[MOD_ROPE + 2 * i + 1] = (float)sin(ang);
            }
            const float* lbp = c.a->in[12];
            for (int i = c.tid; i < 2048; i += 512) { const float p0 = lbp[i], p1 = lbp[2048 + i]; modbase[MOD_LB + i] = 1.f / (1.f + __expf(p0 - p1)); }
        }
    }
}

__device__ __forceinline__ void row_load(const float* p, int lane, f32x4 (&v)[4]) {
#pragma unroll
    for (int j = 0; j < 4; ++j) v[j] = *(const f32x4*)(p + lane * 4 + 256 * j);
}
__device__ __forceinline__ float row_ss(const f32x4 (&v)[4]) {
    float s = 0.f;
#pragma unroll
    for (int j = 0; j < 4; ++j) s += v[j].x * v[j].x + v[j].y * v[j].y + v[j].z * v[j].z + v[j].w * v[j].w;
    return wave_sum(s);
}
__device__ __forceinline__ void row_modnorm_store(const f32x4 (&x)[4], float rstd, const float* g, const float* sh, const float* sc, bf16_t* out, int lane, f32x4 (*hout)[4] = nullptr) {
#pragma unroll
    for (int j = 0; j < 4; ++j) {
        const int c0 = lane * 4 + 256 * j;
        const f32x4 gv = *(const f32x4*)(g + c0), shv = *(const f32x4*)(sh + c0), scv = *(const f32x4*)(sc + c0);
        f32x4 h;
        h.x = x[j].x * rstd * gv.x * (1.f + scv.x) + shv.x; h.y = x[j].y * rstd * gv.y * (1.f + scv.y) + shv.y;
        h.z = x[j].z * rstd * gv.z * (1.f + scv.z) + shv.z; h.w = x[j].w * rstd * gv.w * (1.f + scv.w) + shv.w;
        if (hout) (*hout)[j] = h;
        u32x2 o; o.x = pk2(h.x, h.y); o.y = pk2(h.z, h.w);
        *(u32x2*)(out + c0) = o;
    }
}

__device__ __forceinline__ void phase_norm0(const Ctx& c) {
    bf16_t* H = (bf16_t*)(c.ws + WS_H); const float* ng = c.a->in[6];
    int r = c.wg * 8 + c.wave;
    f32x4 xn[4];
    if (r < R) row_load(c.xin0(r), c.lane, xn);
    for (; r < R; r += c.nwg * 8) {
        f32x4 x[4];
#pragma unroll
        for (int j = 0; j < 4; ++j) x[j] = xn[j];
        if (r + c.nwg * 8 < R) row_load(c.xin0(r + c.nwg * 8), c.lane, xn);
        const float rstd = rsqrtf(row_ss(x) * (1.f / D) + EPS);
        const float* m = c.modp(0, r < C ? 1 : 0);
        row_modnorm_store(x, rstd, ng, m + 0, m + 1024, H + (size_t)r * D, c.lane);
    }
}

namespace at {
constexpr int KP = 144, TILEB = 64 * KP;
__device__ __forceinline__ bf16x8 tr_frag2(const LAS unsigned char* tile, int row0, int col0, int lane) {
    const int q = (lane & 15) >> 2, p = lane & 3;
    const LAS unsigned char* a = tile + (row0 + q) * KP + (col0 + 4 * p) * 2;
    const v4i16_t lo = __builtin_amdgcn_ds_read_tr16_b64_v4i16((LAS v4i16_t*)a);
    const v4i16_t hi = __builtin_amdgcn_ds_read_tr16_b64_v4i16((LAS v4i16_t*)(a + 16 * KP));
    return (bf16x8){lo[0], lo[1], lo[2], lo[3], hi[0], hi[1], hi[2], hi[3]};
}
}
__device__ __forceinline__ void phase_attn(const Ctx& c) {
    using namespace at;
    const bf16_t* Q = (const bf16_t*)(c.ws + WS_Q); const bf16_t* K = (const bf16_t*)(c.ws + WS_K); const bf16_t* V = (const bf16_t*)(c.ws + WS_V);
    bf16_t* O = (bf16_t*)(c.ws + WS_O); const float* sink = c.a->in[9];
    LAS unsigned char* lds = c.lds;
    const int tid = c.tid, lane = c.lane, w = __builtin_amdgcn_readfirstlane(tid >> 6), fr = lane & 15, g = lane >> 4;
    const int lrow = tid >> 3, lch = tid & 7;
    const int nitn = c.nwg == 256 ? 2 : (264 - c.wg + c.nwg - 1) / c.nwg;
    for (int itn = 0; itn < nitn; ++itn) {
        int item = c.wg + itn * c.nwg;
        if (c.nwg == 256 && itn == 1) { const int n_ = c.wg >> 1; item = -1;
            if (n_ == 0) item = 256 + (c.wg & 1); else if (n_ == 127) item = 258 + (c.wg & 1); else if (n_ == 30 || n_ == 31) item = 260 + (c.wg - 60); }
        if (item < 0 || item >= 264) continue;
        const bool isctx = item >= 256;
        const int ci = item - 256;
        const int n = isctx ? 0 : (item >> 1), kh = isctx ? ((ci >> 1) & 1) : (item & 1), cb = isctx ? (ci >> 2) : 0;
        const int p_lo = isctx ? (ci & 1) : 0, p_hi = isctx ? (ci & 1) + 1 : 2;
        const int hq = kh * 8 + w;
        const float sink2 = sink[hq] * LOG2E;
        for (int pass = p_lo; pass < p_hi; ++pass) {
            const int t0 = 128 * n + 64 * pass, qrow0 = isctx ? cb * 128 + 64 * pass : C + t0;
            const int jlo = isctx ? 0 : (t0 >= 128 ? 0 : (128 - t0) / 64), jhi = isctx ? 0 : ((L - t0 + 128) / 64 < 5 ? (L - t0 + 128) / 64 : 5);
            const int ntile = 4 + (jhi - jlo);
            LAS unsigned char* qlds = lds + 4 * TILEB + w * TILEB;
#pragma unroll
            for (int qb = 0; qb < 4; ++qb)
#pragma unroll
                for (int ks = 0; ks < 2; ++ks) *(LAS bf16x8*)(qlds + (16 * qb + fr) * KP + (32 * ks + 8 * g) * 2) = *(const bf16x8*)(Q + (size_t)(qrow0 + 16 * qb + fr) * D + hq * 64 + 32 * ks + 8 * g);
            float mrow[4], lsum[4]; f32x4 OT[4][4];
#pragma unroll
            for (int qb = 0; qb < 4; ++qb) { mrow[qb] = sink2; lsum[qb] = 1.f;
#pragma unroll
                for (int nt = 0; nt < 4; ++nt) OT[qb][nt] = (f32x4){0.f, 0.f, 0.f, 0.f}; }
            u32x4 kreg, vreg;
#define AT_KROW(ti) ((ti) < 4 ? 64 * (ti) : C + t0 - 128 + 64 * (jlo + (ti) - 4))
#define AT_LOAD(ti) do { const size_t ro_ = (size_t)(AT_KROW(ti) + lrow) * 128 + kh * 64 + lch * 8; kreg = *(const u32x4*)(K + ro_); vreg = *(const u32x4*)(V + ro_); } while (0)
#define AT_WRITE(buf) do { *(LAS u32x4*)(lds + (buf) * 2 * TILEB + lrow * KP + lch * 16) = kreg; *(LAS u32x4*)(lds + (buf) * 2 * TILEB + TILEB + lrow * KP + lch * 16) = vreg; } while (0)
            AT_LOAD(0); AT_WRITE(0);
            __syncthreads();
            for (int ti = 0; ti < ntile; ++ti) {
                if (ti + 1 < ntile) AT_LOAD(ti + 1);
                const LAS unsigned char* kb = lds + (ti & 1) * 2 * TILEB; const LAS unsigned char* vb = kb + TILEB;
                const int jj = jlo + ti - 4; const bool masked = (ti >= 4) && (jj == 0 || jj == 4);
                const int k0 = t0 - 128 + 64 * jj;
                bf16x8 Kf[4][2];
#pragma unroll
                for (int mt = 0; mt < 4; ++mt)
#pragma unroll
                    for (int ks = 0; ks < 2; ++ks) Kf[mt][ks] = *(const LAS bf16x8*)(kb + (16 * mt + fr) * KP + (32 * ks + 8 * g) * 2);
                bf16x8 Vf[4][2];
#pragma unroll
                for (int mt = 0; mt < 4; ++mt)
#pragma unroll
                    for (int ks = 0; ks < 2; ++ks)
                        Vf[mt][ks] = tr_frag2(vb, 32 * ks + 4 * g, 16 * mt, lane);
#pragma unroll
                for (int qb = 0; qb < 4; ++qb) {
                    bf16x8 Qq[2];
#pragma unroll
                    for (int ks = 0; ks < 2; ++ks) Qq[ks] = *(const LAS bf16x8*)(qlds + (16 * qb + fr) * KP + (32 * ks + 8 * g) * 2);
                    f32x4 sa[4];
#pragma unroll
                    for (int mt = 0; mt < 4; ++mt) { sa[mt] = (f32x4){0.f, 0.f, 0.f, 0.f};
#pragma unroll
                        for (int ks = 0; ks < 2; ++ks) sa[mt] = __builtin_amdgcn_mfma_f32_16x16x32_bf16(Kf[mt][ks], Qq[ks], sa[mt], 0, 0, 0); }
                    if (masked) {
                        const int tq = t0 + 16 * qb + fr;
#pragma unroll
                        for (int mt = 0; mt < 4; ++mt)
#pragma unroll
                            for (int e = 0; e < 4; ++e) { const int dt = tq - (k0 + 16 * mt + 4 * g + e); if (dt > 128 || dt < -128) sa[mt][e] = -INFINITY; }
                    }
                    float mx = fmaxf(fmaxf(sa[0][0], sa[0][1]), fmaxf(sa[0][2], sa[0][3]));
#pragma unroll
                    for (int mt = 1; mt < 4; ++mt) mx = fmaxf(mx, fmaxf(fmaxf(sa[mt][0], sa[mt][1]), fmaxf(sa[mt][2], sa[mt][3])));
                    mx = fmaxf(mx, __shfl_xor(mx, 16)); mx = fmaxf(mx, __shfl_xor(mx, 32));
                    const float mn = fmaxf(mrow[qb], mx), alpha = __builtin_amdgcn_exp2f(mrow[qb] - mn);
                    mrow[qb] = mn;
                    float rs = 0.f;
#pragma unroll
                    for (int mt = 0; mt < 4; ++mt)
#pragma unroll
                        for (int e = 0; e < 4; ++e) { const float pv = __builtin_amdgcn_exp2f(sa[mt][e] - mn); sa[mt][e] = pv; rs += pv; }
                    rs += __shfl_xor(rs, 16); rs += __shfl_xor(rs, 32);
                    lsum[qb] = lsum[qb] * alpha + rs;
                    bf16x8 Pb[2];
#pragma unroll
                    for (int ks = 0; ks < 2; ++ks) { const f32x4 a0 = sa[2 * ks], a1 = sa[2 * ks + 1];
                        const u32x4 pk = (u32x4){pk2(a0[0], a0[1]), pk2(a0[2], a0[3]), pk2(a1[0], a1[1]), pk2(a1[2], a1[3])}; Pb[ks] = __builtin_bit_cast(bf16x8, pk); }
#pragma unroll
                    for (int nt = 0; nt < 4; ++nt) { OT[qb][nt] = OT[qb][nt] * alpha;
#pragma unroll
                        for (int ks = 0; ks < 2; ++ks) OT[qb][nt] = __builtin_amdgcn_mfma_f32_16x16x32_bf16(Vf[nt][ks], Pb[ks], OT[qb][nt], 0, 0, 0); }
                }
                if (ti + 1 < ntile) AT_WRITE((ti + 1) & 1);
                __syncthreads();
            }
#undef AT_KROW
#undef AT_LOAD
#undef AT_WRITE
#pragma unroll
            for (int qb = 0; qb < 4; ++qb) {
                const float il = 1.f / lsum[qb];
                bf16_t* op = O + (size_t)(qrow0 + 16 * qb + fr) * D + hq * 64 + 4 * g;
#pragma unroll
                for (int nt = 0; nt < 4; ++nt) { const f32x4 v = OT[qb][nt] * il; u32x2 o; o.x = pk2(v[0], v[1]); o.y = pk2(v[2], v[3]); *(u32x2*)(op + 16 * nt) = o; }
            }
        }
    }
}

template <int GS>
__device__ __forceinline__ void phase_postmix(const Ctx& c, int layer, bool route) {
    const float* Y = (const float*)(c.ws + WS_RAW1); unsigned char* H8 = c.ws + WS_H8;
    float* Xout = (float*)(c.ws + (layer == 0 ? WS_X : WS_X1)); const float* Xprev = (const float*)(c.ws + WS_X);
    const float* ng = c.a->in[6] + layer * 4 * D; const float* Wr = c.a->in[15] + (size_t)layer * D * NE; const float* br = c.a->in[16] + layer * NE;
    unsigned* cnt = (unsigned*)(c.ws + WS_CTL) + CW_CNT + layer * NE;
    int* tk_e = (int*)(c.ws + WS_TK); float* tk_g = (float*)(c.ws + WS_TK) + R * 4; int* tk_slot = (int*)(c.ws + WS_TK) + 2 * R * 4;
    int* list = (int*)(c.ws + WS_LIST);
    LAS float* WL = (LAS float*)c.lds;
    LAS float* biasp = (LAS float*)(c.lds + 131072);
    LAS unsigned* lcnt = (LAS unsigned*)(c.lds + 145920); LAS unsigned* lbase = lcnt + 32; LAS float* rsx = (LAS float*)(lcnt + 64);
    LAS float* pvA = (LAS float*)(c.lds + 131072 + 2560); LAS float* pvB = pvA + 1024; LAS float* pvS = pvB + 1024;
    const int lane = c.lane, w = __builtin_amdgcn_readfirstlane(c.tid >> 6), fr = lane & 15, g = lane >> 4;
    constexpr int RP = GS / 8, NW2 = GS / 16;
    const int g_lo = layer == 0 ? 0 : C / GS;
    for (int grp = g_lo + c.wg; grp < R / GS; grp += c.nwg) {
        const int which = grp * GS < C ? 1 : 0;
        const float* m = c.modp(layer, which);
        __syncthreads();
        if (c.tid < NE) lcnt[c.tid] = 0u;
#pragma unroll 4
        for (int j = 0; j < 16; ++j) {
            const int i4 = c.tid + 512 * j, k = i4 >> 3, e0 = (i4 & 7) * 4;
            const f32x4 wv = *(const f32x4*)(Wr + (size_t)k * NE + e0); const float sc = ng[2 * D + k] * (1.f + m[4096 + k]);
            LAS float* dst = WL + ((((k >> 4) * 4 + (k & 3)) * 4 + ((k >> 2) & 3)) * 16) * 2;
#pragma unroll
            for (int q = 0; q < 4; ++q) { const int e = e0 + q; dst[(e & 15) * 2 + (e >> 4)] = wv[q] * sc; }
        }
        for (int k = c.tid; k < D; k += 512) { pvA[k] = m[2048 + k] * ng[D + k]; pvB[k] = ng[2 * D + k] * (1.f + m[4096 + k]); pvS[k] = m[3072 + k]; }
        { const int e = c.tid & 31, part = c.tid >> 5; float sacc = 0.f;
#pragma unroll 16
          for (int k = part * 64; k < part * 64 + 64; ++k) sacc += m[3072 + k] * Wr[k * NE + e];
          biasp[32 + part * 32 + e] = sacc; }
        __syncthreads();
        if (c.tid < 32) { float sacc = br[c.tid];
#pragma unroll
            for (int p = 0; p < 16; ++p) sacc += biasp[32 + p * 32 + c.tid]; biasp[c.tid] = sacc; }
        __syncthreads();
        const int row1 = grp * GS + w * RP;
        f32x4 yn[4], xn[4];
        row_load(Y + (size_t)(layer == 0 ? row1 : row1 - C) * D, lane, yn); row_load(layer == 0 ? c.xin0(row1) : Xprev + (size_t)row1 * D, lane, xn);
        for (int i = 0; i < RP; ++i) {
            const int r = row1 + i;
            f32x4 y[4], x[4];
#pragma unroll
            for (int j = 0; j < 4; ++j) { y[j] = yn[j]; x[j] = xn[j]; }
            if (i + 1 < RP) { row_load(Y + (size_t)(layer == 0 ? r + 1 : r + 1 - C) * D, lane, yn); row_load(layer == 0 ? c.xin0(r + 1) : Xprev + (size_t)(r + 1) * D, lane, xn); }
            const float rstd_y = rsqrtf(row_ss(y) * (1.f / D) + EPS);
#pragma unroll
            for (int j = 0; j < 4; ++j) {
                const int c0 = lane * 4 + 256 * j;
                x[j] += *(const LAS f32x4*)(pvA + c0) * (y[j] * rstd_y);
                *(f32x4*)(Xout + (size_t)r * D + c0) = x[j];
            }
            const float rstd_x = rsqrtf(row_ss(x) * (1.f / D) + EPS);
#pragma unroll
            for (int j = 0; j < 4; ++j) {
                const int c0 = lane * 4 + 256 * j;
                const f32x4 hv = x[j] * rstd_x * *(const LAS f32x4*)(pvB + c0) + *(const LAS f32x4*)(pvS + c0);
                *(unsigned*)(H8 + (size_t)r * D + c0) = pk4_fp8(hv[0] * F8_SH, hv[1] * F8_SH, hv[2] * F8_SH, hv[3] * F8_SH);
            }
            if (lane == 0) rsx[w * RP + i] = rstd_x;
        }
        asm volatile("s_waitcnt vmcnt(0)" ::: "memory");
        __syncthreads();
        const int row0 = grp * GS + w * 16; const bool w2 = w < NW2;
        f32x4 la[2]; la[0] = (f32x4){0.f, 0.f, 0.f, 0.f}; la[1] = la[0];
        if (w2) {
            const float* ap = Xout + (size_t)(row0 + fr) * D + 4 * g;
            const LAS float* bp = WL + (g * 16 + fr) * 2;
#pragma unroll 4
            for (int k4 = 0; k4 < 64; ++k4) {
                const f32x4 a4 = *(const f32x4*)(ap + 16 * k4);
#pragma unroll
                for (int q = 0; q < 4; ++q) {
                    const f32x2 b2 = *(const LAS f32x2*)(bp + (size_t)(4 * k4 + q) * 128);
                    la[0] = __builtin_amdgcn_mfma_f32_16x16x4f32(a4[q], b2[0], la[0], 0, 0, 0);
                    la[1] = __builtin_amdgcn_mfma_f32_16x16x4f32(a4[q], b2[1], la[1], 0, 0, 0);
                }
            }
        }
        float tv[4][4]; int te[4][4];
#pragma unroll
        for (int e = 0; e < 4; ++e) {
            const float rs = rsx[(w2 ? w * 16 : 0) + 4 * g + e];
            float v0 = la[0][e] * rs + biasp[fr], v1 = la[1][e] * rs + biasp[16 + fr];
#pragma unroll
            for (int k = 0; k < 4; ++k) {
                float bv; int bi;
                if (v0 >= v1) { bv = v0; bi = fr; } else { bv = v1; bi = 16 + fr; }
#pragma unroll
                for (int o = 8; o > 0; o >>= 1) {
                    const float ov = __shfl_xor(bv, o); const int oi = __shfl_xor(bi, o);
                    if (ov > bv || (ov == bv && oi < bi)) { bv = ov; bi = oi; }
                }
                tv[e][k] = bv; te[e][k] = bi;
                if (bi == fr) v0 = -INFINITY;
                if (bi == 16 + fr) v1 = -INFINITY;
            }
        }
        float v[4]; int ex[4]; unsigned sl[4];
#pragma unroll
        for (int k = 0; k < 4; ++k) { v[k] = tv[0][k]; ex[k] = te[0][k];
#pragma unroll
            for (int e = 1; e < 4; ++e) if (fr == e) { v[k] = tv[e][k]; ex[k] = te[e][k]; } }
        if (fr < 4 && route && w2) {
#pragma unroll
            for (int k = 0; k < 4; ++k) sl[k] = __hip_atomic_fetch_add(lcnt + ex[k], 1u, __ATOMIC_RELAXED, __HIP_MEMORY_SCOPE_WORKGROUP);
        }
        __syncthreads();
        if (c.tid < NE && route) { const unsigned n = lcnt[c.tid]; lbase[c.tid] = n ? atomicAdd(&cnt[c.tid], n) : 0u; }
        __syncthreads();
        if (fr < 4 && route && w2) {
            const int r = row0 + 4 * g + fr;
            const float e1 = __expf(v[1] - v[0]), e2 = __expf(v[2] - v[0]), e3 = __expf(v[3] - v[0]);
            const float inv = 1.f / (1.f + e1 + e2 + e3);
            const float gk[4] = {inv, e1 * inv, e2 * inv, e3 * inv};
#pragma unroll
            for (int k = 0; k < 4; ++k) {
                const unsigned slot = lbase[ex[k]] + sl[k];
                list[(size_t)ex[k] * R + slot] = r;
                tk_e[r * 4 + k] = ex[k]; tk_g[r * 4 + k] = gk[k]; tk_slot[r * 4 + k] = (int)slot;
            }
        }
    }
}

__device__ __forceinline__ void moe_offsets(const Ctx& c, int layer, LAS int* so) {
    const unsigned* cnt = (const unsigned*)(c.ws + WS_CTL) + CW_CNT + layer * NE;
    __syncthreads();
    if (c.tid < 64) {
        const int n = c.tid < NE ? (int)cnt[c.tid] : 0; int pad = (n + PADM - 1) / PADM * PADM, inc = pad;
#pragma unroll
        for (int o = 1; o < 32; o <<= 1) { const int t = __shfl_up(inc, o); if (c.lane >= o) inc += t; }
        if (c.tid < NE) { so[c.tid] = inc - pad; so[64 + c.tid] = n; }
        if (c.tid == NE - 1) so[32] = inc;
    }
    __syncthreads();
}

__device__ __forceinline__ void moe_tables(const Ctx& c, int layer, LAS int* tb) {
    const unsigned* cnt = (const unsigned*)(c.ws + WS_CTL) + CW_CNT + layer * NE;
    __syncthreads();
    if (c.tid < 64) {
        const int n = c.tid < NE ? (int)cnt[c.tid] : 0; int tiles = (n + PADM - 1) / PADM, inc = tiles;
#pragma unroll
        for (int o = 1; o < 32; o <<= 1) { const int t = __shfl_up(inc, o); if (c.lane >= o) inc += t; }
        if (c.tid < NE) { tb[c.tid] = inc - tiles; tb[64 + c.tid] = n; }
        if (c.tid == NE - 1) tb[32] = inc;
    }
    __syncthreads();
}
__device__ __forceinline__ int vcu_of(const Ctx& c) { return (c.nwg % 8 == 0) ? (c.wg % 8) * (c.nwg / 8) + c.wg / 8 : c.wg; }
__device__ __forceinline__ void phase_moe_gu(const Ctx& c, int layer) {
    LAS int* tb = (LAS int*)(c.lds + 131072 + 1024);
    moe_tables(c, layer, tb);
    pg8::Gemm g{c.ws + WS_H8, c.ws + WS_WGU + (size_t)layer * NE * 2048 * 1024, (size_t)2048 * 1024, (const int*)(c.ws + WS_LIST)};
    pg8::MoeOrder S{tb, tb + 64, 8, c.nwg, vcu_of(c), false};
    pg8::EpiSwiglu E{c.ws + WS_HDN, c.a->in[18] + (size_t)layer * NE * 2048};
    pg8::gemm_phase<pg8::EpiSwiglu, pg8::MoeOrder, true, true, true>(c.lds, g, S, E, c.tid);
}
__device__ __forceinline__ void phase_moe_dn(const Ctx& c, int layer) {
    LAS int* tb = (LAS int*)(c.lds + 131072 + 1024);
    moe_tables(c, layer, tb);
    pg8::Gemm g{c.ws + WS_HDN, c.ws + WS_WDN + (size_t)layer * NE * 1024 * 1024, (size_t)1024 * 1024, nullptr};
    pg8::MoeOrder S{tb, tb + 64, 4, c.nwg, vcu_of(c), true};
    pg8::EpiBf16Bias E{(bf16_t*)(c.ws + WS_OUTB), c.a->in[20] + (size_t)layer * NE * 1024, 1024, 1.f / (F8_SHD * F8_SW)};
    pg8::gemm_phase<pg8::EpiBf16Bias, pg8::MoeOrder, true, false, true>(c.lds, g, S, E, c.tid);
}
__device__ __forceinline__ void phase_gemm_f32(const Ctx& c, const bf16_t* A, int M, const bf16_t* Bt, int N, const float* bias, float* Cout) {
    pg8::Gemm g{A, Bt, 0, nullptr}; pg8::StaticOrder S; S.init(M, N, c.nwg, c.wg);
    pg8::EpiF32 E{Cout, N, bias};
    pg8::gemm_phase<pg8::EpiF32, pg8::StaticOrder, true, false, false>(c.lds, g, S, E, c.tid);
}

__device__ __forceinline__ void phase_gemm_qkv(const Ctx& c) {
    pg8::Gemm g{(const bf16_t*)(c.ws + WS_H), (const bf16_t*)(c.ws + WS_WQKV), 0, nullptr}; pg8::StaticOrder S; S.init(R, QKVD, c.nwg, c.wg);
    pg8::EpiQKV E{(bf16_t*)(c.ws + WS_Q), (bf16_t*)(c.ws + WS_K), (bf16_t*)(c.ws + WS_V), c.a->in[8], (const float*)(c.ws + WS_MOD) + MOD_ROPE};
    pg8::gemm_phase<pg8::EpiQKV, pg8::StaticOrder, true, false, false>(c.lds, g, S, E, c.tid);
}
__device__ __forceinline__ void phase_gemm_inproj(const Ctx& c) {
    pg8::Gemm g{c.ws + WS_H8, c.ws + WS_WIN, 0, nullptr}; pg8::StaticOrder S; S.init(R, HIN, c.nwg, c.wg);
    pg8::EpiInProj E{(bf16_t*)(c.ws + WS_QH), (_Float16*)(c.ws + WS_KF), (_Float16*)(c.ws + WS_KB), (bf16_t*)(c.ws + WS_IV), (bf16_t*)(c.ws + WS_SG), (const float*)(c.ws + WS_MOD) + MOD_LB, 1.f / (F8_SH * F8_SW)};
    pg8::gemm_phase<pg8::EpiInProj, pg8::StaticOrder, true, false, true>(c.lds, g, S, E, c.tid);
}

__device__ __forceinline__ void phase_norm0(const Ctx& c);
constexpr int CONV_A = 20 * 16 + 16 * 16 + 80 * 16 + 16 * 16, CONV_B = 32 * 32 * 16 + 32 * 16 * 16, CONV_CHUNK = 64;
__device__ __forceinline__ TBlk convert_item(const Ctx& c, int it, int part) {
    constexpr int I_QKV = 20 * 16, I_O = 16 * 16, I_IN = 80 * 16, I_HO = 16 * 16, I_GU = 32 * 32 * 16;
    int r = it; TBlk t; t.dst8 = nullptr; t.dst = nullptr;
    if (part == 0) {
        if (r < I_QKV) { const int nb = r % 20, kb = r / 20; t.src = c.a->in[7] + (size_t)kb * 64 * QKVD + nb * 64; t.ldw = QKVD; t.dst = (bf16_t*)(c.ws + WS_WQKV) + (size_t)nb * 64 * 1024 + kb * 64; return t; } r -= I_QKV;
        if (r < I_O) { const int nb = r % 16, kb = r / 16; t.src = c.a->in[10] + (size_t)kb * 64 * D + nb * 64; t.ldw = D; t.dst = (bf16_t*)(c.ws + WS_WO) + (size_t)nb * 64 * 1024 + kb * 64; return t; } r -= I_O;
        if (r < I_IN) { const int nb = r % 80, kb = r / 80; t.src = c.a->in[11] + (size_t)kb * 64 * HIN + nb * 64; t.ldw = HIN; t.dst8 = c.ws + WS_WIN + (size_t)nb * 64 * 1024 + kb * 64; return t; } r -= I_IN;
        if (r < I_HO) { const int nb = r % 16, kb = r / 16; t.src = c.a->in[14] + (size_t)kb * 64 * D + nb * 64; t.ldw = D; t.dst = (bf16_t*)(c.ws + WS_WHO) + (size_t)nb * 64 * 1024 + kb * 64; return t; } r -= I_HO;
    }
    const int moff = (part - 1) * 32;
    if (r < I_GU) { const int mat = moff + r / 512, rr = r % 512, nb = rr % 32, kb = rr / 32; const int n0 = ((nb & 3) >> 1) * 1024 + (nb >> 2) * 128 + (nb & 1) * 64;
        t.src = c.a->in[17] + (size_t)mat * 1024 * 2048 + (size_t)kb * 64 * 2048 + n0; t.ldw = 2048; t.dst8 = c.ws + WS_WGU + ((size_t)mat * 2048 + nb * 64) * 1024 + kb * 64; return t; } r -= I_GU;
    { const int mat = moff + r / 256, rr = r % 256, nb = rr % 16, kb = rr / 16;
        t.src = c.a->in[19] + (size_t)mat * 1024 * 1024 + (size_t)kb * 64 * 1024 + nb * 64; t.ldw = 1024; t.dst8 = c.ws + WS_WDN + ((size_t)mat * 1024 + nb * 64) * 1024 + kb * 64; }
    return t;
}
__device__ __forceinline__ void convert_run(const Ctx& c, int part, int first, int step, int end, LAS float* scr) {
    f32x4 va[16], vb[16];
    int it = first;
    TBlk ta, tbk;
    if (it < end) { ta = convert_item(c, it, part); tb_load(ta, c.lane, va); }
    for (; it < end; it += 2 * step) {
        const bool hb = it + step < end;
        if (hb) { tbk = convert_item(c, it + step, part); tb_load(tbk, c.lane, vb); }
        tb_store(ta, c.lane, va, scr);
        const bool ha = it + 2 * step < end;
        if (ha) { ta = convert_item(c, it + 2 * step, part); tb_load(ta, c.lane, va); }
        if (hb) tb_store(tbk, c.lane, vb, scr);
    }
}
__device__ __forceinline__ void convert_steal(const Ctx& c, int part) {
    LAS float* scr = (LAS float*)c.lds + c.wave * (64 * 65);
    LAS int* chp = (LAS int*)(c.lds + 8 * 64 * 65 * 4);
    unsigned* ctr = (unsigned*)(c.ws + WS_CTL) + CW_CONV + 64 * part;
    for (;;) {
        __syncthreads();
        if (c.tid == 0) *chp = (int)atomicAdd(ctr, 1u);
        __syncthreads();
        const int ch = *chp;
        if (ch >= CONV_B / CONV_CHUNK) break;
        convert_run(c, part, ch * CONV_CHUNK + c.wave, 8, (ch + 1) * CONV_CHUNK, scr);
    }
}
__device__ __forceinline__ void phase_convert(const Ctx& c) {
    LAS float* scr = (LAS float*)c.lds + c.wave * (64 * 65);
    convert_run(c, 0, c.wg * 8 + c.wave, c.nwg * 8, CONV_A, scr);
    __syncthreads();
    phase_norm0(c);
}

__device__ __forceinline__ void phase_combine(const Ctx& c, int layer) {
    LAS int* so = (LAS int*)(c.lds + 32768);
    moe_offsets(c, layer, so);
    const bf16_t* outb = (const bf16_t*)(c.ws + WS_OUTB); float* X = (float*)(c.ws + WS_X); bf16_t* H = (bf16_t*)(c.ws + WS_H);
    const float* Xin = layer == 0 ? X : (const float*)(c.ws + WS_X1);
    const float* ngl = c.a->in[6] + layer * 4 * D;
    const int* tk_e = (const int*)(c.ws + WS_TK); const float* tk_g = (const float*)(c.ws + WS_TK) + R * 4; const int* tk_slot = (const int*)(c.ws + WS_TK) + 2 * R * 4;
    const int r_lo = layer == 0 ? 0 : C, stride = c.nwg * 8;
    int r = r_lo + c.wg * 8 + c.wave;
    int pe[4], ps[4]; float pg[4]; u32x2 wn[4][4]; f32x4 xn[4]; float gn[4];
#define CB_TK(row) do { _Pragma("unroll") for (int k = 0; k < 4; ++k) { pe[k] = tk_e[(row) * 4 + k]; ps[k] = tk_slot[(row) * 4 + k]; pg[k] = tk_g[(row) * 4 + k]; } } while (0)
#define CB_DATA(row) do { _Pragma("unroll") for (int k = 0; k < 4; ++k) { const bf16_t* src_ = outb + (size_t)(so[pe[k]] + ps[k]) * 1024; gn[k] = pg[k]; \
        _Pragma("unroll") for (int j = 0; j < 4; ++j) wn[k][j] = *(const u32x2*)(src_ + c.lane * 4 + 256 * j); } row_load(Xin + (size_t)(row) * D, c.lane, xn); } while (0)
    if (r < R) { CB_TK(r); CB_DATA(r); }
    if (r + stride < R) CB_TK(r + stride);
    for (; r < R; r += stride) {
        const float* m = c.modp(layer, r < C ? 1 : 0);
        f32x4 y[4], x[4];
#pragma unroll
        for (int j = 0; j < 4; ++j) { y[j] = (f32x4){0.f, 0.f, 0.f, 0.f}; x[j] = xn[j]; }
#pragma unroll
        for (int k = 0; k < 4; ++k)
#pragma unroll
            for (int j = 0; j < 4; ++j) { const u32x2 w = wn[k][j]; y[j] += (f32x4){bflo(w.x), bfhi(w.x), bflo(w.y), bfhi(w.y)} * gn[k]; }
        if (r + stride < R) CB_DATA(r + stride);
        if (r + 2 * stride < R) CB_TK(r + 2 * stride);
        const float rstd_y = rsqrtf(row_ss(y) * (1.f / D) + EPS);
#pragma unroll
        for (int j = 0; j < 4; ++j) {
            const int c0 = c.lane * 4 + 256 * j;
            const f32x4 g2 = *(const f32x4*)(m + 5120 + c0), n3 = *(const f32x4*)(ngl + 3 * D + c0);
            x[j].x += g2.x * (y[j].x * rstd_y * n3.x); x[j].y += g2.y * (y[j].y * rstd_y * n3.y);
            x[j].z += g2.z * (y[j].z * rstd_y * n3.z); x[j].w += g2.w * (y[j].w * rstd_y * n3.w);
            if (layer == 0) *(f32x4*)(X + (size_t)r * D + c0) = x[j];
            else *(f32x4*)(c.a->out + (size_t)(r - C) * D + c0) = x[j];
        }
        if (layer == 0) {
            const float rstd_x = rsqrtf(row_ss(x) * (1.f / D) + EPS);
            const float* m1 = c.modp(1, r < C ? 1 : 0); const float* g0 = c.a->in[6] + 4 * D;
#pragma unroll
            for (int j = 0; j < 4; ++j) {
                const int c0 = c.lane * 4 + 256 * j;
                const f32x4 gv = *(const f32x4*)(g0 + c0), shv = *(const f32x4*)(m1 + c0), scv = *(const f32x4*)(m1 + 1024 + c0);
                const f32x4 hv = x[j] * rstd_x * gv * (scv + 1.f) + shv;
                *(unsigned*)(c.ws + WS_H8 + (size_t)r * D + c0) = pk4_fp8(hv[0] * F8_SH, hv[1] * F8_SH, hv[2] * F8_SH, hv[3] * F8_SH);
            }
        }
    }
#undef CB_TK
#undef CB_DATA
}

namespace hg {
typedef _Float16 h2_t __attribute__((ext_vector_type(2)));
constexpr int TB = 272, PB = 144;
constexpr int TILE = 64 * TB;
constexpr int T_QD = 0, T_QC = TILE, T_KD = 2 * TILE, T_KE = 3 * TILE, T_KC = 4 * TILE, T_V0 = 5 * TILE, T_V1 = 6 * TILE;
constexpr int T_QL1 = 7 * TILE, T_KL1 = T_QL1 + 16 * TB, T_P = T_KL1 + 16 * TB, T_TOT = T_P + 64 * PB, T_CT = T_TOT + 4096, T_END = T_CT + 512;
static_assert(T_END <= LDS_BYTES - 64, "hgrn scan LDS map");
__device__ __forceinline__ int row_of(int dir, int p) { return p < C ? (dir ? C - 1 - p : p) : (dir ? C + (L - 1 - (p - C)) : p); }
__device__ __forceinline__ int seg_of(int ch) { return ch < 68 ? ch / 17 : 4 + (ch - 68) / 16; }
__device__ __forceinline__ bf16x8 tr_frag(const LAS unsigned char* tile, int row0, int col0, int lane) {
    const int q = (lane & 15) >> 2, p = lane & 3;
    const LAS unsigned char* a = tile + (row0 + q) * TB + (col0 + 4 * p) * 2;
    const v4i16_t lo = __builtin_amdgcn_ds_read_tr16_b64_v4i16((LAS v4i16_t*)a);
    const v4i16_t hi = __builtin_amdgcn_ds_read_tr16_b64_v4i16((LAS v4i16_t*)(a + 4 * TB));
    return (bf16x8){lo[0], lo[1], lo[2], lo[3], hi[0], hi[1], hi[2], hi[3]};
}
}

__device__ __forceinline__ void phase_hgrn_scan(const Ctx& c) {
    using namespace hg;
#define HG_BAR() asm volatile("s_waitcnt lgkmcnt(0)\n\ts_barrier" ::: "memory")
    const bf16_t* QH = (const bf16_t*)(c.ws + WS_QH); const bf16_t* IV = (const bf16_t*)(c.ws + WS_IV);
    LAS unsigned char* lds = c.lds;
    const int tid = c.tid, lane = c.lane, w = __builtin_amdgcn_readfirstlane(tid >> 6), fr = lane & 15, g = lane >> 4;
    for (int item_ = c.wg; item_ < 256 * SCAN_REP; item_ += c.nwg) {
        const int item = item_ & 255;
        const int chain = item >> 4, seg = item & 15, head = chain >> 1, dir = chain & 1, hc = head * 128;
        const int c0 = seg < 4 ? 17 * seg : 68 + 16 * (seg - 4), nch = seg < 4 ? 17 : 16;
        const _Float16* KX = (const _Float16*)(c.ws + (dir ? WS_KB : WS_KF));
        float* OL = (float*)(c.ws + (dir ? WS_OB : WS_OF)); bf16_t* QS = (bf16_t*)(c.ws + (dir ? WS_QSB : WS_QSF));
        HG_BAR();
        for (int i = tid; i < 64 * PB / 4; i += 512) ((LAS unsigned*)(lds + T_P))[i] = 0u;
        f32x4 Sacc[8];
#pragma unroll
        for (int m = 0; m < 8; ++m) Sacc[m] = (f32x4){0.f, 0.f, 0.f, 0.f};
        float dseg0 = 1.f, dseg1 = 1.f;
        unsigned kraw[8], qraw[8]; u32x4 vraw[2];
#define HG_LOAD(cidx) do { const int p0_ = 64 * (cidx); const bool lat_ = (cidx) >= 4; \
        _Pragma("unroll") for (int i = 0; i < 8; ++i) { const int r_ = row_of(dir, p0_ + 8 * w + i); \
            kraw[i] = *(const unsigned*)(KX + (size_t)r_ * D + hc + 2 * lane); \
            qraw[i] = lat_ ? *(const unsigned*)(QH + (size_t)(r_ - C) * D + hc + 2 * lane) : 0u; } \
        _Pragma("unroll") for (int i = 0; i < 2; ++i) { const int idx_ = tid + 512 * i; const int r_ = row_of(dir, p0_ + (idx_ >> 4)); \
            vraw[i] = *(const u32x4*)(IV + (size_t)r_ * D + hc + (idx_ & 15) * 8); } } while (0)
        HG_LOAD(c0);
        for (int ci = 0; ci < nch; ++ci) {
            const int cidx = c0 + ci; const bool lat = cidx >= 4;
            const int vbuf = (ci & 1) ? T_V1 : T_V0;
            float kf[8][2], qf[8][2], cp[8][2];
            {
                float p0 = 1.f, p1 = 1.f;
#pragma unroll
                for (int i = 0; i < 8; ++i) {
                    const h2_t hv = __builtin_bit_cast(h2_t, kraw[i]);
                    kf[i][0] = (float)hv[0]; kf[i][1] = (float)hv[1];
                    qf[i][0] = bflo(qraw[i]); qf[i][1] = bfhi(qraw[i]);
                    p0 *= (1.f - kf[i][0]); p1 *= (1.f - kf[i][1]); cp[i][0] = p0; cp[i][1] = p1;
                }
                *(LAS f32x2*)(lds + T_TOT + (w * 128 + 2 * lane) * 4) = (f32x2){p0, p1};
#pragma unroll
                for (int i = 0; i < 2; ++i) { const int idx = tid + 512 * i; *(LAS u32x4*)(lds + vbuf + (idx >> 4) * TB + (idx & 15) * 16) = vraw[i]; }
            }
            HG_BAR();
            {
                f32x2 T[8];
#pragma unroll
                for (int x = 0; x < 8; ++x) T[x] = *(const LAS f32x2*)(lds + T_TOT + (x * 128 + 2 * lane) * 4);
                const int I = w >> 1, hh = w & 1;
                f32x2 bd[4];
#pragma unroll
                for (int x = 0; x < 4; ++x) bd[x] = T[2 * x] * T[2 * x + 1];
                f32x2 pre = (f32x2){1.f, 1.f}, cum = (f32x2){1.f, 1.f}, suf = (f32x2){1.f, 1.f}, bdI = (f32x2){1.f, 1.f};
#pragma unroll
                for (int x = 0; x < 8; ++x) if (hh && x == w - 1) pre = T[x];
#pragma unroll
                for (int x = 0; x < 4; ++x) { if (x < I) cum = cum * bd[x]; if (x > I) suf = suf * bd[x]; if (x == I) bdI = bd[x]; }
                const f32x2 ctot = (bd[0] * bd[1]) * (bd[2] * bd[3]);
#pragma unroll
                for (int i = 0; i < 8; ++i) {
                    const int tau = 8 * w + i;
                    float QDv[2], KDv[2], KEv[2], QCv[2], KCv[2];
#pragma unroll
                    for (int x = 0; x < 2; ++x) {
                        const float eq = pre[x] * cp[i][x], rc = __builtin_amdgcn_rcpf(eq);
                        QDv[x] = qf[i][x] * eq; KDv[x] = kf[i][x] * rc; KEv[x] = KDv[x] * bdI[x]; QCv[x] = QDv[x] * cum[x]; KCv[x] = KEv[x] * suf[x];
                    }
                    const int to = tau * TB + lane * 4;
                    *(LAS unsigned*)(lds + T_QD + to) = pk2(QDv[0], QDv[1]);
                    *(LAS unsigned*)(lds + T_KD + to) = pk2(KDv[0], KDv[1]);
                    *(LAS unsigned*)(lds + T_KE + to) = pk2(KEv[0], KEv[1]);
                    *(LAS unsigned*)(lds + T_QC + to) = pk2(QCv[0], QCv[1]);
                    *(LAS unsigned*)(lds + T_KC + to) = pk2(KCv[0], KCv[1]);
                    if (I == 3) *(LAS unsigned*)(lds + T_QL1 + (tau - 48) * TB + lane * 4) = pk2(QDv[0] * bd[2][0], QDv[1] * bd[2][1]);
                    if (I == 0) *(LAS unsigned*)(lds + T_KL1 + tau * TB + lane * 4) = pk2(KEv[0] * bd[1][0], KEv[1] * bd[1][1]);
                    if (lat) { const int r = row_of(dir, 64 * cidx + tau); *(unsigned*)(QS + (size_t)(r - C) * D + hc + 2 * lane) = pk2(QCv[0] * dseg0, QCv[1] * dseg1); }
                }
                dseg0 *= ctot[0]; dseg1 *= ctot[1];
                if (w == 0) *(LAS f32x2*)(lds + T_CT + lane * 8) = ctot;
            }
            HG_BAR();
            if (ci + 1 < nch) HG_LOAD(cidx + 1);
            if (lat) {
                const int nblk = w >= 6 ? 2 : 1;
                for (int b = 0; b < nblk; ++b) {
                    int I, J, qoff, qrow, koff, krow; bool diag = false;
                    if (w < 4) { I = 2 + (w >> 1); J = w & 1; qoff = (w >> 1) ? T_QL1 : T_QD; qrow = (w >> 1) ? 0 : 32; koff = (w & 1) ? T_KE : T_KL1; krow = (w & 1) ? 16 : 0; }
                    else if (w == 4) { I = 1; J = 0; qoff = T_QD; qrow = 16; koff = T_KE; krow = 0; }
                    else if (w == 5) { I = 3; J = 2; qoff = T_QD; qrow = 48; koff = T_KE; krow = 32; }
                    else { I = 2 * (w - 6) + b; J = I; qoff = T_QD; qrow = 16 * I; koff = T_KD; krow = 16 * I; diag = true; }
                    f32x4 pa = (f32x4){0.f, 0.f, 0.f, 0.f};
#pragma unroll
                    for (int ks = 0; ks < 4; ++ks) {
                        const bf16x8 av = *(const LAS bf16x8*)(lds + qoff + (qrow + fr) * TB + (32 * ks + 8 * g) * 2);
                        const bf16x8 bv = *(const LAS bf16x8*)(lds + koff + (krow + fr) * TB + (32 * ks + 8 * g) * 2);
                        pa = __builtin_amdgcn_mfma_f32_16x16x32_bf16(av, bv, pa, 0, 0, 0);
                    }
#pragma unroll
                    for (int e = 0; e < 4; ++e) {
                        const int tl = 4 * g + e; const float val = (diag && fr > tl) ? 0.f : pa[e];
                        *(LAS bf16_t*)(lds + T_P + (16 * I + tl) * PB + (16 * J + fr) * 2) = (bf16_t)f2bf(val);
                    }
                }
            }
            f32x4 oacc[4];
#pragma unroll
            for (int m = 0; m < 4; ++m) oacc[m] = (f32x4){0.f, 0.f, 0.f, 0.f};
            if (lat) {
                bf16x8 Sb[4];
#pragma unroll
                for (int ks = 0; ks < 4; ++ks) {
                    const f32x4 a0 = Sacc[2 * ks], a1 = Sacc[2 * ks + 1];
                    const u32x4 pk = (u32x4){pk2(a0[0], a0[1]), pk2(a0[2], a0[3]), pk2(a1[0], a1[1]), pk2(a1[2], a1[3])};
                    Sb[ks] = __builtin_bit_cast(bf16x8, pk);
                }
#pragma unroll
                for (int m = 0; m < 4; ++m)
#pragma unroll
                    for (int ks = 0; ks < 4; ++ks) {
                        const u32x2 lo = *(const LAS u32x2*)(lds + T_QC + (16 * m + fr) * TB + (32 * ks + 4 * g) * 2);
                        const u32x2 hi = *(const LAS u32x2*)(lds + T_QC + (16 * m + fr) * TB + (32 * ks + 16 + 4 * g) * 2);
                        const u32x4 pk = (u32x4){lo.x, lo.y, hi.x, hi.y};
                        oacc[m] = __builtin_amdgcn_mfma_f32_16x16x32_bf16(__builtin_bit_cast(bf16x8, pk), Sb[ks], oacc[m], 0, 0, 0);
                    }
            }
#pragma unroll
            for (int m = 0; m < 8; ++m) { const f32x4 ct = *(const LAS f32x4*)(lds + T_CT + (16 * m + 4 * g) * 4); Sacc[m] = Sacc[m] * ct; }
            bf16x8 Vf[2];
#pragma unroll
            for (int ks = 0; ks < 2; ++ks) Vf[ks] = tr_frag(lds + vbuf, 32 * ks + 8 * g, 16 * w, lane);
#pragma unroll
            for (int m = 0; m < 8; ++m)
#pragma unroll
                for (int ks = 0; ks < 2; ++ks) Sacc[m] = __builtin_amdgcn_mfma_f32_16x16x32_bf16(tr_frag(lds + T_KC, 32 * ks + 8 * g, 16 * m, lane), Vf[ks], Sacc[m], 0, 0, 0);
            HG_BAR();
            if (lat) {
#pragma unroll
                for (int m = 0; m < 4; ++m)
#pragma unroll
                    for (int ks = 0; ks < 2; ++ks) {
                        if (m < 2 && ks == 1) continue;
                        const bf16x8 av = *(const LAS bf16x8*)(lds + T_P + (16 * m + fr) * PB + (32 * ks + 8 * g) * 2);
                        oacc[m] = __builtin_amdgcn_mfma_f32_16x16x32_bf16(av, Vf[ks], oacc[m], 0, 0, 0);
                    }
#pragma unroll
                for (int m = 0; m < 4; ++m)
#pragma unroll
                    for (int e = 0; e < 4; ++e) { const int r = row_of(dir, 64 * cidx + 16 * m + 4 * g + e); OL[(size_t)(r - C) * D + hc + 16 * w + fr] = oacc[m][e]; }
            }
        }
#undef HG_LOAD
        float* DS = (float*)(c.ws + WS_DS) + (size_t)item * 16384; float* DG = (float*)(c.ws + WS_DG) + item * 128;
#pragma unroll
        for (int m = 0; m < 8; ++m)
#pragma unroll
            for (int e = 0; e < 4; ++e) DS[(16 * m + 4 * g + e) * 128 + 16 * w + fr] = Sacc[m][e];
        if (w == 0) { DG[2 * lane] = dseg0; DG[2 * lane + 1] = dseg1; }
    }
}

#undef HG_BAR
__device__ __forceinline__ void phase_hgrn_fold(const Ctx& c) {
    const float* DS = (const float*)(c.ws + WS_DS); const float* DG = (const float*)(c.ws + WS_DG); bf16_t* SST = (bf16_t*)(c.ws + WS_SST);
    for (int item = c.wg; item < 256; item += c.nwg) {
        const int chain = item >> 4, slice = item & 15, d = 8 * slice + (c.tid >> 6), v2 = (c.tid & 63) * 2;
        float s0 = 0.f, s1 = 0.f;
        float dv[15]; f32x2 ds[15];
#pragma unroll
        for (int sgi = 0; sgi < 15; ++sgi) { dv[sgi] = DG[(chain * 16 + sgi) * 128 + d]; ds[sgi] = *(const f32x2*)(DS + ((size_t)(chain * 16 + sgi) * 128 + d) * 128 + v2); }
        SST[((size_t)(chain * 16) * 128 + v2) * 128 + d] = 0; SST[((size_t)(chain * 16) * 128 + v2 + 1) * 128 + d] = 0;
#pragma unroll
        for (int sgi = 0; sgi < 15; ++sgi) {
            s0 = dv[sgi] * s0 + ds[sgi][0]; s1 = dv[sgi] * s1 + ds[sgi][1];
            SST[((size_t)(chain * 16 + sgi + 1) * 128 + v2) * 128 + d] = (bf16_t)f2bf(s0); SST[((size_t)(chain * 16 + sgi + 1) * 128 + v2 + 1) * 128 + d] = (bf16_t)f2bf(s1);
        }
    }
}

__device__ __forceinline__ void phase_hgrn_readout(const Ctx& c) {
    constexpr int SP = 272, SBUF = 128 * SP, IBUF = 2 * SBUF;
    static_assert(2 * IBUF + 1024 <= LDS_BYTES - 64, "readout LDS map");
    const float* OF = (const float*)(c.ws + WS_OF); const float* OB = (const float*)(c.ws + WS_OB); const bf16_t* SGp = (const bf16_t*)(c.ws + WS_SG);
    const bf16_t* SST = (const bf16_t*)(c.ws + WS_SST); bf16_t* RR = (bf16_t*)(c.ws + WS_RR); const float* hng = c.a->in[13];
    LAS unsigned char* lds = c.lds; LAS float* ssx = (LAS float*)(c.lds + 2 * IBUF);
    const int tid = c.tid, lane = c.lane, w = __builtin_amdgcn_readfirstlane(tid >> 6), fr = lane & 15, g = lane >> 4, mt = w & 3, nh = w >> 2;
#define RO_BAR() asm volatile("s_waitcnt lgkmcnt(0)\n\ts_barrier" ::: "memory")
    u32x4 sreg[8];
#define RO_SST_LOAD(it) do { const int h_ = (it) >> 8, ch_ = (it) & 255; \
        _Pragma("unroll") for (int j = 0; j < 8; ++j) { const int idx_ = tid + 512 * j, dx_ = idx_ >> 11, rem_ = idx_ & 2047; \
            const int sg_ = hg::seg_of(dx_ ? 4 + 255 - ch_ : 4 + ch_); \
            sreg[j] = *(const u32x4*)(SST + ((size_t)((h_ * 2 + dx_) * 16 + sg_) * 128 + (rem_ >> 4)) * 128 + (rem_ & 15) * 8); } } while (0)
#define RO_SST_WRITE(buf) do { _Pragma("unroll") for (int j = 0; j < 8; ++j) { const int idx_ = tid + 512 * j, dx_ = idx_ >> 11, rem_ = idx_ & 2047; \
            *(LAS u32x4*)(lds + (buf) * IBUF + dx_ * SBUF + (rem_ >> 4) * SP + (rem_ & 15) * 16) = sreg[j]; } } while (0)
    int it = c.wg;
    RO_BAR();
    if (it < 2048) { RO_SST_LOAD(it); RO_SST_WRITE(0); }
    RO_BAR();
    for (int k = 0; it < 2048; it += c.nwg, ++k) {
        const int h = it >> 8, ch = it & 255, t0 = 64 * ch + 16 * mt, buf = k & 1;
        const bool has_next = it + c.nwg < 2048;
        if (has_next) RO_SST_LOAD(it + c.nwg);
        f32x4 acc[4]; float sgv[4][4];
#pragma unroll
        for (int n = 0; n < 4; ++n)
#pragma unroll
            for (int e = 0; e < 4; ++e) { const size_t o = (size_t)(t0 + 4 * g + e) * D + h * 128 + 64 * nh + 16 * n + fr; acc[n][e] = OF[o] + OB[o]; sgv[n][e] = bf2f(SGp[o]) * hng[h * 128 + 64 * nh + 16 * n + fr]; }
#pragma unroll
        for (int dx = 0; dx < 2; ++dx) {
            const bf16_t* QS = (const bf16_t*)(c.ws + (dx ? WS_QSB : WS_QSF)) + (size_t)(t0 + fr) * D + h * 128 + 8 * g;
            const LAS unsigned char* sb = lds + buf * IBUF + dx * SBUF + (64 * nh + fr) * SP + 16 * g;
#pragma unroll
            for (int ks = 0; ks < 4; ++ks) {
                const bf16x8 av = *(const bf16x8*)(QS + 32 * ks);
#pragma unroll
                for (int n = 0; n < 4; ++n) acc[n] = __builtin_amdgcn_mfma_f32_16x16x32_bf16(av, *(const LAS bf16x8*)(sb + (16 * n) * SP + 64 * ks), acc[n], 0, 0, 0);
            }
        }
        float ss[4] = {0.f, 0.f, 0.f, 0.f};
#pragma unroll
        for (int n = 0; n < 4; ++n)
#pragma unroll
            for (int e = 0; e < 4; ++e) ss[e] += acc[n][e] * acc[n][e];
#pragma unroll
        for (int e = 0; e < 4; ++e) {
#pragma unroll
            for (int sh = 8; sh > 0; sh >>= 1) ss[e] += __shfl_xor(ss[e], sh);
        }
        if (fr == 0) *(LAS f32x4*)(ssx + ((k & 1) * 8 + w) * 16 + 4 * g) = (f32x4){ss[0], ss[1], ss[2], ss[3]};
        if (has_next) RO_SST_WRITE(buf ^ 1);
        RO_BAR();
        const f32x4 ps = *(const LAS f32x4*)(ssx + ((k & 1) * 8 + (w ^ 4)) * 16 + 4 * g);
#pragma unroll
        for (int e = 0; e < 4; ++e) ss[e] = rsqrtf((ss[e] + ps[e]) * (1.f / 128.f) + EPS);
#pragma unroll
        for (int n = 0; n < 4; ++n)
#pragma unroll
            for (int e = 0; e < 4; ++e) { const size_t o = (size_t)(t0 + 4 * g + e) * D + h * 128 + 64 * nh + 16 * n + fr; RR[o] = (bf16_t)f2bf(acc[n][e] * ss[e] * sgv[n][e]); }
    }
    RO_BAR();
#undef RO_BAR
#undef RO_SST_LOAD
#undef RO_SST_WRITE
}

#define XB_TMO      128
#define XB_XCNT(j)  (256  + 64 * (j))
#define XB_XSUB(j)  (1280 + 64 * (j))
#define XB_XGEN(j)  (2304 + 64 * (j))
#define XB_TOP      3328
#define XB_TOPGEN   3392
#define XCD_BAR_WORDS 3456
#define XB_SPIN_CAP (1u << 18)
__device__ __forceinline__ unsigned xb_ld(unsigned* p)              { return __hip_atomic_load(p, __ATOMIC_RELAXED, __HIP_MEMORY_SCOPE_AGENT); }
__device__ __forceinline__ unsigned xb_add(unsigned* p, unsigned v) { return __hip_atomic_fetch_add(p, v, __ATOMIC_RELAXED, __HIP_MEMORY_SCOPE_AGENT); }
__device__ __forceinline__ unsigned xb_xcc_id() { return (unsigned)__builtin_amdgcn_s_getreg((3 << 11) | 20) & 0xFu; }
#define XB_SPIN(cond, bar) do { unsigned _sp = 0; while (cond) { __builtin_amdgcn_s_sleep(1); \
    if ((++_sp & 255u) == 0u) { if (xb_ld(&(bar)[XB_TMO])) break; if (_sp > XB_SPIN_CAP) { atomicAdd(&(bar)[XB_TMO], 1u); break; } } } } while (0)
struct XcdBarrier { unsigned* bar; unsigned x; volatile LAS unsigned* st; };
__device__ __forceinline__ XcdBarrier xcd_barrier_post(unsigned* bar, volatile LAS unsigned* st) {
    XcdBarrier b; b.bar = bar; b.x = xb_xcc_id(); b.st = st;
    if (threadIdx.x == 0) (void)xb_add(&bar[XB_XCNT(b.x)], 1u);
    return b;
}
__device__ __forceinline__ void xcd_barrier_complete(unsigned* bar, unsigned x, unsigned& nloc, unsigned& nx) {
    const unsigned G = gridDim.x * gridDim.y * gridDim.z;
    unsigned sum, cnt, mine, sp = 0u;
    for (;;) {
        sum = 0u; cnt = 0u; mine = 0u;
#pragma unroll
        for (unsigned j = 0; j < 16; ++j) { const unsigned c = xb_ld(&bar[XB_XCNT(j)]); sum += c; cnt += (c > 0u) ? 1u : 0u; mine = (j == x) ? c : mine; }
        if (sum == G) break;
        __builtin_amdgcn_s_sleep(1);
        if ((++sp & 255u) == 0u) { if (xb_ld(&bar[XB_TMO])) break; if (sp > XB_SPIN_CAP) { atomicAdd(&bar[XB_TMO], 1u); break; } }
    }
    nloc = mine > 0u ? mine : 1u; nx = cnt > 0u ? cnt : 1u;
}
__device__ __forceinline__ void xcd_barrier(const XcdBarrier& b) {
    asm volatile("s_waitcnt vmcnt(0)" ::: "memory");
    __syncthreads();
    if (threadIdx.x == 0) {
        unsigned* bar = b.bar;
        __builtin_amdgcn_s_waitcnt(0);
        unsigned nloc = b.st[0], nx = b.st[1];
        if (nloc == 0u) { xcd_barrier_complete(bar, b.x, nloc, nx); b.st[0] = nloc; b.st[1] = nx; }
        const unsigned old = xb_add(&bar[XB_XSUB(b.x)], 1u);
        const unsigned gen = old / nloc;
        if (old + 1u == (gen + 1u) * nloc) {
            __builtin_amdgcn_fence(__ATOMIC_RELEASE, "agent");
            asm volatile("s_waitcnt vmcnt(0)" ::: "memory");
            const unsigned og = xb_add(&bar[XB_TOP], 1u);
            const unsigned tg = og / nx;
            if (og + 1u == (tg + 1u) * nx) xb_add(&bar[XB_TOPGEN], 1u);
            else XB_SPIN(xb_ld(&bar[XB_TOPGEN]) == tg, bar);
            __builtin_amdgcn_fence(__ATOMIC_ACQUIRE, "agent");
            xb_add(&bar[XB_XGEN(b.x)], 1u);
            asm volatile("s_waitcnt vmcnt(0)" ::: "memory");
        } else {
            XB_SPIN(xb_ld(&bar[XB_XGEN(b.x)]) == gen, bar);
            __builtin_amdgcn_fence(__ATOMIC_ACQUIRE, "agent");
            asm volatile("s_waitcnt vmcnt(0)" ::: "memory");
        }
    }
    __syncthreads();
}

__device__ __forceinline__ void launder(Ctx& c) { asm volatile("" : "+s"(c.a)); asm volatile("" : "+s"(c.ws)); asm volatile("" : "+s"(c.wave));
    c.lane = (int)__builtin_amdgcn_mbcnt_hi(~0u, __builtin_amdgcn_mbcnt_lo(~0u, 0u)); c.tid = c.wave * 64 + c.lane; }
__global__ void __launch_bounds__(512, 2) mk_fwd(Args args) {
    extern __shared__ __attribute__((aligned(16))) unsigned char lds_raw[];
    Ctx c; c.a = (CArgs)__builtin_amdgcn_kernarg_segment_ptr(); c.lds = (LAS unsigned char*)lds_raw; c.tid = threadIdx.x; c.lane = c.tid & 63; c.wave = __builtin_amdgcn_readfirstlane(c.tid >> 6); c.nwg = gridDim.x; c.wg = blockIdx.x; c.ws = c.a->ws;
    volatile LAS unsigned* bst = (volatile LAS unsigned*)(c.lds + LDS_BYTES - 64);
    if (c.tid < 4) bst[c.tid] = 0u;
    __syncthreads();
    const XcdBarrier bar = xcd_barrier_post((unsigned*)(c.ws + WS_CTL) + CW_BAR, bst);
    const int lo = c.a->ph_lo, hi = c.a->ph_hi;
    bool route_ok = true;
#define SEAM(k) do { if (lo <= (k) && (k) + 1 < hi) xcd_barrier(bar); } while (0)
#define IN(k) (lo <= (k) && (k) < hi && (launder(c), true))
#define PH(k, call) do { if (IN(k)) { if (PROBE_PH == (k)) { int nrep_ = 3; asm volatile("" : "+s"(nrep_)); for (int rep_ = 0; rep_ < nrep_; ++rep_) { route_ok = (rep_ + 1 == nrep_); call; if (rep_ + 1 < nrep_) xcd_barrier(bar); } } else { call; } } SEAM(k); } while (0)
    PH(0, phase_prep(c));
    PH(1, phase_convert(c));
    PH(2, phase_gemm_qkv(c));
    PH(3, phase_attn(c));
    PH(4, phase_gemm_f32(c, (const bf16_t*)(c.ws + WS_O), R, (const bf16_t*)(c.ws + WS_WO), D, nullptr, (float*)(c.ws + WS_RAW1)));
    PH(5, { phase_postmix<128>(c, 0, route_ok); convert_steal(c, 1); });
    PH(6, phase_moe_gu(c, 0));
    PH(7, phase_moe_dn(c, 0));
    PH(8, phase_combine(c, 0));
    PH(9, phase_gemm_inproj(c));
    PH(10, phase_hgrn_scan(c));
    PH(11, phase_hgrn_fold(c));
    PH(12, phase_hgrn_readout(c));
    PH(13, phase_gemm_f32(c, (const bf16_t*)(c.ws + WS_RR), L, (const bf16_t*)(c.ws + WS_WHO), D, nullptr, (float*)(c.ws + WS_RAW1)));
    PH(14, { phase_postmix<128>(c, 1, route_ok); convert_steal(c, 2); });
    PH(15, phase_moe_gu(c, 1));
    PH(16, phase_moe_dn(c, 1));
    PH(17, phase_combine(c, 1));
#undef IN
#undef PH
#undef SEAM
}

extern "C" void kernel_launch(void* const* d_in, const int* in_sizes, int n_in, void* d_out, int out_size, void* d_ws, size_t ws_size, hipStream_t stream) {
    static int grid = 0;
    if (grid == 0) {
        if (n_in != 21 || out_size != L * D || ws_size < WS_END) { fprintf(stderr, "kernel_launch: unexpected problem (n_in %d out %d ws %zu need %zu)\n", n_in, out_size, ws_size, (size_t)WS_END); grid = -1; return; }
        int dev = 0, cus = 0, per_cu = 0;
        hipGetDevice(&dev); hipDeviceGetAttribute(&cus, hipDeviceAttributeMultiprocessorCount, dev);
        if (hipFuncSetAttribute((const void*)mk_fwd, hipFuncAttributeMaxDynamicSharedMemorySize, LDS_BYTES) != hipSuccess) { fprintf(stderr, "kernel_launch: hipFuncSetAttribute failed\n"); grid = -1; return; }
        hipOccupancyMaxActiveBlocksPerMultiprocessor(&per_cu, (const void*)mk_fwd, 512, LDS_BYTES);
        if (per_cu < 1) fprintf(stderr, "kernel_launch: occupancy query says %d\n", per_cu);
        (void)hipGetLastError();
        grid = cus > 0 ? cus : 256;
    }
    if (grid < 0) return;
    hipMemsetAsync((char*)d_ws + WS_CTL, 0, MiB, stream);
    Args a{};
    for (int i = 0; i < 21; ++i) a.in[i] = (const float*)d_in[i];
    a.out = (float*)d_out; a.ws = (unsigned char*)d_ws;
    a.ph_lo = 0; a.ph_hi = NPHASE;
    hipLaunchKernelGGL(mk_fwd, dim3(grid), dim3(512), LDS_BYTES, stream, a);
}
```

```cpp
#include <hip/hip_runtime.h>
#include <cstdint>
#include <cstdio>

#define LAS __attribute__((address_space(3)))
typedef unsigned short bf16_t;
typedef short bf16x8 __attribute__((ext_vector_type(8)));
typedef float f32x4 __attribute__((ext_vector_type(4)));
typedef unsigned u32x4 __attribute__((ext_vector_type(4)));
typedef unsigned u32x2 __attribute__((ext_vector_type(2)));
typedef short v4i16_t __attribute__((ext_vector_type(4)));
typedef float f32x2 __attribute__((ext_vector_type(2)));

constexpr int D = 1024, L = 16384, C = 256, R = L + C;
constexpr int QKVD = 1280, HIN = 5120, NE = 32, TOPK = 4;
constexpr int PADM = 256, MAXROWS = 74752;
constexpr float EPS = 1e-6f;
constexpr float LOG2E = 1.4426950408889634f;
constexpr int NPHASE = 18;
#ifndef GEMM_REP
#define GEMM_REP 1
#endif
#ifndef PROBE_NOEPI
#define PROBE_NOEPI 0
#endif
#ifndef PROBE_SHORTK
#define PROBE_SHORTK 0
#endif
#ifndef SCAN_REP
#define SCAN_REP 1
#endif
#ifndef PROBE_PH
#define PROBE_PH (-1)
#endif
constexpr int LDS_BYTES = 147456;

constexpr size_t MiB = 1u << 20;
constexpr size_t al(size_t x) { return (x + MiB - 1) / MiB * MiB; }
constexpr size_t WS_CTL = 0;
constexpr size_t WS_MOD = WS_CTL + MiB;
constexpr size_t WS_X = WS_MOD + MiB;
constexpr size_t WS_H = WS_X + al((size_t)R * D * 4);
constexpr size_t WS_Q = WS_H + al((size_t)R * D * 2);
constexpr size_t WS_K = WS_Q + al((size_t)R * D * 2);
constexpr size_t WS_V = WS_K + al((size_t)R * 128 * 2);
constexpr size_t WS_O = WS_V + al((size_t)R * 128 * 2);
constexpr size_t WS_TK = WS_O + al((size_t)R * D * 2);
constexpr size_t WS_LIST = WS_TK + MiB;
constexpr size_t WS_HDN = WS_LIST + 3 * MiB;
constexpr size_t WS_RAW1 = WS_HDN + al((size_t)MAXROWS * 1024 * 2);
constexpr size_t WS_X1 = WS_RAW1 + al((size_t)R * D * 4);
constexpr size_t WS_OUTB = WS_X1 + al((size_t)R * D * 4);
constexpr size_t WS_QH = WS_OUTB + al((size_t)MAXROWS * 1024 * 2);
constexpr size_t WS_KF = WS_QH + al((size_t)L * D * 2);
constexpr size_t WS_KB = WS_KF + al((size_t)R * D * 2);
constexpr size_t WS_IV = WS_KB + al((size_t)R * D * 2);
constexpr size_t WS_SG = WS_IV + al((size_t)R * D * 2);
constexpr size_t WS_OF = WS_SG + al((size_t)L * D * 2);
constexpr size_t WS_OB = WS_OF + al((size_t)L * D * 4);
constexpr size_t WS_RR = WS_OB + al((size_t)L * D * 4);
constexpr size_t WS_WQKV = WS_RR + al((size_t)L * D * 2);
constexpr size_t WS_WO = WS_WQKV + al((size_t)QKVD * D * 2);
constexpr size_t WS_WIN = WS_WO + al((size_t)D * D * 2);
constexpr size_t WS_WHO = WS_WIN + al((size_t)HIN * D * 2);
constexpr size_t WS_WGU = WS_WHO + al((size_t)D * D * 2);
constexpr size_t WS_WDN = WS_WGU + al((size_t)2 * NE * 2048 * D * 2);
constexpr size_t WS_QSF = WS_WDN + al((size_t)2 * NE * 1024 * D * 2);
constexpr size_t WS_QSB = WS_QSF + al((size_t)L * D * 2);
constexpr size_t WS_DS = WS_QSB + al((size_t)L * D * 2);
constexpr size_t WS_DG = WS_DS + al((size_t)256 * 128 * 128 * 4);
constexpr size_t WS_SST = WS_DG + MiB;
constexpr size_t WS_H8 = WS_SST + al((size_t)256 * 128 * 128 * 2);
constexpr size_t WS_END = WS_H8 + al((size_t)R * D);
static_assert(WS_END <= (size_t)2048 * MiB, "workspace map exceeds 4x the largest input");
constexpr int CW_CNT = 1024;
constexpr int CW_CONV = 2048;
constexpr int CW_BAR = 4096;
constexpr int MOD_ROPE = 32768;
constexpr int MOD_LB = 49152;

struct Args { const float* in[21]; float* out; unsigned char* ws; int ph_lo, ph_hi; };

__device__ __forceinline__ unsigned f2bf(float f) { unsigned u = __float_as_uint(f); return (u + 0x7fffu + ((u >> 16) & 1u)) >> 16; }
typedef float f32x2_t __attribute__((ext_vector_type(2))); typedef __bf16 bf16x2_t __attribute__((ext_vector_type(2)));
__device__ __forceinline__ unsigned pk2(float lo, float hi) { f32x2_t v = {lo, hi}; bf16x2_t b = __builtin_convertvector(v, bf16x2_t); return __builtin_bit_cast(unsigned, b); }
__device__ __forceinline__ unsigned pk4_fp8(float a, float b, float c, float d) {
    a = fminf(fmaxf(a, -448.f), 448.f); b = fminf(fmaxf(b, -448.f), 448.f); c = fminf(fmaxf(c, -448.f), 448.f); d = fminf(fmaxf(d, -448.f), 448.f);
    int v = __builtin_amdgcn_cvt_pk_fp8_f32(a, b, 0, false); v = __builtin_amdgcn_cvt_pk_fp8_f32(c, d, v, true); return (unsigned)v; }
constexpr float F8_SH = 8.f, F8_SW = 64.f, F8_SHD = 4.f;
__device__ __forceinline__ float bflo(unsigned u) { return __uint_as_float(u << 16); }
__device__ __forceinline__ float bfhi(unsigned u) { return __uint_as_float(u & 0xffff0000u); }
__device__ __forceinline__ float bf2f(bf16_t b) { return __uint_as_float(((unsigned)b) << 16); }
__device__ __forceinline__ float wave_sum(float v) {
#pragma unroll
    for (int o = 32; o > 0; o >>= 1) v += __shfl_xor(v, o);
    return v;
}
__device__ __forceinline__ float silu_f(float x) { return x / (1.f + __expf(-x)); }
__device__ __forceinline__ float sigmoid_f(float x) { return 1.f / (1.f + __expf(-x)); }

typedef const __attribute__((address_space(4))) Args* CArgs;
struct Ctx {
    CArgs a;
    LAS unsigned char* lds;
    int tid, lane, wave, nwg, wg;
    unsigned char* ws;
    __device__ __forceinline__ float* modp(int layer, int which) const { return (float*)(ws + WS_MOD) + (layer * 2 + which) * 6144; }
    __device__ __forceinline__ const float* xin0(int r) const { return r < C ? a->in[2] + (size_t)r * D : a->in[0] + (size_t)(r - C) * D; }
};


namespace pg8 {
constexpr int BM = 256, BK = 64, HALF = 128, HTB = HALF * BK * 2, STAGE_BYTES = 8 * HTB, KD = 1024, NXCD = 8, WGM = 8;
__device__ __forceinline__ int lds_byte(int r, int c) { const int st = (r >> 4) * 2 + (c >> 5), rr = r & 15, cc = c & 31, ob = rr * 64 + cc * 2; return st * 1024 + (ob ^ (((ob >> 9) & 1) << 5)); }
__device__ __forceinline__ void stage_rc(int b, int& Rr, int& Cc) { const int st = b / 1024, sb = b % 1024, swz = sb ^ (((sb >> 9) & 1) << 5); Rr = (st >> 1) * 16 + swz / 64; Cc = (st & 1) * 32 + (swz % 64) / 2; }
__device__ __forceinline__ int perm32(int rho) { const int n = rho >> 4, i = rho & 15; return 8 * (i >> 2) + 4 * n + (i & 3); }

struct Unit { int pm, pn, e, goff, gcnt; bool real; int amask, bmask; };
struct Gemm { const void* A; const void* Bt; size_t bstride; const int* list; };

struct StaticOrder {
    int nM, nN, nwg, G, c;
    __device__ __forceinline__ void init(int M, int N, int G_, int c_) { nM = M / BM; nN = N / BM; nwg = nM * nN; G = G_; c = c_; }
    __device__ __forceinline__ bool next(int i, Unit& u) const {
        const int F = nwg / G, Rm = nwg - F * G; int Lq; u.amask = 3; u.bmask = 3;
        if (i < F) Lq = i * G + c;
        else if (i == F && Rm > 0) {
            if (4 * Rm <= G) { if (c >= 4 * Rm) return false; Lq = F * G + (c >> 2); u.amask = 1 << ((c >> 1) & 1); u.bmask = 1 << (c & 1); }
            else if (2 * Rm <= G) { if (c >= 2 * Rm) return false; Lq = F * G + (c >> 1); u.bmask = 1 << (c & 1); }
            else { if (c >= Rm) return false; Lq = F * G + c; }
        } else return false;
        int wgid = Lq; { const int q = nwg / NXCD, r = nwg % NXCD, xcd = wgid % NXCD, off = wgid / NXCD; wgid = (xcd < r ? xcd * (q + 1) : r * (q + 1) + (xcd - r) * q) + off; }
        const int nig = WGM * nN, gid = wgid / nig, fm = gid * WGM, gsz = (nM - fm) < WGM ? (nM - fm) : WGM;
        u.pm = fm + ((wgid % nig) % gsz); u.pn = (wgid % nig) / gsz; u.e = 0; u.goff = 0; u.gcnt = 0; u.real = true; return true;
    }
};
struct MoeOrder {
    const LAS int* tp; const LAS int* cnt; int npn, G, vcu; bool split;
    __device__ __forceinline__ bool next(int i, Unit& u) const {
        const int tot = tp[32] * npn; int lin; u.amask = 3; u.bmask = 3; u.real = true;
        if (GEMM_REP > 1) { const int lin0 = i * G + vcu; if (lin0 >= tot * GEMM_REP) return false; lin = lin0 % tot; u.real = lin0 >= tot * (GEMM_REP - 1); }
        else {
            const int F = tot / G, Rm = tot - F * G;
            if (i < F) lin = i * G + vcu;
            else if (i == F && Rm > 0) {
                if (split && 2 * Rm <= G) { if (vcu >= 2 * Rm) return false; lin = F * G + (vcu >> 1); u.bmask = 1 << (vcu & 1); }
                else { if (vcu >= Rm) return false; lin = F * G + vcu; }
            } else return false;
        }
        const int rt = lin / npn; int e = 0;
#pragma unroll 8
        for (int k = 1; k < 32; ++k) e += (rt >= tp[k]) ? 1 : 0;
        const int mt = rt - tp[e];
        u.pm = rt; u.pn = lin - rt * npn; u.e = e; u.goff = e * R + mt * 256; u.gcnt = cnt[e] - mt * 256; return true;
    }
};

template <int KB>
__device__ __forceinline__ void a_offsets(const Gemm& g, const Unit& u, const int (&sR)[2], const int (&sC)[2], unsigned (&v)[2][2]) {
#pragma unroll
    for (int h = 0; h < 2; ++h)
#pragma unroll
        for (int i = 0; i < 2; ++i) {
            const int rr = h * HALF + sR[i]; int row;
            if (g.list) row = rr < u.gcnt ? g.list[u.goff + rr] : 0; else row = u.pm * BM + rr;
            v[h][i] = (unsigned)(row * KB + sC[i] * 2);
        }
}

struct EpiF32 {
    static constexpr bool PERM = false;
    float* Cp; int ldc; const float* bias;
    __device__ __forceinline__ void operator()(const f32x4 (&acc)[2][2][4][2], const Unit& u, int wr, int wc, int fr, int fq) const {
        const int row0 = u.pm * BM + wr * 64 + fr, col0 = u.pn * BM + wc * 32 + 4 * fq;
#pragma unroll
        for (int bj = 0; bj < 2; ++bj)
#pragma unroll
            for (int n = 0; n < 2; ++n) {
                const int col = col0 + bj * HALF + n * 16;
                if (!((u.bmask >> bj) & 1)) continue;
                const f32x4 bv = bias ? *(const f32x4*)(bias + col) : (f32x4){0.f, 0.f, 0.f, 0.f};
#pragma unroll
                for (int ai = 0; ai < 2; ++ai)
#pragma unroll
                    for (int m = 0; m < 4; ++m) if ((u.amask >> ai) & 1) *(f32x4*)(Cp + (size_t)(row0 + ai * HALF + m * 16) * ldc + col) = acc[ai][bj][m][n] + bv;
            }
    }
};
struct EpiSwiglu {
    static constexpr bool PERM = true;
    unsigned char* Hd; const float* bgu;
    __device__ __forceinline__ void operator()(const f32x4 (&acc)[2][2][4][2], const Unit& u, int wr, int wc, int fr, int fq) const {
        const int row0 = u.pm * BM + wr * 64 + fr, cg0 = u.pn * HALF + wc * 32 + 8 * fq;
        const float* bb = bgu + (size_t)u.e * 2048;
        f32x4 bg[2], bu[2];
#pragma unroll
        for (int n = 0; n < 2; ++n) { bg[n] = *(const f32x4*)(bb + cg0 + 4 * n); bu[n] = *(const f32x4*)(bb + 1024 + cg0 + 4 * n); }
#pragma unroll
        for (int ai = 0; ai < 2; ++ai)
#pragma unroll
            for (int m = 0; m < 4; ++m) {
                u32x2 o;
#pragma unroll
                for (int n = 0; n < 2; ++n) {
                    const f32x4 gv = acc[ai][0][m][n] * (1.f / (F8_SH * F8_SW)) + bg[n], uv = acc[ai][1][m][n] * (1.f / (F8_SH * F8_SW)) + bu[n]; float hv[4];
#pragma unroll
                    for (int q = 0; q < 4; ++q) { const float gg = fminf(gv[q], 7.f), uu = fminf(fmaxf(uv[q], -7.f), 7.f); hv[q] = gg * (1.f / (1.f + __expf(-1.702f * gg))) * (uu + 1.f); }
                    o[n] = pk4_fp8(hv[0] * F8_SHD, hv[1] * F8_SHD, hv[2] * F8_SHD, hv[3] * F8_SHD);
                }
                *(u32x2*)(Hd + (size_t)(row0 + ai * HALF + m * 16) * 1024 + cg0) = o;
            }
    }
};
struct EpiBf16Bias {
    static constexpr bool PERM = true;
    bf16_t* Op; const float* bias; int bias_estride; float scale;
    __device__ __forceinline__ void operator()(const f32x4 (&acc)[2][2][4][2], const Unit& u, int wr, int wc, int fr, int fq) const {
        const int row0 = u.pm * BM + wr * 64 + fr, col0 = u.pn * BM + wc * 32 + 8 * fq;
        const float* bb = bias + (size_t)u.e * bias_estride;
#pragma unroll
        for (int bj = 0; bj < 2; ++bj) {
            const int col = col0 + bj * HALF;
            if (!((u.bmask >> bj) & 1)) continue;
            const f32x4 b0 = *(const f32x4*)(bb + col), b1 = *(const f32x4*)(bb + col + 4);
#pragma unroll
            for (int ai = 0; ai < 2; ++ai)
#pragma unroll
                for (int m = 0; m < 4; ++m) { if (!((u.amask >> ai) & 1)) continue; const f32x4 v0 = acc[ai][bj][m][0] * scale + b0, v1 = acc[ai][bj][m][1] * scale + b1;
                    u32x4 o; o.x = pk2(v0[0], v0[1]); o.y = pk2(v0[2], v0[3]); o.z = pk2(v1[0], v1[1]); o.w = pk2(v1[2], v1[3]);
                    *(u32x4*)(Op + (size_t)(row0 + ai * HALF + m * 16) * 1024 + col) = o; }
        }
    }
};
struct EpiQKV {
    static constexpr bool PERM = false;
    bf16_t* Qp; bf16_t* Kp; bf16_t* Vp; const float* bias; const float* tab;
    __device__ __forceinline__ void operator()(const f32x4 (&acc)[2][2][4][2], const Unit& u, int wr, int wc, int fr, int fq) const {
        const bool lat = u.pm > 0; const float qs = 0.125f * LOG2E;
#pragma unroll
        for (int bj = 0; bj < 2; ++bj) {
            const int colt = u.pn * BM + bj * HALF + wc * 32 + 4 * fq;
            const f32x4 b1 = *(const f32x4*)(bias + colt), b2 = *(const f32x4*)(bias + colt + 16);
            const bool isv = (u.pn == 4) && (bj == 1);
            if (!((u.bmask >> bj) & 1)) continue;
#pragma unroll
            for (int ai = 0; ai < 2; ++ai)
#pragma unroll
                for (int m = 0; m < 4; ++m) {
                    if (!((u.amask >> ai) & 1)) continue;
                    const int r = u.pm * BM + ai * HALF + wr * 64 + m * 16 + fr, t = r - C;
                    f32x4 x1 = acc[ai][bj][m][0] + b1, x2 = acc[ai][bj][m][1] + b2;
                    if (lat && !isv) {
                        const int pos = (wc & 1) ? (t & 63) : (t >> 6);
                        const f32x4 t0 = *(const f32x4*)(tab + (pos * 16 + 4 * fq) * 2), t1 = *(const f32x4*)(tab + (pos * 16 + 4 * fq) * 2 + 4);
                        const float cs[4] = {t0[0], t0[2], t1[0], t1[2]}, sn[4] = {t0[1], t0[3], t1[1], t1[3]};
                        f32x4 o1, o2;
#pragma unroll
                        for (int e = 0; e < 4; ++e) { o1[e] = x1[e] * cs[e] - x2[e] * sn[e]; o2[e] = x2[e] * cs[e] + x1[e] * sn[e]; }
                        x1 = o1; x2 = o2;
                    }
                    u32x2 w1, w2;
                    if (u.pn < 4) {
                        w1.x = pk2(x1[0] * qs, x1[1] * qs); w1.y = pk2(x1[2] * qs, x1[3] * qs); w2.x = pk2(x2[0] * qs, x2[1] * qs); w2.y = pk2(x2[2] * qs, x2[3] * qs);
                        *(u32x2*)(Qp + (size_t)r * 1024 + colt) = w1; *(u32x2*)(Qp + (size_t)r * 1024 + colt + 16) = w2;
                    } else {
                        w1.x = pk2(x1[0], x1[1]); w1.y = pk2(x1[2], x1[3]); w2.x = pk2(x2[0], x2[1]); w2.y = pk2(x2[2], x2[3]);
                        bf16_t* dst = (bj == 0 ? Kp : Vp) + (size_t)r * 128 + wc * 32 + 4 * fq;
                        *(u32x2*)dst = w1; *(u32x2*)(dst + 16) = w2;
                    }
                }
        }
    }
};
struct EpiInProj {
    static constexpr bool PERM = true;
    bf16_t* QH; _Float16* KF; _Float16* KB; bf16_t* IV; bf16_t* SG; const float* lb; float scale;
    __device__ __forceinline__ void operator()(const f32x4 (&acc)[2][2][4][2], const Unit& u, int wr, int wc, int fr, int fq) const {
        const int seg = u.pn >> 2; const bool lat = u.pm > 0;
        if (!lat && (seg == 0 || seg == 4)) return;
        typedef _Float16 h8_t __attribute__((ext_vector_type(8)));
#pragma unroll
        for (int bj = 0; bj < 2; ++bj) {
            const int col = (u.pn & 3) * BM + bj * HALF + wc * 32 + 8 * fq;
            if (!((u.bmask >> bj) & 1)) continue;
            f32x4 lb0 = (f32x4){0.f, 0.f, 0.f, 0.f}, lb1 = lb0;
            if (seg == 1) { lb0 = *(const f32x4*)(lb + col); lb1 = *(const f32x4*)(lb + col + 4); } else if (seg == 2) { lb0 = *(const f32x4*)(lb + 1024 + col); lb1 = *(const f32x4*)(lb + 1024 + col + 4); }
#pragma unroll
            for (int ai = 0; ai < 2; ++ai)
#pragma unroll
                for (int m = 0; m < 4; ++m) {
                    if (!((u.amask >> ai) & 1)) continue;
                    const int r = u.pm * BM + ai * HALF + wr * 64 + m * 16 + fr; const f32x4 v0 = acc[ai][bj][m][0] * scale, v1 = acc[ai][bj][m][1] * scale;
                    if (seg == 1 || seg == 2) {
                        h8_t hv;
#pragma unroll
                        for (int e = 0; e < 4; ++e) { hv[e] = (_Float16)((1.f - lb0[e]) / (1.f + __expf(v0[e]))); hv[4 + e] = (_Float16)((1.f - lb1[e]) / (1.f + __expf(v1[e]))); }
                        *(h8_t*)((seg == 1 ? KF : KB) + (size_t)r * 1024 + col) = hv;
                    } else if (seg == 3) {
                        u32x4 o; o.x = pk2(v0[0], v0[1]); o.y = pk2(v0[2], v0[3]); o.z = pk2(v1[0], v1[1]); o.w = pk2(v1[2], v1[3]); *(u32x4*)(IV + (size_t)r * 1024 + col) = o;
                    } else {
                        float s0[4], s1[4];
#pragma unroll
                        for (int e = 0; e < 4; ++e) { s0[e] = v0[e] / (1.f + __expf(-v0[e])); s1[e] = v1[e] / (1.f + __expf(-v1[e])); }
                        u32x4 o; o.x = pk2(s0[0], s0[1]); o.y = pk2(s0[2], s0[3]); o.z = pk2(s1[0], s1[1]); o.w = pk2(s1[2], s1[3]); *(u32x4*)((seg == 0 ? QH : SG) + (size_t)(r - C) * 1024 + col) = o;
                    }
                }
        }
    }
};

typedef int v8i __attribute__((ext_vector_type(8)));
typedef int v4i __attribute__((ext_vector_type(4)));
template <class Epi, class Sched, bool ALIGN_EPI, bool GATHER, bool FP8>
__device__ __forceinline__ void gemm_phase(LAS unsigned char* lds, const Gemm g, const Sched& S, const Epi& E, const int tid) {
    const int wid = __builtin_amdgcn_readfirstlane(tid >> 6), lane = tid & 63, wr = wid >> 2, wc = wid & 3, fr = lane & 15, fq = lane >> 4;
    constexpr int KB = FP8 ? 1024 : 2048, nt = 1024 / (FP8 ? 128 : 64);
    int sR[2], sC[2]; unsigned voffB[2], voffA[2];
#pragma unroll
    for (int i = 0; i < 2; ++i) { stage_rc(tid * 16 + i * 8192, sR[i], sC[i]); const int Rb = Epi::PERM ? ((sR[i] & ~31) + perm32(sR[i] & 31)) : sR[i]; voffB[i] = (unsigned)(Rb * KB + sC[i] * 2); voffA[i] = (unsigned)(sR[i] * KB + sC[i] * 2); }
    constexpr size_t kstep = (size_t)(BK * 2), hstep = (size_t)HALF * KB, tstep = 2 * hstep;
    const unsigned ldsw = (unsigned)wid * 1024u;
    const int aoff = lds_byte(wr * 64 + fr, fq * 8), boff = lds_byte(wc * 32 + fr, fq * 8);
    const char* Ab = (const char*)g.A;
#define PG8_SA(b, h) (((b) * 2 + (h)) * HTB)
#define PG8_SB(b, h) ((4 + (b) * 2 + (h)) * HTB)
#define PG8_STAGE_B(bufoff, gbase) do { _Pragma("unroll") for (int _i = 0; _i < 2; ++_i) \
        __builtin_amdgcn_global_load_lds((const unsigned*)((const char*)(gbase) + voffB[_i]), (LAS unsigned*)(lds + (bufoff) + ldsw + _i * 8192), 16, 0, 0); } while (0)
#define PG8_STAGE_A(bufoff, kb, v, ubase) do { _Pragma("unroll") for (int _i = 0; _i < 2; ++_i) \
        __builtin_amdgcn_global_load_lds((const unsigned*)((GATHER ? Ab : (ubase)) + (size_t)(kb) + (GATHER ? (v)[_i] : voffA[_i])), (LAS unsigned*)(lds + (bufoff) + ldsw + _i * 8192), 16, 0, 0); } while (0)
#define PG8_LD8(p) __builtin_shufflevector(*(const LAS v4i*)(p), *(const LAS v4i*)((p) + 1024), 0, 1, 2, 3, 4, 5, 6, 7)
#define PG8_LDA(dst, b, h) do { if constexpr (FP8) { _Pragma("unroll") for (int m = 0; m < 4; ++m) dst##8[m] = PG8_LD8(lds + PG8_SA(b, h) + aoff + m * 2048); } else { _Pragma("unroll") for (int m = 0; m < 4; ++m) _Pragma("unroll") for (int k = 0; k < 2; ++k) dst[m][k] = *(const LAS bf16x8*)(lds + PG8_SA(b, h) + aoff + m * 2048 + k * 1024); } } while (0)
#define PG8_LDB(dst, b, h) do { if constexpr (FP8) { _Pragma("unroll") for (int n = 0; n < 2; ++n) dst##8[n] = PG8_LD8(lds + PG8_SB(b, h) + boff + n * 2048); } else { _Pragma("unroll") for (int n = 0; n < 2; ++n) _Pragma("unroll") for (int k = 0; k < 2; ++k) dst[n][k] = *(const LAS bf16x8*)(lds + PG8_SB(b, h) + boff + n * 2048 + k * 1024); } } while (0)
#define PG8_MMA(ai, bj, At, Bt) do { __builtin_amdgcn_s_setprio(1); if constexpr (FP8) { _Pragma("unroll") for (int m = 0; m < 4; ++m) _Pragma("unroll") for (int n = 0; n < 2; ++n) \
        asm volatile("v_mfma_scale_f32_16x16x128_f8f6f4 %0, %1, %2, %0, %3, %3 op_sel_hi:[0,0,0]" : "+v"(acc[ai][bj][m][n]) : "v"(Bt##8[n]), "v"(At##8[m]), "v"(unit_scale)); } else { \
        _Pragma("unroll") for (int m = 0; m < 4; ++m) _Pragma("unroll") for (int n = 0; n < 2; ++n) _Pragma("unroll") for (int k = 0; k < 2; ++k) \
        acc[ai][bj][m][n] = __builtin_amdgcn_mfma_f32_16x16x32_bf16(Bt[n][k], At[m][k], acc[ai][bj][m][n], 0, 0, 0); } __builtin_amdgcn_s_setprio(0); } while (0)
#define PG8_WAIT_V(n) asm volatile("s_waitcnt vmcnt(" #n ")" ::: "memory")
#define PG8_WAIT_L(n) asm volatile("s_waitcnt lgkmcnt(" #n ")" ::: "memory")
#define PG8_BAR __builtin_amdgcn_s_barrier()
#define PG8_SCHED __builtin_amdgcn_sched_barrier(0)
    Unit cur, nxt; int ui = 0;
    if (!S.next(0, cur)) return;
    unsigned cv[2][2], nv[2][2];
    if constexpr (GATHER) a_offsets<KB>(g, cur, sR, sC, cv);
    const char* cA = Ab + (size_t)cur.pm * tstep; const char* nA = cA;
    f32x4 acc[2][2][4][2];
#pragma unroll
    for (int a = 0; a < 2; ++a)
#pragma unroll
        for (int b = 0; b < 2; ++b)
#pragma unroll
            for (int m = 0; m < 4; ++m)
#pragma unroll
                for (int n = 0; n < 2; ++n) acc[a][b][m][n] = (f32x4){0.f, 0.f, 0.f, 0.f};
    bf16x8 At[4][2], B0[2][2], B1[2][2]; v8i At8[4], B08[2], B18[2];
    int unit_scale = 0x7f7f7f7f; asm volatile("" : "+v"(unit_scale));
    const char* cB = (const char*)g.Bt + (size_t)cur.e * g.bstride + (size_t)cur.pn * tstep;
    PG8_STAGE_B(PG8_SB(0, 0), cB); PG8_STAGE_B(PG8_SB(0, 1), cB + hstep); PG8_STAGE_A(PG8_SA(0, 0), 0, cv[0], cA); PG8_STAGE_A(PG8_SA(0, 1), 0, cv[1], cA + hstep);
    if (wr == 1) PG8_BAR;
    PG8_WAIT_V(2); PG8_BAR;
    PG8_STAGE_B(PG8_SB(1, 0), cB + kstep); PG8_STAGE_A(PG8_SA(1, 0), kstep, cv[0], cA); PG8_STAGE_B(PG8_SB(1, 1), cB + hstep + kstep);
    PG8_WAIT_V(6); PG8_BAR;
    for (;;) {
        const bool has_next = S.next(ui + 1, nxt);
        const char* nB = cB;
        nA = cA;
        if (has_next) { if constexpr (GATHER) a_offsets<KB>(g, nxt, sR, sC, nv); nA = Ab + (size_t)nxt.pm * tstep; nB = (const char*)g.Bt + (size_t)nxt.e * g.bstride + (size_t)nxt.pn * tstep; }
        else if constexpr (GATHER) {
#pragma unroll
            for (int h = 0; h < 2; ++h)
#pragma unroll
                for (int i = 0; i < 2; ++i) nv[h][i] = cv[h][i];
        }
        const int ntr = (PROBE_SHORTK && !cur.real) ? 2 : nt;
        const bool m00 = (cur.amask & 1) && (cur.bmask & 1), m01 = (cur.amask & 1) && (cur.bmask & 2), m10 = (cur.amask & 2) && (cur.bmask & 1), m11 = (cur.amask & 2) && (cur.bmask & 2);
#pragma nounroll
        for (int t = 0; t < ntr; t += 2) {
            const bool last = (t == ntr - 2);
            const size_t k1 = (size_t)(t + 1) * kstep, k2 = last ? 0 : (size_t)(t + 2) * kstep, k3 = k2 + kstep;
            const char* b2 = last ? nB : cB + (size_t)(t + 2) * kstep; const char* b3 = b2 + kstep;
            unsigned w0[2], w1[2];
            if constexpr (GATHER) {
#pragma unroll
                for (int i = 0; i < 2; ++i) { w0[i] = last ? nv[0][i] : cv[0][i]; w1[i] = last ? nv[1][i] : cv[1][i]; }
            }
            const char* a2 = last ? nA : cA;
            PG8_LDB(B0, 0, 0); PG8_LDB(B1, 0, 1); PG8_SCHED; PG8_LDA(At, 0, 0); PG8_STAGE_A(PG8_SA(1, 1), k1, cv[1], cA + hstep);
            PG8_WAIT_V(8); PG8_WAIT_L(0); PG8_BAR; if (m00) PG8_MMA(0, 0, At, B0); if (m01) PG8_MMA(0, 1, At, B1); PG8_BAR; PG8_SCHED;
            PG8_LDA(At, 0, 1); PG8_STAGE_B(PG8_SB(0, 0), b2); PG8_STAGE_B(PG8_SB(0, 1), b2 + hstep); PG8_STAGE_A(PG8_SA(0, 0), k2, w0, a2);
            PG8_WAIT_V(8); PG8_WAIT_L(0); PG8_BAR; if (m10) PG8_MMA(1, 0, At, B0); if (m11) PG8_MMA(1, 1, At, B1); PG8_BAR; PG8_SCHED;
            PG8_LDB(B0, 1, 0); PG8_LDB(B1, 1, 1); PG8_SCHED; PG8_LDA(At, 1, 0); PG8_STAGE_A(PG8_SA(0, 1), k2, w1, a2 + hstep);
            PG8_WAIT_V(8); PG8_WAIT_L(0); PG8_BAR; if (m00) PG8_MMA(0, 0, At, B0); if (m01) PG8_MMA(0, 1, At, B1); PG8_BAR; PG8_SCHED;
            PG8_LDA(At, 1, 1); PG8_STAGE_B(PG8_SB(1, 0), b3); PG8_STAGE_B(PG8_SB(1, 1), b3 + hstep); PG8_STAGE_A(PG8_SA(1, 0), k3, w0, a2);
            PG8_WAIT_V(8); PG8_WAIT_L(0); PG8_BAR; if (m10) PG8_MMA(1, 0, At, B0); if (m11) PG8_MMA(1, 1, At, B1); PG8_BAR; PG8_SCHED;
        }
        if constexpr (ALIGN_EPI) { if (wr == 0) PG8_BAR; }
        if constexpr (FP8) asm volatile("s_nop 15\n\ts_nop 15" ::: "memory");
        if (!PROBE_NOEPI || cur.real) E(acc, cur, wr, wc, fr, fq);
        if (!has_next) break;
#pragma unroll
        for (int a = 0; a < 2; ++a)
#pragma unroll
            for (int b = 0; b < 2; ++b)
#pragma unroll
                for (int m = 0; m < 4; ++m)
#pragma unroll
                    for (int n = 0; n < 2; ++n) acc[a][b][m][n] = (f32x4){0.f, 0.f, 0.f, 0.f};
        cur = nxt; cB = nB; cA = nA; ++ui;
        if constexpr (GATHER) {
#pragma unroll
            for (int h = 0; h < 2; ++h)
#pragma unroll
                for (int i = 0; i < 2; ++i) cv[h][i] = nv[h][i];
        }
        if constexpr (ALIGN_EPI) { if (wr == 1) PG8_BAR; }
    }
    PG8_WAIT_V(0);
    if constexpr (!ALIGN_EPI) { if (wr == 0) PG8_BAR; }
    PG8_BAR;
#undef PG8_SA
#undef PG8_SB
#undef PG8_STAGE_A
#undef PG8_STAGE_B
#undef PG8_LDA
#undef PG8_LD8
#undef PG8_LDB
#undef PG8_MMA
#undef PG8_WAIT_V
#undef PG8_WAIT_L
#undef PG8_BAR
#undef PG8_SCHED
}
}

struct TBlk { const float* src; int ldw; bf16_t* dst; unsigned char* dst8; };
__device__ __forceinline__ void tb_load(const TBlk& t, int lane, f32x4 (&v)[16]) {
    const float* p = t.src + (size_t)(lane >> 4) * t.ldw + (lane & 15) * 4;
#pragma unroll
    for (int i = 0; i < 16; ++i) v[i] = *(const f32x4*)(p + (size_t)(4 * i) * t.ldw);
}
__device__ __forceinline__ void tb_store(const TBlk& t, int lane, const f32x4 (&v)[16], LAS float* scr) {
#pragma unroll
    for (int i = 0; i < 16; ++i) { LAS float* d = scr + ((lane >> 4) + 4 * i) * 65 + (lane & 15) * 4; d[0] = v[i].x; d[1] = v[i].y; d[2] = v[i].z; d[3] = v[i].w; }
    asm volatile("s_waitcnt lgkmcnt(0)" ::: "memory"); __builtin_amdgcn_wave_barrier();
    const int c8 = lane & 7;
#pragma unroll
    for (int jj = 0; jj < 8; ++jj) {
        const int n = (lane >> 3) + 8 * jj; const LAS float* p = scr + (8 * c8) * 65 + n;
        if (t.dst8) { u32x2 o; o.x = pk4_fp8(p[0] * F8_SW, p[65] * F8_SW, p[2 * 65] * F8_SW, p[3 * 65] * F8_SW); o.y = pk4_fp8(p[4 * 65] * F8_SW, p[5 * 65] * F8_SW, p[6 * 65] * F8_SW, p[7 * 65] * F8_SW);
            *(u32x2*)(t.dst8 + (size_t)n * 1024 + 8 * c8) = o; }
        else { u32x4 o; o.x = pk2(p[0], p[65]); o.y = pk2(p[2 * 65], p[3 * 65]); o.z = pk2(p[4 * 65], p[5 * 65]); o.w = pk2(p[6 * 65], p[7 * 65]);
            *(u32x4*)(t.dst + (size_t)n * 1024 + 8 * c8) = o; }
    }
    asm volatile("s_waitcnt lgkmcnt(0)" ::: "memory"); __builtin_amdgcn_wave_barrier();
}

__device__ __forceinline__ void phase_prep(const Ctx& c) {
    LAS float* red = (LAS float*)c.lds;
    const float* cv = c.a->in[1]; const float* ccv = c.a->in[3]; const float* ada_w = c.a->in[4]; const float* ada_b = c.a->in[5];
    for (int item = c.wg; item < 193; item += c.nwg) {
        if (item < 192) {
            const int layer = item / 96, cb = item % 96, col = cb * 64 + c.lane;
            const float* W = ada_w + (size_t)layer * D * 6144 + col;
            float a0 = 0.f, a1 = 0.f;
            const int k0 = c.wave * 128;
#pragma unroll 32
            for (int k = 0; k < 128; ++k) { const float w = W[(size_t)(k0 + k) * 6144]; a0 += silu_f(cv[k0 + k]) * w; a1 += silu_f(ccv[k0 + k]) * w; }
            red[(0 * 8 + c.wave) * 64 + c.lane] = a0; red[(1 * 8 + c.wave) * 64 + c.lane] = a1;
            __syncthreads();
            if (c.tid < 128) {
                const int which = c.tid >> 6, l = c.tid & 63; float s = 0.f;
#pragma unroll
                for (int w = 0; w < 8; ++w) s += red[(which * 8 + w) * 64 + l];
                c.modp(layer, which)[cb * 64 + l] = s + ada_b[layer * 6144 + cb * 64 + l];
            }
            __syncthreads();
        } else {
            float* modbase = (float*)(c.ws + WS_MOD);
            for (int i = c.tid; i < 4096; i += 512) {
                const int pos = i >> 4, j = i & 15;
                const double ang = (double)pos * pow(10000.0, -(double)j / 16.0);
                modbase[MOD_ROPE + 2 * i] = (float)cos(ang); modbase[MOD_ROPE + 2 * i + 1] = (float)sin(ang);
            }
            const float* lbp = c.a->in[12];
            for (int i = c.tid; i < 2048; i += 512) { const float p0 = lbp[i], p1 = lbp[2048 + i]; modbase[MOD_LB + i] = 1.f / (1.f + __expf(p0 - p1)); }
        }
    }
}

__device__ __forceinline__ void row_load(const float* p, int lane, f32x4 (&v)[4]) {
#pragma unroll
    for (int j = 0; j < 4; ++j) v[j] = *(const f32x4*)(p + lane * 4 + 256 * j);
}
__device__ __forceinline__ float row_ss(const f32x4 (&v)[4]) {
    float s = 0.f;
#pragma unroll
    for (int j = 0; j < 4; ++j) s += v[j].x * v[j].x + v[j].y * v[j].y + v[j].z * v[j].z + v[j].w * v[j].w;
    return wave_sum(s);
}
__device__ __forceinline__ void row_modnorm_store(const f32x4 (&x)[4], float rstd, const float* g, const float* sh, const float* sc, bf16_t* out, int lane, f32x4 (*hout)[4] = nullptr) {
#pragma unroll
    for (int j = 0; j < 4; ++j) {
        const int c0 = lane * 4 + 256 * j;
        const f32x4 gv = *(const f32x4*)(g + c0), shv = *(const f32x4*)(sh + c0), scv = *(const f32x4*)(sc + c0);
        f32x4 h;
        h.x = x[j].x * rstd * gv.x * (1.f + scv.x) + shv.x; h.y = x[j].y * rstd * gv.y * (1.f + scv.y) + shv.y;
        h.z = x[j].z * rstd * gv.z * (1.f + scv.z) + shv.z; h.w = x[j].w * rstd * gv.w * (1.f + scv.w) + shv.w;
        if (hout) (*hout)[j] = h;
        u32x2 o; o.x = pk2(h.x, h.y); o.y = pk2(h.z, h.w);
        *(u32x2*)(out + c0) = o;
    }
}

__device__ __forceinline__ void phase_norm0(const Ctx& c) {
    bf16_t* H = (bf16_t*)(c.ws + WS_H); const float* ng = c.a->in[6];
    int r = c.wg * 8 + c.wave;
    f32x4 xn[4];
    if (r < R) row_load(c.xin0(r), c.lane, xn);
    for (; r < R; r += c.nwg * 8) {
        f32x4 x[4];
#pragma unroll
        for (int j = 0; j < 4; ++j) x[j] = xn[j];
        if (r + c.nwg * 8 < R) row_load(c.xin0(r + c.nwg * 8), c.lane, xn);
        const float rstd = rsqrtf(row_ss(x) * (1.f / D) + EPS);
        const float* m = c.modp(0, r < C ? 1 : 0);
        row_modnorm_store(x, rstd, ng, m + 0, m + 1024, H + (size_t)r * D, c.lane);
    }
}

namespace at {
constexpr int KP = 144, TILEB = 64 * KP;
__device__ __forceinline__ bf16x8 tr_frag2(const LAS unsigned char* tile, int row0, int col0, int lane) {
    const int q = (lane & 15) >> 2, p = lane & 3;
    const LAS unsigned char* a = tile + (row0 + q) * KP + (col0 + 4 * p) * 2;
    const v4i16_t lo = __builtin_amdgcn_ds_read_tr16_b64_v4i16((LAS v4i16_t*)a);
    const v4i16_t hi = __builtin_amdgcn_ds_read_tr16_b64_v4i16((LAS v4i16_t*)(a + 16 * KP));
    return (bf16x8){lo[0], lo[1], lo[2], lo[3], hi[0], hi[1], hi[2], hi[3]};
}
}
__device__ __forceinline__ void phase_attn(const Ctx& c) {
    using namespace at;
    const bf16_t* Q = (const bf16_t*)(c.ws + WS_Q); const bf16_t* K = (const bf16_t*)(c.ws + WS_K); const bf16_t* V = (const bf16_t*)(c.ws + WS_V);
    bf16_t* O = (bf16_t*)(c.ws + WS_O); const float* sink = c.a->in[9];
    LAS unsigned char* lds = c.lds;
    const int tid = c.tid, lane = c.lane, w = __builtin_amdgcn_readfirstlane(tid >> 6), fr = lane & 15, g = lane >> 4;
    const int lrow = tid >> 3, lch = tid & 7;
    const int nitn = c.nwg == 256 ? 2 : (264 - c.wg + c.nwg - 1) / c.nwg;
    for (int itn = 0; itn < nitn; ++itn) {
        int item = c.wg + itn * c.nwg;
        if (c.nwg == 256 && itn == 1) { const int n_ = c.wg >> 1; item = -1;
            if (n_ == 0) item = 256 + (c.wg & 1); else if (n_ == 127) item = 258 + (c.wg & 1); else if (n_ == 30 || n_ == 31) item = 260 + (c.wg - 60); }
        if (item < 0 || item >= 264) continue;
        const bool isctx = item >= 256;
        const int ci = item - 256;
        const int n = isctx ? 0 : (item >> 1), kh = isctx ? ((ci >> 1) & 1) : (item & 1), cb = isctx ? (ci >> 2) : 0;
        const int p_lo = isctx ? (ci & 1) : 0, p_hi = isctx ? (ci & 1) + 1 : 2;
        const int hq = kh * 8 + w;
        const float sink2 = sink[hq] * LOG2E;
        for (int pass = p_lo; pass < p_hi; ++pass) {
            const int t0 = 128 * n + 64 * pass, qrow0 = isctx ? cb * 128 + 64 * pass : C + t0;
            const int jlo = isctx ? 0 : (t0 >= 128 ? 0 : (128 - t0) / 64), jhi = isctx ? 0 : ((L - t0 + 128) / 64 < 5 ? (L - t0 + 128) / 64 : 5);
            const int ntile = 4 + (jhi - jlo);
            LAS unsigned char* qlds = lds + 4 * TILEB + w * TILEB;
#pragma unroll
            for (int qb = 0; qb < 4; ++qb)
#pragma unroll
                for (int ks = 0; ks < 2; ++ks) *(LAS bf16x8*)(qlds + (16 * qb + fr) * KP + (32 * ks + 8 * g) * 2) = *(const bf16x8*)(Q + (size_t)(qrow0 + 16 * qb + fr) * D + hq * 64 + 32 * ks + 8 * g);
            float mrow[4], lsum[4]; f32x4 OT[4][4];
#pragma unroll
            for (int qb = 0; qb < 4; ++qb) { mrow[qb] = sink2; lsum[qb] = 1.f;
#pragma unroll
                for (int nt = 0; nt < 4; ++nt) OT[qb][nt] = (f32x4){0.f, 0.f, 0.f, 0.f}; }
            u32x4 kreg, vreg;
#define AT_KROW(ti) ((ti) < 4 ? 64 * (ti) : C + t0 - 128 + 64 * (jlo + (ti) - 4))
#define AT_LOAD(ti) do { const size_t ro_ = (size_t)(AT_KROW(ti) + lrow) * 128 + kh * 64 + lch * 8; kreg = *(const u32x4*)(K + ro_); vreg = *(const u32x4*)(V + ro_); } while (0)
#define AT_WRITE(buf) do { *(LAS u32x4*)(lds + (buf) * 2 * TILEB + lrow * KP + lch * 16) = kreg; *(LAS u32x4*)(lds + (buf) * 2 * TILEB + TILEB + lrow * KP + lch * 16) = vreg; } while (0)
            AT_LOAD(0); AT_WRITE(0);
            __syncthreads();
            for (int ti = 0; ti < ntile; ++ti) {
                if (ti + 1 < ntile) AT_LOAD(ti + 1);
                const LAS unsigned char* kb = lds + (ti & 1) * 2 * TILEB; const LAS unsigned char* vb = kb + TILEB;
                const int jj = jlo + ti - 4; const bool masked = (ti >= 4) && (jj == 0 || jj == 4);
                const int k0 = t0 - 128 + 64 * jj;
                bf16x8 Kf[4][2];
#pragma unroll
                for (int mt = 0; mt < 4; ++mt)
#pragma unroll
                    for (int ks = 0; ks < 2; ++ks) Kf[mt][ks] = *(const LAS bf16x8*)(kb + (16 * mt + fr) * KP + (32 * ks + 8 * g) * 2);
                bf16x8 Vf[4][2];
#pragma unroll
                for (int mt = 0; mt < 4; ++mt)
#pragma unroll
                    for (int ks = 0; ks < 2; ++ks)
                        Vf[mt][ks] = tr_frag2(vb, 32 * ks + 4 * g, 16 * mt, lane);
#pragma unroll
                for (int qb = 0; qb < 4; ++qb) {
                    bf16x8 Qq[2];
#pragma unroll
                    for (int ks = 0; ks < 2; ++ks) Qq[ks] = *(const LAS bf16x8*)(qlds + (16 * qb + fr) * KP + (32 * ks + 8 * g) * 2);
                    f32x4 sa[4];
#pragma unroll
                    for (int mt = 0; mt < 4; ++mt) { sa[mt] = (f32x4){0.f, 0.f, 0.f, 0.f};
#pragma unroll
                        for (int ks = 0; ks < 2; ++ks) sa[mt] = __builtin_amdgcn_mfma_f32_16x16x32_bf16(Kf[mt][ks], Qq[ks], sa[mt], 0, 0, 0); }
                    if (masked) {
                        const int tq = t0 + 16 * qb + fr;
#pragma unroll
                        for (int mt = 0; mt < 4; ++mt)
#pragma unroll
                            for (int e = 0; e < 4; ++e) { const int dt = tq - (k0 + 16 * mt + 4 * g + e); if (dt > 128 || dt < -128) sa[mt][e] = -INFINITY; }
                    }
                    float mx = fmaxf(fmaxf(sa[0][0], sa[0][1]), fmaxf(sa[0][2], sa[0][3]));
#pragma unroll
                    for (int mt = 1; mt < 4; ++mt) mx = fmaxf(mx, fmaxf(fmaxf(sa[mt][0], sa[mt][1]), fmaxf(sa[mt][2], sa[mt][3])));
                    mx = fmaxf(mx, __shfl_xor(mx, 16)); mx = fmaxf(mx, __shfl_xor(mx, 32));
                    const float mn = fmaxf(mrow[qb], mx), alpha = __builtin_amdgcn_exp2f(mrow[qb] - mn);
                    mrow[qb] = mn;
                    float rs = 0.f;
#pragma unroll
                    for (int mt = 0; mt < 4; ++mt)
#pragma unroll
                        for (int e = 0; e < 4; ++e) { const float pv = __builtin_amdgcn_exp2f(sa[mt][e] - mn); sa[mt][e] = pv; rs += pv; }
                    rs += __shfl_xor(rs, 16); rs += __shfl_xor(rs, 32);
                    lsum[qb] = lsum[qb] * alpha + rs;
                    bf16x8 Pb[2];
#pragma unroll
                    for (int ks = 0; ks < 2; ++ks) { const f32x4 a0 = sa[2 * ks], a1 = sa[2 * ks + 1];
                        const u32x4 pk = (u32x4){pk2(a0[0], a0[1]), pk2(a0[2], a0[3]), pk2(a1[0], a1[1]), pk2(a1[2], a1[3])}; Pb[ks] = __builtin_bit_cast(bf16x8, pk); }
#pragma unroll
                    for (int nt = 0; nt < 4; ++nt) { OT[qb][nt] = OT[qb][nt] * alpha;
#pragma unroll
                        for (int ks = 0; ks < 2; ++ks) OT[qb][nt] = __builtin_amdgcn_mfma_f32_16x16x32_bf16(Vf[nt][ks], Pb[ks], OT[qb][nt], 0, 0, 0); }
                }
                if (ti + 1 < ntile) AT_WRITE((ti + 1) & 1);
                __syncthreads();
            }
#undef AT_KROW
#undef AT_LOAD
#undef AT_WRITE
#pragma unroll
            for (int qb = 0; qb < 4; ++qb) {
                const float il = 1.f / lsum[qb];
                bf16_t* op = O + (size_t)(qrow0 + 16 * qb + fr) * D + hq * 64 + 4 * g;
#pragma unroll
                for (int nt = 0; nt < 4; ++nt) { const f32x4 v = OT[qb][nt] * il; u32x2 o; o.x = pk2(v[0], v[1]); o.y = pk2(v[2], v[3]); *(u32x2*)(op + 16 * nt) = o; }
            }
        }
    }
}

template <int GS>
__device__ __forceinline__ void phase_postmix(const Ctx& c, int layer, bool route) {
    const float* Y = (const float*)(c.ws + WS_RAW1); unsigned char* H8 = c.ws + WS_H8;
    float* Xout = (float*)(c.ws + (layer == 0 ? WS_X : WS_X1)); const float* Xprev = (const float*)(c.ws + WS_X);
    const float* ng = c.a->in[6] + layer * 4 * D; const float* Wr = c.a->in[15] + (size_t)layer * D * NE; const float* br = c.a->in[16] + layer * NE;
    unsigned* cnt = (unsigned*)(c.ws + WS_CTL) + CW_CNT + layer * NE;
    int* tk_e = (int*)(c.ws + WS_TK); float* tk_g = (float*)(c.ws + WS_TK) + R * 4; int* tk_slot = (int*)(c.ws + WS_TK) + 2 * R * 4;
    int* list = (int*)(c.ws + WS_LIST);
    LAS float* WL = (LAS float*)c.lds;
    LAS float* biasp = (LAS float*)(c.lds + 131072);
    LAS unsigned* lcnt = (LAS unsigned*)(c.lds + 145920); LAS unsigned* lbase = lcnt + 32; LAS float* rsx = (LAS float*)(lcnt + 64);
    LAS float* pvA = (LAS float*)(c.lds + 131072 + 2560); LAS float* pvB = pvA + 1024; LAS float* pvS = pvB + 1024;
    const int lane = c.lane, w = __builtin_amdgcn_readfirstlane(c.tid >> 6), fr = lane & 15, g = lane >> 4;
    constexpr int RP = GS / 8, NW2 = GS / 16;
    const int g_lo = layer == 0 ? 0 : C / GS;
    for (int grp = g_lo + c.wg; grp < R / GS; grp += c.nwg) {
        const int which = grp * GS < C ? 1 : 0;
        const float* m = c.modp(layer, which);
        __syncthreads();
        if (c.tid < NE) lcnt[c.tid] = 0u;
#pragma unroll 4
        for (int j = 0; j < 16; ++j) {
            const int i4 = c.tid + 512 * j, k = i4 >> 3, e0 = (i4 & 7) * 4;
            const f32x4 wv = *(const f32x4*)(Wr + (size_t)k * NE + e0); const float sc = ng[2 * D + k] * (1.f + m[4096 + k]);
            LAS float* dst = WL + ((((k >> 4) * 4 + (k & 3)) * 4 + ((k >> 2) & 3)) * 16) * 2;
#pragma unroll
            for (int q = 0; q < 4; ++q) { const int e = e0 + q; dst[(e & 15) * 2 + (e >> 4)] = wv[q] * sc; }
        }
        for (int k = c.tid; k < D; k += 512) { pvA[k] = m[2048 + k] * ng[D + k]; pvB[k] = ng[2 * D + k] * (1.f + m[4096 + k]); pvS[k] = m[3072 + k]; }
        { const int e = c.tid & 31, part = c.tid >> 5; float sacc = 0.f;
#pragma unroll 16
          for (int k = part * 64; k < part * 64 + 64; ++k) sacc += m[3072 + k] * Wr[k * NE + e];
          biasp[32 + part * 32 + e] = sacc; }
        __syncthreads();
        if (c.tid < 32) { float sacc = br[c.tid];
#pragma unroll
            for (int p = 0; p < 16; ++p) sacc += biasp[32 + p * 32 + c.tid]; biasp[c.tid] = sacc; }
        __syncthreads();
        const int row1 = grp * GS + w * RP;
        f32x4 yn[4], xn[4];
        row_load(Y + (size_t)(layer == 0 ? row1 : row1 - C) * D, lane, yn); row_load(layer == 0 ? c.xin0(row1) : Xprev + (size_t)row1 * D, lane, xn);
        for (int i = 0; i < RP; ++i) {
            const int r = row1 + i;
            f32x4 y[4], x[4];
#pragma unroll
            for (int j = 0; j < 4; ++j) { y[j] = yn[j]; x[j] = xn[j]; }
            if (i + 1 < RP) { row_load(Y + (size_t)(layer == 0 ? r + 1 : r + 1 - C) * D, lane, yn); row_load(layer == 0 ? c.xin0(r + 1) : Xprev + (size_t)(r + 1) * D, lane, xn); }
            const float rstd_y = rsqrtf(row_ss(y) * (1.f / D) + EPS);
#pragma unroll
            for (int j = 0; j < 4; ++j) {
                const int c0 = lane * 4 + 256 * j;
                x[j] += *(const LAS f32x4*)(pvA + c0) * (y[j] * rstd_y);
                *(f32x4*)(Xout + (size_t)r * D + c0) = x[j];
            }
            const float rstd_x = rsqrtf(row_ss(x) * (1.f / D) + EPS);
#pragma unroll
            for (int j = 0; j < 4; ++j) {
                const int c0 = lane * 4 + 256 * j;
                const f32x4 hv = x[j] * rstd_x * *(const LAS f32x4*)(pvB + c0) + *(const LAS f32x4*)(pvS + c0);
                *(unsigned*)(H8 + (size_t)r * D + c0) = pk4_fp8(hv[0] * F8_SH, hv[1] * F8_SH, hv[2] * F8_SH, hv[3] * F8_SH);
            }
            if (lane == 0) rsx[w * RP + i] = rstd_x;
        }
        asm volatile("s_waitcnt vmcnt(0)" ::: "memory");
        __syncthreads();
        const int row0 = grp * GS + w * 16; const bool w2 = w < NW2;
        f32x4 la[2]; la[0] = (f32x4){0.f, 0.f, 0.f, 0.f}; la[1] = la[0];
        if (w2) {
            const float* ap = Xout + (size_t)(row0 + fr) * D + 4 * g;
            const LAS float* bp = WL + (g * 16 + fr) * 2;
#pragma unroll 4
            for (int k4 = 0; k4 < 64; ++k4) {
                const f32x4 a4 = *(const f32x4*)(ap + 16 * k4);
#pragma unroll
                for (int q = 0; q < 4; ++q) {
                    const f32x2 b2 = *(const LAS f32x2*)(bp + (size_t)(4 * k4 + q) * 128);
                    la[0] = __builtin_amdgcn_mfma_f32_16x16x4f32(a4[q], b2[0], la[0], 0, 0, 0);
                    la[1] = __builtin_amdgcn_mfma_f32_16x16x4f32(a4[q], b2[1], la[1], 0, 0, 0);
                }
            }
        }
        float tv[4][4]; int te[4][4];
#pragma unroll
        for (int e = 0; e < 4; ++e) {
            const float rs = rsx[(w2 ? w * 16 : 0) + 4 * g + e];
            float v0 = la[0][e] * rs + biasp[fr], v1 = la[1][e] * rs + biasp[16 + fr];
#pragma unroll
            for (int k = 0; k < 4; ++k) {
                float bv; int bi;
                if (v0 >= v1) { bv = v0; bi = fr; } else { bv = v1; bi = 16 + fr; }
#pragma unroll
                for (int o = 8; o > 0; o >>= 1) {
                    const float ov = __shfl_xor(bv, o); const int oi = __shfl_xor(bi, o);
                    if (ov > bv || (ov == bv && oi < bi)) { bv = ov; bi = oi; }
                }
                tv[e][k] = bv; te[e][k] = bi;
                if (bi == fr) v0 = -INFINITY;
                if (bi == 16 + fr) v1 = -INFINITY;
            }
        }
        float v[4]; int ex[4]; unsigned sl[4];
#pragma unroll
        for (int k = 0; k < 4; ++k) { v[k] = tv[0][k]; ex[k] = te[0][k];
#pragma unroll
            for (int e = 1; e < 4; ++e) if (fr == e) { v[k] = tv[e][k]; ex[k] = te[e][k]; } }
        if (fr < 4 && route && w2) {
#pragma unroll
            for (int k = 0; k < 4; ++k) sl[k] = __hip_atomic_fetch_add(lcnt + ex[k], 1u, __ATOMIC_RELAXED, __HIP_MEMORY_SCOPE_WORKGROUP);
        }
        __syncthreads();
        if (c.tid < NE && route) { const unsigned n = lcnt[c.tid]; lbase[c.tid] = n ? atomicAdd(&cnt[c.tid], n) : 0u; }
        __syncthreads();
        if (fr < 4 && route && w2) {
            const int r = row0 + 4 * g + fr;
            const float e1 = __expf(v[1] - v[0]), e2 = __expf(v[2] - v[0]), e3 = __expf(v[3] - v[0]);
            const float inv = 1.f / (1.f + e1 + e2 + e3);
            const float gk[4] = {inv, e1 * inv, e2 * inv, e3 * inv};
#pragma unroll
            for (int k = 0; k < 4; ++k) {
                const unsigned slot = lbase[ex[k]] + sl[k];
                list[(size_t)ex[k] * R + slot] = r;
                tk_e[r * 4 + k] = ex[k]; tk_g[r * 4 + k] = gk[k]; tk_slot[r * 4 + k] = (int)slot;
            }
        }
    }
}

__device__ __forceinline__ void moe_offsets(const Ctx& c, int layer, LAS int* so) {
    const unsigned* cnt = (const unsigned*)(c.ws + WS_CTL) + CW_CNT + layer * NE;
    __syncthreads();
    if (c.tid < 64) {
        const int n = c.tid < NE ? (int)cnt[c.tid] : 0; int pad = (n + PADM - 1) / PADM * PADM, inc = pad;
#pragma unroll
        for (int o = 1; o < 32; o <<= 1) { const int t = __shfl_up(inc, o); if (c.lane >= o) inc += t; }
        if (c.tid < NE) { so[c.tid] = inc - pad; so[64 + c.tid] = n; }
        if (c.tid == NE - 1) so[32] = inc;
    }
    __syncthreads();
}

__device__ __forceinline__ void moe_tables(const Ctx& c, int layer, LAS int* tb) {
    const unsigned* cnt = (const unsigned*)(c.ws + WS_CTL) + CW_CNT + layer * NE;
    __syncthreads();
    if (c.tid < 64) {
        const int n = c.tid < NE ? (int)cnt[c.tid] : 0; int tiles = (n + PADM - 1) / PADM, inc = tiles;
#pragma unroll
        for (int o = 1; o < 32; o <<= 1) { const int t = __shfl_up(inc, o); if (c.lane >= o) inc += t; }
        if (c.tid < NE) { tb[c.tid] = inc - tiles; tb[64 + c.tid] = n; }
        if (c.tid == NE - 1) tb[32] = inc;
    }
    __syncthreads();
}
__device__ __forceinline__ int vcu_of(const Ctx& c) { return (c.nwg % 8 == 0) ? (c.wg % 8) * (c.nwg / 8) + c.wg / 8 : c.wg; }
__device__ __forceinline__ void phase_moe_gu(const Ctx& c, int layer) {
    LAS int* tb = (LAS int*)(c.lds + 131072 + 1024);
    moe_tables(c, layer, tb);
    pg8::Gemm g{c.ws + WS_H8, c.ws + WS_WGU + (size_t)layer * NE * 2048 * 1024, (size_t)2048 * 1024, (const int*)(c.ws + WS_LIST)};
    pg8::MoeOrder S{tb, tb + 64, 8, c.nwg, vcu_of(c), false};
    pg8::EpiSwiglu E{c.ws + WS_HDN, c.a->in[18] + (size_t)layer * NE * 2048};
    pg8::gemm_phase<pg8::EpiSwiglu, pg8::MoeOrder, true, true, true>(c.lds, g, S, E, c.tid);
}
__device__ __forceinline__ void phase_moe_dn(const Ctx& c, int layer) {
    LAS int* tb = (LAS int*)(c.lds + 131072 + 1024);
    moe_tables(c, layer, tb);
    pg8::Gemm g{c.ws + WS_HDN, c.ws + WS_WDN + (size_t)layer * NE * 1024 * 1024, (size_t)1024 * 1024, nullptr};
    pg8::MoeOrder S{tb, tb + 64, 4, c.nwg, vcu_of(c), true};
    pg8::EpiBf16Bias E{(bf16_t*)(c.ws + WS_OUTB), c.a->in[20] + (size_t)layer * NE * 1024, 1024, 1.f / (F8_SHD * F8_SW)};
    pg8::gemm_phase<pg8::EpiBf16Bias, pg8::MoeOrder, true, false, true>(c.lds, g, S, E, c.tid);
}
__device__ __forceinline__ void phase_gemm_f32(const Ctx& c, const bf16_t* A, int M, const bf16_t* Bt, int N, const float* bias, float* Cout) {
    pg8::Gemm g{A, Bt, 0, nullptr}; pg8::StaticOrder S; S.init(M, N, c.nwg, c.wg);
    pg8::EpiF32 E{Cout, N, bias};
    pg8::gemm_phase<pg8::EpiF32, pg8::StaticOrder, true, false, false>(c.lds, g, S, E, c.tid);
}

__device__ __forceinline__ void phase_gemm_qkv(const Ctx& c) {
    pg8::Gemm g{(const bf16_t*)(c.ws + WS_H), (const bf16_t*)(c.ws + WS_WQKV), 0, nullptr}; pg8::StaticOrder S; S.init(R, QKVD, c.nwg, c.wg);
    pg8::EpiQKV E{(bf16_t*)(c.ws + WS_Q), (bf16_t*)(c.ws + WS_K), (bf16_t*)(c.ws + WS_V), c.a->in[8], (const float*)(c.ws + WS_MOD) + MOD_ROPE};
    pg8::gemm_phase<pg8::EpiQKV, pg8::StaticOrder, true, false, false>(c.lds, g, S, E, c.tid);
}
__device__ __forceinline__ void phase_gemm_inproj(const Ctx& c) {
    pg8::Gemm g{c.ws + WS_H8, c.ws + WS_WIN, 0, nullptr}; pg8::StaticOrder S; S.init(R, HIN, c.nwg, c.wg);
    pg8::EpiInProj E{(bf16_t*)(c.ws + WS_QH), (_Float16*)(c.ws + WS_KF), (_Float16*)(c.ws + WS_KB), (bf16_t*)(c.ws + WS_IV), (bf16_t*)(c.ws + WS_SG), (const float*)(c.ws + WS_MOD) + MOD_LB, 1.f / (F8_SH * F8_SW)};
    pg8::gemm_phase<pg8::EpiInProj, pg8::StaticOrder, true, false, true>(c.lds, g, S, E, c.tid);
}

__device__ __forceinline__ void phase_norm0(const Ctx& c);
constexpr int CONV_A = 20 * 16 + 16 * 16 + 80 * 16 + 16 * 16, CONV_B = 32 * 32 * 16 + 32 * 16 * 16, CONV_CHUNK = 64;
__device__ __forceinline__ TBlk convert_item(const Ctx& c, int it, int part) {
    constexpr int I_QKV = 20 * 16, I_O = 16 * 16, I_IN = 80 * 16, I_HO = 16 * 16, I_GU = 32 * 32 * 16;
    int r = it; TBlk t; t.dst8 = nullptr; t.dst = nullptr;
    if (part == 0) {
        if (r < I_QKV) { const int nb = r % 20, kb = r / 20; t.src = c.a->in[7] + (size_t)kb * 64 * QKVD + nb * 64; t.ldw = QKVD; t.dst = (bf16_t*)(c.ws + WS_WQKV) + (size_t)nb * 64 * 1024 + kb * 64; return t; } r -= I_QKV;
        if (r < I_O) { const int nb = r % 16, kb = r / 16; t.src = c.a->in[10] + (size_t)kb * 64 * D + nb * 64; t.ldw = D; t.dst = (bf16_t*)(c.ws + WS_WO) + (size_t)nb * 64 * 1024 + kb * 64; return t; } r -= I_O;
        if (r < I_IN) { const int nb = r % 80, kb = r / 80; t.src = c.a->in[11] + (size_t)kb * 64 * HIN + nb * 64; t.ldw = HIN; t.dst8 = c.ws + WS_WIN + (size_t)nb * 64 * 1024 + kb * 64; return t; } r -= I_IN;
        if (r < I_HO) { const int nb = r % 16, kb = r / 16; t.src = c.a->in[14] + (size_t)kb * 64 * D + nb * 64; t.ldw = D; t.dst = (bf16_t*)(c.ws + WS_WHO) + (size_t)nb * 64 * 1024 + kb * 64; return t; } r -= I_HO;
    }
    const int moff = (part - 1) * 32;
    if (r < I_GU) { const int mat = moff + r / 512, rr = r % 512, nb = rr % 32, kb = rr / 32; const int n0 = ((nb & 3) >> 1) * 1024 + (nb >> 2) * 128 + (nb & 1) * 64;
        t.src = c.a->in[17] + (size_t)mat * 1024 * 2048 + (size_t)kb * 64 * 2048 + n0; t.ldw = 2048; t.dst8 = c.ws + WS_WGU + ((size_t)mat * 2048 + nb * 64) * 1024 + kb * 64; return t; } r -= I_GU;
    { const int mat = moff + r / 256, rr = r % 256, nb = rr % 16, kb = rr / 16;
        t.src = c.a->in[19] + (size_t)mat * 1024 * 1024 + (size_t)kb * 64 * 1024 + nb * 64; t.ldw = 1024; t.dst8 = c.ws + WS_WDN + ((size_t)mat * 1024 + nb * 64) * 1024 + kb * 64; }
    return t;
}
__device__ __forceinline__ void convert_run(const Ctx& c, int part, int first, int step, int end, LAS float* scr) {
    f32x4 va[16], vb[16];
    int it = first;
    TBlk ta, tbk;
    if (it < end) { ta = convert_item(c, it, part); tb_load(ta, c.lane, va); }
    for (; it < end; it += 2 * step) {
        const bool hb = it + step < end;
        if (hb) { tbk = convert_item(c, it + step, part); tb_load(tbk, c.lane, vb); }
        tb_store(ta, c.lane, va, scr);
        const bool ha = it + 2 * step < end;
        if (ha) { ta = convert_item(c, it + 2 * step, part); tb_load(ta, c.lane, va); }
        if (hb) tb_store(tbk, c.lane, vb, scr);
    }
}
__device__ __forceinline__ void convert_steal(const Ctx& c, int part) {
    LAS float* scr = (LAS float*)c.lds + c.wave * (64 * 65);
    LAS int* chp = (LAS int*)(c.lds + 8 * 64 * 65 * 4);
    unsigned* ctr = (unsigned*)(c.ws + WS_CTL) + CW_CONV + 64 * part;
    for (;;) {
        __syncthreads();
        if (c.tid == 0) *chp = (int)atomicAdd(ctr, 1u);
        __syncthreads();
        const int ch = *chp;
        if (ch >= CONV_B / CONV_CHUNK) break;
        convert_run(c, part, ch * CONV_CHUNK + c.wave, 8, (ch + 1) * CONV_CHUNK, scr);
    }
}
__device__ __forceinline__ void phase_convert(const Ctx& c) {
    LAS float* scr = (LAS float*)c.lds + c.wave * (64 * 65);
    convert_run(c, 0, c.wg * 8 + c.wave, c.nwg * 8, CONV_A, scr);
    __syncthreads();
    phase_norm0(c);
}

__device__ __forceinline__ void phase_combine(const Ctx& c, int layer) {
    LAS int* so = (LAS int*)(c.lds + 32768);
    moe_offsets(c, layer, so);
    const bf16_t* outb = (const bf16_t*)(c.ws + WS_OUTB); float* X = (float*)(c.ws + WS_X); bf16_t* H = (bf16_t*)(c.ws + WS_H);
    const float* Xin = layer == 0 ? X : (const float*)(c.ws + WS_X1);
    const float* ngl = c.a->in[6] + layer * 4 * D;
    const int* tk_e = (const int*)(c.ws + WS_TK); const float* tk_g = (const float*)(c.ws + WS_TK) + R * 4; const int* tk_slot = (const int*)(c.ws + WS_TK) + 2 * R * 4;
    const int r_lo = layer == 0 ? 0 : C, stride = c.nwg * 8;
    int r = r_lo + c.wg * 8 + c.wave;
    int pe[4], ps[4]; float pg[4]; u32x2 wn[4][4]; f32x4 xn[4]; float gn[4];
#define CB_TK(row) do { _Pragma("unroll") for (int k = 0; k < 4; ++k) { pe[k] = tk_e[(row) * 4 + k]; ps[k] = tk_slot[(row) * 4 + k]; pg[k] = tk_g[(row) * 4 + k]; } } while (0)
#define CB_DATA(row) do { _Pragma("unroll") for (int k = 0; k < 4; ++k) { const bf16_t* src_ = outb + (size_t)(so[pe[k]] + ps[k]) * 1024; gn[k] = pg[k]; \
        _Pragma("unroll") for (int j = 0; j < 4; ++j) wn[k][j] = *(const u32x2*)(src_ + c.lane * 4 + 256 * j); } row_load(Xin + (size_t)(row) * D, c.lane, xn); } while (0)
    if (r < R) { CB_TK(r); CB_DATA(r); }
    if (r + stride < R) CB_TK(r + stride);
    for (; r < R; r += stride) {
        const float* m = c.modp(layer, r < C ? 1 : 0);
        f32x4 y[4], x[4];
#pragma unroll
        for (int j = 0; j < 4; ++j) { y[j] = (f32x4){0.f, 0.f, 0.f, 0.f}; x[j] = xn[j]; }
#pragma unroll
        for (int k = 0; k < 4; ++k)
#pragma unroll
            for (int j = 0; j < 4; ++j) { const u32x2 w = wn[k][j]; y[j] += (f32x4){bflo(w.x), bfhi(w.x), bflo(w.y), bfhi(w.y)} * gn[k]; }
        if (r + stride < R) CB_DATA(r + stride);
        if (r + 2 * stride < R) CB_TK(r + 2 * stride);
        const float rstd_y = rsqrtf(row_ss(y) * (1.f / D) + EPS);
#pragma unroll
        for (int j = 0; j < 4; ++j) {
            const int c0 = c.lane * 4 + 256 * j;
            const f32x4 g2 = *(const f32x4*)(m + 5120 + c0), n3 = *(const f32x4*)(ngl + 3 * D + c0);
            x[j].x += g2.x * (y[j].x * rstd_y * n3.x); x[j].y += g2.y * (y[j].y * rstd_y * n3.y);
            x[j].z += g2.z * (y[j].z * rstd_y * n3.z); x[j].w += g2.w * (y[j].w * rstd_y * n3.w);
            if (layer == 0) *(f32x4*)(X + (size_t)r * D + c0) = x[j];
            else *(f32x4*)(c.a->out + (size_t)(r - C) * D + c0) = x[j];
        }
        if (layer == 0) {
            const float rstd_x = rsqrtf(row_ss(x) * (1.f / D) + EPS);
            const float* m1 = c.modp(1, r < C ? 1 : 0); const float* g0 = c.a->in[6] + 4 * D;
#pragma unroll
            for (int j = 0; j < 4; ++j) {
                const int c0 = c.lane * 4 + 256 * j;
                const f32x4 gv = *(const f32x4*)(g0 + c0), shv = *(const f32x4*)(m1 + c0), scv = *(const f32x4*)(m1 + 1024 + c0);
                const f32x4 hv = x[j] * rstd_x * gv * (scv + 1.f) + shv;
                *(unsigned*)(c.ws + WS_H8 + (size_t)r * D + c0) = pk4_fp8(hv[0] * F8_SH, hv[1] * F8_SH, hv[2] * F8_SH, hv[3] * F8_SH);
            }
        }
    }
#undef CB_TK
#undef CB_DATA
}

namespace hg {
typedef _Float16 h2_t __attribute__((ext_vector_type(2)));
constexpr int TB = 272, PB = 144;
constexpr int TILE = 64 * TB;
constexpr int T_QD = 0, T_QC = TILE, T_KD = 2 * TILE, T_KE = 3 * TILE, T_KC = 4 * TILE, T_V0 = 5 * TILE, T_V1 = 6 * TILE;
constexpr int T_QL1 = 7 * TILE, T_KL1 = T_QL1 + 16 * TB, T_P = T_KL1 + 16 * TB, T_TOT = T_P + 64 * PB, T_CT = T_TOT + 4096, T_END = T_CT + 512;
static_assert(T_END <= LDS_BYTES - 64, "hgrn scan LDS map");
__device__ __forceinline__ int row_of(int dir, int p) { return p < C ? (dir ? C - 1 - p : p) : (dir ? C + (L - 1 - (p - C)) : p); }
__device__ __forceinline__ int seg_of(int ch) { return ch < 68 ? ch / 17 : 4 + (ch - 68) / 16; }
__device__ __forceinline__ bf16x8 tr_frag(const LAS unsigned char* tile, int row0, int col0, int lane) {
    const int q = (lane & 15) >> 2, p = lane & 3;
    const LAS unsigned char* a = tile + (row0 + q) * TB + (col0 + 4 * p) * 2;
    const v4i16_t lo = __builtin_amdgcn_ds_read_tr16_b64_v4i16((LAS v4i16_t*)a);
    const v4i16_t hi = __builtin_amdgcn_ds_read_tr16_b64_v4i16((LAS v4i16_t*)(a + 4 * TB));
    return (bf16x8){lo[0], lo[1], lo[2], lo[3], hi[0], hi[1], hi[2], hi[3]};
}
}

__device__ __forceinline__ void phase_hgrn_scan(const Ctx& c) {
    using namespace hg;
#define HG_BAR() asm volatile("s_waitcnt lgkmcnt(0)\n\ts_barrier" ::: "memory")
    const bf16_t* QH = (const bf16_t*)(c.ws + WS_QH); const bf16_t* IV = (const bf16_t*)(c.ws + WS_IV);
    LAS unsigned char* lds = c.lds;
    const int tid = c.tid, lane = c.lane, w = __builtin_amdgcn_readfirstlane(tid >> 6), fr = lane & 15, g = lane >> 4;
    for (int item_ = c.wg; item_ < 256 * SCAN_REP; item_ += c.nwg) {
        const int item = item_ & 255;
        const int chain = item >> 4, seg = item & 15, head = chain >> 1, dir = chain & 1, hc = head * 128;
        const int c0 = seg < 4 ? 17 * seg : 68 + 16 * (seg - 4), nch = seg < 4 ? 17 : 16;
        const _Float16* KX = (const _Float16*)(c.ws + (dir ? WS_KB : WS_KF));
        float* OL = (float*)(c.ws + (dir ? WS_OB : WS_OF)); bf16_t* QS = (bf16_t*)(c.ws + (dir ? WS_QSB : WS_QSF));
        HG_BAR();
        for (int i = tid; i < 64 * PB / 4; i += 512) ((LAS unsigned*)(lds + T_P))[i] = 0u;
        f32x4 Sacc[8];
#pragma unroll
        for (int m = 0; m < 8; ++m) Sacc[m] = (f32x4){0.f, 0.f, 0.f, 0.f};
        float dseg0 = 1.f, dseg1 = 1.f;
        unsigned kraw[8], qraw[8]; u32x4 vraw[2];
#define HG_LOAD(cidx) do { const int p0_ = 64 * (cidx); const bool lat_ = (cidx) >= 4; \
        _Pragma("unroll") for (int i = 0; i < 8; ++i) { const int r_ = row_of(dir, p0_ + 8 * w + i); \
            kraw[i] = *(const unsigned*)(KX + (size_t)r_ * D + hc + 2 * lane); \
            qraw[i] = lat_ ? *(const unsigned*)(QH + (size_t)(r_ - C) * D + hc + 2 * lane) : 0u; } \
        _Pragma("unroll") for (int i = 0; i < 2; ++i) { const int idx_ = tid + 512 * i; const int r_ = row_of(dir, p0_ + (idx_ >> 4)); \
            vraw[i] = *(const u32x4*)(IV + (size_t)r_ * D + hc + (idx_ & 15) * 8); } } while (0)
        HG_LOAD(c0);
        for (int ci = 0; ci < nch; ++ci) {
            const int cidx = c0 + ci; const bool lat = cidx >= 4;
            const int vbuf = (ci & 1) ? T_V1 : T_V0;
            float kf[8][2], qf[8][2], cp[8][2];
            {
                float p0 = 1.f, p1 = 1.f;
#pragma unroll
                for (int i = 0; i < 8; ++i) {
                    const h2_t hv = __builtin_bit_cast(h2_t, kraw[i]);
                    kf[i][0] = (float)hv[0]; kf[i][1] = (float)hv[1];
                    qf[i][0] = bflo(qraw[i]); qf[i][1] = bfhi(qraw[i]);
                    p0 *= (1.f - kf[i][0]); p1 *= (1.f - kf[i][1]); cp[i][0] = p0; cp[i][1] = p1;
                }
                *(LAS f32x2*)(lds + T_TOT + (w * 128 + 2 * lane) * 4) = (f32x2){p0, p1};
#pragma unroll
                for (int i = 0; i < 2; ++i) { const int idx = tid + 512 * i; *(LAS u32x4*)(lds + vbuf + (idx >> 4) * TB + (idx & 15) * 16) = vraw[i]; }
            }
            HG_BAR();
            {
                f32x2 T[8];
#pragma unroll
                for (int x = 0; x < 8; ++x) T[x] = *(const LAS f32x2*)(lds + T_TOT + (x * 128 + 2 * lane) * 4);
                const int I = w >> 1, hh = w & 1;
                f32x2 bd[4];
#pragma unroll
                for (int x = 0; x < 4; ++x) bd[x] = T[2 * x] * T[2 * x + 1];
                f32x2 pre = (f32x2){1.f, 1.f}, cum = (f32x2){1.f, 1.f}, suf = (f32x2){1.f, 1.f}, bdI = (f32x2){1.f, 1.f};
#pragma unroll
                for (int x = 0; x < 8; ++x) if (hh && x == w - 1) pre = T[x];
#pragma unroll
                for (int x = 0; x < 4; ++x) { if (x < I) cum = cum * bd[x]; if (x > I) suf = suf * bd[x]; if (x == I) bdI = bd[x]; }
                const f32x2 ctot = (bd[0] * bd[1]) * (bd[2] * bd[3]);
#pragma unroll
                for (int i = 0; i < 8; ++i) {
                    const int tau = 8 * w + i;
                    float QDv[2], KDv[2], KEv[2], QCv[2], KCv[2];
#pragma unroll
                    for (int x = 0; x < 2; ++x) {
                        const float eq = pre[x] * cp[i][x], rc = __builtin_amdgcn_rcpf(eq);
                        QDv[x] = qf[i][x] * eq; KDv[x] = kf[i][x] * rc; KEv[x] = KDv[x] * bdI[x]; QCv[x] = QDv[x] * cum[x]; KCv[x] = KEv[x] * suf[x];
                    }
                    const int to = tau * TB + lane * 4;
                    *(LAS unsigned*)(lds + T_QD + to) = pk2(QDv[0], QDv[1]);
                    *(LAS unsigned*)(lds + T_KD + to) = pk2(KDv[0], KDv[1]);
                    *(LAS unsigned*)(lds + T_KE + to) = pk2(KEv[0], KEv[1]);
                    *(LAS unsigned*)(lds + T_QC + to) = pk2(QCv[0], QCv[1]);
                    *(LAS unsigned*)(lds + T_KC + to) = pk2(KCv[0], KCv[1]);
                    if (I == 3) *(LAS unsigned*)(lds + T_QL1 + (tau - 48) * TB + lane * 4) = pk2(QDv[0] * bd[2][0], QDv[1] * bd[2][1]);
                    if (I == 0) *(LAS unsigned*)(lds + T_KL1 + tau * TB + lane * 4) = pk2(KEv[0] * bd[1][0], KEv[1] * bd[1][1]);
                    if (lat) { const int r = row_of(dir, 64 * cidx + tau); *(unsigned*)(QS + (size_t)(r - C) * D + hc + 2 * lane) = pk2(QCv[0] * dseg0, QCv[1] * dseg1); }
                }
                dseg0 *= ctot[0]; dseg1 *= ctot[1];
                if (w == 0) *(LAS f32x2*)(lds + T_CT + lane * 8) = ctot;
            }
            HG_BAR();
            if (ci + 1 < nch) HG_LOAD(cidx + 1);
            if (lat) {
                const int nblk = w >= 6 ? 2 : 1;
                for (int b = 0; b < nblk; ++b) {
                    int I, J, qoff, qrow, koff, krow; bool diag = false;
                    if (w < 4) { I = 2 + (w >> 1); J = w & 1; qoff = (w >> 1) ? T_QL1 : T_QD; qrow = (w >> 1) ? 0 : 32; koff = (w & 1) ? T_KE : T_KL1; krow = (w & 1) ? 16 : 0; }
                    else if (w == 4) { I = 1; J = 0; qoff = T_QD; qrow = 16; koff = T_KE; krow = 0; }
                    else if (w == 5) { I = 3; J = 2; qoff = T_QD; qrow = 48; koff = T_KE; krow = 32; }
                    else { I = 2 * (w - 6) + b; J = I; qoff = T_QD; qrow = 16 * I; koff = T_KD; krow = 16 * I; diag = true; }
                    f32x4 pa = (f32x4){0.f, 0.f, 0.f, 0.f};
#pragma unroll
                    for (int ks = 0; ks < 4; ++ks) {
                        const bf16x8 av = *(const LAS bf16x8*)(lds + qoff + (qrow + fr) * TB + (32 * ks + 8 * g) * 2);
                        const bf16x8 bv = *(const LAS bf16x8*)(lds + koff + (krow + fr) * TB + (32 * ks + 8 * g) * 2);
                        pa = __builtin_amdgcn_mfma_f32_16x16x32_bf16(av, bv, pa, 0, 0, 0);
                    }
#pragma unroll
                    for (int e = 0; e < 4; ++e) {
                        const int tl = 4 * g + e; const float val = (diag && fr > tl) ? 0.f : pa[e];
                        *(LAS bf16_t*)(lds + T_P + (16 * I + tl) * PB + (16 * J + fr) * 2) = (bf16_t)f2bf(val);
                    }
                }
            }
            f32x4 oacc[4];
#pragma unroll
            for (int m = 0; m < 4; ++m) oacc[m] = (f32x4){0.f, 0.f, 0.f, 0.f};
            if (lat) {
                bf16x8 Sb[4];
#pragma unroll
                for (int ks = 0; ks < 4; ++ks) {
                    const f32x4 a0 = Sacc[2 * ks], a1 = Sacc[2 * ks + 1];
                    const u32x4 pk = (u32x4){pk2(a0[0], a0[1]), pk2(a0[2], a0[3]), pk2(a1[0], a1[1]), pk2(a1[2], a1[3])};
                    Sb[ks] = __builtin_bit_cast(bf16x8, pk);
                }
#pragma unroll
                for (int m = 0; m < 4; ++m)
#pragma unroll
                    for (int ks = 0; ks < 4; ++ks) {
                        const u32x2 lo = *(const LAS u32x2*)(lds + T_QC + (16 * m + fr) * TB + (32 * ks + 4 * g) * 2);
                        const u32x2 hi = *(const LAS u32x2*)(lds + T_QC + (16 * m + fr) * TB + (32 * ks + 16 + 4 * g) * 2);
                        const u32x4 pk = (u32x4){lo.x, lo.y, hi.x, hi.y};
                        oacc[m] = __builtin_amdgcn_mfma_f32_16x16x32_bf16(__builtin_bit_cast(bf16x8, pk), Sb[ks], oacc[m], 0, 0, 0);
                    }
            }
#pragma unroll
            for (int m = 0; m < 8; ++m) { const f32x4 ct = *(const LAS f32x4*)(lds + T_CT + (16 * m + 4 * g) * 4); Sacc[m] = Sacc[m] * ct; }
            bf16x8 Vf[2];
#pragma unroll
            for (int ks = 0; ks < 2; ++ks) Vf[ks] = tr_frag(lds + vbuf, 32 * ks + 8 * g, 16 * w, lane);
#pragma unroll
            for (int m = 0; m < 8; ++m)
#pragma unroll
                for (int ks = 0; ks < 2; ++ks) Sacc[m] = __builtin_amdgcn_mfma_f32_16x16x32_bf16(tr_frag(lds + T_KC, 32 * ks + 8 * g, 16 * m, lane), Vf[ks], Sacc[m], 0, 0, 0);
            HG_BAR();
            if (lat) {
#pragma unroll
                for (int m = 0; m < 4; ++m)
#pragma unroll
                    for (int ks = 0; ks < 2; ++ks) {
                        if (m < 2 && ks == 1) continue;
                        const bf16x8 av = *(const LAS bf16x8*)(lds + T_P + (16 * m + fr) * PB + (32 * ks + 8 * g) * 2);
                        oacc[m] = __builtin_amdgcn_mfma_f32_16x16x32_bf16(av, Vf[ks], oacc[m], 0, 0, 0);
                    }
#pragma unroll
                for (int m = 0; m < 4; ++m)
#pragma unroll
                    for (int e = 0; e < 4; ++e) { const int r = row_of(dir, 64 * cidx + 16 * m + 4 * g + e); OL[(size_t)(r - C) * D + hc + 16 * w + fr] = oacc[m][e]; }
            }
        }
#undef HG_LOAD
        float* DS = (float*)(c.ws + WS_DS) + (size_t)item * 16384; float* DG = (float*)(c.ws + WS_DG) + item * 128;
#pragma unroll
        for (int m = 0; m < 8; ++m)
#pragma unroll
            for (int e = 0; e < 4; ++e) DS[(16 * m + 4 * g + e) * 128 + 16 * w + fr] = Sacc[m][e];
        if (w == 0) { DG[2 * lane] = dseg0; DG[2 * lane + 1] = dseg1; }
    }
}

#undef HG_BAR
__device__ __forceinline__ void phase_hgrn_fold(const Ctx& c) {
    const float* DS = (const float*)(c.ws + WS_DS); const float* DG = (const float*)(c.ws + WS_DG); bf16_t* SST = (bf16_t*)(c.ws + WS_SST);
    for (int item = c.wg; item < 256; item += c.nwg) {
        const int chain = item >> 4, slice = item & 15, d = 8 * slice + (c.tid >> 6), v2 = (c.tid & 63) * 2;
        float s0 = 0.f, s1 = 0.f;
        float dv[15]; f32x2 ds[15];
#pragma unroll
        for (int sgi = 0; sgi < 15; ++sgi) { dv[sgi] = DG[(chain * 16 + sgi) * 128 + d]; ds[sgi] = *(const f32x2*)(DS + ((size_t)(chain * 16 + sgi) * 128 + d) * 128 + v2); }
        SST[((size_t)(chain * 16) * 128 + v2) * 128 + d] = 0; SST[((size_t)(chain * 16) * 128 + v2 + 1) * 128 + d] = 0;
#pragma unroll
        for (int sgi = 0; sgi < 15; ++sgi) {
            s0 = dv[sgi] * s0 + ds[sgi][0]; s1 = dv[sgi] * s1 + ds[sgi][1];
            SST[((size_t)(chain * 16 + sgi + 1) * 128 + v2) * 128 + d] = (bf16_t)f2bf(s0); SST[((size_t)(chain * 16 + sgi + 1) * 128 + v2 + 1) * 128 + d] = (bf16_t)f2bf(s1);
        }
    }
}

__device__ __forceinline__ void phase_hgrn_readout(const Ctx& c) {
    constexpr int SP = 272, SBUF = 128 * SP, IBUF = 2 * SBUF;
    static_assert(2 * IBUF + 1024 <= LDS_BYTES - 64, "readout LDS map");
    const float* OF = (const float*)(c.ws + WS_OF); const float* OB = (const float*)(c.ws + WS_OB); const bf16_t* SGp = (const bf16_t*)(c.ws + WS_SG);
    const bf16_t* SST = (const bf16_t*)(c.ws + WS_SST); bf16_t* RR = (bf16_t*)(c.ws + WS_RR); const float* hng = c.a->in[13];
    LAS unsigned char* lds = c.lds; LAS float* ssx = (LAS float*)(c.lds + 2 * IBUF);
    const int tid = c.tid, lane = c.lane, w = __builtin_amdgcn_readfirstlane(tid >> 6), fr = lane & 15, g = lane >> 4, mt = w & 3, nh = w >> 2;
#define RO_BAR() asm volatile("s_waitcnt lgkmcnt(0)\n\ts_barrier" ::: "memory")
    u32x4 sreg[8];
#define RO_SST_LOAD(it) do { const int h_ = (it) >> 8, ch_ = (it) & 255; \
        _Pragma("unroll") for (int j = 0; j < 8; ++j) { const int idx_ = tid + 512 * j, dx_ = idx_ >> 11, rem_ = idx_ & 2047; \
            const int sg_ = hg::seg_of(dx_ ? 4 + 255 - ch_ : 4 + ch_); \
            sreg[j] = *(const u32x4*)(SST + ((size_t)((h_ * 2 + dx_) * 16 + sg_) * 128 + (rem_ >> 4)) * 128 + (rem_ & 15) * 8); } } while (0)
#define RO_SST_WRITE(buf) do { _Pragma("unroll") for (int j = 0; j < 8; ++j) { const int idx_ = tid + 512 * j, dx_ = idx_ >> 11, rem_ = idx_ & 2047; \
            *(LAS u32x4*)(lds + (buf) * IBUF + dx_ * SBUF + (rem_ >> 4) * SP + (rem_ & 15) * 16) = sreg[j]; } } while (0)
    int it = c.wg;
    RO_BAR();
    if (it < 2048) { RO_SST_LOAD(it); RO_SST_WRITE(0); }
    RO_BAR();
    for (int k = 0; it < 2048; it += c.nwg, ++k) {
        const int h = it >> 8, ch = it & 255, t0 = 64 * ch + 16 * mt, buf = k & 1;
        const bool has_next = it + c.nwg < 2048;
        if (has_next) RO_SST_LOAD(it + c.nwg);
        f32x4 acc[4]; float sgv[4][4];
#pragma unroll
        for (int n = 0; n < 4; ++n)
#pragma unroll
            for (int e = 0; e < 4; ++e) { const size_t o = (size_t)(t0 + 4 * g + e) * D + h * 128 + 64 * nh + 16 * n + fr; acc[n][e] = OF[o] + OB[o]; sgv[n][e] = bf2f(SGp[o]) * hng[h * 128 + 64 * nh + 16 * n + fr]; }
#pragma unroll
        for (int dx = 0; dx < 2; ++dx) {
            const bf16_t* QS = (const bf16_t*)(c.ws + (dx ? WS_QSB : WS_QSF)) + (size_t)(t0 + fr) * D + h * 128 + 8 * g;
            const LAS unsigned char* sb = lds + buf * IBUF + dx * SBUF + (64 * nh + fr) * SP + 16 * g;
#pragma unroll
            for (int ks = 0; ks < 4; ++ks) {
                const bf16x8 av = *(const bf16x8*)(QS + 32 * ks);
#pragma unroll
                for (int n = 0; n < 4; ++n) acc[n] = __builtin_amdgcn_mfma_f32_16x16x32_bf16(av, *(const LAS bf16x8*)(sb + (16 * n) * SP + 64 * ks), acc[n], 0, 0, 0);
            }
        }
        float ss[4] = {0.f, 0.f, 0.f, 0.f};
#pragma unroll
        for (int n = 0; n < 4; ++n)
#pragma unroll
            for (int e = 0; e < 4; ++e) ss[e] += acc[n][e] * acc[n][e];
#pragma unroll
        for (int e = 0; e < 4; ++e) {
#pragma unroll
            for (int sh = 8; sh > 0; sh >>= 1) ss[e] += __shfl_xor(ss[e], sh);
        }
        if (fr == 0) *(LAS f32x4*)(ssx + ((k & 1) * 8 + w) * 16 + 4 * g) = (f32x4){ss[0], ss[1], ss[2], ss[3]};
        if (has_next) RO_SST_WRITE(buf ^ 1);
        RO_BAR();
        const f32x4 ps = *(const LAS f32x4*)(ssx + ((k & 1) * 8 + (w ^ 4)) * 16 + 4 * g);
#pragma unroll
        for (int e = 0; e < 4; ++e) ss[e] = rsqrtf((ss[e] + ps[e]) * (1.f / 128.f) + EPS);
#pragma unroll
        for (int n = 0; n < 4; ++n)
#pragma unroll
            for (int e = 0; e < 4; ++e) { const size_t o = (size_t)(t0 + 4 * g + e) * D + h * 128 + 64 * nh + 16 * n + fr; RR[o] = (bf16_t)f2bf(acc[n][e] * ss[e] * sgv[n][e]); }
    }
    RO_BAR();
#undef RO_BAR
#undef RO_SST_LOAD
#undef RO_SST_WRITE
}

#define XB_TMO      128
#define XB_XCNT(j)  (256  + 64 * (j))
#define XB_XSUB(j)  (1280 + 64 * (j))
#define XB_XGEN(j)  (2304 + 64 * (j))
#define XB_TOP      3328
#define XB_TOPGEN   3392
#define XCD_BAR_WORDS 3456
#define XB_SPIN_CAP (1u << 18)
__device__ __forceinline__ unsigned xb_ld(unsigned* p)              { return __hip_atomic_load(p, __ATOMIC_RELAXED, __HIP_MEMORY_SCOPE_AGENT); }
__device__ __forceinline__ unsigned xb_add(unsigned* p, unsigned v) { return __hip_atomic_fetch_add(p, v, __ATOMIC_RELAXED, __HIP_MEMORY_SCOPE_AGENT); }
__device__ __forceinline__ unsigned xb_xcc_id() { return (unsigned)__builtin_amdgcn_s_getreg((3 << 11) | 20) & 0xFu; }
#define XB_SPIN(cond, bar) do { unsigned _sp = 0; while (cond) { __builtin_amdgcn_s_sleep(1); \
    if ((++_sp & 255u) == 0u) { if (xb_ld(&(bar)[XB_TMO])) break; if (_sp > XB_SPIN_CAP) { atomicAdd(&(bar)[XB_TMO], 1u); break; } } } } while (0)
struct XcdBarrier { unsigned* bar; unsigned x; volatile LAS unsigned* st; };
__device__ __forceinline__ XcdBarrier xcd_barrier_post(unsigned* bar, volatile LAS unsigned* st) {
    XcdBarrier b; b.bar = bar; b.x = xb_xcc_id(); b.st = st;
    if (threadIdx.x == 0) (void)xb_add(&bar[XB_XCNT(b.x)], 1u);
    return b;
}
__device__ __forceinline__ void xcd_barrier_complete(unsigned* bar, unsigned x, unsigned& nloc, unsigned& nx) {
    const unsigned G = gridDim.x * gridDim.y * gridDim.z;
    unsigned sum, cnt, mine, sp = 0u;
    for (;;) {
        sum = 0u; cnt = 0u; mine = 0u;
#pragma unroll
        for (unsigned j = 0; j < 16; ++j) { const unsigned c = xb_ld(&bar[XB_XCNT(j)]); sum += c; cnt += (c > 0u) ? 1u : 0u; mine = (j == x) ? c : mine; }
        if (sum == G) break;
        __builtin_amdgcn_s_sleep(1);
        if ((++sp & 255u) == 0u) { if (xb_ld(&bar[XB_TMO])) break; if (sp > XB_SPIN_CAP) { atomicAdd(&bar[XB_TMO], 1u); break; } }
    }
    nloc = mine > 0u ? mine : 1u; nx = cnt > 0u ? cnt : 1u;
}
__device__ __forceinline__ void xcd_barrier(const XcdBarrier& b) {
    asm volatile("s_waitcnt vmcnt(0)" ::: "memory");
    __syncthreads();
    if (threadIdx.x == 0) {
        unsigned* bar = b.bar;
        __builtin_amdgcn_s_waitcnt(0);
        unsigned nloc = b.st[0], nx = b.st[1];
        if (nloc == 0u) { xcd_barrier_complete(bar, b.x, nloc, nx); b.st[0] = nloc; b.st[1] = nx; }
        const unsigned old = xb_add(&bar[XB_XSUB(b.x)], 1u);
        const unsigned gen = old / nloc;
        if (old + 1u == (gen + 1u) * nloc) {
            __builtin_amdgcn_fence(__ATOMIC_RELEASE, "agent");
            asm volatile("s_waitcnt vmcnt(0)" ::: "memory");
            const unsigned og = xb_add(&bar[XB_TOP], 1u);
            const unsigned tg = og / nx;
            if (og + 1u == (tg + 1u) * nx) xb_add(&bar[XB_TOPGEN], 1u);
            else XB_SPIN(xb_ld(&bar[XB_TOPGEN]) == tg, bar);
            __builtin_amdgcn_fence(__ATOMIC_ACQUIRE, "agent");
            xb_add(&bar[XB_XGEN(b.x)], 1u);
            asm volatile("s_waitcnt vmcnt(0)" ::: "memory");
        } else {
            XB_SPIN(xb_ld(&bar[XB_XGEN(b.x)]) == gen, bar);
            __builtin_amdgcn_fence(__ATOMIC_ACQUIRE, "agent");
            asm volatile("s_waitcnt vmcnt(0)" ::: "memory");
        }
    }
    __syncthreads();
}

__device__ __forceinline__ void launder(Ctx& c) { asm volatile("" : "+s"(c.a)); asm volatile("" : "+s"(c.ws)); asm volatile("" : "+s"(c.wave));
    c.lane = (int)__builtin_amdgcn_mbcnt_hi(~0u, __builtin_amdgcn_mbcnt_lo(~0u, 0u)); c.tid = c.wave * 64 + c.lane; }
__global__ void __launch_bounds__(512, 2) mk_fwd(Args args) {
    extern __shared__ __attribute__((aligned(16))) unsigned char lds_raw[];
    Ctx c; c.a = (CArgs)__builtin_amdgcn_kernarg_segment_ptr(); c.lds = (LAS unsigned char*)lds_raw; c.tid = threadIdx.x; c.lane = c.tid & 63; c.wave = __builtin_amdgcn_readfirstlane(c.tid >> 6); c.nwg = gridDim.x; c.wg = blockIdx.x; c.ws = c.a->ws;
    volatile LAS unsigned* bst = (volatile LAS unsigned*)(c.lds + LDS_BYTES - 64);
    if (c.tid < 4) bst[c.tid] = 0u;
    __syncthreads();
    const XcdBarrier bar = xcd_barrier_post((unsigned*)(c.ws + WS_CTL) + CW_BAR, bst);
    const int lo = c.a->ph_lo, hi = c.a->ph_hi;
    bool route_ok = true;
#define SEAM(k) do { if (lo <= (k) && (k) + 1 < hi) xcd_barrier(bar); } while (0)
#define IN(k) (lo <= (k) && (k) < hi && (launder(c), true))
#define PH(k, call) do { if (IN(k)) { if (PROBE_PH == (k)) { int nrep_ = 3; asm volatile("" : "+s"(nrep_)); for (int rep_ = 0; rep_ < nrep_; ++rep_) { route_ok = (rep_ + 1 == nrep_); call; if (rep_ + 1 < nrep_) xcd_barrier(bar); } } else { call; } } SEAM(k); } while (0)
    PH(0, phase_prep(c));
    PH(1, phase_convert(c));
    PH(2, phase_gemm_qkv(c));
    PH(3, phase_attn(c));
    PH(4, phase_gemm_f32(c, (const bf16_t*)(c.ws + WS_O), R, (const bf16_t*)(c.ws + WS_WO), D, nullptr, (float*)(c.ws + WS_RAW1)));
    PH(5, { phase_postmix<128>(c, 0, route_ok); convert_steal(c, 1); });
    PH(6, phase_moe_gu(c, 0));
    PH(7, phase_moe_dn(c, 0));
    PH(8, phase_combine(c, 0));
    PH(9, phase_gemm_inproj(c));
    PH(10, phase_hgrn_scan(c));
    PH(11, phase_hgrn_fold(c));
    PH(12, phase_hgrn_readout(c));
    PH(13, phase_gemm_f32(c, (const bf16_t*)(c.ws + WS_RR), L, (const bf16_t*)(c.ws + WS_WHO), D, nullptr, (float*)(c.ws + WS_RAW1)));
    PH(14, { phase_postmix<128>(c, 1, route_ok); convert_steal(c, 2); });
    PH(15, phase_moe_gu(c, 1));
    PH(16, phase_moe_dn(c, 1));
    PH(17, phase_combine(c, 1));
#undef IN
#undef PH
#undef SEAM
}

extern "C" void kernel_launch(void* const* d_in, const int* in_sizes, int n_in, void* d_out, int out_size, void* d_ws, size_t ws_size, hipStream_t stream) {
    static int grid = 0;
    if (grid == 0) {
        if (n_in != 21 || out_size != L * D || ws_size < WS_END) { fprintf(stderr, "kernel_launch: unexpected problem (n_in %d out %d ws %zu need %zu)\n", n_in, out_size, ws_size, (size_t)WS_END); grid = -1; return; }
        int dev = 0, cus = 0, per_cu = 0;
        hipGetDevice(&dev); hipDeviceGetAttribute(&cus, hipDeviceAttributeMultiprocessorCount, dev);
        if (hipFuncSetAttribute((const void*)mk_fwd, hipFuncAttributeMaxDynamicSharedMemorySize, LDS_BYTES) != hipSuccess) { fprintf(stderr, "kernel_launch: hipFuncSetAttribute failed\n"); grid = -1; return; }
        hipOccupancyMaxActiveBlocksPerMultiprocessor(&per_cu, (const void*)mk_fwd, 512, LDS_BYTES);
        if (per_cu < 1) fprintf(stderr, "kernel_launch: occupancy query says %d\n", per_cu);
        (void)hipGetLastError();
        grid = cus > 0 ? cus : 256;
    }
    if (grid < 0) return;
    hipMemsetAsync((char*)d_ws + WS_CTL, 0, MiB, stream);
    Args a{};
    for (int i = 0; i < 21; ++i) a.in[i] = (const float*)d_in[i];
    a.out = (float*)d_out; a.ws = (unsigned char*)d_ws;
    a.ph_lo = 0; a.ph_hi = NPHASE;
    hipLaunchKernelGGL(mk_fwd, dim3(grid), dim3(512), LDS_BYTES, stream, a);
}
```

```cpp
#include <hip/hip_runtime.h>
#include <cstdint>
#include <cstdio>

#define LAS __attribute__((address_space(3)))
typedef unsigned short bf16_t;
typedef short bf16x8 __attribute__((ext_vector_type(8)));
typedef float f32x4 __attribute__((ext_vector_type(4)));
typedef unsigned u32x4 __attribute__((ext_vector_type(4)));
typedef unsigned u32x2 __attribute__((ext_vector_type(2)));
typedef short v4i16_t __attribute__((ext_vector_type(4)));
typedef float f32x2 __attribute__((ext_vector_type(2)));

constexpr int D = 1024, L = 16384, C = 256, R = L + C;
constexpr int QKVD = 1280, HIN = 5120, NE = 32, TOPK = 4;
constexpr int PADM = 256, MAXROWS = 74752;
constexpr float EPS = 1e-6f;
constexpr float LOG2E = 1.4426950408889634f;
constexpr int NPHASE = 18;
#ifndef GEMM_REP
#define GEMM_REP 1
#endif
#ifndef PROBE_NOEPI
#define PROBE_NOEPI 0
#endif
#ifndef PROBE_SHORTK
#define PROBE_SHORTK 0
#endif
#ifndef SCAN_REP
#define SCAN_REP 1
#endif
#ifndef PROBE_PH
#define PROBE_PH (-1)
#endif
constexpr int LDS_BYTES = 147456;

constexpr size_t MiB = 1u << 20;
constexpr size_t al(size_t x) { return (x + MiB - 1) / MiB * MiB; }
constexpr size_t WS_CTL = 0;
constexpr size_t WS_MOD = WS_CTL + MiB;
constexpr size_t WS_X = WS_MOD + MiB;
constexpr size_t WS_H = WS_X + al((size_t)R * D * 4);
constexpr size_t WS_Q = WS_H + al((size_t)R * D * 2);
constexpr size_t WS_K = WS_Q + al((size_t)R * D * 2);
constexpr size_t WS_V = WS_K + al((size_t)R * 128 * 2);
constexpr size_t WS_O = WS_V + al((size_t)R * 128 * 2);
constexpr size_t WS_TK = WS_O + al((size_t)R * D * 2);
constexpr size_t WS_LIST = WS_TK + MiB;
constexpr size_t WS_HDN = WS_LIST + 3 * MiB;
constexpr size_t WS_RAW1 = WS_HDN + al((size_t)MAXROWS * 1024 * 2);
constexpr size_t WS_X1 = WS_RAW1 + al((size_t)R * D * 4);
constexpr size_t WS_OUTB = WS_X1 + al((size_t)R * D * 4);
constexpr size_t WS_QH = WS_OUTB + al((size_t)MAXROWS * 1024 * 2);
constexpr size_t WS_KF = WS_QH + al((size_t)L * D * 2);
constexpr size_t WS_KB = WS_KF + al((size_t)R * D * 2);
constexpr size_t WS_IV = WS_KB + al((size_t)R * D * 2);
constexpr size_t WS_SG = WS_IV + al((size_t)R * D * 2);
constexpr size_t WS_OF = WS_SG + al((size_t)L * D * 2);
constexpr size_t WS_OB = WS_OF + al((size_t)L * D * 4);
constexpr size_t WS_RR = WS_OB + al((size_t)L * D * 4);
constexpr size_t WS_WQKV = WS_RR + al((size_t)L * D * 2);
constexpr size_t WS_WO = WS_WQKV + al((size_t)QKVD * D * 2);
constexpr size_t WS_WIN = WS_WO + al((size_t)D * D * 2);
constexpr size_t WS_WHO = WS_WIN + al((size_t)HIN * D * 2);
constexpr size_t WS_WGU = WS_WHO + al((size_t)D * D * 2);
constexpr size_t WS_WDN = WS_WGU + al((size_t)2 * NE * 2048 * D * 2);
constexpr size_t WS_QSF = WS_WDN + al((size_t)2 * NE * 1024 * D * 2);
constexpr size_t WS_QSB = WS_QSF + al((size_t)L * D * 2);
constexpr size_t WS_DS = WS_QSB + al((size_t)L * D * 2);
constexpr size_t WS_DG = WS_DS + al((size_t)256 * 128 * 128 * 4);
constexpr size_t WS_SST = WS_DG + MiB;
constexpr size_t WS_H8 = WS_SST + al((size_t)256 * 128 * 128 * 2);
constexpr size_t WS_END = WS_H8 + al((size_t)R * D);
static_assert(WS_END <= (size_t)2048 * MiB, "workspace map exceeds 4x the largest input");
constexpr int CW_CNT = 1024;
constexpr int CW_CONV = 2048;
constexpr int CW_BAR = 4096;
constexpr int MOD_ROPE = 32768;
constexpr int MOD_LB = 49152;

struct Args { const float* in[21]; float* out; unsigned char* ws; int ph_lo, ph_hi; };

__device__ __forceinline__ unsigned f2bf(float f) { unsigned u = __float_as_uint(f); return (u + 0x7fffu + ((u >> 16) & 1u)) >> 16; }
typedef float f32x2_t __attribute__((ext_vector_type(2))); typedef __bf16 bf16x2_t __attribute__((ext_vector_type(2)));
__device__ __forceinline__ unsigned pk2(float lo, float hi) { f32x2_t v = {lo, hi}; bf16x2_t b = __builtin_convertvector(v, bf16x2_t); return __builtin_bit_cast(unsigned, b); }
__device__ __forceinline__ unsigned pk4_fp8(float a, float b, float c, float d) {
    a = fminf(fmaxf(a, -448.f), 448.f); b = fminf(fmaxf(b, -448.f), 448.f); c = fminf(fmaxf(c, -448.f), 448.f); d = fminf(fmaxf(d, -448.f), 448.f);
    int v = __builtin_amdgcn_cvt_pk_fp8_f32(a, b, 0, false); v = __builtin_amdgcn_cvt_pk_fp8_f32(c, d, v, true); return (unsigned)v; }
constexpr float F8_SH = 8.f, F8_SW = 64.f, F8_SHD = 4.f;
__device__ __forceinline__ float bflo(unsigned u) { return __uint_as_float(u << 16); }
__device__ __forceinline__ float bfhi(unsigned u) { return __uint_as_float(u & 0xffff0000u); }
__device__ __forceinline__ float bf2f(bf16_t b) { return __uint_as_float(((unsigned)b) << 16); }
__device__ __forceinline__ float wave_sum(float v) {
#pragma unroll
    for (int o = 32; o > 0; o >>= 1) v += __shfl_xor(v, o);
    return v;
}
__device__ __forceinline__ float silu_f(float x) { return x / (1.f + __expf(-x)); }
__device__ __forceinline__ float sigmoid_f(float x) { return 1.f / (1.f + __expf(-x)); }

typedef const __attribute__((address_space(4))) Args* CArgs;
struct Ctx {
    CArgs a;
    LAS unsigned char* lds;
    int tid, lane, wave, nwg, wg;
    unsigned char* ws;
    __device__ __forceinline__ float* modp(int layer, int which) const { return (float*)(ws + WS_MOD) + (layer * 2 + which) * 6144; }
    __device__ __forceinline__ const float* xin0(int r) const { return r < C ? a->in[2] + (size_t)r * D : a->in[0] + (size_t)(r - C) * D; }
};


namespace pg8 {
constexpr int BM = 256, BK = 64, HALF = 128, HTB = HALF * BK * 2, STAGE_BYTES = 8 * HTB, KD = 1024, NXCD = 8, WGM = 8;
__device__ __forceinline__ int lds_byte(int r, int c) { const int st = (r >> 4) * 2 + (c >> 5), rr = r & 15, cc = c & 31, ob = rr * 64 + cc * 2; return st * 1024 + (ob ^ (((ob >> 9) & 1) << 5)); }
__device__ __forceinline__ void stage_rc(int b, int& Rr, int& Cc) { const int st = b / 1024, sb = b % 1024, swz = sb ^ (((sb >> 9) & 1) << 5); Rr = (st >> 1) * 16 + swz / 64; Cc = (st & 1) * 32 + (swz % 64) / 2; }
__device__ __forceinline__ int perm32(int rho) { const int n = rho >> 4, i = rho & 15; return 8 * (i >> 2) + 4 * n + (i & 3); }

struct Unit { int pm, pn, e, goff, gcnt; bool real; int amask, bmask; };
struct Gemm { const void* A; const void* Bt; size_t bstride; const int* list; };

struct StaticOrder {
    int nM, nN, nwg, G, c;
    __device__ __forceinline__ void init(int M, int N, int G_, int c_) { nM = M / BM; nN = N / BM; nwg = nM * nN; G = G_; c = c_; }
    __device__ __forceinline__ bool next(int i, Unit& u) const {
        const int F = nwg / G, Rm = nwg - F * G; int Lq; u.amask = 3; u.bmask = 3;
        if (i < F) Lq = i * G + c;
        else if (i == F && Rm > 0) {
            if (4 * Rm <= G) { if (c >= 4 * Rm) return false; Lq = F * G + (c >> 2); u.amask = 1 << ((c >> 1) & 1); u.bmask = 1 << (c & 1); }
            else if (2 * Rm <= G) { if (c >= 2 * Rm) return false; Lq = F * G + (c >> 1); u.bmask = 1 << (c & 1); }
            else { if (c >= Rm) return false; Lq = F * G + c; }
        } else return false;
        int wgid = Lq; { const int q = nwg / NXCD, r = nwg % NXCD, xcd = wgid % NXCD, off = wgid / NXCD; wgid = (xcd < r ? xcd * (q + 1) : r * (q + 1) + (xcd - r) * q) + off; }
        const int nig = WGM * nN, gid = wgid / nig, fm = gid * WGM, gsz = (nM - fm) < WGM ? (nM - fm) : WGM;
        u.pm = fm + ((wgid % nig) % gsz); u.pn = (wgid % nig) / gsz; u.e = 0; u.goff = 0; u.gcnt = 0; u.real = true; return true;
    }
};
struct MoeOrder {
    const LAS int* tp; const LAS int* cnt; int npn, G, vcu; bool split;
    __device__ __forceinline__ bool next(int i, Unit& u) const {
        const int tot = tp[32] * npn; int lin; u.amask = 3; u.bmask = 3; u.real = true;
        if (GEMM_REP > 1) { const int lin0 = i * G + vcu; if (lin0 >= tot * GEMM_REP) return false; lin = lin0 % tot; u.real = lin0 >= tot * (GEMM_REP - 1); }
        else {
            const int F = tot / G, Rm = tot - F * G;
            if (i < F) lin = i * G + vcu;
            else if (i == F && Rm > 0) {
                if (split && 2 * Rm <= G) { if (vcu >= 2 * Rm) return false; lin = F * G + (vcu >> 1); u.bmask = 1 << (vcu & 1); }
                else { if (vcu >= Rm) return false; lin = F * G + vcu; }
            } else return false;
        }
        const int rt = lin / npn; int e = 0;
#pragma unroll 8
        for (int k = 1; k < 32; ++k) e += (rt >= tp[k]) ? 1 : 0;
        const int mt = rt - tp[e];
        u.pm = rt; u.pn = lin - rt * npn; u.e = e; u.goff = e * R + mt * 256; u.gcnt = cnt[e] - mt * 256; return true;
    }
};

template <int KB>
__device__ __forceinline__ void a_offsets(const Gemm& g, const Unit& u, const int (&sR)[2], const int (&sC)[2], unsigned (&v)[2][2]) {
#pragma unroll
    for (int h = 0; h < 2; ++h)
#pragma unroll
        for (int i = 0; i < 2; ++i) {
            const int rr = h * HALF + sR[i]; int row;
            if (g.list) row = rr < u.gcnt ? g.list[u.goff + rr] : 0; else row = u.pm * BM + rr;
            v[h][i] = (unsigned)(row * KB + sC[i] * 2);
        }
}

struct EpiF32 {
    static constexpr bool PERM = false;
    float* Cp; int ldc; const float* bias;
    __device__ __forceinline__ void operator()(const f32x4 (&acc)[2][2][4][2], const Unit& u, int wr, int wc, int fr, int fq) const {
        const int row0 = u.pm * BM + wr * 64 + fr, col0 = u.pn * BM + wc * 32 + 4 * fq;
#pragma unroll
        for (int bj = 0; bj < 2; ++bj)
#pragma unroll
            for (int n = 0; n < 2; ++n) {
                const int col = col0 + bj * HALF + n * 16;
                if (!((u.bmask >> bj) & 1)) continue;
                const f32x4 bv = bias ? *(const f32x4*)(bias + col) : (f32x4){0.f, 0.f, 0.f, 0.f};
#pragma unroll
                for (int ai = 0; ai < 2; ++ai)
#pragma unroll
                    for (int m = 0; m < 4; ++m) if ((u.amask >> ai) & 1) *(f32x4*)(Cp + (size_t)(row0 + ai * HALF + m * 16) * ldc + col) = acc[ai][bj][m][n] + bv;
            }
    }
};
struct EpiSwiglu {
    static constexpr bool PERM = true;
    unsigned char* Hd; const float* bgu;
    __device__ __forceinline__ void operator()(const f32x4 (&acc)[2][2][4][2], const Unit& u, int wr, int wc, int fr, int fq) const {
        const int row0 = u.pm * BM + wr * 64 + fr, cg0 = u.pn * HALF + wc * 32 + 8 * fq;
        const float* bb = bgu + (size_t)u.e * 2048;
        f32x4 bg[2], bu[2];
#pragma unroll
        for (int n = 0; n < 2; ++n) { bg[n] = *(const f32x4*)(bb + cg0 + 4 * n); bu[n] = *(const f32x4*)(bb + 1024 + cg0 + 4 * n); }
#pragma unroll
        for (int ai = 0; ai < 2; ++ai)
#pragma unroll
            for (int m = 0; m < 4; ++m) {
                u32x2 o;
#pragma unroll
                for (int n = 0; n < 2; ++n) {
                    const f32x4 gv = acc[ai][0][m][n] * (1.f / (F8_SH * F8_SW)) + bg[n], uv = acc[ai][1][m][n] * (1.f / (F8_SH * F8_SW)) + bu[n]; float hv[4];
#pragma unroll
                    for (int q = 0; q < 4; ++q) { const float gg = fminf(gv[q], 7.f), uu = fminf(fmaxf(uv[q], -7.f), 7.f); hv[q] = gg * __builtin_amdgcn_rcpf(1.f + __builtin_amdgcn_exp2f(-1.702f * LOG2E * gg)) * (uu + 1.f); }
                    o[n] = pk4_fp8(hv[0] * F8_SHD, hv[1] * F8_SHD, hv[2] * F8_SHD, hv[3] * F8_SHD);
                }
                *(u32x2*)(Hd + (size_t)(row0 + ai * HALF + m * 16) * 1024 + cg0) = o;
            }
    }
};
struct EpiBf16Bias {
    static constexpr bool PERM = true;
    bf16_t* Op; const float* bias; int bias_estride; float scale;
    __device__ __forceinline__ void operator()(const f32x4 (&acc)[2][2][4][2], const Unit& u, int wr, int wc, int fr, int fq) const {
        const int row0 = u.pm * BM + wr * 64 + fr, col0 = u.pn * BM + wc * 32 + 8 * fq;
        const float* bb = bias + (size_t)u.e * bias_estride;
#pragma unroll
        for (int bj = 0; bj < 2; ++bj) {
            const int col = col0 + bj * HALF;
            if (!((u.bmask >> bj) & 1)) continue;
            const f32x4 b0 = *(const f32x4*)(bb + col), b1 = *(const f32x4*)(bb + col + 4);
#pragma unroll
            for (int ai = 0; ai < 2; ++ai)
#pragma unroll
                for (int m = 0; m < 4; ++m) { if (!((u.amask >> ai) & 1)) continue; const f32x4 v0 = acc[ai][bj][m][0] * scale + b0, v1 = acc[ai][bj][m][1] * scale + b1;
                    u32x4 o; o.x = pk2(v0[0], v0[1]); o.y = pk2(v0[2], v0[3]); o.z = pk2(v1[0], v1[1]); o.w = pk2(v1[2], v1[3]);
                    *(u32x4*)(Op + (size_t)(row0 + ai * HALF + m * 16) * 1024 + col) = o; }
        }
    }
};
struct EpiQKV {
    static constexpr bool PERM = false;
    bf16_t* Qp; bf16_t* Kp; bf16_t* Vp; const float* bias; const float* tab;
    __device__ __forceinline__ void operator()(const f32x4 (&acc)[2][2][4][2], const Unit& u, int wr, int wc, int fr, int fq) const {
        const bool lat = u.pm > 0; const float qs = 0.125f * LOG2E;
#pragma unroll
        for (int bj = 0; bj < 2; ++bj) {
            const int colt = u.pn * BM + bj * HALF + wc * 32 + 4 * fq;
            const f32x4 b1 = *(const f32x4*)(bias + colt), b2 = *(const f32x4*)(bias + colt + 16);
            const bool isv = (u.pn == 4) && (bj == 1);
            if (!((u.bmask >> bj) & 1)) continue;
#pragma unroll
            for (int ai = 0; ai < 2; ++ai)
#pragma unroll
                for (int m = 0; m < 4; ++m) {
                    if (!((u.amask >> ai) & 1)) continue;
                    const int r = u.pm * BM + ai * HALF + wr * 64 + m * 16 + fr, t = r - C;
                    f32x4 x1 = acc[ai][bj][m][0] + b1, x2 = acc[ai][bj][m][1] + b2;
                    if (lat && !isv) {
                        const int pos = (wc & 1) ? (t & 63) : (t >> 6);
                        const f32x4 t0 = *(const f32x4*)(tab + (pos * 16 + 4 * fq) * 2), t1 = *(const f32x4*)(tab + (pos * 16 + 4 * fq) * 2 + 4);
                        const float cs[4] = {t0[0], t0[2], t1[0], t1[2]}, sn[4] = {t0[1], t0[3], t1[1], t1[3]};
                        f32x4 o1, o2;
#pragma unroll
                        for (int e = 0; e < 4; ++e) { o1[e] = x1[e] * cs[e] - x2[e] * sn[e]; o2[e] = x2[e] * cs[e] + x1[e] * sn[e]; }
                        x1 = o1; x2 = o2;
                    }
                    u32x2 w1, w2;
                    if (u.pn < 4) {
                        w1.x = pk2(x1[0] * qs, x1[1] * qs); w1.y = pk2(x1[2] * qs, x1[3] * qs); w2.x = pk2(x2[0] * qs, x2[1] * qs); w2.y = pk2(x2[2] * qs, x2[3] * qs);
                        *(u32x2*)(Qp + (size_t)r * 1024 + colt) = w1; *(u32x2*)(Qp + (size_t)r * 1024 + colt + 16) = w2;
                    } else {
                        w1.x = pk2(x1[0], x1[1]); w1.y = pk2(x1[2], x1[3]); w2.x = pk2(x2[0], x2[1]); w2.y = pk2(x2[2], x2[3]);
                        bf16_t* dst = (bj == 0 ? Kp : Vp) + (size_t)r * 128 + wc * 32 + 4 * fq;
                        *(u32x2*)dst = w1; *(u32x2*)(dst + 16) = w2;
                    }
                }
        }
    }
};
struct EpiInProj {
    static constexpr bool PERM = true;
    bf16_t* QH; _Float16* KF; _Float16* KB; bf16_t* IV; bf16_t* SG; const float* lb; float scale;
    __device__ __forceinline__ void operator()(const f32x4 (&acc)[2][2][4][2], const Unit& u, int wr, int wc, int fr, int fq) const {
        const int seg = u.pn >> 2; const bool lat = u.pm > 0;
        if (!lat && (seg == 0 || seg == 4)) return;
        typedef _Float16 h8_t __attribute__((ext_vector_type(8)));
#pragma unroll
        for (int bj = 0; bj < 2; ++bj) {
            const int col = (u.pn & 3) * BM + bj * HALF + wc * 32 + 8 * fq;
            if (!((u.bmask >> bj) & 1)) continue;
            f32x4 lb0 = (f32x4){0.f, 0.f, 0.f, 0.f}, lb1 = lb0;
            if (seg == 1) { lb0 = *(const f32x4*)(lb + col); lb1 = *(const f32x4*)(lb + col + 4); } else if (seg == 2) { lb0 = *(const f32x4*)(lb + 1024 + col); lb1 = *(const f32x4*)(lb + 1024 + col + 4); }
#pragma unroll
            for (int ai = 0; ai < 2; ++ai)
#pragma unroll
                for (int m = 0; m < 4; ++m) {
                    if (!((u.amask >> ai) & 1)) continue;
                    const int r = u.pm * BM + ai * HALF + wr * 64 + m * 16 + fr; const f32x4 v0 = acc[ai][bj][m][0] * scale, v1 = acc[ai][bj][m][1] * scale;
                    if (seg == 1 || seg == 2) {
                        h8_t hv;
#pragma unroll
                        for (int e = 0; e < 4; ++e) { hv[e] = (_Float16)((1.f - lb0[e]) * __builtin_amdgcn_rcpf(1.f + __builtin_amdgcn_exp2f(LOG2E * v0[e]))); hv[4 + e] = (_Float16)((1.f - lb1[e]) * __builtin_amdgcn_rcpf(1.f + __builtin_amdgcn_exp2f(LOG2E * v1[e]))); }
                        *(h8_t*)((seg == 1 ? KF : KB) + (size_t)r * 1024 + col) = hv;
                    } else if (seg == 3) {
                        u32x4 o; o.x = pk2(v0[0], v0[1]); o.y = pk2(v0[2], v0[3]); o.z = pk2(v1[0], v1[1]); o.w = pk2(v1[2], v1[3]); *(u32x4*)(IV + (size_t)r * 1024 + col) = o;
                    } else {
                        float s0[4], s1[4];
#pragma unroll
                        for (int e = 0; e < 4; ++e) { s0[e] = v0[e] * __builtin_amdgcn_rcpf(1.f + __builtin_amdgcn_exp2f(-LOG2E * v0[e])); s1[e] = v1[e] * __builtin_amdgcn_rcpf(1.f + __builtin_amdgcn_exp2f(-LOG2E * v1[e])); }
                        u32x4 o; o.x = pk2(s0[0], s0[1]); o.y = pk2(s0[2], s0[3]); o.z = pk2(s1[0], s1[1]); o.w = pk2(s1[2], s1[3]); *(u32x4*)((seg == 0 ? QH : SG) + (size_t)(r - C) * 1024 + col) = o;
                    }
                }
        }
    }
};

typedef int v8i __attribute__((ext_vector_type(8)));
typedef int v4i __attribute__((ext_vector_type(4)));
template <class Epi, class Sched, bool ALIGN_EPI, bool GATHER, bool FP8>
__device__ __forceinline__ void gemm_phase(LAS unsigned char* lds, const Gemm g, const Sched& S, const Epi& E, const int tid) {
    const int wid = __builtin_amdgcn_readfirstlane(tid >> 6), lane = tid & 63, wr = wid >> 2, wc = wid & 3, fr = lane & 15, fq = lane >> 4;
    constexpr int KB = FP8 ? 1024 : 2048, nt = 1024 / (FP8 ? 128 : 64);
    int sR[2], sC[2]; unsigned voffB[2], voffA[2];
#pragma unroll
    for (int i = 0; i < 2; ++i) { stage_rc(tid * 16 + i * 8192, sR[i], sC[i]); const int Rb = Epi::PERM ? ((sR[i] & ~31) + perm32(sR[i] & 31)) : sR[i]; voffB[i] = (unsigned)(Rb * KB + sC[i] * 2); voffA[i] = (unsigned)(sR[i] * KB + sC[i] * 2); }
    constexpr size_t kstep = (size_t)(BK * 2), hstep = (size_t)HALF * KB, tstep = 2 * hstep;
    const unsigned ldsw = (unsigned)wid * 1024u;
    const int aoff = lds_byte(wr * 64 + fr, fq * 8), boff = lds_byte(wc * 32 + fr, fq * 8);
    const char* Ab = (const char*)g.A;
#define PG8_SA(b, h) (((b) * 2 + (h)) * HTB)
#define PG8_SB(b, h) ((4 + (b) * 2 + (h)) * HTB)
#define PG8_STAGE_B(bufoff, gbase) do { _Pragma("unroll") for (int _i = 0; _i < 2; ++_i) \
        __builtin_amdgcn_global_load_lds((const unsigned*)((const char*)(gbase) + voffB[_i]), (LAS unsigned*)(lds + (bufoff) + ldsw + _i * 8192), 16, 0, 0); } while (0)
#define PG8_STAGE_A(bufoff, kb, v, ubase) do { _Pragma("unroll") for (int _i = 0; _i < 2; ++_i) \
        __builtin_amdgcn_global_load_lds((const unsigned*)((GATHER ? Ab : (ubase)) + (size_t)(kb) + (GATHER ? (v)[_i] : voffA[_i])), (LAS unsigned*)(lds + (bufoff) + ldsw + _i * 8192), 16, 0, 0); } while (0)
#define PG8_LD8(p) __builtin_shufflevector(*(const LAS v4i*)(p), *(const LAS v4i*)((p) + 1024), 0, 1, 2, 3, 4, 5, 6, 7)
#define PG8_LDA(dst, b, h) do { if constexpr (FP8) { _Pragma("unroll") for (int m = 0; m < 4; ++m) dst##8[m] = PG8_LD8(lds + PG8_SA(b, h) + aoff + m * 2048); } else { _Pragma("unroll") for (int m = 0; m < 4; ++m) _Pragma("unroll") for (int k = 0; k < 2; ++k) dst[m][k] = *(const LAS bf16x8*)(lds + PG8_SA(b, h) + aoff + m * 2048 + k * 1024); } } while (0)
#define PG8_LDB(dst, b, h) do { if constexpr (FP8) { _Pragma("unroll") for (int n = 0; n < 2; ++n) dst##8[n] = PG8_LD8(lds + PG8_SB(b, h) + boff + n * 2048); } else { _Pragma("unroll") for (int n = 0; n < 2; ++n) _Pragma("unroll") for (int k = 0; k < 2; ++k) dst[n][k] = *(const LAS bf16x8*)(lds + PG8_SB(b, h) + boff + n * 2048 + k * 1024); } } while (0)
#define PG8_MMA(ai, bj, At, Bt) do { __builtin_amdgcn_s_setprio(1); if constexpr (FP8) { _Pragma("unroll") for (int m = 0; m < 4; ++m) _Pragma("unroll") for (int n = 0; n < 2; ++n) \
        asm volatile("v_mfma_scale_f32_16x16x128_f8f6f4 %0, %1, %2, %0, %3, %3 op_sel_hi:[0,0,0]" : "+v"(acc[ai][bj][m][n]) : "v"(Bt##8[n]), "v"(At##8[m]), "v"(unit_scale)); } else { \
        _Pragma("unroll") for (int m = 0; m < 4; ++m) _Pragma("unroll") for (int n = 0; n < 2; ++n) _Pragma("unroll") for (int k = 0; k < 2; ++k) \
        acc[ai][bj][m][n] = __builtin_amdgcn_mfma_f32_16x16x32_bf16(Bt[n][k], At[m][k], acc[ai][bj][m][n], 0, 0, 0); } __builtin_amdgcn_s_setprio(0); } while (0)
#define PG8_WAIT_V(n) asm volatile("s_waitcnt vmcnt(" #n ")" ::: "memory")
#define PG8_WAIT_L(n) asm volatile("s_waitcnt lgkmcnt(" #n ")" ::: "memory")
#define PG8_BAR __builtin_amdgcn_s_barrier()
#define PG8_SCHED __builtin_amdgcn_sched_barrier(0)
    Unit cur, nxt; int ui = 0;
    if (!S.next(0, cur)) return;
    unsigned cv[2][2], nv[2][2];
    if constexpr (GATHER) a_offsets<KB>(g, cur, sR, sC, cv);
    const char* cA = Ab + (size_t)cur.pm * tstep; const char* nA = cA;
    f32x4 acc[2][2][4][2];
#pragma unroll
    for (int a = 0; a < 2; ++a)
#pragma unroll
        for (int b = 0; b < 2; ++b)
#pragma unroll
            for (int m = 0; m < 4; ++m)
#pragma unroll
                for (int n = 0; n < 2; ++n) acc[a][b][m][n] = (f32x4){0.f, 0.f, 0.f, 0.f};
    bf16x8 At[4][2], B0[2][2], B1[2][2]; v8i At8[4], B08[2], B18[2];
    int unit_scale = 0x7f7f7f7f; asm volatile("" : "+v"(unit_scale));
    const char* cB = (const char*)g.Bt + (size_t)cur.e * g.bstride + (size_t)cur.pn * tstep;
    PG8_STAGE_B(PG8_SB(0, 0), cB); PG8_STAGE_B(PG8_SB(0, 1), cB + hstep); PG8_STAGE_A(PG8_SA(0, 0), 0, cv[0], cA); PG8_STAGE_A(PG8_SA(0, 1), 0, cv[1], cA + hstep);
    if (wr == 1) PG8_BAR;
    PG8_WAIT_V(2); PG8_BAR;
    PG8_STAGE_B(PG8_SB(1, 0), cB + kstep); PG8_STAGE_A(PG8_SA(1, 0), kstep, cv[0], cA); PG8_STAGE_B(PG8_SB(1, 1), cB + hstep + kstep);
    PG8_WAIT_V(6); PG8_BAR;
    for (;;) {
        const bool has_next = S.next(ui + 1, nxt);
        const char* nB = cB;
        nA = cA;
        if (has_next) { if constexpr (GATHER) a_offsets<KB>(g, nxt, sR, sC, nv); nA = Ab + (size_t)nxt.pm * tstep; nB = (const char*)g.Bt + (size_t)nxt.e * g.bstride + (size_t)nxt.pn * tstep; }
        else if constexpr (GATHER) {
#pragma unroll
            for (int h = 0; h < 2; ++h)
#pragma unroll
                for (int i = 0; i < 2; ++i) nv[h][i] = cv[h][i];
        }
        const int ntr = (PROBE_SHORTK && !cur.real) ? 2 : nt;
        const bool m00 = (cur.amask & 1) && (cur.bmask & 1), m01 = (cur.amask & 1) && (cur.bmask & 2), m10 = (cur.amask & 2) && (cur.bmask & 1), m11 = (cur.amask & 2) && (cur.bmask & 2);
#pragma nounroll
        for (int t = 0; t < ntr; t += 2) {
            const bool last = (t == ntr - 2);
            const size_t k1 = (size_t)(t + 1) * kstep, k2 = last ? 0 : (size_t)(t + 2) * kstep, k3 = k2 + kstep;
            const char* b2 = last ? nB : cB + (size_t)(t + 2) * kstep; const char* b3 = b2 + kstep;
            unsigned w0[2], w1[2];
            if constexpr (GATHER) {
#pragma unroll
                for (int i = 0; i < 2; ++i) { w0[i] = last ? nv[0][i] : cv[0][i]; w1[i] = last ? nv[1][i] : cv[1][i]; }
            }
            const char* a2 = last ? nA : cA;
            PG8_LDB(B0, 0, 0); PG8_LDB(B1, 0, 1); PG8_SCHED; PG8_LDA(At, 0, 0); PG8_STAGE_A(PG8_SA(1, 1), k1, cv[1], cA + hstep);
            PG8_WAIT_V(8); PG8_WAIT_L(0); PG8_BAR; if (m00) PG8_MMA(0, 0, At, B0); if (m01) PG8_MMA(0, 1, At, B1); PG8_BAR; PG8_SCHED;
            PG8_LDA(At, 0, 1); PG8_STAGE_B(PG8_SB(0, 0), b2); PG8_STAGE_B(PG8_SB(0, 1), b2 + hstep); PG8_STAGE_A(PG8_SA(0, 0), k2, w0, a2);
            PG8_WAIT_V(8); PG8_WAIT_L(0); PG8_BAR; if (m10) PG8_MMA(1, 0, At, B0); if (m11) PG8_MMA(1, 1, At, B1); PG8_BAR; PG8_SCHED;
            PG8_LDB(B0, 1, 0); PG8_LDB(B1, 1, 1); PG8_SCHED; PG8_LDA(At, 1, 0); PG8_STAGE_A(PG8_SA(0, 1), k2, w1, a2 + hstep);
            PG8_WAIT_V(8); PG8_WAIT_L(0); PG8_BAR; if (m00) PG8_MMA(0, 0, At, B0); if (m01) PG8_MMA(0, 1, At, B1); PG8_BAR; PG8_SCHED;
            PG8_LDA(At, 1, 1); PG8_STAGE_B(PG8_SB(1, 0), b3); PG8_STAGE_B(PG8_SB(1, 1), b3 + hstep); PG8_STAGE_A(PG8_SA(1, 0), k3, w0, a2);
            PG8_WAIT_V(8); PG8_WAIT_L(0); PG8_BAR; if (m10) PG8_MMA(1, 0, At, B0); if (m11) PG8_MMA(1, 1, At, B1); PG8_BAR; PG8_SCHED;
        }
        if constexpr (ALIGN_EPI) { if (wr == 0) PG8_BAR; }
        if constexpr (FP8) asm volatile("s_nop 15\n\ts_nop 15" ::: "memory");
        if (!PROBE_NOEPI || cur.real) E(acc, cur, wr, wc, fr, fq);
        if (!has_next) break;
#pragma unroll
        for (int a = 0; a < 2; ++a)
#pragma unroll
            for (int b = 0; b < 2; ++b)
#pragma unroll
                for (int m = 0; m < 4; ++m)
#pragma unroll
                    for (int n = 0; n < 2; ++n) acc[a][b][m][n] = (f32x4){0.f, 0.f, 0.f, 0.f};
        cur = nxt; cB = nB; cA = nA; ++ui;
        if constexpr (GATHER) {
#pragma unroll
            for (int h = 0; h < 2; ++h)
#pragma unroll
                for (int i = 0; i < 2; ++i) cv[h][i] = nv[h][i];
        }
        if constexpr (ALIGN_EPI) { if (wr == 1) PG8_BAR; }
    }
    PG8_WAIT_V(0);
    if constexpr (!ALIGN_EPI) { if (wr == 0) PG8_BAR; }
    PG8_BAR;
#undef PG8_SA
#undef PG8_SB
#undef PG8_STAGE_A
#undef PG8_STAGE_B
#undef PG8_LDA
#undef PG8_LD8
#undef PG8_LDB
#undef PG8_MMA
#undef PG8_WAIT_V
#undef PG8_WAIT_L
#undef PG8_BAR
#undef PG8_SCHED
}
}

struct TBlk { const float* src; int ldw; bf16_t* dst; unsigned char* dst8; };
__device__ __forceinline__ void tb_load(const TBlk& t, int lane, f32x4 (&v)[16]) {
    const float* p = t.src + (size_t)(lane >> 4) * t.ldw + (lane & 15) * 4;
#pragma unroll
    for (int i = 0; i < 16; ++i) v[i] = *(const f32x4*)(p + (size_t)(4 * i) * t.ldw);
}
__device__ __forceinline__ void tb_store(const TBlk& t, int lane, const f32x4 (&v)[16], LAS float* scr) {
#pragma unroll
    for (int i = 0; i < 16; ++i) { LAS float* d = scr + ((lane >> 4) + 4 * i) * 65 + (lane & 15) * 4; d[0] = v[i].x; d[1] = v[i].y; d[2] = v[i].z; d[3] = v[i].w; }
    asm volatile("s_waitcnt lgkmcnt(0)" ::: "memory"); __builtin_amdgcn_wave_barrier();
    const int c8 = lane & 7;
#pragma unroll
    for (int jj = 0; jj < 8; ++jj) {
        const int n = (lane >> 3) + 8 * jj; const LAS float* p = scr + (8 * c8) * 65 + n;
        if (t.dst8) { u32x2 o; o.x = pk4_fp8(p[0] * F8_SW, p[65] * F8_SW, p[2 * 65] * F8_SW, p[3 * 65] * F8_SW); o.y = pk4_fp8(p[4 * 65] * F8_SW, p[5 * 65] * F8_SW, p[6 * 65] * F8_SW, p[7 * 65] * F8_SW);
            *(u32x2*)(t.dst8 + (size_t)n * 1024 + 8 * c8) = o; }
        else { u32x4 o; o.x = pk2(p[0], p[65]); o.y = pk2(p[2 * 65], p[3 * 65]); o.z = pk2(p[4 * 65], p[5 * 65]); o.w = pk2(p[6 * 65], p[7 * 65]);
            *(u32x4*)(t.dst + (size_t)n * 1024 + 8 * c8) = o; }
    }
    asm volatile("s_waitcnt lgkmcnt(0)" ::: "memory"); __builtin_amdgcn_wave_barrier();
}

__device__ __forceinline__ void phase_prep(const Ctx& c) {
    LAS float* red = (LAS float*)c.lds;
    const float* cv = c.a->in[1]; const float* ccv = c.a->in[3]; const float* ada_w = c.a->in[4]; const float* ada_b = c.a->in[5];
    for (int item = c.wg; item < 193; item += c.nwg) {
        if (item < 192) {
            const int layer = item / 96, cb = item % 96, col = cb * 64 + c.lane;
            const float* W = ada_w + (size_t)layer * D * 6144 + col;
            float a0 = 0.f, a1 = 0.f;
            const int k0 = c.wave * 128;
#pragma unroll 32
            for (int k = 0; k < 128; ++k) { const float w = W[(size_t)(k0 + k) * 6144]; a0 += silu_f(cv[k0 + k]) * w; a1 += silu_f(ccv[k0 + k]) * w; }
            red[(0 * 8 + c.wave) * 64 + c.lane] = a0; red[(1 * 8 + c.wave) * 64 + c.lane] = a1;
            __syncthreads();
            if (c.tid < 128) {
                const int which = c.tid >> 6, l = c.tid & 63; float s = 0.f;
#pragma unroll
                for (int w = 0; w < 8; ++w) s += red[(which * 8 + w) * 64 + l];
                c.modp(layer, which)[cb * 64 + l] = s + ada_b[layer * 6144 + cb * 64 + l];
            }
            __syncthreads();
        } else {
            float* modbase = (float*)(c.ws + WS_MOD);
            for (int i = c.tid; i < 4096; i += 512) {
                const int pos = i >> 4, j = i & 15;
                const double ang = (double)pos * pow(10000.0, -(double)j / 16.0);
                modbase[MOD_ROPE + 2 * i] = (float)cos(ang); modbase[MOD_ROPE + 2 * i + 1] = (float)sin(ang);
            }
            const float* lbp = c.a->in[12];
            for (int i = c.tid; i < 2048; i += 512) { const float p0 = lbp[i], p1 = lbp[2048 + i]; modbase[MOD_LB + i] = 1.f / (1.f + __expf(p0 - p1)); }
        }
    }
}

__device__ __forceinline__ void row_load(const float* p, int lane, f32x4 (&v)[4]) {
#pragma unroll
    for (int j = 0; j < 4; ++j) v[j] = *(const f32x4*)(p + lane * 4 + 256 * j);
}
__device__ __forceinline__ float row_ss(const f32x4 (&v)[4]) {
    float s = 0.f;
#pragma unroll
    for (int j = 0; j < 4; ++j) s += v[j].x * v[j].x + v[j].y * v[j].y + v[j].z * v[j].z + v[j].w * v[j].w;
    return wave_sum(s);
}
__device__ __forceinline__ void row_modnorm_store(const f32x4 (&x)[4], float rstd, const float* g, const float* sh, const float* sc, bf16_t* out, int lane, f32x4 (*hout)[4] = nullptr) {
#pragma unroll
    for (int j = 0; j < 4; ++j) {
        const int c0 = lane * 4 + 256 * j;
        const f32x4 gv = *(const f32x4*)(g + c0), shv = *(const f32x4*)(sh + c0), scv = *(const f32x4*)(sc + c0);
        f32x4 h;
        h.x = x[j].x * rstd * gv.x * (1.f + scv.x) + shv.x; h.y = x[j].y * rstd * gv.y * (1.f + scv.y) + shv.y;
        h.z = x[j].z * rstd * gv.z * (1.f + scv.z) + shv.z; h.w = x[j].w * rstd * gv.w * (1.f + scv.w) + shv.w;
        if (hout) (*hout)[j] = h;
        u32x2 o; o.x = pk2(h.x, h.y); o.y = pk2(h.z, h.w);
        *(u32x2*)(out + c0) = o;
    }
}

__device__ __forceinline__ void phase_norm0(const Ctx& c) {
    bf16_t* H = (bf16_t*)(c.ws + WS_H); const float* ng = c.a->in[6];
    int r = c.wg * 8 + c.wave;
    f32x4 xn[4];
    if (r < R) row_load(c.xin0(r), c.lane, xn);
    for (; r < R; r += c.nwg * 8) {
        f32x4 x[4];
#pragma unroll
        for (int j = 0; j < 4; ++j) x[j] = xn[j];
        if (r + c.nwg * 8 < R) row_load(c.xin0(r + c.nwg * 8), c.lane, xn);
        const float rstd = rsqrtf(row_ss(x) * (1.f / D) + EPS);
        const float* m = c.modp(0, r < C ? 1 : 0);
        row_modnorm_store(x, rstd, ng, m + 0, m + 1024, H + (size_t)r * D, c.lane);
    }
}

namespace at {
constexpr int KP = 144, TILEB = 64 * KP;
__device__ __forceinline__ bf16x8 tr_frag2(const LAS unsigned char* tile, int row0, int col0, int lane) {
    const int q = (lane & 15) >> 2, p = lane & 3;
    const LAS unsigned char* a = tile + (row0 + q) * KP + (col0 + 4 * p) * 2;
    const v4i16_t lo = __builtin_amdgcn_ds_read_tr16_b64_v4i16((LAS v4i16_t*)a);
    const v4i16_t hi = __builtin_amdgcn_ds_read_tr16_b64_v4i16((LAS v4i16_t*)(a + 16 * KP));
    return (bf16x8){lo[0], lo[1], lo[2], lo[3], hi[0], hi[1], hi[2], hi[3]};
}
}
__device__ __forceinline__ void phase_attn(const Ctx& c) {
    using namespace at;
    const bf16_t* Q = (const bf16_t*)(c.ws + WS_Q); const bf16_t* K = (const bf16_t*)(c.ws + WS_K); const bf16_t* V = (const bf16_t*)(c.ws + WS_V);
    bf16_t* O = (bf16_t*)(c.ws + WS_O); const float* sink = c.a->in[9];
    LAS unsigned char* lds = c.lds;
    const int tid = c.tid, lane = c.lane, w = __builtin_amdgcn_readfirstlane(tid >> 6), fr = lane & 15, g = lane >> 4;
    const int lrow = tid >> 3, lch = tid & 7;
    const int nitn = c.nwg == 256 ? 2 : (264 - c.wg + c.nwg - 1) / c.nwg;
    for (int itn = 0; itn < nitn; ++itn) {
        int item = c.wg + itn * c.nwg;
        if (c.nwg == 256 && itn == 1) { const int n_ = c.wg >> 1; item = -1;
            if (n_ == 0) item = 256 + (c.wg & 1); else if (n_ == 127) item = 258 + (c.wg & 1); else if (n_ == 30 || n_ == 31) item = 260 + (c.wg - 60); }
        if (item < 0 || item >= 264) continue;
        const bool isctx = item >= 256;
        const int ci = item - 256;
        const int n = isctx ? 0 : (item >> 1), kh = isctx ? ((ci >> 1) & 1) : (item & 1), cb = isctx ? (ci >> 2) : 0;
        const int p_lo = isctx ? (ci & 1) : 0, p_hi = isctx ? (ci & 1) + 1 : 2;
        const int hq = kh * 8 + w;
        const float sink2 = sink[hq] * LOG2E;
        for (int pass = p_lo; pass < p_hi; ++pass) {
            const int t0 = 128 * n + 64 * pass, qrow0 = isctx ? cb * 128 + 64 * pass : C + t0;
            const int jlo = isctx ? 0 : (t0 >= 128 ? 0 : (128 - t0) / 64), jhi = isctx ? 0 : ((L - t0 + 128) / 64 < 5 ? (L - t0 + 128) / 64 : 5);
            const int ntile = 4 + (jhi - jlo);
            LAS unsigned char* qlds = lds + 4 * TILEB + w * TILEB;
#pragma unroll
            for (int qb = 0; qb < 4; ++qb)
#pragma unroll
                for (int ks = 0; ks < 2; ++ks) *(LAS bf16x8*)(qlds + (16 * qb + fr) * KP + (32 * ks + 8 * g) * 2) = *(const bf16x8*)(Q + (size_t)(qrow0 + 16 * qb + fr) * D + hq * 64 + 32 * ks + 8 * g);
            float mrow[4], lsum[4]; f32x4 OT[4][4];
#pragma unroll
            for (int qb = 0; qb < 4; ++qb) { mrow[qb] = sink2; lsum[qb] = 1.f;
#pragma unroll
                for (int nt = 0; nt < 4; ++nt) OT[qb][nt] = (f32x4){0.f, 0.f, 0.f, 0.f}; }
            u32x4 kreg, vreg;
#define AT_KROW(ti) ((ti) < 4 ? 64 * (ti) : C + t0 - 128 + 64 * (jlo + (ti) - 4))
#define AT_LOAD(ti) do { const size_t ro_ = (size_t)(AT_KROW(ti) + lrow) * 128 + kh * 64 + lch * 8; kreg = *(const u32x4*)(K + ro_); vreg = *(const u32x4*)(V + ro_); } while (0)
#define AT_WRITE(buf) do { *(LAS u32x4*)(lds + (buf) * 2 * TILEB + lrow * KP + lch * 16) = kreg; *(LAS u32x4*)(lds + (buf) * 2 * TILEB + TILEB + lrow * KP + lch * 16) = vreg; } while (0)
            AT_LOAD(0); AT_WRITE(0);
            __syncthreads();
            for (int ti = 0; ti < ntile; ++ti) {
                if (ti + 1 < ntile) AT_LOAD(ti + 1);
                const LAS unsigned char* kb = lds + (ti & 1) * 2 * TILEB; const LAS unsigned char* vb = kb + TILEB;
                const int jj = jlo + ti - 4; const bool masked = (ti >= 4) && (jj == 0 || jj == 4);
                const int k0 = t0 - 128 + 64 * jj;
                bf16x8 Kf[4][2];
#pragma unroll
                for (int mt = 0; mt < 4; ++mt)
#pragma unroll
                    for (int ks = 0; ks < 2; ++ks) Kf[mt][ks] = *(const LAS bf16x8*)(kb + (16 * mt + fr) * KP + (32 * ks + 8 * g) * 2);
                bf16x8 Vf[4][2];
#pragma unroll
                for (int mt = 0; mt < 4; ++mt)
#pragma unroll
                    for (int ks = 0; ks < 2; ++ks)
                        Vf[mt][ks] = tr_frag2(vb, 32 * ks + 4 * g, 16 * mt, lane);
#pragma unroll
                for (int qb = 0; qb < 4; ++qb) {
                    bf16x8 Qq[2];
#pragma unroll
                    for (int ks = 0; ks < 2; ++ks) Qq[ks] = *(const LAS bf16x8*)(qlds + (16 * qb + fr) * KP + (32 * ks + 8 * g) * 2);
                    f32x4 sa[4];
#pragma unroll
                    for (int mt = 0; mt < 4; ++mt) { sa[mt] = (f32x4){0.f, 0.f, 0.f, 0.f};
#pragma unroll
                        for (int ks = 0; ks < 2; ++ks) sa[mt] = __builtin_amdgcn_mfma_f32_16x16x32_bf16(Kf[mt][ks], Qq[ks], sa[mt], 0, 0, 0); }
                    if (masked) {
                        const int tq = t0 + 16 * qb + fr;
#pragma unroll
                        for (int mt = 0; mt < 4; ++mt)
#pragma unroll
                            for (int e = 0; e < 4; ++e) { const int dt = tq - (k0 + 16 * mt + 4 * g + e); if (dt > 128 || dt < -128) sa[mt][e] = -INFINITY; }
                    }
                    float mx = fmaxf(fmaxf(sa[0][0], sa[0][1]), fmaxf(sa[0][2], sa[0][3]));
#pragma unroll
                    for (int mt = 1; mt < 4; ++mt) mx = fmaxf(mx, fmaxf(fmaxf(sa[mt][0], sa[mt][1]), fmaxf(sa[mt][2], sa[mt][3])));
                    mx = fmaxf(mx, __shfl_xor(mx, 16)); mx = fmaxf(mx, __shfl_xor(mx, 32));
                    const float mn = fmaxf(mrow[qb], mx), alpha = __builtin_amdgcn_exp2f(mrow[qb] - mn);
                    mrow[qb] = mn;
                    float rs = 0.f;
#pragma unroll
                    for (int mt = 0; mt < 4; ++mt)
#pragma unroll
                        for (int e = 0; e < 4; ++e) { const float pv = __builtin_amdgcn_exp2f(sa[mt][e] - mn); sa[mt][e] = pv; rs += pv; }
                    rs += __shfl_xor(rs, 16); rs += __shfl_xor(rs, 32);
                    lsum[qb] = lsum[qb] * alpha + rs;
                    bf16x8 Pb[2];
#pragma unroll
                    for (int ks = 0; ks < 2; ++ks) { const f32x4 a0 = sa[2 * ks], a1 = sa[2 * ks + 1];
                        const u32x4 pk = (u32x4){pk2(a0[0], a0[1]), pk2(a0[2], a0[3]), pk2(a1[0], a1[1]), pk2(a1[2], a1[3])}; Pb[ks] = __builtin_bit_cast(bf16x8, pk); }
#pragma unroll
                    for (int nt = 0; nt < 4; ++nt) { OT[qb][nt] = OT[qb][nt] * alpha;
#pragma unroll
                        for (int ks = 0; ks < 2; ++ks) OT[qb][nt] = __builtin_amdgcn_mfma_f32_16x16x32_bf16(Vf[nt][ks], Pb[ks], OT[qb][nt], 0, 0, 0); }
                }
                if (ti + 1 < ntile) AT_WRITE((ti + 1) & 1);
                __syncthreads();
            }
#undef AT_KROW
#undef AT_LOAD
#undef AT_WRITE
#pragma unroll
            for (int qb = 0; qb < 4; ++qb) {
                const float il = 1.f / lsum[qb];
                bf16_t* op = O + (size_t)(qrow0 + 16 * qb + fr) * D + hq * 64 + 4 * g;
#pragma unroll
                for (int nt = 0; nt < 4; ++nt) { const f32x4 v = OT[qb][nt] * il; u32x2 o; o.x = pk2(v[0], v[1]); o.y = pk2(v[2], v[3]); *(u32x2*)(op + 16 * nt) = o; }
            }
        }
    }
}

template <int GS>
__device__ __forceinline__ void phase_postmix(const Ctx& c, int layer, bool route) {
    const float* Y = (const float*)(c.ws + WS_RAW1); unsigned char* H8 = c.ws + WS_H8;
    float* Xout = (float*)(c.ws + (layer == 0 ? WS_X : WS_X1)); const float* Xprev = (const float*)(c.ws + WS_X);
    const float* ng = c.a->in[6] + layer * 4 * D; const float* Wr = c.a->in[15] + (size_t)layer * D * NE; const float* br = c.a->in[16] + layer * NE;
    unsigned* cnt = (unsigned*)(c.ws + WS_CTL) + CW_CNT + layer * NE;
    int* tk_e = (int*)(c.ws + WS_TK); float* tk_g = (float*)(c.ws + WS_TK) + R * 4; int* tk_slot = (int*)(c.ws + WS_TK) + 2 * R * 4;
    int* list = (int*)(c.ws + WS_LIST);
    LAS float* WL = (LAS float*)c.lds;
    LAS float* biasp = (LAS float*)(c.lds + 131072);
    LAS unsigned* lcnt = (LAS unsigned*)(c.lds + 145920); LAS unsigned* lbase = lcnt + 32; LAS float* rsx = (LAS float*)(lcnt + 64);
    LAS float* pvA = (LAS float*)(c.lds + 131072 + 2560); LAS float* pvB = pvA + 1024; LAS float* pvS = pvB + 1024;
    const int lane = c.lane, w = __builtin_amdgcn_readfirstlane(c.tid >> 6), fr = lane & 15, g = lane >> 4;
    constexpr int RP = GS / 8, NW2 = GS / 16;
    const int g_lo = layer == 0 ? 0 : C / GS;
    for (int grp = g_lo + c.wg; grp < R / GS; grp += c.nwg) {
        const int which = grp * GS < C ? 1 : 0;
        const float* m = c.modp(layer, which);
        __syncthreads();
        if (c.tid < NE) lcnt[c.tid] = 0u;
#pragma unroll 4
        for (int j = 0; j < 16; ++j) {
            const int i4 = c.tid + 512 * j, k = i4 >> 3, e0 = (i4 & 7) * 4;
            const f32x4 wv = *(const f32x4*)(Wr + (size_t)k * NE + e0); const float sc = ng[2 * D + k] * (1.f + m[4096 + k]);
            LAS float* dst = WL + ((((k >> 4) * 4 + (k & 3)) * 4 + ((k >> 2) & 3)) * 16) * 2;
#pragma unroll
            for (int q = 0; q < 4; ++q) { const int e = e0 + q; dst[(e & 15) * 2 + (e >> 4)] = wv[q] * sc; }
        }
        for (int k = c.tid; k < D; k += 512) { pvA[k] = m[2048 + k] * ng[D + k]; pvB[k] = ng[2 * D + k] * (1.f + m[4096 + k]); pvS[k] = m[3072 + k]; }
        { const int e = c.tid & 31, part = c.tid >> 5; float sacc = 0.f;
#pragma unroll 16
          for (int k = part * 64; k < part * 64 + 64; ++k) sacc += m[3072 + k] * Wr[k * NE + e];
          biasp[32 + part * 32 + e] = sacc; }
        __syncthreads();
        if (c.tid < 32) { float sacc = br[c.tid];
#pragma unroll
            for (int p = 0; p < 16; ++p) sacc += biasp[32 + p * 32 + c.tid]; biasp[c.tid] = sacc; }
        __syncthreads();
        const int row1 = grp * GS + w * RP;
        f32x4 yn[4], xn[4];
        row_load(Y + (size_t)(layer == 0 ? row1 : row1 - C) * D, lane, yn); row_load(layer == 0 ? c.xin0(row1) : Xprev + (size_t)row1 * D, lane, xn);
        for (int i = 0; i < RP; ++i) {
            const int r = row1 + i;
            f32x4 y[4], x[4];
#pragma unroll
            for (int j = 0; j < 4; ++j) { y[j] = yn[j]; x[j] = xn[j]; }
            if (i + 1 < RP) { row_load(Y + (size_t)(layer == 0 ? r + 1 : r + 1 - C) * D, lane, yn); row_load(layer == 0 ? c.xin0(r + 1) : Xprev + (size_t)(r + 1) * D, lane, xn); }
            const float rstd_y = rsqrtf(row_ss(y) * (1.f / D) + EPS);
#pragma unroll
            for (int j = 0; j < 4; ++j) {
                const int c0 = lane * 4 + 256 * j;
                x[j] += *(const LAS f32x4*)(pvA + c0) * (y[j] * rstd_y);
                *(f32x4*)(Xout + (size_t)r * D + c0) = x[j];
            }
            const float rstd_x = rsqrtf(row_ss(x) * (1.f / D) + EPS);
#pragma unroll
            for (int j = 0; j < 4; ++j) {
                const int c0 = lane * 4 + 256 * j;
                const f32x4 hv = x[j] * rstd_x * *(const LAS f32x4*)(pvB + c0) + *(const LAS f32x4*)(pvS + c0);
                *(unsigned*)(H8 + (size_t)r * D + c0) = pk4_fp8(hv[0] * F8_SH, hv[1] * F8_SH, hv[2] * F8_SH, hv[3] * F8_SH);
            }
            if (lane == 0) rsx[w * RP + i] = rstd_x;
        }
        asm volatile("s_waitcnt vmcnt(0)" ::: "memory");
        __syncthreads();
        const int row0 = grp * GS + w * 16; const bool w2 = w < NW2;
        f32x4 la[2]; la[0] = (f32x4){0.f, 0.f, 0.f, 0.f}; la[1] = la[0];
        if (w2) {
            const float* ap = Xout + (size_t)(row0 + fr) * D + 4 * g;
            const LAS float* bp = WL + (g * 16 + fr) * 2;
#pragma unroll 4
            for (int k4 = 0; k4 < 64; ++k4) {
                const f32x4 a4 = *(const f32x4*)(ap + 16 * k4);
#pragma unroll
                for (int q = 0; q < 4; ++q) {
                    const f32x2 b2 = *(const LAS f32x2*)(bp + (size_t)(4 * k4 + q) * 128);
                    la[0] = __builtin_amdgcn_mfma_f32_16x16x4f32(a4[q], b2[0], la[0], 0, 0, 0);
                    la[1] = __builtin_amdgcn_mfma_f32_16x16x4f32(a4[q], b2[1], la[1], 0, 0, 0);
                }
            }
        }
        float tv[4][4]; int te[4][4];
#pragma unroll
        for (int e = 0; e < 4; ++e) {
            const float rs = rsx[(w2 ? w * 16 : 0) + 4 * g + e];
            float v0 = la[0][e] * rs + biasp[fr], v1 = la[1][e] * rs + biasp[16 + fr];
#pragma unroll
            for (int k = 0; k < 4; ++k) {
                float bv; int bi;
                if (v0 >= v1) { bv = v0; bi = fr; } else { bv = v1; bi = 16 + fr; }
#pragma unroll
                for (int o = 8; o > 0; o >>= 1) {
                    const float ov = __shfl_xor(bv, o); const int oi = __shfl_xor(bi, o);
                    if (ov > bv || (ov == bv && oi < bi)) { bv = ov; bi = oi; }
                }
                tv[e][k] = bv; te[e][k] = bi;
                if (bi == fr) v0 = -INFINITY;
                if (bi == 16 + fr) v1 = -INFINITY;
            }
        }
        float v[4]; int ex[4]; unsigned sl[4];
#pragma unroll
        for (int k = 0; k < 4; ++k) { v[k] = tv[0][k]; ex[k] = te[0][k];
#pragma unroll
            for (int e = 1; e < 4; ++e) if (fr == e) { v[k] = tv[e][k]; ex[k] = te[e][k]; } }
        if (fr < 4 && route && w2) {
#pragma unroll
            for (int k = 0; k < 4; ++k) sl[k] = __hip_atomic_fetch_add(lcnt + ex[k], 1u, __ATOMIC_RELAXED, __HIP_MEMORY_SCOPE_WORKGROUP);
        }
        __syncthreads();
        if (c.tid < NE && route) { const unsigned n = lcnt[c.tid]; lbase[c.tid] = n ? atomicAdd(&cnt[c.tid], n) : 0u; }
        __syncthreads();
        if (fr < 4 && route && w2) {
            const int r = row0 + 4 * g + fr;
            const float e1 = __expf(v[1] - v[0]), e2 = __expf(v[2] - v[0]), e3 = __expf(v[3] - v[0]);
            const float inv = 1.f / (1.f + e1 + e2 + e3);
            const float gk[4] = {inv, e1 * inv, e2 * inv, e3 * inv};
#pragma unroll
            for (int k = 0; k < 4; ++k) {
                const unsigned slot = lbase[ex[k]] + sl[k];
                list[(size_t)ex[k] * R + slot] = r;
                tk_e[r * 4 + k] = ex[k]; tk_g[r * 4 + k] = gk[k]; tk_slot[r * 4 + k] = (int)slot;
            }
        }
    }
}

__device__ __forceinline__ void moe_offsets(const Ctx& c, int layer, LAS int* so) {
    const unsigned* cnt = (const unsigned*)(c.ws + WS_CTL) + CW_CNT + layer * NE;
    __syncthreads();
    if (c.tid < 64) {
        const int n = c.tid < NE ? (int)cnt[c.tid] : 0; int pad = (n + PADM - 1) / PADM * PADM, inc = pad;
#pragma unroll
        for (int o = 1; o < 32; o <<= 1) { const int t = __shfl_up(inc, o); if (c.lane >= o) inc += t; }
        if (c.tid < NE) { so[c.tid] = inc - pad; so[64 + c.tid] = n; }
        if (c.tid == NE - 1) so[32] = inc;
    }
    __syncthreads();
}

__device__ __forceinline__ void moe_tables(const Ctx& c, int layer, LAS int* tb) {
    const unsigned* cnt = (const unsigned*)(c.ws + WS_CTL) + CW_CNT + layer * NE;
    __syncthreads();
    if (c.tid < 64) {
        const int n = c.tid < NE ? (int)cnt[c.tid] : 0; int tiles = (n + PADM - 1) / PADM, inc = tiles;
#pragma unroll
        for (int o = 1; o < 32; o <<= 1) { const int t = __shfl_up(inc, o); if (c.lane >= o) inc += t; }
        if (c.tid < NE) { tb[c.tid] = inc - tiles; tb[64 + c.tid] = n; }
        if (c.tid == NE - 1) tb[32] = inc;
    }
    __syncthreads();
}
__device__ __forceinline__ int vcu_of(const Ctx& c) { return (c.nwg % 8 == 0) ? (c.wg % 8) * (c.nwg / 8) + c.wg / 8 : c.wg; }
__device__ __forceinline__ void phase_moe_gu(const Ctx& c, int layer) {
    LAS int* tb = (LAS int*)(c.lds + 131072 + 1024);
    moe_tables(c, layer, tb);
    pg8::Gemm g{c.ws + WS_H8, c.ws + WS_WGU + (size_t)layer * NE * 2048 * 1024, (size_t)2048 * 1024, (const int*)(c.ws + WS_LIST)};
    pg8::MoeOrder S{tb, tb + 64, 8, c.nwg, vcu_of(c), false};
    pg8::EpiSwiglu E{c.ws + WS_HDN, c.a->in[18] + (size_t)layer * NE * 2048};
    pg8::gemm_phase<pg8::EpiSwiglu, pg8::MoeOrder, true, true, true>(c.lds, g, S, E, c.tid);
}
__device__ __forceinline__ void phase_moe_dn(const Ctx& c, int layer) {
    LAS int* tb = (LAS int*)(c.lds + 131072 + 1024);
    moe_tables(c, layer, tb);
    pg8::Gemm g{c.ws + WS_HDN, c.ws + WS_WDN + (size_t)layer * NE * 1024 * 1024, (size_t)1024 * 1024, nullptr};
    pg8::MoeOrder S{tb, tb + 64, 4, c.nwg, vcu_of(c), true};
    pg8::EpiBf16Bias E{(bf16_t*)(c.ws + WS_OUTB), c.a->in[20] + (size_t)layer * NE * 1024, 1024, 1.f / (F8_SHD * F8_SW)};
    pg8::gemm_phase<pg8::EpiBf16Bias, pg8::MoeOrder, true, false, true>(c.lds, g, S, E, c.tid);
}
__device__ __forceinline__ void phase_gemm_f32(const Ctx& c, const bf16_t* A, int M, const bf16_t* Bt, int N, const float* bias, float* Cout) {
    pg8::Gemm g{A, Bt, 0, nullptr}; pg8::StaticOrder S; S.init(M, N, c.nwg, c.wg);
    pg8::EpiF32 E{Cout, N, bias};
    pg8::gemm_phase<pg8::EpiF32, pg8::StaticOrder, true, false, false>(c.lds, g, S, E, c.tid);
}

__device__ __forceinline__ void phase_gemm_qkv(const Ctx& c) {
    pg8::Gemm g{(const bf16_t*)(c.ws + WS_H), (const bf16_t*)(c.ws + WS_WQKV), 0, nullptr}; pg8::StaticOrder S; S.init(R, QKVD, c.nwg, c.wg);
    pg8::EpiQKV E{(bf16_t*)(c.ws + WS_Q), (bf16_t*)(c.ws + WS_K), (bf16_t*)(c.ws + WS_V), c.a->in[8], (const float*)(c.ws + WS_MOD) + MOD_ROPE};
    pg8::gemm_phase<pg8::EpiQKV, pg8::StaticOrder, true, false, false>(c.lds, g, S, E, c.tid);
}
__device__ __forceinline__ void phase_gemm_inproj(const Ctx& c) {
    pg8::Gemm g{c.ws + WS_H8, c.ws + WS_WIN, 0, nullptr}; pg8::StaticOrder S; S.init(R, HIN, c.nwg, c.wg);
    pg8::EpiInProj E{(bf16_t*)(c.ws + WS_QH), (_Float16*)(c.ws + WS_KF), (_Float16*)(c.ws + WS_KB), (bf16_t*)(c.ws + WS_IV), (bf16_t*)(c.ws + WS_SG), (const float*)(c.ws + WS_MOD) + MOD_LB, 1.f / (F8_SH * F8_SW)};
    pg8::gemm_phase<pg8::EpiInProj, pg8::StaticOrder, true, false, true>(c.lds, g, S, E, c.tid);
}

__device__ __forceinline__ void phase_norm0(const Ctx& c);
constexpr int CONV_A = 20 * 16 + 16 * 16 + 80 * 16 + 16 * 16, CONV_B = 32 * 32 * 16 + 32 * 16 * 16, CONV_CHUNK = 64;
__device__ __forceinline__ TBlk convert_item(const Ctx& c, int it, int part) {
    constexpr int I_QKV = 20 * 16, I_O = 16 * 16, I_IN = 80 * 16, I_HO = 16 * 16, I_GU = 32 * 32 * 16;
    int r = it; TBlk t; t.dst8 = nullptr; t.dst = nullptr;
    if (part == 0) {
        if (r < I_QKV) { const int nb = r % 20, kb = r / 20; t.src = c.a->in[7] + (size_t)kb * 64 * QKVD + nb * 64; t.ldw = QKVD; t.dst = (bf16_t*)(c.ws + WS_WQKV) + (size_t)nb * 64 * 1024 + kb * 64; return t; } r -= I_QKV;
        if (r < I_O) { const int nb = r % 16, kb = r / 16; t.src = c.a->in[10] + (size_t)kb * 64 * D + nb * 64; t.ldw = D; t.dst = (bf16_t*)(c.ws + WS_WO) + (size_t)nb * 64 * 1024 + kb * 64; return t; } r -= I_O;
        if (r < I_IN) { const int nb = r % 80, kb = r / 80; t.src = c.a->in[11] + (size_t)kb * 64 * HIN + nb * 64; t.ldw = HIN; t.dst8 = c.ws + WS_WIN + (size_t)nb * 64 * 1024 + kb * 64; return t; } r -= I_IN;
        if (r < I_HO) { const int nb = r % 16, kb = r / 16; t.src = c.a->in[14] + (size_t)kb * 64 * D + nb * 64; t.ldw = D; t.dst = (bf16_t*)(c.ws + WS_WHO) + (size_t)nb * 64 * 1024 + kb * 64; return t; } r -= I_HO;
    }
    const int moff = (part - 1) * 32;
    if (r < I_GU) { const int mat = moff + r / 512, rr = r % 512, nb = rr % 32, kb = rr / 32; const int n0 = ((nb & 3) >> 1) * 1024 + (nb >> 2) * 128 + (nb & 1) * 64;
        t.src = c.a->in[17] + (size_t)mat * 1024 * 2048 + (size_t)kb * 64 * 2048 + n0; t.ldw = 2048; t.dst8 = c.ws + WS_WGU + ((size_t)mat * 2048 + nb * 64) * 1024 + kb * 64; return t; } r -= I_GU;
    { const int mat = moff + r / 256, rr = r % 256, nb = rr % 16, kb = rr / 16;
        t.src = c.a->in[19] + (size_t)mat * 1024 * 1024 + (size_t)kb * 64 * 1024 + nb * 64; t.ldw = 1024; t.dst8 = c.ws + WS_WDN + ((size_t)mat * 1024 + nb * 64) * 1024 + kb * 64; }
    return t;
}
__device__ __forceinline__ void convert_run(const Ctx& c, int part, int first, int step, int end, LAS float* scr) {
    f32x4 va[16], vb[16];
    int it = first;
    TBlk ta, tbk;
    if (it < end) { ta = convert_item(c, it, part); tb_load(ta, c.lane, va); }
    for (; it < end; it += 2 * step) {
        const bool hb = it + step < end;
        if (hb) { tbk = convert_item(c, it + step, part); tb_load(tbk, c.lane, vb); }
        tb_store(ta, c.lane, va, scr);
        const bool ha = it + 2 * step < end;
        if (ha) { ta = convert_item(c, it + 2 * step, part); tb_load(ta, c.lane, va); }
        if (hb) tb_store(tbk, c.lane, vb, scr);
    }
}
__device__ __forceinline__ void convert_steal(const Ctx& c, int part) {
    LAS float* scr = (LAS float*)c.lds + c.wave * (64 * 65);
    LAS int* chp = (LAS int*)(c.lds + 8 * 64 * 65 * 4);
    unsigned* ctr = (unsigned*)(c.ws + WS_CTL) + CW_CONV + 64 * part;
    for (;;) {
        __syncthreads();
        if (c.tid == 0) *chp = (int)atomicAdd(ctr, 1u);
        __syncthreads();
        const int ch = *chp;
        if (ch >= CONV_B / CONV_CHUNK) break;
        convert_run(c, part, ch * CONV_CHUNK + c.wave, 8, (ch + 1) * CONV_CHUNK, scr);
    }
}
__device__ __forceinline__ void phase_convert(const Ctx& c) {
    LAS float* scr = (LAS float*)c.lds + c.wave * (64 * 65);
    convert_run(c, 0, c.wg * 8 + c.wave, c.nwg * 8, CONV_A, scr);
    __syncthreads();
    phase_norm0(c);
}

__device__ __forceinline__ void phase_combine(const Ctx& c, int layer) {
    LAS int* so = (LAS int*)(c.lds + 32768);
    moe_offsets(c, layer, so);
    const bf16_t* outb = (const bf16_t*)(c.ws + WS_OUTB); float* X = (float*)(c.ws + WS_X); bf16_t* H = (bf16_t*)(c.ws + WS_H);
    const float* Xin = layer == 0 ? X : (const float*)(c.ws + WS_X1);
    const float* ngl = c.a->in[6] + layer * 4 * D;
    const int* tk_e = (const int*)(c.ws + WS_TK); const float* tk_g = (const float*)(c.ws + WS_TK) + R * 4; const int* tk_slot = (const int*)(c.ws + WS_TK) + 2 * R * 4;
    const int r_lo = layer == 0 ? 0 : C, stride = c.nwg * 8;
    int r = r_lo + c.wg * 8 + c.wave;
    int pe[4], ps[4]; float pg[4]; u32x2 wn[4][4]; f32x4 xn[4]; float gn[4];
#define CB_TK(row) do { _Pragma("unroll") for (int k = 0; k < 4; ++k) { pe[k] = tk_e[(row) * 4 + k]; ps[k] = tk_slot[(row) * 4 + k]; pg[k] = tk_g[(row) * 4 + k]; } } while (0)
#define CB_DATA(row) do { _Pragma("unroll") for (int k = 0; k < 4; ++k) { const bf16_t* src_ = outb + (size_t)(so[pe[k]] + ps[k]) * 1024; gn[k] = pg[k]; \
        _Pragma("unroll") for (int j = 0; j < 4; ++j) wn[k][j] = *(const u32x2*)(src_ + c.lane * 4 + 256 * j); } row_load(Xin + (size_t)(row) * D, c.lane, xn); } while (0)
    if (r < R) { CB_TK(r); CB_DATA(r); }
    if (r + stride < R) CB_TK(r + stride);
    for (; r < R; r += stride) {
        const float* m = c.modp(layer, r < C ? 1 : 0);
        f32x4 y[4], x[4];
#pragma unroll
        for (int j = 0; j < 4; ++j) { y[j] = (f32x4){0.f, 0.f, 0.f, 0.f}; x[j] = xn[j]; }
#pragma unroll
        for (int k = 0; k < 4; ++k)
#pragma unroll
            for (int j = 0; j < 4; ++j) { const u32x2 w = wn[k][j]; y[j] += (f32x4){bflo(w.x), bfhi(w.x), bflo(w.y), bfhi(w.y)} * gn[k]; }
        if (r + stride < R) CB_DATA(r + stride);
        if (r + 2 * stride < R) CB_TK(r + 2 * stride);
        const float rstd_y = rsqrtf(row_ss(y) * (1.f / D) + EPS);
#pragma unroll
        for (int j = 0; j < 4; ++j) {
            const int c0 = c.lane * 4 + 256 * j;
            const f32x4 g2 = *(const f32x4*)(m + 5120 + c0), n3 = *(const f32x4*)(ngl + 3 * D + c0);
            x[j].x += g2.x * (y[j].x * rstd_y * n3.x); x[j].y += g2.y * (y[j].y * rstd_y * n3.y);
            x[j].z += g2.z * (y[j].z * rstd_y * n3.z); x[j].w += g2.w * (y[j].w * rstd_y * n3.w);
            if (layer == 0) *(f32x4*)(X + (size_t)r * D + c0) = x[j];
            else *(f32x4*)(c.a->out + (size_t)(r - C) * D + c0) = x[j];
        }
        if (layer == 0) {
            const float rstd_x = rsqrtf(row_ss(x) * (1.f / D) + EPS);
            const float* m1 = c.modp(1, r < C ? 1 : 0); const float* g0 = c.a->in[6] + 4 * D;
#pragma unroll
            for (int j = 0; j < 4; ++j) {
                const int c0 = c.lane * 4 + 256 * j;
                const f32x4 gv = *(const f32x4*)(g0 + c0), shv = *(const f32x4*)(m1 + c0), scv = *(const f32x4*)(m1 + 1024 + c0);
                const f32x4 hv = x[j] * rstd_x * gv * (scv + 1.f) + shv;
                *(unsigned*)(c.ws + WS_H8 + (size_t)r * D + c0) = pk4_fp8(hv[0] * F8_SH, hv[1] * F8_SH, hv[2] * F8_SH, hv[3] * F8_SH);
            }
        }
    }
#undef CB_TK
#undef CB_DATA
}

namespace hg {
typedef _Float16 h2_t __attribute__((ext_vector_type(2)));
constexpr int TB = 272, PB = 144;
constexpr int TILE = 64 * TB;
constexpr int T_QD = 0, T_QC = TILE, T_KD = 2 * TILE, T_KE = 3 * TILE, T_KC = 4 * TILE, T_V0 = 5 * TILE, T_V1 = 6 * TILE;
constexpr int T_QL1 = 7 * TILE, T_KL1 = T_QL1 + 16 * TB, T_P = T_KL1 + 16 * TB, T_TOT = T_P + 64 * PB, T_CT = T_TOT + 4096, T_END = T_CT + 512;
static_assert(T_END <= LDS_BYTES - 64, "hgrn scan LDS map");
__device__ __forceinline__ int row_of(int dir, int p) { return p < C ? (dir ? C - 1 - p : p) : (dir ? C + (L - 1 - (p - C)) : p); }
__device__ __forceinline__ int seg_of(int ch) { return ch < 68 ? ch / 17 : 4 + (ch - 68) / 16; }
__device__ __forceinline__ bf16x8 tr_frag(const LAS unsigned char* tile, int row0, int col0, int lane) {
    const int q = (lane & 15) >> 2, p = lane & 3;
    const LAS unsigned char* a = tile + (row0 + q) * TB + (col0 + 4 * p) * 2;
    const v4i16_t lo = __builtin_amdgcn_ds_read_tr16_b64_v4i16((LAS v4i16_t*)a);
    const v4i16_t hi = __builtin_amdgcn_ds_read_tr16_b64_v4i16((LAS v4i16_t*)(a + 4 * TB));
    return (bf16x8){lo[0], lo[1], lo[2], lo[3], hi[0], hi[1], hi[2], hi[3]};
}
}

__device__ __forceinline__ void phase_hgrn_scan(const Ctx& c) {
    using namespace hg;
#define HG_BAR() asm volatile("s_waitcnt lgkmcnt(0)\n\ts_barrier" ::: "memory")
    const bf16_t* QH = (const bf16_t*)(c.ws + WS_QH); const bf16_t* IV = (const bf16_t*)(c.ws + WS_IV);
    LAS unsigned char* lds = c.lds;
    const int tid = c.tid, lane = c.lane, w = __builtin_amdgcn_readfirstlane(tid >> 6), fr = lane & 15, g = lane >> 4;
    for (int item_ = c.wg; item_ < 256 * SCAN_REP; item_ += c.nwg) {
        const int item = item_ & 255;
        const int chain = item >> 4, seg = item & 15, head = chain >> 1, dir = chain & 1, hc = head * 128;
        const int c0 = seg < 4 ? 17 * seg : 68 + 16 * (seg - 4), nch = seg < 4 ? 17 : 16;
        const _Float16* KX = (const _Float16*)(c.ws + (dir ? WS_KB : WS_KF));
        float* OL = (float*)(c.ws + (dir ? WS_OB : WS_OF)); bf16_t* QS = (bf16_t*)(c.ws + (dir ? WS_QSB : WS_QSF));
        HG_BAR();
        for (int i = tid; i < 64 * PB / 4; i += 512) ((LAS unsigned*)(lds + T_P))[i] = 0u;
        f32x4 Sacc[8];
#pragma unroll
        for (int m = 0; m < 8; ++m) Sacc[m] = (f32x4){0.f, 0.f, 0.f, 0.f};
        float dseg0 = 1.f, dseg1 = 1.f;
        unsigned kraw[8], qraw[8]; u32x4 vraw[2];
#define HG_LOAD(cidx) do { const int p0_ = 64 * (cidx); const bool lat_ = (cidx) >= 4; \
        _Pragma("unroll") for (int i = 0; i < 8; ++i) { const int r_ = row_of(dir, p0_ + 8 * w + i); \
            kraw[i] = *(const unsigned*)(KX + (size_t)r_ * D + hc + 2 * lane); \
            qraw[i] = lat_ ? *(const unsigned*)(QH + (size_t)(r_ - C) * D + hc + 2 * lane) : 0u; } \
        _Pragma("unroll") for (int i = 0; i < 2; ++i) { const int idx_ = tid + 512 * i; const int r_ = row_of(dir, p0_ + (idx_ >> 4)); \
            vraw[i] = *(const u32x4*)(IV + (size_t)r_ * D + hc + (idx_ & 15) * 8); } } while (0)
        HG_LOAD(c0);
        for (int ci = 0; ci < nch; ++ci) {
            const int cidx = c0 + ci; const bool lat = cidx >= 4;
            const int vbuf = (ci & 1) ? T_V1 : T_V0;
            float kf[8][2], qf[8][2], cp[8][2];
            {
                float p0 = 1.f, p1 = 1.f;
#pragma unroll
                for (int i = 0; i < 8; ++i) {
                    const h2_t hv = __builtin_bit_cast(h2_t, kraw[i]);
                    kf[i][0] = (float)hv[0]; kf[i][1] = (float)hv[1];
                    qf[i][0] = bflo(qraw[i]); qf[i][1] = bfhi(qraw[i]);
                    p0 *= (1.f - kf[i][0]); p1 *= (1.f - kf[i][1]); cp[i][0] = p0; cp[i][1] = p1;
                }
                *(LAS f32x2*)(lds + T_TOT + (w * 128 + 2 * lane) * 4) = (f32x2){p0, p1};
#pragma unroll
                for (int i = 0; i < 2; ++i) { const int idx = tid + 512 * i; *(LAS u32x4*)(lds + vbuf + (idx >> 4) * TB + (idx & 15) * 16) = vraw[i]; }
            }
            HG_BAR();
            {
                f32x2 T[8];
#pragma unroll
                for (int x = 0; x < 8; ++x) T[x] = *(const LAS f32x2*)(lds + T_TOT + (x * 128 + 2 * lane) * 4);
                const int I = w >> 1, hh = w & 1;
                f32x2 bd[4];
#pragma unroll
                for (int x = 0; x < 4; ++x) bd[x] = T[2 * x] * T[2 * x + 1];
                f32x2 pre = (f32x2){1.f, 1.f}, cum = (f32x2){1.f, 1.f}, suf = (f32x2){1.f, 1.f}, bdI = (f32x2){1.f, 1.f};
#pragma unroll
                for (int x = 0; x < 8; ++x) if (hh && x == w - 1) pre = T[x];
#pragma unroll
                for (int x = 0; x < 4; ++x) { if (x < I) cum = cum * bd[x]; if (x > I) suf = suf * bd[x]; if (x == I) bdI = bd[x]; }
                const f32x2 ctot = (bd[0] * bd[1]) * (bd[2] * bd[3]);
#pragma unroll
                for (int i = 0; i < 8; ++i) {
                    const int tau = 8 * w + i;
                    float QDv[2], KDv[2], KEv[2], QCv[2], KCv[2];
#pragma unroll
                    for (int x = 0; x < 2; ++x) {
                        const float eq = pre[x] * cp[i][x], rc = __builtin_amdgcn_rcpf(eq);
                        QDv[x] = qf[i][x] * eq; KDv[x] = kf[i][x] * rc; KEv[x] = KDv[x] * bdI[x]; QCv[x] = QDv[x] * cum[x]; KCv[x] = KEv[x] * suf[x];
                    }
                    const int to = tau * TB + lane * 4;
                    *(LAS unsigned*)(lds + T_QD + to) = pk2(QDv[0], QDv[1]);
                    *(LAS unsigned*)(lds + T_KD + to) = pk2(KDv[0], KDv[1]);
                    *(LAS unsigned*)(lds + T_KE + to) = pk2(KEv[0], KEv[1]);
                    *(LAS unsigned*)(lds + T_QC + to) = pk2(QCv[0], QCv[1]);
                    *(LAS unsigned*)(lds + T_KC + to) = pk2(KCv[0], KCv[1]);
                    if (I == 3) *(LAS unsigned*)(lds + T_QL1 + (tau - 48) * TB + lane * 4) = pk2(QDv[0] * bd[2][0], QDv[1] * bd[2][1]);
                    if (I == 0) *(LAS unsigned*)(lds + T_KL1 + tau * TB + lane * 4) = pk2(KEv[0] * bd[1][0], KEv[1] * bd[1][1]);
                    if (lat) { const int r = row_of(dir, 64 * cidx + tau); *(unsigned*)(QS + (size_t)(r - C) * D + hc + 2 * lane) = pk2(QCv[0] * dseg0, QCv[1] * dseg1); }
                }
                dseg0 *= ctot[0]; dseg1 *= ctot[1];
                if (w == 0) *(LAS f32x2*)(lds + T_CT + lane * 8) = ctot;
            }
            HG_BAR();
            if (ci + 1 < nch) HG_LOAD(cidx + 1);
            if (lat) {
                const int nblk = w >= 6 ? 2 : 1;
                for (int b = 0; b < nblk; ++b) {
                    int I, J, qoff, qrow, koff, krow; bool diag = false;
                    if (w < 4) { I = 2 + (w >> 1); J = w & 1; qoff = (w >> 1) ? T_QL1 : T_QD; qrow = (w >> 1) ? 0 : 32; koff = (w & 1) ? T_KE : T_KL1; krow = (w & 1) ? 16 : 0; }
                    else if (w == 4) { I = 1; J = 0; qoff = T_QD; qrow = 16; koff = T_KE; krow = 0; }
                    else if (w == 5) { I = 3; J = 2; qoff = T_QD; qrow = 48; koff = T_KE; krow = 32; }
                    else { I = 2 * (w - 6) + b; J = I; qoff = T_QD; qrow = 16 * I; koff = T_KD; krow = 16 * I; diag = true; }
                    f32x4 pa = (f32x4){0.f, 0.f, 0.f, 0.f};
#pragma unroll
                    for (int ks = 0; ks < 4; ++ks) {
                        const bf16x8 av = *(const LAS bf16x8*)(lds + qoff + (qrow + fr) * TB + (32 * ks + 8 * g) * 2);
                        const bf16x8 bv = *(const LAS bf16x8*)(lds + koff + (krow + fr) * TB + (32 * ks + 8 * g) * 2);
                        pa = __builtin_amdgcn_mfma_f32_16x16x32_bf16(av, bv, pa, 0, 0, 0);
                    }
#pragma unroll
                    for (int e = 0; e < 4; ++e) {
                        const int tl = 4 * g + e; const float val = (diag && fr > tl) ? 0.f : pa[e];
                        *(LAS bf16_t*)(lds + T_P + (16 * I + tl) * PB + (16 * J + fr) * 2) = (bf16_t)f2bf(val);
                    }
                }
            }
            f32x4 oacc[4];
#pragma unroll
            for (int m = 0; m < 4; ++m) oacc[m] = (f32x4){0.f, 0.f, 0.f, 0.f};
            if (lat) {
                bf16x8 Sb[4];
#pragma unroll
                for (int ks = 0; ks < 4; ++ks) {
                    const f32x4 a0 = Sacc[2 * ks], a1 = Sacc[2 * ks + 1];
                    const u32x4 pk = (u32x4){pk2(a0[0], a0[1]), pk2(a0[2], a0[3]), pk2(a1[0], a1[1]), pk2(a1[2], a1[3])};
                    Sb[ks] = __builtin_bit_cast(bf16x8, pk);
                }
#pragma unroll
                for (int m = 0; m < 4; ++m)
#pragma unroll
                    for (int ks = 0; ks < 4; ++ks) {
                        const u32x2 lo = *(const LAS u32x2*)(lds + T_QC + (16 * m + fr) * TB + (32 * ks + 4 * g) * 2);
                        const u32x2 hi = *(const LAS u32x2*)(lds + T_QC + (16 * m + fr) * TB + (32 * ks + 16 + 4 * g) * 2);
                        const u32x4 pk = (u32x4){lo.x, lo.y, hi.x, hi.y};
                        oacc[m] = __builtin_amdgcn_mfma_f32_16x16x32_bf16(__builtin_bit_cast(bf16x8, pk), Sb[ks], oacc[m], 0, 0, 0);
                    }
            }
#pragma unroll
            for (int m = 0; m < 8; ++m) { const f32x4 ct = *(const LAS f32x4*)(lds + T_CT + (16 * m + 4 * g) * 4); Sacc[m] = Sacc[m] * ct; }
            bf16x8 Vf[2];
#pragma unroll
            for (int ks = 0; ks < 2; ++ks) Vf[ks] = tr_frag(lds + vbuf, 32 * ks + 8 * g, 16 * w, lane);
#pragma unroll
            for (int m = 0; m < 8; ++m)
#pragma unroll
                for (int ks = 0; ks < 2; ++ks) Sacc[m] = __builtin_amdgcn_mfma_f32_16x16x32_bf16(tr_frag(lds + T_KC, 32 * ks + 8 * g, 16 * m, lane), Vf[ks], Sacc[m], 0, 0, 0);
            HG_BAR();
            if (lat) {
#pragma unroll
                for (int m = 0; m < 4; ++m)
#pragma unroll
                    for (int ks = 0; ks < 2; ++ks) {
                        if (m < 2 && ks == 1) continue;
                        const bf16x8 av = *(const LAS bf16x8*)(lds + T_P + (16 * m + fr) * PB + (32 * ks + 8 * g) * 2);
                        oacc[m] = __builtin_amdgcn_mfma_f32_16x16x32_bf16(av, Vf[ks], oacc[m], 0, 0, 0);
                    }
#pragma unroll
                for (int m = 0; m < 4; ++m)
#pragma unroll
                    for (int e = 0; e < 4; ++e) { const int r = row_of(dir, 64 * cidx + 16 * m + 4 * g + e); OL[(size_t)(r - C) * D + hc + 16 * w + fr] = oacc[m][e]; }
            }
        }
#undef HG_LOAD
        float* DS = (float*)(c.ws + WS_DS) + (size_t)item * 16384; float* DG = (float*)(c.ws + WS_DG) + item * 128;
#pragma unroll
        for (int m = 0; m < 8; ++m)
#pragma unroll
            for (int e = 0; e < 4; ++e) DS[(16 * m + 4 * g + e) * 128 + 16 * w + fr] = Sacc[m][e];
        if (w == 0) { DG[2 * lane] = dseg0; DG[2 * lane + 1] = dseg1; }
    }
}

#undef HG_BAR
__device__ __forceinline__ void phase_hgrn_fold(const Ctx& c) {
    const float* DS = (const float*)(c.ws + WS_DS); const float* DG = (const float*)(c.ws + WS_DG); bf16_t* SST = (bf16_t*)(c.ws + WS_SST);
    for (int item = c.wg; item < 256; item += c.nwg) {
        const int chain = item >> 4, slice = item & 15, d = 8 * slice + (c.tid >> 6), v2 = (c.tid & 63) * 2;
        float s0 = 0.f, s1 = 0.f;
        float dv[15]; f32x2 ds[15];
#pragma unroll
        for (int sgi = 0; sgi < 15; ++sgi) { dv[sgi] = DG[(chain * 16 + sgi) * 128 + d]; ds[sgi] = *(const f32x2*)(DS + ((size_t)(chain * 16 + sgi) * 128 + d) * 128 + v2); }
        SST[((size_t)(chain * 16) * 128 + v2) * 128 + d] = 0; SST[((size_t)(chain * 16) * 128 + v2 + 1) * 128 + d] = 0;
#pragma unroll
        for (int sgi = 0; sgi < 15; ++sgi) {
            s0 = dv[sgi] * s0 + ds[sgi][0]; s1 = dv[sgi] * s1 + ds[sgi][1];
            SST[((size_t)(chain * 16 + sgi + 1) * 128 + v2) * 128 + d] = (bf16_t)f2bf(s0); SST[((size_t)(chain * 16 + sgi + 1) * 128 + v2 + 1) * 128 + d] = (bf16_t)f2bf(s1);
        }
    }
}

__device__ __forceinline__ void phase_hgrn_readout(const Ctx& c) {
    constexpr int SP = 272, SBUF = 128 * SP, IBUF = 2 * SBUF;
    static_assert(2 * IBUF + 1024 <= LDS_BYTES - 64, "readout LDS map");
    const float* OF = (const float*)(c.ws + WS_OF); const float* OB = (const float*)(c.ws + WS_OB); const bf16_t* SGp = (const bf16_t*)(c.ws + WS_SG);
    const bf16_t* SST = (const bf16_t*)(c.ws + WS_SST); bf16_t* RR = (bf16_t*)(c.ws + WS_RR); const float* hng = c.a->in[13];
    LAS unsigned char* lds = c.lds; LAS float* ssx = (LAS float*)(c.lds + 2 * IBUF);
    const int tid = c.tid, lane = c.lane, w = __builtin_amdgcn_readfirstlane(tid >> 6), fr = lane & 15, g = lane >> 4, mt = w & 3, nh = w >> 2;
#define RO_BAR() asm volatile("s_waitcnt lgkmcnt(0)\n\ts_barrier" ::: "memory")
    u32x4 sreg[8];
#define RO_SST_LOAD(it) do { const int h_ = (it) >> 8, ch_ = (it) & 255; \
        _Pragma("unroll") for (int j = 0; j < 8; ++j) { const int idx_ = tid + 512 * j, dx_ = idx_ >> 11, rem_ = idx_ & 2047; \
            const int sg_ = hg::seg_of(dx_ ? 4 + 255 - ch_ : 4 + ch_); \
            sreg[j] = *(const u32x4*)(SST + ((size_t)((h_ * 2 + dx_) * 16 + sg_) * 128 + (rem_ >> 4)) * 128 + (rem_ & 15) * 8); } } while (0)
#define RO_SST_WRITE(buf) do { _Pragma("unroll") for (int j = 0; j < 8; ++j) { const int idx_ = tid + 512 * j, dx_ = idx_ >> 11, rem_ = idx_ & 2047; \
            *(LAS u32x4*)(lds + (buf) * IBUF + dx_ * SBUF + (rem_ >> 4) * SP + (rem_ & 15) * 16) = sreg[j]; } } while (0)
    int it = c.wg;
    RO_BAR();
    if (it < 2048) { RO_SST_LOAD(it); RO_SST_WRITE(0); }
    RO_BAR();
    for (int k = 0; it < 2048; it += c.nwg, ++k) {
        const int h = it >> 8, ch = it & 255, t0 = 64 * ch + 16 * mt, buf = k & 1;
        const bool has_next = it + c.nwg < 2048;
        if (has_next) RO_SST_LOAD(it + c.nwg);
        f32x4 acc[4]; float sgv[4][4];
#pragma unroll
        for (int n = 0; n < 4; ++n)
#pragma unroll
            for (int e = 0; e < 4; ++e) { const size_t o = (size_t)(t0 + 4 * g + e) * D + h * 128 + 64 * nh + 16 * n + fr; acc[n][e] = OF[o] + OB[o]; sgv[n][e] = bf2f(SGp[o]) * hng[h * 128 + 64 * nh + 16 * n + fr]; }
#pragma unroll
        for (int dx = 0; dx < 2; ++dx) {
            const bf16_t* QS = (const bf16_t*)(c.ws + (dx ? WS_QSB : WS_QSF)) + (size_t)(t0 + fr) * D + h * 128 + 8 * g;
            const LAS unsigned char* sb = lds + buf * IBUF + dx * SBUF + (64 * nh + fr) * SP + 16 * g;
#pragma unroll
            for (int ks = 0; ks < 4; ++ks) {
                const bf16x8 av = *(const bf16x8*)(QS + 32 * ks);
#pragma unroll
                for (int n = 0; n < 4; ++n) acc[n] = __builtin_amdgcn_mfma_f32_16x16x32_bf16(av, *(const LAS bf16x8*)(sb + (16 * n) * SP + 64 * ks), acc[n], 0, 0, 0);
            }
        }
        float ss[4] = {0.f, 0.f, 0.f, 0.f};
#pragma unroll
        for (int n = 0; n < 4; ++n)
#pragma unroll
            for (int e = 0; e < 4; ++e) ss[e] += acc[n][e] * acc[n][e];
#pragma unroll
        for (int e = 0; e < 4; ++e) {
#pragma unroll
            for (int sh = 8; sh > 0; sh >>= 1) ss[e] += __shfl_xor(ss[e], sh);
        }
        if (fr == 0) *(LAS f32x4*)(ssx + ((k & 1) * 8 + w) * 16 + 4 * g) = (f32x4){ss[0], ss[1], ss[2], ss[3]};
        if (has_next) RO_SST_WRITE(buf ^ 1);
        RO_BAR();
        const f32x4 ps = *(const LAS f32x4*)(ssx + ((k & 1) * 8 + (w ^ 4)) * 16 + 4 * g);
#pragma unroll
        for (int e = 0; e < 4; ++e) ss[e] = rsqrtf((ss[e] + ps[e]) * (1.f / 128.f) + EPS);
#pragma unroll
        for (int n = 0; n < 4; ++n)
#pragma unroll
            for (int e = 0; e < 4; ++e) { const size_t o = (size_t)(t0 + 4 * g + e) * D + h * 128 + 64 * nh + 16 * n + fr; RR[o] = (bf16_t)f2bf(acc[n][e] * ss[e] * sgv[n][e]); }
    }
    RO_BAR();
#undef RO_BAR
#undef RO_SST_LOAD
#undef RO_SST_WRITE
}

#define XB_TMO      128
#define XB_XCNT(j)  (256  + 64 * (j))
#define XB_XSUB(j)  (1280 + 64 * (j))
#define XB_XGEN(j)  (2304 + 64 * (j))
#define XB_TOP      3328
#define XB_TOPGEN   3392
#define XCD_BAR_WORDS 3456
#define XB_SPIN_CAP (1u << 18)
__device__ __forceinline__ unsigned xb_ld(unsigned* p)              { return __hip_atomic_load(p, __ATOMIC_RELAXED, __HIP_MEMORY_SCOPE_AGENT); }
__device__ __forceinline__ unsigned xb_add(unsigned* p, unsigned v) { return __hip_atomic_fetch_add(p, v, __ATOMIC_RELAXED, __HIP_MEMORY_SCOPE_AGENT); }
__device__ __forceinline__ unsigned xb_xcc_id() { return (unsigned)__builtin_amdgcn_s_getreg((3 << 11) | 20) & 0xFu; }
#define XB_SPIN(cond, bar) do { unsigned _sp = 0; while (cond) { __builtin_amdgcn_s_sleep(1); \
    if ((++_sp & 255u) == 0u) { if (xb_ld(&(bar)[XB_TMO])) break; if (_sp > XB_SPIN_CAP) { atomicAdd(&(bar)[XB_TMO], 1u); break; } } } } while (0)
struct XcdBarrier { unsigned* bar; unsigned x; volatile LAS unsigned* st; };
__device__ __forceinline__ XcdBarrier xcd_barrier_post(unsigned* bar, volatile LAS unsigned* st) {
    XcdBarrier b; b.bar = bar; b.x = xb_xcc_id(); b.st = st;
    if (threadIdx.x == 0) (void)xb_add(&bar[XB_XCNT(b.x)], 1u);
    return b;
}
__device__ __forceinline__ void xcd_barrier_complete(unsigned* bar, unsigned x, unsigned& nloc, unsigned& nx) {
    const unsigned G = gridDim.x * gridDim.y * gridDim.z;
    unsigned sum, cnt, mine, sp = 0u;
    for (;;) {
        sum = 0u; cnt = 0u; mine = 0u;
#pragma unroll
        for (unsigned j = 0; j < 16; ++j) { const unsigned c = xb_ld(&bar[XB_XCNT(j)]); sum += c; cnt += (c > 0u) ? 1u : 0u; mine = (j == x) ? c : mine; }
        if (sum == G) break;
        __builtin_amdgcn_s_sleep(1);
        if ((++sp & 255u) == 0u) { if (xb_ld(&bar[XB_TMO])) break; if (sp > XB_SPIN_CAP) { atomicAdd(&bar[XB_TMO], 1u); break; } }
    }
    nloc = mine > 0u ? mine : 1u; nx = cnt > 0u ? cnt : 1u;
}
__device__ __forceinline__ void xcd_barrier(const XcdBarrier& b) {
    asm volatile("s_waitcnt vmcnt(0)" ::: "memory");
    __syncthreads();
    if (threadIdx.x == 0) {
        unsigned* bar = b.bar;
        __builtin_amdgcn_s_waitcnt(0);
        unsigned nloc = b.st[0], nx = b.st[1];
        if (nloc == 0u) { xcd_barrier_complete(bar, b.x, nloc, nx); b.st[0] = nloc; b.st[1] = nx; }
        const unsigned old = xb_add(&bar[XB_XSUB(b.x)], 1u);
        const unsigned gen = old / nloc;
        if (old + 1u == (gen + 1u) * nloc) {
            __builtin_amdgcn_fence(__ATOMIC_RELEASE, "agent");
            asm volatile("s_waitcnt vmcnt(0)" ::: "memory");
            const unsigned og = xb_add(&bar[XB_TOP], 1u);
            const unsigned tg = og / nx;
            if (og + 1u == (tg + 1u) * nx) xb_add(&bar[XB_TOPGEN], 1u);
            else XB_SPIN(xb_ld(&bar[XB_TOPGEN]) == tg, bar);
            __builtin_amdgcn_fence(__ATOMIC_ACQUIRE, "agent");
            xb_add(&bar[XB_XGEN(b.x)], 1u);
            asm volatile("s_waitcnt vmcnt(0)" ::: "memory");
        } else {
            XB_SPIN(xb_ld(&bar[XB_XGEN(b.x)]) == gen, bar);
            __builtin_amdgcn_fence(__ATOMIC_ACQUIRE, "agent");
            asm volatile("s_waitcnt vmcnt(0)" ::: "memory");
        }
    }
    __syncthreads();
}

__device__ __forceinline__ void launder(Ctx& c) { asm volatile("" : "+s"(c.a)); asm volatile("" : "+s"(c.ws)); asm volatile("" : "+s"(c.wave));
    c.lane = (int)__builtin_amdgcn_mbcnt_hi(~0u, __builtin_amdgcn_mbcnt_lo(~0u, 0u)); c.tid = c.wave * 64 + c.lane; }
__global__ void __launch_bounds__(512, 2) mk_fwd(Args args) {
    extern __shared__ __attribute__((aligned(16))) unsigned char lds_raw[];
    Ctx c; c.a = (CArgs)__builtin_amdgcn_kernarg_segment_ptr(); c.lds = (LAS unsigned char*)lds_raw; c.tid = threadIdx.x; c.lane = c.tid & 63; c.wave = __builtin_amdgcn_readfirstlane(c.tid >> 6); c.nwg = gridDim.x; c.wg = blockIdx.x; c.ws = c.a->ws;
    volatile LAS unsigned* bst = (volatile LAS unsigned*)(c.lds + LDS_BYTES - 64);
    if (c.tid < 4) bst[c.tid] = 0u;
    __syncthreads();
    const XcdBarrier bar = xcd_barrier_post((unsigned*)(c.ws + WS_CTL) + CW_BAR, bst);
    const int lo = c.a->ph_lo, hi = c.a->ph_hi;
    bool route_ok = true;
#define SEAM(k) do { if (lo <= (k) && (k) + 1 < hi) xcd_barrier(bar); } while (0)
#define IN(k) (lo <= (k) && (k) < hi && (launder(c), true))
#define PH(k, call) do { if (IN(k)) { if (PROBE_PH == (k)) { int nrep_ = 3; asm volatile("" : "+s"(nrep_)); for (int rep_ = 0; rep_ < nrep_; ++rep_) { route_ok = (rep_ + 1 == nrep_); call; if (rep_ + 1 < nrep_) xcd_barrier(bar); } } else { call; } } SEAM(k); } while (0)
    PH(0, phase_prep(c));
    PH(1, phase_convert(c));
    PH(2, phase_gemm_qkv(c));
    PH(3, phase_attn(c));
    PH(4, phase_gemm_f32(c, (const bf16_t*)(c.ws + WS_O), R, (const bf16_t*)(c.ws + WS_WO), D, nullptr, (float*)(c.ws + WS_RAW1)));
    PH(5, { phase_postmix<128>(c, 0, route_ok); convert_steal(c, 1); });
    PH(6, phase_moe_gu(c, 0));
    PH(7, phase_moe_dn(c, 0));
    PH(8, phase_combine(c, 0));
    PH(9, phase_gemm_inproj(c));
    PH(10, phase_hgrn_scan(c));
    PH(11, phase_hgrn_fold(c));
    PH(12, phase_hgrn_readout(c));
    PH(13, phase_gemm_f32(c, (const bf16_t*)(c.ws + WS_RR), L, (const bf16_t*)(c.ws + WS_WHO), D, nullptr, (float*)(c.ws + WS_RAW1)));
    PH(14, { phase_postmix<128>(c, 1, route_ok); convert_steal(c, 2); });
    PH(15, phase_moe_gu(c, 1));
    PH(16, phase_moe_dn(c, 1));
    PH(17, phase_combine(c, 1));
#undef IN
#undef PH
#undef SEAM
}

extern "C" void kernel_launch(void* const* d_in, const int* in_sizes, int n_in, void* d_out, int out_size, void* d_ws, size_t ws_size, hipStream_t stream) {
    static int grid = 0;
    if (grid == 0) {
        if (n_in != 21 || out_size != L * D || ws_size < WS_END) { fprintf(stderr, "kernel_launch: unexpected problem (n_in %d out %d ws %zu need %zu)\n", n_in, out_size, ws_size, (size_t)WS_END); grid = -1; return; }
        int dev = 0, cus = 0, per_cu = 0;
        hipGetDevice(&dev); hipDeviceGetAttribute(&cus, hipDeviceAttributeMultiprocessorCount, dev);
        if (hipFuncSetAttribute((const void*)mk_fwd, hipFuncAttributeMaxDynamicSharedMemorySize, LDS_BYTES) != hipSuccess) { fprintf(stderr, "kernel_launch: hipFuncSetAttribute failed\n"); grid = -1; return; }
        hipOccupancyMaxActiveBlocksPerMultiprocessor(&per_cu, (const void*)mk_fwd, 512, LDS_BYTES);
        if (per_cu < 1) fprintf(stderr, "kernel_launch: occupancy query says %d\n", per_cu);
        (void)hipGetLastError();
        grid = cus > 0 ? cus : 256;
    }
    if (grid < 0) return;
    hipMemsetAsync((char*)d_ws + WS_CTL, 0, MiB, stream);
    Args a{};
    for (int i = 0; i < 21; ++i) a.in[i] = (const float*)d_in[i];
    a.out = (float*)d_out; a.ws = (unsigned char*)d_ws;
    a.ph_lo = 0; a.ph_hi = NPHASE;
    hipLaunchKernelGGL(mk_fwd, dim3(grid), dim3(512), LDS_BYTES, stream, a);
}
```

```cpp
#include <hip/hip_runtime.h>
#include <cstdint>
#include <cstdio>

#define LAS __attribute__((address_space(3)))
typedef unsigned short bf16_t;
typedef short bf16x8 __attribute__((ext_vector_type(8)));
typedef float f32x4 __attribute__((ext_vector_type(4)));
typedef unsigned u32x4 __attribute__((ext_vector_type(4)));
typedef unsigned u32x2 __attribute__((ext_vector_type(2)));
typedef short v4i16_t __attribute__((ext_vector_type(4)));
typedef float f32x2 __attribute__((ext_vector_type(2)));

constexpr int D = 1024, L = 16384, C = 256, R = L + C;
constexpr int QKVD = 1280, HIN = 5120, NE = 32, TOPK = 4;
constexpr int PADM = 256, MAXROWS = 74752;
constexpr float EPS = 1e-6f;
constexpr float LOG2E = 1.4426950408889634f;
constexpr int NPHASE = 18;
#ifndef GEMM_REP
#define GEMM_REP 1
#endif
#ifndef PROBE_NOEPI
#define PROBE_NOEPI 0
#endif
#ifndef PROBE_SHORTK
#define PROBE_SHORTK 0
#endif
#ifndef SCAN_REP
#define SCAN_REP 1
#endif
#ifndef PROBE_PH
#define PROBE_PH (-1)
#endif
constexpr int LDS_BYTES = 147456;

constexpr size_t MiB = 1u << 20;
constexpr size_t al(size_t x) { return (x + MiB - 1) / MiB * MiB; }
constexpr size_t WS_CTL = 0;
constexpr size_t WS_MOD = WS_CTL + MiB;
constexpr size_t WS_X = WS_MOD + MiB;
constexpr size_t WS_H = WS_X + al((size_t)R * D * 4);
constexpr size_t WS_Q = WS_H + al((size_t)R * D * 2);
constexpr size_t WS_K = WS_Q + al((size_t)R * D * 2);
constexpr size_t WS_V = WS_K + al((size_t)R * 128 * 2);
constexpr size_t WS_O = WS_V + al((size_t)R * 128 * 2);
constexpr size_t WS_TK = WS_O + al((size_t)R * D * 2);
constexpr size_t WS_LIST = WS_TK + MiB;
constexpr size_t WS_HDN = WS_LIST + 3 * MiB;
constexpr size_t WS_RAW1 = WS_HDN + al((size_t)MAXROWS * 1024 * 2);
constexpr size_t WS_X1 = WS_RAW1 + al((size_t)R * D * 4);
constexpr size_t WS_OUTB = WS_X1 + al((size_t)R * D * 4);
constexpr size_t WS_QH = WS_OUTB + al((size_t)MAXROWS * 1024 * 2);
constexpr size_t WS_KF = WS_QH + al((size_t)L * D * 2);
constexpr size_t WS_KB = WS_KF + al((size_t)R * D * 2);
constexpr size_t WS_IV = WS_KB + al((size_t)R * D * 2);
constexpr size_t WS_SG = WS_IV + al((size_t)R * D * 2);
constexpr size_t WS_OF = WS_SG + al((size_t)L * D * 2);
constexpr size_t WS_OB = WS_OF + al((size_t)L * D * 4);
constexpr size_t WS_RR = WS_OB + al((size_t)L * D * 4);
constexpr size_t WS_WQKV = WS_RR + al((size_t)L * D * 2);
constexpr size_t WS_WO = WS_WQKV + al((size_t)QKVD * D * 2);
constexpr size_t WS_WIN = WS_WO + al((size_t)D * D * 2);
constexpr size_t WS_WHO = WS_WIN + al((size_t)HIN * D * 2);
constexpr size_t WS_WGU = WS_WHO + al((size_t)D * D * 2);
constexpr size_t WS_WDN = WS_WGU + al((size_t)2 * NE * 2048 * D * 2);
constexpr size_t WS_QSF = WS_WDN + al((size_t)2 * NE * 1024 * D * 2);
constexpr size_t WS_QSB = WS_QSF + al((size_t)L * D * 2);
constexpr size_t WS_DS = WS_QSB + al((size_t)L * D * 2);
constexpr size_t WS_DG = WS_DS + al((size_t)256 * 128 * 128 * 4);
constexpr size_t WS_SST = WS_DG + MiB;
constexpr size_t WS_H8 = WS_SST + al((size_t)256 * 128 * 128 * 2);
constexpr size_t WS_END = WS_H8 + al((size_t)R * D);
static_assert(WS_END <= (size_t)2048 * MiB, "workspace map exceeds 4x the largest input");
constexpr int CW_CNT = 1024;
constexpr int CW_CONV = 2048;
constexpr int CW_BAR = 4096;
constexpr int MOD_ROPE = 32768;
constexpr int MOD_LB = 49152;

struct Args { const float* in[21]; float* out; unsigned char* ws; int ph_lo, ph_hi; };

__device__ __forceinline__ unsigned f2bf(float f) { unsigned u = __float_as_uint(f); return (u + 0x7fffu + ((u >> 16) & 1u)) >> 16; }
typedef float f32x2_t __attribute__((ext_vector_type(2))); typedef __bf16 bf16x2_t __attribute__((ext_vector_type(2)));
__device__ __forceinline__ unsigned pk2(float lo, float hi) { f32x2_t v = {lo, hi}; bf16x2_t b = __builtin_convertvector(v, bf16x2_t); return __builtin_bit_cast(unsigned, b); }
__device__ __forceinline__ unsigned pk4_fp8(float a, float b, float c, float d) {
    a = fminf(fmaxf(a, -448.f), 448.f); b = fminf(fmaxf(b, -448.f), 448.f); c = fminf(fmaxf(c, -448.f), 448.f); d = fminf(fmaxf(d, -448.f), 448.f);
    int v = __builtin_amdgcn_cvt_pk_fp8_f32(a, b, 0, false); v = __builtin_amdgcn_cvt_pk_fp8_f32(c, d, v, true); return (unsigned)v; }
constexpr float F8_SH = 8.f, F8_SW = 64.f, F8_SHD = 4.f;
__device__ __forceinline__ float bflo(unsigned u) { return __uint_as_float(u << 16); }
__device__ __forceinline__ float bfhi(unsigned u) { return __uint_as_float(u & 0xffff0000u); }
__device__ __forceinline__ float bf2f(bf16_t b) { return __uint_as_float(((unsigned)b) << 16); }
__device__ __forceinline__ float wave_sum(float v) {
#pragma unroll
    for (int o = 32; o > 0; o >>= 1) v += __shfl_xor(v, o);
    return v;
}
__device__ __forceinline__ float silu_f(float x) { return x / (1.f + __expf(-x)); }
__device__ __forceinline__ float sigmoid_f(float x) { return 1.f / (1.f + __expf(-x)); }

typedef const __attribute__((address_space(4))) Args* CArgs;
struct Ctx {
    CArgs a;
    LAS unsigned char* lds;
    int tid, lane, wave, nwg, wg;
    unsigned char* ws;
    __device__ __forceinline__ float* modp(int layer, int which) const { return (float*)(ws + WS_MOD) + (layer * 2 + which) * 6144; }
    __device__ __forceinline__ const float* xin0(int r) const { return r < C ? a->in[2] + (size_t)r * D : a->in[0] + (size_t)(r - C) * D; }
};


namespace pg8 {
constexpr int BM = 256, BK = 64, HALF = 128, HTB = HALF * BK * 2, STAGE_BYTES = 8 * HTB, KD = 1024, NXCD = 8, WGM = 8;
__device__ __forceinline__ int lds_byte(int r, int c) { const int st = (r >> 4) * 2 + (c >> 5), rr = r & 15, cc = c & 31, ob = rr * 64 + cc * 2; return st * 1024 + (ob ^ (((ob >> 9) & 1) << 5)); }
__device__ __forceinline__ void stage_rc(int b, int& Rr, int& Cc) { const int st = b / 1024, sb = b % 1024, swz = sb ^ (((sb >> 9) & 1) << 5); Rr = (st >> 1) * 16 + swz / 64; Cc = (st & 1) * 32 + (swz % 64) / 2; }
__device__ __forceinline__ int perm32(int rho) { const int n = rho >> 4, i = rho & 15; return 8 * (i >> 2) + 4 * n + (i & 3); }

struct Unit { int pm, pn, e, goff, gcnt; bool real; int amask, bmask; };
struct Gemm { const void* A; const void* Bt; size_t bstride; const int* list; };

struct StaticOrder {
    int nM, nN, nwg, G, c;
    __device__ __forceinline__ void init(int M, int N, int G_, int c_) { nM = M / BM; nN = N / BM; nwg = nM * nN; G = G_; c = c_; }
    __device__ __forceinline__ bool next(int i, Unit& u) const {
        const int F = nwg / G, Rm = nwg - F * G; int Lq; u.amask = 3; u.bmask = 3;
        if (i < F) Lq = i * G + c;
        else if (i == F && Rm > 0) {
            if (4 * Rm <= G) { if (c >= 4 * Rm) return false; Lq = F * G + (c >> 2); u.amask = 1 << ((c >> 1) & 1); u.bmask = 1 << (c & 1); }
            else if (2 * Rm <= G) { if (c >= 2 * Rm) return false; Lq = F * G + (c >> 1); u.bmask = 1 << (c & 1); }
            else { if (c >= Rm) return false; Lq = F * G + c; }
        } else return false;
        int wgid = Lq; { const int q = nwg / NXCD, r = nwg % NXCD, xcd = wgid % NXCD, off = wgid / NXCD; wgid = (xcd < r ? xcd * (q + 1) : r * (q + 1) + (xcd - r) * q) + off; }
        const int nig = WGM * nN, gid = wgid / nig, fm = gid * WGM, gsz = (nM - fm) < WGM ? (nM - fm) : WGM;
        u.pm = fm + ((wgid % nig) % gsz); u.pn = (wgid % nig) / gsz; u.e = 0; u.goff = 0; u.gcnt = 0; u.real = true; return true;
    }
};
struct MoeOrder {
    const LAS int* tp; const LAS int* cnt; int npn, G, vcu; bool split;
    __device__ __forceinline__ bool next(int i, Unit& u) const {
        const int tot = tp[32] * npn; int lin; u.amask = 3; u.bmask = 3; u.real = true;
        if (GEMM_REP > 1) { const int lin0 = i * G + vcu; if (lin0 >= tot * GEMM_REP) return false; lin = lin0 % tot; u.real = lin0 >= tot * (GEMM_REP - 1); }
        else {
            const int F = tot / G, Rm = tot - F * G;
            if (i < F) lin = i * G + vcu;
            else if (i == F && Rm > 0) {
                if (split && 2 * Rm <= G) { if (vcu >= 2 * Rm) return false; lin = F * G + (vcu >> 1); u.bmask = 1 << (vcu & 1); }
                else { if (vcu >= Rm) return false; lin = F * G + vcu; }
            } else return false;
        }
        const int rt = lin / npn; int e = 0;
#pragma unroll 8
        for (int k = 1; k < 32; ++k) e += (rt >= tp[k]) ? 1 : 0;
        const int mt = rt - tp[e];
        u.pm = rt; u.pn = lin - rt * npn; u.e = e; u.goff = e * R + mt * 256; u.gcnt = cnt[e] - mt * 256; return true;
    }
};

template <int KB>
__device__ __forceinline__ void a_offsets(const Gemm& g, const Unit& u, const int (&sR)[2], const int (&sC)[2], unsigned (&v)[2][2]) {
#pragma unroll
    for (int h = 0; h < 2; ++h)
#pragma unroll
        for (int i = 0; i < 2; ++i) {
            const int rr = h * HALF + sR[i]; int row;
            if (g.list) row = rr < u.gcnt ? g.list[u.goff + rr] : 0; else row = u.pm * BM + rr;
            v[h][i] = (unsigned)(row * KB + sC[i] * 2);
        }
}

struct EpiF32 {
    static constexpr bool PERM = false;
    bf16_t* Cp; int ldc; const float* bias;
    __device__ __forceinline__ void operator()(const f32x4 (&acc)[2][2][4][2], const Unit& u, int wr, int wc, int fr, int fq) const {
        const int row0 = u.pm * BM + wr * 64 + fr, col0 = u.pn * BM + wc * 32 + 4 * fq;
#pragma unroll
        for (int bj = 0; bj < 2; ++bj)
#pragma unroll
            for (int n = 0; n < 2; ++n) {
                const int col = col0 + bj * HALF + n * 16;
                if (!((u.bmask >> bj) & 1)) continue;
                const f32x4 bv = bias ? *(const f32x4*)(bias + col) : (f32x4){0.f, 0.f, 0.f, 0.f};
#pragma unroll
                for (int ai = 0; ai < 2; ++ai)
#pragma unroll
                    for (int m = 0; m < 4; ++m) if ((u.amask >> ai) & 1) { const f32x4 v = acc[ai][bj][m][n] + bv; u32x2 o; o.x = pk2(v[0], v[1]); o.y = pk2(v[2], v[3]);
                        *(u32x2*)(Cp + (size_t)(row0 + ai * HALF + m * 16) * ldc + col) = o; }
            }
    }
};
struct EpiSwiglu {
    static constexpr bool PERM = true;
    unsigned char* Hd; const float* bgu;
    __device__ __forceinline__ void operator()(const f32x4 (&acc)[2][2][4][2], const Unit& u, int wr, int wc, int fr, int fq) const {
        const int row0 = u.pm * BM + wr * 64 + fr, cg0 = u.pn * HALF + wc * 32 + 8 * fq;
        const float* bb = bgu + (size_t)u.e * 2048;
        f32x4 bg[2], bu[2];
#pragma unroll
        for (int n = 0; n < 2; ++n) { bg[n] = *(const f32x4*)(bb + cg0 + 4 * n); bu[n] = *(const f32x4*)(bb + 1024 + cg0 + 4 * n); }
#pragma unroll
        for (int ai = 0; ai < 2; ++ai)
#pragma unroll
            for (int m = 0; m < 4; ++m) {
                u32x2 o;
#pragma unroll
                for (int n = 0; n < 2; ++n) {
                    const f32x4 gv = acc[ai][0][m][n] * (1.f / (F8_SH * F8_SW)) + bg[n], uv = acc[ai][1][m][n] * (1.f / (F8_SH * F8_SW)) + bu[n]; float hv[4];
#pragma unroll
                    for (int q = 0; q < 4; ++q) { const float gg = fminf(gv[q], 7.f), uu = fminf(fmaxf(uv[q], -7.f), 7.f); hv[q] = gg * __builtin_amdgcn_rcpf(1.f + __builtin_amdgcn_exp2f(-1.702f * LOG2E * gg)) * (uu + 1.f); }
                    o[n] = pk4_fp8(hv[0] * F8_SHD, hv[1] * F8_SHD, hv[2] * F8_SHD, hv[3] * F8_SHD);
                }
                *(u32x2*)(Hd + (size_t)(row0 + ai * HALF + m * 16) * 1024 + cg0) = o;
            }
    }
};
struct EpiBf16Bias {
    static constexpr bool PERM = true;
    bf16_t* Op; const float* bias; int bias_estride; float scale;
    __device__ __forceinline__ void operator()(const f32x4 (&acc)[2][2][4][2], const Unit& u, int wr, int wc, int fr, int fq) const {
        const int row0 = u.pm * BM + wr * 64 + fr, col0 = u.pn * BM + wc * 32 + 8 * fq;
        const float* bb = bias + (size_t)u.e * bias_estride;
#pragma unroll
        for (int bj = 0; bj < 2; ++bj) {
            const int col = col0 + bj * HALF;
            if (!((u.bmask >> bj) & 1)) continue;
            const f32x4 b0 = *(const f32x4*)(bb + col), b1 = *(const f32x4*)(bb + col + 4);
#pragma unroll
            for (int ai = 0; ai < 2; ++ai)
#pragma unroll
                for (int m = 0; m < 4; ++m) { if (!((u.amask >> ai) & 1)) continue; const f32x4 v0 = acc[ai][bj][m][0] * scale + b0, v1 = acc[ai][bj][m][1] * scale + b1;
                    u32x4 o; o.x = pk2(v0[0], v0[1]); o.y = pk2(v0[2], v0[3]); o.z = pk2(v1[0], v1[1]); o.w = pk2(v1[2], v1[3]);
                    *(u32x4*)(Op + (size_t)(row0 + ai * HALF + m * 16) * 1024 + col) = o; }
        }
    }
};
struct EpiQKV {
    static constexpr bool PERM = false;
    bf16_t* Qp; bf16_t* Kp; bf16_t* Vp; const float* bias; const float* tab;
    __device__ __forceinline__ void operator()(const f32x4 (&acc)[2][2][4][2], const Unit& u, int wr, int wc, int fr, int fq) const {
        const bool lat = u.pm > 0; const float qs = 0.125f * LOG2E;
#pragma unroll
        for (int bj = 0; bj < 2; ++bj) {
            const int colt = u.pn * BM + bj * HALF + wc * 32 + 4 * fq;
            const f32x4 b1 = *(const f32x4*)(bias + colt), b2 = *(const f32x4*)(bias + colt + 16);
            const bool isv = (u.pn == 4) && (bj == 1);
            if (!((u.bmask >> bj) & 1)) continue;
#pragma unroll
            for (int ai = 0; ai < 2; ++ai)
#pragma unroll
                for (int m = 0; m < 4; ++m) {
                    if (!((u.amask >> ai) & 1)) continue;
                    const int r = u.pm * BM + ai * HALF + wr * 64 + m * 16 + fr, t = r - C;
                    f32x4 x1 = acc[ai][bj][m][0] + b1, x2 = acc[ai][bj][m][1] + b2;
                    if (lat && !isv) {
                        const int pos = (wc & 1) ? (t & 63) : (t >> 6);
                        const f32x4 t0 = *(const f32x4*)(tab + (pos * 16 + 4 * fq) * 2), t1 = *(const f32x4*)(tab + (pos * 16 + 4 * fq) * 2 + 4);
                        const float cs[4] = {t0[0], t0[2], t1[0], t1[2]}, sn[4] = {t0[1], t0[3], t1[1], t1[3]};
                        f32x4 o1, o2;
#pragma unroll
                        for (int e = 0; e < 4; ++e) { o1[e] = x1[e] * cs[e] - x2[e] * sn[e]; o2[e] = x2[e] * cs[e] + x1[e] * sn[e]; }
                        x1 = o1; x2 = o2;
                    }
                    u32x2 w1, w2;
                    if (u.pn < 4) {
                        w1.x = pk2(x1[0] * qs, x1[1] * qs); w1.y = pk2(x1[2] * qs, x1[3] * qs); w2.x = pk2(x2[0] * qs, x2[1] * qs); w2.y = pk2(x2[2] * qs, x2[3] * qs);
                        *(u32x2*)(Qp + (size_t)r * 1024 + colt) = w1; *(u32x2*)(Qp + (size_t)r * 1024 + colt + 16) = w2;
                    } else {
                        w1.x = pk2(x1[0], x1[1]); w1.y = pk2(x1[2], x1[3]); w2.x = pk2(x2[0], x2[1]); w2.y = pk2(x2[2], x2[3]);
                        bf16_t* dst = (bj == 0 ? Kp : Vp) + (size_t)r * 128 + wc * 32 + 4 * fq;
                        *(u32x2*)dst = w1; *(u32x2*)(dst + 16) = w2;
                    }
                }
        }
    }
};
struct EpiInProj {
    static constexpr bool PERM = true;
    bf16_t* QH; _Float16* KF; _Float16* KB; bf16_t* IV; bf16_t* SG; const float* lb; float scale;
    __device__ __forceinline__ void operator()(const f32x4 (&acc)[2][2][4][2], const Unit& u, int wr, int wc, int fr, int fq) const {
        const int seg = u.pn >> 2; const bool lat = u.pm > 0;
        if (!lat && (seg == 0 || seg == 4)) return;
        typedef _Float16 h8_t __attribute__((ext_vector_type(8)));
#pragma unroll
        for (int bj = 0; bj < 2; ++bj) {
            const int col = (u.pn & 3) * BM + bj * HALF + wc * 32 + 8 * fq;
            if (!((u.bmask >> bj) & 1)) continue;
            f32x4 lb0 = (f32x4){0.f, 0.f, 0.f, 0.f}, lb1 = lb0;
            if (seg == 1) { lb0 = *(const f32x4*)(lb + col); lb1 = *(const f32x4*)(lb + col + 4); } else if (seg == 2) { lb0 = *(const f32x4*)(lb + 1024 + col); lb1 = *(const f32x4*)(lb + 1024 + col + 4); }
#pragma unroll
            for (int ai = 0; ai < 2; ++ai)
#pragma unroll
                for (int m = 0; m < 4; ++m) {
                    if (!((u.amask >> ai) & 1)) continue;
                    const int r = u.pm * BM + ai * HALF + wr * 64 + m * 16 + fr; const f32x4 v0 = acc[ai][bj][m][0] * scale, v1 = acc[ai][bj][m][1] * scale;
                    if (seg == 1 || seg == 2) {
                        h8_t hv;
#pragma unroll
                        for (int e = 0; e < 4; ++e) { hv[e] = (_Float16)((1.f - lb0[e]) * __builtin_amdgcn_rcpf(1.f + __builtin_amdgcn_exp2f(LOG2E * v0[e]))); hv[4 + e] = (_Float16)((1.f - lb1[e]) * __builtin_amdgcn_rcpf(1.f + __builtin_amdgcn_exp2f(LOG2E * v1[e]))); }
                        *(h8_t*)((seg == 1 ? KF : KB) + (size_t)r * 1024 + col) = hv;
                    } else if (seg == 3) {
                        u32x4 o; o.x = pk2(v0[0], v0[1]); o.y = pk2(v0[2], v0[3]); o.z = pk2(v1[0], v1[1]); o.w = pk2(v1[2], v1[3]); *(u32x4*)(IV + (size_t)r * 1024 + col) = o;
                    } else {
                        float s0[4], s1[4];
#pragma unroll
                        for (int e = 0; e < 4; ++e) { s0[e] = v0[e] * __builtin_amdgcn_rcpf(1.f + __builtin_amdgcn_exp2f(-LOG2E * v0[e])); s1[e] = v1[e] * __builtin_amdgcn_rcpf(1.f + __builtin_amdgcn_exp2f(-LOG2E * v1[e])); }
                        u32x4 o; o.x = pk2(s0[0], s0[1]); o.y = pk2(s0[2], s0[3]); o.z = pk2(s1[0], s1[1]); o.w = pk2(s1[2], s1[3]); *(u32x4*)((seg == 0 ? QH : SG) + (size_t)(r - C) * 1024 + col) = o;
                    }
                }
        }
    }
};

typedef int v8i __attribute__((ext_vector_type(8)));
typedef int v4i __attribute__((ext_vector_type(4)));
template <class Epi, class Sched, bool ALIGN_EPI, bool GATHER, bool FP8>
__device__ __forceinline__ void gemm_phase(LAS unsigned char* lds, const Gemm g, const Sched& S, const Epi& E, const int tid) {
    const int wid = __builtin_amdgcn_readfirstlane(tid >> 6), lane = tid & 63, wr = wid >> 2, wc = wid & 3, fr = lane & 15, fq = lane >> 4;
    constexpr int KB = FP8 ? 1024 : 2048, nt = 1024 / (FP8 ? 128 : 64);
    int sR[2], sC[2]; unsigned voffB[2], voffA[2];
#pragma unroll
    for (int i = 0; i < 2; ++i) { stage_rc(tid * 16 + i * 8192, sR[i], sC[i]); const int Rb = Epi::PERM ? ((sR[i] & ~31) + perm32(sR[i] & 31)) : sR[i]; voffB[i] = (unsigned)(Rb * KB + sC[i] * 2); voffA[i] = (unsigned)(sR[i] * KB + sC[i] * 2); }
    constexpr size_t kstep = (size_t)(BK * 2), hstep = (size_t)HALF * KB, tstep = 2 * hstep;
    const unsigned ldsw = (unsigned)wid * 1024u;
    const int aoff = lds_byte(wr * 64 + fr, fq * 8), boff = lds_byte(wc * 32 + fr, fq * 8);
    const char* Ab = (const char*)g.A;
#define PG8_SA(b, h) (((b) * 2 + (h)) * HTB)
#define PG8_SB(b, h) ((4 + (b) * 2 + (h)) * HTB)
#define PG8_STAGE_B(bufoff, gbase) do { _Pragma("unroll") for (int _i = 0; _i < 2; ++_i) \
        __builtin_amdgcn_global_load_lds((const unsigned*)((const char*)(gbase) + voffB[_i]), (LAS unsigned*)(lds + (bufoff) + ldsw + _i * 8192), 16, 0, 0); } while (0)
#define PG8_STAGE_A(bufoff, kb, v, ubase) do { _Pragma("unroll") for (int _i = 0; _i < 2; ++_i) \
        __builtin_amdgcn_global_load_lds((const unsigned*)((GATHER ? Ab : (ubase)) + (size_t)(kb) + (GATHER ? (v)[_i] : voffA[_i])), (LAS unsigned*)(lds + (bufoff) + ldsw + _i * 8192), 16, 0, 0); } while (0)
#define PG8_LD8(p) __builtin_shufflevector(*(const LAS v4i*)(p), *(const LAS v4i*)((p) + 1024), 0, 1, 2, 3, 4, 5, 6, 7)
#define PG8_LDA(dst, b, h) do { if constexpr (FP8) { _Pragma("unroll") for (int m = 0; m < 4; ++m) dst##8[m] = PG8_LD8(lds + PG8_SA(b, h) + aoff + m * 2048); } else { _Pragma("unroll") for (int m = 0; m < 4; ++m) _Pragma("unroll") for (int k = 0; k < 2; ++k) dst[m][k] = *(const LAS bf16x8*)(lds + PG8_SA(b, h) + aoff + m * 2048 + k * 1024); } } while (0)
#define PG8_LDB(dst, b, h) do { if constexpr (FP8) { _Pragma("unroll") for (int n = 0; n < 2; ++n) dst##8[n] = PG8_LD8(lds + PG8_SB(b, h) + boff + n * 2048); } else { _Pragma("unroll") for (int n = 0; n < 2; ++n) _Pragma("unroll") for (int k = 0; k < 2; ++k) dst[n][k] = *(const LAS bf16x8*)(lds + PG8_SB(b, h) + boff + n * 2048 + k * 1024); } } while (0)
#define PG8_MMA(ai, bj, At, Bt) do { __builtin_amdgcn_s_setprio(1); if constexpr (FP8) { _Pragma("unroll") for (int m = 0; m < 4; ++m) _Pragma("unroll") for (int n = 0; n < 2; ++n) \
        asm volatile("v_mfma_scale_f32_16x16x128_f8f6f4 %0, %1, %2, %0, %3, %3 op_sel_hi:[0,0,0]" : "+v"(acc[ai][bj][m][n]) : "v"(Bt##8[n]), "v"(At##8[m]), "v"(unit_scale)); } else { \
        _Pragma("unroll") for (int m = 0; m < 4; ++m) _Pragma("unroll") for (int n = 0; n < 2; ++n) _Pragma("unroll") for (int k = 0; k < 2; ++k) \
        acc[ai][bj][m][n] = __builtin_amdgcn_mfma_f32_16x16x32_bf16(Bt[n][k], At[m][k], acc[ai][bj][m][n], 0, 0, 0); } __builtin_amdgcn_s_setprio(0); } while (0)
#define PG8_WAIT_V(n) asm volatile("s_waitcnt vmcnt(" #n ")" ::: "memory")
#define PG8_WAIT_L(n) asm volatile("s_waitcnt lgkmcnt(" #n ")" ::: "memory")
#define PG8_BAR __builtin_amdgcn_s_barrier()
#define PG8_SCHED __builtin_amdgcn_sched_barrier(0)
    Unit cur, nxt; int ui = 0;
    if (!S.next(0, cur)) return;
    unsigned cv[2][2], nv[2][2];
    if constexpr (GATHER) a_offsets<KB>(g, cur, sR, sC, cv);
    const char* cA = Ab + (size_t)cur.pm * tstep; const char* nA = cA;
    f32x4 acc[2][2][4][2];
#pragma unroll
    for (int a = 0; a < 2; ++a)
#pragma unroll
        for (int b = 0; b < 2; ++b)
#pragma unroll
            for (int m = 0; m < 4; ++m)
#pragma unroll
                for (int n = 0; n < 2; ++n) acc[a][b][m][n] = (f32x4){0.f, 0.f, 0.f, 0.f};
    bf16x8 At[4][2], B0[2][2], B1[2][2]; v8i At8[4], B08[2], B18[2];
    int unit_scale = 0x7f7f7f7f; asm volatile("" : "+v"(unit_scale));
    const char* cB = (const char*)g.Bt + (size_t)cur.e * g.bstride + (size_t)cur.pn * tstep;
    PG8_STAGE_B(PG8_SB(0, 0), cB); PG8_STAGE_B(PG8_SB(0, 1), cB + hstep); PG8_STAGE_A(PG8_SA(0, 0), 0, cv[0], cA); PG8_STAGE_A(PG8_SA(0, 1), 0, cv[1], cA + hstep);
    if (wr == 1) PG8_BAR;
    PG8_WAIT_V(2); PG8_BAR;
    PG8_STAGE_B(PG8_SB(1, 0), cB + kstep); PG8_STAGE_A(PG8_SA(1, 0), kstep, cv[0], cA); PG8_STAGE_B(PG8_SB(1, 1), cB + hstep + kstep);
    PG8_WAIT_V(6); PG8_BAR;
    for (;;) {
        const bool has_next = S.next(ui + 1, nxt);
        const char* nB = cB;
        nA = cA;
        if (has_next) { if constexpr (GATHER) a_offsets<KB>(g, nxt, sR, sC, nv); nA = Ab + (size_t)nxt.pm * tstep; nB = (const char*)g.Bt + (size_t)nxt.e * g.bstride + (size_t)nxt.pn * tstep; }
        else if constexpr (GATHER) {
#pragma unroll
            for (int h = 0; h < 2; ++h)
#pragma unroll
                for (int i = 0; i < 2; ++i) nv[h][i] = cv[h][i];
        }
        const int ntr = (PROBE_SHORTK && !cur.real) ? 2 : nt;
        const bool m00 = (cur.amask & 1) && (cur.bmask & 1), m01 = (cur.amask & 1) && (cur.bmask & 2), m10 = (cur.amask & 2) && (cur.bmask & 1), m11 = (cur.amask & 2) && (cur.bmask & 2);
#pragma nounroll
        for (int t = 0; t < ntr; t += 2) {
            const bool last = (t == ntr - 2);
            const size_t k1 = (size_t)(t + 1) * kstep, k2 = last ? 0 : (size_t)(t + 2) * kstep, k3 = k2 + kstep;
            const char* b2 = last ? nB : cB + (size_t)(t + 2) * kstep; const char* b3 = b2 + kstep;
            unsigned w0[2], w1[2];
            if constexpr (GATHER) {
#pragma unroll
                for (int i = 0; i < 2; ++i) { w0[i] = last ? nv[0][i] : cv[0][i]; w1[i] = last ? nv[1][i] : cv[1][i]; }
            }
            const char* a2 = last ? nA : cA;
            PG8_LDB(B0, 0, 0); PG8_LDB(B1, 0, 1); PG8_SCHED; PG8_LDA(At, 0, 0); PG8_STAGE_A(PG8_SA(1, 1), k1, cv[1], cA + hstep);
            PG8_WAIT_V(8); PG8_WAIT_L(0); PG8_BAR; if (m00) PG8_MMA(0, 0, At, B0); if (m01) PG8_MMA(0, 1, At, B1); PG8_BAR; PG8_SCHED;
            PG8_LDA(At, 0, 1); PG8_STAGE_B(PG8_SB(0, 0), b2); PG8_STAGE_B(PG8_SB(0, 1), b2 + hstep); PG8_STAGE_A(PG8_SA(0, 0), k2, w0, a2);
            PG8_WAIT_V(8); PG8_WAIT_L(0); PG8_BAR; if (m10) PG8_MMA(1, 0, At, B0); if (m11) PG8_MMA(1, 1, At, B1); PG8_BAR; PG8_SCHED;
            PG8_LDB(B0, 1, 0); PG8_LDB(B1, 1, 1); PG8_SCHED; PG8_LDA(At, 1, 0); PG8_STAGE_A(PG8_SA(0, 1), k2, w1, a2 + hstep);
            PG8_WAIT_V(8); PG8_WAIT_L(0); PG8_BAR; if (m00) PG8_MMA(0, 0, At, B0); if (m01) PG8_MMA(0, 1, At, B1); PG8_BAR; PG8_SCHED;
            PG8_LDA(At, 1, 1); PG8_STAGE_B(PG8_SB(1, 0), b3); PG8_STAGE_B(PG8_SB(1, 1), b3 + hstep); PG8_STAGE_A(PG8_SA(1, 0), k3, w0, a2);
            PG8_WAIT_V(8); PG8_WAIT_L(0); PG8_BAR; if (m10) PG8_MMA(1, 0, At, B0); if (m11) PG8_MMA(1, 1, At, B1); PG8_BAR; PG8_SCHED;
        }
        if constexpr (ALIGN_EPI) { if (wr == 0) PG8_BAR; }
        if constexpr (FP8) asm volatile("s_nop 15\n\ts_nop 15" ::: "memory");
        if (!PROBE_NOEPI || cur.real) E(acc, cur, wr, wc, fr, fq);
        if (!has_next) break;
#pragma unroll
        for (int a = 0; a < 2; ++a)
#pragma unroll
            for (int b = 0; b < 2; ++b)
#pragma unroll
                for (int m = 0; m < 4; ++m)
#pragma unroll
                    for (int n = 0; n < 2; ++n) acc[a][b][m][n] = (f32x4){0.f, 0.f, 0.f, 0.f};
        cur = nxt; cB = nB; cA = nA; ++ui;
        if constexpr (GATHER) {
#pragma unroll
            for (int h = 0; h < 2; ++h)
#pragma unroll
                for (int i = 0; i < 2; ++i) cv[h][i] = nv[h][i];
        }
        if constexpr (ALIGN_EPI) { if (wr == 1) PG8_BAR; }
    }
    PG8_WAIT_V(0);
    if constexpr (!ALIGN_EPI) { if (wr == 0) PG8_BAR; }
    PG8_BAR;
#undef PG8_SA
#undef PG8_SB
#undef PG8_STAGE_A
#undef PG8_STAGE_B
#undef PG8_LDA
#undef PG8_LD8
#undef PG8_LDB
#undef PG8_MMA
#undef PG8_WAIT_V
#undef PG8_WAIT_L
#undef PG8_BAR
#undef PG8_SCHED
}
}

struct TBlk { const float* src; int ldw; bf16_t* dst; unsigned char* dst8; };
__device__ __forceinline__ void tb_load(const TBlk& t, int lane, f32x4 (&v)[16]) {
    const float* p = t.src + (size_t)(lane >> 4) * t.ldw + (lane & 15) * 4;
#pragma unroll
    for (int i = 0; i < 16; ++i) v[i] = *(const f32x4*)(p + (size_t)(4 * i) * t.ldw);
}
__device__ __forceinline__ void tb_store(const TBlk& t, int lane, const f32x4 (&v)[16], LAS float* scr) {
#pragma unroll
    for (int i = 0; i < 16; ++i) { LAS float* d = scr + ((lane >> 4) + 4 * i) * 65 + (lane & 15) * 4; d[0] = v[i].x; d[1] = v[i].y; d[2] = v[i].z; d[3] = v[i].w; }
    asm volatile("s_waitcnt lgkmcnt(0)" ::: "memory"); __builtin_amdgcn_wave_barrier();
    const int c8 = lane & 7;
#pragma unroll
    for (int jj = 0; jj < 8; ++jj) {
        const int n = (lane >> 3) + 8 * jj; const LAS float* p = scr + (8 * c8) * 65 + n;
        if (t.dst8) { u32x2 o; o.x = pk4_fp8(p[0] * F8_SW, p[65] * F8_SW, p[2 * 65] * F8_SW, p[3 * 65] * F8_SW); o.y = pk4_fp8(p[4 * 65] * F8_SW, p[5 * 65] * F8_SW, p[6 * 65] * F8_SW, p[7 * 65] * F8_SW);
            *(u32x2*)(t.dst8 + (size_t)n * 1024 + 8 * c8) = o; }
        else { u32x4 o; o.x = pk2(p[0], p[65]); o.y = pk2(p[2 * 65], p[3 * 65]); o.z = pk2(p[4 * 65], p[5 * 65]); o.w = pk2(p[6 * 65], p[7 * 65]);
            *(u32x4*)(t.dst + (size_t)n * 1024 + 8 * c8) = o; }
    }
    asm volatile("s_waitcnt lgkmcnt(0)" ::: "memory"); __builtin_amdgcn_wave_barrier();
}

__device__ __forceinline__ void phase_prep(const Ctx& c) {
    LAS float* red = (LAS float*)c.lds;
    LAS float* sil = red + 1024;
    const float* cv = c.a->in[1]; const float* ccv = c.a->in[3]; const float* ada_w = c.a->in[4]; const float* ada_b = c.a->in[5];
    for (int i = c.tid; i < 2048; i += 512) { const float x = i < 1024 ? cv[i] : ccv[i - 1024]; sil[i] = x * __builtin_amdgcn_rcpf(1.f + __builtin_amdgcn_exp2f(-LOG2E * x)); }
    __syncthreads();
    for (int item = c.wg; item < 193; item += c.nwg) {
        if (item < 192) {
            const int layer = item / 96, cb = item % 96, col = cb * 64 + c.lane;
            const float* W = ada_w + (size_t)layer * D * 6144 + col;
            float a0 = 0.f, a1 = 0.f;
            const int k0 = c.wave * 128;
#pragma unroll 32
            for (int k = 0; k < 128; ++k) { const float w = W[(size_t)(k0 + k) * 6144]; a0 += sil[k0 + k] * w; a1 += sil[1024 + k0 + k] * w; }
            red[(0 * 8 + c.wave) * 64 + c.lane] = a0; red[(1 * 8 + c.wave) * 64 + c.lane] = a1;
            __syncthreads();
            if (c.tid < 128) {
                const int which = c.tid >> 6, l = c.tid & 63; float s = 0.f;
#pragma unroll
                for (int w = 0; w < 8; ++w) s += red[(which * 8 + w) * 64 + l];
                c.modp(layer, which)[cb * 64 + l] = s + ada_b[layer * 6144 + cb * 64 + l];
            }
            __syncthreads();
        } else {
            float* modbase = (float*)(c.ws + WS_MOD);
            for (int i = c.tid; i < 4096; i += 512) {
                const int pos = i >> 4, j = i & 15;
                const double ang = (double)pos * pow(10000.0, -(double)j / 16.0);
                modbase[MOD_ROPE + 2 * i] = (float)cos(ang); modbase[MOD_ROPE + 2 * i + 1] = (float)sin(ang);
            }
            const float* lbp = c.a->in[12];
            for (int i = c.tid; i < 2048; i += 512) { const float p0 = lbp[i], p1 = lbp[2048 + i]; modbase[MOD_LB + i] = 1.f / (1.f + __expf(p0 - p1)); }
        }
    }
}

__device__ __forceinline__ void row_load(const float* p, int lane, f32x4 (&v)[4]) {
#pragma unroll
    for (int j = 0; j < 4; ++j) v[j] = *(const f32x4*)(p + lane * 4 + 256 * j);
}
__device__ __forceinline__ void row_load_bf(const bf16_t* p, int lane, f32x4 (&v)[4]) {
#pragma unroll
    for (int j = 0; j < 4; ++j) { const u32x2 w = *(const u32x2*)(p + lane * 4 + 256 * j); v[j] = (f32x4){bflo(w.x), bfhi(w.x), bflo(w.y), bfhi(w.y)}; }
}
__device__ __forceinline__ float row_ss(const f32x4 (&v)[4]) {
    float s = 0.f;
#pragma unroll
    for (int j = 0; j < 4; ++j) s += v[j].x * v[j].x + v[j].y * v[j].y + v[j].z * v[j].z + v[j].w * v[j].w;
    return wave_sum(s);
}
__device__ __forceinline__ void row_modnorm_store(const f32x4 (&x)[4], float rstd, const float* g, const float* sh, const float* sc, bf16_t* out, int lane, f32x4 (*hout)[4] = nullptr) {
#pragma unroll
    for (int j = 0; j < 4; ++j) {
        const int c0 = lane * 4 + 256 * j;
        const f32x4 gv = *(const f32x4*)(g + c0), shv = *(const f32x4*)(sh + c0), scv = *(const f32x4*)(sc + c0);
        f32x4 h;
        h.x = x[j].x * rstd * gv.x * (1.f + scv.x) + shv.x; h.y = x[j].y * rstd * gv.y * (1.f + scv.y) + shv.y;
        h.z = x[j].z * rstd * gv.z * (1.f + scv.z) + shv.z; h.w = x[j].w * rstd * gv.w * (1.f + scv.w) + shv.w;
        if (hout) (*hout)[j] = h;
        u32x2 o; o.x = pk2(h.x, h.y); o.y = pk2(h.z, h.w);
        *(u32x2*)(out + c0) = o;
    }
}

__device__ __forceinline__ void phase_norm0(const Ctx& c) {
    bf16_t* H = (bf16_t*)(c.ws + WS_H); const float* ng = c.a->in[6];
    int r = c.wg * 8 + c.wave;
    f32x4 xn[4];
    if (r < R) row_load(c.xin0(r), c.lane, xn);
    for (; r < R; r += c.nwg * 8) {
        f32x4 x[4];
#pragma unroll
        for (int j = 0; j < 4; ++j) x[j] = xn[j];
        if (r + c.nwg * 8 < R) row_load(c.xin0(r + c.nwg * 8), c.lane, xn);
        const float rstd = rsqrtf(row_ss(x) * (1.f / D) + EPS);
        const float* m = c.modp(0, r < C ? 1 : 0);
        row_modnorm_store(x, rstd, ng, m + 0, m + 1024, H + (size_t)r * D, c.lane);
    }
}

namespace at {
__device__ __forceinline__ float max3f(float a, float b, float c) { return __builtin_fmaxf(__builtin_fmaxf(a, b), c); }
constexpr int KP = 144, TILEB = 64 * KP;
__device__ __forceinline__ bf16x8 tr_frag2(const LAS unsigned char* tile, int row0, int col0, int lane) {
    const int q = (lane & 15) >> 2, p = lane & 3;
    const LAS unsigned char* a = tile + (row0 + q) * KP + (col0 + 4 * p) * 2;
    const v4i16_t lo = __builtin_amdgcn_ds_read_tr16_b64_v4i16((LAS v4i16_t*)a);
    const v4i16_t hi = __builtin_amdgcn_ds_read_tr16_b64_v4i16((LAS v4i16_t*)(a + 16 * KP));
    return (bf16x8){lo[0], lo[1], lo[2], lo[3], hi[0], hi[1], hi[2], hi[3]};
}
}
__device__ __forceinline__ void phase_attn(const Ctx& c) {
    using namespace at;
    const bf16_t* Q = (const bf16_t*)(c.ws + WS_Q); const bf16_t* K = (const bf16_t*)(c.ws + WS_K); const bf16_t* V = (const bf16_t*)(c.ws + WS_V);
    bf16_t* O = (bf16_t*)(c.ws + WS_O); const float* sink = c.a->in[9];
    LAS unsigned char* lds = c.lds;
    const int tid = c.tid, lane = c.lane, w = __builtin_amdgcn_readfirstlane(tid >> 6), fr = lane & 15, g = lane >> 4;
    const int lrow = tid >> 3, lch = tid & 7;
    const int nitn = c.nwg == 256 ? 2 : (264 - c.wg + c.nwg - 1) / c.nwg;
    for (int itn = 0; itn < nitn; ++itn) {
        int item = c.wg + itn * c.nwg;
        if (c.nwg == 256 && itn == 1) { const int n_ = c.wg >> 1; item = -1;
            if (n_ == 0) item = 256 + (c.wg & 1); else if (n_ == 127) item = 258 + (c.wg & 1); else if (n_ == 30 || n_ == 31) item = 260 + (c.wg - 60); }
        if (item < 0 || item >= 264) continue;
        const bool isctx = item >= 256;
        const int ci = item - 256;
        const int n = isctx ? 0 : (item >> 1), kh = isctx ? ((ci >> 1) & 1) : (item & 1), cb = isctx ? (ci >> 2) : 0;
        const int p_lo = isctx ? (ci & 1) : 0, p_hi = isctx ? (ci & 1) + 1 : 2;
        const int hq = kh * 8 + w;
        const float sink2 = sink[hq] * LOG2E;
        for (int pass = p_lo; pass < p_hi; ++pass) {
            const int t0 = 128 * n + 64 * pass, qrow0 = isctx ? cb * 128 + 64 * pass : C + t0;
            const int jlo = isctx ? 0 : (t0 >= 128 ? 0 : (128 - t0) / 64), jhi = isctx ? 0 : ((L - t0 + 128) / 64 < 5 ? (L - t0 + 128) / 64 : 5);
            const int ntile = 4 + (jhi - jlo);
            LAS unsigned char* qlds = lds + 4 * TILEB + w * TILEB;
#pragma unroll
            for (int qb = 0; qb < 4; ++qb)
#pragma unroll
                for (int ks = 0; ks < 2; ++ks) *(LAS bf16x8*)(qlds + (16 * qb + fr) * KP + (32 * ks + 8 * g) * 2) = *(const bf16x8*)(Q + (size_t)(qrow0 + 16 * qb + fr) * D + hq * 64 + 32 * ks + 8 * g);
            float mrow[4], lsum[4]; f32x4 OT[4][4];
#pragma unroll
            for (int qb = 0; qb < 4; ++qb) { mrow[qb] = sink2; lsum[qb] = 1.f;
#pragma unroll
                for (int nt = 0; nt < 4; ++nt) OT[qb][nt] = (f32x4){0.f, 0.f, 0.f, 0.f}; }
            u32x4 kreg, vreg;
#define AT_KROW(ti) ((ti) < 4 ? 64 * (ti) : C + t0 - 128 + 64 * (jlo + (ti) - 4))
#define AT_LOAD(ti) do { const size_t ro_ = (size_t)(AT_KROW(ti) + lrow) * 128 + kh * 64 + lch * 8; kreg = *(const u32x4*)(K + ro_); vreg = *(const u32x4*)(V + ro_); } while (0)
#define AT_WRITE(buf) do { *(LAS u32x4*)(lds + (buf) * 2 * TILEB + lrow * KP + lch * 16) = kreg; *(LAS u32x4*)(lds + (buf) * 2 * TILEB + TILEB + lrow * KP + lch * 16) = vreg; } while (0)
            AT_LOAD(0); AT_WRITE(0);
            __syncthreads();
            for (int ti = 0; ti < ntile; ++ti) {
                if (ti + 1 < ntile) AT_LOAD(ti + 1);
                const LAS unsigned char* kb = lds + (ti & 1) * 2 * TILEB; const LAS unsigned char* vb = kb + TILEB;
                const int jj = jlo + ti - 4; const bool masked = (ti >= 4) && (jj == 0 || jj == 4);
                const int k0 = t0 - 128 + 64 * jj;
                bf16x8 Kf[4][2];
#pragma unroll
                for (int mt = 0; mt < 4; ++mt)
#pragma unroll
                    for (int ks = 0; ks < 2; ++ks) Kf[mt][ks] = *(const LAS bf16x8*)(kb + (16 * mt + fr) * KP + (32 * ks + 8 * g) * 2);
                bf16x8 Vf[4][2];
#pragma unroll
                for (int mt = 0; mt < 4; ++mt)
#pragma unroll
                    for (int ks = 0; ks < 2; ++ks)
                        Vf[mt][ks] = tr_frag2(vb, 32 * ks + 4 * g, 16 * mt, lane);
#pragma unroll
                for (int qb = 0; qb < 4; ++qb) {
                    bf16x8 Qq[2];
#pragma unroll
                    for (int ks = 0; ks < 2; ++ks) Qq[ks] = *(const LAS bf16x8*)(qlds + (16 * qb + fr) * KP + (32 * ks + 8 * g) * 2);
                    f32x4 sa[4];
#pragma unroll
                    for (int mt = 0; mt < 4; ++mt) { sa[mt] = (f32x4){0.f, 0.f, 0.f, 0.f};
#pragma unroll
                        for (int ks = 0; ks < 2; ++ks) sa[mt] = __builtin_amdgcn_mfma_f32_16x16x32_bf16(Kf[mt][ks], Qq[ks], sa[mt], 0, 0, 0); }
                    if (masked) {
                        const int tq = t0 + 16 * qb + fr;
#pragma unroll
                        for (int mt = 0; mt < 4; ++mt)
#pragma unroll
                            for (int e = 0; e < 4; ++e) { const int dt = tq - (k0 + 16 * mt + 4 * g + e); if (dt > 128 || dt < -128) sa[mt][e] = -INFINITY; }
                    }
                    float mx = max3f(sa[0][0], sa[0][1], sa[0][2]), my = max3f(sa[0][3], sa[1][0], sa[1][1]);
                    mx = max3f(mx, sa[1][2], sa[1][3]); my = max3f(my, sa[2][0], sa[2][1]); mx = max3f(mx, sa[2][2], sa[2][3]); my = max3f(my, sa[3][0], sa[3][1]); mx = max3f(mx, sa[3][2], sa[3][3]);
                    mx = max3f(mx, my, mrow[qb]);
                    mx = max3f(mx, __shfl_xor(mx, 16), mx); mx = max3f(mx, __shfl_xor(mx, 32), mx);
                    const float mn = mx; const bool grew = __any(mn > mrow[qb]);
                    const float alpha = grew ? __builtin_amdgcn_exp2f(mrow[qb] - mn) : 1.f;
                    mrow[qb] = mn;
                    float rs = 0.f;
#pragma unroll
                    for (int mt = 0; mt < 4; ++mt)
#pragma unroll
                        for (int e = 0; e < 4; ++e) { const float pv = __builtin_amdgcn_exp2f(sa[mt][e] - mn); sa[mt][e] = pv; rs += pv; }
                    rs += __shfl_xor(rs, 16); rs += __shfl_xor(rs, 32);
                    lsum[qb] = grew ? lsum[qb] * alpha + rs : lsum[qb] + rs;
                    bf16x8 Pb[2];
#pragma unroll
                    for (int ks = 0; ks < 2; ++ks) { const f32x4 a0 = sa[2 * ks], a1 = sa[2 * ks + 1];
                        const u32x4 pk = (u32x4){pk2(a0[0], a0[1]), pk2(a0[2], a0[3]), pk2(a1[0], a1[1]), pk2(a1[2], a1[3])}; Pb[ks] = __builtin_bit_cast(bf16x8, pk); }
#pragma unroll
                    for (int nt = 0; nt < 4; ++nt) { if (grew) OT[qb][nt] = OT[qb][nt] * alpha;
#pragma unroll
                        for (int ks = 0; ks < 2; ++ks) OT[qb][nt] = __builtin_amdgcn_mfma_f32_16x16x32_bf16(Vf[nt][ks], Pb[ks], OT[qb][nt], 0, 0, 0); }
                }
                if (ti + 1 < ntile) AT_WRITE((ti + 1) & 1);
                __syncthreads();
            }
#undef AT_KROW
#undef AT_LOAD
#undef AT_WRITE
#pragma unroll
            for (int qb = 0; qb < 4; ++qb) {
                const float il = 1.f / lsum[qb];
                bf16_t* op = O + (size_t)(qrow0 + 16 * qb + fr) * D + hq * 64 + 4 * g;
#pragma unroll
                for (int nt = 0; nt < 4; ++nt) { const f32x4 v = OT[qb][nt] * il; u32x2 o; o.x = pk2(v[0], v[1]); o.y = pk2(v[2], v[3]); *(u32x2*)(op + 16 * nt) = o; }
            }
        }
    }
}

template <int GS>
__device__ __forceinline__ void phase_postmix(const Ctx& c, int layer, bool route) {
    const bf16_t* Y = (const bf16_t*)(c.ws + WS_RAW1); unsigned char* H8 = c.ws + WS_H8;
    float* Xout = (float*)(c.ws + (layer == 0 ? WS_X : WS_X1)); const float* Xprev = (const float*)(c.ws + WS_X);
    const float* ng = c.a->in[6] + layer * 4 * D; const float* Wr = c.a->in[15] + (size_t)layer * D * NE; const float* br = c.a->in[16] + layer * NE;
    unsigned* cnt = (unsigned*)(c.ws + WS_CTL) + CW_CNT + layer * NE;
    int* tk_e = (int*)(c.ws + WS_TK); float* tk_g = (float*)(c.ws + WS_TK) + R * 4; int* tk_slot = (int*)(c.ws + WS_TK) + 2 * R * 4;
    int* list = (int*)(c.ws + WS_LIST);
    LAS float* WL = (LAS float*)c.lds;
    LAS float* biasp = (LAS float*)(c.lds + 131072);
    LAS unsigned* lcnt = (LAS unsigned*)(c.lds + 145920); LAS unsigned* lbase = lcnt + 32; LAS float* rsx = (LAS float*)(lcnt + 64);
    LAS float* pvA = (LAS float*)(c.lds + 131072 + 2560); LAS float* pvB = pvA + 1024; LAS float* pvS = pvB + 1024;
    const int lane = c.lane, w = __builtin_amdgcn_readfirstlane(c.tid >> 6), fr = lane & 15, g = lane >> 4;
    constexpr int RP = GS / 8, NW2 = GS / 16;
    const int g_lo = layer == 0 ? 0 : C / GS;
    for (int grp = g_lo + c.wg; grp < R / GS; grp += c.nwg) {
        const int which = grp * GS < C ? 1 : 0;
        const float* m = c.modp(layer, which);
        __syncthreads();
        if (c.tid < NE) lcnt[c.tid] = 0u;
#pragma unroll 4
        for (int j = 0; j < 16; ++j) {
            const int i4 = c.tid + 512 * j, k = i4 >> 3, e0 = (i4 & 7) * 4;
            const f32x4 wv = *(const f32x4*)(Wr + (size_t)k * NE + e0); const float sc = ng[2 * D + k] * (1.f + m[4096 + k]);
            LAS float* dst = WL + ((((k >> 4) * 4 + (k & 3)) * 4 + ((k >> 2) & 3)) * 16) * 2;
#pragma unroll
            for (int q = 0; q < 4; ++q) { const int e = e0 + q; dst[(e & 15) * 2 + (e >> 4)] = wv[q] * sc; }
        }
        for (int k = c.tid; k < D; k += 512) { pvA[k] = m[2048 + k] * ng[D + k]; pvB[k] = ng[2 * D + k] * (1.f + m[4096 + k]); pvS[k] = m[3072 + k]; }
        { const int e = c.tid & 31, part = c.tid >> 5; float sacc = 0.f;
#pragma unroll 16
          for (int k = part * 64; k < part * 64 + 64; ++k) sacc += m[3072 + k] * Wr[k * NE + e];
          biasp[32 + part * 32 + e] = sacc; }
        __syncthreads();
        if (c.tid < 32) { float sacc = br[c.tid];
#pragma unroll
            for (int p = 0; p < 16; ++p) sacc += biasp[32 + p * 32 + c.tid]; biasp[c.tid] = sacc; }
        __syncthreads();
        const int row1 = grp * GS + w * RP;
        f32x4 yn[4], xn[4];
        row_load_bf(Y + (size_t)(layer == 0 ? row1 : row1 - C) * D, lane, yn); row_load(layer == 0 ? c.xin0(row1) : Xprev + (size_t)row1 * D, lane, xn);
        for (int i = 0; i < RP; ++i) {
            const int r = row1 + i;
            f32x4 y[4], x[4];
#pragma unroll
            for (int j = 0; j < 4; ++j) { y[j] = yn[j]; x[j] = xn[j]; }
            if (i + 1 < RP) { row_load_bf(Y + (size_t)(layer == 0 ? r + 1 : r + 1 - C) * D, lane, yn); row_load(layer == 0 ? c.xin0(r + 1) : Xprev + (size_t)(r + 1) * D, lane, xn); }
            const float rstd_y = rsqrtf(row_ss(y) * (1.f / D) + EPS);
#pragma unroll
            for (int j = 0; j < 4; ++j) {
                const int c0 = lane * 4 + 256 * j;
                x[j] += *(const LAS f32x4*)(pvA + c0) * (y[j] * rstd_y);
                *(f32x4*)(Xout + (size_t)r * D + c0) = x[j];
            }
            const float rstd_x = rsqrtf(row_ss(x) * (1.f / D) + EPS);
#pragma unroll
            for (int j = 0; j < 4; ++j) {
                const int c0 = lane * 4 + 256 * j;
                const f32x4 hv = x[j] * rstd_x * *(const LAS f32x4*)(pvB + c0) + *(const LAS f32x4*)(pvS + c0);
                *(unsigned*)(H8 + (size_t)r * D + c0) = pk4_fp8(hv[0] * F8_SH, hv[1] * F8_SH, hv[2] * F8_SH, hv[3] * F8_SH);
            }
            if (lane == 0) rsx[w * RP + i] = rstd_x;
        }
        asm volatile("s_waitcnt vmcnt(0)" ::: "memory");
        __syncthreads();
        const int row0 = grp * GS + w * 16; const bool w2 = w < NW2;
        f32x4 la[2]; la[0] = (f32x4){0.f, 0.f, 0.f, 0.f}; la[1] = la[0];
        if (w2) {
            const float* ap = Xout + (size_t)(row0 + fr) * D + 4 * g;
            const LAS float* bp = WL + (g * 16 + fr) * 2;
#pragma unroll 4
            for (int k4 = 0; k4 < 64; ++k4) {
                const f32x4 a4 = *(const f32x4*)(ap + 16 * k4);
#pragma unroll
                for (int q = 0; q < 4; ++q) {
                    const f32x2 b2 = *(const LAS f32x2*)(bp + (size_t)(4 * k4 + q) * 128);
                    la[0] = __builtin_amdgcn_mfma_f32_16x16x4f32(a4[q], b2[0], la[0], 0, 0, 0);
                    la[1] = __builtin_amdgcn_mfma_f32_16x16x4f32(a4[q], b2[1], la[1], 0, 0, 0);
                }
            }
        }
        float tv[4][4]; int te[4][4];
#pragma unroll
        for (int e = 0; e < 4; ++e) {
            const float rs = rsx[(w2 ? w * 16 : 0) + 4 * g + e];
            float v0 = la[0][e] * rs + biasp[fr], v1 = la[1][e] * rs + biasp[16 + fr];
#pragma unroll
            for (int k = 0; k < 4; ++k) {
                float bv; int bi;
                if (v0 >= v1) { bv = v0; bi = fr; } else { bv = v1; bi = 16 + fr; }
#pragma unroll
                for (int o = 8; o > 0; o >>= 1) {
                    const float ov = __shfl_xor(bv, o); const int oi = __shfl_xor(bi, o);
                    if (ov > bv || (ov == bv && oi < bi)) { bv = ov; bi = oi; }
                }
                tv[e][k] = bv; te[e][k] = bi;
                if (bi == fr) v0 = -INFINITY;
                if (bi == 16 + fr) v1 = -INFINITY;
            }
        }
        float v[4]; int ex[4]; unsigned sl[4];
#pragma unroll
        for (int k = 0; k < 4; ++k) { v[k] = tv[0][k]; ex[k] = te[0][k];
#pragma unroll
            for (int e = 1; e < 4; ++e) if (fr == e) { v[k] = tv[e][k]; ex[k] = te[e][k]; } }
        if (fr < 4 && route && w2) {
#pragma unroll
            for (int k = 0; k < 4; ++k) sl[k] = __hip_atomic_fetch_add(lcnt + ex[k], 1u, __ATOMIC_RELAXED, __HIP_MEMORY_SCOPE_WORKGROUP);
        }
        __syncthreads();
        if (c.tid < NE && route) { const unsigned n = lcnt[c.tid]; lbase[c.tid] = n ? atomicAdd(&cnt[c.tid], n) : 0u; }
        __syncthreads();
        if (fr < 4 && route && w2) {
            const int r = row0 + 4 * g + fr;
            const float e1 = __expf(v[1] - v[0]), e2 = __expf(v[2] - v[0]), e3 = __expf(v[3] - v[0]);
            const float inv = 1.f / (1.f + e1 + e2 + e3);
            const float gk[4] = {inv, e1 * inv, e2 * inv, e3 * inv};
#pragma unroll
            for (int k = 0; k < 4; ++k) {
                const unsigned slot = lbase[ex[k]] + sl[k];
                list[(size_t)ex[k] * R + slot] = r;
                tk_e[r * 4 + k] = ex[k]; tk_g[r * 4 + k] = gk[k]; tk_slot[r * 4 + k] = (int)slot;
            }
        }
    }
}

__device__ __forceinline__ void moe_offsets(const Ctx& c, int layer, LAS int* so) {
    const unsigned* cnt = (const unsigned*)(c.ws + WS_CTL) + CW_CNT + layer * NE;
    __syncthreads();
    if (c.tid < 64) {
        const int n = c.tid < NE ? (int)cnt[c.tid] : 0; int pad = (n + PADM - 1) / PADM * PADM, inc = pad;
#pragma unroll
        for (int o = 1; o < 32; o <<= 1) { const int t = __shfl_up(inc, o); if (c.lane >= o) inc += t; }
        if (c.tid < NE) { so[c.tid] = inc - pad; so[64 + c.tid] = n; }
        if (c.tid == NE - 1) so[32] = inc;
    }
    __syncthreads();
}

__device__ __forceinline__ void moe_tables(const Ctx& c, int layer, LAS int* tb) {
    const unsigned* cnt = (const unsigned*)(c.ws + WS_CTL) + CW_CNT + layer * NE;
    __syncthreads();
    if (c.tid < 64) {
        const int n = c.tid < NE ? (int)cnt[c.tid] : 0; int tiles = (n + PADM - 1) / PADM, inc = tiles;
#pragma unroll
        for (int o = 1; o < 32; o <<= 1) { const int t = __shfl_up(inc, o); if (c.lane >= o) inc += t; }
        if (c.tid < NE) { tb[c.tid] = inc - tiles; tb[64 + c.tid] = n; }
        if (c.tid == NE - 1) tb[32] = inc;
    }
    __syncthreads();
}
__device__ __forceinline__ int vcu_of(const Ctx& c) { return (c.nwg % 8 == 0) ? (c.wg % 8) * (c.nwg / 8) + c.wg / 8 : c.wg; }
__device__ __forceinline__ void phase_moe_gu(const Ctx& c, int layer) {
    LAS int* tb = (LAS int*)(c.lds + 131072 + 1024);
    moe_tables(c, layer, tb);
    pg8::Gemm g{c.ws + WS_H8, c.ws + WS_WGU + (size_t)layer * NE * 2048 * 1024, (size_t)2048 * 1024, (const int*)(c.ws + WS_LIST)};
    pg8::MoeOrder S{tb, tb + 64, 8, c.nwg, vcu_of(c), false};
    pg8::EpiSwiglu E{c.ws + WS_HDN, c.a->in[18] + (size_t)layer * NE * 2048};
    pg8::gemm_phase<pg8::EpiSwiglu, pg8::MoeOrder, true, true, true>(c.lds, g, S, E, c.tid);
}
__device__ __forceinline__ void phase_moe_dn(const Ctx& c, int layer) {
    LAS int* tb = (LAS int*)(c.lds + 131072 + 1024);
    moe_tables(c, layer, tb);
    pg8::Gemm g{c.ws + WS_HDN, c.ws + WS_WDN + (size_t)layer * NE * 1024 * 1024, (size_t)1024 * 1024, nullptr};
    pg8::MoeOrder S{tb, tb + 64, 4, c.nwg, vcu_of(c), true};
    pg8::EpiBf16Bias E{(bf16_t*)(c.ws + WS_OUTB), c.a->in[20] + (size_t)layer * NE * 1024, 1024, 1.f / (F8_SHD * F8_SW)};
    pg8::gemm_phase<pg8::EpiBf16Bias, pg8::MoeOrder, true, false, true>(c.lds, g, S, E, c.tid);
}
__device__ __forceinline__ void phase_gemm_f32(const Ctx& c, const bf16_t* A, int M, const bf16_t* Bt, int N, const float* bias, bf16_t* Cout) {
    pg8::Gemm g{A, Bt, 0, nullptr}; pg8::StaticOrder S; S.init(M, N, c.nwg, c.wg);
    pg8::EpiF32 E{Cout, N, bias};
    pg8::gemm_phase<pg8::EpiF32, pg8::StaticOrder, true, false, false>(c.lds, g, S, E, c.tid);
}

__device__ __forceinline__ void phase_gemm_qkv(const Ctx& c) {
    pg8::Gemm g{(const bf16_t*)(c.ws + WS_H), (const bf16_t*)(c.ws + WS_WQKV), 0, nullptr}; pg8::StaticOrder S; S.init(R, QKVD, c.nwg, c.wg);
    pg8::EpiQKV E{(bf16_t*)(c.ws + WS_Q), (bf16_t*)(c.ws + WS_K), (bf16_t*)(c.ws + WS_V), c.a->in[8], (const float*)(c.ws + WS_MOD) + MOD_ROPE};
    pg8::gemm_phase<pg8::EpiQKV, pg8::StaticOrder, true, false, false>(c.lds, g, S, E, c.tid);
}
__device__ __forceinline__ void phase_gemm_inproj(const Ctx& c) {
    pg8::Gemm g{c.ws + WS_H8, c.ws + WS_WIN, 0, nullptr}; pg8::StaticOrder S; S.init(R, HIN, c.nwg, c.wg);
    pg8::EpiInProj E{(bf16_t*)(c.ws + WS_QH), (_Float16*)(c.ws + WS_KF), (_Float16*)(c.ws + WS_KB), (bf16_t*)(c.ws + WS_IV), (bf16_t*)(c.ws + WS_SG), (const float*)(c.ws + WS_MOD) + MOD_LB, 1.f / (F8_SH * F8_SW)};
    pg8::gemm_phase<pg8::EpiInProj, pg8::StaticOrder, true, false, true>(c.lds, g, S, E, c.tid);
}

__device__ __forceinline__ void phase_norm0(const Ctx& c);
constexpr int CONV_A = 20 * 16 + 16 * 16 + 80 * 16 + 16 * 16, CONV_B = 32 * 32 * 16 + 32 * 16 * 16, CONV_CHUNK = 64;
__device__ __forceinline__ TBlk convert_item(const Ctx& c, int it, int part) {
    constexpr int I_QKV = 20 * 16, I_O = 16 * 16, I_IN = 80 * 16, I_HO = 16 * 16, I_GU = 32 * 32 * 16;
    int r = it; TBlk t; t.dst8 = nullptr; t.dst = nullptr;
    if (part == 0) {
        if (r < I_QKV) { const int nb = r % 20, kb = r / 20; t.src = c.a->in[7] + (size_t)kb * 64 * QKVD + nb * 64; t.ldw = QKVD; t.dst = (bf16_t*)(c.ws + WS_WQKV) + (size_t)nb * 64 * 1024 + kb * 64; return t; } r -= I_QKV;
        if (r < I_O) { const int nb = r % 16, kb = r / 16; t.src = c.a->in[10] + (size_t)kb * 64 * D + nb * 64; t.ldw = D; t.dst = (bf16_t*)(c.ws + WS_WO) + (size_t)nb * 64 * 1024 + kb * 64; return t; } r -= I_O;
        if (r < I_IN) { const int nb = r % 80, kb = r / 80; t.src = c.a->in[11] + (size_t)kb * 64 * HIN + nb * 64; t.ldw = HIN; t.dst8 = c.ws + WS_WIN + (size_t)nb * 64 * 1024 + kb * 64; return t; } r -= I_IN;
        if (r < I_HO) { const int nb = r % 16, kb = r / 16; t.src = c.a->in[14] + (size_t)kb * 64 * D + nb * 64; t.ldw = D; t.dst = (bf16_t*)(c.ws + WS_WHO) + (size_t)nb * 64 * 1024 + kb * 64; return t; } r -= I_HO;
    }
    const int moff = (part - 1) * 32;
    if (r < I_GU) { const int mat = moff + r / 512, rr = r % 512, nb = rr % 32, kb = rr / 32; const int n0 = ((nb & 3) >> 1) * 1024 + (nb >> 2) * 128 + (nb & 1) * 64;
        t.src = c.a->in[17] + (size_t)mat * 1024 * 2048 + (size_t)kb * 64 * 2048 + n0; t.ldw = 2048; t.dst8 = c.ws + WS_WGU + ((size_t)mat * 2048 + nb * 64) * 1024 + kb * 64; return t; } r -= I_GU;
    { const int mat = moff + r / 256, rr = r % 256, nb = rr % 16, kb = rr / 16;
        t.src = c.a->in[19] + (size_t)mat * 1024 * 1024 + (size_t)kb * 64 * 1024 + nb * 64; t.ldw = 1024; t.dst8 = c.ws + WS_WDN + ((size_t)mat * 1024 + nb * 64) * 1024 + kb * 64; }
    return t;
}
__device__ __forceinline__ void convert_run(const Ctx& c, int part, int first, int step, int end, LAS float* scr) {
    f32x4 va[16], vb[16];
    int it = first;
    TBlk ta, tbk;
    if (it < end) { ta = convert_item(c, it, part); tb_load(ta, c.lane, va); }
    for (; it < end; it += 2 * step) {
        const bool hb = it + step < end;
        if (hb) { tbk = convert_item(c, it + step, part); tb_load(tbk, c.lane, vb); }
        tb_store(ta, c.lane, va, scr);
        const bool ha = it + 2 * step < end;
        if (ha) { ta = convert_item(c, it + 2 * step, part); tb_load(ta, c.lane, va); }
        if (hb) tb_store(tbk, c.lane, vb, scr);
    }
}
__device__ __forceinline__ void convert_steal(const Ctx& c, int part) {
    LAS float* scr = (LAS float*)c.lds + c.wave * (64 * 65);
    LAS int* chp = (LAS int*)(c.lds + 8 * 64 * 65 * 4);
    unsigned* ctr = (unsigned*)(c.ws + WS_CTL) + CW_CONV + 64 * part;
    for (;;) {
        __syncthreads();
        if (c.tid == 0) *chp = (int)atomicAdd(ctr, 1u);
        __syncthreads();
        const int ch = *chp;
        if (ch >= CONV_B / CONV_CHUNK) break;
        convert_run(c, part, ch * CONV_CHUNK + c.wave, 8, (ch + 1) * CONV_CHUNK, scr);
    }
}
__device__ __forceinline__ void phase_convert(const Ctx& c) {
    LAS float* scr = (LAS float*)c.lds + c.wave * (64 * 65);
    convert_run(c, 0, c.wg * 8 + c.wave, c.nwg * 8, CONV_A, scr);
    __syncthreads();
    phase_norm0(c);
}

__device__ __forceinline__ void phase_combine(const Ctx& c, int layer) {
    LAS int* so = (LAS int*)(c.lds + 32768);
    moe_offsets(c, layer, so);
    const bf16_t* outb = (const bf16_t*)(c.ws + WS_OUTB); float* X = (float*)(c.ws + WS_X); bf16_t* H = (bf16_t*)(c.ws + WS_H);
    const float* Xin = layer == 0 ? X : (const float*)(c.ws + WS_X1);
    const float* ngl = c.a->in[6] + layer * 4 * D;
    const int* tk_e = (const int*)(c.ws + WS_TK); const float* tk_g = (const float*)(c.ws + WS_TK) + R * 4; const int* tk_slot = (const int*)(c.ws + WS_TK) + 2 * R * 4;
    const int r_lo = layer == 0 ? 0 : C, stride = c.nwg * 8;
    int r = r_lo + c.wg * 8 + c.wave;
    int pe[4], ps[4]; float pg[4]; u32x2 wn[4][4]; f32x4 xn[4]; float gn[4];
#define CB_TK(row) do { _Pragma("unroll") for (int k = 0; k < 4; ++k) { pe[k] = tk_e[(row) * 4 + k]; ps[k] = tk_slot[(row) * 4 + k]; pg[k] = tk_g[(row) * 4 + k]; } } while (0)
#define CB_DATA(row) do { _Pragma("unroll") for (int k = 0; k < 4; ++k) { const bf16_t* src_ = outb + (size_t)(so[pe[k]] + ps[k]) * 1024; gn[k] = pg[k]; \
        _Pragma("unroll") for (int j = 0; j < 4; ++j) wn[k][j] = *(const u32x2*)(src_ + c.lane * 4 + 256 * j); } row_load(Xin + (size_t)(row) * D, c.lane, xn); } while (0)
    if (r < R) { CB_TK(r); CB_DATA(r); }
    if (r + stride < R) CB_TK(r + stride);
    for (; r < R; r += stride) {
        const float* m = c.modp(layer, r < C ? 1 : 0);
        f32x4 y[4], x[4];
#pragma unroll
        for (int j = 0; j < 4; ++j) { y[j] = (f32x4){0.f, 0.f, 0.f, 0.f}; x[j] = xn[j]; }
#pragma unroll
        for (int k = 0; k < 4; ++k)
#pragma unroll
            for (int j = 0; j < 4; ++j) { const u32x2 w = wn[k][j]; y[j] += (f32x4){bflo(w.x), bfhi(w.x), bflo(w.y), bfhi(w.y)} * gn[k]; }
        if (r + stride < R) CB_DATA(r + stride);
        if (r + 2 * stride < R) CB_TK(r + 2 * stride);
        const float rstd_y = rsqrtf(row_ss(y) * (1.f / D) + EPS);
#pragma unroll
        for (int j = 0; j < 4; ++j) {
            const int c0 = c.lane * 4 + 256 * j;
            const f32x4 g2 = *(const f32x4*)(m + 5120 + c0), n3 = *(const f32x4*)(ngl + 3 * D + c0);
            x[j].x += g2.x * (y[j].x * rstd_y * n3.x); x[j].y += g2.y * (y[j].y * rstd_y * n3.y);
            x[j].z += g2.z * (y[j].z * rstd_y * n3.z); x[j].w += g2.w * (y[j].w * rstd_y * n3.w);
            if (layer == 0) *(f32x4*)(X + (size_t)r * D + c0) = x[j];
            else *(f32x4*)(c.a->out + (size_t)(r - C) * D + c0) = x[j];
        }
        if (layer == 0) {
            const float rstd_x = rsqrtf(row_ss(x) * (1.f / D) + EPS);
            const float* m1 = c.modp(1, r < C ? 1 : 0); const float* g0 = c.a->in[6] + 4 * D;
#pragma unroll
            for (int j = 0; j < 4; ++j) {
                const int c0 = c.lane * 4 + 256 * j;
                const f32x4 gv = *(const f32x4*)(g0 + c0), shv = *(const f32x4*)(m1 + c0), scv = *(const f32x4*)(m1 + 1024 + c0);
                const f32x4 hv = x[j] * rstd_x * gv * (scv + 1.f) + shv;
                *(unsigned*)(c.ws + WS_H8 + (size_t)r * D + c0) = pk4_fp8(hv[0] * F8_SH, hv[1] * F8_SH, hv[2] * F8_SH, hv[3] * F8_SH);
            }
        }
    }
#undef CB_TK
#undef CB_DATA
}

namespace hg {
typedef _Float16 h2_t __attribute__((ext_vector_type(2)));
constexpr int TB = 272, PB = 144;
constexpr int TILE = 64 * TB;
constexpr int T_QD = 0, T_QC = TILE, T_KD = 2 * TILE, T_KE = 3 * TILE, T_KC = 4 * TILE, T_V0 = 5 * TILE, T_V1 = 6 * TILE;
constexpr int T_QL1 = 7 * TILE, T_KL1 = T_QL1 + 16 * TB, T_P = T_KL1 + 16 * TB, T_TOT = T_P + 64 * PB, T_CT = T_TOT + 4096, T_END = T_CT + 512;
static_assert(T_END <= LDS_BYTES - 64, "hgrn scan LDS map");
__device__ __forceinline__ int row_of(int dir, int p) { return p < C ? (dir ? C - 1 - p : p) : (dir ? C + (L - 1 - (p - C)) : p); }
__device__ __forceinline__ int seg_of(int ch) { return ch < 68 ? ch / 17 : 4 + (ch - 68) / 16; }
__device__ __forceinline__ bf16x8 tr_frag(const LAS unsigned char* tile, int row0, int col0, int lane) {
    const int q = (lane & 15) >> 2, p = lane & 3;
    const LAS unsigned char* a = tile + (row0 + q) * TB + (col0 + 4 * p) * 2;
    const v4i16_t lo = __builtin_amdgcn_ds_read_tr16_b64_v4i16((LAS v4i16_t*)a);
    const v4i16_t hi = __builtin_amdgcn_ds_read_tr16_b64_v4i16((LAS v4i16_t*)(a + 4 * TB));
    return (bf16x8){lo[0], lo[1], lo[2], lo[3], hi[0], hi[1], hi[2], hi[3]};
}
}

__device__ __forceinline__ void phase_hgrn_scan(const Ctx& c) {
    using namespace hg;
#define HG_BAR() asm volatile("s_waitcnt lgkmcnt(0)\n\ts_barrier" ::: "memory")
    const bf16_t* QH = (const bf16_t*)(c.ws + WS_QH); const bf16_t* IV = (const bf16_t*)(c.ws + WS_IV);
    LAS unsigned char* lds = c.lds;
    const int tid = c.tid, lane = c.lane, w = __builtin_amdgcn_readfirstlane(tid >> 6), fr = lane & 15, g = lane >> 4;
    for (int item_ = c.wg; item_ < 256 * SCAN_REP; item_ += c.nwg) {
        const int item = item_ & 255;
        const int chain = item >> 4, seg = item & 15, head = chain >> 1, dir = chain & 1, hc = head * 128;
        const int c0 = seg < 4 ? 17 * seg : 68 + 16 * (seg - 4), nch = seg < 4 ? 17 : 16;
        const _Float16* KX = (const _Float16*)(c.ws + (dir ? WS_KB : WS_KF));
        float* OL = (float*)(c.ws + (dir ? WS_OB : WS_OF)); bf16_t* QS = (bf16_t*)(c.ws + (dir ? WS_QSB : WS_QSF));
        HG_BAR();
        for (int i = tid; i < 64 * PB / 4; i += 512) ((LAS unsigned*)(lds + T_P))[i] = 0u;
        f32x4 Sacc[8];
#pragma unroll
        for (int m = 0; m < 8; ++m) Sacc[m] = (f32x4){0.f, 0.f, 0.f, 0.f};
        float dseg0 = 1.f, dseg1 = 1.f;
        unsigned kraw[8], qraw[8]; u32x4 vraw[2];
#define HG_LOAD(cidx) do { const int p0_ = 64 * (cidx); const bool lat_ = (cidx) >= 4; \
        _Pragma("unroll") for (int i = 0; i < 8; ++i) { const int r_ = row_of(dir, p0_ + 8 * w + i); \
            kraw[i] = *(const unsigned*)(KX + (size_t)r_ * D + hc + 2 * lane); \
            qraw[i] = lat_ ? *(const unsigned*)(QH + (size_t)(r_ - C) * D + hc + 2 * lane) : 0u; } \
        _Pragma("unroll") for (int i = 0; i < 2; ++i) { const int idx_ = tid + 512 * i; const int r_ = row_of(dir, p0_ + (idx_ >> 4)); \
            vraw[i] = *(const u32x4*)(IV + (size_t)r_ * D + hc + (idx_ & 15) * 8); } } while (0)
        HG_LOAD(c0);
        for (int ci = 0; ci < nch; ++ci) {
            const int cidx = c0 + ci; const bool lat = cidx >= 4;
            const int vbuf = (ci & 1) ? T_V1 : T_V0;
            float kf[8][2], qf[8][2], cp[8][2];
            {
                float p0 = 1.f, p1 = 1.f;
#pragma unroll
                for (int i = 0; i < 8; ++i) {
                    const h2_t hv = __builtin_bit_cast(h2_t, kraw[i]);
                    kf[i][0] = (float)hv[0]; kf[i][1] = (float)hv[1];
                    qf[i][0] = bflo(qraw[i]); qf[i][1] = bfhi(qraw[i]);
                    p0 *= (1.f - kf[i][0]); p1 *= (1.f - kf[i][1]); cp[i][0] = p0; cp[i][1] = p1;
                }
                *(LAS f32x2*)(lds + T_TOT + (w * 128 + 2 * lane) * 4) = (f32x2){p0, p1};
#pragma unroll
                for (int i = 0; i < 2; ++i) { const int idx = tid + 512 * i; *(LAS u32x4*)(lds + vbuf + (idx >> 4) * TB + (idx & 15) * 16) = vraw[i]; }
            }
            HG_BAR();
            {
                f32x2 T[8];
#pragma unroll
                for (int x = 0; x < 8; ++x) T[x] = *(const LAS f32x2*)(lds + T_TOT + (x * 128 + 2 * lane) * 4);
                const int I = w >> 1, hh = w & 1;
                f32x2 bd[4];
#pragma unroll
                for (int x = 0; x < 4; ++x) bd[x] = T[2 * x] * T[2 * x + 1];
                f32x2 pre = (f32x2){1.f, 1.f}, cum = (f32x2){1.f, 1.f}, suf = (f32x2){1.f, 1.f}, bdI = (f32x2){1.f, 1.f};
#pragma unroll
                for (int x = 0; x < 8; ++x) if (hh && x == w - 1) pre = T[x];
#pragma unroll
                for (int x = 0; x < 4; ++x) { if (x < I) cum = cum * bd[x]; if (x > I) suf = suf * bd[x]; if (x == I) bdI = bd[x]; }
                const f32x2 ctot = (bd[0] * bd[1]) * (bd[2] * bd[3]);
#pragma unroll
                for (int i = 0; i < 8; ++i) {
                    const int tau = 8 * w + i;
                    float QDv[2], KDv[2], KEv[2], QCv[2], KCv[2];
#pragma unroll
                    for (int x = 0; x < 2; ++x) {
                        const float eq = pre[x] * cp[i][x], rc = __builtin_amdgcn_rcpf(eq);
                        QDv[x] = qf[i][x] * eq; KDv[x] = kf[i][x] * rc; KEv[x] = KDv[x] * bdI[x]; QCv[x] = QDv[x] * cum[x]; KCv[x] = KEv[x] * suf[x];
                    }
                    const int to = tau * TB + lane * 4;
                    *(LAS unsigned*)(lds + T_QD + to) = pk2(QDv[0], QDv[1]);
                    *(LAS unsigned*)(lds + T_KD + to) = pk2(KDv[0], KDv[1]);
                    *(LAS unsigned*)(lds + T_KE + to) = pk2(KEv[0], KEv[1]);
                    *(LAS unsigned*)(lds + T_QC + to) = pk2(QCv[0], QCv[1]);
                    *(LAS unsigned*)(lds + T_KC + to) = pk2(KCv[0], KCv[1]);
                    if (I == 3) *(LAS unsigned*)(lds + T_QL1 + (tau - 48) * TB + lane * 4) = pk2(QDv[0] * bd[2][0], QDv[1] * bd[2][1]);
                    if (I == 0) *(LAS unsigned*)(lds + T_KL1 + tau * TB + lane * 4) = pk2(KEv[0] * bd[1][0], KEv[1] * bd[1][1]);
                    if (lat) { const int r = row_of(dir, 64 * cidx + tau); *(unsigned*)(QS + (size_t)(r - C) * D + hc + 2 * lane) = pk2(QCv[0] * dseg0, QCv[1] * dseg1); }
                }
                dseg0 *= ctot[0]; dseg1 *= ctot[1];
                if (w == 0) *(LAS f32x2*)(lds + T_CT + lane * 8) = ctot;
            }
            HG_BAR();
            if (ci + 1 < nch) HG_LOAD(cidx + 1);
            if (lat) {
                const int nblk = w >= 6 ? 2 : 1;
                for (int b = 0; b < nblk; ++b) {
                    int I, J, qoff, qrow, koff, krow; bool diag = false;
                    if (w < 4) { I = 2 + (w >> 1); J = w & 1; qoff = (w >> 1) ? T_QL1 : T_QD; qrow = (w >> 1) ? 0 : 32; koff = (w & 1) ? T_KE : T_KL1; krow = (w & 1) ? 16 : 0; }
                    else if (w == 4) { I = 1; J = 0; qoff = T_QD; qrow = 16; koff = T_KE; krow = 0; }
                    else if (w == 5) { I = 3; J = 2; qoff = T_QD; qrow = 48; koff = T_KE; krow = 32; }
                    else { I = 2 * (w - 6) + b; J = I; qoff = T_QD; qrow = 16 * I; koff = T_KD; krow = 16 * I; diag = true; }
                    f32x4 pa = (f32x4){0.f, 0.f, 0.f, 0.f};
#pragma unroll
                    for (int ks = 0; ks < 4; ++ks) {
                        const bf16x8 av = *(const LAS bf16x8*)(lds + qoff + (qrow + fr) * TB + (32 * ks + 8 * g) * 2);
                        const bf16x8 bv = *(const LAS bf16x8*)(lds + koff + (krow + fr) * TB + (32 * ks + 8 * g) * 2);
                        pa = __builtin_amdgcn_mfma_f32_16x16x32_bf16(av, bv, pa, 0, 0, 0);
                    }
#pragma unroll
                    for (int e = 0; e < 4; ++e) {
                        const int tl = 4 * g + e; const float val = (diag && fr > tl) ? 0.f : pa[e];
                        *(LAS bf16_t*)(lds + T_P + (16 * I + tl) * PB + (16 * J + fr) * 2) = (bf16_t)f2bf(val);
                    }
                }
            }
            f32x4 oacc[4];
#pragma unroll
            for (int m = 0; m < 4; ++m) oacc[m] = (f32x4){0.f, 0.f, 0.f, 0.f};
            if (lat) {
                bf16x8 Sb[4];
#pragma unroll
                for (int ks = 0; ks < 4; ++ks) {
                    const f32x4 a0 = Sacc[2 * ks], a1 = Sacc[2 * ks + 1];
                    const u32x4 pk = (u32x4){pk2(a0[0], a0[1]), pk2(a0[2], a0[3]), pk2(a1[0], a1[1]), pk2(a1[2], a1[3])};
                    Sb[ks] = __builtin_bit_cast(bf16x8, pk);
                }
#pragma unroll
                for (int m = 0; m < 4; ++m)
#pragma unroll
                    for (int ks = 0; ks < 4; ++ks) {
                        const u32x2 lo = *(const LAS u32x2*)(lds + T_QC + (16 * m + fr) * TB + (32 * ks + 4 * g) * 2);
                        const u32x2 hi = *(const LAS u32x2*)(lds + T_QC + (16 * m + fr) * TB + (32 * ks + 16 + 4 * g) * 2);
                        const u32x4 pk = (u32x4){lo.x, lo.y, hi.x, hi.y};
                        oacc[m] = __builtin_amdgcn_mfma_f32_16x16x32_bf16(__builtin_bit_cast(bf16x8, pk), Sb[ks], oacc[m], 0, 0, 0);
                    }
            }
#pragma unroll
            for (int m = 0; m < 8; ++m) { const f32x4 ct = *(const LAS f32x4*)(lds + T_CT + (16 * m + 4 * g) * 4); Sacc[m] = Sacc[m] * ct; }
            bf16x8 Vf[2];
#pragma unroll
            for (int ks = 0; ks < 2; ++ks) Vf[ks] = tr_frag(lds + vbuf, 32 * ks + 8 * g, 16 * w, lane);
#pragma unroll
            for (int m = 0; m < 8; ++m)
#pragma unroll
                for (int ks = 0; ks < 2; ++ks) Sacc[m] = __builtin_amdgcn_mfma_f32_16x16x32_bf16(tr_frag(lds + T_KC, 32 * ks + 8 * g, 16 * m, lane), Vf[ks], Sacc[m], 0, 0, 0);
            HG_BAR();
            if (lat) {
#pragma unroll
                for (int m = 0; m < 4; ++m)
#pragma unroll
                    for (int ks = 0; ks < 2; ++ks) {
                        if (m < 2 && ks == 1) continue;
                        const bf16x8 av = *(const LAS bf16x8*)(lds + T_P + (16 * m + fr) * PB + (32 * ks + 8 * g) * 2);
                        oacc[m] = __builtin_amdgcn_mfma_f32_16x16x32_bf16(av, Vf[ks], oacc[m], 0, 0, 0);
                    }
#pragma unroll
                for (int m = 0; m < 4; ++m)
#pragma unroll
                    for (int e = 0; e < 4; ++e) { const int r = row_of(dir, 64 * cidx + 16 * m + 4 * g + e); OL[(size_t)(r - C) * D + hc + 16 * w + fr] = oacc[m][e]; }
            }
        }
#undef HG_LOAD
        float* DS = (float*)(c.ws + WS_DS) + (size_t)item * 16384; float* DG = (float*)(c.ws + WS_DG) + item * 128;
#pragma unroll
        for (int m = 0; m < 8; ++m)
#pragma unroll
            for (int e = 0; e < 4; ++e) DS[(16 * m + 4 * g + e) * 128 + 16 * w + fr] = Sacc[m][e];
        if (w == 0) { DG[2 * lane] = dseg0; DG[2 * lane + 1] = dseg1; }
    }
}

#undef HG_BAR
__device__ __forceinline__ void phase_hgrn_fold(const Ctx& c) {
    const float* DS = (const float*)(c.ws + WS_DS); const float* DG = (const float*)(c.ws + WS_DG); bf16_t* SST = (bf16_t*)(c.ws + WS_SST);
    for (int item = c.wg; item < 256; item += c.nwg) {
        const int chain = item >> 4, slice = item & 15, d = 8 * slice + (c.tid >> 6), v2 = (c.tid & 63) * 2;
        float s0 = 0.f, s1 = 0.f;
        float dv[15]; f32x2 ds[15];
#pragma unroll
        for (int sgi = 0; sgi < 15; ++sgi) { dv[sgi] = DG[(chain * 16 + sgi) * 128 + d]; ds[sgi] = *(const f32x2*)(DS + ((size_t)(chain * 16 + sgi) * 128 + d) * 128 + v2); }
        SST[((size_t)(chain * 16) * 128 + v2) * 128 + d] = 0; SST[((size_t)(chain * 16) * 128 + v2 + 1) * 128 + d] = 0;
#pragma unroll
        for (int sgi = 0; sgi < 15; ++sgi) {
            s0 = dv[sgi] * s0 + ds[sgi][0]; s1 = dv[sgi] * s1 + ds[sgi][1];
            SST[((size_t)(chain * 16 + sgi + 1) * 128 + v2) * 128 + d] = (bf16_t)f2bf(s0); SST[((size_t)(chain * 16 + sgi + 1) * 128 + v2 + 1) * 128 + d] = (bf16_t)f2bf(s1);
        }
    }
}

__device__ __forceinline__ void phase_hgrn_readout(const Ctx& c) {
    constexpr int SP = 272, SBUF = 128 * SP, IBUF = 2 * SBUF;
    static_assert(2 * IBUF + 1024 <= LDS_BYTES - 64, "readout LDS map");
    const float* OF = (const float*)(c.ws + WS_OF); const float* OB = (const float*)(c.ws + WS_OB); const bf16_t* SGp = (const bf16_t*)(c.ws + WS_SG);
    const bf16_t* SST = (const bf16_t*)(c.ws + WS_SST); bf16_t* RR = (bf16_t*)(c.ws + WS_RR); const float* hng = c.a->in[13];
    LAS unsigned char* lds = c.lds; LAS float* ssx = (LAS float*)(c.lds + 2 * IBUF);
    const int tid = c.tid, lane = c.lane, w = __builtin_amdgcn_readfirstlane(tid >> 6), fr = lane & 15, g = lane >> 4, mt = w & 3, nh = w >> 2;
#define RO_BAR() asm volatile("s_waitcnt lgkmcnt(0)\n\ts_barrier" ::: "memory")
    u32x4 sreg[8];
#define RO_SST_LOAD(it) do { const int h_ = (it) >> 8, ch_ = (it) & 255; \
        _Pragma("unroll") for (int j = 0; j < 8; ++j) { const int idx_ = tid + 512 * j, dx_ = idx_ >> 11, rem_ = idx_ & 2047; \
            const int sg_ = hg::seg_of(dx_ ? 4 + 255 - ch_ : 4 + ch_); \
            sreg[j] = *(const u32x4*)(SST + ((size_t)((h_ * 2 + dx_) * 16 + sg_) * 128 + (rem_ >> 4)) * 128 + (rem_ & 15) * 8); } } while (0)
#define RO_SST_WRITE(buf) do { _Pragma("unroll") for (int j = 0; j < 8; ++j) { const int idx_ = tid + 512 * j, dx_ = idx_ >> 11, rem_ = idx_ & 2047; \
            *(LAS u32x4*)(lds + (buf) * IBUF + dx_ * SBUF + (rem_ >> 4) * SP + (rem_ & 15) * 16) = sreg[j]; } } while (0)
    int it = c.wg;
    RO_BAR();
    if (it < 2048) { RO_SST_LOAD(it); RO_SST_WRITE(0); }
    RO_BAR();
    for (int k = 0; it < 2048; it += c.nwg, ++k) {
        const int h = it >> 8, ch = it & 255, t0 = 64 * ch + 16 * mt, buf = k & 1;
        const bool has_next = it + c.nwg < 2048;
        if (has_next) RO_SST_LOAD(it + c.nwg);
        f32x4 acc[4]; float sgv[4][4];
#pragma unroll
        for (int n = 0; n < 4; ++n)
#pragma unroll
            for (int e = 0; e < 4; ++e) { const size_t o = (size_t)(t0 + 4 * g + e) * D + h * 128 + 64 * nh + 16 * n + fr; acc[n][e] = OF[o] + OB[o]; sgv[n][e] = bf2f(SGp[o]) * hng[h * 128 + 64 * nh + 16 * n + fr]; }
#pragma unroll
        for (int dx = 0; dx < 2; ++dx) {
            const bf16_t* QS = (const bf16_t*)(c.ws + (dx ? WS_QSB : WS_QSF)) + (size_t)(t0 + fr) * D + h * 128 + 8 * g;
            const LAS unsigned char* sb = lds + buf * IBUF + dx * SBUF + (64 * nh + fr) * SP + 16 * g;
#pragma unroll
            for (int ks = 0; ks < 4; ++ks) {
                const bf16x8 av = *(const bf16x8*)(QS + 32 * ks);
#pragma unroll
                for (int n = 0; n < 4; ++n) acc[n] = __builtin_amdgcn_mfma_f32_16x16x32_bf16(av, *(const LAS bf16x8*)(sb + (16 * n) * SP + 64 * ks), acc[n], 0, 0, 0);
            }
        }
        float ss[4] = {0.f, 0.f, 0.f, 0.f};
#pragma unroll
        for (int n = 0; n < 4; ++n)
#pragma unroll
            for (int e = 0; e < 4; ++e) ss[e] += acc[n][e] * acc[n][e];
#pragma unroll
        for (int e = 0; e < 4; ++e) {
#pragma unroll
            for (int sh = 8; sh > 0; sh >>= 1) ss[e] += __shfl_xor(ss[e], sh);
        }
        if (fr == 0) *(LAS f32x4*)(ssx + ((k & 1) * 8 + w) * 16 + 4 * g) = (f32x4){ss[0], ss[1], ss[2], ss[3]};
        if (has_next) RO_SST_WRITE(buf ^ 1);
        RO_BAR();
        const f32x4 ps = *(const LAS f32x4*)(ssx + ((k & 1) * 8 + (w ^ 4)) * 16 + 4 * g);
#pragma unroll
        for (int e = 0; e < 4; ++e) ss[e] = rsqrtf((ss[e] + ps[e]) * (1.f / 128.f) + EPS);
#pragma unroll
        for (int n = 0; n < 4; ++n)
#pragma unroll
            for (int e = 0; e < 4; ++e) { const size_t o = (size_t)(t0 + 4 * g + e) * D + h * 128 + 64 * nh + 16 * n + fr; RR[o] = (bf16_t)f2bf(acc[n][e] * ss[e] * sgv[n][e]); }
    }
    RO_BAR();
#undef RO_BAR
#undef RO_SST_LOAD
#undef RO_SST_WRITE
}

#define XB_TMO      128
#define XB_XCNT(j)  (256  + 64 * (j))
#define XB_XSUB(j)  (1280 + 64 * (j))
#define XB_XGEN(j)  (2304 + 64 * (j))
#define XB_TOP      3328
#define XB_TOPGEN   3392
#define XCD_BAR_WORDS 3456
#define XB_SPIN_CAP (1u << 18)
__device__ __forceinline__ unsigned xb_ld(unsigned* p)              { return __hip_atomic_load(p, __ATOMIC_RELAXED, __HIP_MEMORY_SCOPE_AGENT); }
__device__ __forceinline__ unsigned xb_add(unsigned* p, unsigned v) { return __hip_atomic_fetch_add(p, v, __ATOMIC_RELAXED, __HIP_MEMORY_SCOPE_AGENT); }
__device__ __forceinline__ unsigned xb_xcc_id() { return (unsigned)__builtin_amdgcn_s_getreg((3 << 11) | 20) & 0xFu; }
#define XB_SPIN(cond, bar) do { unsigned _sp = 0; while (cond) { __builtin_amdgcn_s_sleep(1); \
    if ((++_sp & 255u) == 0u) { if (xb_ld(&(bar)[XB_TMO])) break; if (_sp > XB_SPIN_CAP) { atomicAdd(&(bar)[XB_TMO], 1u); break; } } } } while (0)
struct XcdBarrier { unsigned* bar; unsigned x; volatile LAS unsigned* st; };
__device__ __forceinline__ XcdBarrier xcd_barrier_post(unsigned* bar, volatile LAS unsigned* st) {
    XcdBarrier b; b.bar = bar; b.x = xb_xcc_id(); b.st = st;
    if (threadIdx.x == 0) (void)xb_add(&bar[XB_XCNT(b.x)], 1u);
    return b;
}
__device__ __forceinline__ void xcd_barrier_complete(unsigned* bar, unsigned x, unsigned& nloc, unsigned& nx) {
    const unsigned G = gridDim.x * gridDim.y * gridDim.z;
    unsigned sum, cnt, mine, sp = 0u;
    for (;;) {
        sum = 0u; cnt = 0u; mine = 0u;
#pragma unroll
        for (unsigned j = 0; j < 16; ++j) { const unsigned c = xb_ld(&bar[XB_XCNT(j)]); sum += c; cnt += (c > 0u) ? 1u : 0u; mine = (j == x) ? c : mine; }
        if (sum == G) break;
        __builtin_amdgcn_s_sleep(1);
        if ((++sp & 255u) == 0u) { if (xb_ld(&bar[XB_TMO])) break; if (sp > XB_SPIN_CAP) { atomicAdd(&bar[XB_TMO], 1u); break; } }
    }
    nloc = mine > 0u ? mine : 1u; nx = cnt > 0u ? cnt : 1u;
}
__device__ __forceinline__ void xcd_barrier(const XcdBarrier& b) {
    asm volatile("s_waitcnt vmcnt(0)" ::: "memory");
    __syncthreads();
    if (threadIdx.x == 0) {
        unsigned* bar = b.bar;
        __builtin_amdgcn_s_waitcnt(0);
        unsigned nloc = b.st[0], nx = b.st[1];
        if (nloc == 0u) { xcd_barrier_complete(bar, b.x, nloc, nx); b.st[0] = nloc; b.st[1] = nx; }
        const unsigned old = xb_add(&bar[XB_XSUB(b.x)], 1u);
        const unsigned gen = old / nloc;
        if (old + 1u == (gen + 1u) * nloc) {
            __builtin_amdgcn_fence(__ATOMIC_RELEASE, "agent");
            asm volatile("s_waitcnt vmcnt(0)" ::: "memory");
            const unsigned og = xb_add(&bar[XB_TOP], 1u);
            const unsigned tg = og / nx;
            if (og + 1u == (tg + 1u) * nx) xb_add(&bar[XB_TOPGEN], 1u);
            else XB_SPIN(xb_ld(&bar[XB_TOPGEN]) == tg, bar);
            __builtin_amdgcn_fence(__ATOMIC_ACQUIRE, "agent");
            xb_add(&bar[XB_XGEN(b.x)], 1u);
            asm volatile("s_waitcnt vmcnt(0)" ::: "memory");
        } else {
            XB_SPIN(xb_ld(&bar[XB_XGEN(b.x)]) == gen, bar);
            __builtin_amdgcn_fence(__ATOMIC_ACQUIRE, "agent");
            asm volatile("s_waitcnt vmcnt(0)" ::: "memory");
        }
    }
    __syncthreads();
}

__device__ __forceinline__ void launder(Ctx& c) { asm volatile("" : "+s"(c.a)); asm volatile("" : "+s"(c.ws)); asm volatile("" : "+s"(c.wave));
    c.lane = (int)__builtin_amdgcn_mbcnt_hi(~0u, __builtin_amdgcn_mbcnt_lo(~0u, 0u)); c.tid = c.wave * 64 + c.lane; }
__global__ void __launch_bounds__(512, 2) mk_fwd(Args args) {
    extern __shared__ __attribute__((aligned(16))) unsigned char lds_raw[];
    Ctx c; c.a = (CArgs)__builtin_amdgcn_kernarg_segment_ptr(); c.lds = (LAS unsigned char*)lds_raw; c.tid = threadIdx.x; c.lane = c.tid & 63; c.wave = __builtin_amdgcn_readfirstlane(c.tid >> 6); c.nwg = gridDim.x; c.wg = blockIdx.x; c.ws = c.a->ws;
    volatile LAS unsigned* bst = (volatile LAS unsigned*)(c.lds + LDS_BYTES - 64);
    if (c.tid < 4) bst[c.tid] = 0u;
    __syncthreads();
    const XcdBarrier bar = xcd_barrier_post((unsigned*)(c.ws + WS_CTL) + CW_BAR, bst);
    const int lo = c.a->ph_lo, hi = c.a->ph_hi;
    bool route_ok = true;
#define SEAM(k) do { if (lo <= (k) && (k) + 1 < hi) xcd_barrier(bar); } while (0)
#define IN(k) (lo <= (k) && (k) < hi && (launder(c), true))
#define PH(k, call) do { if (IN(k)) { if (PROBE_PH == (k)) { int nrep_ = 3; asm volatile("" : "+s"(nrep_)); for (int rep_ = 0; rep_ < nrep_; ++rep_) { route_ok = (rep_ + 1 == nrep_); call; if (rep_ + 1 < nrep_) xcd_barrier(bar); } } else { call; } } SEAM(k); } while (0)
    PH(0, phase_prep(c));
    PH(1, phase_convert(c));
    PH(2, phase_gemm_qkv(c));
    PH(3, phase_attn(c));
    PH(4, phase_gemm_f32(c, (const bf16_t*)(c.ws + WS_O), R, (const bf16_t*)(c.ws + WS_WO), D, nullptr, (bf16_t*)(c.ws + WS_RAW1)));
    PH(5, { phase_postmix<128>(c, 0, route_ok); convert_steal(c, 1); });
    PH(6, phase_moe_gu(c, 0));
    PH(7, phase_moe_dn(c, 0));
    PH(8, phase_combine(c, 0));
    PH(9, phase_gemm_inproj(c));
    PH(10, phase_hgrn_scan(c));
    PH(11, phase_hgrn_fold(c));
    PH(12, phase_hgrn_readout(c));
    PH(13, phase_gemm_f32(c, (const bf16_t*)(c.ws + WS_RR), L, (const bf16_t*)(c.ws + WS_WHO), D, nullptr, (bf16_t*)(c.ws + WS_RAW1)));
    PH(14, { phase_postmix<128>(c, 1, route_ok); convert_steal(c, 2); });
    PH(15, phase_moe_gu(c, 1));
    PH(16, phase_moe_dn(c, 1));
    PH(17, phase_combine(c, 1));
#undef IN
#undef PH
#undef SEAM
}

extern "C" void kernel_launch(void* const* d_in, const int* in_sizes, int n_in, void* d_out, int out_size, void* d_ws, size_t ws_size, hipStream_t stream) {
    static int grid = 0;
    if (grid == 0) {
        if (n_in != 21 || out_size != L * D || ws_size < WS_END) { fprintf(stderr, "kernel_launch: unexpected problem (n_in %d out %d ws %zu need %zu)\n", n_in, out_size, ws_size, (size_t)WS_END); grid = -1; return; }
        int dev = 0, cus = 0, per_cu = 0;
        hipGetDevice(&dev); hipDeviceGetAttribute(&cus, hipDeviceAttributeMultiprocessorCount, dev);
        if (hipFuncSetAttribute((const void*)mk_fwd, hipFuncAttributeMaxDynamicSharedMemorySize, LDS_BYTES) != hipSuccess) { fprintf(stderr, "kernel_launch: hipFuncSetAttribute failed\n"); grid = -1; return; }
        hipOccupancyMaxActiveBlocksPerMultiprocessor(&per_cu, (const void*)mk_fwd, 512, LDS_BYTES);
        if (per_cu < 1) fprintf(stderr, "kernel_launch: occupancy query says %d\n", per_cu);
        (void)hipGetLastError();
        grid = cus > 0 ? cus : 256;
    }
    if (grid < 0) return;
    hipMemsetAsync((char*)d_ws + WS_CTL, 0, MiB, stream);
    Args a{};
    for (int i = 0; i < 21; ++i) a.in[i] = (const float*)d_in[i];
    a.out = (float*)d_out; a.ws = (unsigned char*)d_ws;
    a.ph_lo = 0; a.ph_hi = NPHASE;
    hipLaunchKernelGGL(mk_fwd, dim3(grid), dim3(512), LDS_BYTES, stream, a);
}
```

```cpp
#include <hip/hip_runtime.h>
#include <cstdint>
#include <cstdio>

#define LAS __attribute__((address_space(3)))
typedef unsigned short bf16_t;
typedef short bf16x8 __attribute__((ext_vector_type(8)));
typedef float f32x4 __attribute__((ext_vector_type(4)));
typedef unsigned u32x4 __attribute__((ext_vector_type(4)));
typedef unsigned u32x2 __attribute__((ext_vector_type(2)));
typedef short v4i16_t __attribute__((ext_vector_type(4)));
typedef float f32x2 __attribute__((ext_vector_type(2)));

constexpr int D = 1024, L = 16384, C = 256, R = L + C;
constexpr int QKVD = 1280, HIN = 5120, NE = 32, TOPK = 4;
constexpr int PADM = 256, MAXROWS = 74752;
constexpr float EPS = 1e-6f;
constexpr float LOG2E = 1.4426950408889634f;
constexpr int NPHASE = 18;
#ifndef GEMM_REP
#define GEMM_REP 1
#endif
#ifndef PROBE_NOEPI
#define PROBE_NOEPI 0
#endif
#ifndef PROBE_SHORTK
#define PROBE_SHORTK 0
#endif
#ifndef SCAN_REP
#define SCAN_REP 1
#endif
#ifndef PROBE_PH
#define PROBE_PH (-1)
#endif
constexpr int LDS_BYTES = 147456;

constexpr size_t MiB = 1u << 20;
constexpr size_t al(size_t x) { return (x + MiB - 1) / MiB * MiB; }
constexpr size_t WS_CTL = 0;
constexpr size_t WS_MOD = WS_CTL + MiB;
constexpr size_t WS_X = WS_MOD + MiB;
constexpr size_t WS_H = WS_X + al((size_t)R * D * 4);
constexpr size_t WS_Q = WS_H + al((size_t)R * D * 2);
constexpr size_t WS_K = WS_Q + al((size_t)R * D * 2);
constexpr size_t WS_V = WS_K + al((size_t)R * 128 * 2);
constexpr size_t WS_O = WS_V + al((size_t)R * 128 * 2);
constexpr size_t WS_TK = WS_O + al((size_t)R * D * 2);
constexpr size_t WS_LIST = WS_TK + MiB;
constexpr size_t WS_HDN = WS_LIST + 3 * MiB;
constexpr size_t WS_RAW1 = WS_HDN + al((size_t)MAXROWS * 1024 * 2);
constexpr size_t WS_X1 = WS_RAW1 + al((size_t)R * D * 4);
constexpr size_t WS_OUTB = WS_X1 + al((size_t)R * D * 4);
constexpr size_t WS_QH = WS_OUTB + al((size_t)MAXROWS * 1024 * 2);
constexpr size_t WS_KF = WS_QH + al((size_t)L * D * 2);
constexpr size_t WS_KB = WS_KF + al((size_t)R * D * 2);
constexpr size_t WS_IV = WS_KB + al((size_t)R * D * 2);
constexpr size_t WS_SG = WS_IV + al((size_t)R * D * 2);
constexpr size_t WS_OF = WS_SG + al((size_t)L * D * 2);
constexpr size_t WS_OB = WS_OF + al((size_t)L * D * 4);
constexpr size_t WS_RR = WS_OB + al((size_t)L * D * 4);
constexpr size_t WS_WQKV = WS_RR + al((size_t)L * D * 2);
constexpr size_t WS_WO = WS_WQKV + al((size_t)QKVD * D * 2);
constexpr size_t WS_WIN = WS_WO + al((size_t)D * D * 2);
constexpr size_t WS_WHO = WS_WIN + al((size_t)HIN * D * 2);
constexpr size_t WS_WGU = WS_WHO + al((size_t)D * D * 2);
constexpr size_t WS_WDN = WS_WGU + al((size_t)2 * NE * 2048 * D * 2);
constexpr size_t WS_QSF = WS_WDN + al((size_t)2 * NE * 1024 * D * 2);
constexpr size_t WS_QSB = WS_QSF + al((size_t)L * D * 2);
constexpr size_t WS_DS = WS_QSB + al((size_t)L * D * 2);
constexpr size_t WS_DG = WS_DS + al((size_t)256 * 128 * 128 * 4);
constexpr size_t WS_SST = WS_DG + MiB;
constexpr size_t WS_H8 = WS_SST + al((size_t)256 * 128 * 128 * 2);
constexpr size_t WS_END = WS_H8 + al((size_t)R * D);
static_assert(WS_END <= (size_t)2048 * MiB, "workspace map exceeds 4x the largest input");
constexpr int CW_CNT = 1024;
constexpr int CW_CONV = 2048;
constexpr int CW_BAR = 4096;
constexpr int MOD_ROPE = 32768;
constexpr int MOD_LB = 49152;

struct Args { const float* in[21]; float* out; unsigned char* ws; int ph_lo, ph_hi; };

__device__ __forceinline__ unsigned f2bf(float f) { unsigned u = __float_as_uint(f); return (u + 0x7fffu + ((u >> 16) & 1u)) >> 16; }
typedef float f32x2_t __attribute__((ext_vector_type(2))); typedef __bf16 bf16x2_t __attribute__((ext_vector_type(2)));
__device__ __forceinline__ unsigned pk2(float lo, float hi) { f32x2_t v = {lo, hi}; bf16x2_t b = __builtin_convertvector(v, bf16x2_t); return __builtin_bit_cast(unsigned, b); }
__device__ __forceinline__ unsigned pk4_fp8(float a, float b, float c, float d) {
    a = fminf(fmaxf(a, -448.f), 448.f); b = fminf(fmaxf(b, -448.f), 448.f); c = fminf(fmaxf(c, -448.f), 448.f); d = fminf(fmaxf(d, -448.f), 448.f);
    int v = __builtin_amdgcn_cvt_pk_fp8_f32(a, b, 0, false); v = __builtin_amdgcn_cvt_pk_fp8_f32(c, d, v, true); return (unsigned)v; }
constexpr float F8_SH = 8.f, F8_SW = 64.f, F8_SHD = 4.f;
__device__ __forceinline__ float bflo(unsigned u) { return __uint_as_float(u << 16); }
__device__ __forceinline__ float bfhi(unsigned u) { return __uint_as_float(u & 0xffff0000u); }
__device__ __forceinline__ float bf2f(bf16_t b) { return __uint_as_float(((unsigned)b) << 16); }
__device__ __forceinline__ float wave_sum(float v) {
#pragma unroll
    for (int o = 32; o > 0; o >>= 1) v += __shfl_xor(v, o);
    return v;
}
__device__ __forceinline__ float silu_f(float x) { return x / (1.f + __expf(-x)); }
__device__ __forceinline__ float sigmoid_f(float x) { return 1.f / (1.f + __expf(-x)); }

typedef const __attribute__((address_space(4))) Args* CArgs;
struct Ctx {
    CArgs a;
    LAS unsigned char* lds;
    int tid, lane, wave, nwg, wg;
    unsigned char* ws;
    __device__ __forceinline__ float* modp(int layer, int which) const { return (float*)(ws + WS_MOD) + (layer * 2 + which) * 6144; }
    __device__ __forceinline__ const float* xin0(int r) const { return r < C ? a->in[2] + (size_t)r * D : a->in[0] + (size_t)(r - C) * D; }
};


namespace pg8 {
constexpr int BM = 256, BK = 64, HALF = 128, HTB = HALF * BK * 2, STAGE_BYTES = 8 * HTB, KD = 1024, NXCD = 8, WGM = 8;
__device__ __forceinline__ int lds_byte(int r, int c) { const int st = (r >> 4) * 2 + (c >> 5), rr = r & 15, cc = c & 31, ob = rr * 64 + cc * 2; return st * 1024 + (ob ^ (((ob >> 9) & 1) << 5)); }
__device__ __forceinline__ void stage_rc(int b, int& Rr, int& Cc) { const int st = b / 1024, sb = b % 1024, swz = sb ^ (((sb >> 9) & 1) << 5); Rr = (st >> 1) * 16 + swz / 64; Cc = (st & 1) * 32 + (swz % 64) / 2; }
__device__ __forceinline__ int perm32(int rho) { const int n = rho >> 4, i = rho & 15; return 8 * (i >> 2) + 4 * n + (i & 3); }

struct Unit { int pm, pn, e, goff, gcnt; bool real; int amask, bmask; };
struct Gemm { const void* A; const void* Bt; size_t bstride; const int* list; };

struct StaticOrder {
    int nM, nN, nwg, G, c;
    __device__ __forceinline__ void init(int M, int N, int G_, int c_) { nM = M / BM; nN = N / BM; nwg = nM * nN; G = G_; c = c_; }
    __device__ __forceinline__ bool next(int i, Unit& u) const {
        const int F = nwg / G, Rm = nwg - F * G; int Lq; u.amask = 3; u.bmask = 3;
        if (i < F) Lq = i * G + c;
        else if (i == F && Rm > 0) {
            if (4 * Rm <= G) { if (c >= 4 * Rm) return false; Lq = F * G + (c >> 2); u.amask = 1 << ((c >> 1) & 1); u.bmask = 1 << (c & 1); }
            else if (2 * Rm <= G) { if (c >= 2 * Rm) return false; Lq = F * G + (c >> 1); u.bmask = 1 << (c & 1); }
            else { if (c >= Rm) return false; Lq = F * G + c; }
        } else return false;
        int wgid = Lq; { const int q = nwg / NXCD, r = nwg % NXCD, xcd = wgid % NXCD, off = wgid / NXCD; wgid = (xcd < r ? xcd * (q + 1) : r * (q + 1) + (xcd - r) * q) + off; }
        const int nig = WGM * nN, gid = wgid / nig, fm = gid * WGM, gsz = (nM - fm) < WGM ? (nM - fm) : WGM;
        u.pm = fm + ((wgid % nig) % gsz); u.pn = (wgid % nig) / gsz; u.e = 0; u.goff = 0; u.gcnt = 0; u.real = true; return true;
    }
};
struct MoeOrder {
    const LAS int* tp; const LAS int* cnt; int npn, G, vcu; bool split;
    __device__ __forceinline__ bool next(int i, Unit& u) const {
        const int tot = tp[32] * npn; int lin; u.amask = 3; u.bmask = 3; u.real = true;
        if (GEMM_REP > 1) { const int lin0 = i * G + vcu; if (lin0 >= tot * GEMM_REP) return false; lin = lin0 % tot; u.real = lin0 >= tot * (GEMM_REP - 1); }
        else {
            const int F = tot / G, Rm = tot - F * G;
            if (i < F) lin = i * G + vcu;
            else if (i == F && Rm > 0) {
                if (split && 2 * Rm <= G) { if (vcu >= 2 * Rm) return false; lin = F * G + (vcu >> 1); u.bmask = 1 << (vcu & 1); }
                else { if (vcu >= Rm) return false; lin = F * G + vcu; }
            } else return false;
        }
        const int rt = lin / npn; int e = 0;
#pragma unroll 8
        for (int k = 1; k < 32; ++k) e += (rt >= tp[k]) ? 1 : 0;
        const int mt = rt - tp[e];
        u.pm = rt; u.pn = lin - rt * npn; u.e = e; u.goff = e * R + mt * 256; u.gcnt = cnt[e] - mt * 256; return true;
    }
};

template <int KB>
__device__ __forceinline__ void a_offsets(const Gemm& g, const Unit& u, const int (&sR)[2], const int (&sC)[2], unsigned (&v)[2][2]) {
#pragma unroll
    for (int h = 0; h < 2; ++h)
#pragma unroll
        for (int i = 0; i < 2; ++i) {
            const int rr = h * HALF + sR[i]; int row;
            if (g.list) row = rr < u.gcnt ? g.list[u.goff + rr] : 0; else row = u.pm * BM + rr;
            v[h][i] = (unsigned)(row * KB + sC[i] * 2);
        }
}

struct EpiF32 {
    static constexpr bool PERM = false;
    bf16_t* Cp; int ldc; const float* bias;
    __device__ __forceinline__ void operator()(const f32x4 (&acc)[2][2][4][2], const Unit& u, int wr, int wc, int fr, int fq) const {
        const int row0 = u.pm * BM + wr * 64 + fr, col0 = u.pn * BM + wc * 32 + 4 * fq;
#pragma unroll
        for (int bj = 0; bj < 2; ++bj)
#pragma unroll
            for (int n = 0; n < 2; ++n) {
                const int col = col0 + bj * HALF + n * 16;
                if (!((u.bmask >> bj) & 1)) continue;
                const f32x4 bv = bias ? *(const f32x4*)(bias + col) : (f32x4){0.f, 0.f, 0.f, 0.f};
#pragma unroll
                for (int ai = 0; ai < 2; ++ai)
#pragma unroll
                    for (int m = 0; m < 4; ++m) if ((u.amask >> ai) & 1) { const f32x4 v = acc[ai][bj][m][n] + bv; u32x2 o; o.x = pk2(v[0], v[1]); o.y = pk2(v[2], v[3]);
                        *(u32x2*)(Cp + (size_t)(row0 + ai * HALF + m * 16) * ldc + col) = o; }
            }
    }
};
struct EpiSwiglu {
    static constexpr bool PERM = true;
    unsigned char* Hd; const float* bgu;
    __device__ __forceinline__ void operator()(const f32x4 (&acc)[2][2][4][2], const Unit& u, int wr, int wc, int fr, int fq) const {
        const int row0 = u.pm * BM + wr * 64 + fr, cg0 = u.pn * HALF + wc * 32 + 8 * fq;
        const float* bb = bgu + (size_t)u.e * 2048;
        f32x4 bg[2], bu[2];
#pragma unroll
        for (int n = 0; n < 2; ++n) { bg[n] = *(const f32x4*)(bb + cg0 + 4 * n); bu[n] = *(const f32x4*)(bb + 1024 + cg0 + 4 * n); }
#pragma unroll
        for (int ai = 0; ai < 2; ++ai)
#pragma unroll
            for (int m = 0; m < 4; ++m) {
                u32x2 o;
#pragma unroll
                for (int n = 0; n < 2; ++n) {
                    const f32x4 gv = acc[ai][0][m][n] * (1.f / (F8_SH * F8_SW)) + bg[n], uv = acc[ai][1][m][n] * (1.f / (F8_SH * F8_SW)) + bu[n]; float hv[4];
#pragma unroll
                    for (int q = 0; q < 4; ++q) { const float gg = fminf(gv[q], 7.f), uu = fminf(fmaxf(uv[q], -7.f), 7.f); hv[q] = gg * __builtin_amdgcn_rcpf(1.f + __builtin_amdgcn_exp2f(-1.702f * LOG2E * gg)) * (uu + 1.f); }
                    o[n] = pk4_fp8(hv[0] * F8_SHD, hv[1] * F8_SHD, hv[2] * F8_SHD, hv[3] * F8_SHD);
                }
                *(u32x2*)(Hd + (size_t)(row0 + ai * HALF + m * 16) * 1024 + cg0) = o;
            }
    }
};
struct EpiBf16Bias {
    static constexpr bool PERM = true;
    bf16_t* Op; const float* bias; int bias_estride; float scale;
    __device__ __forceinline__ void operator()(const f32x4 (&acc)[2][2][4][2], const Unit& u, int wr, int wc, int fr, int fq) const {
        const int row0 = u.pm * BM + wr * 64 + fr, col0 = u.pn * BM + wc * 32 + 8 * fq;
        const float* bb = bias + (size_t)u.e * bias_estride;
#pragma unroll
        for (int bj = 0; bj < 2; ++bj) {
            const int col = col0 + bj * HALF;
            if (!((u.bmask >> bj) & 1)) continue;
            const f32x4 b0 = *(const f32x4*)(bb + col), b1 = *(const f32x4*)(bb + col + 4);
#pragma unroll
            for (int ai = 0; ai < 2; ++ai)
#pragma unroll
                for (int m = 0; m < 4; ++m) { if (!((u.amask >> ai) & 1)) continue; const f32x4 v0 = acc[ai][bj][m][0] * scale + b0, v1 = acc[ai][bj][m][1] * scale + b1;
                    u32x4 o; o.x = pk2(v0[0], v0[1]); o.y = pk2(v0[2], v0[3]); o.z = pk2(v1[0], v1[1]); o.w = pk2(v1[2], v1[3]);
                    *(u32x4*)(Op + (size_t)(row0 + ai * HALF + m * 16) * 1024 + col) = o; }
        }
    }
};
struct EpiQKV {
    static constexpr bool PERM = false;
    bf16_t* Qp; bf16_t* Kp; bf16_t* Vp; const float* bias; const float* tab;
    __device__ __forceinline__ void operator()(const f32x4 (&acc)[2][2][4][2], const Unit& u, int wr, int wc, int fr, int fq) const {
        const bool lat = u.pm > 0; const float qs = 0.125f * LOG2E;
#pragma unroll
        for (int bj = 0; bj < 2; ++bj) {
            const int colt = u.pn * BM + bj * HALF + wc * 32 + 4 * fq;
            const f32x4 b1 = *(const f32x4*)(bias + colt), b2 = *(const f32x4*)(bias + colt + 16);
            const bool isv = (u.pn == 4) && (bj == 1);
            if (!((u.bmask >> bj) & 1)) continue;
#pragma unroll
            for (int ai = 0; ai < 2; ++ai)
#pragma unroll
                for (int m = 0; m < 4; ++m) {
                    if (!((u.amask >> ai) & 1)) continue;
                    const int r = u.pm * BM + ai * HALF + wr * 64 + m * 16 + fr, t = r - C;
                    f32x4 x1 = acc[ai][bj][m][0] + b1, x2 = acc[ai][bj][m][1] + b2;
                    if (lat && !isv) {
                        const int pos = (wc & 1) ? (t & 63) : (t >> 6);
                        const f32x4 t0 = *(const f32x4*)(tab + (pos * 16 + 4 * fq) * 2), t1 = *(const f32x4*)(tab + (pos * 16 + 4 * fq) * 2 + 4);
                        const float cs[4] = {t0[0], t0[2], t1[0], t1[2]}, sn[4] = {t0[1], t0[3], t1[1], t1[3]};
                        f32x4 o1, o2;
#pragma unroll
                        for (int e = 0; e < 4; ++e) { o1[e] = x1[e] * cs[e] - x2[e] * sn[e]; o2[e] = x2[e] * cs[e] + x1[e] * sn[e]; }
                        x1 = o1; x2 = o2;
                    }
                    u32x2 w1, w2;
                    if (u.pn < 4) {
                        w1.x = pk2(x1[0] * qs, x1[1] * qs); w1.y = pk2(x1[2] * qs, x1[3] * qs); w2.x = pk2(x2[0] * qs, x2[1] * qs); w2.y = pk2(x2[2] * qs, x2[3] * qs);
                        *(u32x2*)(Qp + (size_t)r * 1024 + colt) = w1; *(u32x2*)(Qp + (size_t)r * 1024 + colt + 16) = w2;
                    } else {
                        w1.x = pk2(x1[0], x1[1]); w1.y = pk2(x1[2], x1[3]); w2.x = pk2(x2[0], x2[1]); w2.y = pk2(x2[2], x2[3]);
                        bf16_t* dst = (bj == 0 ? Kp : Vp) + (size_t)r * 128 + wc * 32 + 4 * fq;
                        *(u32x2*)dst = w1; *(u32x2*)(dst + 16) = w2;
                    }
                }
        }
    }
};
struct EpiInProj {
    static constexpr bool PERM = true;
    bf16_t* QH; _Float16* KF; _Float16* KB; bf16_t* IV; bf16_t* SG; const float* lb; float scale;
    __device__ __forceinline__ void operator()(const f32x4 (&acc)[2][2][4][2], const Unit& u, int wr, int wc, int fr, int fq) const {
        const int seg = u.pn >> 2; const bool lat = u.pm > 0;
        if (!lat && (seg == 0 || seg == 4)) return;
        typedef _Float16 h8_t __attribute__((ext_vector_type(8)));
#pragma unroll
        for (int bj = 0; bj < 2; ++bj) {
            const int col = (u.pn & 3) * BM + bj * HALF + wc * 32 + 8 * fq;
            if (!((u.bmask >> bj) & 1)) continue;
            f32x4 lb0 = (f32x4){0.f, 0.f, 0.f, 0.f}, lb1 = lb0;
            if (seg == 1) { lb0 = *(const f32x4*)(lb + col); lb1 = *(const f32x4*)(lb + col + 4); } else if (seg == 2) { lb0 = *(const f32x4*)(lb + 1024 + col); lb1 = *(const f32x4*)(lb + 1024 + col + 4); }
#pragma unroll
            for (int ai = 0; ai < 2; ++ai)
#pragma unroll
                for (int m = 0; m < 4; ++m) {
                    if (!((u.amask >> ai) & 1)) continue;
                    const int r = u.pm * BM + ai * HALF + wr * 64 + m * 16 + fr; const f32x4 v0 = acc[ai][bj][m][0] * scale, v1 = acc[ai][bj][m][1] * scale;
                    if (seg == 1 || seg == 2) {
                        h8_t hv;
#pragma unroll
                        for (int e = 0; e < 4; ++e) { hv[e] = (_Float16)((1.f - lb0[e]) * __builtin_amdgcn_rcpf(1.f + __builtin_amdgcn_exp2f(LOG2E * v0[e]))); hv[4 + e] = (_Float16)((1.f - lb1[e]) * __builtin_amdgcn_rcpf(1.f + __builtin_amdgcn_exp2f(LOG2E * v1[e]))); }
                        *(h8_t*)((seg == 1 ? KF : KB) + (size_t)r * 1024 + col) = hv;
                    } else if (seg == 3) {
                        u32x4 o; o.x = pk2(v0[0], v0[1]); o.y = pk2(v0[2], v0[3]); o.z = pk2(v1[0], v1[1]); o.w = pk2(v1[2], v1[3]); *(u32x4*)(IV + (size_t)r * 1024 + col) = o;
                    } else {
                        float s0[4], s1[4];
#pragma unroll
                        for (int e = 0; e < 4; ++e) { s0[e] = v0[e] * __builtin_amdgcn_rcpf(1.f + __builtin_amdgcn_exp2f(-LOG2E * v0[e])); s1[e] = v1[e] * __builtin_amdgcn_rcpf(1.f + __builtin_amdgcn_exp2f(-LOG2E * v1[e])); }
                        u32x4 o; o.x = pk2(s0[0], s0[1]); o.y = pk2(s0[2], s0[3]); o.z = pk2(s1[0], s1[1]); o.w = pk2(s1[2], s1[3]); *(u32x4*)((seg == 0 ? QH : SG) + (size_t)(r - C) * 1024 + col) = o;
                    }
                }
        }
    }
};

typedef int v8i __attribute__((ext_vector_type(8)));
typedef int v4i __attribute__((ext_vector_type(4)));
template <class Epi, class Sched, bool ALIGN_EPI, bool GATHER, bool FP8>
__device__ __forceinline__ void gemm_phase(LAS unsigned char* lds, const Gemm g, const Sched& S, const Epi& E, const int tid) {
    const int wid = __builtin_amdgcn_readfirstlane(tid >> 6), lane = tid & 63, wr = wid >> 2, wc = wid & 3, fr = lane & 15, fq = lane >> 4;
    constexpr int KB = FP8 ? 1024 : 2048, nt = 1024 / (FP8 ? 128 : 64);
    int sR[2], sC[2]; unsigned voffB[2], voffA[2];
#pragma unroll
    for (int i = 0; i < 2; ++i) { stage_rc(tid * 16 + i * 8192, sR[i], sC[i]); const int Rb = Epi::PERM ? ((sR[i] & ~31) + perm32(sR[i] & 31)) : sR[i]; voffB[i] = (unsigned)(Rb * KB + sC[i] * 2); voffA[i] = (unsigned)(sR[i] * KB + sC[i] * 2); }
    constexpr size_t kstep = (size_t)(BK * 2), hstep = (size_t)HALF * KB, tstep = 2 * hstep;
    const unsigned ldsw = (unsigned)wid * 1024u;
    const int aoff = lds_byte(wr * 64 + fr, fq * 8), boff = lds_byte(wc * 32 + fr, fq * 8);
    const char* Ab = (const char*)g.A;
#define PG8_SA(b, h) (((b) * 2 + (h)) * HTB)
#define PG8_SB(b, h) ((4 + (b) * 2 + (h)) * HTB)
#define PG8_STAGE_B(bufoff, gbase) do { _Pragma("unroll") for (int _i = 0; _i < 2; ++_i) \
        __builtin_amdgcn_global_load_lds((const unsigned*)((const char*)(gbase) + voffB[_i]), (LAS unsigned*)(lds + (bufoff) + ldsw + _i * 8192), 16, 0, 0); } while (0)
#define PG8_STAGE_A(bufoff, kb, v, ubase) do { _Pragma("unroll") for (int _i = 0; _i < 2; ++_i) \
        __builtin_amdgcn_global_load_lds((const unsigned*)((GATHER ? Ab : (ubase)) + (size_t)(kb) + (GATHER ? (v)[_i] : voffA[_i])), (LAS unsigned*)(lds + (bufoff) + ldsw + _i * 8192), 16, 0, 0); } while (0)
#define PG8_LD8(p) __builtin_shufflevector(*(const LAS v4i*)(p), *(const LAS v4i*)((p) + 1024), 0, 1, 2, 3, 4, 5, 6, 7)
#define PG8_LDA(dst, b, h) do { if constexpr (FP8) { _Pragma("unroll") for (int m = 0; m < 4; ++m) dst##8[m] = PG8_LD8(lds + PG8_SA(b, h) + aoff + m * 2048); } else { _Pragma("unroll") for (int m = 0; m < 4; ++m) _Pragma("unroll") for (int k = 0; k < 2; ++k) dst[m][k] = *(const LAS bf16x8*)(lds + PG8_SA(b, h) + aoff + m * 2048 + k * 1024); } } while (0)
#define PG8_LDB(dst, b, h) do { if constexpr (FP8) { _Pragma("unroll") for (int n = 0; n < 2; ++n) dst##8[n] = PG8_LD8(lds + PG8_SB(b, h) + boff + n * 2048); } else { _Pragma("unroll") for (int n = 0; n < 2; ++n) _Pragma("unroll") for (int k = 0; k < 2; ++k) dst[n][k] = *(const LAS bf16x8*)(lds + PG8_SB(b, h) + boff + n * 2048 + k * 1024); } } while (0)
#define PG8_MMA(ai, bj, At, Bt) do { __builtin_amdgcn_s_setprio(1); if constexpr (FP8) { _Pragma("unroll") for (int m = 0; m < 4; ++m) _Pragma("unroll") for (int n = 0; n < 2; ++n) \
        asm volatile("v_mfma_scale_f32_16x16x128_f8f6f4 %0, %1, %2, %0, %3, %3 op_sel_hi:[0,0,0]" : "+v"(acc[ai][bj][m][n]) : "v"(Bt##8[n]), "v"(At##8[m]), "v"(unit_scale)); } else { \
        _Pragma("unroll") for (int m = 0; m < 4; ++m) _Pragma("unroll") for (int n = 0; n < 2; ++n) _Pragma("unroll") for (int k = 0; k < 2; ++k) \
        acc[ai][bj][m][n] = __builtin_amdgcn_mfma_f32_16x16x32_bf16(Bt[n][k], At[m][k], acc[ai][bj][m][n], 0, 0, 0); } __builtin_amdgcn_s_setprio(0); } while (0)
#define PG8_WAIT_V(n) asm volatile("s_waitcnt vmcnt(" #n ")" ::: "memory")
#define PG8_WAIT_L(n) asm volatile("s_waitcnt lgkmcnt(" #n ")" ::: "memory")
#define PG8_BAR __builtin_amdgcn_s_barrier()
#define PG8_SCHED __builtin_amdgcn_sched_barrier(0)
    Unit cur, nxt; int ui = 0;
    if (!S.next(0, cur)) return;
    unsigned cv[2][2], nv[2][2];
    if constexpr (GATHER) a_offsets<KB>(g, cur, sR, sC, cv);
    const char* cA = Ab + (size_t)cur.pm * tstep; const char* nA = cA;
    f32x4 acc[2][2][4][2];
#pragma unroll
    for (int a = 0; a < 2; ++a)
#pragma unroll
        for (int b = 0; b < 2; ++b)
#pragma unroll
            for (int m = 0; m < 4; ++m)
#pragma unroll
                for (int n = 0; n < 2; ++n) acc[a][b][m][n] = (f32x4){0.f, 0.f, 0.f, 0.f};
    bf16x8 At[4][2], B0[2][2], B1[2][2]; v8i At8[4], B08[2], B18[2];
    int unit_scale = 0x7f7f7f7f; asm volatile("" : "+v"(unit_scale));
    const char* cB = (const char*)g.Bt + (size_t)cur.e * g.bstride + (size_t)cur.pn * tstep;
    PG8_STAGE_B(PG8_SB(0, 0), cB); PG8_STAGE_B(PG8_SB(0, 1), cB + hstep); PG8_STAGE_A(PG8_SA(0, 0), 0, cv[0], cA); PG8_STAGE_A(PG8_SA(0, 1), 0, cv[1], cA + hstep);
    if (wr == 1) PG8_BAR;
    PG8_WAIT_V(2); PG8_BAR;
    PG8_STAGE_B(PG8_SB(1, 0), cB + kstep); PG8_STAGE_A(PG8_SA(1, 0), kstep, cv[0], cA); PG8_STAGE_B(PG8_SB(1, 1), cB + hstep + kstep);
    PG8_WAIT_V(6); PG8_BAR;
    for (;;) {
        const bool has_next = S.next(ui + 1, nxt);
        const char* nB = cB;
        nA = cA;
        if (has_next) { if constexpr (GATHER) a_offsets<KB>(g, nxt, sR, sC, nv); nA = Ab + (size_t)nxt.pm * tstep; nB = (const char*)g.Bt + (size_t)nxt.e * g.bstride + (size_t)nxt.pn * tstep; }
        else if constexpr (GATHER) {
#pragma unroll
            for (int h = 0; h < 2; ++h)
#pragma unroll
                for (int i = 0; i < 2; ++i) nv[h][i] = cv[h][i];
        }
        const int ntr = (PROBE_SHORTK && !cur.real) ? 2 : nt;
        const bool m00 = (cur.amask & 1) && (cur.bmask & 1), m01 = (cur.amask & 1) && (cur.bmask & 2), m10 = (cur.amask & 2) && (cur.bmask & 1), m11 = (cur.amask & 2) && (cur.bmask & 2);
#pragma nounroll
        for (int t = 0; t < ntr; t += 2) {
            const bool last = (t == ntr - 2);
            const size_t k1 = (size_t)(t + 1) * kstep, k2 = last ? 0 : (size_t)(t + 2) * kstep, k3 = k2 + kstep;
            const char* b2 = last ? nB : cB + (size_t)(t + 2) * kstep; const char* b3 = b2 + kstep;
            unsigned w0[2], w1[2];
            if constexpr (GATHER) {
#pragma unroll
                for (int i = 0; i < 2; ++i) { w0[i] = last ? nv[0][i] : cv[0][i]; w1[i] = last ? nv[1][i] : cv[1][i]; }
            }
            const char* a2 = last ? nA : cA;
            PG8_LDB(B0, 0, 0); PG8_LDB(B1, 0, 1); PG8_SCHED; PG8_LDA(At, 0, 0); PG8_STAGE_A(PG8_SA(1, 1), k1, cv[1], cA + hstep);
            PG8_WAIT_V(8); PG8_WAIT_L(0); PG8_BAR; if (m00) PG8_MMA(0, 0, At, B0); if (m01) PG8_MMA(0, 1, At, B1); PG8_BAR; PG8_SCHED;
            PG8_LDA(At, 0, 1); PG8_STAGE_B(PG8_SB(0, 0), b2); PG8_STAGE_B(PG8_SB(0, 1), b2 + hstep); PG8_STAGE_A(PG8_SA(0, 0), k2, w0, a2);
            PG8_WAIT_V(8); PG8_WAIT_L(0); PG8_BAR; if (m10) PG8_MMA(1, 0, At, B0); if (m11) PG8_MMA(1, 1, At, B1); PG8_BAR; PG8_SCHED;
            PG8_LDB(B0, 1, 0); PG8_LDB(B1, 1, 1); PG8_SCHED; PG8_LDA(At, 1, 0); PG8_STAGE_A(PG8_SA(0, 1), k2, w1, a2 + hstep);
            PG8_WAIT_V(8); PG8_WAIT_L(0); PG8_BAR; if (m00) PG8_MMA(0, 0, At, B0); if (m01) PG8_MMA(0, 1, At, B1); PG8_BAR; PG8_SCHED;
            PG8_LDA(At, 1, 1); PG8_STAGE_B(PG8_SB(1, 0), b3); PG8_STAGE_B(PG8_SB(1, 1), b3 + hstep); PG8_STAGE_A(PG8_SA(1, 0), k3, w0, a2);
            PG8_WAIT_V(8); PG8_WAIT_L(0); PG8_BAR; if (m10) PG8_MMA(1, 0, At, B0); if (m11) PG8_MMA(1, 1, At, B1); PG8_BAR; PG8_SCHED;
        }
        if constexpr (ALIGN_EPI) { if (wr == 0) PG8_BAR; }
        if constexpr (FP8) asm volatile("s_nop 15\n\ts_nop 15" ::: "memory");
        if (!PROBE_NOEPI || cur.real) E(acc, cur, wr, wc, fr, fq);
        if (!has_next) break;
#pragma unroll
        for (int a = 0; a < 2; ++a)
#pragma unroll
            for (int b = 0; b < 2; ++b)
#pragma unroll
                for (int m = 0; m < 4; ++m)
#pragma unroll
                    for (int n = 0; n < 2; ++n) acc[a][b][m][n] = (f32x4){0.f, 0.f, 0.f, 0.f};
        cur = nxt; cB = nB; cA = nA; ++ui;
        if constexpr (GATHER) {
#pragma unroll
            for (int h = 0; h < 2; ++h)
#pragma unroll
                for (int i = 0; i < 2; ++i) cv[h][i] = nv[h][i];
        }
        if constexpr (ALIGN_EPI) { if (wr == 1) PG8_BAR; }
    }
    PG8_WAIT_V(0);
    if constexpr (!ALIGN_EPI) { if (wr == 0) PG8_BAR; }
    PG8_BAR;
#undef PG8_SA
#undef PG8_SB
#undef PG8_STAGE_A
#undef PG8_STAGE_B
#undef PG8_LDA
#undef PG8_LD8
#undef PG8_LDB
#undef PG8_MMA
#undef PG8_WAIT_V
#undef PG8_WAIT_L
#undef PG8_BAR
#undef PG8_SCHED
}
}

struct TBlk { const float* src; int ldw; bf16_t* dst; unsigned char* dst8; };
__device__ __forceinline__ void tb_load(const TBlk& t, int lane, f32x4 (&v)[16]) {
    const float* p = t.src + (size_t)(lane >> 4) * t.ldw + (lane & 15) * 4;
#pragma unroll
    for (int i = 0; i < 16; ++i) v[i] = *(const f32x4*)(p + (size_t)(4 * i) * t.ldw);
}
__device__ __forceinline__ void tb_store(const TBlk& t, int lane, const f32x4 (&v)[16], LAS float* scr) {
#pragma unroll
    for (int i = 0; i < 16; ++i) { LAS float* d = scr + ((lane >> 4) + 4 * i) * 65 + (lane & 15) * 4; d[0] = v[i].x; d[1] = v[i].y; d[2] = v[i].z; d[3] = v[i].w; }
    asm volatile("s_waitcnt lgkmcnt(0)" ::: "memory"); __builtin_amdgcn_wave_barrier();
    const int c8 = lane & 7;
#pragma unroll
    for (int jj = 0; jj < 8; ++jj) {
        const int n = (lane >> 3) + 8 * jj; const LAS float* p = scr + (8 * c8) * 65 + n;
        if (t.dst8) { u32x2 o; o.x = pk4_fp8(p[0] * F8_SW, p[65] * F8_SW, p[2 * 65] * F8_SW, p[3 * 65] * F8_SW); o.y = pk4_fp8(p[4 * 65] * F8_SW, p[5 * 65] * F8_SW, p[6 * 65] * F8_SW, p[7 * 65] * F8_SW);
            *(u32x2*)(t.dst8 + (size_t)n * 1024 + 8 * c8) = o; }
        else { u32x4 o; o.x = pk2(p[0], p[65]); o.y = pk2(p[2 * 65], p[3 * 65]); o.z = pk2(p[4 * 65], p[5 * 65]); o.w = pk2(p[6 * 65], p[7 * 65]);
            *(u32x4*)(t.dst + (size_t)n * 1024 + 8 * c8) = o; }
    }
    asm volatile("s_waitcnt lgkmcnt(0)" ::: "memory"); __builtin_amdgcn_wave_barrier();
}

__device__ __forceinline__ void phase_prep(const Ctx& c) {
    LAS float* red = (LAS float*)c.lds;
    LAS float* sil = red + 1024;
    const float* cv = c.a->in[1]; const float* ccv = c.a->in[3]; const float* ada_w = c.a->in[4]; const float* ada_b = c.a->in[5];
    for (int i = c.tid; i < 2048; i += 512) { const float x = i < 1024 ? cv[i] : ccv[i - 1024]; sil[i] = x * __builtin_amdgcn_rcpf(1.f + __builtin_amdgcn_exp2f(-LOG2E * x)); }
    __syncthreads();
    for (int item = c.wg; item < 193; item += c.nwg) {
        if (item < 192) {
            const int layer = item / 96, cb = item % 96, col = cb * 64 + c.lane;
            const float* W = ada_w + (size_t)layer * D * 6144 + col;
            float a0 = 0.f, a1 = 0.f;
            const int k0 = c.wave * 128;
#pragma unroll 32
            for (int k = 0; k < 128; ++k) { const float w = W[(size_t)(k0 + k) * 6144]; a0 += sil[k0 + k] * w; a1 += sil[1024 + k0 + k] * w; }
            red[(0 * 8 + c.wave) * 64 + c.lane] = a0; red[(1 * 8 + c.wave) * 64 + c.lane] = a1;
            __syncthreads();
            if (c.tid < 128) {
                const int which = c.tid >> 6, l = c.tid & 63; float s = 0.f;
#pragma unroll
                for (int w = 0; w < 8; ++w) s += red[(which * 8 + w) * 64 + l];
                c.modp(layer, which)[cb * 64 + l] = s + ada_b[layer * 6144 + cb * 64 + l];
            }
            __syncthreads();
        } else {
            float* modbase = (float*)(c.ws + WS_MOD);
            for (int i = c.tid; i < 4096; i += 512) {
                const int pos = i >> 4, j = i & 15;
                const double ang = (double)pos * pow(10000.0, -(double)j / 16.0);
                modbase[MOD_ROPE + 2 * i] = (float)cos(ang); modbase[MOD_ROPE + 2 * i + 1] = (float)sin(ang);
            }
            const float* lbp = c.a->in[12];
            for (int i = c.tid; i < 2048; i += 512) { const float p0 = lbp[i], p1 = lbp[2048 + i]; modbase[MOD_LB + i] = 1.f / (1.f + __expf(p0 - p1)); }
        }
    }
}

__device__ __forceinline__ void row_load(const float* p, int lane, f32x4 (&v)[4]) {
#pragma unroll
    for (int j = 0; j < 4; ++j) v[j] = *(const f32x4*)(p + lane * 4 + 256 * j);
}
__device__ __forceinline__ void row_load_bf(const bf16_t* p, int lane, f32x4 (&v)[4]) {
#pragma unroll
    for (int j = 0; j < 4; ++j) { const u32x2 w = *(const u32x2*)(p + lane * 4 + 256 * j); v[j] = (f32x4){bflo(w.x), bfhi(w.x), bflo(w.y), bfhi(w.y)}; }
}
__device__ __forceinline__ float row_ss(const f32x4 (&v)[4]) {
    float s = 0.f;
#pragma unroll
    for (int j = 0; j < 4; ++j) s += v[j].x * v[j].x + v[j].y * v[j].y + v[j].z * v[j].z + v[j].w * v[j].w;
    return wave_sum(s);
}
__device__ __forceinline__ void row_modnorm_store(const f32x4 (&x)[4], float rstd, const float* g, const float* sh, const float* sc, bf16_t* out, int lane, f32x4 (*hout)[4] = nullptr) {
#pragma unroll
    for (int j = 0; j < 4; ++j) {
        const int c0 = lane * 4 + 256 * j;
        const f32x4 gv = *(const f32x4*)(g + c0), shv = *(const f32x4*)(sh + c0), scv = *(const f32x4*)(sc + c0);
        f32x4 h;
        h.x = x[j].x * rstd * gv.x * (1.f + scv.x) + shv.x; h.y = x[j].y * rstd * gv.y * (1.f + scv.y) + shv.y;
        h.z = x[j].z * rstd * gv.z * (1.f + scv.z) + shv.z; h.w = x[j].w * rstd * gv.w * (1.f + scv.w) + shv.w;
        if (hout) (*hout)[j] = h;
        u32x2 o; o.x = pk2(h.x, h.y); o.y = pk2(h.z, h.w);
        *(u32x2*)(out + c0) = o;
    }
}

__device__ __forceinline__ void phase_norm0(const Ctx& c) {
    bf16_t* H = (bf16_t*)(c.ws + WS_H); const float* ng = c.a->in[6];
    int r = c.wg * 8 + c.wave;
    f32x4 xn[4];
    if (r < R) row_load(c.xin0(r), c.lane, xn);
    for (; r < R; r += c.nwg * 8) {
        f32x4 x[4];
#pragma unroll
        for (int j = 0; j < 4; ++j) x[j] = xn[j];
        if (r + c.nwg * 8 < R) row_load(c.xin0(r + c.nwg * 8), c.lane, xn);
        const float rstd = rsqrtf(row_ss(x) * (1.f / D) + EPS);
        const float* m = c.modp(0, r < C ? 1 : 0);
        row_modnorm_store(x, rstd, ng, m + 0, m + 1024, H + (size_t)r * D, c.lane);
    }
}

namespace at {
__device__ __forceinline__ float max3f(float a, float b, float c) { return __builtin_fmaxf(__builtin_fmaxf(a, b), c); }
constexpr int KP = 144, TILEB = 64 * KP;
__device__ __forceinline__ bf16x8 tr_frag2(const LAS unsigned char* tile, int row0, int col0, int lane) {
    const int q = (lane & 15) >> 2, p = lane & 3;
    const LAS unsigned char* a = tile + (row0 + q) * KP + (col0 + 4 * p) * 2;
    const v4i16_t lo = __builtin_amdgcn_ds_read_tr16_b64_v4i16((LAS v4i16_t*)a);
    const v4i16_t hi = __builtin_amdgcn_ds_read_tr16_b64_v4i16((LAS v4i16_t*)(a + 16 * KP));
    return (bf16x8){lo[0], lo[1], lo[2], lo[3], hi[0], hi[1], hi[2], hi[3]};
}
}
__device__ __forceinline__ void phase_attn(const Ctx& c) {
    using namespace at;
    const bf16_t* Q = (const bf16_t*)(c.ws + WS_Q); const bf16_t* K = (const bf16_t*)(c.ws + WS_K); const bf16_t* V = (const bf16_t*)(c.ws + WS_V);
    bf16_t* O = (bf16_t*)(c.ws + WS_O); const float* sink = c.a->in[9];
    LAS unsigned char* lds = c.lds;
    const int tid = c.tid, lane = c.lane, w = __builtin_amdgcn_readfirstlane(tid >> 6), fr = lane & 15, g = lane >> 4;
    const int lrow = tid >> 3, lch = tid & 7;
    const int nitn = c.nwg == 256 ? 2 : (264 - c.wg + c.nwg - 1) / c.nwg;
    for (int itn = 0; itn < nitn; ++itn) {
        int item = c.wg + itn * c.nwg;
        if (c.nwg == 256 && itn == 1) { const int n_ = c.wg >> 1; item = -1;
            if (n_ == 0) item = 256 + (c.wg & 1); else if (n_ == 127) item = 258 + (c.wg & 1); else if (n_ == 30 || n_ == 31) item = 260 + (c.wg - 60); }
        if (item < 0 || item >= 264) continue;
        const bool isctx = item >= 256;
        const int ci = item - 256;
        const int n = isctx ? 0 : (item >> 1), kh = isctx ? ((ci >> 1) & 1) : (item & 1), cb = isctx ? (ci >> 2) : 0;
        const int p_lo = isctx ? (ci & 1) : 0, p_hi = isctx ? (ci & 1) + 1 : 2;
        const int hq = kh * 8 + w;
        const float sink2 = sink[hq] * LOG2E;
        for (int pass = p_lo; pass < p_hi; ++pass) {
            const int t0 = 128 * n + 64 * pass, qrow0 = isctx ? cb * 128 + 64 * pass : C + t0;
            const int jlo = isctx ? 0 : (t0 >= 128 ? 0 : (128 - t0) / 64), jhi = isctx ? 0 : ((L - t0 + 128) / 64 < 5 ? (L - t0 + 128) / 64 : 5);
            const int ntile = 4 + (jhi - jlo);
            LAS unsigned char* qlds = lds + 4 * TILEB + w * TILEB;
#pragma unroll
            for (int qb = 0; qb < 4; ++qb)
#pragma unroll
                for (int ks = 0; ks < 2; ++ks) *(LAS bf16x8*)(qlds + (16 * qb + fr) * KP + (32 * ks + 8 * g) * 2) = *(const bf16x8*)(Q + (size_t)(qrow0 + 16 * qb + fr) * D + hq * 64 + 32 * ks + 8 * g);
            float mrow[4], lsum[4]; f32x4 OT[4][4];
#pragma unroll
            for (int qb = 0; qb < 4; ++qb) { mrow[qb] = sink2; lsum[qb] = 1.f;
#pragma unroll
                for (int nt = 0; nt < 4; ++nt) OT[qb][nt] = (f32x4){0.f, 0.f, 0.f, 0.f}; }
            u32x4 kreg, vreg;
#define AT_KROW(ti) ((ti) < 4 ? 64 * (ti) : C + t0 - 128 + 64 * (jlo + (ti) - 4))
#define AT_LOAD(ti) do { const size_t ro_ = (size_t)(AT_KROW(ti) + lrow) * 128 + kh * 64 + lch * 8; kreg = *(const u32x4*)(K + ro_); vreg = *(const u32x4*)(V + ro_); } while (0)
#define AT_WRITE(buf) do { *(LAS u32x4*)(lds + (buf) * 2 * TILEB + lrow * KP + lch * 16) = kreg; *(LAS u32x4*)(lds + (buf) * 2 * TILEB + TILEB + lrow * KP + lch * 16) = vreg; } while (0)
            AT_LOAD(0); AT_WRITE(0);
            __syncthreads();
            for (int ti = 0; ti < ntile; ++ti) {
                if (ti + 1 < ntile) AT_LOAD(ti + 1);
                const LAS unsigned char* kb = lds + (ti & 1) * 2 * TILEB; const LAS unsigned char* vb = kb + TILEB;
                const int jj = jlo + ti - 4; const bool masked = (ti >= 4) && (jj == 0 || jj == 4);
                const int k0 = t0 - 128 + 64 * jj;
                bf16x8 Kf[4][2];
#pragma unroll
                for (int mt = 0; mt < 4; ++mt)
#pragma unroll
                    for (int ks = 0; ks < 2; ++ks) Kf[mt][ks] = *(const LAS bf16x8*)(kb + (16 * mt + fr) * KP + (32 * ks + 8 * g) * 2);
                bf16x8 Vf[4][2];
#pragma unroll
                for (int mt = 0; mt < 4; ++mt)
#pragma unroll
                    for (int ks = 0; ks < 2; ++ks)
                        Vf[mt][ks] = tr_frag2(vb, 32 * ks + 4 * g, 16 * mt, lane);
#pragma unroll
                for (int qb = 0; qb < 4; ++qb) {
                    bf16x8 Qq[2];
#pragma unroll
                    for (int ks = 0; ks < 2; ++ks) Qq[ks] = *(const LAS bf16x8*)(qlds + (16 * qb + fr) * KP + (32 * ks + 8 * g) * 2);
                    f32x4 sa[4];
#pragma unroll
                    for (int mt = 0; mt < 4; ++mt) { sa[mt] = (f32x4){0.f, 0.f, 0.f, 0.f};
#pragma unroll
                        for (int ks = 0; ks < 2; ++ks) sa[mt] = __builtin_amdgcn_mfma_f32_16x16x32_bf16(Kf[mt][ks], Qq[ks], sa[mt], 0, 0, 0); }
                    if (masked) {
                        const int tq = t0 + 16 * qb + fr;
#pragma unroll
                        for (int mt = 0; mt < 4; ++mt)
#pragma unroll
                            for (int e = 0; e < 4; ++e) { const int dt = tq - (k0 + 16 * mt + 4 * g + e); if (dt > 128 || dt < -128) sa[mt][e] = -INFINITY; }
                    }
                    float mx = max3f(sa[0][0], sa[0][1], sa[0][2]), my = max3f(sa[0][3], sa[1][0], sa[1][1]);
                    mx = max3f(mx, sa[1][2], sa[1][3]); my = max3f(my, sa[2][0], sa[2][1]); mx = max3f(mx, sa[2][2], sa[2][3]); my = max3f(my, sa[3][0], sa[3][1]); mx = max3f(mx, sa[3][2], sa[3][3]);
                    mx = max3f(mx, my, mrow[qb]);
                    mx = max3f(mx, __shfl_xor(mx, 16), mx); mx = max3f(mx, __shfl_xor(mx, 32), mx);
                    const float mn = mx; const bool grew = __any(mn > mrow[qb]);
                    const float alpha = grew ? __builtin_amdgcn_exp2f(mrow[qb] - mn) : 1.f;
                    mrow[qb] = mn;
                    float rs = 0.f;
#pragma unroll
                    for (int mt = 0; mt < 4; ++mt)
#pragma unroll
                        for (int e = 0; e < 4; ++e) { const float pv = __builtin_amdgcn_exp2f(sa[mt][e] - mn); sa[mt][e] = pv; rs += pv; }
                    rs += __shfl_xor(rs, 16); rs += __shfl_xor(rs, 32);
                    lsum[qb] = grew ? lsum[qb] * alpha + rs : lsum[qb] + rs;
                    bf16x8 Pb[2];
#pragma unroll
                    for (int ks = 0; ks < 2; ++ks) { const f32x4 a0 = sa[2 * ks], a1 = sa[2 * ks + 1];
                        const u32x4 pk = (u32x4){pk2(a0[0], a0[1]), pk2(a0[2], a0[3]), pk2(a1[0], a1[1]), pk2(a1[2], a1[3])}; Pb[ks] = __builtin_bit_cast(bf16x8, pk); }
#pragma unroll
                    for (int nt = 0; nt < 4; ++nt) { if (grew) OT[qb][nt] = OT[qb][nt] * alpha;
#pragma unroll
                        for (int ks = 0; ks < 2; ++ks) OT[qb][nt] = __builtin_amdgcn_mfma_f32_16x16x32_bf16(Vf[nt][ks], Pb[ks], OT[qb][nt], 0, 0, 0); }
                }
                if (ti + 1 < ntile) AT_WRITE((ti + 1) & 1);
                __syncthreads();
            }
#undef AT_KROW
#undef AT_LOAD
#undef AT_WRITE
#pragma unroll
            for (int qb = 0; qb < 4; ++qb) {
                const float il = 1.f / lsum[qb];
                bf16_t* op = O + (size_t)(qrow0 + 16 * qb + fr) * D + hq * 64 + 4 * g;
#pragma unroll
                for (int nt = 0; nt < 4; ++nt) { const f32x4 v = OT[qb][nt] * il; u32x2 o; o.x = pk2(v[0], v[1]); o.y = pk2(v[2], v[3]); *(u32x2*)(op + 16 * nt) = o; }
            }
        }
    }
}

template <int GS>
__device__ __forceinline__ void phase_postmix(const Ctx& c, int layer, bool route) {
    const bf16_t* Y = (const bf16_t*)(c.ws + WS_RAW1); unsigned char* H8 = c.ws + WS_H8;
    bf16_t* Xout = (bf16_t*)(c.ws + (layer == 0 ? WS_X : WS_X1)); const bf16_t* Xprev = (const bf16_t*)(c.ws + WS_X);
    const float* ng = c.a->in[6] + layer * 4 * D; const float* Wr = c.a->in[15] + (size_t)layer * D * NE; const float* br = c.a->in[16] + layer * NE;
    unsigned* cnt = (unsigned*)(c.ws + WS_CTL) + CW_CNT + layer * NE;
    int* tk_e = (int*)(c.ws + WS_TK); float* tk_g = (float*)(c.ws + WS_TK) + R * 4; int* tk_slot = (int*)(c.ws + WS_TK) + 2 * R * 4;
    int* list = (int*)(c.ws + WS_LIST);
    LAS float* WL = (LAS float*)c.lds;
    LAS float* biasp = (LAS float*)(c.lds + 131072);
    LAS unsigned* lcnt = (LAS unsigned*)(c.lds + 145920); LAS unsigned* lbase = lcnt + 32; LAS float* rsx = (LAS float*)(lcnt + 64);
    LAS float* pvA = (LAS float*)(c.lds + 131072 + 2560); LAS float* pvB = pvA + 1024; LAS float* pvS = pvB + 1024;
    const int lane = c.lane, w = __builtin_amdgcn_readfirstlane(c.tid >> 6), fr = lane & 15, g = lane >> 4;
    constexpr int RP = GS / 8, NW2 = GS / 16;
    const int g_lo = layer == 0 ? 0 : C / GS;
    for (int grp = g_lo + c.wg; grp < R / GS; grp += c.nwg) {
        const int which = grp * GS < C ? 1 : 0;
        const float* m = c.modp(layer, which);
        __syncthreads();
        if (c.tid < NE) lcnt[c.tid] = 0u;
#pragma unroll 4
        for (int j = 0; j < 16; ++j) {
            const int i4 = c.tid + 512 * j, k = i4 >> 3, e0 = (i4 & 7) * 4;
            const f32x4 wv = *(const f32x4*)(Wr + (size_t)k * NE + e0); const float sc = ng[2 * D + k] * (1.f + m[4096 + k]);
            LAS float* dst = WL + ((((k >> 4) * 4 + (k & 3)) * 4 + ((k >> 2) & 3)) * 16) * 2;
#pragma unroll
            for (int q = 0; q < 4; ++q) { const int e = e0 + q; dst[(e & 15) * 2 + (e >> 4)] = wv[q] * sc; }
        }
        for (int k = c.tid; k < D; k += 512) { pvA[k] = m[2048 + k] * ng[D + k]; pvB[k] = ng[2 * D + k] * (1.f + m[4096 + k]); pvS[k] = m[3072 + k]; }
        { const int e = c.tid & 31, part = c.tid >> 5; float sacc = 0.f;
#pragma unroll 16
          for (int k = part * 64; k < part * 64 + 64; ++k) sacc += m[3072 + k] * Wr[k * NE + e];
          biasp[32 + part * 32 + e] = sacc; }
        __syncthreads();
        if (c.tid < 32) { float sacc = br[c.tid];
#pragma unroll
            for (int p = 0; p < 16; ++p) sacc += biasp[32 + p * 32 + c.tid]; biasp[c.tid] = sacc; }
        __syncthreads();
        const int row1 = grp * GS + w * RP;
        f32x4 yn[4], xn[4];
        row_load_bf(Y + (size_t)(layer == 0 ? row1 : row1 - C) * D, lane, yn); if (layer == 0) row_load(c.xin0(row1), lane, xn); else row_load_bf(Xprev + (size_t)row1 * D, lane, xn);
        for (int i = 0; i < RP; ++i) {
            const int r = row1 + i;
            f32x4 y[4], x[4];
#pragma unroll
            for (int j = 0; j < 4; ++j) { y[j] = yn[j]; x[j] = xn[j]; }
            if (i + 1 < RP) { row_load_bf(Y + (size_t)(layer == 0 ? r + 1 : r + 1 - C) * D, lane, yn); if (layer == 0) row_load(c.xin0(r + 1), lane, xn); else row_load_bf(Xprev + (size_t)(r + 1) * D, lane, xn); }
            const float rstd_y = rsqrtf(row_ss(y) * (1.f / D) + EPS);
#pragma unroll
            for (int j = 0; j < 4; ++j) {
                const int c0 = lane * 4 + 256 * j;
                x[j] += *(const LAS f32x4*)(pvA + c0) * (y[j] * rstd_y);
                { u32x2 xo; xo.x = pk2(x[j][0], x[j][1]); xo.y = pk2(x[j][2], x[j][3]); *(u32x2*)(Xout + (size_t)r * D + c0) = xo;
                  x[j] = (f32x4){bflo(xo.x), bfhi(xo.x), bflo(xo.y), bfhi(xo.y)}; }
            }
            const float rstd_x = rsqrtf(row_ss(x) * (1.f / D) + EPS);
#pragma unroll
            for (int j = 0; j < 4; ++j) {
                const int c0 = lane * 4 + 256 * j;
                const f32x4 hv = x[j] * rstd_x * *(const LAS f32x4*)(pvB + c0) + *(const LAS f32x4*)(pvS + c0);
                *(unsigned*)(H8 + (size_t)r * D + c0) = pk4_fp8(hv[0] * F8_SH, hv[1] * F8_SH, hv[2] * F8_SH, hv[3] * F8_SH);
            }
            if (lane == 0) rsx[w * RP + i] = rstd_x;
        }
        asm volatile("s_waitcnt vmcnt(0)" ::: "memory");
        __syncthreads();
        const int row0 = grp * GS + w * 16; const bool w2 = w < NW2;
        f32x4 la[2]; la[0] = (f32x4){0.f, 0.f, 0.f, 0.f}; la[1] = la[0];
        if (w2) {
            const bf16_t* ap = Xout + (size_t)(row0 + fr) * D + 4 * g;
            const LAS float* bp = WL + (g * 16 + fr) * 2;
#pragma unroll 4
            for (int k4 = 0; k4 < 64; ++k4) {
                const u32x2 aw = *(const u32x2*)(ap + 16 * k4); const f32x4 a4 = (f32x4){bflo(aw.x), bfhi(aw.x), bflo(aw.y), bfhi(aw.y)};
#pragma unroll
                for (int q = 0; q < 4; ++q) {
                    const f32x2 b2 = *(const LAS f32x2*)(bp + (size_t)(4 * k4 + q) * 128);
                    la[0] = __builtin_amdgcn_mfma_f32_16x16x4f32(a4[q], b2[0], la[0], 0, 0, 0);
                    la[1] = __builtin_amdgcn_mfma_f32_16x16x4f32(a4[q], b2[1], la[1], 0, 0, 0);
                }
            }
        }
        float tv[4][4]; int te[4][4];
#pragma unroll
        for (int e = 0; e < 4; ++e) {
            const float rs = rsx[(w2 ? w * 16 : 0) + 4 * g + e];
            float v0 = la[0][e] * rs + biasp[fr], v1 = la[1][e] * rs + biasp[16 + fr];
#pragma unroll
            for (int k = 0; k < 4; ++k) {
                float bv; int bi;
                if (v0 >= v1) { bv = v0; bi = fr; } else { bv = v1; bi = 16 + fr; }
#pragma unroll
                for (int o = 8; o > 0; o >>= 1) {
                    const float ov = __shfl_xor(bv, o); const int oi = __shfl_xor(bi, o);
                    if (ov > bv || (ov == bv && oi < bi)) { bv = ov; bi = oi; }
                }
                tv[e][k] = bv; te[e][k] = bi;
                if (bi == fr) v0 = -INFINITY;
                if (bi == 16 + fr) v1 = -INFINITY;
            }
        }
        float v[4]; int ex[4]; unsigned sl[4];
#pragma unroll
        for (int k = 0; k < 4; ++k) { v[k] = tv[0][k]; ex[k] = te[0][k];
#pragma unroll
            for (int e = 1; e < 4; ++e) if (fr == e) { v[k] = tv[e][k]; ex[k] = te[e][k]; } }
        if (fr < 4 && route && w2) {
#pragma unroll
            for (int k = 0; k < 4; ++k) sl[k] = __hip_atomic_fetch_add(lcnt + ex[k], 1u, __ATOMIC_RELAXED, __HIP_MEMORY_SCOPE_WORKGROUP);
        }
        __syncthreads();
        if (c.tid < NE && route) { const unsigned n = lcnt[c.tid]; lbase[c.tid] = n ? atomicAdd(&cnt[c.tid], n) : 0u; }
        __syncthreads();
        if (fr < 4 && route && w2) {
            const int r = row0 + 4 * g + fr;
            const float e1 = __expf(v[1] - v[0]), e2 = __expf(v[2] - v[0]), e3 = __expf(v[3] - v[0]);
            const float inv = 1.f / (1.f + e1 + e2 + e3);
            const float gk[4] = {inv, e1 * inv, e2 * inv, e3 * inv};
#pragma unroll
            for (int k = 0; k < 4; ++k) {
                const unsigned slot = lbase[ex[k]] + sl[k];
                list[(size_t)ex[k] * R + slot] = r;
                tk_e[r * 4 + k] = ex[k]; tk_g[r * 4 + k] = gk[k]; tk_slot[r * 4 + k] = (int)slot;
            }
        }
    }
}

__device__ __forceinline__ void moe_offsets(const Ctx& c, int layer, LAS int* so) {
    const unsigned* cnt = (const unsigned*)(c.ws + WS_CTL) + CW_CNT + layer * NE;
    __syncthreads();
    if (c.tid < 64) {
        const int n = c.tid < NE ? (int)cnt[c.tid] : 0; int pad = (n + PADM - 1) / PADM * PADM, inc = pad;
#pragma unroll
        for (int o = 1; o < 32; o <<= 1) { const int t = __shfl_up(inc, o); if (c.lane >= o) inc += t; }
        if (c.tid < NE) { so[c.tid] = inc - pad; so[64 + c.tid] = n; }
        if (c.tid == NE - 1) so[32] = inc;
    }
    __syncthreads();
}

__device__ __forceinline__ void moe_tables(const Ctx& c, int layer, LAS int* tb) {
    const unsigned* cnt = (const unsigned*)(c.ws + WS_CTL) + CW_CNT + layer * NE;
    __syncthreads();
    if (c.tid < 64) {
        const int n = c.tid < NE ? (int)cnt[c.tid] : 0; int tiles = (n + PADM - 1) / PADM, inc = tiles;
#pragma unroll
        for (int o = 1; o < 32; o <<= 1) { const int t = __shfl_up(inc, o); if (c.lane >= o) inc += t; }
        if (c.tid < NE) { tb[c.tid] = inc - tiles; tb[64 + c.tid] = n; }
        if (c.tid == NE - 1) tb[32] = inc;
    }
    __syncthreads();
}
__device__ __forceinline__ int vcu_of(const Ctx& c) { return (c.nwg % 8 == 0) ? (c.wg % 8) * (c.nwg / 8) + c.wg / 8 : c.wg; }
__device__ __forceinline__ void phase_moe_gu(const Ctx& c, int layer) {
    LAS int* tb = (LAS int*)(c.lds + 131072 + 1024);
    moe_tables(c, layer, tb);
    pg8::Gemm g{c.ws + WS_H8, c.ws + WS_WGU + (size_t)layer * NE * 2048 * 1024, (size_t)2048 * 1024, (const int*)(c.ws + WS_LIST)};
    pg8::MoeOrder S{tb, tb + 64, 8, c.nwg, vcu_of(c), false};
    pg8::EpiSwiglu E{c.ws + WS_HDN, c.a->in[18] + (size_t)layer * NE * 2048};
    pg8::gemm_phase<pg8::EpiSwiglu, pg8::MoeOrder, true, true, true>(c.lds, g, S, E, c.tid);
}
__device__ __forceinline__ void phase_moe_dn(const Ctx& c, int layer) {
    LAS int* tb = (LAS int*)(c.lds + 131072 + 1024);
    moe_tables(c, layer, tb);
    pg8::Gemm g{c.ws + WS_HDN, c.ws + WS_WDN + (size_t)layer * NE * 1024 * 1024, (size_t)1024 * 1024, nullptr};
    pg8::MoeOrder S{tb, tb + 64, 4, c.nwg, vcu_of(c), true};
    pg8::EpiBf16Bias E{(bf16_t*)(c.ws + WS_OUTB), c.a->in[20] + (size_t)layer * NE * 1024, 1024, 1.f / (F8_SHD * F8_SW)};
    pg8::gemm_phase<pg8::EpiBf16Bias, pg8::MoeOrder, true, false, true>(c.lds, g, S, E, c.tid);
}
__device__ __forceinline__ void phase_gemm_f32(const Ctx& c, const bf16_t* A, int M, const bf16_t* Bt, int N, const float* bias, bf16_t* Cout) {
    pg8::Gemm g{A, Bt, 0, nullptr}; pg8::StaticOrder S; S.init(M, N, c.nwg, c.wg);
    pg8::EpiF32 E{Cout, N, bias};
    pg8::gemm_phase<pg8::EpiF32, pg8::StaticOrder, true, false, false>(c.lds, g, S, E, c.tid);
}

__device__ __forceinline__ void phase_gemm_qkv(const Ctx& c) {
    pg8::Gemm g{(const bf16_t*)(c.ws + WS_H), (const bf16_t*)(c.ws + WS_WQKV), 0, nullptr}; pg8::StaticOrder S; S.init(R, QKVD, c.nwg, c.wg);
    pg8::EpiQKV E{(bf16_t*)(c.ws + WS_Q), (bf16_t*)(c.ws + WS_K), (bf16_t*)(c.ws + WS_V), c.a->in[8], (const float*)(c.ws + WS_MOD) + MOD_ROPE};
    pg8::gemm_phase<pg8::EpiQKV, pg8::StaticOrder, true, false, false>(c.lds, g, S, E, c.tid);
}
__device__ __forceinline__ void phase_gemm_inproj(const Ctx& c) {
    pg8::Gemm g{c.ws + WS_H8, c.ws + WS_WIN, 0, nullptr}; pg8::StaticOrder S; S.init(R, HIN, c.nwg, c.wg);
    pg8::EpiInProj E{(bf16_t*)(c.ws + WS_QH), (_Float16*)(c.ws + WS_KF), (_Float16*)(c.ws + WS_KB), (bf16_t*)(c.ws + WS_IV), (bf16_t*)(c.ws + WS_SG), (const float*)(c.ws + WS_MOD) + MOD_LB, 1.f / (F8_SH * F8_SW)};
    pg8::gemm_phase<pg8::EpiInProj, pg8::StaticOrder, true, false, true>(c.lds, g, S, E, c.tid);
}

__device__ __forceinline__ void phase_norm0(const Ctx& c);
constexpr int CONV_A = 20 * 16 + 16 * 16 + 80 * 16 + 16 * 16, CONV_B = 32 * 32 * 16 + 32 * 16 * 16, CONV_CHUNK = 64;
__device__ __forceinline__ TBlk convert_item(const Ctx& c, int it, int part) {
    constexpr int I_QKV = 20 * 16, I_O = 16 * 16, I_IN = 80 * 16, I_HO = 16 * 16, I_GU = 32 * 32 * 16;
    int r = it; TBlk t; t.dst8 = nullptr; t.dst = nullptr;
    if (part == 0) {
        if (r < I_QKV) { const int nb = r % 20, kb = r / 20; t.src = c.a->in[7] + (size_t)kb * 64 * QKVD + nb * 64; t.ldw = QKVD; t.dst = (bf16_t*)(c.ws + WS_WQKV) + (size_t)nb * 64 * 1024 + kb * 64; return t; } r -= I_QKV;
        if (r < I_O) { const int nb = r % 16, kb = r / 16; t.src = c.a->in[10] + (size_t)kb * 64 * D + nb * 64; t.ldw = D; t.dst = (bf16_t*)(c.ws + WS_WO) + (size_t)nb * 64 * 1024 + kb * 64; return t; } r -= I_O;
        if (r < I_IN) { const int nb = r % 80, kb = r / 80; t.src = c.a->in[11] + (size_t)kb * 64 * HIN + nb * 64; t.ldw = HIN; t.dst8 = c.ws + WS_WIN + (size_t)nb * 64 * 1024 + kb * 64; return t; } r -= I_IN;
        if (r < I_HO) { const int nb = r % 16, kb = r / 16; t.src = c.a->in[14] + (size_t)kb * 64 * D + nb * 64; t.ldw = D; t.dst = (bf16_t*)(c.ws + WS_WHO) + (size_t)nb * 64 * 1024 + kb * 64; return t; } r -= I_HO;
    }
    const int moff = (part - 1) * 32;
    if (r < I_GU) { const int mat = moff + r / 512, rr = r % 512, nb = rr % 32, kb = rr / 32; const int n0 = ((nb & 3) >> 1) * 1024 + (nb >> 2) * 128 + (nb & 1) * 64;
        t.src = c.a->in[17] + (size_t)mat * 1024 * 2048 + (size_t)kb * 64 * 2048 + n0; t.ldw = 2048; t.dst8 = c.ws + WS_WGU + ((size_t)mat * 2048 + nb * 64) * 1024 + kb * 64; return t; } r -= I_GU;
    { const int mat = moff + r / 256, rr = r % 256, nb = rr % 16, kb = rr / 16;
        t.src = c.a->in[19] + (size_t)mat * 1024 * 1024 + (size_t)kb * 64 * 1024 + nb * 64; t.ldw = 1024; t.dst8 = c.ws + WS_WDN + ((size_t)mat * 1024 + nb * 64) * 1024 + kb * 64; }
    return t;
}
__device__ __forceinline__ void convert_run(const Ctx& c, int part, int first, int step, int end, LAS float* scr) {
    f32x4 va[16], vb[16];
    int it = first;
    TBlk ta, tbk;
    if (it < end) { ta = convert_item(c, it, part); tb_load(ta, c.lane, va); }
    for (; it < end; it += 2 * step) {
        const bool hb = it + step < end;
        if (hb) { tbk = convert_item(c, it + step, part); tb_load(tbk, c.lane, vb); }
        tb_store(ta, c.lane, va, scr);
        const bool ha = it + 2 * step < end;
        if (ha) { ta = convert_item(c, it + 2 * step, part); tb_load(ta, c.lane, va); }
        if (hb) tb_store(tbk, c.lane, vb, scr);
    }
}
__device__ __forceinline__ void convert_steal(const Ctx& c, int part) {
    LAS float* scr = (LAS float*)c.lds + c.wave * (64 * 65);
    LAS int* chp = (LAS int*)(c.lds + 8 * 64 * 65 * 4);
    unsigned* ctr = (unsigned*)(c.ws + WS_CTL) + CW_CONV + 64 * part;
    for (;;) {
        __syncthreads();
        if (c.tid == 0) *chp = (int)atomicAdd(ctr, 1u);
        __syncthreads();
        const int ch = *chp;
        if (ch >= CONV_B / CONV_CHUNK) break;
        convert_run(c, part, ch * CONV_CHUNK + c.wave, 8, (ch + 1) * CONV_CHUNK, scr);
    }
}
__device__ __forceinline__ void phase_convert(const Ctx& c) {
    LAS float* scr = (LAS float*)c.lds + c.wave * (64 * 65);
    convert_run(c, 0, c.wg * 8 + c.wave, c.nwg * 8, CONV_A, scr);
    __syncthreads();
    phase_norm0(c);
}

__device__ __forceinline__ void phase_combine(const Ctx& c, int layer) {
    LAS int* so = (LAS int*)(c.lds + 32768);
    moe_offsets(c, layer, so);
    const bf16_t* outb = (const bf16_t*)(c.ws + WS_OUTB); bf16_t* X = (bf16_t*)(c.ws + WS_X);
    const bf16_t* Xin = layer == 0 ? X : (const bf16_t*)(c.ws + WS_X1);
    const float* ngl = c.a->in[6] + layer * 4 * D;
    const int* tk_e = (const int*)(c.ws + WS_TK); const float* tk_g = (const float*)(c.ws + WS_TK) + R * 4; const int* tk_slot = (const int*)(c.ws + WS_TK) + 2 * R * 4;
    const int r_lo = layer == 0 ? 0 : C, stride = c.nwg * 8;
    int r = r_lo + c.wg * 8 + c.wave;
    int pe[4], ps[4]; float pg[4]; u32x2 wn[4][4]; f32x4 xn[4]; float gn[4];
#define CB_TK(row) do { _Pragma("unroll") for (int k = 0; k < 4; ++k) { pe[k] = tk_e[(row) * 4 + k]; ps[k] = tk_slot[(row) * 4 + k]; pg[k] = tk_g[(row) * 4 + k]; } } while (0)
#define CB_DATA(row) do { _Pragma("unroll") for (int k = 0; k < 4; ++k) { const bf16_t* src_ = outb + (size_t)(so[pe[k]] + ps[k]) * 1024; gn[k] = pg[k]; \
        _Pragma("unroll") for (int j = 0; j < 4; ++j) wn[k][j] = *(const u32x2*)(src_ + c.lane * 4 + 256 * j); } row_load_bf(Xin + (size_t)(row) * D, c.lane, xn); } while (0)
    if (r < R) { CB_TK(r); CB_DATA(r); }
    if (r + stride < R) CB_TK(r + stride);
    for (; r < R; r += stride) {
        const float* m = c.modp(layer, r < C ? 1 : 0);
        f32x4 y[4], x[4];
#pragma unroll
        for (int j = 0; j < 4; ++j) { y[j] = (f32x4){0.f, 0.f, 0.f, 0.f}; x[j] = xn[j]; }
#pragma unroll
        for (int k = 0; k < 4; ++k)
#pragma unroll
            for (int j = 0; j < 4; ++j) { const u32x2 w = wn[k][j]; y[j] += (f32x4){bflo(w.x), bfhi(w.x), bflo(w.y), bfhi(w.y)} * gn[k]; }
        if (r + stride < R) CB_DATA(r + stride);
        if (r + 2 * stride < R) CB_TK(r + 2 * stride);
        const float rstd_y = rsqrtf(row_ss(y) * (1.f / D) + EPS);
#pragma unroll
        for (int j = 0; j < 4; ++j) {
            const int c0 = c.lane * 4 + 256 * j;
            const f32x4 g2 = *(const f32x4*)(m + 5120 + c0), n3 = *(const f32x4*)(ngl + 3 * D + c0);
            x[j].x += g2.x * (y[j].x * rstd_y * n3.x); x[j].y += g2.y * (y[j].y * rstd_y * n3.y);
            x[j].z += g2.z * (y[j].z * rstd_y * n3.z); x[j].w += g2.w * (y[j].w * rstd_y * n3.w);
            if (layer == 0) { u32x2 xo; xo.x = pk2(x[j][0], x[j][1]); xo.y = pk2(x[j][2], x[j][3]); *(u32x2*)(X + (size_t)r * D + c0) = xo; x[j] = (f32x4){bflo(xo.x), bfhi(xo.x), bflo(xo.y), bfhi(xo.y)}; }
            else *(f32x4*)(c.a->out + (size_t)(r - C) * D + c0) = x[j];
        }
        if (layer == 0) {
            const float rstd_x = rsqrtf(row_ss(x) * (1.f / D) + EPS);
            const float* m1 = c.modp(1, r < C ? 1 : 0); const float* g0 = c.a->in[6] + 4 * D;
#pragma unroll
            for (int j = 0; j < 4; ++j) {
                const int c0 = c.lane * 4 + 256 * j;
                const f32x4 gv = *(const f32x4*)(g0 + c0), shv = *(const f32x4*)(m1 + c0), scv = *(const f32x4*)(m1 + 1024 + c0);
                const f32x4 hv = x[j] * rstd_x * gv * (scv + 1.f) + shv;
                *(unsigned*)(c.ws + WS_H8 + (size_t)r * D + c0) = pk4_fp8(hv[0] * F8_SH, hv[1] * F8_SH, hv[2] * F8_SH, hv[3] * F8_SH);
            }
        }
    }
#undef CB_TK
#undef CB_DATA
}

namespace hg {
typedef _Float16 h2_t __attribute__((ext_vector_type(2)));
constexpr int TB = 272, PB = 144;
constexpr int TILE = 64 * TB;
constexpr int T_QD = 0, T_QC = TILE, T_KD = 2 * TILE, T_KE = 3 * TILE, T_KC = 4 * TILE, T_V0 = 5 * TILE, T_V1 = 6 * TILE;
constexpr int T_QL1 = 7 * TILE, T_KL1 = T_QL1 + 16 * TB, T_P = T_KL1 + 16 * TB, T_TOT = T_P + 64 * PB, T_CT = T_TOT + 4096, T_END = T_CT + 512;
static_assert(T_END <= LDS_BYTES - 64, "hgrn scan LDS map");
__device__ __forceinline__ int row_of(int dir, int p) { return p < C ? (dir ? C - 1 - p : p) : (dir ? C + (L - 1 - (p - C)) : p); }
__device__ __forceinline__ int seg_of(int ch) { return ch < 68 ? ch / 17 : 4 + (ch - 68) / 16; }
__device__ __forceinline__ bf16x8 tr_frag(const LAS unsigned char* tile, int row0, int col0, int lane) {
    const int q = (lane & 15) >> 2, p = lane & 3;
    const LAS unsigned char* a = tile + (row0 + q) * TB + (col0 + 4 * p) * 2;
    const v4i16_t lo = __builtin_amdgcn_ds_read_tr16_b64_v4i16((LAS v4i16_t*)a);
    const v4i16_t hi = __builtin_amdgcn_ds_read_tr16_b64_v4i16((LAS v4i16_t*)(a + 4 * TB));
    return (bf16x8){lo[0], lo[1], lo[2], lo[3], hi[0], hi[1], hi[2], hi[3]};
}
}

__device__ __forceinline__ void phase_hgrn_scan(const Ctx& c) {
    using namespace hg;
#define HG_BAR() asm volatile("s_waitcnt lgkmcnt(0)\n\ts_barrier" ::: "memory")
    const bf16_t* QH = (const bf16_t*)(c.ws + WS_QH); const bf16_t* IV = (const bf16_t*)(c.ws + WS_IV);
    LAS unsigned char* lds = c.lds;
    const int tid = c.tid, lane = c.lane, w = __builtin_amdgcn_readfirstlane(tid >> 6), fr = lane & 15, g = lane >> 4;
    for (int item_ = c.wg; item_ < 256 * SCAN_REP; item_ += c.nwg) {
        const int item = item_ & 255;
        const int chain = item >> 4, seg = item & 15, head = chain >> 1, dir = chain & 1, hc = head * 128;
        const int c0 = seg < 4 ? 17 * seg : 68 + 16 * (seg - 4), nch = seg < 4 ? 17 : 16;
        const _Float16* KX = (const _Float16*)(c.ws + (dir ? WS_KB : WS_KF));
        bf16_t* OL = (bf16_t*)(c.ws + (dir ? WS_OB : WS_OF)); bf16_t* QS = (bf16_t*)(c.ws + (dir ? WS_QSB : WS_QSF));
        HG_BAR();
        for (int i = tid; i < 64 * PB / 4; i += 512) ((LAS unsigned*)(lds + T_P))[i] = 0u;
        f32x4 Sacc[8];
#pragma unroll
        for (int m = 0; m < 8; ++m) Sacc[m] = (f32x4){0.f, 0.f, 0.f, 0.f};
        float dseg0 = 1.f, dseg1 = 1.f;
        unsigned kraw[8], qraw[8]; u32x4 vraw[2];
#define HG_LOAD(cidx) do { const int p0_ = 64 * (cidx); const bool lat_ = (cidx) >= 4; \
        _Pragma("unroll") for (int i = 0; i < 8; ++i) { const int r_ = row_of(dir, p0_ + 8 * w + i); \
            kraw[i] = *(const unsigned*)(KX + (size_t)r_ * D + hc + 2 * lane); \
            qraw[i] = lat_ ? *(const unsigned*)(QH + (size_t)(r_ - C) * D + hc + 2 * lane) : 0u; } \
        _Pragma("unroll") for (int i = 0; i < 2; ++i) { const int idx_ = tid + 512 * i; const int r_ = row_of(dir, p0_ + (idx_ >> 4)); \
            vraw[i] = *(const u32x4*)(IV + (size_t)r_ * D + hc + (idx_ & 15) * 8); } } while (0)
        HG_LOAD(c0);
        for (int ci = 0; ci < nch; ++ci) {
            const int cidx = c0 + ci; const bool lat = cidx >= 4;
            const int vbuf = (ci & 1) ? T_V1 : T_V0;
            float kf[8][2], qf[8][2], cp[8][2];
            {
                float p0 = 1.f, p1 = 1.f;
#pragma unroll
                for (int i = 0; i < 8; ++i) {
                    const h2_t hv = __builtin_bit_cast(h2_t, kraw[i]);
                    kf[i][0] = (float)hv[0]; kf[i][1] = (float)hv[1];
                    qf[i][0] = bflo(qraw[i]); qf[i][1] = bfhi(qraw[i]);
                    p0 *= (1.f - kf[i][0]); p1 *= (1.f - kf[i][1]); cp[i][0] = p0; cp[i][1] = p1;
                }
                *(LAS f32x2*)(lds + T_TOT + (w * 128 + 2 * lane) * 4) = (f32x2){p0, p1};
#pragma unroll
                for (int i = 0; i < 2; ++i) { const int idx = tid + 512 * i; *(LAS u32x4*)(lds + vbuf + (idx >> 4) * TB + (idx & 15) * 16) = vraw[i]; }
            }
            HG_BAR();
            {
                f32x2 T[8];
#pragma unroll
                for (int x = 0; x < 8; ++x) T[x] = *(const LAS f32x2*)(lds + T_TOT + (x * 128 + 2 * lane) * 4);
                const int I = w >> 1, hh = w & 1;
                f32x2 bd[4];
#pragma unroll
                for (int x = 0; x < 4; ++x) bd[x] = T[2 * x] * T[2 * x + 1];
                f32x2 pre = (f32x2){1.f, 1.f}, cum = (f32x2){1.f, 1.f}, suf = (f32x2){1.f, 1.f}, bdI = (f32x2){1.f, 1.f};
#pragma unroll
                for (int x = 0; x < 8; ++x) if (hh && x == w - 1) pre = T[x];
#pragma unroll
                for (int x = 0; x < 4; ++x) { if (x < I) cum = cum * bd[x]; if (x > I) suf = suf * bd[x]; if (x == I) bdI = bd[x]; }
                const f32x2 ctot = (bd[0] * bd[1]) * (bd[2] * bd[3]);
#pragma unroll
                for (int i = 0; i < 8; ++i) {
                    const int tau = 8 * w + i;
                    float QDv[2], KDv[2], KEv[2], QCv[2], KCv[2];
#pragma unroll
                    for (int x = 0; x < 2; ++x) {
                        const float eq = pre[x] * cp[i][x], rc = __builtin_amdgcn_rcpf(eq);
                        QDv[x] = qf[i][x] * eq; KDv[x] = kf[i][x] * rc; KEv[x] = KDv[x] * bdI[x]; QCv[x] = QDv[x] * cum[x]; KCv[x] = KEv[x] * suf[x];
                    }
                    const int to = tau * TB + lane * 4;
                    *(LAS unsigned*)(lds + T_QD + to) = pk2(QDv[0], QDv[1]);
                    *(LAS unsigned*)(lds + T_KD + to) = pk2(KDv[0], KDv[1]);
                    *(LAS unsigned*)(lds + T_KE + to) = pk2(KEv[0], KEv[1]);
                    *(LAS unsigned*)(lds + T_QC + to) = pk2(QCv[0], QCv[1]);
                    *(LAS unsigned*)(lds + T_KC + to) = pk2(KCv[0], KCv[1]);
                    if (I == 3) *(LAS unsigned*)(lds + T_QL1 + (tau - 48) * TB + lane * 4) = pk2(QDv[0] * bd[2][0], QDv[1] * bd[2][1]);
                    if (I == 0) *(LAS unsigned*)(lds + T_KL1 + tau * TB + lane * 4) = pk2(KEv[0] * bd[1][0], KEv[1] * bd[1][1]);
                    if (lat) { const int r = row_of(dir, 64 * cidx + tau); *(unsigned*)(QS + (size_t)(r - C) * D + hc + 2 * lane) = pk2(QCv[0] * dseg0, QCv[1] * dseg1); }
                }
                dseg0 *= ctot[0]; dseg1 *= ctot[1];
                if (w == 0) *(LAS f32x2*)(lds + T_CT + lane * 8) = ctot;
            }
            HG_BAR();
            if (ci + 1 < nch) HG_LOAD(cidx + 1);
            if (lat) {
                const int nblk = w >= 6 ? 2 : 1;
                for (int b = 0; b < nblk; ++b) {
                    int I, J, qoff, qrow, koff, krow; bool diag = false;
                    if (w < 4) { I = 2 + (w >> 1); J = w & 1; qoff = (w >> 1) ? T_QL1 : T_QD; qrow = (w >> 1) ? 0 : 32; koff = (w & 1) ? T_KE : T_KL1; krow = (w & 1) ? 16 : 0; }
                    else if (w == 4) { I = 1; J = 0; qoff = T_QD; qrow = 16; koff = T_KE; krow = 0; }
                    else if (w == 5) { I = 3; J = 2; qoff = T_QD; qrow = 48; koff = T_KE; krow = 32; }
                    else { I = 2 * (w - 6) + b; J = I; qoff = T_QD; qrow = 16 * I; koff = T_KD; krow = 16 * I; diag = true; }
                    f32x4 pa = (f32x4){0.f, 0.f, 0.f, 0.f};
#pragma unroll
                    for (int ks = 0; ks < 4; ++ks) {
                        const bf16x8 av = *(const LAS bf16x8*)(lds + qoff + (qrow + fr) * TB + (32 * ks + 8 * g) * 2);
                        const bf16x8 bv = *(const LAS bf16x8*)(lds + koff + (krow + fr) * TB + (32 * ks + 8 * g) * 2);
                        pa = __builtin_amdgcn_mfma_f32_16x16x32_bf16(av, bv, pa, 0, 0, 0);
                    }
#pragma unroll
                    for (int e = 0; e < 4; ++e) {
                        const int tl = 4 * g + e; const float val = (diag && fr > tl) ? 0.f : pa[e];
                        *(LAS bf16_t*)(lds + T_P + (16 * I + tl) * PB + (16 * J + fr) * 2) = (bf16_t)f2bf(val);
                    }
                }
            }
            f32x4 oacc[4];
#pragma unroll
            for (int m = 0; m < 4; ++m) oacc[m] = (f32x4){0.f, 0.f, 0.f, 0.f};
            if (lat) {
                bf16x8 Sb[4];
#pragma unroll
                for (int ks = 0; ks < 4; ++ks) {
                    const f32x4 a0 = Sacc[2 * ks], a1 = Sacc[2 * ks + 1];
                    const u32x4 pk = (u32x4){pk2(a0[0], a0[1]), pk2(a0[2], a0[3]), pk2(a1[0], a1[1]), pk2(a1[2], a1[3])};
                    Sb[ks] = __builtin_bit_cast(bf16x8, pk);
                }
#pragma unroll
                for (int m = 0; m < 4; ++m)
#pragma unroll
                    for (int ks = 0; ks < 4; ++ks) {
                        const u32x2 lo = *(const LAS u32x2*)(lds + T_QC + (16 * m + fr) * TB + (32 * ks + 4 * g) * 2);
                        const u32x2 hi = *(const LAS u32x2*)(lds + T_QC + (16 * m + fr) * TB + (32 * ks + 16 + 4 * g) * 2);
                        const u32x4 pk = (u32x4){lo.x, lo.y, hi.x, hi.y};
                        oacc[m] = __builtin_amdgcn_mfma_f32_16x16x32_bf16(__builtin_bit_cast(bf16x8, pk), Sb[ks], oacc[m], 0, 0, 0);
                    }
            }
#pragma unroll
            for (int m = 0; m < 8; ++m) { const f32x4 ct = *(const LAS f32x4*)(lds + T_CT + (16 * m + 4 * g) * 4); Sacc[m] = Sacc[m] * ct; }
            bf16x8 Vf[2];
#pragma unroll
            for (int ks = 0; ks < 2; ++ks) Vf[ks] = tr_frag(lds + vbuf, 32 * ks + 8 * g, 16 * w, lane);
#pragma unroll
            for (int m = 0; m < 8; ++m)
#pragma unroll
                for (int ks = 0; ks < 2; ++ks) Sacc[m] = __builtin_amdgcn_mfma_f32_16x16x32_bf16(tr_frag(lds + T_KC, 32 * ks + 8 * g, 16 * m, lane), Vf[ks], Sacc[m], 0, 0, 0);
            HG_BAR();
            if (lat) {
#pragma unroll
                for (int m = 0; m < 4; ++m)
#pragma unroll
                    for (int ks = 0; ks < 2; ++ks) {
                        if (m < 2 && ks == 1) continue;
                        const bf16x8 av = *(const LAS bf16x8*)(lds + T_P + (16 * m + fr) * PB + (32 * ks + 8 * g) * 2);
                        oacc[m] = __builtin_amdgcn_mfma_f32_16x16x32_bf16(av, Vf[ks], oacc[m], 0, 0, 0);
                    }
#pragma unroll
                for (int m = 0; m < 4; ++m)
#pragma unroll
                    for (int e = 0; e < 4; ++e) { const int r = row_of(dir, 64 * cidx + 16 * m + 4 * g + e); OL[(size_t)(r - C) * D + hc + 16 * w + fr] = (bf16_t)f2bf(oacc[m][e]); }
            }
        }
#undef HG_LOAD
        float* DS = (float*)(c.ws + WS_DS) + (size_t)item * 16384; float* DG = (float*)(c.ws + WS_DG) + item * 128;
#pragma unroll
        for (int m = 0; m < 8; ++m)
#pragma unroll
            for (int e = 0; e < 4; ++e) DS[(16 * m + 4 * g + e) * 128 + 16 * w + fr] = Sacc[m][e];
        if (w == 0) { DG[2 * lane] = dseg0; DG[2 * lane + 1] = dseg1; }
    }
}

#undef HG_BAR
__device__ __forceinline__ void phase_hgrn_fold(const Ctx& c) {
    const float* DS = (const float*)(c.ws + WS_DS); const float* DG = (const float*)(c.ws + WS_DG); bf16_t* SST = (bf16_t*)(c.ws + WS_SST);
    for (int item = c.wg; item < 256; item += c.nwg) {
        const int chain = item >> 4, slice = item & 15, d = 8 * slice + (c.tid >> 6), v2 = (c.tid & 63) * 2;
        float s0 = 0.f, s1 = 0.f;
        float dv[15]; f32x2 ds[15];
#pragma unroll
        for (int sgi = 0; sgi < 15; ++sgi) { dv[sgi] = DG[(chain * 16 + sgi) * 128 + d]; ds[sgi] = *(const f32x2*)(DS + ((size_t)(chain * 16 + sgi) * 128 + d) * 128 + v2); }
        SST[((size_t)(chain * 16) * 128 + v2) * 128 + d] = 0; SST[((size_t)(chain * 16) * 128 + v2 + 1) * 128 + d] = 0;
#pragma unroll
        for (int sgi = 0; sgi < 15; ++sgi) {
            s0 = dv[sgi] * s0 + ds[sgi][0]; s1 = dv[sgi] * s1 + ds[sgi][1];
            SST[((size_t)(chain * 16 + sgi + 1) * 128 + v2) * 128 + d] = (bf16_t)f2bf(s0); SST[((size_t)(chain * 16 + sgi + 1) * 128 + v2 + 1) * 128 + d] = (bf16_t)f2bf(s1);
        }
    }
}

__device__ __forceinline__ void phase_hgrn_readout(const Ctx& c) {
    constexpr int SP = 272, SBUF = 128 * SP, IBUF = 2 * SBUF;
    static_assert(2 * IBUF + 1024 <= LDS_BYTES - 64, "readout LDS map");
    const bf16_t* OF = (const bf16_t*)(c.ws + WS_OF); const bf16_t* OB = (const bf16_t*)(c.ws + WS_OB); const bf16_t* SGp = (const bf16_t*)(c.ws + WS_SG);
    const bf16_t* SST = (const bf16_t*)(c.ws + WS_SST); bf16_t* RR = (bf16_t*)(c.ws + WS_RR); const float* hng = c.a->in[13];
    LAS unsigned char* lds = c.lds; LAS float* ssx = (LAS float*)(c.lds + 2 * IBUF);
    const int tid = c.tid, lane = c.lane, w = __builtin_amdgcn_readfirstlane(tid >> 6), fr = lane & 15, g = lane >> 4, mt = w & 3, nh = w >> 2;
#define RO_BAR() asm volatile("s_waitcnt lgkmcnt(0)\n\ts_barrier" ::: "memory")
    u32x4 sreg[8];
#define RO_SST_LOAD(it) do { const int h_ = (it) >> 8, ch_ = (it) & 255; \
        _Pragma("unroll") for (int j = 0; j < 8; ++j) { const int idx_ = tid + 512 * j, dx_ = idx_ >> 11, rem_ = idx_ & 2047; \
            const int sg_ = hg::seg_of(dx_ ? 4 + 255 - ch_ : 4 + ch_); \
            sreg[j] = *(const u32x4*)(SST + ((size_t)((h_ * 2 + dx_) * 16 + sg_) * 128 + (rem_ >> 4)) * 128 + (rem_ & 15) * 8); } } while (0)
#define RO_SST_WRITE(buf) do { _Pragma("unroll") for (int j = 0; j < 8; ++j) { const int idx_ = tid + 512 * j, dx_ = idx_ >> 11, rem_ = idx_ & 2047; \
            *(LAS u32x4*)(lds + (buf) * IBUF + dx_ * SBUF + (rem_ >> 4) * SP + (rem_ & 15) * 16) = sreg[j]; } } while (0)
    int it = c.wg;
    RO_BAR();
    if (it < 2048) { RO_SST_LOAD(it); RO_SST_WRITE(0); }
    RO_BAR();
    for (int k = 0; it < 2048; it += c.nwg, ++k) {
        const int h = it >> 8, ch = it & 255, t0 = 64 * ch + 16 * mt, buf = k & 1;
        const bool has_next = it + c.nwg < 2048;
        if (has_next) RO_SST_LOAD(it + c.nwg);
        f32x4 acc[4]; float sgv[4][4];
#pragma unroll
        for (int n = 0; n < 4; ++n)
#pragma unroll
            for (int e = 0; e < 4; ++e) { const size_t o = (size_t)(t0 + 4 * g + e) * D + h * 128 + 64 * nh + 16 * n + fr; acc[n][e] = bf2f(OF[o]) + bf2f(OB[o]); sgv[n][e] = bf2f(SGp[o]) * hng[h * 128 + 64 * nh + 16 * n + fr]; }
#pragma unroll
        for (int dx = 0; dx < 2; ++dx) {
            const bf16_t* QS = (const bf16_t*)(c.ws + (dx ? WS_QSB : WS_QSF)) + (size_t)(t0 + fr) * D + h * 128 + 8 * g;
            const LAS unsigned char* sb = lds + buf * IBUF + dx * SBUF + (64 * nh + fr) * SP + 16 * g;
#pragma unroll
            for (int ks = 0; ks < 4; ++ks) {
                const bf16x8 av = *(const bf16x8*)(QS + 32 * ks);
#pragma unroll
                for (int n = 0; n < 4; ++n) acc[n] = __builtin_amdgcn_mfma_f32_16x16x32_bf16(av, *(const LAS bf16x8*)(sb + (16 * n) * SP + 64 * ks), acc[n], 0, 0, 0);
            }
        }
        float ss[4] = {0.f, 0.f, 0.f, 0.f};
#pragma unroll
        for (int n = 0; n < 4; ++n)
#pragma unroll
            for (int e = 0; e < 4; ++e) ss[e] += acc[n][e] * acc[n][e];
#pragma unroll
        for (int e = 0; e < 4; ++e) {
#pragma unroll
            for (int sh = 8; sh > 0; sh >>= 1) ss[e] += __shfl_xor(ss[e], sh);
        }
        if (fr == 0) *(LAS f32x4*)(ssx + ((k & 1) * 8 + w) * 16 + 4 * g) = (f32x4){ss[0], ss[1], ss[2], ss[3]};
        if (has_next) RO_SST_WRITE(buf ^ 1);
        RO_BAR();
        const f32x4 ps = *(const LAS f32x4*)(ssx + ((k & 1) * 8 + (w ^ 4)) * 16 + 4 * g);
#pragma unroll
        for (int e = 0; e < 4; ++e) ss[e] = rsqrtf((ss[e] + ps[e]) * (1.f / 128.f) + EPS);
#pragma unroll
        for (int n = 0; n < 4; ++n)
#pragma unroll
            for (int e = 0; e < 4; ++e) { const size_t o = (size_t)(t0 + 4 * g + e) * D + h * 128 + 64 * nh + 16 * n + fr; RR[o] = (bf16_t)f2bf(acc[n][e] * ss[e] * sgv[n][e]); }
    }
    RO_BAR();
#undef RO_BAR
#undef RO_SST_LOAD
#undef RO_SST_WRITE
}

#define XB_TMO      128
#define XB_XCNT(j)  (256  + 64 * (j))
#define XB_XSUB(j)  (1280 + 64 * (j))
#define XB_XGEN(j)  (2304 + 64 * (j))
#define XB_TOP      3328
#define XB_TOPGEN   3392
#define XCD_BAR_WORDS 3456
#define XB_SPIN_CAP (1u << 18)
__device__ __forceinline__ unsigned xb_ld(unsigned* p)              { return __hip_atomic_load(p, __ATOMIC_RELAXED, __HIP_MEMORY_SCOPE_AGENT); }
__device__ __forceinline__ unsigned xb_add(unsigned* p, unsigned v) { return __hip_atomic_fetch_add(p, v, __ATOMIC_RELAXED, __HIP_MEMORY_SCOPE_AGENT); }
__device__ __forceinline__ unsigned xb_xcc_id() { return (unsigned)__builtin_amdgcn_s_getreg((3 << 11) | 20) & 0xFu; }
#define XB_SPIN(cond, bar) do { unsigned _sp = 0; while (cond) { __builtin_amdgcn_s_sleep(1); \
    if ((++_sp & 255u) == 0u) { if (xb_ld(&(bar)[XB_TMO])) break; if (_sp > XB_SPIN_CAP) { atomicAdd(&(bar)[XB_TMO], 1u); break; } } } } while (0)
struct XcdBarrier { unsigned* bar; unsigned x; volatile LAS unsigned* st; };
__device__ __forceinline__ XcdBarrier xcd_barrier_post(unsigned* bar, volatile LAS unsigned* st) {
    XcdBarrier b; b.bar = bar; b.x = xb_xcc_id(); b.st = st;
    if (threadIdx.x == 0) (void)xb_add(&bar[XB_XCNT(b.x)], 1u);
    return b;
}
__device__ __forceinline__ void xcd_barrier_complete(unsigned* bar, unsigned x, unsigned& nloc, unsigned& nx) {
    const unsigned G = gridDim.x * gridDim.y * gridDim.z;
    unsigned sum, cnt, mine, sp = 0u;
    for (;;) {
        sum = 0u; cnt = 0u; mine = 0u;
#pragma unroll
        for (unsigned j = 0; j < 16; ++j) { const unsigned c = xb_ld(&bar[XB_XCNT(j)]); sum += c; cnt += (c > 0u) ? 1u : 0u; mine = (j == x) ? c : mine; }
        if (sum == G) break;
        __builtin_amdgcn_s_sleep(1);
        if ((++sp & 255u) == 0u) { if (xb_ld(&bar[XB_TMO])) break; if (sp > XB_SPIN_CAP) { atomicAdd(&bar[XB_TMO], 1u); break; } }
    }
    nloc = mine > 0u ? mine : 1u; nx = cnt > 0u ? cnt : 1u;
}
__device__ __forceinline__ void xcd_barrier(const XcdBarrier& b) {
    asm volatile("s_waitcnt vmcnt(0)" ::: "memory");
    __syncthreads();
    if (threadIdx.x == 0) {
        unsigned* bar = b.bar;
        __builtin_amdgcn_s_waitcnt(0);
        unsigned nloc = b.st[0], nx = b.st[1];
        if (nloc == 0u) { xcd_barrier_complete(bar, b.x, nloc, nx); b.st[0] = nloc; b.st[1] = nx; }
        const unsigned old = xb_add(&bar[XB_XSUB(b.x)], 1u);
        const unsigned gen = old / nloc;
        if (old + 1u == (gen + 1u) * nloc) {
            __builtin_amdgcn_fence(__ATOMIC_RELEASE, "agent");
            asm volatile("s_waitcnt vmcnt(0)" ::: "memory");
            const unsigned og = xb_add(&bar[XB_TOP], 1u);
            const unsigned tg = og / nx;
            if (og + 1u == (tg + 1u) * nx) xb_add(&bar[XB_TOPGEN], 1u);
            else XB_SPIN(xb_ld(&bar[XB_TOPGEN]) == tg, bar);
            __builtin_amdgcn_fence(__ATOMIC_ACQUIRE, "agent");
            xb_add(&bar[XB_XGEN(b.x)], 1u);
            asm volatile("s_waitcnt vmcnt(0)" ::: "memory");
        } else {
            XB_SPIN(xb_ld(&bar[XB_XGEN(b.x)]) == gen, bar);
            __builtin_amdgcn_fence(__ATOMIC_ACQUIRE, "agent");
            asm volatile("s_waitcnt vmcnt(0)" ::: "memory");
        }
    }
    __syncthreads();
}

__device__ __forceinline__ void launder(Ctx& c) { asm volatile("" : "+s"(c.a)); asm volatile("" : "+s"(c.ws)); asm volatile("" : "+s"(c.wave));
    c.lane = (int)__builtin_amdgcn_mbcnt_hi(~0u, __builtin_amdgcn_mbcnt_lo(~0u, 0u)); c.tid = c.wave * 64 + c.lane; }
__global__ void __launch_bounds__(512, 2) mk_fwd(Args args) {
    extern __shared__ __attribute__((aligned(16))) unsigned char lds_raw[];
    Ctx c; c.a = (CArgs)__builtin_amdgcn_kernarg_segment_ptr(); c.lds = (LAS unsigned char*)lds_raw; c.tid = threadIdx.x; c.lane = c.tid & 63; c.wave = __builtin_amdgcn_readfirstlane(c.tid >> 6); c.nwg = gridDim.x; c.wg = blockIdx.x; c.ws = c.a->ws;
    volatile LAS unsigned* bst = (volatile LAS unsigned*)(c.lds + LDS_BYTES - 64);
    if (c.tid < 4) bst[c.tid] = 0u;
    __syncthreads();
    const XcdBarrier bar = xcd_barrier_post((unsigned*)(c.ws + WS_CTL) + CW_BAR, bst);
    const int lo = c.a->ph_lo, hi = c.a->ph_hi;
    bool route_ok = true;
#define SEAM(k) do { if (lo <= (k) && (k) + 1 < hi) xcd_barrier(bar); } while (0)
#define IN(k) (lo <= (k) && (k) < hi && (launder(c), true))
#define PH(k, call) do { if (IN(k)) { if (PROBE_PH == (k)) { int nrep_ = 3; asm volatile("" : "+s"(nrep_)); for (int rep_ = 0; rep_ < nrep_; ++rep_) { route_ok = (rep_ + 1 == nrep_); call; if (rep_ + 1 < nrep_) xcd_barrier(bar); } } else { call; } } SEAM(k); } while (0)
    PH(0, phase_prep(c));
    PH(1, phase_convert(c));
    PH(2, phase_gemm_qkv(c));
    PH(3, phase_attn(c));
    PH(4, phase_gemm_f32(c, (const bf16_t*)(c.ws + WS_O), R, (const bf16_t*)(c.ws + WS_WO), D, nullptr, (bf16_t*)(c.ws + WS_RAW1)));
    PH(5, { phase_postmix<128>(c, 0, route_ok); convert_steal(c, 1); });
    PH(6, phase_moe_gu(c, 0));
    PH(7, phase_moe_dn(c, 0));
    PH(8, phase_combine(c, 0));
    PH(9, phase_gemm_inproj(c));
    PH(10, phase_hgrn_scan(c));
    PH(11, phase_hgrn_fold(c));
    PH(12, phase_hgrn_readout(c));
    PH(13, phase_gemm_f32(c, (const bf16_t*)(c.ws + WS_RR), L, (const bf16_t*)(c.ws + WS_WHO), D, nullptr, (bf16_t*)(c.ws + WS_RAW1)));
    PH(14, { phase_postmix<128>(c, 1, route_ok); convert_steal(c, 2); });
    PH(15, phase_moe_gu(c, 1));
    PH(16, phase_moe_dn(c, 1));
    PH(17, phase_combine(c, 1));
#undef IN
#undef PH
#undef SEAM
}

extern "C" void kernel_launch(void* const* d_in, const int* in_sizes, int n_in, void* d_out, int out_size, void* d_ws, size_t ws_size, hipStream_t stream) {
    static int grid = 0;
    if (grid == 0) {
        if (n_in != 21 || out_size != L * D || ws_size < WS_END) { fprintf(stderr, "kernel_launch: unexpected problem (n_in %d out %d ws %zu need %zu)\n", n_in, out_size, ws_size, (size_t)WS_END); grid = -1; return; }
        int dev = 0, cus = 0, per_cu = 0;
        hipGetDevice(&dev); hipDeviceGetAttribute(&cus, hipDeviceAttributeMultiprocessorCount, dev);
        if (hipFuncSetAttribute((const void*)mk_fwd, hipFuncAttributeMaxDynamicSharedMemorySize, LDS_BYTES) != hipSuccess) { fprintf(stderr, "kernel_launch: hipFuncSetAttribute failed\n"); grid = -1; return; }
        hipOccupancyMaxActiveBlocksPerMultiprocessor(&per_cu, (const void*)mk_fwd, 512, LDS_BYTES);
        if (per_cu < 1) fprintf(stderr, "kernel_launch: occupancy query says %d\n", per_cu);
        (void)hipGetLastError();
        grid = cus > 0 ? cus : 256;
    }
    if (grid < 0) return;
    hipMemsetAsync((char*)d_ws + WS_CTL, 0, MiB, stream);
    Args a{};
    for (int i = 0; i < 21; ++i) a.in[i] = (const float*)d_in[i];
    a.out = (float*)d_out; a.ws = (unsigned char*)d_ws;
    a.ph_lo = 0; a.ph_hi = NPHASE;
    hipLaunchKernelGGL(mk_fwd, dim3(grid), dim3(512), LDS_BYTES, stream, a);
}
```

```cpp
#include <hip/hip_runtime.h>
#include <cstdint>
#include <cstdio>

#define LAS __attribute__((address_space(3)))
typedef unsigned short bf16_t;
typedef short bf16x8 __attribute__((ext_vector_type(8)));
typedef float f32x4 __attribute__((ext_vector_type(4)));
typedef unsigned u32x4 __attribute__((ext_vector_type(4)));
typedef unsigned u32x2 __attribute__((ext_vector_type(2)));
typedef short v4i16_t __attribute__((ext_vector_type(4)));
typedef float f32x2 __attribute__((ext_vector_type(2)));

constexpr int D = 1024, L = 16384, C = 256, R = L + C;
constexpr int QKVD = 1280, HIN = 5120, NE = 32, TOPK = 4;
constexpr int PADM = 256, MAXROWS = 74752;
constexpr float EPS = 1e-6f;
constexpr float LOG2E = 1.4426950408889634f;
constexpr int NPHASE = 18;
#ifndef GEMM_REP
#define GEMM_REP 1
#endif
#ifndef PROBE_NOEPI
#define PROBE_NOEPI 0
#endif
#ifndef PROBE_SHORTK
#define PROBE_SHORTK 0
#endif
#ifndef SCAN_REP
#define SCAN_REP 1
#endif
#ifndef PROBE_PH
#define PROBE_PH (-1)
#endif
constexpr int LDS_BYTES = 147456;

constexpr size_t MiB = 1u << 20;
constexpr size_t al(size_t x) { return (x + MiB - 1) / MiB * MiB; }
constexpr size_t WS_CTL = 0;
constexpr size_t WS_MOD = WS_CTL + MiB;
constexpr size_t WS_X = WS_MOD + MiB;
constexpr size_t WS_H = WS_X + al((size_t)R * D * 4);
constexpr size_t WS_Q = WS_H + al((size_t)R * D * 2);
constexpr size_t WS_K = WS_Q + al((size_t)R * D * 2);
constexpr size_t WS_V = WS_K + al((size_t)R * 128 * 2);
constexpr size_t WS_O = WS_V + al((size_t)R * 128 * 2);
constexpr size_t WS_TK = WS_O + al((size_t)R * D * 2);
constexpr size_t WS_LIST = WS_TK + MiB;
constexpr size_t WS_HDN = WS_LIST + 3 * MiB;
constexpr size_t WS_RAW1 = WS_HDN + al((size_t)MAXROWS * 1024 * 2);
constexpr size_t WS_X1 = WS_RAW1 + al((size_t)R * D * 4);
constexpr size_t WS_OUTB = WS_X1 + al((size_t)R * D * 4);
constexpr size_t WS_QH = WS_OUTB + al((size_t)MAXROWS * 1024 * 2);
constexpr size_t WS_KF = WS_QH + al((size_t)L * D * 2);
constexpr size_t WS_KB = WS_KF + al((size_t)R * D * 2);
constexpr size_t WS_IV = WS_KB + al((size_t)R * D * 2);
constexpr size_t WS_SG = WS_IV + al((size_t)R * D * 2);
constexpr size_t WS_OF = WS_SG + al((size_t)L * D * 2);
constexpr size_t WS_OB = WS_OF + al((size_t)L * D * 4);
constexpr size_t WS_RR = WS_OB + al((size_t)L * D * 4);
constexpr size_t WS_WQKV = WS_RR + al((size_t)L * D * 2);
constexpr size_t WS_WO = WS_WQKV + al((size_t)QKVD * D * 2);
constexpr size_t WS_WIN = WS_WO + al((size_t)D * D * 2);
constexpr size_t WS_WHO = WS_WIN + al((size_t)HIN * D * 2);
constexpr size_t WS_WGU = WS_WHO + al((size_t)D * D * 2);
constexpr size_t WS_WDN = WS_WGU + al((size_t)2 * NE * 2048 * D * 2);
constexpr size_t WS_QSF = WS_WDN + al((size_t)2 * NE * 1024 * D * 2);
constexpr size_t WS_QSB = WS_QSF + al((size_t)L * D * 2);
constexpr size_t WS_DS = WS_QSB + al((size_t)L * D * 2);
constexpr size_t WS_DG = WS_DS + al((size_t)256 * 128 * 128 * 4);
constexpr size_t WS_SST = WS_DG + MiB;
constexpr size_t WS_H8 = WS_SST + al((size_t)256 * 128 * 128 * 2);
constexpr size_t WS_END = WS_H8 + al((size_t)R * D);
static_assert(WS_END <= (size_t)2048 * MiB, "workspace map exceeds 4x the largest input");
constexpr int CW_CNT = 1024;
constexpr int CW_CONV = 2048;
constexpr int CW_BAR = 4096;
constexpr int MOD_ROPE = 32768;
constexpr int MOD_LB = 49152;

struct Args { const float* in[21]; float* out; unsigned char* ws; int ph_lo, ph_hi; };

__device__ __forceinline__ unsigned f2bf(float f) { unsigned u = __float_as_uint(f); return (u + 0x7fffu + ((u >> 16) & 1u)) >> 16; }
typedef float f32x2_t __attribute__((ext_vector_type(2))); typedef __bf16 bf16x2_t __attribute__((ext_vector_type(2)));
__device__ __forceinline__ unsigned pk2(float lo, float hi) { f32x2_t v = {lo, hi}; bf16x2_t b = __builtin_convertvector(v, bf16x2_t); return __builtin_bit_cast(unsigned, b); }
__device__ __forceinline__ unsigned pk4_fp8(float a, float b, float c, float d) {
    a = fminf(fmaxf(a, -448.f), 448.f); b = fminf(fmaxf(b, -448.f), 448.f); c = fminf(fmaxf(c, -448.f), 448.f); d = fminf(fmaxf(d, -448.f), 448.f);
    int v = __builtin_amdgcn_cvt_pk_fp8_f32(a, b, 0, false); v = __builtin_amdgcn_cvt_pk_fp8_f32(c, d, v, true); return (unsigned)v; }
constexpr float F8_SH = 8.f, F8_SW = 64.f, F8_SHD = 4.f, F8_SO = 16.f;
__device__ __forceinline__ float bflo(unsigned u) { return __uint_as_float(u << 16); }
__device__ __forceinline__ float bfhi(unsigned u) { return __uint_as_float(u & 0xffff0000u); }
__device__ __forceinline__ float bf2f(bf16_t b) { return __uint_as_float(((unsigned)b) << 16); }
__device__ __forceinline__ float wave_sum(float v) {
#pragma unroll
    for (int o = 32; o > 0; o >>= 1) v += __shfl_xor(v, o);
    return v;
}
__device__ __forceinline__ float silu_f(float x) { return x / (1.f + __expf(-x)); }
__device__ __forceinline__ float sigmoid_f(float x) { return 1.f / (1.f + __expf(-x)); }

typedef const __attribute__((address_space(4))) Args* CArgs;
struct Ctx {
    CArgs a;
    LAS unsigned char* lds;
    int tid, lane, wave, nwg, wg;
    unsigned char* ws;
    __device__ __forceinline__ float* modp(int layer, int which) const { return (float*)(ws + WS_MOD) + (layer * 2 + which) * 6144; }
    __device__ __forceinline__ const float* xin0(int r) const { return r < C ? a->in[2] + (size_t)r * D : a->in[0] + (size_t)(r - C) * D; }
};


namespace pg8 {
constexpr int BM = 256, BK = 64, HALF = 128, HTB = HALF * BK * 2, STAGE_BYTES = 8 * HTB, KD = 1024, NXCD = 8, WGM = 8;
__device__ __forceinline__ int lds_byte(int r, int c) { const int st = (r >> 4) * 2 + (c >> 5), rr = r & 15, cc = c & 31, ob = rr * 64 + cc * 2; return st * 1024 + (ob ^ (((ob >> 9) & 1) << 5)); }
__device__ __forceinline__ void stage_rc(int b, int& Rr, int& Cc) { const int st = b / 1024, sb = b % 1024, swz = sb ^ (((sb >> 9) & 1) << 5); Rr = (st >> 1) * 16 + swz / 64; Cc = (st & 1) * 32 + (swz % 64) / 2; }
__device__ __forceinline__ int perm32(int rho) { const int n = rho >> 4, i = rho & 15; return 8 * (i >> 2) + 4 * n + (i & 3); }

struct Unit { int pm, pn, e, goff, gcnt; bool real; int amask, bmask; };
struct Gemm { const void* A; const void* Bt; size_t bstride; const int* list; };

struct StaticOrder {
    int nM, nN, nwg, G, c;
    __device__ __forceinline__ void init(int M, int N, int G_, int c_) { nM = M / BM; nN = N / BM; nwg = nM * nN; G = G_; c = c_; }
    __device__ __forceinline__ bool next(int i, Unit& u) const {
        const int F = nwg / G, Rm = nwg - F * G; int Lq; u.amask = 3; u.bmask = 3;
        if (i < F) Lq = i * G + c;
        else if (i == F && Rm > 0) {
            if (4 * Rm <= G) { if (c >= 4 * Rm) return false; Lq = F * G + (c >> 2); u.amask = 1 << ((c >> 1) & 1); u.bmask = 1 << (c & 1); }
            else if (2 * Rm <= G) { if (c >= 2 * Rm) return false; Lq = F * G + (c >> 1); u.bmask = 1 << (c & 1); }
            else { if (c >= Rm) return false; Lq = F * G + c; }
        } else return false;
        int wgid = Lq; { const int q = nwg / NXCD, r = nwg % NXCD, xcd = wgid % NXCD, off = wgid / NXCD; wgid = (xcd < r ? xcd * (q + 1) : r * (q + 1) + (xcd - r) * q) + off; }
        const int nig = WGM * nN, gid = wgid / nig, fm = gid * WGM, gsz = (nM - fm) < WGM ? (nM - fm) : WGM;
        u.pm = fm + ((wgid % nig) % gsz); u.pn = (wgid % nig) / gsz; u.e = 0; u.goff = 0; u.gcnt = 0; u.real = true; return true;
    }
};
struct MoeOrder {
    const LAS int* tp; const LAS int* cnt; int npn, G, vcu; bool split;
    __device__ __forceinline__ bool next(int i, Unit& u) const {
        const int tot = tp[32] * npn; int lin; u.amask = 3; u.bmask = 3; u.real = true;
        if (GEMM_REP > 1) { const int lin0 = i * G + vcu; if (lin0 >= tot * GEMM_REP) return false; lin = lin0 % tot; u.real = lin0 >= tot * (GEMM_REP - 1); }
        else {
            const int F = tot / G, Rm = tot - F * G;
            if (i < F) lin = i * G + vcu;
            else if (i == F && Rm > 0) {
                if (split && 2 * Rm <= G) { if (vcu >= 2 * Rm) return false; lin = F * G + (vcu >> 1); u.bmask = 1 << (vcu & 1); }
                else { if (vcu >= Rm) return false; lin = F * G + vcu; }
            } else return false;
        }
        const int rt = lin / npn; int e = 0;
#pragma unroll 8
        for (int k = 1; k < 32; ++k) e += (rt >= tp[k]) ? 1 : 0;
        const int mt = rt - tp[e];
        u.pm = rt; u.pn = lin - rt * npn; u.e = e; u.goff = e * R + mt * 256; u.gcnt = cnt[e] - mt * 256; return true;
    }
};

template <int KB>
__device__ __forceinline__ void a_offsets(const Gemm& g, const Unit& u, const int (&sR)[2], const int (&sC)[2], unsigned (&v)[2][2]) {
#pragma unroll
    for (int h = 0; h < 2; ++h)
#pragma unroll
        for (int i = 0; i < 2; ++i) {
            const int rr = h * HALF + sR[i]; int row;
            if (g.list) row = rr < u.gcnt ? g.list[u.goff + rr] : 0; else row = u.pm * BM + rr;
            v[h][i] = (unsigned)(row * KB + sC[i] * 2);
        }
}

struct EpiF32 {
    static constexpr bool PERM = false;
    bf16_t* Cp; int ldc; const float* bias;
    __device__ __forceinline__ void operator()(const f32x4 (&acc)[2][2][4][2], const Unit& u, int wr, int wc, int fr, int fq) const {
        const int row0 = u.pm * BM + wr * 64 + fr, col0 = u.pn * BM + wc * 32 + 4 * fq;
#pragma unroll
        for (int bj = 0; bj < 2; ++bj)
#pragma unroll
            for (int n = 0; n < 2; ++n) {
                const int col = col0 + bj * HALF + n * 16;
                if (!((u.bmask >> bj) & 1)) continue;
                const f32x4 bv = bias ? *(const f32x4*)(bias + col) : (f32x4){0.f, 0.f, 0.f, 0.f};
#pragma unroll
                for (int ai = 0; ai < 2; ++ai)
#pragma unroll
                    for (int m = 0; m < 4; ++m) if ((u.amask >> ai) & 1) { const f32x4 v = acc[ai][bj][m][n] + bv; u32x2 o; o.x = pk2(v[0], v[1]); o.y = pk2(v[2], v[3]);
                        *(u32x2*)(Cp + (size_t)(row0 + ai * HALF + m * 16) * ldc + col) = o; }
            }
    }
};
struct EpiSwiglu {
    static constexpr bool PERM = true;
    unsigned char* Hd; const float* bgu;
    __device__ __forceinline__ void operator()(const f32x4 (&acc)[2][2][4][2], const Unit& u, int wr, int wc, int fr, int fq) const {
        const int row0 = u.pm * BM + wr * 64 + fr, cg0 = u.pn * HALF + wc * 32 + 8 * fq;
        const float* bb = bgu + (size_t)u.e * 2048;
        f32x4 bg[2], bu[2];
#pragma unroll
        for (int n = 0; n < 2; ++n) { bg[n] = *(const f32x4*)(bb + cg0 + 4 * n); bu[n] = *(const f32x4*)(bb + 1024 + cg0 + 4 * n); }
#pragma unroll
        for (int ai = 0; ai < 2; ++ai)
#pragma unroll
            for (int m = 0; m < 4; ++m) {
                u32x2 o;
#pragma unroll
                for (int n = 0; n < 2; ++n) {
                    const f32x4 gv = acc[ai][0][m][n] * (1.f / (F8_SH * F8_SW)) + bg[n], uv = acc[ai][1][m][n] * (1.f / (F8_SH * F8_SW)) + bu[n]; float hv[4];
#pragma unroll
                    for (int q = 0; q < 4; ++q) { const float gg = fminf(gv[q], 7.f), uu = fminf(fmaxf(uv[q], -7.f), 7.f); hv[q] = gg * __builtin_amdgcn_rcpf(1.f + __builtin_amdgcn_exp2f(-1.702f * LOG2E * gg)) * (uu + 1.f); }
                    o[n] = pk4_fp8(hv[0] * F8_SHD, hv[1] * F8_SHD, hv[2] * F8_SHD, hv[3] * F8_SHD);
                }
                *(u32x2*)(Hd + (size_t)(row0 + ai * HALF + m * 16) * 1024 + cg0) = o;
            }
    }
};
struct EpiBf16Bias {
    static constexpr bool PERM = true;
    unsigned char* Op; const float* bias; int bias_estride; float scale;
    __device__ __forceinline__ void operator()(const f32x4 (&acc)[2][2][4][2], const Unit& u, int wr, int wc, int fr, int fq) const {
        const int row0 = u.pm * BM + wr * 64 + fr, col0 = u.pn * BM + wc * 32 + 8 * fq;
        const float* bb = bias + (size_t)u.e * bias_estride;
#pragma unroll
        for (int bj = 0; bj < 2; ++bj) {
            const int col = col0 + bj * HALF;
            if (!((u.bmask >> bj) & 1)) continue;
            const f32x4 b0 = *(const f32x4*)(bb + col) * F8_SO, b1 = *(const f32x4*)(bb + col + 4) * F8_SO;
#pragma unroll
            for (int ai = 0; ai < 2; ++ai)
#pragma unroll
                for (int m = 0; m < 4; ++m) { if (!((u.amask >> ai) & 1)) continue; const f32x4 v0 = acc[ai][bj][m][0] * (scale * F8_SO) + b0, v1 = acc[ai][bj][m][1] * (scale * F8_SO) + b1;
                    u32x2 o; o.x = pk4_fp8(v0[0], v0[1], v0[2], v0[3]); o.y = pk4_fp8(v1[0], v1[1], v1[2], v1[3]);
                    *(u32x2*)(Op + (size_t)(row0 + ai * HALF + m * 16) * 1024 + col) = o; }
        }
    }
};
struct EpiQKV {
    static constexpr bool PERM = false;
    bf16_t* Qp; bf16_t* Kp; bf16_t* Vp; const float* bias; const float* tab;
    __device__ __forceinline__ void operator()(const f32x4 (&acc)[2][2][4][2], const Unit& u, int wr, int wc, int fr, int fq) const {
        const bool lat = u.pm > 0; const float qs = 0.125f * LOG2E;
#pragma unroll
        for (int bj = 0; bj < 2; ++bj) {
            const int colt = u.pn * BM + bj * HALF + wc * 32 + 4 * fq;
            const f32x4 b1 = *(const f32x4*)(bias + colt), b2 = *(const f32x4*)(bias + colt + 16);
            const bool isv = (u.pn == 4) && (bj == 1);
            if (!((u.bmask >> bj) & 1)) continue;
#pragma unroll
            for (int ai = 0; ai < 2; ++ai)
#pragma unroll
                for (int m = 0; m < 4; ++m) {
                    if (!((u.amask >> ai) & 1)) continue;
                    const int r = u.pm * BM + ai * HALF + wr * 64 + m * 16 + fr, t = r - C;
                    f32x4 x1 = acc[ai][bj][m][0] + b1, x2 = acc[ai][bj][m][1] + b2;
                    if (lat && !isv) {
                        const int pos = (wc & 1) ? (t & 63) : (t >> 6);
                        const f32x4 t0 = *(const f32x4*)(tab + (pos * 16 + 4 * fq) * 2), t1 = *(const f32x4*)(tab + (pos * 16 + 4 * fq) * 2 + 4);
                        const float cs[4] = {t0[0], t0[2], t1[0], t1[2]}, sn[4] = {t0[1], t0[3], t1[1], t1[3]};
                        f32x4 o1, o2;
#pragma unroll
                        for (int e = 0; e < 4; ++e) { o1[e] = x1[e] * cs[e] - x2[e] * sn[e]; o2[e] = x2[e] * cs[e] + x1[e] * sn[e]; }
                        x1 = o1; x2 = o2;
                    }
                    u32x2 w1, w2;
                    if (u.pn < 4) {
                        w1.x = pk2(x1[0] * qs, x1[1] * qs); w1.y = pk2(x1[2] * qs, x1[3] * qs); w2.x = pk2(x2[0] * qs, x2[1] * qs); w2.y = pk2(x2[2] * qs, x2[3] * qs);
                        *(u32x2*)(Qp + (size_t)r * 1024 + colt) = w1; *(u32x2*)(Qp + (size_t)r * 1024 + colt + 16) = w2;
                    } else {
                        w1.x = pk2(x1[0], x1[1]); w1.y = pk2(x1[2], x1[3]); w2.x = pk2(x2[0], x2[1]); w2.y = pk2(x2[2], x2[3]);
                        bf16_t* dst = (bj == 0 ? Kp : Vp) + (size_t)r * 128 + wc * 32 + 4 * fq;
                        *(u32x2*)dst = w1; *(u32x2*)(dst + 16) = w2;
                    }
                }
        }
    }
};
struct EpiInProj {
    static constexpr bool PERM = true;
    bf16_t* QH; _Float16* KF; _Float16* KB; bf16_t* IV; bf16_t* SG; const float* lb; float scale;
    __device__ __forceinline__ void operator()(const f32x4 (&acc)[2][2][4][2], const Unit& u, int wr, int wc, int fr, int fq) const {
        const int seg = u.pn >> 2; const bool lat = u.pm > 0;
        if (!lat && (seg == 0 || seg == 4)) return;
        typedef _Float16 h8_t __attribute__((ext_vector_type(8)));
#pragma unroll
        for (int bj = 0; bj < 2; ++bj) {
            const int col = (u.pn & 3) * BM + bj * HALF + wc * 32 + 8 * fq;
            if (!((u.bmask >> bj) & 1)) continue;
            f32x4 lb0 = (f32x4){0.f, 0.f, 0.f, 0.f}, lb1 = lb0;
            if (seg == 1) { lb0 = *(const f32x4*)(lb + col); lb1 = *(const f32x4*)(lb + col + 4); } else if (seg == 2) { lb0 = *(const f32x4*)(lb + 1024 + col); lb1 = *(const f32x4*)(lb + 1024 + col + 4); }
#pragma unroll
            for (int ai = 0; ai < 2; ++ai)
#pragma unroll
                for (int m = 0; m < 4; ++m) {
                    if (!((u.amask >> ai) & 1)) continue;
                    const int r = u.pm * BM + ai * HALF + wr * 64 + m * 16 + fr; const f32x4 v0 = acc[ai][bj][m][0] * scale, v1 = acc[ai][bj][m][1] * scale;
                    if (seg == 1 || seg == 2) {
                        h8_t hv;
#pragma unroll
                        for (int e = 0; e < 4; ++e) { hv[e] = (_Float16)((1.f - lb0[e]) * __builtin_amdgcn_rcpf(1.f + __builtin_amdgcn_exp2f(LOG2E * v0[e]))); hv[4 + e] = (_Float16)((1.f - lb1[e]) * __builtin_amdgcn_rcpf(1.f + __builtin_amdgcn_exp2f(LOG2E * v1[e]))); }
                        *(h8_t*)((seg == 1 ? KF : KB) + (size_t)r * 1024 + col) = hv;
                    } else if (seg == 3) {
                        u32x4 o; o.x = pk2(v0[0], v0[1]); o.y = pk2(v0[2], v0[3]); o.z = pk2(v1[0], v1[1]); o.w = pk2(v1[2], v1[3]); *(u32x4*)(IV + (size_t)r * 1024 + col) = o;
                    } else {
                        float s0[4], s1[4];
#pragma unroll
                        for (int e = 0; e < 4; ++e) { s0[e] = v0[e] * __builtin_amdgcn_rcpf(1.f + __builtin_amdgcn_exp2f(-LOG2E * v0[e])); s1[e] = v1[e] * __builtin_amdgcn_rcpf(1.f + __builtin_amdgcn_exp2f(-LOG2E * v1[e])); }
                        u32x4 o; o.x = pk2(s0[0], s0[1]); o.y = pk2(s0[2], s0[3]); o.z = pk2(s1[0], s1[1]); o.w = pk2(s1[2], s1[3]); *(u32x4*)((seg == 0 ? QH : SG) + (size_t)(r - C) * 1024 + col) = o;
                    }
                }
        }
    }
};

typedef int v8i __attribute__((ext_vector_type(8)));
typedef int v4i __attribute__((ext_vector_type(4)));
template <class Epi, class Sched, bool ALIGN_EPI, bool GATHER, bool FP8>
__device__ __forceinline__ void gemm_phase(LAS unsigned char* lds, const Gemm g, const Sched& S, const Epi& E, const int tid) {
    const int wid = __builtin_amdgcn_readfirstlane(tid >> 6), lane = tid & 63, wr = wid >> 2, wc = wid & 3, fr = lane & 15, fq = lane >> 4;
    constexpr int KB = FP8 ? 1024 : 2048, nt = 1024 / (FP8 ? 128 : 64);
    int sR[2], sC[2]; unsigned voffB[2], voffA[2];
#pragma unroll
    for (int i = 0; i < 2; ++i) { stage_rc(tid * 16 + i * 8192, sR[i], sC[i]); const int Rb = Epi::PERM ? ((sR[i] & ~31) + perm32(sR[i] & 31)) : sR[i]; voffB[i] = (unsigned)(Rb * KB + sC[i] * 2); voffA[i] = (unsigned)(sR[i] * KB + sC[i] * 2); }
    constexpr size_t kstep = (size_t)(BK * 2), hstep = (size_t)HALF * KB, tstep = 2 * hstep;
    const unsigned ldsw = (unsigned)wid * 1024u;
    const int aoff = lds_byte(wr * 64 + fr, fq * 8), boff = lds_byte(wc * 32 + fr, fq * 8);
    const char* Ab = (const char*)g.A;
#define PG8_SA(b, h) (((b) * 2 + (h)) * HTB)
#define PG8_SB(b, h) ((4 + (b) * 2 + (h)) * HTB)
#define PG8_STAGE_B(bufoff, gbase) do { _Pragma("unroll") for (int _i = 0; _i < 2; ++_i) \
        __builtin_amdgcn_global_load_lds((const unsigned*)((const char*)(gbase) + voffB[_i]), (LAS unsigned*)(lds + (bufoff) + ldsw + _i * 8192), 16, 0, 0); } while (0)
#define PG8_STAGE_A(bufoff, kb, v, ubase) do { _Pragma("unroll") for (int _i = 0; _i < 2; ++_i) \
        __builtin_amdgcn_global_load_lds((const unsigned*)((GATHER ? Ab : (ubase)) + (size_t)(kb) + (GATHER ? (v)[_i] : voffA[_i])), (LAS unsigned*)(lds + (bufoff) + ldsw + _i * 8192), 16, 0, 0); } while (0)
#define PG8_LD8(p) __builtin_shufflevector(*(const LAS v4i*)(p), *(const LAS v4i*)((p) + 1024), 0, 1, 2, 3, 4, 5, 6, 7)
#define PG8_LDA(dst, b, h) do { if constexpr (FP8) { _Pragma("unroll") for (int m = 0; m < 4; ++m) dst##8[m] = PG8_LD8(lds + PG8_SA(b, h) + aoff + m * 2048); } else { _Pragma("unroll") for (int m = 0; m < 4; ++m) _Pragma("unroll") for (int k = 0; k < 2; ++k) dst[m][k] = *(const LAS bf16x8*)(lds + PG8_SA(b, h) + aoff + m * 2048 + k * 1024); } } while (0)
#define PG8_LDB(dst, b, h) do { if constexpr (FP8) { _Pragma("unroll") for (int n = 0; n < 2; ++n) dst##8[n] = PG8_LD8(lds + PG8_SB(b, h) + boff + n * 2048); } else { _Pragma("unroll") for (int n = 0; n < 2; ++n) _Pragma("unroll") for (int k = 0; k < 2; ++k) dst[n][k] = *(const LAS bf16x8*)(lds + PG8_SB(b, h) + boff + n * 2048 + k * 1024); } } while (0)
#define PG8_MMA(ai, bj, At, Bt) do { __builtin_amdgcn_s_setprio(1); if constexpr (FP8) { _Pragma("unroll") for (int m = 0; m < 4; ++m) _Pragma("unroll") for (int n = 0; n < 2; ++n) \
        asm volatile("v_mfma_scale_f32_16x16x128_f8f6f4 %0, %1, %2, %0, %3, %3 op_sel_hi:[0,0,0]" : "+v"(acc[ai][bj][m][n]) : "v"(Bt##8[n]), "v"(At##8[m]), "v"(unit_scale)); } else { \
        _Pragma("unroll") for (int m = 0; m < 4; ++m) _Pragma("unroll") for (int n = 0; n < 2; ++n) _Pragma("unroll") for (int k = 0; k < 2; ++k) \
        acc[ai][bj][m][n] = __builtin_amdgcn_mfma_f32_16x16x32_bf16(Bt[n][k], At[m][k], acc[ai][bj][m][n], 0, 0, 0); } __builtin_amdgcn_s_setprio(0); } while (0)
#define PG8_WAIT_V(n) asm volatile("s_waitcnt vmcnt(" #n ")" ::: "memory")
#define PG8_WAIT_L(n) asm volatile("s_waitcnt lgkmcnt(" #n ")" ::: "memory")
#define PG8_BAR __builtin_amdgcn_s_barrier()
#define PG8_SCHED __builtin_amdgcn_sched_barrier(0)
    Unit cur, nxt; int ui = 0;
    if (!S.next(0, cur)) return;
    unsigned cv[2][2], nv[2][2];
    if constexpr (GATHER) a_offsets<KB>(g, cur, sR, sC, cv);
    const char* cA = Ab + (size_t)cur.pm * tstep; const char* nA = cA;
    f32x4 acc[2][2][4][2];
#pragma unroll
    for (int a = 0; a < 2; ++a)
#pragma unroll
        for (int b = 0; b < 2; ++b)
#pragma unroll
            for (int m = 0; m < 4; ++m)
#pragma unroll
                for (int n = 0; n < 2; ++n) acc[a][b][m][n] = (f32x4){0.f, 0.f, 0.f, 0.f};
    bf16x8 At[4][2], B0[2][2], B1[2][2]; v8i At8[4], B08[2], B18[2];
    int unit_scale = 0x7f7f7f7f; asm volatile("" : "+v"(unit_scale));
    const char* cB = (const char*)g.Bt + (size_t)cur.e * g.bstride + (size_t)cur.pn * tstep;
    PG8_STAGE_B(PG8_SB(0, 0), cB); PG8_STAGE_B(PG8_SB(0, 1), cB + hstep); PG8_STAGE_A(PG8_SA(0, 0), 0, cv[0], cA); PG8_STAGE_A(PG8_SA(0, 1), 0, cv[1], cA + hstep);
    if (wr == 1) PG8_BAR;
    PG8_WAIT_V(2); PG8_BAR;
    PG8_STAGE_B(PG8_SB(1, 0), cB + kstep); PG8_STAGE_A(PG8_SA(1, 0), kstep, cv[0], cA); PG8_STAGE_B(PG8_SB(1, 1), cB + hstep + kstep);
    PG8_WAIT_V(6); PG8_BAR;
    for (;;) {
        const bool has_next = S.next(ui + 1, nxt);
        const char* nB = cB;
        nA = cA;
        if (has_next) { if constexpr (GATHER) a_offsets<KB>(g, nxt, sR, sC, nv); nA = Ab + (size_t)nxt.pm * tstep; nB = (const char*)g.Bt + (size_t)nxt.e * g.bstride + (size_t)nxt.pn * tstep; }
        else if constexpr (GATHER) {
#pragma unroll
            for (int h = 0; h < 2; ++h)
#pragma unroll
                for (int i = 0; i < 2; ++i) nv[h][i] = cv[h][i];
        }
        const int ntr = (PROBE_SHORTK && !cur.real) ? 2 : nt;
        const bool m00 = (cur.amask & 1) && (cur.bmask & 1), m01 = (cur.amask & 1) && (cur.bmask & 2), m10 = (cur.amask & 2) && (cur.bmask & 1), m11 = (cur.amask & 2) && (cur.bmask & 2);
#pragma nounroll
        for (int t = 0; t < ntr; t += 2) {
            const bool last = (t == ntr - 2);
            const size_t k1 = (size_t)(t + 1) * kstep, k2 = last ? 0 : (size_t)(t + 2) * kstep, k3 = k2 + kstep;
            const char* b2 = last ? nB : cB + (size_t)(t + 2) * kstep; const char* b3 = b2 + kstep;
            unsigned w0[2], w1[2];
            if constexpr (GATHER) {
#pragma unroll
                for (int i = 0; i < 2; ++i) { w0[i] = last ? nv[0][i] : cv[0][i]; w1[i] = last ? nv[1][i] : cv[1][i]; }
            }
            const char* a2 = last ? nA : cA;
            PG8_LDB(B0, 0, 0); PG8_LDB(B1, 0, 1); PG8_SCHED; PG8_LDA(At, 0, 0); PG8_STAGE_A(PG8_SA(1, 1), k1, cv[1], cA + hstep);
            PG8_WAIT_V(8); PG8_WAIT_L(0); PG8_BAR; if (m00) PG8_MMA(0, 0, At, B0); if (m01) PG8_MMA(0, 1, At, B1); PG8_BAR; PG8_SCHED;
            PG8_LDA(At, 0, 1); PG8_STAGE_B(PG8_SB(0, 0), b2); PG8_STAGE_B(PG8_SB(0, 1), b2 + hstep); PG8_STAGE_A(PG8_SA(0, 0), k2, w0, a2);
            PG8_WAIT_V(8); PG8_WAIT_L(0); PG8_BAR; if (m10) PG8_MMA(1, 0, At, B0); if (m11) PG8_MMA(1, 1, At, B1); PG8_BAR; PG8_SCHED;
            PG8_LDB(B0, 1, 0); PG8_LDB(B1, 1, 1); PG8_SCHED; PG8_LDA(At, 1, 0); PG8_STAGE_A(PG8_SA(0, 1), k2, w1, a2 + hstep);
            PG8_WAIT_V(8); PG8_WAIT_L(0); PG8_BAR; if (m00) PG8_MMA(0, 0, At, B0); if (m01) PG8_MMA(0, 1, At, B1); PG8_BAR; PG8_SCHED;
            PG8_LDA(At, 1, 1); PG8_STAGE_B(PG8_SB(1, 0), b3); PG8_STAGE_B(PG8_SB(1, 1), b3 + hstep); PG8_STAGE_A(PG8_SA(1, 0), k3, w0, a2);
            PG8_WAIT_V(8); PG8_WAIT_L(0); PG8_BAR; if (m10) PG8_MMA(1, 0, At, B0); if (m11) PG8_MMA(1, 1, At, B1); PG8_BAR; PG8_SCHED;
        }
        if constexpr (ALIGN_EPI) { if (wr == 0) PG8_BAR; }
        if constexpr (FP8) asm volatile("s_nop 15\n\ts_nop 15" ::: "memory");
        if (!PROBE_NOEPI || cur.real) E(acc, cur, wr, wc, fr, fq);
        if (!has_next) break;
#pragma unroll
        for (int a = 0; a < 2; ++a)
#pragma unroll
            for (int b = 0; b < 2; ++b)
#pragma unroll
                for (int m = 0; m < 4; ++m)
#pragma unroll
                    for (int n = 0; n < 2; ++n) acc[a][b][m][n] = (f32x4){0.f, 0.f, 0.f, 0.f};
        cur = nxt; cB = nB; cA = nA; ++ui;
        if constexpr (GATHER) {
#pragma unroll
            for (int h = 0; h < 2; ++h)
#pragma unroll
                for (int i = 0; i < 2; ++i) cv[h][i] = nv[h][i];
        }
        if constexpr (ALIGN_EPI) { if (wr == 1) PG8_BAR; }
    }
    PG8_WAIT_V(0);
    if constexpr (!ALIGN_EPI) { if (wr == 0) PG8_BAR; }
    PG8_BAR;
#undef PG8_SA
#undef PG8_SB
#undef PG8_STAGE_A
#undef PG8_STAGE_B
#undef PG8_LDA
#undef PG8_LD8
#undef PG8_LDB
#undef PG8_MMA
#undef PG8_WAIT_V
#undef PG8_WAIT_L
#undef PG8_BAR
#undef PG8_SCHED
}
}

struct TBlk { const float* src; int ldw; bf16_t* dst; unsigned char* dst8; };
__device__ __forceinline__ void tb_load(const TBlk& t, int lane, f32x4 (&v)[16]) {
    const float* p = t.src + (size_t)(lane >> 4) * t.ldw + (lane & 15) * 4;
#pragma unroll
    for (int i = 0; i < 16; ++i) v[i] = *(const f32x4*)(p + (size_t)(4 * i) * t.ldw);
}
__device__ __forceinline__ void tb_store(const TBlk& t, int lane, const f32x4 (&v)[16], LAS float* scr) {
#pragma unroll
    for (int i = 0; i < 16; ++i) { LAS float* d = scr + ((lane >> 4) + 4 * i) * 65 + (lane & 15) * 4; d[0] = v[i].x; d[1] = v[i].y; d[2] = v[i].z; d[3] = v[i].w; }
    asm volatile("s_waitcnt lgkmcnt(0)" ::: "memory"); __builtin_amdgcn_wave_barrier();
    const int c8 = lane & 7;
#pragma unroll
    for (int jj = 0; jj < 8; ++jj) {
        const int n = (lane >> 3) + 8 * jj; const LAS float* p = scr + (8 * c8) * 65 + n;
        if (t.dst8) { u32x2 o; o.x = pk4_fp8(p[0] * F8_SW, p[65] * F8_SW, p[2 * 65] * F8_SW, p[3 * 65] * F8_SW); o.y = pk4_fp8(p[4 * 65] * F8_SW, p[5 * 65] * F8_SW, p[6 * 65] * F8_SW, p[7 * 65] * F8_SW);
            *(u32x2*)(t.dst8 + (size_t)n * 1024 + 8 * c8) = o; }
        else { u32x4 o; o.x = pk2(p[0], p[65]); o.y = pk2(p[2 * 65], p[3 * 65]); o.z = pk2(p[4 * 65], p[5 * 65]); o.w = pk2(p[6 * 65], p[7 * 65]);
            *(u32x4*)(t.dst + (size_t)n * 1024 + 8 * c8) = o; }
    }
    asm volatile("s_waitcnt lgkmcnt(0)" ::: "memory"); __builtin_amdgcn_wave_barrier();
}

__device__ __forceinline__ void phase_prep(const Ctx& c) {
    LAS float* red = (LAS float*)c.lds;
    LAS float* sil = red + 1024;
    const float* cv = c.a->in[1]; const float* ccv = c.a->in[3]; const float* ada_w = c.a->in[4]; const float* ada_b = c.a->in[5];
    for (int i = c.tid; i < 2048; i += 512) { const float x = i < 1024 ? cv[i] : ccv[i - 1024]; sil[i] = x * __builtin_amdgcn_rcpf(1.f + __builtin_amdgcn_exp2f(-LOG2E * x)); }
    __syncthreads();
    for (int item = c.wg; item < 193; item += c.nwg) {
        if (item < 192) {
            const int layer = item / 96, cb = item % 96, col = cb * 64 + c.lane;
            const float* W = ada_w + (size_t)layer * D * 6144 + col;
            float a0 = 0.f, a1 = 0.f;
            const int k0 = c.wave * 128;
#pragma unroll 32
            for (int k = 0; k < 128; ++k) { const float w = W[(size_t)(k0 + k) * 6144]; a0 += sil[k0 + k] * w; a1 += sil[1024 + k0 + k] * w; }
            red[(0 * 8 + c.wave) * 64 + c.lane] = a0; red[(1 * 8 + c.wave) * 64 + c.lane] = a1;
            __syncthreads();
            if (c.tid < 128) {
                const int which = c.tid >> 6, l = c.tid & 63; float s = 0.f;
#pragma unroll
                for (int w = 0; w < 8; ++w) s += red[(which * 8 + w) * 64 + l];
                c.modp(layer, which)[cb * 64 + l] = s + ada_b[layer * 6144 + cb * 64 + l];
            }
            __syncthreads();
        } else {
            float* modbase = (float*)(c.ws + WS_MOD);
            for (int i = c.tid; i < 4096; i += 512) {
                const int pos = i >> 4, j = i & 15;
                const double ang = (double)pos * pow(10000.0, -(double)j / 16.0);
                modbase[MOD_ROPE + 2 * i] = (float)cos(ang); modbase[MOD_ROPE + 2 * i + 1] = (float)sin(ang);
            }
            const float* lbp = c.a->in[12];
            for (int i = c.tid; i < 2048; i += 512) { const float p0 = lbp[i], p1 = lbp[2048 + i]; modbase[MOD_LB + i] = 1.f / (1.f + __expf(p0 - p1)); }
        }
    }
}

__device__ __forceinline__ void row_load(const float* p, int lane, f32x4 (&v)[4]) {
#pragma unroll
    for (int j = 0; j < 4; ++j) v[j] = *(const f32x4*)(p + lane * 4 + 256 * j);
}
__device__ __forceinline__ void row_load_bf(const bf16_t* p, int lane, f32x4 (&v)[4]) {
#pragma unroll
    for (int j = 0; j < 4; ++j) { const u32x2 w = *(const u32x2*)(p + lane * 4 + 256 * j); v[j] = (f32x4){bflo(w.x), bfhi(w.x), bflo(w.y), bfhi(w.y)}; }
}
__device__ __forceinline__ float row_ss(const f32x4 (&v)[4]) {
    float s = 0.f;
#pragma unroll
    for (int j = 0; j < 4; ++j) s += v[j].x * v[j].x + v[j].y * v[j].y + v[j].z * v[j].z + v[j].w * v[j].w;
    return wave_sum(s);
}
__device__ __forceinline__ void row_modnorm_store(const f32x4 (&x)[4], float rstd, const float* g, const float* sh, const float* sc, bf16_t* out, int lane, f32x4 (*hout)[4] = nullptr) {
#pragma unroll
    for (int j = 0; j < 4; ++j) {
        const int c0 = lane * 4 + 256 * j;
        const f32x4 gv = *(const f32x4*)(g + c0), shv = *(const f32x4*)(sh + c0), scv = *(const f32x4*)(sc + c0);
        f32x4 h;
        h.x = x[j].x * rstd * gv.x * (1.f + scv.x) + shv.x; h.y = x[j].y * rstd * gv.y * (1.f + scv.y) + shv.y;
        h.z = x[j].z * rstd * gv.z * (1.f + scv.z) + shv.z; h.w = x[j].w * rstd * gv.w * (1.f + scv.w) + shv.w;
        if (hout) (*hout)[j] = h;
        u32x2 o; o.x = pk2(h.x, h.y); o.y = pk2(h.z, h.w);
        *(u32x2*)(out + c0) = o;
    }
}

__device__ __forceinline__ void phase_norm0(const Ctx& c) {
    bf16_t* H = (bf16_t*)(c.ws + WS_H); const float* ng = c.a->in[6];
    int r = c.wg * 8 + c.wave;
    f32x4 xn[4];
    if (r < R) row_load(c.xin0(r), c.lane, xn);
    for (; r < R; r += c.nwg * 8) {
        f32x4 x[4];
#pragma unroll
        for (int j = 0; j < 4; ++j) x[j] = xn[j];
        if (r + c.nwg * 8 < R) row_load(c.xin0(r + c.nwg * 8), c.lane, xn);
        const float rstd = rsqrtf(row_ss(x) * (1.f / D) + EPS);
        const float* m = c.modp(0, r < C ? 1 : 0);
        row_modnorm_store(x, rstd, ng, m + 0, m + 1024, H + (size_t)r * D, c.lane);
    }
}

namespace at {
__device__ __forceinline__ float max3f(float a, float b, float c) { return __builtin_fmaxf(__builtin_fmaxf(a, b), c); }
constexpr int KP = 144, TILEB = 64 * KP;
__device__ __forceinline__ bf16x8 tr_frag2(const LAS unsigned char* tile, int row0, int col0, int lane) {
    const int q = (lane & 15) >> 2, p = lane & 3;
    const LAS unsigned char* a = tile + (row0 + q) * KP + (col0 + 4 * p) * 2;
    const v4i16_t lo = __builtin_amdgcn_ds_read_tr16_b64_v4i16((LAS v4i16_t*)a);
    const v4i16_t hi = __builtin_amdgcn_ds_read_tr16_b64_v4i16((LAS v4i16_t*)(a + 16 * KP));
    return (bf16x8){lo[0], lo[1], lo[2], lo[3], hi[0], hi[1], hi[2], hi[3]};
}
}
__device__ __forceinline__ void phase_attn(const Ctx& c) {
    using namespace at;
    const bf16_t* Q = (const bf16_t*)(c.ws + WS_Q); const bf16_t* K = (const bf16_t*)(c.ws + WS_K); const bf16_t* V = (const bf16_t*)(c.ws + WS_V);
    bf16_t* O = (bf16_t*)(c.ws + WS_O); const float* sink = c.a->in[9];
    LAS unsigned char* lds = c.lds;
    const int tid = c.tid, lane = c.lane, w = __builtin_amdgcn_readfirstlane(tid >> 6), fr = lane & 15, g = lane >> 4;
    const int lrow = tid >> 3, lch = tid & 7;
    const int nitn = c.nwg == 256 ? 2 : (264 - c.wg + c.nwg - 1) / c.nwg;
    for (int itn = 0; itn < nitn; ++itn) {
        int item = c.wg + itn * c.nwg;
        if (c.nwg == 256 && itn == 1) { const int n_ = c.wg >> 1; item = -1;
            if (n_ == 0) item = 256 + (c.wg & 1); else if (n_ == 127) item = 258 + (c.wg & 1); else if (n_ == 30 || n_ == 31) item = 260 + (c.wg - 60); }
        if (item < 0 || item >= 264) continue;
        const bool isctx = item >= 256;
        const int ci = item - 256;
        const int n = isctx ? 0 : (item >> 1), kh = isctx ? ((ci >> 1) & 1) : (item & 1), cb = isctx ? (ci >> 2) : 0;
        const int p_lo = isctx ? (ci & 1) : 0, p_hi = isctx ? (ci & 1) + 1 : 2;
        const int hq = kh * 8 + w;
        const float sink2 = sink[hq] * LOG2E;
        for (int pass = p_lo; pass < p_hi; ++pass) {
            const int t0 = 128 * n + 64 * pass, qrow0 = isctx ? cb * 128 + 64 * pass : C + t0;
            const int jlo = isctx ? 0 : (t0 >= 128 ? 0 : (128 - t0) / 64), jhi = isctx ? 0 : ((L - t0 + 128) / 64 < 5 ? (L - t0 + 128) / 64 : 5);
            const int ntile = 4 + (jhi - jlo);
            LAS unsigned char* qlds = lds + 4 * TILEB + w * TILEB;
#pragma unroll
            for (int qb = 0; qb < 4; ++qb)
#pragma unroll
                for (int ks = 0; ks < 2; ++ks) *(LAS bf16x8*)(qlds + (16 * qb + fr) * KP + (32 * ks + 8 * g) * 2) = *(const bf16x8*)(Q + (size_t)(qrow0 + 16 * qb + fr) * D + hq * 64 + 32 * ks + 8 * g);
            float mrow[4], lsum[4]; f32x4 OT[4][4];
#pragma unroll
            for (int qb = 0; qb < 4; ++qb) { mrow[qb] = sink2; lsum[qb] = 1.f;
#pragma unroll
                for (int nt = 0; nt < 4; ++nt) OT[qb][nt] = (f32x4){0.f, 0.f, 0.f, 0.f}; }
            u32x4 kreg, vreg;
#define AT_KROW(ti) ((ti) < 4 ? 64 * (ti) : C + t0 - 128 + 64 * (jlo + (ti) - 4))
#define AT_LOAD(ti) do { const size_t ro_ = (size_t)(AT_KROW(ti) + lrow) * 128 + kh * 64 + lch * 8; kreg = *(const u32x4*)(K + ro_); vreg = *(const u32x4*)(V + ro_); } while (0)
#define AT_WRITE(buf) do { *(LAS u32x4*)(lds + (buf) * 2 * TILEB + lrow * KP + lch * 16) = kreg; *(LAS u32x4*)(lds + (buf) * 2 * TILEB + TILEB + lrow * KP + lch * 16) = vreg; } while (0)
            AT_LOAD(0); AT_WRITE(0);
            __syncthreads();
            for (int ti = 0; ti < ntile; ++ti) {
                if (ti + 1 < ntile) AT_LOAD(ti + 1);
                const LAS unsigned char* kb = lds + (ti & 1) * 2 * TILEB; const LAS unsigned char* vb = kb + TILEB;
                const int jj = jlo + ti - 4; const bool masked = (ti >= 4) && (jj == 0 || jj == 4);
                const int k0 = t0 - 128 + 64 * jj;
                bf16x8 Kf[4][2];
#pragma unroll
                for (int mt = 0; mt < 4; ++mt)
#pragma unroll
                    for (int ks = 0; ks < 2; ++ks) Kf[mt][ks] = *(const LAS bf16x8*)(kb + (16 * mt + fr) * KP + (32 * ks + 8 * g) * 2);
                bf16x8 Vf[4][2];
#pragma unroll
                for (int mt = 0; mt < 4; ++mt)
#pragma unroll
                    for (int ks = 0; ks < 2; ++ks)
                        Vf[mt][ks] = tr_frag2(vb, 32 * ks + 4 * g, 16 * mt, lane);
#pragma unroll
                for (int qb = 0; qb < 4; ++qb) {
                    bf16x8 Qq[2];
#pragma unroll
                    for (int ks = 0; ks < 2; ++ks) Qq[ks] = *(const LAS bf16x8*)(qlds + (16 * qb + fr) * KP + (32 * ks + 8 * g) * 2);
                    f32x4 sa[4];
#pragma unroll
                    for (int mt = 0; mt < 4; ++mt) { sa[mt] = (f32x4){0.f, 0.f, 0.f, 0.f};
#pragma unroll
                        for (int ks = 0; ks < 2; ++ks) sa[mt] = __builtin_amdgcn_mfma_f32_16x16x32_bf16(Kf[mt][ks], Qq[ks], sa[mt], 0, 0, 0); }
                    if (masked) {
                        const int tq = t0 + 16 * qb + fr;
#pragma unroll
                        for (int mt = 0; mt < 4; ++mt)
#pragma unroll
                            for (int e = 0; e < 4; ++e) { const int dt = tq - (k0 + 16 * mt + 4 * g + e); if (dt > 128 || dt < -128) sa[mt][e] = -INFINITY; }
                    }
                    float mx = max3f(sa[0][0], sa[0][1], sa[0][2]), my = max3f(sa[0][3], sa[1][0], sa[1][1]);
                    mx = max3f(mx, sa[1][2], sa[1][3]); my = max3f(my, sa[2][0], sa[2][1]); mx = max3f(mx, sa[2][2], sa[2][3]); my = max3f(my, sa[3][0], sa[3][1]); mx = max3f(mx, sa[3][2], sa[3][3]);
                    mx = max3f(mx, my, mrow[qb]);
                    mx = max3f(mx, __shfl_xor(mx, 16), mx); mx = max3f(mx, __shfl_xor(mx, 32), mx);
                    const float mn = mx; const bool grew = __any(mn > mrow[qb]);
                    const float alpha = grew ? __builtin_amdgcn_exp2f(mrow[qb] - mn) : 1.f;
                    mrow[qb] = mn;
                    float rs = 0.f;
#pragma unroll
                    for (int mt = 0; mt < 4; ++mt)
#pragma unroll
                        for (int e = 0; e < 4; ++e) { const float pv = __builtin_amdgcn_exp2f(sa[mt][e] - mn); sa[mt][e] = pv; rs += pv; }
                    rs += __shfl_xor(rs, 16); rs += __shfl_xor(rs, 32);
                    lsum[qb] = grew ? lsum[qb] * alpha + rs : lsum[qb] + rs;
                    bf16x8 Pb[2];
#pragma unroll
                    for (int ks = 0; ks < 2; ++ks) { const f32x4 a0 = sa[2 * ks], a1 = sa[2 * ks + 1];
                        const u32x4 pk = (u32x4){pk2(a0[0], a0[1]), pk2(a0[2], a0[3]), pk2(a1[0], a1[1]), pk2(a1[2], a1[3])}; Pb[ks] = __builtin_bit_cast(bf16x8, pk); }
#pragma unroll
                    for (int nt = 0; nt < 4; ++nt) { if (grew) OT[qb][nt] = OT[qb][nt] * alpha;
#pragma unroll
                        for (int ks = 0; ks < 2; ++ks) OT[qb][nt] = __builtin_amdgcn_mfma_f32_16x16x32_bf16(Vf[nt][ks], Pb[ks], OT[qb][nt], 0, 0, 0); }
                }
                if (ti + 1 < ntile) AT_WRITE((ti + 1) & 1);
                __syncthreads();
            }
#undef AT_KROW
#undef AT_LOAD
#undef AT_WRITE
#pragma unroll
            for (int qb = 0; qb < 4; ++qb) {
                const float il = 1.f / lsum[qb];
                bf16_t* op = O + (size_t)(qrow0 + 16 * qb + fr) * D + hq * 64 + 4 * g;
#pragma unroll
                for (int nt = 0; nt < 4; ++nt) { const f32x4 v = OT[qb][nt] * il; u32x2 o; o.x = pk2(v[0], v[1]); o.y = pk2(v[2], v[3]); *(u32x2*)(op + 16 * nt) = o; }
            }
        }
    }
}

template <int GS>
__device__ __forceinline__ void phase_postmix(const Ctx& c, int layer, bool route) {
    const bf16_t* Y = (const bf16_t*)(c.ws + WS_RAW1); unsigned char* H8 = c.ws + WS_H8;
    bf16_t* Xout = (bf16_t*)(c.ws + (layer == 0 ? WS_X : WS_X1)); const bf16_t* Xprev = (const bf16_t*)(c.ws + WS_X);
    const float* ng = c.a->in[6] + layer * 4 * D; const float* Wr = c.a->in[15] + (size_t)layer * D * NE; const float* br = c.a->in[16] + layer * NE;
    unsigned* cnt = (unsigned*)(c.ws + WS_CTL) + CW_CNT + layer * NE;
    int* tk_e = (int*)(c.ws + WS_TK); float* tk_g = (float*)(c.ws + WS_TK) + R * 4; int* tk_slot = (int*)(c.ws + WS_TK) + 2 * R * 4;
    int* list = (int*)(c.ws + WS_LIST);
    LAS float* WL = (LAS float*)c.lds;
    LAS float* biasp = (LAS float*)(c.lds + 131072);
    LAS unsigned* lcnt = (LAS unsigned*)(c.lds + 145920); LAS unsigned* lbase = lcnt + 32; LAS float* rsx = (LAS float*)(lcnt + 64);
    LAS float* pvA = (LAS float*)(c.lds + 131072 + 2560); LAS float* pvB = pvA + 1024; LAS float* pvS = pvB + 1024;
    const int lane = c.lane, w = __builtin_amdgcn_readfirstlane(c.tid >> 6), fr = lane & 15, g = lane >> 4;
    constexpr int RP = GS / 8, NW2 = GS / 16;
    const int g_lo = layer == 0 ? 0 : C / GS;
    for (int grp = g_lo + c.wg; grp < R / GS; grp += c.nwg) {
        const int which = grp * GS < C ? 1 : 0;
        const float* m = c.modp(layer, which);
        __syncthreads();
        if (c.tid < NE) lcnt[c.tid] = 0u;
#pragma unroll 4
        for (int j = 0; j < 16; ++j) {
            const int i4 = c.tid + 512 * j, k = i4 >> 3, e0 = (i4 & 7) * 4;
            const f32x4 wv = *(const f32x4*)(Wr + (size_t)k * NE + e0); const float sc = ng[2 * D + k] * (1.f + m[4096 + k]);
            LAS float* dst = WL + ((((k >> 4) * 4 + (k & 3)) * 4 + ((k >> 2) & 3)) * 16) * 2;
#pragma unroll
            for (int q = 0; q < 4; ++q) { const int e = e0 + q; dst[(e & 15) * 2 + (e >> 4)] = wv[q] * sc; }
        }
        for (int k = c.tid; k < D; k += 512) { pvA[k] = m[2048 + k] * ng[D + k]; pvB[k] = ng[2 * D + k] * (1.f + m[4096 + k]); pvS[k] = m[3072 + k]; }
        { const int e = c.tid & 31, part = c.tid >> 5; float sacc = 0.f;
#pragma unroll 16
          for (int k = part * 64; k < part * 64 + 64; ++k) sacc += m[3072 + k] * Wr[k * NE + e];
          biasp[32 + part * 32 + e] = sacc; }
        __syncthreads();
        if (c.tid < 32) { float sacc = br[c.tid];
#pragma unroll
            for (int p = 0; p < 16; ++p) sacc += biasp[32 + p * 32 + c.tid]; biasp[c.tid] = sacc; }
        __syncthreads();
        const int row1 = grp * GS + w * RP;
        f32x4 yn[4], xn[4];
        row_load_bf(Y + (size_t)(layer == 0 ? row1 : row1 - C) * D, lane, yn); if (layer == 0) row_load(c.xin0(row1), lane, xn); else row_load_bf(Xprev + (size_t)row1 * D, lane, xn);
        for (int i = 0; i < RP; ++i) {
            const int r = row1 + i;
            f32x4 y[4], x[4];
#pragma unroll
            for (int j = 0; j < 4; ++j) { y[j] = yn[j]; x[j] = xn[j]; }
            if (i + 1 < RP) { row_load_bf(Y + (size_t)(layer == 0 ? r + 1 : r + 1 - C) * D, lane, yn); if (layer == 0) row_load(c.xin0(r + 1), lane, xn); else row_load_bf(Xprev + (size_t)(r + 1) * D, lane, xn); }
            const float rstd_y = rsqrtf(row_ss(y) * (1.f / D) + EPS);
#pragma unroll
            for (int j = 0; j < 4; ++j) {
                const int c0 = lane * 4 + 256 * j;
                x[j] += *(const LAS f32x4*)(pvA + c0) * (y[j] * rstd_y);
                { u32x2 xo; xo.x = pk2(x[j][0], x[j][1]); xo.y = pk2(x[j][2], x[j][3]); *(u32x2*)(Xout + (size_t)r * D + c0) = xo;
                  x[j] = (f32x4){bflo(xo.x), bfhi(xo.x), bflo(xo.y), bfhi(xo.y)}; }
            }
            const float rstd_x = rsqrtf(row_ss(x) * (1.f / D) + EPS);
#pragma unroll
            for (int j = 0; j < 4; ++j) {
                const int c0 = lane * 4 + 256 * j;
                const f32x4 hv = x[j] * rstd_x * *(const LAS f32x4*)(pvB + c0) + *(const LAS f32x4*)(pvS + c0);
                *(unsigned*)(H8 + (size_t)r * D + c0) = pk4_fp8(hv[0] * F8_SH, hv[1] * F8_SH, hv[2] * F8_SH, hv[3] * F8_SH);
            }
            if (lane == 0) rsx[w * RP + i] = rstd_x;
        }
        asm volatile("s_waitcnt vmcnt(0)" ::: "memory");
        __syncthreads();
        const int row0 = grp * GS + w * 16; const bool w2 = w < NW2;
        f32x4 la[2]; la[0] = (f32x4){0.f, 0.f, 0.f, 0.f}; la[1] = la[0];
        if (w2) {
            const bf16_t* ap = Xout + (size_t)(row0 + fr) * D + 4 * g;
            const LAS float* bp = WL + (g * 16 + fr) * 2;
#pragma unroll 4
            for (int k4 = 0; k4 < 64; ++k4) {
                const u32x2 aw = *(const u32x2*)(ap + 16 * k4); const f32x4 a4 = (f32x4){bflo(aw.x), bfhi(aw.x), bflo(aw.y), bfhi(aw.y)};
#pragma unroll
                for (int q = 0; q < 4; ++q) {
                    const f32x2 b2 = *(const LAS f32x2*)(bp + (size_t)(4 * k4 + q) * 128);
                    la[0] = __builtin_amdgcn_mfma_f32_16x16x4f32(a4[q], b2[0], la[0], 0, 0, 0);
                    la[1] = __builtin_amdgcn_mfma_f32_16x16x4f32(a4[q], b2[1], la[1], 0, 0, 0);
                }
            }
        }
        float tv[4][4]; int te[4][4];
#pragma unroll
        for (int e = 0; e < 4; ++e) {
            const float rs = rsx[(w2 ? w * 16 : 0) + 4 * g + e];
            float v0 = la[0][e] * rs + biasp[fr], v1 = la[1][e] * rs + biasp[16 + fr];
#pragma unroll
            for (int k = 0; k < 4; ++k) {
                float bv; int bi;
                if (v0 >= v1) { bv = v0; bi = fr; } else { bv = v1; bi = 16 + fr; }
#pragma unroll
                for (int o = 8; o > 0; o >>= 1) {
                    const float ov = __shfl_xor(bv, o); const int oi = __shfl_xor(bi, o);
                    if (ov > bv || (ov == bv && oi < bi)) { bv = ov; bi = oi; }
                }
                tv[e][k] = bv; te[e][k] = bi;
                if (bi == fr) v0 = -INFINITY;
                if (bi == 16 + fr) v1 = -INFINITY;
            }
        }
        float v[4]; int ex[4]; unsigned sl[4];
#pragma unroll
        for (int k = 0; k < 4; ++k) { v[k] = tv[0][k]; ex[k] = te[0][k];
#pragma unroll
            for (int e = 1; e < 4; ++e) if (fr == e) { v[k] = tv[e][k]; ex[k] = te[e][k]; } }
        if (fr < 4 && route && w2) {
#pragma unroll
            for (int k = 0; k < 4; ++k) sl[k] = __hip_atomic_fetch_add(lcnt + ex[k], 1u, __ATOMIC_RELAXED, __HIP_MEMORY_SCOPE_WORKGROUP);
        }
        __syncthreads();
        if (c.tid < NE && route) { const unsigned n = lcnt[c.tid]; lbase[c.tid] = n ? atomicAdd(&cnt[c.tid], n) : 0u; }
        __syncthreads();
        if (fr < 4 && route && w2) {
            const int r = row0 + 4 * g + fr;
            const float e1 = __expf(v[1] - v[0]), e2 = __expf(v[2] - v[0]), e3 = __expf(v[3] - v[0]);
            const float inv = 1.f / (1.f + e1 + e2 + e3);
            const float gk[4] = {inv, e1 * inv, e2 * inv, e3 * inv};
#pragma unroll
            for (int k = 0; k < 4; ++k) {
                const unsigned slot = lbase[ex[k]] + sl[k];
                list[(size_t)ex[k] * R + slot] = r;
                tk_e[r * 4 + k] = ex[k]; tk_g[r * 4 + k] = gk[k]; tk_slot[r * 4 + k] = (int)slot;
            }
        }
    }
}

__device__ __forceinline__ void moe_offsets(const Ctx& c, int layer, LAS int* so) {
    const unsigned* cnt = (const unsigned*)(c.ws + WS_CTL) + CW_CNT + layer * NE;
    __syncthreads();
    if (c.tid < 64) {
        const int n = c.tid < NE ? (int)cnt[c.tid] : 0; int pad = (n + PADM - 1) / PADM * PADM, inc = pad;
#pragma unroll
        for (int o = 1; o < 32; o <<= 1) { const int t = __shfl_up(inc, o); if (c.lane >= o) inc += t; }
        if (c.tid < NE) { so[c.tid] = inc - pad; so[64 + c.tid] = n; }
        if (c.tid == NE - 1) so[32] = inc;
    }
    __syncthreads();
}

__device__ __forceinline__ void moe_tables(const Ctx& c, int layer, LAS int* tb) {
    const unsigned* cnt = (const unsigned*)(c.ws + WS_CTL) + CW_CNT + layer * NE;
    __syncthreads();
    if (c.tid < 64) {
        const int n = c.tid < NE ? (int)cnt[c.tid] : 0; int tiles = (n + PADM - 1) / PADM, inc = tiles;
#pragma unroll
        for (int o = 1; o < 32; o <<= 1) { const int t = __shfl_up(inc, o); if (c.lane >= o) inc += t; }
        if (c.tid < NE) { tb[c.tid] = inc - tiles; tb[64 + c.tid] = n; }
        if (c.tid == NE - 1) tb[32] = inc;
    }
    __syncthreads();
}
__device__ __forceinline__ int vcu_of(const Ctx& c) { return (c.nwg % 8 == 0) ? (c.wg % 8) * (c.nwg / 8) + c.wg / 8 : c.wg; }
__device__ __forceinline__ void phase_moe_gu(const Ctx& c, int layer) {
    LAS int* tb = (LAS int*)(c.lds + 131072 + 1024);
    moe_tables(c, layer, tb);
    pg8::Gemm g{c.ws + WS_H8, c.ws + WS_WGU + (size_t)layer * NE * 2048 * 1024, (size_t)2048 * 1024, (const int*)(c.ws + WS_LIST)};
    pg8::MoeOrder S{tb, tb + 64, 8, c.nwg, vcu_of(c), false};
    pg8::EpiSwiglu E{c.ws + WS_HDN, c.a->in[18] + (size_t)layer * NE * 2048};
    pg8::gemm_phase<pg8::EpiSwiglu, pg8::MoeOrder, true, true, true>(c.lds, g, S, E, c.tid);
}
__device__ __forceinline__ void phase_moe_dn(const Ctx& c, int layer) {
    LAS int* tb = (LAS int*)(c.lds + 131072 + 1024);
    moe_tables(c, layer, tb);
    pg8::Gemm g{c.ws + WS_HDN, c.ws + WS_WDN + (size_t)layer * NE * 1024 * 1024, (size_t)1024 * 1024, nullptr};
    pg8::MoeOrder S{tb, tb + 64, 4, c.nwg, vcu_of(c), true};
    pg8::EpiBf16Bias E{c.ws + WS_OUTB, c.a->in[20] + (size_t)layer * NE * 1024, 1024, 1.f / (F8_SHD * F8_SW)};
    pg8::gemm_phase<pg8::EpiBf16Bias, pg8::MoeOrder, true, false, true>(c.lds, g, S, E, c.tid);
}
__device__ __forceinline__ void phase_gemm_f32(const Ctx& c, const bf16_t* A, int M, const bf16_t* Bt, int N, const float* bias, bf16_t* Cout) {
    pg8::Gemm g{A, Bt, 0, nullptr}; pg8::StaticOrder S; S.init(M, N, c.nwg, c.wg);
    pg8::EpiF32 E{Cout, N, bias};
    pg8::gemm_phase<pg8::EpiF32, pg8::StaticOrder, true, false, false>(c.lds, g, S, E, c.tid);
}

__device__ __forceinline__ void phase_gemm_qkv(const Ctx& c) {
    pg8::Gemm g{(const bf16_t*)(c.ws + WS_H), (const bf16_t*)(c.ws + WS_WQKV), 0, nullptr}; pg8::StaticOrder S; S.init(R, QKVD, c.nwg, c.wg);
    pg8::EpiQKV E{(bf16_t*)(c.ws + WS_Q), (bf16_t*)(c.ws + WS_K), (bf16_t*)(c.ws + WS_V), c.a->in[8], (const float*)(c.ws + WS_MOD) + MOD_ROPE};
    pg8::gemm_phase<pg8::EpiQKV, pg8::StaticOrder, true, false, false>(c.lds, g, S, E, c.tid);
}
__device__ __forceinline__ void phase_gemm_inproj(const Ctx& c) {
    pg8::Gemm g{c.ws + WS_H8, c.ws + WS_WIN, 0, nullptr}; pg8::StaticOrder S; S.init(R, HIN, c.nwg, c.wg);
    pg8::EpiInProj E{(bf16_t*)(c.ws + WS_QH), (_Float16*)(c.ws + WS_KF), (_Float16*)(c.ws + WS_KB), (bf16_t*)(c.ws + WS_IV), (bf16_t*)(c.ws + WS_SG), (const float*)(c.ws + WS_MOD) + MOD_LB, 1.f / (F8_SH * F8_SW)};
    pg8::gemm_phase<pg8::EpiInProj, pg8::StaticOrder, true, false, true>(c.lds, g, S, E, c.tid);
}

__device__ __forceinline__ void phase_norm0(const Ctx& c);
constexpr int CONV_A = 20 * 16 + 16 * 16 + 80 * 16 + 16 * 16, CONV_B = 32 * 32 * 16 + 32 * 16 * 16, CONV_CHUNK = 64;
__device__ __forceinline__ TBlk convert_item(const Ctx& c, int it, int part) {
    constexpr int I_QKV = 20 * 16, I_O = 16 * 16, I_IN = 80 * 16, I_HO = 16 * 16, I_GU = 32 * 32 * 16;
    int r = it; TBlk t; t.dst8 = nullptr; t.dst = nullptr;
    if (part == 0) {
        if (r < I_QKV) { const int nb = r % 20, kb = r / 20; t.src = c.a->in[7] + (size_t)kb * 64 * QKVD + nb * 64; t.ldw = QKVD; t.dst = (bf16_t*)(c.ws + WS_WQKV) + (size_t)nb * 64 * 1024 + kb * 64; return t; } r -= I_QKV;
        if (r < I_O) { const int nb = r % 16, kb = r / 16; t.src = c.a->in[10] + (size_t)kb * 64 * D + nb * 64; t.ldw = D; t.dst = (bf16_t*)(c.ws + WS_WO) + (size_t)nb * 64 * 1024 + kb * 64; return t; } r -= I_O;
        if (r < I_IN) { const int nb = r % 80, kb = r / 80; t.src = c.a->in[11] + (size_t)kb * 64 * HIN + nb * 64; t.ldw = HIN; t.dst8 = c.ws + WS_WIN + (size_t)nb * 64 * 1024 + kb * 64; return t; } r -= I_IN;
        if (r < I_HO) { const int nb = r % 16, kb = r / 16; t.src = c.a->in[14] + (size_t)kb * 64 * D + nb * 64; t.ldw = D; t.dst = (bf16_t*)(c.ws + WS_WHO) + (size_t)nb * 64 * 1024 + kb * 64; return t; } r -= I_HO;
    }
    const int moff = (part - 1) * 32;
    if (r < I_GU) { const int mat = moff + r / 512, rr = r % 512, nb = rr % 32, kb = rr / 32; const int n0 = ((nb & 3) >> 1) * 1024 + (nb >> 2) * 128 + (nb & 1) * 64;
        t.src = c.a->in[17] + (size_t)mat * 1024 * 2048 + (size_t)kb * 64 * 2048 + n0; t.ldw = 2048; t.dst8 = c.ws + WS_WGU + ((size_t)mat * 2048 + nb * 64) * 1024 + kb * 64; return t; } r -= I_GU;
    { const int mat = moff + r / 256, rr = r % 256, nb = rr % 16, kb = rr / 16;
        t.src = c.a->in[19] + (size_t)mat * 1024 * 1024 + (size_t)kb * 64 * 1024 + nb * 64; t.ldw = 1024; t.dst8 = c.ws + WS_WDN + ((size_t)mat * 1024 + nb * 64) * 1024 + kb * 64; }
    return t;
}
__device__ __forceinline__ void convert_run(const Ctx& c, int part, int first, int step, int end, LAS float* scr) {
    f32x4 va[16], vb[16];
    int it = first;
    TBlk ta, tbk;
    if (it < end) { ta = convert_item(c, it, part); tb_load(ta, c.lane, va); }
    for (; it < end; it += 2 * step) {
        const bool hb = it + step < end;
        if (hb) { tbk = convert_item(c, it + step, part); tb_load(tbk, c.lane, vb); }
        tb_store(ta, c.lane, va, scr);
        const bool ha = it + 2 * step < end;
        if (ha) { ta = convert_item(c, it + 2 * step, part); tb_load(ta, c.lane, va); }
        if (hb) tb_store(tbk, c.lane, vb, scr);
    }
}
__device__ __forceinline__ void convert_steal(const Ctx& c, int part) {
    LAS float* scr = (LAS float*)c.lds + c.wave * (64 * 65);
    LAS int* chp = (LAS int*)(c.lds + 8 * 64 * 65 * 4);
    unsigned* ctr = (unsigned*)(c.ws + WS_CTL) + CW_CONV + 64 * part;
    for (;;) {
        __syncthreads();
        if (c.tid == 0) *chp = (int)atomicAdd(ctr, 1u);
        __syncthreads();
        const int ch = *chp;
        if (ch >= CONV_B / CONV_CHUNK) break;
        convert_run(c, part, ch * CONV_CHUNK + c.wave, 8, (ch + 1) * CONV_CHUNK, scr);
    }
}
__device__ __forceinline__ void phase_convert(const Ctx& c) {
    LAS float* scr = (LAS float*)c.lds + c.wave * (64 * 65);
    convert_run(c, 0, c.wg * 8 + c.wave, c.nwg * 8, CONV_A, scr);
    __syncthreads();
    phase_norm0(c);
}

__device__ __forceinline__ void phase_combine(const Ctx& c, int layer) {
    LAS int* so = (LAS int*)(c.lds + 32768);
    moe_offsets(c, layer, so);
    const unsigned char* outb = c.ws + WS_OUTB; bf16_t* X = (bf16_t*)(c.ws + WS_X);
    const bf16_t* Xin = layer == 0 ? X : (const bf16_t*)(c.ws + WS_X1);
    const float* ngl = c.a->in[6] + layer * 4 * D;
    const int* tk_e = (const int*)(c.ws + WS_TK); const float* tk_g = (const float*)(c.ws + WS_TK) + R * 4; const int* tk_slot = (const int*)(c.ws + WS_TK) + 2 * R * 4;
    const int r_lo = layer == 0 ? 0 : C, stride = c.nwg * 8;
    int r = r_lo + c.wg * 8 + c.wave;
    int pe[4], ps[4]; float pg[4]; unsigned wn[4][4]; f32x4 xn[4]; float gn[4];
#define CB_TK(row) do { _Pragma("unroll") for (int k = 0; k < 4; ++k) { pe[k] = tk_e[(row) * 4 + k]; ps[k] = tk_slot[(row) * 4 + k]; pg[k] = tk_g[(row) * 4 + k]; } } while (0)
#define CB_DATA(row) do { _Pragma("unroll") for (int k = 0; k < 4; ++k) { const unsigned char* src_ = outb + (size_t)(so[pe[k]] + ps[k]) * 1024; gn[k] = pg[k] * (1.f / F8_SO); \
        _Pragma("unroll") for (int j = 0; j < 4; ++j) wn[k][j] = *(const unsigned*)(src_ + c.lane * 4 + 256 * j); } row_load_bf(Xin + (size_t)(row) * D, c.lane, xn); } while (0)
    if (r < R) { CB_TK(r); CB_DATA(r); }
    if (r + stride < R) CB_TK(r + stride);
    for (; r < R; r += stride) {
        const float* m = c.modp(layer, r < C ? 1 : 0);
        f32x4 y[4], x[4];
#pragma unroll
        for (int j = 0; j < 4; ++j) { y[j] = (f32x4){0.f, 0.f, 0.f, 0.f}; x[j] = xn[j]; }
#pragma unroll
        for (int k = 0; k < 4; ++k)
#pragma unroll
            for (int j = 0; j < 4; ++j) { const f32x2 lo = __builtin_amdgcn_cvt_pk_f32_fp8((int)wn[k][j], false), hi = __builtin_amdgcn_cvt_pk_f32_fp8((int)wn[k][j], true); y[j] += (f32x4){lo[0], lo[1], hi[0], hi[1]} * gn[k]; }
        if (r + stride < R) CB_DATA(r + stride);
        if (r + 2 * stride < R) CB_TK(r + 2 * stride);
        const float rstd_y = rsqrtf(row_ss(y) * (1.f / D) + EPS);
#pragma unroll
        for (int j = 0; j < 4; ++j) {
            const int c0 = c.lane * 4 + 256 * j;
            const f32x4 g2 = *(const f32x4*)(m + 5120 + c0), n3 = *(const f32x4*)(ngl + 3 * D + c0);
            x[j].x += g2.x * (y[j].x * rstd_y * n3.x); x[j].y += g2.y * (y[j].y * rstd_y * n3.y);
            x[j].z += g2.z * (y[j].z * rstd_y * n3.z); x[j].w += g2.w * (y[j].w * rstd_y * n3.w);
            if (layer == 0) { u32x2 xo; xo.x = pk2(x[j][0], x[j][1]); xo.y = pk2(x[j][2], x[j][3]); *(u32x2*)(X + (size_t)r * D + c0) = xo; x[j] = (f32x4){bflo(xo.x), bfhi(xo.x), bflo(xo.y), bfhi(xo.y)}; }
            else *(f32x4*)(c.a->out + (size_t)(r - C) * D + c0) = x[j];
        }
        if (layer == 0) {
            const float rstd_x = rsqrtf(row_ss(x) * (1.f / D) + EPS);
            const float* m1 = c.modp(1, r < C ? 1 : 0); const float* g0 = c.a->in[6] + 4 * D;
#pragma unroll
            for (int j = 0; j < 4; ++j) {
                const int c0 = c.lane * 4 + 256 * j;
                const f32x4 gv = *(const f32x4*)(g0 + c0), shv = *(const f32x4*)(m1 + c0), scv = *(const f32x4*)(m1 + 1024 + c0);
                const f32x4 hv = x[j] * rstd_x * gv * (scv + 1.f) + shv;
                *(unsigned*)(c.ws + WS_H8 + (size_t)r * D + c0) = pk4_fp8(hv[0] * F8_SH, hv[1] * F8_SH, hv[2] * F8_SH, hv[3] * F8_SH);
            }
        }
    }
#undef CB_TK
#undef CB_DATA
}

namespace hg {
typedef _Float16 h2_t __attribute__((ext_vector_type(2)));
constexpr int TB = 272, PB = 144;
constexpr int TILE = 64 * TB;
constexpr int T_QD = 0, T_QC = TILE, T_KD = 2 * TILE, T_KE = 3 * TILE, T_KC = 4 * TILE, T_V0 = 5 * TILE, T_V1 = 6 * TILE;
constexpr int T_QL1 = 7 * TILE, T_KL1 = T_QL1 + 16 * TB, T_P = T_KL1 + 16 * TB, T_TOT = T_P + 64 * PB, T_CT = T_TOT + 4096, T_END = T_CT + 512;
static_assert(T_END <= LDS_BYTES - 64, "hgrn scan LDS map");
__device__ __forceinline__ int row_of(int dir, int p) { return p < C ? (dir ? C - 1 - p : p) : (dir ? C + (L - 1 - (p - C)) : p); }
__device__ __forceinline__ int seg_of(int ch) { return ch < 68 ? ch / 17 : 4 + (ch - 68) / 16; }
__device__ __forceinline__ bf16x8 tr_frag(const LAS unsigned char* tile, int row0, int col0, int lane) {
    const int q = (lane & 15) >> 2, p = lane & 3;
    const LAS unsigned char* a = tile + (row0 + q) * TB + (col0 + 4 * p) * 2;
    const v4i16_t lo = __builtin_amdgcn_ds_read_tr16_b64_v4i16((LAS v4i16_t*)a);
    const v4i16_t hi = __builtin_amdgcn_ds_read_tr16_b64_v4i16((LAS v4i16_t*)(a + 4 * TB));
    return (bf16x8){lo[0], lo[1], lo[2], lo[3], hi[0], hi[1], hi[2], hi[3]};
}
}

__device__ __forceinline__ void phase_hgrn_scan(const Ctx& c) {
    using namespace hg;
#define HG_BAR() asm volatile("s_waitcnt lgkmcnt(0)\n\ts_barrier" ::: "memory")
    const bf16_t* QH = (const bf16_t*)(c.ws + WS_QH); const bf16_t* IV = (const bf16_t*)(c.ws + WS_IV);
    LAS unsigned char* lds = c.lds;
    const int tid = c.tid, lane = c.lane, w = __builtin_amdgcn_readfirstlane(tid >> 6), fr = lane & 15, g = lane >> 4;
    for (int item_ = c.wg; item_ < 256 * SCAN_REP; item_ += c.nwg) {
        const int item = item_ & 255;
        const int chain = item >> 4, seg = item & 15, head = chain >> 1, dir = chain & 1, hc = head * 128;
        const int c0 = seg < 4 ? 17 * seg : 68 + 16 * (seg - 4), nch = seg < 4 ? 17 : 16;
        const _Float16* KX = (const _Float16*)(c.ws + (dir ? WS_KB : WS_KF));
        bf16_t* OL = (bf16_t*)(c.ws + (dir ? WS_OB : WS_OF)); bf16_t* QS = (bf16_t*)(c.ws + (dir ? WS_QSB : WS_QSF));
        HG_BAR();
        for (int i = tid; i < 64 * PB / 4; i += 512) ((LAS unsigned*)(lds + T_P))[i] = 0u;
        f32x4 Sacc[8];
#pragma unroll
        for (int m = 0; m < 8; ++m) Sacc[m] = (f32x4){0.f, 0.f, 0.f, 0.f};
        float dseg0 = 1.f, dseg1 = 1.f;
        unsigned kraw[8], qraw[8]; u32x4 vraw[2];
#define HG_LOAD(cidx) do { const int p0_ = 64 * (cidx); const bool lat_ = (cidx) >= 4; \
        _Pragma("unroll") for (int i = 0; i < 8; ++i) { const int r_ = row_of(dir, p0_ + 8 * w + i); \
            kraw[i] = *(const unsigned*)(KX + (size_t)r_ * D + hc + 2 * lane); \
            qraw[i] = lat_ ? *(const unsigned*)(QH + (size_t)(r_ - C) * D + hc + 2 * lane) : 0u; } \
        _Pragma("unroll") for (int i = 0; i < 2; ++i) { const int idx_ = tid + 512 * i; const int r_ = row_of(dir, p0_ + (idx_ >> 4)); \
            vraw[i] = *(const u32x4*)(IV + (size_t)r_ * D + hc + (idx_ & 15) * 8); } } while (0)
        HG_LOAD(c0);
        for (int ci = 0; ci < nch; ++ci) {
            const int cidx = c0 + ci; const bool lat = cidx >= 4;
            const int vbuf = (ci & 1) ? T_V1 : T_V0;
            float kf[8][2], qf[8][2], cp[8][2];
            {
                float p0 = 1.f, p1 = 1.f;
#pragma unroll
                for (int i = 0; i < 8; ++i) {
                    const h2_t hv = __builtin_bit_cast(h2_t, kraw[i]);
                    kf[i][0] = (float)hv[0]; kf[i][1] = (float)hv[1];
                    qf[i][0] = bflo(qraw[i]); qf[i][1] = bfhi(qraw[i]);
                    p0 *= (1.f - kf[i][0]); p1 *= (1.f - kf[i][1]); cp[i][0] = p0; cp[i][1] = p1;
                }
                *(LAS f32x2*)(lds + T_TOT + (w * 128 + 2 * lane) * 4) = (f32x2){p0, p1};
#pragma unroll
                for (int i = 0; i < 2; ++i) { const int idx = tid + 512 * i; *(LAS u32x4*)(lds + vbuf + (idx >> 4) * TB + (idx & 15) * 16) = vraw[i]; }
            }
            HG_BAR();
            {
                f32x2 T[8];
#pragma unroll
                for (int x = 0; x < 8; ++x) T[x] = *(const LAS f32x2*)(lds + T_TOT + (x * 128 + 2 * lane) * 4);
                const int I = w >> 1, hh = w & 1;
                f32x2 bd[4];
#pragma unroll
                for (int x = 0; x < 4; ++x) bd[x] = T[2 * x] * T[2 * x + 1];
                f32x2 pre = (f32x2){1.f, 1.f}, cum = (f32x2){1.f, 1.f}, suf = (f32x2){1.f, 1.f}, bdI = (f32x2){1.f, 1.f};
#pragma unroll
                for (int x = 0; x < 8; ++x) if (hh && x == w - 1) pre = T[x];
#pragma unroll
                for (int x = 0; x < 4; ++x) { if (x < I) cum = cum * bd[x]; if (x > I) suf = suf * bd[x]; if (x == I) bdI = bd[x]; }
                const f32x2 ctot = (bd[0] * bd[1]) * (bd[2] * bd[3]);
#pragma unroll
                for (int i = 0; i < 8; ++i) {
                    const int tau = 8 * w + i;
                    float QDv[2], KDv[2], KEv[2], QCv[2], KCv[2];
#pragma unroll
                    for (int x = 0; x < 2; ++x) {
                        const float eq = pre[x] * cp[i][x], rc = __builtin_amdgcn_rcpf(eq);
                        QDv[x] = qf[i][x] * eq; KDv[x] = kf[i][x] * rc; KEv[x] = KDv[x] * bdI[x]; QCv[x] = QDv[x] * cum[x]; KCv[x] = KEv[x] * suf[x];
                    }
                    const int to = tau * TB + lane * 4;
                    *(LAS unsigned*)(lds + T_QD + to) = pk2(QDv[0], QDv[1]);
                    *(LAS unsigned*)(lds + T_KD + to) = pk2(KDv[0], KDv[1]);
                    *(LAS unsigned*)(lds + T_KE + to) = pk2(KEv[0], KEv[1]);
                    *(LAS unsigned*)(lds + T_QC + to) = pk2(QCv[0], QCv[1]);
                    *(LAS unsigned*)(lds + T_KC + to) = pk2(KCv[0], KCv[1]);
                    if (I == 3) *(LAS unsigned*)(lds + T_QL1 + (tau - 48) * TB + lane * 4) = pk2(QDv[0] * bd[2][0], QDv[1] * bd[2][1]);
                    if (I == 0) *(LAS unsigned*)(lds + T_KL1 + tau * TB + lane * 4) = pk2(KEv[0] * bd[1][0], KEv[1] * bd[1][1]);
                    if (lat) { const int r = row_of(dir, 64 * cidx + tau); *(unsigned*)(QS + (size_t)(r - C) * D + hc + 2 * lane) = pk2(QCv[0] * dseg0, QCv[1] * dseg1); }
                }
                dseg0 *= ctot[0]; dseg1 *= ctot[1];
                if (w == 0) *(LAS f32x2*)(lds + T_CT + lane * 8) = ctot;
            }
            HG_BAR();
            if (ci + 1 < nch) HG_LOAD(cidx + 1);
            if (lat) {
                const int nblk = w >= 6 ? 2 : 1;
                for (int b = 0; b < nblk; ++b) {
                    int I, J, qoff, qrow, koff, krow; bool diag = false;
                    if (w < 4) { I = 2 + (w >> 1); J = w & 1; qoff = (w >> 1) ? T_QL1 : T_QD; qrow = (w >> 1) ? 0 : 32; koff = (w & 1) ? T_KE : T_KL1; krow = (w & 1) ? 16 : 0; }
                    else if (w == 4) { I = 1; J = 0; qoff = T_QD; qrow = 16; koff = T_KE; krow = 0; }
                    else if (w == 5) { I = 3; J = 2; qoff = T_QD; qrow = 48; koff = T_KE; krow = 32; }
                    else { I = 2 * (w - 6) + b; J = I; qoff = T_QD; qrow = 16 * I; koff = T_KD; krow = 16 * I; diag = true; }
                    f32x4 pa = (f32x4){0.f, 0.f, 0.f, 0.f};
#pragma unroll
                    for (int ks = 0; ks < 4; ++ks) {
                        const bf16x8 av = *(const LAS bf16x8*)(lds + qoff + (qrow + fr) * TB + (32 * ks + 8 * g) * 2);
                        const bf16x8 bv = *(const LAS bf16x8*)(lds + koff + (krow + fr) * TB + (32 * ks + 8 * g) * 2);
                        pa = __builtin_amdgcn_mfma_f32_16x16x32_bf16(av, bv, pa, 0, 0, 0);
                    }
#pragma unroll
                    for (int e = 0; e < 4; ++e) {
                        const int tl = 4 * g + e; const float val = (diag && fr > tl) ? 0.f : pa[e];
                        *(LAS bf16_t*)(lds + T_P + (16 * I + tl) * PB + (16 * J + fr) * 2) = (bf16_t)f2bf(val);
                    }
                }
            }
            f32x4 oacc[4];
#pragma unroll
            for (int m = 0; m < 4; ++m) oacc[m] = (f32x4){0.f, 0.f, 0.f, 0.f};
            if (lat) {
                bf16x8 Sb[4];
#pragma unroll
                for (int ks = 0; ks < 4; ++ks) {
                    const f32x4 a0 = Sacc[2 * ks], a1 = Sacc[2 * ks + 1];
                    const u32x4 pk = (u32x4){pk2(a0[0], a0[1]), pk2(a0[2], a0[3]), pk2(a1[0], a1[1]), pk2(a1[2], a1[3])};
                    Sb[ks] = __builtin_bit_cast(bf16x8, pk);
                }
#pragma unroll
                for (int m = 0; m < 4; ++m)
#pragma unroll
                    for (int ks = 0; ks < 4; ++ks) {
                        const u32x2 lo = *(const LAS u32x2*)(lds + T_QC + (16 * m + fr) * TB + (32 * ks + 4 * g) * 2);
                        const u32x2 hi = *(const LAS u32x2*)(lds + T_QC + (16 * m + fr) * TB + (32 * ks + 16 + 4 * g) * 2);
                        const u32x4 pk = (u32x4){lo.x, lo.y, hi.x, hi.y};
                        oacc[m] = __builtin_amdgcn_mfma_f32_16x16x32_bf16(__builtin_bit_cast(bf16x8, pk), Sb[ks], oacc[m], 0, 0, 0);
                    }
            }
#pragma unroll
            for (int m = 0; m < 8; ++m) { const f32x4 ct = *(const LAS f32x4*)(lds + T_CT + (16 * m + 4 * g) * 4); Sacc[m] = Sacc[m] * ct; }
            bf16x8 Vf[2];
#pragma unroll
            for (int ks = 0; ks < 2; ++ks) Vf[ks] = tr_frag(lds + vbuf, 32 * ks + 8 * g, 16 * w, lane);
#pragma unroll
            for (int m = 0; m < 8; ++m)
#pragma unroll
                for (int ks = 0; ks < 2; ++ks) Sacc[m] = __builtin_amdgcn_mfma_f32_16x16x32_bf16(tr_frag(lds + T_KC, 32 * ks + 8 * g, 16 * m, lane), Vf[ks], Sacc[m], 0, 0, 0);
            HG_BAR();
            if (lat) {
#pragma unroll
                for (int m = 0; m < 4; ++m)
#pragma unroll
                    for (int ks = 0; ks < 2; ++ks) {
                        if (m < 2 && ks == 1) continue;
                        const bf16x8 av = *(const LAS bf16x8*)(lds + T_P + (16 * m + fr) * PB + (32 * ks + 8 * g) * 2);
                        oacc[m] = __builtin_amdgcn_mfma_f32_16x16x32_bf16(av, Vf[ks], oacc[m], 0, 0, 0);
                    }
#pragma unroll
                for (int m = 0; m < 4; ++m)
#pragma unroll
                    for (int e = 0; e < 4; ++e) { const int r = row_of(dir, 64 * cidx + 16 * m + 4 * g + e); OL[(size_t)(r - C) * D + hc + 16 * w + fr] = (bf16_t)f2bf(oacc[m][e]); }
            }
        }
#undef HG_LOAD
        float* DS = (float*)(c.ws + WS_DS) + (size_t)item * 16384; float* DG = (float*)(c.ws + WS_DG) + item * 128;
#pragma unroll
        for (int m = 0; m < 8; ++m)
#pragma unroll
            for (int e = 0; e < 4; ++e) DS[(16 * m + 4 * g + e) * 128 + 16 * w + fr] = Sacc[m][e];
        if (w == 0) { DG[2 * lane] = dseg0; DG[2 * lane + 1] = dseg1; }
    }
}

#undef HG_BAR
__device__ __forceinline__ void phase_hgrn_fold(const Ctx& c) {
    const float* DS = (const float*)(c.ws + WS_DS); const float* DG = (const float*)(c.ws + WS_DG); bf16_t* SST = (bf16_t*)(c.ws + WS_SST);
    for (int item = c.wg; item < 256; item += c.nwg) {
        const int chain = item >> 4, slice = item & 15, d = 8 * slice + (c.tid >> 6), v2 = (c.tid & 63) * 2;
        float s0 = 0.f, s1 = 0.f;
        float dv[15]; f32x2 ds[15];
#pragma unroll
        for (int sgi = 0; sgi < 15; ++sgi) { dv[sgi] = DG[(chain * 16 + sgi) * 128 + d]; ds[sgi] = *(const f32x2*)(DS + ((size_t)(chain * 16 + sgi) * 128 + d) * 128 + v2); }
        SST[((size_t)(chain * 16) * 128 + v2) * 128 + d] = 0; SST[((size_t)(chain * 16) * 128 + v2 + 1) * 128 + d] = 0;
#pragma unroll
        for (int sgi = 0; sgi < 15; ++sgi) {
            s0 = dv[sgi] * s0 + ds[sgi][0]; s1 = dv[sgi] * s1 + ds[sgi][1];
            SST[((size_t)(chain * 16 + sgi + 1) * 128 + v2) * 128 + d] = (bf16_t)f2bf(s0); SST[((size_t)(chain * 16 + sgi + 1) * 128 + v2 + 1) * 128 + d] = (bf16_t)f2bf(s1);
        }
    }
}

__device__ __forceinline__ void phase_hgrn_readout(const Ctx& c) {
    constexpr int SP = 272, SBUF = 128 * SP, IBUF = 2 * SBUF;
    static_assert(2 * IBUF + 1024 <= LDS_BYTES - 64, "readout LDS map");
    const bf16_t* OF = (const bf16_t*)(c.ws + WS_OF); const bf16_t* OB = (const bf16_t*)(c.ws + WS_OB); const bf16_t* SGp = (const bf16_t*)(c.ws + WS_SG);
    const bf16_t* SST = (const bf16_t*)(c.ws + WS_SST); bf16_t* RR = (bf16_t*)(c.ws + WS_RR); const float* hng = c.a->in[13];
    LAS unsigned char* lds = c.lds; LAS float* ssx = (LAS float*)(c.lds + 2 * IBUF);
    const int tid = c.tid, lane = c.lane, w = __builtin_amdgcn_readfirstlane(tid >> 6), fr = lane & 15, g = lane >> 4, mt = w & 3, nh = w >> 2;
#define RO_BAR() asm volatile("s_waitcnt lgkmcnt(0)\n\ts_barrier" ::: "memory")
    u32x4 sreg[8];
#define RO_SST_LOAD(it) do { const int h_ = (it) >> 8, ch_ = (it) & 255; \
        _Pragma("unroll") for (int j = 0; j < 8; ++j) { const int idx_ = tid + 512 * j, dx_ = idx_ >> 11, rem_ = idx_ & 2047; \
            const int sg_ = hg::seg_of(dx_ ? 4 + 255 - ch_ : 4 + ch_); \
            sreg[j] = *(const u32x4*)(SST + ((size_t)((h_ * 2 + dx_) * 16 + sg_) * 128 + (rem_ >> 4)) * 128 + (rem_ & 15) * 8); } } while (0)
#define RO_SST_WRITE(buf) do { _Pragma("unroll") for (int j = 0; j < 8; ++j) { const int idx_ = tid + 512 * j, dx_ = idx_ >> 11, rem_ = idx_ & 2047; \
            *(LAS u32x4*)(lds + (buf) * IBUF + dx_ * SBUF + (rem_ >> 4) * SP + (rem_ & 15) * 16) = sreg[j]; } } while (0)
    int it = c.wg;
    RO_BAR();
    if (it < 2048) { RO_SST_LOAD(it); RO_SST_WRITE(0); }
    RO_BAR();
    for (int k = 0; it < 2048; it += c.nwg, ++k) {
        const int h = it >> 8, ch = it & 255, t0 = 64 * ch + 16 * mt, buf = k & 1;
        const bool has_next = it + c.nwg < 2048;
        if (has_next) RO_SST_LOAD(it + c.nwg);
        f32x4 acc[4]; float sgv[4][4];
#pragma unroll
        for (int n = 0; n < 4; ++n)
#pragma unroll
            for (int e = 0; e < 4; ++e) { const size_t o = (size_t)(t0 + 4 * g + e) * D + h * 128 + 64 * nh + 16 * n + fr; acc[n][e] = bf2f(OF[o]) + bf2f(OB[o]); sgv[n][e] = bf2f(SGp[o]) * hng[h * 128 + 64 * nh + 16 * n + fr]; }
#pragma unroll
        for (int dx = 0; dx < 2; ++dx) {
            const bf16_t* QS = (const bf16_t*)(c.ws + (dx ? WS_QSB : WS_QSF)) + (size_t)(t0 + fr) * D + h * 128 + 8 * g;
            const LAS unsigned char* sb = lds + buf * IBUF + dx * SBUF + (64 * nh + fr) * SP + 16 * g;
#pragma unroll
            for (int ks = 0; ks < 4; ++ks) {
                const bf16x8 av = *(const bf16x8*)(QS + 32 * ks);
#pragma unroll
                for (int n = 0; n < 4; ++n) acc[n] = __builtin_amdgcn_mfma_f32_16x16x32_bf16(av, *(const LAS bf16x8*)(sb + (16 * n) * SP + 64 * ks), acc[n], 0, 0, 0);
            }
        }
        float ss[4] = {0.f, 0.f, 0.f, 0.f};
#pragma unroll
        for (int n = 0; n < 4; ++n)
#pragma unroll
            for (int e = 0; e < 4; ++e) ss[e] += acc[n][e] * acc[n][e];
#pragma unroll
        for (int e = 0; e < 4; ++e) {
#pragma unroll
            for (int sh = 8; sh > 0; sh >>= 1) ss[e] += __shfl_xor(ss[e], sh);
        }
        if (fr == 0) *(LAS f32x4*)(ssx + ((k & 1) * 8 + w) * 16 + 4 * g) = (f32x4){ss[0], ss[1], ss[2], ss[3]};
        if (has_next) RO_SST_WRITE(buf ^ 1);
        RO_BAR();
        const f32x4 ps = *(const LAS f32x4*)(ssx + ((k & 1) * 8 + (w ^ 4)) * 16 + 4 * g);
#pragma unroll
        for (int e = 0; e < 4; ++e) ss[e] = rsqrtf((ss[e] + ps[e]) * (1.f / 128.f) + EPS);
#pragma unroll
        for (int n = 0; n < 4; ++n)
#pragma unroll
            for (int e = 0; e < 4; ++e) { const size_t o = (size_t)(t0 + 4 * g + e) * D + h * 128 + 64 * nh + 16 * n + fr; RR[o] = (bf16_t)f2bf(acc[n][e] * ss[e] * sgv[n][e]); }
    }
    RO_BAR();
#undef RO_BAR
#undef RO_SST_LOAD
#undef RO_SST_WRITE
}

#define XB_TMO      128
#define XB_XCNT(j)  (256  + 64 * (j))
#define XB_XSUB(j)  (1280 + 64 * (j))
#define XB_XGEN(j)  (2304 + 64 * (j))
#define XB_TOP      3328
#define XB_TOPGEN   3392
#define XCD_BAR_WORDS 3456
#define XB_SPIN_CAP (1u << 18)
__device__ __forceinline__ unsigned xb_ld(unsigned* p)              { return __hip_atomic_load(p, __ATOMIC_RELAXED, __HIP_MEMORY_SCOPE_AGENT); }
__device__ __forceinline__ unsigned xb_add(unsigned* p, unsigned v) { return __hip_atomic_fetch_add(p, v, __ATOMIC_RELAXED, __HIP_MEMORY_SCOPE_AGENT); }
__device__ __forceinline__ unsigned xb_xcc_id() { return (unsigned)__builtin_amdgcn_s_getreg((3 << 11) | 20) & 0xFu; }
#define XB_SPIN(cond, bar) do { unsigned _sp = 0; while (cond) { __builtin_amdgcn_s_sleep(1); \
    if ((++_sp & 255u) == 0u) { if (xb_ld(&(bar)[XB_TMO])) break; if (_sp > XB_SPIN_CAP) { atomicAdd(&(bar)[XB_TMO], 1u); break; } } } } while (0)
struct XcdBarrier { unsigned* bar; unsigned x; volatile LAS unsigned* st; };
__device__ __forceinline__ XcdBarrier xcd_barrier_post(unsigned* bar, volatile LAS unsigned* st) {
    XcdBarrier b; b.bar = bar; b.x = xb_xcc_id(); b.st = st;
    if (threadIdx.x == 0) (void)xb_add(&bar[XB_XCNT(b.x)], 1u);
    return b;
}
__device__ __forceinline__ void xcd_barrier_complete(unsigned* bar, unsigned x, unsigned& nloc, unsigned& nx) {
    const unsigned G = gridDim.x * gridDim.y * gridDim.z;
    unsigned sum, cnt, mine, sp = 0u;
    for (;;) {
        sum = 0u; cnt = 0u; mine = 0u;
#pragma unroll
        for (unsigned j = 0; j < 16; ++j) { const unsigned c = xb_ld(&bar[XB_XCNT(j)]); sum += c; cnt += (c > 0u) ? 1u : 0u; mine = (j == x) ? c : mine; }
        if (sum == G) break;
        __builtin_amdgcn_s_sleep(1);
        if ((++sp & 255u) == 0u) { if (xb_ld(&bar[XB_TMO])) break; if (sp > XB_SPIN_CAP) { atomicAdd(&bar[XB_TMO], 1u); break; } }
    }
    nloc = mine > 0u ? mine : 1u; nx = cnt > 0u ? cnt : 1u;
}
__device__ __forceinline__ void xcd_barrier(const XcdBarrier& b) {
    asm volatile("s_waitcnt vmcnt(0)" ::: "memory");
    __syncthreads();
    if (threadIdx.x == 0) {
        unsigned* bar = b.bar;
        __builtin_amdgcn_s_waitcnt(0);
        unsigned nloc = b.st[0], nx = b.st[1];
        if (nloc == 0u) { xcd_barrier_complete(bar, b.x, nloc, nx); b.st[0] = nloc; b.st[1] = nx; }
        const unsigned old = xb_add(&bar[XB_XSUB(b.x)], 1u);
        const unsigned gen = old / nloc;
        if (old + 1u == (gen + 1u) * nloc) {
            __builtin_amdgcn_fence(__ATOMIC_RELEASE, "agent");
            asm volatile("s_waitcnt vmcnt(0)" ::: "memory");
            const unsigned og = xb_add(&bar[XB_TOP], 1u);
            const unsigned tg = og / nx;
            if (og + 1u == (tg + 1u) * nx) xb_add(&bar[XB_TOPGEN], 1u);
            else XB_SPIN(xb_ld(&bar[XB_TOPGEN]) == tg, bar);
            __builtin_amdgcn_fence(__ATOMIC_ACQUIRE, "agent");
            xb_add(&bar[XB_XGEN(b.x)], 1u);
            asm volatile("s_waitcnt vmcnt(0)" ::: "memory");
        } else {
            XB_SPIN(xb_ld(&bar[XB_XGEN(b.x)]) == gen, bar);
            __builtin_amdgcn_fence(__ATOMIC_ACQUIRE, "agent");
            asm volatile("s_waitcnt vmcnt(0)" ::: "memory");
        }
    }
    __syncthreads();
}

__device__ __forceinline__ void launder(Ctx& c) { asm volatile("" : "+s"(c.a)); asm volatile("" : "+s"(c.ws)); asm volatile("" : "+s"(c.wave));
    c.lane = (int)__builtin_amdgcn_mbcnt_hi(~0u, __builtin_amdgcn_mbcnt_lo(~0u, 0u)); c.tid = c.wave * 64 + c.lane; }
__global__ void __launch_bounds__(512, 2) mk_fwd(Args args) {
    extern __shared__ __attribute__((aligned(16))) unsigned char lds_raw[];
    Ctx c; c.a = (CArgs)__builtin_amdgcn_kernarg_segment_ptr(); c.lds = (LAS unsigned char*)lds_raw; c.tid = threadIdx.x; c.lane = c.tid & 63; c.wave = __builtin_amdgcn_readfirstlane(c.tid >> 6); c.nwg = gridDim.x; c.wg = blockIdx.x; c.ws = c.a->ws;
    volatile LAS unsigned* bst = (volatile LAS unsigned*)(c.lds + LDS_BYTES - 64);
    if (c.tid < 4) bst[c.tid] = 0u;
    __syncthreads();
    const XcdBarrier bar = xcd_barrier_post((unsigned*)(c.ws + WS_CTL) + CW_BAR, bst);
    const int lo = c.a->ph_lo, hi = c.a->ph_hi;
    bool route_ok = true;
#define SEAM(k) do { if (lo <= (k) && (k) + 1 < hi) xcd_barrier(bar); } while (0)
#define IN(k) (lo <= (k) && (k) < hi && (launder(c), true))
#define PH(k, call) do { if (IN(k)) { if (PROBE_PH == (k)) { int nrep_ = 3; asm volatile("" : "+s"(nrep_)); for (int rep_ = 0; rep_ < nrep_; ++rep_) { route_ok = (rep_ + 1 == nrep_); call; if (rep_ + 1 < nrep_) xcd_barrier(bar); } } else { call; } } SEAM(k); } while (0)
    PH(0, phase_prep(c));
    PH(1, phase_convert(c));
    PH(2, phase_gemm_qkv(c));
    PH(3, phase_attn(c));
    PH(4, phase_gemm_f32(c, (const bf16_t*)(c.ws + WS_O), R, (const bf16_t*)(c.ws + WS_WO), D, nullptr, (bf16_t*)(c.ws + WS_RAW1)));
    PH(5, { phase_postmix<128>(c, 0, route_ok); convert_steal(c, 1); });
    PH(6, phase_moe_gu(c, 0));
    PH(7, phase_moe_dn(c, 0));
    PH(8, phase_combine(c, 0));
    PH(9, phase_gemm_inproj(c));
    PH(10, phase_hgrn_scan(c));
    PH(11, phase_hgrn_fold(c));
    PH(12, phase_hgrn_readout(c));
    PH(13, phase_gemm_f32(c, (const bf16_t*)(c.ws + WS_RR), L, (const bf16_t*)(c.ws + WS_WHO), D, nullptr, (bf16_t*)(c.ws + WS_RAW1)));
    PH(14, { phase_postmix<128>(c, 1, route_ok); convert_steal(c, 2); });
    PH(15, phase_moe_gu(c, 1));
    PH(16, phase_moe_dn(c, 1));
    PH(17, phase_combine(c, 1));
#undef IN
#undef PH
#undef SEAM
}

extern "C" void kernel_launch(void* const* d_in, const int* in_sizes, int n_in, void* d_out, int out_size, void* d_ws, size_t ws_size, hipStream_t stream) {
    static int grid = 0;
    if (grid == 0) {
        if (n_in != 21 || out_size != L * D || ws_size < WS_END) { fprintf(stderr, "kernel_launch: unexpected problem (n_in %d out %d ws %zu need %zu)\n", n_in, out_size, ws_size, (size_t)WS_END); grid = -1; return; }
        int dev = 0, cus = 0, per_cu = 0;
        hipGetDevice(&dev); hipDeviceGetAttribute(&cus, hipDeviceAttributeMultiprocessorCount, dev);
        if (hipFuncSetAttribute((const void*)mk_fwd, hipFuncAttributeMaxDynamicSharedMemorySize, LDS_BYTES) != hipSuccess) { fprintf(stderr, "kernel_launch: hipFuncSetAttribute failed\n"); grid = -1; return; }
        hipOccupancyMaxActiveBlocksPerMultiprocessor(&per_cu, (const void*)mk_fwd, 512, LDS_BYTES);
        if (per_cu < 1) fprintf(stderr, "kernel_launch: occupancy query says %d\n", per_cu);
        (void)hipGetLastError();
        grid = cus > 0 ? cus : 256;
    }
    if (grid < 0) return;
    hipMemsetAsync((char*)d_ws + WS_CTL, 0, MiB, stream);
    Args a{};
    for (int i = 0; i < 21; ++i) a.in[i] = (const float*)d_in[i];
    a.out = (float*)d_out; a.ws = (unsigned char*)d_ws;
    a.ph_lo = 0; a.ph_hi = NPHASE;
    hipLaunchKernelGGL(mk_fwd, dim3(grid), dim3(512), LDS_BYTES, stream, a);
}
```

```cpp
#include <hip/hip_runtime.h>
#include <cstdint>
#include <cstdio>

#define LAS __attribute__((address_space(3)))
typedef unsigned short bf16_t;
typedef short bf16x8 __attribute__((ext_vector_type(8)));
typedef float f32x4 __attribute__((ext_vector_type(4)));
typedef unsigned u32x4 __attribute__((ext_vector_type(4)));
typedef unsigned u32x2 __attribute__((ext_vector_type(2)));
typedef short v4i16_t __attribute__((ext_vector_type(4)));
typedef float f32x2 __attribute__((ext_vector_type(2)));

constexpr int D = 1024, L = 16384, C = 256, R = L + C;
constexpr int QKVD = 1280, HIN = 5120, NE = 32, TOPK = 4;
constexpr int PADM = 256, MAXROWS = 74752;
constexpr float EPS = 1e-6f;
constexpr float LOG2E = 1.4426950408889634f;
constexpr int NPHASE = 18;
#ifndef GEMM_REP
#define GEMM_REP 1
#endif
#ifndef PROBE_NOEPI
#define PROBE_NOEPI 0
#endif
#ifndef PROBE_SHORTK
#define PROBE_SHORTK 0
#endif
#ifndef SCAN_REP
#define SCAN_REP 1
#endif
#ifndef PROBE_PH
#define PROBE_PH (-1)
#endif
constexpr int LDS_BYTES = 147456;

constexpr size_t MiB = 1u << 20;
constexpr size_t al(size_t x) { return (x + MiB - 1) / MiB * MiB; }
constexpr size_t WS_CTL = 0;
constexpr size_t WS_MOD = WS_CTL + MiB;
constexpr size_t WS_X = WS_MOD + MiB;
constexpr size_t WS_H = WS_X + al((size_t)R * D * 4);
constexpr size_t WS_Q = WS_H + al((size_t)R * D * 2);
constexpr size_t WS_K = WS_Q + al((size_t)R * D * 2);
constexpr size_t WS_V = WS_K + al((size_t)R * 128 * 2);
constexpr size_t WS_O = WS_V + al((size_t)R * 128 * 2);
constexpr size_t WS_TK = WS_O + al((size_t)R * D * 2);
constexpr size_t WS_LIST = WS_TK + MiB;
constexpr size_t WS_HDN = WS_LIST + 3 * MiB;
constexpr size_t WS_RAW1 = WS_HDN + al((size_t)MAXROWS * 1024 * 2);
constexpr size_t WS_X1 = WS_RAW1 + al((size_t)R * D * 4);
constexpr size_t WS_OUTB = WS_X1 + al((size_t)R * D * 4);
constexpr size_t WS_QH = WS_OUTB + al((size_t)MAXROWS * 1024 * 2);
constexpr size_t WS_KF = WS_QH + al((size_t)L * D * 2);
constexpr size_t WS_KB = WS_KF + al((size_t)R * D * 2);
constexpr size_t WS_IV = WS_KB + al((size_t)R * D * 2);
constexpr size_t WS_SG = WS_IV + al((size_t)R * D * 2);
constexpr size_t WS_OF = WS_SG + al((size_t)L * D * 2);
constexpr size_t WS_OB = WS_OF + al((size_t)L * D * 4);
constexpr size_t WS_RR = WS_OB + al((size_t)L * D * 4);
constexpr size_t WS_WQKV = WS_RR + al((size_t)L * D * 2);
constexpr size_t WS_WO = WS_WQKV + al((size_t)QKVD * D * 2);
constexpr size_t WS_WIN = WS_WO + al((size_t)D * D * 2);
constexpr size_t WS_WHO = WS_WIN + al((size_t)HIN * D * 2);
constexpr size_t WS_WGU = WS_WHO + al((size_t)D * D * 2);
constexpr size_t WS_WDN = WS_WGU + al((size_t)2 * NE * 2048 * D * 2);
constexpr size_t WS_QSF = WS_WDN + al((size_t)2 * NE * 1024 * D * 2);
constexpr size_t WS_QSB = WS_QSF + al((size_t)L * D * 2);
constexpr size_t WS_DS = WS_QSB + al((size_t)L * D * 2);
constexpr size_t WS_DG = WS_DS + al((size_t)256 * 128 * 128 * 4);
constexpr size_t WS_SST = WS_DG + MiB;
constexpr size_t WS_H8 = WS_SST + al((size_t)256 * 128 * 128 * 2);
constexpr size_t WS_END = WS_H8 + al((size_t)R * D);
static_assert(WS_END <= (size_t)2048 * MiB, "workspace map exceeds 4x the largest input");
constexpr int CW_CNT = 1024;
constexpr int CW_CONV = 2048;
constexpr int CW_BAR = 4096;
constexpr int MOD_ROPE = 32768;
constexpr int MOD_LB = 49152;

struct Args { const float* in[21]; float* out; unsigned char* ws; int ph_lo, ph_hi; };

__device__ __forceinline__ unsigned f2bf(float f) { unsigned u = __float_as_uint(f); return (u + 0x7fffu + ((u >> 16) & 1u)) >> 16; }
typedef float f32x2_t __attribute__((ext_vector_type(2))); typedef __bf16 bf16x2_t __attribute__((ext_vector_type(2)));
__device__ __forceinline__ unsigned pk2(float lo, float hi) { f32x2_t v = {lo, hi}; bf16x2_t b = __builtin_convertvector(v, bf16x2_t); return __builtin_bit_cast(unsigned, b); }
__device__ __forceinline__ unsigned pk4_fp8(float a, float b, float c, float d) {
    a = fminf(fmaxf(a, -448.f), 448.f); b = fminf(fmaxf(b, -448.f), 448.f); c = fminf(fmaxf(c, -448.f), 448.f); d = fminf(fmaxf(d, -448.f), 448.f);
    int v = __builtin_amdgcn_cvt_pk_fp8_f32(a, b, 0, false); v = __builtin_amdgcn_cvt_pk_fp8_f32(c, d, v, true); return (unsigned)v; }
constexpr float F8_SH = 8.f, F8_SW = 64.f, F8_SHD = 4.f, F8_SO = 16.f;
__device__ __forceinline__ float bflo(unsigned u) { return __uint_as_float(u << 16); }
__device__ __forceinline__ float bfhi(unsigned u) { return __uint_as_float(u & 0xffff0000u); }
__device__ __forceinline__ float bf2f(bf16_t b) { return __uint_as_float(((unsigned)b) << 16); }
__device__ __forceinline__ float xadd16(float x) { const auto a = __builtin_amdgcn_permlane16_swap(__float_as_uint(x), __float_as_uint(x), false, false); return __uint_as_float(a[0]) + __uint_as_float(a[1]); }
__device__ __forceinline__ float xadd32(float x) { const auto a = __builtin_amdgcn_permlane32_swap(__float_as_uint(x), __float_as_uint(x), false, false); return __uint_as_float(a[0]) + __uint_as_float(a[1]); }
__device__ __forceinline__ float xmax16(float x) { const auto a = __builtin_amdgcn_permlane16_swap(__float_as_uint(x), __float_as_uint(x), false, false); return fmaxf(__uint_as_float(a[0]), __uint_as_float(a[1])); }
__device__ __forceinline__ float xmax32(float x) { const auto a = __builtin_amdgcn_permlane32_swap(__float_as_uint(x), __float_as_uint(x), false, false); return fmaxf(__uint_as_float(a[0]), __uint_as_float(a[1])); }
__device__ __forceinline__ float wave_sum(float v) {
#pragma unroll
    for (int o = 8; o > 0; o >>= 1) v += __shfl_xor(v, o);
    return xadd32(xadd16(v));
}
__device__ __forceinline__ float silu_f(float x) { return x / (1.f + __expf(-x)); }
__device__ __forceinline__ float sigmoid_f(float x) { return 1.f / (1.f + __expf(-x)); }

typedef const __attribute__((address_space(4))) Args* CArgs;
struct Ctx {
    CArgs a;
    LAS unsigned char* lds;
    int tid, lane, wave, nwg, wg;
    unsigned char* ws;
    __device__ __forceinline__ float* modp(int layer, int which) const { return (float*)(ws + WS_MOD) + (layer * 2 + which) * 6144; }
    __device__ __forceinline__ const float* xin0(int r) const { return r < C ? a->in[2] + (size_t)r * D : a->in[0] + (size_t)(r - C) * D; }
};


namespace pg8 {
constexpr int BM = 256, BK = 64, HALF = 128, HTB = HALF * BK * 2, STAGE_BYTES = 8 * HTB, KD = 1024, NXCD = 8, WGM = 8;
__device__ __forceinline__ int lds_byte(int r, int c) { const int st = (r >> 4) * 2 + (c >> 5), rr = r & 15, cc = c & 31, ob = rr * 64 + cc * 2; return st * 1024 + (ob ^ (((ob >> 9) & 1) << 5)); }
__device__ __forceinline__ void stage_rc(int b, int& Rr, int& Cc) { const int st = b / 1024, sb = b % 1024, swz = sb ^ (((sb >> 9) & 1) << 5); Rr = (st >> 1) * 16 + swz / 64; Cc = (st & 1) * 32 + (swz % 64) / 2; }
__device__ __forceinline__ int perm32(int rho) { const int n = rho >> 4, i = rho & 15; return 8 * (i >> 2) + 4 * n + (i & 3); }

struct Unit { int pm, pn, e, goff, gcnt; bool real; int amask, bmask; };
struct Gemm { const void* A; const void* Bt; size_t bstride; const int* list; };

struct StaticOrder {
    int nM, nN, nwg, G, c;
    __device__ __forceinline__ void init(int M, int N, int G_, int c_) { nM = M / BM; nN = N / BM; nwg = nM * nN; G = G_; c = c_; }
    __device__ __forceinline__ bool next(int i, Unit& u) const {
        const int F = nwg / G, Rm = nwg - F * G; int Lq; u.amask = 3; u.bmask = 3;
        if (i < F) Lq = i * G + c;
        else if (i == F && Rm > 0) {
            if (4 * Rm <= G) { if (c >= 4 * Rm) return false; Lq = F * G + (c >> 2); u.amask = 1 << ((c >> 1) & 1); u.bmask = 1 << (c & 1); }
            else if (2 * Rm <= G) { if (c >= 2 * Rm) return false; Lq = F * G + (c >> 1); u.bmask = 1 << (c & 1); }
            else { if (c >= Rm) return false; Lq = F * G + c; }
        } else return false;
        int wgid = Lq; { const int q = nwg / NXCD, r = nwg % NXCD, xcd = wgid % NXCD, off = wgid / NXCD; wgid = (xcd < r ? xcd * (q + 1) : r * (q + 1) + (xcd - r) * q) + off; }
        const int nig = WGM * nN, gid = wgid / nig, fm = gid * WGM, gsz = (nM - fm) < WGM ? (nM - fm) : WGM;
        u.pm = fm + ((wgid % nig) % gsz); u.pn = (wgid % nig) / gsz; u.e = 0; u.goff = 0; u.gcnt = 0; u.real = true; return true;
    }
};
struct MoeOrder {
    const LAS int* tp; const LAS int* cnt; int npn, G, vcu; bool split;
    __device__ __forceinline__ bool next(int i, Unit& u) const {
        const int tot = tp[32] * npn; int lin; u.amask = 3; u.bmask = 3; u.real = true;
        if (GEMM_REP > 1) { const int lin0 = i * G + vcu; if (lin0 >= tot * GEMM_REP) return false; lin = lin0 % tot; u.real = lin0 >= tot * (GEMM_REP - 1); }
        else {
            const int F = tot / G, Rm = tot - F * G;
            if (i < F) lin = i * G + vcu;
            else if (i == F && Rm > 0) {
                if (split && 2 * Rm <= G) { if (vcu >= 2 * Rm) return false; lin = F * G + (vcu >> 1); u.bmask = 1 << (vcu & 1); }
                else { if (vcu >= Rm) return false; lin = F * G + vcu; }
            } else return false;
        }
        const int rt = lin / npn; int e = 0;
#pragma unroll 8
        for (int k = 1; k < 32; ++k) e += (rt >= tp[k]) ? 1 : 0;
        const int mt = rt - tp[e];
        u.pm = rt; u.pn = lin - rt * npn; u.e = e; u.goff = e * R + mt * 256; u.gcnt = cnt[e] - mt * 256; return true;
    }
};

template <int KB>
__device__ __forceinline__ void a_offsets(const Gemm& g, const Unit& u, const int (&sR)[2], const int (&sC)[2], unsigned (&v)[2][2]) {
#pragma unroll
    for (int h = 0; h < 2; ++h)
#pragma unroll
        for (int i = 0; i < 2; ++i) {
            const int rr = h * HALF + sR[i]; int row;
            if (g.list) row = rr < u.gcnt ? g.list[u.goff + rr] : 0; else row = u.pm * BM + rr;
            v[h][i] = (unsigned)(row * KB + sC[i] * 2);
        }
}

struct EpiF32 {
    static constexpr bool PERM = false;
    bf16_t* Cp; int ldc; const float* bias;
    __device__ __forceinline__ void operator()(const f32x4 (&acc)[2][2][4][2], const Unit& u, int wr, int wc, int fr, int fq) const {
        const int row0 = u.pm * BM + wr * 64 + fr, col0 = u.pn * BM + wc * 32 + 4 * fq;
#pragma unroll
        for (int bj = 0; bj < 2; ++bj)
#pragma unroll
            for (int n = 0; n < 2; ++n) {
                const int col = col0 + bj * HALF + n * 16;
                if (!((u.bmask >> bj) & 1)) continue;
                const f32x4 bv = bias ? *(const f32x4*)(bias + col) : (f32x4){0.f, 0.f, 0.f, 0.f};
#pragma unroll
                for (int ai = 0; ai < 2; ++ai)
#pragma unroll
                    for (int m = 0; m < 4; ++m) if ((u.amask >> ai) & 1) { const f32x4 v = acc[ai][bj][m][n] + bv; u32x2 o; o.x = pk2(v[0], v[1]); o.y = pk2(v[2], v[3]);
                        *(u32x2*)(Cp + (size_t)(row0 + ai * HALF + m * 16) * ldc + col) = o; }
            }
    }
};
struct EpiSwiglu {
    static constexpr bool PERM = true;
    unsigned char* Hd; const float* bgu;
    __device__ __forceinline__ void operator()(const f32x4 (&acc)[2][2][4][2], const Unit& u, int wr, int wc, int fr, int fq) const {
        const int row0 = u.pm * BM + wr * 64 + fr, cg0 = u.pn * HALF + wc * 32 + 8 * fq;
        const float* bb = bgu + (size_t)u.e * 2048;
        f32x4 bg[2], bu[2];
#pragma unroll
        for (int n = 0; n < 2; ++n) { bg[n] = *(const f32x4*)(bb + cg0 + 4 * n); bu[n] = *(const f32x4*)(bb + 1024 + cg0 + 4 * n); }
#pragma unroll
        for (int ai = 0; ai < 2; ++ai)
#pragma unroll
            for (int m = 0; m < 4; ++m) {
                u32x2 o;
#pragma unroll
                for (int n = 0; n < 2; ++n) {
                    const f32x4 gv = acc[ai][0][m][n] * (1.f / (F8_SH * F8_SW)) + bg[n], uv = acc[ai][1][m][n] * (1.f / (F8_SH * F8_SW)) + bu[n]; float hv[4];
#pragma unroll
                    for (int q = 0; q < 4; ++q) { const float gg = fminf(gv[q], 7.f), uu = fminf(fmaxf(uv[q], -7.f), 7.f); hv[q] = gg * __builtin_amdgcn_rcpf(1.f + __builtin_amdgcn_exp2f(-1.702f * LOG2E * gg)) * (uu + 1.f); }
                    o[n] = pk4_fp8(hv[0] * F8_SHD, hv[1] * F8_SHD, hv[2] * F8_SHD, hv[3] * F8_SHD);
                }
                *(u32x2*)(Hd + (size_t)(row0 + ai * HALF + m * 16) * 1024 + cg0) = o;
            }
    }
};
struct EpiBf16Bias {
    static constexpr bool PERM = true;
    unsigned char* Op; const float* bias; int bias_estride; float scale;
    __device__ __forceinline__ void operator()(const f32x4 (&acc)[2][2][4][2], const Unit& u, int wr, int wc, int fr, int fq) const {
        const int row0 = u.pm * BM + wr * 64 + fr, col0 = u.pn * BM + wc * 32 + 8 * fq;
        const float* bb = bias + (size_t)u.e * bias_estride;
#pragma unroll
        for (int bj = 0; bj < 2; ++bj) {
            const int col = col0 + bj * HALF;
            if (!((u.bmask >> bj) & 1)) continue;
            const f32x4 b0 = *(const f32x4*)(bb + col) * F8_SO, b1 = *(const f32x4*)(bb + col + 4) * F8_SO;
#pragma unroll
            for (int ai = 0; ai < 2; ++ai)
#pragma unroll
                for (int m = 0; m < 4; ++m) { if (!((u.amask >> ai) & 1)) continue; const f32x4 v0 = acc[ai][bj][m][0] * (scale * F8_SO) + b0, v1 = acc[ai][bj][m][1] * (scale * F8_SO) + b1;
                    u32x2 o; o.x = pk4_fp8(v0[0], v0[1], v0[2], v0[3]); o.y = pk4_fp8(v1[0], v1[1], v1[2], v1[3]);
                    *(u32x2*)(Op + (size_t)(row0 + ai * HALF + m * 16) * 1024 + col) = o; }
        }
    }
};
struct EpiQKV {
    static constexpr bool PERM = false;
    bf16_t* Qp; bf16_t* Kp; bf16_t* Vp; const float* bias; const float* tab;
    __device__ __forceinline__ void operator()(const f32x4 (&acc)[2][2][4][2], const Unit& u, int wr, int wc, int fr, int fq) const {
        const bool lat = u.pm > 0; const float qs = 0.125f * LOG2E;
#pragma unroll
        for (int bj = 0; bj < 2; ++bj) {
            const int colt = u.pn * BM + bj * HALF + wc * 32 + 4 * fq;
            const f32x4 b1 = *(const f32x4*)(bias + colt), b2 = *(const f32x4*)(bias + colt + 16);
            const bool isv = (u.pn == 4) && (bj == 1);
            if (!((u.bmask >> bj) & 1)) continue;
#pragma unroll
            for (int ai = 0; ai < 2; ++ai)
#pragma unroll
                for (int m = 0; m < 4; ++m) {
                    if (!((u.amask >> ai) & 1)) continue;
                    const int r = u.pm * BM + ai * HALF + wr * 64 + m * 16 + fr, t = r - C;
                    f32x4 x1 = acc[ai][bj][m][0] + b1, x2 = acc[ai][bj][m][1] + b2;
                    if (lat && !isv) {
                        const int pos = (wc & 1) ? (t & 63) : (t >> 6);
                        const f32x4 t0 = *(const f32x4*)(tab + (pos * 16 + 4 * fq) * 2), t1 = *(const f32x4*)(tab + (pos * 16 + 4 * fq) * 2 + 4);
                        const float cs[4] = {t0[0], t0[2], t1[0], t1[2]}, sn[4] = {t0[1], t0[3], t1[1], t1[3]};
                        f32x4 o1, o2;
#pragma unroll
                        for (int e = 0; e < 4; ++e) { o1[e] = x1[e] * cs[e] - x2[e] * sn[e]; o2[e] = x2[e] * cs[e] + x1[e] * sn[e]; }
                        x1 = o1; x2 = o2;
                    }
                    u32x2 w1, w2;
                    if (u.pn < 4) {
                        w1.x = pk2(x1[0] * qs, x1[1] * qs); w1.y = pk2(x1[2] * qs, x1[3] * qs); w2.x = pk2(x2[0] * qs, x2[1] * qs); w2.y = pk2(x2[2] * qs, x2[3] * qs);
                        *(u32x2*)(Qp + (size_t)r * 1024 + colt) = w1; *(u32x2*)(Qp + (size_t)r * 1024 + colt + 16) = w2;
                    } else {
                        w1.x = pk2(x1[0], x1[1]); w1.y = pk2(x1[2], x1[3]); w2.x = pk2(x2[0], x2[1]); w2.y = pk2(x2[2], x2[3]);
                        bf16_t* dst = (bj == 0 ? Kp : Vp) + (size_t)r * 128 + wc * 32 + 4 * fq;
                        *(u32x2*)dst = w1; *(u32x2*)(dst + 16) = w2;
                    }
                }
        }
    }
};
struct EpiInProj {
    static constexpr bool PERM = true;
    bf16_t* QH; _Float16* KF; _Float16* KB; bf16_t* IV; bf16_t* SG; const float* lb; float scale;
    __device__ __forceinline__ void operator()(const f32x4 (&acc)[2][2][4][2], const Unit& u, int wr, int wc, int fr, int fq) const {
        const int seg = u.pn >> 2; const bool lat = u.pm > 0;
        if (!lat && (seg == 0 || seg == 4)) return;
        typedef _Float16 h8_t __attribute__((ext_vector_type(8)));
#pragma unroll
        for (int bj = 0; bj < 2; ++bj) {
            const int col = (u.pn & 3) * BM + bj * HALF + wc * 32 + 8 * fq;
            if (!((u.bmask >> bj) & 1)) continue;
            f32x4 lb0 = (f32x4){0.f, 0.f, 0.f, 0.f}, lb1 = lb0;
            if (seg == 1) { lb0 = *(const f32x4*)(lb + col); lb1 = *(const f32x4*)(lb + col + 4); } else if (seg == 2) { lb0 = *(const f32x4*)(lb + 1024 + col); lb1 = *(const f32x4*)(lb + 1024 + col + 4); }
#pragma unroll
            for (int ai = 0; ai < 2; ++ai)
#pragma unroll
                for (int m = 0; m < 4; ++m) {
                    if (!((u.amask >> ai) & 1)) continue;
                    const int r = u.pm * BM + ai * HALF + wr * 64 + m * 16 + fr; const f32x4 v0 = acc[ai][bj][m][0] * scale, v1 = acc[ai][bj][m][1] * scale;
                    if (seg == 1 || seg == 2) {
                        h8_t hv;
#pragma unroll
                        for (int e = 0; e < 4; ++e) { hv[e] = (_Float16)((1.f - lb0[e]) * __builtin_amdgcn_rcpf(1.f + __builtin_amdgcn_exp2f(LOG2E * v0[e]))); hv[4 + e] = (_Float16)((1.f - lb1[e]) * __builtin_amdgcn_rcpf(1.f + __builtin_amdgcn_exp2f(LOG2E * v1[e]))); }
                        *(h8_t*)((seg == 1 ? KF : KB) + (size_t)r * 1024 + col) = hv;
                    } else if (seg == 3) {
                        u32x4 o; o.x = pk2(v0[0], v0[1]); o.y = pk2(v0[2], v0[3]); o.z = pk2(v1[0], v1[1]); o.w = pk2(v1[2], v1[3]); *(u32x4*)(IV + (size_t)r * 1024 + col) = o;
                    } else {
                        float s0[4], s1[4];
#pragma unroll
                        for (int e = 0; e < 4; ++e) { s0[e] = v0[e] * __builtin_amdgcn_rcpf(1.f + __builtin_amdgcn_exp2f(-LOG2E * v0[e])); s1[e] = v1[e] * __builtin_amdgcn_rcpf(1.f + __builtin_amdgcn_exp2f(-LOG2E * v1[e])); }
                        u32x4 o; o.x = pk2(s0[0], s0[1]); o.y = pk2(s0[2], s0[3]); o.z = pk2(s1[0], s1[1]); o.w = pk2(s1[2], s1[3]); *(u32x4*)((seg == 0 ? QH : SG) + (size_t)(r - C) * 1024 + col) = o;
                    }
                }
        }
    }
};

typedef int v8i __attribute__((ext_vector_type(8)));
typedef int v4i __attribute__((ext_vector_type(4)));
template <class Epi, class Sched, bool ALIGN_EPI, bool GATHER, bool FP8>
__device__ __forceinline__ void gemm_phase(LAS unsigned char* lds, const Gemm g, const Sched& S, const Epi& E, const int tid) {
    const int wid = __builtin_amdgcn_readfirstlane(tid >> 6), lane = tid & 63, wr = wid >> 2, wc = wid & 3, fr = lane & 15, fq = lane >> 4;
    constexpr int KB = FP8 ? 1024 : 2048, nt = 1024 / (FP8 ? 128 : 64);
    int sR[2], sC[2]; unsigned voffB[2], voffA[2];
#pragma unroll
    for (int i = 0; i < 2; ++i) { stage_rc(tid * 16 + i * 8192, sR[i], sC[i]); const int Rb = Epi::PERM ? ((sR[i] & ~31) + perm32(sR[i] & 31)) : sR[i]; voffB[i] = (unsigned)(Rb * KB + sC[i] * 2); voffA[i] = (unsigned)(sR[i] * KB + sC[i] * 2); }
    constexpr size_t kstep = (size_t)(BK * 2), hstep = (size_t)HALF * KB, tstep = 2 * hstep;
    const unsigned ldsw = (unsigned)wid * 1024u;
    const int aoff = lds_byte(wr * 64 + fr, fq * 8), boff = lds_byte(wc * 32 + fr, fq * 8);
    const char* Ab = (const char*)g.A;
#define PG8_SA(b, h) (((b) * 2 + (h)) * HTB)
#define PG8_SB(b, h) ((4 + (b) * 2 + (h)) * HTB)
#define PG8_STAGE_B(bufoff, gbase) do { _Pragma("unroll") for (int _i = 0; _i < 2; ++_i) \
        __builtin_amdgcn_global_load_lds((const unsigned*)((const char*)(gbase) + voffB[_i]), (LAS unsigned*)(lds + (bufoff) + ldsw + _i * 8192), 16, 0, 0); } while (0)
#define PG8_STAGE_A(bufoff, kb, v, ubase) do { _Pragma("unroll") for (int _i = 0; _i < 2; ++_i) \
        __builtin_amdgcn_global_load_lds((const unsigned*)((GATHER ? Ab : (ubase)) + (size_t)(kb) + (GATHER ? (v)[_i] : voffA[_i])), (LAS unsigned*)(lds + (bufoff) + ldsw + _i * 8192), 16, 0, 0); } while (0)
#define PG8_LD8(p) __builtin_shufflevector(*(const LAS v4i*)(p), *(const LAS v4i*)((p) + 1024), 0, 1, 2, 3, 4, 5, 6, 7)
#define PG8_LDA(dst, b, h) do { if constexpr (FP8) { _Pragma("unroll") for (int m = 0; m < 4; ++m) dst##8[m] = PG8_LD8(lds + PG8_SA(b, h) + aoff + m * 2048); } else { _Pragma("unroll") for (int m = 0; m < 4; ++m) _Pragma("unroll") for (int k = 0; k < 2; ++k) dst[m][k] = *(const LAS bf16x8*)(lds + PG8_SA(b, h) + aoff + m * 2048 + k * 1024); } } while (0)
#define PG8_LDB(dst, b, h) do { if constexpr (FP8) { _Pragma("unroll") for (int n = 0; n < 2; ++n) dst##8[n] = PG8_LD8(lds + PG8_SB(b, h) + boff + n * 2048); } else { _Pragma("unroll") for (int n = 0; n < 2; ++n) _Pragma("unroll") for (int k = 0; k < 2; ++k) dst[n][k] = *(const LAS bf16x8*)(lds + PG8_SB(b, h) + boff + n * 2048 + k * 1024); } } while (0)
#define PG8_MMA(ai, bj, At, Bt) do { __builtin_amdgcn_s_setprio(1); if constexpr (FP8) { _Pragma("unroll") for (int m = 0; m < 4; ++m) _Pragma("unroll") for (int n = 0; n < 2; ++n) \
        asm volatile("v_mfma_scale_f32_16x16x128_f8f6f4 %0, %1, %2, %0, %3, %3 op_sel_hi:[0,0,0]" : "+v"(acc[ai][bj][m][n]) : "v"(Bt##8[n]), "v"(At##8[m]), "v"(unit_scale)); } else { \
        _Pragma("unroll") for (int m = 0; m < 4; ++m) _Pragma("unroll") for (int n = 0; n < 2; ++n) _Pragma("unroll") for (int k = 0; k < 2; ++k) \
        acc[ai][bj][m][n] = __builtin_amdgcn_mfma_f32_16x16x32_bf16(Bt[n][k], At[m][k], acc[ai][bj][m][n], 0, 0, 0); } __builtin_amdgcn_s_setprio(0); } while (0)
#define PG8_WAIT_V(n) asm volatile("s_waitcnt vmcnt(" #n ")" ::: "memory")
#define PG8_WAIT_L(n) asm volatile("s_waitcnt lgkmcnt(" #n ")" ::: "memory")
#define PG8_BAR __builtin_amdgcn_s_barrier()
#define PG8_SCHED __builtin_amdgcn_sched_barrier(0)
    Unit cur, nxt; int ui = 0;
    if (!S.next(0, cur)) return;
    unsigned cv[2][2], nv[2][2];
    if constexpr (GATHER) a_offsets<KB>(g, cur, sR, sC, cv);
    const char* cA = Ab + (size_t)cur.pm * tstep; const char* nA = cA;
    f32x4 acc[2][2][4][2];
#pragma unroll
    for (int a = 0; a < 2; ++a)
#pragma unroll
        for (int b = 0; b < 2; ++b)
#pragma unroll
            for (int m = 0; m < 4; ++m)
#pragma unroll
                for (int n = 0; n < 2; ++n) acc[a][b][m][n] = (f32x4){0.f, 0.f, 0.f, 0.f};
    bf16x8 At[4][2], B0[2][2], B1[2][2]; v8i At8[4], B08[2], B18[2];
    int unit_scale = 0x7f7f7f7f; asm volatile("" : "+v"(unit_scale));
    const char* cB = (const char*)g.Bt + (size_t)cur.e * g.bstride + (size_t)cur.pn * tstep;
    PG8_STAGE_B(PG8_SB(0, 0), cB); PG8_STAGE_B(PG8_SB(0, 1), cB + hstep); PG8_STAGE_A(PG8_SA(0, 0), 0, cv[0], cA); PG8_STAGE_A(PG8_SA(0, 1), 0, cv[1], cA + hstep);
    if (wr == 1) PG8_BAR;
    PG8_WAIT_V(2); PG8_BAR;
    PG8_STAGE_B(PG8_SB(1, 0), cB + kstep); PG8_STAGE_A(PG8_SA(1, 0), kstep, cv[0], cA); PG8_STAGE_B(PG8_SB(1, 1), cB + hstep + kstep);
    PG8_WAIT_V(6); PG8_BAR;
    for (;;) {
        const bool has_next = S.next(ui + 1, nxt);
        const char* nB = cB;
        nA = cA;
        if (has_next) { if constexpr (GATHER) a_offsets<KB>(g, nxt, sR, sC, nv); nA = Ab + (size_t)nxt.pm * tstep; nB = (const char*)g.Bt + (size_t)nxt.e * g.bstride + (size_t)nxt.pn * tstep; }
        else if constexpr (GATHER) {
#pragma unroll
            for (int h = 0; h < 2; ++h)
#pragma unroll
                for (int i = 0; i < 2; ++i) nv[h][i] = cv[h][i];
        }
        const int ntr = (PROBE_SHORTK && !cur.real) ? 2 : nt;
        const bool m00 = (cur.amask & 1) && (cur.bmask & 1), m01 = (cur.amask & 1) && (cur.bmask & 2), m10 = (cur.amask & 2) && (cur.bmask & 1), m11 = (cur.amask & 2) && (cur.bmask & 2);
#pragma nounroll
        for (int t = 0; t < ntr; t += 2) {
            const bool last = (t == ntr - 2);
            const size_t k1 = (size_t)(t + 1) * kstep, k2 = last ? 0 : (size_t)(t + 2) * kstep, k3 = k2 + kstep;
            const char* b2 = last ? nB : cB + (size_t)(t + 2) * kstep; const char* b3 = b2 + kstep;
            unsigned w0[2], w1[2];
            if constexpr (GATHER) {
#pragma unroll
                for (int i = 0; i < 2; ++i) { w0[i] = last ? nv[0][i] : cv[0][i]; w1[i] = last ? nv[1][i] : cv[1][i]; }
            }
            const char* a2 = last ? nA : cA;
            PG8_LDB(B0, 0, 0); PG8_LDB(B1, 0, 1); PG8_SCHED; PG8_LDA(At, 0, 0); PG8_STAGE_A(PG8_SA(1, 1), k1, cv[1], cA + hstep);
            PG8_WAIT_V(8); PG8_WAIT_L(0); PG8_BAR; if (m00) PG8_MMA(0, 0, At, B0); if (m01) PG8_MMA(0, 1, At, B1); PG8_BAR; PG8_SCHED;
            PG8_LDA(At, 0, 1); PG8_STAGE_B(PG8_SB(0, 0), b2); PG8_STAGE_B(PG8_SB(0, 1), b2 + hstep); PG8_STAGE_A(PG8_SA(0, 0), k2, w0, a2);
            PG8_WAIT_V(8); PG8_WAIT_L(0); PG8_BAR; if (m10) PG8_MMA(1, 0, At, B0); if (m11) PG8_MMA(1, 1, At, B1); PG8_BAR; PG8_SCHED;
            PG8_LDB(B0, 1, 0); PG8_LDB(B1, 1, 1); PG8_SCHED; PG8_LDA(At, 1, 0); PG8_STAGE_A(PG8_SA(0, 1), k2, w1, a2 + hstep);
            PG8_WAIT_V(8); PG8_WAIT_L(0); PG8_BAR; if (m00) PG8_MMA(0, 0, At, B0); if (m01) PG8_MMA(0, 1, At, B1); PG8_BAR; PG8_SCHED;
            PG8_LDA(At, 1, 1); PG8_STAGE_B(PG8_SB(1, 0), b3); PG8_STAGE_B(PG8_SB(1, 1), b3 + hstep); PG8_STAGE_A(PG8_SA(1, 0), k3, w0, a2);
            PG8_WAIT_V(8); PG8_WAIT_L(0); PG8_BAR; if (m10) PG8_MMA(1, 0, At, B0); if (m11) PG8_MMA(1, 1, At, B1); PG8_BAR; PG8_SCHED;
        }
        if constexpr (ALIGN_EPI) { if (wr == 0) PG8_BAR; }
        if constexpr (FP8) asm volatile("s_nop 15\n\ts_nop 15" ::: "memory");
        if (!PROBE_NOEPI || cur.real) E(acc, cur, wr, wc, fr, fq);
        if (!has_next) break;
#pragma unroll
        for (int a = 0; a < 2; ++a)
#pragma unroll
            for (int b = 0; b < 2; ++b)
#pragma unroll
                for (int m = 0; m < 4; ++m)
#pragma unroll
                    for (int n = 0; n < 2; ++n) acc[a][b][m][n] = (f32x4){0.f, 0.f, 0.f, 0.f};
        cur = nxt; cB = nB; cA = nA; ++ui;
        if constexpr (GATHER) {
#pragma unroll
            for (int h = 0; h < 2; ++h)
#pragma unroll
                for (int i = 0; i < 2; ++i) cv[h][i] = nv[h][i];
        }
        if constexpr (ALIGN_EPI) { if (wr == 1) PG8_BAR; }
    }
    PG8_WAIT_V(0);
    if constexpr (!ALIGN_EPI) { if (wr == 0) PG8_BAR; }
    PG8_BAR;
#undef PG8_SA
#undef PG8_SB
#undef PG8_STAGE_A
#undef PG8_STAGE_B
#undef PG8_LDA
#undef PG8_LD8
#undef PG8_LDB
#undef PG8_MMA
#undef PG8_WAIT_V
#undef PG8_WAIT_L
#undef PG8_BAR
#undef PG8_SCHED
}
}

struct TBlk { const float* src; int ldw; bf16_t* dst; unsigned char* dst8; };
__device__ __forceinline__ void tb_load(const TBlk& t, int lane, f32x4 (&v)[16]) {
    const float* p = t.src + (size_t)(lane >> 4) * t.ldw + (lane & 15) * 4;
#pragma unroll
    for (int i = 0; i < 16; ++i) v[i] = *(const f32x4*)(p + (size_t)(4 * i) * t.ldw);
}
__device__ __forceinline__ void tb_store(const TBlk& t, int lane, const f32x4 (&v)[16], LAS float* scr) {
#pragma unroll
    for (int i = 0; i < 16; ++i) { LAS float* d = scr + ((lane >> 4) + 4 * i) * 65 + (lane & 15) * 4; d[0] = v[i].x; d[1] = v[i].y; d[2] = v[i].z; d[3] = v[i].w; }
    asm volatile("s_waitcnt lgkmcnt(0)" ::: "memory"); __builtin_amdgcn_wave_barrier();
    const int c8 = lane & 7;
#pragma unroll
    for (int jj = 0; jj < 8; ++jj) {
        const int n = (lane >> 3) + 8 * jj; const LAS float* p = scr + (8 * c8) * 65 + n;
        if (t.dst8) { u32x2 o; o.x = pk4_fp8(p[0] * F8_SW, p[65] * F8_SW, p[2 * 65] * F8_SW, p[3 * 65] * F8_SW); o.y = pk4_fp8(p[4 * 65] * F8_SW, p[5 * 65] * F8_SW, p[6 * 65] * F8_SW, p[7 * 65] * F8_SW);
            *(u32x2*)(t.dst8 + (size_t)n * 1024 + 8 * c8) = o; }
        else { u32x4 o; o.x = pk2(p[0], p[65]); o.y = pk2(p[2 * 65], p[3 * 65]); o.z = pk2(p[4 * 65], p[5 * 65]); o.w = pk2(p[6 * 65], p[7 * 65]);
            *(u32x4*)(t.dst + (size_t)n * 1024 + 8 * c8) = o; }
    }
    asm volatile("s_waitcnt lgkmcnt(0)" ::: "memory"); __builtin_amdgcn_wave_barrier();
}

__device__ __forceinline__ void phase_prep(const Ctx& c) {
    LAS float* red = (LAS float*)c.lds;
    LAS float* sil = red + 1024;
    const float* cv = c.a->in[1]; const float* ccv = c.a->in[3]; const float* ada_w = c.a->in[4]; const float* ada_b = c.a->in[5];
    for (int i = c.tid; i < 2048; i += 512) { const float x = i < 1024 ? cv[i] : ccv[i - 1024]; sil[i] = x * __builtin_amdgcn_rcpf(1.f + __builtin_amdgcn_exp2f(-LOG2E * x)); }
    __syncthreads();
    for (int item = c.wg; item < 193; item += c.nwg) {
        if (item < 192) {
            const int layer = item / 96, cb = item % 96, col = cb * 64 + c.lane;
            const float* W = ada_w + (size_t)layer * D * 6144 + col;
            float a0 = 0.f, a1 = 0.f;
            const int k0 = c.wave * 128;
#pragma unroll 32
            for (int k = 0; k < 128; ++k) { const float w = W[(size_t)(k0 + k) * 6144]; a0 += sil[k0 + k] * w; a1 += sil[1024 + k0 + k] * w; }
            red[(0 * 8 + c.wave) * 64 + c.lane] = a0; red[(1 * 8 + c.wave) * 64 + c.lane] = a1;
            __syncthreads();
            if (c.tid < 128) {
                const int which = c.tid >> 6, l = c.tid & 63; float s = 0.f;
#pragma unroll
                for (int w = 0; w < 8; ++w) s += red[(which * 8 + w) * 64 + l];
                c.modp(layer, which)[cb * 64 + l] = s + ada_b[layer * 6144 + cb * 64 + l];
            }
            __syncthreads();
        } else {
            float* modbase = (float*)(c.ws + WS_MOD);
            for (int i = c.tid; i < 4096; i += 512) {
                const int pos = i >> 4, j = i & 15;
                const double ang = (double)pos * pow(10000.0, -(double)j / 16.0);
                modbase[MOD_ROPE + 2 * i] = (float)cos(ang); modbase[MOD_ROPE + 2 * i + 1] = (float)sin(ang);
            }
            const float* lbp = c.a->in[12];
            for (int i = c.tid; i < 2048; i += 512) { const float p0 = lbp[i], p1 = lbp[2048 + i]; modbase[MOD_LB + i] = 1.f / (1.f + __expf(p0 - p1)); }
        }
    }
}

__device__ __forceinline__ void row_load(const float* p, int lane, f32x4 (&v)[4]) {
#pragma unroll
    for (int j = 0; j < 4; ++j) v[j] = *(const f32x4*)(p + lane * 4 + 256 * j);
}
__device__ __forceinline__ void row_load_bf(const bf16_t* p, int lane, f32x4 (&v)[4]) {
#pragma unroll
    for (int j = 0; j < 4; ++j) { const u32x2 w = *(const u32x2*)(p + lane * 4 + 256 * j); v[j] = (f32x4){bflo(w.x), bfhi(w.x), bflo(w.y), bfhi(w.y)}; }
}
__device__ __forceinline__ float row_ss(const f32x4 (&v)[4]) {
    float s = 0.f;
#pragma unroll
    for (int j = 0; j < 4; ++j) s += v[j].x * v[j].x + v[j].y * v[j].y + v[j].z * v[j].z + v[j].w * v[j].w;
    return wave_sum(s);
}
__device__ __forceinline__ void row_modnorm_store(const f32x4 (&x)[4], float rstd, const float* g, const float* sh, const float* sc, bf16_t* out, int lane, f32x4 (*hout)[4] = nullptr) {
#pragma unroll
    for (int j = 0; j < 4; ++j) {
        const int c0 = lane * 4 + 256 * j;
        const f32x4 gv = *(const f32x4*)(g + c0), shv = *(const f32x4*)(sh + c0), scv = *(const f32x4*)(sc + c0);
        f32x4 h;
        h.x = x[j].x * rstd * gv.x * (1.f + scv.x) + shv.x; h.y = x[j].y * rstd * gv.y * (1.f + scv.y) + shv.y;
        h.z = x[j].z * rstd * gv.z * (1.f + scv.z) + shv.z; h.w = x[j].w * rstd * gv.w * (1.f + scv.w) + shv.w;
        if (hout) (*hout)[j] = h;
        u32x2 o; o.x = pk2(h.x, h.y); o.y = pk2(h.z, h.w);
        *(u32x2*)(out + c0) = o;
    }
}

__device__ __forceinline__ void phase_norm0(const Ctx& c) {
    bf16_t* H = (bf16_t*)(c.ws + WS_H); const float* ng = c.a->in[6];
    int r = c.wg * 8 + c.wave;
    f32x4 xn[4];
    if (r < R) row_load(c.xin0(r), c.lane, xn);
    for (; r < R; r += c.nwg * 8) {
        f32x4 x[4];
#pragma unroll
        for (int j = 0; j < 4; ++j) x[j] = xn[j];
        if (r + c.nwg * 8 < R) row_load(c.xin0(r + c.nwg * 8), c.lane, xn);
        const float rstd = rsqrtf(row_ss(x) * (1.f / D) + EPS);
        const float* m = c.modp(0, r < C ? 1 : 0);
        row_modnorm_store(x, rstd, ng, m + 0, m + 1024, H + (size_t)r * D, c.lane);
    }
}

namespace at {
__device__ __forceinline__ float max3f(float a, float b, float c) { return __builtin_fmaxf(__builtin_fmaxf(a, b), c); }
constexpr int KP = 144, TILEB = 64 * KP;
__device__ __forceinline__ bf16x8 tr_frag2(const LAS unsigned char* tile, int row0, int col0, int lane) {
    const int q = (lane & 15) >> 2, p = lane & 3;
    const LAS unsigned char* a = tile + (row0 + q) * KP + (col0 + 4 * p) * 2;
    const v4i16_t lo = __builtin_amdgcn_ds_read_tr16_b64_v4i16((LAS v4i16_t*)a);
    const v4i16_t hi = __builtin_amdgcn_ds_read_tr16_b64_v4i16((LAS v4i16_t*)(a + 16 * KP));
    return (bf16x8){lo[0], lo[1], lo[2], lo[3], hi[0], hi[1], hi[2], hi[3]};
}
}
__device__ __forceinline__ void phase_attn(const Ctx& c) {
    using namespace at;
    const bf16_t* Q = (const bf16_t*)(c.ws + WS_Q); const bf16_t* K = (const bf16_t*)(c.ws + WS_K); const bf16_t* V = (const bf16_t*)(c.ws + WS_V);
    bf16_t* O = (bf16_t*)(c.ws + WS_O); const float* sink = c.a->in[9];
    LAS unsigned char* lds = c.lds;
    const int tid = c.tid, lane = c.lane, w = __builtin_amdgcn_readfirstlane(tid >> 6), fr = lane & 15, g = lane >> 4;
    const int lrow = tid >> 3, lch = tid & 7;
    const int nitn = c.nwg == 256 ? 2 : (264 - c.wg + c.nwg - 1) / c.nwg;
    for (int itn = 0; itn < nitn; ++itn) {
        int item = c.wg + itn * c.nwg;
        if (c.nwg == 256 && itn == 1) { const int n_ = c.wg >> 1; item = -1;
            if (n_ == 0) item = 256 + (c.wg & 1); else if (n_ == 127) item = 258 + (c.wg & 1); else if (n_ == 30 || n_ == 31) item = 260 + (c.wg - 60); }
        if (item < 0 || item >= 264) continue;
        const bool isctx = item >= 256;
        const int ci = item - 256;
        const int n = isctx ? 0 : (item >> 1), kh = isctx ? ((ci >> 1) & 1) : (item & 1), cb = isctx ? (ci >> 2) : 0;
        const int p_lo = isctx ? (ci & 1) : 0, p_hi = isctx ? (ci & 1) + 1 : 2;
        const int hq = kh * 8 + w;
        const float sink2 = sink[hq] * LOG2E;
        for (int pass = p_lo; pass < p_hi; ++pass) {
            const int t0 = 128 * n + 64 * pass, qrow0 = isctx ? cb * 128 + 64 * pass : C + t0;
            const int jlo = isctx ? 0 : (t0 >= 128 ? 0 : (128 - t0) / 64), jhi = isctx ? 0 : ((L - t0 + 128) / 64 < 5 ? (L - t0 + 128) / 64 : 5);
            const int ntile = 4 + (jhi - jlo);
            LAS unsigned char* qlds = lds + 4 * TILEB + w * TILEB;
#pragma unroll
            for (int qb = 0; qb < 4; ++qb)
#pragma unroll
                for (int ks = 0; ks < 2; ++ks) *(LAS bf16x8*)(qlds + (16 * qb + fr) * KP + (32 * ks + 8 * g) * 2) = *(const bf16x8*)(Q + (size_t)(qrow0 + 16 * qb + fr) * D + hq * 64 + 32 * ks + 8 * g);
            float mrow[4], lsum[4]; f32x4 OT[4][4];
#pragma unroll
            for (int qb = 0; qb < 4; ++qb) { mrow[qb] = sink2; lsum[qb] = 1.f;
#pragma unroll
                for (int nt = 0; nt < 4; ++nt) OT[qb][nt] = (f32x4){0.f, 0.f, 0.f, 0.f}; }
            u32x4 kreg, vreg;
#define AT_KROW(ti) ((ti) < 4 ? 64 * (ti) : C + t0 - 128 + 64 * (jlo + (ti) - 4))
#define AT_LOAD(ti) do { const size_t ro_ = (size_t)(AT_KROW(ti) + lrow) * 128 + kh * 64 + lch * 8; kreg = *(const u32x4*)(K + ro_); vreg = *(const u32x4*)(V + ro_); } while (0)
#define AT_WRITE(buf) do { *(LAS u32x4*)(lds + (buf) * 2 * TILEB + lrow * KP + lch * 16) = kreg; *(LAS u32x4*)(lds + (buf) * 2 * TILEB + TILEB + lrow * KP + lch * 16) = vreg; } while (0)
            AT_LOAD(0); AT_WRITE(0);
            __syncthreads();
            for (int ti = 0; ti < ntile; ++ti) {
                if (ti + 1 < ntile) AT_LOAD(ti + 1);
                const LAS unsigned char* kb = lds + (ti & 1) * 2 * TILEB; const LAS unsigned char* vb = kb + TILEB;
                const int jj = jlo + ti - 4; const bool masked = (ti >= 4) && (jj == 0 || jj == 4);
                const int k0 = t0 - 128 + 64 * jj;
                bf16x8 Kf[4][2];
#pragma unroll
                for (int mt = 0; mt < 4; ++mt)
#pragma unroll
                    for (int ks = 0; ks < 2; ++ks) Kf[mt][ks] = *(const LAS bf16x8*)(kb + (16 * mt + fr) * KP + (32 * ks + 8 * g) * 2);
                bf16x8 Vf[4][2];
#pragma unroll
                for (int mt = 0; mt < 4; ++mt)
#pragma unroll
                    for (int ks = 0; ks < 2; ++ks)
                        Vf[mt][ks] = tr_frag2(vb, 32 * ks + 4 * g, 16 * mt, lane);
#pragma unroll
                for (int qb = 0; qb < 4; ++qb) {
                    bf16x8 Qq[2];
#pragma unroll
                    for (int ks = 0; ks < 2; ++ks) Qq[ks] = *(const LAS bf16x8*)(qlds + (16 * qb + fr) * KP + (32 * ks + 8 * g) * 2);
                    f32x4 sa[4];
#pragma unroll
                    for (int mt = 0; mt < 4; ++mt) { sa[mt] = (f32x4){0.f, 0.f, 0.f, 0.f};
#pragma unroll
                        for (int ks = 0; ks < 2; ++ks) sa[mt] = __builtin_amdgcn_mfma_f32_16x16x32_bf16(Kf[mt][ks], Qq[ks], sa[mt], 0, 0, 0); }
                    if (masked) {
                        const int tq = t0 + 16 * qb + fr;
#pragma unroll
                        for (int mt = 0; mt < 4; ++mt)
#pragma unroll
                            for (int e = 0; e < 4; ++e) { const int dt = tq - (k0 + 16 * mt + 4 * g + e); if (dt > 128 || dt < -128) sa[mt][e] = -INFINITY; }
                    }
                    float mx = max3f(sa[0][0], sa[0][1], sa[0][2]), my = max3f(sa[0][3], sa[1][0], sa[1][1]);
                    mx = max3f(mx, sa[1][2], sa[1][3]); my = max3f(my, sa[2][0], sa[2][1]); mx = max3f(mx, sa[2][2], sa[2][3]); my = max3f(my, sa[3][0], sa[3][1]); mx = max3f(mx, sa[3][2], sa[3][3]);
                    mx = max3f(mx, my, mrow[qb]);
                    mx = xmax32(xmax16(mx));
                    const float mn = mx; const bool grew = __any(mn > mrow[qb]);
                    const float alpha = grew ? __builtin_amdgcn_exp2f(mrow[qb] - mn) : 1.f;
                    mrow[qb] = mn;
                    float rs = 0.f;
#pragma unroll
                    for (int mt = 0; mt < 4; ++mt)
#pragma unroll
                        for (int e = 0; e < 4; ++e) { const float pv = __builtin_amdgcn_exp2f(sa[mt][e] - mn); sa[mt][e] = pv; rs += pv; }
                    rs = xadd32(xadd16(rs));
                    lsum[qb] = grew ? lsum[qb] * alpha + rs : lsum[qb] + rs;
                    bf16x8 Pb[2];
#pragma unroll
                    for (int ks = 0; ks < 2; ++ks) { const f32x4 a0 = sa[2 * ks], a1 = sa[2 * ks + 1];
                        const u32x4 pk = (u32x4){pk2(a0[0], a0[1]), pk2(a0[2], a0[3]), pk2(a1[0], a1[1]), pk2(a1[2], a1[3])}; Pb[ks] = __builtin_bit_cast(bf16x8, pk); }
#pragma unroll
                    for (int nt = 0; nt < 4; ++nt) { if (grew) OT[qb][nt] = OT[qb][nt] * alpha;
#pragma unroll
                        for (int ks = 0; ks < 2; ++ks) OT[qb][nt] = __builtin_amdgcn_mfma_f32_16x16x32_bf16(Vf[nt][ks], Pb[ks], OT[qb][nt], 0, 0, 0); }
                }
                if (ti + 1 < ntile) AT_WRITE((ti + 1) & 1);
                __syncthreads();
            }
#undef AT_KROW
#undef AT_LOAD
#undef AT_WRITE
#pragma unroll
            for (int qb = 0; qb < 4; ++qb) {
                const float il = 1.f / lsum[qb];
                bf16_t* op = O + (size_t)(qrow0 + 16 * qb + fr) * D + hq * 64 + 4 * g;
#pragma unroll
                for (int nt = 0; nt < 4; ++nt) { const f32x4 v = OT[qb][nt] * il; u32x2 o; o.x = pk2(v[0], v[1]); o.y = pk2(v[2], v[3]); *(u32x2*)(op + 16 * nt) = o; }
            }
        }
    }
}

template <int GS>
__device__ __forceinline__ void phase_postmix(const Ctx& c, int layer, bool route) {
    const bf16_t* Y = (const bf16_t*)(c.ws + WS_RAW1); unsigned char* H8 = c.ws + WS_H8;
    bf16_t* Xout = (bf16_t*)(c.ws + (layer == 0 ? WS_X : WS_X1)); const bf16_t* Xprev = (const bf16_t*)(c.ws + WS_X);
    const float* ng = c.a->in[6] + layer * 4 * D; const float* Wr = c.a->in[15] + (size_t)layer * D * NE; const float* br = c.a->in[16] + layer * NE;
    unsigned* cnt = (unsigned*)(c.ws + WS_CTL) + CW_CNT + layer * NE;
    int* tk_e = (int*)(c.ws + WS_TK); float* tk_g = (float*)(c.ws + WS_TK) + R * 4; int* tk_slot = (int*)(c.ws + WS_TK) + 2 * R * 4;
    int* list = (int*)(c.ws + WS_LIST);
    LAS float* WL = (LAS float*)c.lds;
    LAS float* biasp = (LAS float*)(c.lds + 131072);
    LAS unsigned* lcnt = (LAS unsigned*)(c.lds + 145920); LAS unsigned* lbase = lcnt + 32; LAS float* rsx = (LAS float*)(lcnt + 64);
    LAS float* pvA = (LAS float*)(c.lds + 131072 + 2560); LAS float* pvB = pvA + 1024; LAS float* pvS = pvB + 1024;
    const int lane = c.lane, w = __builtin_amdgcn_readfirstlane(c.tid >> 6), fr = lane & 15, g = lane >> 4;
    constexpr int RP = GS / 8, NW2 = GS / 16;
    const int g_lo = layer == 0 ? 0 : C / GS;
    for (int grp = g_lo + c.wg; grp < R / GS; grp += c.nwg) {
        const int which = grp * GS < C ? 1 : 0;
        const float* m = c.modp(layer, which);
        __syncthreads();
        if (c.tid < NE) lcnt[c.tid] = 0u;
#pragma unroll 4
        for (int j = 0; j < 16; ++j) {
            const int i4 = c.tid + 512 * j, k = i4 >> 3, e0 = (i4 & 7) * 4;
            const f32x4 wv = *(const f32x4*)(Wr + (size_t)k * NE + e0); const float sc = ng[2 * D + k] * (1.f + m[4096 + k]);
            LAS float* dst = WL + ((((k >> 4) * 4 + (k & 3)) * 4 + ((k >> 2) & 3)) * 16) * 2;
#pragma unroll
            for (int q = 0; q < 4; ++q) { const int e = e0 + q; dst[(e & 15) * 2 + (e >> 4)] = wv[q] * sc; }
        }
        for (int k = c.tid; k < D; k += 512) { pvA[k] = m[2048 + k] * ng[D + k]; pvB[k] = ng[2 * D + k] * (1.f + m[4096 + k]); pvS[k] = m[3072 + k]; }
        { const int e = c.tid & 31, part = c.tid >> 5; float sacc = 0.f;
#pragma unroll 16
          for (int k = part * 64; k < part * 64 + 64; ++k) sacc += m[3072 + k] * Wr[k * NE + e];
          biasp[32 + part * 32 + e] = sacc; }
        __syncthreads();
        if (c.tid < 32) { float sacc = br[c.tid];
#pragma unroll
            for (int p = 0; p < 16; ++p) sacc += biasp[32 + p * 32 + c.tid]; biasp[c.tid] = sacc; }
        __syncthreads();
        const int row1 = grp * GS + w * RP;
        f32x4 yn[4], xn[4];
        row_load_bf(Y + (size_t)(layer == 0 ? row1 : row1 - C) * D, lane, yn); if (layer == 0) row_load(c.xin0(row1), lane, xn); else row_load_bf(Xprev + (size_t)row1 * D, lane, xn);
        for (int i = 0; i < RP; ++i) {
            const int r = row1 + i;
            f32x4 y[4], x[4];
#pragma unroll
            for (int j = 0; j < 4; ++j) { y[j] = yn[j]; x[j] = xn[j]; }
            if (i + 1 < RP) { row_load_bf(Y + (size_t)(layer == 0 ? r + 1 : r + 1 - C) * D, lane, yn); if (layer == 0) row_load(c.xin0(r + 1), lane, xn); else row_load_bf(Xprev + (size_t)(r + 1) * D, lane, xn); }
            const float rstd_y = rsqrtf(row_ss(y) * (1.f / D) + EPS);
#pragma unroll
            for (int j = 0; j < 4; ++j) {
                const int c0 = lane * 4 + 256 * j;
                x[j] += *(const LAS f32x4*)(pvA + c0) * (y[j] * rstd_y);
                { u32x2 xo; xo.x = pk2(x[j][0], x[j][1]); xo.y = pk2(x[j][2], x[j][3]); *(u32x2*)(Xout + (size_t)r * D + c0) = xo;
                  x[j] = (f32x4){bflo(xo.x), bfhi(xo.x), bflo(xo.y), bfhi(xo.y)}; }
            }
            const float rstd_x = rsqrtf(row_ss(x) * (1.f / D) + EPS);
#pragma unroll
            for (int j = 0; j < 4; ++j) {
                const int c0 = lane * 4 + 256 * j;
                const f32x4 hv = x[j] * rstd_x * *(const LAS f32x4*)(pvB + c0) + *(const LAS f32x4*)(pvS + c0);
                *(unsigned*)(H8 + (size_t)r * D + c0) = pk4_fp8(hv[0] * F8_SH, hv[1] * F8_SH, hv[2] * F8_SH, hv[3] * F8_SH);
            }
            if (lane == 0) rsx[w * RP + i] = rstd_x;
        }
        asm volatile("s_waitcnt vmcnt(0)" ::: "memory");
        __syncthreads();
        const int row0 = grp * GS + w * 16; const bool w2 = w < NW2;
        f32x4 la[2]; la[0] = (f32x4){0.f, 0.f, 0.f, 0.f}; la[1] = la[0];
        if (w2) {
            const bf16_t* ap = Xout + (size_t)(row0 + fr) * D + 4 * g;
            const LAS float* bp = WL + (g * 16 + fr) * 2;
#pragma unroll 4
            for (int k4 = 0; k4 < 64; ++k4) {
                const u32x2 aw = *(const u32x2*)(ap + 16 * k4); const f32x4 a4 = (f32x4){bflo(aw.x), bfhi(aw.x), bflo(aw.y), bfhi(aw.y)};
#pragma unroll
                for (int q = 0; q < 4; ++q) {
                    const f32x2 b2 = *(const LAS f32x2*)(bp + (size_t)(4 * k4 + q) * 128);
                    la[0] = __builtin_amdgcn_mfma_f32_16x16x4f32(a4[q], b2[0], la[0], 0, 0, 0);
                    la[1] = __builtin_amdgcn_mfma_f32_16x16x4f32(a4[q], b2[1], la[1], 0, 0, 0);
                }
            }
        }
        float tv[4][4]; int te[4][4];
#pragma unroll
        for (int e = 0; e < 4; ++e) {
            const float rs = rsx[(w2 ? w * 16 : 0) + 4 * g + e];
            float v0 = la[0][e] * rs + biasp[fr], v1 = la[1][e] * rs + biasp[16 + fr];
#pragma unroll
            for (int k = 0; k < 4; ++k) {
                float bv; int bi;
                if (v0 >= v1) { bv = v0; bi = fr; } else { bv = v1; bi = 16 + fr; }
#pragma unroll
                for (int o = 8; o > 0; o >>= 1) {
                    const float ov = __shfl_xor(bv, o); const int oi = __shfl_xor(bi, o);
                    if (ov > bv || (ov == bv && oi < bi)) { bv = ov; bi = oi; }
                }
                tv[e][k] = bv; te[e][k] = bi;
                if (bi == fr) v0 = -INFINITY;
                if (bi == 16 + fr) v1 = -INFINITY;
            }
        }
        float v[4]; int ex[4]; unsigned sl[4];
#pragma unroll
        for (int k = 0; k < 4; ++k) { v[k] = tv[0][k]; ex[k] = te[0][k];
#pragma unroll
            for (int e = 1; e < 4; ++e) if (fr == e) { v[k] = tv[e][k]; ex[k] = te[e][k]; } }
        if (fr < 4 && route && w2) {
#pragma unroll
            for (int k = 0; k < 4; ++k) sl[k] = __hip_atomic_fetch_add(lcnt + ex[k], 1u, __ATOMIC_RELAXED, __HIP_MEMORY_SCOPE_WORKGROUP);
        }
        __syncthreads();
        if (c.tid < NE && route) { const unsigned n = lcnt[c.tid]; lbase[c.tid] = n ? atomicAdd(&cnt[c.tid], n) : 0u; }
        __syncthreads();
        if (fr < 4 && route && w2) {
            const int r = row0 + 4 * g + fr;
            const float e1 = __expf(v[1] - v[0]), e2 = __expf(v[2] - v[0]), e3 = __expf(v[3] - v[0]);
            const float inv = 1.f / (1.f + e1 + e2 + e3);
            const float gk[4] = {inv, e1 * inv, e2 * inv, e3 * inv};
#pragma unroll
            for (int k = 0; k < 4; ++k) {
                const unsigned slot = lbase[ex[k]] + sl[k];
                list[(size_t)ex[k] * R + slot] = r;
                tk_e[r * 4 + k] = ex[k]; tk_g[r * 4 + k] = gk[k]; tk_slot[r * 4 + k] = (int)slot;
            }
        }
    }
}

__device__ __forceinline__ void moe_offsets(const Ctx& c, int layer, LAS int* so) {
    const unsigned* cnt = (const unsigned*)(c.ws + WS_CTL) + CW_CNT + layer * NE;
    __syncthreads();
    if (c.tid < 64) {
        const int n = c.tid < NE ? (int)cnt[c.tid] : 0; int pad = (n + PADM - 1) / PADM * PADM, inc = pad;
#pragma unroll
        for (int o = 1; o < 32; o <<= 1) { const int t = __shfl_up(inc, o); if (c.lane >= o) inc += t; }
        if (c.tid < NE) { so[c.tid] = inc - pad; so[64 + c.tid] = n; }
        if (c.tid == NE - 1) so[32] = inc;
    }
    __syncthreads();
}

__device__ __forceinline__ void moe_tables(const Ctx& c, int layer, LAS int* tb) {
    const unsigned* cnt = (const unsigned*)(c.ws + WS_CTL) + CW_CNT + layer * NE;
    __syncthreads();
    if (c.tid < 64) {
        const int n = c.tid < NE ? (int)cnt[c.tid] : 0; int tiles = (n + PADM - 1) / PADM, inc = tiles;
#pragma unroll
        for (int o = 1; o < 32; o <<= 1) { const int t = __shfl_up(inc, o); if (c.lane >= o) inc += t; }
        if (c.tid < NE) { tb[c.tid] = inc - tiles; tb[64 + c.tid] = n; }
        if (c.tid == NE - 1) tb[32] = inc;
    }
    __syncthreads();
}
__device__ __forceinline__ int vcu_of(const Ctx& c) { return (c.nwg % 8 == 0) ? (c.wg % 8) * (c.nwg / 8) + c.wg / 8 : c.wg; }
__device__ __forceinline__ void phase_moe_gu(const Ctx& c, int layer) {
    LAS int* tb = (LAS int*)(c.lds + 131072 + 1024);
    moe_tables(c, layer, tb);
    pg8::Gemm g{c.ws + WS_H8, c.ws + WS_WGU + (size_t)layer * NE * 2048 * 1024, (size_t)2048 * 1024, (const int*)(c.ws + WS_LIST)};
    pg8::MoeOrder S{tb, tb + 64, 8, c.nwg, vcu_of(c), false};
    pg8::EpiSwiglu E{c.ws + WS_HDN, c.a->in[18] + (size_t)layer * NE * 2048};
    pg8::gemm_phase<pg8::EpiSwiglu, pg8::MoeOrder, true, true, true>(c.lds, g, S, E, c.tid);
}
__device__ __forceinline__ void phase_moe_dn(const Ctx& c, int layer) {
    LAS int* tb = (LAS int*)(c.lds + 131072 + 1024);
    moe_tables(c, layer, tb);
    pg8::Gemm g{c.ws + WS_HDN, c.ws + WS_WDN + (size_t)layer * NE * 1024 * 1024, (size_t)1024 * 1024, nullptr};
    pg8::MoeOrder S{tb, tb + 64, 4, c.nwg, vcu_of(c), true};
    pg8::EpiBf16Bias E{c.ws + WS_OUTB, c.a->in[20] + (size_t)layer * NE * 1024, 1024, 1.f / (F8_SHD * F8_SW)};
    pg8::gemm_phase<pg8::EpiBf16Bias, pg8::MoeOrder, true, false, true>(c.lds, g, S, E, c.tid);
}
__device__ __forceinline__ void phase_gemm_f32(const Ctx& c, const bf16_t* A, int M, const bf16_t* Bt, int N, const float* bias, bf16_t* Cout) {
    pg8::Gemm g{A, Bt, 0, nullptr}; pg8::StaticOrder S; S.init(M, N, c.nwg, c.wg);
    pg8::EpiF32 E{Cout, N, bias};
    pg8::gemm_phase<pg8::EpiF32, pg8::StaticOrder, true, false, false>(c.lds, g, S, E, c.tid);
}

__device__ __forceinline__ void phase_gemm_qkv(const Ctx& c) {
    pg8::Gemm g{(const bf16_t*)(c.ws + WS_H), (const bf16_t*)(c.ws + WS_WQKV), 0, nullptr}; pg8::StaticOrder S; S.init(R, QKVD, c.nwg, c.wg);
    pg8::EpiQKV E{(bf16_t*)(c.ws + WS_Q), (bf16_t*)(c.ws + WS_K), (bf16_t*)(c.ws + WS_V), c.a->in[8], (const float*)(c.ws + WS_MOD) + MOD_ROPE};
    pg8::gemm_phase<pg8::EpiQKV, pg8::StaticOrder, true, false, false>(c.lds, g, S, E, c.tid);
}
__device__ __forceinline__ void phase_gemm_inproj(const Ctx& c) {
    pg8::Gemm g{c.ws + WS_H8, c.ws + WS_WIN, 0, nullptr}; pg8::StaticOrder S; S.init(R, HIN, c.nwg, c.wg);
    pg8::EpiInProj E{(bf16_t*)(c.ws + WS_QH), (_Float16*)(c.ws + WS_KF), (_Float16*)(c.ws + WS_KB), (bf16_t*)(c.ws + WS_IV), (bf16_t*)(c.ws + WS_SG), (const float*)(c.ws + WS_MOD) + MOD_LB, 1.f / (F8_SH * F8_SW)};
    pg8::gemm_phase<pg8::EpiInProj, pg8::StaticOrder, true, false, true>(c.lds, g, S, E, c.tid);
}

__device__ __forceinline__ void phase_norm0(const Ctx& c);
constexpr int CONV_A = 20 * 16 + 16 * 16 + 80 * 16 + 16 * 16, CONV_B = 32 * 32 * 16 + 32 * 16 * 16, CONV_CHUNK = 8;
__device__ __forceinline__ TBlk convert_item(const Ctx& c, int it, int part) {
    constexpr int I_QKV = 20 * 16, I_O = 16 * 16, I_IN = 80 * 16, I_HO = 16 * 16, I_GU = 32 * 32 * 16;
    int r = it; TBlk t; t.dst8 = nullptr; t.dst = nullptr;
    if (part == 0) {
        if (r < I_QKV) { const int nb = r % 20, kb = r / 20; t.src = c.a->in[7] + (size_t)kb * 64 * QKVD + nb * 64; t.ldw = QKVD; t.dst = (bf16_t*)(c.ws + WS_WQKV) + (size_t)nb * 64 * 1024 + kb * 64; return t; } r -= I_QKV;
        if (r < I_O) { const int nb = r % 16, kb = r / 16; t.src = c.a->in[10] + (size_t)kb * 64 * D + nb * 64; t.ldw = D; t.dst = (bf16_t*)(c.ws + WS_WO) + (size_t)nb * 64 * 1024 + kb * 64; return t; } r -= I_O;
        if (r < I_IN) { const int nb = r % 80, kb = r / 80; t.src = c.a->in[11] + (size_t)kb * 64 * HIN + nb * 64; t.ldw = HIN; t.dst8 = c.ws + WS_WIN + (size_t)nb * 64 * 1024 + kb * 64; return t; } r -= I_IN;
        if (r < I_HO) { const int nb = r % 16, kb = r / 16; t.src = c.a->in[14] + (size_t)kb * 64 * D + nb * 64; t.ldw = D; t.dst = (bf16_t*)(c.ws + WS_WHO) + (size_t)nb * 64 * 1024 + kb * 64; return t; } r -= I_HO;
    }
    const int moff = (part - 1) * 32;
    if (r < I_GU) { const int mat = moff + r / 512, rr = r % 512, nb = rr % 32, kb = rr / 32; const int n0 = ((nb & 3) >> 1) * 1024 + (nb >> 2) * 128 + (nb & 1) * 64;
        t.src = c.a->in[17] + (size_t)mat * 1024 * 2048 + (size_t)kb * 64 * 2048 + n0; t.ldw = 2048; t.dst8 = c.ws + WS_WGU + ((size_t)mat * 2048 + nb * 64) * 1024 + kb * 64; return t; } r -= I_GU;
    { const int mat = moff + r / 256, rr = r % 256, nb = rr % 16, kb = rr / 16;
        t.src = c.a->in[19] + (size_t)mat * 1024 * 1024 + (size_t)kb * 64 * 1024 + nb * 64; t.ldw = 1024; t.dst8 = c.ws + WS_WDN + ((size_t)mat * 1024 + nb * 64) * 1024 + kb * 64; }
    return t;
}
__device__ __forceinline__ void convert_run(const Ctx& c, int part, int first, int step, int end, LAS float* scr) {
    f32x4 va[16], vb[16];
    int it = first;
    TBlk ta, tbk;
    if (it < end) { ta = convert_item(c, it, part); tb_load(ta, c.lane, va); }
    for (; it < end; it += 2 * step) {
        const bool hb = it + step < end;
        if (hb) { tbk = convert_item(c, it + step, part); tb_load(tbk, c.lane, vb); }
        tb_store(ta, c.lane, va, scr);
        const bool ha = it + 2 * step < end;
        if (ha) { ta = convert_item(c, it + 2 * step, part); tb_load(ta, c.lane, va); }
        if (hb) tb_store(tbk, c.lane, vb, scr);
    }
}
__device__ __forceinline__ void convert_steal(const Ctx& c, int part) {
    LAS float* scr = (LAS float*)c.lds + c.wave * (64 * 65);
    LAS int* chp = (LAS int*)(c.lds + 8 * 64 * 65 * 4);
    unsigned* ctr = (unsigned*)(c.ws + WS_CTL) + CW_CONV + 64 * part;
    for (;;) {
        __syncthreads();
        if (c.tid == 0) *chp = (int)atomicAdd(ctr, 1u);
        __syncthreads();
        const int ch = *chp;
        if (ch >= CONV_B / CONV_CHUNK) break;
        convert_run(c, part, ch * CONV_CHUNK + c.wave, 8, (ch + 1) * CONV_CHUNK, scr);
    }
}
__device__ __forceinline__ void phase_convert(const Ctx& c) {
    LAS float* scr = (LAS float*)c.lds + c.wave * (64 * 65);
    convert_run(c, 0, c.wg * 8 + c.wave, c.nwg * 8, CONV_A, scr);
    __syncthreads();
    phase_norm0(c);
}

__device__ __forceinline__ void phase_combine(const Ctx& c, int layer) {
    LAS int* so = (LAS int*)(c.lds + 32768);
    moe_offsets(c, layer, so);
    const unsigned char* outb = c.ws + WS_OUTB; bf16_t* X = (bf16_t*)(c.ws + WS_X);
    const bf16_t* Xin = layer == 0 ? X : (const bf16_t*)(c.ws + WS_X1);
    const float* ngl = c.a->in[6] + layer * 4 * D;
    const int* tk_e = (const int*)(c.ws + WS_TK); const float* tk_g = (const float*)(c.ws + WS_TK) + R * 4; const int* tk_slot = (const int*)(c.ws + WS_TK) + 2 * R * 4;
    const int r_lo = layer == 0 ? 0 : C, stride = c.nwg * 8;
    int r = r_lo + c.wg * 8 + c.wave;
    int pe[4], ps[4]; float pg[4]; unsigned wn[4][4]; f32x4 xn[4]; float gn[4];
#define CB_TK(row) do { _Pragma("unroll") for (int k = 0; k < 4; ++k) { pe[k] = tk_e[(row) * 4 + k]; ps[k] = tk_slot[(row) * 4 + k]; pg[k] = tk_g[(row) * 4 + k]; } } while (0)
#define CB_DATA(row) do { _Pragma("unroll") for (int k = 0; k < 4; ++k) { const unsigned char* src_ = outb + (size_t)(so[pe[k]] + ps[k]) * 1024; gn[k] = pg[k] * (1.f / F8_SO); \
        _Pragma("unroll") for (int j = 0; j < 4; ++j) wn[k][j] = *(const unsigned*)(src_ + c.lane * 4 + 256 * j); } row_load_bf(Xin + (size_t)(row) * D, c.lane, xn); } while (0)
    if (r < R) { CB_TK(r); CB_DATA(r); }
    if (r + stride < R) CB_TK(r + stride);
    for (; r < R; r += stride) {
        const float* m = c.modp(layer, r < C ? 1 : 0);
        f32x4 y[4], x[4];
#pragma unroll
        for (int j = 0; j < 4; ++j) { y[j] = (f32x4){0.f, 0.f, 0.f, 0.f}; x[j] = xn[j]; }
#pragma unroll
        for (int k = 0; k < 4; ++k)
#pragma unroll
            for (int j = 0; j < 4; ++j) { const f32x2 lo = __builtin_amdgcn_cvt_pk_f32_fp8((int)wn[k][j], false), hi = __builtin_amdgcn_cvt_pk_f32_fp8((int)wn[k][j], true); y[j] += (f32x4){lo[0], lo[1], hi[0], hi[1]} * gn[k]; }
        if (r + stride < R) CB_DATA(r + stride);
        if (r + 2 * stride < R) CB_TK(r + 2 * stride);
        const float rstd_y = rsqrtf(row_ss(y) * (1.f / D) + EPS);
#pragma unroll
        for (int j = 0; j < 4; ++j) {
            const int c0 = c.lane * 4 + 256 * j;
            const f32x4 g2 = *(const f32x4*)(m + 5120 + c0), n3 = *(const f32x4*)(ngl + 3 * D + c0);
            x[j].x += g2.x * (y[j].x * rstd_y * n3.x); x[j].y += g2.y * (y[j].y * rstd_y * n3.y);
            x[j].z += g2.z * (y[j].z * rstd_y * n3.z); x[j].w += g2.w * (y[j].w * rstd_y * n3.w);
            if (layer == 0) { u32x2 xo; xo.x = pk2(x[j][0], x[j][1]); xo.y = pk2(x[j][2], x[j][3]); *(u32x2*)(X + (size_t)r * D + c0) = xo; x[j] = (f32x4){bflo(xo.x), bfhi(xo.x), bflo(xo.y), bfhi(xo.y)}; }
            else *(f32x4*)(c.a->out + (size_t)(r - C) * D + c0) = x[j];
        }
        if (layer == 0) {
            const float rstd_x = rsqrtf(row_ss(x) * (1.f / D) + EPS);
            const float* m1 = c.modp(1, r < C ? 1 : 0); const float* g0 = c.a->in[6] + 4 * D;
#pragma unroll
            for (int j = 0; j < 4; ++j) {
                const int c0 = c.lane * 4 + 256 * j;
                const f32x4 gv = *(const f32x4*)(g0 + c0), shv = *(const f32x4*)(m1 + c0), scv = *(const f32x4*)(m1 + 1024 + c0);
                const f32x4 hv = x[j] * rstd_x * gv * (scv + 1.f) + shv;
                *(unsigned*)(c.ws + WS_H8 + (size_t)r * D + c0) = pk4_fp8(hv[0] * F8_SH, hv[1] * F8_SH, hv[2] * F8_SH, hv[3] * F8_SH);
            }
        }
    }
#undef CB_TK
#undef CB_DATA
}

namespace hg {
typedef _Float16 h2_t __attribute__((ext_vector_type(2)));
constexpr int TB = 272, PB = 144;
constexpr int TILE = 64 * TB;
constexpr int T_QD = 0, T_QC = TILE, T_KD = 2 * TILE, T_KE = 3 * TILE, T_KC = 4 * TILE, T_V0 = 5 * TILE, T_V1 = 6 * TILE;
constexpr int T_QL1 = 7 * TILE, T_KL1 = T_QL1 + 16 * TB, T_P = T_KL1 + 16 * TB, T_TOT = T_P + 64 * PB, T_CT = T_TOT + 4096, T_END = T_CT + 512;
static_assert(T_END <= LDS_BYTES - 64, "hgrn scan LDS map");
__device__ __forceinline__ int row_of(int dir, int p) { return p < C ? (dir ? C - 1 - p : p) : (dir ? C + (L - 1 - (p - C)) : p); }
__device__ __forceinline__ int seg_of(int ch) { return ch < 68 ? ch / 17 : 4 + (ch - 68) / 16; }
__device__ __forceinline__ bf16x8 tr_frag(const LAS unsigned char* tile, int row0, int col0, int lane) {
    const int q = (lane & 15) >> 2, p = lane & 3;
    const LAS unsigned char* a = tile + (row0 + q) * TB + (col0 + 4 * p) * 2;
    const v4i16_t lo = __builtin_amdgcn_ds_read_tr16_b64_v4i16((LAS v4i16_t*)a);
    const v4i16_t hi = __builtin_amdgcn_ds_read_tr16_b64_v4i16((LAS v4i16_t*)(a + 4 * TB));
    return (bf16x8){lo[0], lo[1], lo[2], lo[3], hi[0], hi[1], hi[2], hi[3]};
}
}

__device__ __forceinline__ void phase_hgrn_scan(const Ctx& c) {
    using namespace hg;
#define HG_BAR() asm volatile("s_waitcnt lgkmcnt(0)\n\ts_barrier" ::: "memory")
    const bf16_t* QH = (const bf16_t*)(c.ws + WS_QH); const bf16_t* IV = (const bf16_t*)(c.ws + WS_IV);
    LAS unsigned char* lds = c.lds;
    const int tid = c.tid, lane = c.lane, w = __builtin_amdgcn_readfirstlane(tid >> 6), fr = lane & 15, g = lane >> 4;
    for (int item_ = c.wg; item_ < 256 * SCAN_REP; item_ += c.nwg) {
        const int item = item_ & 255;
        const int chain = item >> 4, seg = item & 15, head = chain >> 1, dir = chain & 1, hc = head * 128;
        const int c0 = seg < 4 ? 17 * seg : 68 + 16 * (seg - 4), nch = seg < 4 ? 17 : 16;
        const _Float16* KX = (const _Float16*)(c.ws + (dir ? WS_KB : WS_KF));
        bf16_t* OL = (bf16_t*)(c.ws + (dir ? WS_OB : WS_OF)); bf16_t* QS = (bf16_t*)(c.ws + (dir ? WS_QSB : WS_QSF));
        HG_BAR();
        for (int i = tid; i < 64 * PB / 4; i += 512) ((LAS unsigned*)(lds + T_P))[i] = 0u;
        f32x4 Sacc[8];
#pragma unroll
        for (int m = 0; m < 8; ++m) Sacc[m] = (f32x4){0.f, 0.f, 0.f, 0.f};
        float dseg0 = 1.f, dseg1 = 1.f;
        unsigned kraw[8], qraw[8]; u32x4 vraw[2];
#define HG_LOAD(cidx) do { const int p0_ = 64 * (cidx); const bool lat_ = (cidx) >= 4; \
        _Pragma("unroll") for (int i = 0; i < 8; ++i) { const int r_ = row_of(dir, p0_ + 8 * w + i); \
            kraw[i] = *(const unsigned*)(KX + (size_t)r_ * D + hc + 2 * lane); \
            qraw[i] = lat_ ? *(const unsigned*)(QH + (size_t)(r_ - C) * D + hc + 2 * lane) : 0u; } \
        _Pragma("unroll") for (int i = 0; i < 2; ++i) { const int idx_ = tid + 512 * i; const int r_ = row_of(dir, p0_ + (idx_ >> 4)); \
            vraw[i] = *(const u32x4*)(IV + (size_t)r_ * D + hc + (idx_ & 15) * 8); } } while (0)
        HG_LOAD(c0);
        for (int ci = 0; ci < nch; ++ci) {
            const int cidx = c0 + ci; const bool lat = cidx >= 4;
            const int vbuf = (ci & 1) ? T_V1 : T_V0;
            float kf[8][2], qf[8][2], cp[8][2];
            {
                float p0 = 1.f, p1 = 1.f;
#pragma unroll
                for (int i = 0; i < 8; ++i) {
                    const h2_t hv = __builtin_bit_cast(h2_t, kraw[i]);
                    kf[i][0] = (float)hv[0]; kf[i][1] = (float)hv[1];
                    qf[i][0] = bflo(qraw[i]); qf[i][1] = bfhi(qraw[i]);
                    p0 *= (1.f - kf[i][0]); p1 *= (1.f - kf[i][1]); cp[i][0] = p0; cp[i][1] = p1;
                }
                *(LAS f32x2*)(lds + T_TOT + (w * 128 + 2 * lane) * 4) = (f32x2){p0, p1};
#pragma unroll
                for (int i = 0; i < 2; ++i) { const int idx = tid + 512 * i; *(LAS u32x4*)(lds + vbuf + (idx >> 4) * TB + (idx & 15) * 16) = vraw[i]; }
            }
            HG_BAR();
            {
                f32x2 T[8];
#pragma unroll
                for (int x = 0; x < 8; ++x) T[x] = *(const LAS f32x2*)(lds + T_TOT + (x * 128 + 2 * lane) * 4);
                const int I = w >> 1, hh = w & 1;
                f32x2 bd[4];
#pragma unroll
                for (int x = 0; x < 4; ++x) bd[x] = T[2 * x] * T[2 * x + 1];
                f32x2 pre = (f32x2){1.f, 1.f}, cum = (f32x2){1.f, 1.f}, suf = (f32x2){1.f, 1.f}, bdI = (f32x2){1.f, 1.f};
#pragma unroll
                for (int x = 0; x < 8; ++x) if (hh && x == w - 1) pre = T[x];
#pragma unroll
                for (int x = 0; x < 4; ++x) { if (x < I) cum = cum * bd[x]; if (x > I) suf = suf * bd[x]; if (x == I) bdI = bd[x]; }
                const f32x2 ctot = (bd[0] * bd[1]) * (bd[2] * bd[3]);
#pragma unroll
                for (int i = 0; i < 8; ++i) {
                    const int tau = 8 * w + i;
                    float QDv[2], KDv[2], KEv[2], QCv[2], KCv[2];
#pragma unroll
                    for (int x = 0; x < 2; ++x) {
                        const float eq = pre[x] * cp[i][x], rc = __builtin_amdgcn_rcpf(eq);
                        QDv[x] = qf[i][x] * eq; KDv[x] = kf[i][x] * rc; KEv[x] = KDv[x] * bdI[x]; QCv[x] = QDv[x] * cum[x]; KCv[x] = KEv[x] * suf[x];
                    }
                    const int to = tau * TB + lane * 4;
                    *(LAS unsigned*)(lds + T_QD + to) = pk2(QDv[0], QDv[1]);
                    *(LAS unsigned*)(lds + T_KD + to) = pk2(KDv[0], KDv[1]);
                    *(LAS unsigned*)(lds + T_KE + to) = pk2(KEv[0], KEv[1]);
                    *(LAS unsigned*)(lds + T_QC + to) = pk2(QCv[0], QCv[1]);
                    *(LAS unsigned*)(lds + T_KC + to) = pk2(KCv[0], KCv[1]);
                    if (I == 3) *(LAS unsigned*)(lds + T_QL1 + (tau - 48) * TB + lane * 4) = pk2(QDv[0] * bd[2][0], QDv[1] * bd[2][1]);
                    if (I == 0) *(LAS unsigned*)(lds + T_KL1 + tau * TB + lane * 4) = pk2(KEv[0] * bd[1][0], KEv[1] * bd[1][1]);
                    if (lat) { const int r = row_of(dir, 64 * cidx + tau); *(unsigned*)(QS + (size_t)(r - C) * D + hc + 2 * lane) = pk2(QCv[0] * dseg0, QCv[1] * dseg1); }
                }
                dseg0 *= ctot[0]; dseg1 *= ctot[1];
                if (w == 0) *(LAS f32x2*)(lds + T_CT + lane * 8) = ctot;
            }
            HG_BAR();
            if (ci + 1 < nch) HG_LOAD(cidx + 1);
            if (lat) {
                const int nblk = w >= 6 ? 2 : 1;
                for (int b = 0; b < nblk; ++b) {
                    int I, J, qoff, qrow, koff, krow; bool diag = false;
                    if (w < 4) { I = 2 + (w >> 1); J = w & 1; qoff = (w >> 1) ? T_QL1 : T_QD; qrow = (w >> 1) ? 0 : 32; koff = (w & 1) ? T_KE : T_KL1; krow = (w & 1) ? 16 : 0; }
                    else if (w == 4) { I = 1; J = 0; qoff = T_QD; qrow = 16; koff = T_KE; krow = 0; }
                    else if (w == 5) { I = 3; J = 2; qoff = T_QD; qrow = 48; koff = T_KE; krow = 32; }
                    else { I = 2 * (w - 6) + b; J = I; qoff = T_QD; qrow = 16 * I; koff = T_KD; krow = 16 * I; diag = true; }
                    f32x4 pa = (f32x4){0.f, 0.f, 0.f, 0.f};
#pragma unroll
                    for (int ks = 0; ks < 4; ++ks) {
                        const bf16x8 av = *(const LAS bf16x8*)(lds + qoff + (qrow + fr) * TB + (32 * ks + 8 * g) * 2);
                        const bf16x8 bv = *(const LAS bf16x8*)(lds + koff + (krow + fr) * TB + (32 * ks + 8 * g) * 2);
                        pa = __builtin_amdgcn_mfma_f32_16x16x32_bf16(av, bv, pa, 0, 0, 0);
                    }
#pragma unroll
                    for (int e = 0; e < 4; ++e) {
                        const int tl = 4 * g + e; const float val = (diag && fr > tl) ? 0.f : pa[e];
                        *(LAS bf16_t*)(lds + T_P + (16 * I + tl) * PB + (16 * J + fr) * 2) = (bf16_t)f2bf(val);
                    }
                }
            }
            f32x4 oacc[4];
#pragma unroll
            for (int m = 0; m < 4; ++m) oacc[m] = (f32x4){0.f, 0.f, 0.f, 0.f};
            if (lat) {
                bf16x8 Sb[4];
#pragma unroll
                for (int ks = 0; ks < 4; ++ks) {
                    const f32x4 a0 = Sacc[2 * ks], a1 = Sacc[2 * ks + 1];
                    const u32x4 pk = (u32x4){pk2(a0[0], a0[1]), pk2(a0[2], a0[3]), pk2(a1[0], a1[1]), pk2(a1[2], a1[3])};
                    Sb[ks] = __builtin_bit_cast(bf16x8, pk);
                }
#pragma unroll
                for (int m = 0; m < 4; ++m)
#pragma unroll
                    for (int ks = 0; ks < 4; ++ks) {
                        const u32x2 lo = *(const LAS u32x2*)(lds + T_QC + (16 * m + fr) * TB + (32 * ks + 4 * g) * 2);
                        const u32x2 hi = *(const LAS u32x2*)(lds + T_QC + (16 * m + fr) * TB + (32 * ks + 16 + 4 * g) * 2);
                        const u32x4 pk = (u32x4){lo.x, lo.y, hi.x, hi.y};
                        oacc[m] = __builtin_amdgcn_mfma_f32_16x16x32_bf16(__builtin_bit_cast(bf16x8, pk), Sb[ks], oacc[m], 0, 0, 0);
                    }
            }
#pragma unroll
            for (int m = 0; m < 8; ++m) { const f32x4 ct = *(const LAS f32x4*)(lds + T_CT + (16 * m + 4 * g) * 4); Sacc[m] = Sacc[m] * ct; }
            bf16x8 Vf[2];
#pragma unroll
            for (int ks = 0; ks < 2; ++ks) Vf[ks] = tr_frag(lds + vbuf, 32 * ks + 8 * g, 16 * w, lane);
#pragma unroll
            for (int m = 0; m < 8; ++m)
#pragma unroll
                for (int ks = 0; ks < 2; ++ks) Sacc[m] = __builtin_amdgcn_mfma_f32_16x16x32_bf16(tr_frag(lds + T_KC, 32 * ks + 8 * g, 16 * m, lane), Vf[ks], Sacc[m], 0, 0, 0);
            HG_BAR();
            if (lat) {
#pragma unroll
                for (int m = 0; m < 4; ++m)
#pragma unroll
                    for (int ks = 0; ks < 2; ++ks) {
                        if (m < 2 && ks == 1) continue;
                        const bf16x8 av = *(const LAS bf16x8*)(lds + T_P + (16 * m + fr) * PB + (32 * ks + 8 * g) * 2);
                        oacc[m] = __builtin_amdgcn_mfma_f32_16x16x32_bf16(av, Vf[ks], oacc[m], 0, 0, 0);
                    }
#pragma unroll
                for (int m = 0; m < 4; ++m)
#pragma unroll
                    for (int e = 0; e < 4; ++e) { const int r = row_of(dir, 64 * cidx + 16 * m + 4 * g + e); OL[(size_t)(r - C) * D + hc + 16 * w + fr] = (bf16_t)f2bf(oacc[m][e]); }
            }
        }
#undef HG_LOAD
        float* DS = (float*)(c.ws + WS_DS) + (size_t)item * 16384; float* DG = (float*)(c.ws + WS_DG) + item * 128;
#pragma unroll
        for (int m = 0; m < 8; ++m)
#pragma unroll
            for (int e = 0; e < 4; ++e) DS[(16 * m + 4 * g + e) * 128 + 16 * w + fr] = Sacc[m][e];
        if (w == 0) { DG[2 * lane] = dseg0; DG[2 * lane + 1] = dseg1; }
    }
}

#undef HG_BAR
__device__ __forceinline__ void phase_hgrn_fold(const Ctx& c) {
    const float* DS = (const float*)(c.ws + WS_DS); const float* DG = (const float*)(c.ws + WS_DG); bf16_t* SST = (bf16_t*)(c.ws + WS_SST);
    for (int item = c.wg; item < 256; item += c.nwg) {
        const int chain = item >> 4, slice = item & 15, d = 8 * slice + (c.tid >> 6), v2 = (c.tid & 63) * 2;
        float s0 = 0.f, s1 = 0.f;
        float dv[15]; f32x2 ds[15];
#pragma unroll
        for (int sgi = 0; sgi < 15; ++sgi) { dv[sgi] = DG[(chain * 16 + sgi) * 128 + d]; ds[sgi] = *(const f32x2*)(DS + ((size_t)(chain * 16 + sgi) * 128 + d) * 128 + v2); }
        SST[((size_t)(chain * 16) * 128 + v2) * 128 + d] = 0; SST[((size_t)(chain * 16) * 128 + v2 + 1) * 128 + d] = 0;
#pragma unroll
        for (int sgi = 0; sgi < 15; ++sgi) {
            s0 = dv[sgi] * s0 + ds[sgi][0]; s1 = dv[sgi] * s1 + ds[sgi][1];
            SST[((size_t)(chain * 16 + sgi + 1) * 128 + v2) * 128 + d] = (bf16_t)f2bf(s0); SST[((size_t)(chain * 16 + sgi + 1) * 128 + v2 + 1) * 128 + d] = (bf16_t)f2bf(s1);
        }
    }
}

__device__ __forceinline__ void phase_hgrn_readout(const Ctx& c) {
    constexpr int SP = 272, SBUF = 128 * SP, IBUF = 2 * SBUF;
    static_assert(2 * IBUF + 1024 <= LDS_BYTES - 64, "readout LDS map");
    const bf16_t* OF = (const bf16_t*)(c.ws + WS_OF); const bf16_t* OB = (const bf16_t*)(c.ws + WS_OB); const bf16_t* SGp = (const bf16_t*)(c.ws + WS_SG);
    const bf16_t* SST = (const bf16_t*)(c.ws + WS_SST); bf16_t* RR = (bf16_t*)(c.ws + WS_RR); const float* hng = c.a->in[13];
    LAS unsigned char* lds = c.lds; LAS float* ssx = (LAS float*)(c.lds + 2 * IBUF);
    const int tid = c.tid, lane = c.lane, w = __builtin_amdgcn_readfirstlane(tid >> 6), fr = lane & 15, g = lane >> 4, mt = w & 3, nh = w >> 2;
#define RO_BAR() asm volatile("s_waitcnt lgkmcnt(0)\n\ts_barrier" ::: "memory")
    u32x4 sreg[8];
#define RO_SST_LOAD(it) do { const int h_ = (it) >> 8, ch_ = (it) & 255; \
        _Pragma("unroll") for (int j = 0; j < 8; ++j) { const int idx_ = tid + 512 * j, dx_ = idx_ >> 11, rem_ = idx_ & 2047; \
            const int sg_ = hg::seg_of(dx_ ? 4 + 255 - ch_ : 4 + ch_); \
            sreg[j] = *(const u32x4*)(SST + ((size_t)((h_ * 2 + dx_) * 16 + sg_) * 128 + (rem_ >> 4)) * 128 + (rem_ & 15) * 8); } } while (0)
#define RO_SST_WRITE(buf) do { _Pragma("unroll") for (int j = 0; j < 8; ++j) { const int idx_ = tid + 512 * j, dx_ = idx_ >> 11, rem_ = idx_ & 2047; \
            *(LAS u32x4*)(lds + (buf) * IBUF + dx_ * SBUF + (rem_ >> 4) * SP + (rem_ & 15) * 16) = sreg[j]; } } while (0)
    int it = c.wg;
    RO_BAR();
    if (it < 2048) { RO_SST_LOAD(it); RO_SST_WRITE(0); }
    RO_BAR();
    for (int k = 0; it < 2048; it += c.nwg, ++k) {
        const int h = it >> 8, ch = it & 255, t0 = 64 * ch + 16 * mt, buf = k & 1;
        const bool has_next = it + c.nwg < 2048;
        if (has_next) RO_SST_LOAD(it + c.nwg);
        f32x4 acc[4]; float sgv[4][4];
#pragma unroll
        for (int n = 0; n < 4; ++n)
#pragma unroll
            for (int e = 0; e < 4; ++e) { const size_t o = (size_t)(t0 + 4 * g + e) * D + h * 128 + 64 * nh + 16 * n + fr; acc[n][e] = bf2f(OF[o]) + bf2f(OB[o]); sgv[n][e] = bf2f(SGp[o]) * hng[h * 128 + 64 * nh + 16 * n + fr]; }
#pragma unroll
        for (int dx = 0; dx < 2; ++dx) {
            const bf16_t* QS = (const bf16_t*)(c.ws + (dx ? WS_QSB : WS_QSF)) + (size_t)(t0 + fr) * D + h * 128 + 8 * g;
            const LAS unsigned char* sb = lds + buf * IBUF + dx * SBUF + (64 * nh + fr) * SP + 16 * g;
#pragma unroll
            for (int ks = 0; ks < 4; ++ks) {
                const bf16x8 av = *(const bf16x8*)(QS + 32 * ks);
#pragma unroll
                for (int n = 0; n < 4; ++n) acc[n] = __builtin_amdgcn_mfma_f32_16x16x32_bf16(av, *(const LAS bf16x8*)(sb + (16 * n) * SP + 64 * ks), acc[n], 0, 0, 0);
            }
        }
        float ss[4] = {0.f, 0.f, 0.f, 0.f};
#pragma unroll
        for (int n = 0; n < 4; ++n)
#pragma unroll
            for (int e = 0; e < 4; ++e) ss[e] += acc[n][e] * acc[n][e];
#pragma unroll
        for (int e = 0; e < 4; ++e) {
#pragma unroll
            for (int sh = 8; sh > 0; sh >>= 1) ss[e] += __shfl_xor(ss[e], sh);
        }
        if (fr == 0) *(LAS f32x4*)(ssx + ((k & 1) * 8 + w) * 16 + 4 * g) = (f32x4){ss[0], ss[1], ss[2], ss[3]};
        if (has_next) RO_SST_WRITE(buf ^ 1);
        RO_BAR();
        const f32x4 ps = *(const LAS f32x4*)(ssx + ((k & 1) * 8 + (w ^ 4)) * 16 + 4 * g);
#pragma unroll
        for (int e = 0; e < 4; ++e) ss[e] = rsqrtf((ss[e] + ps[e]) * (1.f / 128.f) + EPS);
#pragma unroll
        for (int n = 0; n < 4; ++n)
#pragma unroll
            for (int e = 0; e < 4; ++e) { const size_t o = (size_t)(t0 + 4 * g + e) * D + h * 128 + 64 * nh + 16 * n + fr; RR[o] = (bf16_t)f2bf(acc[n][e] * ss[e] * sgv[n][e]); }
    }
    RO_BAR();
#undef RO_BAR
#undef RO_SST_LOAD
#undef RO_SST_WRITE
}

#define XB_TMO      128
#define XB_XCNT(j)  (256  + 64 * (j))
#define XB_XSUB(j)  (1280 + 64 * (j))
#define XB_XGEN(j)  (2304 + 64 * (j))
#define XB_TOP      3328
#define XB_TOPGEN   3392
#define XCD_BAR_WORDS 3456
#define XB_SPIN_CAP (1u << 18)
__device__ __forceinline__ unsigned xb_ld(unsigned* p)              { return __hip_atomic_load(p, __ATOMIC_RELAXED, __HIP_MEMORY_SCOPE_AGENT); }
__device__ __forceinline__ unsigned xb_add(unsigned* p, unsigned v) { return __hip_atomic_fetch_add(p, v, __ATOMIC_RELAXED, __HIP_MEMORY_SCOPE_AGENT); }
__device__ __forceinline__ unsigned xb_xcc_id() { return (unsigned)__builtin_amdgcn_s_getreg((3 << 11) | 20) & 0xFu; }
#define XB_SPIN(cond, bar) do { unsigned _sp = 0; while (cond) { __builtin_amdgcn_s_sleep(1); \
    if ((++_sp & 255u) == 0u) { if (xb_ld(&(bar)[XB_TMO])) break; if (_sp > XB_SPIN_CAP) { atomicAdd(&(bar)[XB_TMO], 1u); break; } } } } while (0)
struct XcdBarrier { unsigned* bar; unsigned x; volatile LAS unsigned* st; };
__device__ __forceinline__ XcdBarrier xcd_barrier_post(unsigned* bar, volatile LAS unsigned* st) {
    XcdBarrier b; b.bar = bar; b.x = xb_xcc_id(); b.st = st;
    if (threadIdx.x == 0) (void)xb_add(&bar[XB_XCNT(b.x)], 1u);
    return b;
}
__device__ __forceinline__ void xcd_barrier_complete(unsigned* bar, unsigned x, unsigned& nloc, unsigned& nx) {
    const unsigned G = gridDim.x * gridDim.y * gridDim.z;
    unsigned sum, cnt, mine, sp = 0u;
    for (;;) {
        sum = 0u; cnt = 0u; mine = 0u;
#pragma unroll
        for (unsigned j = 0; j < 16; ++j) { const unsigned c = xb_ld(&bar[XB_XCNT(j)]); sum += c; cnt += (c > 0u) ? 1u : 0u; mine = (j == x) ? c : mine; }
        if (sum == G) break;
        __builtin_amdgcn_s_sleep(1);
        if ((++sp & 255u) == 0u) { if (xb_ld(&bar[XB_TMO])) break; if (sp > XB_SPIN_CAP) { atomicAdd(&bar[XB_TMO], 1u); break; } }
    }
    nloc = mine > 0u ? mine : 1u; nx = cnt > 0u ? cnt : 1u;
}
__device__ __forceinline__ void xcd_barrier(const XcdBarrier& b) {
    asm volatile("s_waitcnt vmcnt(0)" ::: "memory");
    __syncthreads();
    if (threadIdx.x == 0) {
        unsigned* bar = b.bar;
        __builtin_amdgcn_s_waitcnt(0);
        unsigned nloc = b.st[0], nx = b.st[1];
        if (nloc == 0u) { xcd_barrier_complete(bar, b.x, nloc, nx); b.st[0] = nloc; b.st[1] = nx; }
        const unsigned old = xb_add(&bar[XB_XSUB(b.x)], 1u);
        const unsigned gen = old / nloc;
        if (old + 1u == (gen + 1u) * nloc) {
            __builtin_amdgcn_fence(__ATOMIC_RELEASE, "agent");
            asm volatile("s_waitcnt vmcnt(0)" ::: "memory");
            const unsigned og = xb_add(&bar[XB_TOP], 1u);
            const unsigned tg = og / nx;
            if (og + 1u == (tg + 1u) * nx) xb_add(&bar[XB_TOPGEN], 1u);
            else XB_SPIN(xb_ld(&bar[XB_TOPGEN]) == tg, bar);
            __builtin_amdgcn_fence(__ATOMIC_ACQUIRE, "agent");
            xb_add(&bar[XB_XGEN(b.x)], 1u);
            asm volatile("s_waitcnt vmcnt(0)" ::: "memory");
        } else {
            XB_SPIN(xb_ld(&bar[XB_XGEN(b.x)]) == gen, bar);
            __builtin_amdgcn_fence(__ATOMIC_ACQUIRE, "agent");
            asm volatile("s_waitcnt vmcnt(0)" ::: "memory");
        }
    }
    __syncthreads();
}

__device__ __forceinline__ void launder(Ctx& c) { asm volatile("" : "+s"(c.a)); asm volatile("" : "+s"(c.ws)); asm volatile("" : "+s"(c.wave));
    c.lane = (int)__builtin_amdgcn_mbcnt_hi(~0u, __builtin_amdgcn_mbcnt_lo(~0u, 0u)); c.tid = c.wave * 64 + c.lane; }
__global__ void __launch_bounds__(512, 2) mk_fwd(Args args) {
    extern __shared__ __attribute__((aligned(16))) unsigned char lds_raw[];
    Ctx c; c.a = (CArgs)__builtin_amdgcn_kernarg_segment_ptr(); c.lds = (LAS unsigned char*)lds_raw; c.tid = threadIdx.x; c.lane = c.tid & 63; c.wave = __builtin_amdgcn_readfirstlane(c.tid >> 6); c.nwg = gridDim.x; c.wg = blockIdx.x; c.ws = c.a->ws;
    volatile LAS unsigned* bst = (volatile LAS unsigned*)(c.lds + LDS_BYTES - 64);
    if (c.tid < 4) bst[c.tid] = 0u;
    __syncthreads();
    const XcdBarrier bar = xcd_barrier_post((unsigned*)(c.ws + WS_CTL) + CW_BAR, bst);
    const int lo = c.a->ph_lo, hi = c.a->ph_hi;
    bool route_ok = true;
#define SEAM(k) do { if (lo <= (k) && (k) + 1 < hi) xcd_barrier(bar); } while (0)
#define IN(k) (lo <= (k) && (k) < hi && (launder(c), true))
#define PH(k, call) do { if (IN(k)) { if (PROBE_PH == (k)) { int nrep_ = 3; asm volatile("" : "+s"(nrep_)); for (int rep_ = 0; rep_ < nrep_; ++rep_) { route_ok = (rep_ + 1 == nrep_); call; if (rep_ + 1 < nrep_) xcd_barrier(bar); } } else { call; } } SEAM(k); } while (0)
    PH(0, phase_prep(c));
    PH(1, phase_convert(c));
    PH(2, phase_gemm_qkv(c));
    PH(3, phase_attn(c));
    PH(4, phase_gemm_f32(c, (const bf16_t*)(c.ws + WS_O), R, (const bf16_t*)(c.ws + WS_WO), D, nullptr, (bf16_t*)(c.ws + WS_RAW1)));
    PH(5, { phase_postmix<128>(c, 0, route_ok); convert_steal(c, 1); });
    PH(6, phase_moe_gu(c, 0));
    PH(7, phase_moe_dn(c, 0));
    PH(8, phase_combine(c, 0));
    PH(9, phase_gemm_inproj(c));
    PH(10, phase_hgrn_scan(c));
    PH(11, phase_hgrn_fold(c));
    PH(12, phase_hgrn_readout(c));
    PH(13, phase_gemm_f32(c, (const bf16_t*)(c.ws + WS_RR), L, (const bf16_t*)(c.ws + WS_WHO), D, nullptr, (bf16_t*)(c.ws + WS_RAW1)));
    PH(14, { phase_postmix<128>(c, 1, route_ok); convert_steal(c, 2); });
    PH(15, phase_moe_gu(c, 1));
    PH(16, phase_moe_dn(c, 1));
    PH(17, phase_combine(c, 1));
#undef IN
#undef PH
#undef SEAM
}

extern "C" void kernel_launch(void* const* d_in, const int* in_sizes, int n_in, void* d_out, int out_size, void* d_ws, size_t ws_size, hipStream_t stream) {
    static int grid = 0;
    if (grid == 0) {
        if (n_in != 21 || out_size != L * D || ws_size < WS_END) { fprintf(stderr, "kernel_launch: unexpected problem (n_in %d out %d ws %zu need %zu)\n", n_in, out_size, ws_size, (size_t)WS_END); grid = -1; return; }
        int dev = 0, cus = 0, per_cu = 0;
        hipGetDevice(&dev); hipDeviceGetAttribute(&cus, hipDeviceAttributeMultiprocessorCount, dev);
        if (hipFuncSetAttribute((const void*)mk_fwd, hipFuncAttributeMaxDynamicSharedMemorySize, LDS_BYTES) != hipSuccess) { fprintf(stderr, "kernel_launch: hipFuncSetAttribute failed\n"); grid = -1; return; }
        hipOccupancyMaxActiveBlocksPerMultiprocessor(&per_cu, (const void*)mk_fwd, 512, LDS_BYTES);
        if (per_cu < 1) fprintf(stderr, "kernel_launch: occupancy query says %d\n", per_cu);
        (void)hipGetLastError();
        grid = cus > 0 ? cus : 256;
    }
    if (grid < 0) return;
    hipMemsetAsync((char*)d_ws + WS_CTL, 0, MiB, stream);
    Args a{};
    for (int i = 0; i < 21; ++i) a.in[i] = (const float*)d_in[i];
    a.out = (float*)d_out; a.ws = (unsigned char*)d_ws;
    a.ph_lo = 0; a.ph_hi = NPHASE;
    hipLaunchKernelGGL(mk_fwd, dim3(grid), dim3(512), LDS_BYTES, stream, a);
}
```

```cpp
#include <hip/hip_runtime.h>
#include <cstdint>
#include <cstdio>

#define LAS __attribute__((address_space(3)))
typedef unsigned short bf16_t;
typedef short bf16x8 __attribute__((ext_vector_type(8)));
typedef float f32x4 __attribute__((ext_vector_type(4)));
typedef unsigned u32x4 __attribute__((ext_vector_type(4)));
typedef unsigned u32x2 __attribute__((ext_vector_type(2)));
typedef short v4i16_t __attribute__((ext_vector_type(4)));
typedef float f32x2 __attribute__((ext_vector_type(2)));

constexpr int D = 1024, L = 16384, C = 256, R = L + C;
constexpr int QKVD = 1280, HIN = 5120, NE = 32, TOPK = 4;
constexpr int PADM = 256, MAXROWS = 74752;
constexpr float EPS = 1e-6f;
constexpr float LOG2E = 1.4426950408889634f;
constexpr int NPHASE = 18;
#ifndef GEMM_REP
#define GEMM_REP 1
#endif
#ifndef PROBE_NOEPI
#define PROBE_NOEPI 0
#endif
#ifndef PROBE_SHORTK
#define PROBE_SHORTK 0
#endif
#ifndef SCAN_REP
#define SCAN_REP 1
#endif
#ifndef PROBE_PH
#define PROBE_PH (-1)
#endif
constexpr int LDS_BYTES = 147456;

constexpr size_t MiB = 1u << 20;
constexpr size_t al(size_t x) { return (x + MiB - 1) / MiB * MiB; }
constexpr size_t WS_CTL = 0;
constexpr size_t WS_MOD = WS_CTL + MiB;
constexpr size_t WS_X = WS_MOD + MiB;
constexpr size_t WS_H = WS_X + al((size_t)R * D * 4);
constexpr size_t WS_Q = WS_H + al((size_t)R * D * 2);
constexpr size_t WS_K = WS_Q + al((size_t)R * D * 2);
constexpr size_t WS_V = WS_K + al((size_t)R * 128 * 2);
constexpr size_t WS_O = WS_V + al((size_t)R * 128 * 2);
constexpr size_t WS_TK = WS_O + al((size_t)R * D * 2);
constexpr size_t WS_LIST = WS_TK + MiB;
constexpr size_t WS_HDN = WS_LIST + 3 * MiB;
constexpr size_t WS_RAW1 = WS_HDN + al((size_t)MAXROWS * 1024 * 2);
constexpr size_t WS_X1 = WS_RAW1 + al((size_t)R * D * 4);
constexpr size_t WS_OUTB = WS_X1 + al((size_t)R * D * 4);
constexpr size_t WS_QH = WS_OUTB + al((size_t)MAXROWS * 1024 * 2);
constexpr size_t WS_KF = WS_QH + al((size_t)L * D * 2);
constexpr size_t WS_KB = WS_KF + al((size_t)R * D * 2);
constexpr size_t WS_IV = WS_KB + al((size_t)R * D * 2);
constexpr size_t WS_SG = WS_IV + al((size_t)R * D * 2);
constexpr size_t WS_OF = WS_SG + al((size_t)L * D * 2);
constexpr size_t WS_OB = WS_OF + al((size_t)L * D * 4);
constexpr size_t WS_RR = WS_OB + al((size_t)L * D * 4);
constexpr size_t WS_WQKV = WS_RR + al((size_t)L * D * 2);
constexpr size_t WS_WO = WS_WQKV + al((size_t)QKVD * D * 2);
constexpr size_t WS_WIN = WS_WO + al((size_t)D * D * 2);
constexpr size_t WS_WHO = WS_WIN + al((size_t)HIN * D * 2);
constexpr size_t WS_WGU = WS_WHO + al((size_t)D * D * 2);
constexpr size_t WS_WDN = WS_WGU + al((size_t)2 * NE * 2048 * D * 2);
constexpr size_t WS_QSF = WS_WDN + al((size_t)2 * NE * 1024 * D * 2);
constexpr size_t WS_QSB = WS_QSF + al((size_t)L * D * 2);
constexpr size_t WS_DS = WS_QSB + al((size_t)L * D * 2);
constexpr size_t WS_DG = WS_DS + al((size_t)256 * 128 * 128 * 4);
constexpr size_t WS_SST = WS_DG + MiB;
constexpr size_t WS_H8 = WS_SST + al((size_t)256 * 128 * 128 * 2);
constexpr size_t WS_END = WS_H8 + al((size_t)R * D);
static_assert(WS_END <= (size_t)2048 * MiB, "workspace map exceeds 4x the largest input");
constexpr int CW_CNT = 1024;
constexpr int CW_CONV = 2048;
constexpr int CW_BAR = 4096;
constexpr int MOD_ROPE = 32768;
constexpr int MOD_LB = 49152;

struct Args { const float* in[21]; float* out; unsigned char* ws; int ph_lo, ph_hi; };

__device__ __forceinline__ unsigned f2bf(float f) { unsigned u = __float_as_uint(f); return (u + 0x7fffu + ((u >> 16) & 1u)) >> 16; }
typedef float f32x2_t __attribute__((ext_vector_type(2))); typedef __bf16 bf16x2_t __attribute__((ext_vector_type(2)));
__device__ __forceinline__ unsigned pk2(float lo, float hi) { f32x2_t v = {lo, hi}; bf16x2_t b = __builtin_convertvector(v, bf16x2_t); return __builtin_bit_cast(unsigned, b); }
__device__ __forceinline__ unsigned pk4_fp8(float a, float b, float c, float d) {
    a = fminf(fmaxf(a, -448.f), 448.f); b = fminf(fmaxf(b, -448.f), 448.f); c = fminf(fmaxf(c, -448.f), 448.f); d = fminf(fmaxf(d, -448.f), 448.f);
    int v = __builtin_amdgcn_cvt_pk_fp8_f32(a, b, 0, false); v = __builtin_amdgcn_cvt_pk_fp8_f32(c, d, v, true); return (unsigned)v; }
constexpr float F8_SH = 8.f, F8_SW = 64.f, F8_SHD = 4.f, F8_SO = 16.f;
__device__ __forceinline__ float bflo(unsigned u) { return __uint_as_float(u << 16); }
__device__ __forceinline__ float bfhi(unsigned u) { return __uint_as_float(u & 0xffff0000u); }
__device__ __forceinline__ float bf2f(bf16_t b) { return __uint_as_float(((unsigned)b) << 16); }
__device__ __forceinline__ float xadd16(float x) { const auto a = __builtin_amdgcn_permlane16_swap(__float_as_uint(x), __float_as_uint(x), false, false); return __uint_as_float(a[0]) + __uint_as_float(a[1]); }
__device__ __forceinline__ float xadd32(float x) { const auto a = __builtin_amdgcn_permlane32_swap(__float_as_uint(x), __float_as_uint(x), false, false); return __uint_as_float(a[0]) + __uint_as_float(a[1]); }
__device__ __forceinline__ float xmax16(float x) { const auto a = __builtin_amdgcn_permlane16_swap(__float_as_uint(x), __float_as_uint(x), false, false); return fmaxf(__uint_as_float(a[0]), __uint_as_float(a[1])); }
__device__ __forceinline__ float xmax32(float x) { const auto a = __builtin_amdgcn_permlane32_swap(__float_as_uint(x), __float_as_uint(x), false, false); return fmaxf(__uint_as_float(a[0]), __uint_as_float(a[1])); }
__device__ __forceinline__ float wave_sum(float v) {
#pragma unroll
    for (int o = 8; o > 0; o >>= 1) v += __shfl_xor(v, o);
    return xadd32(xadd16(v));
}
__device__ __forceinline__ float silu_f(float x) { return x / (1.f + __expf(-x)); }
__device__ __forceinline__ float sigmoid_f(float x) { return 1.f / (1.f + __expf(-x)); }

typedef const __attribute__((address_space(4))) Args* CArgs;
struct Ctx {
    CArgs a;
    LAS unsigned char* lds;
    int tid, lane, wave, nwg, wg;
    unsigned char* ws;
    __device__ __forceinline__ float* modp(int layer, int which) const { return (float*)(ws + WS_MOD) + (layer * 2 + which) * 6144; }
    __device__ __forceinline__ const float* xin0(int r) const { return r < C ? a->in[2] + (size_t)r * D : a->in[0] + (size_t)(r - C) * D; }
};


namespace pg8 {
constexpr int BM = 256, BK = 64, HALF = 128, HTB = HALF * BK * 2, STAGE_BYTES = 8 * HTB, KD = 1024, NXCD = 8, WGM = 8;
__device__ __forceinline__ int lds_byte(int r, int c) { const int st = (r >> 4) * 2 + (c >> 5), rr = r & 15, cc = c & 31, ob = rr * 64 + cc * 2; return st * 1024 + (ob ^ (((ob >> 9) & 1) << 5)); }
__device__ __forceinline__ void stage_rc(int b, int& Rr, int& Cc) { const int st = b / 1024, sb = b % 1024, swz = sb ^ (((sb >> 9) & 1) << 5); Rr = (st >> 1) * 16 + swz / 64; Cc = (st & 1) * 32 + (swz % 64) / 2; }
__device__ __forceinline__ int perm32(int rho) { const int n = rho >> 4, i = rho & 15; return 8 * (i >> 2) + 4 * n + (i & 3); }

struct Unit { int pm, pn, e, goff, gcnt; bool real; int amask, bmask; };
struct Gemm { const void* A; const void* Bt; size_t bstride; const int* list; };

struct StaticOrder {
    int nM, nN, nwg, G, c;
    __device__ __forceinline__ void init(int M, int N, int G_, int c_) { nM = M / BM; nN = N / BM; nwg = nM * nN; G = G_; c = c_; }
    __device__ __forceinline__ bool next(int i, Unit& u) const {
        const int F = nwg / G, Rm = nwg - F * G; int Lq; u.amask = 3; u.bmask = 3;
        if (i < F) Lq = i * G + c;
        else if (i == F && Rm > 0) {
            if (4 * Rm <= G) { if (c >= 4 * Rm) return false; Lq = F * G + (c >> 2); u.amask = 1 << ((c >> 1) & 1); u.bmask = 1 << (c & 1); }
            else if (2 * Rm <= G) { if (c >= 2 * Rm) return false; Lq = F * G + (c >> 1); u.bmask = 1 << (c & 1); }
            else { if (c >= Rm) return false; Lq = F * G + c; }
        } else return false;
        int wgid = Lq; { const int q = nwg / NXCD, r = nwg % NXCD, xcd = wgid % NXCD, off = wgid / NXCD; wgid = (xcd < r ? xcd * (q + 1) : r * (q + 1) + (xcd - r) * q) + off; }
        const int nig = WGM * nN, gid = wgid / nig, fm = gid * WGM, gsz = (nM - fm) < WGM ? (nM - fm) : WGM;
        u.pm = fm + ((wgid % nig) % gsz); u.pn = (wgid % nig) / gsz; u.e = 0; u.goff = 0; u.gcnt = 0; u.real = true; return true;
    }
};
struct MoeOrder {
    const LAS int* tp; const LAS int* cnt; int npn, G, vcu; bool split;
    __device__ __forceinline__ bool next(int i, Unit& u) const {
        const int tot = tp[32] * npn; int lin; u.amask = 3; u.bmask = 3; u.real = true;
        if (GEMM_REP > 1) { const int lin0 = i * G + vcu; if (lin0 >= tot * GEMM_REP) return false; lin = lin0 % tot; u.real = lin0 >= tot * (GEMM_REP - 1); }
        else {
            const int F = tot / G, Rm = tot - F * G;
            if (i < F) lin = i * G + vcu;
            else if (i == F && Rm > 0) {
                if (split && 2 * Rm <= G) { if (vcu >= 2 * Rm) return false; lin = F * G + (vcu >> 1); u.bmask = 1 << (vcu & 1); }
                else { if (vcu >= Rm) return false; lin = F * G + vcu; }
            } else return false;
        }
        const int rt = lin / npn; int e = 0;
#pragma unroll 8
        for (int k = 1; k < 32; ++k) e += (rt >= tp[k]) ? 1 : 0;
        const int mt = rt - tp[e];
        u.pm = rt; u.pn = lin - rt * npn; u.e = e; u.goff = e * R + mt * 256; u.gcnt = cnt[e] - mt * 256; return true;
    }
};

__device__ __forceinline__ void a_rows(const Gemm& g, const Unit& u, const int (&sR)[2], int (&rows)[2][2]) {
#pragma unroll
    for (int h = 0; h < 2; ++h)
#pragma unroll
        for (int i = 0; i < 2; ++i) { const int rr = h * HALF + sR[i]; rows[h][i] = rr < u.gcnt ? g.list[u.goff + rr] : 0; }
}
template <int KB>
__device__ __forceinline__ void a_offsets(const Gemm& g, const Unit& u, const int (&sR)[2], const int (&sC)[2], unsigned (&v)[2][2]) {
#pragma unroll
    for (int h = 0; h < 2; ++h)
#pragma unroll
        for (int i = 0; i < 2; ++i) {
            const int rr = h * HALF + sR[i]; int row;
            if (g.list) row = rr < u.gcnt ? g.list[u.goff + rr] : 0; else row = u.pm * BM + rr;
            v[h][i] = (unsigned)(row * KB + sC[i] * 2);
        }
}

struct EpiF32 {
    static constexpr bool LDSBIAS = false; static constexpr bool PERM = false;
    bf16_t* Cp; int ldc; const float* bias;
    __device__ __forceinline__ void operator()(const f32x4 (&acc)[2][2][4][2], const Unit& u, int wr, int wc, int fr, int fq, const LAS float* bl) const {
        const int row0 = u.pm * BM + wr * 64 + fr, col0 = u.pn * BM + wc * 32 + 4 * fq;
#pragma unroll
        for (int bj = 0; bj < 2; ++bj)
#pragma unroll
            for (int n = 0; n < 2; ++n) {
                const int col = col0 + bj * HALF + n * 16;
                if (!((u.bmask >> bj) & 1)) continue;
                const f32x4 bv = bias ? *(const f32x4*)(bias + col) : (f32x4){0.f, 0.f, 0.f, 0.f};
#pragma unroll
                for (int ai = 0; ai < 2; ++ai)
#pragma unroll
                    for (int m = 0; m < 4; ++m) if ((u.amask >> ai) & 1) { const f32x4 v = acc[ai][bj][m][n] + bv; u32x2 o; o.x = pk2(v[0], v[1]); o.y = pk2(v[2], v[3]);
                        *(u32x2*)(Cp + (size_t)(row0 + ai * HALF + m * 16) * ldc + col) = o; }
            }
    }
};
struct EpiSwiglu {
    static constexpr bool LDSBIAS = true; static constexpr bool PERM = true;
    unsigned char* Hd; const float* bgu;
    __device__ __forceinline__ const char* bias_base(const Unit& u) const { return (const char*)(bgu + (size_t)u.e * 2048 + u.pn * HALF); }
    __device__ __forceinline__ unsigned bias_voff(int lane) const { return (unsigned)(((lane >> 5) * 1024 + (lane & 31) * 4) * 4); }
    __device__ __forceinline__ void operator()(const f32x4 (&acc)[2][2][4][2], const Unit& u, int wr, int wc, int fr, int fq, const LAS float* bl) const {
        const int row0 = u.pm * BM + wr * 64 + fr, cg0 = u.pn * HALF + wc * 32 + 8 * fq;
        f32x4 bg[2], bu[2];
#pragma unroll
        for (int n = 0; n < 2; ++n) { bg[n] = *(const LAS f32x4*)(bl + wc * 32 + 8 * fq + 4 * n); bu[n] = *(const LAS f32x4*)(bl + 128 + wc * 32 + 8 * fq + 4 * n); }
#pragma unroll
        for (int ai = 0; ai < 2; ++ai)
#pragma unroll
            for (int m = 0; m < 4; ++m) {
                u32x2 o;
#pragma unroll
                for (int n = 0; n < 2; ++n) {
                    const f32x4 gv = acc[ai][0][m][n] * (1.f / (F8_SH * F8_SW)) + bg[n], uv = acc[ai][1][m][n] * (1.f / (F8_SH * F8_SW)) + bu[n]; float hv[4];
#pragma unroll
                    for (int q = 0; q < 4; ++q) { const float gg = fminf(gv[q], 7.f), uu = fminf(fmaxf(uv[q], -7.f), 7.f); hv[q] = gg * __builtin_amdgcn_rcpf(1.f + __builtin_amdgcn_exp2f(-1.702f * LOG2E * gg)) * (uu + 1.f); }
                    o[n] = pk4_fp8(hv[0] * F8_SHD, hv[1] * F8_SHD, hv[2] * F8_SHD, hv[3] * F8_SHD);
                }
                *(u32x2*)(Hd + (size_t)(row0 + ai * HALF + m * 16) * 1024 + cg0) = o;
            }
    }
};
struct EpiBf16Bias {
    static constexpr bool LDSBIAS = true; static constexpr bool PERM = true;
    unsigned char* Op; const float* bias; int bias_estride; float scale;
    __device__ __forceinline__ const char* bias_base(const Unit& u) const { return (const char*)(bias + (size_t)u.e * bias_estride + u.pn * BM); }
    __device__ __forceinline__ unsigned bias_voff(int lane) const { return (unsigned)(lane * 16); }
    __device__ __forceinline__ void operator()(const f32x4 (&acc)[2][2][4][2], const Unit& u, int wr, int wc, int fr, int fq, const LAS float* bl) const {
        const int row0 = u.pm * BM + wr * 64 + fr, col0 = u.pn * BM + wc * 32 + 8 * fq;
#pragma unroll
        for (int bj = 0; bj < 2; ++bj) {
            const int col = col0 + bj * HALF;
            if (!((u.bmask >> bj) & 1)) continue;
            const f32x4 b0 = *(const LAS f32x4*)(bl + bj * HALF + wc * 32 + 8 * fq) * F8_SO, b1 = *(const LAS f32x4*)(bl + bj * HALF + wc * 32 + 8 * fq + 4) * F8_SO;
#pragma unroll
            for (int ai = 0; ai < 2; ++ai)
#pragma unroll
                for (int m = 0; m < 4; ++m) { if (!((u.amask >> ai) & 1)) continue; const f32x4 v0 = acc[ai][bj][m][0] * (scale * F8_SO) + b0, v1 = acc[ai][bj][m][1] * (scale * F8_SO) + b1;
                    u32x2 o; o.x = pk4_fp8(v0[0], v0[1], v0[2], v0[3]); o.y = pk4_fp8(v1[0], v1[1], v1[2], v1[3]);
                    *(u32x2*)(Op + (size_t)(row0 + ai * HALF + m * 16) * 1024 + col) = o; }
        }
    }
};
struct EpiQKV {
    static constexpr bool LDSBIAS = false; static constexpr bool PERM = false;
    bf16_t* Qp; bf16_t* Kp; bf16_t* Vp; const float* bias; const float* tab;
    __device__ __forceinline__ void operator()(const f32x4 (&acc)[2][2][4][2], const Unit& u, int wr, int wc, int fr, int fq, const LAS float* bl) const {
        const bool lat = u.pm > 0; const float qs = 0.125f * LOG2E;
#pragma unroll
        for (int bj = 0; bj < 2; ++bj) {
            const int colt = u.pn * BM + bj * HALF + wc * 32 + 4 * fq;
            const f32x4 b1 = *(const f32x4*)(bias + colt), b2 = *(const f32x4*)(bias + colt + 16);
            const bool isv = (u.pn == 4) && (bj == 1);
            if (!((u.bmask >> bj) & 1)) continue;
#pragma unroll
            for (int ai = 0; ai < 2; ++ai)
#pragma unroll
                for (int m = 0; m < 4; ++m) {
                    if (!((u.amask >> ai) & 1)) continue;
                    const int r = u.pm * BM + ai * HALF + wr * 64 + m * 16 + fr, t = r - C;
                    f32x4 x1 = acc[ai][bj][m][0] + b1, x2 = acc[ai][bj][m][1] + b2;
                    if (lat && !isv) {
                        const int pos = (wc & 1) ? (t & 63) : (t >> 6);
                        const f32x4 t0 = *(const f32x4*)(tab + (pos * 16 + 4 * fq) * 2), t1 = *(const f32x4*)(tab + (pos * 16 + 4 * fq) * 2 + 4);
                        const float cs[4] = {t0[0], t0[2], t1[0], t1[2]}, sn[4] = {t0[1], t0[3], t1[1], t1[3]};
                        f32x4 o1, o2;
#pragma unroll
                        for (int e = 0; e < 4; ++e) { o1[e] = x1[e] * cs[e] - x2[e] * sn[e]; o2[e] = x2[e] * cs[e] + x1[e] * sn[e]; }
                        x1 = o1; x2 = o2;
                    }
                    u32x2 w1, w2;
                    if (u.pn < 4) {
                        w1.x = pk2(x1[0] * qs, x1[1] * qs); w1.y = pk2(x1[2] * qs, x1[3] * qs); w2.x = pk2(x2[0] * qs, x2[1] * qs); w2.y = pk2(x2[2] * qs, x2[3] * qs);
                        *(u32x2*)(Qp + (size_t)r * 1024 + colt) = w1; *(u32x2*)(Qp + (size_t)r * 1024 + colt + 16) = w2;
                    } else {
                        w1.x = pk2(x1[0], x1[1]); w1.y = pk2(x1[2], x1[3]); w2.x = pk2(x2[0], x2[1]); w2.y = pk2(x2[2], x2[3]);
                        bf16_t* dst = (bj == 0 ? Kp : Vp) + (size_t)r * 128 + wc * 32 + 4 * fq;
                        *(u32x2*)dst = w1; *(u32x2*)(dst + 16) = w2;
                    }
                }
        }
    }
};
struct EpiInProj {
    static constexpr bool LDSBIAS = false; static constexpr bool PERM = true;
    bf16_t* QH; _Float16* KF; _Float16* KB; bf16_t* IV; bf16_t* SG; const float* lb; float scale;
    __device__ __forceinline__ void operator()(const f32x4 (&acc)[2][2][4][2], const Unit& u, int wr, int wc, int fr, int fq, const LAS float* bl) const {
        const int seg = u.pn >> 2; const bool lat = u.pm > 0;
        if (!lat && (seg == 0 || seg == 4)) return;
        typedef _Float16 h8_t __attribute__((ext_vector_type(8)));
#pragma unroll
        for (int bj = 0; bj < 2; ++bj) {
            const int col = (u.pn & 3) * BM + bj * HALF + wc * 32 + 8 * fq;
            if (!((u.bmask >> bj) & 1)) continue;
            f32x4 lb0 = (f32x4){0.f, 0.f, 0.f, 0.f}, lb1 = lb0;
            if (seg == 1) { lb0 = *(const f32x4*)(lb + col); lb1 = *(const f32x4*)(lb + col + 4); } else if (seg == 2) { lb0 = *(const f32x4*)(lb + 1024 + col); lb1 = *(const f32x4*)(lb + 1024 + col + 4); }
#pragma unroll
            for (int ai = 0; ai < 2; ++ai)
#pragma unroll
                for (int m = 0; m < 4; ++m) {
                    if (!((u.amask >> ai) & 1)) continue;
                    const int r = u.pm * BM + ai * HALF + wr * 64 + m * 16 + fr; const f32x4 v0 = acc[ai][bj][m][0] * scale, v1 = acc[ai][bj][m][1] * scale;
                    if (seg == 1 || seg == 2) {
                        h8_t hv;
#pragma unroll
                        for (int e = 0; e < 4; ++e) { hv[e] = (_Float16)((1.f - lb0[e]) * __builtin_amdgcn_rcpf(1.f + __builtin_amdgcn_exp2f(LOG2E * v0[e]))); hv[4 + e] = (_Float16)((1.f - lb1[e]) * __builtin_amdgcn_rcpf(1.f + __builtin_amdgcn_exp2f(LOG2E * v1[e]))); }
                        *(h8_t*)((seg == 1 ? KF : KB) + (size_t)r * 1024 + col) = hv;
                    } else if (seg == 3) {
                        u32x4 o; o.x = pk2(v0[0], v0[1]); o.y = pk2(v0[2], v0[3]); o.z = pk2(v1[0], v1[1]); o.w = pk2(v1[2], v1[3]); *(u32x4*)(IV + (size_t)r * 1024 + col) = o;
                    } else {
                        float s0[4], s1[4];
#pragma unroll
                        for (int e = 0; e < 4; ++e) { s0[e] = v0[e] * __builtin_amdgcn_rcpf(1.f + __builtin_amdgcn_exp2f(-LOG2E * v0[e])); s1[e] = v1[e] * __builtin_amdgcn_rcpf(1.f + __builtin_amdgcn_exp2f(-LOG2E * v1[e])); }
                        u32x4 o; o.x = pk2(s0[0], s0[1]); o.y = pk2(s0[2], s0[3]); o.z = pk2(s1[0], s1[1]); o.w = pk2(s1[2], s1[3]); *(u32x4*)((seg == 0 ? QH : SG) + (size_t)(r - C) * 1024 + col) = o;
                    }
                }
        }
    }
};

typedef int v8i __attribute__((ext_vector_type(8)));
typedef int v4i __attribute__((ext_vector_type(4)));
template <class Epi, class Sched, bool ALIGN_EPI, bool GATHER, bool FP8>
__device__ __forceinline__ void gemm_phase(LAS unsigned char* lds, const Gemm g, const Sched& S, const Epi& E, const int tid) {
    const int wid = __builtin_amdgcn_readfirstlane(tid >> 6), lane = tid & 63, wr = wid >> 2, wc = wid & 3, fr = lane & 15, fq = lane >> 4;
    constexpr int KB = FP8 ? 1024 : 2048, nt = 1024 / (FP8 ? 128 : 64);
    int sR[2], sC[2]; unsigned voffB[2], voffA[2];
#pragma unroll
    for (int i = 0; i < 2; ++i) { stage_rc(tid * 16 + i * 8192, sR[i], sC[i]); const int Rb = Epi::PERM ? ((sR[i] & ~31) + perm32(sR[i] & 31)) : sR[i]; voffB[i] = (unsigned)(Rb * KB + sC[i] * 2); voffA[i] = (unsigned)(sR[i] * KB + sC[i] * 2); }
    constexpr size_t kstep = (size_t)(BK * 2), hstep = (size_t)HALF * KB, tstep = 2 * hstep;
    const unsigned ldsw = (unsigned)wid * 1024u;
    const int aoff = lds_byte(wr * 64 + fr, fq * 8), boff = lds_byte(wc * 32 + fr, fq * 8);
    const char* Ab = (const char*)g.A;
#define PG8_SA(b, h) (((b) * 2 + (h)) * HTB)
#define PG8_SB(b, h) ((4 + (b) * 2 + (h)) * HTB)
#define PG8_STAGE_B(bufoff, gbase) do { _Pragma("unroll") for (int _i = 0; _i < 2; ++_i) \
        __builtin_amdgcn_global_load_lds((const unsigned*)((const char*)(gbase) + voffB[_i]), (LAS unsigned*)(lds + (bufoff) + ldsw + _i * 8192), 16, 0, 0); } while (0)
#define PG8_STAGE_A(bufoff, kb, v, ubase) do { _Pragma("unroll") for (int _i = 0; _i < 2; ++_i) \
        __builtin_amdgcn_global_load_lds((const unsigned*)((GATHER ? Ab : (ubase)) + (size_t)(kb) + (GATHER ? (v)[_i] : voffA[_i])), (LAS unsigned*)(lds + (bufoff) + ldsw + _i * 8192), 16, 0, 0); } while (0)
#define PG8_LD8(p) __builtin_shufflevector(*(const LAS v4i*)(p), *(const LAS v4i*)((p) + 1024), 0, 1, 2, 3, 4, 5, 6, 7)
#define PG8_LDA(dst, b, h) do { if constexpr (FP8) { _Pragma("unroll") for (int m = 0; m < 4; ++m) dst##8[m] = PG8_LD8(lds + PG8_SA(b, h) + aoff + m * 2048); } else { _Pragma("unroll") for (int m = 0; m < 4; ++m) _Pragma("unroll") for (int k = 0; k < 2; ++k) dst[m][k] = *(const LAS bf16x8*)(lds + PG8_SA(b, h) + aoff + m * 2048 + k * 1024); } } while (0)
#define PG8_LDB(dst, b, h) do { if constexpr (FP8) { _Pragma("unroll") for (int n = 0; n < 2; ++n) dst##8[n] = PG8_LD8(lds + PG8_SB(b, h) + boff + n * 2048); } else { _Pragma("unroll") for (int n = 0; n < 2; ++n) _Pragma("unroll") for (int k = 0; k < 2; ++k) dst[n][k] = *(const LAS bf16x8*)(lds + PG8_SB(b, h) + boff + n * 2048 + k * 1024); } } while (0)
#define PG8_MMA(ai, bj, At, Bt) do { __builtin_amdgcn_s_setprio(1); if constexpr (FP8) { _Pragma("unroll") for (int m = 0; m < 4; ++m) _Pragma("unroll") for (int n = 0; n < 2; ++n) \
        asm volatile("v_mfma_scale_f32_16x16x128_f8f6f4 %0, %1, %2, %0, %3, %3 op_sel_hi:[0,0,0]" : "+v"(acc[ai][bj][m][n]) : "v"(Bt##8[n]), "v"(At##8[m]), "v"(unit_scale)); } else { \
        _Pragma("unroll") for (int m = 0; m < 4; ++m) _Pragma("unroll") for (int n = 0; n < 2; ++n) _Pragma("unroll") for (int k = 0; k < 2; ++k) \
        acc[ai][bj][m][n] = __builtin_amdgcn_mfma_f32_16x16x32_bf16(Bt[n][k], At[m][k], acc[ai][bj][m][n], 0, 0, 0); } __builtin_amdgcn_s_setprio(0); } while (0)
#define PG8_WAIT_V(n) asm volatile("s_waitcnt vmcnt(" #n ")" ::: "memory")
#define PG8_WAIT_L(n) asm volatile("s_waitcnt lgkmcnt(" #n ")" ::: "memory")
#define PG8_BAR __builtin_amdgcn_s_barrier()
#define PG8_SCHED __builtin_amdgcn_sched_barrier(0)
    Unit cur, nxt; int ui = 0;
    if (!S.next(0, cur)) return;
    unsigned cv[2][2]; int nvr[2][2];
    if constexpr (GATHER) a_offsets<KB>(g, cur, sR, sC, cv);
    const char* cA = Ab + (size_t)cur.pm * tstep; const char* nA = cA;
    f32x4 acc[2][2][4][2];
#pragma unroll
    for (int a = 0; a < 2; ++a)
#pragma unroll
        for (int b = 0; b < 2; ++b)
#pragma unroll
            for (int m = 0; m < 4; ++m)
#pragma unroll
                for (int n = 0; n < 2; ++n) acc[a][b][m][n] = (f32x4){0.f, 0.f, 0.f, 0.f};
    bf16x8 At[4][2], B0[2][2], B1[2][2]; v8i At8[4], B08[2], B18[2];
    int unit_scale = 0x7f7f7f7f; asm volatile("" : "+v"(unit_scale));
    const char* cB = (const char*)g.Bt + (size_t)cur.e * g.bstride + (size_t)cur.pn * tstep;
#define PG8_BIAS(uu, slot) do { if constexpr (Epi::LDSBIAS) { if (wid == 0) { int l_ = lane; asm volatile("" : "+v"(l_)); \
        __builtin_amdgcn_global_load_lds((const unsigned*)(E.bias_base(uu) + E.bias_voff(l_)), (LAS unsigned*)(lds + STAGE_BYTES + 4096 + (slot) * 1024), 16, 0, 0); } } } while (0)
    PG8_BIAS(cur, 0);
    PG8_STAGE_B(PG8_SB(0, 0), cB); PG8_STAGE_B(PG8_SB(0, 1), cB + hstep); PG8_STAGE_A(PG8_SA(0, 0), 0, cv[0], cA); PG8_STAGE_A(PG8_SA(0, 1), 0, cv[1], cA + hstep);
    if (wr == 1) PG8_BAR;
    PG8_WAIT_V(2); PG8_BAR;
    PG8_STAGE_B(PG8_SB(1, 0), cB + kstep); PG8_STAGE_A(PG8_SA(1, 0), kstep, cv[0], cA); PG8_STAGE_B(PG8_SB(1, 1), cB + hstep + kstep);
    PG8_WAIT_V(6); PG8_BAR;
    for (;;) {
        const bool has_next = S.next(ui + 1, nxt);
        const char* nB = cB;
        nA = cA;
        if (has_next) { PG8_BIAS(nxt, (ui + 1) % 3); if constexpr (GATHER) a_rows(g, nxt, sR, nvr); nA = Ab + (size_t)nxt.pm * tstep; nB = (const char*)g.Bt + (size_t)nxt.e * g.bstride + (size_t)nxt.pn * tstep; }

        const int ntr = (PROBE_SHORTK && !cur.real) ? 2 : nt;
        const bool m00 = (cur.amask & 1) && (cur.bmask & 1), m01 = (cur.amask & 1) && (cur.bmask & 2), m10 = (cur.amask & 2) && (cur.bmask & 1), m11 = (cur.amask & 2) && (cur.bmask & 2);
#pragma nounroll
        for (int t = 0; t < ntr; t += 2) {
            const bool last = (t == ntr - 2);
            if constexpr (GATHER) { if (last && has_next) asm volatile("" : "+v"(nvr[0][0]), "+v"(nvr[0][1]), "+v"(nvr[1][0]), "+v"(nvr[1][1])); }
            const size_t k1 = (size_t)(t + 1) * kstep, k2 = last ? 0 : (size_t)(t + 2) * kstep, k3 = k2 + kstep;
            const char* b2 = last ? nB : cB + (size_t)(t + 2) * kstep; const char* b3 = b2 + kstep;
            unsigned w0[2], w1[2];
            if constexpr (GATHER) {
#pragma unroll
                for (int i = 0; i < 2; ++i) { w0[i] = (last && has_next) ? (unsigned)(nvr[0][i] * KB + sC[i] * 2) : cv[0][i]; w1[i] = (last && has_next) ? (unsigned)(nvr[1][i] * KB + sC[i] * 2) : cv[1][i]; }
            }
            const char* a2 = last ? nA : cA;
            PG8_LDB(B0, 0, 0); PG8_LDB(B1, 0, 1); PG8_SCHED; PG8_LDA(At, 0, 0); PG8_STAGE_A(PG8_SA(1, 1), k1, cv[1], cA + hstep);
            PG8_WAIT_V(8); PG8_WAIT_L(0); PG8_BAR; if (m00) PG8_MMA(0, 0, At, B0); if (m01) PG8_MMA(0, 1, At, B1); PG8_BAR; PG8_SCHED;
            PG8_LDA(At, 0, 1); PG8_STAGE_B(PG8_SB(0, 0), b2); PG8_STAGE_B(PG8_SB(0, 1), b2 + hstep); PG8_STAGE_A(PG8_SA(0, 0), k2, w0, a2);
            PG8_WAIT_V(8); PG8_WAIT_L(0); PG8_BAR; if (m10) PG8_MMA(1, 0, At, B0); if (m11) PG8_MMA(1, 1, At, B1); PG8_BAR; PG8_SCHED;
            PG8_LDB(B0, 1, 0); PG8_LDB(B1, 1, 1); PG8_SCHED; PG8_LDA(At, 1, 0); PG8_STAGE_A(PG8_SA(0, 1), k2, w1, a2 + hstep);
            PG8_WAIT_V(8); PG8_WAIT_L(0); PG8_BAR; if (m00) PG8_MMA(0, 0, At, B0); if (m01) PG8_MMA(0, 1, At, B1); PG8_BAR; PG8_SCHED;
            PG8_LDA(At, 1, 1); PG8_STAGE_B(PG8_SB(1, 0), b3); PG8_STAGE_B(PG8_SB(1, 1), b3 + hstep); PG8_STAGE_A(PG8_SA(1, 0), k3, w0, a2);
            PG8_WAIT_V(8); PG8_WAIT_L(0); PG8_BAR; if (m10) PG8_MMA(1, 0, At, B0); if (m11) PG8_MMA(1, 1, At, B1); PG8_BAR; PG8_SCHED;
        }
        if constexpr (ALIGN_EPI) { if (wr == 0) PG8_BAR; }
        if constexpr (FP8) asm volatile("s_nop 15\n\ts_nop 15" ::: "memory");
        if (!PROBE_NOEPI || cur.real) E(acc, cur, wr, wc, fr, fq, (const LAS float*)(lds + STAGE_BYTES + 4096 + (ui % 3) * 1024));
        if (!has_next) break;
#pragma unroll
        for (int a = 0; a < 2; ++a)
#pragma unroll
            for (int b = 0; b < 2; ++b)
#pragma unroll
                for (int m = 0; m < 4; ++m)
#pragma unroll
                    for (int n = 0; n < 2; ++n) acc[a][b][m][n] = (f32x4){0.f, 0.f, 0.f, 0.f};
        cur = nxt; cB = nB; cA = nA; ++ui;
        if constexpr (GATHER) {
#pragma unroll
            for (int h = 0; h < 2; ++h)
#pragma unroll
                for (int i = 0; i < 2; ++i) cv[h][i] = (unsigned)(nvr[h][i] * KB + sC[i] * 2);
        }
        if constexpr (ALIGN_EPI) { if (wr == 1) PG8_BAR; }
    }
    PG8_WAIT_V(0);
    if constexpr (!ALIGN_EPI) { if (wr == 0) PG8_BAR; }
    PG8_BAR;
#undef PG8_SA
#undef PG8_SB
#undef PG8_STAGE_A
#undef PG8_STAGE_B
#undef PG8_LDA
#undef PG8_BIAS
#undef PG8_LD8
#undef PG8_LDB
#undef PG8_MMA
#undef PG8_WAIT_V
#undef PG8_WAIT_L
#undef PG8_BAR
#undef PG8_SCHED
}
}

struct TBlk { const float* src; int ldw; bf16_t* dst; unsigned char* dst8; };
__device__ __forceinline__ void tb_load(const TBlk& t, int lane, f32x4 (&v)[16]) {
    const float* p = t.src + (size_t)(lane >> 4) * t.ldw + (lane & 15) * 4;
#pragma unroll
    for (int i = 0; i < 16; ++i) v[i] = *(const f32x4*)(p + (size_t)(4 * i) * t.ldw);
}
__device__ __forceinline__ void tb_store(const TBlk& t, int lane, const f32x4 (&v)[16], LAS float* scr) {
#pragma unroll
    for (int i = 0; i < 16; ++i) { LAS float* d = scr + ((lane >> 4) + 4 * i) * 65 + (lane & 15) * 4; d[0] = v[i].x; d[1] = v[i].y; d[2] = v[i].z; d[3] = v[i].w; }
    asm volatile("s_waitcnt lgkmcnt(0)" ::: "memory"); __builtin_amdgcn_wave_barrier();
    const int c8 = lane & 7;
#pragma unroll
    for (int jj = 0; jj < 8; ++jj) {
        const int n = (lane >> 3) + 8 * jj; const LAS float* p = scr + (8 * c8) * 65 + n;
        if (t.dst8) { u32x2 o; o.x = pk4_fp8(p[0] * F8_SW, p[65] * F8_SW, p[2 * 65] * F8_SW, p[3 * 65] * F8_SW); o.y = pk4_fp8(p[4 * 65] * F8_SW, p[5 * 65] * F8_SW, p[6 * 65] * F8_SW, p[7 * 65] * F8_SW);
            *(u32x2*)(t.dst8 + (size_t)n * 1024 + 8 * c8) = o; }
        else { u32x4 o; o.x = pk2(p[0], p[65]); o.y = pk2(p[2 * 65], p[3 * 65]); o.z = pk2(p[4 * 65], p[5 * 65]); o.w = pk2(p[6 * 65], p[7 * 65]);
            *(u32x4*)(t.dst + (size_t)n * 1024 + 8 * c8) = o; }
    }
    asm volatile("s_waitcnt lgkmcnt(0)" ::: "memory"); __builtin_amdgcn_wave_barrier();
}

__device__ __forceinline__ void phase_prep(const Ctx& c) {
    LAS float* red = (LAS float*)c.lds;
    LAS float* sil = red + 1024;
    const float* cv = c.a->in[1]; const float* ccv = c.a->in[3]; const float* ada_w = c.a->in[4]; const float* ada_b = c.a->in[5];
    for (int i = c.tid; i < 2048; i += 512) { const float x = i < 1024 ? cv[i] : ccv[i - 1024]; sil[i] = x * __builtin_amdgcn_rcpf(1.f + __builtin_amdgcn_exp2f(-LOG2E * x)); }
    __syncthreads();
    for (int item = c.wg; item < 193; item += c.nwg) {
        if (item < 192) {
            const int layer = item / 96, cb = item % 96, col = cb * 64 + c.lane;
            const float* W = ada_w + (size_t)layer * D * 6144 + col;
            float a0 = 0.f, a1 = 0.f;
            const int k0 = c.wave * 128;
#pragma unroll 32
            for (int k = 0; k < 128; ++k) { const float w = W[(size_t)(k0 + k) * 6144]; a0 += sil[k0 + k] * w; a1 += sil[1024 + k0 + k] * w; }
            red[(0 * 8 + c.wave) * 64 + c.lane] = a0; red[(1 * 8 + c.wave) * 64 + c.lane] = a1;
            __syncthreads();
            if (c.tid < 128) {
                const int which = c.tid >> 6, l = c.tid & 63; float s = 0.f;
#pragma unroll
                for (int w = 0; w < 8; ++w) s += red[(which * 8 + w) * 64 + l];
                c.modp(layer, which)[cb * 64 + l] = s + ada_b[layer * 6144 + cb * 64 + l];
            }
            __syncthreads();
        } else {
            float* modbase = (float*)(c.ws + WS_MOD);
            for (int i = c.tid; i < 4096; i += 512) {
                const int pos = i >> 4, j = i & 15;
                const double ang = (double)pos * pow(10000.0, -(double)j / 16.0);
                modbase[MOD_ROPE + 2 * i] = (float)cos(ang); modbase[MOD_ROPE + 2 * i + 1] = (float)sin(ang);
            }
            const float* lbp = c.a->in[12];
            for (int i = c.tid; i < 2048; i += 512) { const float p0 = lbp[i], p1 = lbp[2048 + i]; modbase[MOD_LB + i] = 1.f / (1.f + __expf(p0 - p1)); }
        }
    }
}

__device__ __forceinline__ void row_load(const float* p, int lane, f32x4 (&v)[4]) {
#pragma unroll
    for (int j = 0; j < 4; ++j) v[j] = *(const f32x4*)(p + lane * 4 + 256 * j);
}
__device__ __forceinline__ void row_load_bf(const bf16_t* p, int lane, f32x4 (&v)[4]) {
#pragma unroll
    for (int j = 0; j < 4; ++j) { const u32x2 w = *(const u32x2*)(p + lane * 4 + 256 * j); v[j] = (f32x4){bflo(w.x), bfhi(w.x), bflo(w.y), bfhi(w.y)}; }
}
__device__ __forceinline__ float row_ss(const f32x4 (&v)[4]) {
    float s = 0.f;
#pragma unroll
    for (int j = 0; j < 4; ++j) s += v[j].x * v[j].x + v[j].y * v[j].y + v[j].z * v[j].z + v[j].w * v[j].w;
    return wave_sum(s);
}
__device__ __forceinline__ void row_modnorm_store(const f32x4 (&x)[4], float rstd, const float* g, const float* sh, const float* sc, bf16_t* out, int lane, f32x4 (*hout)[4] = nullptr) {
#pragma unroll
    for (int j = 0; j < 4; ++j) {
        const int c0 = lane * 4 + 256 * j;
        const f32x4 gv = *(const f32x4*)(g + c0), shv = *(const f32x4*)(sh + c0), scv = *(const f32x4*)(sc + c0);
        f32x4 h;
        h.x = x[j].x * rstd * gv.x * (1.f + scv.x) + shv.x; h.y = x[j].y * rstd * gv.y * (1.f + scv.y) + shv.y;
        h.z = x[j].z * rstd * gv.z * (1.f + scv.z) + shv.z; h.w = x[j].w * rstd * gv.w * (1.f + scv.w) + shv.w;
        if (hout) (*hout)[j] = h;
        u32x2 o; o.x = pk2(h.x, h.y); o.y = pk2(h.z, h.w);
        *(u32x2*)(out + c0) = o;
    }
}

__device__ __forceinline__ void phase_norm0(const Ctx& c) {
    bf16_t* H = (bf16_t*)(c.ws + WS_H); const float* ng = c.a->in[6];
    int r = c.wg * 8 + c.wave;
    f32x4 xn[4];
    if (r < R) row_load(c.xin0(r), c.lane, xn);
    for (; r < R; r += c.nwg * 8) {
        f32x4 x[4];
#pragma unroll
        for (int j = 0; j < 4; ++j) x[j] = xn[j];
        if (r + c.nwg * 8 < R) row_load(c.xin0(r + c.nwg * 8), c.lane, xn);
        const float rstd = rsqrtf(row_ss(x) * (1.f / D) + EPS);
        const float* m = c.modp(0, r < C ? 1 : 0);
        row_modnorm_store(x, rstd, ng, m + 0, m + 1024, H + (size_t)r * D, c.lane);
    }
}

namespace at {
__device__ __forceinline__ float max3f(float a, float b, float c) { return __builtin_fmaxf(__builtin_fmaxf(a, b), c); }
constexpr int KP = 144, TILEB = 64 * KP;
__device__ __forceinline__ bf16x8 tr_frag2(const LAS unsigned char* tile, int row0, int col0, int lane) {
    const int q = (lane & 15) >> 2, p = lane & 3;
    const LAS unsigned char* a = tile + (row0 + q) * KP + (col0 + 4 * p) * 2;
    const v4i16_t lo = __builtin_amdgcn_ds_read_tr16_b64_v4i16((LAS v4i16_t*)a);
    const v4i16_t hi = __builtin_amdgcn_ds_read_tr16_b64_v4i16((LAS v4i16_t*)(a + 16 * KP));
    return (bf16x8){lo[0], lo[1], lo[2], lo[3], hi[0], hi[1], hi[2], hi[3]};
}
}
__device__ __forceinline__ void phase_attn(const Ctx& c) {
    using namespace at;
    const bf16_t* Q = (const bf16_t*)(c.ws + WS_Q); const bf16_t* K = (const bf16_t*)(c.ws + WS_K); const bf16_t* V = (const bf16_t*)(c.ws + WS_V);
    bf16_t* O = (bf16_t*)(c.ws + WS_O); const float* sink = c.a->in[9];
    LAS unsigned char* lds = c.lds;
    const int tid = c.tid, lane = c.lane, w = __builtin_amdgcn_readfirstlane(tid >> 6), fr = lane & 15, g = lane >> 4;
    const int lrow = tid >> 3, lch = tid & 7;
    const int nitn = c.nwg == 256 ? 2 : (264 - c.wg + c.nwg - 1) / c.nwg;
    for (int itn = 0; itn < nitn; ++itn) {
        int item = c.wg + itn * c.nwg;
        if (c.nwg == 256 && itn == 1) { const int n_ = c.wg >> 1; item = -1;
            if (n_ == 0) item = 256 + (c.wg & 1); else if (n_ == 127) item = 258 + (c.wg & 1); else if (n_ == 30 || n_ == 31) item = 260 + (c.wg - 60); }
        if (item < 0 || item >= 264) continue;
        const bool isctx = item >= 256;
        const int ci = item - 256;
        const int n = isctx ? 0 : (item >> 1), kh = isctx ? ((ci >> 1) & 1) : (item & 1), cb = isctx ? (ci >> 2) : 0;
        const int p_lo = isctx ? (ci & 1) : 0, p_hi = isctx ? (ci & 1) + 1 : 2;
        const int hq = kh * 8 + w;
        const float sink2 = sink[hq] * LOG2E;
        for (int pass = p_lo; pass < p_hi; ++pass) {
            const int t0 = 128 * n + 64 * pass, qrow0 = isctx ? cb * 128 + 64 * pass : C + t0;
            const int jlo = isctx ? 0 : (t0 >= 128 ? 0 : (128 - t0) / 64), jhi = isctx ? 0 : ((L - t0 + 128) / 64 < 5 ? (L - t0 + 128) / 64 : 5);
            const int ntile = 4 + (jhi - jlo);
            LAS unsigned char* qlds = lds + 4 * TILEB + w * TILEB;
#pragma unroll
            for (int qb = 0; qb < 4; ++qb)
#pragma unroll
                for (int ks = 0; ks < 2; ++ks) *(LAS bf16x8*)(qlds + (16 * qb + fr) * KP + (32 * ks + 8 * g) * 2) = *(const bf16x8*)(Q + (size_t)(qrow0 + 16 * qb + fr) * D + hq * 64 + 32 * ks + 8 * g);
            float mrow[4], lsum[4]; f32x4 OT[4][4];
#pragma unroll
            for (int qb = 0; qb < 4; ++qb) { mrow[qb] = sink2; lsum[qb] = 1.f;
#pragma unroll
                for (int nt = 0; nt < 4; ++nt) OT[qb][nt] = (f32x4){0.f, 0.f, 0.f, 0.f}; }
            u32x4 kreg, vreg;
#define AT_KROW(ti) ((ti) < 4 ? 64 * (ti) : C + t0 - 128 + 64 * (jlo + (ti) - 4))
#define AT_LOAD(ti) do { const size_t ro_ = (size_t)(AT_KROW(ti) + lrow) * 128 + kh * 64 + lch * 8; kreg = *(const u32x4*)(K + ro_); vreg = *(const u32x4*)(V + ro_); } while (0)
#define AT_WRITE(buf) do { *(LAS u32x4*)(lds + (buf) * 2 * TILEB + lrow * KP + lch * 16) = kreg; *(LAS u32x4*)(lds + (buf) * 2 * TILEB + TILEB + lrow * KP + lch * 16) = vreg; } while (0)
            AT_LOAD(0); AT_WRITE(0);
            __syncthreads();
            for (int ti = 0; ti < ntile; ++ti) {
                if (ti + 1 < ntile) AT_LOAD(ti + 1);
                const LAS unsigned char* kb = lds + (ti & 1) * 2 * TILEB; const LAS unsigned char* vb = kb + TILEB;
                const int jj = jlo + ti - 4; const bool masked = (ti >= 4) && (jj == 0 || jj == 4);
                const int k0 = t0 - 128 + 64 * jj;
                bf16x8 Kf[4][2];
#pragma unroll
                for (int mt = 0; mt < 4; ++mt)
#pragma unroll
                    for (int ks = 0; ks < 2; ++ks) Kf[mt][ks] = *(const LAS bf16x8*)(kb + (16 * mt + fr) * KP + (32 * ks + 8 * g) * 2);
                bf16x8 Vf[4][2];
#pragma unroll
                for (int mt = 0; mt < 4; ++mt)
#pragma unroll
                    for (int ks = 0; ks < 2; ++ks)
                        Vf[mt][ks] = tr_frag2(vb, 32 * ks + 4 * g, 16 * mt, lane);
#pragma unroll
                for (int qb = 0; qb < 4; ++qb) {
                    bf16x8 Qq[2];
#pragma unroll
                    for (int ks = 0; ks < 2; ++ks) Qq[ks] = *(const LAS bf16x8*)(qlds + (16 * qb + fr) * KP + (32 * ks + 8 * g) * 2);
                    f32x4 sa[4];
#pragma unroll
                    for (int mt = 0; mt < 4; ++mt) { sa[mt] = (f32x4){0.f, 0.f, 0.f, 0.f};
#pragma unroll
                        for (int ks = 0; ks < 2; ++ks) sa[mt] = __builtin_amdgcn_mfma_f32_16x16x32_bf16(Kf[mt][ks], Qq[ks], sa[mt], 0, 0, 0); }
                    if (masked) {
                        const int tq = t0 + 16 * qb + fr;
#pragma unroll
                        for (int mt = 0; mt < 4; ++mt)
#pragma unroll
                            for (int e = 0; e < 4; ++e) { const int dt = tq - (k0 + 16 * mt + 4 * g + e); if (dt > 128 || dt < -128) sa[mt][e] = -INFINITY; }
                    }
                    float mx = max3f(sa[0][0], sa[0][1], sa[0][2]), my = max3f(sa[0][3], sa[1][0], sa[1][1]);
                    mx = max3f(mx, sa[1][2], sa[1][3]); my = max3f(my, sa[2][0], sa[2][1]); mx = max3f(mx, sa[2][2], sa[2][3]); my = max3f(my, sa[3][0], sa[3][1]); mx = max3f(mx, sa[3][2], sa[3][3]);
                    mx = max3f(mx, my, mrow[qb]);
                    mx = xmax32(xmax16(mx));
                    const float mn = mx; const bool grew = __any(mn > mrow[qb]);
                    const float alpha = grew ? __builtin_amdgcn_exp2f(mrow[qb] - mn) : 1.f;
                    mrow[qb] = mn;
                    float rs = 0.f;
#pragma unroll
                    for (int mt = 0; mt < 4; ++mt)
#pragma unroll
                        for (int e = 0; e < 4; ++e) { const float pv = __builtin_amdgcn_exp2f(sa[mt][e] - mn); sa[mt][e] = pv; rs += pv; }
                    rs = xadd32(xadd16(rs));
                    lsum[qb] = grew ? lsum[qb] * alpha + rs : lsum[qb] + rs;
                    bf16x8 Pb[2];
#pragma unroll
                    for (int ks = 0; ks < 2; ++ks) { const f32x4 a0 = sa[2 * ks], a1 = sa[2 * ks + 1];
                        const u32x4 pk = (u32x4){pk2(a0[0], a0[1]), pk2(a0[2], a0[3]), pk2(a1[0], a1[1]), pk2(a1[2], a1[3])}; Pb[ks] = __builtin_bit_cast(bf16x8, pk); }
#pragma unroll
                    for (int nt = 0; nt < 4; ++nt) { if (grew) OT[qb][nt] = OT[qb][nt] * alpha;
#pragma unroll
                        for (int ks = 0; ks < 2; ++ks) OT[qb][nt] = __builtin_amdgcn_mfma_f32_16x16x32_bf16(Vf[nt][ks], Pb[ks], OT[qb][nt], 0, 0, 0); }
                }
                if (ti + 1 < ntile) AT_WRITE((ti + 1) & 1);
                __syncthreads();
            }
#undef AT_KROW
#undef AT_LOAD
#undef AT_WRITE
#pragma unroll
            for (int qb = 0; qb < 4; ++qb) {
                const float il = 1.f / lsum[qb];
                bf16_t* op = O + (size_t)(qrow0 + 16 * qb + fr) * D + hq * 64 + 4 * g;
#pragma unroll
                for (int nt = 0; nt < 4; ++nt) { const f32x4 v = OT[qb][nt] * il; u32x2 o; o.x = pk2(v[0], v[1]); o.y = pk2(v[2], v[3]); *(u32x2*)(op + 16 * nt) = o; }
            }
        }
    }
}

template <int GS>
__device__ __forceinline__ void phase_postmix(const Ctx& c, int layer, bool route) {
    const bf16_t* Y = (const bf16_t*)(c.ws + WS_RAW1); unsigned char* H8 = c.ws + WS_H8;
    bf16_t* Xout = (bf16_t*)(c.ws + (layer == 0 ? WS_X : WS_X1)); const bf16_t* Xprev = (const bf16_t*)(c.ws + WS_X);
    const float* ng = c.a->in[6] + layer * 4 * D; const float* Wr = c.a->in[15] + (size_t)layer * D * NE; const float* br = c.a->in[16] + layer * NE;
    unsigned* cnt = (unsigned*)(c.ws + WS_CTL) + CW_CNT + layer * NE;
    int* tk_e = (int*)(c.ws + WS_TK); float* tk_g = (float*)(c.ws + WS_TK) + R * 4; int* tk_slot = (int*)(c.ws + WS_TK) + 2 * R * 4;
    int* list = (int*)(c.ws + WS_LIST);
    LAS float* WL = (LAS float*)c.lds;
    LAS float* biasp = (LAS float*)(c.lds + 131072);
    LAS unsigned* lcnt = (LAS unsigned*)(c.lds + 145920); LAS unsigned* lbase = lcnt + 32; LAS float* rsx = (LAS float*)(lcnt + 64);
    LAS float* pvA = (LAS float*)(c.lds + 131072 + 2560); LAS float* pvB = pvA + 1024; LAS float* pvS = pvB + 1024;
    const int lane = c.lane, w = __builtin_amdgcn_readfirstlane(c.tid >> 6), fr = lane & 15, g = lane >> 4;
    constexpr int RP = GS / 8, NW2 = GS / 16;
    const int g_lo = layer == 0 ? 0 : C / GS;
    for (int grp = g_lo + c.wg; grp < R / GS; grp += c.nwg) {
        const int which = grp * GS < C ? 1 : 0;
        const float* m = c.modp(layer, which);
        __syncthreads();
        if (c.tid < NE) lcnt[c.tid] = 0u;
#pragma unroll 4
        for (int j = 0; j < 16; ++j) {
            const int i4 = c.tid + 512 * j, k = i4 >> 3, e0 = (i4 & 7) * 4;
            const f32x4 wv = *(const f32x4*)(Wr + (size_t)k * NE + e0); const float sc = ng[2 * D + k] * (1.f + m[4096 + k]);
            LAS float* dst = WL + ((((k >> 4) * 4 + (k & 3)) * 4 + ((k >> 2) & 3)) * 16) * 2;
#pragma unroll
            for (int q = 0; q < 4; ++q) { const int e = e0 + q; dst[(e & 15) * 2 + (e >> 4)] = wv[q] * sc; }
        }
        for (int k = c.tid; k < D; k += 512) { pvA[k] = m[2048 + k] * ng[D + k]; pvB[k] = ng[2 * D + k] * (1.f + m[4096 + k]); pvS[k] = m[3072 + k]; }
        { const int e = c.tid & 31, part = c.tid >> 5; float sacc = 0.f;
#pragma unroll 16
          for (int k = part * 64; k < part * 64 + 64; ++k) sacc += m[3072 + k] * Wr[k * NE + e];
          biasp[32 + part * 32 + e] = sacc; }
        __syncthreads();
        if (c.tid < 32) { float sacc = br[c.tid];
#pragma unroll
            for (int p = 0; p < 16; ++p) sacc += biasp[32 + p * 32 + c.tid]; biasp[c.tid] = sacc; }
        __syncthreads();
        const int row1 = grp * GS + w * RP;
        f32x4 y0[4], x0[4], y1[4], x1[4], yn0[4], xn0[4], yn1[4], xn1[4];
#define PM_LOAD(RW, YY, XX) do { row_load_bf(Y + (size_t)(layer == 0 ? (RW) : (RW) - C) * D, lane, YY); if (layer == 0) row_load(c.xin0(RW), lane, XX); else row_load_bf(Xprev + (size_t)(RW) * D, lane, XX); } while (0)
#define PM_ROW(RW, YY, XX, II) do { \
            const float rstd_y = rsqrtf(row_ss(YY) * (1.f / D) + EPS); \
            _Pragma("unroll") for (int j = 0; j < 4; ++j) { const int c0 = lane * 4 + 256 * j; \
                XX[j] += *(const LAS f32x4*)(pvA + c0) * (YY[j] * rstd_y); \
                u32x2 xo; xo[0] = pk2(XX[j][0], XX[j][1]); xo[1] = pk2(XX[j][2], XX[j][3]); *(u32x2*)(Xout + (size_t)(RW) * D + c0) = xo; \
                XX[j] = (f32x4){bflo(xo[0]), bfhi(xo[0]), bflo(xo[1]), bfhi(xo[1])}; }     \
            const float rstd_x = rsqrtf(row_ss(XX) * (1.f / D) + EPS); \
            _Pragma("unroll") for (int j = 0; j < 4; ++j) { const int c0 = lane * 4 + 256 * j; \
                const f32x4 hv = XX[j] * rstd_x * *(const LAS f32x4*)(pvB + c0) + *(const LAS f32x4*)(pvS + c0); \
                *(unsigned*)(H8 + (size_t)(RW) * D + c0) = pk4_fp8(hv[0] * F8_SH, hv[1] * F8_SH, hv[2] * F8_SH, hv[3] * F8_SH); } \
            if (lane == 0) rsx[w * RP + (II)] = rstd_x; } while (0)
        PM_LOAD(row1, yn0, xn0); PM_LOAD(row1 + 1, yn1, xn1);
        for (int i = 0; i < RP; i += 2) {
            const int r = row1 + i;
#pragma unroll
            for (int j = 0; j < 4; ++j) { y0[j] = yn0[j]; x0[j] = xn0[j]; y1[j] = yn1[j]; x1[j] = xn1[j]; }
            if (i + 2 < RP) { PM_LOAD(r + 2, yn0, xn0); PM_LOAD(r + 3, yn1, xn1); }
            PM_ROW(r, y0, x0, i);
            PM_ROW(r + 1, y1, x1, i + 1);
        }
#undef PM_LOAD
#undef PM_ROW
        asm volatile("s_waitcnt vmcnt(0)" ::: "memory");
        __syncthreads();
        const int row0 = grp * GS + w * 16; const bool w2 = w < NW2;
        f32x4 la[2]; la[0] = (f32x4){0.f, 0.f, 0.f, 0.f}; la[1] = la[0];
        if (w2) {
            const bf16_t* ap = Xout + (size_t)(row0 + fr) * D + 4 * g;
            const LAS float* bp = WL + (g * 16 + fr) * 2;
#pragma unroll 4
            for (int k4 = 0; k4 < 64; ++k4) {
                const u32x2 aw = *(const u32x2*)(ap + 16 * k4); const f32x4 a4 = (f32x4){bflo(aw.x), bfhi(aw.x), bflo(aw.y), bfhi(aw.y)};
#pragma unroll
                for (int q = 0; q < 4; ++q) {
                    const f32x2 b2 = *(const LAS f32x2*)(bp + (size_t)(4 * k4 + q) * 128);
                    la[0] = __builtin_amdgcn_mfma_f32_16x16x4f32(a4[q], b2[0], la[0], 0, 0, 0);
                    la[1] = __builtin_amdgcn_mfma_f32_16x16x4f32(a4[q], b2[1], la[1], 0, 0, 0);
                }
            }
        }
        float tv[4][4]; int te[4][4];
#pragma unroll
        for (int e = 0; e < 4; ++e) {
            const float rs = rsx[(w2 ? w * 16 : 0) + 4 * g + e];
            float v0 = la[0][e] * rs + biasp[fr], v1 = la[1][e] * rs + biasp[16 + fr];
#pragma unroll
            for (int k = 0; k < 4; ++k) {
                float bv; int bi;
                if (v0 >= v1) { bv = v0; bi = fr; } else { bv = v1; bi = 16 + fr; }
#pragma unroll
                for (int o = 8; o > 0; o >>= 1) {
                    const float ov = __shfl_xor(bv, o); const int oi = __shfl_xor(bi, o);
                    if (ov > bv || (ov == bv && oi < bi)) { bv = ov; bi = oi; }
                }
                tv[e][k] = bv; te[e][k] = bi;
                if (bi == fr) v0 = -INFINITY;
                if (bi == 16 + fr) v1 = -INFINITY;
            }
        }
        float v[4]; int ex[4]; unsigned sl[4];
#pragma unroll
        for (int k = 0; k < 4; ++k) { v[k] = tv[0][k]; ex[k] = te[0][k];
#pragma unroll
            for (int e = 1; e < 4; ++e) if (fr == e) { v[k] = tv[e][k]; ex[k] = te[e][k]; } }
        if (fr < 4 && route && w2) {
#pragma unroll
            for (int k = 0; k < 4; ++k) sl[k] = __hip_atomic_fetch_add(lcnt + ex[k], 1u, __ATOMIC_RELAXED, __HIP_MEMORY_SCOPE_WORKGROUP);
        }
        __syncthreads();
        if (c.tid < NE && route) { const unsigned n = lcnt[c.tid]; lbase[c.tid] = n ? atomicAdd(&cnt[c.tid], n) : 0u; }
        __syncthreads();
        if (fr < 4 && route && w2) {
            const int r = row0 + 4 * g + fr;
            const float e1 = __expf(v[1] - v[0]), e2 = __expf(v[2] - v[0]), e3 = __expf(v[3] - v[0]);
            const float inv = 1.f / (1.f + e1 + e2 + e3);
            const float gk[4] = {inv, e1 * inv, e2 * inv, e3 * inv};
#pragma unroll
            for (int k = 0; k < 4; ++k) {
                const unsigned slot = lbase[ex[k]] + sl[k];
                list[(size_t)ex[k] * R + slot] = r;
                tk_e[r * 4 + k] = ex[k]; tk_g[r * 4 + k] = gk[k]; tk_slot[r * 4 + k] = (int)slot;
            }
        }
    }
}

__device__ __forceinline__ void moe_offsets(const Ctx& c, int layer, LAS int* so) {
    const unsigned* cnt = (const unsigned*)(c.ws + WS_CTL) + CW_CNT + layer * NE;
    __syncthreads();
    if (c.tid < 64) {
        const int n = c.tid < NE ? (int)cnt[c.tid] : 0; int pad = (n + PADM - 1) / PADM * PADM, inc = pad;
#pragma unroll
        for (int o = 1; o < 32; o <<= 1) { const int t = __shfl_up(inc, o); if (c.lane >= o) inc += t; }
        if (c.tid < NE) { so[c.tid] = inc - pad; so[64 + c.tid] = n; }
        if (c.tid == NE - 1) so[32] = inc;
    }
    __syncthreads();
}

__device__ __forceinline__ void moe_tables(const Ctx& c, int layer, LAS int* tb) {
    const unsigned* cnt = (const unsigned*)(c.ws + WS_CTL) + CW_CNT + layer * NE;
    __syncthreads();
    if (c.tid < 64) {
        const int n = c.tid < NE ? (int)cnt[c.tid] : 0; int tiles = (n + PADM - 1) / PADM, inc = tiles;
#pragma unroll
        for (int o = 1; o < 32; o <<= 1) { const int t = __shfl_up(inc, o); if (c.lane >= o) inc += t; }
        if (c.tid < NE) { tb[c.tid] = inc - tiles; tb[64 + c.tid] = n; }
        if (c.tid == NE - 1) tb[32] = inc;
    }
    __syncthreads();
}
__device__ __forceinline__ int vcu_of(const Ctx& c) { return (c.nwg % 8 == 0) ? (c.wg % 8) * (c.nwg / 8) + c.wg / 8 : c.wg; }
__device__ __forceinline__ void phase_moe_gu(const Ctx& c, int layer) {
    LAS int* tb = (LAS int*)(c.lds + 131072 + 1024);
    moe_tables(c, layer, tb);
    pg8::Gemm g{c.ws + WS_H8, c.ws + WS_WGU + (size_t)layer * NE * 2048 * 1024, (size_t)2048 * 1024, (const int*)(c.ws + WS_LIST)};
    pg8::MoeOrder S{tb, tb + 64, 8, c.nwg, vcu_of(c), false};
    pg8::EpiSwiglu E{c.ws + WS_HDN, c.a->in[18] + (size_t)layer * NE * 2048};
    pg8::gemm_phase<pg8::EpiSwiglu, pg8::MoeOrder, true, true, true>(c.lds, g, S, E, c.tid);
}
__device__ __forceinline__ void phase_moe_dn(const Ctx& c, int layer) {
    LAS int* tb = (LAS int*)(c.lds + 131072 + 1024);
    moe_tables(c, layer, tb);
    pg8::Gemm g{c.ws + WS_HDN, c.ws + WS_WDN + (size_t)layer * NE * 1024 * 1024, (size_t)1024 * 1024, nullptr};
    pg8::MoeOrder S{tb, tb + 64, 4, c.nwg, vcu_of(c), true};
    pg8::EpiBf16Bias E{c.ws + WS_OUTB, c.a->in[20] + (size_t)layer * NE * 1024, 1024, 1.f / (F8_SHD * F8_SW)};
    pg8::gemm_phase<pg8::EpiBf16Bias, pg8::MoeOrder, true, false, true>(c.lds, g, S, E, c.tid);
}
__device__ __forceinline__ void phase_gemm_f32(const Ctx& c, const bf16_t* A, int M, const bf16_t* Bt, int N, const float* bias, bf16_t* Cout) {
    pg8::Gemm g{A, Bt, 0, nullptr}; pg8::StaticOrder S; S.init(M, N, c.nwg, c.wg);
    pg8::EpiF32 E{Cout, N, bias};
    pg8::gemm_phase<pg8::EpiF32, pg8::StaticOrder, true, false, false>(c.lds, g, S, E, c.tid);
}

__device__ __forceinline__ void phase_gemm_qkv(const Ctx& c) {
    pg8::Gemm g{(const bf16_t*)(c.ws + WS_H), (const bf16_t*)(c.ws + WS_WQKV), 0, nullptr}; pg8::StaticOrder S; S.init(R, QKVD, c.nwg, c.wg);
    pg8::EpiQKV E{(bf16_t*)(c.ws + WS_Q), (bf16_t*)(c.ws + WS_K), (bf16_t*)(c.ws + WS_V), c.a->in[8], (const float*)(c.ws + WS_MOD) + MOD_ROPE};
    pg8::gemm_phase<pg8::EpiQKV, pg8::StaticOrder, true, false, false>(c.lds, g, S, E, c.tid);
}
__device__ __forceinline__ void phase_gemm_inproj(const Ctx& c) {
    pg8::Gemm g{c.ws + WS_H8, c.ws + WS_WIN, 0, nullptr}; pg8::StaticOrder S; S.init(R, HIN, c.nwg, c.wg);
    pg8::EpiInProj E{(bf16_t*)(c.ws + WS_QH), (_Float16*)(c.ws + WS_KF), (_Float16*)(c.ws + WS_KB), (bf16_t*)(c.ws + WS_IV), (bf16_t*)(c.ws + WS_SG), (const float*)(c.ws + WS_MOD) + MOD_LB, 1.f / (F8_SH * F8_SW)};
    pg8::gemm_phase<pg8::EpiInProj, pg8::StaticOrder, true, false, true>(c.lds, g, S, E, c.tid);
}

__device__ __forceinline__ void phase_norm0(const Ctx& c);
constexpr int CONV_A = 20 * 16 + 16 * 16 + 80 * 16 + 16 * 16, CONV_B = 32 * 32 * 16 + 32 * 16 * 16, CONV_CHUNK = 8;
__device__ __forceinline__ TBlk convert_item(const Ctx& c, int it, int part) {
    constexpr int I_QKV = 20 * 16, I_O = 16 * 16, I_IN = 80 * 16, I_HO = 16 * 16, I_GU = 32 * 32 * 16;
    int r = it; TBlk t; t.dst8 = nullptr; t.dst = nullptr;
    if (part == 0) {
        if (r < I_QKV) { const int nb = r % 20, kb = r / 20; t.src = c.a->in[7] + (size_t)kb * 64 * QKVD + nb * 64; t.ldw = QKVD; t.dst = (bf16_t*)(c.ws + WS_WQKV) + (size_t)nb * 64 * 1024 + kb * 64; return t; } r -= I_QKV;
        if (r < I_O) { const int nb = r % 16, kb = r / 16; t.src = c.a->in[10] + (size_t)kb * 64 * D + nb * 64; t.ldw = D; t.dst = (bf16_t*)(c.ws + WS_WO) + (size_t)nb * 64 * 1024 + kb * 64; return t; } r -= I_O;
        if (r < I_IN) { const int nb = r % 80, kb = r / 80; t.src = c.a->in[11] + (size_t)kb * 64 * HIN + nb * 64; t.ldw = HIN; t.dst8 = c.ws + WS_WIN + (size_t)nb * 64 * 1024 + kb * 64; return t; } r -= I_IN;
        if (r < I_HO) { const int nb = r % 16, kb = r / 16; t.src = c.a->in[14] + (size_t)kb * 64 * D + nb * 64; t.ldw = D; t.dst = (bf16_t*)(c.ws + WS_WHO) + (size_t)nb * 64 * 1024 + kb * 64; return t; } r -= I_HO;
    }
    const int moff = (part - 1) * 32;
    if (r < I_GU) { const int mat = moff + r / 512, rr = r % 512, nb = rr % 32, kb = rr / 32; const int n0 = ((nb & 3) >> 1) * 1024 + (nb >> 2) * 128 + (nb & 1) * 64;
        t.src = c.a->in[17] + (size_t)mat * 1024 * 2048 + (size_t)kb * 64 * 2048 + n0; t.ldw = 2048; t.dst8 = c.ws + WS_WGU + ((size_t)mat * 2048 + nb * 64) * 1024 + kb * 64; return t; } r -= I_GU;
    { const int mat = moff + r / 256, rr = r % 256, nb = rr % 16, kb = rr / 16;
        t.src = c.a->in[19] + (size_t)mat * 1024 * 1024 + (size_t)kb * 64 * 1024 + nb * 64; t.ldw = 1024; t.dst8 = c.ws + WS_WDN + ((size_t)mat * 1024 + nb * 64) * 1024 + kb * 64; }
    return t;
}
__device__ __forceinline__ void convert_run(const Ctx& c, int part, int first, int step, int end, LAS float* scr) {
    f32x4 va[16], vb[16];
    int it = first;
    TBlk ta, tbk;
    if (it < end) { ta = convert_item(c, it, part); tb_load(ta, c.lane, va); }
    for (; it < end; it += 2 * step) {
        const bool hb = it + step < end;
        if (hb) { tbk = convert_item(c, it + step, part); tb_load(tbk, c.lane, vb); }
        tb_store(ta, c.lane, va, scr);
        const bool ha = it + 2 * step < end;
        if (ha) { ta = convert_item(c, it + 2 * step, part); tb_load(ta, c.lane, va); }
        if (hb) tb_store(tbk, c.lane, vb, scr);
    }
}
__device__ __forceinline__ void convert_steal(const Ctx& c, int part) {
    LAS float* scr = (LAS float*)c.lds + c.wave * (64 * 65);
    LAS int* chp = (LAS int*)(c.lds + 8 * 64 * 65 * 4);
    unsigned* ctr = (unsigned*)(c.ws + WS_CTL) + CW_CONV + 64 * part;
    for (;;) {
        __syncthreads();
        if (c.tid == 0) *chp = (int)atomicAdd(ctr, 1u);
        __syncthreads();
        const int ch = *chp;
        if (ch >= CONV_B / CONV_CHUNK) break;
        convert_run(c, part, ch * CONV_CHUNK + c.wave, 8, (ch + 1) * CONV_CHUNK, scr);
    }
}
__device__ __forceinline__ void convert_steal_n(const Ctx& c, int part, int nmax) {
    LAS float* scr = (LAS float*)c.lds + c.wave * (64 * 65);
    LAS int* chp = (LAS int*)(c.lds + 8 * 64 * 65 * 4);
    unsigned* ctr = (unsigned*)(c.ws + WS_CTL) + CW_CONV + 64 * part;
    for (int n = 0; n < nmax; ++n) {
        __syncthreads();
        if (c.tid == 0) *chp = (int)atomicAdd(ctr, 1u);
        __syncthreads();
        const int ch = *chp;
        if (ch >= CONV_B / CONV_CHUNK) break;
        convert_run(c, part, ch * CONV_CHUNK + c.wave, 8, (ch + 1) * CONV_CHUNK, scr);
    }
    __syncthreads();
}
__device__ __forceinline__ void phase_convert(const Ctx& c) {
    LAS float* scr = (LAS float*)c.lds + c.wave * (64 * 65);
    convert_run(c, 0, c.wg * 8 + c.wave, c.nwg * 8, CONV_A, scr);
    __syncthreads();
    phase_norm0(c);
}

__device__ __forceinline__ void phase_combine(const Ctx& c, int layer) {
    LAS int* so = (LAS int*)(c.lds + 32768);
    moe_offsets(c, layer, so);
    const unsigned char* outb = c.ws + WS_OUTB; bf16_t* X = (bf16_t*)(c.ws + WS_X);
    const bf16_t* Xin = layer == 0 ? X : (const bf16_t*)(c.ws + WS_X1);
    const float* ngl = c.a->in[6] + layer * 4 * D;
    const int* tk_e = (const int*)(c.ws + WS_TK); const float* tk_g = (const float*)(c.ws + WS_TK) + R * 4; const int* tk_slot = (const int*)(c.ws + WS_TK) + 2 * R * 4;
    const int r_lo = layer == 0 ? 0 : C, stride = c.nwg * 8;
    int r = r_lo + c.wg * 8 + c.wave;
    struct TK { int e[4], s[4]; float g[4]; };
    struct DT { unsigned w[4][4]; f32x4 x[4]; float g[4]; };
    TK ta, tb; DT da, db, na, nb;
#define CB_TK(T, row) do { _Pragma("unroll") for (int k = 0; k < 4; ++k) { T.e[k] = tk_e[(row) * 4 + k]; T.s[k] = tk_slot[(row) * 4 + k]; T.g[k] = tk_g[(row) * 4 + k]; } } while (0)
#define CB_DATA(DD, T, row) do { _Pragma("unroll") for (int k = 0; k < 4; ++k) { const unsigned char* src_ = outb + (size_t)(so[T.e[k]] + T.s[k]) * 1024; DD.g[k] = T.g[k] * (1.f / F8_SO); \
        _Pragma("unroll") for (int j = 0; j < 4; ++j) DD.w[k][j] = *(const unsigned*)(src_ + c.lane * 4 + 256 * j); } row_load_bf(Xin + (size_t)(row) * D, c.lane, DD.x); } while (0)
#define CB_ROW(DD, rr) do { const int r_ = (rr); \
        const float* m = c.modp(layer, r_ < C ? 1 : 0); \
        f32x4 y[4], x[4]; \
        _Pragma("unroll") for (int j = 0; j < 4; ++j) { y[j] = (f32x4){0.f, 0.f, 0.f, 0.f}; x[j] = DD.x[j]; } \
        _Pragma("unroll") for (int k = 0; k < 4; ++k) _Pragma("unroll") for (int j = 0; j < 4; ++j) { \
            const f32x2 lo = __builtin_amdgcn_cvt_pk_f32_fp8((int)DD.w[k][j], false), hi = __builtin_amdgcn_cvt_pk_f32_fp8((int)DD.w[k][j], true); y[j] += (f32x4){lo[0], lo[1], hi[0], hi[1]} * DD.g[k]; } \
        const float rstd_y = rsqrtf(row_ss(y) * (1.f / D) + EPS); \
        _Pragma("unroll") for (int j = 0; j < 4; ++j) { const int c0 = c.lane * 4 + 256 * j; \
            const f32x4 g2 = *(const f32x4*)(m + 5120 + c0), n3 = *(const f32x4*)(ngl + 3 * D + c0); \
            x[j] += g2 * (y[j] * rstd_y * n3); \
            if (layer == 0) { u32x2 xo; xo[0] = pk2(x[j][0], x[j][1]); xo[1] = pk2(x[j][2], x[j][3]); *(u32x2*)(X + (size_t)r_ * D + c0) = xo; x[j] = (f32x4){bflo(xo[0]), bfhi(xo[0]), bflo(xo[1]), bfhi(xo[1])}; } \
            else *(f32x4*)(c.a->out + (size_t)(r_ - C) * D + c0) = x[j]; } \
        if (layer == 0) { \
            const float rstd_x = rsqrtf(row_ss(x) * (1.f / D) + EPS); \
            const float* m1 = c.modp(1, r_ < C ? 1 : 0); const float* g0 = c.a->in[6] + 4 * D; \
            _Pragma("unroll") for (int j = 0; j < 4; ++j) { const int c0 = c.lane * 4 + 256 * j; \
                const f32x4 gv = *(const f32x4*)(g0 + c0), shv = *(const f32x4*)(m1 + c0), scv = *(const f32x4*)(m1 + 1024 + c0); \
                const f32x4 hv = x[j] * rstd_x * gv * (scv + 1.f) + shv; \
                *(unsigned*)(c.ws + WS_H8 + (size_t)r_ * D + c0) = pk4_fp8(hv[0] * F8_SH, hv[1] * F8_SH, hv[2] * F8_SH, hv[3] * F8_SH); } } } while (0)
    if (r < R) { CB_TK(ta, r); CB_DATA(da, ta, r); }
    if (r + stride < R) { CB_TK(tb, r + stride); CB_DATA(db, tb, r + stride); }
    if (r + 2 * stride < R) CB_TK(ta, r + 2 * stride);
    if (r + 3 * stride < R) CB_TK(tb, r + 3 * stride);
    for (; r < R; r += 2 * stride) {
        const bool h1 = r + stride < R, h2 = r + 2 * stride < R, h3 = r + 3 * stride < R;
        if (h2) CB_DATA(na, ta, r + 2 * stride);
        if (h3) CB_DATA(nb, tb, r + 3 * stride);
        if (r + 4 * stride < R) CB_TK(ta, r + 4 * stride);
        if (r + 5 * stride < R) CB_TK(tb, r + 5 * stride);
        CB_ROW(da, r);
        if (h1) CB_ROW(db, r + stride);
        da = na; db = nb;
    }
#undef CB_ROW
#undef CB_TK
#undef CB_DATA
}

namespace hg {
typedef _Float16 h2_t __attribute__((ext_vector_type(2)));
constexpr int TB = 272, PB = 144;
constexpr int TILE = 64 * TB;
constexpr int T_QD = 0, T_QC = TILE, T_KD = 2 * TILE, T_KE = 3 * TILE, T_KC = 4 * TILE, T_V0 = 5 * TILE, T_V1 = 6 * TILE;
constexpr int T_QL1 = 7 * TILE, T_KL1 = T_QL1 + 16 * TB, T_P = T_KL1 + 16 * TB, T_TOT = T_P + 64 * PB, T_CT = T_TOT + 4096, T_END = T_CT + 512;
static_assert(T_END <= LDS_BYTES - 64, "hgrn scan LDS map");
__device__ __forceinline__ int row_of(int dir, int p) { return p < C ? (dir ? C - 1 - p : p) : (dir ? C + (L - 1 - (p - C)) : p); }
__device__ __forceinline__ int seg_of(int ch) { return ch < 68 ? ch / 17 : 4 + (ch - 68) / 16; }
__device__ __forceinline__ bf16x8 tr_frag(const LAS unsigned char* tile, int row0, int col0, int lane) {
    const int q = (lane & 15) >> 2, p = lane & 3;
    const LAS unsigned char* a = tile + (row0 + q) * TB + (col0 + 4 * p) * 2;
    const v4i16_t lo = __builtin_amdgcn_ds_read_tr16_b64_v4i16((LAS v4i16_t*)a);
    const v4i16_t hi = __builtin_amdgcn_ds_read_tr16_b64_v4i16((LAS v4i16_t*)(a + 4 * TB));
    return (bf16x8){lo[0], lo[1], lo[2], lo[3], hi[0], hi[1], hi[2], hi[3]};
}
}

__device__ __forceinline__ void phase_hgrn_scan(const Ctx& c) {
    using namespace hg;
#define HG_BAR() asm volatile("s_waitcnt lgkmcnt(0)\n\ts_barrier" ::: "memory")
    const bf16_t* QH = (const bf16_t*)(c.ws + WS_QH); const bf16_t* IV = (const bf16_t*)(c.ws + WS_IV);
    LAS unsigned char* lds = c.lds;
    const int tid = c.tid, lane = c.lane, w = __builtin_amdgcn_readfirstlane(tid >> 6), fr = lane & 15, g = lane >> 4;
    for (int item_ = c.wg; item_ < 256 * SCAN_REP; item_ += c.nwg) {
        const int item = item_ & 255;
        const int chain = item >> 4, seg = item & 15, head = chain >> 1, dir = chain & 1, hc = head * 128;
        const int c0 = seg < 4 ? 17 * seg : 68 + 16 * (seg - 4), nch = seg < 4 ? 17 : 16;
        const _Float16* KX = (const _Float16*)(c.ws + (dir ? WS_KB : WS_KF));
        bf16_t* OL = (bf16_t*)(c.ws + (dir ? WS_OB : WS_OF)); bf16_t* QS = (bf16_t*)(c.ws + (dir ? WS_QSB : WS_QSF));
        HG_BAR();
        for (int i = tid; i < 64 * PB / 4; i += 512) ((LAS unsigned*)(lds + T_P))[i] = 0u;
        f32x4 Sacc[8];
#pragma unroll
        for (int m = 0; m < 8; ++m) Sacc[m] = (f32x4){0.f, 0.f, 0.f, 0.f};
        float dseg0 = 1.f, dseg1 = 1.f;
        unsigned kraw[8], qraw[8]; u32x4 vraw[2];
#define HG_LOAD(cidx) do { const int p0_ = 64 * (cidx); const bool lat_ = (cidx) >= 4; \
        _Pragma("unroll") for (int i = 0; i < 8; ++i) { const int r_ = row_of(dir, p0_ + 8 * w + i); \
            kraw[i] = *(const unsigned*)(KX + (size_t)r_ * D + hc + 2 * lane); \
            qraw[i] = lat_ ? *(const unsigned*)(QH + (size_t)(r_ - C) * D + hc + 2 * lane) : 0u; } \
        _Pragma("unroll") for (int i = 0; i < 2; ++i) { const int idx_ = tid + 512 * i; const int r_ = row_of(dir, p0_ + (idx_ >> 4)); \
            vraw[i] = *(const u32x4*)(IV + (size_t)r_ * D + hc + (idx_ & 15) * 8); } } while (0)
        HG_LOAD(c0);
        for (int ci = 0; ci < nch; ++ci) {
            const int cidx = c0 + ci; const bool lat = cidx >= 4;
            const int vbuf = (ci & 1) ? T_V1 : T_V0;
            float kf[8][2], qf[8][2], cp[8][2];
            {
                float p0 = 1.f, p1 = 1.f;
#pragma unroll
                for (int i = 0; i < 8; ++i) {
                    const h2_t hv = __builtin_bit_cast(h2_t, kraw[i]);
                    kf[i][0] = (float)hv[0]; kf[i][1] = (float)hv[1];
                    qf[i][0] = bflo(qraw[i]); qf[i][1] = bfhi(qraw[i]);
                    p0 *= (1.f - kf[i][0]); p1 *= (1.f - kf[i][1]); cp[i][0] = p0; cp[i][1] = p1;
                }
                *(LAS f32x2*)(lds + T_TOT + (w * 128 + 2 * lane) * 4) = (f32x2){p0, p1};
#pragma unroll
                for (int i = 0; i < 2; ++i) { const int idx = tid + 512 * i; *(LAS u32x4*)(lds + vbuf + (idx >> 4) * TB + (idx & 15) * 16) = vraw[i]; }
            }
            HG_BAR();
            {
                f32x2 T[8];
#pragma unroll
                for (int x = 0; x < 8; ++x) T[x] = *(const LAS f32x2*)(lds + T_TOT + (x * 128 + 2 * lane) * 4);
                const int I = w >> 1, hh = w & 1;
                f32x2 bd[4];
#pragma unroll
                for (int x = 0; x < 4; ++x) bd[x] = T[2 * x] * T[2 * x + 1];
                f32x2 pre = (f32x2){1.f, 1.f}, cum = (f32x2){1.f, 1.f}, suf = (f32x2){1.f, 1.f}, bdI = (f32x2){1.f, 1.f};
#pragma unroll
                for (int x = 0; x < 8; ++x) if (hh && x == w - 1) pre = T[x];
#pragma unroll
                for (int x = 0; x < 4; ++x) { if (x < I) cum = cum * bd[x]; if (x > I) suf = suf * bd[x]; if (x == I) bdI = bd[x]; }
                const f32x2 ctot = (bd[0] * bd[1]) * (bd[2] * bd[3]);
#pragma unroll
                for (int i = 0; i < 8; ++i) {
                    const int tau = 8 * w + i;
                    float QDv[2], KDv[2], KEv[2], QCv[2], KCv[2];
#pragma unroll
                    for (int x = 0; x < 2; ++x) {
                        const float eq = pre[x] * cp[i][x], rc = __builtin_amdgcn_rcpf(eq);
                        QDv[x] = qf[i][x] * eq; KDv[x] = kf[i][x] * rc; KEv[x] = KDv[x] * bdI[x]; QCv[x] = QDv[x] * cum[x]; KCv[x] = KEv[x] * suf[x];
                    }
                    const int to = tau * TB + lane * 4;
                    *(LAS unsigned*)(lds + T_QD + to) = pk2(QDv[0], QDv[1]);
                    *(LAS unsigned*)(lds + T_KD + to) = pk2(KDv[0], KDv[1]);
                    *(LAS unsigned*)(lds + T_KE + to) = pk2(KEv[0], KEv[1]);
                    *(LAS unsigned*)(lds + T_QC + to) = pk2(QCv[0], QCv[1]);
                    *(LAS unsigned*)(lds + T_KC + to) = pk2(KCv[0], KCv[1]);
                    if (I == 3) *(LAS unsigned*)(lds + T_QL1 + (tau - 48) * TB + lane * 4) = pk2(QDv[0] * bd[2][0], QDv[1] * bd[2][1]);
                    if (I == 0) *(LAS unsigned*)(lds + T_KL1 + tau * TB + lane * 4) = pk2(KEv[0] * bd[1][0], KEv[1] * bd[1][1]);
                    if (lat) { const int r = row_of(dir, 64 * cidx + tau); *(unsigned*)(QS + (size_t)(r - C) * D + hc + 2 * lane) = pk2(QCv[0] * dseg0, QCv[1] * dseg1); }
                }
                dseg0 *= ctot[0]; dseg1 *= ctot[1];
                if (w == 0) *(LAS f32x2*)(lds + T_CT + lane * 8) = ctot;
            }
            HG_BAR();
            if (ci + 1 < nch) HG_LOAD(cidx + 1);
            if (lat) {
                const int nblk = w >= 6 ? 2 : 1;
                for (int b = 0; b < nblk; ++b) {
                    int I, J, qoff, qrow, koff, krow; bool diag = false;
                    if (w < 4) { I = 2 + (w >> 1); J = w & 1; qoff = (w >> 1) ? T_QL1 : T_QD; qrow = (w >> 1) ? 0 : 32; koff = (w & 1) ? T_KE : T_KL1; krow = (w & 1) ? 16 : 0; }
                    else if (w == 4) { I = 1; J = 0; qoff = T_QD; qrow = 16; koff = T_KE; krow = 0; }
                    else if (w == 5) { I = 3; J = 2; qoff = T_QD; qrow = 48; koff = T_KE; krow = 32; }
                    else { I = 2 * (w - 6) + b; J = I; qoff = T_QD; qrow = 16 * I; koff = T_KD; krow = 16 * I; diag = true; }
                    f32x4 pa = (f32x4){0.f, 0.f, 0.f, 0.f};
#pragma unroll
                    for (int ks = 0; ks < 4; ++ks) {
                        const bf16x8 av = *(const LAS bf16x8*)(lds + qoff + (qrow + fr) * TB + (32 * ks + 8 * g) * 2);
                        const bf16x8 bv = *(const LAS bf16x8*)(lds + koff + (krow + fr) * TB + (32 * ks + 8 * g) * 2);
                        pa = __builtin_amdgcn_mfma_f32_16x16x32_bf16(av, bv, pa, 0, 0, 0);
                    }
#pragma unroll
                    for (int e = 0; e < 4; ++e) {
                        const int tl = 4 * g + e; const float val = (diag && fr > tl) ? 0.f : pa[e];
                        *(LAS bf16_t*)(lds + T_P + (16 * I + tl) * PB + (16 * J + fr) * 2) = (bf16_t)f2bf(val);
                    }
                }
            }
            f32x4 oacc[4];
#pragma unroll
            for (int m = 0; m < 4; ++m) oacc[m] = (f32x4){0.f, 0.f, 0.f, 0.f};
            if (lat) {
                bf16x8 Sb[4];
#pragma unroll
                for (int ks = 0; ks < 4; ++ks) {
                    const f32x4 a0 = Sacc[2 * ks], a1 = Sacc[2 * ks + 1];
                    const u32x4 pk = (u32x4){pk2(a0[0], a0[1]), pk2(a0[2], a0[3]), pk2(a1[0], a1[1]), pk2(a1[2], a1[3])};
                    Sb[ks] = __builtin_bit_cast(bf16x8, pk);
                }
#pragma unroll
                for (int m = 0; m < 4; ++m)
#pragma unroll
                    for (int ks = 0; ks < 4; ++ks) {
                        const u32x2 lo = *(const LAS u32x2*)(lds + T_QC + (16 * m + fr) * TB + (32 * ks + 4 * g) * 2);
                        const u32x2 hi = *(const LAS u32x2*)(lds + T_QC + (16 * m + fr) * TB + (32 * ks + 16 + 4 * g) * 2);
                        const u32x4 pk = (u32x4){lo.x, lo.y, hi.x, hi.y};
                        oacc[m] = __builtin_amdgcn_mfma_f32_16x16x32_bf16(Sb[ks], __builtin_bit_cast(bf16x8, pk), oacc[m], 0, 0, 0);
                    }
            }
#pragma unroll
            for (int m = 0; m < 8; ++m) { const f32x4 ct = *(const LAS f32x4*)(lds + T_CT + (16 * m + 4 * g) * 4); Sacc[m] = Sacc[m] * ct; }
            bf16x8 Vf[2];
#pragma unroll
            for (int ks = 0; ks < 2; ++ks) Vf[ks] = tr_frag(lds + vbuf, 32 * ks + 8 * g, 16 * w, lane);
#pragma unroll
            for (int m = 0; m < 8; ++m)
#pragma unroll
                for (int ks = 0; ks < 2; ++ks) Sacc[m] = __builtin_amdgcn_mfma_f32_16x16x32_bf16(tr_frag(lds + T_KC, 32 * ks + 8 * g, 16 * m, lane), Vf[ks], Sacc[m], 0, 0, 0);
            HG_BAR();
            if (lat) {
#pragma unroll
                for (int m = 0; m < 4; ++m)
#pragma unroll
                    for (int ks = 0; ks < 2; ++ks) {
                        if (m < 2 && ks == 1) continue;
                        const bf16x8 av = *(const LAS bf16x8*)(lds + T_P + (16 * m + fr) * PB + (32 * ks + 8 * g) * 2);
                        oacc[m] = __builtin_amdgcn_mfma_f32_16x16x32_bf16(Vf[ks], av, oacc[m], 0, 0, 0);
                    }
#pragma unroll
                for (int m = 0; m < 4; ++m) { const int r = row_of(dir, 64 * cidx + 16 * m + fr); u32x2 o; o.x = pk2(oacc[m][0], oacc[m][1]); o.y = pk2(oacc[m][2], oacc[m][3]);
                    *(u32x2*)(OL + (size_t)(r - C) * D + hc + 16 * w + 4 * g) = o; }
            }
        }
#undef HG_LOAD
        float* DS = (float*)(c.ws + WS_DS) + (size_t)item * 16384; float* DG = (float*)(c.ws + WS_DG) + item * 128;
#pragma unroll
        for (int m = 0; m < 8; ++m)
#pragma unroll
            for (int e = 0; e < 4; ++e) DS[(16 * m + 4 * g + e) * 128 + 16 * w + fr] = Sacc[m][e];
        if (w == 0) { DG[2 * lane] = dseg0; DG[2 * lane + 1] = dseg1; }
    }
}

#undef HG_BAR
__device__ __forceinline__ void phase_hgrn_fold(const Ctx& c) {
    const float* DS = (const float*)(c.ws + WS_DS); const float* DG = (const float*)(c.ws + WS_DG); bf16_t* SST = (bf16_t*)(c.ws + WS_SST);
    for (int item = c.wg; item < 256; item += c.nwg) {
        const int chain = item >> 4, slice = item & 15, d = 8 * slice + (c.tid >> 6), v2 = (c.tid & 63) * 2;
        float s0 = 0.f, s1 = 0.f;
        float dv[15]; f32x2 ds[15];
#pragma unroll
        for (int sgi = 0; sgi < 15; ++sgi) { dv[sgi] = DG[(chain * 16 + sgi) * 128 + d]; ds[sgi] = *(const f32x2*)(DS + ((size_t)(chain * 16 + sgi) * 128 + d) * 128 + v2); }
        SST[((size_t)(chain * 16) * 128 + v2) * 128 + d] = 0; SST[((size_t)(chain * 16) * 128 + v2 + 1) * 128 + d] = 0;
#pragma unroll
        for (int sgi = 0; sgi < 15; ++sgi) {
            s0 = dv[sgi] * s0 + ds[sgi][0]; s1 = dv[sgi] * s1 + ds[sgi][1];
            SST[((size_t)(chain * 16 + sgi + 1) * 128 + v2) * 128 + d] = (bf16_t)f2bf(s0); SST[((size_t)(chain * 16 + sgi + 1) * 128 + v2 + 1) * 128 + d] = (bf16_t)f2bf(s1);
        }
    }
}

__device__ __forceinline__ void phase_hgrn_readout(const Ctx& c) {
    constexpr int SP = 272, SBUF = 128 * SP, IBUF = 2 * SBUF;
    static_assert(2 * IBUF + 1024 <= LDS_BYTES - 64, "readout LDS map");
    const bf16_t* OF = (const bf16_t*)(c.ws + WS_OF); const bf16_t* OB = (const bf16_t*)(c.ws + WS_OB); const bf16_t* SGp = (const bf16_t*)(c.ws + WS_SG);
    const bf16_t* SST = (const bf16_t*)(c.ws + WS_SST); bf16_t* RR = (bf16_t*)(c.ws + WS_RR); const float* hng = c.a->in[13];
    LAS unsigned char* lds = c.lds; LAS float* ssx = (LAS float*)(c.lds + 2 * IBUF);
    const int tid = c.tid, lane = c.lane, w = __builtin_amdgcn_readfirstlane(tid >> 6), fr = lane & 15, g = lane >> 4, mt = w & 3, nh = w >> 2;
#define RO_BAR() asm volatile("s_waitcnt lgkmcnt(0)\n\ts_barrier" ::: "memory")
    u32x4 sreg[8];
#define RO_SST_LOAD(it) do { const int h_ = (it) >> 8, ch_ = (it) & 255; \
        _Pragma("unroll") for (int j = 0; j < 8; ++j) { const int idx_ = tid + 512 * j, dx_ = idx_ >> 11, rem_ = idx_ & 2047; \
            const int sg_ = hg::seg_of(dx_ ? 4 + 255 - ch_ : 4 + ch_); \
            sreg[j] = *(const u32x4*)(SST + ((size_t)((h_ * 2 + dx_) * 16 + sg_) * 128 + (rem_ >> 4)) * 128 + (rem_ & 15) * 8); } } while (0)
#define RO_SST_WRITE(buf) do { _Pragma("unroll") for (int j = 0; j < 8; ++j) { const int idx_ = tid + 512 * j, dx_ = idx_ >> 11, rem_ = idx_ & 2047; \
            *(LAS u32x4*)(lds + (buf) * IBUF + dx_ * SBUF + (rem_ >> 4) * SP + (rem_ & 15) * 16) = sreg[j]; } } while (0)
    int it = c.wg;
    u32x2 ra[4], rb[4], rg[4]; bf16x8 rq[2][4];
#define RO_IN_LOAD(itx) do { const int h_ = (itx) >> 8, t0_ = 64 * ((itx) & 255) + 16 * mt; \
        _Pragma("unroll") for (int n = 0; n < 4; ++n) { const size_t o_ = (size_t)(t0_ + fr) * D + h_ * 128 + 64 * nh + 16 * n + 4 * g; \
            ra[n] = *(const u32x2*)(OF + o_); rb[n] = *(const u32x2*)(OB + o_); rg[n] = *(const u32x2*)(SGp + o_); } \
        _Pragma("unroll") for (int dx = 0; dx < 2; ++dx) { const bf16_t* QS_ = (const bf16_t*)(c.ws + (dx ? WS_QSB : WS_QSF)) + (size_t)(t0_ + fr) * D + h_ * 128 + 8 * g; \
            _Pragma("unroll") for (int ks = 0; ks < 4; ++ks) rq[dx][ks] = *(const bf16x8*)(QS_ + 32 * ks); } } while (0)
    RO_BAR();
    if (it < 2048) { RO_SST_LOAD(it); RO_SST_WRITE(0); RO_IN_LOAD(it); }
    RO_BAR();
    for (int k = 0; it < 2048; it += c.nwg, ++k) {
        const int h = it >> 8, ch = it & 255, t0 = 64 * ch + 16 * mt, buf = k & 1;
        const bool has_next = it + c.nwg < 2048;
        f32x4 acc[4], sgv[4];
        bf16x8 aq[2][4];
#pragma unroll
        for (int n = 0; n < 4; ++n) {
            const f32x4 gn = *(const f32x4*)(hng + h * 128 + 64 * nh + 16 * n + 4 * g);
            acc[n] = (f32x4){bflo(ra[n].x) + bflo(rb[n].x), bfhi(ra[n].x) + bfhi(rb[n].x), bflo(ra[n].y) + bflo(rb[n].y), bfhi(ra[n].y) + bfhi(rb[n].y)};
            sgv[n] = (f32x4){bflo(rg[n].x), bfhi(rg[n].x), bflo(rg[n].y), bfhi(rg[n].y)} * gn;
        }
#pragma unroll
        for (int dx = 0; dx < 2; ++dx)
#pragma unroll
            for (int ks = 0; ks < 4; ++ks) aq[dx][ks] = rq[dx][ks];
        if (has_next) { RO_SST_LOAD(it + c.nwg); RO_IN_LOAD(it + c.nwg); }
#pragma unroll
        for (int dx = 0; dx < 2; ++dx) {
            const LAS unsigned char* sb = lds + buf * IBUF + dx * SBUF + (64 * nh + fr) * SP + 16 * g;
#pragma unroll
            for (int ks = 0; ks < 4; ++ks) {
#pragma unroll
                for (int n = 0; n < 4; ++n) acc[n] = __builtin_amdgcn_mfma_f32_16x16x32_bf16(*(const LAS bf16x8*)(sb + (16 * n) * SP + 64 * ks), aq[dx][ks], acc[n], 0, 0, 0);
            }
        }
        float ss = 0.f;
#pragma unroll
        for (int n = 0; n < 4; ++n) ss += acc[n][0] * acc[n][0] + acc[n][1] * acc[n][1] + acc[n][2] * acc[n][2] + acc[n][3] * acc[n][3];
        ss = xadd32(xadd16(ss));
        if (g == 0) ssx[((k & 1) * 8 + w) * 16 + fr] = ss;
        if (has_next) RO_SST_WRITE(buf ^ 1);
        RO_BAR();
        const float rstd = rsqrtf((ss + ssx[((k & 1) * 8 + (w ^ 4)) * 16 + fr]) * (1.f / 128.f) + EPS);
#pragma unroll
        for (int n = 0; n < 4; ++n) {
            const f32x4 v = acc[n] * rstd * sgv[n]; u32x2 o; o.x = pk2(v[0], v[1]); o.y = pk2(v[2], v[3]);
            *(u32x2*)(RR + (size_t)(t0 + fr) * D + h * 128 + 64 * nh + 16 * n + 4 * g) = o;
        }
    }
    RO_BAR();
#undef RO_BAR
#undef RO_SST_LOAD
#undef RO_SST_WRITE
#undef RO_IN_LOAD
}

#define XB_TMO      128
#define XB_XCNT(j)  (256  + 64 * (j))
#define XB_XSUB(j)  (1280 + 64 * (j))
#define XB_XGEN(j)  (2304 + 64 * (j))
#define XB_TOP      3328
#define XB_TOPGEN   3392
#define XCD_BAR_WORDS 3456
#define XB_SPIN_CAP (1u << 18)
__device__ __forceinline__ unsigned xb_ld(unsigned* p)              { return __hip_atomic_load(p, __ATOMIC_RELAXED, __HIP_MEMORY_SCOPE_AGENT); }
__device__ __forceinline__ unsigned xb_add(unsigned* p, unsigned v) { return __hip_atomic_fetch_add(p, v, __ATOMIC_RELAXED, __HIP_MEMORY_SCOPE_AGENT); }
__device__ __forceinline__ unsigned xb_xcc_id() { return (unsigned)__builtin_amdgcn_s_getreg((3 << 11) | 20) & 0xFu; }
#define XB_SPIN(cond, bar) do { unsigned _sp = 0; while (cond) { __builtin_amdgcn_s_sleep(1); \
    if ((++_sp & 255u) == 0u) { if (xb_ld(&(bar)[XB_TMO])) break; if (_sp > XB_SPIN_CAP) { atomicAdd(&(bar)[XB_TMO], 1u); break; } } } } while (0)
struct XcdBarrier { unsigned* bar; unsigned x; volatile LAS unsigned* st; };
__device__ __forceinline__ XcdBarrier xcd_barrier_post(unsigned* bar, volatile LAS unsigned* st) {
    XcdBarrier b; b.bar = bar; b.x = xb_xcc_id(); b.st = st;
    if (threadIdx.x == 0) (void)xb_add(&bar[XB_XCNT(b.x)], 1u);
    return b;
}
__device__ __forceinline__ void xcd_barrier_complete(unsigned* bar, unsigned x, unsigned& nloc, unsigned& nx) {
    const unsigned G = gridDim.x * gridDim.y * gridDim.z;
    unsigned sum, cnt, mine, sp = 0u;
    for (;;) {
        sum = 0u; cnt = 0u; mine = 0u;
#pragma unroll
        for (unsigned j = 0; j < 16; ++j) { const unsigned c = xb_ld(&bar[XB_XCNT(j)]); sum += c; cnt += (c > 0u) ? 1u : 0u; mine = (j == x) ? c : mine; }
        if (sum == G) break;
        __builtin_amdgcn_s_sleep(1);
        if ((++sp & 255u) == 0u) { if (xb_ld(&bar[XB_TMO])) break; if (sp > XB_SPIN_CAP) { atomicAdd(&bar[XB_TMO], 1u); break; } }
    }
    nloc = mine > 0u ? mine : 1u; nx = cnt > 0u ? cnt : 1u;
}
__device__ __forceinline__ void xcd_barrier(const XcdBarrier& b) {
    asm volatile("s_waitcnt vmcnt(0)" ::: "memory");
    __syncthreads();
    if (threadIdx.x == 0) {
        unsigned* bar = b.bar;
        __builtin_amdgcn_s_waitcnt(0);
        unsigned nloc = b.st[0], nx = b.st[1];
        if (nloc == 0u) { xcd_barrier_complete(bar, b.x, nloc, nx); b.st[0] = nloc; b.st[1] = nx; }
        const unsigned old = xb_add(&bar[XB_XSUB(b.x)], 1u);
        const unsigned gen = old / nloc;
        if (old + 1u == (gen + 1u) * nloc) {
            __builtin_amdgcn_fence(__ATOMIC_RELEASE, "agent");
            asm volatile("s_waitcnt vmcnt(0)" ::: "memory");
            const unsigned og = xb_add(&bar[XB_TOP], 1u);
            const unsigned tg = og / nx;
            if (og + 1u == (tg + 1u) * nx) xb_add(&bar[XB_TOPGEN], 1u);
            else XB_SPIN(xb_ld(&bar[XB_TOPGEN]) == tg, bar);
            __builtin_amdgcn_fence(__ATOMIC_ACQUIRE, "agent");
            xb_add(&bar[XB_XGEN(b.x)], 1u);
            asm volatile("s_waitcnt vmcnt(0)" ::: "memory");
        } else {
            XB_SPIN(xb_ld(&bar[XB_XGEN(b.x)]) == gen, bar);
            __builtin_amdgcn_fence(__ATOMIC_ACQUIRE, "agent");
            asm volatile("s_waitcnt vmcnt(0)" ::: "memory");
        }
    }
    __syncthreads();
}

__device__ __forceinline__ void launder(Ctx& c) { asm volatile("" : "+s"(c.a)); asm volatile("" : "+s"(c.ws)); asm volatile("" : "+s"(c.wave));
    c.lane = (int)__builtin_amdgcn_mbcnt_hi(~0u, __builtin_amdgcn_mbcnt_lo(~0u, 0u)); c.tid = c.wave * 64 + c.lane; }
__global__ void __launch_bounds__(512, 2) mk_fwd(Args args) {
    extern __shared__ __attribute__((aligned(16))) unsigned char lds_raw[];
    Ctx c; c.a = (CArgs)__builtin_amdgcn_kernarg_segment_ptr(); c.lds = (LAS unsigned char*)lds_raw; c.tid = threadIdx.x; c.lane = c.tid & 63; c.wave = __builtin_amdgcn_readfirstlane(c.tid >> 6); c.nwg = gridDim.x; c.wg = blockIdx.x; c.ws = c.a->ws;
    volatile LAS unsigned* bst = (volatile LAS unsigned*)(c.lds + LDS_BYTES - 64);
    if (c.tid < 4) bst[c.tid] = 0u;
    __syncthreads();
    const XcdBarrier bar = xcd_barrier_post((unsigned*)(c.ws + WS_CTL) + CW_BAR, bst);
    const int lo = c.a->ph_lo, hi = c.a->ph_hi;
    bool route_ok = true;
#define SEAM(k) do { if (lo <= (k) && (k) + 1 < hi) xcd_barrier(bar); } while (0)
#define IN(k) (lo <= (k) && (k) < hi && (launder(c), true))
#define PH(k, call) do { if (IN(k)) { if (PROBE_PH == (k)) { int nrep_ = 3; asm volatile("" : "+s"(nrep_)); for (int rep_ = 0; rep_ < nrep_; ++rep_) { route_ok = (rep_ + 1 == nrep_); call; if (rep_ + 1 < nrep_) xcd_barrier(bar); } } else { call; } } SEAM(k); } while (0)
    PH(0, phase_prep(c));
    PH(1, phase_convert(c));
    PH(2, { phase_gemm_qkv(c); if (c.nwg == 256 && c.wg >= 138) convert_steal_n(c, 1, 3); });
    PH(3, phase_attn(c));
    PH(4, { phase_gemm_f32(c, (const bf16_t*)(c.ws + WS_O), R, (const bf16_t*)(c.ws + WS_WO), D, nullptr, (bf16_t*)(c.ws + WS_RAW1)); if (c.nwg == 256 && c.wg >= 16) convert_steal_n(c, 1, 2); });
    PH(5, { phase_postmix<128>(c, 0, route_ok); convert_steal(c, 1); });
    PH(6, phase_moe_gu(c, 0));
    PH(7, phase_moe_dn(c, 0));
    PH(8, phase_combine(c, 0));
    PH(9, { phase_gemm_inproj(c); if (c.nwg == 256 && c.wg >= 80) convert_steal_n(c, 2, 2); });
    PH(10, phase_hgrn_scan(c));
    PH(11, phase_hgrn_fold(c));
    PH(12, phase_hgrn_readout(c));
    PH(13, phase_gemm_f32(c, (const bf16_t*)(c.ws + WS_RR), L, (const bf16_t*)(c.ws + WS_WHO), D, nullptr, (bf16_t*)(c.ws + WS_RAW1)));
    PH(14, { phase_postmix<128>(c, 1, route_ok); convert_steal(c, 2); });
    PH(15, phase_moe_gu(c, 1));
    PH(16, phase_moe_dn(c, 1));
    PH(17, phase_combine(c, 1));
#undef IN
#undef PH
#undef SEAM
}

extern "C" void kernel_launch(void* const* d_in, const int* in_sizes, int n_in, void* d_out, int out_size, void* d_ws, size_t ws_size, hipStream_t stream) {
    static int grid = 0;
    if (grid == 0) {
        if (n_in != 21 || out_size != L * D || ws_size < WS_END) { fprintf(stderr, "kernel_launch: unexpected problem (n_in %d out %d ws %zu need %zu)\n", n_in, out_size, ws_size, (size_t)WS_END); grid = -1; return; }
        int dev = 0, cus = 0, per_cu = 0;
        hipGetDevice(&dev); hipDeviceGetAttribute(&cus, hipDeviceAttributeMultiprocessorCount, dev);
        if (hipFuncSetAttribute((const void*)mk_fwd, hipFuncAttributeMaxDynamicSharedMemorySize, LDS_BYTES) != hipSuccess) { fprintf(stderr, "kernel_launch: hipFuncSetAttribute failed\n"); grid = -1; return; }
        hipOccupancyMaxActiveBlocksPerMultiprocessor(&per_cu, (const void*)mk_fwd, 512, LDS_BYTES);
        if (per_cu < 1) fprintf(stderr, "kernel_launch: occupancy query says %d\n", per_cu);
        (void)hipGetLastError();
        grid = cus > 0 ? cus : 256;
    }
    if (grid < 0) return;
    hipMemsetAsync((char*)d_ws + WS_CTL, 0, MiB, stream);
    Args a{};
    for (int i = 0; i < 21; ++i) a.in[i] = (const float*)d_in[i];
    a.out = (float*)d_out; a.ws = (unsigned char*)d_ws;
    a.ph_lo = 0; a.ph_hi = NPHASE;
    hipLaunchKernelGGL(mk_fwd, dim3(grid), dim3(512), LDS_BYTES, stream, a);
}
```

```cpp
#include <hip/hip_runtime.h>
#include <cstdint>
#include <cstdio>

#define LAS __attribute__((address_space(3)))
typedef unsigned short bf16_t;
typedef short bf16x8 __attribute__((ext_vector_type(8)));
typedef float f32x4 __attribute__((ext_vector_type(4)));
typedef unsigned u32x4 __attribute__((ext_vector_type(4)));
typedef unsigned u32x2 __attribute__((ext_vector_type(2)));
typedef short v4i16_t __attribute__((ext_vector_type(4)));
typedef float f32x2 __attribute__((ext_vector_type(2)));

constexpr int D = 1024, L = 16384, C = 256, R = L + C;
constexpr int QKVD = 1280, HIN = 5120, NE = 32, TOPK = 4;
constexpr int PADM = 256, MAXROWS = 74752;
constexpr float EPS = 1e-6f;
constexpr float LOG2E = 1.4426950408889634f;
constexpr int NPHASE = 18;
#ifndef GEMM_REP
#define GEMM_REP 1
#endif
#ifndef PROBE_NOEPI
#define PROBE_NOEPI 0
#endif
#ifndef PROBE_SHORTK
#define PROBE_SHORTK 0
#endif
#ifndef SCAN_REP
#define SCAN_REP 1
#endif
#ifndef PROBE_PH
#define PROBE_PH (-1)
#endif
constexpr int LDS_BYTES = 147456;

constexpr size_t MiB = 1u << 20;
constexpr size_t al(size_t x) { return (x + MiB - 1) / MiB * MiB; }
constexpr size_t WS_CTL = 0;
constexpr size_t WS_MOD = WS_CTL + MiB;
constexpr size_t WS_X = WS_MOD + MiB;
constexpr size_t WS_H = WS_X + al((size_t)R * D * 4);
constexpr size_t WS_Q = WS_H + al((size_t)R * D * 2);
constexpr size_t WS_K = WS_Q + al((size_t)R * D * 2);
constexpr size_t WS_V = WS_K + al((size_t)R * 128 * 2);
constexpr size_t WS_O = WS_V + al((size_t)R * 128 * 2);
constexpr size_t WS_TK = WS_O + al((size_t)R * D * 2);
constexpr size_t WS_LIST = WS_TK + MiB;
constexpr size_t WS_HDN = WS_LIST + 3 * MiB;
constexpr size_t WS_RAW1 = WS_HDN + al((size_t)MAXROWS * 1024 * 2);
constexpr size_t WS_X1 = WS_RAW1 + al((size_t)R * D * 4);
constexpr size_t WS_OUTB = WS_X1 + al((size_t)R * D * 4);
constexpr size_t WS_QH = WS_OUTB + al((size_t)MAXROWS * 1024 * 2);
constexpr size_t WS_KF = WS_QH + al((size_t)L * D * 2);
constexpr size_t WS_KB = WS_KF + al((size_t)R * D * 2);
constexpr size_t WS_IV = WS_KB + al((size_t)R * D * 2);
constexpr size_t WS_SG = WS_IV + al((size_t)R * D * 2);
constexpr size_t WS_OF = WS_SG + al((size_t)L * D * 2);
constexpr size_t WS_OB = WS_OF + al((size_t)L * D * 4);
constexpr size_t WS_RR = WS_OB + al((size_t)L * D * 4);
constexpr size_t WS_WQKV = WS_RR + al((size_t)L * D * 2);
constexpr size_t WS_WO = WS_WQKV + al((size_t)QKVD * D * 2);
constexpr size_t WS_WIN = WS_WO + al((size_t)D * D * 2);
constexpr size_t WS_WHO = WS_WIN + al((size_t)HIN * D * 2);
constexpr size_t WS_WGU = WS_WHO + al((size_t)D * D * 2);
constexpr size_t WS_WDN = WS_WGU + al((size_t)2 * NE * 2048 * D * 2);
constexpr size_t WS_QSF = WS_WDN + al((size_t)2 * NE * 1024 * D * 2);
constexpr size_t WS_QSB = WS_QSF + al((size_t)L * D * 2);
constexpr size_t WS_DS = WS_QSB + al((size_t)L * D * 2);
constexpr size_t WS_DG = WS_DS + al((size_t)256 * 128 * 128 * 4);
constexpr size_t WS_SST = WS_DG + MiB;
constexpr size_t WS_H8 = WS_SST + al((size_t)256 * 128 * 128 * 2);
constexpr size_t WS_END = WS_H8 + al((size_t)R * D);
static_assert(WS_END <= (size_t)2048 * MiB, "workspace map exceeds 4x the largest input");
constexpr int CW_CNT = 1024;
constexpr int CW_CONV = 2048;
constexpr int CW_BAR = 4096;
constexpr int MOD_ROPE = 32768;
constexpr int MOD_LB = 49152;

struct Args { const float* in[21]; float* out; unsigned char* ws; int ph_lo, ph_hi; };

__device__ __forceinline__ unsigned f2bf(float f) { unsigned u = __float_as_uint(f); return (u + 0x7fffu + ((u >> 16) & 1u)) >> 16; }
typedef float f32x2_t __attribute__((ext_vector_type(2))); typedef __bf16 bf16x2_t __attribute__((ext_vector_type(2)));
__device__ __forceinline__ unsigned pk2(float lo, float hi) { f32x2_t v = {lo, hi}; bf16x2_t b = __builtin_convertvector(v, bf16x2_t); return __builtin_bit_cast(unsigned, b); }
__device__ __forceinline__ unsigned pk4_fp8(float a, float b, float c, float d) {
    a = fminf(fmaxf(a, -448.f), 448.f); b = fminf(fmaxf(b, -448.f), 448.f); c = fminf(fmaxf(c, -448.f), 448.f); d = fminf(fmaxf(d, -448.f), 448.f);
    int v = __builtin_amdgcn_cvt_pk_fp8_f32(a, b, 0, false); v = __builtin_amdgcn_cvt_pk_fp8_f32(c, d, v, true); return (unsigned)v; }
constexpr float F8_SH = 8.f, F8_SW = 64.f, F8_SHD = 4.f, F8_SO = 16.f;
__device__ __forceinline__ float bflo(unsigned u) { return __uint_as_float(u << 16); }
__device__ __forceinline__ float bfhi(unsigned u) { return __uint_as_float(u & 0xffff0000u); }
__device__ __forceinline__ float bf2f(bf16_t b) { return __uint_as_float(((unsigned)b) << 16); }
__device__ __forceinline__ float xadd16(float x) { const auto a = __builtin_amdgcn_permlane16_swap(__float_as_uint(x), __float_as_uint(x), false, false); return __uint_as_float(a[0]) + __uint_as_float(a[1]); }
__device__ __forceinline__ float xadd32(float x) { const auto a = __builtin_amdgcn_permlane32_swap(__float_as_uint(x), __float_as_uint(x), false, false); return __uint_as_float(a[0]) + __uint_as_float(a[1]); }
__device__ __forceinline__ float xmax16(float x) { const auto a = __builtin_amdgcn_permlane16_swap(__float_as_uint(x), __float_as_uint(x), false, false); return fmaxf(__uint_as_float(a[0]), __uint_as_float(a[1])); }
__device__ __forceinline__ float xmax32(float x) { const auto a = __builtin_amdgcn_permlane32_swap(__float_as_uint(x), __float_as_uint(x), false, false); return fmaxf(__uint_as_float(a[0]), __uint_as_float(a[1])); }
__device__ __forceinline__ float wave_sum(float v) {
#pragma unroll
    for (int o = 8; o > 0; o >>= 1) v += __shfl_xor(v, o);
    return xadd32(xadd16(v));
}
__device__ __forceinline__ float silu_f(float x) { return x / (1.f + __expf(-x)); }
__device__ __forceinline__ float sigmoid_f(float x) { return 1.f / (1.f + __expf(-x)); }

typedef const __attribute__((address_space(4))) Args* CArgs;
struct Ctx {
    CArgs a;
    LAS unsigned char* lds;
    int tid, lane, wave, nwg, wg;
    unsigned char* ws;
    __device__ __forceinline__ float* modp(int layer, int which) const { return (float*)(ws + WS_MOD) + (layer * 2 + which) * 6144; }
    __device__ __forceinline__ const float* xin0(int r) const { return r < C ? a->in[2] + (size_t)r * D : a->in[0] + (size_t)(r - C) * D; }
};


namespace pg8 {
constexpr int BM = 256, BK = 64, HALF = 128, HTB = HALF * BK * 2, STAGE_BYTES = 8 * HTB, KD = 1024, NXCD = 8, WGM = 8;
__device__ __forceinline__ int lds_byte(int r, int c) { const int st = (r >> 4) * 2 + (c >> 5), rr = r & 15, cc = c & 31, ob = rr * 64 + cc * 2; return st * 1024 + (ob ^ (((ob >> 9) & 1) << 5)); }
__device__ __forceinline__ void stage_rc(int b, int& Rr, int& Cc) { const int st = b / 1024, sb = b % 1024, swz = sb ^ (((sb >> 9) & 1) << 5); Rr = (st >> 1) * 16 + swz / 64; Cc = (st & 1) * 32 + (swz % 64) / 2; }
__device__ __forceinline__ int perm32(int rho) { const int n = rho >> 4, i = rho & 15; return 8 * (i >> 2) + 4 * n + (i & 3); }

struct Unit { int pm, pn, e, goff, gcnt; bool real; int amask, bmask; };
struct Gemm { const void* A; const void* Bt; size_t bstride; const int* list; };

struct StaticOrder {
    int nM, nN, nwg, G, c;
    __device__ __forceinline__ void init(int M, int N, int G_, int c_) { nM = M / BM; nN = N / BM; nwg = nM * nN; G = G_; c = c_; }
    __device__ __forceinline__ bool next(int i, Unit& u) const {
        const int F = nwg / G, Rm = nwg - F * G; int Lq; u.amask = 3; u.bmask = 3;
        if (i < F) Lq = i * G + c;
        else if (i == F && Rm > 0) {
            if (4 * Rm <= G) { if (c >= 4 * Rm) return false; Lq = F * G + (c >> 2); u.amask = 1 << ((c >> 1) & 1); u.bmask = 1 << (c & 1); }
            else if (2 * Rm <= G) { if (c >= 2 * Rm) return false; Lq = F * G + (c >> 1); u.bmask = 1 << (c & 1); }
            else { if (c >= Rm) return false; Lq = F * G + c; }
        } else return false;
        int wgid = Lq; { const int q = nwg / NXCD, r = nwg % NXCD, xcd = wgid % NXCD, off = wgid / NXCD; wgid = (xcd < r ? xcd * (q + 1) : r * (q + 1) + (xcd - r) * q) + off; }
        const int nig = WGM * nN, gid = wgid / nig, fm = gid * WGM, gsz = (nM - fm) < WGM ? (nM - fm) : WGM;
        u.pm = fm + ((wgid % nig) % gsz); u.pn = (wgid % nig) / gsz; u.e = 0; u.goff = 0; u.gcnt = 0; u.real = true; return true;
    }
};
struct MoeOrder {
    const LAS int* tp; const LAS int* cnt; int npn, G, vcu; bool split;
    __device__ __forceinline__ bool next(int i, Unit& u) const {
        const int tot = tp[32] * npn; int lin; u.amask = 3; u.bmask = 3; u.real = true;
        if (GEMM_REP > 1) { const int lin0 = i * G + vcu; if (lin0 >= tot * GEMM_REP) return false; lin = lin0 % tot; u.real = lin0 >= tot * (GEMM_REP - 1); }
        else {
            const int F = tot / G, Rm = tot - F * G;
            if (i < F) lin = i * G + vcu;
            else if (i == F && Rm > 0) {
                if (split && 2 * Rm <= G) { if (vcu >= 2 * Rm) return false; lin = F * G + (vcu >> 1); u.bmask = 1 << (vcu & 1); }
                else { if (vcu >= Rm) return false; lin = F * G + vcu; }
            } else return false;
        }
        const int rt = lin / npn; int e = 0;
#pragma unroll 8
        for (int k = 1; k < 32; ++k) e += (rt >= tp[k]) ? 1 : 0;
        const int mt = rt - tp[e];
        u.pm = rt; u.pn = lin - rt * npn; u.e = e; u.goff = e * R + mt * 256; u.gcnt = cnt[e] - mt * 256; return true;
    }
};

__device__ __forceinline__ void a_rows(const Gemm& g, const Unit& u, const int (&sR)[2], int (&rows)[2][2]) {
#pragma unroll
    for (int h = 0; h < 2; ++h)
#pragma unroll
        for (int i = 0; i < 2; ++i) { const int rr = h * HALF + sR[i]; rows[h][i] = rr < u.gcnt ? g.list[u.goff + rr] : 0; }
}
template <int KB>
__device__ __forceinline__ void a_offsets(const Gemm& g, const Unit& u, const int (&sR)[2], const int (&sC)[2], unsigned (&v)[2][2]) {
#pragma unroll
    for (int h = 0; h < 2; ++h)
#pragma unroll
        for (int i = 0; i < 2; ++i) {
            const int rr = h * HALF + sR[i]; int row;
            if (g.list) row = rr < u.gcnt ? g.list[u.goff + rr] : 0; else row = u.pm * BM + rr;
            v[h][i] = (unsigned)(row * KB + sC[i] * 2);
        }
}

struct EpiF32 {
    static constexpr bool LDSBIAS = false; static constexpr bool PERM = false;
    bf16_t* Cp; int ldc; const float* bias;
    __device__ __forceinline__ void operator()(const f32x4 (&acc)[2][2][4][2], const Unit& u, int wr, int wc, int fr, int fq, const LAS float* bl) const {
        const int row0 = u.pm * BM + wr * 64 + fr, col0 = u.pn * BM + wc * 32 + 4 * fq;
#pragma unroll
        for (int bj = 0; bj < 2; ++bj)
#pragma unroll
            for (int n = 0; n < 2; ++n) {
                const int col = col0 + bj * HALF + n * 16;
                if (!((u.bmask >> bj) & 1)) continue;
                const f32x4 bv = bias ? *(const f32x4*)(bias + col) : (f32x4){0.f, 0.f, 0.f, 0.f};
#pragma unroll
                for (int ai = 0; ai < 2; ++ai)
#pragma unroll
                    for (int m = 0; m < 4; ++m) if ((u.amask >> ai) & 1) { const f32x4 v = acc[ai][bj][m][n] + bv; u32x2 o; o.x = pk2(v[0], v[1]); o.y = pk2(v[2], v[3]);
                        *(u32x2*)(Cp + (size_t)(row0 + ai * HALF + m * 16) * ldc + col) = o; }
            }
    }
};
struct EpiSwiglu {
    static constexpr bool LDSBIAS = true; static constexpr bool PERM = true;
    unsigned char* Hd; const float* bgu;
    __device__ __forceinline__ const char* bias_base(const Unit& u) const { return (const char*)(bgu + (size_t)u.e * 2048 + u.pn * HALF); }
    __device__ __forceinline__ unsigned bias_voff(int lane) const { return (unsigned)(((lane >> 5) * 1024 + (lane & 31) * 4) * 4); }
    __device__ __forceinline__ void operator()(const f32x4 (&acc)[2][2][4][2], const Unit& u, int wr, int wc, int fr, int fq, const LAS float* bl) const {
        const int row0 = u.pm * BM + wr * 64 + fr, cg0 = u.pn * HALF + wc * 32 + 8 * fq;
        f32x4 bg[2], bu[2];
#pragma unroll
        for (int n = 0; n < 2; ++n) { bg[n] = *(const LAS f32x4*)(bl + wc * 32 + 8 * fq + 4 * n); bu[n] = *(const LAS f32x4*)(bl + 128 + wc * 32 + 8 * fq + 4 * n); }
#pragma unroll
        for (int ai = 0; ai < 2; ++ai)
#pragma unroll
            for (int m = 0; m < 4; ++m) {
                u32x2 o;
#pragma unroll
                for (int n = 0; n < 2; ++n) {
                    const f32x4 gv = acc[ai][0][m][n] * (1.f / (F8_SH * F8_SW)) + bg[n], uv = acc[ai][1][m][n] * (1.f / (F8_SH * F8_SW)) + bu[n]; float hv[4];
#pragma unroll
                    for (int q = 0; q < 4; ++q) { const float gg = fminf(gv[q], 7.f), uu = fminf(fmaxf(uv[q], -7.f), 7.f); hv[q] = gg * __builtin_amdgcn_rcpf(1.f + __builtin_amdgcn_exp2f(-1.702f * LOG2E * gg)) * (uu + 1.f); }
                    o[n] = pk4_fp8(hv[0] * F8_SHD, hv[1] * F8_SHD, hv[2] * F8_SHD, hv[3] * F8_SHD);
                }
                *(u32x2*)(Hd + (size_t)(row0 + ai * HALF + m * 16) * 1024 + cg0) = o;
            }
    }
};
struct EpiBf16Bias {
    static constexpr bool LDSBIAS = true; static constexpr bool PERM = true;
    unsigned char* Op; const float* bias; int bias_estride; float scale;
    __device__ __forceinline__ const char* bias_base(const Unit& u) const { return (const char*)(bias + (size_t)u.e * bias_estride + u.pn * BM); }
    __device__ __forceinline__ unsigned bias_voff(int lane) const { return (unsigned)(lane * 16); }
    __device__ __forceinline__ void operator()(const f32x4 (&acc)[2][2][4][2], const Unit& u, int wr, int wc, int fr, int fq, const LAS float* bl) const {
        const int row0 = u.pm * BM + wr * 64 + fr, col0 = u.pn * BM + wc * 32 + 8 * fq;
#pragma unroll
        for (int bj = 0; bj < 2; ++bj) {
            const int col = col0 + bj * HALF;
            if (!((u.bmask >> bj) & 1)) continue;
            const f32x4 b0 = *(const LAS f32x4*)(bl + bj * HALF + wc * 32 + 8 * fq) * F8_SO, b1 = *(const LAS f32x4*)(bl + bj * HALF + wc * 32 + 8 * fq + 4) * F8_SO;
#pragma unroll
            for (int ai = 0; ai < 2; ++ai)
#pragma unroll
                for (int m = 0; m < 4; ++m) { if (!((u.amask >> ai) & 1)) continue; const f32x4 v0 = acc[ai][bj][m][0] * (scale * F8_SO) + b0, v1 = acc[ai][bj][m][1] * (scale * F8_SO) + b1;
                    u32x2 o; o.x = pk4_fp8(v0[0], v0[1], v0[2], v0[3]); o.y = pk4_fp8(v1[0], v1[1], v1[2], v1[3]);
                    *(u32x2*)(Op + (size_t)(row0 + ai * HALF + m * 16) * 1024 + col) = o; }
        }
    }
};
struct EpiQKV {
    static constexpr bool LDSBIAS = false; static constexpr bool PERM = false;
    bf16_t* Qp; bf16_t* Kp; bf16_t* Vp; const float* bias; const float* tab;
    __device__ __forceinline__ void operator()(const f32x4 (&acc)[2][2][4][2], const Unit& u, int wr, int wc, int fr, int fq, const LAS float* bl) const {
        const bool lat = u.pm > 0; const float qs = 0.125f * LOG2E;
#pragma unroll
        for (int bj = 0; bj < 2; ++bj) {
            const int colt = u.pn * BM + bj * HALF + wc * 32 + 4 * fq;
            const f32x4 b1 = *(const f32x4*)(bias + colt), b2 = *(const f32x4*)(bias + colt + 16);
            const bool isv = (u.pn == 4) && (bj == 1);
            if (!((u.bmask >> bj) & 1)) continue;
#pragma unroll
            for (int ai = 0; ai < 2; ++ai)
#pragma unroll
                for (int m = 0; m < 4; ++m) {
                    if (!((u.amask >> ai) & 1)) continue;
                    const int r = u.pm * BM + ai * HALF + wr * 64 + m * 16 + fr, t = r - C;
                    f32x4 x1 = acc[ai][bj][m][0] + b1, x2 = acc[ai][bj][m][1] + b2;
                    if (lat && !isv) {
                        const int pos = (wc & 1) ? (t & 63) : (t >> 6);
                        const f32x4 t0 = *(const f32x4*)(tab + (pos * 16 + 4 * fq) * 2), t1 = *(const f32x4*)(tab + (pos * 16 + 4 * fq) * 2 + 4);
                        const float cs[4] = {t0[0], t0[2], t1[0], t1[2]}, sn[4] = {t0[1], t0[3], t1[1], t1[3]};
                        f32x4 o1, o2;
#pragma unroll
                        for (int e = 0; e < 4; ++e) { o1[e] = x1[e] * cs[e] - x2[e] * sn[e]; o2[e] = x2[e] * cs[e] + x1[e] * sn[e]; }
                        x1 = o1; x2 = o2;
                    }
                    u32x2 w1, w2;
                    if (u.pn < 4) {
                        w1.x = pk2(x1[0] * qs, x1[1] * qs); w1.y = pk2(x1[2] * qs, x1[3] * qs); w2.x = pk2(x2[0] * qs, x2[1] * qs); w2.y = pk2(x2[2] * qs, x2[3] * qs);
                        *(u32x2*)(Qp + (size_t)r * 1024 + colt) = w1; *(u32x2*)(Qp + (size_t)r * 1024 + colt + 16) = w2;
                    } else {
                        w1.x = pk2(x1[0], x1[1]); w1.y = pk2(x1[2], x1[3]); w2.x = pk2(x2[0], x2[1]); w2.y = pk2(x2[2], x2[3]);
                        bf16_t* dst = (bj == 0 ? Kp : Vp) + (size_t)r * 128 + wc * 32 + 4 * fq;
                        *(u32x2*)dst = w1; *(u32x2*)(dst + 16) = w2;
                    }
                }
        }
    }
};
struct EpiInProj {
    static constexpr bool LDSBIAS = false; static constexpr bool PERM = true;
    bf16_t* QH; _Float16* KF; _Float16* KB; bf16_t* IV; bf16_t* SG; const float* lb; float scale;
    __device__ __forceinline__ void operator()(const f32x4 (&acc)[2][2][4][2], const Unit& u, int wr, int wc, int fr, int fq, const LAS float* bl) const {
        const int seg = u.pn >> 2; const bool lat = u.pm > 0;
        if (!lat && (seg == 0 || seg == 4)) return;
        typedef _Float16 h8_t __attribute__((ext_vector_type(8)));
#pragma unroll
        for (int bj = 0; bj < 2; ++bj) {
            const int col = (u.pn & 3) * BM + bj * HALF + wc * 32 + 8 * fq;
            if (!((u.bmask >> bj) & 1)) continue;
            f32x4 lb0 = (f32x4){0.f, 0.f, 0.f, 0.f}, lb1 = lb0;
            if (seg == 1) { lb0 = *(const f32x4*)(lb + col); lb1 = *(const f32x4*)(lb + col + 4); } else if (seg == 2) { lb0 = *(const f32x4*)(lb + 1024 + col); lb1 = *(const f32x4*)(lb + 1024 + col + 4); }
#pragma unroll
            for (int ai = 0; ai < 2; ++ai)
#pragma unroll
                for (int m = 0; m < 4; ++m) {
                    if (!((u.amask >> ai) & 1)) continue;
                    const int r = u.pm * BM + ai * HALF + wr * 64 + m * 16 + fr; const f32x4 v0 = acc[ai][bj][m][0] * scale, v1 = acc[ai][bj][m][1] * scale;
                    if (seg == 1 || seg == 2) {
                        h8_t hv;
#pragma unroll
                        for (int e = 0; e < 4; ++e) { hv[e] = (_Float16)((1.f - lb0[e]) * __builtin_amdgcn_rcpf(1.f + __builtin_amdgcn_exp2f(LOG2E * v0[e]))); hv[4 + e] = (_Float16)((1.f - lb1[e]) * __builtin_amdgcn_rcpf(1.f + __builtin_amdgcn_exp2f(LOG2E * v1[e]))); }
                        *(h8_t*)((seg == 1 ? KF : KB) + (size_t)r * 1024 + col) = hv;
                    } else if (seg == 3) {
                        u32x4 o; o.x = pk2(v0[0], v0[1]); o.y = pk2(v0[2], v0[3]); o.z = pk2(v1[0], v1[1]); o.w = pk2(v1[2], v1[3]); *(u32x4*)(IV + (size_t)r * 1024 + col) = o;
                    } else {
                        float s0[4], s1[4];
#pragma unroll
                        for (int e = 0; e < 4; ++e) { s0[e] = v0[e] * __builtin_amdgcn_rcpf(1.f + __builtin_amdgcn_exp2f(-LOG2E * v0[e])); s1[e] = v1[e] * __builtin_amdgcn_rcpf(1.f + __builtin_amdgcn_exp2f(-LOG2E * v1[e])); }
                        u32x4 o; o.x = pk2(s0[0], s0[1]); o.y = pk2(s0[2], s0[3]); o.z = pk2(s1[0], s1[1]); o.w = pk2(s1[2], s1[3]); *(u32x4*)((seg == 0 ? QH : SG) + (size_t)(r - C) * 1024 + col) = o;
                    }
                }
        }
    }
};

typedef int v8i __attribute__((ext_vector_type(8)));
typedef int v4i __attribute__((ext_vector_type(4)));
template <class Epi, class Sched, bool ALIGN_EPI, bool GATHER, bool FP8>
__device__ __forceinline__ void gemm_phase(LAS unsigned char* lds, const Gemm g, const Sched& S, const Epi& E, const int tid) {
    const int wid = __builtin_amdgcn_readfirstlane(tid >> 6), lane = tid & 63, wr = wid >> 2, wc = wid & 3, fr = lane & 15, fq = lane >> 4;
    constexpr int KB = FP8 ? 1024 : 2048, nt = 1024 / (FP8 ? 128 : 64);
    int sR[2], sC[2]; unsigned voffB[2], voffA[2];
#pragma unroll
    for (int i = 0; i < 2; ++i) { stage_rc(tid * 16 + i * 8192, sR[i], sC[i]); const int Rb = Epi::PERM ? ((sR[i] & ~31) + perm32(sR[i] & 31)) : sR[i]; voffB[i] = (unsigned)(Rb * KB + sC[i] * 2); voffA[i] = (unsigned)(sR[i] * KB + sC[i] * 2); }
    constexpr size_t kstep = (size_t)(BK * 2), hstep = (size_t)HALF * KB, tstep = 2 * hstep;
    const unsigned ldsw = (unsigned)wid * 1024u;
    const int aoff = lds_byte(wr * 64 + fr, fq * 8), boff = lds_byte(wc * 32 + fr, fq * 8);
    const char* Ab = (const char*)g.A;
#define PG8_SA(b, h) (((b) * 2 + (h)) * HTB)
#define PG8_SB(b, h) ((4 + (b) * 2 + (h)) * HTB)
#define PG8_STAGE_B(bufoff, gbase) do { _Pragma("unroll") for (int _i = 0; _i < 2; ++_i) \
        __builtin_amdgcn_global_load_lds((const unsigned*)((const char*)(gbase) + voffB[_i]), (LAS unsigned*)(lds + (bufoff) + ldsw + _i * 8192), 16, 0, 0); } while (0)
#define PG8_STAGE_A(bufoff, kb, v, ubase) do { _Pragma("unroll") for (int _i = 0; _i < 2; ++_i) \
        __builtin_amdgcn_global_load_lds((const unsigned*)((GATHER ? Ab : (ubase)) + (size_t)(kb) + (GATHER ? (v)[_i] : voffA[_i])), (LAS unsigned*)(lds + (bufoff) + ldsw + _i * 8192), 16, 0, 0); } while (0)
#define PG8_LD8(p) __builtin_shufflevector(*(const LAS v4i*)(p), *(const LAS v4i*)((p) + 1024), 0, 1, 2, 3, 4, 5, 6, 7)
#define PG8_LDA(dst, b, h) do { if constexpr (FP8) { _Pragma("unroll") for (int m = 0; m < 4; ++m) dst##8[m] = PG8_LD8(lds + PG8_SA(b, h) + aoff + m * 2048); } else { _Pragma("unroll") for (int m = 0; m < 4; ++m) _Pragma("unroll") for (int k = 0; k < 2; ++k) dst[m][k] = *(const LAS bf16x8*)(lds + PG8_SA(b, h) + aoff + m * 2048 + k * 1024); } } while (0)
#define PG8_LDB(dst, b, h) do { if constexpr (FP8) { _Pragma("unroll") for (int n = 0; n < 2; ++n) dst##8[n] = PG8_LD8(lds + PG8_SB(b, h) + boff + n * 2048); } else { _Pragma("unroll") for (int n = 0; n < 2; ++n) _Pragma("unroll") for (int k = 0; k < 2; ++k) dst[n][k] = *(const LAS bf16x8*)(lds + PG8_SB(b, h) + boff + n * 2048 + k * 1024); } } while (0)
#define PG8_MMA(ai, bj, At, Bt) do { __builtin_amdgcn_s_setprio(1); if constexpr (FP8) { _Pragma("unroll") for (int m = 0; m < 4; ++m) _Pragma("unroll") for (int n = 0; n < 2; ++n) \
        asm volatile("v_mfma_scale_f32_16x16x128_f8f6f4 %0, %1, %2, %0, %3, %3 op_sel_hi:[0,0,0]" : "+v"(acc[ai][bj][m][n]) : "v"(Bt##8[n]), "v"(At##8[m]), "v"(unit_scale)); } else { \
        _Pragma("unroll") for (int m = 0; m < 4; ++m) _Pragma("unroll") for (int n = 0; n < 2; ++n) _Pragma("unroll") for (int k = 0; k < 2; ++k) \
        acc[ai][bj][m][n] = __builtin_amdgcn_mfma_f32_16x16x32_bf16(Bt[n][k], At[m][k], acc[ai][bj][m][n], 0, 0, 0); } __builtin_amdgcn_s_setprio(0); } while (0)
#define PG8_WAIT_V(n) asm volatile("s_waitcnt vmcnt(" #n ")" ::: "memory")
#define PG8_WAIT_L(n) asm volatile("s_waitcnt lgkmcnt(" #n ")" ::: "memory")
#define PG8_BAR __builtin_amdgcn_s_barrier()
#define PG8_SCHED __builtin_amdgcn_sched_barrier(0)
    Unit cur, nxt; int ui = 0;
    if (!S.next(0, cur)) return;
    unsigned cv[2][2]; int nvr[2][2];
    if constexpr (GATHER) a_offsets<KB>(g, cur, sR, sC, cv);
    const char* cA = Ab + (size_t)cur.pm * tstep; const char* nA = cA;
    f32x4 acc[2][2][4][2];
#pragma unroll
    for (int a = 0; a < 2; ++a)
#pragma unroll
        for (int b = 0; b < 2; ++b)
#pragma unroll
            for (int m = 0; m < 4; ++m)
#pragma unroll
                for (int n = 0; n < 2; ++n) acc[a][b][m][n] = (f32x4){0.f, 0.f, 0.f, 0.f};
    bf16x8 At[4][2], B0[2][2], B1[2][2]; v8i At8[4], B08[2], B18[2];
    int unit_scale = 0x7f7f7f7f; asm volatile("" : "+v"(unit_scale));
    const char* cB = (const char*)g.Bt + (size_t)cur.e * g.bstride + (size_t)cur.pn * tstep;
#define PG8_BIAS(uu, slot) do { if constexpr (Epi::LDSBIAS) { if (wid == 0) { int l_ = lane; asm volatile("" : "+v"(l_)); \
        __builtin_amdgcn_global_load_lds((const unsigned*)(E.bias_base(uu) + E.bias_voff(l_)), (LAS unsigned*)(lds + STAGE_BYTES + 4096 + (slot) * 1024), 16, 0, 0); } } } while (0)
    PG8_BIAS(cur, 0);
    PG8_STAGE_B(PG8_SB(0, 0), cB); PG8_STAGE_B(PG8_SB(0, 1), cB + hstep); PG8_STAGE_A(PG8_SA(0, 0), 0, cv[0], cA); PG8_STAGE_A(PG8_SA(0, 1), 0, cv[1], cA + hstep);
    if (wr == 1) PG8_BAR;
    PG8_WAIT_V(2); PG8_BAR;
    PG8_STAGE_B(PG8_SB(1, 0), cB + kstep); PG8_STAGE_A(PG8_SA(1, 0), kstep, cv[0], cA); PG8_STAGE_B(PG8_SB(1, 1), cB + hstep + kstep);
    PG8_WAIT_V(6); PG8_BAR;
    for (;;) {
        const bool has_next = S.next(ui + 1, nxt);
        const char* nB = cB;
        nA = cA;
        if (has_next) { PG8_BIAS(nxt, (ui + 1) % 3); if constexpr (GATHER) a_rows(g, nxt, sR, nvr); nA = Ab + (size_t)nxt.pm * tstep; nB = (const char*)g.Bt + (size_t)nxt.e * g.bstride + (size_t)nxt.pn * tstep; }

        const int ntr = (PROBE_SHORTK && !cur.real) ? 2 : nt;
        const bool m00 = (cur.amask & 1) && (cur.bmask & 1), m01 = (cur.amask & 1) && (cur.bmask & 2), m10 = (cur.amask & 2) && (cur.bmask & 1), m11 = (cur.amask & 2) && (cur.bmask & 2);
#pragma nounroll
        for (int t = 0; t < ntr; t += 2) {
            const bool last = (t == ntr - 2);
            if constexpr (GATHER) { if (last && has_next) asm volatile("" : "+v"(nvr[0][0]), "+v"(nvr[0][1]), "+v"(nvr[1][0]), "+v"(nvr[1][1])); }
            const size_t k1 = (size_t)(t + 1) * kstep, k2 = last ? 0 : (size_t)(t + 2) * kstep, k3 = k2 + kstep;
            const char* b2 = last ? nB : cB + (size_t)(t + 2) * kstep; const char* b3 = b2 + kstep;
            unsigned w0[2], w1[2];
            if constexpr (GATHER) {
#pragma unroll
                for (int i = 0; i < 2; ++i) { w0[i] = (last && has_next) ? (unsigned)(nvr[0][i] * KB + sC[i] * 2) : cv[0][i]; w1[i] = (last && has_next) ? (unsigned)(nvr[1][i] * KB + sC[i] * 2) : cv[1][i]; }
            }
            const char* a2 = last ? nA : cA;
            PG8_LDB(B0, 0, 0); PG8_LDB(B1, 0, 1); PG8_SCHED; PG8_LDA(At, 0, 0); PG8_STAGE_A(PG8_SA(1, 1), k1, cv[1], cA + hstep);
            PG8_WAIT_V(8); PG8_WAIT_L(0); PG8_BAR; if (m00) PG8_MMA(0, 0, At, B0); if (m01) PG8_MMA(0, 1, At, B1); PG8_BAR; PG8_SCHED;
            PG8_LDA(At, 0, 1); PG8_STAGE_B(PG8_SB(0, 0), b2); PG8_STAGE_B(PG8_SB(0, 1), b2 + hstep); PG8_STAGE_A(PG8_SA(0, 0), k2, w0, a2);
            PG8_WAIT_V(8); PG8_WAIT_L(0); PG8_BAR; if (m10) PG8_MMA(1, 0, At, B0); if (m11) PG8_MMA(1, 1, At, B1); PG8_BAR; PG8_SCHED;
            PG8_LDB(B0, 1, 0); PG8_LDB(B1, 1, 1); PG8_SCHED; PG8_LDA(At, 1, 0); PG8_STAGE_A(PG8_SA(0, 1), k2, w1, a2 + hstep);
            PG8_WAIT_V(8); PG8_WAIT_L(0); PG8_BAR; if (m00) PG8_MMA(0, 0, At, B0); if (m01) PG8_MMA(0, 1, At, B1); PG8_BAR; PG8_SCHED;
            PG8_LDA(At, 1, 1); PG8_STAGE_B(PG8_SB(1, 0), b3); PG8_STAGE_B(PG8_SB(1, 1), b3 + hstep); PG8_STAGE_A(PG8_SA(1, 0), k3, w0, a2);
            PG8_WAIT_V(8); PG8_WAIT_L(0); PG8_BAR; if (m10) PG8_MMA(1, 0, At, B0); if (m11) PG8_MMA(1, 1, At, B1); PG8_BAR; PG8_SCHED;
        }
        if constexpr (ALIGN_EPI) { if (wr == 0) PG8_BAR; }
        if constexpr (FP8) asm volatile("s_nop 15\n\ts_nop 15" ::: "memory");
        if (!PROBE_NOEPI || cur.real) E(acc, cur, wr, wc, fr, fq, (const LAS float*)(lds + STAGE_BYTES + 4096 + (ui % 3) * 1024));
        if (!has_next) break;
#pragma unroll
        for (int a = 0; a < 2; ++a)
#pragma unroll
            for (int b = 0; b < 2; ++b)
#pragma unroll
                for (int m = 0; m < 4; ++m)
#pragma unroll
                    for (int n = 0; n < 2; ++n) acc[a][b][m][n] = (f32x4){0.f, 0.f, 0.f, 0.f};
        cur = nxt; cB = nB; cA = nA; ++ui;
        if constexpr (GATHER) {
#pragma unroll
            for (int h = 0; h < 2; ++h)
#pragma unroll
                for (int i = 0; i < 2; ++i) cv[h][i] = (unsigned)(nvr[h][i] * KB + sC[i] * 2);
        }
        if constexpr (ALIGN_EPI) { if (wr == 1) PG8_BAR; }
    }
    PG8_WAIT_V(0);
    if constexpr (!ALIGN_EPI) { if (wr == 0) PG8_BAR; }
    PG8_BAR;
#undef PG8_SA
#undef PG8_SB
#undef PG8_STAGE_A
#undef PG8_STAGE_B
#undef PG8_LDA
#undef PG8_BIAS
#undef PG8_LD8
#undef PG8_LDB
#undef PG8_MMA
#undef PG8_WAIT_V
#undef PG8_WAIT_L
#undef PG8_BAR
#undef PG8_SCHED
}
}

struct TBlk { const float* src; int ldw; bf16_t* dst; unsigned char* dst8; };
__device__ __forceinline__ void tb_load(const TBlk& t, int lane, f32x4 (&v)[16]) {
    const float* p = t.src + (size_t)(lane >> 4) * t.ldw + (lane & 15) * 4;
#pragma unroll
    for (int i = 0; i < 16; ++i) v[i] = *(const f32x4*)(p + (size_t)(4 * i) * t.ldw);
}
__device__ __forceinline__ void tb_store(const TBlk& t, int lane, const f32x4 (&v)[16], LAS float* scr) {
#pragma unroll
    for (int i = 0; i < 16; ++i) { LAS float* d = scr + ((lane >> 4) + 4 * i) * 65 + (lane & 15) * 4; d[0] = v[i].x; d[1] = v[i].y; d[2] = v[i].z; d[3] = v[i].w; }
    asm volatile("s_waitcnt lgkmcnt(0)" ::: "memory"); __builtin_amdgcn_wave_barrier();
    const int c8 = lane & 7;
#pragma unroll
    for (int jj = 0; jj < 8; ++jj) {
        const int n = (lane >> 3) + 8 * jj; const LAS float* p = scr + (8 * c8) * 65 + n;
        if (t.dst8) { u32x2 o; o.x = pk4_fp8(p[0] * F8_SW, p[65] * F8_SW, p[2 * 65] * F8_SW, p[3 * 65] * F8_SW); o.y = pk4_fp8(p[4 * 65] * F8_SW, p[5 * 65] * F8_SW, p[6 * 65] * F8_SW, p[7 * 65] * F8_SW);
            *(u32x2*)(t.dst8 + (size_t)n * 1024 + 8 * c8) = o; }
        else { u32x4 o; o.x = pk2(p[0], p[65]); o.y = pk2(p[2 * 65], p[3 * 65]); o.z = pk2(p[4 * 65], p[5 * 65]); o.w = pk2(p[6 * 65], p[7 * 65]);
            *(u32x4*)(t.dst + (size_t)n * 1024 + 8 * c8) = o; }
    }
    asm volatile("s_waitcnt lgkmcnt(0)" ::: "memory"); __builtin_amdgcn_wave_barrier();
}

__device__ __forceinline__ void phase_prep(const Ctx& c) {
    LAS float* red = (LAS float*)c.lds;
    LAS float* sil = red + 1024;
    const float* cv = c.a->in[1]; const float* ccv = c.a->in[3]; const float* ada_w = c.a->in[4]; const float* ada_b = c.a->in[5];
    for (int i = c.tid; i < 2048; i += 512) { const float x = i < 1024 ? cv[i] : ccv[i - 1024]; sil[i] = x * __builtin_amdgcn_rcpf(1.f + __builtin_amdgcn_exp2f(-LOG2E * x)); }
    __syncthreads();
    for (int item = c.wg; item < 193; item += c.nwg) {
        if (item < 192) {
            const int layer = item / 96, cb = item % 96, col = cb * 64 + c.lane;
            const float* W = ada_w + (size_t)layer * D * 6144 + col;
            float a0 = 0.f, a1 = 0.f;
            const int k0 = c.wave * 128;
#pragma unroll 32
            for (int k = 0; k < 128; ++k) { const float w = W[(size_t)(k0 + k) * 6144]; a0 += sil[k0 + k] * w; a1 += sil[1024 + k0 + k] * w; }
            red[(0 * 8 + c.wave) * 64 + c.lane] = a0; red[(1 * 8 + c.wave) * 64 + c.lane] = a1;
            __syncthreads();
            if (c.tid < 128) {
                const int which = c.tid >> 6, l = c.tid & 63; float s = 0.f;
#pragma unroll
                for (int w = 0; w < 8; ++w) s += red[(which * 8 + w) * 64 + l];
                c.modp(layer, which)[cb * 64 + l] = s + ada_b[layer * 6144 + cb * 64 + l];
            }
            __syncthreads();
        } else {
            float* modbase = (float*)(c.ws + WS_MOD);
            for (int i = c.tid; i < 4096; i += 512) {
                const int pos = i >> 4, j = i & 15;
                const double ang = (double)pos * pow(10000.0, -(double)j / 16.0);
                modbase[MOD_ROPE + 2 * i] = (float)cos(ang); modbase[MOD_ROPE + 2 * i + 1] = (float)sin(ang);
            }
            const float* lbp = c.a->in[12];
            for (int i = c.tid; i < 2048; i += 512) { const float p0 = lbp[i], p1 = lbp[2048 + i]; modbase[MOD_LB + i] = 1.f / (1.f + __expf(p0 - p1)); }
        }
    }
}

__device__ __forceinline__ void row_load(const float* p, int lane, f32x4 (&v)[4]) {
#pragma unroll
    for (int j = 0; j < 4; ++j) v[j] = *(const f32x4*)(p + lane * 4 + 256 * j);
}
__device__ __forceinline__ void row_load_bf(const bf16_t* p, int lane, f32x4 (&v)[4]) {
#pragma unroll
    for (int j = 0; j < 4; ++j) { const u32x2 w = *(const u32x2*)(p + lane * 4 + 256 * j); v[j] = (f32x4){bflo(w.x), bfhi(w.x), bflo(w.y), bfhi(w.y)}; }
}
__device__ __forceinline__ float row_ss(const f32x4 (&v)[4]) {
    float s = 0.f;
#pragma unroll
    for (int j = 0; j < 4; ++j) s += v[j].x * v[j].x + v[j].y * v[j].y + v[j].z * v[j].z + v[j].w * v[j].w;
    return wave_sum(s);
}
__device__ __forceinline__ void row_modnorm_store(const f32x4 (&x)[4], float rstd, const float* g, const float* sh, const float* sc, bf16_t* out, int lane, f32x4 (*hout)[4] = nullptr) {
#pragma unroll
    for (int j = 0; j < 4; ++j) {
        const int c0 = lane * 4 + 256 * j;
        const f32x4 gv = *(const f32x4*)(g + c0), shv = *(const f32x4*)(sh + c0), scv = *(const f32x4*)(sc + c0);
        f32x4 h;
        h.x = x[j].x * rstd * gv.x * (1.f + scv.x) + shv.x; h.y = x[j].y * rstd * gv.y * (1.f + scv.y) + shv.y;
        h.z = x[j].z * rstd * gv.z * (1.f + scv.z) + shv.z; h.w = x[j].w * rstd * gv.w * (1.f + scv.w) + shv.w;
        if (hout) (*hout)[j] = h;
        u32x2 o; o.x = pk2(h.x, h.y); o.y = pk2(h.z, h.w);
        *(u32x2*)(out + c0) = o;
    }
}

__device__ __forceinline__ void phase_norm0(const Ctx& c) {
    bf16_t* H = (bf16_t*)(c.ws + WS_H); const float* ng = c.a->in[6];
    int r = c.wg * 8 + c.wave;
    f32x4 xn[4];
    if (r < R) row_load(c.xin0(r), c.lane, xn);
    for (; r < R; r += c.nwg * 8) {
        f32x4 x[4];
#pragma unroll
        for (int j = 0; j < 4; ++j) x[j] = xn[j];
        if (r + c.nwg * 8 < R) row_load(c.xin0(r + c.nwg * 8), c.lane, xn);
        const float rstd = rsqrtf(row_ss(x) * (1.f / D) + EPS);
        const float* m = c.modp(0, r < C ? 1 : 0);
        row_modnorm_store(x, rstd, ng, m + 0, m + 1024, H + (size_t)r * D, c.lane);
    }
}

namespace at {
__device__ __forceinline__ float max3f(float a, float b, float c) { return __builtin_fmaxf(__builtin_fmaxf(a, b), c); }
constexpr int KP = 144, TILEB = 64 * KP;
__device__ __forceinline__ bf16x8 tr_frag2(const LAS unsigned char* tile, int row0, int col0, int lane) {
    const int q = (lane & 15) >> 2, p = lane & 3;
    const LAS unsigned char* a = tile + (row0 + q) * KP + (col0 + 4 * p) * 2;
    const v4i16_t lo = __builtin_amdgcn_ds_read_tr16_b64_v4i16((LAS v4i16_t*)a);
    const v4i16_t hi = __builtin_amdgcn_ds_read_tr16_b64_v4i16((LAS v4i16_t*)(a + 16 * KP));
    return (bf16x8){lo[0], lo[1], lo[2], lo[3], hi[0], hi[1], hi[2], hi[3]};
}
}
__device__ __forceinline__ void phase_attn(const Ctx& c) {
    using namespace at;
    const bf16_t* Q = (const bf16_t*)(c.ws + WS_Q); const bf16_t* K = (const bf16_t*)(c.ws + WS_K); const bf16_t* V = (const bf16_t*)(c.ws + WS_V);
    bf16_t* O = (bf16_t*)(c.ws + WS_O); const float* sink = c.a->in[9];
    LAS unsigned char* lds = c.lds;
    const int tid = c.tid, lane = c.lane, w = __builtin_amdgcn_readfirstlane(tid >> 6), fr = lane & 15, g = lane >> 4;
    const int lrow = tid >> 3, lch = tid & 7;
    const int nitn = c.nwg == 256 ? 2 : (264 - c.wg + c.nwg - 1) / c.nwg;
    for (int itn = 0; itn < nitn; ++itn) {
        int item = c.wg + itn * c.nwg;
        if (c.nwg == 256 && itn == 1) { const int n_ = c.wg >> 1; item = -1;
            if (n_ == 0) item = 256 + (c.wg & 1); else if (n_ == 127) item = 258 + (c.wg & 1); else if (n_ == 30 || n_ == 31) item = 260 + (c.wg - 60); }
        if (item < 0 || item >= 264) continue;
        const bool isctx = item >= 256;
        const int ci = item - 256;
        const int n = isctx ? 0 : (item >> 1), kh = isctx ? ((ci >> 1) & 1) : (item & 1), cb = isctx ? (ci >> 2) : 0;
        const int p_lo = isctx ? (ci & 1) : 0, p_hi = isctx ? (ci & 1) + 1 : 2;
        const int hq = kh * 8 + w;
        const float sink2 = sink[hq] * LOG2E;
        for (int pass = p_lo; pass < p_hi; ++pass) {
            const int t0 = 128 * n + 64 * pass, qrow0 = isctx ? cb * 128 + 64 * pass : C + t0;
            const int jlo = isctx ? 0 : (t0 >= 128 ? 0 : (128 - t0) / 64), jhi = isctx ? 0 : ((L - t0 + 128) / 64 < 5 ? (L - t0 + 128) / 64 : 5);
            const int ntile = 4 + (jhi - jlo);
            LAS unsigned char* qlds = lds + 4 * TILEB + w * TILEB;
#pragma unroll
            for (int qb = 0; qb < 4; ++qb)
#pragma unroll
                for (int ks = 0; ks < 2; ++ks) *(LAS bf16x8*)(qlds + (16 * qb + fr) * KP + (32 * ks + 8 * g) * 2) = *(const bf16x8*)(Q + (size_t)(qrow0 + 16 * qb + fr) * D + hq * 64 + 32 * ks + 8 * g);
            float mrow[4], lsum[4]; f32x4 OT[4][4];
#pragma unroll
            for (int qb = 0; qb < 4; ++qb) { mrow[qb] = sink2; lsum[qb] = 1.f;
#pragma unroll
                for (int nt = 0; nt < 4; ++nt) OT[qb][nt] = (f32x4){0.f, 0.f, 0.f, 0.f}; }
            u32x4 kreg, vreg;
#define AT_KROW(ti) ((ti) < 4 ? 64 * (ti) : C + t0 - 128 + 64 * (jlo + (ti) - 4))
#define AT_LOAD(ti) do { const size_t ro_ = (size_t)(AT_KROW(ti) + lrow) * 128 + kh * 64 + lch * 8; kreg = *(const u32x4*)(K + ro_); vreg = *(const u32x4*)(V + ro_); } while (0)
#define AT_WRITE(buf) do { *(LAS u32x4*)(lds + (buf) * 2 * TILEB + lrow * KP + lch * 16) = kreg; *(LAS u32x4*)(lds + (buf) * 2 * TILEB + TILEB + lrow * KP + lch * 16) = vreg; } while (0)
            AT_LOAD(0); AT_WRITE(0);
            __syncthreads();
            for (int ti = 0; ti < ntile; ++ti) {
                if (ti + 1 < ntile) AT_LOAD(ti + 1);
                const LAS unsigned char* kb = lds + (ti & 1) * 2 * TILEB; const LAS unsigned char* vb = kb + TILEB;
                const int jj = jlo + ti - 4; const bool mlo_t = (ti >= 4) && jj == 0, mup_t = (ti >= 4) && jj == 4;
                const float fl = mlo_t ? -INFINITY : 0.f, fu = mup_t ? -INFINITY : 0.f;
                const f32x4 mlow = (f32x4){fl, fl, fl, fl}, mup = (f32x4){fu, fu, fu, fu};
                f32x4 mdiag;
#pragma unroll
                for (int e = 0; e < 4; ++e) mdiag[e] = (mlo_t && fr > 4 * g + e) || (mup_t && fr < 4 * g + e) ? -INFINITY : 0.f;
                bf16x8 Kf[4][2];
#pragma unroll
                for (int mt = 0; mt < 4; ++mt)
#pragma unroll
                    for (int ks = 0; ks < 2; ++ks) Kf[mt][ks] = *(const LAS bf16x8*)(kb + (16 * mt + fr) * KP + (32 * ks + 8 * g) * 2);
                bf16x8 Vf[4][2];
#pragma unroll
                for (int mt = 0; mt < 4; ++mt)
#pragma unroll
                    for (int ks = 0; ks < 2; ++ks)
                        Vf[mt][ks] = tr_frag2(vb, 32 * ks + 4 * g, 16 * mt, lane);
#define AT_QB(qb) do { \
                    bf16x8 Qq[2]; \
                    _Pragma("unroll") for (int ks = 0; ks < 2; ++ks) Qq[ks] = *(const LAS bf16x8*)(qlds + (16 * (qb) + fr) * KP + (32 * ks + 8 * g) * 2); \
                    f32x4 sa[4]; \
                    _Pragma("unroll") for (int mt = 0; mt < 4; ++mt) { sa[mt] = (qb) == mt ? mdiag : ((qb) > mt ? mlow : mup);     \
                        _Pragma("unroll") for (int ks = 0; ks < 2; ++ks) sa[mt] = __builtin_amdgcn_mfma_f32_16x16x32_bf16(Kf[mt][ks], Qq[ks], sa[mt], 0, 0, 0); } \
                    float mx = max3f(sa[0][0], sa[0][1], sa[0][2]), my = max3f(sa[0][3], sa[1][0], sa[1][1]); \
                    mx = max3f(mx, sa[1][2], sa[1][3]); my = max3f(my, sa[2][0], sa[2][1]); mx = max3f(mx, sa[2][2], sa[2][3]); my = max3f(my, sa[3][0], sa[3][1]); mx = max3f(mx, sa[3][2], sa[3][3]); \
                    mx = max3f(mx, my, mrow[qb]); \
                    const float mn = xmax32(xmax16(mx)); \
                    const float alpha = __builtin_amdgcn_exp2f(mrow[qb] - mn); \
                    mrow[qb] = mn; \
                    float rs = 0.f; \
                    _Pragma("unroll") for (int mt = 0; mt < 4; ++mt) _Pragma("unroll") for (int e = 0; e < 4; ++e) { const float pv = __builtin_amdgcn_exp2f(sa[mt][e] - mn); sa[mt][e] = pv; rs += pv; } \
                    rs = xadd32(xadd16(rs)); \
                    lsum[qb] = lsum[qb] * alpha + rs; \
                    bf16x8 Pb[2]; \
                    _Pragma("unroll") for (int ks = 0; ks < 2; ++ks) { const f32x4 a0 = sa[2 * ks], a1 = sa[2 * ks + 1]; \
                        const u32x4 pk = (u32x4){pk2(a0[0], a0[1]), pk2(a0[2], a0[3]), pk2(a1[0], a1[1]), pk2(a1[2], a1[3])}; Pb[ks] = __builtin_bit_cast(bf16x8, pk); } \
                    _Pragma("unroll") for (int nt = 0; nt < 4; ++nt) { OT[qb][nt] = OT[qb][nt] * alpha; \
                        _Pragma("unroll") for (int ks = 0; ks < 2; ++ks) OT[qb][nt] = __builtin_amdgcn_mfma_f32_16x16x32_bf16(Vf[nt][ks], Pb[ks], OT[qb][nt], 0, 0, 0); } } while (0)
                AT_QB(0); AT_QB(1); AT_QB(2); AT_QB(3);
#undef AT_QB
                if (ti + 1 < ntile) AT_WRITE((ti + 1) & 1);
                __syncthreads();
            }
#undef AT_KROW
#undef AT_LOAD
#undef AT_WRITE
#pragma unroll
            for (int qb = 0; qb < 4; ++qb) {
                const float il = 1.f / lsum[qb];
                bf16_t* op = O + (size_t)(qrow0 + 16 * qb + fr) * D + hq * 64 + 4 * g;
#pragma unroll
                for (int nt = 0; nt < 4; ++nt) { const f32x4 v = OT[qb][nt] * il; u32x2 o; o.x = pk2(v[0], v[1]); o.y = pk2(v[2], v[3]); *(u32x2*)(op + 16 * nt) = o; }
            }
        }
    }
}

template <int GS>
__device__ __forceinline__ void phase_postmix(const Ctx& c, int layer, bool route) {
    const bf16_t* Y = (const bf16_t*)(c.ws + WS_RAW1); unsigned char* H8 = c.ws + WS_H8;
    bf16_t* Xout = (bf16_t*)(c.ws + (layer == 0 ? WS_X : WS_X1)); const bf16_t* Xprev = (const bf16_t*)(c.ws + WS_X);
    const float* ng = c.a->in[6] + layer * 4 * D; const float* Wr = c.a->in[15] + (size_t)layer * D * NE; const float* br = c.a->in[16] + layer * NE;
    unsigned* cnt = (unsigned*)(c.ws + WS_CTL) + CW_CNT + layer * NE;
    int* tk_e = (int*)(c.ws + WS_TK); float* tk_g = (float*)(c.ws + WS_TK) + R * 4; int* tk_slot = (int*)(c.ws + WS_TK) + 2 * R * 4;
    int* list = (int*)(c.ws + WS_LIST);
    LAS float* WL = (LAS float*)c.lds;
    LAS float* biasp = (LAS float*)(c.lds + 131072);
    LAS unsigned* lcnt = (LAS unsigned*)(c.lds + 145920); LAS unsigned* lbase = lcnt + 32; LAS float* rsx = (LAS float*)(lcnt + 64);
    LAS float* pvA = (LAS float*)(c.lds + 131072 + 2560); LAS float* pvB = pvA + 1024; LAS float* pvS = pvB + 1024;
    const int lane = c.lane, w = __builtin_amdgcn_readfirstlane(c.tid >> 6), fr = lane & 15, g = lane >> 4;
    constexpr int RP = GS / 8, NW2 = GS / 16;
    const int g_lo = layer == 0 ? 0 : C / GS;
    for (int grp = g_lo + c.wg; grp < R / GS; grp += c.nwg) {
        const int which = grp * GS < C ? 1 : 0;
        const float* m = c.modp(layer, which);
        __syncthreads();
        if (c.tid < NE) lcnt[c.tid] = 0u;
#pragma unroll 4
        for (int j = 0; j < 16; ++j) {
            const int i4 = c.tid + 512 * j, k = i4 >> 3, e0 = (i4 & 7) * 4;
            const f32x4 wv = *(const f32x4*)(Wr + (size_t)k * NE + e0); const float sc = ng[2 * D + k] * (1.f + m[4096 + k]);
            LAS float* dst = WL + ((((k >> 4) * 4 + (k & 3)) * 4 + ((k >> 2) & 3)) * 16) * 2;
#pragma unroll
            for (int q = 0; q < 4; ++q) { const int e = e0 + q; dst[(e & 15) * 2 + (e >> 4)] = wv[q] * sc; }
        }
        for (int k = c.tid; k < D; k += 512) { pvA[k] = m[2048 + k] * ng[D + k]; pvB[k] = ng[2 * D + k] * (1.f + m[4096 + k]); pvS[k] = m[3072 + k]; }
        { const int e = c.tid & 31, part = c.tid >> 5; float sacc = 0.f;
#pragma unroll 16
          for (int k = part * 64; k < part * 64 + 64; ++k) sacc += m[3072 + k] * Wr[k * NE + e];
          biasp[32 + part * 32 + e] = sacc; }
        __syncthreads();
        if (c.tid < 32) { float sacc = br[c.tid];
#pragma unroll
            for (int p = 0; p < 16; ++p) sacc += biasp[32 + p * 32 + c.tid]; biasp[c.tid] = sacc; }
        __syncthreads();
        const int row1 = grp * GS + w * RP;
        f32x4 y0[4], x0[4], y1[4], x1[4], yn0[4], xn0[4], yn1[4], xn1[4];
#define PM_LOAD(RW, YY, XX) do { row_load_bf(Y + (size_t)(layer == 0 ? (RW) : (RW) - C) * D, lane, YY); if (layer == 0) row_load(c.xin0(RW), lane, XX); else row_load_bf(Xprev + (size_t)(RW) * D, lane, XX); } while (0)
#define PM_ROW(RW, YY, XX, II) do { \
            const float rstd_y = rsqrtf(row_ss(YY) * (1.f / D) + EPS); \
            _Pragma("unroll") for (int j = 0; j < 4; ++j) { const int c0 = lane * 4 + 256 * j; \
                XX[j] += *(const LAS f32x4*)(pvA + c0) * (YY[j] * rstd_y); \
                u32x2 xo; xo[0] = pk2(XX[j][0], XX[j][1]); xo[1] = pk2(XX[j][2], XX[j][3]); *(u32x2*)(Xout + (size_t)(RW) * D + c0) = xo; \
                XX[j] = (f32x4){bflo(xo[0]), bfhi(xo[0]), bflo(xo[1]), bfhi(xo[1])}; }     \
            const float rstd_x = rsqrtf(row_ss(XX) * (1.f / D) + EPS); \
            _Pragma("unroll") for (int j = 0; j < 4; ++j) { const int c0 = lane * 4 + 256 * j; \
                const f32x4 hv = XX[j] * rstd_x * *(const LAS f32x4*)(pvB + c0) + *(const LAS f32x4*)(pvS + c0); \
                *(unsigned*)(H8 + (size_t)(RW) * D + c0) = pk4_fp8(hv[0] * F8_SH, hv[1] * F8_SH, hv[2] * F8_SH, hv[3] * F8_SH); } \
            if (lane == 0) rsx[w * RP + (II)] = rstd_x; } while (0)
        PM_LOAD(row1, yn0, xn0); PM_LOAD(row1 + 1, yn1, xn1);
        for (int i = 0; i < RP; i += 2) {
            const int r = row1 + i;
#pragma unroll
            for (int j = 0; j < 4; ++j) { y0[j] = yn0[j]; x0[j] = xn0[j]; y1[j] = yn1[j]; x1[j] = xn1[j]; }
            if (i + 2 < RP) { PM_LOAD(r + 2, yn0, xn0); PM_LOAD(r + 3, yn1, xn1); }
            PM_ROW(r, y0, x0, i);
            PM_ROW(r + 1, y1, x1, i + 1);
        }
#undef PM_LOAD
#undef PM_ROW
        asm volatile("s_waitcnt vmcnt(0)" ::: "memory");
        __syncthreads();
        const int row0 = grp * GS + w * 16; const bool w2 = w < NW2;
        f32x4 la[2]; la[0] = (f32x4){0.f, 0.f, 0.f, 0.f}; la[1] = la[0];
        if (w2) {
            const bf16_t* ap = Xout + (size_t)(row0 + fr) * D + 4 * g;
            const LAS float* bp = WL + (g * 16 + fr) * 2;
#pragma unroll 4
            for (int k4 = 0; k4 < 64; ++k4) {
                const u32x2 aw = *(const u32x2*)(ap + 16 * k4); const f32x4 a4 = (f32x4){bflo(aw.x), bfhi(aw.x), bflo(aw.y), bfhi(aw.y)};
#pragma unroll
                for (int q = 0; q < 4; ++q) {
                    const f32x2 b2 = *(const LAS f32x2*)(bp + (size_t)(4 * k4 + q) * 128);
                    la[0] = __builtin_amdgcn_mfma_f32_16x16x4f32(a4[q], b2[0], la[0], 0, 0, 0);
                    la[1] = __builtin_amdgcn_mfma_f32_16x16x4f32(a4[q], b2[1], la[1], 0, 0, 0);
                }
            }
        }
        float tv[4][4]; int te[4][4];
#pragma unroll
        for (int e = 0; e < 4; ++e) {
            const float rs = rsx[(w2 ? w * 16 : 0) + 4 * g + e];
            float v0 = la[0][e] * rs + biasp[fr], v1 = la[1][e] * rs + biasp[16 + fr];
#pragma unroll
            for (int k = 0; k < 4; ++k) {
                float bv; int bi;
                if (v0 >= v1) { bv = v0; bi = fr; } else { bv = v1; bi = 16 + fr; }
#pragma unroll
                for (int o = 8; o > 0; o >>= 1) {
                    const float ov = __shfl_xor(bv, o); const int oi = __shfl_xor(bi, o);
                    if (ov > bv || (ov == bv && oi < bi)) { bv = ov; bi = oi; }
                }
                tv[e][k] = bv; te[e][k] = bi;
                if (bi == fr) v0 = -INFINITY;
                if (bi == 16 + fr) v1 = -INFINITY;
            }
        }
        float v[4]; int ex[4]; unsigned sl[4];
#pragma unroll
        for (int k = 0; k < 4; ++k) { v[k] = tv[0][k]; ex[k] = te[0][k];
#pragma unroll
            for (int e = 1; e < 4; ++e) if (fr == e) { v[k] = tv[e][k]; ex[k] = te[e][k]; } }
        if (fr < 4 && route && w2) {
#pragma unroll
            for (int k = 0; k < 4; ++k) sl[k] = __hip_atomic_fetch_add(lcnt + ex[k], 1u, __ATOMIC_RELAXED, __HIP_MEMORY_SCOPE_WORKGROUP);
        }
        __syncthreads();
        if (c.tid < NE && route) { const unsigned n = lcnt[c.tid]; lbase[c.tid] = n ? atomicAdd(&cnt[c.tid], n) : 0u; }
        __syncthreads();
        if (fr < 4 && route && w2) {
            const int r = row0 + 4 * g + fr;
            const float e1 = __expf(v[1] - v[0]), e2 = __expf(v[2] - v[0]), e3 = __expf(v[3] - v[0]);
            const float inv = 1.f / (1.f + e1 + e2 + e3);
            const float gk[4] = {inv, e1 * inv, e2 * inv, e3 * inv};
#pragma unroll
            for (int k = 0; k < 4; ++k) {
                const unsigned slot = lbase[ex[k]] + sl[k];
                list[(size_t)ex[k] * R + slot] = r;
                tk_e[r * 4 + k] = ex[k]; tk_g[r * 4 + k] = gk[k]; tk_slot[r * 4 + k] = (int)slot;
            }
        }
    }
}

__device__ __forceinline__ void moe_offsets(const Ctx& c, int layer, LAS int* so) {
    const unsigned* cnt = (const unsigned*)(c.ws + WS_CTL) + CW_CNT + layer * NE;
    __syncthreads();
    if (c.tid < 64) {
        const int n = c.tid < NE ? (int)cnt[c.tid] : 0; int pad = (n + PADM - 1) / PADM * PADM, inc = pad;
#pragma unroll
        for (int o = 1; o < 32; o <<= 1) { const int t = __shfl_up(inc, o); if (c.lane >= o) inc += t; }
        if (c.tid < NE) { so[c.tid] = inc - pad; so[64 + c.tid] = n; }
        if (c.tid == NE - 1) so[32] = inc;
    }
    __syncthreads();
}

__device__ __forceinline__ void moe_tables(const Ctx& c, int layer, LAS int* tb) {
    const unsigned* cnt = (const unsigned*)(c.ws + WS_CTL) + CW_CNT + layer * NE;
    __syncthreads();
    if (c.tid < 64) {
        const int n = c.tid < NE ? (int)cnt[c.tid] : 0; int tiles = (n + PADM - 1) / PADM, inc = tiles;
#pragma unroll
        for (int o = 1; o < 32; o <<= 1) { const int t = __shfl_up(inc, o); if (c.lane >= o) inc += t; }
        if (c.tid < NE) { tb[c.tid] = inc - tiles; tb[64 + c.tid] = n; }
        if (c.tid == NE - 1) tb[32] = inc;
    }
    __syncthreads();
}
__device__ __forceinline__ int vcu_of(const Ctx& c) { return (c.nwg % 8 == 0) ? (c.wg % 8) * (c.nwg / 8) + c.wg / 8 : c.wg; }
__device__ __forceinline__ void phase_moe_gu(const Ctx& c, int layer) {
    LAS int* tb = (LAS int*)(c.lds + 131072 + 1024);
    moe_tables(c, layer, tb);
    pg8::Gemm g{c.ws + WS_H8, c.ws + WS_WGU + (size_t)layer * NE * 2048 * 1024, (size_t)2048 * 1024, (const int*)(c.ws + WS_LIST)};
    pg8::MoeOrder S{tb, tb + 64, 8, c.nwg, vcu_of(c), false};
    pg8::EpiSwiglu E{c.ws + WS_HDN, c.a->in[18] + (size_t)layer * NE * 2048};
    pg8::gemm_phase<pg8::EpiSwiglu, pg8::MoeOrder, true, true, true>(c.lds, g, S, E, c.tid);
}
__device__ __forceinline__ void phase_moe_dn(const Ctx& c, int layer) {
    LAS int* tb = (LAS int*)(c.lds + 131072 + 1024);
    moe_tables(c, layer, tb);
    pg8::Gemm g{c.ws + WS_HDN, c.ws + WS_WDN + (size_t)layer * NE * 1024 * 1024, (size_t)1024 * 1024, nullptr};
    pg8::MoeOrder S{tb, tb + 64, 4, c.nwg, vcu_of(c), true};
    pg8::EpiBf16Bias E{c.ws + WS_OUTB, c.a->in[20] + (size_t)layer * NE * 1024, 1024, 1.f / (F8_SHD * F8_SW)};
    pg8::gemm_phase<pg8::EpiBf16Bias, pg8::MoeOrder, true, false, true>(c.lds, g, S, E, c.tid);
}
__device__ __forceinline__ void phase_gemm_f32(const Ctx& c, const bf16_t* A, int M, const bf16_t* Bt, int N, const float* bias, bf16_t* Cout) {
    pg8::Gemm g{A, Bt, 0, nullptr}; pg8::StaticOrder S; S.init(M, N, c.nwg, c.wg);
    pg8::EpiF32 E{Cout, N, bias};
    pg8::gemm_phase<pg8::EpiF32, pg8::StaticOrder, true, false, false>(c.lds, g, S, E, c.tid);
}

__device__ __forceinline__ void phase_gemm_qkv(const Ctx& c) {
    pg8::Gemm g{(const bf16_t*)(c.ws + WS_H), (const bf16_t*)(c.ws + WS_WQKV), 0, nullptr}; pg8::StaticOrder S; S.init(R, QKVD, c.nwg, c.wg);
    pg8::EpiQKV E{(bf16_t*)(c.ws + WS_Q), (bf16_t*)(c.ws + WS_K), (bf16_t*)(c.ws + WS_V), c.a->in[8], (const float*)(c.ws + WS_MOD) + MOD_ROPE};
    pg8::gemm_phase<pg8::EpiQKV, pg8::StaticOrder, true, false, false>(c.lds, g, S, E, c.tid);
}
__device__ __forceinline__ void phase_gemm_inproj(const Ctx& c) {
    pg8::Gemm g{c.ws + WS_H8, c.ws + WS_WIN, 0, nullptr}; pg8::StaticOrder S; S.init(R, HIN, c.nwg, c.wg);
    pg8::EpiInProj E{(bf16_t*)(c.ws + WS_QH), (_Float16*)(c.ws + WS_KF), (_Float16*)(c.ws + WS_KB), (bf16_t*)(c.ws + WS_IV), (bf16_t*)(c.ws + WS_SG), (const float*)(c.ws + WS_MOD) + MOD_LB, 1.f / (F8_SH * F8_SW)};
    pg8::gemm_phase<pg8::EpiInProj, pg8::StaticOrder, true, false, true>(c.lds, g, S, E, c.tid);
}

__device__ __forceinline__ void phase_norm0(const Ctx& c);
constexpr int CONV_A = 20 * 16 + 16 * 16 + 80 * 16 + 16 * 16, CONV_B = 32 * 32 * 16 + 32 * 16 * 16, CONV_CHUNK = 8;
__device__ __forceinline__ TBlk convert_item(const Ctx& c, int it, int part) {
    constexpr int I_QKV = 20 * 16, I_O = 16 * 16, I_IN = 80 * 16, I_HO = 16 * 16, I_GU = 32 * 32 * 16;
    int r = it; TBlk t; t.dst8 = nullptr; t.dst = nullptr;
    if (part == 0) {
        if (r < I_QKV) { const int nb = r % 20, kb = r / 20; t.src = c.a->in[7] + (size_t)kb * 64 * QKVD + nb * 64; t.ldw = QKVD; t.dst = (bf16_t*)(c.ws + WS_WQKV) + (size_t)nb * 64 * 1024 + kb * 64; return t; } r -= I_QKV;
        if (r < I_O) { const int nb = r % 16, kb = r / 16; t.src = c.a->in[10] + (size_t)kb * 64 * D + nb * 64; t.ldw = D; t.dst = (bf16_t*)(c.ws + WS_WO) + (size_t)nb * 64 * 1024 + kb * 64; return t; } r -= I_O;
        if (r < I_IN) { const int nb = r % 80, kb = r / 80; t.src = c.a->in[11] + (size_t)kb * 64 * HIN + nb * 64; t.ldw = HIN; t.dst8 = c.ws + WS_WIN + (size_t)nb * 64 * 1024 + kb * 64; return t; } r -= I_IN;
        if (r < I_HO) { const int nb = r % 16, kb = r / 16; t.src = c.a->in[14] + (size_t)kb * 64 * D + nb * 64; t.ldw = D; t.dst = (bf16_t*)(c.ws + WS_WHO) + (size_t)nb * 64 * 1024 + kb * 64; return t; } r -= I_HO;
    }
    const int moff = (part - 1) * 32;
    if (r < I_GU) { const int mat = moff + r / 512, rr = r % 512, nb = rr % 32, kb = rr / 32; const int n0 = ((nb & 3) >> 1) * 1024 + (nb >> 2) * 128 + (nb & 1) * 64;
        t.src = c.a->in[17] + (size_t)mat * 1024 * 2048 + (size_t)kb * 64 * 2048 + n0; t.ldw = 2048; t.dst8 = c.ws + WS_WGU + ((size_t)mat * 2048 + nb * 64) * 1024 + kb * 64; return t; } r -= I_GU;
    { const int mat = moff + r / 256, rr = r % 256, nb = rr % 16, kb = rr / 16;
        t.src = c.a->in[19] + (size_t)mat * 1024 * 1024 + (size_t)kb * 64 * 1024 + nb * 64; t.ldw = 1024; t.dst8 = c.ws + WS_WDN + ((size_t)mat * 1024 + nb * 64) * 1024 + kb * 64; }
    return t;
}
__device__ __forceinline__ void convert_run(const Ctx& c, int part, int first, int step, int end, LAS float* scr) {
    f32x4 va[16], vb[16];
    int it = first;
    TBlk ta, tbk;
    if (it < end) { ta = convert_item(c, it, part); tb_load(ta, c.lane, va); }
    for (; it < end; it += 2 * step) {
        const bool hb = it + step < end;
        if (hb) { tbk = convert_item(c, it + step, part); tb_load(tbk, c.lane, vb); }
        tb_store(ta, c.lane, va, scr);
        const bool ha = it + 2 * step < end;
        if (ha) { ta = convert_item(c, it + 2 * step, part); tb_load(ta, c.lane, va); }
        if (hb) tb_store(tbk, c.lane, vb, scr);
    }
}
__device__ __forceinline__ void convert_steal(const Ctx& c, int part) {
    LAS float* scr = (LAS float*)c.lds + c.wave * (64 * 65);
    LAS int* chp = (LAS int*)(c.lds + 8 * 64 * 65 * 4);
    unsigned* ctr = (unsigned*)(c.ws + WS_CTL) + CW_CONV + 64 * part;
    for (;;) {
        __syncthreads();
        if (c.tid == 0) *chp = (int)atomicAdd(ctr, 1u);
        __syncthreads();
        const int ch = *chp;
        if (ch >= CONV_B / CONV_CHUNK) break;
        convert_run(c, part, ch * CONV_CHUNK + c.wave, 8, (ch + 1) * CONV_CHUNK, scr);
    }
}
__device__ __forceinline__ void convert_steal_n(const Ctx& c, int part, int nmax) {
    LAS float* scr = (LAS float*)c.lds + c.wave * (64 * 65);
    LAS int* chp = (LAS int*)(c.lds + 8 * 64 * 65 * 4);
    unsigned* ctr = (unsigned*)(c.ws + WS_CTL) + CW_CONV + 64 * part;
    for (int n = 0; n < nmax; ++n) {
        __syncthreads();
        if (c.tid == 0) *chp = (int)atomicAdd(ctr, 1u);
        __syncthreads();
        const int ch = *chp;
        if (ch >= CONV_B / CONV_CHUNK) break;
        convert_run(c, part, ch * CONV_CHUNK + c.wave, 8, (ch + 1) * CONV_CHUNK, scr);
    }
    __syncthreads();
}
__device__ __forceinline__ void phase_convert(const Ctx& c) {
    LAS float* scr = (LAS float*)c.lds + c.wave * (64 * 65);
    convert_run(c, 0, c.wg * 8 + c.wave, c.nwg * 8, CONV_A, scr);
    __syncthreads();
    phase_norm0(c);
}

__device__ __forceinline__ void phase_combine(const Ctx& c, int layer) {
    LAS int* so = (LAS int*)(c.lds + 32768);
    moe_offsets(c, layer, so);
    const unsigned char* outb = c.ws + WS_OUTB; bf16_t* X = (bf16_t*)(c.ws + WS_X);
    const bf16_t* Xin = layer == 0 ? X : (const bf16_t*)(c.ws + WS_X1);
    const float* ngl = c.a->in[6] + layer * 4 * D;
    const int* tk_e = (const int*)(c.ws + WS_TK); const float* tk_g = (const float*)(c.ws + WS_TK) + R * 4; const int* tk_slot = (const int*)(c.ws + WS_TK) + 2 * R * 4;
    const int r_lo = layer == 0 ? 0 : C, stride = c.nwg * 8;
    int r = r_lo + c.wg * 8 + c.wave;
    struct TK { int e[4], s[4]; float g[4]; };
    struct DT { unsigned w[4][4]; f32x4 x[4]; float g[4]; };
    TK ta, tb; DT da, db, na, nb;
#define CB_TK(T, row) do { _Pragma("unroll") for (int k = 0; k < 4; ++k) { T.e[k] = tk_e[(row) * 4 + k]; T.s[k] = tk_slot[(row) * 4 + k]; T.g[k] = tk_g[(row) * 4 + k]; } } while (0)
#define CB_DATA(DD, T, row) do { _Pragma("unroll") for (int k = 0; k < 4; ++k) { const unsigned char* src_ = outb + (size_t)(so[T.e[k]] + T.s[k]) * 1024; DD.g[k] = T.g[k] * (1.f / F8_SO); \
        _Pragma("unroll") for (int j = 0; j < 4; ++j) DD.w[k][j] = *(const unsigned*)(src_ + c.lane * 4 + 256 * j); } row_load_bf(Xin + (size_t)(row) * D, c.lane, DD.x); } while (0)
#define CB_ROW(DD, rr) do { const int r_ = (rr); \
        const float* m = c.modp(layer, r_ < C ? 1 : 0); \
        f32x4 y[4], x[4]; \
        _Pragma("unroll") for (int j = 0; j < 4; ++j) { y[j] = (f32x4){0.f, 0.f, 0.f, 0.f}; x[j] = DD.x[j]; } \
        _Pragma("unroll") for (int k = 0; k < 4; ++k) _Pragma("unroll") for (int j = 0; j < 4; ++j) { \
            const f32x2 lo = __builtin_amdgcn_cvt_pk_f32_fp8((int)DD.w[k][j], false), hi = __builtin_amdgcn_cvt_pk_f32_fp8((int)DD.w[k][j], true); y[j] += (f32x4){lo[0], lo[1], hi[0], hi[1]} * DD.g[k]; } \
        const float rstd_y = rsqrtf(row_ss(y) * (1.f / D) + EPS); \
        _Pragma("unroll") for (int j = 0; j < 4; ++j) { const int c0 = c.lane * 4 + 256 * j; \
            const f32x4 g2 = *(const f32x4*)(m + 5120 + c0), n3 = *(const f32x4*)(ngl + 3 * D + c0); \
            x[j] += g2 * (y[j] * rstd_y * n3); \
            if (layer == 0) { u32x2 xo; xo[0] = pk2(x[j][0], x[j][1]); xo[1] = pk2(x[j][2], x[j][3]); *(u32x2*)(X + (size_t)r_ * D + c0) = xo; x[j] = (f32x4){bflo(xo[0]), bfhi(xo[0]), bflo(xo[1]), bfhi(xo[1])}; } \
            else *(f32x4*)(c.a->out + (size_t)(r_ - C) * D + c0) = x[j]; } \
        if (layer == 0) { \
            const float rstd_x = rsqrtf(row_ss(x) * (1.f / D) + EPS); \
            const float* m1 = c.modp(1, r_ < C ? 1 : 0); const float* g0 = c.a->in[6] + 4 * D; \
            _Pragma("unroll") for (int j = 0; j < 4; ++j) { const int c0 = c.lane * 4 + 256 * j; \
                const f32x4 gv = *(const f32x4*)(g0 + c0), shv = *(const f32x4*)(m1 + c0), scv = *(const f32x4*)(m1 + 1024 + c0); \
                const f32x4 hv = x[j] * rstd_x * gv * (scv + 1.f) + shv; \
                *(unsigned*)(c.ws + WS_H8 + (size_t)r_ * D + c0) = pk4_fp8(hv[0] * F8_SH, hv[1] * F8_SH, hv[2] * F8_SH, hv[3] * F8_SH); } } } while (0)
    if (r < R) { CB_TK(ta, r); CB_DATA(da, ta, r); }
    if (r + stride < R) { CB_TK(tb, r + stride); CB_DATA(db, tb, r + stride); }
    if (r + 2 * stride < R) CB_TK(ta, r + 2 * stride);
    if (r + 3 * stride < R) CB_TK(tb, r + 3 * stride);
    for (; r < R; r += 2 * stride) {
        const bool h1 = r + stride < R, h2 = r + 2 * stride < R, h3 = r + 3 * stride < R;
        if (h2) CB_DATA(na, ta, r + 2 * stride);
        if (h3) CB_DATA(nb, tb, r + 3 * stride);
        if (r + 4 * stride < R) CB_TK(ta, r + 4 * stride);
        if (r + 5 * stride < R) CB_TK(tb, r + 5 * stride);
        CB_ROW(da, r);
        if (h1) CB_ROW(db, r + stride);
        da = na; db = nb;
    }
#undef CB_ROW
#undef CB_TK
#undef CB_DATA
}

namespace hg {
typedef _Float16 h2_t __attribute__((ext_vector_type(2)));
constexpr int TB = 272, PB = 144;
constexpr int TILE = 64 * TB;
constexpr int T_QD = 0, T_QC = TILE, T_KD = 2 * TILE, T_KE = 3 * TILE, T_KC = 4 * TILE, T_V0 = 5 * TILE, T_V1 = 6 * TILE;
constexpr int T_QL1 = 7 * TILE, T_KL1 = T_QL1 + 16 * TB, T_P = T_KL1 + 16 * TB, T_TOT = T_P + 64 * PB, T_CT = T_TOT + 4096, T_END = T_CT + 512;
static_assert(T_END <= LDS_BYTES - 64, "hgrn scan LDS map");
__device__ __forceinline__ int row_of(int dir, int p) { return p < C ? (dir ? C - 1 - p : p) : (dir ? C + (L - 1 - (p - C)) : p); }
__device__ __forceinline__ int seg_of(int ch) { return ch < 68 ? ch / 17 : 4 + (ch - 68) / 16; }
__device__ __forceinline__ bf16x8 tr_frag(const LAS unsigned char* tile, int row0, int col0, int lane) {
    const int q = (lane & 15) >> 2, p = lane & 3;
    const LAS unsigned char* a = tile + (row0 + q) * TB + (col0 + 4 * p) * 2;
    const v4i16_t lo = __builtin_amdgcn_ds_read_tr16_b64_v4i16((LAS v4i16_t*)a);
    const v4i16_t hi = __builtin_amdgcn_ds_read_tr16_b64_v4i16((LAS v4i16_t*)(a + 4 * TB));
    return (bf16x8){lo[0], lo[1], lo[2], lo[3], hi[0], hi[1], hi[2], hi[3]};
}
}

__device__ __forceinline__ void phase_hgrn_scan(const Ctx& c) {
    using namespace hg;
#define HG_BAR() asm volatile("s_waitcnt lgkmcnt(0)\n\ts_barrier" ::: "memory")
    const bf16_t* QH = (const bf16_t*)(c.ws + WS_QH); const bf16_t* IV = (const bf16_t*)(c.ws + WS_IV);
    LAS unsigned char* lds = c.lds;
    const int tid = c.tid, lane = c.lane, w = __builtin_amdgcn_readfirstlane(tid >> 6), fr = lane & 15, g = lane >> 4;
    for (int item_ = c.wg; item_ < 256 * SCAN_REP; item_ += c.nwg) {
        const int item = item_ & 255;
        const int chain = item >> 4, seg = item & 15, head = chain >> 1, dir = chain & 1, hc = head * 128;
        const int c0 = seg < 4 ? 17 * seg : 68 + 16 * (seg - 4), nch = seg < 4 ? 17 : 16;
        const _Float16* KX = (const _Float16*)(c.ws + (dir ? WS_KB : WS_KF));
        bf16_t* OL = (bf16_t*)(c.ws + (dir ? WS_OB : WS_OF)); bf16_t* QS = (bf16_t*)(c.ws + (dir ? WS_QSB : WS_QSF));
        HG_BAR();
        for (int i = tid; i < 64 * PB / 4; i += 512) ((LAS unsigned*)(lds + T_P))[i] = 0u;
        f32x4 Sacc[8];
#pragma unroll
        for (int m = 0; m < 8; ++m) Sacc[m] = (f32x4){0.f, 0.f, 0.f, 0.f};
        float dseg0 = 1.f, dseg1 = 1.f;
        unsigned kraw[8], qraw[8]; u32x4 vraw[2];
#define HG_LOAD(cidx) do { const int p0_ = 64 * (cidx); const bool lat_ = (cidx) >= 4; \
        _Pragma("unroll") for (int i = 0; i < 8; ++i) { const int r_ = row_of(dir, p0_ + 8 * w + i); \
            kraw[i] = *(const unsigned*)(KX + (size_t)r_ * D + hc + 2 * lane); \
            qraw[i] = lat_ ? *(const unsigned*)(QH + (size_t)(r_ - C) * D + hc + 2 * lane) : 0u; } \
        _Pragma("unroll") for (int i = 0; i < 2; ++i) { const int idx_ = tid + 512 * i; const int r_ = row_of(dir, p0_ + (idx_ >> 4)); \
            vraw[i] = *(const u32x4*)(IV + (size_t)r_ * D + hc + (idx_ & 15) * 8); } } while (0)
        HG_LOAD(c0);
        for (int ci = 0; ci < nch; ++ci) {
            const int cidx = c0 + ci; const bool lat = cidx >= 4;
            const int vbuf = (ci & 1) ? T_V1 : T_V0;
            float kf[8][2], qf[8][2], cp[8][2];
            {
                float p0 = 1.f, p1 = 1.f;
#pragma unroll
                for (int i = 0; i < 8; ++i) {
                    const h2_t hv = __builtin_bit_cast(h2_t, kraw[i]);
                    kf[i][0] = (float)hv[0]; kf[i][1] = (float)hv[1];
                    qf[i][0] = bflo(qraw[i]); qf[i][1] = bfhi(qraw[i]);
                    p0 *= (1.f - kf[i][0]); p1 *= (1.f - kf[i][1]); cp[i][0] = p0; cp[i][1] = p1;
                }
                *(LAS f32x2*)(lds + T_TOT + (w * 128 + 2 * lane) * 4) = (f32x2){p0, p1};
#pragma unroll
                for (int i = 0; i < 2; ++i) { const int idx = tid + 512 * i; *(LAS u32x4*)(lds + vbuf + (idx >> 4) * TB + (idx & 15) * 16) = vraw[i]; }
            }
            HG_BAR();
            {
                f32x2 T[8];
#pragma unroll
                for (int x = 0; x < 8; ++x) T[x] = *(const LAS f32x2*)(lds + T_TOT + (x * 128 + 2 * lane) * 4);
                const int I = w >> 1, hh = w & 1;
                f32x2 bd[4];
#pragma unroll
                for (int x = 0; x < 4; ++x) bd[x] = T[2 * x] * T[2 * x + 1];
                f32x2 pre = (f32x2){1.f, 1.f}, cum = (f32x2){1.f, 1.f}, suf = (f32x2){1.f, 1.f}, bdI = (f32x2){1.f, 1.f};
#pragma unroll
                for (int x = 0; x < 8; ++x) if (hh && x == w - 1) pre = T[x];
#pragma unroll
                for (int x = 0; x < 4; ++x) { if (x < I) cum = cum * bd[x]; if (x > I) suf = suf * bd[x]; if (x == I) bdI = bd[x]; }
                const f32x2 ctot = (bd[0] * bd[1]) * (bd[2] * bd[3]);
#pragma unroll
                for (int i = 0; i < 8; ++i) {
                    const int tau = 8 * w + i;
                    float QDv[2], KDv[2], KEv[2], QCv[2], KCv[2];
#pragma unroll
                    for (int x = 0; x < 2; ++x) {
                        const float eq = pre[x] * cp[i][x], rc = __builtin_amdgcn_rcpf(eq);
                        QDv[x] = qf[i][x] * eq; KDv[x] = kf[i][x] * rc; KEv[x] = KDv[x] * bdI[x]; QCv[x] = QDv[x] * cum[x]; KCv[x] = KEv[x] * suf[x];
                    }
                    const int to = tau * TB + lane * 4;
                    *(LAS unsigned*)(lds + T_QD + to) = pk2(QDv[0], QDv[1]);
                    *(LAS unsigned*)(lds + T_KD + to) = pk2(KDv[0], KDv[1]);
                    *(LAS unsigned*)(lds + T_KE + to) = pk2(KEv[0], KEv[1]);
                    *(LAS unsigned*)(lds + T_QC + to) = pk2(QCv[0], QCv[1]);
                    *(LAS unsigned*)(lds + T_KC + to) = pk2(KCv[0], KCv[1]);
                    if (I == 3) *(LAS unsigned*)(lds + T_QL1 + (tau - 48) * TB + lane * 4) = pk2(QDv[0] * bd[2][0], QDv[1] * bd[2][1]);
                    if (I == 0) *(LAS unsigned*)(lds + T_KL1 + tau * TB + lane * 4) = pk2(KEv[0] * bd[1][0], KEv[1] * bd[1][1]);
                    if (lat) { const int r = row_of(dir, 64 * cidx + tau); *(unsigned*)(QS + (size_t)(r - C) * D + hc + 2 * lane) = pk2(QCv[0] * dseg0, QCv[1] * dseg1); }
                }
                dseg0 *= ctot[0]; dseg1 *= ctot[1];
                if (w == 0) *(LAS f32x2*)(lds + T_CT + lane * 8) = ctot;
            }
            HG_BAR();
            if (ci + 1 < nch) HG_LOAD(cidx + 1);
            if (lat) {
                const int nblk = w >= 6 ? 2 : 1;
                for (int b = 0; b < nblk; ++b) {
                    int I, J, qoff, qrow, koff, krow; bool diag = false;
                    if (w < 4) { I = 2 + (w >> 1); J = w & 1; qoff = (w >> 1) ? T_QL1 : T_QD; qrow = (w >> 1) ? 0 : 32; koff = (w & 1) ? T_KE : T_KL1; krow = (w & 1) ? 16 : 0; }
                    else if (w == 4) { I = 1; J = 0; qoff = T_QD; qrow = 16; koff = T_KE; krow = 0; }
                    else if (w == 5) { I = 3; J = 2; qoff = T_QD; qrow = 48; koff = T_KE; krow = 32; }
                    else { I = 2 * (w - 6) + b; J = I; qoff = T_QD; qrow = 16 * I; koff = T_KD; krow = 16 * I; diag = true; }
                    f32x4 pa = (f32x4){0.f, 0.f, 0.f, 0.f};
#pragma unroll
                    for (int ks = 0; ks < 4; ++ks) {
                        const bf16x8 av = *(const LAS bf16x8*)(lds + qoff + (qrow + fr) * TB + (32 * ks + 8 * g) * 2);
                        const bf16x8 bv = *(const LAS bf16x8*)(lds + koff + (krow + fr) * TB + (32 * ks + 8 * g) * 2);
                        pa = __builtin_amdgcn_mfma_f32_16x16x32_bf16(av, bv, pa, 0, 0, 0);
                    }
#pragma unroll
                    for (int e = 0; e < 4; ++e) {
                        const int tl = 4 * g + e; const float val = (diag && fr > tl) ? 0.f : pa[e];
                        *(LAS bf16_t*)(lds + T_P + (16 * I + tl) * PB + (16 * J + fr) * 2) = (bf16_t)f2bf(val);
                    }
                }
            }
            f32x4 oacc[4];
#pragma unroll
            for (int m = 0; m < 4; ++m) oacc[m] = (f32x4){0.f, 0.f, 0.f, 0.f};
            if (lat) {
                bf16x8 Sb[4];
#pragma unroll
                for (int ks = 0; ks < 4; ++ks) {
                    const f32x4 a0 = Sacc[2 * ks], a1 = Sacc[2 * ks + 1];
                    const u32x4 pk = (u32x4){pk2(a0[0], a0[1]), pk2(a0[2], a0[3]), pk2(a1[0], a1[1]), pk2(a1[2], a1[3])};
                    Sb[ks] = __builtin_bit_cast(bf16x8, pk);
                }
#pragma unroll
                for (int m = 0; m < 4; ++m)
#pragma unroll
                    for (int ks = 0; ks < 4; ++ks) {
                        const u32x2 lo = *(const LAS u32x2*)(lds + T_QC + (16 * m + fr) * TB + (32 * ks + 4 * g) * 2);
                        const u32x2 hi = *(const LAS u32x2*)(lds + T_QC + (16 * m + fr) * TB + (32 * ks + 16 + 4 * g) * 2);
                        const u32x4 pk = (u32x4){lo.x, lo.y, hi.x, hi.y};
                        oacc[m] = __builtin_amdgcn_mfma_f32_16x16x32_bf16(Sb[ks], __builtin_bit_cast(bf16x8, pk), oacc[m], 0, 0, 0);
                    }
            }
#pragma unroll
            for (int m = 0; m < 8; ++m) { const f32x4 ct = *(const LAS f32x4*)(lds + T_CT + (16 * m + 4 * g) * 4); Sacc[m] = Sacc[m] * ct; }
            bf16x8 Vf[2];
#pragma unroll
            for (int ks = 0; ks < 2; ++ks) Vf[ks] = tr_frag(lds + vbuf, 32 * ks + 8 * g, 16 * w, lane);
#pragma unroll
            for (int m = 0; m < 8; ++m)
#pragma unroll
                for (int ks = 0; ks < 2; ++ks) Sacc[m] = __builtin_amdgcn_mfma_f32_16x16x32_bf16(tr_frag(lds + T_KC, 32 * ks + 8 * g, 16 * m, lane), Vf[ks], Sacc[m], 0, 0, 0);
            HG_BAR();
            if (lat) {
#pragma unroll
                for (int m = 0; m < 4; ++m)
#pragma unroll
                    for (int ks = 0; ks < 2; ++ks) {
                        if (m < 2 && ks == 1) continue;
                        const bf16x8 av = *(const LAS bf16x8*)(lds + T_P + (16 * m + fr) * PB + (32 * ks + 8 * g) * 2);
                        oacc[m] = __builtin_amdgcn_mfma_f32_16x16x32_bf16(Vf[ks], av, oacc[m], 0, 0, 0);
                    }
#pragma unroll
                for (int m = 0; m < 4; ++m) { const int r = row_of(dir, 64 * cidx + 16 * m + fr); u32x2 o; o.x = pk2(oacc[m][0], oacc[m][1]); o.y = pk2(oacc[m][2], oacc[m][3]);
                    *(u32x2*)(OL + (size_t)(r - C) * D + hc + 16 * w + 4 * g) = o; }
            }
        }
#undef HG_LOAD
        float* DS = (float*)(c.ws + WS_DS) + (size_t)item * 16384; float* DG = (float*)(c.ws + WS_DG) + item * 128;
#pragma unroll
        for (int m = 0; m < 8; ++m)
#pragma unroll
            for (int e = 0; e < 4; ++e) DS[(16 * m + 4 * g + e) * 128 + 16 * w + fr] = Sacc[m][e];
        if (w == 0) { DG[2 * lane] = dseg0; DG[2 * lane + 1] = dseg1; }
    }
}

#undef HG_BAR
__device__ __forceinline__ void phase_hgrn_fold(const Ctx& c) {
    const float* DS = (const float*)(c.ws + WS_DS); const float* DG = (const float*)(c.ws + WS_DG); bf16_t* SST = (bf16_t*)(c.ws + WS_SST);
    for (int item = c.wg; item < 256; item += c.nwg) {
        const int chain = item >> 4, slice = item & 15, d = 8 * slice + (c.tid >> 6), v2 = (c.tid & 63) * 2;
        float s0 = 0.f, s1 = 0.f;
        float dv[15]; f32x2 ds[15];
#pragma unroll
        for (int sgi = 0; sgi < 15; ++sgi) { dv[sgi] = DG[(chain * 16 + sgi) * 128 + d]; ds[sgi] = *(const f32x2*)(DS + ((size_t)(chain * 16 + sgi) * 128 + d) * 128 + v2); }
        SST[((size_t)(chain * 16) * 128 + v2) * 128 + d] = 0; SST[((size_t)(chain * 16) * 128 + v2 + 1) * 128 + d] = 0;
#pragma unroll
        for (int sgi = 0; sgi < 15; ++sgi) {
            s0 = dv[sgi] * s0 + ds[sgi][0]; s1 = dv[sgi] * s1 + ds[sgi][1];
            SST[((size_t)(chain * 16 + sgi + 1) * 128 + v2) * 128 + d] = (bf16_t)f2bf(s0); SST[((size_t)(chain * 16 + sgi + 1) * 128 + v2 + 1) * 128 + d] = (bf16_t)f2bf(s1);
        }
    }
}

__device__ __forceinline__ void phase_hgrn_readout(const Ctx& c) {
    constexpr int SP = 272, SBUF = 128 * SP, IBUF = 2 * SBUF;
    static_assert(2 * IBUF + 1024 <= LDS_BYTES - 64, "readout LDS map");
    const bf16_t* OF = (const bf16_t*)(c.ws + WS_OF); const bf16_t* OB = (const bf16_t*)(c.ws + WS_OB); const bf16_t* SGp = (const bf16_t*)(c.ws + WS_SG);
    const bf16_t* SST = (const bf16_t*)(c.ws + WS_SST); bf16_t* RR = (bf16_t*)(c.ws + WS_RR); const float* hng = c.a->in[13];
    LAS unsigned char* lds = c.lds; LAS float* ssx = (LAS float*)(c.lds + 2 * IBUF);
    const int tid = c.tid, lane = c.lane, w = __builtin_amdgcn_readfirstlane(tid >> 6), fr = lane & 15, g = lane >> 4, mt = w & 3, nh = w >> 2;
#define RO_BAR() asm volatile("s_waitcnt lgkmcnt(0)\n\ts_barrier" ::: "memory")
    u32x4 sreg[8];
#define RO_H(q) ((c.nwg == 256) ? ((q) & 255) >> 5 : (q) >> 8)
#define RO_CH(q) ((c.nwg == 256) ? (((q) & 31) << 3) + ((q) >> 8) : (q) & 255)
#define RO_SST_LOAD(it) do { const int h_ = RO_H(it), ch_ = RO_CH(it); \
        _Pragma("unroll") for (int j = 0; j < 8; ++j) { const int idx_ = tid + 512 * j, dx_ = idx_ >> 11, rem_ = idx_ & 2047; \
            const int sg_ = hg::seg_of(dx_ ? 4 + 255 - ch_ : 4 + ch_); \
            sreg[j] = *(const u32x4*)(SST + ((size_t)((h_ * 2 + dx_) * 16 + sg_) * 128 + (rem_ >> 4)) * 128 + (rem_ & 15) * 8); } } while (0)
#define RO_SST_WRITE(buf) do { _Pragma("unroll") for (int j = 0; j < 8; ++j) { const int idx_ = tid + 512 * j, dx_ = idx_ >> 11, rem_ = idx_ & 2047; \
            *(LAS u32x4*)(lds + (buf) * IBUF + dx_ * SBUF + (rem_ >> 4) * SP + (rem_ & 15) * 16) = sreg[j]; } } while (0)
    int it = c.wg;
    u32x2 ra[4], rb[4], rg[4]; bf16x8 rq[2][4];
#define RO_IN_LOAD(itx) do { const int h_ = RO_H(itx), t0_ = 64 * RO_CH(itx) + 16 * mt; \
        _Pragma("unroll") for (int n = 0; n < 4; ++n) { const size_t o_ = (size_t)(t0_ + fr) * D + h_ * 128 + 64 * nh + 16 * n + 4 * g; \
            ra[n] = *(const u32x2*)(OF + o_); rb[n] = *(const u32x2*)(OB + o_); rg[n] = *(const u32x2*)(SGp + o_); } \
        _Pragma("unroll") for (int dx = 0; dx < 2; ++dx) { const bf16_t* QS_ = (const bf16_t*)(c.ws + (dx ? WS_QSB : WS_QSF)) + (size_t)(t0_ + fr) * D + h_ * 128 + 8 * g; \
            _Pragma("unroll") for (int ks = 0; ks < 4; ++ks) rq[dx][ks] = *(const bf16x8*)(QS_ + 32 * ks); } } while (0)
    RO_BAR();
    if (it < 2048) { RO_SST_LOAD(it); RO_SST_WRITE(0); RO_IN_LOAD(it); }
    RO_BAR();
    int buf = 0;
    for (int k = 0; it < 2048; it += c.nwg, ++k) {
        const int h = RO_H(it), ch = RO_CH(it), t0 = 64 * ch + 16 * mt;
        const bool has_next = it + c.nwg < 2048;
        const int hn = RO_H(it + c.nwg), chn = RO_CH(it + c.nwg);
        const bool reload = has_next && (hn != h || hg::seg_of(4 + chn) != hg::seg_of(4 + ch) || hg::seg_of(4 + 255 - chn) != hg::seg_of(4 + 255 - ch));
        f32x4 acc[4], sgv[4];
        bf16x8 aq[2][4];
#pragma unroll
        for (int n = 0; n < 4; ++n) {
            const f32x4 gn = *(const f32x4*)(hng + h * 128 + 64 * nh + 16 * n + 4 * g);
            acc[n] = (f32x4){bflo(ra[n].x) + bflo(rb[n].x), bfhi(ra[n].x) + bfhi(rb[n].x), bflo(ra[n].y) + bflo(rb[n].y), bfhi(ra[n].y) + bfhi(rb[n].y)};
            sgv[n] = (f32x4){bflo(rg[n].x), bfhi(rg[n].x), bflo(rg[n].y), bfhi(rg[n].y)} * gn;
        }
#pragma unroll
        for (int dx = 0; dx < 2; ++dx)
#pragma unroll
            for (int ks = 0; ks < 4; ++ks) aq[dx][ks] = rq[dx][ks];
        if (reload) RO_SST_LOAD(it + c.nwg);
        if (has_next) RO_IN_LOAD(it + c.nwg);
#pragma unroll
        for (int dx = 0; dx < 2; ++dx) {
            const LAS unsigned char* sb = lds + buf * IBUF + dx * SBUF + (64 * nh + fr) * SP + 16 * g;
#pragma unroll
            for (int ks = 0; ks < 4; ++ks) {
#pragma unroll
                for (int n = 0; n < 4; ++n) acc[n] = __builtin_amdgcn_mfma_f32_16x16x32_bf16(*(const LAS bf16x8*)(sb + (16 * n) * SP + 64 * ks), aq[dx][ks], acc[n], 0, 0, 0);
            }
        }
        float ss = 0.f;
#pragma unroll
        for (int n = 0; n < 4; ++n) ss += acc[n][0] * acc[n][0] + acc[n][1] * acc[n][1] + acc[n][2] * acc[n][2] + acc[n][3] * acc[n][3];
        ss = xadd32(xadd16(ss));
        if (g == 0) ssx[((k & 1) * 8 + w) * 16 + fr] = ss;
        if (reload) RO_SST_WRITE(buf ^ 1);
        RO_BAR();
        const float rstd = rsqrtf((ss + ssx[((k & 1) * 8 + (w ^ 4)) * 16 + fr]) * (1.f / 128.f) + EPS);
#pragma unroll
        for (int n = 0; n < 4; ++n) {
            const f32x4 v = acc[n] * rstd * sgv[n]; u32x2 o; o.x = pk2(v[0], v[1]); o.y = pk2(v[2], v[3]);
            *(u32x2*)(RR + (size_t)(t0 + fr) * D + h * 128 + 64 * nh + 16 * n + 4 * g) = o;
        }
        if (reload) buf ^= 1;
    }
    RO_BAR();
#undef RO_BAR
#undef RO_SST_LOAD
#undef RO_SST_WRITE
#undef RO_H
#undef RO_CH
#undef RO_IN_LOAD
}

#define XB_TMO      128
#define XB_XCNT(j)  (256  + 64 * (j))
#define XB_XSUB(j)  (1280 + 64 * (j))
#define XB_XGEN(j)  (2304 + 64 * (j))
#define XB_TOP      3328
#define XB_TOPGEN   3392
#define XCD_BAR_WORDS 3456
#define XB_SPIN_CAP (1u << 18)
__device__ __forceinline__ unsigned xb_ld(unsigned* p)              { return __hip_atomic_load(p, __ATOMIC_RELAXED, __HIP_MEMORY_SCOPE_AGENT); }
__device__ __forceinline__ unsigned xb_add(unsigned* p, unsigned v) { return __hip_atomic_fetch_add(p, v, __ATOMIC_RELAXED, __HIP_MEMORY_SCOPE_AGENT); }
__device__ __forceinline__ unsigned xb_xcc_id() { return (unsigned)__builtin_amdgcn_s_getreg((3 << 11) | 20) & 0xFu; }
#define XB_SPIN(cond, bar) do { unsigned _sp = 0; while (cond) { __builtin_amdgcn_s_sleep(1); \
    if ((++_sp & 255u) == 0u) { if (xb_ld(&(bar)[XB_TMO])) break; if (_sp > XB_SPIN_CAP) { atomicAdd(&(bar)[XB_TMO], 1u); break; } } } } while (0)
struct XcdBarrier { unsigned* bar; unsigned x; volatile LAS unsigned* st; };
__device__ __forceinline__ XcdBarrier xcd_barrier_post(unsigned* bar, volatile LAS unsigned* st) {
    XcdBarrier b; b.bar = bar; b.x = xb_xcc_id(); b.st = st;
    if (threadIdx.x == 0) (void)xb_add(&bar[XB_XCNT(b.x)], 1u);
    return b;
}
__device__ __forceinline__ void xcd_barrier_complete(unsigned* bar, unsigned x, unsigned& nloc, unsigned& nx) {
    const unsigned G = gridDim.x * gridDim.y * gridDim.z;
    unsigned sum, cnt, mine, sp = 0u;
    for (;;) {
        sum = 0u; cnt = 0u; mine = 0u;
#pragma unroll
        for (unsigned j = 0; j < 16; ++j) { const unsigned c = xb_ld(&bar[XB_XCNT(j)]); sum += c; cnt += (c > 0u) ? 1u : 0u; mine = (j == x) ? c : mine; }
        if (sum == G) break;
        __builtin_amdgcn_s_sleep(1);
        if ((++sp & 255u) == 0u) { if (xb_ld(&bar[XB_TMO])) break; if (sp > XB_SPIN_CAP) { atomicAdd(&bar[XB_TMO], 1u); break; } }
    }
    nloc = mine > 0u ? mine : 1u; nx = cnt > 0u ? cnt : 1u;
}
__device__ __forceinline__ void xcd_barrier(const XcdBarrier& b) {
    asm volatile("s_waitcnt vmcnt(0)" ::: "memory");
    __syncthreads();
    if (threadIdx.x == 0) {
        unsigned* bar = b.bar;
        __builtin_amdgcn_s_waitcnt(0);
        unsigned nloc = b.st[0], nx = b.st[1];
        if (nloc == 0u) { xcd_barrier_complete(bar, b.x, nloc, nx); b.st[0] = nloc; b.st[1] = nx; }
        const unsigned old = xb_add(&bar[XB_XSUB(b.x)], 1u);
        const unsigned gen = old / nloc;
        if (old + 1u == (gen + 1u) * nloc) {
            __builtin_amdgcn_fence(__ATOMIC_RELEASE, "agent");
            asm volatile("s_waitcnt vmcnt(0)" ::: "memory");
            const unsigned og = xb_add(&bar[XB_TOP], 1u);
            const unsigned tg = og / nx;
            if (og + 1u == (tg + 1u) * nx) xb_add(&bar[XB_TOPGEN], 1u);
            else XB_SPIN(xb_ld(&bar[XB_TOPGEN]) == tg, bar);
            __builtin_amdgcn_fence(__ATOMIC_ACQUIRE, "agent");
            xb_add(&bar[XB_XGEN(b.x)], 1u);
            asm volatile("s_waitcnt vmcnt(0)" ::: "memory");
        } else {
            XB_SPIN(xb_ld(&bar[XB_XGEN(b.x)]) == gen, bar);
            __builtin_amdgcn_fence(__ATOMIC_ACQUIRE, "agent");
            asm volatile("s_waitcnt vmcnt(0)" ::: "memory");
        }
    }
    __syncthreads();
}

__device__ __forceinline__ void launder(Ctx& c) { asm volatile("" : "+s"(c.a)); asm volatile("" : "+s"(c.ws)); asm volatile("" : "+s"(c.wave));
    c.lane = (int)__builtin_amdgcn_mbcnt_hi(~0u, __builtin_amdgcn_mbcnt_lo(~0u, 0u)); c.tid = c.wave * 64 + c.lane; }
__global__ void __launch_bounds__(512, 2) mk_fwd(Args args) {
    extern __shared__ __attribute__((aligned(16))) unsigned char lds_raw[];
    Ctx c; c.a = (CArgs)__builtin_amdgcn_kernarg_segment_ptr(); c.lds = (LAS unsigned char*)lds_raw; c.tid = threadIdx.x; c.lane = c.tid & 63; c.wave = __builtin_amdgcn_readfirstlane(c.tid >> 6); c.nwg = gridDim.x; c.wg = blockIdx.x; c.ws = c.a->ws;
    volatile LAS unsigned* bst = (volatile LAS unsigned*)(c.lds + LDS_BYTES - 64);
    if (c.tid < 4) bst[c.tid] = 0u;
    __syncthreads();
    const XcdBarrier bar = xcd_barrier_post((unsigned*)(c.ws + WS_CTL) + CW_BAR, bst);
    const int lo = c.a->ph_lo, hi = c.a->ph_hi;
    bool route_ok = true;
#define SEAM(k) do { if (lo <= (k) && (k) + 1 < hi) xcd_barrier(bar); } while (0)
#define IN(k) (lo <= (k) && (k) < hi && (launder(c), true))
#define PH(k, call) do { if (IN(k)) { if (PROBE_PH == (k)) { int nrep_ = 3; asm volatile("" : "+s"(nrep_)); for (int rep_ = 0; rep_ < nrep_; ++rep_) { route_ok = (rep_ + 1 == nrep_); call; if (rep_ + 1 < nrep_) xcd_barrier(bar); } } else { call; } } SEAM(k); } while (0)
    PH(0, phase_prep(c));
    PH(1, phase_convert(c));
    PH(2, { phase_gemm_qkv(c); if (c.nwg == 256 && c.wg >= 138) convert_steal_n(c, 1, 3); });
    PH(3, phase_attn(c));
    PH(4, { phase_gemm_f32(c, (const bf16_t*)(c.ws + WS_O), R, (const bf16_t*)(c.ws + WS_WO), D, nullptr, (bf16_t*)(c.ws + WS_RAW1)); if (c.nwg == 256 && c.wg >= 16) convert_steal_n(c, 1, 2); });
    PH(5, { phase_postmix<128>(c, 0, route_ok); convert_steal(c, 1); });
    PH(6, phase_moe_gu(c, 0));
    PH(7, phase_moe_dn(c, 0));
    PH(8, phase_combine(c, 0));
    PH(9, { phase_gemm_inproj(c); if (c.nwg == 256 && c.wg >= 80) convert_steal_n(c, 2, 2); });
    PH(10, phase_hgrn_scan(c));
    PH(11, phase_hgrn_fold(c));
    PH(12, phase_hgrn_readout(c));
    PH(13, phase_gemm_f32(c, (const bf16_t*)(c.ws + WS_RR), L, (const bf16_t*)(c.ws + WS_WHO), D, nullptr, (bf16_t*)(c.ws + WS_RAW1)));
    PH(14, { phase_postmix<128>(c, 1, route_ok); convert_steal(c, 2); });
    PH(15, phase_moe_gu(c, 1));
    PH(16, phase_moe_dn(c, 1));
    PH(17, phase_combine(c, 1));
#undef IN
#undef PH
#undef SEAM
}

extern "C" void kernel_launch(void* const* d_in, const int* in_sizes, int n_in, void* d_out, int out_size, void* d_ws, size_t ws_size, hipStream_t stream) {
    static int grid = 0;
    if (grid == 0) {
        if (n_in != 21 || out_size != L * D || ws_size < WS_END) { fprintf(stderr, "kernel_launch: unexpected problem (n_in %d out %d ws %zu need %zu)\n", n_in, out_size, ws_size, (size_t)WS_END); grid = -1; return; }
        int dev = 0, cus = 0, per_cu = 0;
        hipGetDevice(&dev); hipDeviceGetAttribute(&cus, hipDeviceAttributeMultiprocessorCount, dev);
        if (hipFuncSetAttribute((const void*)mk_fwd, hipFuncAttributeMaxDynamicSharedMemorySize, LDS_BYTES) != hipSuccess) { fprintf(stderr, "kernel_launch: hipFuncSetAttribute failed\n"); grid = -1; return; }
        hipOccupancyMaxActiveBlocksPerMultiprocessor(&per_cu, (const void*)mk_fwd, 512, LDS_BYTES);
        if (per_cu < 1) fprintf(stderr, "kernel_launch: occupancy query says %d\n", per_cu);
        (void)hipGetLastError();
        grid = cus > 0 ? cus : 256;
    }
    if (grid < 0) return;
    hipMemsetAsync((char*)d_ws + WS_CTL, 0, MiB, stream);
    Args a{};
    for (int i = 0; i < 21; ++i) a.in[i] = (const float*)d_in[i];
    a.out = (float*)d_out; a.ws = (unsigned char*)d_ws;
    a.ph_lo = 0; a.ph_hi = NPHASE;
    hipLaunchKernelGGL(mk_fwd, dim3(grid), dim3(512), LDS_BYTES, stream, a);
}
```

```cpp
#include <hip/hip_runtime.h>
#include <cstdint>
#include <cstdio>

#define LAS __attribute__((address_space(3)))
typedef unsigned short bf16_t;
typedef short bf16x8 __attribute__((ext_vector_type(8)));
typedef float f32x4 __attribute__((ext_vector_type(4)));
typedef unsigned u32x4 __attribute__((ext_vector_type(4)));
typedef unsigned u32x2 __attribute__((ext_vector_type(2)));
typedef short v4i16_t __attribute__((ext_vector_type(4)));
typedef float f32x2 __attribute__((ext_vector_type(2)));

constexpr int D = 1024, L = 16384, C = 256, R = L + C;
constexpr int QKVD = 1280, HIN = 5120, NE = 32, TOPK = 4;
constexpr int PADM = 256, MAXROWS = 74752;
constexpr float EPS = 1e-6f;
constexpr float LOG2E = 1.4426950408889634f;
constexpr int NPHASE = 18;
#ifndef GEMM_REP
#define GEMM_REP 1
#endif
#ifndef PROBE_NOEPI
#define PROBE_NOEPI 0
#endif
#ifndef PROBE_SHORTK
#define PROBE_SHORTK 0
#endif
#ifndef SCAN_REP
#define SCAN_REP 1
#endif
#ifndef PROBE_PH
#define PROBE_PH (-1)
#endif
constexpr int LDS_BYTES = 147456;

constexpr size_t MiB = 1u << 20;
constexpr size_t al(size_t x) { return (x + MiB - 1) / MiB * MiB; }
constexpr size_t WS_CTL = 0;
constexpr size_t WS_MOD = WS_CTL + MiB;
constexpr size_t WS_X = WS_MOD + MiB;
constexpr size_t WS_H = WS_X + al((size_t)R * D * 4);
constexpr size_t WS_Q = WS_H + al((size_t)R * D * 2);
constexpr size_t WS_K = WS_Q + al((size_t)R * D * 2);
constexpr size_t WS_V = WS_K + al((size_t)R * 128 * 2);
constexpr size_t WS_O = WS_V + al((size_t)R * 128 * 2);
constexpr size_t WS_TK = WS_O + al((size_t)R * D * 2);
constexpr size_t WS_LIST = WS_TK + MiB;
constexpr size_t WS_HDN = WS_LIST + 3 * MiB;
constexpr size_t WS_RAW1 = WS_HDN + al((size_t)MAXROWS * 1024 * 2);
constexpr size_t WS_X1 = WS_RAW1 + al((size_t)R * D * 4);
constexpr size_t WS_OUTB = WS_X1 + al((size_t)R * D * 4);
constexpr size_t WS_QH = WS_OUTB + al((size_t)MAXROWS * 1024 * 2);
constexpr size_t WS_KF = WS_QH + al((size_t)L * D * 2);
constexpr size_t WS_KB = WS_KF + al((size_t)R * D * 2);
constexpr size_t WS_IV = WS_KB + al((size_t)R * D * 2);
constexpr size_t WS_SG = WS_IV + al((size_t)R * D * 2);
constexpr size_t WS_OF = WS_SG + al((size_t)L * D * 2);
constexpr size_t WS_OB = WS_OF + al((size_t)L * D * 4);
constexpr size_t WS_RR = WS_OB + al((size_t)L * D * 4);
constexpr size_t WS_WQKV = WS_RR + al((size_t)L * D * 2);
constexpr size_t WS_WO = WS_WQKV + al((size_t)QKVD * D * 2);
constexpr size_t WS_WIN = WS_WO + al((size_t)D * D * 2);
constexpr size_t WS_WHO = WS_WIN + al((size_t)HIN * D * 2);
constexpr size_t WS_WGU = WS_WHO + al((size_t)D * D * 2);
constexpr size_t WS_WDN = WS_WGU + al((size_t)2 * NE * 2048 * D * 2);
constexpr size_t WS_QSF = WS_WDN + al((size_t)2 * NE * 1024 * D * 2);
constexpr size_t WS_QSB = WS_QSF + al((size_t)L * D * 2);
constexpr size_t WS_DS = WS_QSB + al((size_t)L * D * 2);
constexpr size_t WS_DG = WS_DS + al((size_t)256 * 128 * 128 * 4);
constexpr size_t WS_SST = WS_DG + MiB;
constexpr size_t WS_H8 = WS_SST + al((size_t)256 * 128 * 128 * 2);
constexpr size_t WS_END = WS_H8 + al((size_t)R * D);
static_assert(WS_END <= (size_t)2048 * MiB, "workspace map exceeds 4x the largest input");
constexpr int CW_CNT = 1024;
constexpr int CW_CONV = 2048;
constexpr int CW_BAR = 4096;
constexpr int MOD_ROPE = 32768;
constexpr int MOD_LB = 49152;

struct Args { const float* in[21]; float* out; unsigned char* ws; int ph_lo, ph_hi; };

__device__ __forceinline__ unsigned f2bf(float f) { unsigned u = __float_as_uint(f); return (u + 0x7fffu + ((u >> 16) & 1u)) >> 16; }
typedef float f32x2_t __attribute__((ext_vector_type(2))); typedef __bf16 bf16x2_t __attribute__((ext_vector_type(2)));
__device__ __forceinline__ unsigned pk2(float lo, float hi) { f32x2_t v = {lo, hi}; bf16x2_t b = __builtin_convertvector(v, bf16x2_t); return __builtin_bit_cast(unsigned, b); }
__device__ __forceinline__ unsigned pk4_fp8(float a, float b, float c, float d) {
    a = fminf(fmaxf(a, -448.f), 448.f); b = fminf(fmaxf(b, -448.f), 448.f); c = fminf(fmaxf(c, -448.f), 448.f); d = fminf(fmaxf(d, -448.f), 448.f);
    int v = __builtin_amdgcn_cvt_pk_fp8_f32(a, b, 0, false); v = __builtin_amdgcn_cvt_pk_fp8_f32(c, d, v, true); return (unsigned)v; }
__device__ __forceinline__ unsigned pk4_fp8_nc(float a, float b, float c, float d) {
    int v = __builtin_amdgcn_cvt_pk_fp8_f32(a, b, 0, false); v = __builtin_amdgcn_cvt_pk_fp8_f32(c, d, v, true); return (unsigned)v; }
constexpr float F8_SH = 8.f, F8_SW = 64.f, F8_SHD = 4.f, F8_SO = 16.f;
__device__ __forceinline__ float bflo(unsigned u) { return __uint_as_float(u << 16); }
__device__ __forceinline__ float bfhi(unsigned u) { return __uint_as_float(u & 0xffff0000u); }
__device__ __forceinline__ float bf2f(bf16_t b) { return __uint_as_float(((unsigned)b) << 16); }
__device__ __forceinline__ float xadd16(float x) { const auto a = __builtin_amdgcn_permlane16_swap(__float_as_uint(x), __float_as_uint(x), false, false); return __uint_as_float(a[0]) + __uint_as_float(a[1]); }
__device__ __forceinline__ float xadd32(float x) { const auto a = __builtin_amdgcn_permlane32_swap(__float_as_uint(x), __float_as_uint(x), false, false); return __uint_as_float(a[0]) + __uint_as_float(a[1]); }
__device__ __forceinline__ float xmax16(float x) { const auto a = __builtin_amdgcn_permlane16_swap(__float_as_uint(x), __float_as_uint(x), false, false); return fmaxf(__uint_as_float(a[0]), __uint_as_float(a[1])); }
__device__ __forceinline__ float xmax32(float x) { const auto a = __builtin_amdgcn_permlane32_swap(__float_as_uint(x), __float_as_uint(x), false, false); return fmaxf(__uint_as_float(a[0]), __uint_as_float(a[1])); }
__device__ __forceinline__ float wave_sum(float v) {
#pragma unroll
    for (int o = 8; o > 0; o >>= 1) v += __shfl_xor(v, o);
    return xadd32(xadd16(v));
}
__device__ __forceinline__ float silu_f(float x) { return x / (1.f + __expf(-x)); }
__device__ __forceinline__ float sigmoid_f(float x) { return 1.f / (1.f + __expf(-x)); }

typedef const __attribute__((address_space(4))) Args* CArgs;
struct Ctx {
    CArgs a;
    LAS unsigned char* lds;
    int tid, lane, wave, nwg, wg;
    unsigned char* ws;
    __device__ __forceinline__ float* modp(int layer, int which) const { return (float*)(ws + WS_MOD) + (layer * 2 + which) * 6144; }
    __device__ __forceinline__ const float* xin0(int r) const { return r < C ? a->in[2] + (size_t)r * D : a->in[0] + (size_t)(r - C) * D; }
};


namespace pg8 {
constexpr int BM = 256, BK = 64, HALF = 128, HTB = HALF * BK * 2, STAGE_BYTES = 8 * HTB, KD = 1024, NXCD = 8, WGM = 8;
__device__ __forceinline__ int lds_byte(int r, int c) { const int st = (r >> 4) * 2 + (c >> 5), rr = r & 15, cc = c & 31, ob = rr * 64 + cc * 2; return st * 1024 + (ob ^ (((ob >> 9) & 1) << 5)); }
__device__ __forceinline__ void stage_rc(int b, int& Rr, int& Cc) { const int st = b / 1024, sb = b % 1024, swz = sb ^ (((sb >> 9) & 1) << 5); Rr = (st >> 1) * 16 + swz / 64; Cc = (st & 1) * 32 + (swz % 64) / 2; }
__device__ __forceinline__ int perm32(int rho) { const int n = rho >> 4, i = rho & 15; return 8 * (i >> 2) + 4 * n + (i & 3); }

struct Unit { int pm, pn, e, goff, gcnt; bool real; int amask, bmask; };
struct Gemm { const void* A; const void* Bt; size_t bstride; const int* list; };

struct StaticOrder {
    int nM, nN, nwg, G, c;
    __device__ __forceinline__ void init(int M, int N, int G_, int c_) { nM = M / BM; nN = N / BM; nwg = nM * nN; G = G_; c = c_; }
    __device__ __forceinline__ bool next(int i, Unit& u) const {
        const int F = nwg / G, Rm = nwg - F * G; int Lq; u.amask = 3; u.bmask = 3;
        if (i < F) Lq = i * G + c;
        else if (i == F && Rm > 0) {
            if (4 * Rm <= G) { if (c >= 4 * Rm) return false; Lq = F * G + (c >> 2); u.amask = 1 << ((c >> 1) & 1); u.bmask = 1 << (c & 1); }
            else if (2 * Rm <= G) { if (c >= 2 * Rm) return false; Lq = F * G + (c >> 1); u.bmask = 1 << (c & 1); }
            else { if (c >= Rm) return false; Lq = F * G + c; }
        } else return false;
        int wgid = Lq; { const int q = nwg / NXCD, r = nwg % NXCD, xcd = wgid % NXCD, off = wgid / NXCD; wgid = (xcd < r ? xcd * (q + 1) : r * (q + 1) + (xcd - r) * q) + off; }
        const int nig = WGM * nN, gid = wgid / nig, fm = gid * WGM, gsz = (nM - fm) < WGM ? (nM - fm) : WGM;
        u.pm = fm + ((wgid % nig) % gsz); u.pn = (wgid % nig) / gsz; u.e = 0; u.goff = 0; u.gcnt = 0; u.real = true; return true;
    }
};
struct MoeOrder {
    const LAS int* tp; const LAS int* cnt; int npn, G, vcu; bool split;
    __device__ __forceinline__ bool next(int i, Unit& u) const {
        const int tot = tp[32] * npn; int lin; u.amask = 3; u.bmask = 3; u.real = true;
        if (GEMM_REP > 1) { const int lin0 = i * G + vcu; if (lin0 >= tot * GEMM_REP) return false; lin = lin0 % tot; u.real = lin0 >= tot * (GEMM_REP - 1); }
        else {
            const int F = tot / G, Rm = tot - F * G;
            if (i < F) lin = i * G + vcu;
            else if (i == F && Rm > 0) {
                if (split && 2 * Rm <= G) { if (vcu >= 2 * Rm) return false; lin = F * G + (vcu >> 1); u.bmask = 1 << (vcu & 1); }
                else { if (vcu >= Rm) return false; lin = F * G + vcu; }
            } else return false;
        }
        const int rt = lin / npn; int e = 0;
#pragma unroll 8
        for (int k = 1; k < 32; ++k) e += (rt >= tp[k]) ? 1 : 0;
        const int mt = rt - tp[e];
        u.pm = rt; u.pn = lin - rt * npn; u.e = e; u.goff = e * R + mt * 256; u.gcnt = cnt[e] - mt * 256; return true;
    }
};

__device__ __forceinline__ void a_rows(const Gemm& g, const Unit& u, const int (&sR)[2], int (&rows)[2][2]) {
#pragma unroll
    for (int h = 0; h < 2; ++h)
#pragma unroll
        for (int i = 0; i < 2; ++i) { const int rr = h * HALF + sR[i]; rows[h][i] = rr < u.gcnt ? g.list[u.goff + rr] : 0; }
}
template <int KB>
__device__ __forceinline__ void a_offsets(const Gemm& g, const Unit& u, const int (&sR)[2], const int (&sC)[2], unsigned (&v)[2][2]) {
#pragma unroll
    for (int h = 0; h < 2; ++h)
#pragma unroll
        for (int i = 0; i < 2; ++i) {
            const int rr = h * HALF + sR[i]; int row;
            if (g.list) row = rr < u.gcnt ? g.list[u.goff + rr] : 0; else row = u.pm * BM + rr;
            v[h][i] = (unsigned)(row * KB + sC[i] * 2);
        }
}

struct EpiF32 {
    static constexpr bool LDSBIAS = false; static constexpr bool PERM = false;
    bf16_t* Cp; int ldc; const float* bias;
    __device__ __forceinline__ void operator()(const f32x4 (&acc)[2][2][4][2], const Unit& u, int wr, int wc, int fr, int fq, const LAS float* bl) const {
        const int row0 = u.pm * BM + wr * 64 + fr, col0 = u.pn * BM + wc * 32 + 4 * fq;
#pragma unroll
        for (int bj = 0; bj < 2; ++bj)
#pragma unroll
            for (int n = 0; n < 2; ++n) {
                const int col = col0 + bj * HALF + n * 16;
                if (!((u.bmask >> bj) & 1)) continue;
                const f32x4 bv = bias ? *(const f32x4*)(bias + col) : (f32x4){0.f, 0.f, 0.f, 0.f};
#pragma unroll
                for (int ai = 0; ai < 2; ++ai)
#pragma unroll
                    for (int m = 0; m < 4; ++m) if ((u.amask >> ai) & 1) { const f32x4 v = acc[ai][bj][m][n] + bv; u32x2 o; o.x = pk2(v[0], v[1]); o.y = pk2(v[2], v[3]);
                        *(u32x2*)(Cp + (size_t)(row0 + ai * HALF + m * 16) * ldc + col) = o; }
            }
    }
};
struct EpiSwiglu {
    static constexpr bool LDSBIAS = true; static constexpr bool PERM = true;
    unsigned char* Hd; const float* bgu;
    __device__ __forceinline__ const char* bias_base(const Unit& u) const { return (const char*)(bgu + (size_t)u.e * 2048 + u.pn * HALF); }
    __device__ __forceinline__ unsigned bias_voff(int lane) const { return (unsigned)(((lane >> 5) * 1024 + (lane & 31) * 4) * 4); }
    __device__ __forceinline__ void operator()(const f32x4 (&acc)[2][2][4][2], const Unit& u, int wr, int wc, int fr, int fq, const LAS float* bl) const {
        const int row0 = u.pm * BM + wr * 64 + fr, cg0 = u.pn * HALF + wc * 32 + 8 * fq;
        f32x4 bg[2], bu[2];
#pragma unroll
        for (int n = 0; n < 2; ++n) { bg[n] = *(const LAS f32x4*)(bl + wc * 32 + 8 * fq + 4 * n); bu[n] = *(const LAS f32x4*)(bl + 128 + wc * 32 + 8 * fq + 4 * n); }
#pragma unroll
        for (int ai = 0; ai < 2; ++ai)
#pragma unroll
            for (int m = 0; m < 4; ++m) {
                u32x2 o;
#pragma unroll
                for (int n = 0; n < 2; ++n) {
                    const f32x4 gv = acc[ai][0][m][n] * (1.f / (F8_SH * F8_SW)) + bg[n], uv = acc[ai][1][m][n] * (1.f / (F8_SH * F8_SW)) + bu[n]; float hv[4];
#pragma unroll
                    for (int q = 0; q < 4; ++q) { const float gg = fminf(gv[q], 7.f), uu = fminf(fmaxf(uv[q], -7.f), 7.f);
                        hv[q] = gg * __builtin_amdgcn_rcpf(1.f + __builtin_amdgcn_exp2f(-1.702f * LOG2E * gg)) * (uu * F8_SHD + F8_SHD); }
                    o[n] = pk4_fp8_nc(hv[0], hv[1], hv[2], hv[3]);
                }
                *(u32x2*)(Hd + (size_t)(row0 + ai * HALF + m * 16) * 1024 + cg0) = o;
            }
    }
};
struct EpiBf16Bias {
    static constexpr bool LDSBIAS = true; static constexpr bool PERM = true;
    unsigned char* Op; const float* bias; int bias_estride; float scale;
    __device__ __forceinline__ const char* bias_base(const Unit& u) const { return (const char*)(bias + (size_t)u.e * bias_estride + u.pn * BM); }
    __device__ __forceinline__ unsigned bias_voff(int lane) const { return (unsigned)(lane * 16); }
    __device__ __forceinline__ void operator()(const f32x4 (&acc)[2][2][4][2], const Unit& u, int wr, int wc, int fr, int fq, const LAS float* bl) const {
        const int row0 = u.pm * BM + wr * 64 + fr, col0 = u.pn * BM + wc * 32 + 8 * fq;
#pragma unroll
        for (int bj = 0; bj < 2; ++bj) {
            const int col = col0 + bj * HALF;
            if (!((u.bmask >> bj) & 1)) continue;
            const f32x4 b0 = *(const LAS f32x4*)(bl + bj * HALF + wc * 32 + 8 * fq) * F8_SO, b1 = *(const LAS f32x4*)(bl + bj * HALF + wc * 32 + 8 * fq + 4) * F8_SO;
#pragma unroll
            for (int ai = 0; ai < 2; ++ai)
#pragma unroll
                for (int m = 0; m < 4; ++m) { if (!((u.amask >> ai) & 1)) continue; const f32x4 v0 = acc[ai][bj][m][0] * (scale * F8_SO) + b0, v1 = acc[ai][bj][m][1] * (scale * F8_SO) + b1;
                    u32x2 o; o.x = pk4_fp8(v0[0], v0[1], v0[2], v0[3]); o.y = pk4_fp8(v1[0], v1[1], v1[2], v1[3]);
                    *(u32x2*)(Op + (size_t)(row0 + ai * HALF + m * 16) * 1024 + col) = o; }
        }
    }
};
struct EpiQKV {
    static constexpr bool LDSBIAS = false; static constexpr bool PERM = false;
    bf16_t* Qp; bf16_t* Kp; bf16_t* Vp; const float* bias; const float* tab;
    __device__ __forceinline__ void operator()(const f32x4 (&acc)[2][2][4][2], const Unit& u, int wr, int wc, int fr, int fq, const LAS float* bl) const {
        const bool lat = u.pm > 0; const float qs = 0.125f * LOG2E;
#pragma unroll
        for (int bj = 0; bj < 2; ++bj) {
            const int colt = u.pn * BM + bj * HALF + wc * 32 + 4 * fq;
            const f32x4 b1 = *(const f32x4*)(bias + colt), b2 = *(const f32x4*)(bias + colt + 16);
            const bool isv = (u.pn == 4) && (bj == 1);
            if (!((u.bmask >> bj) & 1)) continue;
#pragma unroll
            for (int ai = 0; ai < 2; ++ai)
#pragma unroll
                for (int m = 0; m < 4; ++m) {
                    if (!((u.amask >> ai) & 1)) continue;
                    const int r = u.pm * BM + ai * HALF + wr * 64 + m * 16 + fr, t = r - C;
                    f32x4 x1 = acc[ai][bj][m][0] + b1, x2 = acc[ai][bj][m][1] + b2;
                    if (lat && !isv) {
                        const int pos = (wc & 1) ? (t & 63) : (t >> 6);
                        const f32x4 t0 = *(const f32x4*)(tab + (pos * 16 + 4 * fq) * 2), t1 = *(const f32x4*)(tab + (pos * 16 + 4 * fq) * 2 + 4);
                        const float cs[4] = {t0[0], t0[2], t1[0], t1[2]}, sn[4] = {t0[1], t0[3], t1[1], t1[3]};
                        f32x4 o1, o2;
#pragma unroll
                        for (int e = 0; e < 4; ++e) { o1[e] = x1[e] * cs[e] - x2[e] * sn[e]; o2[e] = x2[e] * cs[e] + x1[e] * sn[e]; }
                        x1 = o1; x2 = o2;
                    }
                    u32x2 w1, w2;
                    if (u.pn < 4) {
                        w1.x = pk2(x1[0] * qs, x1[1] * qs); w1.y = pk2(x1[2] * qs, x1[3] * qs); w2.x = pk2(x2[0] * qs, x2[1] * qs); w2.y = pk2(x2[2] * qs, x2[3] * qs);
                        *(u32x2*)(Qp + (size_t)r * 1024 + colt) = w1; *(u32x2*)(Qp + (size_t)r * 1024 + colt + 16) = w2;
                    } else {
                        w1.x = pk2(x1[0], x1[1]); w1.y = pk2(x1[2], x1[3]); w2.x = pk2(x2[0], x2[1]); w2.y = pk2(x2[2], x2[3]);
                        bf16_t* dst = (bj == 0 ? Kp : Vp) + (size_t)r * 128 + wc * 32 + 4 * fq;
                        *(u32x2*)dst = w1; *(u32x2*)(dst + 16) = w2;
                    }
                }
        }
    }
};
struct EpiInProj {
    static constexpr bool LDSBIAS = false; static constexpr bool PERM = true;
    bf16_t* QH; _Float16* KF; _Float16* KB; bf16_t* IV; bf16_t* SG; const float* lb; float scale;
    __device__ __forceinline__ void operator()(const f32x4 (&acc)[2][2][4][2], const Unit& u, int wr, int wc, int fr, int fq, const LAS float* bl) const {
        const int seg = u.pn >> 2; const bool lat = u.pm > 0;
        if (!lat && (seg == 0 || seg == 4)) return;
        typedef _Float16 h8_t __attribute__((ext_vector_type(8)));
#pragma unroll
        for (int bj = 0; bj < 2; ++bj) {
            const int col = (u.pn & 3) * BM + bj * HALF + wc * 32 + 8 * fq;
            if (!((u.bmask >> bj) & 1)) continue;
            f32x4 lb0 = (f32x4){0.f, 0.f, 0.f, 0.f}, lb1 = lb0;
            if (seg == 1) { lb0 = *(const f32x4*)(lb + col); lb1 = *(const f32x4*)(lb + col + 4); } else if (seg == 2) { lb0 = *(const f32x4*)(lb + 1024 + col); lb1 = *(const f32x4*)(lb + 1024 + col + 4); }
#pragma unroll
            for (int ai = 0; ai < 2; ++ai)
#pragma unroll
                for (int m = 0; m < 4; ++m) {
                    if (!((u.amask >> ai) & 1)) continue;
                    const int r = u.pm * BM + ai * HALF + wr * 64 + m * 16 + fr; const f32x4 v0 = acc[ai][bj][m][0] * scale, v1 = acc[ai][bj][m][1] * scale;
                    if (seg == 1 || seg == 2) {
                        h8_t hv;
#pragma unroll
                        for (int e = 0; e < 4; ++e) { hv[e] = (_Float16)((1.f - lb0[e]) * __builtin_amdgcn_rcpf(1.f + __builtin_amdgcn_exp2f(LOG2E * v0[e]))); hv[4 + e] = (_Float16)((1.f - lb1[e]) * __builtin_amdgcn_rcpf(1.f + __builtin_amdgcn_exp2f(LOG2E * v1[e]))); }
                        *(h8_t*)((seg == 1 ? KF : KB) + (size_t)r * 1024 + col) = hv;
                    } else if (seg == 3) {
                        u32x4 o; o.x = pk2(v0[0], v0[1]); o.y = pk2(v0[2], v0[3]); o.z = pk2(v1[0], v1[1]); o.w = pk2(v1[2], v1[3]); *(u32x4*)(IV + (size_t)r * 1024 + col) = o;
                    } else {
                        float s0[4], s1[4];
#pragma unroll
                        for (int e = 0; e < 4; ++e) { s0[e] = v0[e] * __builtin_amdgcn_rcpf(1.f + __builtin_amdgcn_exp2f(-LOG2E * v0[e])); s1[e] = v1[e] * __builtin_amdgcn_rcpf(1.f + __builtin_amdgcn_exp2f(-LOG2E * v1[e])); }
                        u32x4 o; o.x = pk2(s0[0], s0[1]); o.y = pk2(s0[2], s0[3]); o.z = pk2(s1[0], s1[1]); o.w = pk2(s1[2], s1[3]); *(u32x4*)((seg == 0 ? QH : SG) + (size_t)(r - C) * 1024 + col) = o;
                    }
                }
        }
    }
};

typedef int v8i __attribute__((ext_vector_type(8)));
typedef int v4i __attribute__((ext_vector_type(4)));
template <class Epi, class Sched, bool ALIGN_EPI, bool GATHER, bool FP8>
__device__ __forceinline__ void gemm_phase(LAS unsigned char* lds, const Gemm g, const Sched& S, const Epi& E, const int tid) {
    const int wid = __builtin_amdgcn_readfirstlane(tid >> 6), lane = tid & 63, wr = wid >> 2, wc = wid & 3, fr = lane & 15, fq = lane >> 4;
    constexpr int KB = FP8 ? 1024 : 2048, nt = 1024 / (FP8 ? 128 : 64);
    int sR[2], sC[2]; unsigned voffB[2], voffA[2];
#pragma unroll
    for (int i = 0; i < 2; ++i) { stage_rc(tid * 16 + i * 8192, sR[i], sC[i]); const int Rb = Epi::PERM ? ((sR[i] & ~31) + perm32(sR[i] & 31)) : sR[i]; voffB[i] = (unsigned)(Rb * KB + sC[i] * 2); voffA[i] = (unsigned)(sR[i] * KB + sC[i] * 2); }
    constexpr size_t kstep = (size_t)(BK * 2), hstep = (size_t)HALF * KB, tstep = 2 * hstep;
    const unsigned ldsw = (unsigned)wid * 1024u;
    const int aoff = lds_byte(wr * 64 + fr, fq * 8), boff = lds_byte(wc * 32 + fr, fq * 8);
    const char* Ab = (const char*)g.A;
#define PG8_SA(b, h) (((b) * 2 + (h)) * HTB)
#define PG8_SB(b, h) ((4 + (b) * 2 + (h)) * HTB)
#define PG8_STAGE_B(bufoff, gbase) do { _Pragma("unroll") for (int _i = 0; _i < 2; ++_i) \
        __builtin_amdgcn_global_load_lds((const unsigned*)((const char*)(gbase) + voffB[_i]), (LAS unsigned*)(lds + (bufoff) + ldsw + _i * 8192), 16, 0, 0); } while (0)
#define PG8_STAGE_A(bufoff, kb, v, ubase) do { _Pragma("unroll") for (int _i = 0; _i < 2; ++_i) \
        __builtin_amdgcn_global_load_lds((const unsigned*)((GATHER ? Ab : (ubase)) + (size_t)(kb) + (GATHER ? (v)[_i] : voffA[_i])), (LAS unsigned*)(lds + (bufoff) + ldsw + _i * 8192), 16, 0, 0); } while (0)
#define PG8_LD8(p) __builtin_shufflevector(*(const LAS v4i*)(p), *(const LAS v4i*)((p) + 1024), 0, 1, 2, 3, 4, 5, 6, 7)
#define PG8_LDA(dst, b, h) do { if constexpr (FP8) { _Pragma("unroll") for (int m = 0; m < 4; ++m) dst##8[m] = PG8_LD8(lds + PG8_SA(b, h) + aoff + m * 2048); } else { _Pragma("unroll") for (int m = 0; m < 4; ++m) _Pragma("unroll") for (int k = 0; k < 2; ++k) dst[m][k] = *(const LAS bf16x8*)(lds + PG8_SA(b, h) + aoff + m * 2048 + k * 1024); } } while (0)
#define PG8_LDB(dst, b, h) do { if constexpr (FP8) { _Pragma("unroll") for (int n = 0; n < 2; ++n) dst##8[n] = PG8_LD8(lds + PG8_SB(b, h) + boff + n * 2048); } else { _Pragma("unroll") for (int n = 0; n < 2; ++n) _Pragma("unroll") for (int k = 0; k < 2; ++k) dst[n][k] = *(const LAS bf16x8*)(lds + PG8_SB(b, h) + boff + n * 2048 + k * 1024); } } while (0)
#define PG8_MMA(ai, bj, At, Bt) do { __builtin_amdgcn_s_setprio(1); if constexpr (FP8) { _Pragma("unroll") for (int m = 0; m < 4; ++m) _Pragma("unroll") for (int n = 0; n < 2; ++n) \
        asm volatile("v_mfma_scale_f32_16x16x128_f8f6f4 %0, %1, %2, %0, %3, %3 op_sel_hi:[0,0,0]" : "+v"(acc[ai][bj][m][n]) : "v"(Bt##8[n]), "v"(At##8[m]), "v"(unit_scale)); } else { \
        _Pragma("unroll") for (int m = 0; m < 4; ++m) _Pragma("unroll") for (int n = 0; n < 2; ++n) _Pragma("unroll") for (int k = 0; k < 2; ++k) \
        acc[ai][bj][m][n] = __builtin_amdgcn_mfma_f32_16x16x32_bf16(Bt[n][k], At[m][k], acc[ai][bj][m][n], 0, 0, 0); } __builtin_amdgcn_s_setprio(0); } while (0)
#define PG8_WAIT_V(n) asm volatile("s_waitcnt vmcnt(" #n ")" ::: "memory")
#define PG8_WAIT_L(n) asm volatile("s_waitcnt lgkmcnt(" #n ")" ::: "memory")
#define PG8_BAR __builtin_amdgcn_s_barrier()
#define PG8_SCHED __builtin_amdgcn_sched_barrier(0)
    Unit cur, nxt; int ui = 0;
    if (!S.next(0, cur)) return;
    unsigned cv[2][2]; int nvr[2][2];
    if constexpr (GATHER) a_offsets<KB>(g, cur, sR, sC, cv);
    const char* cA = Ab + (size_t)cur.pm * tstep; const char* nA = cA;
    f32x4 acc[2][2][4][2];
#pragma unroll
    for (int a = 0; a < 2; ++a)
#pragma unroll
        for (int b = 0; b < 2; ++b)
#pragma unroll
            for (int m = 0; m < 4; ++m)
#pragma unroll
                for (int n = 0; n < 2; ++n) acc[a][b][m][n] = (f32x4){0.f, 0.f, 0.f, 0.f};
    bf16x8 At[4][2], B0[2][2], B1[2][2]; v8i At8[4], B08[2], B18[2];
    int unit_scale = 0x7f7f7f7f; asm volatile("" : "+v"(unit_scale));
    const char* cB = (const char*)g.Bt + (size_t)cur.e * g.bstride + (size_t)cur.pn * tstep;
#define PG8_BIAS(uu, slot) do { if constexpr (Epi::LDSBIAS) { if (wid == 0) { int l_ = lane; asm volatile("" : "+v"(l_)); \
        __builtin_amdgcn_global_load_lds((const unsigned*)(E.bias_base(uu) + E.bias_voff(l_)), (LAS unsigned*)(lds + STAGE_BYTES + 4096 + (slot) * 1024), 16, 0, 0); } } } while (0)
    PG8_BIAS(cur, 0);
    PG8_STAGE_B(PG8_SB(0, 0), cB); PG8_STAGE_B(PG8_SB(0, 1), cB + hstep); PG8_STAGE_A(PG8_SA(0, 0), 0, cv[0], cA); PG8_STAGE_A(PG8_SA(0, 1), 0, cv[1], cA + hstep);
    if (wr == 1) PG8_BAR;
    PG8_WAIT_V(2); PG8_BAR;
    PG8_STAGE_B(PG8_SB(1, 0), cB + kstep); PG8_STAGE_A(PG8_SA(1, 0), kstep, cv[0], cA); PG8_STAGE_B(PG8_SB(1, 1), cB + hstep + kstep);
    PG8_WAIT_V(6); PG8_BAR;
    for (;;) {
        const bool has_next = S.next(ui + 1, nxt);
        const char* nB = cB;
        nA = cA;
        if (has_next) { PG8_BIAS(nxt, (ui + 1) % 3); if constexpr (GATHER) a_rows(g, nxt, sR, nvr); nA = Ab + (size_t)nxt.pm * tstep; nB = (const char*)g.Bt + (size_t)nxt.e * g.bstride + (size_t)nxt.pn * tstep; }

        const int ntr = (PROBE_SHORTK && !cur.real) ? 2 : nt;
        const bool m00 = (cur.amask & 1) && (cur.bmask & 1), m01 = (cur.amask & 1) && (cur.bmask & 2), m10 = (cur.amask & 2) && (cur.bmask & 1), m11 = (cur.amask & 2) && (cur.bmask & 2);
#pragma nounroll
        for (int t = 0; t < ntr; t += 2) {
            const bool last = (t == ntr - 2);
            if constexpr (GATHER) { if (last && has_next) asm volatile("" : "+v"(nvr[0][0]), "+v"(nvr[0][1]), "+v"(nvr[1][0]), "+v"(nvr[1][1])); }
            const size_t k1 = (size_t)(t + 1) * kstep, k2 = last ? 0 : (size_t)(t + 2) * kstep, k3 = k2 + kstep;
            const char* b2 = last ? nB : cB + (size_t)(t + 2) * kstep; const char* b3 = b2 + kstep;
            unsigned w0[2], w1[2];
            if constexpr (GATHER) {
#pragma unroll
                for (int i = 0; i < 2; ++i) { w0[i] = (last && has_next) ? (unsigned)(nvr[0][i] * KB + sC[i] * 2) : cv[0][i]; w1[i] = (last && has_next) ? (unsigned)(nvr[1][i] * KB + sC[i] * 2) : cv[1][i]; }
            }
            const char* a2 = last ? nA : cA;
            PG8_LDB(B0, 0, 0); PG8_LDB(B1, 0, 1); PG8_SCHED; PG8_LDA(At, 0, 0); PG8_STAGE_A(PG8_SA(1, 1), k1, cv[1], cA + hstep);
            PG8_WAIT_V(8); PG8_WAIT_L(0); PG8_BAR; if (m00) PG8_MMA(0, 0, At, B0); if (m01) PG8_MMA(0, 1, At, B1); PG8_BAR; PG8_SCHED;
            PG8_LDA(At, 0, 1); PG8_STAGE_B(PG8_SB(0, 0), b2); PG8_STAGE_B(PG8_SB(0, 1), b2 + hstep); PG8_STAGE_A(PG8_SA(0, 0), k2, w0, a2);
            PG8_WAIT_V(8); PG8_WAIT_L(0); PG8_BAR; if (m10) PG8_MMA(1, 0, At, B0); if (m11) PG8_MMA(1, 1, At, B1); PG8_BAR; PG8_SCHED;
            PG8_LDB(B0, 1, 0); PG8_LDB(B1, 1, 1); PG8_SCHED; PG8_LDA(At, 1, 0); PG8_STAGE_A(PG8_SA(0, 1), k2, w1, a2 + hstep);
            PG8_WAIT_V(8); PG8_WAIT_L(0); PG8_BAR; if (m00) PG8_MMA(0, 0, At, B0); if (m01) PG8_MMA(0, 1, At, B1); PG8_BAR; PG8_SCHED;
            PG8_LDA(At, 1, 1); PG8_STAGE_B(PG8_SB(1, 0), b3); PG8_STAGE_B(PG8_SB(1, 1), b3 + hstep); PG8_STAGE_A(PG8_SA(1, 0), k3, w0, a2);
            PG8_WAIT_V(8); PG8_WAIT_L(0); PG8_BAR; if (m10) PG8_MMA(1, 0, At, B0); if (m11) PG8_MMA(1, 1, At, B1); PG8_BAR; PG8_SCHED;
        }
        if constexpr (ALIGN_EPI) { if (wr == 0) PG8_BAR; }
        if constexpr (FP8) asm volatile("s_nop 15\n\ts_nop 15" ::: "memory");
        if (!PROBE_NOEPI || cur.real) E(acc, cur, wr, wc, fr, fq, (const LAS float*)(lds + STAGE_BYTES + 4096 + (ui % 3) * 1024));
        if (!has_next) break;
#pragma unroll
        for (int a = 0; a < 2; ++a)
#pragma unroll
            for (int b = 0; b < 2; ++b)
#pragma unroll
                for (int m = 0; m < 4; ++m)
#pragma unroll
                    for (int n = 0; n < 2; ++n) acc[a][b][m][n] = (f32x4){0.f, 0.f, 0.f, 0.f};
        cur = nxt; cB = nB; cA = nA; ++ui;
        if constexpr (GATHER) {
#pragma unroll
            for (int h = 0; h < 2; ++h)
#pragma unroll
                for (int i = 0; i < 2; ++i) cv[h][i] = (unsigned)(nvr[h][i] * KB + sC[i] * 2);
        }
        if constexpr (ALIGN_EPI) { if (wr == 1) PG8_BAR; }
    }
    PG8_WAIT_V(0);
    if constexpr (!ALIGN_EPI) { if (wr == 0) PG8_BAR; }
    PG8_BAR;
#undef PG8_SA
#undef PG8_SB
#undef PG8_STAGE_A
#undef PG8_STAGE_B
#undef PG8_LDA
#undef PG8_BIAS
#undef PG8_LD8
#undef PG8_LDB
#undef PG8_MMA
#undef PG8_WAIT_V
#undef PG8_WAIT_L
#undef PG8_BAR
#undef PG8_SCHED
}
}

struct TBlk { const float* src; int ldw; bf16_t* dst; unsigned char* dst8; };
__device__ __forceinline__ void tb_load(const TBlk& t, int lane, f32x4 (&v)[16]) {
    const float* p = t.src + (size_t)(lane >> 4) * t.ldw + (lane & 15) * 4;
#pragma unroll
    for (int i = 0; i < 16; ++i) v[i] = *(const f32x4*)(p + (size_t)(4 * i) * t.ldw);
}
__device__ __forceinline__ void tb_store(const TBlk& t, int lane, const f32x4 (&v)[16], LAS float* scr) {
#pragma unroll
    for (int i = 0; i < 16; ++i) { LAS float* d = scr + ((lane >> 4) + 4 * i) * 65 + (lane & 15) * 4; d[0] = v[i].x; d[1] = v[i].y; d[2] = v[i].z; d[3] = v[i].w; }
    asm volatile("s_waitcnt lgkmcnt(0)" ::: "memory"); __builtin_amdgcn_wave_barrier();
    const int c8 = lane & 7;
#pragma unroll
    for (int jj = 0; jj < 8; ++jj) {
        const int n = (lane >> 3) + 8 * jj; const LAS float* p = scr + (8 * c8) * 65 + n;
        if (t.dst8) { u32x2 o; o.x = pk4_fp8(p[0] * F8_SW, p[65] * F8_SW, p[2 * 65] * F8_SW, p[3 * 65] * F8_SW); o.y = pk4_fp8(p[4 * 65] * F8_SW, p[5 * 65] * F8_SW, p[6 * 65] * F8_SW, p[7 * 65] * F8_SW);
            *(u32x2*)(t.dst8 + (size_t)n * 1024 + 8 * c8) = o; }
        else { u32x4 o; o.x = pk2(p[0], p[65]); o.y = pk2(p[2 * 65], p[3 * 65]); o.z = pk2(p[4 * 65], p[5 * 65]); o.w = pk2(p[6 * 65], p[7 * 65]);
            *(u32x4*)(t.dst + (size_t)n * 1024 + 8 * c8) = o; }
    }
    asm volatile("s_waitcnt lgkmcnt(0)" ::: "memory"); __builtin_amdgcn_wave_barrier();
}

__device__ __forceinline__ void phase_prep(const Ctx& c) {
    LAS float* red = (LAS float*)c.lds;
    LAS float* sil = red + 1024;
    const float* cv = c.a->in[1]; const float* ccv = c.a->in[3]; const float* ada_w = c.a->in[4]; const float* ada_b = c.a->in[5];
    for (int i = c.tid; i < 2048; i += 512) { const float x = i < 1024 ? cv[i] : ccv[i - 1024]; sil[i] = x * __builtin_amdgcn_rcpf(1.f + __builtin_amdgcn_exp2f(-LOG2E * x)); }
    __syncthreads();
    for (int item = c.wg; item < 193; item += c.nwg) {
        if (item < 192) {
            const int layer = item / 96, cb = item % 96, col = cb * 64 + c.lane;
            const float* W = ada_w + (size_t)layer * D * 6144 + col;
            float a0 = 0.f, a1 = 0.f;
            const int k0 = c.wave * 128;
#pragma unroll 32
            for (int k = 0; k < 128; ++k) { const float w = W[(size_t)(k0 + k) * 6144]; a0 += sil[k0 + k] * w; a1 += sil[1024 + k0 + k] * w; }
            red[(0 * 8 + c.wave) * 64 + c.lane] = a0; red[(1 * 8 + c.wave) * 64 + c.lane] = a1;
            __syncthreads();
            if (c.tid < 128) {
                const int which = c.tid >> 6, l = c.tid & 63; float s = 0.f;
#pragma unroll
                for (int w = 0; w < 8; ++w) s += red[(which * 8 + w) * 64 + l];
                c.modp(layer, which)[cb * 64 + l] = s + ada_b[layer * 6144 + cb * 64 + l];
            }
            __syncthreads();
        } else {
            float* modbase = (float*)(c.ws + WS_MOD);
            for (int i = c.tid; i < 4096; i += 512) {
                const int pos = i >> 4, j = i & 15;
                const double ang = (double)pos * pow(10000.0, -(double)j / 16.0);
                modbase[MOD_ROPE + 2 * i] = (float)cos(ang); modbase[MOD_ROPE + 2 * i + 1] = (float)sin(ang);
            }
            const float* lbp = c.a->in[12];
            for (int i = c.tid; i < 2048; i += 512) { const float p0 = lbp[i], p1 = lbp[2048 + i]; modbase[MOD_LB + i] = 1.f / (1.f + __expf(p0 - p1)); }
        }
    }
}

__device__ __forceinline__ void row_load(const float* p, int lane, f32x4 (&v)[4]) {
#pragma unroll
    for (int j = 0; j < 4; ++j) v[j] = *(const f32x4*)(p + lane * 4 + 256 * j);
}
__device__ __forceinline__ void row_load_bf(const bf16_t* p, int lane, f32x4 (&v)[4]) {
#pragma unroll
    for (int j = 0; j < 4; ++j) { const u32x2 w = *(const u32x2*)(p + lane * 4 + 256 * j); v[j] = (f32x4){bflo(w.x), bfhi(w.x), bflo(w.y), bfhi(w.y)}; }
}
__device__ __forceinline__ float row_ss(const f32x4 (&v)[4]) {
    float s = 0.f;
#pragma unroll
    for (int j = 0; j < 4; ++j) s += v[j].x * v[j].x + v[j].y * v[j].y + v[j].z * v[j].z + v[j].w * v[j].w;
    return wave_sum(s);
}
__device__ __forceinline__ void row_modnorm_store(const f32x4 (&x)[4], float rstd, const float* g, const float* sh, const float* sc, bf16_t* out, int lane, f32x4 (*hout)[4] = nullptr) {
#pragma unroll
    for (int j = 0; j < 4; ++j) {
        const int c0 = lane * 4 + 256 * j;
        const f32x4 gv = *(const f32x4*)(g + c0), shv = *(const f32x4*)(sh + c0), scv = *(const f32x4*)(sc + c0);
        f32x4 h;
        h.x = x[j].x * rstd * gv.x * (1.f + scv.x) + shv.x; h.y = x[j].y * rstd * gv.y * (1.f + scv.y) + shv.y;
        h.z = x[j].z * rstd * gv.z * (1.f + scv.z) + shv.z; h.w = x[j].w * rstd * gv.w * (1.f + scv.w) + shv.w;
        if (hout) (*hout)[j] = h;
        u32x2 o; o.x = pk2(h.x, h.y); o.y = pk2(h.z, h.w);
        *(u32x2*)(out + c0) = o;
    }
}

__device__ __forceinline__ void phase_norm0(const Ctx& c) {
    bf16_t* H = (bf16_t*)(c.ws + WS_H); const float* ng = c.a->in[6];
    int r = c.wg * 8 + c.wave;
    f32x4 xn[4];
    if (r < R) row_load(c.xin0(r), c.lane, xn);
    for (; r < R; r += c.nwg * 8) {
        f32x4 x[4];
#pragma unroll
        for (int j = 0; j < 4; ++j) x[j] = xn[j];
        if (r + c.nwg * 8 < R) row_load(c.xin0(r + c.nwg * 8), c.lane, xn);
        const float rstd = rsqrtf(row_ss(x) * (1.f / D) + EPS);
        const float* m = c.modp(0, r < C ? 1 : 0);
        row_modnorm_store(x, rstd, ng, m + 0, m + 1024, H + (size_t)r * D, c.lane);
    }
}

namespace at {
__device__ __forceinline__ float max3f(float a, float b, float c) { return __builtin_fmaxf(__builtin_fmaxf(a, b), c); }
constexpr int KP = 144, TILEB = 64 * KP;
__device__ __forceinline__ bf16x8 tr_frag2(const LAS unsigned char* tile, int row0, int col0, int lane) {
    const int q = (lane & 15) >> 2, p = lane & 3;
    const LAS unsigned char* a = tile + (row0 + q) * KP + (col0 + 4 * p) * 2;
    const v4i16_t lo = __builtin_amdgcn_ds_read_tr16_b64_v4i16((LAS v4i16_t*)a);
    const v4i16_t hi = __builtin_amdgcn_ds_read_tr16_b64_v4i16((LAS v4i16_t*)(a + 16 * KP));
    return (bf16x8){lo[0], lo[1], lo[2], lo[3], hi[0], hi[1], hi[2], hi[3]};
}
}
__device__ __forceinline__ void phase_attn(const Ctx& c) {
    using namespace at;
    const bf16_t* Q = (const bf16_t*)(c.ws + WS_Q); const bf16_t* K = (const bf16_t*)(c.ws + WS_K); const bf16_t* V = (const bf16_t*)(c.ws + WS_V);
    bf16_t* O = (bf16_t*)(c.ws + WS_O); const float* sink = c.a->in[9];
    LAS unsigned char* lds = c.lds;
    const int tid = c.tid, lane = c.lane, w = __builtin_amdgcn_readfirstlane(tid >> 6), fr = lane & 15, g = lane >> 4;
    const int lrow = tid >> 3, lch = tid & 7;
    const int nitn = c.nwg == 256 ? 2 : (264 - c.wg + c.nwg - 1) / c.nwg;
    for (int itn = 0; itn < nitn; ++itn) {
        int item = c.wg + itn * c.nwg;
        if (c.nwg == 256 && itn == 1) { const int n_ = c.wg >> 1; item = -1;
            if (n_ == 0) item = 256 + (c.wg & 1); else if (n_ == 127) item = 258 + (c.wg & 1); else if (n_ == 30 || n_ == 31) item = 260 + (c.wg - 60); }
        if (item < 0 || item >= 264) continue;
        const bool isctx = item >= 256;
        const int ci = item - 256;
        const int n = isctx ? 0 : (item >> 1), kh = isctx ? ((ci >> 1) & 1) : (item & 1), cb = isctx ? (ci >> 2) : 0;
        const int p_lo = isctx ? (ci & 1) : 0, p_hi = isctx ? (ci & 1) + 1 : 2;
        const int hq = kh * 8 + w;
        const float sink2 = sink[hq] * LOG2E;
        for (int pass = p_lo; pass < p_hi; ++pass) {
            const int t0 = 128 * n + 64 * pass, qrow0 = isctx ? cb * 128 + 64 * pass : C + t0;
            const int jlo = isctx ? 0 : (t0 >= 128 ? 0 : (128 - t0) / 64), jhi = isctx ? 0 : ((L - t0 + 128) / 64 < 5 ? (L - t0 + 128) / 64 : 5);
            const int ntile = 4 + (jhi - jlo);
            LAS unsigned char* qlds = lds + 4 * TILEB + w * TILEB;
#pragma unroll
            for (int qb = 0; qb < 4; ++qb)
#pragma unroll
                for (int ks = 0; ks < 2; ++ks) *(LAS bf16x8*)(qlds + (16 * qb + fr) * KP + (32 * ks + 8 * g) * 2) = *(const bf16x8*)(Q + (size_t)(qrow0 + 16 * qb + fr) * D + hq * 64 + 32 * ks + 8 * g);
            float mrow[4], lsum[4]; f32x4 OT[4][4];
#pragma unroll
            for (int qb = 0; qb < 4; ++qb) { mrow[qb] = sink2; lsum[qb] = 1.f;
#pragma unroll
                for (int nt = 0; nt < 4; ++nt) OT[qb][nt] = (f32x4){0.f, 0.f, 0.f, 0.f}; }
            u32x4 kreg, vreg;
#define AT_KROW(ti) ((ti) < 4 ? 64 * (ti) : C + t0 - 128 + 64 * (jlo + (ti) - 4))
#define AT_LOAD(ti) do { const size_t ro_ = (size_t)(AT_KROW(ti) + lrow) * 128 + kh * 64 + lch * 8; kreg = *(const u32x4*)(K + ro_); vreg = *(const u32x4*)(V + ro_); } while (0)
#define AT_WRITE(buf) do { *(LAS u32x4*)(lds + (buf) * 2 * TILEB + lrow * KP + lch * 16) = kreg; *(LAS u32x4*)(lds + (buf) * 2 * TILEB + TILEB + lrow * KP + lch * 16) = vreg; } while (0)
            AT_LOAD(0); AT_WRITE(0);
            __syncthreads();
            for (int ti = 0; ti < ntile; ++ti) {
                if (ti + 1 < ntile) AT_LOAD(ti + 1);
                const LAS unsigned char* kb = lds + (ti & 1) * 2 * TILEB; const LAS unsigned char* vb = kb + TILEB;
                const int jj = jlo + ti - 4; const bool mlo_t = (ti >= 4) && jj == 0, mup_t = (ti >= 4) && jj == 4;
                const float fl = mlo_t ? -INFINITY : 0.f, fu = mup_t ? -INFINITY : 0.f;
                const f32x4 mlow = (f32x4){fl, fl, fl, fl}, mup = (f32x4){fu, fu, fu, fu};
                f32x4 mdiag;
#pragma unroll
                for (int e = 0; e < 4; ++e) mdiag[e] = (mlo_t && fr > 4 * g + e) || (mup_t && fr < 4 * g + e) ? -INFINITY : 0.f;
                bf16x8 Kf[4][2];
#pragma unroll
                for (int mt = 0; mt < 4; ++mt)
#pragma unroll
                    for (int ks = 0; ks < 2; ++ks) Kf[mt][ks] = *(const LAS bf16x8*)(kb + (16 * mt + fr) * KP + (32 * ks + 8 * g) * 2);
                bf16x8 Vf[4][2];
#pragma unroll
                for (int mt = 0; mt < 4; ++mt)
#pragma unroll
                    for (int ks = 0; ks < 2; ++ks)
                        Vf[mt][ks] = tr_frag2(vb, 32 * ks + 4 * g, 16 * mt, lane);
#define AT_QB(qb) do { \
                    bf16x8 Qq[2]; \
                    _Pragma("unroll") for (int ks = 0; ks < 2; ++ks) Qq[ks] = *(const LAS bf16x8*)(qlds + (16 * (qb) + fr) * KP + (32 * ks + 8 * g) * 2); \
                    f32x4 sa[4]; \
                    _Pragma("unroll") for (int mt = 0; mt < 4; ++mt) { sa[mt] = (qb) == mt ? mdiag : ((qb) > mt ? mlow : mup);     \
                        _Pragma("unroll") for (int ks = 0; ks < 2; ++ks) sa[mt] = __builtin_amdgcn_mfma_f32_16x16x32_bf16(Kf[mt][ks], Qq[ks], sa[mt], 0, 0, 0); } \
                    float mx = max3f(sa[0][0], sa[0][1], sa[0][2]), my = max3f(sa[0][3], sa[1][0], sa[1][1]); \
                    mx = max3f(mx, sa[1][2], sa[1][3]); my = max3f(my, sa[2][0], sa[2][1]); mx = max3f(mx, sa[2][2], sa[2][3]); my = max3f(my, sa[3][0], sa[3][1]); mx = max3f(mx, sa[3][2], sa[3][3]); \
                    mx = max3f(mx, my, mrow[qb]); \
                    const float mn = xmax32(xmax16(mx)); \
                    const float alpha = __builtin_amdgcn_exp2f(mrow[qb] - mn); \
                    mrow[qb] = mn; \
                    float rs = 0.f; \
                    _Pragma("unroll") for (int mt = 0; mt < 4; ++mt) _Pragma("unroll") for (int e = 0; e < 4; ++e) { const float pv = __builtin_amdgcn_exp2f(sa[mt][e] - mn); sa[mt][e] = pv; rs += pv; } \
                    rs = xadd32(xadd16(rs)); \
                    lsum[qb] = lsum[qb] * alpha + rs; \
                    bf16x8 Pb[2]; \
                    _Pragma("unroll") for (int ks = 0; ks < 2; ++ks) { const f32x4 a0 = sa[2 * ks], a1 = sa[2 * ks + 1]; \
                        const u32x4 pk = (u32x4){pk2(a0[0], a0[1]), pk2(a0[2], a0[3]), pk2(a1[0], a1[1]), pk2(a1[2], a1[3])}; Pb[ks] = __builtin_bit_cast(bf16x8, pk); } \
                    _Pragma("unroll") for (int nt = 0; nt < 4; ++nt) { OT[qb][nt] = OT[qb][nt] * alpha; \
                        _Pragma("unroll") for (int ks = 0; ks < 2; ++ks) OT[qb][nt] = __builtin_amdgcn_mfma_f32_16x16x32_bf16(Vf[nt][ks], Pb[ks], OT[qb][nt], 0, 0, 0); } } while (0)
                AT_QB(0); AT_QB(1); AT_QB(2); AT_QB(3);
#undef AT_QB
                if (ti + 1 < ntile) AT_WRITE((ti + 1) & 1);
                __syncthreads();
            }
#undef AT_KROW
#undef AT_LOAD
#undef AT_WRITE
#pragma unroll
            for (int qb = 0; qb < 4; ++qb) {
                const float il = 1.f / lsum[qb];
                bf16_t* op = O + (size_t)(qrow0 + 16 * qb + fr) * D + hq * 64 + 4 * g;
#pragma unroll
                for (int nt = 0; nt < 4; ++nt) { const f32x4 v = OT[qb][nt] * il; u32x2 o; o.x = pk2(v[0], v[1]); o.y = pk2(v[2], v[3]); *(u32x2*)(op + 16 * nt) = o; }
            }
        }
    }
}

template <int GS>
__device__ __forceinline__ void phase_postmix(const Ctx& c, int layer, bool route) {
    const bf16_t* Y = (const bf16_t*)(c.ws + WS_RAW1); unsigned char* H8 = c.ws + WS_H8;
    bf16_t* Xout = (bf16_t*)(c.ws + (layer == 0 ? WS_X : WS_X1)); const bf16_t* Xprev = (const bf16_t*)(c.ws + WS_X);
    const float* ng = c.a->in[6] + layer * 4 * D; const float* Wr = c.a->in[15] + (size_t)layer * D * NE; const float* br = c.a->in[16] + layer * NE;
    unsigned* cnt = (unsigned*)(c.ws + WS_CTL) + CW_CNT + layer * NE;
    int* tk_e = (int*)(c.ws + WS_TK); float* tk_g = (float*)(c.ws + WS_TK) + R * 4; int* tk_slot = (int*)(c.ws + WS_TK) + 2 * R * 4;
    int* list = (int*)(c.ws + WS_LIST);
    LAS float* WL = (LAS float*)c.lds;
    LAS float* biasp = (LAS float*)(c.lds + 131072);
    LAS unsigned* lcnt = (LAS unsigned*)(c.lds + 145920); LAS unsigned* lbase = lcnt + 32; LAS float* rsx = (LAS float*)(lcnt + 64);
    LAS float* pvA = (LAS float*)(c.lds + 131072 + 2560); LAS float* pvB = pvA + 1024; LAS float* pvS = pvB + 1024;
    const int lane = c.lane, w = __builtin_amdgcn_readfirstlane(c.tid >> 6), fr = lane & 15, g = lane >> 4;
    constexpr int RP = GS / 8, NW2 = GS / 16;
    const int g_lo = layer == 0 ? 0 : C / GS;
    for (int grp = g_lo + c.wg; grp < R / GS; grp += c.nwg) {
        const int which = grp * GS < C ? 1 : 0;
        const float* m = c.modp(layer, which);
        __syncthreads();
        if (c.tid < NE) lcnt[c.tid] = 0u;
#pragma unroll 4
        for (int j = 0; j < 16; ++j) {
            const int i4 = c.tid + 512 * j, k = i4 >> 3, e0 = (i4 & 7) * 4;
            const f32x4 wv = *(const f32x4*)(Wr + (size_t)k * NE + e0); const float sc = ng[2 * D + k] * (1.f + m[4096 + k]);
            LAS float* dst = WL + ((((k >> 4) * 4 + (k & 3)) * 4 + ((k >> 2) & 3)) * 16) * 2;
#pragma unroll
            for (int q = 0; q < 4; ++q) { const int e = e0 + q; dst[(e & 15) * 2 + (e >> 4)] = wv[q] * sc; }
        }
        for (int k = c.tid; k < D; k += 512) { pvA[k] = m[2048 + k] * ng[D + k]; pvB[k] = ng[2 * D + k] * (1.f + m[4096 + k]); pvS[k] = m[3072 + k]; }
        { const int e = c.tid & 31, part = c.tid >> 5; float sacc = 0.f;
#pragma unroll 16
          for (int k = part * 64; k < part * 64 + 64; ++k) sacc += m[3072 + k] * Wr[k * NE + e];
          biasp[32 + part * 32 + e] = sacc; }
        __syncthreads();
        if (c.tid < 32) { float sacc = br[c.tid];
#pragma unroll
            for (int p = 0; p < 16; ++p) sacc += biasp[32 + p * 32 + c.tid]; biasp[c.tid] = sacc; }
        __syncthreads();
        const int row1 = grp * GS + w * RP;
        f32x4 y0[4], x0[4], y1[4], x1[4], yn0[4], xn0[4], yn1[4], xn1[4];
#define PM_LOAD(RW, YY, XX) do { row_load_bf(Y + (size_t)(layer == 0 ? (RW) : (RW) - C) * D, lane, YY); if (layer == 0) row_load(c.xin0(RW), lane, XX); else row_load_bf(Xprev + (size_t)(RW) * D, lane, XX); } while (0)
#define PM_ROW(RW, YY, XX, II) do { \
            const float rstd_y = rsqrtf(row_ss(YY) * (1.f / D) + EPS); \
            _Pragma("unroll") for (int j = 0; j < 4; ++j) { const int c0 = lane * 4 + 256 * j; \
                XX[j] += *(const LAS f32x4*)(pvA + c0) * (YY[j] * rstd_y); \
                u32x2 xo; xo[0] = pk2(XX[j][0], XX[j][1]); xo[1] = pk2(XX[j][2], XX[j][3]); *(u32x2*)(Xout + (size_t)(RW) * D + c0) = xo; \
                XX[j] = (f32x4){bflo(xo[0]), bfhi(xo[0]), bflo(xo[1]), bfhi(xo[1])}; }     \
            const float rstd_x = rsqrtf(row_ss(XX) * (1.f / D) + EPS); \
            _Pragma("unroll") for (int j = 0; j < 4; ++j) { const int c0 = lane * 4 + 256 * j; \
                const f32x4 hv = XX[j] * rstd_x * *(const LAS f32x4*)(pvB + c0) + *(const LAS f32x4*)(pvS + c0); \
                *(unsigned*)(H8 + (size_t)(RW) * D + c0) = pk4_fp8(hv[0] * F8_SH, hv[1] * F8_SH, hv[2] * F8_SH, hv[3] * F8_SH); } \
            if (lane == 0) rsx[w * RP + (II)] = rstd_x; } while (0)
        PM_LOAD(row1, yn0, xn0); PM_LOAD(row1 + 1, yn1, xn1);
        for (int i = 0; i < RP; i += 2) {
            const int r = row1 + i;
#pragma unroll
            for (int j = 0; j < 4; ++j) { y0[j] = yn0[j]; x0[j] = xn0[j]; y1[j] = yn1[j]; x1[j] = xn1[j]; }
            if (i + 2 < RP) { PM_LOAD(r + 2, yn0, xn0); PM_LOAD(r + 3, yn1, xn1); }
            PM_ROW(r, y0, x0, i);
            PM_ROW(r + 1, y1, x1, i + 1);
        }
#undef PM_LOAD
#undef PM_ROW
        asm volatile("s_waitcnt vmcnt(0)" ::: "memory");
        __syncthreads();
        const int row0 = grp * GS + w * 16; const bool w2 = w < NW2;
        f32x4 la[2]; la[0] = (f32x4){0.f, 0.f, 0.f, 0.f}; la[1] = la[0];
        if (w2) {
            const bf16_t* ap = Xout + (size_t)(row0 + fr) * D + 4 * g;
            const LAS float* bp = WL + (g * 16 + fr) * 2;
#pragma unroll 4
            for (int k4 = 0; k4 < 64; ++k4) {
                const u32x2 aw = *(const u32x2*)(ap + 16 * k4); const f32x4 a4 = (f32x4){bflo(aw.x), bfhi(aw.x), bflo(aw.y), bfhi(aw.y)};
#pragma unroll
                for (int q = 0; q < 4; ++q) {
                    const f32x2 b2 = *(const LAS f32x2*)(bp + (size_t)(4 * k4 + q) * 128);
                    la[0] = __builtin_amdgcn_mfma_f32_16x16x4f32(a4[q], b2[0], la[0], 0, 0, 0);
                    la[1] = __builtin_amdgcn_mfma_f32_16x16x4f32(a4[q], b2[1], la[1], 0, 0, 0);
                }
            }
        }
        float tv[4][4]; int te[4][4];
#pragma unroll
        for (int e = 0; e < 4; ++e) {
            const float rs = rsx[(w2 ? w * 16 : 0) + 4 * g + e];
            float v0 = la[0][e] * rs + biasp[fr], v1 = la[1][e] * rs + biasp[16 + fr];
#pragma unroll
            for (int k = 0; k < 4; ++k) {
                float bv; int bi;
                if (v0 >= v1) { bv = v0; bi = fr; } else { bv = v1; bi = 16 + fr; }
#pragma unroll
                for (int o = 8; o > 0; o >>= 1) {
                    const float ov = __shfl_xor(bv, o); const int oi = __shfl_xor(bi, o);
                    if (ov > bv || (ov == bv && oi < bi)) { bv = ov; bi = oi; }
                }
                tv[e][k] = bv; te[e][k] = bi;
                if (bi == fr) v0 = -INFINITY;
                if (bi == 16 + fr) v1 = -INFINITY;
            }
        }
        float v[4]; int ex[4]; unsigned sl[4];
#pragma unroll
        for (int k = 0; k < 4; ++k) { v[k] = tv[0][k]; ex[k] = te[0][k];
#pragma unroll
            for (int e = 1; e < 4; ++e) if (fr == e) { v[k] = tv[e][k]; ex[k] = te[e][k]; } }
        if (fr < 4 && route && w2) {
#pragma unroll
            for (int k = 0; k < 4; ++k) sl[k] = __hip_atomic_fetch_add(lcnt + ex[k], 1u, __ATOMIC_RELAXED, __HIP_MEMORY_SCOPE_WORKGROUP);
        }
        __syncthreads();
        if (c.tid < NE && route) { const unsigned n = lcnt[c.tid]; lbase[c.tid] = n ? atomicAdd(&cnt[c.tid], n) : 0u; }
        __syncthreads();
        if (fr < 4 && route && w2) {
            const int r = row0 + 4 * g + fr;
            const float e1 = __expf(v[1] - v[0]), e2 = __expf(v[2] - v[0]), e3 = __expf(v[3] - v[0]);
            const float inv = 1.f / (1.f + e1 + e2 + e3);
            const float gk[4] = {inv, e1 * inv, e2 * inv, e3 * inv};
#pragma unroll
            for (int k = 0; k < 4; ++k) {
                const unsigned slot = lbase[ex[k]] + sl[k];
                list[(size_t)ex[k] * R + slot] = r;
                tk_e[r * 4 + k] = ex[k]; tk_g[r * 4 + k] = gk[k]; tk_slot[r * 4 + k] = (int)slot;
            }
        }
    }
}

__device__ __forceinline__ void moe_offsets(const Ctx& c, int layer, LAS int* so) {
    const unsigned* cnt = (const unsigned*)(c.ws + WS_CTL) + CW_CNT + layer * NE;
    __syncthreads();
    if (c.tid < 64) {
        const int n = c.tid < NE ? (int)cnt[c.tid] : 0; int pad = (n + PADM - 1) / PADM * PADM, inc = pad;
#pragma unroll
        for (int o = 1; o < 32; o <<= 1) { const int t = __shfl_up(inc, o); if (c.lane >= o) inc += t; }
        if (c.tid < NE) { so[c.tid] = inc - pad; so[64 + c.tid] = n; }
        if (c.tid == NE - 1) so[32] = inc;
    }
    __syncthreads();
}

__device__ __forceinline__ void moe_tables(const Ctx& c, int layer, LAS int* tb) {
    const unsigned* cnt = (const unsigned*)(c.ws + WS_CTL) + CW_CNT + layer * NE;
    __syncthreads();
    if (c.tid < 64) {
        const int n = c.tid < NE ? (int)cnt[c.tid] : 0; int tiles = (n + PADM - 1) / PADM, inc = tiles;
#pragma unroll
        for (int o = 1; o < 32; o <<= 1) { const int t = __shfl_up(inc, o); if (c.lane >= o) inc += t; }
        if (c.tid < NE) { tb[c.tid] = inc - tiles; tb[64 + c.tid] = n; }
        if (c.tid == NE - 1) tb[32] = inc;
    }
    __syncthreads();
}
__device__ __forceinline__ int vcu_of(const Ctx& c) { return (c.nwg % 8 == 0) ? (c.wg % 8) * (c.nwg / 8) + c.wg / 8 : c.wg; }
__device__ __forceinline__ void phase_moe_gu(const Ctx& c, int layer) {
    LAS int* tb = (LAS int*)(c.lds + 131072 + 1024);
    moe_tables(c, layer, tb);
    pg8::Gemm g{c.ws + WS_H8, c.ws + WS_WGU + (size_t)layer * NE * 2048 * 1024, (size_t)2048 * 1024, (const int*)(c.ws + WS_LIST)};
    pg8::MoeOrder S{tb, tb + 64, 8, c.nwg, vcu_of(c), false};
    pg8::EpiSwiglu E{c.ws + WS_HDN, c.a->in[18] + (size_t)layer * NE * 2048};
    pg8::gemm_phase<pg8::EpiSwiglu, pg8::MoeOrder, true, true, true>(c.lds, g, S, E, c.tid);
}
__device__ __forceinline__ void phase_moe_dn(const Ctx& c, int layer) {
    LAS int* tb = (LAS int*)(c.lds + 131072 + 1024);
    moe_tables(c, layer, tb);
    pg8::Gemm g{c.ws + WS_HDN, c.ws + WS_WDN + (size_t)layer * NE * 1024 * 1024, (size_t)1024 * 1024, nullptr};
    pg8::MoeOrder S{tb, tb + 64, 4, c.nwg, vcu_of(c), true};
    pg8::EpiBf16Bias E{c.ws + WS_OUTB, c.a->in[20] + (size_t)layer * NE * 1024, 1024, 1.f / (F8_SHD * F8_SW)};
    pg8::gemm_phase<pg8::EpiBf16Bias, pg8::MoeOrder, true, false, true>(c.lds, g, S, E, c.tid);
}
__device__ __forceinline__ void phase_gemm_f32(const Ctx& c, const bf16_t* A, int M, const bf16_t* Bt, int N, const float* bias, bf16_t* Cout) {
    pg8::Gemm g{A, Bt, 0, nullptr}; pg8::StaticOrder S; S.init(M, N, c.nwg, c.wg);
    pg8::EpiF32 E{Cout, N, bias};
    pg8::gemm_phase<pg8::EpiF32, pg8::StaticOrder, true, false, false>(c.lds, g, S, E, c.tid);
}

__device__ __forceinline__ void phase_gemm_qkv(const Ctx& c) {
    pg8::Gemm g{(const bf16_t*)(c.ws + WS_H), (const bf16_t*)(c.ws + WS_WQKV), 0, nullptr}; pg8::StaticOrder S; S.init(R, QKVD, c.nwg, c.wg);
    pg8::EpiQKV E{(bf16_t*)(c.ws + WS_Q), (bf16_t*)(c.ws + WS_K), (bf16_t*)(c.ws + WS_V), c.a->in[8], (const float*)(c.ws + WS_MOD) + MOD_ROPE};
    pg8::gemm_phase<pg8::EpiQKV, pg8::StaticOrder, true, false, false>(c.lds, g, S, E, c.tid);
}
__device__ __forceinline__ void phase_gemm_inproj(const Ctx& c) {
    pg8::Gemm g{c.ws + WS_H8, c.ws + WS_WIN, 0, nullptr}; pg8::StaticOrder S; S.init(R, HIN, c.nwg, c.wg);
    pg8::EpiInProj E{(bf16_t*)(c.ws + WS_QH), (_Float16*)(c.ws + WS_KF), (_Float16*)(c.ws + WS_KB), (bf16_t*)(c.ws + WS_IV), (bf16_t*)(c.ws + WS_SG), (const float*)(c.ws + WS_MOD) + MOD_LB, 1.f / (F8_SH * F8_SW)};
    pg8::gemm_phase<pg8::EpiInProj, pg8::StaticOrder, true, false, true>(c.lds, g, S, E, c.tid);
}

__device__ __forceinline__ void phase_norm0(const Ctx& c);
constexpr int CONV_A = 20 * 16 + 16 * 16 + 80 * 16 + 16 * 16, CONV_B = 32 * 32 * 16 + 32 * 16 * 16, CONV_CHUNK = 8;
__device__ __forceinline__ TBlk convert_item(const Ctx& c, int it, int part) {
    constexpr int I_QKV = 20 * 16, I_O = 16 * 16, I_IN = 80 * 16, I_HO = 16 * 16, I_GU = 32 * 32 * 16;
    int r = it; TBlk t; t.dst8 = nullptr; t.dst = nullptr;
    if (part == 0) {
        if (r < I_QKV) { const int nb = r % 20, kb = r / 20; t.src = c.a->in[7] + (size_t)kb * 64 * QKVD + nb * 64; t.ldw = QKVD; t.dst = (bf16_t*)(c.ws + WS_WQKV) + (size_t)nb * 64 * 1024 + kb * 64; return t; } r -= I_QKV;
        if (r < I_O) { const int nb = r % 16, kb = r / 16; t.src = c.a->in[10] + (size_t)kb * 64 * D + nb * 64; t.ldw = D; t.dst = (bf16_t*)(c.ws + WS_WO) + (size_t)nb * 64 * 1024 + kb * 64; return t; } r -= I_O;
        if (r < I_IN) { const int nb = r % 80, kb = r / 80; t.src = c.a->in[11] + (size_t)kb * 64 * HIN + nb * 64; t.ldw = HIN; t.dst8 = c.ws + WS_WIN + (size_t)nb * 64 * 1024 + kb * 64; return t; } r -= I_IN;
        if (r < I_HO) { const int nb = r % 16, kb = r / 16; t.src = c.a->in[14] + (size_t)kb * 64 * D + nb * 64; t.ldw = D; t.dst = (bf16_t*)(c.ws + WS_WHO) + (size_t)nb * 64 * 1024 + kb * 64; return t; } r -= I_HO;
    }
    const int moff = (part - 1) * 32;
    if (r < I_GU) { const int mat = moff + r / 512, rr = r % 512, nb = rr % 32, kb = rr / 32; const int n0 = ((nb & 3) >> 1) * 1024 + (nb >> 2) * 128 + (nb & 1) * 64;
        t.src = c.a->in[17] + (size_t)mat * 1024 * 2048 + (size_t)kb * 64 * 2048 + n0; t.ldw = 2048; t.dst8 = c.ws + WS_WGU + ((size_t)mat * 2048 + nb * 64) * 1024 + kb * 64; return t; } r -= I_GU;
    { const int mat = moff + r / 256, rr = r % 256, nb = rr % 16, kb = rr / 16;
        t.src = c.a->in[19] + (size_t)mat * 1024 * 1024 + (size_t)kb * 64 * 1024 + nb * 64; t.ldw = 1024; t.dst8 = c.ws + WS_WDN + ((size_t)mat * 1024 + nb * 64) * 1024 + kb * 64; }
    return t;
}
__device__ __forceinline__ void convert_run(const Ctx& c, int part, int first, int step, int end, LAS float* scr) {
    f32x4 va[16], vb[16];
    int it = first;
    TBlk ta, tbk;
    if (it < end) { ta = convert_item(c, it, part); tb_load(ta, c.lane, va); }
    for (; it < end; it += 2 * step) {
        const bool hb = it + step < end;
        if (hb) { tbk = convert_item(c, it + step, part); tb_load(tbk, c.lane, vb); }
        tb_store(ta, c.lane, va, scr);
        const bool ha = it + 2 * step < end;
        if (ha) { ta = convert_item(c, it + 2 * step, part); tb_load(ta, c.lane, va); }
        if (hb) tb_store(tbk, c.lane, vb, scr);
    }
}
__device__ __forceinline__ void convert_steal(const Ctx& c, int part) {
    LAS float* scr = (LAS float*)c.lds + c.wave * (64 * 65);
    LAS int* chp = (LAS int*)(c.lds + 8 * 64 * 65 * 4);
    unsigned* ctr = (unsigned*)(c.ws + WS_CTL) + CW_CONV + 64 * part;
    for (;;) {
        __syncthreads();
        if (c.tid == 0) *chp = (int)atomicAdd(ctr, 1u);
        __syncthreads();
        const int ch = *chp;
        if (ch >= CONV_B / CONV_CHUNK) break;
        convert_run(c, part, ch * CONV_CHUNK + c.wave, 8, (ch + 1) * CONV_CHUNK, scr);
    }
}
__device__ __forceinline__ void convert_steal_n(const Ctx& c, int part, int nmax) {
    LAS float* scr = (LAS float*)c.lds + c.wave * (64 * 65);
    LAS int* chp = (LAS int*)(c.lds + 8 * 64 * 65 * 4);
    unsigned* ctr = (unsigned*)(c.ws + WS_CTL) + CW_CONV + 64 * part;
    for (int n = 0; n < nmax; ++n) {
        __syncthreads();
        if (c.tid == 0) *chp = (int)atomicAdd(ctr, 1u);
        __syncthreads();
        const int ch = *chp;
        if (ch >= CONV_B / CONV_CHUNK) break;
        convert_run(c, part, ch * CONV_CHUNK + c.wave, 8, (ch + 1) * CONV_CHUNK, scr);
    }
    __syncthreads();
}
__device__ __forceinline__ void phase_convert(const Ctx& c) {
    LAS float* scr = (LAS float*)c.lds + c.wave * (64 * 65);
    convert_run(c, 0, c.wg * 8 + c.wave, c.nwg * 8, CONV_A, scr);
    __syncthreads();
    phase_norm0(c);
}

__device__ __forceinline__ void phase_combine(const Ctx& c, int layer) {
    LAS int* so = (LAS int*)(c.lds + 32768);
    moe_offsets(c, layer, so);
    const unsigned char* outb = c.ws + WS_OUTB; bf16_t* X = (bf16_t*)(c.ws + WS_X);
    const bf16_t* Xin = layer == 0 ? X : (const bf16_t*)(c.ws + WS_X1);
    const float* ngl = c.a->in[6] + layer * 4 * D;
    const int* tk_e = (const int*)(c.ws + WS_TK); const float* tk_g = (const float*)(c.ws + WS_TK) + R * 4; const int* tk_slot = (const int*)(c.ws + WS_TK) + 2 * R * 4;
    const int r_lo = layer == 0 ? 0 : C, stride = c.nwg * 8;
    int r = r_lo + c.wg * 8 + c.wave;
    struct TK { int e[4], s[4]; float g[4]; };
    struct DT { unsigned w[4][4]; f32x4 x[4]; float g[4]; };
    TK ta, tb; DT da, db, na, nb;
#define CB_TK(T, row) do { _Pragma("unroll") for (int k = 0; k < 4; ++k) { T.e[k] = tk_e[(row) * 4 + k]; T.s[k] = tk_slot[(row) * 4 + k]; T.g[k] = tk_g[(row) * 4 + k]; } } while (0)
#define CB_DATA(DD, T, row) do { _Pragma("unroll") for (int k = 0; k < 4; ++k) { const unsigned char* src_ = outb + (size_t)(so[T.e[k]] + T.s[k]) * 1024; DD.g[k] = T.g[k] * (1.f / F8_SO); \
        _Pragma("unroll") for (int j = 0; j < 4; ++j) DD.w[k][j] = *(const unsigned*)(src_ + c.lane * 4 + 256 * j); } row_load_bf(Xin + (size_t)(row) * D, c.lane, DD.x); } while (0)
#define CB_ROW(DD, rr) do { const int r_ = (rr); \
        const float* m = c.modp(layer, r_ < C ? 1 : 0); \
        f32x4 y[4], x[4]; \
        _Pragma("unroll") for (int j = 0; j < 4; ++j) { y[j] = (f32x4){0.f, 0.f, 0.f, 0.f}; x[j] = DD.x[j]; } \
        _Pragma("unroll") for (int k = 0; k < 4; ++k) _Pragma("unroll") for (int j = 0; j < 4; ++j) { \
            const f32x2 lo = __builtin_amdgcn_cvt_pk_f32_fp8((int)DD.w[k][j], false), hi = __builtin_amdgcn_cvt_pk_f32_fp8((int)DD.w[k][j], true); y[j] += (f32x4){lo[0], lo[1], hi[0], hi[1]} * DD.g[k]; } \
        const float rstd_y = rsqrtf(row_ss(y) * (1.f / D) + EPS); \
        _Pragma("unroll") for (int j = 0; j < 4; ++j) { const int c0 = c.lane * 4 + 256 * j; \
            const f32x4 g2 = *(const f32x4*)(m + 5120 + c0), n3 = *(const f32x4*)(ngl + 3 * D + c0); \
            x[j] += g2 * (y[j] * rstd_y * n3); \
            if (layer == 0) { u32x2 xo; xo[0] = pk2(x[j][0], x[j][1]); xo[1] = pk2(x[j][2], x[j][3]); *(u32x2*)(X + (size_t)r_ * D + c0) = xo; x[j] = (f32x4){bflo(xo[0]), bfhi(xo[0]), bflo(xo[1]), bfhi(xo[1])}; } \
            else *(f32x4*)(c.a->out + (size_t)(r_ - C) * D + c0) = x[j]; } \
        if (layer == 0) { \
            const float rstd_x = rsqrtf(row_ss(x) * (1.f / D) + EPS); \
            const float* m1 = c.modp(1, r_ < C ? 1 : 0); const float* g0 = c.a->in[6] + 4 * D; \
            _Pragma("unroll") for (int j = 0; j < 4; ++j) { const int c0 = c.lane * 4 + 256 * j; \
                const f32x4 gv = *(const f32x4*)(g0 + c0), shv = *(const f32x4*)(m1 + c0), scv = *(const f32x4*)(m1 + 1024 + c0); \
                const f32x4 hv = x[j] * rstd_x * gv * (scv + 1.f) + shv; \
                *(unsigned*)(c.ws + WS_H8 + (size_t)r_ * D + c0) = pk4_fp8(hv[0] * F8_SH, hv[1] * F8_SH, hv[2] * F8_SH, hv[3] * F8_SH); } } } while (0)
    if (r < R) { CB_TK(ta, r); CB_DATA(da, ta, r); }
    if (r + stride < R) { CB_TK(tb, r + stride); CB_DATA(db, tb, r + stride); }
    if (r + 2 * stride < R) CB_TK(ta, r + 2 * stride);
    if (r + 3 * stride < R) CB_TK(tb, r + 3 * stride);
    for (; r < R; r += 2 * stride) {
        const bool h1 = r + stride < R, h2 = r + 2 * stride < R, h3 = r + 3 * stride < R;
        if (h2) CB_DATA(na, ta, r + 2 * stride);
        if (h3) CB_DATA(nb, tb, r + 3 * stride);
        if (r + 4 * stride < R) CB_TK(ta, r + 4 * stride);
        if (r + 5 * stride < R) CB_TK(tb, r + 5 * stride);
        CB_ROW(da, r);
        if (h1) CB_ROW(db, r + stride);
        da = na; db = nb;
    }
#undef CB_ROW
#undef CB_TK
#undef CB_DATA
}

namespace hg {
typedef _Float16 h2_t __attribute__((ext_vector_type(2)));
constexpr int TB = 272, PB = 144;
constexpr int TILE = 64 * TB;
constexpr int T_QD = 0, T_QC = TILE, T_KD = 2 * TILE, T_KE = 3 * TILE, T_KC = 4 * TILE, T_V0 = 5 * TILE, T_V1 = 6 * TILE;
constexpr int T_QL1 = 7 * TILE, T_KL1 = T_QL1 + 16 * TB, T_P = T_KL1 + 16 * TB, T_TOT = T_P + 64 * PB, T_CT = T_TOT + 4096, T_END = T_CT + 512;
static_assert(T_END <= LDS_BYTES - 64, "hgrn scan LDS map");
__device__ __forceinline__ int row_of(int dir, int p) { return p < C ? (dir ? C - 1 - p : p) : (dir ? C + (L - 1 - (p - C)) : p); }
__device__ __forceinline__ int seg_of(int ch) { return ch < 68 ? ch / 17 : 4 + (ch - 68) / 16; }
__device__ __forceinline__ bf16x8 tr_frag(const LAS unsigned char* tile, int row0, int col0, int lane) {
    const int q = (lane & 15) >> 2, p = lane & 3;
    const LAS unsigned char* a = tile + (row0 + q) * TB + (col0 + 4 * p) * 2;
    const v4i16_t lo = __builtin_amdgcn_ds_read_tr16_b64_v4i16((LAS v4i16_t*)a);
    const v4i16_t hi = __builtin_amdgcn_ds_read_tr16_b64_v4i16((LAS v4i16_t*)(a + 4 * TB));
    return (bf16x8){lo[0], lo[1], lo[2], lo[3], hi[0], hi[1], hi[2], hi[3]};
}
}

__device__ __forceinline__ void phase_hgrn_scan(const Ctx& c) {
    using namespace hg;
#define HG_BAR() asm volatile("s_waitcnt lgkmcnt(0)\n\ts_barrier" ::: "memory")
    const bf16_t* QH = (const bf16_t*)(c.ws + WS_QH); const bf16_t* IV = (const bf16_t*)(c.ws + WS_IV);
    LAS unsigned char* lds = c.lds;
    const int tid = c.tid, lane = c.lane, w = __builtin_amdgcn_readfirstlane(tid >> 6), fr = lane & 15, g = lane >> 4;
    for (int item_ = c.wg; item_ < 256 * SCAN_REP; item_ += c.nwg) {
        const int item = item_ & 255;
        const int chain = item >> 4, seg = item & 15, head = chain >> 1, dir = chain & 1, hc = head * 128;
        const int c0 = seg < 4 ? 17 * seg : 68 + 16 * (seg - 4), nch = seg < 4 ? 17 : 16;
        const _Float16* KX = (const _Float16*)(c.ws + (dir ? WS_KB : WS_KF));
        bf16_t* OL = (bf16_t*)(c.ws + (dir ? WS_OB : WS_OF)); bf16_t* QS = (bf16_t*)(c.ws + (dir ? WS_QSB : WS_QSF));
        HG_BAR();
        for (int i = tid; i < 64 * PB / 4; i += 512) ((LAS unsigned*)(lds + T_P))[i] = 0u;
        f32x4 Sacc[8];
#pragma unroll
        for (int m = 0; m < 8; ++m) Sacc[m] = (f32x4){0.f, 0.f, 0.f, 0.f};
        float dseg0 = 1.f, dseg1 = 1.f;
        unsigned kraw[8], qraw[8]; u32x4 vraw[2];
#define HG_LOAD(cidx) do { const int p0_ = 64 * (cidx); const bool lat_ = (cidx) >= 4; \
        _Pragma("unroll") for (int i = 0; i < 8; ++i) { const int r_ = row_of(dir, p0_ + 8 * w + i); \
            kraw[i] = *(const unsigned*)(KX + (size_t)r_ * D + hc + 2 * lane); \
            qraw[i] = lat_ ? *(const unsigned*)(QH + (size_t)(r_ - C) * D + hc + 2 * lane) : 0u; } \
        _Pragma("unroll") for (int i = 0; i < 2; ++i) { const int idx_ = tid + 512 * i; const int r_ = row_of(dir, p0_ + (idx_ >> 4)); \
            vraw[i] = *(const u32x4*)(IV + (size_t)r_ * D + hc + (idx_ & 15) * 8); } } while (0)
        HG_LOAD(c0);
        for (int ci = 0; ci < nch; ++ci) {
            const int cidx = c0 + ci; const bool lat = cidx >= 4;
            const int vbuf = (ci & 1) ? T_V1 : T_V0;
            float kf[8][2], qf[8][2], cp[8][2];
            {
                float p0 = 1.f, p1 = 1.f;
#pragma unroll
                for (int i = 0; i < 8; ++i) {
                    const h2_t hv = __builtin_bit_cast(h2_t, kraw[i]);
                    kf[i][0] = (float)hv[0]; kf[i][1] = (float)hv[1];
                    qf[i][0] = bflo(qraw[i]); qf[i][1] = bfhi(qraw[i]);
                    p0 *= (1.f - kf[i][0]); p1 *= (1.f - kf[i][1]); cp[i][0] = p0; cp[i][1] = p1;
                }
                *(LAS f32x2*)(lds + T_TOT + (w * 128 + 2 * lane) * 4) = (f32x2){p0, p1};
#pragma unroll
                for (int i = 0; i < 2; ++i) { const int idx = tid + 512 * i; *(LAS u32x4*)(lds + vbuf + (idx >> 4) * TB + (idx & 15) * 16) = vraw[i]; }
            }
            HG_BAR();
            {
                f32x2 T[8];
#pragma unroll
                for (int x = 0; x < 8; ++x) T[x] = *(const LAS f32x2*)(lds + T_TOT + (x * 128 + 2 * lane) * 4);
                const int I = w >> 1, hh = w & 1;
                f32x2 bd[4];
#pragma unroll
                for (int x = 0; x < 4; ++x) bd[x] = T[2 * x] * T[2 * x + 1];
                f32x2 pre = (f32x2){1.f, 1.f}, cum = (f32x2){1.f, 1.f}, suf = (f32x2){1.f, 1.f}, bdI = (f32x2){1.f, 1.f};
#pragma unroll
                for (int x = 0; x < 8; ++x) if (hh && x == w - 1) pre = T[x];
#pragma unroll
                for (int x = 0; x < 4; ++x) { if (x < I) cum = cum * bd[x]; if (x > I) suf = suf * bd[x]; if (x == I) bdI = bd[x]; }
                const f32x2 ctot = (bd[0] * bd[1]) * (bd[2] * bd[3]);
#pragma unroll
                for (int i = 0; i < 8; ++i) {
                    const int tau = 8 * w + i;
                    float QDv[2], KDv[2], KEv[2], QCv[2], KCv[2];
#pragma unroll
                    for (int x = 0; x < 2; ++x) {
                        const float eq = pre[x] * cp[i][x], rc = __builtin_amdgcn_rcpf(eq);
                        QDv[x] = qf[i][x] * eq; KDv[x] = kf[i][x] * rc; KEv[x] = KDv[x] * bdI[x]; QCv[x] = QDv[x] * cum[x]; KCv[x] = KEv[x] * suf[x];
                    }
                    const int to = tau * TB + lane * 4;
                    *(LAS unsigned*)(lds + T_QD + to) = pk2(QDv[0], QDv[1]);
                    *(LAS unsigned*)(lds + T_KD + to) = pk2(KDv[0], KDv[1]);
                    *(LAS unsigned*)(lds + T_KE + to) = pk2(KEv[0], KEv[1]);
                    *(LAS unsigned*)(lds + T_QC + to) = pk2(QCv[0], QCv[1]);
                    *(LAS unsigned*)(lds + T_KC + to) = pk2(KCv[0], KCv[1]);
                    if (I == 3) *(LAS unsigned*)(lds + T_QL1 + (tau - 48) * TB + lane * 4) = pk2(QDv[0] * bd[2][0], QDv[1] * bd[2][1]);
                    if (I == 0) *(LAS unsigned*)(lds + T_KL1 + tau * TB + lane * 4) = pk2(KEv[0] * bd[1][0], KEv[1] * bd[1][1]);
                    if (lat) { const int r = row_of(dir, 64 * cidx + tau); *(unsigned*)(QS + (size_t)(r - C) * D + hc + 2 * lane) = pk2(QCv[0] * dseg0, QCv[1] * dseg1); }
                }
                dseg0 *= ctot[0]; dseg1 *= ctot[1];
                if (w == 0) *(LAS f32x2*)(lds + T_CT + lane * 8) = ctot;
            }
            HG_BAR();
            if (ci + 1 < nch) HG_LOAD(cidx + 1);
            if (lat) {
                const int nblk = w >= 6 ? 2 : 1;
                for (int b = 0; b < nblk; ++b) {
                    int I, J, qoff, qrow, koff, krow; bool diag = false;
                    if (w < 4) { I = 2 + (w >> 1); J = w & 1; qoff = (w >> 1) ? T_QL1 : T_QD; qrow = (w >> 1) ? 0 : 32; koff = (w & 1) ? T_KE : T_KL1; krow = (w & 1) ? 16 : 0; }
                    else if (w == 4) { I = 1; J = 0; qoff = T_QD; qrow = 16; koff = T_KE; krow = 0; }
                    else if (w == 5) { I = 3; J = 2; qoff = T_QD; qrow = 48; koff = T_KE; krow = 32; }
                    else { I = 2 * (w - 6) + b; J = I; qoff = T_QD; qrow = 16 * I; koff = T_KD; krow = 16 * I; diag = true; }
                    f32x4 pa = (f32x4){0.f, 0.f, 0.f, 0.f};
#pragma unroll
                    for (int ks = 0; ks < 4; ++ks) {
                        const bf16x8 av = *(const LAS bf16x8*)(lds + qoff + (qrow + fr) * TB + (32 * ks + 8 * g) * 2);
                        const bf16x8 bv = *(const LAS bf16x8*)(lds + koff + (krow + fr) * TB + (32 * ks + 8 * g) * 2);
                        pa = __builtin_amdgcn_mfma_f32_16x16x32_bf16(av, bv, pa, 0, 0, 0);
                    }
#pragma unroll
                    for (int e = 0; e < 4; ++e) {
                        const int tl = 4 * g + e; const float val = (diag && fr > tl) ? 0.f : pa[e];
                        *(LAS bf16_t*)(lds + T_P + (16 * I + tl) * PB + (16 * J + fr) * 2) = (bf16_t)f2bf(val);
                    }
                }
            }
            f32x4 oacc[4];
#pragma unroll
            for (int m = 0; m < 4; ++m) oacc[m] = (f32x4){0.f, 0.f, 0.f, 0.f};
            if (lat) {
                bf16x8 Sb[4];
#pragma unroll
                for (int ks = 0; ks < 4; ++ks) {
                    const f32x4 a0 = Sacc[2 * ks], a1 = Sacc[2 * ks + 1];
                    const u32x4 pk = (u32x4){pk2(a0[0], a0[1]), pk2(a0[2], a0[3]), pk2(a1[0], a1[1]), pk2(a1[2], a1[3])};
                    Sb[ks] = __builtin_bit_cast(bf16x8, pk);
                }
#pragma unroll
                for (int m = 0; m < 4; ++m)
#pragma unroll
                    for (int ks = 0; ks < 4; ++ks) {
                        const u32x2 lo = *(const LAS u32x2*)(lds + T_QC + (16 * m + fr) * TB + (32 * ks + 4 * g) * 2);
                        const u32x2 hi = *(const LAS u32x2*)(lds + T_QC + (16 * m + fr) * TB + (32 * ks + 16 + 4 * g) * 2);
                        const u32x4 pk = (u32x4){lo.x, lo.y, hi.x, hi.y};
                        oacc[m] = __builtin_amdgcn_mfma_f32_16x16x32_bf16(Sb[ks], __builtin_bit_cast(bf16x8, pk), oacc[m], 0, 0, 0);
                    }
            }
#pragma unroll
            for (int m = 0; m < 8; ++m) { const f32x4 ct = *(const LAS f32x4*)(lds + T_CT + (16 * m + 4 * g) * 4); Sacc[m] = Sacc[m] * ct; }
            bf16x8 Vf[2];
#pragma unroll
            for (int ks = 0; ks < 2; ++ks) Vf[ks] = tr_frag(lds + vbuf, 32 * ks + 8 * g, 16 * w, lane);
#pragma unroll
            for (int m = 0; m < 8; ++m)
#pragma unroll
                for (int ks = 0; ks < 2; ++ks) Sacc[m] = __builtin_amdgcn_mfma_f32_16x16x32_bf16(tr_frag(lds + T_KC, 32 * ks + 8 * g, 16 * m, lane), Vf[ks], Sacc[m], 0, 0, 0);
            HG_BAR();
            if (lat) {
#pragma unroll
                for (int m = 0; m < 4; ++m)
#pragma unroll
                    for (int ks = 0; ks < 2; ++ks) {
                        if (m < 2 && ks == 1) continue;
                        const bf16x8 av = *(const LAS bf16x8*)(lds + T_P + (16 * m + fr) * PB + (32 * ks + 8 * g) * 2);
                        oacc[m] = __builtin_amdgcn_mfma_f32_16x16x32_bf16(Vf[ks], av, oacc[m], 0, 0, 0);
                    }
#pragma unroll
                for (int m = 0; m < 4; ++m) { const int r = row_of(dir, 64 * cidx + 16 * m + fr); u32x2 o; o.x = pk2(oacc[m][0], oacc[m][1]); o.y = pk2(oacc[m][2], oacc[m][3]);
                    *(u32x2*)(OL + (size_t)(r - C) * D + hc + 16 * w + 4 * g) = o; }
            }
        }
#undef HG_LOAD
        float* DS = (float*)(c.ws + WS_DS) + (size_t)item * 16384; float* DG = (float*)(c.ws + WS_DG) + item * 128;
#pragma unroll
        for (int m = 0; m < 8; ++m)
#pragma unroll
            for (int e = 0; e < 4; ++e) DS[(16 * m + 4 * g + e) * 128 + 16 * w + fr] = Sacc[m][e];
        if (w == 0) { DG[2 * lane] = dseg0; DG[2 * lane + 1] = dseg1; }
    }
}

#undef HG_BAR
__device__ __forceinline__ void phase_hgrn_fold(const Ctx& c) {
    const float* DS = (const float*)(c.ws + WS_DS); const float* DG = (const float*)(c.ws + WS_DG); bf16_t* SST = (bf16_t*)(c.ws + WS_SST);
    for (int item = c.wg; item < 256; item += c.nwg) {
        const int chain = item >> 4, slice = item & 15, d = 8 * slice + (c.tid >> 6), v2 = (c.tid & 63) * 2;
        float s0 = 0.f, s1 = 0.f;
        float dv[15]; f32x2 ds[15];
#pragma unroll
        for (int sgi = 0; sgi < 15; ++sgi) { dv[sgi] = DG[(chain * 16 + sgi) * 128 + d]; ds[sgi] = *(const f32x2*)(DS + ((size_t)(chain * 16 + sgi) * 128 + d) * 128 + v2); }
        SST[((size_t)(chain * 16) * 128 + v2) * 128 + d] = 0; SST[((size_t)(chain * 16) * 128 + v2 + 1) * 128 + d] = 0;
#pragma unroll
        for (int sgi = 0; sgi < 15; ++sgi) {
            s0 = dv[sgi] * s0 + ds[sgi][0]; s1 = dv[sgi] * s1 + ds[sgi][1];
            SST[((size_t)(chain * 16 + sgi + 1) * 128 + v2) * 128 + d] = (bf16_t)f2bf(s0); SST[((size_t)(chain * 16 + sgi + 1) * 128 + v2 + 1) * 128 + d] = (bf16_t)f2bf(s1);
        }
    }
}

__device__ __forceinline__ void phase_hgrn_readout(const Ctx& c) {
    constexpr int SP = 272, SBUF = 128 * SP, IBUF = 2 * SBUF;
    static_assert(2 * IBUF + 1024 <= LDS_BYTES - 64, "readout LDS map");
    const bf16_t* OF = (const bf16_t*)(c.ws + WS_OF); const bf16_t* OB = (const bf16_t*)(c.ws + WS_OB); const bf16_t* SGp = (const bf16_t*)(c.ws + WS_SG);
    const bf16_t* SST = (const bf16_t*)(c.ws + WS_SST); bf16_t* RR = (bf16_t*)(c.ws + WS_RR); const float* hng = c.a->in[13];
    LAS unsigned char* lds = c.lds; LAS float* ssx = (LAS float*)(c.lds + 2 * IBUF);
    const int tid = c.tid, lane = c.lane, w = __builtin_amdgcn_readfirstlane(tid >> 6), fr = lane & 15, g = lane >> 4, mt = w & 3, nh = w >> 2;
#define RO_BAR() asm volatile("s_waitcnt lgkmcnt(0)\n\ts_barrier" ::: "memory")
    u32x4 sreg[8];
#define RO_H(q) ((c.nwg == 256) ? ((q) & 255) >> 5 : (q) >> 8)
#define RO_CH(q) ((c.nwg == 256) ? (((q) & 31) << 3) + ((q) >> 8) : (q) & 255)
#define RO_SST_LOAD(it) do { const int h_ = RO_H(it), ch_ = RO_CH(it); \
        _Pragma("unroll") for (int j = 0; j < 8; ++j) { const int idx_ = tid + 512 * j, dx_ = idx_ >> 11, rem_ = idx_ & 2047; \
            const int sg_ = hg::seg_of(dx_ ? 4 + 255 - ch_ : 4 + ch_); \
            sreg[j] = *(const u32x4*)(SST + ((size_t)((h_ * 2 + dx_) * 16 + sg_) * 128 + (rem_ >> 4)) * 128 + (rem_ & 15) * 8); } } while (0)
#define RO_SST_WRITE(buf) do { _Pragma("unroll") for (int j = 0; j < 8; ++j) { const int idx_ = tid + 512 * j, dx_ = idx_ >> 11, rem_ = idx_ & 2047; \
            *(LAS u32x4*)(lds + (buf) * IBUF + dx_ * SBUF + (rem_ >> 4) * SP + (rem_ & 15) * 16) = sreg[j]; } } while (0)
    int it = c.wg;
    u32x2 ra[4], rb[4], rg[4]; bf16x8 rq[2][4];
#define RO_IN_LOAD(itx) do { const int h_ = RO_H(itx), t0_ = 64 * RO_CH(itx) + 16 * mt; \
        _Pragma("unroll") for (int n = 0; n < 4; ++n) { const size_t o_ = (size_t)(t0_ + fr) * D + h_ * 128 + 64 * nh + 16 * n + 4 * g; \
            ra[n] = *(const u32x2*)(OF + o_); rb[n] = *(const u32x2*)(OB + o_); rg[n] = *(const u32x2*)(SGp + o_); } \
        _Pragma("unroll") for (int dx = 0; dx < 2; ++dx) { const bf16_t* QS_ = (const bf16_t*)(c.ws + (dx ? WS_QSB : WS_QSF)) + (size_t)(t0_ + fr) * D + h_ * 128 + 8 * g; \
            _Pragma("unroll") for (int ks = 0; ks < 4; ++ks) rq[dx][ks] = *(const bf16x8*)(QS_ + 32 * ks); } } while (0)
    RO_BAR();
    if (it < 2048) { RO_SST_LOAD(it); RO_SST_WRITE(0); RO_IN_LOAD(it); }
    RO_BAR();
    int buf = 0;
    for (int k = 0; it < 2048; it += c.nwg, ++k) {
        const int h = RO_H(it), ch = RO_CH(it), t0 = 64 * ch + 16 * mt;
        const bool has_next = it + c.nwg < 2048;
        const int hn = RO_H(it + c.nwg), chn = RO_CH(it + c.nwg);
        const bool reload = has_next && (hn != h || hg::seg_of(4 + chn) != hg::seg_of(4 + ch) || hg::seg_of(4 + 255 - chn) != hg::seg_of(4 + 255 - ch));
        f32x4 acc[4], sgv[4];
        bf16x8 aq[2][4];
#pragma unroll
        for (int n = 0; n < 4; ++n) {
            const f32x4 gn = *(const f32x4*)(hng + h * 128 + 64 * nh + 16 * n + 4 * g);
            acc[n] = (f32x4){bflo(ra[n].x) + bflo(rb[n].x), bfhi(ra[n].x) + bfhi(rb[n].x), bflo(ra[n].y) + bflo(rb[n].y), bfhi(ra[n].y) + bfhi(rb[n].y)};
            sgv[n] = (f32x4){bflo(rg[n].x), bfhi(rg[n].x), bflo(rg[n].y), bfhi(rg[n].y)} * gn;
        }
#pragma unroll
        for (int dx = 0; dx < 2; ++dx)
#pragma unroll
            for (int ks = 0; ks < 4; ++ks) aq[dx][ks] = rq[dx][ks];
        if (reload) RO_SST_LOAD(it + c.nwg);
        if (has_next) RO_IN_LOAD(it + c.nwg);
#pragma unroll
        for (int dx = 0; dx < 2; ++dx) {
            const LAS unsigned char* sb = lds + buf * IBUF + dx * SBUF + (64 * nh + fr) * SP + 16 * g;
#pragma unroll
            for (int ks = 0; ks < 4; ++ks) {
#pragma unroll
                for (int n = 0; n < 4; ++n) acc[n] = __builtin_amdgcn_mfma_f32_16x16x32_bf16(*(const LAS bf16x8*)(sb + (16 * n) * SP + 64 * ks), aq[dx][ks], acc[n], 0, 0, 0);
            }
        }
        float ss = 0.f;
#pragma unroll
        for (int n = 0; n < 4; ++n) ss += acc[n][0] * acc[n][0] + acc[n][1] * acc[n][1] + acc[n][2] * acc[n][2] + acc[n][3] * acc[n][3];
        ss = xadd32(xadd16(ss));
        if (g == 0) ssx[((k & 1) * 8 + w) * 16 + fr] = ss;
        if (reload) RO_SST_WRITE(buf ^ 1);
        RO_BAR();
        const float rstd = rsqrtf((ss + ssx[((k & 1) * 8 + (w ^ 4)) * 16 + fr]) * (1.f / 128.f) + EPS);
#pragma unroll
        for (int n = 0; n < 4; ++n) {
            const f32x4 v = acc[n] * rstd * sgv[n]; u32x2 o; o.x = pk2(v[0], v[1]); o.y = pk2(v[2], v[3]);
            *(u32x2*)(RR + (size_t)(t0 + fr) * D + h * 128 + 64 * nh + 16 * n + 4 * g) = o;
        }
        if (reload) buf ^= 1;
    }
    RO_BAR();
#undef RO_BAR
#undef RO_SST_LOAD
#undef RO_SST_WRITE
#undef RO_H
#undef RO_CH
#undef RO_IN_LOAD
}

#define XB_TMO      128
#define XB_XCNT(j)  (256  + 64 * (j))
#define XB_XSUB(j)  (1280 + 64 * (j))
#define XB_XGEN(j)  (2304 + 64 * (j))
#define XB_TOP      3328
#define XB_TOPGEN   3392
#define XCD_BAR_WORDS 3456
#define XB_SPIN_CAP (1u << 18)
__device__ __forceinline__ unsigned xb_ld(unsigned* p)              { return __hip_atomic_load(p, __ATOMIC_RELAXED, __HIP_MEMORY_SCOPE_AGENT); }
__device__ __forceinline__ unsigned xb_add(unsigned* p, unsigned v) { return __hip_atomic_fetch_add(p, v, __ATOMIC_RELAXED, __HIP_MEMORY_SCOPE_AGENT); }
__device__ __forceinline__ unsigned xb_xcc_id() { return (unsigned)__builtin_amdgcn_s_getreg((3 << 11) | 20) & 0xFu; }
#define XB_SPIN(cond, bar) do { unsigned _sp = 0; while (cond) { __builtin_amdgcn_s_sleep(1); \
    if ((++_sp & 255u) == 0u) { if (xb_ld(&(bar)[XB_TMO])) break; if (_sp > XB_SPIN_CAP) { atomicAdd(&(bar)[XB_TMO], 1u); break; } } } } while (0)
struct XcdBarrier { unsigned* bar; unsigned x; volatile LAS unsigned* st; };
__device__ __forceinline__ XcdBarrier xcd_barrier_post(unsigned* bar, volatile LAS unsigned* st) {
    XcdBarrier b; b.bar = bar; b.x = xb_xcc_id(); b.st = st;
    if (threadIdx.x == 0) (void)xb_add(&bar[XB_XCNT(b.x)], 1u);
    return b;
}
__device__ __forceinline__ void xcd_barrier_complete(unsigned* bar, unsigned x, unsigned& nloc, unsigned& nx) {
    const unsigned G = gridDim.x * gridDim.y * gridDim.z;
    unsigned sum, cnt, mine, sp = 0u;
    for (;;) {
        sum = 0u; cnt = 0u; mine = 0u;
#pragma unroll
        for (unsigned j = 0; j < 16; ++j) { const unsigned c = xb_ld(&bar[XB_XCNT(j)]); sum += c; cnt += (c > 0u) ? 1u : 0u; mine = (j == x) ? c : mine; }
        if (sum == G) break;
        __builtin_amdgcn_s_sleep(1);
        if ((++sp & 255u) == 0u) { if (xb_ld(&bar[XB_TMO])) break; if (sp > XB_SPIN_CAP) { atomicAdd(&bar[XB_TMO], 1u); break; } }
    }
    nloc = mine > 0u ? mine : 1u; nx = cnt > 0u ? cnt : 1u;
}
__device__ __forceinline__ void xcd_barrier(const XcdBarrier& b) {
    asm volatile("s_waitcnt vmcnt(0)" ::: "memory");
    __syncthreads();
    if (threadIdx.x == 0) {
        unsigned* bar = b.bar;
        __builtin_amdgcn_s_waitcnt(0);
        unsigned nloc = b.st[0], nx = b.st[1];
        if (nloc == 0u) { xcd_barrier_complete(bar, b.x, nloc, nx); b.st[0] = nloc; b.st[1] = nx; }
        const unsigned old = xb_add(&bar[XB_XSUB(b.x)], 1u);
        const unsigned gen = old / nloc;
        if (old + 1u == (gen + 1u) * nloc) {
            __builtin_amdgcn_fence(__ATOMIC_RELEASE, "agent");
            asm volatile("s_waitcnt vmcnt(0)" ::: "memory");
            const unsigned og = xb_add(&bar[XB_TOP], 1u);
            const unsigned tg = og / nx;
            if (og + 1u == (tg + 1u) * nx) xb_add(&bar[XB_TOPGEN], 1u);
            else XB_SPIN(xb_ld(&bar[XB_TOPGEN]) == tg, bar);
            __builtin_amdgcn_fence(__ATOMIC_ACQUIRE, "agent");
            xb_add(&bar[XB_XGEN(b.x)], 1u);
            asm volatile("s_waitcnt vmcnt(0)" ::: "memory");
        } else {
            XB_SPIN(xb_ld(&bar[XB_XGEN(b.x)]) == gen, bar);
            __builtin_amdgcn_fence(__ATOMIC_ACQUIRE, "agent");
            asm volatile("s_waitcnt vmcnt(0)" ::: "memory");
        }
    }
    __syncthreads();
}

__device__ __forceinline__ void launder(Ctx& c) { asm volatile("" : "+s"(c.a)); asm volatile("" : "+s"(c.ws)); asm volatile("" : "+s"(c.wave));
    c.lane = (int)__builtin_amdgcn_mbcnt_hi(~0u, __builtin_amdgcn_mbcnt_lo(~0u, 0u)); c.tid = c.wave * 64 + c.lane; }
__global__ void __launch_bounds__(512, 2) mk_fwd(Args args) {
    extern __shared__ __attribute__((aligned(16))) unsigned char lds_raw[];
    Ctx c; c.a = (CArgs)__builtin_amdgcn_kernarg_segment_ptr(); c.lds = (LAS unsigned char*)lds_raw; c.tid = threadIdx.x; c.lane = c.tid & 63; c.wave = __builtin_amdgcn_readfirstlane(c.tid >> 6); c.nwg = gridDim.x; c.wg = blockIdx.x; c.ws = c.a->ws;
    volatile LAS unsigned* bst = (volatile LAS unsigned*)(c.lds + LDS_BYTES - 64);
    if (c.tid < 4) bst[c.tid] = 0u;
    __syncthreads();
    const XcdBarrier bar = xcd_barrier_post((unsigned*)(c.ws + WS_CTL) + CW_BAR, bst);
    const int lo = c.a->ph_lo, hi = c.a->ph_hi;
    bool route_ok = true;
#define SEAM(k) do { if (lo <= (k) && (k) + 1 < hi) xcd_barrier(bar); } while (0)
#define IN(k) (lo <= (k) && (k) < hi && (launder(c), true))
#define PH(k, call) do { if (IN(k)) { if (PROBE_PH == (k)) { int nrep_ = 3; asm volatile("" : "+s"(nrep_)); for (int rep_ = 0; rep_ < nrep_; ++rep_) { route_ok = (rep_ + 1 == nrep_); call; if (rep_ + 1 < nrep_) xcd_barrier(bar); } } else { call; } } SEAM(k); } while (0)
    PH(0, phase_prep(c));
    PH(1, phase_convert(c));
    PH(2, { phase_gemm_qkv(c); if (c.nwg == 256 && c.wg >= 138) convert_steal_n(c, 1, 3); });
    PH(3, phase_attn(c));
    PH(4, { phase_gemm_f32(c, (const bf16_t*)(c.ws + WS_O), R, (const bf16_t*)(c.ws + WS_WO), D, nullptr, (bf16_t*)(c.ws + WS_RAW1)); if (c.nwg == 256 && c.wg >= 16) convert_steal_n(c, 1, 2); });
    PH(5, { phase_postmix<128>(c, 0, route_ok); convert_steal(c, 1); });
    PH(6, phase_moe_gu(c, 0));
    PH(7, phase_moe_dn(c, 0));
    PH(8, phase_combine(c, 0));
    PH(9, { phase_gemm_inproj(c); if (c.nwg == 256 && c.wg >= 80) convert_steal_n(c, 2, 2); });
    PH(10, phase_hgrn_scan(c));
    PH(11, phase_hgrn_fold(c));
    PH(12, phase_hgrn_readout(c));
    PH(13, phase_gemm_f32(c, (const bf16_t*)(c.ws + WS_RR), L, (const bf16_t*)(c.ws + WS_WHO), D, nullptr, (bf16_t*)(c.ws + WS_RAW1)));
    PH(14, { phase_postmix<128>(c, 1, route_ok); convert_steal(c, 2); });
    PH(15, phase_moe_gu(c, 1));
    PH(16, phase_moe_dn(c, 1));
    PH(17, phase_combine(c, 1));
#undef IN
#undef PH
#undef SEAM
}

extern "C" void kernel_launch(void* const* d_in, const int* in_sizes, int n_in, void* d_out, int out_size, void* d_ws, size_t ws_size, hipStream_t stream) {
    static int grid = 0;
    if (grid == 0) {
        if (n_in != 21 || out_size != L * D || ws_size < WS_END) { fprintf(stderr, "kernel_launch: unexpected problem (n_in %d out %d ws %zu need %zu)\n", n_in, out_size, ws_size, (size_t)WS_END); grid = -1; return; }
        int dev = 0, cus = 0, per_cu = 0;
        hipGetDevice(&dev); hipDeviceGetAttribute(&cus, hipDeviceAttributeMultiprocessorCount, dev);
        if (hipFuncSetAttribute((const void*)mk_fwd, hipFuncAttributeMaxDynamicSharedMemorySize, LDS_BYTES) != hipSuccess) { fprintf(stderr, "kernel_launch: hipFuncSetAttribute failed\n"); grid = -1; return; }
        hipOccupancyMaxActiveBlocksPerMultiprocessor(&per_cu, (const void*)mk_fwd, 512, LDS_BYTES);
        if (per_cu < 1) fprintf(stderr, "kernel_launch: occupancy query says %d\n", per_cu);
        (void)hipGetLastError();
        grid = cus > 0 ? cus : 256;
    }
    if (grid < 0) return;
    hipMemsetAsync((char*)d_ws + WS_CTL, 0, MiB, stream);
    Args a{};
    for (int i = 0; i < 21; ++i) a.in[i] = (const float*)d_in[i];
    a.out = (float*)d_out; a.ws = (unsigned char*)d_ws;
    a.ph_lo = 0; a.ph_hi = NPHASE;
    hipLaunchKernelGGL(mk_fwd, dim3(grid), dim3(512), LDS_BYTES, stream, a);
}
```

```cpp
#include <hip/hip_runtime.h>
#include <cstdint>
#include <cstdio>

#define LAS __attribute__((address_space(3)))
typedef unsigned short bf16_t;
typedef short bf16x8 __attribute__((ext_vector_type(8)));
typedef float f32x4 __attribute__((ext_vector_type(4)));
typedef unsigned u32x4 __attribute__((ext_vector_type(4)));
typedef unsigned u32x2 __attribute__((ext_vector_type(2)));
typedef short v4i16_t __attribute__((ext_vector_type(4)));
typedef float f32x2 __attribute__((ext_vector_type(2)));

constexpr int D = 1024, L = 16384, C = 256, R = L + C;
constexpr int QKVD = 1280, HIN = 5120, NE = 32, TOPK = 4;
constexpr int PADM = 256, MAXROWS = 74752;
constexpr float EPS = 1e-6f;
constexpr float LOG2E = 1.4426950408889634f;
constexpr int NPHASE = 18;
#ifndef GEMM_REP
#define GEMM_REP 1
#endif
#ifndef PROBE_NOEPI
#define PROBE_NOEPI 0
#endif
#ifndef PROBE_SHORTK
#define PROBE_SHORTK 0
#endif
#ifndef SCAN_REP
#define SCAN_REP 1
#endif
#ifndef PROBE_PH
#define PROBE_PH (-1)
#endif
constexpr int LDS_BYTES = 147456;

constexpr size_t MiB = 1u << 20;
constexpr size_t al(size_t x) { return (x + MiB - 1) / MiB * MiB; }
constexpr size_t WS_CTL = 0;
constexpr size_t WS_MOD = WS_CTL + MiB;
constexpr size_t WS_X = WS_MOD + MiB;
constexpr size_t WS_H = WS_X + al((size_t)R * D * 4);
constexpr size_t WS_Q = WS_H + al((size_t)R * D * 2);
constexpr size_t WS_K = WS_Q + al((size_t)R * D * 2);
constexpr size_t WS_V = WS_K + al((size_t)R * 128 * 2);
constexpr size_t WS_O = WS_V + al((size_t)R * 128 * 2);
constexpr size_t WS_TK = WS_O + al((size_t)R * D * 2);
constexpr size_t WS_LIST = WS_TK + MiB;
constexpr size_t WS_HDN = WS_LIST + 3 * MiB;
constexpr size_t WS_RAW1 = WS_HDN + al((size_t)MAXROWS * 1024 * 2);
constexpr size_t WS_X1 = WS_RAW1 + al((size_t)R * D * 4);
constexpr size_t WS_OUTB = WS_X1 + al((size_t)R * D * 4);
constexpr size_t WS_QH = WS_OUTB + al((size_t)MAXROWS * 1024 * 2);
constexpr size_t WS_KF = WS_QH + al((size_t)L * D * 2);
constexpr size_t WS_KB = WS_KF + al((size_t)R * D * 2);
constexpr size_t WS_IV = WS_KB + al((size_t)R * D * 2);
constexpr size_t WS_SG = WS_IV + al((size_t)R * D * 2);
constexpr size_t WS_OF = WS_SG + al((size_t)L * D * 2);
constexpr size_t WS_OB = WS_OF + al((size_t)L * D * 4);
constexpr size_t WS_RR = WS_OB + al((size_t)L * D * 4);
constexpr size_t WS_WQKV = WS_RR + al((size_t)L * D * 2);
constexpr size_t WS_WO = WS_WQKV + al((size_t)QKVD * D * 2);
constexpr size_t WS_WIN = WS_WO + al((size_t)D * D * 2);
constexpr size_t WS_WHO = WS_WIN + al((size_t)HIN * D * 2);
constexpr size_t WS_WGU = WS_WHO + al((size_t)D * D * 2);
constexpr size_t WS_WDN = WS_WGU + al((size_t)2 * NE * 2048 * D * 2);
constexpr size_t WS_QSF = WS_WDN + al((size_t)2 * NE * 1024 * D * 2);
constexpr size_t WS_QSB = WS_QSF + al((size_t)L * D * 2);
constexpr size_t WS_DS = WS_QSB + al((size_t)L * D * 2);
constexpr size_t WS_DG = WS_DS + al((size_t)256 * 128 * 128 * 4);
constexpr size_t WS_SST = WS_DG + MiB;
constexpr size_t WS_H8 = WS_SST + al((size_t)256 * 128 * 128 * 2);
constexpr size_t WS_END = WS_H8 + al((size_t)R * D);
static_assert(WS_END <= (size_t)2048 * MiB, "workspace map exceeds 4x the largest input");
constexpr int CW_CNT = 1024;
constexpr int CW_CONV = 2048;
constexpr int CW_BAR = 4096;
constexpr int MOD_ROPE = 32768;
constexpr int RT_PITCH = 2064, RT_IMG = 2 * 32 * RT_PITCH, RT_BYTES = RT_IMG + 256 + 3 * 4096, RT_OFF = 262144;
static_assert(RT_OFF + 4 * RT_BYTES <= (int)MiB, "router tables inside the MOD region");
constexpr int MOD_LB = 49152;

struct Args { const float* in[21]; float* out; unsigned char* ws; int ph_lo, ph_hi; };

__device__ __forceinline__ unsigned f2bf(float f) { unsigned u = __float_as_uint(f); return (u + 0x7fffu + ((u >> 16) & 1u)) >> 16; }
typedef float f32x2_t __attribute__((ext_vector_type(2))); typedef __bf16 bf16x2_t __attribute__((ext_vector_type(2)));
__device__ __forceinline__ unsigned pk2(float lo, float hi) { f32x2_t v = {lo, hi}; bf16x2_t b = __builtin_convertvector(v, bf16x2_t); return __builtin_bit_cast(unsigned, b); }
__device__ __forceinline__ unsigned pk4_fp8(float a, float b, float c, float d) {
    a = fminf(fmaxf(a, -448.f), 448.f); b = fminf(fmaxf(b, -448.f), 448.f); c = fminf(fmaxf(c, -448.f), 448.f); d = fminf(fmaxf(d, -448.f), 448.f);
    int v = __builtin_amdgcn_cvt_pk_fp8_f32(a, b, 0, false); v = __builtin_amdgcn_cvt_pk_fp8_f32(c, d, v, true); return (unsigned)v; }
__device__ __forceinline__ unsigned pk4_fp8_nc(float a, float b, float c, float d) {
    int v = __builtin_amdgcn_cvt_pk_fp8_f32(a, b, 0, false); v = __builtin_amdgcn_cvt_pk_fp8_f32(c, d, v, true); return (unsigned)v; }
constexpr float F8_SH = 8.f, F8_SW = 64.f, F8_SHD = 4.f, F8_SO = 16.f;
__device__ __forceinline__ float bflo(unsigned u) { return __uint_as_float(u << 16); }
__device__ __forceinline__ float bfhi(unsigned u) { return __uint_as_float(u & 0xffff0000u); }
__device__ __forceinline__ float bf2f(bf16_t b) { return __uint_as_float(((unsigned)b) << 16); }
__device__ __forceinline__ float xadd16(float x) { const auto a = __builtin_amdgcn_permlane16_swap(__float_as_uint(x), __float_as_uint(x), false, false); return __uint_as_float(a[0]) + __uint_as_float(a[1]); }
__device__ __forceinline__ float xadd32(float x) { const auto a = __builtin_amdgcn_permlane32_swap(__float_as_uint(x), __float_as_uint(x), false, false); return __uint_as_float(a[0]) + __uint_as_float(a[1]); }
__device__ __forceinline__ float xmax16(float x) { const auto a = __builtin_amdgcn_permlane16_swap(__float_as_uint(x), __float_as_uint(x), false, false); return fmaxf(__uint_as_float(a[0]), __uint_as_float(a[1])); }
__device__ __forceinline__ float xmax32(float x) { const auto a = __builtin_amdgcn_permlane32_swap(__float_as_uint(x), __float_as_uint(x), false, false); return fmaxf(__uint_as_float(a[0]), __uint_as_float(a[1])); }
__device__ __forceinline__ float wave_sum(float v) {
#pragma unroll
    for (int o = 8; o > 0; o >>= 1) v += __shfl_xor(v, o);
    return xadd32(xadd16(v));
}
__device__ __forceinline__ float silu_f(float x) { return x / (1.f + __expf(-x)); }
__device__ __forceinline__ float sigmoid_f(float x) { return 1.f / (1.f + __expf(-x)); }

typedef const __attribute__((address_space(4))) Args* CArgs;
struct Ctx {
    CArgs a;
    LAS unsigned char* lds;
    int tid, lane, wave, nwg, wg;
    unsigned char* ws;
    __device__ __forceinline__ float* modp(int layer, int which) const { return (float*)(ws + WS_MOD) + (layer * 2 + which) * 6144; }
    __device__ __forceinline__ const float* xin0(int r) const { return r < C ? a->in[2] + (size_t)r * D : a->in[0] + (size_t)(r - C) * D; }
};


namespace pg8 {
constexpr int BM = 256, BK = 64, HALF = 128, HTB = HALF * BK * 2, STAGE_BYTES = 8 * HTB, KD = 1024, NXCD = 8, WGM = 8;
__device__ __forceinline__ int lds_byte(int r, int c) { const int st = (r >> 4) * 2 + (c >> 5), rr = r & 15, cc = c & 31, ob = rr * 64 + cc * 2; return st * 1024 + (ob ^ (((ob >> 9) & 1) << 5)); }
__device__ __forceinline__ void stage_rc(int b, int& Rr, int& Cc) { const int st = b / 1024, sb = b % 1024, swz = sb ^ (((sb >> 9) & 1) << 5); Rr = (st >> 1) * 16 + swz / 64; Cc = (st & 1) * 32 + (swz % 64) / 2; }
__device__ __forceinline__ int perm32(int rho) { const int n = rho >> 4, i = rho & 15; return 8 * (i >> 2) + 4 * n + (i & 3); }

struct Unit { int pm, pn, e, goff, gcnt; bool real; int amask, bmask; };
struct Gemm { const void* A; const void* Bt; size_t bstride; const int* list; };

struct StaticOrder {
    int nM, nN, nwg, G, c;
    __device__ __forceinline__ void init(int M, int N, int G_, int c_) { nM = M / BM; nN = N / BM; nwg = nM * nN; G = G_; c = c_; }
    __device__ __forceinline__ bool next(int i, Unit& u) const {
        const int F = nwg / G, Rm = nwg - F * G; int Lq; u.amask = 3; u.bmask = 3;
        if (i < F) Lq = i * G + c;
        else if (i == F && Rm > 0) {
            if (4 * Rm <= G) { if (c >= 4 * Rm) return false; Lq = F * G + (c >> 2); u.amask = 1 << ((c >> 1) & 1); u.bmask = 1 << (c & 1); }
            else if (2 * Rm <= G) { if (c >= 2 * Rm) return false; Lq = F * G + (c >> 1); u.bmask = 1 << (c & 1); }
            else { if (c >= Rm) return false; Lq = F * G + c; }
        } else return false;
        int wgid = Lq; { const int q = nwg / NXCD, r = nwg % NXCD, xcd = wgid % NXCD, off = wgid / NXCD; wgid = (xcd < r ? xcd * (q + 1) : r * (q + 1) + (xcd - r) * q) + off; }
        const int nig = WGM * nN, gid = wgid / nig, fm = gid * WGM, gsz = (nM - fm) < WGM ? (nM - fm) : WGM;
        u.pm = fm + ((wgid % nig) % gsz); u.pn = (wgid % nig) / gsz; u.e = 0; u.goff = 0; u.gcnt = 0; u.real = true; return true;
    }
};
struct MoeOrder {
    const LAS int* tp; const LAS int* cnt; int npn, G, vcu; bool split;
    __device__ __forceinline__ bool next(int i, Unit& u) const {
        const int tot = tp[32] * npn; int lin; u.amask = 3; u.bmask = 3; u.real = true;
        if (GEMM_REP > 1) { const int lin0 = i * G + vcu; if (lin0 >= tot * GEMM_REP) return false; lin = lin0 % tot; u.real = lin0 >= tot * (GEMM_REP - 1); }
        else {
            const int F = tot / G, Rm = tot - F * G;
            if (i < F) lin = i * G + vcu;
            else if (i == F && Rm > 0) {
                if (split && 2 * Rm <= G) { if (vcu >= 2 * Rm) return false; lin = F * G + (vcu >> 1); u.bmask = 1 << (vcu & 1); }
                else { if (vcu >= Rm) return false; lin = F * G + vcu; }
            } else return false;
        }
        const int rt = lin / npn; int e = 0;
#pragma unroll 8
        for (int k = 1; k < 32; ++k) e += (rt >= tp[k]) ? 1 : 0;
        const int mt = rt - tp[e];
        u.pm = rt; u.pn = lin - rt * npn; u.e = e; u.goff = e * R + mt * 256; u.gcnt = cnt[e] - mt * 256; return true;
    }
};

__device__ __forceinline__ void a_rows(const Gemm& g, const Unit& u, const int (&sR)[2], int (&rows)[2][2]) {
#pragma unroll
    for (int h = 0; h < 2; ++h)
#pragma unroll
        for (int i = 0; i < 2; ++i) { const int rr = h * HALF + sR[i]; rows[h][i] = rr < u.gcnt ? g.list[u.goff + rr] : 0; }
}
template <int KB>
__device__ __forceinline__ void a_offsets(const Gemm& g, const Unit& u, const int (&sR)[2], const int (&sC)[2], unsigned (&v)[2][2]) {
#pragma unroll
    for (int h = 0; h < 2; ++h)
#pragma unroll
        for (int i = 0; i < 2; ++i) {
            const int rr = h * HALF + sR[i]; int row;
            if (g.list) row = rr < u.gcnt ? g.list[u.goff + rr] : 0; else row = u.pm * BM + rr;
            v[h][i] = (unsigned)(row * KB + sC[i] * 2);
        }
}

struct EpiF32 {
    static constexpr bool LDSBIAS = false; static constexpr bool PERM = false;
    bf16_t* Cp; int ldc; const float* bias;
    __device__ __forceinline__ void operator()(const f32x4 (&acc)[2][2][4][2], const Unit& u, int wr, int wc, int fr, int fq, const LAS float* bl) const {
        const int row0 = u.pm * BM + wr * 64 + fr, col0 = u.pn * BM + wc * 32 + 4 * fq;
#pragma unroll
        for (int bj = 0; bj < 2; ++bj)
#pragma unroll
            for (int n = 0; n < 2; ++n) {
                const int col = col0 + bj * HALF + n * 16;
                if (!((u.bmask >> bj) & 1)) continue;
                const f32x4 bv = bias ? *(const f32x4*)(bias + col) : (f32x4){0.f, 0.f, 0.f, 0.f};
#pragma unroll
                for (int ai = 0; ai < 2; ++ai)
#pragma unroll
                    for (int m = 0; m < 4; ++m) if ((u.amask >> ai) & 1) { const f32x4 v = acc[ai][bj][m][n] + bv; u32x2 o; o.x = pk2(v[0], v[1]); o.y = pk2(v[2], v[3]);
                        *(u32x2*)(Cp + (size_t)(row0 + ai * HALF + m * 16) * ldc + col) = o; }
            }
    }
};
struct EpiSwiglu {
    static constexpr bool LDSBIAS = true; static constexpr bool PERM = true;
    unsigned char* Hd; const float* bgu;
    __device__ __forceinline__ const char* bias_base(const Unit& u) const { return (const char*)(bgu + (size_t)u.e * 2048 + u.pn * HALF); }
    __device__ __forceinline__ unsigned bias_voff(int lane) const { return (unsigned)(((lane >> 5) * 1024 + (lane & 31) * 4) * 4); }
    __device__ __forceinline__ void operator()(const f32x4 (&acc)[2][2][4][2], const Unit& u, int wr, int wc, int fr, int fq, const LAS float* bl) const {
        const int row0 = u.pm * BM + wr * 64 + fr, cg0 = u.pn * HALF + wc * 32 + 8 * fq;
        f32x4 bg[2], bu[2];
#pragma unroll
        for (int n = 0; n < 2; ++n) { bg[n] = *(const LAS f32x4*)(bl + wc * 32 + 8 * fq + 4 * n); bu[n] = *(const LAS f32x4*)(bl + 128 + wc * 32 + 8 * fq + 4 * n); }
#pragma unroll
        for (int ai = 0; ai < 2; ++ai)
#pragma unroll
            for (int m = 0; m < 4; ++m) {
                u32x2 o;
#pragma unroll
                for (int n = 0; n < 2; ++n) {
                    const f32x4 gv = acc[ai][0][m][n] * (1.f / (F8_SH * F8_SW)) + bg[n], uv = acc[ai][1][m][n] * (1.f / (F8_SH * F8_SW)) + bu[n]; float hv[4];
#pragma unroll
                    for (int q = 0; q < 4; ++q) { const float gg = fminf(gv[q], 7.f), uu = fminf(fmaxf(uv[q], -7.f), 7.f);
                        hv[q] = gg * __builtin_amdgcn_rcpf(1.f + __builtin_amdgcn_exp2f(-1.702f * LOG2E * gg)) * (uu * F8_SHD + F8_SHD); }
                    o[n] = pk4_fp8_nc(hv[0], hv[1], hv[2], hv[3]);
                }
                *(u32x2*)(Hd + (size_t)(row0 + ai * HALF + m * 16) * 1024 + cg0) = o;
            }
    }
};
struct EpiBf16Bias {
    static constexpr bool LDSBIAS = true; static constexpr bool PERM = true;
    unsigned char* Op; const float* bias; int bias_estride; float scale;
    __device__ __forceinline__ const char* bias_base(const Unit& u) const { return (const char*)(bias + (size_t)u.e * bias_estride + u.pn * BM); }
    __device__ __forceinline__ unsigned bias_voff(int lane) const { return (unsigned)(lane * 16); }
    __device__ __forceinline__ void operator()(const f32x4 (&acc)[2][2][4][2], const Unit& u, int wr, int wc, int fr, int fq, const LAS float* bl) const {
        const int row0 = u.pm * BM + wr * 64 + fr, col0 = u.pn * BM + wc * 32 + 8 * fq;
#pragma unroll
        for (int bj = 0; bj < 2; ++bj) {
            const int col = col0 + bj * HALF;
            if (!((u.bmask >> bj) & 1)) continue;
            const f32x4 b0 = *(const LAS f32x4*)(bl + bj * HALF + wc * 32 + 8 * fq) * F8_SO, b1 = *(const LAS f32x4*)(bl + bj * HALF + wc * 32 + 8 * fq + 4) * F8_SO;
#pragma unroll
            for (int ai = 0; ai < 2; ++ai)
#pragma unroll
                for (int m = 0; m < 4; ++m) { if (!((u.amask >> ai) & 1)) continue; const f32x4 v0 = acc[ai][bj][m][0] * (scale * F8_SO) + b0, v1 = acc[ai][bj][m][1] * (scale * F8_SO) + b1;
                    u32x2 o; o.x = pk4_fp8(v0[0], v0[1], v0[2], v0[3]); o.y = pk4_fp8(v1[0], v1[1], v1[2], v1[3]);
                    *(u32x2*)(Op + (size_t)(row0 + ai * HALF + m * 16) * 1024 + col) = o; }
        }
    }
};
struct EpiQKV {
    static constexpr bool LDSBIAS = false; static constexpr bool PERM = false;
    bf16_t* Qp; bf16_t* Kp; bf16_t* Vp; const float* bias; const float* tab;
    __device__ __forceinline__ void operator()(const f32x4 (&acc)[2][2][4][2], const Unit& u, int wr, int wc, int fr, int fq, const LAS float* bl) const {
        const bool lat = u.pm > 0; const float qs = 0.125f * LOG2E;
#pragma unroll
        for (int bj = 0; bj < 2; ++bj) {
            const int colt = u.pn * BM + bj * HALF + wc * 32 + 4 * fq;
            const f32x4 b1 = *(const f32x4*)(bias + colt), b2 = *(const f32x4*)(bias + colt + 16);
            const bool isv = (u.pn == 4) && (bj == 1);
            if (!((u.bmask >> bj) & 1)) continue;
#pragma unroll
            for (int ai = 0; ai < 2; ++ai)
#pragma unroll
                for (int m = 0; m < 4; ++m) {
                    if (!((u.amask >> ai) & 1)) continue;
                    const int r = u.pm * BM + ai * HALF + wr * 64 + m * 16 + fr, t = r - C;
                    f32x4 x1 = acc[ai][bj][m][0] + b1, x2 = acc[ai][bj][m][1] + b2;
                    if (lat && !isv) {
                        const int pos = (wc & 1) ? (t & 63) : (t >> 6);
                        const f32x4 t0 = *(const f32x4*)(tab + (pos * 16 + 4 * fq) * 2), t1 = *(const f32x4*)(tab + (pos * 16 + 4 * fq) * 2 + 4);
                        const float cs[4] = {t0[0], t0[2], t1[0], t1[2]}, sn[4] = {t0[1], t0[3], t1[1], t1[3]};
                        f32x4 o1, o2;
#pragma unroll
                        for (int e = 0; e < 4; ++e) { o1[e] = x1[e] * cs[e] - x2[e] * sn[e]; o2[e] = x2[e] * cs[e] + x1[e] * sn[e]; }
                        x1 = o1; x2 = o2;
                    }
                    u32x2 w1, w2;
                    if (u.pn < 4) {
                        w1.x = pk2(x1[0] * qs, x1[1] * qs); w1.y = pk2(x1[2] * qs, x1[3] * qs); w2.x = pk2(x2[0] * qs, x2[1] * qs); w2.y = pk2(x2[2] * qs, x2[3] * qs);
                        *(u32x2*)(Qp + (size_t)r * 1024 + colt) = w1; *(u32x2*)(Qp + (size_t)r * 1024 + colt + 16) = w2;
                    } else {
                        w1.x = pk2(x1[0], x1[1]); w1.y = pk2(x1[2], x1[3]); w2.x = pk2(x2[0], x2[1]); w2.y = pk2(x2[2], x2[3]);
                        bf16_t* dst = (bj == 0 ? Kp : Vp) + (size_t)r * 128 + wc * 32 + 4 * fq;
                        *(u32x2*)dst = w1; *(u32x2*)(dst + 16) = w2;
                    }
                }
        }
    }
};
struct EpiInProj {
    static constexpr bool LDSBIAS = false; static constexpr bool PERM = true;
    bf16_t* QH; _Float16* KF; _Float16* KB; bf16_t* IV; bf16_t* SG; const float* lb; float scale;
    __device__ __forceinline__ void operator()(const f32x4 (&acc)[2][2][4][2], const Unit& u, int wr, int wc, int fr, int fq, const LAS float* bl) const {
        const int seg = u.pn >> 2; const bool lat = u.pm > 0;
        if (!lat && (seg == 0 || seg == 4)) return;
        typedef _Float16 h8_t __attribute__((ext_vector_type(8)));
#pragma unroll
        for (int bj = 0; bj < 2; ++bj) {
            const int col = (u.pn & 3) * BM + bj * HALF + wc * 32 + 8 * fq;
            if (!((u.bmask >> bj) & 1)) continue;
            f32x4 lb0 = (f32x4){0.f, 0.f, 0.f, 0.f}, lb1 = lb0;
            if (seg == 1) { lb0 = *(const f32x4*)(lb + col); lb1 = *(const f32x4*)(lb + col + 4); } else if (seg == 2) { lb0 = *(const f32x4*)(lb + 1024 + col); lb1 = *(const f32x4*)(lb + 1024 + col + 4); }
#pragma unroll
            for (int ai = 0; ai < 2; ++ai)
#pragma unroll
                for (int m = 0; m < 4; ++m) {
                    if (!((u.amask >> ai) & 1)) continue;
                    const int r = u.pm * BM + ai * HALF + wr * 64 + m * 16 + fr; const f32x4 v0 = acc[ai][bj][m][0] * scale, v1 = acc[ai][bj][m][1] * scale;
                    if (seg == 1 || seg == 2) {
                        h8_t hv;
#pragma unroll
                        for (int e = 0; e < 4; ++e) { hv[e] = (_Float16)((1.f - lb0[e]) * __builtin_amdgcn_rcpf(1.f + __builtin_amdgcn_exp2f(LOG2E * v0[e]))); hv[4 + e] = (_Float16)((1.f - lb1[e]) * __builtin_amdgcn_rcpf(1.f + __builtin_amdgcn_exp2f(LOG2E * v1[e]))); }
                        *(h8_t*)((seg == 1 ? KF : KB) + (size_t)r * 1024 + col) = hv;
                    } else if (seg == 3) {
                        u32x4 o; o.x = pk2(v0[0], v0[1]); o.y = pk2(v0[2], v0[3]); o.z = pk2(v1[0], v1[1]); o.w = pk2(v1[2], v1[3]); *(u32x4*)(IV + (size_t)r * 1024 + col) = o;
                    } else {
                        float s0[4], s1[4];
#pragma unroll
                        for (int e = 0; e < 4; ++e) { s0[e] = v0[e] * __builtin_amdgcn_rcpf(1.f + __builtin_amdgcn_exp2f(-LOG2E * v0[e])); s1[e] = v1[e] * __builtin_amdgcn_rcpf(1.f + __builtin_amdgcn_exp2f(-LOG2E * v1[e])); }
                        u32x4 o; o.x = pk2(s0[0], s0[1]); o.y = pk2(s0[2], s0[3]); o.z = pk2(s1[0], s1[1]); o.w = pk2(s1[2], s1[3]); *(u32x4*)((seg == 0 ? QH : SG) + (size_t)(r - C) * 1024 + col) = o;
                    }
                }
        }
    }
};

typedef int v8i __attribute__((ext_vector_type(8)));
typedef int v4i __attribute__((ext_vector_type(4)));
template <class Epi, class Sched, bool ALIGN_EPI, bool GATHER, bool FP8>
__device__ __forceinline__ void gemm_phase(LAS unsigned char* lds, const Gemm g, const Sched& S, const Epi& E, const int tid) {
    const int wid = __builtin_amdgcn_readfirstlane(tid >> 6), lane = tid & 63, wr = wid >> 2, wc = wid & 3, fr = lane & 15, fq = lane >> 4;
    constexpr int KB = FP8 ? 1024 : 2048, nt = 1024 / (FP8 ? 128 : 64);
    int sR[2], sC[2]; unsigned voffB[2], voffA[2];
#pragma unroll
    for (int i = 0; i < 2; ++i) { stage_rc(tid * 16 + i * 8192, sR[i], sC[i]); const int Rb = Epi::PERM ? ((sR[i] & ~31) + perm32(sR[i] & 31)) : sR[i]; voffB[i] = (unsigned)(Rb * KB + sC[i] * 2); voffA[i] = (unsigned)(sR[i] * KB + sC[i] * 2); }
    constexpr size_t kstep = (size_t)(BK * 2), hstep = (size_t)HALF * KB, tstep = 2 * hstep;
    const unsigned ldsw = (unsigned)wid * 1024u;
    const int aoff = lds_byte(wr * 64 + fr, fq * 8), boff = lds_byte(wc * 32 + fr, fq * 8);
    const char* Ab = (const char*)g.A;
#define PG8_SA(b, h) (((b) * 2 + (h)) * HTB)
#define PG8_SB(b, h) ((4 + (b) * 2 + (h)) * HTB)
#define PG8_STAGE_B(bufoff, gbase) do { _Pragma("unroll") for (int _i = 0; _i < 2; ++_i) \
        __builtin_amdgcn_global_load_lds((const unsigned*)((const char*)(gbase) + voffB[_i]), (LAS unsigned*)(lds + (bufoff) + ldsw + _i * 8192), 16, 0, 0); } while (0)
#define PG8_STAGE_A(bufoff, kb, v, ubase) do { _Pragma("unroll") for (int _i = 0; _i < 2; ++_i) \
        __builtin_amdgcn_global_load_lds((const unsigned*)((GATHER ? Ab : (ubase)) + (size_t)(kb) + (GATHER ? (v)[_i] : voffA[_i])), (LAS unsigned*)(lds + (bufoff) + ldsw + _i * 8192), 16, 0, 0); } while (0)
#define PG8_LD8(p) __builtin_shufflevector(*(const LAS v4i*)(p), *(const LAS v4i*)((p) + 1024), 0, 1, 2, 3, 4, 5, 6, 7)
#define PG8_LDA(dst, b, h) do { if constexpr (FP8) { _Pragma("unroll") for (int m = 0; m < 4; ++m) dst##8[m] = PG8_LD8(lds + PG8_SA(b, h) + aoff + m * 2048); } else { _Pragma("unroll") for (int m = 0; m < 4; ++m) _Pragma("unroll") for (int k = 0; k < 2; ++k) dst[m][k] = *(const LAS bf16x8*)(lds + PG8_SA(b, h) + aoff + m * 2048 + k * 1024); } } while (0)
#define PG8_LDB(dst, b, h) do { if constexpr (FP8) { _Pragma("unroll") for (int n = 0; n < 2; ++n) dst##8[n] = PG8_LD8(lds + PG8_SB(b, h) + boff + n * 2048); } else { _Pragma("unroll") for (int n = 0; n < 2; ++n) _Pragma("unroll") for (int k = 0; k < 2; ++k) dst[n][k] = *(const LAS bf16x8*)(lds + PG8_SB(b, h) + boff + n * 2048 + k * 1024); } } while (0)
#define PG8_MMA(ai, bj, At, Bt) do { __builtin_amdgcn_s_setprio(1); if constexpr (FP8) { _Pragma("unroll") for (int m = 0; m < 4; ++m) _Pragma("unroll") for (int n = 0; n < 2; ++n) \
        asm volatile("v_mfma_scale_f32_16x16x128_f8f6f4 %0, %1, %2, %0, %3, %3 op_sel_hi:[0,0,0]" : "+v"(acc[ai][bj][m][n]) : "v"(Bt##8[n]), "v"(At##8[m]), "v"(unit_scale)); } else { \
        _Pragma("unroll") for (int m = 0; m < 4; ++m) _Pragma("unroll") for (int n = 0; n < 2; ++n) _Pragma("unroll") for (int k = 0; k < 2; ++k) \
        acc[ai][bj][m][n] = __builtin_amdgcn_mfma_f32_16x16x32_bf16(Bt[n][k], At[m][k], acc[ai][bj][m][n], 0, 0, 0); } __builtin_amdgcn_s_setprio(0); } while (0)
#define PG8_WAIT_V(n) asm volatile("s_waitcnt vmcnt(" #n ")" ::: "memory")
#define PG8_WAIT_L(n) asm volatile("s_waitcnt lgkmcnt(" #n ")" ::: "memory")
#define PG8_BAR __builtin_amdgcn_s_barrier()
#define PG8_SCHED __builtin_amdgcn_sched_barrier(0)
    Unit cur, nxt; int ui = 0;
    if (!S.next(0, cur)) return;
    unsigned cv[2][2]; int nvr[2][2];
    if constexpr (GATHER) a_offsets<KB>(g, cur, sR, sC, cv);
    const char* cA = Ab + (size_t)cur.pm * tstep; const char* nA = cA;
    f32x4 acc[2][2][4][2];
#pragma unroll
    for (int a = 0; a < 2; ++a)
#pragma unroll
        for (int b = 0; b < 2; ++b)
#pragma unroll
            for (int m = 0; m < 4; ++m)
#pragma unroll
                for (int n = 0; n < 2; ++n) acc[a][b][m][n] = (f32x4){0.f, 0.f, 0.f, 0.f};
    bf16x8 At[4][2], B0[2][2], B1[2][2]; v8i At8[4], B08[2], B18[2];
    int unit_scale = 0x7f7f7f7f; asm volatile("" : "+v"(unit_scale));
    const char* cB = (const char*)g.Bt + (size_t)cur.e * g.bstride + (size_t)cur.pn * tstep;
#define PG8_BIAS(uu, slot) do { if constexpr (Epi::LDSBIAS) { if (wid == 0) { int l_ = lane; asm volatile("" : "+v"(l_)); \
        __builtin_amdgcn_global_load_lds((const unsigned*)(E.bias_base(uu) + E.bias_voff(l_)), (LAS unsigned*)(lds + STAGE_BYTES + 4096 + (slot) * 1024), 16, 0, 0); } } } while (0)
    PG8_BIAS(cur, 0);
    PG8_STAGE_B(PG8_SB(0, 0), cB); PG8_STAGE_B(PG8_SB(0, 1), cB + hstep); PG8_STAGE_A(PG8_SA(0, 0), 0, cv[0], cA); PG8_STAGE_A(PG8_SA(0, 1), 0, cv[1], cA + hstep);
    if (wr == 1) PG8_BAR;
    PG8_WAIT_V(2); PG8_BAR;
    PG8_STAGE_B(PG8_SB(1, 0), cB + kstep); PG8_STAGE_A(PG8_SA(1, 0), kstep, cv[0], cA); PG8_STAGE_B(PG8_SB(1, 1), cB + hstep + kstep);
    PG8_WAIT_V(6); PG8_BAR;
    for (;;) {
        const bool has_next = S.next(ui + 1, nxt);
        const char* nB = cB;
        nA = cA;
        if (has_next) { PG8_BIAS(nxt, (ui + 1) % 3); if constexpr (GATHER) a_rows(g, nxt, sR, nvr); nA = Ab + (size_t)nxt.pm * tstep; nB = (const char*)g.Bt + (size_t)nxt.e * g.bstride + (size_t)nxt.pn * tstep; }

        const int ntr = (PROBE_SHORTK && !cur.real) ? 2 : nt;
        const bool m00 = (cur.amask & 1) && (cur.bmask & 1), m01 = (cur.amask & 1) && (cur.bmask & 2), m10 = (cur.amask & 2) && (cur.bmask & 1), m11 = (cur.amask & 2) && (cur.bmask & 2);
#pragma nounroll
        for (int t = 0; t < ntr; t += 2) {
            const bool last = (t == ntr - 2);
            if constexpr (GATHER) { if (last && has_next) asm volatile("" : "+v"(nvr[0][0]), "+v"(nvr[0][1]), "+v"(nvr[1][0]), "+v"(nvr[1][1])); }
            const size_t k1 = (size_t)(t + 1) * kstep, k2 = last ? 0 : (size_t)(t + 2) * kstep, k3 = k2 + kstep;
            const char* b2 = last ? nB : cB + (size_t)(t + 2) * kstep; const char* b3 = b2 + kstep;
            unsigned w0[2], w1[2];
            if constexpr (GATHER) {
#pragma unroll
                for (int i = 0; i < 2; ++i) { w0[i] = (last && has_next) ? (unsigned)(nvr[0][i] * KB + sC[i] * 2) : cv[0][i]; w1[i] = (last && has_next) ? (unsigned)(nvr[1][i] * KB + sC[i] * 2) : cv[1][i]; }
            }
            const char* a2 = last ? nA : cA;
            PG8_LDB(B0, 0, 0); PG8_LDB(B1, 0, 1); PG8_SCHED; PG8_LDA(At, 0, 0); PG8_STAGE_A(PG8_SA(1, 1), k1, cv[1], cA + hstep);
            PG8_WAIT_V(8); PG8_WAIT_L(0); PG8_BAR; if (m00) PG8_MMA(0, 0, At, B0); if (m01) PG8_MMA(0, 1, At, B1); PG8_BAR; PG8_SCHED;
            PG8_LDA(At, 0, 1); PG8_STAGE_B(PG8_SB(0, 0), b2); PG8_STAGE_B(PG8_SB(0, 1), b2 + hstep); PG8_STAGE_A(PG8_SA(0, 0), k2, w0, a2);
            PG8_WAIT_V(8); PG8_WAIT_L(0); PG8_BAR; if (m10) PG8_MMA(1, 0, At, B0); if (m11) PG8_MMA(1, 1, At, B1); PG8_BAR; PG8_SCHED;
            PG8_LDB(B0, 1, 0); PG8_LDB(B1, 1, 1); PG8_SCHED; PG8_LDA(At, 1, 0); PG8_STAGE_A(PG8_SA(0, 1), k2, w1, a2 + hstep);
            PG8_WAIT_V(8); PG8_WAIT_L(0); PG8_BAR; if (m00) PG8_MMA(0, 0, At, B0); if (m01) PG8_MMA(0, 1, At, B1); PG8_BAR; PG8_SCHED;
            PG8_LDA(At, 1, 1); PG8_STAGE_B(PG8_SB(1, 0), b3); PG8_STAGE_B(PG8_SB(1, 1), b3 + hstep); PG8_STAGE_A(PG8_SA(1, 0), k3, w0, a2);
            PG8_WAIT_V(8); PG8_WAIT_L(0); PG8_BAR; if (m10) PG8_MMA(1, 0, At, B0); if (m11) PG8_MMA(1, 1, At, B1); PG8_BAR; PG8_SCHED;
        }
        if constexpr (ALIGN_EPI) { if (wr == 0) PG8_BAR; }
        if constexpr (FP8) asm volatile("s_nop 15\n\ts_nop 15" ::: "memory");
        if (!PROBE_NOEPI || cur.real) E(acc, cur, wr, wc, fr, fq, (const LAS float*)(lds + STAGE_BYTES + 4096 + (ui % 3) * 1024));
        if (!has_next) break;
#pragma unroll
        for (int a = 0; a < 2; ++a)
#pragma unroll
            for (int b = 0; b < 2; ++b)
#pragma unroll
                for (int m = 0; m < 4; ++m)
#pragma unroll
                    for (int n = 0; n < 2; ++n) acc[a][b][m][n] = (f32x4){0.f, 0.f, 0.f, 0.f};
        cur = nxt; cB = nB; cA = nA; ++ui;
        if constexpr (GATHER) {
#pragma unroll
            for (int h = 0; h < 2; ++h)
#pragma unroll
                for (int i = 0; i < 2; ++i) cv[h][i] = (unsigned)(nvr[h][i] * KB + sC[i] * 2);
        }
        if constexpr (ALIGN_EPI) { if (wr == 1) PG8_BAR; }
    }
    PG8_WAIT_V(0);
    if constexpr (!ALIGN_EPI) { if (wr == 0) PG8_BAR; }
    PG8_BAR;
#undef PG8_SA
#undef PG8_SB
#undef PG8_STAGE_A
#undef PG8_STAGE_B
#undef PG8_LDA
#undef PG8_BIAS
#undef PG8_LD8
#undef PG8_LDB
#undef PG8_MMA
#undef PG8_WAIT_V
#undef PG8_WAIT_L
#undef PG8_BAR
#undef PG8_SCHED
}
}

struct TBlk { const float* src; int ldw; bf16_t* dst; unsigned char* dst8; };
__device__ __forceinline__ void tb_load(const TBlk& t, int lane, f32x4 (&v)[16]) {
    const float* p = t.src + (size_t)(lane >> 4) * t.ldw + (lane & 15) * 4;
#pragma unroll
    for (int i = 0; i < 16; ++i) v[i] = *(const f32x4*)(p + (size_t)(4 * i) * t.ldw);
}
__device__ __forceinline__ void tb_store(const TBlk& t, int lane, const f32x4 (&v)[16], LAS float* scr) {
#pragma unroll
    for (int i = 0; i < 16; ++i) { LAS float* d = scr + ((lane >> 4) + 4 * i) * 65 + (lane & 15) * 4; d[0] = v[i].x; d[1] = v[i].y; d[2] = v[i].z; d[3] = v[i].w; }
    asm volatile("s_waitcnt lgkmcnt(0)" ::: "memory"); __builtin_amdgcn_wave_barrier();
    const int c8 = lane & 7;
#pragma unroll
    for (int jj = 0; jj < 8; ++jj) {
        const int n = (lane >> 3) + 8 * jj; const LAS float* p = scr + (8 * c8) * 65 + n;
        if (t.dst8) { u32x2 o; o.x = pk4_fp8(p[0] * F8_SW, p[65] * F8_SW, p[2 * 65] * F8_SW, p[3 * 65] * F8_SW); o.y = pk4_fp8(p[4 * 65] * F8_SW, p[5 * 65] * F8_SW, p[6 * 65] * F8_SW, p[7 * 65] * F8_SW);
            *(u32x2*)(t.dst8 + (size_t)n * 1024 + 8 * c8) = o; }
        else { u32x4 o; o.x = pk2(p[0], p[65]); o.y = pk2(p[2 * 65], p[3 * 65]); o.z = pk2(p[4 * 65], p[5 * 65]); o.w = pk2(p[6 * 65], p[7 * 65]);
            *(u32x4*)(t.dst + (size_t)n * 1024 + 8 * c8) = o; }
    }
    asm volatile("s_waitcnt lgkmcnt(0)" ::: "memory"); __builtin_amdgcn_wave_barrier();
}

__device__ __forceinline__ void phase_prep(const Ctx& c) {
    LAS float* red = (LAS float*)c.lds;
    LAS float* sil = red + 1024;
    const float* cv = c.a->in[1]; const float* ccv = c.a->in[3]; const float* ada_w = c.a->in[4]; const float* ada_b = c.a->in[5];
    for (int i = c.tid; i < 2048; i += 512) { const float x = i < 1024 ? cv[i] : ccv[i - 1024]; sil[i] = x * __builtin_amdgcn_rcpf(1.f + __builtin_amdgcn_exp2f(-LOG2E * x)); }
    __syncthreads();
    for (int item = c.wg; item < 193; item += c.nwg) {
        if (item < 192) {
            const int layer = item / 96, cb = item % 96, col = cb * 64 + c.lane;
            const float* W = ada_w + (size_t)layer * D * 6144 + col;
            float a0 = 0.f, a1 = 0.f;
            const int k0 = c.wave * 128;
#pragma unroll 32
            for (int k = 0; k < 128; ++k) { const float w = W[(size_t)(k0 + k) * 6144]; a0 += sil[k0 + k] * w; a1 += sil[1024 + k0 + k] * w; }
            red[(0 * 8 + c.wave) * 64 + c.lane] = a0; red[(1 * 8 + c.wave) * 64 + c.lane] = a1;
            __syncthreads();
            if (c.tid < 128) {
                const int which = c.tid >> 6, l = c.tid & 63; float s = 0.f;
#pragma unroll
                for (int w = 0; w < 8; ++w) s += red[(which * 8 + w) * 64 + l];
                c.modp(layer, which)[cb * 64 + l] = s + ada_b[layer * 6144 + cb * 64 + l];
            }
            __syncthreads();
        } else {
            float* modbase = (float*)(c.ws + WS_MOD);
            for (int i = c.tid; i < 4096; i += 512) {
                const int pos = i >> 4, j = i & 15;
                const double ang = (double)pos * pow(10000.0, -(double)j / 16.0);
                modbase[MOD_ROPE + 2 * i] = (float)cos(ang); modbase[MOD_ROPE + 2 * i + 1] = (float)sin(ang);
            }
            const float* lbp = c.a->in[12];
            for (int i = c.tid; i < 2048; i += 512) { const float p0 = lbp[i], p1 = lbp[2048 + i]; modbase[MOD_LB + i] = 1.f / (1.f + __expf(p0 - p1)); }
        }
    }
}

__device__ __forceinline__ void row_load(const float* p, int lane, f32x4 (&v)[4]) {
#pragma unroll
    for (int j = 0; j < 4; ++j) v[j] = *(const f32x4*)(p + lane * 4 + 256 * j);
}
__device__ __forceinline__ void row_load_bf(const bf16_t* p, int lane, f32x4 (&v)[4]) {
#pragma unroll
    for (int j = 0; j < 4; ++j) { const u32x2 w = *(const u32x2*)(p + lane * 4 + 256 * j); v[j] = (f32x4){bflo(w.x), bfhi(w.x), bflo(w.y), bfhi(w.y)}; }
}
__device__ __forceinline__ float row_ss(const f32x4 (&v)[4]) {
    float s = 0.f;
#pragma unroll
    for (int j = 0; j < 4; ++j) s += v[j].x * v[j].x + v[j].y * v[j].y + v[j].z * v[j].z + v[j].w * v[j].w;
    return wave_sum(s);
}
__device__ __forceinline__ void row_modnorm_store(const f32x4 (&x)[4], float rstd, const float* g, const float* sh, const float* sc, bf16_t* out, int lane, f32x4 (*hout)[4] = nullptr) {
#pragma unroll
    for (int j = 0; j < 4; ++j) {
        const int c0 = lane * 4 + 256 * j;
        const f32x4 gv = *(const f32x4*)(g + c0), shv = *(const f32x4*)(sh + c0), scv = *(const f32x4*)(sc + c0);
        f32x4 h;
        h.x = x[j].x * rstd * gv.x * (1.f + scv.x) + shv.x; h.y = x[j].y * rstd * gv.y * (1.f + scv.y) + shv.y;
        h.z = x[j].z * rstd * gv.z * (1.f + scv.z) + shv.z; h.w = x[j].w * rstd * gv.w * (1.f + scv.w) + shv.w;
        if (hout) (*hout)[j] = h;
        u32x2 o; o.x = pk2(h.x, h.y); o.y = pk2(h.z, h.w);
        *(u32x2*)(out + c0) = o;
    }
}

__device__ __forceinline__ void phase_norm0(const Ctx& c) {
    bf16_t* H = (bf16_t*)(c.ws + WS_H); const float* ng = c.a->in[6];
    int r = c.wg * 8 + c.wave;
    f32x4 xn[4];
    if (r < R) row_load(c.xin0(r), c.lane, xn);
    for (; r < R; r += c.nwg * 8) {
        f32x4 x[4];
#pragma unroll
        for (int j = 0; j < 4; ++j) x[j] = xn[j];
        if (r + c.nwg * 8 < R) row_load(c.xin0(r + c.nwg * 8), c.lane, xn);
        const float rstd = rsqrtf(row_ss(x) * (1.f / D) + EPS);
        const float* m = c.modp(0, r < C ? 1 : 0);
        row_modnorm_store(x, rstd, ng, m + 0, m + 1024, H + (size_t)r * D, c.lane);
    }
}

namespace at {
__device__ __forceinline__ float max3f(float a, float b, float c) { return __builtin_fmaxf(__builtin_fmaxf(a, b), c); }
constexpr int KP = 144, TILEB = 64 * KP;
__device__ __forceinline__ bf16x8 tr_frag2(const LAS unsigned char* tile, int row0, int col0, int lane) {
    const int q = (lane & 15) >> 2, p = lane & 3;
    const LAS unsigned char* a = tile + (row0 + q) * KP + (col0 + 4 * p) * 2;
    const v4i16_t lo = __builtin_amdgcn_ds_read_tr16_b64_v4i16((LAS v4i16_t*)a);
    const v4i16_t hi = __builtin_amdgcn_ds_read_tr16_b64_v4i16((LAS v4i16_t*)(a + 16 * KP));
    return (bf16x8){lo[0], lo[1], lo[2], lo[3], hi[0], hi[1], hi[2], hi[3]};
}
}
__device__ __forceinline__ void phase_attn(const Ctx& c) {
    using namespace at;
    const bf16_t* Q = (const bf16_t*)(c.ws + WS_Q); const bf16_t* K = (const bf16_t*)(c.ws + WS_K); const bf16_t* V = (const bf16_t*)(c.ws + WS_V);
    bf16_t* O = (bf16_t*)(c.ws + WS_O); const float* sink = c.a->in[9];
    LAS unsigned char* lds = c.lds;
    const int tid = c.tid, lane = c.lane, w = __builtin_amdgcn_readfirstlane(tid >> 6), fr = lane & 15, g = lane >> 4;
    const int lrow = tid >> 3, lch = tid & 7;
    const int nitn = c.nwg == 256 ? 2 : (264 - c.wg + c.nwg - 1) / c.nwg;
    for (int itn = 0; itn < nitn; ++itn) {
        int item = c.wg + itn * c.nwg;
        if (c.nwg == 256 && itn == 1) { const int n_ = c.wg >> 1; item = -1;
            if (n_ == 0) item = 256 + (c.wg & 1); else if (n_ == 127) item = 258 + (c.wg & 1); else if (n_ == 30 || n_ == 31) item = 260 + (c.wg - 60); }
        if (item < 0 || item >= 264) continue;
        const bool isctx = item >= 256;
        const int ci = item - 256;
        const int n = isctx ? 0 : (item >> 1), kh = isctx ? ((ci >> 1) & 1) : (item & 1), cb = isctx ? (ci >> 2) : 0;
        const int p_lo = isctx ? (ci & 1) : 0, p_hi = isctx ? (ci & 1) + 1 : 2;
        const int hq = kh * 8 + w;
        const float sink2 = sink[hq] * LOG2E;
        for (int pass = p_lo; pass < p_hi; ++pass) {
            const int t0 = 128 * n + 64 * pass, qrow0 = isctx ? cb * 128 + 64 * pass : C + t0;
            const int jlo = isctx ? 0 : (t0 >= 128 ? 0 : (128 - t0) / 64), jhi = isctx ? 0 : ((L - t0 + 128) / 64 < 5 ? (L - t0 + 128) / 64 : 5);
            const int ntile = 4 + (jhi - jlo);
            LAS unsigned char* qlds = lds + 4 * TILEB + w * TILEB;
#pragma unroll
            for (int qb = 0; qb < 4; ++qb)
#pragma unroll
                for (int ks = 0; ks < 2; ++ks) *(LAS bf16x8*)(qlds + (16 * qb + fr) * KP + (32 * ks + 8 * g) * 2) = *(const bf16x8*)(Q + (size_t)(qrow0 + 16 * qb + fr) * D + hq * 64 + 32 * ks + 8 * g);
            float mrow[4], lsum[4]; f32x4 OT[4][4];
#pragma unroll
            for (int qb = 0; qb < 4; ++qb) { mrow[qb] = sink2; lsum[qb] = 1.f;
#pragma unroll
                for (int nt = 0; nt < 4; ++nt) OT[qb][nt] = (f32x4){0.f, 0.f, 0.f, 0.f}; }
            u32x4 kreg, vreg;
#define AT_KROW(ti) ((ti) < 4 ? 64 * (ti) : C + t0 - 128 + 64 * (jlo + (ti) - 4))
#define AT_LOAD(ti) do { const size_t ro_ = (size_t)(AT_KROW(ti) + lrow) * 128 + kh * 64 + lch * 8; kreg = *(const u32x4*)(K + ro_); vreg = *(const u32x4*)(V + ro_); } while (0)
#define AT_WRITE(buf) do { *(LAS u32x4*)(lds + (buf) * 2 * TILEB + lrow * KP + lch * 16) = kreg; *(LAS u32x4*)(lds + (buf) * 2 * TILEB + TILEB + lrow * KP + lch * 16) = vreg; } while (0)
            AT_LOAD(0); AT_WRITE(0);
            __syncthreads();
            for (int ti = 0; ti < ntile; ++ti) {
                if (ti + 1 < ntile) AT_LOAD(ti + 1);
                const LAS unsigned char* kb = lds + (ti & 1) * 2 * TILEB; const LAS unsigned char* vb = kb + TILEB;
                const int jj = jlo + ti - 4; const bool mlo_t = (ti >= 4) && jj == 0, mup_t = (ti >= 4) && jj == 4;
                const float fl = mlo_t ? -INFINITY : 0.f, fu = mup_t ? -INFINITY : 0.f;
                const f32x4 mlow = (f32x4){fl, fl, fl, fl}, mup = (f32x4){fu, fu, fu, fu};
                f32x4 mdiag;
#pragma unroll
                for (int e = 0; e < 4; ++e) mdiag[e] = (mlo_t && fr > 4 * g + e) || (mup_t && fr < 4 * g + e) ? -INFINITY : 0.f;
                bf16x8 Kf[4][2];
#pragma unroll
                for (int mt = 0; mt < 4; ++mt)
#pragma unroll
                    for (int ks = 0; ks < 2; ++ks) Kf[mt][ks] = *(const LAS bf16x8*)(kb + (16 * mt + fr) * KP + (32 * ks + 8 * g) * 2);
                bf16x8 Vf[4][2];
#pragma unroll
                for (int mt = 0; mt < 4; ++mt)
#pragma unroll
                    for (int ks = 0; ks < 2; ++ks)
                        Vf[mt][ks] = tr_frag2(vb, 32 * ks + 4 * g, 16 * mt, lane);
#define AT_QB(qb) do { \
                    bf16x8 Qq[2]; \
                    _Pragma("unroll") for (int ks = 0; ks < 2; ++ks) Qq[ks] = *(const LAS bf16x8*)(qlds + (16 * (qb) + fr) * KP + (32 * ks + 8 * g) * 2); \
                    f32x4 sa[4]; \
                    _Pragma("unroll") for (int mt = 0; mt < 4; ++mt) { sa[mt] = (qb) == mt ? mdiag : ((qb) > mt ? mlow : mup);     \
                        _Pragma("unroll") for (int ks = 0; ks < 2; ++ks) sa[mt] = __builtin_amdgcn_mfma_f32_16x16x32_bf16(Kf[mt][ks], Qq[ks], sa[mt], 0, 0, 0); } \
                    float mx = max3f(sa[0][0], sa[0][1], sa[0][2]), my = max3f(sa[0][3], sa[1][0], sa[1][1]); \
                    mx = max3f(mx, sa[1][2], sa[1][3]); my = max3f(my, sa[2][0], sa[2][1]); mx = max3f(mx, sa[2][2], sa[2][3]); my = max3f(my, sa[3][0], sa[3][1]); mx = max3f(mx, sa[3][2], sa[3][3]); \
                    mx = max3f(mx, my, mrow[qb]); \
                    const float mn = xmax32(xmax16(mx)); \
                    const float alpha = __builtin_amdgcn_exp2f(mrow[qb] - mn); \
                    mrow[qb] = mn; \
                    float rs = 0.f; \
                    _Pragma("unroll") for (int mt = 0; mt < 4; ++mt) _Pragma("unroll") for (int e = 0; e < 4; ++e) { const float pv = __builtin_amdgcn_exp2f(sa[mt][e] - mn); sa[mt][e] = pv; rs += pv; } \
                    rs = xadd32(xadd16(rs)); \
                    lsum[qb] = lsum[qb] * alpha + rs; \
                    bf16x8 Pb[2]; \
                    _Pragma("unroll") for (int ks = 0; ks < 2; ++ks) { const f32x4 a0 = sa[2 * ks], a1 = sa[2 * ks + 1]; \
                        const u32x4 pk = (u32x4){pk2(a0[0], a0[1]), pk2(a0[2], a0[3]), pk2(a1[0], a1[1]), pk2(a1[2], a1[3])}; Pb[ks] = __builtin_bit_cast(bf16x8, pk); } \
                    _Pragma("unroll") for (int nt = 0; nt < 4; ++nt) { OT[qb][nt] = OT[qb][nt] * alpha; \
                        _Pragma("unroll") for (int ks = 0; ks < 2; ++ks) OT[qb][nt] = __builtin_amdgcn_mfma_f32_16x16x32_bf16(Vf[nt][ks], Pb[ks], OT[qb][nt], 0, 0, 0); } } while (0)
                AT_QB(0); AT_QB(1); AT_QB(2); AT_QB(3);
#undef AT_QB
                if (ti + 1 < ntile) AT_WRITE((ti + 1) & 1);
                __syncthreads();
            }
#undef AT_KROW
#undef AT_LOAD
#undef AT_WRITE
#pragma unroll
            for (int qb = 0; qb < 4; ++qb) {
                const float il = 1.f / lsum[qb];
                bf16_t* op = O + (size_t)(qrow0 + 16 * qb + fr) * D + hq * 64 + 4 * g;
#pragma unroll
                for (int nt = 0; nt < 4; ++nt) { const f32x4 v = OT[qb][nt] * il; u32x2 o; o.x = pk2(v[0], v[1]); o.y = pk2(v[2], v[3]); *(u32x2*)(op + 16 * nt) = o; }
            }
        }
    }
}


__device__ __forceinline__ void router_tables(const Ctx& c) {
    LAS float* red = (LAS float*)c.lds;
    for (int item = c.wg; item < 32; item += c.nwg) {
        const int t = item >> 3, j = item & 7, layer = t >> 1, which = t & 1;
        const float* m = c.modp(layer, which); const float* ng = c.a->in[6] + layer * 4 * D; const float* Wr = c.a->in[15] + (size_t)layer * D * NE; const float* br = c.a->in[16] + layer * NE;
        unsigned char* tab = c.ws + WS_MOD + RT_OFF + (size_t)t * RT_BYTES;
        bf16_t* img = (bf16_t*)tab;
        { const int k = 128 * j + (c.tid >> 2), e0 = (c.tid & 3) * 8; const float sc = ng[2 * D + k] * (1.f + m[4096 + k]);
#pragma unroll
          for (int q = 0; q < 8; ++q) { const float w = Wr[(size_t)k * NE + e0 + q] * sc; const unsigned hi = f2bf(w); const float lo = w - bf2f((bf16_t)hi);
              img[(size_t)(e0 + q) * (RT_PITCH / 2) + k] = (bf16_t)hi; img[(size_t)(32 + e0 + q) * (RT_PITCH / 2) + k] = (bf16_t)f2bf(lo); } }
        if (j == 0) {
            __syncthreads();
            { const int e = c.tid & 31, part = c.tid >> 5; float sacc = 0.f;
#pragma unroll 16
              for (int k = part * 64; k < part * 64 + 64; ++k) sacc += m[3072 + k] * Wr[k * NE + e];
              red[part * 32 + e] = sacc; }
            __syncthreads();
            if (c.tid < 32) { float sacc = br[c.tid];
#pragma unroll
                for (int p = 0; p < 16; ++p) sacc += red[p * 32 + c.tid]; ((float*)(tab + RT_IMG))[c.tid] = sacc; }
            __syncthreads();
        }
        if (j == 1) { float* pv = (float*)(tab + RT_IMG + 256);
            for (int k = c.tid; k < D; k += 512) { pv[k] = m[2048 + k] * ng[D + k]; pv[1024 + k] = ng[2 * D + k] * (1.f + m[4096 + k]); pv[2048 + k] = m[3072 + k]; } }
    }
}

template <int GS>
__device__ __forceinline__ void phase_postmix(const Ctx& c, int layer, bool route) {
    const bf16_t* Y = (const bf16_t*)(c.ws + WS_RAW1); unsigned char* H8 = c.ws + WS_H8;
    bf16_t* Xout = (bf16_t*)(c.ws + (layer == 0 ? WS_X : WS_X1)); const bf16_t* Xprev = (const bf16_t*)(c.ws + WS_X);
    const float* ng = c.a->in[6] + layer * 4 * D; const float* Wr = c.a->in[15] + (size_t)layer * D * NE; const float* br = c.a->in[16] + layer * NE;
    unsigned* cnt = (unsigned*)(c.ws + WS_CTL) + CW_CNT + layer * NE;
    int* tk_e = (int*)(c.ws + WS_TK); float* tk_g = (float*)(c.ws + WS_TK) + R * 4; int* tk_slot = (int*)(c.ws + WS_TK) + 2 * R * 4;
    int* list = (int*)(c.ws + WS_LIST);
    LAS float* biasp = (LAS float*)(c.lds + RT_IMG);
    LAS float* pvA = (LAS float*)(c.lds + RT_IMG + 256); LAS float* pvB = pvA + 1024; LAS float* pvS = pvB + 1024;
    LAS unsigned* lcnt = (LAS unsigned*)(c.lds + RT_BYTES); LAS unsigned* lbase = lcnt + 32; LAS float* rsx = (LAS float*)(lcnt + 64);
    static_assert(RT_BYTES + 256 + 512 <= LDS_BYTES - 64, "post-mixer LDS map");
    const int lane = c.lane, w = __builtin_amdgcn_readfirstlane(c.tid >> 6), fr = lane & 15, g = lane >> 4;
    constexpr int RP = GS / 8, NW2 = GS / 16;
    const int g_lo = layer == 0 ? 0 : C / GS;
    for (int grp = g_lo + c.wg; grp < R / GS; grp += c.nwg) {
        const int which = grp * GS < C ? 1 : 0;
        const float* m = c.modp(layer, which);
        __syncthreads();
        if (c.tid < NE) lcnt[c.tid] = 0u;
        { const u32x4* src = (const u32x4*)(c.ws + WS_MOD + RT_OFF + (size_t)(layer * 2 + which) * RT_BYTES);
#pragma unroll 6
          for (int i = c.tid; i < RT_BYTES / 16; i += 512) *(LAS u32x4*)(c.lds + 16 * i) = src[i]; }
        __syncthreads();
        const int row1 = grp * GS + w * RP;
        f32x4 y0[4], x0[4], y1[4], x1[4], yn0[4], xn0[4], yn1[4], xn1[4];
#define PM_LOAD(RW, YY, XX) do { row_load_bf(Y + (size_t)(layer == 0 ? (RW) : (RW) - C) * D, lane, YY); if (layer == 0) row_load(c.xin0(RW), lane, XX); else row_load_bf(Xprev + (size_t)(RW) * D, lane, XX); } while (0)
#define PM_ROW(RW, YY, XX, II) do { \
            const float rstd_y = rsqrtf(row_ss(YY) * (1.f / D) + EPS); \
            _Pragma("unroll") for (int j = 0; j < 4; ++j) { const int c0 = lane * 4 + 256 * j; \
                XX[j] += *(const LAS f32x4*)(pvA + c0) * (YY[j] * rstd_y); \
                u32x2 xo; xo[0] = pk2(XX[j][0], XX[j][1]); xo[1] = pk2(XX[j][2], XX[j][3]); *(u32x2*)(Xout + (size_t)(RW) * D + c0) = xo; \
                XX[j] = (f32x4){bflo(xo[0]), bfhi(xo[0]), bflo(xo[1]), bfhi(xo[1])}; }     \
            const float rstd_x = rsqrtf(row_ss(XX) * (1.f / D) + EPS); \
            _Pragma("unroll") for (int j = 0; j < 4; ++j) { const int c0 = lane * 4 + 256 * j; \
                const f32x4 hv = XX[j] * rstd_x * *(const LAS f32x4*)(pvB + c0) + *(const LAS f32x4*)(pvS + c0); \
                *(unsigned*)(H8 + (size_t)(RW) * D + c0) = pk4_fp8(hv[0] * F8_SH, hv[1] * F8_SH, hv[2] * F8_SH, hv[3] * F8_SH); } \
            if (lane == 0) rsx[w * RP + (II)] = rstd_x; } while (0)
        PM_LOAD(row1, yn0, xn0); PM_LOAD(row1 + 1, yn1, xn1);
        for (int i = 0; i < RP; i += 2) {
            const int r = row1 + i;
#pragma unroll
            for (int j = 0; j < 4; ++j) { y0[j] = yn0[j]; x0[j] = xn0[j]; y1[j] = yn1[j]; x1[j] = xn1[j]; }
            if (i + 2 < RP) { PM_LOAD(r + 2, yn0, xn0); PM_LOAD(r + 3, yn1, xn1); }
            PM_ROW(r, y0, x0, i);
            PM_ROW(r + 1, y1, x1, i + 1);
        }
#undef PM_LOAD
#undef PM_ROW
        asm volatile("s_waitcnt vmcnt(0)" ::: "memory");
        __syncthreads();
        const int row0 = grp * GS + w * 16; const bool w2 = w < NW2;
        f32x4 la[2]; la[0] = (f32x4){0.f, 0.f, 0.f, 0.f}; la[1] = la[0];
        if (w2) {
            const bf16_t* ap = Xout + (size_t)(row0 + fr) * D + 8 * g;
            const LAS unsigned char* bp = c.lds + fr * RT_PITCH + 16 * g;
#pragma unroll 4
            for (int ks = 0; ks < 32; ++ks) {
                const bf16x8 av = *(const bf16x8*)(ap + 32 * ks);
#pragma unroll
                for (int nt = 0; nt < 2; ++nt) {
                    la[nt] = __builtin_amdgcn_mfma_f32_16x16x32_bf16(av, *(const LAS bf16x8*)(bp + (16 * nt) * RT_PITCH + 64 * ks), la[nt], 0, 0, 0);
                    la[nt] = __builtin_amdgcn_mfma_f32_16x16x32_bf16(av, *(const LAS bf16x8*)(bp + (32 + 16 * nt) * RT_PITCH + 64 * ks), la[nt], 0, 0, 0);
                }
            }
        }
        float tv[4][4]; int te[4][4];
#pragma unroll
        for (int e = 0; e < 4; ++e) {
            const float rs = rsx[(w2 ? w * 16 : 0) + 4 * g + e];
            float v0 = la[0][e] * rs + biasp[fr], v1 = la[1][e] * rs + biasp[16 + fr];
#pragma unroll
            for (int k = 0; k < 4; ++k) {
                float bv; int bi;
                if (v0 >= v1) { bv = v0; bi = fr; } else { bv = v1; bi = 16 + fr; }
#pragma unroll
                for (int o = 8; o > 0; o >>= 1) {
                    const float ov = __shfl_xor(bv, o); const int oi = __shfl_xor(bi, o);
                    if (ov > bv || (ov == bv && oi < bi)) { bv = ov; bi = oi; }
                }
                tv[e][k] = bv; te[e][k] = bi;
                if (bi == fr) v0 = -INFINITY;
                if (bi == 16 + fr) v1 = -INFINITY;
            }
        }
        float v[4]; int ex[4]; unsigned sl[4];
#pragma unroll
        for (int k = 0; k < 4; ++k) { v[k] = tv[0][k]; ex[k] = te[0][k];
#pragma unroll
            for (int e = 1; e < 4; ++e) if (fr == e) { v[k] = tv[e][k]; ex[k] = te[e][k]; } }
        if (fr < 4 && route && w2) {
#pragma unroll
            for (int k = 0; k < 4; ++k) sl[k] = __hip_atomic_fetch_add(lcnt + ex[k], 1u, __ATOMIC_RELAXED, __HIP_MEMORY_SCOPE_WORKGROUP);
        }
        __syncthreads();
        if (c.tid < NE && route) { const unsigned n = lcnt[c.tid]; lbase[c.tid] = n ? atomicAdd(&cnt[c.tid], n) : 0u; }
        __syncthreads();
        if (fr < 4 && route && w2) {
            const int r = row0 + 4 * g + fr;
            const float e1 = __expf(v[1] - v[0]), e2 = __expf(v[2] - v[0]), e3 = __expf(v[3] - v[0]);
            const float inv = 1.f / (1.f + e1 + e2 + e3);
            const float gk[4] = {inv, e1 * inv, e2 * inv, e3 * inv};
#pragma unroll
            for (int k = 0; k < 4; ++k) {
                const unsigned slot = lbase[ex[k]] + sl[k];
                list[(size_t)ex[k] * R + slot] = r;
                tk_e[r * 4 + k] = ex[k]; tk_g[r * 4 + k] = gk[k]; tk_slot[r * 4 + k] = (int)slot;
            }
        }
    }
}

__device__ __forceinline__ void moe_offsets(const Ctx& c, int layer, LAS int* so) {
    const unsigned* cnt = (const unsigned*)(c.ws + WS_CTL) + CW_CNT + layer * NE;
    __syncthreads();
    if (c.tid < 64) {
        const int n = c.tid < NE ? (int)cnt[c.tid] : 0; int pad = (n + PADM - 1) / PADM * PADM, inc = pad;
#pragma unroll
        for (int o = 1; o < 32; o <<= 1) { const int t = __shfl_up(inc, o); if (c.lane >= o) inc += t; }
        if (c.tid < NE) { so[c.tid] = inc - pad; so[64 + c.tid] = n; }
        if (c.tid == NE - 1) so[32] = inc;
    }
    __syncthreads();
}

__device__ __forceinline__ void moe_tables(const Ctx& c, int layer, LAS int* tb) {
    const unsigned* cnt = (const unsigned*)(c.ws + WS_CTL) + CW_CNT + layer * NE;
    __syncthreads();
    if (c.tid < 64) {
        const int n = c.tid < NE ? (int)cnt[c.tid] : 0; int tiles = (n + PADM - 1) / PADM, inc = tiles;
#pragma unroll
        for (int o = 1; o < 32; o <<= 1) { const int t = __shfl_up(inc, o); if (c.lane >= o) inc += t; }
        if (c.tid < NE) { tb[c.tid] = inc - tiles; tb[64 + c.tid] = n; }
        if (c.tid == NE - 1) tb[32] = inc;
    }
    __syncthreads();
}
__device__ __forceinline__ int vcu_of(const Ctx& c) { return (c.nwg % 8 == 0) ? (c.wg % 8) * (c.nwg / 8) + c.wg / 8 : c.wg; }
__device__ __forceinline__ void phase_moe_gu(const Ctx& c, int layer) {
    LAS int* tb = (LAS int*)(c.lds + 131072 + 1024);
    moe_tables(c, layer, tb);
    pg8::Gemm g{c.ws + WS_H8, c.ws + WS_WGU + (size_t)layer * NE * 2048 * 1024, (size_t)2048 * 1024, (const int*)(c.ws + WS_LIST)};
    pg8::MoeOrder S{tb, tb + 64, 8, c.nwg, vcu_of(c), false};
    pg8::EpiSwiglu E{c.ws + WS_HDN, c.a->in[18] + (size_t)layer * NE * 2048};
    pg8::gemm_phase<pg8::EpiSwiglu, pg8::MoeOrder, true, true, true>(c.lds, g, S, E, c.tid);
}
__device__ __forceinline__ void phase_moe_dn(const Ctx& c, int layer) {
    LAS int* tb = (LAS int*)(c.lds + 131072 + 1024);
    moe_tables(c, layer, tb);
    pg8::Gemm g{c.ws + WS_HDN, c.ws + WS_WDN + (size_t)layer * NE * 1024 * 1024, (size_t)1024 * 1024, nullptr};
    pg8::MoeOrder S{tb, tb + 64, 4, c.nwg, vcu_of(c), true};
    pg8::EpiBf16Bias E{c.ws + WS_OUTB, c.a->in[20] + (size_t)layer * NE * 1024, 1024, 1.f / (F8_SHD * F8_SW)};
    pg8::gemm_phase<pg8::EpiBf16Bias, pg8::MoeOrder, true, false, true>(c.lds, g, S, E, c.tid);
}
__device__ __forceinline__ void phase_gemm_f32(const Ctx& c, const bf16_t* A, int M, const bf16_t* Bt, int N, const float* bias, bf16_t* Cout) {
    pg8::Gemm g{A, Bt, 0, nullptr}; pg8::StaticOrder S; S.init(M, N, c.nwg, c.wg);
    pg8::EpiF32 E{Cout, N, bias};
    pg8::gemm_phase<pg8::EpiF32, pg8::StaticOrder, true, false, false>(c.lds, g, S, E, c.tid);
}

__device__ __forceinline__ void phase_gemm_qkv(const Ctx& c) {
    pg8::Gemm g{(const bf16_t*)(c.ws + WS_H), (const bf16_t*)(c.ws + WS_WQKV), 0, nullptr}; pg8::StaticOrder S; S.init(R, QKVD, c.nwg, c.wg);
    pg8::EpiQKV E{(bf16_t*)(c.ws + WS_Q), (bf16_t*)(c.ws + WS_K), (bf16_t*)(c.ws + WS_V), c.a->in[8], (const float*)(c.ws + WS_MOD) + MOD_ROPE};
    pg8::gemm_phase<pg8::EpiQKV, pg8::StaticOrder, true, false, false>(c.lds, g, S, E, c.tid);
}
__device__ __forceinline__ void phase_gemm_inproj(const Ctx& c) {
    pg8::Gemm g{c.ws + WS_H8, c.ws + WS_WIN, 0, nullptr}; pg8::StaticOrder S; S.init(R, HIN, c.nwg, c.wg);
    pg8::EpiInProj E{(bf16_t*)(c.ws + WS_QH), (_Float16*)(c.ws + WS_KF), (_Float16*)(c.ws + WS_KB), (bf16_t*)(c.ws + WS_IV), (bf16_t*)(c.ws + WS_SG), (const float*)(c.ws + WS_MOD) + MOD_LB, 1.f / (F8_SH * F8_SW)};
    pg8::gemm_phase<pg8::EpiInProj, pg8::StaticOrder, true, false, true>(c.lds, g, S, E, c.tid);
}

__device__ __forceinline__ void phase_norm0(const Ctx& c);
constexpr int CONV_A = 20 * 16 + 16 * 16 + 80 * 16 + 16 * 16, CONV_B = 32 * 32 * 16 + 32 * 16 * 16, CONV_CHUNK = 8;
__device__ __forceinline__ TBlk convert_item(const Ctx& c, int it, int part) {
    constexpr int I_QKV = 20 * 16, I_O = 16 * 16, I_IN = 80 * 16, I_HO = 16 * 16, I_GU = 32 * 32 * 16;
    int r = it; TBlk t; t.dst8 = nullptr; t.dst = nullptr;
    if (part == 0) {
        if (r < I_QKV) { const int nb = r % 20, kb = r / 20; t.src = c.a->in[7] + (size_t)kb * 64 * QKVD + nb * 64; t.ldw = QKVD; t.dst = (bf16_t*)(c.ws + WS_WQKV) + (size_t)nb * 64 * 1024 + kb * 64; return t; } r -= I_QKV;
        if (r < I_O) { const int nb = r % 16, kb = r / 16; t.src = c.a->in[10] + (size_t)kb * 64 * D + nb * 64; t.ldw = D; t.dst = (bf16_t*)(c.ws + WS_WO) + (size_t)nb * 64 * 1024 + kb * 64; return t; } r -= I_O;
        if (r < I_IN) { const int nb = r % 80, kb = r / 80; t.src = c.a->in[11] + (size_t)kb * 64 * HIN + nb * 64; t.ldw = HIN; t.dst8 = c.ws + WS_WIN + (size_t)nb * 64 * 1024 + kb * 64; return t; } r -= I_IN;
        if (r < I_HO) { const int nb = r % 16, kb = r / 16; t.src = c.a->in[14] + (size_t)kb * 64 * D + nb * 64; t.ldw = D; t.dst = (bf16_t*)(c.ws + WS_WHO) + (size_t)nb * 64 * 1024 + kb * 64; return t; } r -= I_HO;
    }
    const int moff = (part - 1) * 32;
    if (r < I_GU) { const int mat = moff + r / 512, rr = r % 512, nb = rr % 32, kb = rr / 32; const int n0 = ((nb & 3) >> 1) * 1024 + (nb >> 2) * 128 + (nb & 1) * 64;
        t.src = c.a->in[17] + (size_t)mat * 1024 * 2048 + (size_t)kb * 64 * 2048 + n0; t.ldw = 2048; t.dst8 = c.ws + WS_WGU + ((size_t)mat * 2048 + nb * 64) * 1024 + kb * 64; return t; } r -= I_GU;
    { const int mat = moff + r / 256, rr = r % 256, nb = rr % 16, kb = rr / 16;
        t.src = c.a->in[19] + (size_t)mat * 1024 * 1024 + (size_t)kb * 64 * 1024 + nb * 64; t.ldw = 1024; t.dst8 = c.ws + WS_WDN + ((size_t)mat * 1024 + nb * 64) * 1024 + kb * 64; }
    return t;
}
__device__ __forceinline__ void convert_run(const Ctx& c, int part, int first, int step, int end, LAS float* scr) {
    f32x4 va[16], vb[16];
    int it = first;
    TBlk ta, tbk;
    if (it < end) { ta = convert_item(c, it, part); tb_load(ta, c.lane, va); }
    for (; it < end; it += 2 * step) {
        const bool hb = it + step < end;
        if (hb) { tbk = convert_item(c, it + step, part); tb_load(tbk, c.lane, vb); }
        tb_store(ta, c.lane, va, scr);
        const bool ha = it + 2 * step < end;
        if (ha) { ta = convert_item(c, it + 2 * step, part); tb_load(ta, c.lane, va); }
        if (hb) tb_store(tbk, c.lane, vb, scr);
    }
}
__device__ __forceinline__ void convert_steal(const Ctx& c, int part) {
    LAS float* scr = (LAS float*)c.lds + c.wave * (64 * 65);
    LAS int* chp = (LAS int*)(c.lds + 8 * 64 * 65 * 4);
    unsigned* ctr = (unsigned*)(c.ws + WS_CTL) + CW_CONV + 64 * part;
    for (;;) {
        __syncthreads();
        if (c.tid == 0) *chp = (int)atomicAdd(ctr, 1u);
        __syncthreads();
        const int ch = *chp;
        if (ch >= CONV_B / CONV_CHUNK) break;
        convert_run(c, part, ch * CONV_CHUNK + c.wave, 8, (ch + 1) * CONV_CHUNK, scr);
    }
}
__device__ __forceinline__ void convert_steal_n(const Ctx& c, int part, int nmax) {
    LAS float* scr = (LAS float*)c.lds + c.wave * (64 * 65);
    LAS int* chp = (LAS int*)(c.lds + 8 * 64 * 65 * 4);
    unsigned* ctr = (unsigned*)(c.ws + WS_CTL) + CW_CONV + 64 * part;
    for (int n = 0; n < nmax; ++n) {
        __syncthreads();
        if (c.tid == 0) *chp = (int)atomicAdd(ctr, 1u);
        __syncthreads();
        const int ch = *chp;
        if (ch >= CONV_B / CONV_CHUNK) break;
        convert_run(c, part, ch * CONV_CHUNK + c.wave, 8, (ch + 1) * CONV_CHUNK, scr);
    }
    __syncthreads();
}
__device__ __forceinline__ void phase_convert(const Ctx& c) {
    LAS float* scr = (LAS float*)c.lds + c.wave * (64 * 65);
    convert_run(c, 0, c.wg * 8 + c.wave, c.nwg * 8, CONV_A, scr);
    __syncthreads();
    router_tables(c);
    __syncthreads();
    phase_norm0(c);
}

__device__ __forceinline__ void phase_combine(const Ctx& c, int layer) {
    LAS int* so = (LAS int*)(c.lds + 32768);
    moe_offsets(c, layer, so);
    const unsigned char* outb = c.ws + WS_OUTB; bf16_t* X = (bf16_t*)(c.ws + WS_X);
    const bf16_t* Xin = layer == 0 ? X : (const bf16_t*)(c.ws + WS_X1);
    const float* ngl = c.a->in[6] + layer * 4 * D;
    const int* tk_e = (const int*)(c.ws + WS_TK); const float* tk_g = (const float*)(c.ws + WS_TK) + R * 4; const int* tk_slot = (const int*)(c.ws + WS_TK) + 2 * R * 4;
    const int r_lo = layer == 0 ? 0 : C, stride = c.nwg * 8;
    int r = r_lo + c.wg * 8 + c.wave;
    struct TK { int e[4], s[4]; float g[4]; };
    struct DT { unsigned w[4][4]; f32x4 x[4]; float g[4]; };
    TK ta, tb; DT da, db, na, nb;
#define CB_TK(T, row) do { _Pragma("unroll") for (int k = 0; k < 4; ++k) { T.e[k] = tk_e[(row) * 4 + k]; T.s[k] = tk_slot[(row) * 4 + k]; T.g[k] = tk_g[(row) * 4 + k]; } } while (0)
#define CB_DATA(DD, T, row) do { _Pragma("unroll") for (int k = 0; k < 4; ++k) { const unsigned char* src_ = outb + (size_t)(so[T.e[k]] + T.s[k]) * 1024; DD.g[k] = T.g[k] * (1.f / F8_SO); \
        _Pragma("unroll") for (int j = 0; j < 4; ++j) DD.w[k][j] = *(const unsigned*)(src_ + c.lane * 4 + 256 * j); } row_load_bf(Xin + (size_t)(row) * D, c.lane, DD.x); } while (0)
#define CB_ROW(DD, rr) do { const int r_ = (rr); \
        const float* m = c.modp(layer, r_ < C ? 1 : 0); \
        f32x4 y[4], x[4]; \
        _Pragma("unroll") for (int j = 0; j < 4; ++j) { y[j] = (f32x4){0.f, 0.f, 0.f, 0.f}; x[j] = DD.x[j]; } \
        _Pragma("unroll") for (int k = 0; k < 4; ++k) _Pragma("unroll") for (int j = 0; j < 4; ++j) { \
            const f32x2 lo = __builtin_amdgcn_cvt_pk_f32_fp8((int)DD.w[k][j], false), hi = __builtin_amdgcn_cvt_pk_f32_fp8((int)DD.w[k][j], true); y[j] += (f32x4){lo[0], lo[1], hi[0], hi[1]} * DD.g[k]; } \
        const float rstd_y = rsqrtf(row_ss(y) * (1.f / D) + EPS); \
        _Pragma("unroll") for (int j = 0; j < 4; ++j) { const int c0 = c.lane * 4 + 256 * j; \
            const f32x4 g2 = *(const f32x4*)(m + 5120 + c0), n3 = *(const f32x4*)(ngl + 3 * D + c0); \
            x[j] += g2 * (y[j] * rstd_y * n3); \
            if (layer == 0) { u32x2 xo; xo[0] = pk2(x[j][0], x[j][1]); xo[1] = pk2(x[j][2], x[j][3]); *(u32x2*)(X + (size_t)r_ * D + c0) = xo; x[j] = (f32x4){bflo(xo[0]), bfhi(xo[0]), bflo(xo[1]), bfhi(xo[1])}; } \
            else *(f32x4*)(c.a->out + (size_t)(r_ - C) * D + c0) = x[j]; } \
        if (layer == 0) { \
            const float rstd_x = rsqrtf(row_ss(x) * (1.f / D) + EPS); \
            const float* m1 = c.modp(1, r_ < C ? 1 : 0); const float* g0 = c.a->in[6] + 4 * D; \
            _Pragma("unroll") for (int j = 0; j < 4; ++j) { const int c0 = c.lane * 4 + 256 * j; \
                const f32x4 gv = *(const f32x4*)(g0 + c0), shv = *(const f32x4*)(m1 + c0), scv = *(const f32x4*)(m1 + 1024 + c0); \
                const f32x4 hv = x[j] * rstd_x * gv * (scv + 1.f) + shv; \
                *(unsigned*)(c.ws + WS_H8 + (size_t)r_ * D + c0) = pk4_fp8(hv[0] * F8_SH, hv[1] * F8_SH, hv[2] * F8_SH, hv[3] * F8_SH); } } } while (0)
    if (r < R) { CB_TK(ta, r); CB_DATA(da, ta, r); }
    if (r + stride < R) { CB_TK(tb, r + stride); CB_DATA(db, tb, r + stride); }
    if (r + 2 * stride < R) CB_TK(ta, r + 2 * stride);
    if (r + 3 * stride < R) CB_TK(tb, r + 3 * stride);
    for (; r < R; r += 2 * stride) {
        const bool h1 = r + stride < R, h2 = r + 2 * stride < R, h3 = r + 3 * stride < R;
        if (h2) CB_DATA(na, ta, r + 2 * stride);
        if (h3) CB_DATA(nb, tb, r + 3 * stride);
        if (r + 4 * stride < R) CB_TK(ta, r + 4 * stride);
        if (r + 5 * stride < R) CB_TK(tb, r + 5 * stride);
        CB_ROW(da, r);
        if (h1) CB_ROW(db, r + stride);
        da = na; db = nb;
    }
#undef CB_ROW
#undef CB_TK
#undef CB_DATA
}

namespace hg {
typedef _Float16 h2_t __attribute__((ext_vector_type(2)));
constexpr int TB = 272, PB = 144;
constexpr int TILE = 64 * TB;
constexpr int T_QD = 0, T_QC = TILE, T_KD = 2 * TILE, T_KE = 3 * TILE, T_KC = 4 * TILE, T_V0 = 5 * TILE, T_V1 = 6 * TILE;
constexpr int T_QL1 = 7 * TILE, T_KL1 = T_QL1 + 16 * TB, T_P = T_KL1 + 16 * TB, T_TOT = T_P + 64 * PB, T_CT = T_TOT + 4096, T_END = T_CT + 512;
static_assert(T_END <= LDS_BYTES - 64, "hgrn scan LDS map");
__device__ __forceinline__ int row_of(int dir, int p) { return p < C ? (dir ? C - 1 - p : p) : (dir ? C + (L - 1 - (p - C)) : p); }
__device__ __forceinline__ int seg_of(int ch) { return ch < 68 ? ch / 17 : 4 + (ch - 68) / 16; }
__device__ __forceinline__ bf16x8 tr_frag(const LAS unsigned char* tile, int row0, int col0, int lane) {
    const int q = (lane & 15) >> 2, p = lane & 3;
    const LAS unsigned char* a = tile + (row0 + q) * TB + (col0 + 4 * p) * 2;
    const v4i16_t lo = __builtin_amdgcn_ds_read_tr16_b64_v4i16((LAS v4i16_t*)a);
    const v4i16_t hi = __builtin_amdgcn_ds_read_tr16_b64_v4i16((LAS v4i16_t*)(a + 4 * TB));
    return (bf16x8){lo[0], lo[1], lo[2], lo[3], hi[0], hi[1], hi[2], hi[3]};
}
}

__device__ __forceinline__ void phase_hgrn_scan(const Ctx& c) {
    using namespace hg;
#define HG_BAR() asm volatile("s_waitcnt lgkmcnt(0)\n\ts_barrier" ::: "memory")
    const bf16_t* QH = (const bf16_t*)(c.ws + WS_QH); const bf16_t* IV = (const bf16_t*)(c.ws + WS_IV);
    LAS unsigned char* lds = c.lds;
    const int tid = c.tid, lane = c.lane, w = __builtin_amdgcn_readfirstlane(tid >> 6), fr = lane & 15, g = lane >> 4;
    for (int item_ = c.wg; item_ < 256 * SCAN_REP; item_ += c.nwg) {
        const int item = item_ & 255;
        const int chain = item >> 4, seg = item & 15, head = chain >> 1, dir = chain & 1, hc = head * 128;
        const int c0 = seg < 4 ? 17 * seg : 68 + 16 * (seg - 4), nch = seg < 4 ? 17 : 16;
        const _Float16* KX = (const _Float16*)(c.ws + (dir ? WS_KB : WS_KF));
        bf16_t* OL = (bf16_t*)(c.ws + (dir ? WS_OB : WS_OF)); bf16_t* QS = (bf16_t*)(c.ws + (dir ? WS_QSB : WS_QSF));
        HG_BAR();
        for (int i = tid; i < 64 * PB / 4; i += 512) ((LAS unsigned*)(lds + T_P))[i] = 0u;
        f32x4 Sacc[8];
#pragma unroll
        for (int m = 0; m < 8; ++m) Sacc[m] = (f32x4){0.f, 0.f, 0.f, 0.f};
        float dseg0 = 1.f, dseg1 = 1.f;
        unsigned kraw[8], qraw[8]; u32x4 vraw[2];
#define HG_LOAD(cidx) do { const int p0_ = 64 * (cidx); const bool lat_ = (cidx) >= 4; \
        _Pragma("unroll") for (int i = 0; i < 8; ++i) { const int r_ = row_of(dir, p0_ + 8 * w + i); \
            kraw[i] = *(const unsigned*)(KX + (size_t)r_ * D + hc + 2 * lane); \
            qraw[i] = lat_ ? *(const unsigned*)(QH + (size_t)(r_ - C) * D + hc + 2 * lane) : 0u; } \
        _Pragma("unroll") for (int i = 0; i < 2; ++i) { const int idx_ = tid + 512 * i; const int r_ = row_of(dir, p0_ + (idx_ >> 4)); \
            vraw[i] = *(const u32x4*)(IV + (size_t)r_ * D + hc + (idx_ & 15) * 8); } } while (0)
        HG_LOAD(c0);
        for (int ci = 0; ci < nch; ++ci) {
            const int cidx = c0 + ci; const bool lat = cidx >= 4;
            const int vbuf = (ci & 1) ? T_V1 : T_V0;
            float kf[8][2], qf[8][2], cp[8][2];
            {
                float p0 = 1.f, p1 = 1.f;
#pragma unroll
                for (int i = 0; i < 8; ++i) {
                    const h2_t hv = __builtin_bit_cast(h2_t, kraw[i]);
                    kf[i][0] = (float)hv[0]; kf[i][1] = (float)hv[1];
                    qf[i][0] = bflo(qraw[i]); qf[i][1] = bfhi(qraw[i]);
                    p0 *= (1.f - kf[i][0]); p1 *= (1.f - kf[i][1]); cp[i][0] = p0; cp[i][1] = p1;
                }
                *(LAS f32x2*)(lds + T_TOT + (w * 128 + 2 * lane) * 4) = (f32x2){p0, p1};
#pragma unroll
                for (int i = 0; i < 2; ++i) { const int idx = tid + 512 * i; *(LAS u32x4*)(lds + vbuf + (idx >> 4) * TB + (idx & 15) * 16) = vraw[i]; }
            }
            HG_BAR();
            {
                f32x2 T[8];
#pragma unroll
                for (int x = 0; x < 8; ++x) T[x] = *(const LAS f32x2*)(lds + T_TOT + (x * 128 + 2 * lane) * 4);
                const int I = w >> 1, hh = w & 1;
                f32x2 bd[4];
#pragma unroll
                for (int x = 0; x < 4; ++x) bd[x] = T[2 * x] * T[2 * x + 1];
                f32x2 pre = (f32x2){1.f, 1.f}, cum = (f32x2){1.f, 1.f}, suf = (f32x2){1.f, 1.f}, bdI = (f32x2){1.f, 1.f};
#pragma unroll
                for (int x = 0; x < 8; ++x) if (hh && x == w - 1) pre = T[x];
#pragma unroll
                for (int x = 0; x < 4; ++x) { if (x < I) cum = cum * bd[x]; if (x > I) suf = suf * bd[x]; if (x == I) bdI = bd[x]; }
                const f32x2 ctot = (bd[0] * bd[1]) * (bd[2] * bd[3]);
#pragma unroll
                for (int i = 0; i < 8; ++i) {
                    const int tau = 8 * w + i;
                    float QDv[2], KDv[2], KEv[2], QCv[2], KCv[2];
#pragma unroll
                    for (int x = 0; x < 2; ++x) {
                        const float eq = pre[x] * cp[i][x], rc = __builtin_amdgcn_rcpf(eq);
                        QDv[x] = qf[i][x] * eq; KDv[x] = kf[i][x] * rc; KEv[x] = KDv[x] * bdI[x]; QCv[x] = QDv[x] * cum[x]; KCv[x] = KEv[x] * suf[x];
                    }
                    const int to = tau * TB + lane * 4;
                    *(LAS unsigned*)(lds + T_QD + to) = pk2(QDv[0], QDv[1]);
                    *(LAS unsigned*)(lds + T_KD + to) = pk2(KDv[0], KDv[1]);
                    *(LAS unsigned*)(lds + T_KE + to) = pk2(KEv[0], KEv[1]);
                    *(LAS unsigned*)(lds + T_QC + to) = pk2(QCv[0], QCv[1]);
                    *(LAS unsigned*)(lds + T_KC + to) = pk2(KCv[0], KCv[1]);
                    if (I == 3) *(LAS unsigned*)(lds + T_QL1 + (tau - 48) * TB + lane * 4) = pk2(QDv[0] * bd[2][0], QDv[1] * bd[2][1]);
                    if (I == 0) *(LAS unsigned*)(lds + T_KL1 + tau * TB + lane * 4) = pk2(KEv[0] * bd[1][0], KEv[1] * bd[1][1]);
                    if (lat) { const int r = row_of(dir, 64 * cidx + tau); *(unsigned*)(QS + (size_t)(r - C) * D + hc + 2 * lane) = pk2(QCv[0] * dseg0, QCv[1] * dseg1); }
                }
                dseg0 *= ctot[0]; dseg1 *= ctot[1];
                if (w == 0) *(LAS f32x2*)(lds + T_CT + lane * 8) = ctot;
            }
            HG_BAR();
            if (ci + 1 < nch) HG_LOAD(cidx + 1);
            if (lat) {
                const int nblk = w >= 6 ? 2 : 1;
                for (int b = 0; b < nblk; ++b) {
                    int I, J, qoff, qrow, koff, krow; bool diag = false;
                    if (w < 4) { I = 2 + (w >> 1); J = w & 1; qoff = (w >> 1) ? T_QL1 : T_QD; qrow = (w >> 1) ? 0 : 32; koff = (w & 1) ? T_KE : T_KL1; krow = (w & 1) ? 16 : 0; }
                    else if (w == 4) { I = 1; J = 0; qoff = T_QD; qrow = 16; koff = T_KE; krow = 0; }
                    else if (w == 5) { I = 3; J = 2; qoff = T_QD; qrow = 48; koff = T_KE; krow = 32; }
                    else { I = 2 * (w - 6) + b; J = I; qoff = T_QD; qrow = 16 * I; koff = T_KD; krow = 16 * I; diag = true; }
                    f32x4 pa = (f32x4){0.f, 0.f, 0.f, 0.f};
#pragma unroll
                    for (int ks = 0; ks < 4; ++ks) {
                        const bf16x8 av = *(const LAS bf16x8*)(lds + qoff + (qrow + fr) * TB + (32 * ks + 8 * g) * 2);
                        const bf16x8 bv = *(const LAS bf16x8*)(lds + koff + (krow + fr) * TB + (32 * ks + 8 * g) * 2);
                        pa = __builtin_amdgcn_mfma_f32_16x16x32_bf16(av, bv, pa, 0, 0, 0);
                    }
#pragma unroll
                    for (int e = 0; e < 4; ++e) {
                        const int tl = 4 * g + e; const float val = (diag && fr > tl) ? 0.f : pa[e];
                        *(LAS bf16_t*)(lds + T_P + (16 * I + tl) * PB + (16 * J + fr) * 2) = (bf16_t)f2bf(val);
                    }
                }
            }
            f32x4 oacc[4];
#pragma unroll
            for (int m = 0; m < 4; ++m) oacc[m] = (f32x4){0.f, 0.f, 0.f, 0.f};
            if (lat) {
                bf16x8 Sb[4];
#pragma unroll
                for (int ks = 0; ks < 4; ++ks) {
                    const f32x4 a0 = Sacc[2 * ks], a1 = Sacc[2 * ks + 1];
                    const u32x4 pk = (u32x4){pk2(a0[0], a0[1]), pk2(a0[2], a0[3]), pk2(a1[0], a1[1]), pk2(a1[2], a1[3])};
                    Sb[ks] = __builtin_bit_cast(bf16x8, pk);
                }
#pragma unroll
                for (int m = 0; m < 4; ++m)
#pragma unroll
                    for (int ks = 0; ks < 4; ++ks) {
                        const u32x2 lo = *(const LAS u32x2*)(lds + T_QC + (16 * m + fr) * TB + (32 * ks + 4 * g) * 2);
                        const u32x2 hi = *(const LAS u32x2*)(lds + T_QC + (16 * m + fr) * TB + (32 * ks + 16 + 4 * g) * 2);
                        const u32x4 pk = (u32x4){lo.x, lo.y, hi.x, hi.y};
                        oacc[m] = __builtin_amdgcn_mfma_f32_16x16x32_bf16(Sb[ks], __builtin_bit_cast(bf16x8, pk), oacc[m], 0, 0, 0);
                    }
            }
#pragma unroll
            for (int m = 0; m < 8; ++m) { const f32x4 ct = *(const LAS f32x4*)(lds + T_CT + (16 * m + 4 * g) * 4); Sacc[m] = Sacc[m] * ct; }
            bf16x8 Vf[2];
#pragma unroll
            for (int ks = 0; ks < 2; ++ks) Vf[ks] = tr_frag(lds + vbuf, 32 * ks + 8 * g, 16 * w, lane);
#pragma unroll
            for (int m = 0; m < 8; ++m)
#pragma unroll
                for (int ks = 0; ks < 2; ++ks) Sacc[m] = __builtin_amdgcn_mfma_f32_16x16x32_bf16(tr_frag(lds + T_KC, 32 * ks + 8 * g, 16 * m, lane), Vf[ks], Sacc[m], 0, 0, 0);
            HG_BAR();
            if (lat) {
#pragma unroll
                for (int m = 0; m < 4; ++m)
#pragma unroll
                    for (int ks = 0; ks < 2; ++ks) {
                        if (m < 2 && ks == 1) continue;
                        const bf16x8 av = *(const LAS bf16x8*)(lds + T_P + (16 * m + fr) * PB + (32 * ks + 8 * g) * 2);
                        oacc[m] = __builtin_amdgcn_mfma_f32_16x16x32_bf16(Vf[ks], av, oacc[m], 0, 0, 0);
                    }
#pragma unroll
                for (int m = 0; m < 4; ++m) { const int r = row_of(dir, 64 * cidx + 16 * m + fr); u32x2 o; o.x = pk2(oacc[m][0], oacc[m][1]); o.y = pk2(oacc[m][2], oacc[m][3]);
                    *(u32x2*)(OL + (size_t)(r - C) * D + hc + 16 * w + 4 * g) = o; }
            }
        }
#undef HG_LOAD
        float* DS = (float*)(c.ws + WS_DS) + (size_t)item * 16384; float* DG = (float*)(c.ws + WS_DG) + item * 128;
#pragma unroll
        for (int m = 0; m < 8; ++m)
#pragma unroll
            for (int e = 0; e < 4; ++e) DS[(16 * m + 4 * g + e) * 128 + 16 * w + fr] = Sacc[m][e];
        if (w == 0) { DG[2 * lane] = dseg0; DG[2 * lane + 1] = dseg1; }
    }
}

#undef HG_BAR
__device__ __forceinline__ void phase_hgrn_fold(const Ctx& c) {
    const float* DS = (const float*)(c.ws + WS_DS); const float* DG = (const float*)(c.ws + WS_DG); bf16_t* SST = (bf16_t*)(c.ws + WS_SST);
    for (int item = c.wg; item < 256; item += c.nwg) {
        const int chain = item >> 4, slice = item & 15, d = 8 * slice + (c.tid >> 6), v2 = (c.tid & 63) * 2;
        float s0 = 0.f, s1 = 0.f;
        float dv[15]; f32x2 ds[15];
#pragma unroll
        for (int sgi = 0; sgi < 15; ++sgi) { dv[sgi] = DG[(chain * 16 + sgi) * 128 + d]; ds[sgi] = *(const f32x2*)(DS + ((size_t)(chain * 16 + sgi) * 128 + d) * 128 + v2); }
        SST[((size_t)(chain * 16) * 128 + v2) * 128 + d] = 0; SST[((size_t)(chain * 16) * 128 + v2 + 1) * 128 + d] = 0;
#pragma unroll
        for (int sgi = 0; sgi < 15; ++sgi) {
            s0 = dv[sgi] * s0 + ds[sgi][0]; s1 = dv[sgi] * s1 + ds[sgi][1];
            SST[((size_t)(chain * 16 + sgi + 1) * 128 + v2) * 128 + d] = (bf16_t)f2bf(s0); SST[((size_t)(chain * 16 + sgi + 1) * 128 + v2 + 1) * 128 + d] = (bf16_t)f2bf(s1);
        }
    }
}

__device__ __forceinline__ void phase_hgrn_readout(const Ctx& c) {
    constexpr int SP = 272, SBUF = 128 * SP, IBUF = 2 * SBUF;
    static_assert(2 * IBUF + 1024 <= LDS_BYTES - 64, "readout LDS map");
    const bf16_t* OF = (const bf16_t*)(c.ws + WS_OF); const bf16_t* OB = (const bf16_t*)(c.ws + WS_OB); const bf16_t* SGp = (const bf16_t*)(c.ws + WS_SG);
    const bf16_t* SST = (const bf16_t*)(c.ws + WS_SST); bf16_t* RR = (bf16_t*)(c.ws + WS_RR); const float* hng = c.a->in[13];
    LAS unsigned char* lds = c.lds; LAS float* ssx = (LAS float*)(c.lds + 2 * IBUF);
    const int tid = c.tid, lane = c.lane, w = __builtin_amdgcn_readfirstlane(tid >> 6), fr = lane & 15, g = lane >> 4, mt = w & 3, nh = w >> 2;
#define RO_BAR() asm volatile("s_waitcnt lgkmcnt(0)\n\ts_barrier" ::: "memory")
    u32x4 sreg[8];
#define RO_H(q) ((c.nwg == 256) ? ((q) & 255) >> 5 : (q) >> 8)
#define RO_CH(q) ((c.nwg == 256) ? (((q) & 31) << 3) + ((q) >> 8) : (q) & 255)
#define RO_SST_LOAD(it) do { const int h_ = RO_H(it), ch_ = RO_CH(it); \
        _Pragma("unroll") for (int j = 0; j < 8; ++j) { const int idx_ = tid + 512 * j, dx_ = idx_ >> 11, rem_ = idx_ & 2047; \
            const int sg_ = hg::seg_of(dx_ ? 4 + 255 - ch_ : 4 + ch_); \
            sreg[j] = *(const u32x4*)(SST + ((size_t)((h_ * 2 + dx_) * 16 + sg_) * 128 + (rem_ >> 4)) * 128 + (rem_ & 15) * 8); } } while (0)
#define RO_SST_WRITE(buf) do { _Pragma("unroll") for (int j = 0; j < 8; ++j) { const int idx_ = tid + 512 * j, dx_ = idx_ >> 11, rem_ = idx_ & 2047; \
            *(LAS u32x4*)(lds + (buf) * IBUF + dx_ * SBUF + (rem_ >> 4) * SP + (rem_ & 15) * 16) = sreg[j]; } } while (0)
    int it = c.wg;
    u32x2 ra[4], rb[4], rg[4]; bf16x8 rq[2][4];
#define RO_IN_LOAD(itx) do { const int h_ = RO_H(itx), t0_ = 64 * RO_CH(itx) + 16 * mt; \
        _Pragma("unroll") for (int n = 0; n < 4; ++n) { const size_t o_ = (size_t)(t0_ + fr) * D + h_ * 128 + 64 * nh + 16 * n + 4 * g; \
            ra[n] = *(const u32x2*)(OF + o_); rb[n] = *(const u32x2*)(OB + o_); rg[n] = *(const u32x2*)(SGp + o_); } \
        _Pragma("unroll") for (int dx = 0; dx < 2; ++dx) { const bf16_t* QS_ = (const bf16_t*)(c.ws + (dx ? WS_QSB : WS_QSF)) + (size_t)(t0_ + fr) * D + h_ * 128 + 8 * g; \
            _Pragma("unroll") for (int ks = 0; ks < 4; ++ks) rq[dx][ks] = *(const bf16x8*)(QS_ + 32 * ks); } } while (0)
    RO_BAR();
    if (it < 2048) { RO_SST_LOAD(it); RO_SST_WRITE(0); RO_IN_LOAD(it); }
    RO_BAR();
    int buf = 0;
    for (int k = 0; it < 2048; it += c.nwg, ++k) {
        const int h = RO_H(it), ch = RO_CH(it), t0 = 64 * ch + 16 * mt;
        const bool has_next = it + c.nwg < 2048;
        const int hn = RO_H(it + c.nwg), chn = RO_CH(it + c.nwg);
        const bool reload = has_next && (hn != h || hg::seg_of(4 + chn) != hg::seg_of(4 + ch) || hg::seg_of(4 + 255 - chn) != hg::seg_of(4 + 255 - ch));
        f32x4 acc[4], sgv[4];
        bf16x8 aq[2][4];
#pragma unroll
        for (int n = 0; n < 4; ++n) {
            const f32x4 gn = *(const f32x4*)(hng + h * 128 + 64 * nh + 16 * n + 4 * g);
            acc[n] = (f32x4){bflo(ra[n].x) + bflo(rb[n].x), bfhi(ra[n].x) + bfhi(rb[n].x), bflo(ra[n].y) + bflo(rb[n].y), bfhi(ra[n].y) + bfhi(rb[n].y)};
            sgv[n] = (f32x4){bflo(rg[n].x), bfhi(rg[n].x), bflo(rg[n].y), bfhi(rg[n].y)} * gn;
        }
#pragma unroll
        for (int dx = 0; dx < 2; ++dx)
#pragma unroll
            for (int ks = 0; ks < 4; ++ks) aq[dx][ks] = rq[dx][ks];
        if (reload) RO_SST_LOAD(it + c.nwg);
        if (has_next) RO_IN_LOAD(it + c.nwg);
#pragma unroll
        for (int dx = 0; dx < 2; ++dx) {
            const LAS unsigned char* sb = lds + buf * IBUF + dx * SBUF + (64 * nh + fr) * SP + 16 * g;
#pragma unroll
            for (int ks = 0; ks < 4; ++ks) {
#pragma unroll
                for (int n = 0; n < 4; ++n) acc[n] = __builtin_amdgcn_mfma_f32_16x16x32_bf16(*(const LAS bf16x8*)(sb + (16 * n) * SP + 64 * ks), aq[dx][ks], acc[n], 0, 0, 0);
            }
        }
        float ss = 0.f;
#pragma unroll
        for (int n = 0; n < 4; ++n) ss += acc[n][0] * acc[n][0] + acc[n][1] * acc[n][1] + acc[n][2] * acc[n][2] + acc[n][3] * acc[n][3];
        ss = xadd32(xadd16(ss));
        if (g == 0) ssx[((k & 1) * 8 + w) * 16 + fr] = ss;
        if (reload) RO_SST_WRITE(buf ^ 1);
        RO_BAR();
        const float rstd = rsqrtf((ss + ssx[((k & 1) * 8 + (w ^ 4)) * 16 + fr]) * (1.f / 128.f) + EPS);
#pragma unroll
        for (int n = 0; n < 4; ++n) {
            const f32x4 v = acc[n] * rstd * sgv[n]; u32x2 o; o.x = pk2(v[0], v[1]); o.y = pk2(v[2], v[3]);
            *(u32x2*)(RR + (size_t)(t0 + fr) * D + h * 128 + 64 * nh + 16 * n + 4 * g) = o;
        }
        if (reload) buf ^= 1;
    }
    RO_BAR();
#undef RO_BAR
#undef RO_SST_LOAD
#undef RO_SST_WRITE
#undef RO_H
#undef RO_CH
#undef RO_IN_LOAD
}

#define XB_TMO      128
#define XB_XCNT(j)  (256  + 64 * (j))
#define XB_XSUB(j)  (1280 + 64 * (j))
#define XB_XGEN(j)  (2304 + 64 * (j))
#define XB_TOP      3328
#define XB_TOPGEN   3392
#define XCD_BAR_WORDS 3456
#define XB_SPIN_CAP (1u << 18)
__device__ __forceinline__ unsigned xb_ld(unsigned* p)              { return __hip_atomic_load(p, __ATOMIC_RELAXED, __HIP_MEMORY_SCOPE_AGENT); }
__device__ __forceinline__ unsigned xb_add(unsigned* p, unsigned v) { return __hip_atomic_fetch_add(p, v, __ATOMIC_RELAXED, __HIP_MEMORY_SCOPE_AGENT); }
__device__ __forceinline__ unsigned xb_xcc_id() { return (unsigned)__builtin_amdgcn_s_getreg((3 << 11) | 20) & 0xFu; }
#define XB_SPIN(cond, bar) do { unsigned _sp = 0; while (cond) { __builtin_amdgcn_s_sleep(1); \
    if ((++_sp & 255u) == 0u) { if (xb_ld(&(bar)[XB_TMO])) break; if (_sp > XB_SPIN_CAP) { atomicAdd(&(bar)[XB_TMO], 1u); break; } } } } while (0)
struct XcdBarrier { unsigned* bar; unsigned x; volatile LAS unsigned* st; };
__device__ __forceinline__ XcdBarrier xcd_barrier_post(unsigned* bar, volatile LAS unsigned* st) {
    XcdBarrier b; b.bar = bar; b.x = xb_xcc_id(); b.st = st;
    if (threadIdx.x == 0) (void)xb_add(&bar[XB_XCNT(b.x)], 1u);
    return b;
}
__device__ __forceinline__ void xcd_barrier_complete(unsigned* bar, unsigned x, unsigned& nloc, unsigned& nx) {
    const unsigned G = gridDim.x * gridDim.y * gridDim.z;
    unsigned sum, cnt, mine, sp = 0u;
    for (;;) {
        sum = 0u; cnt = 0u; mine = 0u;
#pragma unroll
        for (unsigned j = 0; j < 16; ++j) { const unsigned c = xb_ld(&bar[XB_XCNT(j)]); sum += c; cnt += (c > 0u) ? 1u : 0u; mine = (j == x) ? c : mine; }
        if (sum == G) break;
        __builtin_amdgcn_s_sleep(1);
        if ((++sp & 255u) == 0u) { if (xb_ld(&bar[XB_TMO])) break; if (sp > XB_SPIN_CAP) { atomicAdd(&bar[XB_TMO], 1u); break; } }
    }
    nloc = mine > 0u ? mine : 1u; nx = cnt > 0u ? cnt : 1u;
}
__device__ __forceinline__ void xcd_barrier(const XcdBarrier& b) {
    asm volatile("s_waitcnt vmcnt(0)" ::: "memory");
    __syncthreads();
    if (threadIdx.x == 0) {
        unsigned* bar = b.bar;
        __builtin_amdgcn_s_waitcnt(0);
        unsigned nloc = b.st[0], nx = b.st[1];
        if (nloc == 0u) { xcd_barrier_complete(bar, b.x, nloc, nx); b.st[0] = nloc; b.st[1] = nx; }
        const unsigned old = xb_add(&bar[XB_XSUB(b.x)], 1u);
        const unsigned gen = old / nloc;
        if (old + 1u == (gen + 1u) * nloc) {
            __builtin_amdgcn_fence(__ATOMIC_RELEASE, "agent");
            asm volatile("s_waitcnt vmcnt(0)" ::: "memory");
            const unsigned og = xb_add(&bar[XB_TOP], 1u);
            const unsigned tg = og / nx;
            if (og + 1u == (tg + 1u) * nx) xb_add(&bar[XB_TOPGEN], 1u);
            else XB_SPIN(xb_ld(&bar[XB_TOPGEN]) == tg, bar);
            __builtin_amdgcn_fence(__ATOMIC_ACQUIRE, "agent");
            xb_add(&bar[XB_XGEN(b.x)], 1u);
            asm volatile("s_waitcnt vmcnt(0)" ::: "memory");
        } else {
            XB_SPIN(xb_ld(&bar[XB_XGEN(b.x)]) == gen, bar);
            __builtin_amdgcn_fence(__ATOMIC_ACQUIRE, "agent");
            asm volatile("s_waitcnt vmcnt(0)" ::: "memory");
        }
    }
    __syncthreads();
}

__device__ __forceinline__ void launder(Ctx& c) { asm volatile("" : "+s"(c.a)); asm volatile("" : "+s"(c.ws)); asm volatile("" : "+s"(c.wave));
    c.lane = (int)__builtin_amdgcn_mbcnt_hi(~0u, __builtin_amdgcn_mbcnt_lo(~0u, 0u)); c.tid = c.wave * 64 + c.lane; }
__global__ void __launch_bounds__(512, 2) mk_fwd(Args args) {
    extern __shared__ __attribute__((aligned(16))) unsigned char lds_raw[];
    Ctx c; c.a = (CArgs)__builtin_amdgcn_kernarg_segment_ptr(); c.lds = (LAS unsigned char*)lds_raw; c.tid = threadIdx.x; c.lane = c.tid & 63; c.wave = __builtin_amdgcn_readfirstlane(c.tid >> 6); c.nwg = gridDim.x; c.wg = blockIdx.x; c.ws = c.a->ws;
    volatile LAS unsigned* bst = (volatile LAS unsigned*)(c.lds + LDS_BYTES - 64);
    if (c.tid < 4) bst[c.tid] = 0u;
    __syncthreads();
    const XcdBarrier bar = xcd_barrier_post((unsigned*)(c.ws + WS_CTL) + CW_BAR, bst);
    const int lo = c.a->ph_lo, hi = c.a->ph_hi;
    bool route_ok = true;
#define SEAM(k) do { if (lo <= (k) && (k) + 1 < hi) xcd_barrier(bar); } while (0)
#define IN(k) (lo <= (k) && (k) < hi && (launder(c), true))
#define PH(k, call) do { if (IN(k)) { if (PROBE_PH == (k)) { int nrep_ = 3; asm volatile("" : "+s"(nrep_)); for (int rep_ = 0; rep_ < nrep_; ++rep_) { route_ok = (rep_ + 1 == nrep_); call; if (rep_ + 1 < nrep_) xcd_barrier(bar); } } else { call; } } SEAM(k); } while (0)
    PH(0, phase_prep(c));
    PH(1, phase_convert(c));
    PH(2, { phase_gemm_qkv(c); if (c.nwg == 256 && c.wg >= 138) convert_steal_n(c, 1, 3); });
    PH(3, phase_attn(c));
    PH(4, { phase_gemm_f32(c, (const bf16_t*)(c.ws + WS_O), R, (const bf16_t*)(c.ws + WS_WO), D, nullptr, (bf16_t*)(c.ws + WS_RAW1)); if (c.nwg == 256 && c.wg >= 16) convert_steal_n(c, 1, 2); });
    PH(5, { phase_postmix<128>(c, 0, route_ok); convert_steal(c, 1); });
    PH(6, phase_moe_gu(c, 0));
    PH(7, phase_moe_dn(c, 0));
    PH(8, phase_combine(c, 0));
    PH(9, { phase_gemm_inproj(c); if (c.nwg == 256 && c.wg >= 80) convert_steal_n(c, 2, 2); });
    PH(10, phase_hgrn_scan(c));
    PH(11, phase_hgrn_fold(c));
    PH(12, phase_hgrn_readout(c));
    PH(13, phase_gemm_f32(c, (const bf16_t*)(c.ws + WS_RR), L, (const bf16_t*)(c.ws + WS_WHO), D, nullptr, (bf16_t*)(c.ws + WS_RAW1)));
    PH(14, { phase_postmix<128>(c, 1, route_ok); convert_steal(c, 2); });
    PH(15, phase_moe_gu(c, 1));
    PH(16, phase_moe_dn(c, 1));
    PH(17, phase_combine(c, 1));
#undef IN
#undef PH
#undef SEAM
}

extern "C" void kernel_launch(void* const* d_in, const int* in_sizes, int n_in, void* d_out, int out_size, void* d_ws, size_t ws_size, hipStream_t stream) {
    static int grid = 0;
    if (grid == 0) {
        if (n_in != 21 || out_size != L * D || ws_size < WS_END) { fprintf(stderr, "kernel_launch: unexpected problem (n_in %d out %d ws %zu need %zu)\n", n_in, out_size, ws_size, (size_t)WS_END); grid = -1; return; }
        int dev = 0, cus = 0, per_cu = 0;
        hipGetDevice(&dev); hipDeviceGetAttribute(&cus, hipDeviceAttributeMultiprocessorCount, dev);
        if (hipFuncSetAttribute((const void*)mk_fwd, hipFuncAttributeMaxDynamicSharedMemorySize, LDS_BYTES) != hipSuccess) { fprintf(stderr, "kernel_launch: hipFuncSetAttribute failed\n"); grid = -1; return; }
        hipOccupancyMaxActiveBlocksPerMultiprocessor(&per_cu, (const void*)mk_fwd, 512, LDS_BYTES);
        if (per_cu < 1) fprintf(stderr, "kernel_launch: occupancy query says %d\n", per_cu);
        (void)hipGetLastError();
        grid = cus > 0 ? cus : 256;
    }
    if (grid < 0) return;
    hipMemsetAsync((char*)d_ws + WS_CTL, 0, MiB, stream);
    Args a{};
    for (int i = 0; i < 21; ++i) a.in[i] = (const float*)d_in[i];
    a.out = (float*)d_out; a.ws = (unsigned char*)d_ws;
    a.ph_lo = 0; a.ph_hi = NPHASE;
    hipLaunchKernelGGL(mk_fwd, dim3(grid), dim3(512), LDS_BYTES, stream, a);
}
```

```cpp
#include <hip/hip_runtime.h>
#include <cstdint>
#include <cstdio>

#define LAS __attribute__((address_space(3)))
#define GAS __attribute__((address_space(1)))
typedef unsigned short bf16_t;
typedef short bf16x8 __attribute__((ext_vector_type(8)));
typedef float f32x4 __attribute__((ext_vector_type(4)));
typedef unsigned u32x4 __attribute__((ext_vector_type(4)));
typedef unsigned u32x2 __attribute__((ext_vector_type(2)));
typedef short v4i16_t __attribute__((ext_vector_type(4)));
typedef float f32x2 __attribute__((ext_vector_type(2)));

constexpr int D = 1024, L = 16384, C = 256, R = L + C;
constexpr int QKVD = 1280, HIN = 5120, NE = 32, TOPK = 4;
constexpr int PADM = 256, MAXROWS = 74752;
constexpr float EPS = 1e-6f;
constexpr float LOG2E = 1.4426950408889634f;
constexpr int NPHASE = 18;
#ifndef GEMM_REP
#define GEMM_REP 1
#endif
#ifndef PROBE_NOEPI
#define PROBE_NOEPI 0
#endif
#ifndef PROBE_SHORTK
#define PROBE_SHORTK 0
#endif
#ifndef SCAN_REP
#define SCAN_REP 1
#endif
#ifndef PROBE_PH
#define PROBE_PH (-1)
#endif
constexpr int LDS_BYTES = 147456;

constexpr size_t MiB = 1u << 20;
constexpr size_t al(size_t x) { return (x + MiB - 1) / MiB * MiB; }
constexpr size_t WS_CTL = 0;
constexpr size_t WS_MOD = WS_CTL + MiB;
constexpr size_t WS_X = WS_MOD + MiB;
constexpr size_t WS_H = WS_X + al((size_t)R * D * 4);
constexpr size_t WS_Q = WS_H + al((size_t)R * D * 2);
constexpr size_t WS_K = WS_Q + al((size_t)R * D * 2);
constexpr size_t WS_V = WS_K + al((size_t)R * 128 * 2);
constexpr size_t WS_O = WS_V + al((size_t)R * 128 * 2);
constexpr size_t WS_TK = WS_O + al((size_t)R * D * 2);
constexpr size_t WS_LIST = WS_TK + MiB;
constexpr size_t WS_HDN = WS_LIST + 3 * MiB;
constexpr size_t WS_RAW1 = WS_HDN + al((size_t)MAXROWS * 1024 * 2);
constexpr size_t WS_X1 = WS_RAW1 + al((size_t)R * D * 4);
constexpr size_t WS_OUTB = WS_X1 + al((size_t)R * D * 4);
constexpr size_t WS_QH = WS_OUTB + al((size_t)MAXROWS * 1024 * 2);
constexpr size_t WS_KF = WS_QH + al((size_t)L * D * 2);
constexpr size_t WS_KB = WS_KF + al((size_t)R * D * 2);
constexpr size_t WS_IV = WS_KB + al((size_t)R * D * 2);
constexpr size_t WS_SG = WS_IV + al((size_t)R * D * 2);
constexpr size_t WS_OF = WS_SG + al((size_t)L * D * 2);
constexpr size_t WS_OB = WS_OF + al((size_t)L * D * 4);
constexpr size_t WS_RR = WS_OB + al((size_t)L * D * 4);
constexpr size_t WS_WQKV = WS_RR + al((size_t)L * D * 2);
constexpr size_t WS_WO = WS_WQKV + al((size_t)QKVD * D * 2);
constexpr size_t WS_WIN = WS_WO + al((size_t)D * D * 2);
constexpr size_t WS_WHO = WS_WIN + al((size_t)HIN * D * 2);
constexpr size_t WS_WGU = WS_WHO + al((size_t)D * D * 2);
constexpr size_t WS_WDN = WS_WGU + al((size_t)2 * NE * 2048 * D * 2);
constexpr size_t WS_QSF = WS_WDN + al((size_t)2 * NE * 1024 * D * 2);
constexpr size_t WS_QSB = WS_QSF + al((size_t)L * D * 2);
constexpr size_t WS_DS = WS_QSB + al((size_t)L * D * 2);
constexpr size_t WS_DG = WS_DS + al((size_t)256 * 128 * 128 * 4);
constexpr size_t WS_SST = WS_DG + MiB;
constexpr size_t WS_H8 = WS_SST + al((size_t)256 * 128 * 128 * 2);
constexpr size_t WS_END = WS_H8 + al((size_t)R * D);
static_assert(WS_END <= (size_t)2048 * MiB, "workspace map exceeds 4x the largest input");
constexpr int CW_CNT = 1024;
constexpr int CW_CONV = 2048;
constexpr int CW_BAR = 4096;
constexpr int MOD_ROPE = 32768;
constexpr int RT_PITCH = 2064, RT_IMG = 2 * 32 * RT_PITCH, RT_BYTES = RT_IMG + 256 + 3 * 4096, RT_OFF = 262144;
static_assert(RT_OFF + 4 * RT_BYTES <= (int)MiB, "router tables inside the MOD region");
constexpr int MOD_LB = 49152;

struct Args { const float* in[21]; float* out; unsigned char* ws; int ph_lo, ph_hi; };

__device__ __forceinline__ unsigned f2bf(float f) { unsigned u = __float_as_uint(f); return (u + 0x7fffu + ((u >> 16) & 1u)) >> 16; }
typedef float f32x2_t __attribute__((ext_vector_type(2))); typedef __bf16 bf16x2_t __attribute__((ext_vector_type(2)));
__device__ __forceinline__ unsigned pk2(float lo, float hi) { f32x2_t v = {lo, hi}; bf16x2_t b = __builtin_convertvector(v, bf16x2_t); return __builtin_bit_cast(unsigned, b); }
__device__ __forceinline__ unsigned pk4_fp8(float a, float b, float c, float d) {
    a = fminf(fmaxf(a, -448.f), 448.f); b = fminf(fmaxf(b, -448.f), 448.f); c = fminf(fmaxf(c, -448.f), 448.f); d = fminf(fmaxf(d, -448.f), 448.f);
    int v = __builtin_amdgcn_cvt_pk_fp8_f32(a, b, 0, false); v = __builtin_amdgcn_cvt_pk_fp8_f32(c, d, v, true); return (unsigned)v; }
__device__ __forceinline__ unsigned pk4_fp8_nc(float a, float b, float c, float d) {
    int v = __builtin_amdgcn_cvt_pk_fp8_f32(a, b, 0, false); v = __builtin_amdgcn_cvt_pk_fp8_f32(c, d, v, true); return (unsigned)v; }
constexpr bool FP8_OPROJ = true, FP8_HOPROJ = true;
constexpr float GATE_C = 1.702f * 1.4426950408889634f;
constexpr float F8_SH = 8.f, F8_SW = 64.f, F8_SHD = 4.f, F8_SO = 16.f;
__device__ __forceinline__ float bflo(unsigned u) { return __uint_as_float(u << 16); }
__device__ __forceinline__ float bfhi(unsigned u) { return __uint_as_float(u & 0xffff0000u); }
__device__ __forceinline__ float bf2f(bf16_t b) { return __uint_as_float(((unsigned)b) << 16); }
__device__ __forceinline__ float xadd16(float x) { const auto a = __builtin_amdgcn_permlane16_swap(__float_as_uint(x), __float_as_uint(x), false, false); return __uint_as_float(a[0]) + __uint_as_float(a[1]); }
__device__ __forceinline__ float xadd32(float x) { const auto a = __builtin_amdgcn_permlane32_swap(__float_as_uint(x), __float_as_uint(x), false, false); return __uint_as_float(a[0]) + __uint_as_float(a[1]); }
__device__ __forceinline__ float xmax16(float x) { const auto a = __builtin_amdgcn_permlane16_swap(__float_as_uint(x), __float_as_uint(x), false, false); return fmaxf(__uint_as_float(a[0]), __uint_as_float(a[1])); }
__device__ __forceinline__ float xmax32(float x) { const auto a = __builtin_amdgcn_permlane32_swap(__float_as_uint(x), __float_as_uint(x), false, false); return fmaxf(__uint_as_float(a[0]), __uint_as_float(a[1])); }
#define WS_DPP(v, ctrl) ((v) + __builtin_bit_cast(float, __builtin_amdgcn_update_dpp(0, __builtin_bit_cast(int, (v)), (ctrl), 0xf, 0xf, false)))
__device__ __forceinline__ float wave_sum(float v) {
    v = WS_DPP(v, 0xB1); v = WS_DPP(v, 0x4E); v = WS_DPP(v, 0x141); v = WS_DPP(v, 0x140);
    return xadd32(xadd16(v));
}
__device__ __forceinline__ float silu_f(float x) { return x / (1.f + __expf(-x)); }
__device__ __forceinline__ float sigmoid_f(float x) { return 1.f / (1.f + __expf(-x)); }

typedef const __attribute__((address_space(4))) Args* CArgs;
struct Ctx {
    CArgs a;
    LAS unsigned char* lds;
    int tid, lane, wave, nwg, wg;
    struct WsPtr { GAS unsigned char* p; __device__ __forceinline__ unsigned char* operator+(size_t off) const { return (unsigned char*)(p + off); } } ws;
    __device__ __forceinline__ const float* in(int i) const { return (const float*)(const GAS float*)a->in[i]; }
    __device__ __forceinline__ float* outp() const { return (float*)(GAS float*)a->out; }
    __device__ __forceinline__ float* modp(int layer, int which) const { return (float*)(ws + WS_MOD) + (layer * 2 + which) * 6144; }
    __device__ __forceinline__ const float* xin0(int r) const { return r < C ? in(2) + (size_t)r * D : in(0) + (size_t)(r - C) * D; }
};


namespace pg8 {
constexpr int BM = 256, BK = 64, HALF = 128, HTB = HALF * BK * 2, STAGE_BYTES = 8 * HTB, KD = 1024, NXCD = 8, WGM = 8;
__device__ __forceinline__ int lds_byte(int r, int c) { const int st = (r >> 4) * 2 + (c >> 5), rr = r & 15, cc = c & 31, ob = rr * 64 + cc * 2; return st * 1024 + (ob ^ (((ob >> 9) & 1) << 5)); }
__device__ __forceinline__ void stage_rc(int b, int& Rr, int& Cc) { const int st = b / 1024, sb = b % 1024, swz = sb ^ (((sb >> 9) & 1) << 5); Rr = (st >> 1) * 16 + swz / 64; Cc = (st & 1) * 32 + (swz % 64) / 2; }
__device__ __forceinline__ int perm32(int rho) { const int n = rho >> 4, i = rho & 15; return 8 * (i >> 2) + 4 * n + (i & 3); }

__device__ __forceinline__ u32x4 pair16(u32x2 a, u32x2 b) {
    const auto sx = __builtin_amdgcn_permlane16_swap(a.x, b.x, false, false), sy = __builtin_amdgcn_permlane16_swap(a.y, b.y, false, false);
    return (u32x4){sx[0], sy[0], sx[1], sy[1]};
}
struct Unit { int pm, pn, e, goff, gcnt; bool real; int amask, bmask; };
struct Gemm { const void* A; const void* Bt; size_t bstride; const int* list; };

struct StaticOrder {
    int nM, nN, nwg, G, c;
    __device__ __forceinline__ void init(int M, int N, int G_, int c_) { nM = M / BM; nN = N / BM; nwg = nM * nN; G = G_; c = c_; }
    __device__ __forceinline__ bool next(int i, Unit& u) const {
        const int F = nwg / G, Rm = nwg - F * G; int Lq; u.amask = 3; u.bmask = 3;
        if (i < F) Lq = i * G + c;
        else if (i == F && Rm > 0) {
            if (4 * Rm <= G) { if (c >= 4 * Rm) return false; Lq = F * G + (c >> 2); u.amask = 1 << ((c >> 1) & 1); u.bmask = 1 << (c & 1); }
            else if (2 * Rm <= G) { if (c >= 2 * Rm) return false; Lq = F * G + (c >> 1); u.bmask = 1 << (c & 1); }
            else { if (c >= Rm) return false; Lq = F * G + c; }
        } else return false;
        int wgid = Lq; { const int q = nwg / NXCD, r = nwg % NXCD, xcd = wgid % NXCD, off = wgid / NXCD; wgid = (xcd < r ? xcd * (q + 1) : r * (q + 1) + (xcd - r) * q) + off; }
        const int nig = WGM * nN, gid = wgid / nig, fm = gid * WGM, gsz = (nM - fm) < WGM ? (nM - fm) : WGM;
        u.pm = fm + ((wgid % nig) % gsz); u.pn = (wgid % nig) / gsz; u.e = 0; u.goff = 0; u.gcnt = 0; u.real = true; return true;
    }
};
struct MoeOrder {
    const LAS int* tp; const LAS int* cnt; int npn, G, vcu; bool split;
    __device__ __forceinline__ bool next(int i, Unit& u) const {
        const int lnpn = npn == 8 ? 3 : 2;
        const int tot = tp[32] << lnpn; int lin; u.amask = 3; u.bmask = 3; u.real = true;
        if (GEMM_REP > 1) { const int lin0 = i * G + vcu; if (lin0 >= tot * GEMM_REP) return false; lin = lin0 % tot; u.real = lin0 >= tot * (GEMM_REP - 1); }
        else {
            const int F = G == 256 ? (tot >> 8) : tot / G, Rm = tot - F * G;
            if (i < F) lin = i * G + vcu;
            else if (i == F && Rm > 0) {
                if (split && 2 * Rm <= G) { if (vcu >= 2 * Rm) return false; lin = F * G + (vcu >> 1); u.bmask = 1 << (vcu & 1); }
                else { if (vcu >= Rm) return false; lin = F * G + vcu; }
            } else return false;
        }
        const int rt = lin >> lnpn;
        const int ln = (int)__builtin_amdgcn_mbcnt_hi(~0u, __builtin_amdgcn_mbcnt_lo(~0u, 0u));
        const int e = __builtin_popcountll(__builtin_amdgcn_ballot_w64(ln >= 1 && ln < 32 && rt >= tp[ln & 31]));
        const int mt = rt - tp[e];
        u.pm = rt; u.pn = lin - (rt << lnpn); u.e = e; u.goff = e * R + mt * 256; u.gcnt = cnt[e] - mt * 256;
        return true;
    }
};

__device__ __forceinline__ void a_rows(const Gemm& g, const Unit& u, const int (&sR)[2], int (&rows)[2][2]) {
#pragma unroll
    for (int h = 0; h < 2; ++h)
#pragma unroll
        for (int i = 0; i < 2; ++i) { const int rr = h * HALF + sR[i]; rows[h][i] = rr < u.gcnt ? g.list[u.goff + rr] : 0; }
}
template <int KB>
__device__ __forceinline__ void a_offsets(const Gemm& g, const Unit& u, const int (&sR)[2], const int (&sC)[2], unsigned (&v)[2][2]) {
#pragma unroll
    for (int h = 0; h < 2; ++h)
#pragma unroll
        for (int i = 0; i < 2; ++i) {
            const int rr = h * HALF + sR[i]; int row;
            if (g.list) row = rr < u.gcnt ? g.list[u.goff + rr] : 0; else row = u.pm * BM + rr;
            v[h][i] = (unsigned)(row * KB + sC[i] * 2);
        }
}

struct EpiF32 {
    static constexpr bool LDSBIAS = false; static constexpr bool PERM = false;
    bf16_t* Cp; int ldc; const float* bias; float scale;
    __device__ __forceinline__ void operator()(const f32x4 (&acc)[2][2][4][2], const Unit& u, int wr, int wc, int fr, int fq, const LAS float* bl) const {
        const int row0 = u.pm * BM + wr * 64 + fr, col0 = u.pn * BM + wc * 32 + 4 * fq;
#pragma unroll
        for (int bj = 0; bj < 2; ++bj)
#pragma unroll
            for (int n = 0; n < 2; ++n) {
                const int col = col0 + bj * HALF + n * 16;
                if (!((u.bmask >> bj) & 1)) continue;
                const f32x4 bv = bias ? *(const f32x4*)(bias + col) : (f32x4){0.f, 0.f, 0.f, 0.f};
#pragma unroll
                for (int ai = 0; ai < 2; ++ai)
#pragma unroll
                    for (int mp = 0; mp < 2; ++mp) if ((u.amask >> ai) & 1) { u32x2 o[2];
#pragma unroll
                        for (int i = 0; i < 2; ++i) { const f32x4 v = acc[ai][bj][2 * mp + i][n] * scale + bv; o[i].x = pk2(v[0], v[1]); o[i].y = pk2(v[2], v[3]); }
                        *(u32x4*)(Cp + (size_t)(row0 + ai * HALF + (2 * mp + (fq & 1)) * 16) * ldc + col - 4 * (fq & 1)) = pair16(o[0], o[1]); }
            }
    }
};
struct EpiSwiglu {
    static constexpr bool LDSBIAS = true; static constexpr bool PERM = true;
    unsigned char* Hd; const float* bgu;
    __device__ __forceinline__ const char* bias_base(const Unit& u) const { return (const char*)(bgu + (size_t)u.e * 2048 + u.pn * HALF); }
    __device__ __forceinline__ unsigned bias_voff(int lane) const { return (unsigned)(((lane >> 5) * 1024 + (lane & 31) * 4) * 4); }
    __device__ __forceinline__ void operator()(const f32x4 (&acc)[2][2][4][2], const Unit& u, int wr, int wc, int fr, int fq, const LAS float* bl) const {
        const int row0 = u.pm * BM + wr * 64 + fr, cg0 = u.pn * HALF + wc * 32 + 8 * fq;
        f32x4 bg[2], bu[2];
#pragma unroll
        for (int n = 0; n < 2; ++n) { bg[n] = *(const LAS f32x4*)(bl + wc * 32 + 8 * fq + 4 * n) * GATE_C; bu[n] = *(const LAS f32x4*)(bl + 128 + wc * 32 + 8 * fq + 4 * n) * (F8_SHD / GATE_C) + (F8_SHD / GATE_C); }
#pragma unroll
        for (int ai = 0; ai < 2; ++ai)
#pragma unroll
            for (int mp = 0; mp < 2; ++mp) {
                u32x2 o[2];
#pragma unroll
                for (int i = 0; i < 2; ++i) { const int m = 2 * mp + i;
#pragma unroll
                    for (int n = 0; n < 2; ++n) {
                        const f32x4 gv = acc[ai][0][m][n] * (1.f / (F8_SH * F8_SW)) + bg[n], uv = acc[ai][1][m][n] * (F8_SHD / (F8_SH * F8_SW * GATE_C)) + bu[n]; float hv[4];
#pragma unroll
                        for (int q = 0; q < 4; ++q) { const float gg = fminf(gv[q], 7.f * GATE_C), uu = fminf(fmaxf(uv[q], -6.f * F8_SHD / GATE_C), 8.f * F8_SHD / GATE_C);
                            hv[q] = gg * __builtin_amdgcn_rcpf(1.f + __builtin_amdgcn_exp2f(-gg)) * uu; }
                        o[i][n] = pk4_fp8_nc(hv[0], hv[1], hv[2], hv[3]);
                    } }
                *(u32x4*)(Hd + (size_t)(row0 + ai * HALF + (2 * mp + (fq & 1)) * 16) * 1024 + cg0 - 8 * (fq & 1)) = pair16(o[0], o[1]);
            }
    }
};
struct EpiBf16Bias {
    static constexpr bool LDSBIAS = true; static constexpr bool PERM = true;
    unsigned char* Op; const float* bias; int bias_estride; float scale;
    __device__ __forceinline__ const char* bias_base(const Unit& u) const { return (const char*)(bias + (size_t)u.e * bias_estride + u.pn * BM); }
    __device__ __forceinline__ unsigned bias_voff(int lane) const { return (unsigned)(lane * 16); }
    __device__ __forceinline__ void operator()(const f32x4 (&acc)[2][2][4][2], const Unit& u, int wr, int wc, int fr, int fq, const LAS float* bl) const {
        const int row0 = u.pm * BM + wr * 64 + fr, col0 = u.pn * BM + wc * 32 + 8 * fq;
#pragma unroll
        for (int bj = 0; bj < 2; ++bj) {
            const int col = col0 + bj * HALF;
            if (!((u.bmask >> bj) & 1)) continue;
            const f32x4 b0 = *(const LAS f32x4*)(bl + bj * HALF + wc * 32 + 8 * fq) * F8_SO, b1 = *(const LAS f32x4*)(bl + bj * HALF + wc * 32 + 8 * fq + 4) * F8_SO;
#pragma unroll
            for (int ai = 0; ai < 2; ++ai)
#pragma unroll
                for (int mp = 0; mp < 2; ++mp) { if (!((u.amask >> ai) & 1)) continue; u32x2 o[2];
#pragma unroll
                    for (int i = 0; i < 2; ++i) { const int m = 2 * mp + i; const f32x4 v0 = acc[ai][bj][m][0] * (scale * F8_SO) + b0, v1 = acc[ai][bj][m][1] * (scale * F8_SO) + b1;
                        o[i].x = pk4_fp8(v0[0], v0[1], v0[2], v0[3]); o[i].y = pk4_fp8(v1[0], v1[1], v1[2], v1[3]); }
                    *(u32x4*)(Op + (size_t)(row0 + ai * HALF + (2 * mp + (fq & 1)) * 16) * 1024 + col - 8 * (fq & 1)) = pair16(o[0], o[1]); }
        }
    }
};
struct EpiQKV {
    static constexpr bool LDSBIAS = false; static constexpr bool PERM = false;
    bf16_t* Qp; bf16_t* Kp; bf16_t* Vp; const float* bias; const float* tab;
    __device__ __forceinline__ void operator()(const f32x4 (&acc)[2][2][4][2], const Unit& u, int wr, int wc, int fr, int fq, const LAS float* bl) const {
        const bool lat = u.pm > 0; const float qs = 0.125f * LOG2E;
#pragma unroll
        for (int bj = 0; bj < 2; ++bj) {
            const int colt = u.pn * BM + bj * HALF + wc * 32 + 4 * fq;
            const f32x4 b1 = *(const f32x4*)(bias + colt), b2 = *(const f32x4*)(bias + colt + 16);
            const bool isv = (u.pn == 4) && (bj == 1);
            if (!((u.bmask >> bj) & 1)) continue;
#pragma unroll
            for (int ai = 0; ai < 2; ++ai)
#pragma unroll
                for (int mp = 0; mp < 2; ++mp) {
                    if (!((u.amask >> ai) & 1)) continue;
                    u32x2 w1[2], w2[2];
#pragma unroll
                    for (int i = 0; i < 2; ++i) { const int m = 2 * mp + i;
                        const int r = u.pm * BM + ai * HALF + wr * 64 + m * 16 + fr, t = r - C;
                        f32x4 x1 = acc[ai][bj][m][0] + b1, x2 = acc[ai][bj][m][1] + b2;
                        if (lat && !isv) {
                            const int pos = (wc & 1) ? (t & 63) : (t >> 6);
                            const f32x4 t0 = *(const f32x4*)(tab + (pos * 16 + 4 * fq) * 2), t1 = *(const f32x4*)(tab + (pos * 16 + 4 * fq) * 2 + 4);
                            const float cs[4] = {t0[0], t0[2], t1[0], t1[2]}, sn[4] = {t0[1], t0[3], t1[1], t1[3]};
                            f32x4 o1, o2;
#pragma unroll
                            for (int e = 0; e < 4; ++e) { o1[e] = x1[e] * cs[e] - x2[e] * sn[e]; o2[e] = x2[e] * cs[e] + x1[e] * sn[e]; }
                            x1 = o1; x2 = o2;
                        }
                        const float sc_ = u.pn < 4 ? qs : 1.f;
                        w1[i].x = pk2(x1[0] * sc_, x1[1] * sc_); w1[i].y = pk2(x1[2] * sc_, x1[3] * sc_); w2[i].x = pk2(x2[0] * sc_, x2[1] * sc_); w2[i].y = pk2(x2[2] * sc_, x2[3] * sc_);
                    }
                    const int rs = u.pm * BM + ai * HALF + wr * 64 + (2 * mp + (fq & 1)) * 16 + fr, cs_ = 4 * (fq & 1);
                    const u32x4 p1 = pair16(w1[0], w1[1]), p2 = pair16(w2[0], w2[1]);
                    if (u.pn < 4) { *(u32x4*)(Qp + (size_t)rs * 1024 + colt - cs_) = p1; *(u32x4*)(Qp + (size_t)rs * 1024 + colt + 16 - cs_) = p2; }
                    else { bf16_t* dst = (bj == 0 ? Kp : Vp) + (size_t)rs * 128 + wc * 32 + 4 * fq - cs_; *(u32x4*)dst = p1; *(u32x4*)(dst + 16) = p2; }
                }
        }
    }
};
struct EpiInProj {
    static constexpr bool LDSBIAS = true; static constexpr bool PERM = true;
    bf16_t* QH; _Float16* KF; _Float16* KB; bf16_t* IV; bf16_t* SG; const float* lb; float scale;
    __device__ __forceinline__ const char* bias_base(const Unit& u) const { const int seg = u.pn >> 2; return (const char*)(lb + ((seg == 2) ? 1024 : 0) + (u.pn & 3) * BM); }
    __device__ __forceinline__ unsigned bias_voff(int lane) const { return (unsigned)(lane * 16); }
    __device__ __forceinline__ void operator()(const f32x4 (&acc)[2][2][4][2], const Unit& u, int wr, int wc, int fr, int fq, const LAS float* bl) const {
        const int seg = u.pn >> 2; const bool lat = u.pm > 0;
        if (!lat && (seg == 0 || seg == 4)) return;
        typedef _Float16 h8_t __attribute__((ext_vector_type(8)));
#pragma unroll
        for (int bj = 0; bj < 2; ++bj) {
            const int col = (u.pn & 3) * BM + bj * HALF + wc * 32 + 8 * fq;
            if (!((u.bmask >> bj) & 1)) continue;
            f32x4 lb0 = (f32x4){0.f, 0.f, 0.f, 0.f}, lb1 = lb0;
            if (seg == 1 || seg == 2) { lb0 = *(const LAS f32x4*)(bl + bj * HALF + wc * 32 + 8 * fq); lb1 = *(const LAS f32x4*)(bl + bj * HALF + wc * 32 + 8 * fq + 4); }
#pragma unroll
            for (int ai = 0; ai < 2; ++ai)
#pragma unroll
                for (int m = 0; m < 4; ++m) {
                    if (!((u.amask >> ai) & 1)) continue;
                    const int r = u.pm * BM + ai * HALF + wr * 64 + m * 16 + fr; const f32x4 v0 = acc[ai][bj][m][0] * scale, v1 = acc[ai][bj][m][1] * scale;
                    if (seg == 1 || seg == 2) {
                        h8_t hv;
#pragma unroll
                        for (int e = 0; e < 4; ++e) { hv[e] = (_Float16)((1.f - lb0[e]) * __builtin_amdgcn_rcpf(1.f + __builtin_amdgcn_exp2f(acc[ai][bj][m][0][e] * (LOG2E * scale)))); hv[4 + e] = (_Float16)((1.f - lb1[e]) * __builtin_amdgcn_rcpf(1.f + __builtin_amdgcn_exp2f(acc[ai][bj][m][1][e] * (LOG2E * scale)))); }
                        *(h8_t*)((seg == 1 ? KF : KB) + (size_t)r * 1024 + col) = hv;
                    } else if (seg == 3) {
                        u32x4 o; o.x = pk2(v0[0], v0[1]); o.y = pk2(v0[2], v0[3]); o.z = pk2(v1[0], v1[1]); o.w = pk2(v1[2], v1[3]); *(u32x4*)(IV + (size_t)r * 1024 + col) = o;
                    } else {
                        float s0[4], s1[4];
#pragma unroll
                        for (int e = 0; e < 4; ++e) { s0[e] = v0[e] * __builtin_amdgcn_rcpf(1.f + __builtin_amdgcn_exp2f(-LOG2E * v0[e])); s1[e] = v1[e] * __builtin_amdgcn_rcpf(1.f + __builtin_amdgcn_exp2f(-LOG2E * v1[e])); }
                        u32x4 o; o.x = pk2(s0[0], s0[1]); o.y = pk2(s0[2], s0[3]); o.z = pk2(s1[0], s1[1]); o.w = pk2(s1[2], s1[3]); *(u32x4*)((seg == 0 ? QH : SG) + (size_t)(r - C) * 1024 + col) = o;
                    }
                }
        }
    }
};

typedef int v8i __attribute__((ext_vector_type(8)));
typedef int v4i __attribute__((ext_vector_type(4)));
template <class Epi, class Sched, bool ALIGN_EPI, bool GATHER, bool FP8>
__device__ __forceinline__ void gemm_phase(LAS unsigned char* lds, const Gemm g, const Sched& S, const Epi& E, const int tid) {
    const int wid = __builtin_amdgcn_readfirstlane(tid >> 6), lane = tid & 63, wr = wid >> 2, wc = wid & 3, fr = lane & 15, fq = lane >> 4;
    constexpr int KB = FP8 ? 1024 : 2048, nt = 1024 / (FP8 ? 128 : 64);
    int sR[2], sC[2]; unsigned voffB[2], voffA[2];
    stage_rc(tid * 16, sR[0], sC[0]); sR[1] = sR[0] + 64; sC[1] = sC[0];
    { const int Rb = Epi::PERM ? ((sR[0] & ~31) + perm32(sR[0] & 31)) : sR[0]; voffB[0] = (unsigned)(Rb * KB + sC[0] * 2); voffA[0] = (unsigned)(sR[0] * KB + sC[0] * 2); voffB[1] = voffB[0] + 64u * KB; voffA[1] = voffA[0] + 64u * KB; }
    constexpr size_t kstep = (size_t)(BK * 2), hstep = (size_t)HALF * KB, tstep = 2 * hstep;
    const unsigned ldsw = (unsigned)wid * 1024u;
    const int aoff = lds_byte(wr * 64 + fr, fq * 8), boff = lds_byte(wc * 32 + fr, fq * 8);
    const char* Ab = (const char*)g.A;
#define PG8_SA(b, h) (((b) * 2 + (h)) * HTB)
#define PG8_SB(b, h) ((4 + (b) * 2 + (h)) * HTB)
#define PG8_STAGE_B(bufoff, gbase) do { _Pragma("unroll") for (int _i = 0; _i < 2; ++_i) \
        __builtin_amdgcn_global_load_lds((const unsigned*)((const char*)(gbase) + voffB[_i]), (LAS unsigned*)(lds + (bufoff) + ldsw + _i * 8192), 16, 0, 0); } while (0)
#define PG8_STAGE_A(bufoff, kb, v, ubase) do { _Pragma("unroll") for (int _i = 0; _i < 2; ++_i) \
        __builtin_amdgcn_global_load_lds((const unsigned*)((GATHER ? Ab : (ubase)) + (size_t)(kb) + (GATHER ? (v)[_i] : voffA[_i])), (LAS unsigned*)(lds + (bufoff) + ldsw + _i * 8192), 16, 0, 0); } while (0)
#define PG8_LD8(p) __builtin_shufflevector(*(const LAS v4i*)(p), *(const LAS v4i*)((p) + 1024), 0, 1, 2, 3, 4, 5, 6, 7)
#define PG8_LDA(dst, b, h) do { if constexpr (FP8) { _Pragma("unroll") for (int m = 0; m < 4; ++m) dst##8[m] = PG8_LD8(lds + PG8_SA(b, h) + aoff + m * 2048); } else { _Pragma("unroll") for (int m = 0; m < 4; ++m) _Pragma("unroll") for (int k = 0; k < 2; ++k) dst[m][k] = *(const LAS bf16x8*)(lds + PG8_SA(b, h) + aoff + m * 2048 + k * 1024); } } while (0)
#define PG8_LDB(dst, b, h) do { if constexpr (FP8) { _Pragma("unroll") for (int n = 0; n < 2; ++n) dst##8[n] = PG8_LD8(lds + PG8_SB(b, h) + boff + n * 2048); } else { _Pragma("unroll") for (int n = 0; n < 2; ++n) _Pragma("unroll") for (int k = 0; k < 2; ++k) dst[n][k] = *(const LAS bf16x8*)(lds + PG8_SB(b, h) + boff + n * 2048 + k * 1024); } } while (0)
#define PG8_MMA(ai, bj, At, Bt) do { __builtin_amdgcn_s_setprio(1); if constexpr (FP8) { _Pragma("unroll") for (int m = 0; m < 4; ++m) _Pragma("unroll") for (int n = 0; n < 2; ++n) \
        asm volatile("v_mfma_scale_f32_16x16x128_f8f6f4 %0, %1, %2, %0, %3, %3 op_sel_hi:[0,0,0]" : "+v"(acc[ai][bj][m][n]) : "v"(Bt##8[n]), "v"(At##8[m]), "v"(unit_scale)); } else { \
        _Pragma("unroll") for (int m = 0; m < 4; ++m) _Pragma("unroll") for (int n = 0; n < 2; ++n) _Pragma("unroll") for (int k = 0; k < 2; ++k) \
        acc[ai][bj][m][n] = __builtin_amdgcn_mfma_f32_16x16x32_bf16(Bt[n][k], At[m][k], acc[ai][bj][m][n], 0, 0, 0); } __builtin_amdgcn_s_setprio(0); } while (0)
#define PG8_MMA0(ai, bj, At, Bt) do { __builtin_amdgcn_s_setprio(1); if constexpr (FP8) { _Pragma("unroll") for (int m = 0; m < 4; ++m) _Pragma("unroll") for (int n = 0; n < 2; ++n) \
        asm volatile("v_mfma_scale_f32_16x16x128_f8f6f4 %0, %1, %2, 0, %3, %3 op_sel_hi:[0,0,0]" : "+v"(acc[ai][bj][m][n]) : "v"(Bt##8[n]), "v"(At##8[m]), "v"(unit_scale)); } else { \
        _Pragma("unroll") for (int m = 0; m < 4; ++m) _Pragma("unroll") for (int n = 0; n < 2; ++n) { \
        acc[ai][bj][m][n] = __builtin_amdgcn_mfma_f32_16x16x32_bf16(Bt[n][0], At[m][0], (f32x4){0.f, 0.f, 0.f, 0.f}, 0, 0, 0); \
        acc[ai][bj][m][n] = __builtin_amdgcn_mfma_f32_16x16x32_bf16(Bt[n][1], At[m][1], acc[ai][bj][m][n], 0, 0, 0); } } __builtin_amdgcn_s_setprio(0); } while (0)
#define PG8_WAIT_V(n) asm volatile("s_waitcnt vmcnt(" #n ")" ::: "memory")
#define PG8_WAIT_L(n) asm volatile("s_waitcnt lgkmcnt(" #n ")" ::: "memory")
#define PG8_BAR __builtin_amdgcn_s_barrier()
#define PG8_SCHED __builtin_amdgcn_sched_barrier(0)
    Unit cur, nxt; int ui = 0;
    if (!S.next(0, cur)) return;
    unsigned cv[2][2]; int nvr[2][2];
    if constexpr (GATHER) a_offsets<KB>(g, cur, sR, sC, cv);
    const char* cA = Ab + (size_t)cur.pm * tstep; const char* nA = cA;
    f32x4 acc[2][2][4][2];
    bf16x8 At[4][2], B0[2][2], B1[2][2]; v8i At8[4], B08[2], B18[2];
    int unit_scale = 0x7f7f7f7f; asm volatile("" : "+v"(unit_scale));
    const char* cB = (const char*)g.Bt + (size_t)cur.e * g.bstride + (size_t)cur.pn * tstep;
#define PG8_BIAS(uu, slot) do { if constexpr (Epi::LDSBIAS) { if (wid == 0) { int l_; asm volatile("v_mbcnt_lo_u32_b32 %0, -1, 0\n\tv_mbcnt_hi_u32_b32 %0, -1, %0" : "=v"(l_)); \
        __builtin_amdgcn_global_load_lds((const unsigned*)(E.bias_base(uu) + E.bias_voff(l_)), (LAS unsigned*)(lds + STAGE_BYTES + 4096 + (slot) * 1024), 16, 0, 0); } } } while (0)
    PG8_BIAS(cur, 0);
    PG8_STAGE_B(PG8_SB(0, 0), cB); PG8_STAGE_B(PG8_SB(0, 1), cB + hstep); PG8_STAGE_A(PG8_SA(0, 0), 0, cv[0], cA); PG8_STAGE_A(PG8_SA(0, 1), 0, cv[1], cA + hstep);
    PG8_STAGE_B(PG8_SB(1, 0), cB + kstep); PG8_STAGE_A(PG8_SA(1, 0), kstep, cv[0], cA); PG8_STAGE_B(PG8_SB(1, 1), cB + hstep + kstep);
    if (wr == 1) PG8_BAR;
    PG8_WAIT_V(8); PG8_BAR;
    PG8_WAIT_V(6); PG8_BAR;
    for (;;) {
        const bool has_next = S.next(ui + 1, nxt);
        const char* nB = cB;
        nA = cA;
        if (has_next) { PG8_BIAS(nxt, (ui + 1) % 3); if constexpr (GATHER) a_rows(g, nxt, sR, nvr); nA = Ab + (size_t)nxt.pm * tstep; nB = (const char*)g.Bt + (size_t)nxt.e * g.bstride + (size_t)nxt.pn * tstep; }

        const int ntr = (PROBE_SHORTK && !cur.real) ? 2 : nt;
        const bool m00 = (cur.amask & 1) && (cur.bmask & 1), m01 = (cur.amask & 1) && (cur.bmask & 2), m10 = (cur.amask & 2) && (cur.bmask & 1), m11 = (cur.amask & 2) && (cur.bmask & 2);
#define PG8_KITER(MMAF) do { \
            const bool last = (t == ntr - 2); \
            if constexpr (GATHER) { if (last && has_next) asm volatile("" : "+v"(nvr[0][0]), "+v"(nvr[0][1]), "+v"(nvr[1][0]), "+v"(nvr[1][1])); } \
            const size_t k1 = (size_t)(t + 1) * kstep, k2 = last ? 0 : (size_t)(t + 2) * kstep, k3 = k2 + kstep; \
            const char* b2 = last ? nB : cB + (size_t)(t + 2) * kstep; const char* b3 = b2 + kstep; \
            unsigned w0[2], w1[2]; \
            if constexpr (GATHER) { \
                _Pragma("unroll") \
                for (int i = 0; i < 2; ++i) { w0[i] = (last && has_next) ? (unsigned)(nvr[0][i] * KB + sC[i] * 2) : cv[0][i]; w1[i] = (last && has_next) ? (unsigned)(nvr[1][i] * KB + sC[i] * 2) : cv[1][i]; } \
            } \
            const char* a2 = last ? nA : cA; \
            PG8_LDB(B0, 0, 0); PG8_LDB(B1, 0, 1); PG8_SCHED; PG8_LDA(At, 0, 0); PG8_STAGE_A(PG8_SA(1, 1), k1, cv[1], cA + hstep); \
            PG8_WAIT_V(8); PG8_WAIT_L(0); PG8_BAR; if (m00) MMAF(0, 0, At, B0); if (m01) MMAF(0, 1, At, B1); PG8_BAR; PG8_SCHED; \
            PG8_LDA(At, 0, 1); PG8_STAGE_B(PG8_SB(0, 0), b2); PG8_STAGE_B(PG8_SB(0, 1), b2 + hstep); PG8_STAGE_A(PG8_SA(0, 0), k2, w0, a2); \
            PG8_WAIT_V(8); PG8_WAIT_L(0); PG8_BAR; if (m10) MMAF(1, 0, At, B0); if (m11) MMAF(1, 1, At, B1); PG8_BAR; PG8_SCHED; \
            PG8_LDB(B0, 1, 0); PG8_LDB(B1, 1, 1); PG8_SCHED; PG8_LDA(At, 1, 0); PG8_STAGE_A(PG8_SA(0, 1), k2, w1, a2 + hstep); \
            PG8_WAIT_V(8); PG8_WAIT_L(0); PG8_BAR; if (m00) PG8_MMA(0, 0, At, B0); if (m01) PG8_MMA(0, 1, At, B1); PG8_BAR; PG8_SCHED; \
            PG8_LDA(At, 1, 1); PG8_STAGE_B(PG8_SB(1, 0), b3); PG8_STAGE_B(PG8_SB(1, 1), b3 + hstep); PG8_STAGE_A(PG8_SA(1, 0), k3, w0, a2); \
            PG8_WAIT_V(8); PG8_WAIT_L(0); PG8_BAR; if (m10) PG8_MMA(1, 0, At, B0); if (m11) PG8_MMA(1, 1, At, B1); PG8_BAR; PG8_SCHED; \
        } while (0)
        { const int t = 0; PG8_KITER(PG8_MMA0); }
#pragma nounroll
        for (int t = 2; t < ntr; t += 2) { PG8_KITER(PG8_MMA); }
#undef PG8_KITER
        if constexpr (ALIGN_EPI) { if (wr == 0) PG8_BAR; }
        if constexpr (FP8) asm volatile("s_nop 15\n\ts_nop 15" ::: "memory");
        { int ln_; asm volatile("v_mbcnt_lo_u32_b32 %0, -1, 0\n\tv_mbcnt_hi_u32_b32 %0, -1, %0" : "=v"(ln_));
          if (!PROBE_NOEPI || cur.real) E(acc, cur, wr, wc, ln_ & 15, ln_ >> 4, (const LAS float*)(lds + STAGE_BYTES + 4096 + (ui % 3) * 1024)); }
        if (!has_next) break;
        cur = nxt; cB = nB; cA = nA; ++ui;
        if constexpr (GATHER) {
#pragma unroll
            for (int h = 0; h < 2; ++h)
#pragma unroll
                for (int i = 0; i < 2; ++i) cv[h][i] = (unsigned)(nvr[h][i] * KB + sC[i] * 2);
        }
        if constexpr (ALIGN_EPI) { if (wr == 1) PG8_BAR; }
    }
    PG8_WAIT_V(0);
    if constexpr (!ALIGN_EPI) { if (wr == 0) PG8_BAR; }
    PG8_BAR;
#undef PG8_SA
#undef PG8_SB
#undef PG8_STAGE_A
#undef PG8_STAGE_B
#undef PG8_LDA
#undef PG8_BIAS
#undef PG8_LD8
#undef PG8_LDB
#undef PG8_MMA
#undef PG8_MMA0
#undef PG8_WAIT_V
#undef PG8_WAIT_L
#undef PG8_BAR
#undef PG8_SCHED
}
}

struct TBlk { const float* src; int ldw; bf16_t* dst; unsigned char* dst8; float ws; };
__device__ __forceinline__ void tb_load(const TBlk& t, int lane, f32x4 (&v)[16]) {
    const float* p = t.src + (size_t)(lane >> 4) * t.ldw + (lane & 15) * 4;
#pragma unroll
    for (int i = 0; i < 16; ++i) v[i] = __builtin_nontemporal_load((const f32x4*)(p + (size_t)(4 * i) * t.ldw));
}
__device__ __forceinline__ void tb_store(const TBlk& t, int lane, const f32x4 (&v)[16], LAS float* scr) {
#pragma unroll
    for (int i = 0; i < 16; ++i) { LAS float* d = scr + ((lane >> 4) + 4 * i) * 65 + (lane & 15) * 4; d[0] = v[i].x; d[1] = v[i].y; d[2] = v[i].z; d[3] = v[i].w; }
    asm volatile("s_waitcnt lgkmcnt(0)" ::: "memory"); __builtin_amdgcn_wave_barrier();
    const int c8 = lane & 7;
#pragma unroll
    for (int jj = 0; jj < 8; ++jj) {
        const int n = (lane >> 3) + 8 * jj; const LAS float* p = scr + (8 * c8) * 65 + n;
        if (t.dst8) { const float ws = t.ws; u32x2 o; o.x = pk4_fp8(p[0] * ws, p[65] * ws, p[2 * 65] * ws, p[3 * 65] * ws); o.y = pk4_fp8(p[4 * 65] * ws, p[5 * 65] * ws, p[6 * 65] * ws, p[7 * 65] * ws);
            *(u32x2*)(t.dst8 + (size_t)n * 1024 + 8 * c8) = o; }
        else { u32x4 o; o.x = pk2(p[0], p[65]); o.y = pk2(p[2 * 65], p[3 * 65]); o.z = pk2(p[4 * 65], p[5 * 65]); o.w = pk2(p[6 * 65], p[7 * 65]);
            *(u32x4*)(t.dst + (size_t)n * 1024 + 8 * c8) = o; }
    }
    asm volatile("s_waitcnt lgkmcnt(0)" ::: "memory"); __builtin_amdgcn_wave_barrier();
}

__device__ __forceinline__ void phase_prep(const Ctx& c) {
    LAS float* red = (LAS float*)c.lds;
    LAS float* sil = red + 1024;
    const float* cv = c.in(1); const float* ccv = c.in(3); const float* ada_w = c.in(4); const float* ada_b = c.in(5);
    for (int i = c.tid; i < 2048; i += 512) { const float x = i < 1024 ? cv[i] : ccv[i - 1024]; sil[i] = x * __builtin_amdgcn_rcpf(1.f + __builtin_amdgcn_exp2f(-LOG2E * x)); }
    __syncthreads();
    for (int item = c.wg; item < 256; item += c.nwg) {
        if (item < 192) {
            const int layer = item / 96, cb = item % 96, col = cb * 64 + c.lane;
            const float* W = ada_w + (size_t)layer * D * 6144 + col;
            float a0 = 0.f, a1 = 0.f;
            const int k0 = c.wave * 128;
#pragma unroll 64
            for (int k = 0; k < 128; ++k) { const float w = __builtin_nontemporal_load(W + (size_t)(k0 + k) * 6144); a0 += sil[k0 + k] * w; a1 += sil[1024 + k0 + k] * w; }
            red[(0 * 8 + c.wave) * 64 + c.lane] = a0; red[(1 * 8 + c.wave) * 64 + c.lane] = a1;
            __syncthreads();
            if (c.tid < 128) {
                const int which = c.tid >> 6, l = c.tid & 63; float s = 0.f;
#pragma unroll
                for (int w = 0; w < 8; ++w) s += red[(which * 8 + w) * 64 + l];
                c.modp(layer, which)[cb * 64 + l] = s + ada_b[layer * 6144 + cb * 64 + l];
            }
            __syncthreads();
        } else {
            float* modbase = (float*)(c.ws + WS_MOD); const int sl = item - 192;
            if (c.tid < 64) {
                const int i = sl * 64 + c.tid, pos = i >> 4, j = i & 15;
                const double ang = (double)pos * pow(10000.0, -(double)j / 16.0);
                modbase[MOD_ROPE + 2 * i] = (float)cos(ang); modbase[MOD_ROPE + 2 * i + 1] = (float)sin(ang);
            } else if (c.tid < 96) {
                const float* lbp = c.in(12);
                const int i = sl * 32 + (c.tid - 64); const float p0 = lbp[i], p1 = lbp[2048 + i]; modbase[MOD_LB + i] = 1.f / (1.f + __expf(p0 - p1));
            }
        }
    }
}

__device__ __forceinline__ void row_load(const float* p, int lane, f32x4 (&v)[4]) {
#pragma unroll
    for (int j = 0; j < 4; ++j) v[j] = __builtin_nontemporal_load((const f32x4*)(p + lane * 4 + 256 * j));
}
__device__ __forceinline__ void row_load_bf(const bf16_t* p, int lane, f32x4 (&v)[4]) {
#pragma unroll
    for (int j = 0; j < 4; ++j) { const u32x2 w = *(const u32x2*)(p + lane * 4 + 256 * j); v[j] = (f32x4){bflo(w.x), bfhi(w.x), bflo(w.y), bfhi(w.y)}; }
}
__device__ __forceinline__ float row_ss(const f32x4 (&v)[4]) {
    float s = 0.f;
#pragma unroll
    for (int j = 0; j < 4; ++j) s += v[j].x * v[j].x + v[j].y * v[j].y + v[j].z * v[j].z + v[j].w * v[j].w;
    return wave_sum(s);
}
__device__ __forceinline__ void row_modnorm_store(const f32x4 (&x)[4], float rstd, const float* g, const float* sh, const float* sc, bf16_t* out, int lane, f32x4 (*hout)[4] = nullptr) {
#pragma unroll
    for (int j = 0; j < 4; ++j) {
        const int c0 = lane * 4 + 256 * j;
        const f32x4 gv = *(const f32x4*)(g + c0), shv = *(const f32x4*)(sh + c0), scv = *(const f32x4*)(sc + c0);
        f32x4 h;
        h.x = x[j].x * rstd * gv.x * (1.f + scv.x) + shv.x; h.y = x[j].y * rstd * gv.y * (1.f + scv.y) + shv.y;
        h.z = x[j].z * rstd * gv.z * (1.f + scv.z) + shv.z; h.w = x[j].w * rstd * gv.w * (1.f + scv.w) + shv.w;
        if (hout) (*hout)[j] = h;
        u32x2 o; o.x = pk2(h.x, h.y); o.y = pk2(h.z, h.w);
        *(u32x2*)(out + c0) = o;
    }
}

__device__ __forceinline__ void phase_norm0(const Ctx& c) {
    bf16_t* H = (bf16_t*)(c.ws + WS_H); const float* ng = c.in(6);
    LAS float* vl = (LAS float*)c.lds;
    for (int i = c.tid; i < 1024; i += 512) { vl[i] = ng[i]; vl[1024 + i] = c.modp(0, 0)[i]; vl[2048 + i] = c.modp(0, 1)[i]; vl[3072 + i] = c.modp(0, 0)[1024 + i]; vl[4096 + i] = c.modp(0, 1)[1024 + i]; }
    __syncthreads();
    const int r0 = c.wg * 8 + c.wave, stride = c.nwg * 8;
    if (r0 >= R) return;
#define N0_ROW(XX, rr) do { const int r_ = (rr), vo_ = r_ < C ? 1024 : 0; \
        const float rstd = rsqrtf(row_ss(XX) * (1.f / D) + EPS); \
        _Pragma("unroll") for (int j = 0; j < 4; ++j) { const int c0 = c.lane * 4 + 256 * j; \
            const f32x4 gv = *(const LAS f32x4*)(vl + c0), shv = *(const LAS f32x4*)(vl + 1024 + vo_ + c0), scv = *(const LAS f32x4*)(vl + 3072 + vo_ + c0); \
            const f32x4 h = XX[j] * rstd * gv * (scv + 1.f) + shv; \
            u32x2 o; o.x = pk2(h[0], h[1]); o.y = pk2(h[2], h[3]); *(u32x2*)(H + (size_t)r_ * D + c0) = o; } } while (0)
    f32x4 xa[4], xb[4];
    row_load(c.xin0(r0), c.lane, xa);
    for (int r = r0;;) {
        { const int rn = r + stride; row_load(c.xin0(rn < R ? rn : r0), rn < R ? c.lane : 0, xb); }
        N0_ROW(xa, r);
        r += stride; if (r >= R) break;
        { const int rn = r + stride; row_load(c.xin0(rn < R ? rn : r0), rn < R ? c.lane : 0, xa); }
        N0_ROW(xb, r);
        r += stride; if (r >= R) break;
    }
#undef N0_ROW
}

namespace at {
__device__ __forceinline__ float max3f(float a, float b, float c) { return __builtin_fmaxf(__builtin_fmaxf(a, b), c); }
constexpr int KP = 128, TILEB = 64 * KP;
__device__ __forceinline__ bf16x8 tr_frag2(const LAS unsigned char* tile, int row0, int col0, int lane) {
    const int q = (lane & 15) >> 2, p = lane & 3;
    const int r = row0 + q;
    const LAS unsigned char* a = tile + r * KP + ((((col0 >> 3) + (p >> 1)) ^ (((r >> 1) & 3) << 1)) << 4) + (p & 1) * 8;
    const v4i16_t lo = __builtin_amdgcn_ds_read_tr16_b64_v4i16((LAS v4i16_t*)a);
    const v4i16_t hi = __builtin_amdgcn_ds_read_tr16_b64_v4i16((LAS v4i16_t*)(a + 16 * KP));
    return (bf16x8){lo[0], lo[1], lo[2], lo[3], hi[0], hi[1], hi[2], hi[3]};
}
}
__device__ __forceinline__ void phase_attn(const Ctx& c) {
    using namespace at;
    const bf16_t* Q = (const bf16_t*)(c.ws + WS_Q); const bf16_t* K = (const bf16_t*)(c.ws + WS_K); const bf16_t* V = (const bf16_t*)(c.ws + WS_V);
    unsigned char* O = c.ws + WS_O; const float* sink = c.in(9);
    LAS unsigned char* lds = c.lds;
    const int tid = c.tid, lane = c.lane, w = __builtin_amdgcn_readfirstlane(tid >> 6), fr = lane & 15, g = lane >> 4;
    const int lrow = tid >> 3, lch = tid & 7;
    const int nitn = c.nwg == 256 ? 2 : (264 - c.wg + c.nwg - 1) / c.nwg;
    const bf16x8 ones8 = __builtin_bit_cast(bf16x8, (u32x4){0x3f803f80u, 0x3f803f80u, 0x3f803f80u, 0x3f803f80u});
    for (int itn = 0; itn < nitn; ++itn) {
        int item = c.wg + itn * c.nwg;
        if (c.nwg == 256 && itn == 1) { const int n_ = c.wg >> 1; item = -1;
            if (n_ == 0) item = 256 + (c.wg & 1); else if (n_ == 127) item = 258 + (c.wg & 1); else if (n_ == 30 || n_ == 31) item = 260 + (c.wg - 60); }
        if (item < 0 || item >= 264) continue;
        const bool isctx = item >= 256;
        const int ci = item - 256;
        const int n = isctx ? 0 : (item >> 1), kh = isctx ? ((ci >> 1) & 1) : (item & 1), cb = isctx ? (ci >> 2) : 0;
        const int p_lo = isctx ? (ci & 1) : 0, p_hi = isctx ? (ci & 1) + 1 : 2;
        const int hq = kh * 8 + w;
        const float sink2 = sink[hq] * LOG2E;
        for (int pass = p_lo; pass < p_hi; ++pass) {
            const int t0 = 128 * n + 64 * pass, qrow0 = isctx ? cb * 128 + 64 * pass : C + t0;
            const int jlo = isctx ? 0 : (t0 >= 128 ? 0 : (128 - t0) / 64), jhi = isctx ? 0 : ((L - t0 + 128) / 64 < 5 ? (L - t0 + 128) / 64 : 5);
            const int ntile = 4 + (jhi - jlo);
            LAS unsigned char* qlds = lds + 4 * TILEB + w * TILEB;
#pragma unroll
            for (int qb = 0; qb < 4; ++qb)
#pragma unroll
                for (int ks = 0; ks < 2; ++ks) *(LAS bf16x8*)(qlds + (16 * qb + fr) * KP + (((4 * ks + g) ^ ((fr >> 1) & 7)) << 4)) = *(const GAS bf16x8*)(Q + (size_t)(qrow0 + 16 * qb + fr) * D + hq * 64 + 32 * ks + 8 * g);
            float mrow[4]; f32x4 lacc[4]; f32x4 OT[4][4];
#pragma unroll
            for (int qb = 0; qb < 4; ++qb) { mrow[qb] = sink2; lacc[qb] = (f32x4){1.f, 1.f, 1.f, 1.f};
#pragma unroll
                for (int nt = 0; nt < 4; ++nt) OT[qb][nt] = (f32x4){0.f, 0.f, 0.f, 0.f}; }
            u32x4 kreg, vreg;
#define AT_KROW(ti) ((ti) < 4 ? 64 * (ti) : C + t0 - 128 + 64 * (jlo + (ti) - 4))
#define AT_LOAD(ti) do { const size_t ro_ = (size_t)(AT_KROW(ti) + lrow) * 128 + kh * 64 + lch * 8; kreg = *(const GAS u32x4*)(K + ro_); vreg = *(const GAS u32x4*)(V + ro_); } while (0)
#define AT_WRITE(buf) do { *(LAS u32x4*)(lds + (buf) * 2 * TILEB + lrow * KP + ((lch ^ ((lrow >> 1) & 7)) << 4)) = kreg; *(LAS u32x4*)(lds + (buf) * 2 * TILEB + TILEB + lrow * KP + ((lch ^ (((lrow >> 1) & 3) << 1)) << 4)) = vreg; } while (0)
            AT_LOAD(0); AT_WRITE(0);
            __syncthreads();
            for (int ti = 0; ti < ntile; ++ti) {
                if (ti + 1 < ntile) AT_LOAD(ti + 1);
                const LAS unsigned char* kb = lds + (ti & 1) * 2 * TILEB; const LAS unsigned char* vb = kb + TILEB;
                const int jj = jlo + ti - 4; const bool mlo_t = (ti >= 4) && jj == 0, mup_t = (ti >= 4) && jj == 4;
                const float fl = mlo_t ? -INFINITY : 0.f, fu = mup_t ? -INFINITY : 0.f;
                const f32x4 mlow = (f32x4){fl, fl, fl, fl}, mup = (f32x4){fu, fu, fu, fu};
                f32x4 mdiag;
#pragma unroll
                for (int e = 0; e < 4; ++e) mdiag[e] = (mlo_t && fr > 4 * g + e) || (mup_t && fr < 4 * g + e) ? -INFINITY : 0.f;
                bf16x8 Kf[4][2];
#pragma unroll
                for (int mt = 0; mt < 4; ++mt)
#pragma unroll
                    for (int ks = 0; ks < 2; ++ks) Kf[mt][ks] = *(const LAS bf16x8*)(kb + (16 * mt + fr) * KP + (((4 * ks + g) ^ ((fr >> 1) & 7)) << 4));
                bf16x8 Vf[4][2];
#pragma unroll
                for (int mt = 0; mt < 4; ++mt)
#pragma unroll
                    for (int ks = 0; ks < 2; ++ks)
                        Vf[mt][ks] = tr_frag2(vb, 32 * ks + 4 * g, 16 * mt, lane);
#define AT_QB(qb) do { \
                    bf16x8 Qq[2]; \
                    _Pragma("unroll") for (int ks = 0; ks < 2; ++ks) Qq[ks] = *(const LAS bf16x8*)(qlds + (16 * (qb) + fr) * KP + (((4 * ks + g) ^ ((fr >> 1) & 7)) << 4)); \
                    f32x4 sa[4]; const float nm_ = -mrow[qb]; const f32x4 cin = (f32x4){nm_, nm_, nm_, nm_};     \
                    _Pragma("unroll") for (int mt = 0; mt < 4; ++mt) { sa[mt] = __builtin_amdgcn_mfma_f32_16x16x32_bf16(Kf[mt][0], Qq[0], cin, 0, 0, 0); sa[mt] = __builtin_amdgcn_mfma_f32_16x16x32_bf16(Kf[mt][1], Qq[1], sa[mt], 0, 0, 0); } \
                    if (mlo_t || mup_t) { _Pragma("unroll") for (int mt = 0; mt < 4; ++mt) sa[mt] += (qb) == mt ? mdiag : ((qb) > mt ? mlow : mup); }     \
                    float mx = max3f(sa[0][0], sa[0][1], sa[0][2]), my = max3f(sa[0][3], sa[1][0], sa[1][1]); \
                    mx = max3f(mx, sa[1][2], sa[1][3]); my = max3f(my, sa[2][0], sa[2][1]); mx = max3f(mx, sa[2][2], sa[2][3]); my = max3f(my, sa[3][0], sa[3][1]); mx = max3f(mx, sa[3][2], sa[3][3]); \
                    mx = __builtin_fmaxf(mx, my); \
                      \
                    if (__builtin_amdgcn_ballot_w64(mx > 8.f) != 0) { \
                        const float dm_ = xmax32(xmax16(__builtin_fmaxf(mx, 0.f)));     \
                        const float alpha = __builtin_amdgcn_exp2f(-dm_); \
                        mrow[qb] += dm_; lacc[qb] = lacc[qb] * alpha; \
                        _Pragma("unroll") for (int nt = 0; nt < 4; ++nt) OT[qb][nt] = OT[qb][nt] * alpha; \
                        _Pragma("unroll") for (int mt = 0; mt < 4; ++mt) sa[mt] = sa[mt] - dm_; \
                    } \
                    _Pragma("unroll") for (int mt = 0; mt < 4; ++mt) _Pragma("unroll") for (int e = 0; e < 4; ++e) sa[mt][e] = __builtin_amdgcn_exp2f(sa[mt][e]); \
                    bf16x8 Pb[2]; \
                    _Pragma("unroll") for (int ks = 0; ks < 2; ++ks) { const f32x4 a0 = sa[2 * ks], a1 = sa[2 * ks + 1]; \
                        const u32x4 pk = (u32x4){pk2(a0[0], a0[1]), pk2(a0[2], a0[3]), pk2(a1[0], a1[1]), pk2(a1[2], a1[3])}; Pb[ks] = __builtin_bit_cast(bf16x8, pk); } \
                    _Pragma("unroll") for (int ks = 0; ks < 2; ++ks) lacc[qb] = __builtin_amdgcn_mfma_f32_16x16x32_bf16(ones8, Pb[ks], lacc[qb], 0, 0, 0); \
                    _Pragma("unroll") for (int nt = 0; nt < 4; ++nt) { \
                        _Pragma("unroll") for (int ks = 0; ks < 2; ++ks) OT[qb][nt] = __builtin_amdgcn_mfma_f32_16x16x32_bf16(Vf[nt][ks], Pb[ks], OT[qb][nt], 0, 0, 0); } } while (0)
                AT_QB(0); AT_QB(1); AT_QB(2); AT_QB(3);
#undef AT_QB
                if (ti + 1 < ntile) AT_WRITE((ti + 1) & 1);
                __syncthreads();
                if (w >= 4) __builtin_amdgcn_s_sleep(3);
            }
#undef AT_KROW
#undef AT_LOAD
#undef AT_WRITE
#pragma unroll
            for (int qb = 0; qb < 4; ++qb) {
                const float il = (FP8_OPROJ ? F8_SH : 1.f) / lacc[qb][0];
                if (FP8_OPROJ) {
                    unsigned wv[4];
#pragma unroll
                    for (int nt = 0; nt < 4; ++nt) { const f32x4 v = OT[qb][nt] * il; wv[nt] = pk4_fp8(v[0], v[1], v[2], v[3]); }
                    const auto s01 = __builtin_amdgcn_permlane16_swap(wv[0], wv[1], false, false), s23 = __builtin_amdgcn_permlane16_swap(wv[2], wv[3], false, false);
                    const auto t02 = __builtin_amdgcn_permlane32_swap(s01[0], s23[0], false, false), t13 = __builtin_amdgcn_permlane32_swap(s01[1], s23[1], false, false);
                    const u32x4 o = (u32x4){t02[0], t13[0], t02[1], t13[1]};
                    *(GAS u32x4*)(O + (size_t)(qrow0 + 16 * qb + fr) * D + hq * 64 + 16 * g) = o;
                } else {
#pragma unroll
                    for (int nt = 0; nt < 4; ++nt) { const f32x4 v = OT[qb][nt] * il; u32x2 o; o.x = pk2(v[0], v[1]); o.y = pk2(v[2], v[3]); *(GAS u32x2*)((bf16_t*)O + (size_t)(qrow0 + 16 * qb + fr) * D + hq * 64 + 4 * g + 16 * nt) = o; }
                }
            }
        }
    }
}


__device__ __forceinline__ void router_tables(const Ctx& c, int first, int step) {
    LAS float* red = (LAS float*)c.lds;
    for (int item = first; item < 32; item += step) {
        const int t = item >> 3, j = item & 7, layer = t >> 1, which = t & 1;
        const float* m = c.modp(layer, which); const float* ng = c.in(6) + layer * 4 * D; const float* Wr = c.in(15) + (size_t)layer * D * NE; const float* br = c.in(16) + layer * NE;
        unsigned char* tab = c.ws + WS_MOD + RT_OFF + (size_t)t * RT_BYTES;
        bf16_t* img = (bf16_t*)tab;
        { const int k = 128 * j + (c.tid >> 2), e0 = (c.tid & 3) * 8; const float sc = ng[2 * D + k] * (1.f + m[4096 + k]);
#pragma unroll
          for (int q = 0; q < 8; ++q) { const float w = Wr[(size_t)k * NE + e0 + q] * sc; const unsigned hi = f2bf(w); const float lo = w - bf2f((bf16_t)hi);
              img[(size_t)(e0 + q) * (RT_PITCH / 2) + k] = (bf16_t)hi; img[(size_t)(32 + e0 + q) * (RT_PITCH / 2) + k] = (bf16_t)f2bf(lo); } }
        if (j == 0) {
            __syncthreads();
            { const int e = c.tid & 31, part = c.tid >> 5; float sacc = 0.f;
#pragma unroll 16
              for (int k = part * 64; k < part * 64 + 64; ++k) sacc += m[3072 + k] * Wr[k * NE + e];
              red[part * 32 + e] = sacc; }
            __syncthreads();
            if (c.tid < 32) { float sacc = br[c.tid];
#pragma unroll
                for (int p = 0; p < 16; ++p) sacc += red[p * 32 + c.tid]; ((float*)(tab + RT_IMG))[c.tid] = sacc; }
            __syncthreads();
        }
        if (j == 1) { float* pv = (float*)(tab + RT_IMG + 256);
            for (int k = c.tid; k < D; k += 512) { pv[k] = m[2048 + k] * ng[D + k]; pv[1024 + k] = ng[2 * D + k] * (1.f + m[4096 + k]); pv[2048 + k] = m[3072 + k]; } }
    }
}

template <int GS>
__device__ __forceinline__ void phase_postmix(const Ctx& c, int layer, bool route) {
    const bf16_t* Y = (const bf16_t*)(c.ws + WS_RAW1); unsigned char* H8 = c.ws + WS_H8;
    bf16_t* Xout = (bf16_t*)(c.ws + (layer == 0 ? WS_X : WS_X1)); const bf16_t* Xprev = (const bf16_t*)(c.ws + WS_X);
    const float* ng = c.in(6) + layer * 4 * D; const float* Wr = c.in(15) + (size_t)layer * D * NE; const float* br = c.in(16) + layer * NE;
    unsigned* cnt = (unsigned*)(c.ws + WS_CTL) + CW_CNT + layer * NE;
    int* tk_e = (int*)(c.ws + WS_TK); float* tk_g = (float*)(c.ws + WS_TK) + R * 4; int* tk_slot = (int*)(c.ws + WS_TK) + 2 * R * 4;
    int* list = (int*)(c.ws + WS_LIST);
    LAS float* biasp = (LAS float*)(c.lds + RT_IMG);
    LAS float* pvA = (LAS float*)(c.lds + RT_IMG + 256); LAS float* pvB = pvA + 1024; LAS float* pvS = pvB + 1024;
    LAS unsigned* lcnt = (LAS unsigned*)(c.lds + RT_BYTES); LAS unsigned* lbase = lcnt + 32; LAS float* rsx = (LAS float*)(lcnt + 64);
    static_assert(RT_BYTES + 256 + 512 <= LDS_BYTES - 64, "post-mixer LDS map");
    const int lane = c.lane, w = __builtin_amdgcn_readfirstlane(c.tid >> 6), fr = lane & 15, g = lane >> 4;
    constexpr int RP = GS / 8, NW2 = GS / 16;
    const int g_lo = layer == 0 ? 0 : C / GS;
    for (int grp = g_lo + c.wg; grp < R / GS; grp += c.nwg) {
        const int which = grp * GS < C ? 1 : 0;
        const float* m = c.modp(layer, which);
        __syncthreads();
        if (c.tid < NE) lcnt[c.tid] = 0u;
        { const u32x4* src = (const u32x4*)(c.ws + WS_MOD + RT_OFF + (size_t)(layer * 2 + which) * RT_BYTES);
#pragma unroll 6
          for (int i = c.tid; i < RT_BYTES / 16; i += 512) *(LAS u32x4*)(c.lds + 16 * i) = src[i]; }
        __syncthreads();
        const int row1 = grp * GS + w * RP;
        f32x4 y0[4], x0[4], y1[4], x1[4], yn0[4], xn0[4], yn1[4], xn1[4];
#define PM_LOAD(RW, YY, XX) do { row_load_bf(Y + (size_t)(layer == 0 ? (RW) : (RW) - C) * D, lane, YY); if (layer == 0) row_load(c.xin0(RW), lane, XX); else row_load_bf(Xprev + (size_t)(RW) * D, lane, XX); } while (0)
#define PM_ROW(RW, YY, XX, II) do { \
            const float rstd_y = rsqrtf(row_ss(YY) * (1.f / D) + EPS); \
            _Pragma("unroll") for (int j = 0; j < 4; ++j) { const int c0 = lane * 4 + 256 * j; \
                XX[j] += *(const LAS f32x4*)(pvA + c0) * (YY[j] * rstd_y); \
                u32x2 xo; xo[0] = pk2(XX[j][0], XX[j][1]); xo[1] = pk2(XX[j][2], XX[j][3]); *(u32x2*)(Xout + (size_t)(RW) * D + c0) = xo; \
                XX[j] = (f32x4){bflo(xo[0]), bfhi(xo[0]), bflo(xo[1]), bfhi(xo[1])}; }     \
            const float rstd_x = rsqrtf(row_ss(XX) * (1.f / D) + EPS); \
            _Pragma("unroll") for (int j = 0; j < 4; ++j) { const int c0 = lane * 4 + 256 * j; \
                const f32x4 hv = XX[j] * rstd_x * *(const LAS f32x4*)(pvB + c0) + *(const LAS f32x4*)(pvS + c0); \
                *(unsigned*)(H8 + (size_t)(RW) * D + c0) = pk4_fp8(hv[0] * F8_SH, hv[1] * F8_SH, hv[2] * F8_SH, hv[3] * F8_SH); } \
            if (lane == 0) rsx[w * RP + (II)] = rstd_x; } while (0)
        PM_LOAD(row1, yn0, xn0); PM_LOAD(row1 + 1, yn1, xn1);
        for (int i = 0; i < RP; i += 2) {
            const int r = row1 + i;
#pragma unroll
            for (int j = 0; j < 4; ++j) { y0[j] = yn0[j]; x0[j] = xn0[j]; y1[j] = yn1[j]; x1[j] = xn1[j]; }
            if (i + 2 < RP) { PM_LOAD(r + 2, yn0, xn0); PM_LOAD(r + 3, yn1, xn1); }
            PM_ROW(r, y0, x0, i);
            PM_ROW(r + 1, y1, x1, i + 1);
        }
#undef PM_LOAD
#undef PM_ROW
        asm volatile("s_waitcnt vmcnt(0)" ::: "memory");
        __syncthreads();
        const int row0 = grp * GS + w * 16; const bool w2 = w < NW2;
        f32x4 la[2]; la[0] = (f32x4){0.f, 0.f, 0.f, 0.f}; la[1] = la[0];
        if (w2) {
            const bf16_t* ap = Xout + (size_t)(row0 + fr) * D + 8 * g;
            const LAS unsigned char* bp = c.lds + fr * RT_PITCH + 16 * g;
#pragma unroll 4
            for (int ks = 0; ks < 32; ++ks) {
                const bf16x8 av = *(const bf16x8*)(ap + 32 * ks);
#pragma unroll
                for (int nt = 0; nt < 2; ++nt) {
                    la[nt] = __builtin_amdgcn_mfma_f32_16x16x32_bf16(av, *(const LAS bf16x8*)(bp + (16 * nt) * RT_PITCH + 64 * ks), la[nt], 0, 0, 0);
                    la[nt] = __builtin_amdgcn_mfma_f32_16x16x32_bf16(av, *(const LAS bf16x8*)(bp + (32 + 16 * nt) * RT_PITCH + 64 * ks), la[nt], 0, 0, 0);
                }
            }
        }
        float tv[4][4]; int te[4][4];
#pragma unroll
        for (int e = 0; e < 4; ++e) {
            const float rs = rsx[(w2 ? w * 16 : 0) + 4 * g + e];
            float v0 = la[0][e] * rs + biasp[fr], v1 = la[1][e] * rs + biasp[16 + fr];
#pragma unroll
            for (int k = 0; k < 4; ++k) {
                float bv; int bi;
                if (v0 >= v1) { bv = v0; bi = fr; } else { bv = v1; bi = 16 + fr; }
#define PM_ROR(n) do { const float ov = __builtin_bit_cast(float, __builtin_amdgcn_update_dpp(0, __builtin_bit_cast(int, bv), 0x120 + (n), 0xf, 0xf, false)); \
                       const int oi = __builtin_amdgcn_update_dpp(0, bi, 0x120 + (n), 0xf, 0xf, false); \
                       if (ov > bv || (ov == bv && oi < bi)) { bv = ov; bi = oi; } } while (0)
                PM_ROR(8); PM_ROR(4); PM_ROR(2); PM_ROR(1);
#undef PM_ROR
                tv[e][k] = bv; te[e][k] = bi;
                if (bi == fr) v0 = -INFINITY;
                if (bi == 16 + fr) v1 = -INFINITY;
            }
        }
        float v[4]; int ex[4]; unsigned sl[4];
#pragma unroll
        for (int k = 0; k < 4; ++k) { v[k] = tv[0][k]; ex[k] = te[0][k];
#pragma unroll
            for (int e = 1; e < 4; ++e) if (fr == e) { v[k] = tv[e][k]; ex[k] = te[e][k]; } }
        if (fr < 4 && route && w2) {
#pragma unroll
            for (int k = 0; k < 4; ++k) sl[k] = __hip_atomic_fetch_add(lcnt + ex[k], 1u, __ATOMIC_RELAXED, __HIP_MEMORY_SCOPE_WORKGROUP);
        }
        __syncthreads();
        if (c.tid < NE && route) { const unsigned n = lcnt[c.tid]; lbase[c.tid] = n ? atomicAdd(&cnt[c.tid], n) : 0u; }
        __syncthreads();
        if (fr < 4 && route && w2) {
            const int r = row0 + 4 * g + fr;
            const float e1 = __expf(v[1] - v[0]), e2 = __expf(v[2] - v[0]), e3 = __expf(v[3] - v[0]);
            const float inv = 1.f / (1.f + e1 + e2 + e3);
            const float gk[4] = {inv, e1 * inv, e2 * inv, e3 * inv};
#pragma unroll
            for (int k = 0; k < 4; ++k) {
                const unsigned slot = lbase[ex[k]] + sl[k];
                list[(size_t)ex[k] * R + slot] = r;
                tk_e[r * 4 + k] = ex[k]; tk_g[r * 4 + k] = gk[k]; tk_slot[r * 4 + k] = (int)slot;
            }
        }
    }
}

__device__ __forceinline__ void moe_offsets(const Ctx& c, int layer, LAS int* so) {
    const unsigned* cnt = (const unsigned*)(c.ws + WS_CTL) + CW_CNT + layer * NE;
    __syncthreads();
    if (c.tid < 64) {
        const int n = c.tid < NE ? (int)cnt[c.tid] : 0; int pad = (n + PADM - 1) / PADM * PADM, inc = pad;
#pragma unroll
        for (int o = 1; o < 32; o <<= 1) { const int t = __shfl_up(inc, o); if (c.lane >= o) inc += t; }
        if (c.tid < NE) { so[c.tid] = inc - pad; so[64 + c.tid] = n; }
        if (c.tid == NE - 1) so[32] = inc;
    }
    __syncthreads();
}

__device__ __forceinline__ void moe_tables(const Ctx& c, int layer, LAS int* tb) {
    const unsigned* cnt = (const unsigned*)(c.ws + WS_CTL) + CW_CNT + layer * NE;
    __syncthreads();
    if (c.tid < 64) {
        const int n = c.tid < NE ? (int)cnt[c.tid] : 0; int tiles = (n + PADM - 1) / PADM, inc = tiles;
#pragma unroll
        for (int o = 1; o < 32; o <<= 1) { const int t = __shfl_up(inc, o); if (c.lane >= o) inc += t; }
        if (c.tid < NE) { tb[c.tid] = inc - tiles; tb[64 + c.tid] = n; }
        if (c.tid == NE - 1) tb[32] = inc;
    }
    __syncthreads();
}
__device__ __forceinline__ int vcu_of(const Ctx& c) { return (c.nwg % 8 == 0) ? (c.wg % 8) * (c.nwg / 8) + c.wg / 8 : c.wg; }
__device__ __forceinline__ void phase_moe_gu(const Ctx& c, int layer) {
    LAS int* tb = (LAS int*)(c.lds + 133184);
    moe_tables(c, layer, tb);
    pg8::Gemm g{c.ws + WS_H8, c.ws + WS_WGU + (size_t)layer * NE * 2048 * 1024, (size_t)2048 * 1024, (const int*)(c.ws + WS_LIST)};
    pg8::MoeOrder S{tb, tb + 64, 8, c.nwg, vcu_of(c), false};
    pg8::EpiSwiglu E{c.ws + WS_HDN, c.in(18) + (size_t)layer * NE * 2048};
    pg8::gemm_phase<pg8::EpiSwiglu, pg8::MoeOrder, true, true, true>(c.lds, g, S, E, c.tid);
}
__device__ __forceinline__ void phase_moe_dn(const Ctx& c, int layer) {
    LAS int* tb = (LAS int*)(c.lds + 133184);
    pg8::Gemm g{c.ws + WS_HDN, c.ws + WS_WDN + (size_t)layer * NE * 1024 * 1024, (size_t)1024 * 1024, nullptr};
    pg8::MoeOrder S{tb, tb + 64, 4, c.nwg, vcu_of(c), true};
    pg8::EpiBf16Bias E{c.ws + WS_OUTB, c.in(20) + (size_t)layer * NE * 1024, 1024, 1.f / (F8_SHD * F8_SW)};
    pg8::gemm_phase<pg8::EpiBf16Bias, pg8::MoeOrder, true, false, true>(c.lds, g, S, E, c.tid);
}
template <bool F8>
__device__ __forceinline__ void phase_gemm_f32(const Ctx& c, const unsigned char* A, int M, const unsigned char* Bt, int N, const float* bias, bf16_t* Cout) {
    pg8::Gemm g{A, Bt, 0, nullptr}; pg8::StaticOrder S; S.init(M, N, c.nwg, c.wg);
    pg8::EpiF32 E{Cout, N, bias, F8 ? 1.f / (F8_SH * F8_SW) : 1.f};
    pg8::gemm_phase<pg8::EpiF32, pg8::StaticOrder, true, false, F8>(c.lds, g, S, E, c.tid);
}

__device__ __forceinline__ void phase_gemm_qkv(const Ctx& c) {
    pg8::Gemm g{(const bf16_t*)(c.ws + WS_H), (const bf16_t*)(c.ws + WS_WQKV), 0, nullptr}; pg8::StaticOrder S; S.init(R, QKVD, c.nwg, c.wg);
    pg8::EpiQKV E{(bf16_t*)(c.ws + WS_Q), (bf16_t*)(c.ws + WS_K), (bf16_t*)(c.ws + WS_V), c.in(8), (const float*)(c.ws + WS_MOD) + MOD_ROPE};
    pg8::gemm_phase<pg8::EpiQKV, pg8::StaticOrder, true, false, false>(c.lds, g, S, E, c.tid);
}
__device__ __forceinline__ void phase_gemm_inproj(const Ctx& c) {
    pg8::Gemm g{c.ws + WS_H8, c.ws + WS_WIN, 0, nullptr}; pg8::StaticOrder S; S.init(R, HIN, c.nwg, c.wg);
    pg8::EpiInProj E{(bf16_t*)(c.ws + WS_QH), (_Float16*)(c.ws + WS_KF), (_Float16*)(c.ws + WS_KB), (bf16_t*)(c.ws + WS_IV), (bf16_t*)(c.ws + WS_SG), (const float*)(c.ws + WS_MOD) + MOD_LB, 1.f / (F8_SH * F8_SW)};
    pg8::gemm_phase<pg8::EpiInProj, pg8::StaticOrder, true, false, true>(c.lds, g, S, E, c.tid);
}

__device__ __forceinline__ void phase_norm0(const Ctx& c);
constexpr int CONV_A = 20 * 16 + 16 * 16 + 80 * 16 + 16 * 16, CONV_B = 32 * 32 * 16 + 32 * 16 * 16, CONV_CHUNK = 8;
__device__ __forceinline__ TBlk convert_item(const Ctx& c, int it, int part) {
    constexpr int I_QKV = 20 * 16, I_O = 16 * 16, I_IN = 80 * 16, I_HO = 16 * 16, I_GU = 32 * 32 * 16;
    int r = it; TBlk t; t.dst8 = nullptr; t.dst = nullptr; t.ws = F8_SW;
    if (part == 0) {
        if (r < I_QKV) { const int nb = r % 20, kb = r / 20; t.src = c.in(7) + (size_t)kb * 64 * QKVD + nb * 64; t.ldw = QKVD; t.dst = (bf16_t*)(c.ws + WS_WQKV) + (size_t)nb * 64 * 1024 + kb * 64; return t; } r -= I_QKV;
        if (r < I_O) { const int nb = r % 16, kb = r / 16; t.src = c.in(10) + (size_t)kb * 64 * D + nb * 64; t.ldw = D; if (FP8_OPROJ) t.dst8 = c.ws + WS_WO + (size_t)nb * 64 * 1024 + kb * 64; else t.dst = (bf16_t*)(c.ws + WS_WO) + (size_t)nb * 64 * 1024 + kb * 64; return t; } r -= I_O;
        if (r < I_IN) { const int nb = r % 80, kb = r / 80; t.src = c.in(11) + (size_t)kb * 64 * HIN + nb * 64; t.ldw = HIN; t.dst8 = c.ws + WS_WIN + (size_t)nb * 64 * 1024 + kb * 64; return t; } r -= I_IN;
        if (r < I_HO) { const int nb = r % 16, kb = r / 16; t.src = c.in(14) + (size_t)kb * 64 * D + nb * 64; t.ldw = D; if (FP8_HOPROJ) t.dst8 = c.ws + WS_WHO + (size_t)nb * 64 * 1024 + kb * 64; else t.dst = (bf16_t*)(c.ws + WS_WHO) + (size_t)nb * 64 * 1024 + kb * 64; return t; } r -= I_HO;
    }
    const int moff = (part - 1) * 32;
    if (r < I_GU) { const int mat = moff + r / 512, rr = r % 512, chk = rr >> 3, wi = rr & 7, nb = (chk & 7) * 4 + (wi >> 1), kb = (chk >> 3) * 2 + (wi & 1); const int n0 = ((nb & 3) >> 1) * 1024 + (nb >> 2) * 128 + (nb & 1) * 64;
        t.src = c.in(17) + (size_t)mat * 1024 * 2048 + (size_t)kb * 64 * 2048 + n0; t.ldw = 2048; if ((nb & 3) < 2) t.ws = F8_SW * GATE_C; t.dst8 = c.ws + WS_WGU + ((size_t)mat * 2048 + nb * 64) * 1024 + kb * 64; return t; } r -= I_GU;
    { const int mat = moff + r / 256, rr = r % 256, chk = rr >> 3, wi = rr & 7, nb = (chk & 3) * 4 + (wi >> 1), kb = (chk >> 2) * 2 + (wi & 1);
        t.src = c.in(19) + (size_t)mat * 1024 * 1024 + (size_t)kb * 64 * 1024 + nb * 64; t.ldw = 1024; t.dst8 = c.ws + WS_WDN + ((size_t)mat * 1024 + nb * 64) * 1024 + kb * 64; }
    return t;
}
__device__ __forceinline__ void convert_run(const Ctx& c, int part, int first, int step, int end, LAS float* scr) {
    f32x4 va[16], vb[16];
    int it = first;
    TBlk ta, tbk;
    if (it < end) { ta = convert_item(c, it, part); tb_load(ta, c.lane, va); }
    for (; it < end; it += 2 * step) {
        const bool hb = it + step < end;
        if (hb) { tbk = convert_item(c, it + step, part); tb_load(tbk, c.lane, vb); }
        tb_store(ta, c.lane, va, scr);
        const bool ha = it + 2 * step < end;
        if (ha) { ta = convert_item(c, it + 2 * step, part); tb_load(ta, c.lane, va); }
        if (hb) tb_store(tbk, c.lane, vb, scr);
    }
}
__device__ __forceinline__ void convert_steal(const Ctx& c, int part) {
    LAS float* scr = (LAS float*)c.lds + c.wave * (64 * 65);
    LAS int* chp = (LAS int*)(c.lds + 8 * 64 * 65 * 4);
    unsigned* ctr = (unsigned*)(c.ws + WS_CTL) + CW_CONV + 64 * part;
    __syncthreads();
    for (int it = 0;; ++it) {
        if (c.tid == 0) chp[it & 1] = (int)atomicAdd(ctr, 1u);
        asm volatile("s_waitcnt lgkmcnt(0)\n\ts_barrier" ::: "memory");
        const int ch = chp[it & 1];
        if (ch >= CONV_B / CONV_CHUNK) break;
        convert_run(c, part, ch * CONV_CHUNK + c.wave, 8, (ch + 1) * CONV_CHUNK, scr);
    }
    __syncthreads();
}
__device__ __forceinline__ void convert_steal_n(const Ctx& c, int part, int nmax) {
    LAS float* scr = (LAS float*)c.lds + c.wave * (64 * 65);
    LAS int* chp = (LAS int*)(c.lds + 8 * 64 * 65 * 4);
    unsigned* ctr = (unsigned*)(c.ws + WS_CTL) + CW_CONV + 64 * part;
    for (int n = 0; n < nmax; ++n) {
        __syncthreads();
        if (c.tid == 0) *chp = (int)atomicAdd(ctr, 1u);
        __syncthreads();
        const int ch = *chp;
        if (ch >= CONV_B / CONV_CHUNK) break;
        convert_run(c, part, ch * CONV_CHUNK + c.wave, 8, (ch + 1) * CONV_CHUNK, scr);
    }
    __syncthreads();
}
constexpr int CW_DONE = 3072;
__device__ __forceinline__ void convert_steal_until(const Ctx& c, int part, unsigned* done, unsigned need) {
    LAS float* scr = (LAS float*)c.lds + c.wave * (64 * 65);
    LAS int* chp = (LAS int*)(c.lds + 8 * 64 * 65 * 4);
    unsigned* ctr = (unsigned*)(c.ws + WS_CTL) + CW_CONV + 64 * part;
    __syncthreads();
    for (int it = 0;; ++it) {
        if (c.tid == 0) { const unsigned fin = __hip_atomic_load(done, __ATOMIC_RELAXED, __HIP_MEMORY_SCOPE_AGENT); chp[it & 1] = fin >= need ? 0x7fffffff : (int)atomicAdd(ctr, 1u); }
        asm volatile("s_waitcnt lgkmcnt(0)\n\ts_barrier" ::: "memory");
        const int ch = chp[it & 1];
        if (ch >= CONV_B / CONV_CHUNK) break;
        convert_run(c, part, ch * CONV_CHUNK + c.wave, 8, (ch + 1) * CONV_CHUNK, scr);
    }
    __syncthreads();
}
__device__ __forceinline__ void tail_steal(const Ctx& c, int part, int ntail, int k) {
    unsigned* done = (unsigned*)(c.ws + WS_CTL) + CW_DONE + 64 * k;
    if (c.wg < ntail && c.tid == 0) atomicAdd(done, 1u);
    convert_steal_until(c, part, done, (unsigned)ntail);
}
__device__ __forceinline__ void phase_convert(const Ctx& c) {
    LAS float* scr = (LAS float*)c.lds + c.wave * (64 * 65);
    convert_run(c, 0, c.wg * 8 + c.wave, c.nwg * 8, CONV_A, scr);
    __syncthreads();
    if (c.nwg != 256) router_tables(c, c.wg, c.nwg);
    __syncthreads();
    phase_norm0(c);
}

__device__ __forceinline__ void phase_combine(const Ctx& c, int layer) {
    const LAS int* tbl = (const LAS int*)(c.lds + 133184);
    const unsigned char* outb = c.ws + WS_OUTB; bf16_t* X = (bf16_t*)(c.ws + WS_X);
    const bf16_t* Xin = layer == 0 ? X : (const bf16_t*)(c.ws + WS_X1);
    const float* ngl = c.in(6) + layer * 4 * D;
    const int* tk_e = (const int*)(c.ws + WS_TK); const float* tk_g = (const float*)(c.ws + WS_TK) + R * 4; const int* tk_slot = (const int*)(c.ws + WS_TK) + 2 * R * 4;
    const int r_lo = layer == 0 ? 0 : C, stride = c.nwg * 8;
    LAS float* vl = (LAS float*)c.lds;
    for (int i = c.tid; i < 1024; i += 512) { const int p = ((i & 15) >> 2) * 256 + (i >> 4) * 4 + (i & 3);
        vl[p] = ngl[3 * D + i]; vl[2048 + p] = c.modp(layer, 0)[5120 + i];
        if (layer == 0) { vl[1024 + p] = (c.in(6) + 4 * D)[i]; vl[3072 + p] = c.modp(0, 1)[5120 + i];
            vl[4096 + p] = c.modp(1, 0)[i]; vl[5120 + p] = c.modp(1, 1)[i]; vl[6144 + p] = c.modp(1, 0)[1024 + i]; vl[7168 + p] = c.modp(1, 1)[1024 + i]; } }
    __syncthreads();
    int r = r_lo + c.wg * 8 + c.wave;
    if (r >= R) return;
    const int r0 = r;
    struct TK { int e[4], s[4]; float g[4]; };
    struct DT { u32x4 w[4]; u32x4 x[2]; float g[4]; };
    TK ta, tb, tx; DT d0a, d0b, d1a, d1b, dx;
    const bool hasx = c.nwg == 256 && r0 + 8 * stride < R;
    const int Rl = hasx ? r0 + 8 * stride : R;
#define CB_RC(row) ((row) < Rl ? (row) : r0)
#define CB_TK(T, row) do { const int rw_ = (row); _Pragma("unroll") for (int k = 0; k < 4; ++k) { T.e[k] = tk_e[rw_ * 4 + k]; T.s[k] = tk_slot[rw_ * 4 + k]; T.g[k] = tk_g[rw_ * 4 + k]; } } while (0)
#define CB_DATA(DD, T, row) CB_DATAX(DD, T, CB_RC(row), (row) < Rl)
#define CB_DATAX(DD, T, row, ok) do { const int rw_ = (row); const int lo_ = (ok) ? c.lane * 16 : 0;     \
        _Pragma("unroll") for (int k = 0; k < 4; ++k) { const unsigned char* src_ = outb + (size_t)(tbl[T.e[k]] * PADM + T.s[k]) * 1024; DD.g[k] = T.g[k] * (1.f / F8_SO); \
        DD.w[k] = *(const u32x4*)(src_ + lo_); } DD.x[0] = *(const u32x4*)(Xin + (size_t)rw_ * D + lo_); DD.x[1] = *(const u32x4*)(Xin + (size_t)rw_ * D + lo_ + 8); } while (0)
#define CB_ROW(DD, rr) do { const int r_ = (rr); \
        const int vo_ = r_ < C ? 1024 : 0; \
        f32x4 y[4], x[4]; \
        _Pragma("unroll") for (int j = 0; j < 4; ++j) { y[j] = (f32x4){0.f, 0.f, 0.f, 0.f}; const unsigned xa = DD.x[j >> 1][2 * (j & 1)], xb = DD.x[j >> 1][2 * (j & 1) + 1]; x[j] = (f32x4){bflo(xa), bfhi(xa), bflo(xb), bfhi(xb)}; } \
        _Pragma("unroll") for (int k = 0; k < 4; ++k) _Pragma("unroll") for (int j = 0; j < 4; ++j) { \
            const f32x2 lo = __builtin_amdgcn_cvt_pk_f32_fp8((int)DD.w[k][j], false), hi = __builtin_amdgcn_cvt_pk_f32_fp8((int)DD.w[k][j], true); y[j] += (f32x4){lo[0], lo[1], hi[0], hi[1]} * DD.g[k]; } \
        const float rstd_y = rsqrtf(row_ss(y) * (1.f / D) + EPS); \
        u32x4 xs[2]; \
        _Pragma("unroll") for (int j = 0; j < 4; ++j) { const int c0 = c.lane * 16 + 4 * j; \
            const f32x4 g2 = *(const LAS f32x4*)(vl + 2048 + vo_ + 256 * j + 4 * c.lane), n3 = *(const LAS f32x4*)(vl + 256 * j + 4 * c.lane); \
            x[j] += g2 * (y[j] * rstd_y * n3); \
            if (layer == 0) { const unsigned p0 = pk2(x[j][0], x[j][1]), p1 = pk2(x[j][2], x[j][3]); xs[j >> 1][2 * (j & 1)] = p0; xs[j >> 1][2 * (j & 1) + 1] = p1; x[j] = (f32x4){bflo(p0), bfhi(p0), bflo(p1), bfhi(p1)}; } \
            else *(f32x4*)(c.outp() + (size_t)(r_ - C) * D + c0) = x[j]; } \
        if (layer == 0) { \
            *(u32x4*)(X + (size_t)r_ * D + c.lane * 16) = xs[0]; *(u32x4*)(X + (size_t)r_ * D + c.lane * 16 + 8) = xs[1]; \
            const float rstd_x = rsqrtf(row_ss(x) * (1.f / D) + EPS); \
            u32x4 hs; \
            _Pragma("unroll") for (int j = 0; j < 4; ++j) { const int c0 = c.lane * 16 + 4 * j; \
                const f32x4 gv = *(const LAS f32x4*)(vl + 1024 + 256 * j + 4 * c.lane), shv = *(const LAS f32x4*)(vl + 4096 + vo_ + 256 * j + 4 * c.lane), scv = *(const LAS f32x4*)(vl + 6144 + vo_ + 256 * j + 4 * c.lane); \
                const f32x4 hv = x[j] * rstd_x * gv * (scv + 1.f) + shv; \
                hs[j] = pk4_fp8(hv[0] * F8_SH, hv[1] * F8_SH, hv[2] * F8_SH, hv[3] * F8_SH); } \
            *(u32x4*)(c.ws + WS_H8 + (size_t)r_ * D + c.lane * 16) = hs; } } while (0)
    CB_TK(ta, r); CB_TK(tb, CB_RC(r + stride)); if (hasx) CB_TK(tx, r0 + 8 * stride);
    CB_DATA(d0a, ta, r); CB_DATA(d0b, tb, r + stride); if (hasx) CB_DATAX(dx, tx, r0 + 8 * stride, true);
    CB_TK(ta, CB_RC(r + 2 * stride)); CB_TK(tb, CB_RC(r + 3 * stride));
    CB_DATA(d1a, ta, r + 2 * stride); CB_DATA(d1b, tb, r + 3 * stride);
    CB_TK(ta, CB_RC(r + 4 * stride)); CB_TK(tb, CB_RC(r + 5 * stride));
    if (hasx) CB_ROW(dx, r0 + 8 * stride);
    for (;;) {
        CB_ROW(d0a, r); if (r + stride < Rl) CB_ROW(d0b, r + stride);
        r += 2 * stride; if (r >= Rl) break;
        CB_DATA(d0a, ta, r + 2 * stride); CB_DATA(d0b, tb, r + 3 * stride);
        CB_TK(ta, CB_RC(r + 4 * stride)); CB_TK(tb, CB_RC(r + 5 * stride));
        CB_ROW(d1a, r); if (r + stride < Rl) CB_ROW(d1b, r + stride);
        r += 2 * stride; if (r >= Rl) break;
        CB_DATA(d1a, ta, r + 2 * stride); CB_DATA(d1b, tb, r + 3 * stride);
        CB_TK(ta, CB_RC(r + 4 * stride)); CB_TK(tb, CB_RC(r + 5 * stride));
    }
#undef CB_RC
#undef CB_ROW
#undef CB_TK
#undef CB_DATA
#undef CB_DATAX
}

namespace hg {
typedef _Float16 h2_t __attribute__((ext_vector_type(2)));
constexpr int TB = 272, PB = 144;
constexpr int TILE = 64 * TB;
constexpr int T_QD = 0, T_QC = TILE, T_KD = 2 * TILE, T_KE = 3 * TILE, T_KC = 4 * TILE, T_V0 = 5 * TILE, T_V1 = 6 * TILE;
constexpr int T_QL1 = 7 * TILE, T_KL1 = T_QL1 + 16 * TB, T_P = T_KL1 + 16 * TB, T_TOT = T_P + 64 * PB, T_CT = T_TOT + 4096, T_END = T_CT + 512;
static_assert(T_END <= LDS_BYTES - 64, "hgrn scan LDS map");
__device__ __forceinline__ int row_of(int dir, int p) { return p < C ? (dir ? C - 1 - p : p) : (dir ? C + (L - 1 - (p - C)) : p); }
__device__ __forceinline__ int seg_of(int ch) { return ch < 68 ? ch / 17 : 4 + (ch - 68) / 16; }
__device__ __forceinline__ bf16x8 tr_frag(const LAS unsigned char* tile, int row0, int col0, int lane) {
    const int q = (lane & 15) >> 2, p = lane & 3;
    const LAS unsigned char* a = tile + (row0 + q) * TB + (col0 + 4 * p) * 2;
    const v4i16_t lo = __builtin_amdgcn_ds_read_tr16_b64_v4i16((LAS v4i16_t*)a);
    const v4i16_t hi = __builtin_amdgcn_ds_read_tr16_b64_v4i16((LAS v4i16_t*)(a + 4 * TB));
    return (bf16x8){lo[0], lo[1], lo[2], lo[3], hi[0], hi[1], hi[2], hi[3]};
}
}

__device__ __forceinline__ void phase_hgrn_scan(const Ctx& c) {
    using namespace hg;
#define HG_BAR() asm volatile("s_waitcnt lgkmcnt(0)\n\ts_barrier" ::: "memory")
    const bf16_t* QH = (const bf16_t*)(c.ws + WS_QH); const bf16_t* IV = (const bf16_t*)(c.ws + WS_IV);
    LAS unsigned char* lds = c.lds;
    const int tid = c.tid, lane = c.lane, w = __builtin_amdgcn_readfirstlane(tid >> 6), fr = lane & 15, g = lane >> 4;
    for (int item_ = c.wg; item_ < 256 * SCAN_REP; item_ += c.nwg) {
        const int item = item_ & 255;
        const int chain = item >> 4, seg = item & 15, head = chain >> 1, dir = chain & 1, hc = head * 128;
        const int c0 = seg < 4 ? 17 * seg : 68 + 16 * (seg - 4), nch = seg < 4 ? 17 : 16;
        const _Float16* KX = (const _Float16*)(c.ws + (dir ? WS_KB : WS_KF));
        bf16_t* OL = (bf16_t*)(c.ws + (dir ? WS_OB : WS_OF)); bf16_t* QS = (bf16_t*)(c.ws + (dir ? WS_QSB : WS_QSF));
        HG_BAR();
        for (int i = tid; i < 64 * PB / 4; i += 512) ((LAS unsigned*)(lds + T_P))[i] = 0u;
        f32x4 Sacc[8];
#pragma unroll
        for (int m = 0; m < 8; ++m) Sacc[m] = (f32x4){0.f, 0.f, 0.f, 0.f};
        float dseg0 = 1.f, dseg1 = 1.f;
        unsigned kraw[8], qraw[8]; u32x4 vraw[2];
#define HG_LOAD(cidx) do { const int p0_ = 64 * (cidx); const bool lat_ = (cidx) >= 4; \
        _Pragma("unroll") for (int i = 0; i < 8; ++i) { const int r_ = row_of(dir, p0_ + 8 * w + i); \
            kraw[i] = *(const unsigned*)(KX + (size_t)r_ * D + hc + 2 * lane); \
            qraw[i] = lat_ ? *(const unsigned*)(QH + (size_t)(r_ - C) * D + hc + 2 * lane) : 0u; } \
        _Pragma("unroll") for (int i = 0; i < 2; ++i) { const int idx_ = tid + 512 * i; const int r_ = row_of(dir, p0_ + (idx_ >> 4)); \
            vraw[i] = *(const u32x4*)(IV + (size_t)r_ * D + hc + (idx_ & 15) * 8); } } while (0)
        HG_LOAD(c0);
        u32x2 olq[4];
#pragma unroll
        for (int m = 0; m < 4; ++m) olq[m] = (u32x2){0u, 0u};
#define HG_OLSTORE(cx) do { _Pragma("unroll") for (int m = 0; m < 4; ++m) { const int r_ = row_of(dir, 64 * (cx) + 16 * m + fr); *(u32x2*)(OL + (size_t)(r_ - C) * D + hc + 16 * w + 4 * g) = olq[m]; } } while (0)
        for (int ci = 0; ci < nch; ++ci) {
            const int cidx = c0 + ci; const bool lat = cidx >= 4;
            const int vbuf = (ci & 1) ? T_V1 : T_V0;
            float kf[8][2], qf[8][2], cp[8][2];
            {
                float p0 = 1.f, p1 = 1.f;
#pragma unroll
                for (int i = 0; i < 8; ++i) {
                    const h2_t hv = __builtin_bit_cast(h2_t, kraw[i]);
                    kf[i][0] = (float)hv[0]; kf[i][1] = (float)hv[1];
                    qf[i][0] = bflo(qraw[i]); qf[i][1] = bfhi(qraw[i]);
                    p0 *= (1.f - kf[i][0]); p1 *= (1.f - kf[i][1]); cp[i][0] = p0; cp[i][1] = p1;
                }
                *(LAS f32x2*)(lds + T_TOT + (w * 128 + 2 * lane) * 4) = (f32x2){p0, p1};
#pragma unroll
                for (int i = 0; i < 2; ++i) { const int idx = tid + 512 * i; *(LAS u32x4*)(lds + vbuf + (idx >> 4) * TB + (idx & 15) * 16) = vraw[i]; }
            }
            HG_BAR();
            {
                f32x2 T[8];
#pragma unroll
                for (int x = 0; x < 8; ++x) T[x] = *(const LAS f32x2*)(lds + T_TOT + (x * 128 + 2 * lane) * 4);
                const int I = w >> 1, hh = w & 1;
                f32x2 bd[4];
#pragma unroll
                for (int x = 0; x < 4; ++x) bd[x] = T[2 * x] * T[2 * x + 1];
                f32x2 pre = (f32x2){1.f, 1.f}, cum = (f32x2){1.f, 1.f}, suf = (f32x2){1.f, 1.f}, bdI = (f32x2){1.f, 1.f};
#pragma unroll
                for (int x = 0; x < 8; ++x) if (hh && x == w - 1) pre = T[x];
#pragma unroll
                for (int x = 0; x < 4; ++x) { if (x < I) cum = cum * bd[x]; if (x > I) suf = suf * bd[x]; if (x == I) bdI = bd[x]; }
                const f32x2 ctot = (bd[0] * bd[1]) * (bd[2] * bd[3]);
#pragma unroll
                for (int i = 0; i < 8; ++i) {
                    const int tau = 8 * w + i;
                    float QDv[2], KDv[2], KEv[2], QCv[2], KCv[2];
#pragma unroll
                    for (int x = 0; x < 2; ++x) {
                        const float eq = pre[x] * cp[i][x], rc = __builtin_amdgcn_rcpf(eq);
                        QDv[x] = qf[i][x] * eq; KDv[x] = kf[i][x] * rc; KEv[x] = KDv[x] * bdI[x]; QCv[x] = QDv[x] * cum[x]; KCv[x] = KEv[x] * suf[x];
                    }
                    const int to = tau * TB + lane * 4;
                    *(LAS unsigned*)(lds + T_QD + to) = pk2(QDv[0], QDv[1]);
                    *(LAS unsigned*)(lds + T_KD + to) = pk2(KDv[0], KDv[1]);
                    *(LAS unsigned*)(lds + T_KE + to) = pk2(KEv[0], KEv[1]);
                    *(LAS unsigned*)(lds + T_QC + to) = pk2(QCv[0], QCv[1]);
                    *(LAS unsigned*)(lds + T_KC + to) = pk2(KCv[0], KCv[1]);
                    if (I == 3) *(LAS unsigned*)(lds + T_QL1 + (tau - 48) * TB + lane * 4) = pk2(QDv[0] * bd[2][0], QDv[1] * bd[2][1]);
                    if (I == 0) *(LAS unsigned*)(lds + T_KL1 + tau * TB + lane * 4) = pk2(KEv[0] * bd[1][0], KEv[1] * bd[1][1]);
                    if (lat) { const int r = row_of(dir, 64 * cidx + tau); *(unsigned*)(QS + (size_t)(r - C) * D + hc + 2 * lane) = pk2(QCv[0] * dseg0, QCv[1] * dseg1); }
                }
                dseg0 *= ctot[0]; dseg1 *= ctot[1];
                if (w == 0) *(LAS f32x2*)(lds + T_CT + lane * 8) = ctot;
            }
            HG_BAR();
            if (ci > 0 && cidx - 1 >= 4) HG_OLSTORE(cidx - 1);
            if (ci + 1 < nch) HG_LOAD(cidx + 1);
            if (lat) {
                const int nblk = w >= 6 ? 2 : 1;
                for (int b = 0; b < nblk; ++b) {
                    int I, J, qoff, qrow, koff, krow; bool diag = false;
                    if (w < 4) { I = 2 + (w >> 1); J = w & 1; qoff = (w >> 1) ? T_QL1 : T_QD; qrow = (w >> 1) ? 0 : 32; koff = (w & 1) ? T_KE : T_KL1; krow = (w & 1) ? 16 : 0; }
                    else if (w == 4) { I = 1; J = 0; qoff = T_QD; qrow = 16; koff = T_KE; krow = 0; }
                    else if (w == 5) { I = 3; J = 2; qoff = T_QD; qrow = 48; koff = T_KE; krow = 32; }
                    else { I = 2 * (w - 6) + b; J = I; qoff = T_QD; qrow = 16 * I; koff = T_KD; krow = 16 * I; diag = true; }
                    f32x4 pa = (f32x4){0.f, 0.f, 0.f, 0.f};
#pragma unroll
                    for (int ks = 0; ks < 4; ++ks) {
                        const bf16x8 av = *(const LAS bf16x8*)(lds + qoff + (qrow + fr) * TB + (32 * ks + 8 * g) * 2);
                        const bf16x8 bv = *(const LAS bf16x8*)(lds + koff + (krow + fr) * TB + (32 * ks + 8 * g) * 2);
                        pa = __builtin_amdgcn_mfma_f32_16x16x32_bf16(av, bv, pa, 0, 0, 0);
                    }
#pragma unroll
                    for (int e = 0; e < 4; ++e) {
                        const int tl = 4 * g + e; const float val = (diag && fr > tl) ? 0.f : pa[e];
                        *(LAS bf16_t*)(lds + T_P + (16 * I + tl) * PB + (16 * J + fr) * 2) = (bf16_t)f2bf(val);
                    }
                }
            }
            f32x4 oacc[4];
#pragma unroll
            for (int m = 0; m < 4; ++m) oacc[m] = (f32x4){0.f, 0.f, 0.f, 0.f};
            if (lat) {
                bf16x8 Sb[4];
#pragma unroll
                for (int ks = 0; ks < 4; ++ks) {
                    const f32x4 a0 = Sacc[2 * ks], a1 = Sacc[2 * ks + 1];
                    const u32x4 pk = (u32x4){pk2(a0[0], a0[1]), pk2(a0[2], a0[3]), pk2(a1[0], a1[1]), pk2(a1[2], a1[3])};
                    Sb[ks] = __builtin_bit_cast(bf16x8, pk);
                }
#pragma unroll
                for (int m = 0; m < 4; ++m)
#pragma unroll
                    for (int ks = 0; ks < 4; ++ks) {
                        const u32x2 lo = *(const LAS u32x2*)(lds + T_QC + (16 * m + fr) * TB + (32 * ks + 4 * g) * 2);
                        const u32x2 hi = *(const LAS u32x2*)(lds + T_QC + (16 * m + fr) * TB + (32 * ks + 16 + 4 * g) * 2);
                        const u32x4 pk = (u32x4){lo.x, lo.y, hi.x, hi.y};
                        oacc[m] = __builtin_amdgcn_mfma_f32_16x16x32_bf16(Sb[ks], __builtin_bit_cast(bf16x8, pk), oacc[m], 0, 0, 0);
                    }
            }
#pragma unroll
            for (int m = 0; m < 8; ++m) { const f32x4 ct = *(const LAS f32x4*)(lds + T_CT + (16 * m + 4 * g) * 4); Sacc[m] = Sacc[m] * ct; }
            bf16x8 Vf[2];
#pragma unroll
            for (int ks = 0; ks < 2; ++ks) Vf[ks] = tr_frag(lds + vbuf, 32 * ks + 8 * g, 16 * w, lane);
#pragma unroll
            for (int m = 0; m < 8; ++m)
#pragma unroll
                for (int ks = 0; ks < 2; ++ks) Sacc[m] = __builtin_amdgcn_mfma_f32_16x16x32_bf16(tr_frag(lds + T_KC, 32 * ks + 8 * g, 16 * m, lane), Vf[ks], Sacc[m], 0, 0, 0);
            HG_BAR();
            if (lat) {
#pragma unroll
                for (int m = 0; m < 4; ++m)
#pragma unroll
                    for (int ks = 0; ks < 2; ++ks) {
                        if (m < 2 && ks == 1) continue;
                        const bf16x8 av = *(const LAS bf16x8*)(lds + T_P + (16 * m + fr) * PB + (32 * ks + 8 * g) * 2);
                        oacc[m] = __builtin_amdgcn_mfma_f32_16x16x32_bf16(Vf[ks], av, oacc[m], 0, 0, 0);
                    }
#pragma unroll
                for (int m = 0; m < 4; ++m) { olq[m].x = pk2(oacc[m][0], oacc[m][1]); olq[m].y = pk2(oacc[m][2], oacc[m][3]); }
            }
        }
        if (c0 + nch - 1 >= 4) HG_OLSTORE(c0 + nch - 1);
#undef HG_OLSTORE
#undef HG_LOAD
        float* DS = (float*)(c.ws + WS_DS) + (size_t)item * 16384; float* DG = (float*)(c.ws + WS_DG) + item * 128;
#pragma unroll
        for (int m = 0; m < 8; ++m) *(f32x4*)(DS + (16 * w + fr) * 128 + 16 * m + 4 * g) = Sacc[m];
        if (w == 0) { DG[2 * lane] = dseg0; DG[2 * lane + 1] = dseg1; }
    }
}

#undef HG_BAR
__device__ __forceinline__ void phase_hgrn_fold(const Ctx& c) {
    const float* DS = (const float*)(c.ws + WS_DS); const float* DG = (const float*)(c.ws + WS_DG); bf16_t* SST = (bf16_t*)(c.ws + WS_SST);
    for (int item = c.wg; item < 256; item += c.nwg) {
        const int chain = item >> 4, slice = item & 15, v = 8 * slice + (c.tid >> 6), d2 = (c.tid & 63) * 2;
        float s0 = 0.f, s1 = 0.f;
        f32x2 dv[15], ds[15];
#pragma unroll
        for (int sgi = 0; sgi < 15; ++sgi) { dv[sgi] = *(const f32x2*)(DG + (chain * 16 + sgi) * 128 + d2); ds[sgi] = *(const f32x2*)(DS + ((size_t)(chain * 16 + sgi) * 128 + v) * 128 + d2); }
        *(unsigned*)(SST + ((size_t)(chain * 16) * 128 + v) * 128 + d2) = 0u;
#pragma unroll
        for (int sgi = 0; sgi < 15; ++sgi) {
            s0 = dv[sgi][0] * s0 + ds[sgi][0]; s1 = dv[sgi][1] * s1 + ds[sgi][1];
            *(unsigned*)(SST + ((size_t)(chain * 16 + sgi + 1) * 128 + v) * 128 + d2) = pk2(s0, s1);
        }
    }
}

__device__ __forceinline__ void phase_hgrn_readout(const Ctx& c) {
    constexpr int SP = 272, SBUF = 128 * SP, IBUF = 2 * SBUF;
    static_assert(2 * IBUF + 1024 + 4096 <= LDS_BYTES - 64, "readout LDS map");
    const bf16_t* OF = (const bf16_t*)(c.ws + WS_OF); const bf16_t* OB = (const bf16_t*)(c.ws + WS_OB); const bf16_t* SGp = (const bf16_t*)(c.ws + WS_SG);
    const bf16_t* SST = (const bf16_t*)(c.ws + WS_SST); unsigned char* RR = c.ws + WS_RR; const float* hng = c.in(13);
    LAS unsigned char* lds = c.lds; LAS float* ssx = (LAS float*)(c.lds + 2 * IBUF);
    LAS float* hngl = (LAS float*)(c.lds + 2 * IBUF + 1024);
    const int tid = c.tid, lane = c.lane, w = __builtin_amdgcn_readfirstlane(tid >> 6), fr = lane & 15, g = lane >> 4, mt = w & 3, nh = w >> 2;
#define RO_BAR() asm volatile("s_waitcnt lgkmcnt(0)\n\ts_barrier" ::: "memory")
    u32x4 sreg[8];
#define RO_H(q) ((c.nwg == 256) ? ((q) & 255) >> 5 : (q) >> 8)
#define RO_CH(q) ((c.nwg == 256) ? (((q) & 31) << 3) + ((q) >> 8) : (q) & 255)
#define RO_SST_LOAD(it) do { const int h_ = RO_H(it), ch_ = RO_CH(it); \
        _Pragma("unroll") for (int j = 0; j < 8; ++j) { const int idx_ = tid + 512 * j, dx_ = idx_ >> 11, rem_ = idx_ & 2047; \
            const int sg_ = hg::seg_of(dx_ ? 4 + 255 - ch_ : 4 + ch_); \
            sreg[j] = *(const GAS u32x4*)(SST + ((size_t)((h_ * 2 + dx_) * 16 + sg_) * 128 + (rem_ >> 4)) * 128 + (rem_ & 15) * 8); } } while (0)
#define RO_SST_WRITE(buf) do { _Pragma("unroll") for (int j = 0; j < 8; ++j) { const int idx_ = tid + 512 * j, dx_ = idx_ >> 11, rem_ = idx_ & 2047; \
            *(LAS u32x4*)(lds + (buf) * IBUF + dx_ * SBUF + (rem_ >> 4) * SP + (rem_ & 15) * 16) = sreg[j]; } } while (0)
    int it = c.wg;
    u32x4 ra0[2], rb0[2], rg0[2], ra1[2], rb1[2], rg1[2]; bf16x8 rq0[2][4], rq1[2][4];
#define RO_IN_LOAD_A(itx, RA, RB, RG) do { const int h_ = RO_H(itx), t0_ = 64 * RO_CH(itx) + 16 * mt; \
        _Pragma("unroll") for (int j = 0; j < 2; ++j) { const size_t o_ = ro_ok ? (size_t)(t0_ + fr) * D + h_ * 128 + 64 * nh + 32 * j + 8 * g : (size_t)0;     \
            RA[j] = *(const GAS u32x4*)(OF + o_); RB[j] = *(const GAS u32x4*)(OB + o_); RG[j] = *(const GAS u32x4*)(SGp + o_); } } while (0)
#define RO_IN_LOAD_Q(itx, RQ) do { const int h_ = RO_H(itx), t0_ = 64 * RO_CH(itx) + 16 * mt; \
        _Pragma("unroll") for (int dx = 0; dx < 2; ++dx) { const bf16_t* QS_ = (const bf16_t*)(c.ws + (dx ? WS_QSB : WS_QSF)) + (ro_ok ? (size_t)(t0_ + fr) * D + h_ * 128 + 8 * g : (size_t)0); \
            _Pragma("unroll") for (int ks = 0; ks < 4; ++ks) RQ[dx][ks] = *(const GAS bf16x8*)(QS_ + 32 * ks); } } while (0)
#define RO_IN_LOAD(itx, RA, RB, RG, RQ) do { RO_IN_LOAD_A(itx, RA, RB, RG); RO_IN_LOAD_Q(itx, RQ); } while (0)
    RO_BAR();
    if (c.tid < 256) *(LAS f32x4*)(hngl + 4 * c.tid) = *(const GAS f32x4*)(hng + 4 * c.tid);
    if (it < 2048) { const bool ro_ok = true; RO_SST_LOAD(it); RO_SST_WRITE(0); RO_IN_LOAD(it, ra0, rb0, rg0, rq0); }
    { const bool ro_ok = it + c.nwg < 2048; const int it1 = ro_ok ? it + c.nwg : (it < 2048 ? it : 0); RO_IN_LOAD(it1, ra1, rb1, rg1, rq1); }
    RO_BAR();
    int buf = 0, k = 0;
#define RO_BODY(RA, RB, RG, RQ) do { \
        const int h = RO_H(it), ch = RO_CH(it), t0 = 64 * ch + 16 * mt; \
        const bool has_next = it + c.nwg < 2048, has_next2 = it + 2 * c.nwg < 2048; \
          \
        const int hn = RO_H(it + c.nwg), chn = RO_CH(it + c.nwg); \
        const bool reload = has_next && (hn != h || hg::seg_of(4 + chn) != hg::seg_of(4 + ch) || hg::seg_of(4 + 255 - chn) != hg::seg_of(4 + 255 - ch)); \
        f32x4 acc[4]; u32x4 gsv[2];                              \
        _Pragma("unroll") for (int n = 0; n < 4; ++n) { const unsigned a0_ = RA[n >> 1][2 * (n & 1)], a1_ = RA[n >> 1][2 * (n & 1) + 1], b0_ = RB[n >> 1][2 * (n & 1)], b1_ = RB[n >> 1][2 * (n & 1) + 1]; \
            acc[n] = (f32x4){bflo(a0_) + bflo(b0_), bfhi(a0_) + bfhi(b0_), bflo(a1_) + bflo(b1_), bfhi(a1_) + bfhi(b1_)}; } \
        gsv[0] = RG[0]; gsv[1] = RG[1]; \
        if (reload) RO_SST_LOAD(it + c.nwg); \
        const bool ro_ok = has_next2; const int itp = has_next2 ? it + 2 * c.nwg : it;          \
        RO_IN_LOAD_A(itp, RA, RB, RG); \
        _Pragma("unroll") for (int dx = 0; dx < 2; ++dx) { \
            const LAS unsigned char* sb = lds + buf * IBUF + dx * SBUF + (64 * nh + 8 * (fr >> 2) + (fr & 3)) * SP + 16 * g;     \
            _Pragma("unroll") for (int ks = 0; ks < 4; ++ks) { \
                _Pragma("unroll") for (int n = 0; n < 4; ++n) acc[n] = __builtin_amdgcn_mfma_f32_16x16x32_bf16(*(const LAS bf16x8*)(sb + (32 * (n >> 1) + 4 * (n & 1)) * SP + 64 * ks), RQ[dx][ks], acc[n], 0, 0, 0); } } \
        RO_IN_LOAD_Q(itp, RQ);         \
        float ss = 0.f; \
        _Pragma("unroll") for (int n = 0; n < 4; ++n) ss += acc[n][0] * acc[n][0] + acc[n][1] * acc[n][1] + acc[n][2] * acc[n][2] + acc[n][3] * acc[n][3]; \
        ss = xadd32(xadd16(ss));                                     \
        if (g == 0) ssx[((k & 1) * 8 + w) * 16 + fr] = ss; \
        if (reload) RO_SST_WRITE(buf ^ 1); \
        RO_BAR(); \
        const float rstd = rsqrtf((ss + ssx[((k & 1) * 8 + (w ^ 4)) * 16 + fr]) * (1.f / 128.f) + EPS); \
        _Pragma("unroll") for (int j = 0; j < 2; ++j) { f32x4 vv[2]; \
            _Pragma("unroll") for (int i = 0; i < 2; ++i) { const int n = 2 * j + i; \
                const f32x4 gn = *(const LAS f32x4*)(hngl + h * 128 + 64 * nh + 32 * j + 8 * g + 4 * i); const unsigned g0_ = gsv[j][2 * i], g1_ = gsv[j][2 * i + 1]; \
                vv[i] = acc[n] * (rstd * (FP8_HOPROJ ? F8_SH : 1.f)) * ((f32x4){bflo(g0_), bfhi(g0_), bflo(g1_), bfhi(g1_)} * gn); } \
            const size_t ro_ = (size_t)(t0 + fr) * D + h * 128 + 64 * nh + 32 * j + 8 * g; \
            if (FP8_HOPROJ) { u32x2 o; o.x = pk4_fp8(vv[0][0], vv[0][1], vv[0][2], vv[0][3]); o.y = pk4_fp8(vv[1][0], vv[1][1], vv[1][2], vv[1][3]); *(GAS u32x2*)(RR + ro_) = o; } \
            else { u32x4 o; o.x = pk2(vv[0][0], vv[0][1]); o.y = pk2(vv[0][2], vv[0][3]); o.z = pk2(vv[1][0], vv[1][1]); o.w = pk2(vv[1][2], vv[1][3]); *(GAS u32x4*)((bf16_t*)RR + ro_) = o; } } \
        if (reload) buf ^= 1; } while (0)
    while (it < 2048) {
        RO_BODY(ra0, rb0, rg0, rq0);
        it += c.nwg; ++k;
        if (it >= 2048) break;
        RO_BODY(ra1, rb1, rg1, rq1);
        it += c.nwg; ++k;
    }
#undef RO_BODY
    RO_BAR();
#undef RO_BAR
#undef RO_SST_LOAD
#undef RO_SST_WRITE
#undef RO_H
#undef RO_CH
#undef RO_IN_LOAD
#undef RO_IN_LOAD_A
#undef RO_IN_LOAD_Q
}

#define XB_TMO      128
#define XB_XCNT(j)  (256  + 64 * (j))
#define XB_XSUB(j)  (1280 + 64 * (j))
#define XB_XGEN(j)  (2304 + 64 * (j))
#define XB_TOP      3328
#define XB_TOPGEN   3392
#define XCD_BAR_WORDS 3456
static_assert(CW_BAR + XCD_BAR_WORDS <= 8192, "control words inside the 32 KiB that kernel_launch zeroes");
#define XB_SPIN_CAP (1u << 18)
__device__ __forceinline__ unsigned xb_ld(unsigned* p)              { return __hip_atomic_load(p, __ATOMIC_RELAXED, __HIP_MEMORY_SCOPE_AGENT); }
__device__ __forceinline__ unsigned xb_add(unsigned* p, unsigned v) { return __hip_atomic_fetch_add(p, v, __ATOMIC_RELAXED, __HIP_MEMORY_SCOPE_AGENT); }
__device__ __forceinline__ unsigned xb_xcc_id() { return (unsigned)__builtin_amdgcn_s_getreg((3 << 11) | 20) & 0xFu; }
#define XB_SPIN(cond, bar) do { unsigned _sp = 0; while (cond) { __builtin_amdgcn_s_sleep(1); \
    if ((++_sp & 255u) == 0u) { if (xb_ld(&(bar)[XB_TMO])) break; if (_sp > XB_SPIN_CAP) { atomicAdd(&(bar)[XB_TMO], 1u); break; } } } } while (0)
struct XcdBarrier { unsigned* bar; unsigned x; volatile LAS unsigned* st; };
__device__ __forceinline__ XcdBarrier xcd_barrier_post(unsigned* bar, volatile LAS unsigned* st) {
    XcdBarrier b; b.bar = bar; b.x = xb_xcc_id(); b.st = st;
    if (threadIdx.x == 0) (void)xb_add(&bar[XB_XCNT(b.x)], 1u);
    return b;
}
__device__ __forceinline__ void xcd_barrier_complete(unsigned* bar, unsigned x, unsigned& nloc, unsigned& nx) {
    const unsigned G = gridDim.x * gridDim.y * gridDim.z;
    unsigned sum, cnt, mine, sp = 0u;
    for (;;) {
        sum = 0u; cnt = 0u; mine = 0u;
#pragma unroll
        for (unsigned j = 0; j < 16; ++j) { const unsigned c = xb_ld(&bar[XB_XCNT(j)]); sum += c; cnt += (c > 0u) ? 1u : 0u; mine = (j == x) ? c : mine; }
        if (sum == G) break;
        __builtin_amdgcn_s_sleep(1);
        if ((++sp & 255u) == 0u) { if (xb_ld(&bar[XB_TMO])) break; if (sp > XB_SPIN_CAP) { atomicAdd(&bar[XB_TMO], 1u); break; } }
    }
    nloc = mine > 0u ? mine : 1u; nx = cnt > 0u ? cnt : 1u;
}
__device__ __forceinline__ void xcd_barrier(const XcdBarrier& b) {
    asm volatile("s_waitcnt vmcnt(0)" ::: "memory");
    __syncthreads();
    if (threadIdx.x == 0) {
        unsigned* bar = b.bar;
        __builtin_amdgcn_s_waitcnt(0);
        unsigned nloc = b.st[0], nx = b.st[1];
        if (nloc == 0u) { xcd_barrier_complete(bar, b.x, nloc, nx); b.st[0] = nloc; b.st[1] = nx; }
        const unsigned old = xb_add(&bar[XB_XSUB(b.x)], 1u);
        const unsigned gen = old / nloc;
        if (old + 1u == (gen + 1u) * nloc) {
            __builtin_amdgcn_fence(__ATOMIC_RELEASE, "agent");
            asm volatile("s_waitcnt vmcnt(0)" ::: "memory");
            const unsigned og = xb_add(&bar[XB_TOP], 1u);
            const unsigned tg = og / nx;
            if (og + 1u == (tg + 1u) * nx) xb_add(&bar[XB_TOPGEN], 1u);
            else XB_SPIN(xb_ld(&bar[XB_TOPGEN]) == tg, bar);
            __builtin_amdgcn_fence(__ATOMIC_ACQUIRE, "agent");
            xb_add(&bar[XB_XGEN(b.x)], 1u);
            asm volatile("s_waitcnt vmcnt(0)" ::: "memory");
        } else {
            XB_SPIN(xb_ld(&bar[XB_XGEN(b.x)]) == gen, bar);
            __builtin_amdgcn_fence(__ATOMIC_ACQUIRE, "agent");
            asm volatile("s_waitcnt vmcnt(0)" ::: "memory");
        }
    }
    __syncthreads();
}

__device__ __forceinline__ void launder(Ctx& c) { asm volatile("" : "+s"(c.a)); asm volatile("" : "+s"(c.ws.p)); asm volatile("" : "+s"(c.wave));
    c.lane = (int)__builtin_amdgcn_mbcnt_hi(~0u, __builtin_amdgcn_mbcnt_lo(~0u, 0u)); c.tid = c.wave * 64 + c.lane; }
__global__ void __launch_bounds__(512, 2) mk_fwd(Args args) {
    extern __shared__ __attribute__((aligned(16))) unsigned char lds_raw[];
    Ctx c; c.a = (CArgs)__builtin_amdgcn_kernarg_segment_ptr(); c.lds = (LAS unsigned char*)lds_raw; c.tid = threadIdx.x; c.lane = c.tid & 63; c.wave = __builtin_amdgcn_readfirstlane(c.tid >> 6); c.nwg = gridDim.x; c.wg = blockIdx.x; c.ws.p = (GAS unsigned char*)c.a->ws;
    volatile LAS unsigned* bst = (volatile LAS unsigned*)(c.lds + LDS_BYTES - 64);
    if (c.tid < 4) bst[c.tid] = 0u;
    __syncthreads();
    const XcdBarrier bar = xcd_barrier_post((unsigned*)(c.ws + WS_CTL) + CW_BAR, bst);
    const int lo = c.a->ph_lo, hi = c.a->ph_hi;
    bool route_ok = true;
#define SEAM(k) do { if (lo <= (k) && (k) + 1 < hi) xcd_barrier(bar); } while (0)
#define IN(k) (lo <= (k) && (k) < hi && (launder(c), true))
#define PH(k, call) do { if (IN(k)) { if (PROBE_PH == (k)) { int nrep_ = 3; asm volatile("" : "+s"(nrep_)); for (int rep_ = 0; rep_ < nrep_; ++rep_) { route_ok = (rep_ + 1 == nrep_); call; if (rep_ + 1 < nrep_) xcd_barrier(bar); } } else { call; } } SEAM(k); } while (0)
    PH(0, phase_prep(c));
    PH(1, phase_convert(c));
    PH(2, { phase_gemm_qkv(c); if (c.nwg == 256) { if (c.wg >= 224) { __syncthreads(); router_tables(c, c.wg - 224, 32); } tail_steal(c, 1, 138, 0); } });
    PH(3, phase_attn(c));
    PH(4, { phase_gemm_f32<FP8_OPROJ>(c, c.ws + WS_O, R, c.ws + WS_WO, D, nullptr, (bf16_t*)(c.ws + WS_RAW1)); if (c.nwg == 256) tail_steal(c, 1, 16, 1); });
    PH(5, { phase_postmix<128>(c, 0, route_ok); convert_steal(c, 1); });
    PH(6, { phase_moe_gu(c, 0); if (c.nwg == 256) tail_steal(c, 2, 256, 3); });
    PH(7, { phase_moe_dn(c, 0); if (c.nwg == 256) tail_steal(c, 2, 256, 4); });
    PH(8, phase_combine(c, 0));
    PH(9, { phase_gemm_inproj(c); if (c.nwg == 256) tail_steal(c, 2, 80, 2); });
    PH(10, phase_hgrn_scan(c));
    PH(11, phase_hgrn_fold(c));
    PH(12, phase_hgrn_readout(c));
    PH(13, phase_gemm_f32<FP8_HOPROJ>(c, c.ws + WS_RR, L, c.ws + WS_WHO, D, nullptr, (bf16_t*)(c.ws + WS_RAW1)));
    PH(14, { phase_postmix<128>(c, 1, route_ok); convert_steal(c, 2); });
    PH(15, phase_moe_gu(c, 1));
    PH(16, phase_moe_dn(c, 1));
    PH(17, phase_combine(c, 1));
#undef IN
#undef PH
#undef SEAM
}

extern "C" void kernel_launch(void* const* d_in, const int* in_sizes, int n_in, void* d_out, int out_size, void* d_ws, size_t ws_size, hipStream_t stream) {
    static int grid = 0;
    if (grid == 0) {
        if (n_in != 21 || out_size != L * D || ws_size < WS_END) { fprintf(stderr, "kernel_launch: unexpected problem (n_in %d out %d ws %zu need %zu)\n", n_in, out_size, ws_size, (size_t)WS_END); grid = -1; return; }
        int dev = 0, cus = 0, per_cu = 0;
        hipGetDevice(&dev); hipDeviceGetAttribute(&cus, hipDeviceAttributeMultiprocessorCount, dev);
        if (hipFuncSetAttribute((const void*)mk_fwd, hipFuncAttributeMaxDynamicSharedMemorySize, LDS_BYTES) != hipSuccess) { fprintf(stderr, "kernel_launch: hipFuncSetAttribute failed\n"); grid = -1; return; }
        hipOccupancyMaxActiveBlocksPerMultiprocessor(&per_cu, (const void*)mk_fwd, 512, LDS_BYTES);
        if (per_cu < 1) fprintf(stderr, "kernel_launch: occupancy query says %d\n", per_cu);
        (void)hipGetLastError();
        grid = cus > 0 ? cus : 256;
    }
    if (grid < 0) return;
    hipMemsetAsync((char*)d_ws + WS_CTL, 0, 32768, stream);
    Args a{};
    for (int i = 0; i < 21; ++i) a.in[i] = (const float*)d_in[i];
    a.out = (float*)d_out; a.ws = (unsigned char*)d_ws;
    a.ph_lo = 0; a.ph_hi = NPHASE;
    hipLaunchKernelGGL(mk_fwd, dim3(grid), dim3(512), LDS_BYTES, stream, a);
}
```
